# Optimizing an MI355X kernel written in HIP

```python
import numpy as np
import jax
import jax.numpy as jnp
from jax import lax

D_MODEL = 2048
BATCH = 4
SEQ = 4096
DEPTH = 1

D_MIX = D_MODEL
NSA_HEADS = 16
NSA_KV_GROUPS = 4
NSA_REP = NSA_HEADS // NSA_KV_GROUPS
HEAD_DIM = 64
NSA_WIDTH = NSA_HEADS * HEAD_DIM
GMLP_WIDTH = D_MIX - NSA_WIDTH
GMLP_GROUPS = 8
GMLP_GROUP_DIM = GMLP_WIDTH // GMLP_GROUPS
GMLP_CHUNK = 128
CMP_BLOCK = 32
CMP_STRIDE = 16
CMP_HIDDEN = 256
SEL_BLOCK = 64
SEL_TOPK = 16
WINDOW = 512
Q_BLOCK = 128
N_BRANCH = 3
Q_COLS = NSA_WIDTH
KV_COLS = NSA_KV_GROUPS * HEAD_DIM
GATE_COLS = NSA_HEADS * N_BRANCH
IN_COLS = Q_COLS + 6 * KV_COLS + GATE_COLS + 2 * GMLP_WIDTH
D_FF = 5632
CONV_WIDTH = 3
NORM_EPS = 1e-6
LN_EPS = 1e-5
NEG_BIG = -1e30
SEL_BIG = 1e9

kernel_name = "hybrid_nsa_gmlp_convffn"


def _rms_norm(x, w):
    xf = x.astype(jnp.float32)
    y = xf * lax.rsqrt(jnp.mean(xf * xf, axis=-1, keepdims=True) + NORM_EPS)
    return (y * w.astype(jnp.float32)).astype(x.dtype)


def _layer_norm(x, w, b):
    xf = x.astype(jnp.float32)
    mu = jnp.mean(xf, axis=-1, keepdims=True)
    var = jnp.mean(jnp.square(xf - mu), axis=-1, keepdims=True)
    y = (xf - mu) * lax.rsqrt(var + LN_EPS)
    return (y * w.astype(jnp.float32) + b.astype(jnp.float32)).astype(x.dtype)


def _masked_softmax(s, mask):
    s = jnp.where(mask, s, NEG_BIG)
    m = jnp.max(s, axis=-1, keepdims=True)
    e = jnp.where(mask, jnp.exp(s - m), 0.0)
    return e / jnp.maximum(jnp.sum(e, axis=-1, keepdims=True), 1e-30)


def _alibi_slopes(n):
    return np.power(2.0, -8.0 * np.arange(1, n + 1) / n).astype(np.float32)


def _cmp_sel_overlap(n_cmp, n_sel):
    start = np.arange(n_cmp)[:, None] * CMP_STRIDE
    s0 = np.arange(n_sel)[None, :] * SEL_BLOCK
    return ((start < s0 + SEL_BLOCK) & (start + CMP_BLOCK > s0)).astype(np.float32)


def _compress(raw, idx, pos, w1, w2):
    blk = raw[:, idx] + pos[None, None, :, None, :]
    b, n, l, g, d = blk.shape
    blk = blk.transpose(0, 3, 1, 2, 4).reshape(b, g, n, l * d)
    return jax.nn.gelu(blk @ w1) @ w2


def _nsa(q, kc_raw, vc_raw, ks, vs, kw, vw, gate_logits, q_norm_w, k_norm_w, cmp_pos, cmp_w1, cmp_w2):
    B, T, _ = q.shape
    G, R, Dh = NSA_KV_GROUPS, NSA_REP, HEAD_DIM
    n_cmp = (T - CMP_BLOCK) // CMP_STRIDE + 1
    n_sel = T // SEL_BLOCK
    k_sel = min(SEL_TOPK, n_sel)
    n_qb = T // Q_BLOCK

    q = _rms_norm(q.reshape(B, T, NSA_HEADS, Dh), q_norm_w) * (Dh ** -0.5)
    q = q.reshape(B, T, G, R, Dh).transpose(0, 2, 3, 1, 4)
    gates = jax.nn.sigmoid(gate_logits.astype(jnp.float32))
    gates = gates.reshape(B, T, G, R, N_BRANCH).transpose(0, 2, 3, 1, 4)

    def kv_heads(a):
        return a.reshape(B, T, G, Dh)

    idx_c = np.arange(n_cmp)[:, None] * CMP_STRIDE + np.arange(CMP_BLOCK)[None, :]
    kc = _rms_norm(_compress(kv_heads(kc_raw), idx_c, cmp_pos[0], cmp_w1[0], cmp_w2[0]), k_norm_w[0])
    vc = _compress(kv_heads(vc_raw), idx_c, cmp_pos[1], cmp_w1[1], cmp_w2[1])
    cmp_end = jnp.asarray(idx_c[:, -1].astype(np.int32))
    cmp_center = jnp.asarray(idx_c.mean(axis=1).astype(np.float32))
    overlap = jnp.asarray(_cmp_sel_overlap(n_cmp, n_sel))

    ks = _rms_norm(kv_heads(ks), k_norm_w[1]).transpose(0, 2, 1, 3).reshape(B, G, n_sel, SEL_BLOCK, Dh)
    vs = kv_heads(vs).transpose(0, 2, 1, 3).reshape(B, G, n_sel, SEL_BLOCK, Dh)

    pad = ((0, 0), (0, 0), (WINDOW, 0), (0, 0))
    kw = jnp.pad(_rms_norm(kv_heads(kw), k_norm_w[2]).transpose(0, 2, 1, 3), pad)
    vw = jnp.pad(kv_heads(vw).transpose(0, 2, 1, 3), pad)

    slopes = jnp.asarray(_alibi_slopes(NSA_HEADS).reshape(G, R))[None, :, :, None, None]
    b_idx = jnp.arange(B)[:, None, None, None]
    g_idx = jnp.arange(G)[None, :, None, None]
    sel_off = jnp.arange(SEL_BLOCK, dtype=jnp.int32)
    win_off = jnp.arange(WINDOW + Q_BLOCK, dtype=jnp.int32)
    blk_ids = jnp.arange(n_sel, dtype=jnp.int32)

    def attend_block(qb):
        q0 = qb * Q_BLOCK
        qblk = lax.dynamic_slice_in_dim(q, q0, Q_BLOCK, axis=3)
        gblk = lax.dynamic_slice_in_dim(gates, q0, Q_BLOCK, axis=3)
        t = q0 + jnp.arange(Q_BLOCK, dtype=jnp.int32)
        tf = t.astype(jnp.float32)

        s_c = jnp.einsum('bgrqd,bgnd->bgrqn', qblk, kc).astype(jnp.float32)
        s_c = s_c - slopes * (tf[:, None] - cmp_center[None, :])
        p_c = _masked_softmax(s_c, cmp_end[None, :] <= t[:, None])
        o_c = jnp.einsum('bgrqn,bgnd->bgrqd', p_c.astype(vc.dtype), vc)

        imp = jnp.einsum('bgrqn,nj->bgqj', p_c, overlap)
        cur = t[:, None] // SEL_BLOCK
        valid = blk_ids[None, :] <= cur
        forced = (blk_ids[None, :] == 0) | (blk_ids[None, :] == cur) | (blk_ids[None, :] == cur - 1)
        score = jnp.where(valid, jnp.where(forced, SEL_BIG, imp), -SEL_BIG)
        top_val, top_idx = lax.top_k(score, k_sel)
        kg = ks[b_idx, g_idx, top_idx]
        vg = vs[b_idx, g_idx, top_idx]
        pos = top_idx[..., None] * SEL_BLOCK + sel_off
        m_s = (top_val > -0.5 * SEL_BIG)[..., None] & (pos <= t[:, None, None])
        s_s = jnp.einsum('bgrqd,bgqkld->bgrqkl', qblk, kg).astype(jnp.float32)
        s_s = s_s - slopes[..., None] * (tf[:, None, None] - pos.astype(jnp.float32))[:, :, None]
        n_keys = k_sel * SEL_BLOCK
        p_s = _masked_softmax(s_s.reshape(B, G, R, Q_BLOCK, n_keys),
                              m_s.reshape(B, G, 1, Q_BLOCK, n_keys)).reshape(s_s.shape)
        o_s = jnp.einsum('bgrqkl,bgqkld->bgrqd', p_s.astype(vg.dtype), vg)

        kwb = lax.dynamic_slice_in_dim(kw, q0, WINDOW + Q_BLOCK, axis=2)
        vwb = lax.dynamic_slice_in_dim(vw, q0, WINDOW + Q_BLOCK, axis=2)
        posw = q0 - WINDOW + win_off
        dist = t[:, None] - posw[None, :]
        m_w = (posw[None, :] >= 0) & (dist >= 0) & (dist < WINDOW)
        s_w = jnp.einsum('bgrqd,bgkd->bgrqk', qblk, kwb).astype(jnp.float32)
        s_w = s_w - slopes * dist.astype(jnp.float32)
        p_w = _masked_softmax(s_w, m_w)
        o_w = jnp.einsum('bgrqk,bgkd->bgrqd', p_w.astype(vwb.dtype), vwb)

        o = gblk[..., 0:1] * o_c + gblk[..., 1:2] * o_s + gblk[..., 2:3] * o_w
        return o.astype(q.dtype)

    out = lax.map(attend_block, jnp.arange(n_qb, dtype=jnp.int32))
    return out.transpose(1, 0, 4, 2, 3, 5).reshape(B, T, NSA_WIDTH)


def _spatial_gating(z, ln_w, ln_b, sw, sb):
    B, T, _ = z.shape
    u, v = jnp.split(jax.nn.gelu(z), 2, axis=-1)
    v = _layer_norm(v, ln_w, ln_b)
    v = v.reshape(B, T // GMLP_CHUNK, GMLP_CHUNK, GMLP_GROUPS, GMLP_GROUP_DIM)
    causal = jnp.tril(jnp.ones((GMLP_CHUNK, GMLP_CHUNK), dtype=bool))
    w = jnp.where(causal[None], sw, jnp.zeros_like(sw))
    v_mix = jnp.einsum('gts,bnsgc->bntgc', w, v) + sb.T[None, None, :, :, None]
    return u * v_mix.reshape(B, T, GMLP_WIDTH)


def _conv_ffn(x, w_up, conv_w, conv_b, w_down):
    h = x @ w_up
    T = h.shape[1]
    hp = jnp.pad(h, ((0, 0), (CONV_WIDTH - 1, 0), (0, 0)))
    h = conv_b + sum(conv_w[k] * hp[:, k:k + T] for k in range(CONV_WIDTH))
    gate, up = jnp.split(h, 2, axis=-1)
    return (jax.nn.silu(gate) * up) @ w_down


def setup_inputs(seed: int = 0) -> dict:
    key = jax.random.key(seed)
    ks = jax.random.split(key, 18)
    f32 = jnp.float32
    nrm = lambda k, shape, s: jax.random.normal(k, shape, f32) * s
    return {
        "x": nrm(ks[0], (BATCH, SEQ, D_MODEL), 1.0),
        "attn_norm_w": 1.0 + nrm(ks[1], (D_MODEL,), 0.02),
        "w_in": nrm(ks[2], (D_MODEL, IN_COLS), D_MODEL ** -0.5),
        "q_norm_w": 1.0 + nrm(ks[3], (HEAD_DIM,), 0.02),
        "k_norm_w": 1.0 + nrm(ks[4], (N_BRANCH, HEAD_DIM), 0.02),
        "cmp_pos": nrm(ks[5], (2, CMP_BLOCK, HEAD_DIM), 0.1),
        "cmp_w1": nrm(ks[6], (2, CMP_BLOCK * HEAD_DIM, CMP_HIDDEN), (CMP_BLOCK * HEAD_DIM) ** -0.5),
        "cmp_w2": nrm(ks[7], (2, CMP_HIDDEN, HEAD_DIM), CMP_HIDDEN ** -0.5),
        "gmlp_ln_w": 1.0 + nrm(ks[8], (GMLP_WIDTH,), 0.02),
        "gmlp_ln_b": nrm(ks[9], (GMLP_WIDTH,), 0.02),
        "spatial_w": nrm(ks[10], (GMLP_GROUPS, GMLP_CHUNK, GMLP_CHUNK), 0.5 * GMLP_CHUNK ** -0.5),
        "spatial_b": 1.0 + nrm(ks[11], (GMLP_GROUPS, GMLP_CHUNK), 0.1),
        "w_out": nrm(ks[12], (D_MIX, D_MODEL), D_MIX ** -0.5),
        "ffn_norm_w": 1.0 + nrm(ks[13], (D_MODEL,), 0.02),
        "w_up": nrm(ks[14], (D_MODEL, 2 * D_FF), D_MODEL ** -0.5),
        "conv_w": nrm(ks[15], (CONV_WIDTH, 2 * D_FF), CONV_WIDTH ** -0.5),
        "conv_b": nrm(ks[16], (2 * D_FF,), 0.02),
        "w_down": nrm(ks[17], (D_FF, D_MODEL), D_FF ** -0.5),
    }


def reference(x, attn_norm_w, w_in, q_norm_w, k_norm_w, cmp_pos, cmp_w1, cmp_w2, gmlp_ln_w, gmlp_ln_b,
              spatial_w, spatial_b, w_out, ffn_norm_w, w_up, conv_w, conv_b, w_down):
    splits = [int(c) for c in np.cumsum([Q_COLS] + [KV_COLS] * 6 + [GATE_COLS])]
    for _ in range(DEPTH):
        h = _rms_norm(x, attn_norm_w)
        proj = h @ w_in
        q, kc, vc, ksl, vsl, kwn, vwn, gl, z = jnp.split(proj, splits, axis=-1)
        a = _nsa(q, kc, vc, ksl, vsl, kwn, vwn, gl, q_norm_w, k_norm_w, cmp_pos, cmp_w1, cmp_w2)
        b = _spatial_gating(z, gmlp_ln_w, gmlp_ln_b, spatial_w, spatial_b)
        x = x + jnp.concatenate([a, b], axis=-1) @ w_out
        x = x + _conv_ffn(_rms_norm(x, ffn_norm_w), w_up, conv_w, conv_b, w_down)
    return x
```

```cpp
#include <hip/hip_runtime.h>
#include <cstdio>
#include <cstdint>

constexpr int D_MODEL = 2048, BATCH = 4, SEQ = 4096, MTOK = BATCH * SEQ;
constexpr int IN_COLS = 4656, NPROJ = 4864;
constexpr int D_FF = 5632, N_UP = 2 * D_FF;
constexpr int NBG = 16;
constexpr size_t KVSZ = (size_t)NBG * SEQ * 64;
constexpr float LOG2E = 1.4426950408889634f;

constexpr size_t MiB = 1u << 20;
constexpr size_t WS_CTL = 0;
constexpr size_t WS_WIN = 1 * MiB, WS_WOUT = 20 * MiB, WS_WUP = 28 * MiB, WS_WDOWN = 72 * MiB, WS_W1C = 94 * MiB;
constexpr size_t WS_SMALL = 96 * MiB;
constexpr size_t SM_BIASP = 0, SM_BIAS1 = 65536, SM_R2 = 131072, SM_W2T = 196608  , SM_SWB = 262144  ;
constexpr size_t WS_XN = 97 * MiB;
constexpr size_t WS_Q = 161 * MiB;
constexpr size_t WS_KV6 = 193 * MiB;
constexpr size_t WS_U = 241 * MiB, WS_GV = 273 * MiB;
constexpr size_t WS_GATES = 305 * MiB;
constexpr size_t WS_VSTAT = 308 * MiB;
constexpr size_t WS_KC = 310 * MiB, WS_VC = 310 * MiB + 524288;
constexpr size_t WS_HC = 311 * MiB;
constexpr size_t WS_AB = 315 * MiB;
constexpr size_t WS_SSQ = 379 * MiB;
constexpr size_t WS_G = 161 * MiB;
constexpr size_t WS_HID = 381 * MiB;
constexpr size_t WS_HLAST = 381 * MiB, WS_FIRST = 388 * MiB;
constexpr size_t WS_END = 469 * MiB;

#define LAS __attribute__((address_space(3)))
typedef unsigned short bf16_t;
typedef unsigned u32x4_t __attribute__((ext_vector_type(4)));
typedef unsigned u32x2_t __attribute__((ext_vector_type(2)));
typedef float f32x4_t __attribute__((ext_vector_type(4)));

__device__ __forceinline__ float bf2f(unsigned short h) { return __uint_as_float(((unsigned)h) << 16); }
__device__ __forceinline__ unsigned f2bf(float f) { unsigned u = __float_as_uint(f); return (u + 0x7fffu + ((u >> 16) & 1u)) >> 16; }
__device__ __forceinline__ unsigned pk2(float lo, float hi) { return f2bf(lo) | (f2bf(hi) << 16); }
__device__ __forceinline__ float gelu_tanh(float x) {
    const float u = 0.7978845608028654f * (x + 0.044715f * x * x * x);
    const float e = __builtin_amdgcn_exp2f(-2.8853900817779268f * u);
    return x * __builtin_amdgcn_rcpf(1.0f + e);
}
__device__ __forceinline__ float sigmoidf_(float x) { return __builtin_amdgcn_rcpf(1.0f + __builtin_amdgcn_exp2f(-LOG2E * x)); }
__device__ __forceinline__ float wave_sum(float v) {
#pragma unroll
    for (int o = 1; o < 64; o <<= 1) v += __shfl_xor(v, o);
    return v;
}
__device__ __forceinline__ void unpack8(u32x4_t r, float (&f)[8]) {
    f[0] = __uint_as_float(r.x << 16); f[1] = __uint_as_float(r.x & 0xffff0000u);
    f[2] = __uint_as_float(r.y << 16); f[3] = __uint_as_float(r.y & 0xffff0000u);
    f[4] = __uint_as_float(r.z << 16); f[5] = __uint_as_float(r.z & 0xffff0000u);
    f[6] = __uint_as_float(r.w << 16); f[7] = __uint_as_float(r.w & 0xffff0000u);
}

__device__ __forceinline__ int fresh_lane() { unsigned z_ = 0u; asm volatile("" : "+v"(z_)); return (int)__builtin_amdgcn_mbcnt_hi(~0u, __builtin_amdgcn_mbcnt_lo(~0u, z_)); }
__device__ __forceinline__ int fresh_tid(int wave_s) { return wave_s * 64 + fresh_lane(); }
namespace pg8 {
#define PG8_LAS __attribute__((address_space(3)))
typedef unsigned short bf16_t;
typedef short bf16x8 __attribute__((ext_vector_type(8)));
typedef float f32x4 __attribute__((ext_vector_type(4)));
typedef unsigned u32x4 __attribute__((ext_vector_type(4)));
constexpr int BM = 256, BK = 64, HALF = 128, HTB = HALF * BK * 2  , STAGE_BYTES = 8 * HTB, NXCD = 8, WGM = 8;

__host__ __device__ __forceinline__ int lds_byte(int r, int c) { const int st = (r >> 4) * 2 + (c >> 5), rr = r & 15, cc = c & 31, ob = rr * 64 + cc * 2; return st * 1024 + (ob ^ (((ob >> 9) & 1) << 5)); }
__host__ __device__ __forceinline__ void stage_rc(int b, int& R, int& C) { const int st = b / 1024, sb = b % 1024, swz = sb ^ (((sb >> 9) & 1) << 5); R = (st >> 1) * 16 + swz / 64; C = (st & 1) * 32 + (swz % 64) / 2; }
__host__ __device__ __forceinline__ int perm32(int rho) { const int n = rho >> 4, i = rho & 15; return 8 * (i >> 2) + 4 * n + (i & 3); }

struct Unit { int pm, pn; };
struct Gemm { const bf16_t* A; const bf16_t* Bt; int M, N, K, lda; };

struct StaticOrder {
    int nM, nN, nwg, G, c;
    __host__ __device__ void init(int M, int N, int G_, int c_) { nM = M / BM; nN = N / BM; nwg = nM * nN; G = G_; c = c_; }
    __host__ __device__ bool next(int i, Unit& u) const {
        const long L = (long)i * G + c; if (L >= nwg) return false;
        int wgid = (int)L; { const int q = nwg / NXCD, r = nwg % NXCD, xcd = wgid % NXCD, off = wgid / NXCD; wgid = (xcd < r ? xcd * (q + 1) : r * (q + 1) + (xcd - r) * q) + off; }
        const int nig = WGM * nN, gid = wgid / nig, fm = gid * WGM, gsz = (nM - fm) < WGM ? (nM - fm) : WGM;
        u.pm = fm + ((wgid % nig) % gsz); u.pn = (wgid % nig) / gsz; return true;
    }
    __device__ __forceinline__ void a_ready(const Unit&) const {}
    __device__ __forceinline__ void done(const Unit&) const {}
};

__device__ __forceinline__ unsigned cvt_pk_bf16(float lo, float hi) { unsigned r; asm volatile("v_cvt_pk_bf16_f32 %0, %1, %2" : "=v"(r) : "v"(lo), "v"(hi)); return r; }

struct EpiProj {
    static constexpr bool PERM = true, AFTER_DRAIN = false;
    bf16_t* Q; bf16_t* KV6; bf16_t* U; bf16_t* GV; float* GATES; float* VSTAT; const float* q_norm_w; const float* k_norm_w;
    __device__ __forceinline__ void operator()(const f32x4 (&acc)[2][2][4][2], const Unit& u, int wr, int wc, int fr, int fq) const {
        const int pn = u.pn, row0 = u.pm * BM + wr * 64 + fr;
        if (pn < 10) {
            const bool normed = (pn < 4) || pn == 6 || pn == 8;
            const float* w = pn < 4 ? q_norm_w : (k_norm_w + (pn == 6 ? 64 : 128));
            const float sc = pn < 4 ? 0.125f * LOG2E : 1.0f;
            f32x4 wv[2][2];
#pragma unroll
            for (int bj = 0; bj < 2; ++bj)
#pragma unroll
                for (int n = 0; n < 2; ++n) wv[bj][n] = normed ? (*(const f32x4*)(w + 32 * bj + 8 * fq + 4 * n)) * sc : (f32x4){1.f, 1.f, 1.f, 1.f};
#pragma unroll
            for (int ai = 0; ai < 2; ++ai)
#pragma unroll
                for (int m = 0; m < 4; ++m) {
                    const int row = row0 + ai * HALF + m * 16;
                    float r = 1.f;
                    if (normed) {
                        float ss = 0.f;
#pragma unroll
                        for (int bj = 0; bj < 2; ++bj)
#pragma unroll
                            for (int n = 0; n < 2; ++n) { const f32x4 x = acc[ai][bj][m][n]; ss += (x[0] * x[0] + x[1] * x[1]) + (x[2] * x[2] + x[3] * x[3]); }
                        ss += __shfl_xor(ss, 16); ss += __shfl_xor(ss, 32);
                        r = __builtin_amdgcn_rsqf(ss * (1.0f / 64.0f) + 1e-6f);
                    }
                    bf16_t* dst;
                    if (pn < 4) dst = Q + (size_t)row * 1024 + pn * 256 + wc * 64 + 8 * fq;
                    else { const int b = row >> 12, t = row & 4095; dst = KV6 + (size_t)(pn - 4) * KVSZ + ((size_t)((b * 4 + wc) * 4096 + t)) * 64 + 8 * fq; }
#pragma unroll
                    for (int bj = 0; bj < 2; ++bj) {
                        const f32x4 v0 = acc[ai][bj][m][0] * r * wv[bj][0], v1 = acc[ai][bj][m][1] * r * wv[bj][1];
                        u32x4 o; o.x = cvt_pk_bf16(v0[0], v0[1]); o.y = cvt_pk_bf16(v0[2], v0[3]); o.z = cvt_pk_bf16(v1[0], v1[1]); o.w = cvt_pk_bf16(v1[2], v1[3]);
                        *(u32x4*)(dst + 32 * bj) = o;
                    }
                }
        } else if (pn < 18) {
            const bool isv = pn >= 14; const int ct = isv ? pn - 14 : pn - 10;
            bf16_t* base = (isv ? GV : U) + ct * 256 + wc * 64 + 8 * fq;
#pragma unroll
            for (int ai = 0; ai < 2; ++ai)
#pragma unroll
                for (int m = 0; m < 4; ++m) {
                    const int row = row0 + ai * HALF + m * 16; float s1 = 0.f, s2 = 0.f;
#pragma unroll
                    for (int bj = 0; bj < 2; ++bj) {
                        f32x4 v0 = acc[ai][bj][m][0], v1 = acc[ai][bj][m][1];
#pragma unroll
                        for (int e = 0; e < 4; ++e) { v0[e] = gelu_tanh(v0[e]); v1[e] = gelu_tanh(v1[e]); s1 += v0[e] + v1[e]; s2 += v0[e] * v0[e] + v1[e] * v1[e]; }
                        u32x4 o; o.x = cvt_pk_bf16(v0[0], v0[1]); o.y = cvt_pk_bf16(v0[2], v0[3]); o.z = cvt_pk_bf16(v1[0], v1[1]); o.w = cvt_pk_bf16(v1[2], v1[3]);
                        *(u32x4*)(base + (size_t)row * 1024 + 32 * bj) = o;
                    }
                    if (isv) {
                        s1 += __shfl_xor(s1, 16); s1 += __shfl_xor(s1, 32); s2 += __shfl_xor(s2, 16); s2 += __shfl_xor(s2, 32);
                        if (fq == 0) { float* p = VSTAT + ((size_t)row * 16 + ct * 4 + wc) * 2; p[0] = s1; p[1] = s2; }
                    }
                }
        } else {
            if (wc == 0) {
#pragma unroll
                for (int ai = 0; ai < 2; ++ai)
#pragma unroll
                    for (int m = 0; m < 4; ++m) {
                        const int row = row0 + ai * HALF + m * 16;
#pragma unroll
                        for (int bj = 0; bj < 2; ++bj)
#pragma unroll
                            for (int n = 0; n < 2; ++n) {
                                const int L = 32 * bj + 8 * fq + 4 * n;
                                if (L < 48) { f32x4 v = acc[ai][bj][m][n]; f32x4 o; o[0] = sigmoidf_(v[0]); o[1] = sigmoidf_(v[1]); o[2] = sigmoidf_(v[2]); o[3] = sigmoidf_(v[3]); *(f32x4*)(GATES + (size_t)row * 48 + L) = o; }
                            }
                    }
            }
        }
    }
};
struct EpiRes1 {
    static constexpr bool PERM = false, AFTER_DRAIN = false;
    const float* x; float* out; bf16_t* X1b; float* SSQ;
    __device__ __forceinline__ void operator()(const f32x4 (&acc)[2][2][4][2], const Unit& u, int wr, int wc, int fr, int fq) const {
        const int row0 = u.pm * BM + wr * 64 + fr, col0 = u.pn * BM + wc * 32 + 4 * fq;
#pragma unroll
        for (int ai = 0; ai < 2; ++ai)
#pragma unroll
            for (int m = 0; m < 4; ++m) { const int row = row0 + ai * HALF + m * 16; const size_t off = (size_t)row * D_MODEL + col0; float ss = 0.f;
#pragma unroll
                for (int bj = 0; bj < 2; ++bj)
#pragma unroll
                    for (int n = 0; n < 2; ++n) { const size_t o2 = off + bj * HALF + n * 16; const f32x4 v = *(const f32x4*)(x + o2) + acc[ai][bj][m][n];
                        ss += (v[0] * v[0] + v[1] * v[1]) + (v[2] * v[2] + v[3] * v[3]);
                        u32x2_t w; w.x = cvt_pk_bf16(v[0], v[1]); w.y = cvt_pk_bf16(v[2], v[3]); *(u32x2_t*)(X1b + o2) = w; }
                ss += __shfl_xor(ss, 16); ss += __shfl_xor(ss, 32);
                if (fq == 0) SSQ[(size_t)row * 32 + u.pn * 4 + wc] = ss; }
    }
};
struct EpiDown {
    static constexpr bool PERM = false, AFTER_DRAIN = false;
    float* out; const bf16_t* X1b;
    __device__ __forceinline__ void operator()(const f32x4 (&acc)[2][2][4][2], const Unit& u, int wr, int wc, int fr, int fq) const {
        const int row0 = u.pm * BM + wr * 64 + fr, col0 = u.pn * BM + wc * 32 + 4 * fq;
#pragma unroll
        for (int ai = 0; ai < 2; ++ai)
#pragma unroll
            for (int m = 0; m < 4; ++m) { const size_t off = (size_t)(row0 + ai * HALF + m * 16) * D_MODEL + col0;
#pragma unroll
                for (int bj = 0; bj < 2; ++bj)
#pragma unroll
                    for (int n = 0; n < 2; ++n) { const u32x2_t w = *(const u32x2_t*)(X1b + off + bj * HALF + n * 16);
                        f32x4 v; v[0] = __uint_as_float(w.x << 16); v[1] = __uint_as_float(w.x & 0xffff0000u); v[2] = __uint_as_float(w.y << 16); v[3] = __uint_as_float(w.y & 0xffff0000u);
                        *(f32x4*)(out + off + bj * HALF + n * 16) = v + acc[ai][bj][m][n]; } }
    }
};
__device__ __forceinline__ unsigned f2bf_(float f) { unsigned u = __float_as_uint(f); return (u + 0x7fffu + ((u >> 16) & 1u)) >> 16; }
struct EpiUpConv {
    static constexpr bool PERM = true, AFTER_DRAIN = false;
    bf16_t* G; const float* SSQ; const float* cw; const float* cb; float* HLAST; float* FIRST; PG8_LAS unsigned char* xlds;
    __device__ __forceinline__ void operator()(const f32x4 (&acc)[2][2][4][2], const Unit& u, int wr, int wc, int fr_in, int fq_in) const {
        (void)fr_in; (void)fq_in;
        unsigned z_ = 0u; asm volatile("" : "+v"(z_));
        const int lane_ = (int)__builtin_amdgcn_mbcnt_hi(~0u, __builtin_amdgcn_mbcnt_lo(~0u, z_)); const int fr = lane_ & 15, fq = lane_ >> 4;
        const int row0 = u.pm * BM + wr * 64 + fr;
        PG8_LAS float* X = (PG8_LAS float*)xlds;
        const unsigned tile = (unsigned)(u.pm * (N_UP / 256) + u.pn);
        PG8_LAS float* R2L = X + 3072;
        { const int t_ = (wr * 4 + wc) * 64 + fq * 16 + fr;
          if (t_ < 256) { const f32x4* sp = (const f32x4*)(SSQ + (size_t)(u.pm * BM + t_) * 32); f32x4 a = sp[0];
#pragma unroll
              for (int i = 1; i < 8; ++i) a += sp[i];
              R2L[t_] = __builtin_amdgcn_rsqf(((a[0] + a[1]) + (a[2] + a[3])) * (1.0f / D_MODEL) + 1e-6f); } }
        asm volatile("s_waitcnt vmcnt(0) lgkmcnt(0)" ::: "memory"); __builtin_amdgcn_s_barrier(); asm volatile("" ::: "memory");
        const int lrow0 = wr * 64 + fr;
        if (fr >= 14) {
#pragma unroll
            for (int ai = 0; ai < 2; ++ai) { const int sg = 2 * ai + wr; const float r3 = R2L[lrow0 + ai * HALF + 48];
#pragma unroll
                for (int bj = 0; bj < 2; ++bj)
#pragma unroll
                    for (int n = 0; n < 2; ++n) { const f32x4 h = acc[ai][bj][3][n] * r3;
                        *(PG8_LAS f32x4*)(X + ((sg * 4 + wc) * 2 + (fr - 14)) * 64 + bj * 32 + 8 * fq + 4 * n) = h;
                        if (ai == 1 && wr == 1) *(f32x4*)(HLAST + (unsigned)((tile * 2 + (fr - 14)) * 256 + bj * HALF + wc * 32 + 8 * fq + 4 * n)) = h; } }
        }
        PG8_LAS float* Wl = X + 2048;
        { const int t_ = (wr * 4 + wc) * 64 + fq * 16 + fr;
#pragma unroll
          for (int i2 = 0; i2 < 2; ++i2) { const int i = t_ + 512 * i2, k = i >> 8, p = i & 255, c = (p < 128 ? 0 : D_FF - 128) + u.pn * 128 + p;
              Wl[i] = k < 3 ? cw[(unsigned)(k * N_UP + c)] : cb[(unsigned)c]; } }
        asm volatile("s_waitcnt vmcnt(0) lgkmcnt(0)" ::: "memory"); __builtin_amdgcn_s_barrier(); asm volatile("" ::: "memory");
        const int cbase = u.pn * 128 + wc * 32 + 8 * fq;
        const bool seq_start = (u.pm & 15) == 0;
#pragma unroll
        for (int ai = 0; ai < 2; ++ai) {
            const int sg = 2 * ai + wr;
            float rs[4];
#pragma unroll
            for (int m = 0; m < 4; ++m) rs[m] = R2L[lrow0 + ai * HALF + m * 16];
            const bool defer = (ai == 0) && (wr == 0) && !seq_start && (fr < 2);
#pragma unroll
            for (int n = 0; n < 2; ++n) {
                unsigned pk[4][2];
#pragma unroll
                for (int e = 0; e < 4; ++e) {
                    asm volatile("" ::: "memory"); __builtin_amdgcn_sched_barrier(0);
                    PG8_LAS const float* wp = Wl + wc * 32 + 8 * fq + 4 * n + e;
                    const float wg0 = wp[0], wg1 = wp[256], wg2 = wp[512], bg = wp[768], wu0 = wp[128], wu1 = wp[384], wu2 = wp[640], bu = wp[896];
                    float hg1 = 0.f, hg2 = 0.f, hu1 = 0.f, hu2 = 0.f;
                    if (ai == 1 || wr == 1) { PG8_LAS const float* xp = X + (((sg - 1) * 4 + wc) * 2) * 64 + 8 * fq + 4 * n + e; hg2 = xp[0]; hg1 = xp[64]; hu2 = xp[32]; hu1 = xp[96]; }
                    float ag = hg1, bgp = fr == 0 ? hg2 : hg1, au = hu1, bup = fr == 0 ? hu2 : hu1;
#pragma unroll
                    for (int m = 0; m < 4; ++m) {
                        const float vg = acc[ai][0][m][n][e] * rs[m], vu = acc[ai][1][m][n][e] * rs[m];
                        const float rg1 = __uint_as_float(__builtin_amdgcn_update_dpp(0u, __float_as_uint(vg), 0x121, 0xf, 0xf, false)), rg2 = __uint_as_float(__builtin_amdgcn_update_dpp(0u, __float_as_uint(vg), 0x122, 0xf, 0xf, false));
                        const float ru1 = __uint_as_float(__builtin_amdgcn_update_dpp(0u, __float_as_uint(vu), 0x121, 0xf, 0xf, false)), ru2 = __uint_as_float(__builtin_amdgcn_update_dpp(0u, __float_as_uint(vu), 0x122, 0xf, 0xf, false));
                        const float pg1 = fr >= 1 ? rg1 : ag, pg2 = fr >= 2 ? rg2 : bgp, pu1 = fr >= 1 ? ru1 : au, pu2 = fr >= 2 ? ru2 : bup;
                        const float cg = bg + wg0 * pg2 + wg1 * pg1 + wg2 * vg, cu = bu + wu0 * pu2 + wu1 * pu1 + wu2 * vu;
                        if (m == 0 && defer) { float* fp = FIRST + (unsigned)((tile * 2 + fr) * 256 + wc * 32 + 8 * fq + 4 * n + e); fp[0] = cg; fp[HALF] = cu; }
                        const unsigned hb = f2bf_(cg * sigmoidf_(cg) * cu);
                        if ((e & 1) == 0) pk[m][e >> 1] = hb; else pk[m][e >> 1] |= hb << 16;
                        ag = rg1; bgp = rg2; au = ru1; bup = ru2;
                    }
                }
#pragma unroll
                for (int m = 0; m < 4; ++m)
                    if (!(m == 0 && defer)) { u32x2_t o; o.x = pk[m][0]; o.y = pk[m][1]; *(u32x2_t*)(G + (unsigned)((row0 + ai * HALF + m * 16) * D_FF + cbase + 4 * n)) = o; }
            }
        }
    }
};
template <class Epi, class Sched, bool ALIGN_EPI = false, bool SP2 = false>
__device__ __forceinline__ void gemm_phase(PG8_LAS unsigned char* lds, const Gemm g, const Sched& S, const Epi& E, const int wave_s) {
    const int tid = fresh_tid(wave_s), wid = wave_s, lane = tid & 63,
          wr = wid >> 2, wc = wid & 3, fr = lane & 15, fq = lane >> 4;
    const int K = g.K, nt = K / BK;
    unsigned voffA[2], voffB[2];
#pragma unroll
    for (int i = 0; i < 2; ++i) { int R, C; stage_rc(tid * 16 + i * 8192, R, C); const int Rb = Epi::PERM ? ((R & ~31) + perm32(R & 31)) : R;
        voffA[i] = (unsigned)(R * g.lda + C) * 2u; voffB[i] = (unsigned)(Rb * K + C) * 2u; }
    const size_t kstep = (size_t)(BK * 2);
    const size_t hstepA = (size_t)HALF * g.lda * 2, hstepB = (size_t)HALF * K * 2;
    const size_t tstepA = 2 * hstepA, tstepB = 2 * hstepB;
    const unsigned ldsw = (unsigned)wid * 1024u;
    const int aoff = lds_byte(wr * 64 + fr, fq * 8), boff = lds_byte(wc * 32 + fr, fq * 8);
#define PG8_SA(b, h) (((b) * 2 + (h)) * HTB)
#define PG8_SB(b, h) ((4 + (b) * 2 + (h)) * HTB)
#define PG8_STAGE(bufoff, gbase, voff) do { _Pragma("unroll") for (int _i = 0; _i < 2; ++_i) \
        __builtin_amdgcn_global_load_lds((const unsigned*)((const char*)(gbase) + (voff)[_i]), (PG8_LAS unsigned*)(lds + (bufoff) + ldsw + _i * 8192), 16, 0, 0); } while (0)
#define PG8_LDA(dst, b, h) do { _Pragma("unroll") for (int m = 0; m < 4; ++m) _Pragma("unroll") for (int k = 0; k < 2; ++k) dst[m][k] = *(const PG8_LAS bf16x8*)(lds + PG8_SA(b, h) + aoff + m * 2048 + k * 1024); } while (0)
#define PG8_LDB(dst, b, h) do { _Pragma("unroll") for (int n = 0; n < 2; ++n) _Pragma("unroll") for (int k = 0; k < 2; ++k) dst[n][k] = *(const PG8_LAS bf16x8*)(lds + PG8_SB(b, h) + boff + n * 2048 + k * 1024); } while (0)
#define PG8_MMA(ai, bj, At, Bt) do { __builtin_amdgcn_s_setprio(1); _Pragma("unroll") for (int m = 0; m < 4; ++m) _Pragma("unroll") for (int n = 0; n < 2; ++n) _Pragma("unroll") for (int k = 0; k < 2; ++k) \
        acc[ai][bj][m][n] = __builtin_amdgcn_mfma_f32_16x16x32_bf16(Bt[n][k], At[m][k], acc[ai][bj][m][n], 0, 0, 0); __builtin_amdgcn_s_setprio(0); } while (0)
#define PG8_WAIT_V(n) asm volatile("s_waitcnt vmcnt(" #n ")" ::: "memory")
#define PG8_WAIT_L(n) asm volatile("s_waitcnt lgkmcnt(" #n ")" ::: "memory")
#define PG8_BAR __builtin_amdgcn_s_barrier()
#define PG8_SCHED __builtin_amdgcn_sched_barrier(0)
    Unit cur, nxt; int ui = 0;
    if (!S.next(0, cur)) return;
    f32x4 acc[2][2][4][2];
#pragma unroll
    for (int a = 0; a < 2; ++a)
#pragma unroll
        for (int b = 0; b < 2; ++b)
#pragma unroll
            for (int m = 0; m < 4; ++m)
#pragma unroll
                for (int n = 0; n < 2; ++n) acc[a][b][m][n] = (f32x4){0.f, 0.f, 0.f, 0.f};
    bf16x8 At[4][2], B0[2][2], B1[2][2];
    const char* cA = (const char*)g.A + (size_t)cur.pm * tstepA; const char* cB = (const char*)g.Bt + (size_t)cur.pn * tstepB;
    S.a_ready(cur);
    if constexpr (SP2) {
        PG8_STAGE(PG8_SB(0, 0), cB, voffB); PG8_STAGE(PG8_SB(0, 1), cB + hstepB, voffB); PG8_STAGE(PG8_SA(0, 0), cA, voffA); PG8_STAGE(PG8_SA(0, 1), cA + hstepA, voffA);
        if (wr == 1) PG8_BAR;
        PG8_WAIT_V(2); PG8_BAR;
        PG8_STAGE(PG8_SB(1, 0), cB + kstep, voffB); PG8_STAGE(PG8_SA(1, 0), cA + kstep, voffA); PG8_STAGE(PG8_SB(1, 1), cB + hstepB + kstep, voffB);
        PG8_WAIT_V(6); PG8_BAR;
    } else {
        PG8_STAGE(PG8_SB(0, 0), cB, voffB); PG8_STAGE(PG8_SA(0, 0), cA, voffA); PG8_STAGE(PG8_SB(0, 1), cB + hstepB, voffB); PG8_STAGE(PG8_SA(0, 1), cA + hstepA, voffA);
        if (wr == 1) PG8_BAR;
        PG8_WAIT_V(4); PG8_BAR;
        PG8_STAGE(PG8_SB(1, 0), cB + kstep, voffB); PG8_STAGE(PG8_SA(1, 0), cA + kstep, voffA); PG8_STAGE(PG8_SB(1, 1), cB + hstepB + kstep, voffB);
        PG8_WAIT_V(6); PG8_BAR;
    }
    for (;;) {
        const bool has_next = S.next(ui + 1, nxt);
        const char* nA = has_next ? (const char*)g.A + (size_t)nxt.pm * tstepA : cA; const char* nB = has_next ? (const char*)g.Bt + (size_t)nxt.pn * tstepB : cB;
        for (int t = 0; t < nt; t += 2) {
            const bool last = (t == nt - 2);
            const char* a1 = cA + (size_t)(t + 1) * kstep;
            const char* a2 = last ? nA : cA + (size_t)(t + 2) * kstep; const char* b2 = last ? nB : cB + (size_t)(t + 2) * kstep;
            const char* a3 = a2 + kstep; const char* b3 = b2 + kstep;
            if (last && has_next) S.a_ready(nxt);
            if constexpr (SP2) {
            PG8_LDB(B0, 0, 0); PG8_LDB(B1, 0, 1); PG8_SCHED; PG8_LDA(At, 0, 0); PG8_STAGE(PG8_SA(1, 1), a1 + hstepA, voffA);
            PG8_WAIT_V(8); PG8_WAIT_L(0); PG8_BAR; PG8_MMA(0, 0, At, B0); PG8_MMA(0, 1, At, B1); PG8_BAR; PG8_SCHED;
            PG8_LDA(At, 0, 1); PG8_STAGE(PG8_SB(0, 0), b2, voffB); PG8_STAGE(PG8_SB(0, 1), b2 + hstepB, voffB); PG8_STAGE(PG8_SA(0, 0), a2, voffA);
            PG8_WAIT_V(8); PG8_WAIT_L(0); PG8_BAR; PG8_MMA(1, 0, At, B0); PG8_MMA(1, 1, At, B1); PG8_BAR; PG8_SCHED;
            PG8_LDB(B0, 1, 0); PG8_LDB(B1, 1, 1); PG8_SCHED; PG8_LDA(At, 1, 0); PG8_STAGE(PG8_SA(0, 1), a2 + hstepA, voffA);
            PG8_WAIT_V(8); PG8_WAIT_L(0); PG8_BAR; PG8_MMA(0, 0, At, B0); PG8_MMA(0, 1, At, B1); PG8_BAR; PG8_SCHED;
            PG8_LDA(At, 1, 1); PG8_STAGE(PG8_SB(1, 0), b3, voffB); PG8_STAGE(PG8_SB(1, 1), b3 + hstepB, voffB); PG8_STAGE(PG8_SA(1, 0), a3, voffA);
            PG8_WAIT_V(8); PG8_WAIT_L(0); PG8_BAR; PG8_MMA(1, 0, At, B0); PG8_MMA(1, 1, At, B1); PG8_BAR; PG8_SCHED;
            } else {
            PG8_LDB(B0, 0, 0); PG8_SCHED; PG8_LDA(At, 0, 0); PG8_STAGE(PG8_SA(1, 1), a1 + hstepA, voffA);
            PG8_WAIT_L(8); PG8_BAR; PG8_WAIT_L(0); PG8_MMA(0, 0, At, B0); PG8_BAR; PG8_SCHED;
            PG8_LDB(B1, 0, 1); PG8_STAGE(PG8_SB(0, 0), b2, voffB);
            PG8_BAR; PG8_WAIT_L(0); PG8_MMA(0, 1, At, B1); PG8_BAR;
            PG8_LDA(At, 0, 1); PG8_STAGE(PG8_SA(0, 0), a2, voffA);
            PG8_BAR; PG8_WAIT_L(0); PG8_MMA(1, 0, At, B0); PG8_BAR; PG8_SCHED;
            PG8_STAGE(PG8_SB(0, 1), b2 + hstepB, voffB);
            PG8_WAIT_V(6); PG8_BAR; PG8_MMA(1, 1, At, B1); PG8_BAR;
            PG8_LDB(B0, 1, 0); PG8_SCHED; PG8_LDA(At, 1, 0); PG8_STAGE(PG8_SA(0, 1), a2 + hstepA, voffA);
            PG8_WAIT_L(8); PG8_BAR; PG8_WAIT_L(0); PG8_MMA(0, 0, At, B0); PG8_BAR; PG8_SCHED;
            PG8_LDB(B1, 1, 1); PG8_STAGE(PG8_SB(1, 0), b3, voffB);
            PG8_BAR; PG8_WAIT_L(0); PG8_MMA(0, 1, At, B1); PG8_BAR;
            PG8_LDA(At, 1, 1); PG8_STAGE(PG8_SA(1, 0), a3, voffA);
            PG8_BAR; PG8_WAIT_L(0); PG8_MMA(1, 0, At, B0); PG8_BAR; PG8_SCHED;
            PG8_STAGE(PG8_SB(1, 1), b3 + hstepB, voffB);
            PG8_WAIT_V(6); PG8_BAR; PG8_MMA(1, 1, At, B1); PG8_BAR;
            }
        }
        if constexpr (ALIGN_EPI) { if (wr == 0) PG8_BAR; }
        if constexpr (!Epi::AFTER_DRAIN) { E(acc, cur, wr, wc, fr, fq); S.done(cur); }
        if (!has_next) break;
#pragma unroll
        for (int a = 0; a < 2; ++a)
#pragma unroll
            for (int b = 0; b < 2; ++b)
#pragma unroll
                for (int m = 0; m < 4; ++m)
#pragma unroll
                    for (int n = 0; n < 2; ++n) acc[a][b][m][n] = (f32x4){0.f, 0.f, 0.f, 0.f};
        cur = nxt; cA = nA; cB = nB; ++ui;
        if constexpr (ALIGN_EPI) { if (wr == 1) PG8_BAR; }
    }
    PG8_WAIT_V(0);
    if constexpr (!ALIGN_EPI) { if (wr == 0) PG8_BAR; }
    PG8_BAR;
    if constexpr (Epi::AFTER_DRAIN) { E.fused(acc, cur, wr, wc, fr, fq, lds, wid, lane); S.done(cur); }
#undef PG8_SA
#undef PG8_SB
#undef PG8_STAGE
#undef PG8_LDA
#undef PG8_LDB
#undef PG8_MMA
#undef PG8_WAIT_V
#undef PG8_WAIT_L
#undef PG8_BAR
#undef PG8_SCHED
}
}
constexpr int NWAVES = 8;
template <class RowMap>
__device__ __forceinline__ void transpose_item(const float* __restrict__ W, int K, int N, bf16_t* WT, const float* __restrict__ kscale, RowMap rm, LAS float* scr, int item, int lane) {
    const int nblk = (N + 31) / 32, kb = item / nblk, nb = item % nblk, k0 = 64 * kb, n0 = 32 * nb;
    const int nr = n0 + (lane & 31);
    float v[32];
#pragma unroll
    for (int i = 0; i < 32; ++i) { const int kk = 2 * i + (lane >> 5); v[i] = (nr < N) ? W[(size_t)(k0 + kk) * N + nr] : 0.f; }
    if (kscale) {
#pragma unroll
        for (int i = 0; i < 32; ++i) v[i] *= kscale[k0 + 2 * i + (lane >> 5)];
    }
#pragma unroll
    for (int i = 0; i < 32; ++i) scr[(2 * i + (lane >> 5)) * 33 + (lane & 31)] = v[i];
    asm volatile("s_waitcnt lgkmcnt(0)" ::: "memory");
    const int c = lane & 7;
#pragma unroll
    for (int j = 0; j < 4; ++j) { const int nl = (lane >> 3) + 8 * j, n = n0 + nl;
        if (n < N) { const LAS float* s = scr + (8 * c) * 33 + nl;
            u32x4_t o; o.x = pk2(s[0 * 33], s[1 * 33]); o.y = pk2(s[2 * 33], s[3 * 33]); o.z = pk2(s[4 * 33], s[5 * 33]); o.w = pk2(s[6 * 33], s[7 * 33]);
            *(u32x4_t*)(WT + (size_t)rm(n) * K + k0 + 8 * c) = o; } }
    asm volatile("s_waitcnt lgkmcnt(0)" ::: "memory");
}
struct RmIdent { __device__ __forceinline__ int operator()(int n) const { return n; } };
struct RmWin {
    __device__ __forceinline__ int operator()(int c) const {
        const int nc = c < 2560 ? c : (c < 2608 ? 4608 + (c - 2560) : 2560 + (c - 2608));
        const int tile = nc >> 8, L = nc & 255, wc = L >> 6, bj = (L >> 5) & 1, j = L & 31;
        return tile * 256 + 128 * bj + 32 * wc + j;
    }
};
struct RmWup {
    __device__ __forceinline__ int operator()(int c) const { const int up = c >= D_FF, cc = up ? c - D_FF : c; return (cc >> 7) * 256 + up * 128 + (cc & 127); }
};

struct Ptrs {
    const float* in[18]; float* out; unsigned char* ws;
};

__device__ __forceinline__ void p0_prologue(const Ptrs& P, LAS unsigned char* lds, int vcu, int G, const int wave) {
    const int lane = fresh_lane();
    LAS float* scr = (LAS float*)(lds + wave * 16384);
    const int gw = vcu * NWAVES + wave, NGW = G * NWAVES;
    unsigned char* ws = P.ws;
    bf16_t* WinT = (bf16_t*)(ws + WS_WIN); bf16_t* WoutT = (bf16_t*)(ws + WS_WOUT); bf16_t* WupT = (bf16_t*)(ws + WS_WUP); bf16_t* WdownT = (bf16_t*)(ws + WS_WDOWN); bf16_t* W1cT = (bf16_t*)(ws + WS_W1C);
    const float* x = P.in[0]; const float* attn_norm_w = P.in[1]; const float* w_in = P.in[2]; const float* cmp_pos = P.in[5]; const float* cmp_w1 = P.in[6];
    const float* w_out = P.in[12]; const float* ffn_norm_w = P.in[13]; const float* w_up = P.in[14]; const float* w_down = P.in[17];
    constexpr int I_IN = 32 * 146, I_UP = 32 * 352, I_W1 = 32 * 8, I_W2 = 4 * 2;
    constexpr int NITEMS = I_IN + I_UP + 2 * I_W1 + 2 * I_W2;
    (void)w_out; (void)w_down; (void)WoutT; (void)WdownT;
    for (int it = gw; it < NITEMS; it += NGW) {
        int r = it;
        if (r < I_IN) { transpose_item(w_in, 2048, IN_COLS, WinT, nullptr, RmWin(), scr, r, lane); continue; } r -= I_IN;
        if (r < I_UP) { transpose_item(w_up, 2048, N_UP, WupT, ffn_norm_w, RmWup(), scr, r, lane); continue; } r -= I_UP;
        if (r < I_W1) { transpose_item(cmp_w1, 2048, 256, W1cT, nullptr, RmIdent(), scr, r, lane); continue; } r -= I_W1;
        if (r < I_W1) { transpose_item(cmp_w1 + (size_t)2048 * 256, 2048, 256, W1cT + (size_t)256 * 2048, nullptr, RmIdent(), scr, r, lane); continue; } r -= I_W1;
        { const int kv = r >= I_W2 ? 1 : 0; transpose_item(P.in[7] + (size_t)kv * 256 * 64, 256, 64, (bf16_t*)(ws + WS_SMALL + SM_W2T) + (size_t)kv * 64 * 256, nullptr, RmIdent(), scr, r - kv * I_W2, lane); }
    }
    for (int i = gw * 64 + lane; i < 8 * 16384; i += NGW * 64) { const int t = (i >> 7) & 127, sx = i & 127; ((bf16_t*)(ws + WS_SMALL + SM_SWB))[i] = (bf16_t)(sx <= t ? f2bf(P.in[10][i]) : 0u); }
    for (int p = gw; p < 256; p += NGW) {
        const int L = 64 * ((p >> 5) & 3) + 32 * (p >> 7) + (p & 31);
        if (L >= 48) { u32x4_t z = {0u, 0u, 0u, 0u}; u32x4_t* d = (u32x4_t*)(WinT + (size_t)(18 * 256 + p) * 2048);
#pragma unroll
            for (int j = 0; j < 4; ++j) d[lane + 64 * j] = z; }
    }
    bf16_t* XN = (bf16_t*)(ws + WS_XN);
    for (int m = gw; m < MTOK; m += 2 * NGW) {
        const int m2 = m + NGW;
        const f32x4_t* xr = (const f32x4_t*)(x + (size_t)m * D_MODEL) + lane;
        const f32x4_t* xr2 = (const f32x4_t*)(x + (size_t)(m2 < MTOK ? m2 : m) * D_MODEL) + lane;
        f32x4_t v[8], v2[8]; float s = 0.f, s2 = 0.f;
#pragma unroll
        for (int j = 0; j < 8; ++j) { v[j] = xr[64 * j]; v2[j] = xr2[64 * j]; }
#pragma unroll
        for (int j = 0; j < 8; ++j) { s += (v[j][0] * v[j][0] + v[j][1] * v[j][1]) + (v[j][2] * v[j][2] + v[j][3] * v[j][3]); s2 += (v2[j][0] * v2[j][0] + v2[j][1] * v2[j][1]) + (v2[j][2] * v2[j][2] + v2[j][3] * v2[j][3]); }
        const float r = __builtin_amdgcn_rsqf(wave_sum(s) * (1.0f / D_MODEL) + 1e-6f), r2 = __builtin_amdgcn_rsqf(wave_sum(s2) * (1.0f / D_MODEL) + 1e-6f);
        u32x2_t* o8 = (u32x2_t*)(XN + (size_t)m * D_MODEL) + lane; u32x2_t* o82 = (u32x2_t*)(XN + (size_t)m2 * D_MODEL) + lane;
#pragma unroll
        for (int j = 0; j < 8; ++j) { const f32x4_t w = ((const f32x4_t*)attn_norm_w)[lane + 64 * j];
            u32x2_t o; o.x = pk2(v[j][0] * r * w[0], v[j][1] * r * w[1]); o.y = pk2(v[j][2] * r * w[2], v[j][3] * r * w[3]); o8[64 * j] = o;
            if (m2 < MTOK) { u32x2_t q; q.x = pk2(v2[j][0] * r2 * w[0], v2[j][1] * r2 * w[1]); q.y = pk2(v2[j][2] * r2 * w[2], v2[j][3] * r2 * w[3]); o82[64 * j] = q; } }
    }
    float* BIASP = (float*)(ws + WS_SMALL + SM_BIASP);
    for (int it = gw; it < 64; it += NGW) {
        const int kv = it >> 5, kc = it & 31; f32x4_t a = {0.f, 0.f, 0.f, 0.f};
        const float* pp = cmp_pos + kv * 2048 + kc * 64; const float* w1 = cmp_w1 + ((size_t)kv * 2048 + kc * 64) * 256;
        for (int k = 0; k < 64; ++k) { const f32x4_t w = ((const f32x4_t*)(w1 + (size_t)k * 256))[lane]; a += w * pp[k]; }
        ((f32x4_t*)(BIASP + (size_t)it * 256))[lane] = a;
    }
}

__device__ __forceinline__ void p1_tail_transposes(const Ptrs& P, LAS unsigned char* lds, int vb, int nb, const int wave) {
    const int lane = fresh_lane();
    LAS float* scr = (LAS float*)(lds + wave * 16384);
    const int gw = vb * NWAVES + wave, NGW = nb * NWAVES;
    unsigned char* ws = P.ws;
    constexpr int I_OUT = 32 * 64, I_DOWN = 88 * 64;
    for (int it = gw; it < I_OUT + I_DOWN; it += NGW) {
        if (it < I_OUT) transpose_item(P.in[12], 2048, 2048, (bf16_t*)(ws + WS_WOUT), nullptr, RmIdent(), scr, it, lane);
        else transpose_item(P.in[17], D_FF, 2048, (bf16_t*)(ws + WS_WDOWN), nullptr, RmIdent(), scr, it - I_OUT, lane);
    }
}

__device__ __forceinline__ void bias1_stage(unsigned char* ws, int idx  ) {
    const float* BIASP = (const float*)(ws + WS_SMALL + SM_BIASP); float* BIAS1 = (float*)(ws + WS_SMALL + SM_BIAS1);
    const int kv = idx >> 8, j = idx & 255; float s = 0.f;
    for (int kc = 0; kc < 32; ++kc) s += BIASP[(size_t)(kv * 32 + kc) * 256 + j];
    BIAS1[idx] = s;
}
namespace nsa {
using bf16x8 = __attribute__((ext_vector_type(8))) short;
using s16x4 = __attribute__((ext_vector_type(4))) short;
using f32x16 = __attribute__((ext_vector_type(16))) float;
typedef float f32x2_t __attribute__((ext_vector_type(2))); typedef __bf16 bf16x2_t __attribute__((ext_vector_type(2)));
constexpr int L_K = 0, L_V = 16384, L_WSF = 32768, L_OST = 34816, L_IMP = 100352, L_MASK = 116736, L_WU = 117248, L_END = 117312;
constexpr int SLOTB = 8192;
constexpr float THR = 8.0f;
#define NSA_SBAR() __builtin_amdgcn_sched_barrier(0)
__device__ __forceinline__ int crow(int r, int hi) { return (r & 3) + 8 * (r >> 2) + 4 * hi; }
__device__ __forceinline__ void glds16(const void* gbase  , unsigned voff  , unsigned lds_dst) { unsigned keep;
    asm volatile("s_mov_b32 %0, m0\n\ts_mov_b32 m0, %3\n\ts_nop 0\n\tglobal_load_lds_dwordx4 %1, %2\n\ts_mov_b32 m0, %0" : "=&s"(keep) : "v"(voff), "s"(gbase), "s"(lds_dst) : "memory"); }
__device__ __forceinline__ unsigned cvtpk_s(float lo, float hi) { f32x2_t v = {lo, hi}; bf16x2_t b = __builtin_convertvector(v, bf16x2_t); return __builtin_bit_cast(unsigned, b); }
#define NSA_WAIT_BAR() asm volatile("s_waitcnt vmcnt(0) lgkmcnt(0)\n\ts_barrier" ::: "memory")

__device__ __forceinline__ void qkt(f32x16& p0, f32x16& p1, LAS const char* Kslot, const bf16x8 (&qr)[4], int r32, int hi) {
    LAS const char* kb = Kslot + hi * 1024 + r32 * 16;
#pragma unroll
    for (int d0 = 0; d0 < 4; ++d0) {
        const bf16x8 b0 = *(LAS const bf16x8*)(kb + d0 * 2048);
        const bf16x8 b1 = *(LAS const bf16x8*)(kb + d0 * 2048 + 512);
        p0 = __builtin_amdgcn_mfma_f32_32x32x16_bf16(b0, qr[d0], p0, 0, 0, 0); p1 = __builtin_amdgcn_mfma_f32_32x32x16_bf16(b1, qr[d0], p1, 0, 0, 0);
    }
}
struct VFrag { s16x4 lo[2][4], hi[2][4]; };
__device__ __forceinline__ void vload(VFrag& f, int vb) {
#pragma unroll
    for (int d0 = 0; d0 < 2; ++d0)
#pragma unroll
        for (int ks = 0; ks < 4; ++ks) {
            asm volatile("ds_read_b64_tr_b16 %0,%1 offset:%c2" : "=&v"(f.lo[d0][ks]) : "v"(vb), "i"(d0 * 4096 + ks * 1024) : "memory");
            asm volatile("ds_read_b64_tr_b16 %0,%1 offset:%c2" : "=&v"(f.hi[d0][ks]) : "v"(vb), "i"(d0 * 4096 + ks * 1024 + 512) : "memory"); }
}
__device__ __forceinline__ void pvmma(f32x16 (&o)[2], VFrag& f, bf16x8 pa0, bf16x8 pa1, bf16x8 pa2, bf16x8 pa3) {
    asm volatile("s_waitcnt lgkmcnt(0)" : "+v"(f.lo[0][0]), "+v"(f.lo[0][1]), "+v"(f.lo[0][2]), "+v"(f.lo[0][3]), "+v"(f.hi[0][0]), "+v"(f.hi[0][1]), "+v"(f.hi[0][2]), "+v"(f.hi[0][3]) :: "memory");
    asm volatile("" : "+v"(f.lo[1][0]), "+v"(f.lo[1][1]), "+v"(f.lo[1][2]), "+v"(f.lo[1][3]), "+v"(f.hi[1][0]), "+v"(f.hi[1][1]), "+v"(f.hi[1][2]), "+v"(f.hi[1][3]));
    NSA_SBAR();
#pragma unroll
    for (int d0 = 0; d0 < 2; ++d0) {
#define NSA_PK(k) (bf16x8){f.lo[d0][k][0], f.lo[d0][k][1], f.lo[d0][k][2], f.lo[d0][k][3], f.hi[d0][k][0], f.hi[d0][k][1], f.hi[d0][k][2], f.hi[d0][k][3]}
        o[d0] = __builtin_amdgcn_mfma_f32_32x32x16_bf16(pa0, NSA_PK(0), o[d0], 0, 0, 0);
        o[d0] = __builtin_amdgcn_mfma_f32_32x32x16_bf16(pa1, NSA_PK(1), o[d0], 0, 0, 0);
        o[d0] = __builtin_amdgcn_mfma_f32_32x32x16_bf16(pa2, NSA_PK(2), o[d0], 0, 0, 0);
        o[d0] = __builtin_amdgcn_mfma_f32_32x32x16_bf16(pa3, NSA_PK(3), o[d0], 0, 0, 0);
#undef NSA_PK
    }
}
__device__ __forceinline__ void pv(f32x16 (&o)[2], int vb, bf16x8 pa0, bf16x8 pa1, bf16x8 pa2, bf16x8 pa3) { VFrag f; vload(f, vb); pvmma(o, f, pa0, pa1, pa2, pa3); }
__device__ __forceinline__ float rowmax32(const f32x16& p0, const f32x16& p1) {
    float a = __builtin_fmaxf(p0[0], p1[0]);
#pragma unroll
    for (int r = 1; r < 16; ++r) a = __builtin_fmaxf(a, __builtin_fmaxf(p0[r], p1[r]));
    auto rr = __builtin_amdgcn_permlane32_swap(__float_as_uint(a), __float_as_uint(a), false, false);
    return __builtin_fmaxf(__uint_as_float(rr[0]), __uint_as_float(rr[1]));
}
struct State { float m, l; f32x16 o[2]; };
__device__ __forceinline__ void state_init(State& s) { s.m = -1e30f; s.l = 0.f; s.o[0] = f32x16{}; s.o[1] = f32x16{}; }

template <int BMUL, int MASK, bool LOADV>
__device__ __forceinline__ void tile_scores(f32x16& p0, f32x16& p1, LAS const char* Kslot, const bf16x8 (&qr)[4], const f32x16& bk, float c0, float b32, int lim, int r32, int hi, VFrag& vf, int vb) {
#pragma unroll
    for (int r = 0; r < 16; ++r) { const float b = (BMUL == 1) ? bk[r] + c0 : __builtin_fmaf(bk[r], (float)BMUL, c0); p0[r] = b; p1[r] = b + b32; }
    qkt(p0, p1, Kslot, qr, r32, hi);
    if (LOADV) vload(vf, vb);
    const int limh = lim - 4 * hi;
#pragma unroll
    for (int r = 0; r < 16; ++r) {
        const int kk = (r & 3) + 8 * (r >> 2);
        if (MASK == 1) { if (!(kk <= limh)) p0[r] = -INFINITY; if (!(kk + 32 <= limh)) p1[r] = -INFINITY; }
        if (MASK == 2) { if (!(kk > limh)) p0[r] = -INFINITY; if (!(kk + 32 > limh)) p1[r] = -INFINITY; }
        if (MASK == 3) { if (!(kk < limh)) p0[r] = -INFINITY; if (!(kk + 32 < limh)) p1[r] = -INFINITY; }
    }
}
__device__ __forceinline__ float tile_ref(const State& st, float rb0, bool rowlive) { return (st.m < -1e29f && rowlive) ? rb0 : st.m; }
__device__ __forceinline__ void tile_softmax_pv(State& st, f32x16& p0, f32x16& p1, float mref, VFrag& vf, LAS float* wsf, int r32, int hi) {
    float a0 = p0[0], a1 = p1[0];
#pragma unroll
    for (int r = 1; r < 16; ++r) { a0 = __builtin_fmaxf(a0, p0[r]); a1 = __builtin_fmaxf(a1, p1[r]); }
    float mx = __builtin_fmaxf(a0, a1);
    { auto rr = __builtin_amdgcn_permlane32_swap(__float_as_uint(mx), __float_as_uint(mx), false, false); mx = __builtin_fmaxf(__uint_as_float(rr[0]), __uint_as_float(rr[1])); }
    if (__any(mx > THR)) {
        const float dl = __builtin_fmaxf(mx, 0.f), alpha = __builtin_amdgcn_exp2f(-dl);
        mref += dl; st.l *= alpha;
        if (hi == 0) wsf[r32] = alpha;
        asm volatile("s_waitcnt lgkmcnt(0)" ::: "memory");
#pragma unroll
        for (int r = 0; r < 16; ++r) { const float a = wsf[crow(r, hi)]; st.o[0][r] *= a; st.o[1][r] *= a; p0[r] -= dl; p1[r] -= dl; }
    }
    st.m = mref;
    float ls = 0.f;
#pragma unroll
    for (int r = 0; r < 16; ++r) { p0[r] = __builtin_amdgcn_exp2f(p0[r]); p1[r] = __builtin_amdgcn_exp2f(p1[r]); ls += p0[r] + p1[r]; }
    st.l += ls;
    u32x4_t pw0, pw1, pw2, pw3;
    pw0 = (u32x4_t){cvtpk_s(p0[0], p0[1]), cvtpk_s(p0[2], p0[3]), cvtpk_s(p0[4], p0[5]), cvtpk_s(p0[6], p0[7])};
    pw1 = (u32x4_t){cvtpk_s(p0[8], p0[9]), cvtpk_s(p0[10], p0[11]), cvtpk_s(p0[12], p0[13]), cvtpk_s(p0[14], p0[15])};
    pw2 = (u32x4_t){cvtpk_s(p1[0], p1[1]), cvtpk_s(p1[2], p1[3]), cvtpk_s(p1[4], p1[5]), cvtpk_s(p1[6], p1[7])};
    pw3 = (u32x4_t){cvtpk_s(p1[8], p1[9]), cvtpk_s(p1[10], p1[11]), cvtpk_s(p1[12], p1[13]), cvtpk_s(p1[14], p1[15])};
    pvmma(st.o, vf, __builtin_bit_cast(bf16x8, pw0), __builtin_bit_cast(bf16x8, pw1), __builtin_bit_cast(bf16x8, pw2), __builtin_bit_cast(bf16x8, pw3));
}
template <bool FIRST>
__device__ __forceinline__ void fold_branch(LAS float* ostg, State& st, float gate, LAS float* wsf, int r32, int hi) {
    float l = st.l;
    { auto rr = __builtin_amdgcn_permlane32_swap(__float_as_uint(l), __float_as_uint(l), false, false); l = __uint_as_float(rr[0]) + __uint_as_float(rr[1]); }
    const float f = l > 0.f ? gate / l : 0.f;
    asm volatile("s_waitcnt lgkmcnt(0)" ::: "memory");
    if (hi == 0) wsf[r32] = f;
    asm volatile("s_waitcnt lgkmcnt(0)" ::: "memory");
#pragma unroll
    for (int r = 0; r < 16; ++r) { const int orow = crow(r, hi); const float a = wsf[orow];
#pragma unroll
        for (int d0 = 0; d0 < 2; ++d0) { LAS float* p = ostg + orow * 64 + d0 * 32 + r32; if (FIRST) *p = st.o[d0][r] * a; else *p += st.o[d0][r] * a; } }
    asm volatile("s_waitcnt lgkmcnt(0)" ::: "memory");
}

__device__ __forceinline__ void nsa_unit(const Ptrs& P, LAS unsigned char* lds, int bg, int qt, const int wave_s) {
    unsigned char* ws = P.ws;
    const int lane = fresh_lane(), r32 = lane & 31, hi = lane >> 5; const int wid = wave_s;
    const int b = bg >> 2, g = bg & 3, t0 = 64 * qt;
    const int tl = 8 * wid + (r32 >> 2), hq = r32 & 3;
    const size_t m0 = (size_t)b * SEQ + t0;
    const bf16_t* Q = (const bf16_t*)(ws + WS_Q); const bf16_t* KV6 = (const bf16_t*)(ws + WS_KV6);
    const bf16_t* KSb = KV6 + 2 * KVSZ + (size_t)bg * SEQ * 64; const bf16_t* VSb = KV6 + 3 * KVSZ + (size_t)bg * SEQ * 64;
    const bf16_t* KWb = KV6 + 4 * KVSZ + (size_t)bg * SEQ * 64; const bf16_t* VWb = KV6 + 5 * KVSZ + (size_t)bg * SEQ * 64;
    const bf16_t* KCb = (const bf16_t*)(ws + WS_KC) + (size_t)bg * 256 * 64; const bf16_t* VCb = (const bf16_t*)(ws + WS_VC) + (size_t)bg * 256 * 64;
    const float* GATES = (const float*)(ws + WS_GATES); bf16_t* AB = (bf16_t*)(ws + WS_AB);
    const unsigned lds0 = (unsigned)(uintptr_t)lds;
    LAS float* wsf = (LAS float*)(lds + L_WSF) + wid * 64;
    LAS float* IMP = (LAS float*)(lds + L_IMP);
    LAS unsigned* MASK = (LAS unsigned*)(lds + L_MASK); LAS unsigned* WU = (LAS unsigned*)(lds + L_WU);
    const int koff = lane * 64 + wid * 8, voff = (16 * (wid & 3) + (lane >> 2)) * 64 + (wid >> 2) * 32 + (lane & 3) * 8;
    const unsigned kdst = lds0 + L_K + wid * 1024, vdst = lds0 + L_V + wid * 1024;
#define NSA_DMA_K(base, tile, slot) glds16((base) + (size_t)(tile) * 4096, (unsigned)koff * 2u, (unsigned)__builtin_amdgcn_readfirstlane(kdst + (slot) * SLOTB))
#define NSA_DMA_V(base, tile, slot) glds16((base) + (size_t)(tile) * 4096, (unsigned)voff * 2u, (unsigned)__builtin_amdgcn_readfirstlane(vdst + (slot) * SLOTB))
    const int vb0 = (int)(lds0 + L_V) + ((lane >> 4) & 1) * 32 + (lane & 3) * 8 + (4 * hi + ((lane & 15) >> 2)) * 64;
    LAS const char* Kbase = (LAS const char*)(lds + L_K);
    bf16x8 qr[4];
    { const bf16_t* qp = Q + (m0 + tl) * 1024 + (4 * g + hq) * 64 + hi * 8;
#pragma unroll
      for (int d0 = 0; d0 < 4; ++d0) qr[d0] = *(const bf16x8*)(qp + d0 * 16); }
    const float sl2 = __builtin_amdgcn_exp2f(-0.5f * (float)(4 * g + hq + 1)) * LOG2E;
    f32x16 bk;
#pragma unroll
    for (int r = 0; r < 16; ++r) bk[r] = sl2 * (float)((r & 3) + 8 * (r >> 2));
    const float b32t = 32.0f * sl2, b32c = 512.0f * sl2, hoff_t = 4.0f * (float)hi * sl2, hoff_c = 64.0f * (float)hi * sl2;
    float gate[3];
    { const float* gp = GATES + (m0 + tl) * 48 + (4 * g + hq) * 3; gate[0] = gp[0]; gate[1] = gp[1]; gate[2] = gp[2]; }
    LAS float* ostg = (LAS float*)(lds + L_OST) + wid * 2048;
    State st;
    f32x16 p0, p1;

    int tc = 0;
    VFrag vf;
    const int nvmax = (t0 + 63 >= 31) ? ((t0 + 63 - 31) >> 4) + 1 : 0;
    const int nct = (nvmax + 63) >> 6;
    const int tq = t0 + tl, nv = tq >= 31 ? ((tq - 31) >> 4) + 1 : 0;
    {
        state_init(st);
        const int j0 = qt >= 8 ? qt - 8 : 0, nt = qt - j0 + 1;
        NSA_DMA_K(KWb, j0, 0); NSA_DMA_V(VWb, j0, 0); NSA_WAIT_BAR();
        for (int i = 0; i < nt; ++i) {
            const int j = j0 + i, slot = (tc + i) & 1;
            if (i + 1 < nt) { NSA_DMA_K(KWb, j + 1, slot ^ 1); NSA_DMA_V(VWb, j + 1, slot ^ 1); }
            else { NSA_DMA_K(KCb, 0, slot ^ 1); NSA_DMA_V(VCb, 0, slot ^ 1); }
            const float rb0 = sl2 * (float)(64 * j - t0), mref = tile_ref(st, rb0, true), c0 = rb0 + hoff_t - mref;
            if (j == qt) tile_scores<1, 1, true>(p0, p1, Kbase + slot * SLOTB, qr, bk, c0, b32t, tl, r32, hi, vf, vb0 + slot * SLOTB);
            else if (j == qt - 8) tile_scores<1, 2, true>(p0, p1, Kbase + slot * SLOTB, qr, bk, c0, b32t, tl, r32, hi, vf, vb0 + slot * SLOTB);
            else tile_scores<1, 0, true>(p0, p1, Kbase + slot * SLOTB, qr, bk, c0, b32t, 0, r32, hi, vf, vb0 + slot * SLOTB);
            tile_softmax_pv(st, p0, p1, mref, vf, wsf, r32, hi);
            NSA_WAIT_BAR();
        }
        tc += nt;
        fold_branch<true>(ostg, st, gate[2], wsf, r32, hi);
    }
    {
        state_init(st);
        for (int c = 0; c < nct; ++c) {
            const int slot = (tc + c) & 1;
            if (c + 1 < nct) { NSA_DMA_K(KCb, c + 1, slot ^ 1); NSA_DMA_V(VCb, c + 1, slot ^ 1); }
            else if (qt >= 16) { NSA_DMA_K(KCb, 0, slot ^ 1); }
            else { NSA_DMA_K(KSb, 0, slot ^ 1); NSA_DMA_V(VSb, 0, slot ^ 1); }
            const float rb0 = sl2 * ((float)(1024 * c - t0) + 15.5f), mref = tile_ref(st, rb0, true), c0 = rb0 + hoff_c - mref;
            tile_scores<16, 3, true>(p0, p1, Kbase + slot * SLOTB, qr, bk, c0, b32c, nv - 64 * c, r32, hi, vf, vb0 + slot * SLOTB);
            tile_softmax_pv(st, p0, p1, mref, vf, wsf, r32, hi);
            NSA_WAIT_BAR();
        }
        tc += nct;
    }
    const float mc_fin = st.m; float lc = st.l;
    fold_branch<false>(ostg, st, gate[0], wsf, r32, hi);
    if (qt >= 16) {
        { auto rr = __builtin_amdgcn_permlane32_swap(__float_as_uint(lc), __float_as_uint(lc), false, false); lc = __uint_as_float(rr[0]) + __uint_as_float(rr[1]); }
        const float invl = lc > 0.f ? 1.0f / lc : 0.f;
        float carry = 0.f;
        for (int c = 0; c < nct; ++c) {
            const int slot = (tc + c) & 1;
            if (c + 1 < nct) { NSA_DMA_K(KCb, c + 1, slot ^ 1); }
            else { NSA_DMA_K(KSb, 0, slot ^ 1); NSA_DMA_V(VSb, 0, slot ^ 1); }
            const float c0 = sl2 * ((float)(1024 * c - t0) + 15.5f) + hoff_c - mc_fin;
            tile_scores<16, 3, false>(p0, p1, Kbase + slot * SLOTB, qr, bk, c0, b32c, nv - 64 * c, r32, hi, vf, 0);
#pragma unroll
            for (int r = 0; r < 16; ++r) { p0[r] = __builtin_amdgcn_exp2f(p0[r]) * invl; p1[r] = __builtin_amdgcn_exp2f(p1[r]) * invl; }
            float imp0[4], imp1[4], pl0[4], pl1[4];
#pragma unroll
            for (int a = 0; a < 4; ++a) {
                imp0[a] = (p0[4 * a] + p0[4 * a + 1]) + (p0[4 * a + 2] + p0[4 * a + 3]); imp1[a] = (p1[4 * a] + p1[4 * a + 1]) + (p1[4 * a + 2] + p1[4 * a + 3]);
                pl0[a] = __shfl_xor(p0[4 * a + 3], 32); pl1[a] = __shfl_xor(p1[4 * a + 3], 32);
            }
            if (hi) {
#pragma unroll
                for (int a = 0; a < 4; ++a) { imp0[a] += pl0[a]; imp1[a] += pl1[a]; }
            } else {
                imp0[0] += carry; imp1[0] += pl0[3];
#pragma unroll
                for (int a = 1; a < 4; ++a) { imp0[a] += pl0[a - 1]; imp1[a] += pl1[a - 1]; }
            }
            carry = pl1[3];
#pragma unroll
            for (int a = 0; a < 4; ++a) {
                imp0[a] += __shfl_xor(imp0[a], 1); imp0[a] += __shfl_xor(imp0[a], 2); imp1[a] += __shfl_xor(imp1[a], 1); imp1[a] += __shfl_xor(imp1[a], 2);
                if (hq == 0) { IMP[tl * 64 + 16 * c + 2 * a + hi] = imp0[a]; IMP[tl * 64 + 16 * c + 8 + 2 * a + hi] = imp1[a]; }
            }
            NSA_WAIT_BAR();
        }
        tc += nct;
    }
    unsigned long long wu = 0ull;
    if (qt < 16) {
        wu = (2ull << qt) - 1ull;
        if (lane < 8) { MASK[2 * (8 * wid + lane)] = (unsigned)wu; MASK[2 * (8 * wid + lane) + 1] = (unsigned)(wu >> 32); }
    } else {
        const int j = lane; const bool valid = j <= qt, forced = (j == 0) || (j == qt) || (j == qt - 1);
        for (int k = 0; k < 8; ++k) {
            const float imp = IMP[(8 * wid + k) * 64 + j];
            const float scv = valid ? (forced ? 1e9f : imp) : -1e9f;
            const unsigned fb = __float_as_uint(scv), key = fb ^ ((fb >> 31) ? 0xffffffffu : 0x80000000u);
            unsigned T = 0u;
#pragma unroll
            for (int bit = 31; bit >= 0; --bit) { const unsigned cand = T | (1u << bit); if (__builtin_popcountll(__ballot(key >= cand)) >= 16) T = cand; }
            const unsigned long long gt = __ballot(key > T), eq = __ballot(key == T);
            const int need = 16 - __builtin_popcountll(gt);
            const int before = (int)__builtin_amdgcn_mbcnt_hi((unsigned)(eq >> 32), __builtin_amdgcn_mbcnt_lo((unsigned)eq, 0u));
            const bool sel = (key > T) || ((key == T) && (before < need));
            const unsigned long long mk = __ballot(sel && (scv > -0.5e9f));
            wu |= mk;
            if (lane == 0) { MASK[2 * (8 * wid + k)] = (unsigned)mk; MASK[2 * (8 * wid + k) + 1] = (unsigned)(mk >> 32); }
        }
    }
    if (lane == 0) { WU[2 * wid] = (unsigned)wu; WU[2 * wid + 1] = (unsigned)(wu >> 32); }
    NSA_WAIT_BAR();
    unsigned long long uni = 0ull;
#pragma unroll
    for (int w = 0; w < 8; ++w) uni |= ((unsigned long long)WU[2 * w]) | (((unsigned long long)WU[2 * w + 1]) << 32);
    uni = ((unsigned long long)__builtin_amdgcn_readfirstlane((unsigned)uni)) | (((unsigned long long)__builtin_amdgcn_readfirstlane((unsigned)(uni >> 32))) << 32);
    const unsigned long long mymask = ((unsigned long long)MASK[2 * tl]) | (((unsigned long long)MASK[2 * tl + 1]) << 32);
    {
        state_init(st);
        unsigned long long rem = uni;
        int j = __builtin_ctzll(rem); rem &= rem - 1;
        for (int i = 0;; ++i) {
            const int slot = (tc + i) & 1; const bool more = rem != 0ull;
            int jn = 0;
            if (more) { jn = __builtin_ctzll(rem); rem &= rem - 1; NSA_DMA_K(KSb, jn, slot ^ 1); NSA_DMA_V(VSb, jn, slot ^ 1); }
            if ((wu >> j) & 1ull) {
                const bool live = ((mymask >> j) & 1ull) != 0ull;
                const float rb0 = sl2 * (float)(64 * j - t0), mref = tile_ref(st, rb0, live), c0 = live ? rb0 + hoff_t - mref : -INFINITY;
                if (j == qt) tile_scores<1, 1, true>(p0, p1, Kbase + slot * SLOTB, qr, bk, c0, b32t, tl, r32, hi, vf, vb0 + slot * SLOTB);
                else tile_scores<1, 0, true>(p0, p1, Kbase + slot * SLOTB, qr, bk, c0, b32t, 0, r32, hi, vf, vb0 + slot * SLOTB);
                tile_softmax_pv(st, p0, p1, mref, vf, wsf, r32, hi);
            }
            NSA_WAIT_BAR();
            if (!more) break;
            j = jn;
        }
        fold_branch<false>(ostg, st, gate[1], wsf, r32, hi);
    }
    {
#pragma unroll
        for (int i = 0; i < 4; ++i) { const int row = i * 8 + (lane >> 3), ch = lane & 7;
            const f32x4_t v0 = *(LAS const f32x4_t*)(ostg + row * 64 + ch * 8), v1 = *(LAS const f32x4_t*)(ostg + row * 64 + ch * 8 + 4);
            u32x4_t v; v.x = cvtpk_s(v0[0], v0[1]); v.y = cvtpk_s(v0[2], v0[3]); v.z = cvtpk_s(v1[0], v1[1]); v.w = cvtpk_s(v1[2], v1[3]);
            *(u32x4_t*)(AB + (m0 + 8 * wid + (row >> 2)) * 2048 + 256 * g + (row & 3) * 64 + ch * 8) = v; }
    }
    NSA_WAIT_BAR();
#undef NSA_DMA_K
#undef NSA_DMA_V
}
__device__ __forceinline__ void nsa_phase(const Ptrs& P, LAS unsigned char* lds, int bid, int G, const int wave_s) {
    for (int u = bid; u < 1024; u += G) {
        const int c = u & 255, i = u >> 8, s = c & 63;
        nsa_unit(P, lds, 4 * (c >> 6) + i, (i & 1) ? 63 - s : s, wave_s);
    }
}
}

namespace p2 {
using nsa::bf16x8; using nsa::f32x16; using nsa::s16x4; using nsa::crow; using nsa::glds16; using nsa::cvtpk_s;
#define P2_WAIT_BAR() asm volatile("s_waitcnt vmcnt(0) lgkmcnt(0)\n\ts_barrier" ::: "memory")
constexpr int CB_BUF = 40960;
constexpr int CP_STRIDE = 65;
__device__ __forceinline__ void compress_unit(const Ptrs& P, LAS unsigned char* lds, int u, const int wave_s) {
    unsigned char* ws = P.ws;
    const int lane = fresh_lane(), r32 = lane & 31, hi = lane >> 5, wid = wave_s;
    const int kv = u >> 6, bg = (u >> 2) & 15, n0 = 64 * (u & 3);
    const bf16_t* Ag = (const bf16_t*)(ws + WS_KV6) + (size_t)kv * KVSZ + (size_t)bg * SEQ * 64 + (size_t)n0 * 1024;
    const bf16_t* Bg = (const bf16_t*)(ws + WS_W1C) + (size_t)kv * 256 * 2048;
    const unsigned lds0 = (unsigned)(uintptr_t)lds;
    const unsigned aoff = (unsigned)(lane * 1024 + wid * 8) * 2u, boff = (unsigned)(lane * 2048 + wid * 8) * 2u;
    const unsigned dstw = lds0 + wid * 1024;
#define P2_DMA_TILE(kt, buf) do { const unsigned d_ = (unsigned)__builtin_amdgcn_readfirstlane(dstw + (buf) * CB_BUF); \
        glds16(Ag + (kt) * 64, aoff, d_); \
        _Pragma("unroll") for (int ct_ = 0; ct_ < 4; ++ct_) glds16(Bg + (size_t)ct_ * 64 * 2048 + (kt) * 64, boff, d_ + 8192u * (ct_ + 1)); } while (0)
    const int ct = wid >> 1, half = wid & 1, ncol0 = 64 * ct + 32 * half;
    f32x16 hT[2]; hT[0] = f32x16{}; hT[1] = f32x16{};
    P2_DMA_TILE(0, 0); P2_WAIT_BAR();
    for (int kt = 0; kt < 32; ++kt) {
        const int buf = kt & 1;
        if (kt + 1 < 32) P2_DMA_TILE(kt + 1, buf ^ 1);
        LAS const char* sa = (LAS const char*)(lds + buf * CB_BUF) + hi * 1024 + r32 * 16;
        LAS const char* sb = (LAS const char*)(lds + buf * CB_BUF + 8192 * (ct + 1)) + half * 512 + hi * 1024 + r32 * 16;
#pragma unroll
        for (int d0 = 0; d0 < 4; ++d0) {
            const bf16x8 bf = *(LAS const bf16x8*)(sb + d0 * 2048), a0 = *(LAS const bf16x8*)(sa + d0 * 2048), a1 = *(LAS const bf16x8*)(sa + d0 * 2048 + 512);
            hT[0] = __builtin_amdgcn_mfma_f32_32x32x16_bf16(bf, a0, hT[0], 0, 0, 0);
            hT[1] = __builtin_amdgcn_mfma_f32_32x32x16_bf16(bf, a1, hT[1], 0, 0, 0);
        }
        P2_WAIT_BAR();
    }
    const float* bias1 = (const float*)(ws + WS_SMALL + SM_BIAS1) + kv * 256 + ncol0;
    bf16x8 hb[2][2];
#pragma unroll
    for (int mt = 0; mt < 2; ++mt) {
        float g[16];
#pragma unroll
        for (int r = 0; r < 16; ++r) g[r] = gelu_tanh(hT[mt][r] + bias1[crow(r, hi)]);
#pragma unroll
        for (int s = 0; s < 2; ++s) { u32x4_t w; w.x = cvtpk_s(g[8 * s], g[8 * s + 1]); w.y = cvtpk_s(g[8 * s + 2], g[8 * s + 3]); w.z = cvtpk_s(g[8 * s + 4], g[8 * s + 5]); w.w = cvtpk_s(g[8 * s + 6], g[8 * s + 7]);
            hb[mt][s] = __builtin_bit_cast(bf16x8, w); }
    }
    const bf16_t* w2t = (const bf16_t*)(ws + WS_SMALL + SM_W2T) + (size_t)kv * 64 * 256;
    f32x16 oT[2][2];
#pragma unroll
    for (int dt = 0; dt < 2; ++dt)
#pragma unroll
        for (int mt = 0; mt < 2; ++mt) oT[dt][mt] = f32x16{};
#pragma unroll
    for (int dt = 0; dt < 2; ++dt)
#pragma unroll
        for (int s = 0; s < 2; ++s) {
            const bf16_t* wp = w2t + (size_t)(32 * dt + r32) * 256 + ncol0 + 16 * s + 4 * hi;
            const u32x2_t lo = *(const u32x2_t*)wp, hi2 = *(const u32x2_t*)(wp + 8);
            const u32x4_t wv = {lo.x, lo.y, hi2.x, hi2.y}; const bf16x8 wf = __builtin_bit_cast(bf16x8, wv);
#pragma unroll
            for (int mt = 0; mt < 2; ++mt) oT[dt][mt] = __builtin_amdgcn_mfma_f32_32x32x16_bf16(wf, hb[mt][s], oT[dt][mt], 0, 0, 0);
        }
    LAS float* part = (LAS float*)lds + wid * 64 * CP_STRIDE;
#pragma unroll
    for (int dt = 0; dt < 2; ++dt)
#pragma unroll
        for (int mt = 0; mt < 2; ++mt)
#pragma unroll
            for (int r = 0; r < 16; ++r) part[(32 * mt + r32) * CP_STRIDE + 32 * dt + crow(r, hi)] = oT[dt][mt][r];
    P2_WAIT_BAR();
    {
        const int tid = wid * 64 + lane, m = tid >> 3, dg = tid & 7;
        float o[8];
#pragma unroll
        for (int e = 0; e < 8; ++e) { float s = 0.f;
#pragma unroll
            for (int w = 0; w < 8; ++w) s += ((LAS const float*)lds)[(w * 64 + m) * CP_STRIDE + 8 * dg + e];
            o[e] = s; }
        if (kv == 0) {
            float ss = 0.f;
#pragma unroll
            for (int e = 0; e < 8; ++e) ss += o[e] * o[e];
            ss += __shfl_xor(ss, 1); ss += __shfl_xor(ss, 2); ss += __shfl_xor(ss, 4);
            const float rr = __builtin_amdgcn_rsqf(ss * (1.0f / 64.0f) + 1e-6f);
#pragma unroll
            for (int e = 0; e < 8; ++e) o[e] *= rr * P.in[4][8 * dg + e];
        }
        const int n = n0 + m;
        u32x4_t v = {0u, 0u, 0u, 0u};
        if (n < 255) { v.x = cvtpk_s(o[0], o[1]); v.y = cvtpk_s(o[2], o[3]); v.z = cvtpk_s(o[4], o[5]); v.w = cvtpk_s(o[6], o[7]); }
        *(u32x4_t*)((bf16_t*)(ws + (kv ? WS_VC : WS_KC)) + ((size_t)bg * 256 + n) * 64 + 8 * dg) = v;
    }
    P2_WAIT_BAR();
#undef P2_DMA_TILE
}

constexpr int G_V = 0, G_ST = 32768, G_OST = 33792, G_END = 33792 + 65536;
__device__ __forceinline__ void gmlp_unit(const Ptrs& P, LAS unsigned char* lds, int unit, const int wave_s) {
    unsigned char* ws = P.ws;
    const int lane = fresh_lane(), r32 = lane & 31, hi = lane >> 5, wid = wave_s, tid = wid * 64 + lane;
    const int g = unit & 7, chunk = (unit >> 3) & 31, b = unit >> 8; const int m0 = b * SEQ + chunk * 128;
    const bf16_t* GV = (const bf16_t*)(ws + WS_GV); const bf16_t* U = (const bf16_t*)(ws + WS_U); const float* VSTAT = (const float*)(ws + WS_VSTAT);
    const bf16_t* SWB = (const bf16_t*)(ws + WS_SMALL + SM_SWB) + (size_t)g * 16384;
    bf16_t* AB = (bf16_t*)(ws + WS_AB);
    const float* ln_w = P.in[8]; const float* ln_b = P.in[9]; const float* sbp = P.in[11];
    LAS float* st = (LAS float*)(lds + G_ST);
    if (tid < 128) { const float* p = VSTAT + (size_t)(m0 + tid) * 32; float s1 = 0.f, s2 = 0.f;
#pragma unroll
        for (int i = 0; i < 16; ++i) { s1 += p[2 * i]; s2 += p[2 * i + 1]; }
        const float mean = s1 * (1.0f / 1024.0f); float var = s2 * (1.0f / 1024.0f) - mean * mean; var = var < 0.f ? 0.f : var;
        st[2 * tid] = mean; st[2 * tid + 1] = __builtin_amdgcn_rsqf(var + 1e-5f); }
    P2_WAIT_BAR();
#pragma unroll
    for (int i = 0; i < 4; ++i) { const int idx = tid + 512 * i, s = idx >> 4, c8 = idx & 15;
        const u32x4_t raw = *(const u32x4_t*)(GV + (size_t)(m0 + s) * 1024 + g * 128 + 8 * c8); float f[8]; unpack8(raw, f);
        const float mean = st[2 * s], rstd = st[2 * s + 1];
        const f32x4_t w0 = *(const f32x4_t*)(ln_w + g * 128 + 8 * c8), w1 = *(const f32x4_t*)(ln_w + g * 128 + 8 * c8 + 4), b0 = *(const f32x4_t*)(ln_b + g * 128 + 8 * c8), b1 = *(const f32x4_t*)(ln_b + g * 128 + 8 * c8 + 4);
        float y[8];
#pragma unroll
        for (int e = 0; e < 4; ++e) { y[e] = (f[e] - mean) * rstd * w0[e] + b0[e]; y[4 + e] = (f[4 + e] - mean) * rstd * w1[e] + b1[e]; }
        u32x4_t o; o.x = cvtpk_s(y[0], y[1]); o.y = cvtpk_s(y[2], y[3]); o.z = cvtpk_s(y[4], y[5]); o.w = cvtpk_s(y[6], y[7]);
        const int st_ = s >> 6, sk = s & 63, ch = c8 >> 3, x = c8 & 7;
        *(LAS u32x4_t*)(lds + G_V + (st_ * 2 + ch) * 8192 + (x >> 2) * 4096 + (sk >> 4) * 1024 + (sk & 15) * 64 + (x & 3) * 16) = o; }
    P2_WAIT_BAR();
    const int tb = wid >> 1, ch = wid & 1;
    f32x16 o[2]; o[0] = f32x16{}; o[1] = f32x16{};
    const int vb0 = (int)((unsigned)(uintptr_t)lds + G_V) + ((lane >> 4) & 1) * 32 + (lane & 3) * 8 + (4 * hi + ((lane & 15) >> 2)) * 64;
    const int nst = tb >= 2 ? 2 : 1;
    for (int st_ = 0; st_ < nst; ++st_) {
        bf16x8 pa[4];
#pragma unroll
        for (int ks = 0; ks < 4; ++ks) {
            const bf16_t* wp = SWB + (size_t)(32 * tb + r32) * 128 + 64 * st_ + 16 * ks + 4 * hi;
            const u32x2_t lo = *(const u32x2_t*)wp, hi2 = *(const u32x2_t*)(wp + 8);
            const u32x4_t wv = {lo.x, lo.y, hi2.x, hi2.y}; pa[ks] = __builtin_bit_cast(bf16x8, wv); }
        nsa::pv(o, vb0 + (st_ * 2 + ch) * 8192, pa[0], pa[1], pa[2], pa[3]);
    }
    LAS float* ostg = (LAS float*)(lds + G_OST) + wid * 2048;
#pragma unroll
    for (int r = 0; r < 16; ++r) { const int orow = crow(r, hi);
#pragma unroll
        for (int d0 = 0; d0 < 2; ++d0) ostg[orow * 64 + d0 * 32 + r32] = o[d0][r]; }
    asm volatile("s_waitcnt lgkmcnt(0)" ::: "memory");
#pragma unroll
    for (int i = 0; i < 4; ++i) { const int row = i * 8 + (lane >> 3), c8 = lane & 7, t = 32 * tb + row;
        const f32x4_t v0 = *(LAS const f32x4_t*)(ostg + row * 64 + c8 * 8), v1 = *(LAS const f32x4_t*)(ostg + row * 64 + c8 * 8 + 4);
        const size_t grow = (size_t)(m0 + t); const int col = g * 128 + 64 * ch + 8 * c8;
        float uf[8]; unpack8(*(const u32x4_t*)(U + grow * 1024 + col), uf);
        const float sbv = sbp[g * 128 + t];
        u32x4_t w; w.x = cvtpk_s(uf[0] * (v0[0] + sbv), uf[1] * (v0[1] + sbv)); w.y = cvtpk_s(uf[2] * (v0[2] + sbv), uf[3] * (v0[3] + sbv));
        w.z = cvtpk_s(uf[4] * (v1[0] + sbv), uf[5] * (v1[1] + sbv)); w.w = cvtpk_s(uf[6] * (v1[2] + sbv), uf[7] * (v1[3] + sbv));
        *(u32x4_t*)(AB + grow * 2048 + 1024 + col) = w; }
    P2_WAIT_BAR();
}
#undef P2_WAIT_BAR
}

#define XB_TMO      128
#define XB_XCNT(j)  (256  + 64 * (j))
#define XB_XSUB(j)  (1280 + 64 * (j))
#define XB_XGEN(j)  (2304 + 64 * (j))
#define XB_TOP      3328
#define XB_TOPGEN   3392
#define XCD_BAR_WORDS 3456
#define XB_SPIN_CAP (1u << 18)

__device__ __forceinline__ unsigned xb_ld(unsigned* p)              { return __hip_atomic_load(p, __ATOMIC_RELAXED, __HIP_MEMORY_SCOPE_AGENT); }
__device__ __forceinline__ unsigned xb_add(unsigned* p, unsigned v) { return __hip_atomic_fetch_add(p, v, __ATOMIC_RELAXED, __HIP_MEMORY_SCOPE_AGENT); }
__device__ __forceinline__ unsigned xb_xcc_id() { return (unsigned)__builtin_amdgcn_s_getreg((3 << 11) | 20) & 0xFu; }
#define XB_SPIN(cond, bar) do { unsigned _sp = 0; while (cond) { __builtin_amdgcn_s_sleep(1); \
    if ((++_sp & 255u) == 0u) { if (xb_ld(&(bar)[XB_TMO])) break; if (_sp > XB_SPIN_CAP) { atomicAdd(&(bar)[XB_TMO], 1u); break; } } } } while (0)

struct XcdBarrier {
    unsigned* bar; unsigned x; unsigned w0;
    volatile LAS unsigned* st;
};

__device__ __forceinline__ XcdBarrier xcd_barrier_post(unsigned* bar, volatile LAS unsigned* st, int wave_s) {
    XcdBarrier b; b.bar = bar; b.x = xb_xcc_id(); b.st = st; b.w0 = wave_s == 0 ? 1u : 0u;
    if (b.w0 && fresh_lane() == 0) (void)xb_add(&bar[XB_XCNT(b.x)], 1u);
    return b;
}
__device__ __forceinline__ void xcd_barrier_complete(unsigned* bar, unsigned x, unsigned& nloc, unsigned& nx) {
    const unsigned G = gridDim.x * gridDim.y * gridDim.z;
    unsigned sum, cnt, mine, sp = 0u;
    for (;;) {
        sum = 0u; cnt = 0u; mine = 0u;
#pragma unroll
        for (unsigned j = 0; j < 16; ++j) { const unsigned c = xb_ld(&bar[XB_XCNT(j)]); sum += c; cnt += (c > 0u) ? 1u : 0u; mine = (j == x) ? c : mine; }
        if (sum == G) break;
        __builtin_amdgcn_s_sleep(1);
        if ((++sp & 255u) == 0u) { if (xb_ld(&bar[XB_TMO])) break; if (sp > XB_SPIN_CAP) { atomicAdd(&bar[XB_TMO], 1u); break; } }
    }
    nloc = mine > 0u ? mine : 1u; nx = cnt > 0u ? cnt : 1u;
}

__device__ __forceinline__ void xcd_barrier(const XcdBarrier& b) {
    asm volatile("s_waitcnt vmcnt(0)" ::: "memory");
    __syncthreads();
    if (b.w0 && fresh_lane() == 0) {
        unsigned* bar = b.bar;
        __builtin_amdgcn_s_waitcnt(0);
        unsigned nloc = b.st[0], nx = b.st[1];
        if (nloc == 0u) { xcd_barrier_complete(bar, b.x, nloc, nx); b.st[0] = nloc; b.st[1] = nx; }
        const unsigned old = xb_add(&bar[XB_XSUB(b.x)], 1u);
        const unsigned gen = old / nloc;
        if (old + 1u == (gen + 1u) * nloc) {
            __builtin_amdgcn_fence(__ATOMIC_RELEASE, "agent");
            asm volatile("s_waitcnt vmcnt(0)" ::: "memory");
            const unsigned og = xb_add(&bar[XB_TOP], 1u);
            const unsigned tg = og / nx;
            if (og + 1u == (tg + 1u) * nx) xb_add(&bar[XB_TOPGEN], 1u);
            else XB_SPIN(xb_ld(&bar[XB_TOPGEN]) == tg, bar);
            __builtin_amdgcn_fence(__ATOMIC_ACQUIRE, "agent");
            xb_add(&bar[XB_XGEN(b.x)], 1u);
            asm volatile("s_waitcnt vmcnt(0)" ::: "memory");
        } else {
            XB_SPIN(xb_ld(&bar[XB_XGEN(b.x)]) == gen, bar);
            __builtin_amdgcn_fence(__ATOMIC_ACQUIRE, "agent");
            asm volatile("s_waitcnt vmcnt(0)" ::: "memory");
        }
    }
    __syncthreads();
}

constexpr int LDS_BYTES = 147456;
constexpr int LDS_XCH = 132096;
constexpr int LDS_MISC = 145408;
__global__ void __launch_bounds__(512, 2) mega_fwd(Ptrs P) {
    extern __shared__ __attribute__((aligned(16))) unsigned char lds_raw[];
    LAS unsigned char* lds = (LAS unsigned char*)lds_raw;
    unsigned char* ws = P.ws;
    const int wave = __builtin_amdgcn_readfirstlane(threadIdx.x >> 6);
    const int G = gridDim.x, bid = blockIdx.x;
    if (wave == 0) { const int l_ = fresh_lane(); if (l_ < 2) ((LAS unsigned*)(lds + LDS_MISC))[l_] = 0u; }
    __syncthreads();
    const XcdBarrier bar = xcd_barrier_post((unsigned*)(ws + WS_CTL), (volatile LAS unsigned*)(lds + LDS_MISC), wave);
    p0_prologue(P, lds, bid, G, wave);
    xcd_barrier(bar);
    if (bid == 0) bias1_stage(ws, fresh_tid(wave));
    {
        pg8::Gemm g{(const bf16_t*)(ws + WS_XN), (const bf16_t*)(ws + WS_WIN), MTOK, NPROJ, 2048, 2048};
        pg8::StaticOrder S; S.init(MTOK, NPROJ, G, bid);
        pg8::EpiProj E{(bf16_t*)(ws + WS_Q), (bf16_t*)(ws + WS_KV6), (bf16_t*)(ws + WS_U), (bf16_t*)(ws + WS_GV), (float*)(ws + WS_GATES), (float*)(ws + WS_VSTAT), P.in[3], P.in[4]};
        pg8::gemm_phase<pg8::EpiProj, pg8::StaticOrder, true, true>(lds, g, S, E, wave);
    }
    { const int nfull = (MTOK / 256) * (NPROJ / 256) - 4 * G;
      if (bid >= nfull && nfull < G) p1_tail_transposes(P, lds, bid - nfull, G - nfull, wave); else if (nfull >= G && G > 0) p1_tail_transposes(P, lds, bid, G, wave); }
    xcd_barrier(bar);
    if (bid < 128 && G >= 256) p2::compress_unit(P, lds, bid, wave);
    else if (G >= 256) { for (int u = bid - 128; u < 1024; u += G - 128) p2::gmlp_unit(P, lds, u, wave); }
    xcd_barrier(bar);
    nsa::nsa_phase(P, lds, bid, G, wave);
    xcd_barrier(bar);
    {
        pg8::Gemm g{(const bf16_t*)(ws + WS_AB), (const bf16_t*)(ws + WS_WOUT), MTOK, 2048, 2048, 2048};
        pg8::StaticOrder S; S.init(MTOK, 2048, G, bid);
        pg8::EpiRes1 E{P.in[0], P.out, (bf16_t*)(ws + WS_XN), (float*)(ws + WS_SSQ)};
        pg8::gemm_phase<pg8::EpiRes1, pg8::StaticOrder, true, true>(lds, g, S, E, wave);
    }
    xcd_barrier(bar);
    {
        pg8::Gemm g{(const bf16_t*)(ws + WS_XN), (const bf16_t*)(ws + WS_WUP), MTOK, N_UP, 2048, 2048};
        pg8::StaticOrder S; S.init(MTOK, N_UP, G, bid);
        pg8::EpiUpConv E{(bf16_t*)(ws + WS_G), (const float*)(ws + WS_SSQ), P.in[15], P.in[16], (float*)(ws + WS_HLAST), (float*)(ws + WS_FIRST), lds + LDS_XCH};
        pg8::gemm_phase<pg8::EpiUpConv, pg8::StaticOrder, true, true>(lds, g, S, E, wave);
    }
    xcd_barrier(bar);
    for (int it = bid * 512 + fresh_tid(wave); it < 60 * 44 * 2 * 16; it += G * 512) {
        const int c8 = it & 15, row = (it >> 4) & 1, tl_ = it >> 5, pn = tl_ % 44, pmi = tl_ / 44, pm = pmi + pmi / 15 + 1;
        const float* cw = P.in[15]; const float* cb = P.in[16]; (void)cb;
        const float* fp = (const float*)(ws + WS_FIRST) + ((size_t)(pm * 44 + pn) * 2 + row) * 256 + 8 * c8;
        const float* lp = (const float*)(ws + WS_HLAST) + ((size_t)((pm - 1) * 44 + pn) * 2) * 256 + 8 * c8;
        const int ch = pn * 128 + 8 * c8;
        float r[8];
#pragma unroll
        for (int e = 0; e < 8; ++e) {
            const float l0g = lp[e], l1g = lp[256 + e], l0u = lp[128 + e], l1u = lp[256 + 128 + e];
            const float w0g = cw[ch + e], w1g = cw[N_UP + ch + e], w0u = cw[D_FF + ch + e], w1u = cw[N_UP + D_FF + ch + e];
            const float cg = fp[e] + (row == 0 ? w1g * l1g + w0g * l0g : w0g * l1g), cu = fp[128 + e] + (row == 0 ? w1u * l1u + w0u * l0u : w0u * l1u);
            r[e] = cg * sigmoidf_(cg) * cu;
        }
        u32x4_t o; o.x = pk2(r[0], r[1]); o.y = pk2(r[2], r[3]); o.z = pk2(r[4], r[5]); o.w = pk2(r[6], r[7]);
        *(u32x4_t*)((bf16_t*)(ws + WS_G) + (size_t)(pm * 256 + row) * D_FF + ch) = o;
    }
    xcd_barrier(bar);
    {
        pg8::Gemm g{(const bf16_t*)(ws + WS_G), (const bf16_t*)(ws + WS_WDOWN), MTOK, 2048, D_FF, D_FF};
        pg8::StaticOrder S; S.init(MTOK, 2048, G, bid);
        pg8::EpiDown E{P.out, (const bf16_t*)(ws + WS_XN)};
        pg8::gemm_phase<pg8::EpiDown, pg8::StaticOrder, true, true>(lds, g, S, E, wave);
    }
}

extern "C" void kernel_launch(void* const* d_in, const int* in_sizes, int n_in, void* d_out, int out_size, void* d_ws, size_t ws_size, hipStream_t stream) {
    static int grid_blocks = 0;
    if (!grid_blocks) {
        int dev = 0, cus = 0, per_cu = 0;
        (void)hipGetDevice(&dev);
        (void)hipDeviceGetAttribute(&cus, hipDeviceAttributeMultiprocessorCount, dev);
        (void)hipFuncSetAttribute((const void*)mega_fwd, hipFuncAttributeMaxDynamicSharedMemorySize, LDS_BYTES);
        (void)hipOccupancyMaxActiveBlocksPerMultiprocessor(&per_cu, (const void*)mega_fwd, 512, LDS_BYTES);
        if (per_cu < 1) { fprintf(stderr, "kernel_launch: occupancy query says %d blocks/CU\n", per_cu); per_cu = 1; }
        grid_blocks = cus * 1;
        (void)hipGetLastError();
    }
    if (n_in != 18 || ws_size < WS_END) { fprintf(stderr, "kernel_launch: unexpected n_in %d / ws %zu\n", n_in, ws_size); return; }
    Ptrs P{};
    for (int i = 0; i < 18; ++i) P.in[i] = (const float*)d_in[i];
    P.out = (float*)d_out; P.ws = (unsigned char*)d_ws;
    (void)hipMemsetAsync((char*)d_ws + WS_CTL, 0, 16384, stream);
    mega_fwd<<<dim3(grid_blocks), dim3(512), LDS_BYTES, stream>>>(P);
}
```

```cpp
#include <hip/hip_runtime.h>
#include <cstdio>
#include <cstdint>

constexpr int D_MODEL = 2048, BATCH = 4, SEQ = 4096, MTOK = BATCH * SEQ;
constexpr int IN_COLS = 4656, NPROJ = 4864;
constexpr int D_FF = 5632, N_UP = 2 * D_FF;
constexpr int NBG = 16;
constexpr size_t KVSZ = (size_t)NBG * SEQ * 64;
constexpr float LOG2E = 1.4426950408889634f;

constexpr size_t MiB = 1u << 20;
constexpr size_t WS_CTL = 0;
constexpr size_t WS_WIN = 1 * MiB, WS_WOUT = 20 * MiB, WS_WUP = 28 * MiB, WS_WDOWN = 72 * MiB, WS_W1C = 94 * MiB;
constexpr size_t WS_SMALL = 96 * MiB;
constexpr size_t SM_BIASP = 0, SM_BIAS1 = 65536, SM_R2 = 131072, SM_W2T = 196608  , SM_SWB = 262144  ;
constexpr size_t WS_XN = 97 * MiB;
constexpr size_t WS_Q = 161 * MiB;
constexpr size_t WS_KV6 = 193 * MiB;
constexpr size_t WS_U = 241 * MiB, WS_GV = 273 * MiB;
constexpr size_t WS_GATES = 305 * MiB;
constexpr size_t WS_VSTAT = 308 * MiB;
constexpr size_t WS_KC = 310 * MiB, WS_VC = 310 * MiB + 524288;
constexpr size_t WS_HC = 311 * MiB;
constexpr size_t WS_AB = 315 * MiB;
constexpr size_t WS_SSQ = 379 * MiB;
constexpr size_t WS_G = 161 * MiB;
constexpr size_t WS_HID = 381 * MiB;
constexpr size_t WS_HLAST = 381 * MiB, WS_FIRST = 388 * MiB;
constexpr size_t WS_END = 469 * MiB;

#define LAS __attribute__((address_space(3)))
typedef unsigned short bf16_t;
typedef unsigned u32x4_t __attribute__((ext_vector_type(4)));
typedef unsigned u32x2_t __attribute__((ext_vector_type(2)));
typedef float f32x4_t __attribute__((ext_vector_type(4)));

__device__ __forceinline__ float bf2f(unsigned short h) { return __uint_as_float(((unsigned)h) << 16); }
__device__ __forceinline__ unsigned f2bf(float f) { unsigned u = __float_as_uint(f); return (u + 0x7fffu + ((u >> 16) & 1u)) >> 16; }
__device__ __forceinline__ unsigned pk2(float lo, float hi) { return f2bf(lo) | (f2bf(hi) << 16); }
__device__ __forceinline__ float gelu_tanh(float x) {
    const float u = 0.7978845608028654f * (x + 0.044715f * x * x * x);
    const float e = __builtin_amdgcn_exp2f(-2.8853900817779268f * u);
    return x * __builtin_amdgcn_rcpf(1.0f + e);
}
__device__ __forceinline__ float sigmoidf_(float x) { return __builtin_amdgcn_rcpf(1.0f + __builtin_amdgcn_exp2f(-LOG2E * x)); }
__device__ __forceinline__ float wave_sum(float v) {
#pragma unroll
    for (int o = 1; o < 64; o <<= 1) v += __shfl_xor(v, o);
    return v;
}
__device__ __forceinline__ void unpack8(u32x4_t r, float (&f)[8]) {
    f[0] = __uint_as_float(r.x << 16); f[1] = __uint_as_float(r.x & 0xffff0000u);
    f[2] = __uint_as_float(r.y << 16); f[3] = __uint_as_float(r.y & 0xffff0000u);
    f[4] = __uint_as_float(r.z << 16); f[5] = __uint_as_float(r.z & 0xffff0000u);
    f[6] = __uint_as_float(r.w << 16); f[7] = __uint_as_float(r.w & 0xffff0000u);
}

__device__ __forceinline__ int fresh_lane() { unsigned z_ = 0u; asm volatile("" : "+v"(z_)); return (int)__builtin_amdgcn_mbcnt_hi(~0u, __builtin_amdgcn_mbcnt_lo(~0u, z_)); }
__device__ __forceinline__ int fresh_tid(int wave_s) { return wave_s * 64 + fresh_lane(); }
namespace pg8 {
#define PG8_LAS __attribute__((address_space(3)))
typedef unsigned short bf16_t;
typedef short bf16x8 __attribute__((ext_vector_type(8)));
typedef float f32x4 __attribute__((ext_vector_type(4)));
typedef unsigned u32x4 __attribute__((ext_vector_type(4)));
constexpr int BM = 256, BK = 64, HALF = 128, HTB = HALF * BK * 2  , STAGE_BYTES = 8 * HTB, NXCD = 8, WGM = 8;

__host__ __device__ __forceinline__ int lds_byte(int r, int c) { const int st = (r >> 4) * 2 + (c >> 5), rr = r & 15, cc = c & 31, ob = rr * 64 + cc * 2; return st * 1024 + (ob ^ (((ob >> 9) & 1) << 5)); }
__host__ __device__ __forceinline__ void stage_rc(int b, int& R, int& C) { const int st = b / 1024, sb = b % 1024, swz = sb ^ (((sb >> 9) & 1) << 5); R = (st >> 1) * 16 + swz / 64; C = (st & 1) * 32 + (swz % 64) / 2; }
__host__ __device__ __forceinline__ int perm32(int rho) { const int n = rho >> 4, i = rho & 15; return 8 * (i >> 2) + 4 * n + (i & 3); }

struct Unit { int pm, pn; };
struct Gemm { const bf16_t* A; const bf16_t* Bt; int M, N, K, lda; };

struct StaticOrder {
    int nM, nN, nwg, G, c;
    __host__ __device__ void init(int M, int N, int G_, int c_) { nM = M / BM; nN = N / BM; nwg = nM * nN; G = G_; c = c_; }
    __host__ __device__ bool next(int i, Unit& u) const {
        const long L = (long)i * G + c; if (L >= nwg) return false;
        int wgid = (int)L; { const int q = nwg / NXCD, r = nwg % NXCD, xcd = wgid % NXCD, off = wgid / NXCD; wgid = (xcd < r ? xcd * (q + 1) : r * (q + 1) + (xcd - r) * q) + off; }
        const int nig = WGM * nN, gid = wgid / nig, fm = gid * WGM, gsz = (nM - fm) < WGM ? (nM - fm) : WGM;
        u.pm = fm + ((wgid % nig) % gsz); u.pn = (wgid % nig) / gsz; return true;
    }
    __device__ __forceinline__ void a_ready(const Unit&) const {}
    __device__ __forceinline__ void done(const Unit&) const {}
};

__device__ __forceinline__ unsigned cvt_pk_bf16(float lo, float hi) { unsigned r; asm volatile("v_cvt_pk_bf16_f32 %0, %1, %2" : "=v"(r) : "v"(lo), "v"(hi)); return r; }

struct EpiProj {
    static constexpr bool PERM = true, AFTER_DRAIN = false;
    bf16_t* Q; bf16_t* KV6; bf16_t* U; bf16_t* GV; float* GATES; float* VSTAT; const float* q_norm_w; const float* k_norm_w;
    __device__ __forceinline__ void operator()(const f32x4 (&acc)[2][2][4][2], const Unit& u, int wr, int wc, int fr, int fq) const {
        const int pn = u.pn, row0 = u.pm * BM + wr * 64 + fr;
        if (pn < 10) {
            const bool normed = (pn < 4) || pn == 6 || pn == 8;
            const float* w = pn < 4 ? q_norm_w : (k_norm_w + (pn == 6 ? 64 : 128));
            const float sc = pn < 4 ? 0.125f * LOG2E : 1.0f;
            f32x4 wv[2][2];
#pragma unroll
            for (int bj = 0; bj < 2; ++bj)
#pragma unroll
                for (int n = 0; n < 2; ++n) wv[bj][n] = normed ? (*(const f32x4*)(w + 32 * bj + 8 * fq + 4 * n)) * sc : (f32x4){1.f, 1.f, 1.f, 1.f};
#pragma unroll
            for (int ai = 0; ai < 2; ++ai)
#pragma unroll
                for (int m = 0; m < 4; ++m) {
                    const int row = row0 + ai * HALF + m * 16;
                    float r = 1.f;
                    if (normed) {
                        float ss = 0.f;
#pragma unroll
                        for (int bj = 0; bj < 2; ++bj)
#pragma unroll
                            for (int n = 0; n < 2; ++n) { const f32x4 x = acc[ai][bj][m][n]; ss += (x[0] * x[0] + x[1] * x[1]) + (x[2] * x[2] + x[3] * x[3]); }
                        ss += __shfl_xor(ss, 16); ss += __shfl_xor(ss, 32);
                        r = __builtin_amdgcn_rsqf(ss * (1.0f / 64.0f) + 1e-6f);
                    }
                    bf16_t* dst;
                    if (pn < 4) dst = Q + (size_t)row * 1024 + pn * 256 + wc * 64 + 8 * fq;
                    else { const int b = row >> 12, t = row & 4095; dst = KV6 + (size_t)(pn - 4) * KVSZ + ((size_t)((b * 4 + wc) * 4096 + t)) * 64 + 8 * fq; }
#pragma unroll
                    for (int bj = 0; bj < 2; ++bj) {
                        const f32x4 v0 = acc[ai][bj][m][0] * r * wv[bj][0], v1 = acc[ai][bj][m][1] * r * wv[bj][1];
                        u32x4 o; o.x = cvt_pk_bf16(v0[0], v0[1]); o.y = cvt_pk_bf16(v0[2], v0[3]); o.z = cvt_pk_bf16(v1[0], v1[1]); o.w = cvt_pk_bf16(v1[2], v1[3]);
                        *(u32x4*)(dst + 32 * bj) = o;
                    }
                }
        } else if (pn < 18) {
            const bool isv = pn >= 14; const int ct = isv ? pn - 14 : pn - 10;
            bf16_t* base = (isv ? GV : U) + ct * 256 + wc * 64 + 8 * fq;
#pragma unroll
            for (int ai = 0; ai < 2; ++ai)
#pragma unroll
                for (int m = 0; m < 4; ++m) {
                    const int row = row0 + ai * HALF + m * 16; float s1 = 0.f, s2 = 0.f;
#pragma unroll
                    for (int bj = 0; bj < 2; ++bj) {
                        f32x4 v0 = acc[ai][bj][m][0], v1 = acc[ai][bj][m][1];
#pragma unroll
                        for (int e = 0; e < 4; ++e) { v0[e] = gelu_tanh(v0[e]); v1[e] = gelu_tanh(v1[e]); s1 += v0[e] + v1[e]; s2 += v0[e] * v0[e] + v1[e] * v1[e]; }
                        u32x4 o; o.x = cvt_pk_bf16(v0[0], v0[1]); o.y = cvt_pk_bf16(v0[2], v0[3]); o.z = cvt_pk_bf16(v1[0], v1[1]); o.w = cvt_pk_bf16(v1[2], v1[3]);
                        *(u32x4*)(base + (size_t)row * 1024 + 32 * bj) = o;
                    }
                    if (isv) {
                        s1 += __shfl_xor(s1, 16); s1 += __shfl_xor(s1, 32); s2 += __shfl_xor(s2, 16); s2 += __shfl_xor(s2, 32);
                        if (fq == 0) { float* p = VSTAT + ((size_t)row * 16 + ct * 4 + wc) * 2; p[0] = s1; p[1] = s2; }
                    }
                }
        } else {
            if (wc == 0) {
#pragma unroll
                for (int ai = 0; ai < 2; ++ai)
#pragma unroll
                    for (int m = 0; m < 4; ++m) {
                        const int row = row0 + ai * HALF + m * 16;
#pragma unroll
                        for (int bj = 0; bj < 2; ++bj)
#pragma unroll
                            for (int n = 0; n < 2; ++n) {
                                const int L = 32 * bj + 8 * fq + 4 * n;
                                if (L < 48) { f32x4 v = acc[ai][bj][m][n]; f32x4 o; o[0] = sigmoidf_(v[0]); o[1] = sigmoidf_(v[1]); o[2] = sigmoidf_(v[2]); o[3] = sigmoidf_(v[3]); *(f32x4*)(GATES + (size_t)row * 48 + L) = o; }
                            }
                    }
            }
        }
    }
};
struct EpiCmp {
    static constexpr bool PERM = true, AFTER_DRAIN = false;
    bf16_t* HC; const float* bias1;
    __device__ __forceinline__ void operator()(const f32x4 (&acc)[2][2][4][2], const Unit& u, int wr, int wc, int fr, int fq) const {
        const int row0 = u.pm * BM + wr * 64 + fr, col0 = wc * 32 + 8 * fq;
        f32x4 bv[2][2];
#pragma unroll
        for (int bj = 0; bj < 2; ++bj)
#pragma unroll
            for (int n = 0; n < 2; ++n) bv[bj][n] = *(const f32x4*)(bias1 + u.pn * 256 + col0 + bj * HALF + 4 * n);
#pragma unroll
        for (int ai = 0; ai < 2; ++ai)
#pragma unroll
            for (int m = 0; m < 4; ++m) { bf16_t* rowp = HC + (size_t)(row0 + ai * HALF + m * 16) * 256 + col0;
#pragma unroll
                for (int bj = 0; bj < 2; ++bj) { f32x4 v0 = acc[ai][bj][m][0] + bv[bj][0], v1 = acc[ai][bj][m][1] + bv[bj][1];
#pragma unroll
                    for (int e = 0; e < 4; ++e) { v0[e] = gelu_tanh(v0[e]); v1[e] = gelu_tanh(v1[e]); }
                    u32x4 o; o.x = cvt_pk_bf16(v0[0], v0[1]); o.y = cvt_pk_bf16(v0[2], v0[3]); o.z = cvt_pk_bf16(v1[0], v1[1]); o.w = cvt_pk_bf16(v1[2], v1[3]);
                    *(u32x4*)(rowp + bj * HALF) = o; } }
    }
};
struct CmpOrder {
    int c, G;
    __device__ bool next(int i, Unit& u) const { const int L = i * G + c; if (L >= 32) return false; u.pm = L; u.pn = L >> 4; return true; }
    __device__ __forceinline__ void a_ready(const Unit&) const {}
    __device__ __forceinline__ void done(const Unit&) const {}
};
struct EpiRes1 {
    static constexpr bool PERM = false, AFTER_DRAIN = false;
    const float* x; float* out; bf16_t* X1b; float* SSQ;
    __device__ __forceinline__ void operator()(const f32x4 (&acc)[2][2][4][2], const Unit& u, int wr, int wc, int fr, int fq) const {
        const int row0 = u.pm * BM + wr * 64 + fr, col0 = u.pn * BM + wc * 32 + 4 * fq;
#pragma unroll
        for (int ai = 0; ai < 2; ++ai)
#pragma unroll
            for (int m = 0; m < 4; ++m) { const int row = row0 + ai * HALF + m * 16; const size_t off = (size_t)row * D_MODEL + col0; float ss = 0.f;
#pragma unroll
                for (int bj = 0; bj < 2; ++bj)
#pragma unroll
                    for (int n = 0; n < 2; ++n) { const size_t o2 = off + bj * HALF + n * 16; const f32x4 v = *(const f32x4*)(x + o2) + acc[ai][bj][m][n];
                        ss += (v[0] * v[0] + v[1] * v[1]) + (v[2] * v[2] + v[3] * v[3]);
                        u32x2_t w; w.x = cvt_pk_bf16(v[0], v[1]); w.y = cvt_pk_bf16(v[2], v[3]); *(u32x2_t*)(X1b + o2) = w; }
                ss += __shfl_xor(ss, 16); ss += __shfl_xor(ss, 32);
                if (fq == 0) SSQ[(size_t)row * 32 + u.pn * 4 + wc] = ss; }
    }
};
struct EpiUpV1 {
    static constexpr bool PERM = true, AFTER_DRAIN = false;
    bf16_t* HID; const float* R2;
    __device__ __forceinline__ void operator()(const f32x4 (&acc)[2][2][4][2], const Unit& u, int wr, int wc, int fr, int fq) const {
        const int row0 = u.pm * BM + wr * 64 + fr, col0 = u.pn * BM + wc * 32 + 8 * fq;
#pragma unroll
        for (int ai = 0; ai < 2; ++ai)
#pragma unroll
            for (int m = 0; m < 4; ++m) { const int row = row0 + ai * HALF + m * 16; const float r = R2[row]; bf16_t* rowp = HID + (size_t)row * N_UP + col0;
#pragma unroll
                for (int bj = 0; bj < 2; ++bj) { const f32x4 v0 = acc[ai][bj][m][0] * r, v1 = acc[ai][bj][m][1] * r;
                    u32x4 o; o.x = cvt_pk_bf16(v0[0], v0[1]); o.y = cvt_pk_bf16(v0[2], v0[3]); o.z = cvt_pk_bf16(v1[0], v1[1]); o.w = cvt_pk_bf16(v1[2], v1[3]);
                    *(u32x4*)(rowp + bj * HALF) = o; } }
    }
};
struct EpiDown {
    static constexpr bool PERM = false, AFTER_DRAIN = false;
    float* out; const bf16_t* X1b;
    __device__ __forceinline__ void operator()(const f32x4 (&acc)[2][2][4][2], const Unit& u, int wr, int wc, int fr, int fq) const {
        const int row0 = u.pm * BM + wr * 64 + fr, col0 = u.pn * BM + wc * 32 + 4 * fq;
#pragma unroll
        for (int ai = 0; ai < 2; ++ai)
#pragma unroll
            for (int m = 0; m < 4; ++m) { const size_t off = (size_t)(row0 + ai * HALF + m * 16) * D_MODEL + col0;
#pragma unroll
                for (int bj = 0; bj < 2; ++bj)
#pragma unroll
                    for (int n = 0; n < 2; ++n) { const u32x2_t w = *(const u32x2_t*)(X1b + off + bj * HALF + n * 16);
                        f32x4 v; v[0] = __uint_as_float(w.x << 16); v[1] = __uint_as_float(w.x & 0xffff0000u); v[2] = __uint_as_float(w.y << 16); v[3] = __uint_as_float(w.y & 0xffff0000u);
                        *(f32x4*)(out + off + bj * HALF + n * 16) = v + acc[ai][bj][m][n]; } }
    }
};
__device__ __forceinline__ unsigned f2bf_(float f) { unsigned u = __float_as_uint(f); return (u + 0x7fffu + ((u >> 16) & 1u)) >> 16; }
struct EpiUpConv {
    static constexpr bool PERM = true, AFTER_DRAIN = false;
    bf16_t* G; const float* R2; const float* cw; const float* cb; float* HLAST; float* FIRST; PG8_LAS unsigned char* xlds;
    __device__ __forceinline__ void operator()(const f32x4 (&acc)[2][2][4][2], const Unit& u, int wr, int wc, int fr_in, int fq_in) const {
        (void)fr_in; (void)fq_in;
        unsigned z_ = 0u; asm volatile("" : "+v"(z_));
        const int lane_ = (int)__builtin_amdgcn_mbcnt_hi(~0u, __builtin_amdgcn_mbcnt_lo(~0u, z_)); const int fr = lane_ & 15, fq = lane_ >> 4;
        const int row0 = u.pm * BM + wr * 64 + fr;
        PG8_LAS float* X = (PG8_LAS float*)xlds;
        const unsigned tile = (unsigned)(u.pm * (N_UP / 256) + u.pn);
        if (fr >= 14) {
#pragma unroll
            for (int ai = 0; ai < 2; ++ai) { const int sg = 2 * ai + wr; const float r3 = R2[row0 + ai * HALF + 48];
#pragma unroll
                for (int bj = 0; bj < 2; ++bj)
#pragma unroll
                    for (int n = 0; n < 2; ++n) { const f32x4 h = acc[ai][bj][3][n] * r3;
                        *(PG8_LAS f32x4*)(X + ((sg * 4 + wc) * 2 + (fr - 14)) * 64 + bj * 32 + 8 * fq + 4 * n) = h;
                        if (ai == 1 && wr == 1) *(f32x4*)(HLAST + (unsigned)((tile * 2 + (fr - 14)) * 256 + bj * HALF + wc * 32 + 8 * fq + 4 * n)) = h; } }
        }
        PG8_LAS float* R2L = X + 3072;
        PG8_LAS float* Wl = X + 2048;
        { const int t_ = (wr * 4 + wc) * 64 + fq * 16 + fr;
#pragma unroll
          for (int i2 = 0; i2 < 2; ++i2) { const int i = t_ + 512 * i2, k = i >> 8, p = i & 255, c = (p < 128 ? 0 : D_FF - 128) + u.pn * 128 + p;
              Wl[i] = k < 3 ? cw[(unsigned)(k * N_UP + c)] : cb[(unsigned)c]; }
          if (t_ < 256) R2L[t_] = R2[u.pm * BM + t_]; }
        asm volatile("s_waitcnt vmcnt(0) lgkmcnt(0)" ::: "memory"); __builtin_amdgcn_s_barrier(); asm volatile("" ::: "memory");
        const int cbase = u.pn * 128 + wc * 32 + 8 * fq;
        const bool seq_start = (u.pm & 15) == 0;
#pragma unroll
        for (int ai = 0; ai < 2; ++ai) {
            const int sg = 2 * ai + wr;
            float rs[4];
#pragma unroll
            for (int m = 0; m < 4; ++m) rs[m] = R2L[wr * 64 + fr + ai * HALF + m * 16];
            const bool defer = (ai == 0) && (wr == 0) && !seq_start && (fr < 2);
#pragma unroll
            for (int n = 0; n < 2; ++n) {
                unsigned pk[4][2];
#pragma unroll
                for (int e = 0; e < 4; ++e) {
                    asm volatile("" ::: "memory"); __builtin_amdgcn_sched_barrier(0);
                    PG8_LAS const float* wp = Wl + wc * 32 + 8 * fq + 4 * n + e;
                    const float wg0 = wp[0], wg1 = wp[256], wg2 = wp[512], bg = wp[768], wu0 = wp[128], wu1 = wp[384], wu2 = wp[640], bu = wp[896];
                    float hg1 = 0.f, hg2 = 0.f, hu1 = 0.f, hu2 = 0.f;
                    if (ai == 1 || wr == 1) { PG8_LAS const float* xp = X + (((sg - 1) * 4 + wc) * 2) * 64 + 8 * fq + 4 * n + e; hg2 = xp[0]; hg1 = xp[64]; hu2 = xp[32]; hu1 = xp[96]; }
                    float ag = hg1, bgp = fr == 0 ? hg2 : hg1, au = hu1, bup = fr == 0 ? hu2 : hu1;
#pragma unroll
                    for (int m = 0; m < 4; ++m) {
                        const float vg = acc[ai][0][m][n][e] * rs[m], vu = acc[ai][1][m][n][e] * rs[m];
                        const float rg1 = __uint_as_float(__builtin_amdgcn_update_dpp(0u, __float_as_uint(vg), 0x121, 0xf, 0xf, false)), rg2 = __uint_as_float(__builtin_amdgcn_update_dpp(0u, __float_as_uint(vg), 0x122, 0xf, 0xf, false));
                        const float ru1 = __uint_as_float(__builtin_amdgcn_update_dpp(0u, __float_as_uint(vu), 0x121, 0xf, 0xf, false)), ru2 = __uint_as_float(__builtin_amdgcn_update_dpp(0u, __float_as_uint(vu), 0x122, 0xf, 0xf, false));
                        const float pg1 = fr >= 1 ? rg1 : ag, pg2 = fr >= 2 ? rg2 : bgp, pu1 = fr >= 1 ? ru1 : au, pu2 = fr >= 2 ? ru2 : bup;
                        const float cg = bg + wg0 * pg2 + wg1 * pg1 + wg2 * vg, cu = bu + wu0 * pu2 + wu1 * pu1 + wu2 * vu;
                        if (m == 0 && defer) { float* fp = FIRST + (unsigned)((tile * 2 + fr) * 256 + wc * 32 + 8 * fq + 4 * n + e); fp[0] = cg; fp[HALF] = cu; }
                        const unsigned hb = cvt_pk_bf16(cg * sigmoidf_(cg) * cu, 0.f);
                        if ((e & 1) == 0) pk[m][e >> 1] = hb; else pk[m][e >> 1] |= hb << 16;
                        ag = rg1; bgp = rg2; au = ru1; bup = ru2;
                    }
                }
#pragma unroll
                for (int m = 0; m < 4; ++m)
                    if (!(m == 0 && defer)) { u32x2_t o; o.x = pk[m][0]; o.y = pk[m][1]; *(u32x2_t*)(G + (unsigned)((row0 + ai * HALF + m * 16) * D_FF + cbase + 4 * n)) = o; }
            }
        }
    }
};
template <class Epi, class Sched, bool ALIGN_EPI = false, bool SP2 = false>
__device__ __forceinline__ void gemm_phase(PG8_LAS unsigned char* lds, const Gemm g, const Sched& S, const Epi& E, const int wave_s) {
    const int tid = fresh_tid(wave_s), wid = wave_s, lane = tid & 63,
          wr = wid >> 2, wc = wid & 3, fr = lane & 15, fq = lane >> 4;
    const int K = g.K, nt = K / BK;
    unsigned voffA[2], voffB[2];
#pragma unroll
    for (int i = 0; i < 2; ++i) { int R, C; stage_rc(tid * 16 + i * 8192, R, C); const int Rb = Epi::PERM ? ((R & ~31) + perm32(R & 31)) : R;
        voffA[i] = (unsigned)(R * g.lda + C) * 2u; voffB[i] = (unsigned)(Rb * K + C) * 2u; }
    const size_t kstep = (size_t)(BK * 2);
    const size_t hstepA = (size_t)HALF * g.lda * 2, hstepB = (size_t)HALF * K * 2;
    const size_t tstepA = 2 * hstepA, tstepB = 2 * hstepB;
    const unsigned ldsw = (unsigned)wid * 1024u;
    const int aoff = lds_byte(wr * 64 + fr, fq * 8), boff = lds_byte(wc * 32 + fr, fq * 8);
#define PG8_SA(b, h) (((b) * 2 + (h)) * HTB)
#define PG8_SB(b, h) ((4 + (b) * 2 + (h)) * HTB)
#define PG8_STAGE(bufoff, gbase, voff) do { _Pragma("unroll") for (int _i = 0; _i < 2; ++_i) \
        __builtin_amdgcn_global_load_lds((const unsigned*)((const char*)(gbase) + (voff)[_i]), (PG8_LAS unsigned*)(lds + (bufoff) + ldsw + _i * 8192), 16, 0, 0); } while (0)
#define PG8_LDA(dst, b, h) do { _Pragma("unroll") for (int m = 0; m < 4; ++m) _Pragma("unroll") for (int k = 0; k < 2; ++k) dst[m][k] = *(const PG8_LAS bf16x8*)(lds + PG8_SA(b, h) + aoff + m * 2048 + k * 1024); } while (0)
#define PG8_LDB(dst, b, h) do { _Pragma("unroll") for (int n = 0; n < 2; ++n) _Pragma("unroll") for (int k = 0; k < 2; ++k) dst[n][k] = *(const PG8_LAS bf16x8*)(lds + PG8_SB(b, h) + boff + n * 2048 + k * 1024); } while (0)
#define PG8_MMA(ai, bj, At, Bt) do { __builtin_amdgcn_s_setprio(1); _Pragma("unroll") for (int m = 0; m < 4; ++m) _Pragma("unroll") for (int n = 0; n < 2; ++n) _Pragma("unroll") for (int k = 0; k < 2; ++k) \
        acc[ai][bj][m][n] = __builtin_amdgcn_mfma_f32_16x16x32_bf16(Bt[n][k], At[m][k], acc[ai][bj][m][n], 0, 0, 0); __builtin_amdgcn_s_setprio(0); } while (0)
#define PG8_WAIT_V(n) asm volatile("s_waitcnt vmcnt(" #n ")" ::: "memory")
#define PG8_WAIT_L(n) asm volatile("s_waitcnt lgkmcnt(" #n ")" ::: "memory")
#define PG8_BAR __builtin_amdgcn_s_barrier()
#define PG8_SCHED __builtin_amdgcn_sched_barrier(0)
    Unit cur, nxt; int ui = 0;
    if (!S.next(0, cur)) return;
    f32x4 acc[2][2][4][2];
#pragma unroll
    for (int a = 0; a < 2; ++a)
#pragma unroll
        for (int b = 0; b < 2; ++b)
#pragma unroll
            for (int m = 0; m < 4; ++m)
#pragma unroll
                for (int n = 0; n < 2; ++n) acc[a][b][m][n] = (f32x4){0.f, 0.f, 0.f, 0.f};
    bf16x8 At[4][2], B0[2][2], B1[2][2];
    const char* cA = (const char*)g.A + (size_t)cur.pm * tstepA; const char* cB = (const char*)g.Bt + (size_t)cur.pn * tstepB;
    S.a_ready(cur);
    if constexpr (SP2) {
        PG8_STAGE(PG8_SB(0, 0), cB, voffB); PG8_STAGE(PG8_SB(0, 1), cB + hstepB, voffB); PG8_STAGE(PG8_SA(0, 0), cA, voffA); PG8_STAGE(PG8_SA(0, 1), cA + hstepA, voffA);
        if (wr == 1) PG8_BAR;
        PG8_WAIT_V(2); PG8_BAR;
        PG8_STAGE(PG8_SB(1, 0), cB + kstep, voffB); PG8_STAGE(PG8_SA(1, 0), cA + kstep, voffA); PG8_STAGE(PG8_SB(1, 1), cB + hstepB + kstep, voffB);
        PG8_WAIT_V(6); PG8_BAR;
    } else {
        PG8_STAGE(PG8_SB(0, 0), cB, voffB); PG8_STAGE(PG8_SA(0, 0), cA, voffA); PG8_STAGE(PG8_SB(0, 1), cB + hstepB, voffB); PG8_STAGE(PG8_SA(0, 1), cA + hstepA, voffA);
        if (wr == 1) PG8_BAR;
        PG8_WAIT_V(4); PG8_BAR;
        PG8_STAGE(PG8_SB(1, 0), cB + kstep, voffB); PG8_STAGE(PG8_SA(1, 0), cA + kstep, voffA); PG8_STAGE(PG8_SB(1, 1), cB + hstepB + kstep, voffB);
        PG8_WAIT_V(6); PG8_BAR;
    }
    for (;;) {
        const bool has_next = S.next(ui + 1, nxt);
        const char* nA = has_next ? (const char*)g.A + (size_t)nxt.pm * tstepA : cA; const char* nB = has_next ? (const char*)g.Bt + (size_t)nxt.pn * tstepB : cB;
        for (int t = 0; t < nt; t += 2) {
            const bool last = (t == nt - 2);
            const char* a1 = cA + (size_t)(t + 1) * kstep;
            const char* a2 = last ? nA : cA + (size_t)(t + 2) * kstep; const char* b2 = last ? nB : cB + (size_t)(t + 2) * kstep;
            const char* a3 = a2 + kstep; const char* b3 = b2 + kstep;
            if (last && has_next) S.a_ready(nxt);
            if constexpr (SP2) {
            PG8_LDB(B0, 0, 0); PG8_LDB(B1, 0, 1); PG8_SCHED; PG8_LDA(At, 0, 0); PG8_STAGE(PG8_SA(1, 1), a1 + hstepA, voffA);
            PG8_WAIT_V(8); PG8_WAIT_L(0); PG8_BAR; PG8_MMA(0, 0, At, B0); PG8_MMA(0, 1, At, B1); PG8_BAR; PG8_SCHED;
            PG8_LDA(At, 0, 1); PG8_STAGE(PG8_SB(0, 0), b2, voffB); PG8_STAGE(PG8_SB(0, 1), b2 + hstepB, voffB); PG8_STAGE(PG8_SA(0, 0), a2, voffA);
            PG8_WAIT_V(8); PG8_WAIT_L(0); PG8_BAR; PG8_MMA(1, 0, At, B0); PG8_MMA(1, 1, At, B1); PG8_BAR; PG8_SCHED;
            PG8_LDB(B0, 1, 0); PG8_LDB(B1, 1, 1); PG8_SCHED; PG8_LDA(At, 1, 0); PG8_STAGE(PG8_SA(0, 1), a2 + hstepA, voffA);
            PG8_WAIT_V(8); PG8_WAIT_L(0); PG8_BAR; PG8_MMA(0, 0, At, B0); PG8_MMA(0, 1, At, B1); PG8_BAR; PG8_SCHED;
            PG8_LDA(At, 1, 1); PG8_STAGE(PG8_SB(1, 0), b3, voffB); PG8_STAGE(PG8_SB(1, 1), b3 + hstepB, voffB); PG8_STAGE(PG8_SA(1, 0), a3, voffA);
            PG8_WAIT_V(8); PG8_WAIT_L(0); PG8_BAR; PG8_MMA(1, 0, At, B0); PG8_MMA(1, 1, At, B1); PG8_BAR; PG8_SCHED;
            } else {
            PG8_LDB(B0, 0, 0); PG8_SCHED; PG8_LDA(At, 0, 0); PG8_STAGE(PG8_SA(1, 1), a1 + hstepA, voffA);
            PG8_WAIT_L(8); PG8_BAR; PG8_WAIT_L(0); PG8_MMA(0, 0, At, B0); PG8_BAR; PG8_SCHED;
            PG8_LDB(B1, 0, 1); PG8_STAGE(PG8_SB(0, 0), b2, voffB);
            PG8_BAR; PG8_WAIT_L(0); PG8_MMA(0, 1, At, B1); PG8_BAR;
            PG8_LDA(At, 0, 1); PG8_STAGE(PG8_SA(0, 0), a2, voffA);
            PG8_BAR; PG8_WAIT_L(0); PG8_MMA(1, 0, At, B0); PG8_BAR; PG8_SCHED;
            PG8_STAGE(PG8_SB(0, 1), b2 + hstepB, voffB);
            PG8_WAIT_V(6); PG8_BAR; PG8_MMA(1, 1, At, B1); PG8_BAR;
            PG8_LDB(B0, 1, 0); PG8_SCHED; PG8_LDA(At, 1, 0); PG8_STAGE(PG8_SA(0, 1), a2 + hstepA, voffA);
            PG8_WAIT_L(8); PG8_BAR; PG8_WAIT_L(0); PG8_MMA(0, 0, At, B0); PG8_BAR; PG8_SCHED;
            PG8_LDB(B1, 1, 1); PG8_STAGE(PG8_SB(1, 0), b3, voffB);
            PG8_BAR; PG8_WAIT_L(0); PG8_MMA(0, 1, At, B1); PG8_BAR;
            PG8_LDA(At, 1, 1); PG8_STAGE(PG8_SA(1, 0), a3, voffA);
            PG8_BAR; PG8_WAIT_L(0); PG8_MMA(1, 0, At, B0); PG8_BAR; PG8_SCHED;
            PG8_STAGE(PG8_SB(1, 1), b3 + hstepB, voffB);
            PG8_WAIT_V(6); PG8_BAR; PG8_MMA(1, 1, At, B1); PG8_BAR;
            }
        }
        if constexpr (ALIGN_EPI) { if (wr == 0) PG8_BAR; }
        if constexpr (!Epi::AFTER_DRAIN) { E(acc, cur, wr, wc, fr, fq); S.done(cur); }
        if (!has_next) break;
#pragma unroll
        for (int a = 0; a < 2; ++a)
#pragma unroll
            for (int b = 0; b < 2; ++b)
#pragma unroll
                for (int m = 0; m < 4; ++m)
#pragma unroll
                    for (int n = 0; n < 2; ++n) acc[a][b][m][n] = (f32x4){0.f, 0.f, 0.f, 0.f};
        cur = nxt; cA = nA; cB = nB; ++ui;
        if constexpr (ALIGN_EPI) { if (wr == 1) PG8_BAR; }
    }
    PG8_WAIT_V(0);
    if constexpr (!ALIGN_EPI) { if (wr == 0) PG8_BAR; }
    PG8_BAR;
    if constexpr (Epi::AFTER_DRAIN) { E.fused(acc, cur, wr, wc, fr, fq, lds, wid, lane); S.done(cur); }
#undef PG8_SA
#undef PG8_SB
#undef PG8_STAGE
#undef PG8_LDA
#undef PG8_LDB
#undef PG8_MMA
#undef PG8_WAIT_V
#undef PG8_WAIT_L
#undef PG8_BAR
#undef PG8_SCHED
}
}
constexpr int NWAVES = 8;
template <class RowMap>
__device__ __forceinline__ void transpose_item(const float* __restrict__ W, int K, int N, bf16_t* WT, const float* __restrict__ kscale, RowMap rm, LAS float* scr, int item, int lane) {
    const int nblk = (N + 31) / 32, kb = item / nblk, nb = item % nblk, k0 = 64 * kb, n0 = 32 * nb;
    const int nr = n0 + (lane & 31);
    float v[32];
#pragma unroll
    for (int i = 0; i < 32; ++i) { const int kk = 2 * i + (lane >> 5); v[i] = (nr < N) ? W[(size_t)(k0 + kk) * N + nr] : 0.f; }
    if (kscale) {
#pragma unroll
        for (int i = 0; i < 32; ++i) v[i] *= kscale[k0 + 2 * i + (lane >> 5)];
    }
#pragma unroll
    for (int i = 0; i < 32; ++i) scr[(2 * i + (lane >> 5)) * 33 + (lane & 31)] = v[i];
    asm volatile("s_waitcnt lgkmcnt(0)" ::: "memory");
    const int c = lane & 7;
#pragma unroll
    for (int j = 0; j < 4; ++j) { const int nl = (lane >> 3) + 8 * j, n = n0 + nl;
        if (n < N) { const LAS float* s = scr + (8 * c) * 33 + nl;
            u32x4_t o; o.x = pk2(s[0 * 33], s[1 * 33]); o.y = pk2(s[2 * 33], s[3 * 33]); o.z = pk2(s[4 * 33], s[5 * 33]); o.w = pk2(s[6 * 33], s[7 * 33]);
            *(u32x4_t*)(WT + (size_t)rm(n) * K + k0 + 8 * c) = o; } }
    asm volatile("s_waitcnt lgkmcnt(0)" ::: "memory");
}
struct RmIdent { __device__ __forceinline__ int operator()(int n) const { return n; } };
struct RmWin {
    __device__ __forceinline__ int operator()(int c) const {
        const int nc = c < 2560 ? c : (c < 2608 ? 4608 + (c - 2560) : 2560 + (c - 2608));
        const int tile = nc >> 8, L = nc & 255, wc = L >> 6, bj = (L >> 5) & 1, j = L & 31;
        return tile * 256 + 128 * bj + 32 * wc + j;
    }
};
struct RmWup {
    __device__ __forceinline__ int operator()(int c) const { const int up = c >= D_FF, cc = up ? c - D_FF : c; return (cc >> 7) * 256 + up * 128 + (cc & 127); }
};

struct Ptrs {
    const float* in[18]; float* out; unsigned char* ws;
};

__device__ __forceinline__ void p0_prologue(const Ptrs& P, LAS unsigned char* lds, int vcu, int G, const int wave) {
    const int lane = fresh_lane();
    LAS float* scr = (LAS float*)(lds + wave * 16384);
    const int gw = vcu * NWAVES + wave, NGW = G * NWAVES;
    unsigned char* ws = P.ws;
    bf16_t* WinT = (bf16_t*)(ws + WS_WIN); bf16_t* WoutT = (bf16_t*)(ws + WS_WOUT); bf16_t* WupT = (bf16_t*)(ws + WS_WUP); bf16_t* WdownT = (bf16_t*)(ws + WS_WDOWN); bf16_t* W1cT = (bf16_t*)(ws + WS_W1C);
    const float* x = P.in[0]; const float* attn_norm_w = P.in[1]; const float* w_in = P.in[2]; const float* cmp_pos = P.in[5]; const float* cmp_w1 = P.in[6];
    const float* w_out = P.in[12]; const float* ffn_norm_w = P.in[13]; const float* w_up = P.in[14]; const float* w_down = P.in[17];
    constexpr int I_IN = 32 * 146, I_OUT = 32 * 64, I_UP = 32 * 352, I_DOWN = 88 * 64, I_W1 = 32 * 8, I_W2 = 4 * 2;
    constexpr int NITEMS = I_IN + I_OUT + I_UP + I_DOWN + 2 * I_W1 + 2 * I_W2;
    for (int it = gw; it < NITEMS; it += NGW) {
        int r = it;
        if (r < I_IN) { transpose_item(w_in, 2048, IN_COLS, WinT, nullptr, RmWin(), scr, r, lane); continue; } r -= I_IN;
        if (r < I_OUT) { transpose_item(w_out, 2048, 2048, WoutT, nullptr, RmIdent(), scr, r, lane); continue; } r -= I_OUT;
        if (r < I_UP) { transpose_item(w_up, 2048, N_UP, WupT, ffn_norm_w, RmWup(), scr, r, lane); continue; } r -= I_UP;
        if (r < I_DOWN) { transpose_item(w_down, D_FF, 2048, WdownT, nullptr, RmIdent(), scr, r, lane); continue; } r -= I_DOWN;
        if (r < I_W1) { transpose_item(cmp_w1, 2048, 256, W1cT, nullptr, RmIdent(), scr, r, lane); continue; } r -= I_W1;
        if (r < I_W1) { transpose_item(cmp_w1 + (size_t)2048 * 256, 2048, 256, W1cT + (size_t)256 * 2048, nullptr, RmIdent(), scr, r, lane); continue; } r -= I_W1;
        { const int kv = r >= I_W2 ? 1 : 0; transpose_item(P.in[7] + (size_t)kv * 256 * 64, 256, 64, (bf16_t*)(ws + WS_SMALL + SM_W2T) + (size_t)kv * 64 * 256, nullptr, RmIdent(), scr, r - kv * I_W2, lane); }
    }
    for (int i = gw * 64 + lane; i < 8 * 16384; i += NGW * 64) { const int t = (i >> 7) & 127, sx = i & 127; ((bf16_t*)(ws + WS_SMALL + SM_SWB))[i] = (bf16_t)(sx <= t ? f2bf(P.in[10][i]) : 0u); }
    for (int p = gw; p < 256; p += NGW) {
        const int L = 64 * ((p >> 5) & 3) + 32 * (p >> 7) + (p & 31);
        if (L >= 48) { u32x4_t z = {0u, 0u, 0u, 0u}; u32x4_t* d = (u32x4_t*)(WinT + (size_t)(18 * 256 + p) * 2048);
#pragma unroll
            for (int j = 0; j < 4; ++j) d[lane + 64 * j] = z; }
    }
    bf16_t* XN = (bf16_t*)(ws + WS_XN);
    for (int m = gw; m < MTOK; m += 2 * NGW) {
        const int m2 = m + NGW;
        const f32x4_t* xr = (const f32x4_t*)(x + (size_t)m * D_MODEL) + lane;
        const f32x4_t* xr2 = (const f32x4_t*)(x + (size_t)(m2 < MTOK ? m2 : m) * D_MODEL) + lane;
        f32x4_t v[8], v2[8]; float s = 0.f, s2 = 0.f;
#pragma unroll
        for (int j = 0; j < 8; ++j) { v[j] = xr[64 * j]; v2[j] = xr2[64 * j]; }
#pragma unroll
        for (int j = 0; j < 8; ++j) { s += (v[j][0] * v[j][0] + v[j][1] * v[j][1]) + (v[j][2] * v[j][2] + v[j][3] * v[j][3]); s2 += (v2[j][0] * v2[j][0] + v2[j][1] * v2[j][1]) + (v2[j][2] * v2[j][2] + v2[j][3] * v2[j][3]); }
        const float r = __builtin_amdgcn_rsqf(wave_sum(s) * (1.0f / D_MODEL) + 1e-6f), r2 = __builtin_amdgcn_rsqf(wave_sum(s2) * (1.0f / D_MODEL) + 1e-6f);
        u32x2_t* o8 = (u32x2_t*)(XN + (size_t)m * D_MODEL) + lane; u32x2_t* o82 = (u32x2_t*)(XN + (size_t)m2 * D_MODEL) + lane;
#pragma unroll
        for (int j = 0; j < 8; ++j) { const f32x4_t w = ((const f32x4_t*)attn_norm_w)[lane + 64 * j];
            u32x2_t o; o.x = pk2(v[j][0] * r * w[0], v[j][1] * r * w[1]); o.y = pk2(v[j][2] * r * w[2], v[j][3] * r * w[3]); o8[64 * j] = o;
            if (m2 < MTOK) { u32x2_t q; q.x = pk2(v2[j][0] * r2 * w[0], v2[j][1] * r2 * w[1]); q.y = pk2(v2[j][2] * r2 * w[2], v2[j][3] * r2 * w[3]); o82[64 * j] = q; } }
    }
    float* BIASP = (float*)(ws + WS_SMALL + SM_BIASP);
    for (int it = gw; it < 64; it += NGW) {
        const int kv = it >> 5, kc = it & 31; f32x4_t a = {0.f, 0.f, 0.f, 0.f};
        const float* pp = cmp_pos + kv * 2048 + kc * 64; const float* w1 = cmp_w1 + ((size_t)kv * 2048 + kc * 64) * 256;
        for (int k = 0; k < 64; ++k) { const f32x4_t w = ((const f32x4_t*)(w1 + (size_t)k * 256))[lane]; a += w * pp[k]; }
        ((f32x4_t*)(BIASP + (size_t)it * 256))[lane] = a;
    }
}

__device__ __forceinline__ void bias1_stage(unsigned char* ws, int idx  ) {
    const float* BIASP = (const float*)(ws + WS_SMALL + SM_BIASP); float* BIAS1 = (float*)(ws + WS_SMALL + SM_BIAS1);
    const int kv = idx >> 8, j = idx & 255; float s = 0.f;
    for (int kc = 0; kc < 32; ++kc) s += BIASP[(size_t)(kv * 32 + kc) * 256 + j];
    BIAS1[idx] = s;
}
__device__ __forceinline__ void cmp2_row(const Ptrs& P, int R, int lane) {
    unsigned char* ws = P.ws; const bf16_t* HC = (const bf16_t*)(ws + WS_HC);
    const int kv = R >> 12, rr = R & 4095, n = rr & 255;
    bf16_t* dst = (bf16_t*)(ws + (kv ? WS_VC : WS_KC)) + (size_t)rr * 64 + lane;
    if (n == 255) { *dst = 0; return; }
    const float* w2 = P.in[7] + (size_t)kv * 256 * 64;
    const u32x2_t hr = *(const u32x2_t*)(HC + (size_t)R * 256 + 4 * lane);
    float h[4] = {__uint_as_float(hr.x << 16), __uint_as_float(hr.x & 0xffff0000u), __uint_as_float(hr.y << 16), __uint_as_float(hr.y & 0xffff0000u)};
    float o = 0.f;
    for (int jj = 0; jj < 64; ++jj) {
#pragma unroll
        for (int i = 0; i < 4; ++i) o += __shfl(h[i], jj) * w2[(size_t)(4 * jj + i) * 64 + lane];
    }
    if (kv == 0) { const float ss = wave_sum(o * o); o *= __builtin_amdgcn_rsqf(ss * (1.0f / 64.0f) + 1e-6f) * P.in[4][lane]; }
    *dst = (bf16_t)f2bf(o);
}

__device__ __forceinline__ void gmlp_unit_v1(const Ptrs& P, LAS unsigned char* lds, int unit, const int wave_s) {
    unsigned char* ws = P.ws; const int tid = fresh_tid(wave_s);
    const int g = unit & 7, chunk = (unit >> 3) & 31, b = unit >> 8; const int m0 = b * SEQ + chunk * 128;
    LAS float* vn = (LAS float*)lds; LAS float* Wl = (LAS float*)(lds + 65536); LAS float* st = (LAS float*)(lds + 131072);
    const bf16_t* GV = (const bf16_t*)(ws + WS_GV); const bf16_t* U = (const bf16_t*)(ws + WS_U); const float* VSTAT = (const float*)(ws + WS_VSTAT);
    bf16_t* AB = (bf16_t*)(ws + WS_AB);
    const float* ln_w = P.in[8]; const float* ln_b = P.in[9]; const float* sw = P.in[10]; const float* sb = P.in[11];
    if (tid < 128) { const float* p = VSTAT + (size_t)(m0 + tid) * 32; float s1 = 0.f, s2 = 0.f;
#pragma unroll
        for (int i = 0; i < 16; ++i) { s1 += p[2 * i]; s2 += p[2 * i + 1]; }
        const float mean = s1 * (1.0f / 1024.0f); float var = s2 * (1.0f / 1024.0f) - mean * mean; var = var < 0.f ? 0.f : var;
        st[2 * tid] = mean; st[2 * tid + 1] = __builtin_amdgcn_rsqf(var + 1e-5f); }
    for (int i = 0; i < 32; ++i) { const int idx = tid + 512 * i, t = idx >> 7, s = idx & 127; Wl[idx] = (s <= t) ? sw[(size_t)g * 16384 + idx] : 0.f; }
    __syncthreads();
#pragma unroll
    for (int i = 0; i < 4; ++i) { const int idx = tid + 512 * i, s = idx >> 4, c8 = idx & 15;
        const u32x4_t raw = *(const u32x4_t*)(GV + (size_t)(m0 + s) * 1024 + g * 128 + 8 * c8); float f[8]; unpack8(raw, f);
        const float mean = st[2 * s], rstd = st[2 * s + 1];
#pragma unroll
        for (int e = 0; e < 8; ++e) { const int c = g * 128 + 8 * c8 + e; vn[s * 128 + 8 * c8 + e] = (f[e] - mean) * rstd * ln_w[c] + ln_b[c]; } }
    __syncthreads();
    const int c = tid & 127, tq = tid >> 7;
    for (int i = 0; i < 8; ++i) {
        const int t0 = 4 * (tq + 4 * i); float a0 = 0.f, a1 = 0.f, a2 = 0.f, a3 = 0.f;
        for (int s4 = 0; s4 <= t0; s4 += 4) {
            const f32x4_t w0 = *(const LAS f32x4_t*)(Wl + (t0 + 0) * 128 + s4), w1 = *(const LAS f32x4_t*)(Wl + (t0 + 1) * 128 + s4), w2 = *(const LAS f32x4_t*)(Wl + (t0 + 2) * 128 + s4), w3 = *(const LAS f32x4_t*)(Wl + (t0 + 3) * 128 + s4);
#pragma unroll
            for (int k = 0; k < 4; ++k) { const float v = vn[(s4 + k) * 128 + c]; a0 += w0[k] * v; a1 += w1[k] * v; a2 += w2[k] * v; a3 += w3[k] * v; }
        }
        const float av[4] = {a0, a1, a2, a3};
#pragma unroll
        for (int k = 0; k < 4; ++k) { const int t = t0 + k; const size_t row = (size_t)(m0 + t);
            const float uu = bf2f(U[row * 1024 + g * 128 + c]); AB[row * 2048 + 1024 + g * 128 + c] = (bf16_t)f2bf(uu * (av[k] + sb[g * 128 + t])); }
    }
    __syncthreads();
}

__device__ __forceinline__ void conv_item(const Ptrs& P, int b, int idx) {
    const int t = idx / 704, c8 = idx % 704, c0 = 8 * c8, j = c0 >> 7, i0 = c0 & 127;
    const bf16_t* HID = (const bf16_t*)(P.ws + WS_HID); const float* cw = P.in[15]; const float* cb = P.in[16];
    float gt[8], up[8];
#pragma unroll
    for (int e = 0; e < 8; ++e) { gt[e] = cb[c0 + e]; up[e] = cb[D_FF + c0 + e]; }
#pragma unroll
    for (int k = 0; k < 3; ++k) { const int tt = t - 2 + k; if (tt < 0) continue;
        float hg[8], hu[8]; unpack8(*(const u32x4_t*)(HID + (size_t)tt * N_UP + 256 * j + i0), hg); unpack8(*(const u32x4_t*)(HID + (size_t)tt * N_UP + 256 * j + 128 + i0), hu);
#pragma unroll
        for (int e = 0; e < 8; ++e) { gt[e] += cw[(size_t)k * N_UP + c0 + e] * hg[e]; up[e] += cw[(size_t)k * N_UP + D_FF + c0 + e] * hu[e]; } }
    float r[8];
#pragma unroll
    for (int e = 0; e < 8; ++e) r[e] = gt[e] * sigmoidf_(gt[e]) * up[e];
    u32x4_t o; o.x = pk2(r[0], r[1]); o.y = pk2(r[2], r[3]); o.z = pk2(r[4], r[5]); o.w = pk2(r[6], r[7]);
    *(u32x4_t*)((bf16_t*)(P.ws + WS_G) + ((size_t)b * SEQ + t) * D_FF + c0) = o;
}

namespace nsa {
using bf16x8 = __attribute__((ext_vector_type(8))) short;
using s16x4 = __attribute__((ext_vector_type(4))) short;
using f32x16 = __attribute__((ext_vector_type(16))) float;
typedef float f32x2_t __attribute__((ext_vector_type(2))); typedef __bf16 bf16x2_t __attribute__((ext_vector_type(2)));
constexpr int L_K = 0, L_V = 16384, L_WSF = 32768, L_OST = 34816, L_IMP = 100352, L_MASK = 116736, L_WU = 117248, L_END = 117312;
constexpr int SLOTB = 8192;
constexpr float THR = 8.0f;
#define NSA_SBAR() __builtin_amdgcn_sched_barrier(0)
__device__ __forceinline__ int crow(int r, int hi) { return (r & 3) + 8 * (r >> 2) + 4 * hi; }
__device__ __forceinline__ void glds16(const void* gbase  , unsigned voff  , unsigned lds_dst) { unsigned keep;
    asm volatile("s_mov_b32 %0, m0\n\ts_mov_b32 m0, %3\n\ts_nop 0\n\tglobal_load_lds_dwordx4 %1, %2\n\ts_mov_b32 m0, %0" : "=&s"(keep) : "v"(voff), "s"(gbase), "s"(lds_dst) : "memory"); }
__device__ __forceinline__ unsigned cvtpk_s(float lo, float hi) { f32x2_t v = {lo, hi}; bf16x2_t b = __builtin_convertvector(v, bf16x2_t); return __builtin_bit_cast(unsigned, b); }
#define NSA_WAIT_BAR() asm volatile("s_waitcnt vmcnt(0) lgkmcnt(0)\n\ts_barrier" ::: "memory")

__device__ __forceinline__ void qkt(f32x16& p0, f32x16& p1, LAS const char* Kslot, const bf16x8 (&qr)[4], int r32, int hi) {
    LAS const char* kb = Kslot + hi * 1024 + r32 * 16;
#pragma unroll
    for (int d0 = 0; d0 < 4; ++d0) {
        const bf16x8 b0 = *(LAS const bf16x8*)(kb + d0 * 2048);
        const bf16x8 b1 = *(LAS const bf16x8*)(kb + d0 * 2048 + 512);
        p0 = __builtin_amdgcn_mfma_f32_32x32x16_bf16(b0, qr[d0], p0, 0, 0, 0); p1 = __builtin_amdgcn_mfma_f32_32x32x16_bf16(b1, qr[d0], p1, 0, 0, 0);
    }
}
struct VFrag { s16x4 lo[2][4], hi[2][4]; };
__device__ __forceinline__ void vload(VFrag& f, int vb) {
#pragma unroll
    for (int d0 = 0; d0 < 2; ++d0)
#pragma unroll
        for (int ks = 0; ks < 4; ++ks) {
            asm volatile("ds_read_b64_tr_b16 %0,%1 offset:%c2" : "=&v"(f.lo[d0][ks]) : "v"(vb), "i"(d0 * 4096 + ks * 1024) : "memory");
            asm volatile("ds_read_b64_tr_b16 %0,%1 offset:%c2" : "=&v"(f.hi[d0][ks]) : "v"(vb), "i"(d0 * 4096 + ks * 1024 + 512) : "memory"); }
}
__device__ __forceinline__ void pvmma(f32x16 (&o)[2], VFrag& f, bf16x8 pa0, bf16x8 pa1, bf16x8 pa2, bf16x8 pa3) {
    asm volatile("s_waitcnt lgkmcnt(0)" : "+v"(f.lo[0][0]), "+v"(f.lo[0][1]), "+v"(f.lo[0][2]), "+v"(f.lo[0][3]), "+v"(f.hi[0][0]), "+v"(f.hi[0][1]), "+v"(f.hi[0][2]), "+v"(f.hi[0][3]) :: "memory");
    asm volatile("" : "+v"(f.lo[1][0]), "+v"(f.lo[1][1]), "+v"(f.lo[1][2]), "+v"(f.lo[1][3]), "+v"(f.hi[1][0]), "+v"(f.hi[1][1]), "+v"(f.hi[1][2]), "+v"(f.hi[1][3]));
    NSA_SBAR();
#pragma unroll
    for (int d0 = 0; d0 < 2; ++d0) {
#define NSA_PK(k) (bf16x8){f.lo[d0][k][0], f.lo[d0][k][1], f.lo[d0][k][2], f.lo[d0][k][3], f.hi[d0][k][0], f.hi[d0][k][1], f.hi[d0][k][2], f.hi[d0][k][3]}
        o[d0] = __builtin_amdgcn_mfma_f32_32x32x16_bf16(pa0, NSA_PK(0), o[d0], 0, 0, 0);
        o[d0] = __builtin_amdgcn_mfma_f32_32x32x16_bf16(pa1, NSA_PK(1), o[d0], 0, 0, 0);
        o[d0] = __builtin_amdgcn_mfma_f32_32x32x16_bf16(pa2, NSA_PK(2), o[d0], 0, 0, 0);
        o[d0] = __builtin_amdgcn_mfma_f32_32x32x16_bf16(pa3, NSA_PK(3), o[d0], 0, 0, 0);
#undef NSA_PK
    }
}
__device__ __forceinline__ void pv(f32x16 (&o)[2], int vb, bf16x8 pa0, bf16x8 pa1, bf16x8 pa2, bf16x8 pa3) { VFrag f; vload(f, vb); pvmma(o, f, pa0, pa1, pa2, pa3); }
__device__ __forceinline__ float rowmax32(const f32x16& p0, const f32x16& p1) {
    float a = __builtin_fmaxf(p0[0], p1[0]);
#pragma unroll
    for (int r = 1; r < 16; ++r) a = __builtin_fmaxf(a, __builtin_fmaxf(p0[r], p1[r]));
    auto rr = __builtin_amdgcn_permlane32_swap(__float_as_uint(a), __float_as_uint(a), false, false);
    return __builtin_fmaxf(__uint_as_float(rr[0]), __uint_as_float(rr[1]));
}
struct State { float m, l; f32x16 o[2]; };
__device__ __forceinline__ void state_init(State& s) { s.m = -1e30f; s.l = 0.f; s.o[0] = f32x16{}; s.o[1] = f32x16{}; }

template <int BMUL, int MASK, bool LOADV>
__device__ __forceinline__ void tile_scores(f32x16& p0, f32x16& p1, LAS const char* Kslot, const bf16x8 (&qr)[4], const f32x16& bk, float c0, float b32, int lim, int r32, int hi, VFrag& vf, int vb) {
#pragma unroll
    for (int r = 0; r < 16; ++r) { const float b = (BMUL == 1) ? bk[r] + c0 : __builtin_fmaf(bk[r], (float)BMUL, c0); p0[r] = b; p1[r] = b + b32; }
    qkt(p0, p1, Kslot, qr, r32, hi);
    if (LOADV) vload(vf, vb);
    const int limh = lim - 4 * hi;
#pragma unroll
    for (int r = 0; r < 16; ++r) {
        const int kk = (r & 3) + 8 * (r >> 2);
        if (MASK == 1) { if (!(kk <= limh)) p0[r] = -INFINITY; if (!(kk + 32 <= limh)) p1[r] = -INFINITY; }
        if (MASK == 2) { if (!(kk > limh)) p0[r] = -INFINITY; if (!(kk + 32 > limh)) p1[r] = -INFINITY; }
        if (MASK == 3) { if (!(kk < limh)) p0[r] = -INFINITY; if (!(kk + 32 < limh)) p1[r] = -INFINITY; }
    }
}
__device__ __forceinline__ float tile_ref(const State& st, float rb0, bool rowlive) { return (st.m < -1e29f && rowlive) ? rb0 : st.m; }
__device__ __forceinline__ void tile_softmax_pv(State& st, f32x16& p0, f32x16& p1, float mref, VFrag& vf, LAS float* wsf, int r32, int hi) {
    float a0 = p0[0], a1 = p1[0];
#pragma unroll
    for (int r = 1; r < 16; ++r) { a0 = __builtin_fmaxf(a0, p0[r]); a1 = __builtin_fmaxf(a1, p1[r]); }
    float mx = __builtin_fmaxf(a0, a1);
    { auto rr = __builtin_amdgcn_permlane32_swap(__float_as_uint(mx), __float_as_uint(mx), false, false); mx = __builtin_fmaxf(__uint_as_float(rr[0]), __uint_as_float(rr[1])); }
    if (__any(mx > THR)) {
        const float dl = __builtin_fmaxf(mx, 0.f), alpha = __builtin_amdgcn_exp2f(-dl);
        mref += dl; st.l *= alpha;
        if (hi == 0) wsf[r32] = alpha;
        asm volatile("s_waitcnt lgkmcnt(0)" ::: "memory");
#pragma unroll
        for (int r = 0; r < 16; ++r) { const float a = wsf[crow(r, hi)]; st.o[0][r] *= a; st.o[1][r] *= a; p0[r] -= dl; p1[r] -= dl; }
    }
    st.m = mref;
    float ls = 0.f;
#pragma unroll
    for (int r = 0; r < 16; ++r) { p0[r] = __builtin_amdgcn_exp2f(p0[r]); p1[r] = __builtin_amdgcn_exp2f(p1[r]); ls += p0[r] + p1[r]; }
    st.l += ls;
    u32x4_t pw0, pw1, pw2, pw3;
    pw0 = (u32x4_t){cvtpk_s(p0[0], p0[1]), cvtpk_s(p0[2], p0[3]), cvtpk_s(p0[4], p0[5]), cvtpk_s(p0[6], p0[7])};
    pw1 = (u32x4_t){cvtpk_s(p0[8], p0[9]), cvtpk_s(p0[10], p0[11]), cvtpk_s(p0[12], p0[13]), cvtpk_s(p0[14], p0[15])};
    pw2 = (u32x4_t){cvtpk_s(p1[0], p1[1]), cvtpk_s(p1[2], p1[3]), cvtpk_s(p1[4], p1[5]), cvtpk_s(p1[6], p1[7])};
    pw3 = (u32x4_t){cvtpk_s(p1[8], p1[9]), cvtpk_s(p1[10], p1[11]), cvtpk_s(p1[12], p1[13]), cvtpk_s(p1[14], p1[15])};
    pvmma(st.o, vf, __builtin_bit_cast(bf16x8, pw0), __builtin_bit_cast(bf16x8, pw1), __builtin_bit_cast(bf16x8, pw2), __builtin_bit_cast(bf16x8, pw3));
}
template <bool FIRST>
__device__ __forceinline__ void fold_branch(LAS float* ostg, State& st, float gate, LAS float* wsf, int r32, int hi) {
    float l = st.l;
    { auto rr = __builtin_amdgcn_permlane32_swap(__float_as_uint(l), __float_as_uint(l), false, false); l = __uint_as_float(rr[0]) + __uint_as_float(rr[1]); }
    const float f = l > 0.f ? gate / l : 0.f;
    asm volatile("s_waitcnt lgkmcnt(0)" ::: "memory");
    if (hi == 0) wsf[r32] = f;
    asm volatile("s_waitcnt lgkmcnt(0)" ::: "memory");
#pragma unroll
    for (int r = 0; r < 16; ++r) { const int orow = crow(r, hi); const float a = wsf[orow];
#pragma unroll
        for (int d0 = 0; d0 < 2; ++d0) { LAS float* p = ostg + orow * 64 + d0 * 32 + r32; if (FIRST) *p = st.o[d0][r] * a; else *p += st.o[d0][r] * a; } }
    asm volatile("s_waitcnt lgkmcnt(0)" ::: "memory");
}

__device__ __forceinline__ void nsa_unit(const Ptrs& P, LAS unsigned char* lds, int bg, int qt, const int wave_s) {
    unsigned char* ws = P.ws;
    const int lane = fresh_lane(), r32 = lane & 31, hi = lane >> 5; const int wid = wave_s;
    const int b = bg >> 2, g = bg & 3, t0 = 64 * qt;
    const int tl = 8 * wid + (r32 >> 2), hq = r32 & 3;
    const size_t m0 = (size_t)b * SEQ + t0;
    const bf16_t* Q = (const bf16_t*)(ws + WS_Q); const bf16_t* KV6 = (const bf16_t*)(ws + WS_KV6);
    const bf16_t* KSb = KV6 + 2 * KVSZ + (size_t)bg * SEQ * 64; const bf16_t* VSb = KV6 + 3 * KVSZ + (size_t)bg * SEQ * 64;
    const bf16_t* KWb = KV6 + 4 * KVSZ + (size_t)bg * SEQ * 64; const bf16_t* VWb = KV6 + 5 * KVSZ + (size_t)bg * SEQ * 64;
    const bf16_t* KCb = (const bf16_t*)(ws + WS_KC) + (size_t)bg * 256 * 64; const bf16_t* VCb = (const bf16_t*)(ws + WS_VC) + (size_t)bg * 256 * 64;
    const float* GATES = (const float*)(ws + WS_GATES); bf16_t* AB = (bf16_t*)(ws + WS_AB);
    const unsigned lds0 = (unsigned)(uintptr_t)lds;
    LAS float* wsf = (LAS float*)(lds + L_WSF) + wid * 64;
    LAS float* IMP = (LAS float*)(lds + L_IMP);
    LAS unsigned* MASK = (LAS unsigned*)(lds + L_MASK); LAS unsigned* WU = (LAS unsigned*)(lds + L_WU);
    const int koff = lane * 64 + wid * 8, voff = (16 * (wid & 3) + (lane >> 2)) * 64 + (wid >> 2) * 32 + (lane & 3) * 8;
    const unsigned kdst = lds0 + L_K + wid * 1024, vdst = lds0 + L_V + wid * 1024;
#define NSA_DMA_K(base, tile, slot) glds16((base) + (size_t)(tile) * 4096, (unsigned)koff * 2u, (unsigned)__builtin_amdgcn_readfirstlane(kdst + (slot) * SLOTB))
#define NSA_DMA_V(base, tile, slot) glds16((base) + (size_t)(tile) * 4096, (unsigned)voff * 2u, (unsigned)__builtin_amdgcn_readfirstlane(vdst + (slot) * SLOTB))
    const int vb0 = (int)(lds0 + L_V) + ((lane >> 4) & 1) * 32 + (lane & 3) * 8 + (4 * hi + ((lane & 15) >> 2)) * 64;
    LAS const char* Kbase = (LAS const char*)(lds + L_K);
    bf16x8 qr[4];
    { const bf16_t* qp = Q + (m0 + tl) * 1024 + (4 * g + hq) * 64 + hi * 8;
#pragma unroll
      for (int d0 = 0; d0 < 4; ++d0) qr[d0] = *(const bf16x8*)(qp + d0 * 16); }
    const float sl2 = __builtin_amdgcn_exp2f(-0.5f * (float)(4 * g + hq + 1)) * LOG2E;
    f32x16 bk;
#pragma unroll
    for (int r = 0; r < 16; ++r) bk[r] = sl2 * (float)((r & 3) + 8 * (r >> 2));
    const float b32t = 32.0f * sl2, b32c = 512.0f * sl2, hoff_t = 4.0f * (float)hi * sl2, hoff_c = 64.0f * (float)hi * sl2;
    float gate[3];
    { const float* gp = GATES + (m0 + tl) * 48 + (4 * g + hq) * 3; gate[0] = gp[0]; gate[1] = gp[1]; gate[2] = gp[2]; }
    LAS float* ostg = (LAS float*)(lds + L_OST) + wid * 2048;
    State st;
    f32x16 p0, p1;

    int tc = 0;
    VFrag vf;
    const int nvmax = (t0 + 63 >= 31) ? ((t0 + 63 - 31) >> 4) + 1 : 0;
    const int nct = (nvmax + 63) >> 6;
    const int tq = t0 + tl, nv = tq >= 31 ? ((tq - 31) >> 4) + 1 : 0;
    {
        state_init(st);
        const int j0 = qt >= 8 ? qt - 8 : 0, nt = qt - j0 + 1;
        NSA_DMA_K(KWb, qt, 0); NSA_DMA_V(VWb, qt, 0); NSA_WAIT_BAR();
        for (int i = 0; i < nt; ++i) {
            const int j = qt - i, slot = (tc + i) & 1;
            if (i + 1 < nt) { NSA_DMA_K(KWb, j - 1, slot ^ 1); NSA_DMA_V(VWb, j - 1, slot ^ 1); }
            else { NSA_DMA_K(KCb, nct - 1, slot ^ 1); NSA_DMA_V(VCb, nct - 1, slot ^ 1); }
            const float rb0 = sl2 * (float)(64 * j - t0), mref = tile_ref(st, rb0, true), c0 = rb0 + hoff_t - mref;
            if (j == qt) tile_scores<1, 1, true>(p0, p1, Kbase + slot * SLOTB, qr, bk, c0, b32t, tl, r32, hi, vf, vb0 + slot * SLOTB);
            else if (j == qt - 8) tile_scores<1, 2, true>(p0, p1, Kbase + slot * SLOTB, qr, bk, c0, b32t, tl, r32, hi, vf, vb0 + slot * SLOTB);
            else tile_scores<1, 0, true>(p0, p1, Kbase + slot * SLOTB, qr, bk, c0, b32t, 0, r32, hi, vf, vb0 + slot * SLOTB);
            tile_softmax_pv(st, p0, p1, mref, vf, wsf, r32, hi);
            NSA_WAIT_BAR();
        }
        tc += nt;
        fold_branch<true>(ostg, st, gate[2], wsf, r32, hi);
    }
    {
        state_init(st);
        for (int ci = 0; ci < nct; ++ci) {
            const int c = nct - 1 - ci, slot = (tc + ci) & 1;
            if (ci + 1 < nct) { NSA_DMA_K(KCb, c - 1, slot ^ 1); NSA_DMA_V(VCb, c - 1, slot ^ 1); }
            else if (qt >= 16) { NSA_DMA_K(KCb, 0, slot ^ 1); }
            else { NSA_DMA_K(KSb, qt, slot ^ 1); NSA_DMA_V(VSb, qt, slot ^ 1); }
            const float rb0 = sl2 * ((float)(1024 * c - t0) + 15.5f), mref = tile_ref(st, rb0, true), c0 = rb0 + hoff_c - mref;
            tile_scores<16, 3, true>(p0, p1, Kbase + slot * SLOTB, qr, bk, c0, b32c, nv - 64 * c, r32, hi, vf, vb0 + slot * SLOTB);
            tile_softmax_pv(st, p0, p1, mref, vf, wsf, r32, hi);
            NSA_WAIT_BAR();
        }
        tc += nct;
    }
    const float mc_fin = st.m; float lc = st.l;
    fold_branch<false>(ostg, st, gate[0], wsf, r32, hi);
    if (qt >= 16) {
        { auto rr = __builtin_amdgcn_permlane32_swap(__float_as_uint(lc), __float_as_uint(lc), false, false); lc = __uint_as_float(rr[0]) + __uint_as_float(rr[1]); }
        const float invl = lc > 0.f ? 1.0f / lc : 0.f;
        float carry = 0.f;
        for (int c = 0; c < nct; ++c) {
            const int slot = (tc + c) & 1;
            if (c + 1 < nct) { NSA_DMA_K(KCb, c + 1, slot ^ 1); }
            else { NSA_DMA_K(KSb, qt, slot ^ 1); NSA_DMA_V(VSb, qt, slot ^ 1); }
            const float c0 = sl2 * ((float)(1024 * c - t0) + 15.5f) + hoff_c - mc_fin;
            tile_scores<16, 3, false>(p0, p1, Kbase + slot * SLOTB, qr, bk, c0, b32c, nv - 64 * c, r32, hi, vf, 0);
#pragma unroll
            for (int r = 0; r < 16; ++r) { p0[r] = __builtin_amdgcn_exp2f(p0[r]) * invl; p1[r] = __builtin_amdgcn_exp2f(p1[r]) * invl; }
            float imp0[4], imp1[4], pl0[4], pl1[4];
#pragma unroll
            for (int a = 0; a < 4; ++a) {
                imp0[a] = (p0[4 * a] + p0[4 * a + 1]) + (p0[4 * a + 2] + p0[4 * a + 3]); imp1[a] = (p1[4 * a] + p1[4 * a + 1]) + (p1[4 * a + 2] + p1[4 * a + 3]);
                pl0[a] = __shfl_xor(p0[4 * a + 3], 32); pl1[a] = __shfl_xor(p1[4 * a + 3], 32);
            }
            if (hi) {
#pragma unroll
                for (int a = 0; a < 4; ++a) { imp0[a] += pl0[a]; imp1[a] += pl1[a]; }
            } else {
                imp0[0] += carry; imp1[0] += pl0[3];
#pragma unroll
                for (int a = 1; a < 4; ++a) { imp0[a] += pl0[a - 1]; imp1[a] += pl1[a - 1]; }
            }
            carry = pl1[3];
#pragma unroll
            for (int a = 0; a < 4; ++a) {
                imp0[a] += __shfl_xor(imp0[a], 1); imp0[a] += __shfl_xor(imp0[a], 2); imp1[a] += __shfl_xor(imp1[a], 1); imp1[a] += __shfl_xor(imp1[a], 2);
                if (hq == 0) { IMP[tl * 64 + 16 * c + 2 * a + hi] = imp0[a]; IMP[tl * 64 + 16 * c + 8 + 2 * a + hi] = imp1[a]; }
            }
            NSA_WAIT_BAR();
        }
        tc += nct;
    }
    unsigned long long wu = 0ull;
    if (qt < 16) {
        wu = (2ull << qt) - 1ull;
        if (lane < 8) { MASK[2 * (8 * wid + lane)] = (unsigned)wu; MASK[2 * (8 * wid + lane) + 1] = (unsigned)(wu >> 32); }
    } else {
        const int j = lane; const bool valid = j <= qt, forced = (j == 0) || (j == qt) || (j == qt - 1);
        for (int k = 0; k < 8; ++k) {
            const float imp = IMP[(8 * wid + k) * 64 + j];
            const float scv = valid ? (forced ? 1e9f : imp) : -1e9f;
            const unsigned fb = __float_as_uint(scv), key = fb ^ ((fb >> 31) ? 0xffffffffu : 0x80000000u);
            unsigned T = 0u;
#pragma unroll
            for (int bit = 31; bit >= 0; --bit) { const unsigned cand = T | (1u << bit); if (__builtin_popcountll(__ballot(key >= cand)) >= 16) T = cand; }
            const unsigned long long gt = __ballot(key > T), eq = __ballot(key == T);
            const int need = 16 - __builtin_popcountll(gt);
            const int before = (int)__builtin_amdgcn_mbcnt_hi((unsigned)(eq >> 32), __builtin_amdgcn_mbcnt_lo((unsigned)eq, 0u));
            const bool sel = (key > T) || ((key == T) && (before < need));
            const unsigned long long mk = __ballot(sel && (scv > -0.5e9f));
            wu |= mk;
            if (lane == 0) { MASK[2 * (8 * wid + k)] = (unsigned)mk; MASK[2 * (8 * wid + k) + 1] = (unsigned)(mk >> 32); }
        }
    }
    if (lane == 0) { WU[2 * wid] = (unsigned)wu; WU[2 * wid + 1] = (unsigned)(wu >> 32); }
    NSA_WAIT_BAR();
    unsigned long long uni = 0ull;
#pragma unroll
    for (int w = 0; w < 8; ++w) uni |= ((unsigned long long)WU[2 * w]) | (((unsigned long long)WU[2 * w + 1]) << 32);
    uni = ((unsigned long long)__builtin_amdgcn_readfirstlane((unsigned)uni)) | (((unsigned long long)__builtin_amdgcn_readfirstlane((unsigned)(uni >> 32))) << 32);
    const unsigned long long mymask = ((unsigned long long)MASK[2 * tl]) | (((unsigned long long)MASK[2 * tl + 1]) << 32);
    {
        state_init(st);
        unsigned long long rem = uni;
        int j = 63 - __builtin_clzll(rem); rem &= ~(1ull << j);
        for (int i = 0;; ++i) {
            const int slot = (tc + i) & 1; const bool more = rem != 0ull;
            int jn = 0;
            if (more) { jn = 63 - __builtin_clzll(rem); rem &= ~(1ull << jn); NSA_DMA_K(KSb, jn, slot ^ 1); NSA_DMA_V(VSb, jn, slot ^ 1); }
            if ((wu >> j) & 1ull) {
                const bool live = ((mymask >> j) & 1ull) != 0ull;
                const float rb0 = sl2 * (float)(64 * j - t0), mref = tile_ref(st, rb0, live), c0 = live ? rb0 + hoff_t - mref : -INFINITY;
                if (j == qt) tile_scores<1, 1, true>(p0, p1, Kbase + slot * SLOTB, qr, bk, c0, b32t, tl, r32, hi, vf, vb0 + slot * SLOTB);
                else tile_scores<1, 0, true>(p0, p1, Kbase + slot * SLOTB, qr, bk, c0, b32t, 0, r32, hi, vf, vb0 + slot * SLOTB);
                tile_softmax_pv(st, p0, p1, mref, vf, wsf, r32, hi);
            }
            NSA_WAIT_BAR();
            if (!more) break;
            j = jn;
        }
        fold_branch<false>(ostg, st, gate[1], wsf, r32, hi);
    }
    {
#pragma unroll
        for (int i = 0; i < 4; ++i) { const int row = i * 8 + (lane >> 3), ch = lane & 7;
            const f32x4_t v0 = *(LAS const f32x4_t*)(ostg + row * 64 + ch * 8), v1 = *(LAS const f32x4_t*)(ostg + row * 64 + ch * 8 + 4);
            u32x4_t v; v.x = cvtpk_s(v0[0], v0[1]); v.y = cvtpk_s(v0[2], v0[3]); v.z = cvtpk_s(v1[0], v1[1]); v.w = cvtpk_s(v1[2], v1[3]);
            *(u32x4_t*)(AB + (m0 + 8 * wid + (row >> 2)) * 2048 + 256 * g + (row & 3) * 64 + ch * 8) = v; }
    }
    NSA_WAIT_BAR();
#undef NSA_DMA_K
#undef NSA_DMA_V
}
__device__ __forceinline__ void nsa_phase(const Ptrs& P, LAS unsigned char* lds, int bid, int G, const int wave_s) {
    for (int u = bid; u < 1024; u += G) {
        const int c = u & 255, i = u >> 8, s = c & 63;
        nsa_unit(P, lds, 4 * (c >> 6) + i, (i & 1) ? 63 - s : s, wave_s);
    }
}
}

namespace p2 {
using nsa::bf16x8; using nsa::f32x16; using nsa::s16x4; using nsa::crow; using nsa::glds16; using nsa::cvtpk_s;
#define P2_WAIT_BAR() asm volatile("s_waitcnt vmcnt(0) lgkmcnt(0)\n\ts_barrier" ::: "memory")
constexpr int CB_BUF = 40960;
constexpr int CP_STRIDE = 65;
__device__ __forceinline__ void compress_unit(const Ptrs& P, LAS unsigned char* lds, int u, const int wave_s) {
    unsigned char* ws = P.ws;
    const int lane = fresh_lane(), r32 = lane & 31, hi = lane >> 5, wid = wave_s;
    const int kv = u >> 6, bg = (u >> 2) & 15, n0 = 64 * (u & 3);
    const bf16_t* Ag = (const bf16_t*)(ws + WS_KV6) + (size_t)kv * KVSZ + (size_t)bg * SEQ * 64 + (size_t)n0 * 1024;
    const bf16_t* Bg = (const bf16_t*)(ws + WS_W1C) + (size_t)kv * 256 * 2048;
    const unsigned lds0 = (unsigned)(uintptr_t)lds;
    const unsigned aoff = (unsigned)(lane * 1024 + wid * 8) * 2u, boff = (unsigned)(lane * 2048 + wid * 8) * 2u;
    const unsigned dstw = lds0 + wid * 1024;
#define P2_DMA_TILE(kt, buf) do { const unsigned d_ = (unsigned)__builtin_amdgcn_readfirstlane(dstw + (buf) * CB_BUF); \
        glds16(Ag + (kt) * 64, aoff, d_); \
        _Pragma("unroll") for (int ct_ = 0; ct_ < 4; ++ct_) glds16(Bg + (size_t)ct_ * 64 * 2048 + (kt) * 64, boff, d_ + 8192u * (ct_ + 1)); } while (0)
    const int ct = wid >> 1, half = wid & 1, ncol0 = 64 * ct + 32 * half;
    f32x16 hT[2]; hT[0] = f32x16{}; hT[1] = f32x16{};
    P2_DMA_TILE(0, 0); P2_WAIT_BAR();
    for (int kt = 0; kt < 32; ++kt) {
        const int buf = kt & 1;
        if (kt + 1 < 32) P2_DMA_TILE(kt + 1, buf ^ 1);
        LAS const char* sa = (LAS const char*)(lds + buf * CB_BUF) + hi * 1024 + r32 * 16;
        LAS const char* sb = (LAS const char*)(lds + buf * CB_BUF + 8192 * (ct + 1)) + half * 512 + hi * 1024 + r32 * 16;
#pragma unroll
        for (int d0 = 0; d0 < 4; ++d0) {
            const bf16x8 bf = *(LAS const bf16x8*)(sb + d0 * 2048), a0 = *(LAS const bf16x8*)(sa + d0 * 2048), a1 = *(LAS const bf16x8*)(sa + d0 * 2048 + 512);
            hT[0] = __builtin_amdgcn_mfma_f32_32x32x16_bf16(bf, a0, hT[0], 0, 0, 0);
            hT[1] = __builtin_amdgcn_mfma_f32_32x32x16_bf16(bf, a1, hT[1], 0, 0, 0);
        }
        P2_WAIT_BAR();
    }
    const float* bias1 = (const float*)(ws + WS_SMALL + SM_BIAS1) + kv * 256 + ncol0;
    bf16x8 hb[2][2];
#pragma unroll
    for (int mt = 0; mt < 2; ++mt) {
        float g[16];
#pragma unroll
        for (int r = 0; r < 16; ++r) g[r] = gelu_tanh(hT[mt][r] + bias1[crow(r, hi)]);
#pragma unroll
        for (int s = 0; s < 2; ++s) { u32x4_t w; w.x = cvtpk_s(g[8 * s], g[8 * s + 1]); w.y = cvtpk_s(g[8 * s + 2], g[8 * s + 3]); w.z = cvtpk_s(g[8 * s + 4], g[8 * s + 5]); w.w = cvtpk_s(g[8 * s + 6], g[8 * s + 7]);
            hb[mt][s] = __builtin_bit_cast(bf16x8, w); }
    }
    const bf16_t* w2t = (const bf16_t*)(ws + WS_SMALL + SM_W2T) + (size_t)kv * 64 * 256;
    f32x16 oT[2][2];
#pragma unroll
    for (int dt = 0; dt < 2; ++dt)
#pragma unroll
        for (int mt = 0; mt < 2; ++mt) oT[dt][mt] = f32x16{};
#pragma unroll
    for (int dt = 0; dt < 2; ++dt)
#pragma unroll
        for (int s = 0; s < 2; ++s) {
            const bf16_t* wp = w2t + (size_t)(32 * dt + r32) * 256 + ncol0 + 16 * s + 4 * hi;
            const u32x2_t lo = *(const u32x2_t*)wp, hi2 = *(const u32x2_t*)(wp + 8);
            const u32x4_t wv = {lo.x, lo.y, hi2.x, hi2.y}; const bf16x8 wf = __builtin_bit_cast(bf16x8, wv);
#pragma unroll
            for (int mt = 0; mt < 2; ++mt) oT[dt][mt] = __builtin_amdgcn_mfma_f32_32x32x16_bf16(wf, hb[mt][s], oT[dt][mt], 0, 0, 0);
        }
    LAS float* part = (LAS float*)lds + wid * 64 * CP_STRIDE;
#pragma unroll
    for (int dt = 0; dt < 2; ++dt)
#pragma unroll
        for (int mt = 0; mt < 2; ++mt)
#pragma unroll
            for (int r = 0; r < 16; ++r) part[(32 * mt + r32) * CP_STRIDE + 32 * dt + crow(r, hi)] = oT[dt][mt][r];
    P2_WAIT_BAR();
    {
        const int tid = wid * 64 + lane, m = tid >> 3, dg = tid & 7;
        float o[8];
#pragma unroll
        for (int e = 0; e < 8; ++e) { float s = 0.f;
#pragma unroll
            for (int w = 0; w < 8; ++w) s += ((LAS const float*)lds)[(w * 64 + m) * CP_STRIDE + 8 * dg + e];
            o[e] = s; }
        if (kv == 0) {
            float ss = 0.f;
#pragma unroll
            for (int e = 0; e < 8; ++e) ss += o[e] * o[e];
            ss += __shfl_xor(ss, 1); ss += __shfl_xor(ss, 2); ss += __shfl_xor(ss, 4);
            const float rr = __builtin_amdgcn_rsqf(ss * (1.0f / 64.0f) + 1e-6f);
#pragma unroll
            for (int e = 0; e < 8; ++e) o[e] *= rr * P.in[4][8 * dg + e];
        }
        const int n = n0 + m;
        u32x4_t v = {0u, 0u, 0u, 0u};
        if (n < 255) { v.x = cvtpk_s(o[0], o[1]); v.y = cvtpk_s(o[2], o[3]); v.z = cvtpk_s(o[4], o[5]); v.w = cvtpk_s(o[6], o[7]); }
        *(u32x4_t*)((bf16_t*)(ws + (kv ? WS_VC : WS_KC)) + ((size_t)bg * 256 + n) * 64 + 8 * dg) = v;
    }
    P2_WAIT_BAR();
#undef P2_DMA_TILE
}

constexpr int G_V = 0, G_ST = 32768, G_OST = 33792, G_END = 33792 + 65536;
__device__ __forceinline__ void gmlp_unit(const Ptrs& P, LAS unsigned char* lds, int unit, const int wave_s) {
    unsigned char* ws = P.ws;
    const int lane = fresh_lane(), r32 = lane & 31, hi = lane >> 5, wid = wave_s, tid = wid * 64 + lane;
    const int g = unit & 7, chunk = (unit >> 3) & 31, b = unit >> 8; const int m0 = b * SEQ + chunk * 128;
    const bf16_t* GV = (const bf16_t*)(ws + WS_GV); const bf16_t* U = (const bf16_t*)(ws + WS_U); const float* VSTAT = (const float*)(ws + WS_VSTAT);
    const bf16_t* SWB = (const bf16_t*)(ws + WS_SMALL + SM_SWB) + (size_t)g * 16384;
    bf16_t* AB = (bf16_t*)(ws + WS_AB);
    const float* ln_w = P.in[8]; const float* ln_b = P.in[9]; const float* sbp = P.in[11];
    LAS float* st = (LAS float*)(lds + G_ST);
    if (tid < 128) { const float* p = VSTAT + (size_t)(m0 + tid) * 32; float s1 = 0.f, s2 = 0.f;
#pragma unroll
        for (int i = 0; i < 16; ++i) { s1 += p[2 * i]; s2 += p[2 * i + 1]; }
        const float mean = s1 * (1.0f / 1024.0f); float var = s2 * (1.0f / 1024.0f) - mean * mean; var = var < 0.f ? 0.f : var;
        st[2 * tid] = mean; st[2 * tid + 1] = __builtin_amdgcn_rsqf(var + 1e-5f); }
    P2_WAIT_BAR();
#pragma unroll
    for (int i = 0; i < 4; ++i) { const int idx = tid + 512 * i, s = idx >> 4, c8 = idx & 15;
        const u32x4_t raw = *(const u32x4_t*)(GV + (size_t)(m0 + s) * 1024 + g * 128 + 8 * c8); float f[8]; unpack8(raw, f);
        const float mean = st[2 * s], rstd = st[2 * s + 1];
        const f32x4_t w0 = *(const f32x4_t*)(ln_w + g * 128 + 8 * c8), w1 = *(const f32x4_t*)(ln_w + g * 128 + 8 * c8 + 4), b0 = *(const f32x4_t*)(ln_b + g * 128 + 8 * c8), b1 = *(const f32x4_t*)(ln_b + g * 128 + 8 * c8 + 4);
        float y[8];
#pragma unroll
        for (int e = 0; e < 4; ++e) { y[e] = (f[e] - mean) * rstd * w0[e] + b0[e]; y[4 + e] = (f[4 + e] - mean) * rstd * w1[e] + b1[e]; }
        u32x4_t o; o.x = cvtpk_s(y[0], y[1]); o.y = cvtpk_s(y[2], y[3]); o.z = cvtpk_s(y[4], y[5]); o.w = cvtpk_s(y[6], y[7]);
        const int st_ = s >> 6, sk = s & 63, ch = c8 >> 3, x = c8 & 7;
        *(LAS u32x4_t*)(lds + G_V + (st_ * 2 + ch) * 8192 + (x >> 2) * 4096 + (sk >> 4) * 1024 + (sk & 15) * 64 + (x & 3) * 16) = o; }
    P2_WAIT_BAR();
    const int tb = wid >> 1, ch = wid & 1;
    f32x16 o[2]; o[0] = f32x16{}; o[1] = f32x16{};
    const int vb0 = (int)((unsigned)(uintptr_t)lds + G_V) + ((lane >> 4) & 1) * 32 + (lane & 3) * 8 + (4 * hi + ((lane & 15) >> 2)) * 64;
    const int nst = tb >= 2 ? 2 : 1;
    for (int st_ = 0; st_ < nst; ++st_) {
        bf16x8 pa[4];
#pragma unroll
        for (int ks = 0; ks < 4; ++ks) {
            const bf16_t* wp = SWB + (size_t)(32 * tb + r32) * 128 + 64 * st_ + 16 * ks + 4 * hi;
            const u32x2_t lo = *(const u32x2_t*)wp, hi2 = *(const u32x2_t*)(wp + 8);
            const u32x4_t wv = {lo.x, lo.y, hi2.x, hi2.y}; pa[ks] = __builtin_bit_cast(bf16x8, wv); }
        nsa::pv(o, vb0 + (st_ * 2 + ch) * 8192, pa[0], pa[1], pa[2], pa[3]);
    }
    LAS float* ostg = (LAS float*)(lds + G_OST) + wid * 2048;
#pragma unroll
    for (int r = 0; r < 16; ++r) { const int orow = crow(r, hi);
#pragma unroll
        for (int d0 = 0; d0 < 2; ++d0) ostg[orow * 64 + d0 * 32 + r32] = o[d0][r]; }
    asm volatile("s_waitcnt lgkmcnt(0)" ::: "memory");
#pragma unroll
    for (int i = 0; i < 4; ++i) { const int row = i * 8 + (lane >> 3), c8 = lane & 7, t = 32 * tb + row;
        const f32x4_t v0 = *(LAS const f32x4_t*)(ostg + row * 64 + c8 * 8), v1 = *(LAS const f32x4_t*)(ostg + row * 64 + c8 * 8 + 4);
        const size_t grow = (size_t)(m0 + t); const int col = g * 128 + 64 * ch + 8 * c8;
        float uf[8]; unpack8(*(const u32x4_t*)(U + grow * 1024 + col), uf);
        const float sbv = sbp[g * 128 + t];
        u32x4_t w; w.x = cvtpk_s(uf[0] * (v0[0] + sbv), uf[1] * (v0[1] + sbv)); w.y = cvtpk_s(uf[2] * (v0[2] + sbv), uf[3] * (v0[3] + sbv));
        w.z = cvtpk_s(uf[4] * (v1[0] + sbv), uf[5] * (v1[1] + sbv)); w.w = cvtpk_s(uf[6] * (v1[2] + sbv), uf[7] * (v1[3] + sbv));
        *(u32x4_t*)(AB + grow * 2048 + 1024 + col) = w; }
    P2_WAIT_BAR();
}
#undef P2_WAIT_BAR
}

#define XB_TMO      128
#define XB_XCNT(j)  (256  + 64 * (j))
#define XB_XSUB(j)  (1280 + 64 * (j))
#define XB_XGEN(j)  (2304 + 64 * (j))
#define XB_TOP      3328
#define XB_TOPGEN   3392
#define XCD_BAR_WORDS 3456
#define XB_SPIN_CAP (1u << 18)

__device__ __forceinline__ unsigned xb_ld(unsigned* p)              { return __hip_atomic_load(p, __ATOMIC_RELAXED, __HIP_MEMORY_SCOPE_AGENT); }
__device__ __forceinline__ unsigned xb_add(unsigned* p, unsigned v) { return __hip_atomic_fetch_add(p, v, __ATOMIC_RELAXED, __HIP_MEMORY_SCOPE_AGENT); }
__device__ __forceinline__ unsigned xb_xcc_id() { return (unsigned)__builtin_amdgcn_s_getreg((3 << 11) | 20) & 0xFu; }
#define XB_SPIN(cond, bar) do { unsigned _sp = 0; while (cond) { __builtin_amdgcn_s_sleep(1); \
    if ((++_sp & 255u) == 0u) { if (xb_ld(&(bar)[XB_TMO])) break; if (_sp > XB_SPIN_CAP) { atomicAdd(&(bar)[XB_TMO], 1u); break; } } } } while (0)

struct XcdBarrier {
    unsigned* bar; unsigned x; unsigned w0;
    volatile LAS unsigned* st;
};

__device__ __forceinline__ XcdBarrier xcd_barrier_post(unsigned* bar, volatile LAS unsigned* st, int wave_s) {
    XcdBarrier b; b.bar = bar; b.x = xb_xcc_id(); b.st = st; b.w0 = wave_s == 0 ? 1u : 0u;
    if (b.w0 && fresh_lane() == 0) (void)xb_add(&bar[XB_XCNT(b.x)], 1u);
    return b;
}
__device__ __forceinline__ void xcd_barrier_complete(unsigned* bar, unsigned x, unsigned& nloc, unsigned& nx) {
    const unsigned G = gridDim.x * gridDim.y * gridDim.z;
    unsigned sum, cnt, mine, sp = 0u;
    for (;;) {
        sum = 0u; cnt = 0u; mine = 0u;
#pragma unroll
        for (unsigned j = 0; j < 16; ++j) { const unsigned c = xb_ld(&bar[XB_XCNT(j)]); sum += c; cnt += (c > 0u) ? 1u : 0u; mine = (j == x) ? c : mine; }
        if (sum == G) break;
        __builtin_amdgcn_s_sleep(1);
        if ((++sp & 255u) == 0u) { if (xb_ld(&bar[XB_TMO])) break; if (sp > XB_SPIN_CAP) { atomicAdd(&bar[XB_TMO], 1u); break; } }
    }
    nloc = mine > 0u ? mine : 1u; nx = cnt > 0u ? cnt : 1u;
}

__device__ __forceinline__ void xcd_barrier(const XcdBarrier& b) {
    asm volatile("s_waitcnt vmcnt(0)" ::: "memory");
    __syncthreads();
    if (b.w0 && fresh_lane() == 0) {
        unsigned* bar = b.bar;
        __builtin_amdgcn_s_waitcnt(0);
        unsigned nloc = b.st[0], nx = b.st[1];
        if (nloc == 0u) { xcd_barrier_complete(bar, b.x, nloc, nx); b.st[0] = nloc; b.st[1] = nx; }
        const unsigned old = xb_add(&bar[XB_XSUB(b.x)], 1u);
        const unsigned gen = old / nloc;
        if (old + 1u == (gen + 1u) * nloc) {
            __builtin_amdgcn_fence(__ATOMIC_RELEASE, "agent");
            asm volatile("s_waitcnt vmcnt(0)" ::: "memory");
            const unsigned og = xb_add(&bar[XB_TOP], 1u);
            const unsigned tg = og / nx;
            if (og + 1u == (tg + 1u) * nx) xb_add(&bar[XB_TOPGEN], 1u);
            else XB_SPIN(xb_ld(&bar[XB_TOPGEN]) == tg, bar);
            __builtin_amdgcn_fence(__ATOMIC_ACQUIRE, "agent");
            xb_add(&bar[XB_XGEN(b.x)], 1u);
            asm volatile("s_waitcnt vmcnt(0)" ::: "memory");
        } else {
            XB_SPIN(xb_ld(&bar[XB_XGEN(b.x)]) == gen, bar);
            __builtin_amdgcn_fence(__ATOMIC_ACQUIRE, "agent");
            asm volatile("s_waitcnt vmcnt(0)" ::: "memory");
        }
    }
    __syncthreads();
}

constexpr int LDS_BYTES = 147456;
constexpr int LDS_XCH = 132096;
constexpr int LDS_MISC = 145408;
__global__ void __launch_bounds__(512, 2) mega_fwd(Ptrs P) {
    extern __shared__ __attribute__((aligned(16))) unsigned char lds_raw[];
    LAS unsigned char* lds = (LAS unsigned char*)lds_raw;
    unsigned char* ws = P.ws;
    const int wave = __builtin_amdgcn_readfirstlane(threadIdx.x >> 6);
    const int G = gridDim.x, bid = blockIdx.x;
    if (wave == 0) { const int l_ = fresh_lane(); if (l_ < 2) ((LAS unsigned*)(lds + LDS_MISC))[l_] = 0u; }
    __syncthreads();
    const XcdBarrier bar = xcd_barrier_post((unsigned*)(ws + WS_CTL), (volatile LAS unsigned*)(lds + LDS_MISC), wave);
    p0_prologue(P, lds, bid, G, wave);
    xcd_barrier(bar);
    if (bid == 0) bias1_stage(ws, fresh_tid(wave));
    {
        pg8::Gemm g{(const bf16_t*)(ws + WS_XN), (const bf16_t*)(ws + WS_WIN), MTOK, NPROJ, 2048, 2048};
        pg8::StaticOrder S; S.init(MTOK, NPROJ, G, bid);
        pg8::EpiProj E{(bf16_t*)(ws + WS_Q), (bf16_t*)(ws + WS_KV6), (bf16_t*)(ws + WS_U), (bf16_t*)(ws + WS_GV), (float*)(ws + WS_GATES), (float*)(ws + WS_VSTAT), P.in[3], P.in[4]};
        pg8::gemm_phase<pg8::EpiProj, pg8::StaticOrder, true, true>(lds, g, S, E, wave);
    }
    xcd_barrier(bar);
    if (bid < 128 && G >= 256) p2::compress_unit(P, lds, bid, wave);
    else if (G >= 256) { for (int u = bid - 128; u < 1024; u += G - 128) p2::gmlp_unit(P, lds, u, wave); }
    xcd_barrier(bar);
    nsa::nsa_phase(P, lds, bid, G, wave);
    xcd_barrier(bar);
    {
        pg8::Gemm g{(const bf16_t*)(ws + WS_AB), (const bf16_t*)(ws + WS_WOUT), MTOK, 2048, 2048, 2048};
        pg8::StaticOrder S; S.init(MTOK, 2048, G, bid);
        pg8::EpiRes1 E{P.in[0], P.out, (bf16_t*)(ws + WS_XN), (float*)(ws + WS_SSQ)};
        pg8::gemm_phase<pg8::EpiRes1, pg8::StaticOrder, true, true>(lds, g, S, E, wave);
    }
    xcd_barrier(bar);
    for (int m = bid * 512 + fresh_tid(wave); m < MTOK; m += G * 512) {
        const float* p = (const float*)(ws + WS_SSQ) + (size_t)m * 32; float s = 0.f;
#pragma unroll
        for (int i = 0; i < 32; ++i) s += p[i];
        ((float*)(ws + WS_SMALL + SM_R2))[m] = __builtin_amdgcn_rsqf(s * (1.0f / D_MODEL) + 1e-6f);
    }
    xcd_barrier(bar);
    {
        pg8::Gemm g{(const bf16_t*)(ws + WS_XN), (const bf16_t*)(ws + WS_WUP), MTOK, N_UP, 2048, 2048};
        pg8::StaticOrder S; S.init(MTOK, N_UP, G, bid);
        pg8::EpiUpConv E{(bf16_t*)(ws + WS_G), (const float*)(ws + WS_SMALL + SM_R2), P.in[15], P.in[16], (float*)(ws + WS_HLAST), (float*)(ws + WS_FIRST), lds + LDS_XCH};
        pg8::gemm_phase<pg8::EpiUpConv, pg8::StaticOrder, true, true>(lds, g, S, E, wave);
    }
    xcd_barrier(bar);
    for (int it = bid * 512 + fresh_tid(wave); it < 60 * 44 * 2 * 16; it += G * 512) {
        const int c8 = it & 15, row = (it >> 4) & 1, tl_ = it >> 5, pn = tl_ % 44, pmi = tl_ / 44, pm = pmi + pmi / 15 + 1;
        const float* cw = P.in[15]; const float* cb = P.in[16]; (void)cb;
        const float* fp = (const float*)(ws + WS_FIRST) + ((size_t)(pm * 44 + pn) * 2 + row) * 256 + 8 * c8;
        const float* lp = (const float*)(ws + WS_HLAST) + ((size_t)((pm - 1) * 44 + pn) * 2) * 256 + 8 * c8;
        const int ch = pn * 128 + 8 * c8;
        float r[8];
#pragma unroll
        for (int e = 0; e < 8; ++e) {
            const float l0g = lp[e], l1g = lp[256 + e], l0u = lp[128 + e], l1u = lp[256 + 128 + e];
            const float w0g = cw[ch + e], w1g = cw[N_UP + ch + e], w0u = cw[D_FF + ch + e], w1u = cw[N_UP + D_FF + ch + e];
            const float cg = fp[e] + (row == 0 ? w1g * l1g + w0g * l0g : w0g * l1g), cu = fp[128 + e] + (row == 0 ? w1u * l1u + w0u * l0u : w0u * l1u);
            r[e] = cg * sigmoidf_(cg) * cu;
        }
        u32x4_t o; o.x = pk2(r[0], r[1]); o.y = pk2(r[2], r[3]); o.z = pk2(r[4], r[5]); o.w = pk2(r[6], r[7]);
        *(u32x4_t*)((bf16_t*)(ws + WS_G) + (size_t)(pm * 256 + row) * D_FF + ch) = o;
    }
    xcd_barrier(bar);
    {
        pg8::Gemm g{(const bf16_t*)(ws + WS_G), (const bf16_t*)(ws + WS_WDOWN), MTOK, 2048, D_FF, D_FF};
        pg8::StaticOrder S; S.init(MTOK, 2048, G, bid);
        pg8::EpiDown E{P.out, (const bf16_t*)(ws + WS_XN)};
        pg8::gemm_phase<pg8::EpiDown, pg8::StaticOrder, true, true>(lds, g, S, E, wave);
    }
}

extern "C" void kernel_launch(void* const* d_in, const int* in_sizes, int n_in, void* d_out, int out_size, void* d_ws, size_t ws_size, hipStream_t stream) {
    static int grid_blocks = 0;
    if (!grid_blocks) {
        int dev = 0, cus = 0, per_cu = 0;
        (void)hipGetDevice(&dev);
        (void)hipDeviceGetAttribute(&cus, hipDeviceAttributeMultiprocessorCount, dev);
        (void)hipFuncSetAttribute((const void*)mega_fwd, hipFuncAttributeMaxDynamicSharedMemorySize, LDS_BYTES);
        (void)hipOccupancyMaxActiveBlocksPerMultiprocessor(&per_cu, (const void*)mega_fwd, 512, LDS_BYTES);
        if (per_cu < 1) { fprintf(stderr, "kernel_launch: occupancy query says %d blocks/CU\n", per_cu); per_cu = 1; }
        grid_blocks = cus * 1;
        (void)hipGetLastError();
    }
    if (n_in != 18 || ws_size < WS_END) { fprintf(stderr, "kernel_launch: unexpected n_in %d / ws %zu\n", n_in, ws_size); return; }
    Ptrs P{};
    for (int i = 0; i < 18; ++i) P.in[i] = (const float*)d_in[i];
    P.out = (float*)d_out; P.ws = (unsigned char*)d_ws;
    (void)hipMemsetAsync((char*)d_ws + WS_CTL, 0, 16384, stream);
    mega_fwd<<<dim3(grid_blocks), dim3(512), LDS_BYTES, stream>>>(P);
}
```

```cpp
#include <hip/hip_runtime.h>
#include <cstdio>
#include <cstdint>

constexpr int D_MODEL = 2048, BATCH = 4, SEQ = 4096, MTOK = BATCH * SEQ;
constexpr int IN_COLS = 4656, NPROJ = 4864;
constexpr int D_FF = 5632, N_UP = 2 * D_FF;
constexpr int NBG = 16;
constexpr size_t KVSZ = (size_t)NBG * SEQ * 64;
constexpr float LOG2E = 1.4426950408889634f;

constexpr size_t MiB = 1u << 20;
constexpr size_t WS_CTL = 0;
constexpr size_t WS_WIN = 1 * MiB, WS_WOUT = 20 * MiB, WS_WUP = 28 * MiB, WS_WDOWN = 72 * MiB, WS_W1C = 94 * MiB;
constexpr size_t WS_SMALL = 96 * MiB;
constexpr size_t SM_BIASP = 0, SM_BIAS1 = 65536, SM_R2 = 131072, SM_W2T = 196608  , SM_SWB = 262144  ;
constexpr size_t WS_XN = 97 * MiB;
constexpr size_t WS_Q = 161 * MiB;
constexpr size_t WS_KV6 = 193 * MiB;
constexpr size_t WS_U = 241 * MiB, WS_GV = 273 * MiB;
constexpr size_t WS_GATES = 305 * MiB;
constexpr size_t WS_VSTAT = 308 * MiB;
constexpr size_t WS_KC = 310 * MiB, WS_VC = 310 * MiB + 524288;
constexpr size_t WS_HC = 311 * MiB;
constexpr size_t WS_AB = 315 * MiB;
constexpr size_t WS_SSQ = 379 * MiB;
constexpr size_t WS_G = 161 * MiB;
constexpr size_t WS_HID = 381 * MiB;
constexpr size_t WS_HLAST = 381 * MiB, WS_FIRST = 388 * MiB;
constexpr size_t WS_END = 469 * MiB;

#define LAS __attribute__((address_space(3)))
typedef unsigned short bf16_t;
typedef unsigned u32x4_t __attribute__((ext_vector_type(4)));
typedef unsigned u32x2_t __attribute__((ext_vector_type(2)));
typedef float f32x4_t __attribute__((ext_vector_type(4)));

__device__ __forceinline__ float bf2f(unsigned short h) { return __uint_as_float(((unsigned)h) << 16); }
__device__ __forceinline__ unsigned f2bf(float f) { unsigned u = __float_as_uint(f); return (u + 0x7fffu + ((u >> 16) & 1u)) >> 16; }
__device__ __forceinline__ unsigned pk2(float lo, float hi) { return f2bf(lo) | (f2bf(hi) << 16); }
__device__ __forceinline__ float gelu_tanh(float x) {
    const float u = 0.7978845608028654f * (x + 0.044715f * x * x * x);
    const float e = __builtin_amdgcn_exp2f(-2.8853900817779268f * u);
    return x * __builtin_amdgcn_rcpf(1.0f + e);
}
__device__ __forceinline__ float sigmoidf_(float x) { return __builtin_amdgcn_rcpf(1.0f + __builtin_amdgcn_exp2f(-LOG2E * x)); }
__device__ __forceinline__ float wave_sum(float v) {
#pragma unroll
    for (int o = 1; o < 64; o <<= 1) v += __shfl_xor(v, o);
    return v;
}
__device__ __forceinline__ void unpack8(u32x4_t r, float (&f)[8]) {
    f[0] = __uint_as_float(r.x << 16); f[1] = __uint_as_float(r.x & 0xffff0000u);
    f[2] = __uint_as_float(r.y << 16); f[3] = __uint_as_float(r.y & 0xffff0000u);
    f[4] = __uint_as_float(r.z << 16); f[5] = __uint_as_float(r.z & 0xffff0000u);
    f[6] = __uint_as_float(r.w << 16); f[7] = __uint_as_float(r.w & 0xffff0000u);
}

__device__ __forceinline__ int fresh_lane() { unsigned z_ = 0u; asm volatile("" : "+v"(z_)); return (int)__builtin_amdgcn_mbcnt_hi(~0u, __builtin_amdgcn_mbcnt_lo(~0u, z_)); }
__device__ __forceinline__ int fresh_tid(int wave_s) { return wave_s * 64 + fresh_lane(); }
namespace pg8 {
#define PG8_LAS __attribute__((address_space(3)))
typedef unsigned short bf16_t;
typedef short bf16x8 __attribute__((ext_vector_type(8)));
typedef float f32x4 __attribute__((ext_vector_type(4)));
typedef unsigned u32x4 __attribute__((ext_vector_type(4)));
constexpr int BM = 256, BK = 64, HALF = 128, HTB = HALF * BK * 2  , STAGE_BYTES = 8 * HTB, NXCD = 8, WGM = 8;

__host__ __device__ __forceinline__ int lds_byte(int r, int c) { const int st = (r >> 4) * 2 + (c >> 5), rr = r & 15, cc = c & 31, ob = rr * 64 + cc * 2; return st * 1024 + (ob ^ (((ob >> 9) & 1) << 5)); }
__host__ __device__ __forceinline__ void stage_rc(int b, int& R, int& C) { const int st = b / 1024, sb = b % 1024, swz = sb ^ (((sb >> 9) & 1) << 5); R = (st >> 1) * 16 + swz / 64; C = (st & 1) * 32 + (swz % 64) / 2; }
__host__ __device__ __forceinline__ int perm32(int rho) { const int n = rho >> 4, i = rho & 15; return 8 * (i >> 2) + 4 * n + (i & 3); }

struct Unit { int pm, pn; };
struct Gemm { const bf16_t* A; const bf16_t* Bt; int M, N, K, lda; };

struct StaticOrder {
    int nM, nN, nwg, G, c;
    __host__ __device__ void init(int M, int N, int G_, int c_) { nM = M / BM; nN = N / BM; nwg = nM * nN; G = G_; c = c_; }
    __host__ __device__ bool next(int i, Unit& u) const {
        const long L = (long)i * G + c; if (L >= nwg) return false;
        int wgid = (int)L; { const int q = nwg / NXCD, r = nwg % NXCD, xcd = wgid % NXCD, off = wgid / NXCD; wgid = (xcd < r ? xcd * (q + 1) : r * (q + 1) + (xcd - r) * q) + off; }
        const int nig = WGM * nN, gid = wgid / nig, fm = gid * WGM, gsz = (nM - fm) < WGM ? (nM - fm) : WGM;
        u.pm = fm + ((wgid % nig) % gsz); u.pn = (wgid % nig) / gsz; return true;
    }
    __device__ __forceinline__ void a_ready(const Unit&) const {}
    __device__ __forceinline__ void done(const Unit&) const {}
};

__device__ __forceinline__ unsigned cvt_pk_bf16(float lo, float hi) { unsigned r; asm volatile("v_cvt_pk_bf16_f32 %0, %1, %2" : "=v"(r) : "v"(lo), "v"(hi)); return r; }

struct EpiProj {
    static constexpr bool PERM = true, AFTER_DRAIN = false;
    bf16_t* Q; bf16_t* KV6; bf16_t* U; bf16_t* GV; float* GATES; float* VSTAT; const float* q_norm_w; const float* k_norm_w;
    __device__ __forceinline__ void operator()(const f32x4 (&acc)[2][2][4][2], const Unit& u, int wr, int wc, int fr, int fq) const {
        const int pn = u.pn, row0 = u.pm * BM + wr * 64 + fr;
        if (pn < 10) {
            const bool normed = (pn < 4) || pn == 6 || pn == 8;
            const float* w = pn < 4 ? q_norm_w : (k_norm_w + (pn == 6 ? 64 : 128));
            const float sc = pn < 4 ? 0.125f * LOG2E : 1.0f;
            f32x4 wv[2][2];
#pragma unroll
            for (int bj = 0; bj < 2; ++bj)
#pragma unroll
                for (int n = 0; n < 2; ++n) wv[bj][n] = normed ? (*(const f32x4*)(w + 32 * bj + 8 * fq + 4 * n)) * sc : (f32x4){1.f, 1.f, 1.f, 1.f};
#pragma unroll
            for (int ai = 0; ai < 2; ++ai)
#pragma unroll
                for (int m = 0; m < 4; ++m) {
                    const int row = row0 + ai * HALF + m * 16;
                    float r = 1.f;
                    if (normed) {
                        float ss = 0.f;
#pragma unroll
                        for (int bj = 0; bj < 2; ++bj)
#pragma unroll
                            for (int n = 0; n < 2; ++n) { const f32x4 x = acc[ai][bj][m][n]; ss += (x[0] * x[0] + x[1] * x[1]) + (x[2] * x[2] + x[3] * x[3]); }
                        ss += __shfl_xor(ss, 16); ss += __shfl_xor(ss, 32);
                        r = __builtin_amdgcn_rsqf(ss * (1.0f / 64.0f) + 1e-6f);
                    }
                    bf16_t* dst;
                    if (pn < 4) dst = Q + (size_t)row * 1024 + pn * 256 + wc * 64 + 8 * fq;
                    else { const int b = row >> 12, t = row & 4095; dst = KV6 + (size_t)(pn - 4) * KVSZ + ((size_t)((b * 4 + wc) * 4096 + t)) * 64 + 8 * fq; }
#pragma unroll
                    for (int bj = 0; bj < 2; ++bj) {
                        const f32x4 v0 = acc[ai][bj][m][0] * r * wv[bj][0], v1 = acc[ai][bj][m][1] * r * wv[bj][1];
                        u32x4 o; o.x = cvt_pk_bf16(v0[0], v0[1]); o.y = cvt_pk_bf16(v0[2], v0[3]); o.z = cvt_pk_bf16(v1[0], v1[1]); o.w = cvt_pk_bf16(v1[2], v1[3]);
                        *(u32x4*)(dst + 32 * bj) = o;
                    }
                }
        } else if (pn < 18) {
            const bool isv = pn >= 14; const int ct = isv ? pn - 14 : pn - 10;
            bf16_t* base = (isv ? GV : U) + ct * 256 + wc * 64 + 8 * fq;
#pragma unroll
            for (int ai = 0; ai < 2; ++ai)
#pragma unroll
                for (int m = 0; m < 4; ++m) {
                    const int row = row0 + ai * HALF + m * 16; float s1 = 0.f, s2 = 0.f;
#pragma unroll
                    for (int bj = 0; bj < 2; ++bj) {
                        f32x4 v0 = acc[ai][bj][m][0], v1 = acc[ai][bj][m][1];
#pragma unroll
                        for (int e = 0; e < 4; ++e) { v0[e] = gelu_tanh(v0[e]); v1[e] = gelu_tanh(v1[e]); s1 += v0[e] + v1[e]; s2 += v0[e] * v0[e] + v1[e] * v1[e]; }
                        u32x4 o; o.x = cvt_pk_bf16(v0[0], v0[1]); o.y = cvt_pk_bf16(v0[2], v0[3]); o.z = cvt_pk_bf16(v1[0], v1[1]); o.w = cvt_pk_bf16(v1[2], v1[3]);
                        *(u32x4*)(base + (size_t)row * 1024 + 32 * bj) = o;
                    }
                    if (isv) {
                        s1 += __shfl_xor(s1, 16); s1 += __shfl_xor(s1, 32); s2 += __shfl_xor(s2, 16); s2 += __shfl_xor(s2, 32);
                        if (fq == 0) { float* p = VSTAT + ((size_t)row * 16 + ct * 4 + wc) * 2; p[0] = s1; p[1] = s2; }
                    }
                }
        } else {
            if (wc == 0) {
#pragma unroll
                for (int ai = 0; ai < 2; ++ai)
#pragma unroll
                    for (int m = 0; m < 4; ++m) {
                        const int row = row0 + ai * HALF + m * 16;
#pragma unroll
                        for (int bj = 0; bj < 2; ++bj)
#pragma unroll
                            for (int n = 0; n < 2; ++n) {
                                const int L = 32 * bj + 8 * fq + 4 * n;
                                if (L < 48) { f32x4 v = acc[ai][bj][m][n]; f32x4 o; o[0] = sigmoidf_(v[0]); o[1] = sigmoidf_(v[1]); o[2] = sigmoidf_(v[2]); o[3] = sigmoidf_(v[3]); *(f32x4*)(GATES + (size_t)row * 48 + L) = o; }
                            }
                    }
            }
        }
    }
};
struct EpiCmp {
    static constexpr bool PERM = true, AFTER_DRAIN = false;
    bf16_t* HC; const float* bias1;
    __device__ __forceinline__ void operator()(const f32x4 (&acc)[2][2][4][2], const Unit& u, int wr, int wc, int fr, int fq) const {
        const int row0 = u.pm * BM + wr * 64 + fr, col0 = wc * 32 + 8 * fq;
        f32x4 bv[2][2];
#pragma unroll
        for (int bj = 0; bj < 2; ++bj)
#pragma unroll
            for (int n = 0; n < 2; ++n) bv[bj][n] = *(const f32x4*)(bias1 + u.pn * 256 + col0 + bj * HALF + 4 * n);
#pragma unroll
        for (int ai = 0; ai < 2; ++ai)
#pragma unroll
            for (int m = 0; m < 4; ++m) { bf16_t* rowp = HC + (size_t)(row0 + ai * HALF + m * 16) * 256 + col0;
#pragma unroll
                for (int bj = 0; bj < 2; ++bj) { f32x4 v0 = acc[ai][bj][m][0] + bv[bj][0], v1 = acc[ai][bj][m][1] + bv[bj][1];
#pragma unroll
                    for (int e = 0; e < 4; ++e) { v0[e] = gelu_tanh(v0[e]); v1[e] = gelu_tanh(v1[e]); }
                    u32x4 o; o.x = cvt_pk_bf16(v0[0], v0[1]); o.y = cvt_pk_bf16(v0[2], v0[3]); o.z = cvt_pk_bf16(v1[0], v1[1]); o.w = cvt_pk_bf16(v1[2], v1[3]);
                    *(u32x4*)(rowp + bj * HALF) = o; } }
    }
};
struct CmpOrder {
    int c, G;
    __device__ bool next(int i, Unit& u) const { const int L = i * G + c; if (L >= 32) return false; u.pm = L; u.pn = L >> 4; return true; }
    __device__ __forceinline__ void a_ready(const Unit&) const {}
    __device__ __forceinline__ void done(const Unit&) const {}
};
struct EpiRes1 {
    static constexpr bool PERM = false, AFTER_DRAIN = false;
    const float* x; float* out; bf16_t* X1b; float* SSQ;
    __device__ __forceinline__ void operator()(const f32x4 (&acc)[2][2][4][2], const Unit& u, int wr, int wc, int fr, int fq) const {
        const int row0 = u.pm * BM + wr * 64 + fr, col0 = u.pn * BM + wc * 32 + 4 * fq;
#pragma unroll
        for (int ai = 0; ai < 2; ++ai)
#pragma unroll
            for (int m = 0; m < 4; ++m) { const int row = row0 + ai * HALF + m * 16; const size_t off = (size_t)row * D_MODEL + col0; float ss = 0.f;
#pragma unroll
                for (int bj = 0; bj < 2; ++bj)
#pragma unroll
                    for (int n = 0; n < 2; ++n) { const size_t o2 = off + bj * HALF + n * 16; const f32x4 v = *(const f32x4*)(x + o2) + acc[ai][bj][m][n];
                        ss += (v[0] * v[0] + v[1] * v[1]) + (v[2] * v[2] + v[3] * v[3]);
                        u32x2_t w; w.x = cvt_pk_bf16(v[0], v[1]); w.y = cvt_pk_bf16(v[2], v[3]); *(u32x2_t*)(X1b + o2) = w; }
                ss += __shfl_xor(ss, 16); ss += __shfl_xor(ss, 32);
                if (fq == 0) SSQ[(size_t)row * 32 + u.pn * 4 + wc] = ss; }
    }
};
struct EpiUpV1 {
    static constexpr bool PERM = true, AFTER_DRAIN = false;
    bf16_t* HID; const float* R2;
    __device__ __forceinline__ void operator()(const f32x4 (&acc)[2][2][4][2], const Unit& u, int wr, int wc, int fr, int fq) const {
        const int row0 = u.pm * BM + wr * 64 + fr, col0 = u.pn * BM + wc * 32 + 8 * fq;
#pragma unroll
        for (int ai = 0; ai < 2; ++ai)
#pragma unroll
            for (int m = 0; m < 4; ++m) { const int row = row0 + ai * HALF + m * 16; const float r = R2[row]; bf16_t* rowp = HID + (size_t)row * N_UP + col0;
#pragma unroll
                for (int bj = 0; bj < 2; ++bj) { const f32x4 v0 = acc[ai][bj][m][0] * r, v1 = acc[ai][bj][m][1] * r;
                    u32x4 o; o.x = cvt_pk_bf16(v0[0], v0[1]); o.y = cvt_pk_bf16(v0[2], v0[3]); o.z = cvt_pk_bf16(v1[0], v1[1]); o.w = cvt_pk_bf16(v1[2], v1[3]);
                    *(u32x4*)(rowp + bj * HALF) = o; } }
    }
};
struct EpiDown {
    static constexpr bool PERM = false, AFTER_DRAIN = false;
    float* out; const bf16_t* X1b;
    __device__ __forceinline__ void operator()(const f32x4 (&acc)[2][2][4][2], const Unit& u, int wr, int wc, int fr, int fq) const {
        const int row0 = u.pm * BM + wr * 64 + fr, col0 = u.pn * BM + wc * 32 + 4 * fq;
#pragma unroll
        for (int ai = 0; ai < 2; ++ai)
#pragma unroll
            for (int m = 0; m < 4; ++m) { const size_t off = (size_t)(row0 + ai * HALF + m * 16) * D_MODEL + col0;
#pragma unroll
                for (int bj = 0; bj < 2; ++bj)
#pragma unroll
                    for (int n = 0; n < 2; ++n) { const u32x2_t w = *(const u32x2_t*)(X1b + off + bj * HALF + n * 16);
                        f32x4 v; v[0] = __uint_as_float(w.x << 16); v[1] = __uint_as_float(w.x & 0xffff0000u); v[2] = __uint_as_float(w.y << 16); v[3] = __uint_as_float(w.y & 0xffff0000u);
                        *(f32x4*)(out + off + bj * HALF + n * 16) = v + acc[ai][bj][m][n]; } }
    }
};
__device__ __forceinline__ unsigned f2bf_(float f) { unsigned u = __float_as_uint(f); return (u + 0x7fffu + ((u >> 16) & 1u)) >> 16; }
struct EpiUpConv {
    static constexpr bool PERM = true, AFTER_DRAIN = false;
    bf16_t* G; const float* R2; const float* cw; const float* cb; float* HLAST; float* FIRST; PG8_LAS unsigned char* xlds;
    __device__ __forceinline__ void operator()(const f32x4 (&acc)[2][2][4][2], const Unit& u, int wr, int wc, int fr_in, int fq_in) const {
        (void)fr_in; (void)fq_in;
        unsigned z_ = 0u; asm volatile("" : "+v"(z_));
        const int lane_ = (int)__builtin_amdgcn_mbcnt_hi(~0u, __builtin_amdgcn_mbcnt_lo(~0u, z_)); const int fr = lane_ & 15, fq = lane_ >> 4;
        const int row0 = u.pm * BM + wr * 64 + fr;
        PG8_LAS float* X = (PG8_LAS float*)xlds;
        const unsigned tile = (unsigned)(u.pm * (N_UP / 256) + u.pn);
        if (fr >= 14) {
#pragma unroll
            for (int ai = 0; ai < 2; ++ai) { const int sg = 2 * ai + wr; const float r3 = R2[row0 + ai * HALF + 48];
#pragma unroll
                for (int bj = 0; bj < 2; ++bj)
#pragma unroll
                    for (int n = 0; n < 2; ++n) { const f32x4 h = acc[ai][bj][3][n] * r3;
                        *(PG8_LAS f32x4*)(X + ((sg * 4 + wc) * 2 + (fr - 14)) * 64 + bj * 32 + 8 * fq + 4 * n) = h;
                        if (ai == 1 && wr == 1) *(f32x4*)(HLAST + (unsigned)((tile * 2 + (fr - 14)) * 256 + bj * HALF + wc * 32 + 8 * fq + 4 * n)) = h; } }
        }
        PG8_LAS float* R2L = X + 3072;
        PG8_LAS float* Wl = X + 2048;
        { const int t_ = (wr * 4 + wc) * 64 + fq * 16 + fr;
#pragma unroll
          for (int i2 = 0; i2 < 2; ++i2) { const int i = t_ + 512 * i2, k = i >> 8, p = i & 255, c = (p < 128 ? 0 : D_FF - 128) + u.pn * 128 + p;
              Wl[i] = k < 3 ? cw[(unsigned)(k * N_UP + c)] : cb[(unsigned)c]; }
          if (t_ < 256) R2L[t_] = R2[u.pm * BM + t_]; }
        asm volatile("s_waitcnt vmcnt(0) lgkmcnt(0)" ::: "memory"); __builtin_amdgcn_s_barrier(); asm volatile("" ::: "memory");
        const int cbase = u.pn * 128 + wc * 32 + 8 * fq;
        const bool seq_start = (u.pm & 15) == 0;
#pragma unroll
        for (int ai = 0; ai < 2; ++ai) {
            const int sg = 2 * ai + wr;
            float rs[4];
#pragma unroll
            for (int m = 0; m < 4; ++m) rs[m] = R2L[wr * 64 + fr + ai * HALF + m * 16];
            const bool defer = (ai == 0) && (wr == 0) && !seq_start && (fr < 2);
#pragma unroll
            for (int n = 0; n < 2; ++n) {
                unsigned pk[4][2];
#pragma unroll
                for (int e = 0; e < 4; ++e) {
                    asm volatile("" ::: "memory"); __builtin_amdgcn_sched_barrier(0);
                    PG8_LAS const float* wp = Wl + wc * 32 + 8 * fq + 4 * n + e;
                    const float wg0 = wp[0], wg1 = wp[256], wg2 = wp[512], bg = wp[768], wu0 = wp[128], wu1 = wp[384], wu2 = wp[640], bu = wp[896];
                    float hg1 = 0.f, hg2 = 0.f, hu1 = 0.f, hu2 = 0.f;
                    if (ai == 1 || wr == 1) { PG8_LAS const float* xp = X + (((sg - 1) * 4 + wc) * 2) * 64 + 8 * fq + 4 * n + e; hg2 = xp[0]; hg1 = xp[64]; hu2 = xp[32]; hu1 = xp[96]; }
                    float ag = hg1, bgp = fr == 0 ? hg2 : hg1, au = hu1, bup = fr == 0 ? hu2 : hu1;
#pragma unroll
                    for (int m = 0; m < 4; ++m) {
                        const float vg = acc[ai][0][m][n][e] * rs[m], vu = acc[ai][1][m][n][e] * rs[m];
                        const float rg1 = __uint_as_float(__builtin_amdgcn_update_dpp(0u, __float_as_uint(vg), 0x121, 0xf, 0xf, false)), rg2 = __uint_as_float(__builtin_amdgcn_update_dpp(0u, __float_as_uint(vg), 0x122, 0xf, 0xf, false));
                        const float ru1 = __uint_as_float(__builtin_amdgcn_update_dpp(0u, __float_as_uint(vu), 0x121, 0xf, 0xf, false)), ru2 = __uint_as_float(__builtin_amdgcn_update_dpp(0u, __float_as_uint(vu), 0x122, 0xf, 0xf, false));
                        const float pg1 = fr >= 1 ? rg1 : ag, pg2 = fr >= 2 ? rg2 : bgp, pu1 = fr >= 1 ? ru1 : au, pu2 = fr >= 2 ? ru2 : bup;
                        const float cg = bg + wg0 * pg2 + wg1 * pg1 + wg2 * vg, cu = bu + wu0 * pu2 + wu1 * pu1 + wu2 * vu;
                        if (m == 0 && defer) { float* fp = FIRST + (unsigned)((tile * 2 + fr) * 256 + wc * 32 + 8 * fq + 4 * n + e); fp[0] = cg; fp[HALF] = cu; }
                        const unsigned hb = cvt_pk_bf16(cg * sigmoidf_(cg) * cu, 0.f);
                        if ((e & 1) == 0) pk[m][e >> 1] = hb; else pk[m][e >> 1] |= hb << 16;
                        ag = rg1; bgp = rg2; au = ru1; bup = ru2;
                    }
                }
#pragma unroll
                for (int m = 0; m < 4; ++m)
                    if (!(m == 0 && defer)) { u32x2_t o; o.x = pk[m][0]; o.y = pk[m][1]; *(u32x2_t*)(G + (unsigned)((row0 + ai * HALF + m * 16) * D_FF + cbase + 4 * n)) = o; }
            }
        }
    }
};
template <class Epi, class Sched, bool ALIGN_EPI = false, bool SP2 = false>
__device__ __forceinline__ void gemm_phase(PG8_LAS unsigned char* lds, const Gemm g, const Sched& S, const Epi& E, const int wave_s) {
    const int tid = fresh_tid(wave_s), wid = wave_s, lane = tid & 63,
          wr = wid >> 2, wc = wid & 3, fr = lane & 15, fq = lane >> 4;
    const int K = g.K, nt = K / BK;
    unsigned voffA[2], voffB[2];
#pragma unroll
    for (int i = 0; i < 2; ++i) { int R, C; stage_rc(tid * 16 + i * 8192, R, C); const int Rb = Epi::PERM ? ((R & ~31) + perm32(R & 31)) : R;
        voffA[i] = (unsigned)(R * g.lda + C) * 2u; voffB[i] = (unsigned)(Rb * K + C) * 2u; }
    const size_t kstep = (size_t)(BK * 2);
    const size_t hstepA = (size_t)HALF * g.lda * 2, hstepB = (size_t)HALF * K * 2;
    const size_t tstepA = 2 * hstepA, tstepB = 2 * hstepB;
    const unsigned ldsw = (unsigned)wid * 1024u;
    const int aoff = lds_byte(wr * 64 + fr, fq * 8), boff = lds_byte(wc * 32 + fr, fq * 8);
#define PG8_SA(b, h) (((b) * 2 + (h)) * HTB)
#define PG8_SB(b, h) ((4 + (b) * 2 + (h)) * HTB)
#define PG8_STAGE(bufoff, gbase, voff) do { _Pragma("unroll") for (int _i = 0; _i < 2; ++_i) \
        __builtin_amdgcn_global_load_lds((const unsigned*)((const char*)(gbase) + (voff)[_i]), (PG8_LAS unsigned*)(lds + (bufoff) + ldsw + _i * 8192), 16, 0, 0); } while (0)
#define PG8_LDA(dst, b, h) do { _Pragma("unroll") for (int m = 0; m < 4; ++m) _Pragma("unroll") for (int k = 0; k < 2; ++k) dst[m][k] = *(const PG8_LAS bf16x8*)(lds + PG8_SA(b, h) + aoff + m * 2048 + k * 1024); } while (0)
#define PG8_LDB(dst, b, h) do { _Pragma("unroll") for (int n = 0; n < 2; ++n) _Pragma("unroll") for (int k = 0; k < 2; ++k) dst[n][k] = *(const PG8_LAS bf16x8*)(lds + PG8_SB(b, h) + boff + n * 2048 + k * 1024); } while (0)
#define PG8_MMA(ai, bj, At, Bt) do { __builtin_amdgcn_s_setprio(1); _Pragma("unroll") for (int m = 0; m < 4; ++m) _Pragma("unroll") for (int n = 0; n < 2; ++n) _Pragma("unroll") for (int k = 0; k < 2; ++k) \
        acc[ai][bj][m][n] = __builtin_amdgcn_mfma_f32_16x16x32_bf16(Bt[n][k], At[m][k], acc[ai][bj][m][n], 0, 0, 0); __builtin_amdgcn_s_setprio(0); } while (0)
#define PG8_WAIT_V(n) asm volatile("s_waitcnt vmcnt(" #n ")" ::: "memory")
#define PG8_WAIT_L(n) asm volatile("s_waitcnt lgkmcnt(" #n ")" ::: "memory")
#define PG8_BAR __builtin_amdgcn_s_barrier()
#define PG8_SCHED __builtin_amdgcn_sched_barrier(0)
    Unit cur, nxt; int ui = 0;
    if (!S.next(0, cur)) return;
    f32x4 acc[2][2][4][2];
#pragma unroll
    for (int a = 0; a < 2; ++a)
#pragma unroll
        for (int b = 0; b < 2; ++b)
#pragma unroll
            for (int m = 0; m < 4; ++m)
#pragma unroll
                for (int n = 0; n < 2; ++n) acc[a][b][m][n] = (f32x4){0.f, 0.f, 0.f, 0.f};
    bf16x8 At[4][2], B0[2][2], B1[2][2];
    const char* cA = (const char*)g.A + (size_t)cur.pm * tstepA; const char* cB = (const char*)g.Bt + (size_t)cur.pn * tstepB;
    S.a_ready(cur);
    if constexpr (SP2) {
        PG8_STAGE(PG8_SB(0, 0), cB, voffB); PG8_STAGE(PG8_SB(0, 1), cB + hstepB, voffB); PG8_STAGE(PG8_SA(0, 0), cA, voffA); PG8_STAGE(PG8_SA(0, 1), cA + hstepA, voffA);
        if (wr == 1) PG8_BAR;
        PG8_WAIT_V(2); PG8_BAR;
        PG8_STAGE(PG8_SB(1, 0), cB + kstep, voffB); PG8_STAGE(PG8_SA(1, 0), cA + kstep, voffA); PG8_STAGE(PG8_SB(1, 1), cB + hstepB + kstep, voffB);
        PG8_WAIT_V(6); PG8_BAR;
    } else {
        PG8_STAGE(PG8_SB(0, 0), cB, voffB); PG8_STAGE(PG8_SA(0, 0), cA, voffA); PG8_STAGE(PG8_SB(0, 1), cB + hstepB, voffB); PG8_STAGE(PG8_SA(0, 1), cA + hstepA, voffA);
        if (wr == 1) PG8_BAR;
        PG8_WAIT_V(4); PG8_BAR;
        PG8_STAGE(PG8_SB(1, 0), cB + kstep, voffB); PG8_STAGE(PG8_SA(1, 0), cA + kstep, voffA); PG8_STAGE(PG8_SB(1, 1), cB + hstepB + kstep, voffB);
        PG8_WAIT_V(6); PG8_BAR;
    }
    for (;;) {
        const bool has_next = S.next(ui + 1, nxt);
        const char* nA = has_next ? (const char*)g.A + (size_t)nxt.pm * tstepA : cA; const char* nB = has_next ? (const char*)g.Bt + (size_t)nxt.pn * tstepB : cB;
        for (int t = 0; t < nt; t += 2) {
            const bool last = (t == nt - 2);
            const char* a1 = cA + (size_t)(t + 1) * kstep;
            const char* a2 = last ? nA : cA + (size_t)(t + 2) * kstep; const char* b2 = last ? nB : cB + (size_t)(t + 2) * kstep;
            const char* a3 = a2 + kstep; const char* b3 = b2 + kstep;
            if (last && has_next) S.a_ready(nxt);
            if constexpr (SP2) {
            PG8_LDB(B0, 0, 0); PG8_LDB(B1, 0, 1); PG8_SCHED; PG8_LDA(At, 0, 0); PG8_STAGE(PG8_SA(1, 1), a1 + hstepA, voffA);
            PG8_WAIT_V(8); PG8_WAIT_L(0); PG8_BAR; PG8_MMA(0, 0, At, B0); PG8_MMA(0, 1, At, B1); PG8_BAR; PG8_SCHED;
            PG8_LDA(At, 0, 1); PG8_STAGE(PG8_SB(0, 0), b2, voffB); PG8_STAGE(PG8_SB(0, 1), b2 + hstepB, voffB); PG8_STAGE(PG8_SA(0, 0), a2, voffA);
            PG8_WAIT_V(8); PG8_WAIT_L(0); PG8_BAR; PG8_MMA(1, 0, At, B0); PG8_MMA(1, 1, At, B1); PG8_BAR; PG8_SCHED;
            PG8_LDB(B0, 1, 0); PG8_LDB(B1, 1, 1); PG8_SCHED; PG8_LDA(At, 1, 0); PG8_STAGE(PG8_SA(0, 1), a2 + hstepA, voffA);
            PG8_WAIT_V(8); PG8_WAIT_L(0); PG8_BAR; PG8_MMA(0, 0, At, B0); PG8_MMA(0, 1, At, B1); PG8_BAR; PG8_SCHED;
            PG8_LDA(At, 1, 1); PG8_STAGE(PG8_SB(1, 0), b3, voffB); PG8_STAGE(PG8_SB(1, 1), b3 + hstepB, voffB); PG8_STAGE(PG8_SA(1, 0), a3, voffA);
            PG8_WAIT_V(8); PG8_WAIT_L(0); PG8_BAR; PG8_MMA(1, 0, At, B0); PG8_MMA(1, 1, At, B1); PG8_BAR; PG8_SCHED;
            } else {
            PG8_LDB(B0, 0, 0); PG8_SCHED; PG8_LDA(At, 0, 0); PG8_STAGE(PG8_SA(1, 1), a1 + hstepA, voffA);
            PG8_WAIT_L(8); PG8_BAR; PG8_WAIT_L(0); PG8_MMA(0, 0, At, B0); PG8_BAR; PG8_SCHED;
            PG8_LDB(B1, 0, 1); PG8_STAGE(PG8_SB(0, 0), b2, voffB);
            PG8_BAR; PG8_WAIT_L(0); PG8_MMA(0, 1, At, B1); PG8_BAR;
            PG8_LDA(At, 0, 1); PG8_STAGE(PG8_SA(0, 0), a2, voffA);
            PG8_BAR; PG8_WAIT_L(0); PG8_MMA(1, 0, At, B0); PG8_BAR; PG8_SCHED;
            PG8_STAGE(PG8_SB(0, 1), b2 + hstepB, voffB);
            PG8_WAIT_V(6); PG8_BAR; PG8_MMA(1, 1, At, B1); PG8_BAR;
            PG8_LDB(B0, 1, 0); PG8_SCHED; PG8_LDA(At, 1, 0); PG8_STAGE(PG8_SA(0, 1), a2 + hstepA, voffA);
            PG8_WAIT_L(8); PG8_BAR; PG8_WAIT_L(0); PG8_MMA(0, 0, At, B0); PG8_BAR; PG8_SCHED;
            PG8_LDB(B1, 1, 1); PG8_STAGE(PG8_SB(1, 0), b3, voffB);
            PG8_BAR; PG8_WAIT_L(0); PG8_MMA(0, 1, At, B1); PG8_BAR;
            PG8_LDA(At, 1, 1); PG8_STAGE(PG8_SA(1, 0), a3, voffA);
            PG8_BAR; PG8_WAIT_L(0); PG8_MMA(1, 0, At, B0); PG8_BAR; PG8_SCHED;
            PG8_STAGE(PG8_SB(1, 1), b3 + hstepB, voffB);
            PG8_WAIT_V(6); PG8_BAR; PG8_MMA(1, 1, At, B1); PG8_BAR;
            }
        }
        if constexpr (ALIGN_EPI) { if (wr == 0) PG8_BAR; }
        if constexpr (!Epi::AFTER_DRAIN) { E(acc, cur, wr, wc, fr, fq); S.done(cur); }
        if (!has_next) break;
#pragma unroll
        for (int a = 0; a < 2; ++a)
#pragma unroll
            for (int b = 0; b < 2; ++b)
#pragma unroll
                for (int m = 0; m < 4; ++m)
#pragma unroll
                    for (int n = 0; n < 2; ++n) acc[a][b][m][n] = (f32x4){0.f, 0.f, 0.f, 0.f};
        cur = nxt; cA = nA; cB = nB; ++ui;
        if constexpr (ALIGN_EPI) { if (wr == 1) PG8_BAR; }
    }
    PG8_WAIT_V(0);
    if constexpr (!ALIGN_EPI) { if (wr == 0) PG8_BAR; }
    PG8_BAR;
    if constexpr (Epi::AFTER_DRAIN) { E.fused(acc, cur, wr, wc, fr, fq, lds, wid, lane); S.done(cur); }
#undef PG8_SA
#undef PG8_SB
#undef PG8_STAGE
#undef PG8_LDA
#undef PG8_LDB
#undef PG8_MMA
#undef PG8_WAIT_V
#undef PG8_WAIT_L
#undef PG8_BAR
#undef PG8_SCHED
}
}
constexpr int NWAVES = 8;
template <class RowMap>
__device__ __forceinline__ void transpose_item(const float* __restrict__ W, int K, int N, bf16_t* WT, const float* __restrict__ kscale, RowMap rm, LAS float* scr, int item, int lane) {
    const int nblk = (N + 31) / 32, kb = item / nblk, nb = item % nblk, k0 = 64 * kb, n0 = 32 * nb;
    const int nr = n0 + (lane & 31);
    float v[32];
#pragma unroll
    for (int i = 0; i < 32; ++i) { const int kk = 2 * i + (lane >> 5); v[i] = (nr < N) ? W[(size_t)(k0 + kk) * N + nr] : 0.f; }
    if (kscale) {
#pragma unroll
        for (int i = 0; i < 32; ++i) v[i] *= kscale[k0 + 2 * i + (lane >> 5)];
    }
#pragma unroll
    for (int i = 0; i < 32; ++i) scr[(2 * i + (lane >> 5)) * 33 + (lane & 31)] = v[i];
    asm volatile("s_waitcnt lgkmcnt(0)" ::: "memory");
    const int c = lane & 7;
#pragma unroll
    for (int j = 0; j < 4; ++j) { const int nl = (lane >> 3) + 8 * j, n = n0 + nl;
        if (n < N) { const LAS float* s = scr + (8 * c) * 33 + nl;
            u32x4_t o; o.x = pk2(s[0 * 33], s[1 * 33]); o.y = pk2(s[2 * 33], s[3 * 33]); o.z = pk2(s[4 * 33], s[5 * 33]); o.w = pk2(s[6 * 33], s[7 * 33]);
            *(u32x4_t*)(WT + (size_t)rm(n) * K + k0 + 8 * c) = o; } }
    asm volatile("s_waitcnt lgkmcnt(0)" ::: "memory");
}
struct RmIdent { __device__ __forceinline__ int operator()(int n) const { return n; } };
struct RmWin {
    __device__ __forceinline__ int operator()(int c) const {
        const int nc = c < 2560 ? c : (c < 2608 ? 4608 + (c - 2560) : 2560 + (c - 2608));
        const int tile = nc >> 8, L = nc & 255, wc = L >> 6, bj = (L >> 5) & 1, j = L & 31;
        return tile * 256 + 128 * bj + 32 * wc + j;
    }
};
struct RmWup {
    __device__ __forceinline__ int operator()(int c) const { const int up = c >= D_FF, cc = up ? c - D_FF : c; return (cc >> 7) * 256 + up * 128 + (cc & 127); }
};

struct Ptrs {
    const float* in[18]; float* out; unsigned char* ws;
};

__device__ __forceinline__ void p0_prologue(const Ptrs& P, LAS unsigned char* lds, int vcu, int G, const int wave) {
    const int lane = fresh_lane();
    LAS float* scr = (LAS float*)(lds + wave * 16384);
    const int gw = vcu * NWAVES + wave, NGW = G * NWAVES;
    unsigned char* ws = P.ws;
    bf16_t* WinT = (bf16_t*)(ws + WS_WIN); bf16_t* WoutT = (bf16_t*)(ws + WS_WOUT); bf16_t* WupT = (bf16_t*)(ws + WS_WUP); bf16_t* WdownT = (bf16_t*)(ws + WS_WDOWN); bf16_t* W1cT = (bf16_t*)(ws + WS_W1C);
    const float* x = P.in[0]; const float* attn_norm_w = P.in[1]; const float* w_in = P.in[2]; const float* cmp_pos = P.in[5]; const float* cmp_w1 = P.in[6];
    const float* w_out = P.in[12]; const float* ffn_norm_w = P.in[13]; const float* w_up = P.in[14]; const float* w_down = P.in[17];
    constexpr int I_IN = 32 * 146, I_OUT = 32 * 64, I_UP = 32 * 352, I_DOWN = 88 * 64, I_W1 = 32 * 8, I_W2 = 4 * 2;
    constexpr int NITEMS = I_IN + I_OUT + I_UP + I_DOWN + 2 * I_W1 + 2 * I_W2;
    for (int it = gw; it < NITEMS; it += NGW) {
        int r = it;
        if (r < I_IN) { transpose_item(w_in, 2048, IN_COLS, WinT, nullptr, RmWin(), scr, r, lane); continue; } r -= I_IN;
        if (r < I_OUT) { transpose_item(w_out, 2048, 2048, WoutT, nullptr, RmIdent(), scr, r, lane); continue; } r -= I_OUT;
        if (r < I_UP) { transpose_item(w_up, 2048, N_UP, WupT, ffn_norm_w, RmWup(), scr, r, lane); continue; } r -= I_UP;
        if (r < I_DOWN) { transpose_item(w_down, D_FF, 2048, WdownT, nullptr, RmIdent(), scr, r, lane); continue; } r -= I_DOWN;
        if (r < I_W1) { transpose_item(cmp_w1, 2048, 256, W1cT, nullptr, RmIdent(), scr, r, lane); continue; } r -= I_W1;
        if (r < I_W1) { transpose_item(cmp_w1 + (size_t)2048 * 256, 2048, 256, W1cT + (size_t)256 * 2048, nullptr, RmIdent(), scr, r, lane); continue; } r -= I_W1;
        { const int kv = r >= I_W2 ? 1 : 0; transpose_item(P.in[7] + (size_t)kv * 256 * 64, 256, 64, (bf16_t*)(ws + WS_SMALL + SM_W2T) + (size_t)kv * 64 * 256, nullptr, RmIdent(), scr, r - kv * I_W2, lane); }
    }
    for (int i = gw * 64 + lane; i < 8 * 16384; i += NGW * 64) { const int t = (i >> 7) & 127, sx = i & 127; ((bf16_t*)(ws + WS_SMALL + SM_SWB))[i] = (bf16_t)(sx <= t ? f2bf(P.in[10][i]) : 0u); }
    for (int p = gw; p < 256; p += NGW) {
        const int L = 64 * ((p >> 5) & 3) + 32 * (p >> 7) + (p & 31);
        if (L >= 48) { u32x4_t z = {0u, 0u, 0u, 0u}; u32x4_t* d = (u32x4_t*)(WinT + (size_t)(18 * 256 + p) * 2048);
#pragma unroll
            for (int j = 0; j < 4; ++j) d[lane + 64 * j] = z; }
    }
    bf16_t* XN = (bf16_t*)(ws + WS_XN);
    for (int m = gw; m < MTOK; m += 2 * NGW) {
        const int m2 = m + NGW;
        const f32x4_t* xr = (const f32x4_t*)(x + (size_t)m * D_MODEL) + lane;
        const f32x4_t* xr2 = (const f32x4_t*)(x + (size_t)(m2 < MTOK ? m2 : m) * D_MODEL) + lane;
        f32x4_t v[8], v2[8]; float s = 0.f, s2 = 0.f;
#pragma unroll
        for (int j = 0; j < 8; ++j) { v[j] = xr[64 * j]; v2[j] = xr2[64 * j]; }
#pragma unroll
        for (int j = 0; j < 8; ++j) { s += (v[j][0] * v[j][0] + v[j][1] * v[j][1]) + (v[j][2] * v[j][2] + v[j][3] * v[j][3]); s2 += (v2[j][0] * v2[j][0] + v2[j][1] * v2[j][1]) + (v2[j][2] * v2[j][2] + v2[j][3] * v2[j][3]); }
        const float r = __builtin_amdgcn_rsqf(wave_sum(s) * (1.0f / D_MODEL) + 1e-6f), r2 = __builtin_amdgcn_rsqf(wave_sum(s2) * (1.0f / D_MODEL) + 1e-6f);
        u32x2_t* o8 = (u32x2_t*)(XN + (size_t)m * D_MODEL) + lane; u32x2_t* o82 = (u32x2_t*)(XN + (size_t)m2 * D_MODEL) + lane;
#pragma unroll
        for (int j = 0; j < 8; ++j) { const f32x4_t w = ((const f32x4_t*)attn_norm_w)[lane + 64 * j];
            u32x2_t o; o.x = pk2(v[j][0] * r * w[0], v[j][1] * r * w[1]); o.y = pk2(v[j][2] * r * w[2], v[j][3] * r * w[3]); o8[64 * j] = o;
            if (m2 < MTOK) { u32x2_t q; q.x = pk2(v2[j][0] * r2 * w[0], v2[j][1] * r2 * w[1]); q.y = pk2(v2[j][2] * r2 * w[2], v2[j][3] * r2 * w[3]); o82[64 * j] = q; } }
    }
    float* BIASP = (float*)(ws + WS_SMALL + SM_BIASP);
    for (int it = gw; it < 64; it += NGW) {
        const int kv = it >> 5, kc = it & 31; f32x4_t a = {0.f, 0.f, 0.f, 0.f};
        const float* pp = cmp_pos + kv * 2048 + kc * 64; const float* w1 = cmp_w1 + ((size_t)kv * 2048 + kc * 64) * 256;
        for (int k = 0; k < 64; ++k) { const f32x4_t w = ((const f32x4_t*)(w1 + (size_t)k * 256))[lane]; a += w * pp[k]; }
        ((f32x4_t*)(BIASP + (size_t)it * 256))[lane] = a;
    }
}

__device__ __forceinline__ void bias1_stage(unsigned char* ws, int idx  ) {
    const float* BIASP = (const float*)(ws + WS_SMALL + SM_BIASP); float* BIAS1 = (float*)(ws + WS_SMALL + SM_BIAS1);
    const int kv = idx >> 8, j = idx & 255; float s = 0.f;
    for (int kc = 0; kc < 32; ++kc) s += BIASP[(size_t)(kv * 32 + kc) * 256 + j];
    BIAS1[idx] = s;
}
__device__ __forceinline__ void cmp2_row(const Ptrs& P, int R, int lane) {
    unsigned char* ws = P.ws; const bf16_t* HC = (const bf16_t*)(ws + WS_HC);
    const int kv = R >> 12, rr = R & 4095, n = rr & 255;
    bf16_t* dst = (bf16_t*)(ws + (kv ? WS_VC : WS_KC)) + (size_t)rr * 64 + lane;
    if (n == 255) { *dst = 0; return; }
    const float* w2 = P.in[7] + (size_t)kv * 256 * 64;
    const u32x2_t hr = *(const u32x2_t*)(HC + (size_t)R * 256 + 4 * lane);
    float h[4] = {__uint_as_float(hr.x << 16), __uint_as_float(hr.x & 0xffff0000u), __uint_as_float(hr.y << 16), __uint_as_float(hr.y & 0xffff0000u)};
    float o = 0.f;
    for (int jj = 0; jj < 64; ++jj) {
#pragma unroll
        for (int i = 0; i < 4; ++i) o += __shfl(h[i], jj) * w2[(size_t)(4 * jj + i) * 64 + lane];
    }
    if (kv == 0) { const float ss = wave_sum(o * o); o *= __builtin_amdgcn_rsqf(ss * (1.0f / 64.0f) + 1e-6f) * P.in[4][lane]; }
    *dst = (bf16_t)f2bf(o);
}

__device__ __forceinline__ void gmlp_unit_v1(const Ptrs& P, LAS unsigned char* lds, int unit, const int wave_s) {
    unsigned char* ws = P.ws; const int tid = fresh_tid(wave_s);
    const int g = unit & 7, chunk = (unit >> 3) & 31, b = unit >> 8; const int m0 = b * SEQ + chunk * 128;
    LAS float* vn = (LAS float*)lds; LAS float* Wl = (LAS float*)(lds + 65536); LAS float* st = (LAS float*)(lds + 131072);
    const bf16_t* GV = (const bf16_t*)(ws + WS_GV); const bf16_t* U = (const bf16_t*)(ws + WS_U); const float* VSTAT = (const float*)(ws + WS_VSTAT);
    bf16_t* AB = (bf16_t*)(ws + WS_AB);
    const float* ln_w = P.in[8]; const float* ln_b = P.in[9]; const float* sw = P.in[10]; const float* sb = P.in[11];
    if (tid < 128) { const float* p = VSTAT + (size_t)(m0 + tid) * 32; float s1 = 0.f, s2 = 0.f;
#pragma unroll
        for (int i = 0; i < 16; ++i) { s1 += p[2 * i]; s2 += p[2 * i + 1]; }
        const float mean = s1 * (1.0f / 1024.0f); float var = s2 * (1.0f / 1024.0f) - mean * mean; var = var < 0.f ? 0.f : var;
        st[2 * tid] = mean; st[2 * tid + 1] = __builtin_amdgcn_rsqf(var + 1e-5f); }
    for (int i = 0; i < 32; ++i) { const int idx = tid + 512 * i, t = idx >> 7, s = idx & 127; Wl[idx] = (s <= t) ? sw[(size_t)g * 16384 + idx] : 0.f; }
    __syncthreads();
#pragma unroll
    for (int i = 0; i < 4; ++i) { const int idx = tid + 512 * i, s = idx >> 4, c8 = idx & 15;
        const u32x4_t raw = *(const u32x4_t*)(GV + (size_t)(m0 + s) * 1024 + g * 128 + 8 * c8); float f[8]; unpack8(raw, f);
        const float mean = st[2 * s], rstd = st[2 * s + 1];
#pragma unroll
        for (int e = 0; e < 8; ++e) { const int c = g * 128 + 8 * c8 + e; vn[s * 128 + 8 * c8 + e] = (f[e] - mean) * rstd * ln_w[c] + ln_b[c]; } }
    __syncthreads();
    const int c = tid & 127, tq = tid >> 7;
    for (int i = 0; i < 8; ++i) {
        const int t0 = 4 * (tq + 4 * i); float a0 = 0.f, a1 = 0.f, a2 = 0.f, a3 = 0.f;
        for (int s4 = 0; s4 <= t0; s4 += 4) {
            const f32x4_t w0 = *(const LAS f32x4_t*)(Wl + (t0 + 0) * 128 + s4), w1 = *(const LAS f32x4_t*)(Wl + (t0 + 1) * 128 + s4), w2 = *(const LAS f32x4_t*)(Wl + (t0 + 2) * 128 + s4), w3 = *(const LAS f32x4_t*)(Wl + (t0 + 3) * 128 + s4);
#pragma unroll
            for (int k = 0; k < 4; ++k) { const float v = vn[(s4 + k) * 128 + c]; a0 += w0[k] * v; a1 += w1[k] * v; a2 += w2[k] * v; a3 += w3[k] * v; }
        }
        const float av[4] = {a0, a1, a2, a3};
#pragma unroll
        for (int k = 0; k < 4; ++k) { const int t = t0 + k; const size_t row = (size_t)(m0 + t);
            const float uu = bf2f(U[row * 1024 + g * 128 + c]); AB[row * 2048 + 1024 + g * 128 + c] = (bf16_t)f2bf(uu * (av[k] + sb[g * 128 + t])); }
    }
    __syncthreads();
}

__device__ __forceinline__ void conv_item(const Ptrs& P, int b, int idx) {
    const int t = idx / 704, c8 = idx % 704, c0 = 8 * c8, j = c0 >> 7, i0 = c0 & 127;
    const bf16_t* HID = (const bf16_t*)(P.ws + WS_HID); const float* cw = P.in[15]; const float* cb = P.in[16];
    float gt[8], up[8];
#pragma unroll
    for (int e = 0; e < 8; ++e) { gt[e] = cb[c0 + e]; up[e] = cb[D_FF + c0 + e]; }
#pragma unroll
    for (int k = 0; k < 3; ++k) { const int tt = t - 2 + k; if (tt < 0) continue;
        float hg[8], hu[8]; unpack8(*(const u32x4_t*)(HID + (size_t)tt * N_UP + 256 * j + i0), hg); unpack8(*(const u32x4_t*)(HID + (size_t)tt * N_UP + 256 * j + 128 + i0), hu);
#pragma unroll
        for (int e = 0; e < 8; ++e) { gt[e] += cw[(size_t)k * N_UP + c0 + e] * hg[e]; up[e] += cw[(size_t)k * N_UP + D_FF + c0 + e] * hu[e]; } }
    float r[8];
#pragma unroll
    for (int e = 0; e < 8; ++e) r[e] = gt[e] * sigmoidf_(gt[e]) * up[e];
    u32x4_t o; o.x = pk2(r[0], r[1]); o.y = pk2(r[2], r[3]); o.z = pk2(r[4], r[5]); o.w = pk2(r[6], r[7]);
    *(u32x4_t*)((bf16_t*)(P.ws + WS_G) + ((size_t)b * SEQ + t) * D_FF + c0) = o;
}

namespace nsa {
using bf16x8 = __attribute__((ext_vector_type(8))) short;
using s16x4 = __attribute__((ext_vector_type(4))) short;
using f32x16 = __attribute__((ext_vector_type(16))) float;
typedef float f32x2_t __attribute__((ext_vector_type(2))); typedef __bf16 bf16x2_t __attribute__((ext_vector_type(2)));
constexpr int L_K = 0, L_V = 16384, L_WSF = 32768, L_OST = 34816, L_IMP = 100352, L_MASK = 116736, L_WU = 117248, L_END = 117312;
constexpr int SLOTB = 8192;
constexpr float THR = 8.0f;
#define NSA_SBAR() __builtin_amdgcn_sched_barrier(0)
__device__ __forceinline__ int crow(int r, int hi) { return (r & 3) + 8 * (r >> 2) + 4 * hi; }
__device__ __forceinline__ void glds16(const void* gbase  , unsigned voff  , unsigned lds_dst) { unsigned keep;
    asm volatile("s_mov_b32 %0, m0\n\ts_mov_b32 m0, %3\n\ts_nop 0\n\tglobal_load_lds_dwordx4 %1, %2\n\ts_mov_b32 m0, %0" : "=&s"(keep) : "v"(voff), "s"(gbase), "s"(lds_dst) : "memory"); }
__device__ __forceinline__ unsigned cvtpk_s(float lo, float hi) { f32x2_t v = {lo, hi}; bf16x2_t b = __builtin_convertvector(v, bf16x2_t); return __builtin_bit_cast(unsigned, b); }
#define NSA_WAIT_BAR() asm volatile("s_waitcnt vmcnt(0) lgkmcnt(0)\n\ts_barrier" ::: "memory")

__device__ __forceinline__ void qkt(f32x16& p0, f32x16& p1, LAS const char* Kslot, const bf16x8 (&qr)[4], int r32, int hi) {
    LAS const char* kb = Kslot + hi * 1024 + r32 * 16;
#pragma unroll
    for (int d0 = 0; d0 < 4; ++d0) {
        const bf16x8 b0 = *(LAS const bf16x8*)(kb + d0 * 2048);
        const bf16x8 b1 = *(LAS const bf16x8*)(kb + d0 * 2048 + 512);
        p0 = __builtin_amdgcn_mfma_f32_32x32x16_bf16(b0, qr[d0], p0, 0, 0, 0); p1 = __builtin_amdgcn_mfma_f32_32x32x16_bf16(b1, qr[d0], p1, 0, 0, 0);
    }
}
struct VFrag { s16x4 lo[2][4], hi[2][4]; };
__device__ __forceinline__ void vload(VFrag& f, int vb) {
#pragma unroll
    for (int d0 = 0; d0 < 2; ++d0)
#pragma unroll
        for (int ks = 0; ks < 4; ++ks) {
            asm volatile("ds_read_b64_tr_b16 %0,%1 offset:%c2" : "=&v"(f.lo[d0][ks]) : "v"(vb), "i"(d0 * 4096 + ks * 1024) : "memory");
            asm volatile("ds_read_b64_tr_b16 %0,%1 offset:%c2" : "=&v"(f.hi[d0][ks]) : "v"(vb), "i"(d0 * 4096 + ks * 1024 + 512) : "memory"); }
}
__device__ __forceinline__ void pvmma(f32x16 (&o)[2], VFrag& f, bf16x8 pa0, bf16x8 pa1, bf16x8 pa2, bf16x8 pa3) {
    asm volatile("s_waitcnt lgkmcnt(0)" : "+v"(f.lo[0][0]), "+v"(f.lo[0][1]), "+v"(f.lo[0][2]), "+v"(f.lo[0][3]), "+v"(f.hi[0][0]), "+v"(f.hi[0][1]), "+v"(f.hi[0][2]), "+v"(f.hi[0][3]) :: "memory");
    asm volatile("" : "+v"(f.lo[1][0]), "+v"(f.lo[1][1]), "+v"(f.lo[1][2]), "+v"(f.lo[1][3]), "+v"(f.hi[1][0]), "+v"(f.hi[1][1]), "+v"(f.hi[1][2]), "+v"(f.hi[1][3]));
    NSA_SBAR();
#pragma unroll
    for (int d0 = 0; d0 < 2; ++d0) {
#define NSA_PK(k) (bf16x8){f.lo[d0][k][0], f.lo[d0][k][1], f.lo[d0][k][2], f.lo[d0][k][3], f.hi[d0][k][0], f.hi[d0][k][1], f.hi[d0][k][2], f.hi[d0][k][3]}
        o[d0] = __builtin_amdgcn_mfma_f32_32x32x16_bf16(pa0, NSA_PK(0), o[d0], 0, 0, 0);
        o[d0] = __builtin_amdgcn_mfma_f32_32x32x16_bf16(pa1, NSA_PK(1), o[d0], 0, 0, 0);
        o[d0] = __builtin_amdgcn_mfma_f32_32x32x16_bf16(pa2, NSA_PK(2), o[d0], 0, 0, 0);
        o[d0] = __builtin_amdgcn_mfma_f32_32x32x16_bf16(pa3, NSA_PK(3), o[d0], 0, 0, 0);
#undef NSA_PK
    }
}
__device__ __forceinline__ void pv(f32x16 (&o)[2], int vb, bf16x8 pa0, bf16x8 pa1, bf16x8 pa2, bf16x8 pa3) { VFrag f; vload(f, vb); pvmma(o, f, pa0, pa1, pa2, pa3); }
__device__ __forceinline__ float rowmax32(const f32x16& p0, const f32x16& p1) {
    float a = __builtin_fmaxf(p0[0], p1[0]);
#pragma unroll
    for (int r = 1; r < 16; ++r) a = __builtin_fmaxf(a, __builtin_fmaxf(p0[r], p1[r]));
    auto rr = __builtin_amdgcn_permlane32_swap(__float_as_uint(a), __float_as_uint(a), false, false);
    return __builtin_fmaxf(__uint_as_float(rr[0]), __uint_as_float(rr[1]));
}
struct State { float m, l; f32x16 o[2]; };
__device__ __forceinline__ void state_init(State& s) { s.m = -1e30f; s.l = 0.f; s.o[0] = f32x16{}; s.o[1] = f32x16{}; }

template <int BMUL, int MASK, bool LOADV>
__device__ __forceinline__ void tile_scores(f32x16& p0, f32x16& p1, LAS const char* Kslot, const bf16x8 (&qr)[4], const f32x16& bk, float c0, float b32, int lim, int r32, int hi, VFrag& vf, int vb) {
#pragma unroll
    for (int r = 0; r < 16; ++r) { const float b = (BMUL == 1) ? bk[r] + c0 : __builtin_fmaf(bk[r], (float)BMUL, c0); p0[r] = b; p1[r] = b + b32; }
    qkt(p0, p1, Kslot, qr, r32, hi);
    if (LOADV) vload(vf, vb);
    const int limh = lim - 4 * hi;
#pragma unroll
    for (int r = 0; r < 16; ++r) {
        const int kk = (r & 3) + 8 * (r >> 2);
        if (MASK == 1) { if (!(kk <= limh)) p0[r] = -INFINITY; if (!(kk + 32 <= limh)) p1[r] = -INFINITY; }
        if (MASK == 2) { if (!(kk > limh)) p0[r] = -INFINITY; if (!(kk + 32 > limh)) p1[r] = -INFINITY; }
        if (MASK == 3) { if (!(kk < limh)) p0[r] = -INFINITY; if (!(kk + 32 < limh)) p1[r] = -INFINITY; }
    }
}
__device__ __forceinline__ float tile_ref(const State& st, float rb0, bool rowlive) { return (st.m < -1e29f && rowlive) ? rb0 : st.m; }
__device__ __forceinline__ void tile_softmax_pv(State& st, f32x16& p0, f32x16& p1, float mref, VFrag& vf, LAS float* wsf, int r32, int hi) {
    float a0 = p0[0], a1 = p1[0];
#pragma unroll
    for (int r = 1; r < 16; ++r) { a0 = __builtin_fmaxf(a0, p0[r]); a1 = __builtin_fmaxf(a1, p1[r]); }
    float mx = __builtin_fmaxf(a0, a1);
    { auto rr = __builtin_amdgcn_permlane32_swap(__float_as_uint(mx), __float_as_uint(mx), false, false); mx = __builtin_fmaxf(__uint_as_float(rr[0]), __uint_as_float(rr[1])); }
    if (__any(mx > THR)) {
        const float dl = __builtin_fmaxf(mx, 0.f), alpha = __builtin_amdgcn_exp2f(-dl);
        mref += dl; st.l *= alpha;
        if (hi == 0) wsf[r32] = alpha;
        asm volatile("s_waitcnt lgkmcnt(0)" ::: "memory");
#pragma unroll
        for (int r = 0; r < 16; ++r) { const float a = wsf[crow(r, hi)]; st.o[0][r] *= a; st.o[1][r] *= a; p0[r] -= dl; p1[r] -= dl; }
    }
    st.m = mref;
    float ls = 0.f;
#pragma unroll
    for (int r = 0; r < 16; ++r) { p0[r] = __builtin_amdgcn_exp2f(p0[r]); p1[r] = __builtin_amdgcn_exp2f(p1[r]); ls += p0[r] + p1[r]; }
    st.l += ls;
    u32x4_t pw0, pw1, pw2, pw3;
    pw0 = (u32x4_t){cvtpk_s(p0[0], p0[1]), cvtpk_s(p0[2], p0[3]), cvtpk_s(p0[4], p0[5]), cvtpk_s(p0[6], p0[7])};
    pw1 = (u32x4_t){cvtpk_s(p0[8], p0[9]), cvtpk_s(p0[10], p0[11]), cvtpk_s(p0[12], p0[13]), cvtpk_s(p0[14], p0[15])};
    pw2 = (u32x4_t){cvtpk_s(p1[0], p1[1]), cvtpk_s(p1[2], p1[3]), cvtpk_s(p1[4], p1[5]), cvtpk_s(p1[6], p1[7])};
    pw3 = (u32x4_t){cvtpk_s(p1[8], p1[9]), cvtpk_s(p1[10], p1[11]), cvtpk_s(p1[12], p1[13]), cvtpk_s(p1[14], p1[15])};
    pvmma(st.o, vf, __builtin_bit_cast(bf16x8, pw0), __builtin_bit_cast(bf16x8, pw1), __builtin_bit_cast(bf16x8, pw2), __builtin_bit_cast(bf16x8, pw3));
}
template <bool FIRST>
__device__ __forceinline__ void fold_branch(LAS float* ostg, State& st, float gate, LAS float* wsf, int r32, int hi) {
    float l = st.l;
    { auto rr = __builtin_amdgcn_permlane32_swap(__float_as_uint(l), __float_as_uint(l), false, false); l = __uint_as_float(rr[0]) + __uint_as_float(rr[1]); }
    const float f = l > 0.f ? gate / l : 0.f;
    asm volatile("s_waitcnt lgkmcnt(0)" ::: "memory");
    if (hi == 0) wsf[r32] = f;
    asm volatile("s_waitcnt lgkmcnt(0)" ::: "memory");
#pragma unroll
    for (int r = 0; r < 16; ++r) { const int orow = crow(r, hi); const float a = wsf[orow];
#pragma unroll
        for (int d0 = 0; d0 < 2; ++d0) { LAS float* p = ostg + orow * 64 + d0 * 32 + r32; if (FIRST) *p = st.o[d0][r] * a; else *p += st.o[d0][r] * a; } }
    asm volatile("s_waitcnt lgkmcnt(0)" ::: "memory");
}

__device__ __forceinline__ int nsa_unit(const Ptrs& P, LAS unsigned char* lds, int bg, int qt, const int wave_s, unsigned* qctr, int qbase) {
    unsigned char* ws = P.ws;
    const int lane = fresh_lane(), r32 = lane & 31, hi = lane >> 5; const int wid = wave_s;
    const int b = bg >> 2, g = bg & 3, t0 = 64 * qt;
    const int tl = 8 * wid + (r32 >> 2), hq = r32 & 3;
    const size_t m0 = (size_t)b * SEQ + t0;
    const bf16_t* Q = (const bf16_t*)(ws + WS_Q); const bf16_t* KV6 = (const bf16_t*)(ws + WS_KV6);
    const bf16_t* KSb = KV6 + 2 * KVSZ + (size_t)bg * SEQ * 64; const bf16_t* VSb = KV6 + 3 * KVSZ + (size_t)bg * SEQ * 64;
    const bf16_t* KWb = KV6 + 4 * KVSZ + (size_t)bg * SEQ * 64; const bf16_t* VWb = KV6 + 5 * KVSZ + (size_t)bg * SEQ * 64;
    const bf16_t* KCb = (const bf16_t*)(ws + WS_KC) + (size_t)bg * 256 * 64; const bf16_t* VCb = (const bf16_t*)(ws + WS_VC) + (size_t)bg * 256 * 64;
    const float* GATES = (const float*)(ws + WS_GATES); bf16_t* AB = (bf16_t*)(ws + WS_AB);
    const unsigned lds0 = (unsigned)(uintptr_t)lds;
    LAS float* wsf = (LAS float*)(lds + L_WSF) + wid * 64;
    LAS float* IMP = (LAS float*)(lds + L_IMP);
    LAS unsigned* MASK = (LAS unsigned*)(lds + L_MASK); LAS unsigned* WU = (LAS unsigned*)(lds + L_WU);
    const int koff = lane * 64 + wid * 8, voff = (16 * (wid & 3) + (lane >> 2)) * 64 + (wid >> 2) * 32 + (lane & 3) * 8;
    const unsigned kdst = lds0 + L_K + wid * 1024, vdst = lds0 + L_V + wid * 1024;
#define NSA_DMA_K(base, tile, slot) glds16((base) + (size_t)(tile) * 4096, (unsigned)koff * 2u, (unsigned)__builtin_amdgcn_readfirstlane(kdst + (slot) * SLOTB))
#define NSA_DMA_V(base, tile, slot) glds16((base) + (size_t)(tile) * 4096, (unsigned)voff * 2u, (unsigned)__builtin_amdgcn_readfirstlane(vdst + (slot) * SLOTB))
    const int vb0 = (int)(lds0 + L_V) + ((lane >> 4) & 1) * 32 + (lane & 3) * 8 + (4 * hi + ((lane & 15) >> 2)) * 64;
    LAS const char* Kbase = (LAS const char*)(lds + L_K);
    bf16x8 qr[4];
    { const bf16_t* qp = Q + (m0 + tl) * 1024 + (4 * g + hq) * 64 + hi * 8;
#pragma unroll
      for (int d0 = 0; d0 < 4; ++d0) qr[d0] = *(const bf16x8*)(qp + d0 * 16); }
    const float sl2 = __builtin_amdgcn_exp2f(-0.5f * (float)(4 * g + hq + 1)) * LOG2E;
    f32x16 bk;
#pragma unroll
    for (int r = 0; r < 16; ++r) bk[r] = sl2 * (float)((r & 3) + 8 * (r >> 2));
    const float b32t = 32.0f * sl2, b32c = 512.0f * sl2, hoff_t = 4.0f * (float)hi * sl2, hoff_c = 64.0f * (float)hi * sl2;
    float gate[3];
    { const float* gp = GATES + (m0 + tl) * 48 + (4 * g + hq) * 3; gate[0] = gp[0]; gate[1] = gp[1]; gate[2] = gp[2]; }
    LAS float* ostg = (LAS float*)(lds + L_OST) + wid * 2048;
    State st;
    f32x16 p0, p1;
    int nxt_ticket = 0;

    int tc = 0;
    VFrag vf;
    const int nvmax = (t0 + 63 >= 31) ? ((t0 + 63 - 31) >> 4) + 1 : 0;
    const int nct = (nvmax + 63) >> 6;
    const int tq = t0 + tl, nv = tq >= 31 ? ((tq - 31) >> 4) + 1 : 0;
    {
        state_init(st);
        const int j0 = qt >= 8 ? qt - 8 : 0, nt = qt - j0 + 1;
        NSA_DMA_K(KWb, qt, 0); NSA_DMA_V(VWb, qt, 0); NSA_WAIT_BAR();
        for (int i = 0; i < nt; ++i) {
            const int j = qt - i, slot = (tc + i) & 1;
            if (i + 1 < nt) { NSA_DMA_K(KWb, j - 1, slot ^ 1); NSA_DMA_V(VWb, j - 1, slot ^ 1); }
            else { NSA_DMA_K(KCb, nct - 1, slot ^ 1); NSA_DMA_V(VCb, nct - 1, slot ^ 1); }
            const float rb0 = sl2 * (float)(64 * j - t0), mref = tile_ref(st, rb0, true), c0 = rb0 + hoff_t - mref;
            if (j == qt) tile_scores<1, 1, true>(p0, p1, Kbase + slot * SLOTB, qr, bk, c0, b32t, tl, r32, hi, vf, vb0 + slot * SLOTB);
            else if (j == qt - 8) tile_scores<1, 2, true>(p0, p1, Kbase + slot * SLOTB, qr, bk, c0, b32t, tl, r32, hi, vf, vb0 + slot * SLOTB);
            else tile_scores<1, 0, true>(p0, p1, Kbase + slot * SLOTB, qr, bk, c0, b32t, 0, r32, hi, vf, vb0 + slot * SLOTB);
            tile_softmax_pv(st, p0, p1, mref, vf, wsf, r32, hi);
            NSA_WAIT_BAR();
        }
        tc += nt;
        fold_branch<true>(ostg, st, gate[2], wsf, r32, hi);
    }
    {
        state_init(st);
        for (int ci = 0; ci < nct; ++ci) {
            const int c = nct - 1 - ci, slot = (tc + ci) & 1;
            if (ci + 1 < nct) { NSA_DMA_K(KCb, c - 1, slot ^ 1); NSA_DMA_V(VCb, c - 1, slot ^ 1); }
            else if (qt >= 16) { NSA_DMA_K(KCb, 0, slot ^ 1); }
            else { NSA_DMA_K(KSb, qt, slot ^ 1); NSA_DMA_V(VSb, qt, slot ^ 1); }
            const float rb0 = sl2 * ((float)(1024 * c - t0) + 15.5f), mref = tile_ref(st, rb0, true), c0 = rb0 + hoff_c - mref;
            tile_scores<16, 3, true>(p0, p1, Kbase + slot * SLOTB, qr, bk, c0, b32c, nv - 64 * c, r32, hi, vf, vb0 + slot * SLOTB);
            tile_softmax_pv(st, p0, p1, mref, vf, wsf, r32, hi);
            NSA_WAIT_BAR();
        }
        tc += nct;
    }
    const float mc_fin = st.m; float lc = st.l;
    fold_branch<false>(ostg, st, gate[0], wsf, r32, hi);
    if (qt >= 16) {
        { auto rr = __builtin_amdgcn_permlane32_swap(__float_as_uint(lc), __float_as_uint(lc), false, false); lc = __uint_as_float(rr[0]) + __uint_as_float(rr[1]); }
        const float invl = lc > 0.f ? 1.0f / lc : 0.f;
        float carry = 0.f;
        for (int c = 0; c < nct; ++c) {
            const int slot = (tc + c) & 1;
            if (c + 1 < nct) { NSA_DMA_K(KCb, c + 1, slot ^ 1); }
            else { NSA_DMA_K(KSb, qt, slot ^ 1); NSA_DMA_V(VSb, qt, slot ^ 1); }
            const float c0 = sl2 * ((float)(1024 * c - t0) + 15.5f) + hoff_c - mc_fin;
            tile_scores<16, 3, false>(p0, p1, Kbase + slot * SLOTB, qr, bk, c0, b32c, nv - 64 * c, r32, hi, vf, 0);
#pragma unroll
            for (int r = 0; r < 16; ++r) { p0[r] = __builtin_amdgcn_exp2f(p0[r]) * invl; p1[r] = __builtin_amdgcn_exp2f(p1[r]) * invl; }
            float imp0[4], imp1[4], pl0[4], pl1[4];
#pragma unroll
            for (int a = 0; a < 4; ++a) {
                imp0[a] = (p0[4 * a] + p0[4 * a + 1]) + (p0[4 * a + 2] + p0[4 * a + 3]); imp1[a] = (p1[4 * a] + p1[4 * a + 1]) + (p1[4 * a + 2] + p1[4 * a + 3]);
                pl0[a] = __shfl_xor(p0[4 * a + 3], 32); pl1[a] = __shfl_xor(p1[4 * a + 3], 32);
            }
            if (hi) {
#pragma unroll
                for (int a = 0; a < 4; ++a) { imp0[a] += pl0[a]; imp1[a] += pl1[a]; }
            } else {
                imp0[0] += carry; imp1[0] += pl0[3];
#pragma unroll
                for (int a = 1; a < 4; ++a) { imp0[a] += pl0[a - 1]; imp1[a] += pl1[a - 1]; }
            }
            carry = pl1[3];
#pragma unroll
            for (int a = 0; a < 4; ++a) {
                imp0[a] += __shfl_xor(imp0[a], 1); imp0[a] += __shfl_xor(imp0[a], 2); imp1[a] += __shfl_xor(imp1[a], 1); imp1[a] += __shfl_xor(imp1[a], 2);
                if (hq == 0) { IMP[tl * 64 + 16 * c + 2 * a + hi] = imp0[a]; IMP[tl * 64 + 16 * c + 8 + 2 * a + hi] = imp1[a]; }
            }
            NSA_WAIT_BAR();
        }
        tc += nct;
    }
    unsigned long long wu = 0ull;
    if (qt < 16) {
        wu = (2ull << qt) - 1ull;
        if (lane < 8) { MASK[2 * (8 * wid + lane)] = (unsigned)wu; MASK[2 * (8 * wid + lane) + 1] = (unsigned)(wu >> 32); }
    } else {
        const int j = lane; const bool valid = j <= qt, forced = (j == 0) || (j == qt) || (j == qt - 1);
        for (int k = 0; k < 8; ++k) {
            const float imp = IMP[(8 * wid + k) * 64 + j];
            const float scv = valid ? (forced ? 1e9f : imp) : -1e9f;
            const unsigned fb = __float_as_uint(scv), key = fb ^ ((fb >> 31) ? 0xffffffffu : 0x80000000u);
            unsigned T = 0u;
#pragma unroll
            for (int bit = 31; bit >= 0; --bit) { const unsigned cand = T | (1u << bit); if (__builtin_popcountll(__ballot(key >= cand)) >= 16) T = cand; }
            const unsigned long long gt = __ballot(key > T), eq = __ballot(key == T);
            const int need = 16 - __builtin_popcountll(gt);
            const int before = (int)__builtin_amdgcn_mbcnt_hi((unsigned)(eq >> 32), __builtin_amdgcn_mbcnt_lo((unsigned)eq, 0u));
            const bool sel = (key > T) || ((key == T) && (before < need));
            const unsigned long long mk = __ballot(sel && (scv > -0.5e9f));
            wu |= mk;
            if (lane == 0) { MASK[2 * (8 * wid + k)] = (unsigned)mk; MASK[2 * (8 * wid + k) + 1] = (unsigned)(mk >> 32); }
        }
    }
    if (lane == 0) { WU[2 * wid] = (unsigned)wu; WU[2 * wid + 1] = (unsigned)(wu >> 32); }
    NSA_WAIT_BAR();
    unsigned long long uni = 0ull;
#pragma unroll
    for (int w = 0; w < 8; ++w) uni |= ((unsigned long long)WU[2 * w]) | (((unsigned long long)WU[2 * w + 1]) << 32);
    uni = ((unsigned long long)__builtin_amdgcn_readfirstlane((unsigned)uni)) | (((unsigned long long)__builtin_amdgcn_readfirstlane((unsigned)(uni >> 32))) << 32);
    const unsigned long long mymask = ((unsigned long long)MASK[2 * tl]) | (((unsigned long long)MASK[2 * tl + 1]) << 32);
    {
        state_init(st);
        unsigned long long rem = uni;
        int j = 63 - __builtin_clzll(rem); rem &= ~(1ull << j);
        for (int i = 0;; ++i) {
            const int slot = (tc + i) & 1; const bool more = rem != 0ull;
            int jn = 0;
            if (more) { jn = 63 - __builtin_clzll(rem); rem &= ~(1ull << jn); NSA_DMA_K(KSb, jn, slot ^ 1); NSA_DMA_V(VSb, jn, slot ^ 1); }
            if ((wu >> j) & 1ull) {
                const bool live = ((mymask >> j) & 1ull) != 0ull;
                const float rb0 = sl2 * (float)(64 * j - t0), mref = tile_ref(st, rb0, live), c0 = live ? rb0 + hoff_t - mref : -INFINITY;
                if (j == qt) tile_scores<1, 1, true>(p0, p1, Kbase + slot * SLOTB, qr, bk, c0, b32t, tl, r32, hi, vf, vb0 + slot * SLOTB);
                else tile_scores<1, 0, true>(p0, p1, Kbase + slot * SLOTB, qr, bk, c0, b32t, 0, r32, hi, vf, vb0 + slot * SLOTB);
                tile_softmax_pv(st, p0, p1, mref, vf, wsf, r32, hi);
            }
            NSA_WAIT_BAR();
            if (!more) break;
            j = jn;
        }
        if (wid == 0 && lane == 0) nxt_ticket = qbase + (int)__hip_atomic_fetch_add(qctr, 1u, __ATOMIC_RELAXED, __HIP_MEMORY_SCOPE_AGENT);
        fold_branch<false>(ostg, st, gate[1], wsf, r32, hi);
    }
    {
#pragma unroll
        for (int i = 0; i < 4; ++i) { const int row = i * 8 + (lane >> 3), ch = lane & 7;
            const f32x4_t v0 = *(LAS const f32x4_t*)(ostg + row * 64 + ch * 8), v1 = *(LAS const f32x4_t*)(ostg + row * 64 + ch * 8 + 4);
            u32x4_t v; v.x = cvtpk_s(v0[0], v0[1]); v.y = cvtpk_s(v0[2], v0[3]); v.z = cvtpk_s(v1[0], v1[1]); v.w = cvtpk_s(v1[2], v1[3]);
            *(u32x4_t*)(AB + (m0 + 8 * wid + (row >> 2)) * 2048 + 256 * g + (row & 3) * 64 + ch * 8) = v; }
    }
    NSA_WAIT_BAR();
#undef NSA_DMA_K
#undef NSA_DMA_V
    return nxt_ticket;
}
constexpr int L_QS = 145416;
__device__ __forceinline__ void nsa_phase(const Ptrs& P, LAS unsigned char* lds, int bid, int G, const int wave_s) {
    unsigned* qctr = (unsigned*)(P.ws + WS_CTL) + 3584;
    LAS int* qs = (LAS int*)(lds + L_QS);
    int k = bid;
    while (k < 1024) {
        const int qt = 63 - (k >> 4), g = 3 - ((k >> 2) & 3), b = k & 3;
        const int nxt = nsa_unit(P, lds, b * 4 + g, qt, wave_s, qctr, G);
        if (wave_s == 0 && fresh_lane() == 0) *qs = nxt;
        NSA_WAIT_BAR();
        k = __builtin_amdgcn_readfirstlane(*qs);
    }
}
}

namespace p2 {
using nsa::bf16x8; using nsa::f32x16; using nsa::s16x4; using nsa::crow; using nsa::glds16; using nsa::cvtpk_s;
#define P2_WAIT_BAR() asm volatile("s_waitcnt vmcnt(0) lgkmcnt(0)\n\ts_barrier" ::: "memory")
constexpr int CB_BUF = 40960;
constexpr int CP_STRIDE = 65;
__device__ __forceinline__ void compress_unit(const Ptrs& P, LAS unsigned char* lds, int u, const int wave_s) {
    unsigned char* ws = P.ws;
    const int lane = fresh_lane(), r32 = lane & 31, hi = lane >> 5, wid = wave_s;
    const int kv = u >> 6, bg = (u >> 2) & 15, n0 = 64 * (u & 3);
    const bf16_t* Ag = (const bf16_t*)(ws + WS_KV6) + (size_t)kv * KVSZ + (size_t)bg * SEQ * 64 + (size_t)n0 * 1024;
    const bf16_t* Bg = (const bf16_t*)(ws + WS_W1C) + (size_t)kv * 256 * 2048;
    const unsigned lds0 = (unsigned)(uintptr_t)lds;
    const unsigned aoff = (unsigned)(lane * 1024 + wid * 8) * 2u, boff = (unsigned)(lane * 2048 + wid * 8) * 2u;
    const unsigned dstw = lds0 + wid * 1024;
#define P2_DMA_TILE(kt, buf) do { const unsigned d_ = (unsigned)__builtin_amdgcn_readfirstlane(dstw + (buf) * CB_BUF); \
        glds16(Ag + (kt) * 64, aoff, d_); \
        _Pragma("unroll") for (int ct_ = 0; ct_ < 4; ++ct_) glds16(Bg + (size_t)ct_ * 64 * 2048 + (kt) * 64, boff, d_ + 8192u * (ct_ + 1)); } while (0)
    const int ct = wid >> 1, half = wid & 1, ncol0 = 64 * ct + 32 * half;
    f32x16 hT[2]; hT[0] = f32x16{}; hT[1] = f32x16{};
    P2_DMA_TILE(0, 0); P2_WAIT_BAR();
    for (int kt = 0; kt < 32; ++kt) {
        const int buf = kt & 1;
        if (kt + 1 < 32) P2_DMA_TILE(kt + 1, buf ^ 1);
        LAS const char* sa = (LAS const char*)(lds + buf * CB_BUF) + hi * 1024 + r32 * 16;
        LAS const char* sb = (LAS const char*)(lds + buf * CB_BUF + 8192 * (ct + 1)) + half * 512 + hi * 1024 + r32 * 16;
#pragma unroll
        for (int d0 = 0; d0 < 4; ++d0) {
            const bf16x8 bf = *(LAS const bf16x8*)(sb + d0 * 2048), a0 = *(LAS const bf16x8*)(sa + d0 * 2048), a1 = *(LAS const bf16x8*)(sa + d0 * 2048 + 512);
            hT[0] = __builtin_amdgcn_mfma_f32_32x32x16_bf16(bf, a0, hT[0], 0, 0, 0);
            hT[1] = __builtin_amdgcn_mfma_f32_32x32x16_bf16(bf, a1, hT[1], 0, 0, 0);
        }
        P2_WAIT_BAR();
    }
    const float* bias1 = (const float*)(ws + WS_SMALL + SM_BIAS1) + kv * 256 + ncol0;
    bf16x8 hb[2][2];
#pragma unroll
    for (int mt = 0; mt < 2; ++mt) {
        float g[16];
#pragma unroll
        for (int r = 0; r < 16; ++r) g[r] = gelu_tanh(hT[mt][r] + bias1[crow(r, hi)]);
#pragma unroll
        for (int s = 0; s < 2; ++s) { u32x4_t w; w.x = cvtpk_s(g[8 * s], g[8 * s + 1]); w.y = cvtpk_s(g[8 * s + 2], g[8 * s + 3]); w.z = cvtpk_s(g[8 * s + 4], g[8 * s + 5]); w.w = cvtpk_s(g[8 * s + 6], g[8 * s + 7]);
            hb[mt][s] = __builtin_bit_cast(bf16x8, w); }
    }
    const bf16_t* w2t = (const bf16_t*)(ws + WS_SMALL + SM_W2T) + (size_t)kv * 64 * 256;
    f32x16 oT[2][2];
#pragma unroll
    for (int dt = 0; dt < 2; ++dt)
#pragma unroll
        for (int mt = 0; mt < 2; ++mt) oT[dt][mt] = f32x16{};
#pragma unroll
    for (int dt = 0; dt < 2; ++dt)
#pragma unroll
        for (int s = 0; s < 2; ++s) {
            const bf16_t* wp = w2t + (size_t)(32 * dt + r32) * 256 + ncol0 + 16 * s + 4 * hi;
            const u32x2_t lo = *(const u32x2_t*)wp, hi2 = *(const u32x2_t*)(wp + 8);
            const u32x4_t wv = {lo.x, lo.y, hi2.x, hi2.y}; const bf16x8 wf = __builtin_bit_cast(bf16x8, wv);
#pragma unroll
            for (int mt = 0; mt < 2; ++mt) oT[dt][mt] = __builtin_amdgcn_mfma_f32_32x32x16_bf16(wf, hb[mt][s], oT[dt][mt], 0, 0, 0);
        }
    LAS float* part = (LAS float*)lds + wid * 64 * CP_STRIDE;
#pragma unroll
    for (int dt = 0; dt < 2; ++dt)
#pragma unroll
        for (int mt = 0; mt < 2; ++mt)
#pragma unroll
            for (int r = 0; r < 16; ++r) part[(32 * mt + r32) * CP_STRIDE + 32 * dt + crow(r, hi)] = oT[dt][mt][r];
    P2_WAIT_BAR();
    {
        const int tid = wid * 64 + lane, m = tid >> 3, dg = tid & 7;
        float o[8];
#pragma unroll
        for (int e = 0; e < 8; ++e) { float s = 0.f;
#pragma unroll
            for (int w = 0; w < 8; ++w) s += ((LAS const float*)lds)[(w * 64 + m) * CP_STRIDE + 8 * dg + e];
            o[e] = s; }
        if (kv == 0) {
            float ss = 0.f;
#pragma unroll
            for (int e = 0; e < 8; ++e) ss += o[e] * o[e];
            ss += __shfl_xor(ss, 1); ss += __shfl_xor(ss, 2); ss += __shfl_xor(ss, 4);
            const float rr = __builtin_amdgcn_rsqf(ss * (1.0f / 64.0f) + 1e-6f);
#pragma unroll
            for (int e = 0; e < 8; ++e) o[e] *= rr * P.in[4][8 * dg + e];
        }
        const int n = n0 + m;
        u32x4_t v = {0u, 0u, 0u, 0u};
        if (n < 255) { v.x = cvtpk_s(o[0], o[1]); v.y = cvtpk_s(o[2], o[3]); v.z = cvtpk_s(o[4], o[5]); v.w = cvtpk_s(o[6], o[7]); }
        *(u32x4_t*)((bf16_t*)(ws + (kv ? WS_VC : WS_KC)) + ((size_t)bg * 256 + n) * 64 + 8 * dg) = v;
    }
    P2_WAIT_BAR();
#undef P2_DMA_TILE
}

constexpr int G_V = 0, G_ST = 32768, G_OST = 33792, G_END = 33792 + 65536;
__device__ __forceinline__ void gmlp_unit(const Ptrs& P, LAS unsigned char* lds, int unit, const int wave_s) {
    unsigned char* ws = P.ws;
    const int lane = fresh_lane(), r32 = lane & 31, hi = lane >> 5, wid = wave_s, tid = wid * 64 + lane;
    const int g = unit & 7, chunk = (unit >> 3) & 31, b = unit >> 8; const int m0 = b * SEQ + chunk * 128;
    const bf16_t* GV = (const bf16_t*)(ws + WS_GV); const bf16_t* U = (const bf16_t*)(ws + WS_U); const float* VSTAT = (const float*)(ws + WS_VSTAT);
    const bf16_t* SWB = (const bf16_t*)(ws + WS_SMALL + SM_SWB) + (size_t)g * 16384;
    bf16_t* AB = (bf16_t*)(ws + WS_AB);
    const float* ln_w = P.in[8]; const float* ln_b = P.in[9]; const float* sbp = P.in[11];
    LAS float* st = (LAS float*)(lds + G_ST);
    if (tid < 128) { const float* p = VSTAT + (size_t)(m0 + tid) * 32; float s1 = 0.f, s2 = 0.f;
#pragma unroll
        for (int i = 0; i < 16; ++i) { s1 += p[2 * i]; s2 += p[2 * i + 1]; }
        const float mean = s1 * (1.0f / 1024.0f); float var = s2 * (1.0f / 1024.0f) - mean * mean; var = var < 0.f ? 0.f : var;
        st[2 * tid] = mean; st[2 * tid + 1] = __builtin_amdgcn_rsqf(var + 1e-5f); }
    P2_WAIT_BAR();
#pragma unroll
    for (int i = 0; i < 4; ++i) { const int idx = tid + 512 * i, s = idx >> 4, c8 = idx & 15;
        const u32x4_t raw = *(const u32x4_t*)(GV + (size_t)(m0 + s) * 1024 + g * 128 + 8 * c8); float f[8]; unpack8(raw, f);
        const float mean = st[2 * s], rstd = st[2 * s + 1];
        const f32x4_t w0 = *(const f32x4_t*)(ln_w + g * 128 + 8 * c8), w1 = *(const f32x4_t*)(ln_w + g * 128 + 8 * c8 + 4), b0 = *(const f32x4_t*)(ln_b + g * 128 + 8 * c8), b1 = *(const f32x4_t*)(ln_b + g * 128 + 8 * c8 + 4);
        float y[8];
#pragma unroll
        for (int e = 0; e < 4; ++e) { y[e] = (f[e] - mean) * rstd * w0[e] + b0[e]; y[4 + e] = (f[4 + e] - mean) * rstd * w1[e] + b1[e]; }
        u32x4_t o; o.x = cvtpk_s(y[0], y[1]); o.y = cvtpk_s(y[2], y[3]); o.z = cvtpk_s(y[4], y[5]); o.w = cvtpk_s(y[6], y[7]);
        const int st_ = s >> 6, sk = s & 63, ch = c8 >> 3, x = c8 & 7;
        *(LAS u32x4_t*)(lds + G_V + (st_ * 2 + ch) * 8192 + (x >> 2) * 4096 + (sk >> 4) * 1024 + (sk & 15) * 64 + (x & 3) * 16) = o; }
    P2_WAIT_BAR();
    const int tb = wid >> 1, ch = wid & 1;
    f32x16 o[2]; o[0] = f32x16{}; o[1] = f32x16{};
    const int vb0 = (int)((unsigned)(uintptr_t)lds + G_V) + ((lane >> 4) & 1) * 32 + (lane & 3) * 8 + (4 * hi + ((lane & 15) >> 2)) * 64;
    const int nst = tb >= 2 ? 2 : 1;
    for (int st_ = 0; st_ < nst; ++st_) {
        bf16x8 pa[4];
#pragma unroll
        for (int ks = 0; ks < 4; ++ks) {
            const bf16_t* wp = SWB + (size_t)(32 * tb + r32) * 128 + 64 * st_ + 16 * ks + 4 * hi;
            const u32x2_t lo = *(const u32x2_t*)wp, hi2 = *(const u32x2_t*)(wp + 8);
            const u32x4_t wv = {lo.x, lo.y, hi2.x, hi2.y}; pa[ks] = __builtin_bit_cast(bf16x8, wv); }
        nsa::pv(o, vb0 + (st_ * 2 + ch) * 8192, pa[0], pa[1], pa[2], pa[3]);
    }
    LAS float* ostg = (LAS float*)(lds + G_OST) + wid * 2048;
#pragma unroll
    for (int r = 0; r < 16; ++r) { const int orow = crow(r, hi);
#pragma unroll
        for (int d0 = 0; d0 < 2; ++d0) ostg[orow * 64 + d0 * 32 + r32] = o[d0][r]; }
    asm volatile("s_waitcnt lgkmcnt(0)" ::: "memory");
#pragma unroll
    for (int i = 0; i < 4; ++i) { const int row = i * 8 + (lane >> 3), c8 = lane & 7, t = 32 * tb + row;
        const f32x4_t v0 = *(LAS const f32x4_t*)(ostg + row * 64 + c8 * 8), v1 = *(LAS const f32x4_t*)(ostg + row * 64 + c8 * 8 + 4);
        const size_t grow = (size_t)(m0 + t); const int col = g * 128 + 64 * ch + 8 * c8;
        float uf[8]; unpack8(*(const u32x4_t*)(U + grow * 1024 + col), uf);
        const float sbv = sbp[g * 128 + t];
        u32x4_t w; w.x = cvtpk_s(uf[0] * (v0[0] + sbv), uf[1] * (v0[1] + sbv)); w.y = cvtpk_s(uf[2] * (v0[2] + sbv), uf[3] * (v0[3] + sbv));
        w.z = cvtpk_s(uf[4] * (v1[0] + sbv), uf[5] * (v1[1] + sbv)); w.w = cvtpk_s(uf[6] * (v1[2] + sbv), uf[7] * (v1[3] + sbv));
        *(u32x4_t*)(AB + grow * 2048 + 1024 + col) = w; }
    P2_WAIT_BAR();
}
#undef P2_WAIT_BAR
}

#define XB_TMO      128
#define XB_XCNT(j)  (256  + 64 * (j))
#define XB_XSUB(j)  (1280 + 64 * (j))
#define XB_XGEN(j)  (2304 + 64 * (j))
#define XB_TOP      3328
#define XB_TOPGEN   3392
#define XCD_BAR_WORDS 3456
#define XB_SPIN_CAP (1u << 18)

__device__ __forceinline__ unsigned xb_ld(unsigned* p)              { return __hip_atomic_load(p, __ATOMIC_RELAXED, __HIP_MEMORY_SCOPE_AGENT); }
__device__ __forceinline__ unsigned xb_add(unsigned* p, unsigned v) { return __hip_atomic_fetch_add(p, v, __ATOMIC_RELAXED, __HIP_MEMORY_SCOPE_AGENT); }
__device__ __forceinline__ unsigned xb_xcc_id() { return (unsigned)__builtin_amdgcn_s_getreg((3 << 11) | 20) & 0xFu; }
#define XB_SPIN(cond, bar) do { unsigned _sp = 0; while (cond) { __builtin_amdgcn_s_sleep(1); \
    if ((++_sp & 255u) == 0u) { if (xb_ld(&(bar)[XB_TMO])) break; if (_sp > XB_SPIN_CAP) { atomicAdd(&(bar)[XB_TMO], 1u); break; } } } } while (0)

struct XcdBarrier {
    unsigned* bar; unsigned x; unsigned w0;
    volatile LAS unsigned* st;
};

__device__ __forceinline__ XcdBarrier xcd_barrier_post(unsigned* bar, volatile LAS unsigned* st, int wave_s) {
    XcdBarrier b; b.bar = bar; b.x = xb_xcc_id(); b.st = st; b.w0 = wave_s == 0 ? 1u : 0u;
    if (b.w0 && fresh_lane() == 0) (void)xb_add(&bar[XB_XCNT(b.x)], 1u);
    return b;
}
__device__ __forceinline__ void xcd_barrier_complete(unsigned* bar, unsigned x, unsigned& nloc, unsigned& nx) {
    const unsigned G = gridDim.x * gridDim.y * gridDim.z;
    unsigned sum, cnt, mine, sp = 0u;
    for (;;) {
        sum = 0u; cnt = 0u; mine = 0u;
#pragma unroll
        for (unsigned j = 0; j < 16; ++j) { const unsigned c = xb_ld(&bar[XB_XCNT(j)]); sum += c; cnt += (c > 0u) ? 1u : 0u; mine = (j == x) ? c : mine; }
        if (sum == G) break;
        __builtin_amdgcn_s_sleep(1);
        if ((++sp & 255u) == 0u) { if (xb_ld(&bar[XB_TMO])) break; if (sp > XB_SPIN_CAP) { atomicAdd(&bar[XB_TMO], 1u); break; } }
    }
    nloc = mine > 0u ? mine : 1u; nx = cnt > 0u ? cnt : 1u;
}

__device__ __forceinline__ void xcd_barrier(const XcdBarrier& b) {
    asm volatile("s_waitcnt vmcnt(0)" ::: "memory");
    __syncthreads();
    if (b.w0 && fresh_lane() == 0) {
        unsigned* bar = b.bar;
        __builtin_amdgcn_s_waitcnt(0);
        unsigned nloc = b.st[0], nx = b.st[1];
        if (nloc == 0u) { xcd_barrier_complete(bar, b.x, nloc, nx); b.st[0] = nloc; b.st[1] = nx; }
        const unsigned old = xb_add(&bar[XB_XSUB(b.x)], 1u);
        const unsigned gen = old / nloc;
        if (old + 1u == (gen + 1u) * nloc) {
            __builtin_amdgcn_fence(__ATOMIC_RELEASE, "agent");
            asm volatile("s_waitcnt vmcnt(0)" ::: "memory");
            const unsigned og = xb_add(&bar[XB_TOP], 1u);
            const unsigned tg = og / nx;
            if (og + 1u == (tg + 1u) * nx) xb_add(&bar[XB_TOPGEN], 1u);
            else XB_SPIN(xb_ld(&bar[XB_TOPGEN]) == tg, bar);
            __builtin_amdgcn_fence(__ATOMIC_ACQUIRE, "agent");
            xb_add(&bar[XB_XGEN(b.x)], 1u);
            asm volatile("s_waitcnt vmcnt(0)" ::: "memory");
        } else {
            XB_SPIN(xb_ld(&bar[XB_XGEN(b.x)]) == gen, bar);
            __builtin_amdgcn_fence(__ATOMIC_ACQUIRE, "agent");
            asm volatile("s_waitcnt vmcnt(0)" ::: "memory");
        }
    }
    __syncthreads();
}

constexpr int LDS_BYTES = 147456;
constexpr int LDS_XCH = 132096;
constexpr int LDS_MISC = 145408;
__global__ void __launch_bounds__(512, 2) mega_fwd(Ptrs P) {
    extern __shared__ __attribute__((aligned(16))) unsigned char lds_raw[];
    LAS unsigned char* lds = (LAS unsigned char*)lds_raw;
    unsigned char* ws = P.ws;
    const int wave = __builtin_amdgcn_readfirstlane(threadIdx.x >> 6);
    const int G = gridDim.x, bid = blockIdx.x;
    if (wave == 0) { const int l_ = fresh_lane(); if (l_ < 2) ((LAS unsigned*)(lds + LDS_MISC))[l_] = 0u; }
    __syncthreads();
    const XcdBarrier bar = xcd_barrier_post((unsigned*)(ws + WS_CTL), (volatile LAS unsigned*)(lds + LDS_MISC), wave);
    p0_prologue(P, lds, bid, G, wave);
    xcd_barrier(bar);
    if (bid == 0) bias1_stage(ws, fresh_tid(wave));
    {
        pg8::Gemm g{(const bf16_t*)(ws + WS_XN), (const bf16_t*)(ws + WS_WIN), MTOK, NPROJ, 2048, 2048};
        pg8::StaticOrder S; S.init(MTOK, NPROJ, G, bid);
        pg8::EpiProj E{(bf16_t*)(ws + WS_Q), (bf16_t*)(ws + WS_KV6), (bf16_t*)(ws + WS_U), (bf16_t*)(ws + WS_GV), (float*)(ws + WS_GATES), (float*)(ws + WS_VSTAT), P.in[3], P.in[4]};
        pg8::gemm_phase<pg8::EpiProj, pg8::StaticOrder, true, true>(lds, g, S, E, wave);
    }
    xcd_barrier(bar);
    if (bid < 128 && G >= 256) p2::compress_unit(P, lds, bid, wave);
    else if (G >= 256) { for (int u = bid - 128; u < 1024; u += G - 128) p2::gmlp_unit(P, lds, u, wave); }
    xcd_barrier(bar);
    nsa::nsa_phase(P, lds, bid, G, wave);
    xcd_barrier(bar);
    {
        pg8::Gemm g{(const bf16_t*)(ws + WS_AB), (const bf16_t*)(ws + WS_WOUT), MTOK, 2048, 2048, 2048};
        pg8::StaticOrder S; S.init(MTOK, 2048, G, bid);
        pg8::EpiRes1 E{P.in[0], P.out, (bf16_t*)(ws + WS_XN), (float*)(ws + WS_SSQ)};
        pg8::gemm_phase<pg8::EpiRes1, pg8::StaticOrder, true, true>(lds, g, S, E, wave);
    }
    xcd_barrier(bar);
    for (int m = bid * 512 + fresh_tid(wave); m < MTOK; m += G * 512) {
        const float* p = (const float*)(ws + WS_SSQ) + (size_t)m * 32; float s = 0.f;
#pragma unroll
        for (int i = 0; i < 32; ++i) s += p[i];
        ((float*)(ws + WS_SMALL + SM_R2))[m] = __builtin_amdgcn_rsqf(s * (1.0f / D_MODEL) + 1e-6f);
    }
    xcd_barrier(bar);
    {
        pg8::Gemm g{(const bf16_t*)(ws + WS_XN), (const bf16_t*)(ws + WS_WUP), MTOK, N_UP, 2048, 2048};
        pg8::StaticOrder S; S.init(MTOK, N_UP, G, bid);
        pg8::EpiUpConv E{(bf16_t*)(ws + WS_G), (const float*)(ws + WS_SMALL + SM_R2), P.in[15], P.in[16], (float*)(ws + WS_HLAST), (float*)(ws + WS_FIRST), lds + LDS_XCH};
        pg8::gemm_phase<pg8::EpiUpConv, pg8::StaticOrder, true, true>(lds, g, S, E, wave);
    }
    xcd_barrier(bar);
    for (int it = bid * 512 + fresh_tid(wave); it < 60 * 44 * 2 * 16; it += G * 512) {
        const int c8 = it & 15, row = (it >> 4) & 1, tl_ = it >> 5, pn = tl_ % 44, pmi = tl_ / 44, pm = pmi + pmi / 15 + 1;
        const float* cw = P.in[15]; const float* cb = P.in[16]; (void)cb;
        const float* fp = (const float*)(ws + WS_FIRST) + ((size_t)(pm * 44 + pn) * 2 + row) * 256 + 8 * c8;
        const float* lp = (const float*)(ws + WS_HLAST) + ((size_t)((pm - 1) * 44 + pn) * 2) * 256 + 8 * c8;
        const int ch = pn * 128 + 8 * c8;
        float r[8];
#pragma unroll
        for (int e = 0; e < 8; ++e) {
            const float l0g = lp[e], l1g = lp[256 + e], l0u = lp[128 + e], l1u = lp[256 + 128 + e];
            const float w0g = cw[ch + e], w1g = cw[N_UP + ch + e], w0u = cw[D_FF + ch + e], w1u = cw[N_UP + D_FF + ch + e];
            const float cg = fp[e] + (row == 0 ? w1g * l1g + w0g * l0g : w0g * l1g), cu = fp[128 + e] + (row == 0 ? w1u * l1u + w0u * l0u : w0u * l1u);
            r[e] = cg * sigmoidf_(cg) * cu;
        }
        u32x4_t o; o.x = pk2(r[0], r[1]); o.y = pk2(r[2], r[3]); o.z = pk2(r[4], r[5]); o.w = pk2(r[6], r[7]);
        *(u32x4_t*)((bf16_t*)(ws + WS_G) + (size_t)(pm * 256 + row) * D_FF + ch) = o;
    }
    xcd_barrier(bar);
    {
        pg8::Gemm g{(const bf16_t*)(ws + WS_G), (const bf16_t*)(ws + WS_WDOWN), MTOK, 2048, D_FF, D_FF};
        pg8::StaticOrder S; S.init(MTOK, 2048, G, bid);
        pg8::EpiDown E{P.out, (const bf16_t*)(ws + WS_XN)};
        pg8::gemm_phase<pg8::EpiDown, pg8::StaticOrder, true, true>(lds, g, S, E, wave);
    }
}

extern "C" void kernel_launch(void* const* d_in, const int* in_sizes, int n_in, void* d_out, int out_size, void* d_ws, size_t ws_size, hipStream_t stream) {
    static int grid_blocks = 0;
    if (!grid_blocks) {
        int dev = 0, cus = 0, per_cu = 0;
        (void)hipGetDevice(&dev);
        (void)hipDeviceGetAttribute(&cus, hipDeviceAttributeMultiprocessorCount, dev);
        (void)hipFuncSetAttribute((const void*)mega_fwd, hipFuncAttributeMaxDynamicSharedMemorySize, LDS_BYTES);
        (void)hipOccupancyMaxActiveBlocksPerMultiprocessor(&per_cu, (const void*)mega_fwd, 512, LDS_BYTES);
        if (per_cu < 1) { fprintf(stderr, "kernel_launch: occupancy query says %d blocks/CU\n", per_cu); per_cu = 1; }
        grid_blocks = cus * 1;
        (void)hipGetLastError();
    }
    if (n_in != 18 || ws_size < WS_END) { fprintf(stderr, "kernel_launch: unexpected n_in %d / ws %zu\n", n_in, ws_size); return; }
    Ptrs P{};
    for (int i = 0; i < 18; ++i) P.in[i] = (const float*)d_in[i];
    P.out = (float*)d_out; P.ws = (unsigned char*)d_ws;
    (void)hipMemsetAsync((char*)d_ws + WS_CTL, 0, 16384, stream);
    mega_fwd<<<dim3(grid_blocks), dim3(512), LDS_BYTES, stream>>>(P);
}
```

```cpp
#include <hip/hip_runtime.h>
#include <cstdio>
#include <cstdint>

constexpr int D_MODEL = 2048, BATCH = 4, SEQ = 4096, MTOK = BATCH * SEQ;
constexpr int IN_COLS = 4656, NPROJ = 4864;
constexpr int D_FF = 5632, N_UP = 2 * D_FF;
constexpr int NBG = 16;
constexpr size_t KVSZ = (size_t)NBG * SEQ * 64;
constexpr float LOG2E = 1.4426950408889634f;

constexpr size_t MiB = 1u << 20;
constexpr size_t WS_CTL = 0;
constexpr size_t WS_WIN = 1 * MiB, WS_WOUT = 20 * MiB, WS_WUP = 28 * MiB, WS_WDOWN = 72 * MiB, WS_W1C = 94 * MiB;
constexpr size_t WS_SMALL = 96 * MiB;
constexpr size_t SM_BIASP = 0, SM_BIAS1 = 65536, SM_R2 = 131072, SM_W2T = 196608  , SM_SWB = 262144  ;
constexpr size_t WS_XN = 97 * MiB;
constexpr size_t WS_Q = 161 * MiB;
constexpr size_t WS_KV6 = 193 * MiB;
constexpr size_t WS_U = 241 * MiB, WS_GV = 273 * MiB;
constexpr size_t WS_GATES = 305 * MiB;
constexpr size_t WS_VSTAT = 308 * MiB;
constexpr size_t WS_KC = 310 * MiB, WS_VC = 310 * MiB + 524288;
constexpr size_t WS_HC = 311 * MiB;
constexpr size_t WS_AB = 315 * MiB;
constexpr size_t WS_SSQ = 379 * MiB;
constexpr size_t WS_G = 161 * MiB;
constexpr size_t WS_HID = 381 * MiB;
constexpr size_t WS_HLAST = 381 * MiB, WS_FIRST = 388 * MiB;
constexpr size_t WS_END = 469 * MiB;

#define LAS __attribute__((address_space(3)))
typedef unsigned short bf16_t;
typedef unsigned u32x4_t __attribute__((ext_vector_type(4)));
typedef unsigned u32x2_t __attribute__((ext_vector_type(2)));
typedef float f32x4_t __attribute__((ext_vector_type(4)));

__device__ __forceinline__ float bf2f(unsigned short h) { return __uint_as_float(((unsigned)h) << 16); }
__device__ __forceinline__ unsigned f2bf(float f) { unsigned u = __float_as_uint(f); return (u + 0x7fffu + ((u >> 16) & 1u)) >> 16; }
__device__ __forceinline__ unsigned pk2(float lo, float hi) { return f2bf(lo) | (f2bf(hi) << 16); }
__device__ __forceinline__ float gelu_tanh(float x) {
    const float u = 0.7978845608028654f * (x + 0.044715f * x * x * x);
    const float e = __builtin_amdgcn_exp2f(-2.8853900817779268f * u);
    return x * __builtin_amdgcn_rcpf(1.0f + e);
}
__device__ __forceinline__ float sigmoidf_(float x) { return __builtin_amdgcn_rcpf(1.0f + __builtin_amdgcn_exp2f(-LOG2E * x)); }
__device__ __forceinline__ float wave_sum(float v) {
#pragma unroll
    for (int o = 1; o < 64; o <<= 1) v += __shfl_xor(v, o);
    return v;
}
__device__ __forceinline__ void unpack8(u32x4_t r, float (&f)[8]) {
    f[0] = __uint_as_float(r.x << 16); f[1] = __uint_as_float(r.x & 0xffff0000u);
    f[2] = __uint_as_float(r.y << 16); f[3] = __uint_as_float(r.y & 0xffff0000u);
    f[4] = __uint_as_float(r.z << 16); f[5] = __uint_as_float(r.z & 0xffff0000u);
    f[6] = __uint_as_float(r.w << 16); f[7] = __uint_as_float(r.w & 0xffff0000u);
}

__device__ __forceinline__ int fresh_lane() { unsigned z_ = 0u; asm volatile("" : "+v"(z_)); return (int)__builtin_amdgcn_mbcnt_hi(~0u, __builtin_amdgcn_mbcnt_lo(~0u, z_)); }
__device__ __forceinline__ int fresh_tid(int wave_s) { return wave_s * 64 + fresh_lane(); }
namespace pg8 {
#define PG8_LAS __attribute__((address_space(3)))
typedef unsigned short bf16_t;
typedef short bf16x8 __attribute__((ext_vector_type(8)));
typedef float f32x4 __attribute__((ext_vector_type(4)));
typedef unsigned u32x4 __attribute__((ext_vector_type(4)));
constexpr int BM = 256, BK = 64, HALF = 128, HTB = HALF * BK * 2  , STAGE_BYTES = 8 * HTB, NXCD = 8, WGM = 8;

__host__ __device__ __forceinline__ int lds_byte(int r, int c) { const int st = (r >> 4) * 2 + (c >> 5), rr = r & 15, cc = c & 31, ob = rr * 64 + cc * 2; return st * 1024 + (ob ^ (((ob >> 9) & 1) << 5)); }
__host__ __device__ __forceinline__ void stage_rc(int b, int& R, int& C) { const int st = b / 1024, sb = b % 1024, swz = sb ^ (((sb >> 9) & 1) << 5); R = (st >> 1) * 16 + swz / 64; C = (st & 1) * 32 + (swz % 64) / 2; }
__host__ __device__ __forceinline__ int perm32(int rho) { const int n = rho >> 4, i = rho & 15; return 8 * (i >> 2) + 4 * n + (i & 3); }

struct Unit { int pm, pn; };
struct Gemm { const bf16_t* A; const bf16_t* Bt; int M, N, K, lda; };

struct StaticOrder {
    int nM, nN, nwg, G, c;
    __host__ __device__ void init(int M, int N, int G_, int c_) { nM = M / BM; nN = N / BM; nwg = nM * nN; G = G_; c = c_; }
    __host__ __device__ bool next(int i, Unit& u) const {
        const long L = (long)i * G + c; if (L >= nwg) return false;
        int wgid = (int)L; { const int q = nwg / NXCD, r = nwg % NXCD, xcd = wgid % NXCD, off = wgid / NXCD; wgid = (xcd < r ? xcd * (q + 1) : r * (q + 1) + (xcd - r) * q) + off; }
        const int nig = WGM * nN, gid = wgid / nig, fm = gid * WGM, gsz = (nM - fm) < WGM ? (nM - fm) : WGM;
        u.pm = fm + ((wgid % nig) % gsz); u.pn = (wgid % nig) / gsz; return true;
    }
    __device__ __forceinline__ void a_ready(const Unit&) const {}
    __device__ __forceinline__ void done(const Unit&) const {}
};

__device__ __forceinline__ unsigned cvt_pk_bf16(float lo, float hi) { unsigned r; asm volatile("v_cvt_pk_bf16_f32 %0, %1, %2" : "=v"(r) : "v"(lo), "v"(hi)); return r; }

struct EpiProj {
    static constexpr bool PERM = true, AFTER_DRAIN = false;
    bf16_t* Q; bf16_t* KV6; bf16_t* U; bf16_t* GV; float* GATES; float* VSTAT; const float* q_norm_w; const float* k_norm_w;
    __device__ __forceinline__ void operator()(const f32x4 (&acc)[2][2][4][2], const Unit& u, int wr, int wc, int fr, int fq) const {
        const int pn = u.pn, row0 = u.pm * BM + wr * 64 + fr;
        if (pn < 10) {
            const bool normed = (pn < 4) || pn == 6 || pn == 8;
            const float* w = pn < 4 ? q_norm_w : (k_norm_w + (pn == 6 ? 64 : 128));
            const float sc = pn < 4 ? 0.125f * LOG2E : 1.0f;
            f32x4 wv[2][2];
#pragma unroll
            for (int bj = 0; bj < 2; ++bj)
#pragma unroll
                for (int n = 0; n < 2; ++n) wv[bj][n] = normed ? (*(const f32x4*)(w + 32 * bj + 8 * fq + 4 * n)) * sc : (f32x4){1.f, 1.f, 1.f, 1.f};
#pragma unroll
            for (int ai = 0; ai < 2; ++ai)
#pragma unroll
                for (int m = 0; m < 4; ++m) {
                    const int row = row0 + ai * HALF + m * 16;
                    float r = 1.f;
                    if (normed) {
                        float ss = 0.f;
#pragma unroll
                        for (int bj = 0; bj < 2; ++bj)
#pragma unroll
                            for (int n = 0; n < 2; ++n) { const f32x4 x = acc[ai][bj][m][n]; ss += (x[0] * x[0] + x[1] * x[1]) + (x[2] * x[2] + x[3] * x[3]); }
                        ss += __shfl_xor(ss, 16); ss += __shfl_xor(ss, 32);
                        r = __builtin_amdgcn_rsqf(ss * (1.0f / 64.0f) + 1e-6f);
                    }
                    bf16_t* dst;
                    if (pn < 4) dst = Q + (size_t)row * 1024 + pn * 256 + wc * 64 + 8 * fq;
                    else { const int b = row >> 12, t = row & 4095; dst = KV6 + (size_t)(pn - 4) * KVSZ + ((size_t)((b * 4 + wc) * 4096 + t)) * 64 + 8 * fq; }
#pragma unroll
                    for (int bj = 0; bj < 2; ++bj) {
                        const f32x4 v0 = acc[ai][bj][m][0] * r * wv[bj][0], v1 = acc[ai][bj][m][1] * r * wv[bj][1];
                        u32x4 o; o.x = cvt_pk_bf16(v0[0], v0[1]); o.y = cvt_pk_bf16(v0[2], v0[3]); o.z = cvt_pk_bf16(v1[0], v1[1]); o.w = cvt_pk_bf16(v1[2], v1[3]);
                        *(u32x4*)(dst + 32 * bj) = o;
                    }
                }
        } else if (pn < 18) {
            const bool isv = pn >= 14; const int ct = isv ? pn - 14 : pn - 10;
            bf16_t* base = (isv ? GV : U) + ct * 256 + wc * 64 + 8 * fq;
#pragma unroll
            for (int ai = 0; ai < 2; ++ai)
#pragma unroll
                for (int m = 0; m < 4; ++m) {
                    const int row = row0 + ai * HALF + m * 16; float s1 = 0.f, s2 = 0.f;
#pragma unroll
                    for (int bj = 0; bj < 2; ++bj) {
                        f32x4 v0 = acc[ai][bj][m][0], v1 = acc[ai][bj][m][1];
#pragma unroll
                        for (int e = 0; e < 4; ++e) { v0[e] = gelu_tanh(v0[e]); v1[e] = gelu_tanh(v1[e]); s1 += v0[e] + v1[e]; s2 += v0[e] * v0[e] + v1[e] * v1[e]; }
                        u32x4 o; o.x = cvt_pk_bf16(v0[0], v0[1]); o.y = cvt_pk_bf16(v0[2], v0[3]); o.z = cvt_pk_bf16(v1[0], v1[1]); o.w = cvt_pk_bf16(v1[2], v1[3]);
                        *(u32x4*)(base + (size_t)row * 1024 + 32 * bj) = o;
                    }
                    if (isv) {
                        s1 += __shfl_xor(s1, 16); s1 += __shfl_xor(s1, 32); s2 += __shfl_xor(s2, 16); s2 += __shfl_xor(s2, 32);
                        if (fq == 0) { float* p = VSTAT + ((size_t)row * 16 + ct * 4 + wc) * 2; p[0] = s1; p[1] = s2; }
                    }
                }
        } else {
            if (wc == 0) {
#pragma unroll
                for (int ai = 0; ai < 2; ++ai)
#pragma unroll
                    for (int m = 0; m < 4; ++m) {
                        const int row = row0 + ai * HALF + m * 16;
#pragma unroll
                        for (int bj = 0; bj < 2; ++bj)
#pragma unroll
                            for (int n = 0; n < 2; ++n) {
                                const int L = 32 * bj + 8 * fq + 4 * n;
                                if (L < 48) { f32x4 v = acc[ai][bj][m][n]; f32x4 o; o[0] = sigmoidf_(v[0]); o[1] = sigmoidf_(v[1]); o[2] = sigmoidf_(v[2]); o[3] = sigmoidf_(v[3]); *(f32x4*)(GATES + (size_t)row * 48 + L) = o; }
                            }
                    }
            }
        }
    }
};
struct EpiCmp {
    static constexpr bool PERM = true, AFTER_DRAIN = false;
    bf16_t* HC; const float* bias1;
    __device__ __forceinline__ void operator()(const f32x4 (&acc)[2][2][4][2], const Unit& u, int wr, int wc, int fr, int fq) const {
        const int row0 = u.pm * BM + wr * 64 + fr, col0 = wc * 32 + 8 * fq;
        f32x4 bv[2][2];
#pragma unroll
        for (int bj = 0; bj < 2; ++bj)
#pragma unroll
            for (int n = 0; n < 2; ++n) bv[bj][n] = *(const f32x4*)(bias1 + u.pn * 256 + col0 + bj * HALF + 4 * n);
#pragma unroll
        for (int ai = 0; ai < 2; ++ai)
#pragma unroll
            for (int m = 0; m < 4; ++m) { bf16_t* rowp = HC + (size_t)(row0 + ai * HALF + m * 16) * 256 + col0;
#pragma unroll
                for (int bj = 0; bj < 2; ++bj) { f32x4 v0 = acc[ai][bj][m][0] + bv[bj][0], v1 = acc[ai][bj][m][1] + bv[bj][1];
#pragma unroll
                    for (int e = 0; e < 4; ++e) { v0[e] = gelu_tanh(v0[e]); v1[e] = gelu_tanh(v1[e]); }
                    u32x4 o; o.x = cvt_pk_bf16(v0[0], v0[1]); o.y = cvt_pk_bf16(v0[2], v0[3]); o.z = cvt_pk_bf16(v1[0], v1[1]); o.w = cvt_pk_bf16(v1[2], v1[3]);
                    *(u32x4*)(rowp + bj * HALF) = o; } }
    }
};
struct CmpOrder {
    int c, G;
    __device__ bool next(int i, Unit& u) const { const int L = i * G + c; if (L >= 32) return false; u.pm = L; u.pn = L >> 4; return true; }
    __device__ __forceinline__ void a_ready(const Unit&) const {}
    __device__ __forceinline__ void done(const Unit&) const {}
};
struct EpiRes1 {
    static constexpr bool PERM = false, AFTER_DRAIN = false;
    const float* x; float* out; bf16_t* X1b; float* SSQ;
    __device__ __forceinline__ void operator()(const f32x4 (&acc)[2][2][4][2], const Unit& u, int wr, int wc, int fr, int fq) const {
        const int row0 = u.pm * BM + wr * 64 + fr, col0 = u.pn * BM + wc * 32 + 4 * fq;
#pragma unroll
        for (int ai = 0; ai < 2; ++ai)
#pragma unroll
            for (int m = 0; m < 4; ++m) { const int row = row0 + ai * HALF + m * 16; const size_t off = (size_t)row * D_MODEL + col0; float ss = 0.f;
#pragma unroll
                for (int bj = 0; bj < 2; ++bj)
#pragma unroll
                    for (int n = 0; n < 2; ++n) { const size_t o2 = off + bj * HALF + n * 16; const f32x4 v = *(const f32x4*)(x + o2) + acc[ai][bj][m][n];
                        ss += (v[0] * v[0] + v[1] * v[1]) + (v[2] * v[2] + v[3] * v[3]);
                        u32x2_t w; w.x = cvt_pk_bf16(v[0], v[1]); w.y = cvt_pk_bf16(v[2], v[3]); *(u32x2_t*)(X1b + o2) = w; }
                ss += __shfl_xor(ss, 16); ss += __shfl_xor(ss, 32);
                if (fq == 0) SSQ[(size_t)row * 32 + u.pn * 4 + wc] = ss; }
    }
};
struct EpiUpV1 {
    static constexpr bool PERM = true, AFTER_DRAIN = false;
    bf16_t* HID; const float* R2;
    __device__ __forceinline__ void operator()(const f32x4 (&acc)[2][2][4][2], const Unit& u, int wr, int wc, int fr, int fq) const {
        const int row0 = u.pm * BM + wr * 64 + fr, col0 = u.pn * BM + wc * 32 + 8 * fq;
#pragma unroll
        for (int ai = 0; ai < 2; ++ai)
#pragma unroll
            for (int m = 0; m < 4; ++m) { const int row = row0 + ai * HALF + m * 16; const float r = R2[row]; bf16_t* rowp = HID + (size_t)row * N_UP + col0;
#pragma unroll
                for (int bj = 0; bj < 2; ++bj) { const f32x4 v0 = acc[ai][bj][m][0] * r, v1 = acc[ai][bj][m][1] * r;
                    u32x4 o; o.x = cvt_pk_bf16(v0[0], v0[1]); o.y = cvt_pk_bf16(v0[2], v0[3]); o.z = cvt_pk_bf16(v1[0], v1[1]); o.w = cvt_pk_bf16(v1[2], v1[3]);
                    *(u32x4*)(rowp + bj * HALF) = o; } }
    }
};
struct EpiDown {
    static constexpr bool PERM = false, AFTER_DRAIN = false;
    float* out; const bf16_t* X1b;
    __device__ __forceinline__ void operator()(const f32x4 (&acc)[2][2][4][2], const Unit& u, int wr, int wc, int fr, int fq) const {
        const int row0 = u.pm * BM + wr * 64 + fr, col0 = u.pn * BM + wc * 32 + 4 * fq;
#pragma unroll
        for (int ai = 0; ai < 2; ++ai)
#pragma unroll
            for (int m = 0; m < 4; ++m) { const size_t off = (size_t)(row0 + ai * HALF + m * 16) * D_MODEL + col0;
#pragma unroll
                for (int bj = 0; bj < 2; ++bj)
#pragma unroll
                    for (int n = 0; n < 2; ++n) { const u32x2_t w = *(const u32x2_t*)(X1b + off + bj * HALF + n * 16);
                        f32x4 v; v[0] = __uint_as_float(w.x << 16); v[1] = __uint_as_float(w.x & 0xffff0000u); v[2] = __uint_as_float(w.y << 16); v[3] = __uint_as_float(w.y & 0xffff0000u);
                        *(f32x4*)(out + off + bj * HALF + n * 16) = v + acc[ai][bj][m][n]; } }
    }
};
__device__ __forceinline__ unsigned f2bf_(float f) { unsigned u = __float_as_uint(f); return (u + 0x7fffu + ((u >> 16) & 1u)) >> 16; }
struct EpiUpConv {
    static constexpr bool PERM = true, AFTER_DRAIN = false;
    bf16_t* G; const float* R2; const float* cw; const float* cb; float* HLAST; float* FIRST; PG8_LAS unsigned char* xlds;
    __device__ __forceinline__ void operator()(const f32x4 (&acc)[2][2][4][2], const Unit& u, int wr, int wc, int fr_in, int fq_in) const {
        (void)fr_in; (void)fq_in;
        unsigned z_ = 0u; asm volatile("" : "+v"(z_));
        const int lane_ = (int)__builtin_amdgcn_mbcnt_hi(~0u, __builtin_amdgcn_mbcnt_lo(~0u, z_)); const int fr = lane_ & 15, fq = lane_ >> 4;
        const int row0 = u.pm * BM + wr * 64 + fr;
        PG8_LAS float* X = (PG8_LAS float*)xlds;
        const unsigned tile = (unsigned)(u.pm * (N_UP / 256) + u.pn);
        if (fr >= 14) {
#pragma unroll
            for (int ai = 0; ai < 2; ++ai) { const int sg = 2 * ai + wr; const float r3 = R2[row0 + ai * HALF + 48];
#pragma unroll
                for (int bj = 0; bj < 2; ++bj)
#pragma unroll
                    for (int n = 0; n < 2; ++n) { const f32x4 h = acc[ai][bj][3][n] * r3;
                        *(PG8_LAS f32x4*)(X + ((sg * 4 + wc) * 2 + (fr - 14)) * 64 + bj * 32 + 8 * fq + 4 * n) = h;
                        if (ai == 1 && wr == 1) *(f32x4*)(HLAST + (unsigned)((tile * 2 + (fr - 14)) * 256 + bj * HALF + wc * 32 + 8 * fq + 4 * n)) = h; } }
        }
        PG8_LAS float* R2L = X + 3072;
        PG8_LAS float* Wl = X + 2048;
        { const int t_ = (wr * 4 + wc) * 64 + fq * 16 + fr;
#pragma unroll
          for (int i2 = 0; i2 < 2; ++i2) { const int i = t_ + 512 * i2, k = i >> 8, p = i & 255, c = (p < 128 ? 0 : D_FF - 128) + u.pn * 128 + p;
              Wl[i] = k < 3 ? cw[(unsigned)(k * N_UP + c)] : cb[(unsigned)c]; }
          if (t_ < 256) R2L[t_] = R2[u.pm * BM + t_]; }
        asm volatile("s_waitcnt vmcnt(0) lgkmcnt(0)" ::: "memory"); __builtin_amdgcn_s_barrier(); asm volatile("" ::: "memory");
        const int cbase = u.pn * 128 + wc * 32 + 8 * fq;
        const bool seq_start = (u.pm & 15) == 0;
#pragma unroll
        for (int ai = 0; ai < 2; ++ai) {
            const int sg = 2 * ai + wr;
            float rs[4];
#pragma unroll
            for (int m = 0; m < 4; ++m) rs[m] = R2L[wr * 64 + fr + ai * HALF + m * 16];
            const bool defer = (ai == 0) && (wr == 0) && !seq_start && (fr < 2);
#pragma unroll
            for (int n = 0; n < 2; ++n) {
                unsigned pk[4][2];
#pragma unroll
                for (int e = 0; e < 4; ++e) {
                    asm volatile("" ::: "memory"); __builtin_amdgcn_sched_barrier(0);
                    PG8_LAS const float* wp = Wl + wc * 32 + 8 * fq + 4 * n + e;
                    const float wg0 = wp[0], wg1 = wp[256], wg2 = wp[512], bg = wp[768], wu0 = wp[128], wu1 = wp[384], wu2 = wp[640], bu = wp[896];
                    float hg1 = 0.f, hg2 = 0.f, hu1 = 0.f, hu2 = 0.f;
                    if (ai == 1 || wr == 1) { PG8_LAS const float* xp = X + (((sg - 1) * 4 + wc) * 2) * 64 + 8 * fq + 4 * n + e; hg2 = xp[0]; hg1 = xp[64]; hu2 = xp[32]; hu1 = xp[96]; }
                    float ag = hg1, bgp = fr == 0 ? hg2 : hg1, au = hu1, bup = fr == 0 ? hu2 : hu1;
#pragma unroll
                    for (int m = 0; m < 4; ++m) {
                        const float vg = acc[ai][0][m][n][e] * rs[m], vu = acc[ai][1][m][n][e] * rs[m];
                        const float rg1 = __uint_as_float(__builtin_amdgcn_update_dpp(0u, __float_as_uint(vg), 0x121, 0xf, 0xf, false)), rg2 = __uint_as_float(__builtin_amdgcn_update_dpp(0u, __float_as_uint(vg), 0x122, 0xf, 0xf, false));
                        const float ru1 = __uint_as_float(__builtin_amdgcn_update_dpp(0u, __float_as_uint(vu), 0x121, 0xf, 0xf, false)), ru2 = __uint_as_float(__builtin_amdgcn_update_dpp(0u, __float_as_uint(vu), 0x122, 0xf, 0xf, false));
                        const float pg1 = fr >= 1 ? rg1 : ag, pg2 = fr >= 2 ? rg2 : bgp, pu1 = fr >= 1 ? ru1 : au, pu2 = fr >= 2 ? ru2 : bup;
                        const float cg = bg + wg0 * pg2 + wg1 * pg1 + wg2 * vg, cu = bu + wu0 * pu2 + wu1 * pu1 + wu2 * vu;
                        if (m == 0 && defer) { float* fp = FIRST + (unsigned)((tile * 2 + fr) * 256 + wc * 32 + 8 * fq + 4 * n + e); fp[0] = cg; fp[HALF] = cu; }
                        const unsigned hb = cvt_pk_bf16(cg * sigmoidf_(cg) * cu, 0.f);
                        if ((e & 1) == 0) pk[m][e >> 1] = hb; else pk[m][e >> 1] |= hb << 16;
                        ag = rg1; bgp = rg2; au = ru1; bup = ru2;
                    }
                }
#pragma unroll
                for (int m = 0; m < 4; ++m)
                    if (!(m == 0 && defer)) { u32x2_t o; o.x = pk[m][0]; o.y = pk[m][1]; *(u32x2_t*)(G + (unsigned)((row0 + ai * HALF + m * 16) * D_FF + cbase + 4 * n)) = o; }
            }
        }
    }
};
template <class Epi, class Sched, bool ALIGN_EPI = false, bool SP2 = false>
__device__ __forceinline__ void gemm_phase(PG8_LAS unsigned char* lds, const Gemm g, const Sched& S, const Epi& E, const int wave_s) {
    const int tid = fresh_tid(wave_s), wid = wave_s, lane = tid & 63,
          wr = wid >> 2, wc = wid & 3, fr = lane & 15, fq = lane >> 4;
    const int K = g.K, nt = K / BK;
    unsigned voffA[2], voffB[2];
#pragma unroll
    for (int i = 0; i < 2; ++i) { int R, C; stage_rc(tid * 16 + i * 8192, R, C); const int Rb = Epi::PERM ? ((R & ~31) + perm32(R & 31)) : R;
        voffA[i] = (unsigned)(R * g.lda + C) * 2u; voffB[i] = (unsigned)(Rb * K + C) * 2u; }
    const size_t kstep = (size_t)(BK * 2);
    const size_t hstepA = (size_t)HALF * g.lda * 2, hstepB = (size_t)HALF * K * 2;
    const size_t tstepA = 2 * hstepA, tstepB = 2 * hstepB;
    const unsigned ldsw = (unsigned)wid * 1024u;
    const int aoff = lds_byte(wr * 64 + fr, fq * 8), boff = lds_byte(wc * 32 + fr, fq * 8);
#define PG8_SA(b, h) (((b) * 2 + (h)) * HTB)
#define PG8_SB(b, h) ((4 + (b) * 2 + (h)) * HTB)
#define PG8_STAGE(bufoff, gbase, voff) do { _Pragma("unroll") for (int _i = 0; _i < 2; ++_i) \
        __builtin_amdgcn_global_load_lds((const unsigned*)((const char*)(gbase) + (voff)[_i]), (PG8_LAS unsigned*)(lds + (bufoff) + ldsw + _i * 8192), 16, 0, 0); } while (0)
#define PG8_LDA(dst, b, h) do { _Pragma("unroll") for (int m = 0; m < 4; ++m) _Pragma("unroll") for (int k = 0; k < 2; ++k) dst[m][k] = *(const PG8_LAS bf16x8*)(lds + PG8_SA(b, h) + aoff + m * 2048 + k * 1024); } while (0)
#define PG8_LDB(dst, b, h) do { _Pragma("unroll") for (int n = 0; n < 2; ++n) _Pragma("unroll") for (int k = 0; k < 2; ++k) dst[n][k] = *(const PG8_LAS bf16x8*)(lds + PG8_SB(b, h) + boff + n * 2048 + k * 1024); } while (0)
#define PG8_MMA(ai, bj, At, Bt) do { __builtin_amdgcn_s_setprio(1); _Pragma("unroll") for (int m = 0; m < 4; ++m) _Pragma("unroll") for (int n = 0; n < 2; ++n) _Pragma("unroll") for (int k = 0; k < 2; ++k) \
        acc[ai][bj][m][n] = __builtin_amdgcn_mfma_f32_16x16x32_bf16(Bt[n][k], At[m][k], acc[ai][bj][m][n], 0, 0, 0); __builtin_amdgcn_s_setprio(0); } while (0)
#define PG8_WAIT_V(n) asm volatile("s_waitcnt vmcnt(" #n ")" ::: "memory")
#define PG8_WAIT_L(n) asm volatile("s_waitcnt lgkmcnt(" #n ")" ::: "memory")
#define PG8_BAR __builtin_amdgcn_s_barrier()
#define PG8_SCHED __builtin_amdgcn_sched_barrier(0)
    Unit cur, nxt; int ui = 0;
    if (!S.next(0, cur)) return;
    f32x4 acc[2][2][4][2];
#pragma unroll
    for (int a = 0; a < 2; ++a)
#pragma unroll
        for (int b = 0; b < 2; ++b)
#pragma unroll
            for (int m = 0; m < 4; ++m)
#pragma unroll
                for (int n = 0; n < 2; ++n) acc[a][b][m][n] = (f32x4){0.f, 0.f, 0.f, 0.f};
    bf16x8 At[4][2], B0[2][2], B1[2][2];
    const char* cA = (const char*)g.A + (size_t)cur.pm * tstepA; const char* cB = (const char*)g.Bt + (size_t)cur.pn * tstepB;
    S.a_ready(cur);
    if constexpr (SP2) {
        PG8_STAGE(PG8_SB(0, 0), cB, voffB); PG8_STAGE(PG8_SB(0, 1), cB + hstepB, voffB); PG8_STAGE(PG8_SA(0, 0), cA, voffA); PG8_STAGE(PG8_SA(0, 1), cA + hstepA, voffA);
        if (wr == 1) PG8_BAR;
        PG8_WAIT_V(2); PG8_BAR;
        PG8_STAGE(PG8_SB(1, 0), cB + kstep, voffB); PG8_STAGE(PG8_SA(1, 0), cA + kstep, voffA); PG8_STAGE(PG8_SB(1, 1), cB + hstepB + kstep, voffB);
        PG8_WAIT_V(6); PG8_BAR;
    } else {
        PG8_STAGE(PG8_SB(0, 0), cB, voffB); PG8_STAGE(PG8_SA(0, 0), cA, voffA); PG8_STAGE(PG8_SB(0, 1), cB + hstepB, voffB); PG8_STAGE(PG8_SA(0, 1), cA + hstepA, voffA);
        if (wr == 1) PG8_BAR;
        PG8_WAIT_V(4); PG8_BAR;
        PG8_STAGE(PG8_SB(1, 0), cB + kstep, voffB); PG8_STAGE(PG8_SA(1, 0), cA + kstep, voffA); PG8_STAGE(PG8_SB(1, 1), cB + hstepB + kstep, voffB);
        PG8_WAIT_V(6); PG8_BAR;
    }
    for (;;) {
        const bool has_next = S.next(ui + 1, nxt);
        const char* nA = has_next ? (const char*)g.A + (size_t)nxt.pm * tstepA : cA; const char* nB = has_next ? (const char*)g.Bt + (size_t)nxt.pn * tstepB : cB;
        for (int t = 0; t < nt; t += 2) {
            const bool last = (t == nt - 2);
            const char* a1 = cA + (size_t)(t + 1) * kstep;
            const char* a2 = last ? nA : cA + (size_t)(t + 2) * kstep; const char* b2 = last ? nB : cB + (size_t)(t + 2) * kstep;
            const char* a3 = a2 + kstep; const char* b3 = b2 + kstep;
            if (last && has_next) S.a_ready(nxt);
            if constexpr (SP2) {
            PG8_LDB(B0, 0, 0); PG8_LDB(B1, 0, 1); PG8_SCHED; PG8_LDA(At, 0, 0); PG8_STAGE(PG8_SA(1, 1), a1 + hstepA, voffA);
            PG8_WAIT_V(8); PG8_WAIT_L(0); PG8_BAR; PG8_MMA(0, 0, At, B0); PG8_MMA(0, 1, At, B1); PG8_BAR; PG8_SCHED;
            PG8_LDA(At, 0, 1); PG8_STAGE(PG8_SB(0, 0), b2, voffB); PG8_STAGE(PG8_SB(0, 1), b2 + hstepB, voffB); PG8_STAGE(PG8_SA(0, 0), a2, voffA);
            PG8_WAIT_V(8); PG8_WAIT_L(0); PG8_BAR; PG8_MMA(1, 0, At, B0); PG8_MMA(1, 1, At, B1); PG8_BAR; PG8_SCHED;
            PG8_LDB(B0, 1, 0); PG8_LDB(B1, 1, 1); PG8_SCHED; PG8_LDA(At, 1, 0); PG8_STAGE(PG8_SA(0, 1), a2 + hstepA, voffA);
            PG8_WAIT_V(8); PG8_WAIT_L(0); PG8_BAR; PG8_MMA(0, 0, At, B0); PG8_MMA(0, 1, At, B1); PG8_BAR; PG8_SCHED;
            PG8_LDA(At, 1, 1); PG8_STAGE(PG8_SB(1, 0), b3, voffB); PG8_STAGE(PG8_SB(1, 1), b3 + hstepB, voffB); PG8_STAGE(PG8_SA(1, 0), a3, voffA);
            PG8_WAIT_V(8); PG8_WAIT_L(0); PG8_BAR; PG8_MMA(1, 0, At, B0); PG8_MMA(1, 1, At, B1); PG8_BAR; PG8_SCHED;
            } else {
            PG8_LDB(B0, 0, 0); PG8_SCHED; PG8_LDA(At, 0, 0); PG8_STAGE(PG8_SA(1, 1), a1 + hstepA, voffA);
            PG8_WAIT_L(8); PG8_BAR; PG8_WAIT_L(0); PG8_MMA(0, 0, At, B0); PG8_BAR; PG8_SCHED;
            PG8_LDB(B1, 0, 1); PG8_STAGE(PG8_SB(0, 0), b2, voffB);
            PG8_BAR; PG8_WAIT_L(0); PG8_MMA(0, 1, At, B1); PG8_BAR;
            PG8_LDA(At, 0, 1); PG8_STAGE(PG8_SA(0, 0), a2, voffA);
            PG8_BAR; PG8_WAIT_L(0); PG8_MMA(1, 0, At, B0); PG8_BAR; PG8_SCHED;
            PG8_STAGE(PG8_SB(0, 1), b2 + hstepB, voffB);
            PG8_WAIT_V(6); PG8_BAR; PG8_MMA(1, 1, At, B1); PG8_BAR;
            PG8_LDB(B0, 1, 0); PG8_SCHED; PG8_LDA(At, 1, 0); PG8_STAGE(PG8_SA(0, 1), a2 + hstepA, voffA);
            PG8_WAIT_L(8); PG8_BAR; PG8_WAIT_L(0); PG8_MMA(0, 0, At, B0); PG8_BAR; PG8_SCHED;
            PG8_LDB(B1, 1, 1); PG8_STAGE(PG8_SB(1, 0), b3, voffB);
            PG8_BAR; PG8_WAIT_L(0); PG8_MMA(0, 1, At, B1); PG8_BAR;
            PG8_LDA(At, 1, 1); PG8_STAGE(PG8_SA(1, 0), a3, voffA);
            PG8_BAR; PG8_WAIT_L(0); PG8_MMA(1, 0, At, B0); PG8_BAR; PG8_SCHED;
            PG8_STAGE(PG8_SB(1, 1), b3 + hstepB, voffB);
            PG8_WAIT_V(6); PG8_BAR; PG8_MMA(1, 1, At, B1); PG8_BAR;
            }
        }
        if constexpr (ALIGN_EPI) { if (wr == 0) PG8_BAR; }
        if constexpr (!Epi::AFTER_DRAIN) { E(acc, cur, wr, wc, fr, fq); S.done(cur); }
        if (!has_next) break;
#pragma unroll
        for (int a = 0; a < 2; ++a)
#pragma unroll
            for (int b = 0; b < 2; ++b)
#pragma unroll
                for (int m = 0; m < 4; ++m)
#pragma unroll
                    for (int n = 0; n < 2; ++n) acc[a][b][m][n] = (f32x4){0.f, 0.f, 0.f, 0.f};
        cur = nxt; cA = nA; cB = nB; ++ui;
        if constexpr (ALIGN_EPI) { if (wr == 1) PG8_BAR; }
    }
    PG8_WAIT_V(0);
    if constexpr (!ALIGN_EPI) { if (wr == 0) PG8_BAR; }
    PG8_BAR;
    if constexpr (Epi::AFTER_DRAIN) { E.fused(acc, cur, wr, wc, fr, fq, lds, wid, lane); S.done(cur); }
#undef PG8_SA
#undef PG8_SB
#undef PG8_STAGE
#undef PG8_LDA
#undef PG8_LDB
#undef PG8_MMA
#undef PG8_WAIT_V
#undef PG8_WAIT_L
#undef PG8_BAR
#undef PG8_SCHED
}
}
constexpr int NWAVES = 8;
template <class RowMap>
__device__ __forceinline__ void transpose_item(const float* __restrict__ W, int K, int N, bf16_t* WT, const float* __restrict__ kscale, RowMap rm, LAS float* scr, int item, int lane) {
    const int nblk = (N + 31) / 32, kb = item / nblk, nb = item % nblk, k0 = 64 * kb, n0 = 32 * nb;
    const int nr = n0 + (lane & 31);
    float v[32];
#pragma unroll
    for (int i = 0; i < 32; ++i) { const int kk = 2 * i + (lane >> 5); v[i] = (nr < N) ? W[(size_t)(k0 + kk) * N + nr] : 0.f; }
    if (kscale) {
#pragma unroll
        for (int i = 0; i < 32; ++i) v[i] *= kscale[k0 + 2 * i + (lane >> 5)];
    }
#pragma unroll
    for (int i = 0; i < 32; ++i) scr[(2 * i + (lane >> 5)) * 33 + (lane & 31)] = v[i];
    asm volatile("s_waitcnt lgkmcnt(0)" ::: "memory");
    const int c = lane & 7;
#pragma unroll
    for (int j = 0; j < 4; ++j) { const int nl = (lane >> 3) + 8 * j, n = n0 + nl;
        if (n < N) { const LAS float* s = scr + (8 * c) * 33 + nl;
            u32x4_t o; o.x = pk2(s[0 * 33], s[1 * 33]); o.y = pk2(s[2 * 33], s[3 * 33]); o.z = pk2(s[4 * 33], s[5 * 33]); o.w = pk2(s[6 * 33], s[7 * 33]);
            *(u32x4_t*)(WT + (size_t)rm(n) * K + k0 + 8 * c) = o; } }
    asm volatile("s_waitcnt lgkmcnt(0)" ::: "memory");
}
struct RmIdent { __device__ __forceinline__ int operator()(int n) const { return n; } };
struct RmWin {
    __device__ __forceinline__ int operator()(int c) const {
        const int nc = c < 2560 ? c : (c < 2608 ? 4608 + (c - 2560) : 2560 + (c - 2608));
        const int tile = nc >> 8, L = nc & 255, wc = L >> 6, bj = (L >> 5) & 1, j = L & 31;
        return tile * 256 + 128 * bj + 32 * wc + j;
    }
};
struct RmWup {
    __device__ __forceinline__ int operator()(int c) const { const int up = c >= D_FF, cc = up ? c - D_FF : c; return (cc >> 7) * 256 + up * 128 + (cc & 127); }
};

struct Ptrs {
    const float* in[18]; float* out; unsigned char* ws;
};

__device__ __forceinline__ void p0_prologue(const Ptrs& P, LAS unsigned char* lds, int vcu, int G, const int wave) {
    const int lane = fresh_lane();
    LAS float* scr = (LAS float*)(lds + wave * 16384);
    const int gw = vcu * NWAVES + wave, NGW = G * NWAVES;
    unsigned char* ws = P.ws;
    bf16_t* WinT = (bf16_t*)(ws + WS_WIN); bf16_t* WoutT = (bf16_t*)(ws + WS_WOUT); bf16_t* WupT = (bf16_t*)(ws + WS_WUP); bf16_t* WdownT = (bf16_t*)(ws + WS_WDOWN); bf16_t* W1cT = (bf16_t*)(ws + WS_W1C);
    const float* x = P.in[0]; const float* attn_norm_w = P.in[1]; const float* w_in = P.in[2]; const float* cmp_pos = P.in[5]; const float* cmp_w1 = P.in[6];
    const float* w_out = P.in[12]; const float* ffn_norm_w = P.in[13]; const float* w_up = P.in[14]; const float* w_down = P.in[17];
    constexpr int I_IN = 32 * 146, I_W1 = 32 * 8, I_W2 = 4 * 2;
    constexpr int NITEMS = I_IN + 2 * I_W1 + 2 * I_W2;
    (void)w_out; (void)w_up; (void)w_down; (void)ffn_norm_w; (void)WoutT; (void)WupT; (void)WdownT;
    for (int it = gw; it < NITEMS; it += NGW) {
        int r = it;
        if (r < I_IN) { transpose_item(w_in, 2048, IN_COLS, WinT, nullptr, RmWin(), scr, r, lane); continue; } r -= I_IN;
        if (r < I_W1) { transpose_item(cmp_w1, 2048, 256, W1cT, nullptr, RmIdent(), scr, r, lane); continue; } r -= I_W1;
        if (r < I_W1) { transpose_item(cmp_w1 + (size_t)2048 * 256, 2048, 256, W1cT + (size_t)256 * 2048, nullptr, RmIdent(), scr, r, lane); continue; } r -= I_W1;
        { const int kv = r >= I_W2 ? 1 : 0; transpose_item(P.in[7] + (size_t)kv * 256 * 64, 256, 64, (bf16_t*)(ws + WS_SMALL + SM_W2T) + (size_t)kv * 64 * 256, nullptr, RmIdent(), scr, r - kv * I_W2, lane); }
    }
    for (int i = gw * 64 + lane; i < 8 * 16384; i += NGW * 64) { const int t = (i >> 7) & 127, sx = i & 127; ((bf16_t*)(ws + WS_SMALL + SM_SWB))[i] = (bf16_t)(sx <= t ? f2bf(P.in[10][i]) : 0u); }
    for (int p = gw; p < 256; p += NGW) {
        const int L = 64 * ((p >> 5) & 3) + 32 * (p >> 7) + (p & 31);
        if (L >= 48) { u32x4_t z = {0u, 0u, 0u, 0u}; u32x4_t* d = (u32x4_t*)(WinT + (size_t)(18 * 256 + p) * 2048);
#pragma unroll
            for (int j = 0; j < 4; ++j) d[lane + 64 * j] = z; }
    }
    bf16_t* XN = (bf16_t*)(ws + WS_XN);
    for (int m = gw; m < MTOK; m += 2 * NGW) {
        const int m2 = m + NGW;
        const f32x4_t* xr = (const f32x4_t*)(x + (size_t)m * D_MODEL) + lane;
        const f32x4_t* xr2 = (const f32x4_t*)(x + (size_t)(m2 < MTOK ? m2 : m) * D_MODEL) + lane;
        f32x4_t v[8], v2[8]; float s = 0.f, s2 = 0.f;
#pragma unroll
        for (int j = 0; j < 8; ++j) { v[j] = xr[64 * j]; v2[j] = xr2[64 * j]; }
#pragma unroll
        for (int j = 0; j < 8; ++j) { s += (v[j][0] * v[j][0] + v[j][1] * v[j][1]) + (v[j][2] * v[j][2] + v[j][3] * v[j][3]); s2 += (v2[j][0] * v2[j][0] + v2[j][1] * v2[j][1]) + (v2[j][2] * v2[j][2] + v2[j][3] * v2[j][3]); }
        const float r = __builtin_amdgcn_rsqf(wave_sum(s) * (1.0f / D_MODEL) + 1e-6f), r2 = __builtin_amdgcn_rsqf(wave_sum(s2) * (1.0f / D_MODEL) + 1e-6f);
        u32x2_t* o8 = (u32x2_t*)(XN + (size_t)m * D_MODEL) + lane; u32x2_t* o82 = (u32x2_t*)(XN + (size_t)m2 * D_MODEL) + lane;
#pragma unroll
        for (int j = 0; j < 8; ++j) { const f32x4_t w = ((const f32x4_t*)attn_norm_w)[lane + 64 * j];
            u32x2_t o; o.x = pk2(v[j][0] * r * w[0], v[j][1] * r * w[1]); o.y = pk2(v[j][2] * r * w[2], v[j][3] * r * w[3]); o8[64 * j] = o;
            if (m2 < MTOK) { u32x2_t q; q.x = pk2(v2[j][0] * r2 * w[0], v2[j][1] * r2 * w[1]); q.y = pk2(v2[j][2] * r2 * w[2], v2[j][3] * r2 * w[3]); o82[64 * j] = q; } }
    }
    float* BIASP = (float*)(ws + WS_SMALL + SM_BIASP);
    for (int it = gw; it < 64; it += NGW) {
        const int kv = it >> 5, kc = it & 31; f32x4_t a = {0.f, 0.f, 0.f, 0.f};
        const float* pp = cmp_pos + kv * 2048 + kc * 64; const float* w1 = cmp_w1 + ((size_t)kv * 2048 + kc * 64) * 256;
        for (int k = 0; k < 64; ++k) { const f32x4_t w = ((const f32x4_t*)(w1 + (size_t)k * 256))[lane]; a += w * pp[k]; }
        ((f32x4_t*)(BIASP + (size_t)it * 256))[lane] = a;
    }
}

__device__ __forceinline__ void bias1_stage(unsigned char* ws, int idx  ) {
    const float* BIASP = (const float*)(ws + WS_SMALL + SM_BIASP); float* BIAS1 = (float*)(ws + WS_SMALL + SM_BIAS1);
    const int kv = idx >> 8, j = idx & 255; float s = 0.f;
    for (int kc = 0; kc < 32; ++kc) s += BIASP[(size_t)(kv * 32 + kc) * 256 + j];
    BIAS1[idx] = s;
}
__device__ __forceinline__ void cmp2_row(const Ptrs& P, int R, int lane) {
    unsigned char* ws = P.ws; const bf16_t* HC = (const bf16_t*)(ws + WS_HC);
    const int kv = R >> 12, rr = R & 4095, n = rr & 255;
    bf16_t* dst = (bf16_t*)(ws + (kv ? WS_VC : WS_KC)) + (size_t)rr * 64 + lane;
    if (n == 255) { *dst = 0; return; }
    const float* w2 = P.in[7] + (size_t)kv * 256 * 64;
    const u32x2_t hr = *(const u32x2_t*)(HC + (size_t)R * 256 + 4 * lane);
    float h[4] = {__uint_as_float(hr.x << 16), __uint_as_float(hr.x & 0xffff0000u), __uint_as_float(hr.y << 16), __uint_as_float(hr.y & 0xffff0000u)};
    float o = 0.f;
    for (int jj = 0; jj < 64; ++jj) {
#pragma unroll
        for (int i = 0; i < 4; ++i) o += __shfl(h[i], jj) * w2[(size_t)(4 * jj + i) * 64 + lane];
    }
    if (kv == 0) { const float ss = wave_sum(o * o); o *= __builtin_amdgcn_rsqf(ss * (1.0f / 64.0f) + 1e-6f) * P.in[4][lane]; }
    *dst = (bf16_t)f2bf(o);
}

__device__ __forceinline__ void gmlp_unit_v1(const Ptrs& P, LAS unsigned char* lds, int unit, const int wave_s) {
    unsigned char* ws = P.ws; const int tid = fresh_tid(wave_s);
    const int g = unit & 7, chunk = (unit >> 3) & 31, b = unit >> 8; const int m0 = b * SEQ + chunk * 128;
    LAS float* vn = (LAS float*)lds; LAS float* Wl = (LAS float*)(lds + 65536); LAS float* st = (LAS float*)(lds + 131072);
    const bf16_t* GV = (const bf16_t*)(ws + WS_GV); const bf16_t* U = (const bf16_t*)(ws + WS_U); const float* VSTAT = (const float*)(ws + WS_VSTAT);
    bf16_t* AB = (bf16_t*)(ws + WS_AB);
    const float* ln_w = P.in[8]; const float* ln_b = P.in[9]; const float* sw = P.in[10]; const float* sb = P.in[11];
    if (tid < 128) { const float* p = VSTAT + (size_t)(m0 + tid) * 32; float s1 = 0.f, s2 = 0.f;
#pragma unroll
        for (int i = 0; i < 16; ++i) { s1 += p[2 * i]; s2 += p[2 * i + 1]; }
        const float mean = s1 * (1.0f / 1024.0f); float var = s2 * (1.0f / 1024.0f) - mean * mean; var = var < 0.f ? 0.f : var;
        st[2 * tid] = mean; st[2 * tid + 1] = __builtin_amdgcn_rsqf(var + 1e-5f); }
    for (int i = 0; i < 32; ++i) { const int idx = tid + 512 * i, t = idx >> 7, s = idx & 127; Wl[idx] = (s <= t) ? sw[(size_t)g * 16384 + idx] : 0.f; }
    __syncthreads();
#pragma unroll
    for (int i = 0; i < 4; ++i) { const int idx = tid + 512 * i, s = idx >> 4, c8 = idx & 15;
        const u32x4_t raw = *(const u32x4_t*)(GV + (size_t)(m0 + s) * 1024 + g * 128 + 8 * c8); float f[8]; unpack8(raw, f);
        const float mean = st[2 * s], rstd = st[2 * s + 1];
#pragma unroll
        for (int e = 0; e < 8; ++e) { const int c = g * 128 + 8 * c8 + e; vn[s * 128 + 8 * c8 + e] = (f[e] - mean) * rstd * ln_w[c] + ln_b[c]; } }
    __syncthreads();
    const int c = tid & 127, tq = tid >> 7;
    for (int i = 0; i < 8; ++i) {
        const int t0 = 4 * (tq + 4 * i); float a0 = 0.f, a1 = 0.f, a2 = 0.f, a3 = 0.f;
        for (int s4 = 0; s4 <= t0; s4 += 4) {
            const f32x4_t w0 = *(const LAS f32x4_t*)(Wl + (t0 + 0) * 128 + s4), w1 = *(const LAS f32x4_t*)(Wl + (t0 + 1) * 128 + s4), w2 = *(const LAS f32x4_t*)(Wl + (t0 + 2) * 128 + s4), w3 = *(const LAS f32x4_t*)(Wl + (t0 + 3) * 128 + s4);
#pragma unroll
            for (int k = 0; k < 4; ++k) { const float v = vn[(s4 + k) * 128 + c]; a0 += w0[k] * v; a1 += w1[k] * v; a2 += w2[k] * v; a3 += w3[k] * v; }
        }
        const float av[4] = {a0, a1, a2, a3};
#pragma unroll
        for (int k = 0; k < 4; ++k) { const int t = t0 + k; const size_t row = (size_t)(m0 + t);
            const float uu = bf2f(U[row * 1024 + g * 128 + c]); AB[row * 2048 + 1024 + g * 128 + c] = (bf16_t)f2bf(uu * (av[k] + sb[g * 128 + t])); }
    }
    __syncthreads();
}

__device__ __forceinline__ void conv_item(const Ptrs& P, int b, int idx) {
    const int t = idx / 704, c8 = idx % 704, c0 = 8 * c8, j = c0 >> 7, i0 = c0 & 127;
    const bf16_t* HID = (const bf16_t*)(P.ws + WS_HID); const float* cw = P.in[15]; const float* cb = P.in[16];
    float gt[8], up[8];
#pragma unroll
    for (int e = 0; e < 8; ++e) { gt[e] = cb[c0 + e]; up[e] = cb[D_FF + c0 + e]; }
#pragma unroll
    for (int k = 0; k < 3; ++k) { const int tt = t - 2 + k; if (tt < 0) continue;
        float hg[8], hu[8]; unpack8(*(const u32x4_t*)(HID + (size_t)tt * N_UP + 256 * j + i0), hg); unpack8(*(const u32x4_t*)(HID + (size_t)tt * N_UP + 256 * j + 128 + i0), hu);
#pragma unroll
        for (int e = 0; e < 8; ++e) { gt[e] += cw[(size_t)k * N_UP + c0 + e] * hg[e]; up[e] += cw[(size_t)k * N_UP + D_FF + c0 + e] * hu[e]; } }
    float r[8];
#pragma unroll
    for (int e = 0; e < 8; ++e) r[e] = gt[e] * sigmoidf_(gt[e]) * up[e];
    u32x4_t o; o.x = pk2(r[0], r[1]); o.y = pk2(r[2], r[3]); o.z = pk2(r[4], r[5]); o.w = pk2(r[6], r[7]);
    *(u32x4_t*)((bf16_t*)(P.ws + WS_G) + ((size_t)b * SEQ + t) * D_FF + c0) = o;
}

constexpr int LW_OUT = 32 * 64, LW_UP = 32 * 352, LW_DOWN = 88 * 64, LW_ITEMS = LW_OUT + LW_UP + LW_DOWN, LW_CHUNKS = LW_ITEMS / 64;
static_assert(LW_ITEMS % 64 == 0, "late weight items per chunk");
__device__ __forceinline__ void late_weight_chunk(const Ptrs& P, LAS unsigned char* lds, int chunk, const int wave) {
    const int lane = fresh_lane();
    LAS float* scr = (LAS float*)(lds + wave * 16384);
    unsigned char* ws = P.ws;
    for (int i = 0; i < 8; ++i) {
        int r = chunk * 64 + i * 8 + wave;
        if (r < LW_OUT) { transpose_item(P.in[12], 2048, 2048, (bf16_t*)(ws + WS_WOUT), nullptr, RmIdent(), scr, r, lane); continue; } r -= LW_OUT;
        if (r < LW_UP) { transpose_item(P.in[14], 2048, N_UP, (bf16_t*)(ws + WS_WUP), P.in[13], RmWup(), scr, r, lane); continue; } r -= LW_UP;
        transpose_item(P.in[17], D_FF, 2048, (bf16_t*)(ws + WS_WDOWN), nullptr, RmIdent(), scr, r, lane);
    }
}

namespace nsa {
using bf16x8 = __attribute__((ext_vector_type(8))) short;
using s16x4 = __attribute__((ext_vector_type(4))) short;
using f32x16 = __attribute__((ext_vector_type(16))) float;
typedef float f32x2_t __attribute__((ext_vector_type(2))); typedef __bf16 bf16x2_t __attribute__((ext_vector_type(2)));
constexpr int L_K = 0, L_V = 16384, L_WSF = 32768, L_OST = 34816, L_IMP = 100352, L_MASK = 116736, L_WU = 117248, L_END = 117312;
constexpr int SLOTB = 8192;
constexpr float THR = 8.0f;
#define NSA_SBAR() __builtin_amdgcn_sched_barrier(0)
__device__ __forceinline__ int crow(int r, int hi) { return (r & 3) + 8 * (r >> 2) + 4 * hi; }
__device__ __forceinline__ void glds16(const void* gbase  , unsigned voff  , unsigned lds_dst) { unsigned keep;
    asm volatile("s_mov_b32 %0, m0\n\ts_mov_b32 m0, %3\n\ts_nop 0\n\tglobal_load_lds_dwordx4 %1, %2\n\ts_mov_b32 m0, %0" : "=&s"(keep) : "v"(voff), "s"(gbase), "s"(lds_dst) : "memory"); }
__device__ __forceinline__ unsigned cvtpk_s(float lo, float hi) { f32x2_t v = {lo, hi}; bf16x2_t b = __builtin_convertvector(v, bf16x2_t); return __builtin_bit_cast(unsigned, b); }
#define NSA_WAIT_BAR() asm volatile("s_waitcnt vmcnt(0) lgkmcnt(0)\n\ts_barrier" ::: "memory")

__device__ __forceinline__ void qkt(f32x16& p0, f32x16& p1, LAS const char* Kslot, const bf16x8 (&qr)[4], int r32, int hi) {
    LAS const char* kb = Kslot + hi * 1024 + r32 * 16;
#pragma unroll
    for (int d0 = 0; d0 < 4; ++d0) {
        const bf16x8 b0 = *(LAS const bf16x8*)(kb + d0 * 2048);
        const bf16x8 b1 = *(LAS const bf16x8*)(kb + d0 * 2048 + 512);
        p0 = __builtin_amdgcn_mfma_f32_32x32x16_bf16(b0, qr[d0], p0, 0, 0, 0); p1 = __builtin_amdgcn_mfma_f32_32x32x16_bf16(b1, qr[d0], p1, 0, 0, 0);
    }
}
struct VFrag { s16x4 lo[2][4], hi[2][4]; };
__device__ __forceinline__ void vload(VFrag& f, int vb) {
#pragma unroll
    for (int d0 = 0; d0 < 2; ++d0)
#pragma unroll
        for (int ks = 0; ks < 4; ++ks) {
            asm volatile("ds_read_b64_tr_b16 %0,%1 offset:%c2" : "=&v"(f.lo[d0][ks]) : "v"(vb), "i"(d0 * 4096 + ks * 1024) : "memory");
            asm volatile("ds_read_b64_tr_b16 %0,%1 offset:%c2" : "=&v"(f.hi[d0][ks]) : "v"(vb), "i"(d0 * 4096 + ks * 1024 + 512) : "memory"); }
}
__device__ __forceinline__ void pvmma(f32x16 (&o)[2], VFrag& f, bf16x8 pa0, bf16x8 pa1, bf16x8 pa2, bf16x8 pa3) {
    asm volatile("s_waitcnt lgkmcnt(0)" : "+v"(f.lo[0][0]), "+v"(f.lo[0][1]), "+v"(f.lo[0][2]), "+v"(f.lo[0][3]), "+v"(f.hi[0][0]), "+v"(f.hi[0][1]), "+v"(f.hi[0][2]), "+v"(f.hi[0][3]) :: "memory");
    asm volatile("" : "+v"(f.lo[1][0]), "+v"(f.lo[1][1]), "+v"(f.lo[1][2]), "+v"(f.lo[1][3]), "+v"(f.hi[1][0]), "+v"(f.hi[1][1]), "+v"(f.hi[1][2]), "+v"(f.hi[1][3]));
    NSA_SBAR();
#pragma unroll
    for (int d0 = 0; d0 < 2; ++d0) {
#define NSA_PK(k) (bf16x8){f.lo[d0][k][0], f.lo[d0][k][1], f.lo[d0][k][2], f.lo[d0][k][3], f.hi[d0][k][0], f.hi[d0][k][1], f.hi[d0][k][2], f.hi[d0][k][3]}
        o[d0] = __builtin_amdgcn_mfma_f32_32x32x16_bf16(pa0, NSA_PK(0), o[d0], 0, 0, 0);
        o[d0] = __builtin_amdgcn_mfma_f32_32x32x16_bf16(pa1, NSA_PK(1), o[d0], 0, 0, 0);
        o[d0] = __builtin_amdgcn_mfma_f32_32x32x16_bf16(pa2, NSA_PK(2), o[d0], 0, 0, 0);
        o[d0] = __builtin_amdgcn_mfma_f32_32x32x16_bf16(pa3, NSA_PK(3), o[d0], 0, 0, 0);
#undef NSA_PK
    }
}
__device__ __forceinline__ void pv(f32x16 (&o)[2], int vb, bf16x8 pa0, bf16x8 pa1, bf16x8 pa2, bf16x8 pa3) { VFrag f; vload(f, vb); pvmma(o, f, pa0, pa1, pa2, pa3); }
__device__ __forceinline__ float rowmax32(const f32x16& p0, const f32x16& p1) {
    float a = __builtin_fmaxf(p0[0], p1[0]);
#pragma unroll
    for (int r = 1; r < 16; ++r) a = __builtin_fmaxf(a, __builtin_fmaxf(p0[r], p1[r]));
    auto rr = __builtin_amdgcn_permlane32_swap(__float_as_uint(a), __float_as_uint(a), false, false);
    return __builtin_fmaxf(__uint_as_float(rr[0]), __uint_as_float(rr[1]));
}
struct State { float m, l; f32x16 o[2]; };
__device__ __forceinline__ void state_init(State& s) { s.m = -1e30f; s.l = 0.f; s.o[0] = f32x16{}; s.o[1] = f32x16{}; }

template <int BMUL, int MASK, bool LOADV>
__device__ __forceinline__ void tile_scores(f32x16& p0, f32x16& p1, LAS const char* Kslot, const bf16x8 (&qr)[4], const f32x16& bk, float c0, float b32, int lim, int r32, int hi, VFrag& vf, int vb) {
#pragma unroll
    for (int r = 0; r < 16; ++r) { const float b = (BMUL == 1) ? bk[r] + c0 : __builtin_fmaf(bk[r], (float)BMUL, c0); p0[r] = b; p1[r] = b + b32; }
    qkt(p0, p1, Kslot, qr, r32, hi);
    if (LOADV) vload(vf, vb);
    const int limh = lim - 4 * hi;
#pragma unroll
    for (int r = 0; r < 16; ++r) {
        const int kk = (r & 3) + 8 * (r >> 2);
        if (MASK == 1) { if (!(kk <= limh)) p0[r] = -INFINITY; if (!(kk + 32 <= limh)) p1[r] = -INFINITY; }
        if (MASK == 2) { if (!(kk > limh)) p0[r] = -INFINITY; if (!(kk + 32 > limh)) p1[r] = -INFINITY; }
        if (MASK == 3) { if (!(kk < limh)) p0[r] = -INFINITY; if (!(kk + 32 < limh)) p1[r] = -INFINITY; }
    }
}
__device__ __forceinline__ float tile_ref(const State& st, float rb0, bool rowlive) { return (st.m < -1e29f && rowlive) ? rb0 : st.m; }
__device__ __forceinline__ void tile_softmax_pv(State& st, f32x16& p0, f32x16& p1, float mref, VFrag& vf, LAS float* wsf, int r32, int hi) {
    float a0 = p0[0], a1 = p1[0];
#pragma unroll
    for (int r = 1; r < 16; ++r) { a0 = __builtin_fmaxf(a0, p0[r]); a1 = __builtin_fmaxf(a1, p1[r]); }
    float mx = __builtin_fmaxf(a0, a1);
    { auto rr = __builtin_amdgcn_permlane32_swap(__float_as_uint(mx), __float_as_uint(mx), false, false); mx = __builtin_fmaxf(__uint_as_float(rr[0]), __uint_as_float(rr[1])); }
    if (__any(mx > THR)) {
        const float dl = __builtin_fmaxf(mx, 0.f), alpha = __builtin_amdgcn_exp2f(-dl);
        mref += dl; st.l *= alpha;
        if (hi == 0) wsf[r32] = alpha;
        asm volatile("s_waitcnt lgkmcnt(0)" ::: "memory");
#pragma unroll
        for (int r = 0; r < 16; ++r) { const float a = wsf[crow(r, hi)]; st.o[0][r] *= a; st.o[1][r] *= a; p0[r] -= dl; p1[r] -= dl; }
    }
    st.m = mref;
    float ls = 0.f;
#pragma unroll
    for (int r = 0; r < 16; ++r) { p0[r] = __builtin_amdgcn_exp2f(p0[r]); p1[r] = __builtin_amdgcn_exp2f(p1[r]); ls += p0[r] + p1[r]; }
    st.l += ls;
    u32x4_t pw0, pw1, pw2, pw3;
    pw0 = (u32x4_t){cvtpk_s(p0[0], p0[1]), cvtpk_s(p0[2], p0[3]), cvtpk_s(p0[4], p0[5]), cvtpk_s(p0[6], p0[7])};
    pw1 = (u32x4_t){cvtpk_s(p0[8], p0[9]), cvtpk_s(p0[10], p0[11]), cvtpk_s(p0[12], p0[13]), cvtpk_s(p0[14], p0[15])};
    pw2 = (u32x4_t){cvtpk_s(p1[0], p1[1]), cvtpk_s(p1[2], p1[3]), cvtpk_s(p1[4], p1[5]), cvtpk_s(p1[6], p1[7])};
    pw3 = (u32x4_t){cvtpk_s(p1[8], p1[9]), cvtpk_s(p1[10], p1[11]), cvtpk_s(p1[12], p1[13]), cvtpk_s(p1[14], p1[15])};
    pvmma(st.o, vf, __builtin_bit_cast(bf16x8, pw0), __builtin_bit_cast(bf16x8, pw1), __builtin_bit_cast(bf16x8, pw2), __builtin_bit_cast(bf16x8, pw3));
}
template <bool FIRST>
__device__ __forceinline__ void fold_branch(LAS float* ostg, State& st, float gate, LAS float* wsf, int r32, int hi) {
    float l = st.l;
    { auto rr = __builtin_amdgcn_permlane32_swap(__float_as_uint(l), __float_as_uint(l), false, false); l = __uint_as_float(rr[0]) + __uint_as_float(rr[1]); }
    const float f = l > 0.f ? gate / l : 0.f;
    asm volatile("s_waitcnt lgkmcnt(0)" ::: "memory");
    if (hi == 0) wsf[r32] = f;
    asm volatile("s_waitcnt lgkmcnt(0)" ::: "memory");
#pragma unroll
    for (int r = 0; r < 16; ++r) { const int orow = crow(r, hi); const float a = wsf[orow];
#pragma unroll
        for (int d0 = 0; d0 < 2; ++d0) { LAS float* p = ostg + orow * 64 + d0 * 32 + r32; if (FIRST) *p = st.o[d0][r] * a; else *p += st.o[d0][r] * a; } }
    asm volatile("s_waitcnt lgkmcnt(0)" ::: "memory");
}

__device__ __forceinline__ int nsa_unit(const Ptrs& P, LAS unsigned char* lds, int bg, int qt, const int wave_s, unsigned* qctr, int qbase) {
    unsigned char* ws = P.ws;
    const int lane = fresh_lane(), r32 = lane & 31, hi = lane >> 5; const int wid = wave_s;
    const int b = bg >> 2, g = bg & 3, t0 = 64 * qt;
    const int tl = 8 * wid + (r32 >> 2), hq = r32 & 3;
    const size_t m0 = (size_t)b * SEQ + t0;
    const bf16_t* Q = (const bf16_t*)(ws + WS_Q); const bf16_t* KV6 = (const bf16_t*)(ws + WS_KV6);
    const bf16_t* KSb = KV6 + 2 * KVSZ + (size_t)bg * SEQ * 64; const bf16_t* VSb = KV6 + 3 * KVSZ + (size_t)bg * SEQ * 64;
    const bf16_t* KWb = KV6 + 4 * KVSZ + (size_t)bg * SEQ * 64; const bf16_t* VWb = KV6 + 5 * KVSZ + (size_t)bg * SEQ * 64;
    const bf16_t* KCb = (const bf16_t*)(ws + WS_KC) + (size_t)bg * 256 * 64; const bf16_t* VCb = (const bf16_t*)(ws + WS_VC) + (size_t)bg * 256 * 64;
    const float* GATES = (const float*)(ws + WS_GATES); bf16_t* AB = (bf16_t*)(ws + WS_AB);
    const unsigned lds0 = (unsigned)(uintptr_t)lds;
    LAS float* wsf = (LAS float*)(lds + L_WSF) + wid * 64;
    LAS float* IMP = (LAS float*)(lds + L_IMP);
    LAS unsigned* MASK = (LAS unsigned*)(lds + L_MASK); LAS unsigned* WU = (LAS unsigned*)(lds + L_WU);
    const int koff = lane * 64 + wid * 8, voff = (16 * (wid & 3) + (lane >> 2)) * 64 + (wid >> 2) * 32 + (lane & 3) * 8;
    const unsigned kdst = lds0 + L_K + wid * 1024, vdst = lds0 + L_V + wid * 1024;
#define NSA_DMA_K(base, tile, slot) glds16((base) + (size_t)(tile) * 4096, (unsigned)koff * 2u, (unsigned)__builtin_amdgcn_readfirstlane(kdst + (slot) * SLOTB))
#define NSA_DMA_V(base, tile, slot) glds16((base) + (size_t)(tile) * 4096, (unsigned)voff * 2u, (unsigned)__builtin_amdgcn_readfirstlane(vdst + (slot) * SLOTB))
    const int vb0 = (int)(lds0 + L_V) + ((lane >> 4) & 1) * 32 + (lane & 3) * 8 + (4 * hi + ((lane & 15) >> 2)) * 64;
    LAS const char* Kbase = (LAS const char*)(lds + L_K);
    bf16x8 qr[4];
    { const bf16_t* qp = Q + (m0 + tl) * 1024 + (4 * g + hq) * 64 + hi * 8;
#pragma unroll
      for (int d0 = 0; d0 < 4; ++d0) qr[d0] = *(const bf16x8*)(qp + d0 * 16); }
    const float sl2 = __builtin_amdgcn_exp2f(-0.5f * (float)(4 * g + hq + 1)) * LOG2E;
    f32x16 bk;
#pragma unroll
    for (int r = 0; r < 16; ++r) bk[r] = sl2 * (float)((r & 3) + 8 * (r >> 2));
    const float b32t = 32.0f * sl2, b32c = 512.0f * sl2, hoff_t = 4.0f * (float)hi * sl2, hoff_c = 64.0f * (float)hi * sl2;
    float gate[3];
    { const float* gp = GATES + (m0 + tl) * 48 + (4 * g + hq) * 3; gate[0] = gp[0]; gate[1] = gp[1]; gate[2] = gp[2]; }
    LAS float* ostg = (LAS float*)(lds + L_OST) + wid * 2048;
    State st;
    f32x16 p0, p1;
    int nxt_ticket = 0;

    int tc = 0;
    VFrag vf;
    const int nvmax = (t0 + 63 >= 31) ? ((t0 + 63 - 31) >> 4) + 1 : 0;
    const int nct = (nvmax + 63) >> 6;
    const int tq = t0 + tl, nv = tq >= 31 ? ((tq - 31) >> 4) + 1 : 0;
    {
        state_init(st);
        const int j0 = qt >= 8 ? qt - 8 : 0, nt = qt - j0 + 1;
        NSA_DMA_K(KWb, qt, 0); NSA_DMA_V(VWb, qt, 0); NSA_WAIT_BAR();
        for (int i = 0; i < nt; ++i) {
            const int j = qt - i, slot = (tc + i) & 1;
            if (i + 1 < nt) { NSA_DMA_K(KWb, j - 1, slot ^ 1); NSA_DMA_V(VWb, j - 1, slot ^ 1); }
            else { NSA_DMA_K(KCb, nct - 1, slot ^ 1); NSA_DMA_V(VCb, nct - 1, slot ^ 1); }
            const float rb0 = sl2 * (float)(64 * j - t0), mref = tile_ref(st, rb0, true), c0 = rb0 + hoff_t - mref;
            if (j == qt) tile_scores<1, 1, true>(p0, p1, Kbase + slot * SLOTB, qr, bk, c0, b32t, tl, r32, hi, vf, vb0 + slot * SLOTB);
            else if (j == qt - 8) tile_scores<1, 2, true>(p0, p1, Kbase + slot * SLOTB, qr, bk, c0, b32t, tl, r32, hi, vf, vb0 + slot * SLOTB);
            else tile_scores<1, 0, true>(p0, p1, Kbase + slot * SLOTB, qr, bk, c0, b32t, 0, r32, hi, vf, vb0 + slot * SLOTB);
            tile_softmax_pv(st, p0, p1, mref, vf, wsf, r32, hi);
            NSA_WAIT_BAR();
        }
        tc += nt;
        fold_branch<true>(ostg, st, gate[2], wsf, r32, hi);
    }
    {
        state_init(st);
        for (int ci = 0; ci < nct; ++ci) {
            const int c = nct - 1 - ci, slot = (tc + ci) & 1;
            if (ci + 1 < nct) { NSA_DMA_K(KCb, c - 1, slot ^ 1); NSA_DMA_V(VCb, c - 1, slot ^ 1); }
            else if (qt >= 16) { NSA_DMA_K(KCb, 0, slot ^ 1); }
            else { NSA_DMA_K(KSb, qt, slot ^ 1); NSA_DMA_V(VSb, qt, slot ^ 1); }
            const float rb0 = sl2 * ((float)(1024 * c - t0) + 15.5f), mref = tile_ref(st, rb0, true), c0 = rb0 + hoff_c - mref;
            tile_scores<16, 3, true>(p0, p1, Kbase + slot * SLOTB, qr, bk, c0, b32c, nv - 64 * c, r32, hi, vf, vb0 + slot * SLOTB);
            tile_softmax_pv(st, p0, p1, mref, vf, wsf, r32, hi);
            NSA_WAIT_BAR();
        }
        tc += nct;
    }
    const float mc_fin = st.m; float lc = st.l;
    fold_branch<false>(ostg, st, gate[0], wsf, r32, hi);
    if (qt >= 16) {
        { auto rr = __builtin_amdgcn_permlane32_swap(__float_as_uint(lc), __float_as_uint(lc), false, false); lc = __uint_as_float(rr[0]) + __uint_as_float(rr[1]); }
        const float invl = lc > 0.f ? 1.0f / lc : 0.f;
        float carry = 0.f;
        for (int c = 0; c < nct; ++c) {
            const int slot = (tc + c) & 1;
            if (c + 1 < nct) { NSA_DMA_K(KCb, c + 1, slot ^ 1); }
            else { NSA_DMA_K(KSb, qt, slot ^ 1); NSA_DMA_V(VSb, qt, slot ^ 1); }
            const float c0 = sl2 * ((float)(1024 * c - t0) + 15.5f) + hoff_c - mc_fin;
            tile_scores<16, 3, false>(p0, p1, Kbase + slot * SLOTB, qr, bk, c0, b32c, nv - 64 * c, r32, hi, vf, 0);
#pragma unroll
            for (int r = 0; r < 16; ++r) { p0[r] = __builtin_amdgcn_exp2f(p0[r]) * invl; p1[r] = __builtin_amdgcn_exp2f(p1[r]) * invl; }
            float imp0[4], imp1[4], pl0[4], pl1[4];
#pragma unroll
            for (int a = 0; a < 4; ++a) {
                imp0[a] = (p0[4 * a] + p0[4 * a + 1]) + (p0[4 * a + 2] + p0[4 * a + 3]); imp1[a] = (p1[4 * a] + p1[4 * a + 1]) + (p1[4 * a + 2] + p1[4 * a + 3]);
                pl0[a] = __shfl_xor(p0[4 * a + 3], 32); pl1[a] = __shfl_xor(p1[4 * a + 3], 32);
            }
            if (hi) {
#pragma unroll
                for (int a = 0; a < 4; ++a) { imp0[a] += pl0[a]; imp1[a] += pl1[a]; }
            } else {
                imp0[0] += carry; imp1[0] += pl0[3];
#pragma unroll
                for (int a = 1; a < 4; ++a) { imp0[a] += pl0[a - 1]; imp1[a] += pl1[a - 1]; }
            }
            carry = pl1[3];
#pragma unroll
            for (int a = 0; a < 4; ++a) {
                imp0[a] += __shfl_xor(imp0[a], 1); imp0[a] += __shfl_xor(imp0[a], 2); imp1[a] += __shfl_xor(imp1[a], 1); imp1[a] += __shfl_xor(imp1[a], 2);
                if (hq == 0) { IMP[tl * 64 + 16 * c + 2 * a + hi] = imp0[a]; IMP[tl * 64 + 16 * c + 8 + 2 * a + hi] = imp1[a]; }
            }
            NSA_WAIT_BAR();
        }
        tc += nct;
    }
    unsigned long long wu = 0ull;
    if (qt < 16) {
        wu = (2ull << qt) - 1ull;
        if (lane < 8) { MASK[2 * (8 * wid + lane)] = (unsigned)wu; MASK[2 * (8 * wid + lane) + 1] = (unsigned)(wu >> 32); }
    } else {
        const int j = lane; const bool valid = j <= qt, forced = (j == 0) || (j == qt) || (j == qt - 1);
        for (int k = 0; k < 8; ++k) {
            const float imp = IMP[(8 * wid + k) * 64 + j];
            const float scv = valid ? (forced ? 1e9f : imp) : -1e9f;
            const unsigned fb = __float_as_uint(scv), key = fb ^ ((fb >> 31) ? 0xffffffffu : 0x80000000u);
            unsigned T = 0u;
#pragma unroll
            for (int bit = 31; bit >= 0; --bit) { const unsigned cand = T | (1u << bit); if (__builtin_popcountll(__ballot(key >= cand)) >= 16) T = cand; }
            const unsigned long long gt = __ballot(key > T), eq = __ballot(key == T);
            const int need = 16 - __builtin_popcountll(gt);
            const int before = (int)__builtin_amdgcn_mbcnt_hi((unsigned)(eq >> 32), __builtin_amdgcn_mbcnt_lo((unsigned)eq, 0u));
            const bool sel = (key > T) || ((key == T) && (before < need));
            const unsigned long long mk = __ballot(sel && (scv > -0.5e9f));
            wu |= mk;
            if (lane == 0) { MASK[2 * (8 * wid + k)] = (unsigned)mk; MASK[2 * (8 * wid + k) + 1] = (unsigned)(mk >> 32); }
        }
    }
    if (lane == 0) { WU[2 * wid] = (unsigned)wu; WU[2 * wid + 1] = (unsigned)(wu >> 32); }
    NSA_WAIT_BAR();
    unsigned long long uni = 0ull;
#pragma unroll
    for (int w = 0; w < 8; ++w) uni |= ((unsigned long long)WU[2 * w]) | (((unsigned long long)WU[2 * w + 1]) << 32);
    uni = ((unsigned long long)__builtin_amdgcn_readfirstlane((unsigned)uni)) | (((unsigned long long)__builtin_amdgcn_readfirstlane((unsigned)(uni >> 32))) << 32);
    const unsigned long long mymask = ((unsigned long long)MASK[2 * tl]) | (((unsigned long long)MASK[2 * tl + 1]) << 32);
    {
        state_init(st);
        unsigned long long rem = uni;
        int j = 63 - __builtin_clzll(rem); rem &= ~(1ull << j);
        for (int i = 0;; ++i) {
            const int slot = (tc + i) & 1; const bool more = rem != 0ull;
            int jn = 0;
            if (more) { jn = 63 - __builtin_clzll(rem); rem &= ~(1ull << jn); NSA_DMA_K(KSb, jn, slot ^ 1); NSA_DMA_V(VSb, jn, slot ^ 1); }
            if ((wu >> j) & 1ull) {
                const bool live = ((mymask >> j) & 1ull) != 0ull;
                const float rb0 = sl2 * (float)(64 * j - t0), mref = tile_ref(st, rb0, live), c0 = live ? rb0 + hoff_t - mref : -INFINITY;
                if (j == qt) tile_scores<1, 1, true>(p0, p1, Kbase + slot * SLOTB, qr, bk, c0, b32t, tl, r32, hi, vf, vb0 + slot * SLOTB);
                else tile_scores<1, 0, true>(p0, p1, Kbase + slot * SLOTB, qr, bk, c0, b32t, 0, r32, hi, vf, vb0 + slot * SLOTB);
                tile_softmax_pv(st, p0, p1, mref, vf, wsf, r32, hi);
            }
            NSA_WAIT_BAR();
            if (!more) break;
            j = jn;
        }
        if (wid == 0 && lane == 0) nxt_ticket = qbase + (int)__hip_atomic_fetch_add(qctr, 1u, __ATOMIC_RELAXED, __HIP_MEMORY_SCOPE_AGENT);
        fold_branch<false>(ostg, st, gate[1], wsf, r32, hi);
    }
    {
#pragma unroll
        for (int i = 0; i < 4; ++i) { const int row = i * 8 + (lane >> 3), ch = lane & 7;
            const f32x4_t v0 = *(LAS const f32x4_t*)(ostg + row * 64 + ch * 8), v1 = *(LAS const f32x4_t*)(ostg + row * 64 + ch * 8 + 4);
            u32x4_t v; v.x = cvtpk_s(v0[0], v0[1]); v.y = cvtpk_s(v0[2], v0[3]); v.z = cvtpk_s(v1[0], v1[1]); v.w = cvtpk_s(v1[2], v1[3]);
            *(u32x4_t*)(AB + (m0 + 8 * wid + (row >> 2)) * 2048 + 256 * g + (row & 3) * 64 + ch * 8) = v; }
    }
    NSA_WAIT_BAR();
#undef NSA_DMA_K
#undef NSA_DMA_V
    return nxt_ticket;
}
constexpr int L_QS = 145416;
__device__ __forceinline__ void nsa_phase(const Ptrs& P, LAS unsigned char* lds, int bid, int G, const int wave_s) {
    unsigned* qctr = (unsigned*)(P.ws + WS_CTL) + 3584;
    LAS int* qs = (LAS int*)(lds + L_QS);
    int k = bid;
    while (k < 1024 + LW_CHUNKS) {
        int nxt;
        if (k < 1024) {
            const int qt = 63 - (k >> 4), g = 3 - ((k >> 2) & 3), b = k & 3;
            nxt = nsa_unit(P, lds, b * 4 + g, qt, wave_s, qctr, G);
        } else {
            nxt = 0;
            if (wave_s == 0 && fresh_lane() == 0) nxt = G + (int)__hip_atomic_fetch_add(qctr, 1u, __ATOMIC_RELAXED, __HIP_MEMORY_SCOPE_AGENT);
            late_weight_chunk(P, lds, k - 1024, wave_s);
        }
        if (wave_s == 0 && fresh_lane() == 0) *qs = nxt;
        NSA_WAIT_BAR();
        k = __builtin_amdgcn_readfirstlane(*qs);
    }
}
}

namespace p2 {
using nsa::bf16x8; using nsa::f32x16; using nsa::s16x4; using nsa::crow; using nsa::glds16; using nsa::cvtpk_s;
#define P2_WAIT_BAR() asm volatile("s_waitcnt vmcnt(0) lgkmcnt(0)\n\ts_barrier" ::: "memory")
constexpr int CB_BUF = 40960;
constexpr int CP_STRIDE = 65;
__device__ __forceinline__ void compress_unit(const Ptrs& P, LAS unsigned char* lds, int u, const int wave_s) {
    unsigned char* ws = P.ws;
    const int lane = fresh_lane(), r32 = lane & 31, hi = lane >> 5, wid = wave_s;
    const int kv = u >> 6, bg = (u >> 2) & 15, n0 = 64 * (u & 3);
    const bf16_t* Ag = (const bf16_t*)(ws + WS_KV6) + (size_t)kv * KVSZ + (size_t)bg * SEQ * 64 + (size_t)n0 * 1024;
    const bf16_t* Bg = (const bf16_t*)(ws + WS_W1C) + (size_t)kv * 256 * 2048;
    const unsigned lds0 = (unsigned)(uintptr_t)lds;
    const unsigned aoff = (unsigned)(lane * 1024 + wid * 8) * 2u, boff = (unsigned)(lane * 2048 + wid * 8) * 2u;
    const unsigned dstw = lds0 + wid * 1024;
#define P2_DMA_TILE(kt, buf) do { const unsigned d_ = (unsigned)__builtin_amdgcn_readfirstlane(dstw + (buf) * CB_BUF); \
        glds16(Ag + (kt) * 64, aoff, d_); \
        _Pragma("unroll") for (int ct_ = 0; ct_ < 4; ++ct_) glds16(Bg + (size_t)ct_ * 64 * 2048 + (kt) * 64, boff, d_ + 8192u * (ct_ + 1)); } while (0)
    const int ct = wid >> 1, half = wid & 1, ncol0 = 64 * ct + 32 * half;
    f32x16 hT[2]; hT[0] = f32x16{}; hT[1] = f32x16{};
    P2_DMA_TILE(0, 0); P2_WAIT_BAR();
    for (int kt = 0; kt < 32; ++kt) {
        const int buf = kt & 1;
        if (kt + 1 < 32) P2_DMA_TILE(kt + 1, buf ^ 1);
        LAS const char* sa = (LAS const char*)(lds + buf * CB_BUF) + hi * 1024 + r32 * 16;
        LAS const char* sb = (LAS const char*)(lds + buf * CB_BUF + 8192 * (ct + 1)) + half * 512 + hi * 1024 + r32 * 16;
#pragma unroll
        for (int d0 = 0; d0 < 4; ++d0) {
            const bf16x8 bf = *(LAS const bf16x8*)(sb + d0 * 2048), a0 = *(LAS const bf16x8*)(sa + d0 * 2048), a1 = *(LAS const bf16x8*)(sa + d0 * 2048 + 512);
            hT[0] = __builtin_amdgcn_mfma_f32_32x32x16_bf16(bf, a0, hT[0], 0, 0, 0);
            hT[1] = __builtin_amdgcn_mfma_f32_32x32x16_bf16(bf, a1, hT[1], 0, 0, 0);
        }
        P2_WAIT_BAR();
    }
    const float* bias1 = (const float*)(ws + WS_SMALL + SM_BIAS1) + kv * 256 + ncol0;
    bf16x8 hb[2][2];
#pragma unroll
    for (int mt = 0; mt < 2; ++mt) {
        float g[16];
#pragma unroll
        for (int r = 0; r < 16; ++r) g[r] = gelu_tanh(hT[mt][r] + bias1[crow(r, hi)]);
#pragma unroll
        for (int s = 0; s < 2; ++s) { u32x4_t w; w.x = cvtpk_s(g[8 * s], g[8 * s + 1]); w.y = cvtpk_s(g[8 * s + 2], g[8 * s + 3]); w.z = cvtpk_s(g[8 * s + 4], g[8 * s + 5]); w.w = cvtpk_s(g[8 * s + 6], g[8 * s + 7]);
            hb[mt][s] = __builtin_bit_cast(bf16x8, w); }
    }
    const bf16_t* w2t = (const bf16_t*)(ws + WS_SMALL + SM_W2T) + (size_t)kv * 64 * 256;
    f32x16 oT[2][2];
#pragma unroll
    for (int dt = 0; dt < 2; ++dt)
#pragma unroll
        for (int mt = 0; mt < 2; ++mt) oT[dt][mt] = f32x16{};
#pragma unroll
    for (int dt = 0; dt < 2; ++dt)
#pragma unroll
        for (int s = 0; s < 2; ++s) {
            const bf16_t* wp = w2t + (size_t)(32 * dt + r32) * 256 + ncol0 + 16 * s + 4 * hi;
            const u32x2_t lo = *(const u32x2_t*)wp, hi2 = *(const u32x2_t*)(wp + 8);
            const u32x4_t wv = {lo.x, lo.y, hi2.x, hi2.y}; const bf16x8 wf = __builtin_bit_cast(bf16x8, wv);
#pragma unroll
            for (int mt = 0; mt < 2; ++mt) oT[dt][mt] = __builtin_amdgcn_mfma_f32_32x32x16_bf16(wf, hb[mt][s], oT[dt][mt], 0, 0, 0);
        }
    LAS float* part = (LAS float*)lds + wid * 64 * CP_STRIDE;
#pragma unroll
    for (int dt = 0; dt < 2; ++dt)
#pragma unroll
        for (int mt = 0; mt < 2; ++mt)
#pragma unroll
            for (int r = 0; r < 16; ++r) part[(32 * mt + r32) * CP_STRIDE + 32 * dt + crow(r, hi)] = oT[dt][mt][r];
    P2_WAIT_BAR();
    {
        const int tid = wid * 64 + lane, m = tid >> 3, dg = tid & 7;
        float o[8];
#pragma unroll
        for (int e = 0; e < 8; ++e) { float s = 0.f;
#pragma unroll
            for (int w = 0; w < 8; ++w) s += ((LAS const float*)lds)[(w * 64 + m) * CP_STRIDE + 8 * dg + e];
            o[e] = s; }
        if (kv == 0) {
            float ss = 0.f;
#pragma unroll
            for (int e = 0; e < 8; ++e) ss += o[e] * o[e];
            ss += __shfl_xor(ss, 1); ss += __shfl_xor(ss, 2); ss += __shfl_xor(ss, 4);
            const float rr = __builtin_amdgcn_rsqf(ss * (1.0f / 64.0f) + 1e-6f);
#pragma unroll
            for (int e = 0; e < 8; ++e) o[e] *= rr * P.in[4][8 * dg + e];
        }
        const int n = n0 + m;
        u32x4_t v = {0u, 0u, 0u, 0u};
        if (n < 255) { v.x = cvtpk_s(o[0], o[1]); v.y = cvtpk_s(o[2], o[3]); v.z = cvtpk_s(o[4], o[5]); v.w = cvtpk_s(o[6], o[7]); }
        *(u32x4_t*)((bf16_t*)(ws + (kv ? WS_VC : WS_KC)) + ((size_t)bg * 256 + n) * 64 + 8 * dg) = v;
    }
    P2_WAIT_BAR();
#undef P2_DMA_TILE
}

constexpr int G_V = 0, G_ST = 32768, G_OST = 33792, G_END = 33792 + 65536;
__device__ __forceinline__ void gmlp_unit(const Ptrs& P, LAS unsigned char* lds, int unit, const int wave_s) {
    unsigned char* ws = P.ws;
    const int lane = fresh_lane(), r32 = lane & 31, hi = lane >> 5, wid = wave_s, tid = wid * 64 + lane;
    const int g = unit & 7, chunk = (unit >> 3) & 31, b = unit >> 8; const int m0 = b * SEQ + chunk * 128;
    const bf16_t* GV = (const bf16_t*)(ws + WS_GV); const bf16_t* U = (const bf16_t*)(ws + WS_U); const float* VSTAT = (const float*)(ws + WS_VSTAT);
    const bf16_t* SWB = (const bf16_t*)(ws + WS_SMALL + SM_SWB) + (size_t)g * 16384;
    bf16_t* AB = (bf16_t*)(ws + WS_AB);
    const float* ln_w = P.in[8]; const float* ln_b = P.in[9]; const float* sbp = P.in[11];
    LAS float* st = (LAS float*)(lds + G_ST);
    if (tid < 128) { const float* p = VSTAT + (size_t)(m0 + tid) * 32; float s1 = 0.f, s2 = 0.f;
#pragma unroll
        for (int i = 0; i < 16; ++i) { s1 += p[2 * i]; s2 += p[2 * i + 1]; }
        const float mean = s1 * (1.0f / 1024.0f); float var = s2 * (1.0f / 1024.0f) - mean * mean; var = var < 0.f ? 0.f : var;
        st[2 * tid] = mean; st[2 * tid + 1] = __builtin_amdgcn_rsqf(var + 1e-5f); }
    P2_WAIT_BAR();
#pragma unroll
    for (int i = 0; i < 4; ++i) { const int idx = tid + 512 * i, s = idx >> 4, c8 = idx & 15;
        const u32x4_t raw = *(const u32x4_t*)(GV + (size_t)(m0 + s) * 1024 + g * 128 + 8 * c8); float f[8]; unpack8(raw, f);
        const float mean = st[2 * s], rstd = st[2 * s + 1];
        const f32x4_t w0 = *(const f32x4_t*)(ln_w + g * 128 + 8 * c8), w1 = *(const f32x4_t*)(ln_w + g * 128 + 8 * c8 + 4), b0 = *(const f32x4_t*)(ln_b + g * 128 + 8 * c8), b1 = *(const f32x4_t*)(ln_b + g * 128 + 8 * c8 + 4);
        float y[8];
#pragma unroll
        for (int e = 0; e < 4; ++e) { y[e] = (f[e] - mean) * rstd * w0[e] + b0[e]; y[4 + e] = (f[4 + e] - mean) * rstd * w1[e] + b1[e]; }
        u32x4_t o; o.x = cvtpk_s(y[0], y[1]); o.y = cvtpk_s(y[2], y[3]); o.z = cvtpk_s(y[4], y[5]); o.w = cvtpk_s(y[6], y[7]);
        const int st_ = s >> 6, sk = s & 63, ch = c8 >> 3, x = c8 & 7;
        *(LAS u32x4_t*)(lds + G_V + (st_ * 2 + ch) * 8192 + (x >> 2) * 4096 + (sk >> 4) * 1024 + (sk & 15) * 64 + (x & 3) * 16) = o; }
    P2_WAIT_BAR();
    const int tb = wid >> 1, ch = wid & 1;
    f32x16 o[2]; o[0] = f32x16{}; o[1] = f32x16{};
    const int vb0 = (int)((unsigned)(uintptr_t)lds + G_V) + ((lane >> 4) & 1) * 32 + (lane & 3) * 8 + (4 * hi + ((lane & 15) >> 2)) * 64;
    const int nst = tb >= 2 ? 2 : 1;
    for (int st_ = 0; st_ < nst; ++st_) {
        bf16x8 pa[4];
#pragma unroll
        for (int ks = 0; ks < 4; ++ks) {
            const bf16_t* wp = SWB + (size_t)(32 * tb + r32) * 128 + 64 * st_ + 16 * ks + 4 * hi;
            const u32x2_t lo = *(const u32x2_t*)wp, hi2 = *(const u32x2_t*)(wp + 8);
            const u32x4_t wv = {lo.x, lo.y, hi2.x, hi2.y}; pa[ks] = __builtin_bit_cast(bf16x8, wv); }
        nsa::pv(o, vb0 + (st_ * 2 + ch) * 8192, pa[0], pa[1], pa[2], pa[3]);
    }
    LAS float* ostg = (LAS float*)(lds + G_OST) + wid * 2048;
#pragma unroll
    for (int r = 0; r < 16; ++r) { const int orow = crow(r, hi);
#pragma unroll
        for (int d0 = 0; d0 < 2; ++d0) ostg[orow * 64 + d0 * 32 + r32] = o[d0][r]; }
    asm volatile("s_waitcnt lgkmcnt(0)" ::: "memory");
#pragma unroll
    for (int i = 0; i < 4; ++i) { const int row = i * 8 + (lane >> 3), c8 = lane & 7, t = 32 * tb + row;
        const f32x4_t v0 = *(LAS const f32x4_t*)(ostg + row * 64 + c8 * 8), v1 = *(LAS const f32x4_t*)(ostg + row * 64 + c8 * 8 + 4);
        const size_t grow = (size_t)(m0 + t); const int col = g * 128 + 64 * ch + 8 * c8;
        float uf[8]; unpack8(*(const u32x4_t*)(U + grow * 1024 + col), uf);
        const float sbv = sbp[g * 128 + t];
        u32x4_t w; w.x = cvtpk_s(uf[0] * (v0[0] + sbv), uf[1] * (v0[1] + sbv)); w.y = cvtpk_s(uf[2] * (v0[2] + sbv), uf[3] * (v0[3] + sbv));
        w.z = cvtpk_s(uf[4] * (v1[0] + sbv), uf[5] * (v1[1] + sbv)); w.w = cvtpk_s(uf[6] * (v1[2] + sbv), uf[7] * (v1[3] + sbv));
        *(u32x4_t*)(AB + grow * 2048 + 1024 + col) = w; }
    P2_WAIT_BAR();
}
#undef P2_WAIT_BAR
}

#define XB_TMO      128
#define XB_XCNT(j)  (256  + 64 * (j))
#define XB_XSUB(j)  (1280 + 64 * (j))
#define XB_XGEN(j)  (2304 + 64 * (j))
#define XB_TOP      3328
#define XB_TOPGEN   3392
#define XCD_BAR_WORDS 3456
#define XB_SPIN_CAP (1u << 18)

__device__ __forceinline__ unsigned xb_ld(unsigned* p)              { return __hip_atomic_load(p, __ATOMIC_RELAXED, __HIP_MEMORY_SCOPE_AGENT); }
__device__ __forceinline__ unsigned xb_add(unsigned* p, unsigned v) { return __hip_atomic_fetch_add(p, v, __ATOMIC_RELAXED, __HIP_MEMORY_SCOPE_AGENT); }
__device__ __forceinline__ unsigned xb_xcc_id() { return (unsigned)__builtin_amdgcn_s_getreg((3 << 11) | 20) & 0xFu; }
#define XB_SPIN(cond, bar) do { unsigned _sp = 0; while (cond) { __builtin_amdgcn_s_sleep(1); \
    if ((++_sp & 255u) == 0u) { if (xb_ld(&(bar)[XB_TMO])) break; if (_sp > XB_SPIN_CAP) { atomicAdd(&(bar)[XB_TMO], 1u); break; } } } } while (0)

struct XcdBarrier {
    unsigned* bar; unsigned x; unsigned w0;
    volatile LAS unsigned* st;
};

__device__ __forceinline__ XcdBarrier xcd_barrier_post(unsigned* bar, volatile LAS unsigned* st, int wave_s) {
    XcdBarrier b; b.bar = bar; b.x = xb_xcc_id(); b.st = st; b.w0 = wave_s == 0 ? 1u : 0u;
    if (b.w0 && fresh_lane() == 0) (void)xb_add(&bar[XB_XCNT(b.x)], 1u);
    return b;
}
__device__ __forceinline__ void xcd_barrier_complete(unsigned* bar, unsigned x, unsigned& nloc, unsigned& nx) {
    const unsigned G = gridDim.x * gridDim.y * gridDim.z;
    unsigned sum, cnt, mine, sp = 0u;
    for (;;) {
        sum = 0u; cnt = 0u; mine = 0u;
#pragma unroll
        for (unsigned j = 0; j < 16; ++j) { const unsigned c = xb_ld(&bar[XB_XCNT(j)]); sum += c; cnt += (c > 0u) ? 1u : 0u; mine = (j == x) ? c : mine; }
        if (sum == G) break;
        __builtin_amdgcn_s_sleep(1);
        if ((++sp & 255u) == 0u) { if (xb_ld(&bar[XB_TMO])) break; if (sp > XB_SPIN_CAP) { atomicAdd(&bar[XB_TMO], 1u); break; } }
    }
    nloc = mine > 0u ? mine : 1u; nx = cnt > 0u ? cnt : 1u;
}

__device__ __forceinline__ void xcd_barrier(const XcdBarrier& b) {
    asm volatile("s_waitcnt vmcnt(0)" ::: "memory");
    __syncthreads();
    if (b.w0 && fresh_lane() == 0) {
        unsigned* bar = b.bar;
        __builtin_amdgcn_s_waitcnt(0);
        unsigned nloc = b.st[0], nx = b.st[1];
        if (nloc == 0u) { xcd_barrier_complete(bar, b.x, nloc, nx); b.st[0] = nloc; b.st[1] = nx; }
        const unsigned old = xb_add(&bar[XB_XSUB(b.x)], 1u);
        const unsigned gen = old / nloc;
        if (old + 1u == (gen + 1u) * nloc) {
            __builtin_amdgcn_fence(__ATOMIC_RELEASE, "agent");
            asm volatile("s_waitcnt vmcnt(0)" ::: "memory");
            const unsigned og = xb_add(&bar[XB_TOP], 1u);
            const unsigned tg = og / nx;
            if (og + 1u == (tg + 1u) * nx) xb_add(&bar[XB_TOPGEN], 1u);
            else XB_SPIN(xb_ld(&bar[XB_TOPGEN]) == tg, bar);
            __builtin_amdgcn_fence(__ATOMIC_ACQUIRE, "agent");
            xb_add(&bar[XB_XGEN(b.x)], 1u);
            asm volatile("s_waitcnt vmcnt(0)" ::: "memory");
        } else {
            XB_SPIN(xb_ld(&bar[XB_XGEN(b.x)]) == gen, bar);
            __builtin_amdgcn_fence(__ATOMIC_ACQUIRE, "agent");
            asm volatile("s_waitcnt vmcnt(0)" ::: "memory");
        }
    }
    __syncthreads();
}

constexpr int LDS_BYTES = 147456;
constexpr int LDS_XCH = 132096;
constexpr int LDS_MISC = 145408;
__global__ void __launch_bounds__(512, 2) mega_fwd(Ptrs P) {
    extern __shared__ __attribute__((aligned(16))) unsigned char lds_raw[];
    LAS unsigned char* lds = (LAS unsigned char*)lds_raw;
    unsigned char* ws = P.ws;
    const int wave = __builtin_amdgcn_readfirstlane(threadIdx.x >> 6);
    const int G = gridDim.x, bid = blockIdx.x;
    if (wave == 0) { const int l_ = fresh_lane(); if (l_ < 2) ((LAS unsigned*)(lds + LDS_MISC))[l_] = 0u; }
    __syncthreads();
    const XcdBarrier bar = xcd_barrier_post((unsigned*)(ws + WS_CTL), (volatile LAS unsigned*)(lds + LDS_MISC), wave);
    p0_prologue(P, lds, bid, G, wave);
    xcd_barrier(bar);
    if (bid == 0) bias1_stage(ws, fresh_tid(wave));
    {
        pg8::Gemm g{(const bf16_t*)(ws + WS_XN), (const bf16_t*)(ws + WS_WIN), MTOK, NPROJ, 2048, 2048};
        pg8::StaticOrder S; S.init(MTOK, NPROJ, G, bid);
        pg8::EpiProj E{(bf16_t*)(ws + WS_Q), (bf16_t*)(ws + WS_KV6), (bf16_t*)(ws + WS_U), (bf16_t*)(ws + WS_GV), (float*)(ws + WS_GATES), (float*)(ws + WS_VSTAT), P.in[3], P.in[4]};
        pg8::gemm_phase<pg8::EpiProj, pg8::StaticOrder, true, true>(lds, g, S, E, wave);
    }
    xcd_barrier(bar);
    if (bid < 128 && G >= 256) p2::compress_unit(P, lds, bid, wave);
    else if (G >= 256) { for (int u = bid - 128; u < 1024; u += G - 128) p2::gmlp_unit(P, lds, u, wave); }
    xcd_barrier(bar);
    nsa::nsa_phase(P, lds, bid, G, wave);
    xcd_barrier(bar);
    {
        pg8::Gemm g{(const bf16_t*)(ws + WS_AB), (const bf16_t*)(ws + WS_WOUT), MTOK, 2048, 2048, 2048};
        pg8::StaticOrder S; S.init(MTOK, 2048, G, bid);
        pg8::EpiRes1 E{P.in[0], P.out, (bf16_t*)(ws + WS_XN), (float*)(ws + WS_SSQ)};
        pg8::gemm_phase<pg8::EpiRes1, pg8::StaticOrder, true, true>(lds, g, S, E, wave);
    }
    xcd_barrier(bar);
    for (int m = bid * 512 + fresh_tid(wave); m < MTOK; m += G * 512) {
        const float* p = (const float*)(ws + WS_SSQ) + (size_t)m * 32; float s = 0.f;
#pragma unroll
        for (int i = 0; i < 32; ++i) s += p[i];
        ((float*)(ws + WS_SMALL + SM_R2))[m] = __builtin_amdgcn_rsqf(s * (1.0f / D_MODEL) + 1e-6f);
    }
    xcd_barrier(bar);
    {
        pg8::Gemm g{(const bf16_t*)(ws + WS_XN), (const bf16_t*)(ws + WS_WUP), MTOK, N_UP, 2048, 2048};
        pg8::StaticOrder S; S.init(MTOK, N_UP, G, bid);
        pg8::EpiUpConv E{(bf16_t*)(ws + WS_G), (const float*)(ws + WS_SMALL + SM_R2), P.in[15], P.in[16], (float*)(ws + WS_HLAST), (float*)(ws + WS_FIRST), lds + LDS_XCH};
        pg8::gemm_phase<pg8::EpiUpConv, pg8::StaticOrder, true, true>(lds, g, S, E, wave);
    }
    xcd_barrier(bar);
    for (int it = bid * 512 + fresh_tid(wave); it < 60 * 44 * 2 * 16; it += G * 512) {
        const int c8 = it & 15, row = (it >> 4) & 1, tl_ = it >> 5, pn = tl_ % 44, pmi = tl_ / 44, pm = pmi + pmi / 15 + 1;
        const float* cw = P.in[15]; const float* cb = P.in[16]; (void)cb;
        const float* fp = (const float*)(ws + WS_FIRST) + ((size_t)(pm * 44 + pn) * 2 + row) * 256 + 8 * c8;
        const float* lp = (const float*)(ws + WS_HLAST) + ((size_t)((pm - 1) * 44 + pn) * 2) * 256 + 8 * c8;
        const int ch = pn * 128 + 8 * c8;
        float r[8];
#pragma unroll
        for (int e = 0; e < 8; ++e) {
            const float l0g = lp[e], l1g = lp[256 + e], l0u = lp[128 + e], l1u = lp[256 + 128 + e];
            const float w0g = cw[ch + e], w1g = cw[N_UP + ch + e], w0u = cw[D_FF + ch + e], w1u = cw[N_UP + D_FF + ch + e];
            const float cg = fp[e] + (row == 0 ? w1g * l1g + w0g * l0g : w0g * l1g), cu = fp[128 + e] + (row == 0 ? w1u * l1u + w0u * l0u : w0u * l1u);
            r[e] = cg * sigmoidf_(cg) * cu;
        }
        u32x4_t o; o.x = pk2(r[0], r[1]); o.y = pk2(r[2], r[3]); o.z = pk2(r[4], r[5]); o.w = pk2(r[6], r[7]);
        *(u32x4_t*)((bf16_t*)(ws + WS_G) + (size_t)(pm * 256 + row) * D_FF + ch) = o;
    }
    xcd_barrier(bar);
    {
        pg8::Gemm g{(const bf16_t*)(ws + WS_G), (const bf16_t*)(ws + WS_WDOWN), MTOK, 2048, D_FF, D_FF};
        pg8::StaticOrder S; S.init(MTOK, 2048, G, bid);
        pg8::EpiDown E{P.out, (const bf16_t*)(ws + WS_XN)};
        pg8::gemm_phase<pg8::EpiDown, pg8::StaticOrder, true, true>(lds, g, S, E, wave);
    }
}

extern "C" void kernel_launch(void* const* d_in, const int* in_sizes, int n_in, void* d_out, int out_size, void* d_ws, size_t ws_size, hipStream_t stream) {
    static int grid_blocks = 0;
    if (!grid_blocks) {
        int dev = 0, cus = 0, per_cu = 0;
        (void)hipGetDevice(&dev);
        (void)hipDeviceGetAttribute(&cus, hipDeviceAttributeMultiprocessorCount, dev);
        (void)hipFuncSetAttribute((const void*)mega_fwd, hipFuncAttributeMaxDynamicSharedMemorySize, LDS_BYTES);
        (void)hipOccupancyMaxActiveBlocksPerMultiprocessor(&per_cu, (const void*)mega_fwd, 512, LDS_BYTES);
        if (per_cu < 1) { fprintf(stderr, "kernel_launch: occupancy query says %d blocks/CU\n", per_cu); per_cu = 1; }
        grid_blocks = cus * 1;
        (void)hipGetLastError();
    }
    if (n_in != 18 || ws_size < WS_END) { fprintf(stderr, "kernel_launch: unexpected n_in %d / ws %zu\n", n_in, ws_size); return; }
    Ptrs P{};
    for (int i = 0; i < 18; ++i) P.in[i] = (const float*)d_in[i];
    P.out = (float*)d_out; P.ws = (unsigned char*)d_ws;
    (void)hipMemsetAsync((char*)d_ws + WS_CTL, 0, 16384, stream);
    mega_fwd<<<dim3(grid_blocks), dim3(512), LDS_BYTES, stream>>>(P);
}
```

```cpp
#include <hip/hip_runtime.h>
#include <cstdio>
#include <cstdint>

constexpr int D_MODEL = 2048, BATCH = 4, SEQ = 4096, MTOK = BATCH * SEQ;
constexpr int IN_COLS = 4656, NPROJ = 4864;
constexpr int D_FF = 5632, N_UP = 2 * D_FF;
constexpr int NBG = 16;
constexpr size_t KVSZ = (size_t)NBG * SEQ * 64;
constexpr float LOG2E = 1.4426950408889634f;

constexpr size_t MiB = 1u << 20;
constexpr size_t WS_CTL = 0;
constexpr size_t WS_WIN = 1 * MiB, WS_WOUT = 20 * MiB, WS_WUP = 28 * MiB, WS_WDOWN = 72 * MiB, WS_W1C = 94 * MiB;
constexpr size_t WS_SMALL = 96 * MiB;
constexpr size_t SM_BIASP = 0, SM_BIAS1 = 65536, SM_R2 = 131072, SM_W2T = 196608  , SM_SWB = 262144  ;
constexpr size_t WS_XN = 97 * MiB;
constexpr size_t WS_Q = 161 * MiB;
constexpr size_t WS_KV6 = 193 * MiB;
constexpr size_t WS_U = 241 * MiB, WS_GV = 273 * MiB;
constexpr size_t WS_GATES = 305 * MiB;
constexpr size_t WS_VSTAT = 308 * MiB;
constexpr size_t WS_KC = 310 * MiB, WS_VC = 310 * MiB + 524288;
constexpr size_t WS_HC = 311 * MiB;
constexpr size_t WS_AB = 315 * MiB;
constexpr size_t WS_SSQ = 379 * MiB;
constexpr size_t WS_G = 161 * MiB;
constexpr size_t WS_HID = 381 * MiB;
constexpr size_t WS_HLAST = 381 * MiB, WS_FIRST = 388 * MiB;
constexpr size_t WS_END = 469 * MiB;

#define LAS __attribute__((address_space(3)))
typedef unsigned short bf16_t;
typedef unsigned u32x4_t __attribute__((ext_vector_type(4)));
typedef unsigned u32x2_t __attribute__((ext_vector_type(2)));
typedef float f32x4_t __attribute__((ext_vector_type(4)));

__device__ __forceinline__ float bf2f(unsigned short h) { return __uint_as_float(((unsigned)h) << 16); }
__device__ __forceinline__ unsigned f2bf(float f) { unsigned u = __float_as_uint(f); return (u + 0x7fffu + ((u >> 16) & 1u)) >> 16; }
__device__ __forceinline__ unsigned pk2(float lo, float hi) { return f2bf(lo) | (f2bf(hi) << 16); }
__device__ __forceinline__ float gelu_tanh(float x) {
    const float u = 0.7978845608028654f * (x + 0.044715f * x * x * x);
    const float e = __builtin_amdgcn_exp2f(-2.8853900817779268f * u);
    return x * __builtin_amdgcn_rcpf(1.0f + e);
}
__device__ __forceinline__ float sigmoidf_(float x) { return __builtin_amdgcn_rcpf(1.0f + __builtin_amdgcn_exp2f(-LOG2E * x)); }
__device__ __forceinline__ float wave_sum(float v) {
#pragma unroll
    for (int o = 1; o < 64; o <<= 1) v += __shfl_xor(v, o);
    return v;
}
__device__ __forceinline__ void unpack8(u32x4_t r, float (&f)[8]) {
    f[0] = __uint_as_float(r.x << 16); f[1] = __uint_as_float(r.x & 0xffff0000u);
    f[2] = __uint_as_float(r.y << 16); f[3] = __uint_as_float(r.y & 0xffff0000u);
    f[4] = __uint_as_float(r.z << 16); f[5] = __uint_as_float(r.z & 0xffff0000u);
    f[6] = __uint_as_float(r.w << 16); f[7] = __uint_as_float(r.w & 0xffff0000u);
}

__device__ __forceinline__ int fresh_lane() { unsigned z_ = 0u; asm volatile("" : "+v"(z_)); return (int)__builtin_amdgcn_mbcnt_hi(~0u, __builtin_amdgcn_mbcnt_lo(~0u, z_)); }
__device__ __forceinline__ int fresh_tid(int wave_s) { return wave_s * 64 + fresh_lane(); }
namespace pg8 {
#define PG8_LAS __attribute__((address_space(3)))
typedef unsigned short bf16_t;
typedef short bf16x8 __attribute__((ext_vector_type(8)));
typedef float f32x4 __attribute__((ext_vector_type(4)));
typedef unsigned u32x4 __attribute__((ext_vector_type(4)));
constexpr int BM = 256, BK = 64, HALF = 128, HTB = HALF * BK * 2  , STAGE_BYTES = 8 * HTB, NXCD = 8, WGM = 8;

__host__ __device__ __forceinline__ int lds_byte(int r, int c) { const int st = (r >> 4) * 2 + (c >> 5), rr = r & 15, cc = c & 31, ob = rr * 64 + cc * 2; return st * 1024 + (ob ^ (((ob >> 9) & 1) << 5)); }
__host__ __device__ __forceinline__ void stage_rc(int b, int& R, int& C) { const int st = b / 1024, sb = b % 1024, swz = sb ^ (((sb >> 9) & 1) << 5); R = (st >> 1) * 16 + swz / 64; C = (st & 1) * 32 + (swz % 64) / 2; }
__host__ __device__ __forceinline__ int perm32(int rho) { const int n = rho >> 4, i = rho & 15; return 8 * (i >> 2) + 4 * n + (i & 3); }

struct Unit { int pm, pn; };
struct Gemm { const bf16_t* A; const bf16_t* Bt; int M, N, K, lda; };

struct StaticOrder {
    int nM, nN, nwg, G, c;
    __host__ __device__ void init(int M, int N, int G_, int c_) { nM = M / BM; nN = N / BM; nwg = nM * nN; G = G_; c = c_; }
    __host__ __device__ bool next(int i, Unit& u) const {
        const long L = (long)i * G + c; if (L >= nwg) return false;
        int wgid = (int)L; { const int q = nwg / NXCD, r = nwg % NXCD, xcd = wgid % NXCD, off = wgid / NXCD; wgid = (xcd < r ? xcd * (q + 1) : r * (q + 1) + (xcd - r) * q) + off; }
        const int nig = WGM * nN, gid = wgid / nig, fm = gid * WGM, gsz = (nM - fm) < WGM ? (nM - fm) : WGM;
        u.pm = fm + ((wgid % nig) % gsz); u.pn = (wgid % nig) / gsz; return true;
    }
    __device__ __forceinline__ void a_ready(const Unit&) const {}
    __device__ __forceinline__ void done(const Unit&) const {}
};

__device__ __forceinline__ unsigned cvt_pk_bf16(float lo, float hi) { unsigned r; asm volatile("v_cvt_pk_bf16_f32 %0, %1, %2" : "=v"(r) : "v"(lo), "v"(hi)); return r; }

struct EpiProj {
    static constexpr bool PERM = true, AFTER_DRAIN = false;
    bf16_t* Q; bf16_t* KV6; bf16_t* U; bf16_t* GV; float* GATES; float* VSTAT; const float* q_norm_w; const float* k_norm_w;
    __device__ __forceinline__ void operator()(const f32x4 (&acc)[2][2][4][2], const Unit& u, int wr, int wc, int fr, int fq) const {
        const int pn = u.pn, row0 = u.pm * BM + wr * 64 + fr;
        if (pn < 10) {
            const bool normed = (pn < 4) || pn == 6 || pn == 8;
            const float* w = pn < 4 ? q_norm_w : (k_norm_w + (pn == 6 ? 64 : 128));
            const float sc = pn < 4 ? 0.125f * LOG2E : 1.0f;
            f32x4 wv[2][2];
#pragma unroll
            for (int bj = 0; bj < 2; ++bj)
#pragma unroll
                for (int n = 0; n < 2; ++n) wv[bj][n] = normed ? (*(const f32x4*)(w + 32 * bj + 8 * fq + 4 * n)) * sc : (f32x4){1.f, 1.f, 1.f, 1.f};
#pragma unroll
            for (int ai = 0; ai < 2; ++ai)
#pragma unroll
                for (int m = 0; m < 4; ++m) {
                    const int row = row0 + ai * HALF + m * 16;
                    float r = 1.f;
                    if (normed) {
                        float ss = 0.f;
#pragma unroll
                        for (int bj = 0; bj < 2; ++bj)
#pragma unroll
                            for (int n = 0; n < 2; ++n) { const f32x4 x = acc[ai][bj][m][n]; ss += (x[0] * x[0] + x[1] * x[1]) + (x[2] * x[2] + x[3] * x[3]); }
                        ss += __shfl_xor(ss, 16); ss += __shfl_xor(ss, 32);
                        r = __builtin_amdgcn_rsqf(ss * (1.0f / 64.0f) + 1e-6f);
                    }
                    bf16_t* dst;
                    if (pn < 4) dst = Q + (size_t)row * 1024 + pn * 256 + wc * 64 + 8 * fq;
                    else { const int b = row >> 12, t = row & 4095; dst = KV6 + (size_t)(pn - 4) * KVSZ + ((size_t)((b * 4 + wc) * 4096 + t)) * 64 + 8 * fq; }
#pragma unroll
                    for (int bj = 0; bj < 2; ++bj) {
                        const f32x4 v0 = acc[ai][bj][m][0] * r * wv[bj][0], v1 = acc[ai][bj][m][1] * r * wv[bj][1];
                        u32x4 o; o.x = cvt_pk_bf16(v0[0], v0[1]); o.y = cvt_pk_bf16(v0[2], v0[3]); o.z = cvt_pk_bf16(v1[0], v1[1]); o.w = cvt_pk_bf16(v1[2], v1[3]);
                        *(u32x4*)(dst + 32 * bj) = o;
                    }
                }
        } else if (pn < 18) {
            const bool isv = pn >= 14; const int ct = isv ? pn - 14 : pn - 10;
            bf16_t* base = (isv ? GV : U) + ct * 256 + wc * 64 + 8 * fq;
#pragma unroll
            for (int ai = 0; ai < 2; ++ai)
#pragma unroll
                for (int m = 0; m < 4; ++m) {
                    const int row = row0 + ai * HALF + m * 16; float s1 = 0.f, s2 = 0.f;
#pragma unroll
                    for (int bj = 0; bj < 2; ++bj) {
                        f32x4 v0 = acc[ai][bj][m][0], v1 = acc[ai][bj][m][1];
#pragma unroll
                        for (int e = 0; e < 4; ++e) { v0[e] = gelu_tanh(v0[e]); v1[e] = gelu_tanh(v1[e]); s1 += v0[e] + v1[e]; s2 += v0[e] * v0[e] + v1[e] * v1[e]; }
                        u32x4 o; o.x = cvt_pk_bf16(v0[0], v0[1]); o.y = cvt_pk_bf16(v0[2], v0[3]); o.z = cvt_pk_bf16(v1[0], v1[1]); o.w = cvt_pk_bf16(v1[2], v1[3]);
                        *(u32x4*)(base + (size_t)row * 1024 + 32 * bj) = o;
                    }
                    if (isv) {
                        s1 += __shfl_xor(s1, 16); s1 += __shfl_xor(s1, 32); s2 += __shfl_xor(s2, 16); s2 += __shfl_xor(s2, 32);
                        if (fq == 0) { float* p = VSTAT + ((size_t)row * 16 + ct * 4 + wc) * 2; p[0] = s1; p[1] = s2; }
                    }
                }
        } else {
            if (wc == 0) {
#pragma unroll
                for (int ai = 0; ai < 2; ++ai)
#pragma unroll
                    for (int m = 0; m < 4; ++m) {
                        const int row = row0 + ai * HALF + m * 16;
#pragma unroll
                        for (int bj = 0; bj < 2; ++bj)
#pragma unroll
                            for (int n = 0; n < 2; ++n) {
                                const int L = 32 * bj + 8 * fq + 4 * n;
                                if (L < 48) { f32x4 v = acc[ai][bj][m][n]; f32x4 o; o[0] = sigmoidf_(v[0]); o[1] = sigmoidf_(v[1]); o[2] = sigmoidf_(v[2]); o[3] = sigmoidf_(v[3]); *(f32x4*)(GATES + (size_t)row * 48 + L) = o; }
                            }
                    }
            }
        }
    }
};
struct EpiCmp {
    static constexpr bool PERM = true, AFTER_DRAIN = false;
    bf16_t* HC; const float* bias1;
    __device__ __forceinline__ void operator()(const f32x4 (&acc)[2][2][4][2], const Unit& u, int wr, int wc, int fr, int fq) const {
        const int row0 = u.pm * BM + wr * 64 + fr, col0 = wc * 32 + 8 * fq;
        f32x4 bv[2][2];
#pragma unroll
        for (int bj = 0; bj < 2; ++bj)
#pragma unroll
            for (int n = 0; n < 2; ++n) bv[bj][n] = *(const f32x4*)(bias1 + u.pn * 256 + col0 + bj * HALF + 4 * n);
#pragma unroll
        for (int ai = 0; ai < 2; ++ai)
#pragma unroll
            for (int m = 0; m < 4; ++m) { bf16_t* rowp = HC + (size_t)(row0 + ai * HALF + m * 16) * 256 + col0;
#pragma unroll
                for (int bj = 0; bj < 2; ++bj) { f32x4 v0 = acc[ai][bj][m][0] + bv[bj][0], v1 = acc[ai][bj][m][1] + bv[bj][1];
#pragma unroll
                    for (int e = 0; e < 4; ++e) { v0[e] = gelu_tanh(v0[e]); v1[e] = gelu_tanh(v1[e]); }
                    u32x4 o; o.x = cvt_pk_bf16(v0[0], v0[1]); o.y = cvt_pk_bf16(v0[2], v0[3]); o.z = cvt_pk_bf16(v1[0], v1[1]); o.w = cvt_pk_bf16(v1[2], v1[3]);
                    *(u32x4*)(rowp + bj * HALF) = o; } }
    }
};
struct CmpOrder {
    int c, G;
    __device__ bool next(int i, Unit& u) const { const int L = i * G + c; if (L >= 32) return false; u.pm = L; u.pn = L >> 4; return true; }
    __device__ __forceinline__ void a_ready(const Unit&) const {}
    __device__ __forceinline__ void done(const Unit&) const {}
};
struct EpiRes1 {
    static constexpr bool PERM = false, AFTER_DRAIN = false;
    const float* x; float* out; bf16_t* X1b; float* SSQ;
    __device__ __forceinline__ void operator()(const f32x4 (&acc)[2][2][4][2], const Unit& u, int wr, int wc, int fr, int fq) const {
        const int row0 = u.pm * BM + wr * 64 + fr, col0 = u.pn * BM + wc * 32 + 4 * fq;
#pragma unroll
        for (int ai = 0; ai < 2; ++ai)
#pragma unroll
            for (int mp = 0; mp < 2; ++mp) {
                f32x4 xin[2][2][2];
#pragma unroll
                for (int mi = 0; mi < 2; ++mi)
#pragma unroll
                    for (int bj = 0; bj < 2; ++bj)
#pragma unroll
                        for (int n = 0; n < 2; ++n) xin[mi][bj][n] = *(const f32x4*)(x + (size_t)(row0 + ai * HALF + (2 * mp + mi) * 16) * D_MODEL + col0 + bj * HALF + n * 16);
                __builtin_amdgcn_sched_barrier(0);
#pragma unroll
                for (int mi = 0; mi < 2; ++mi) { const int m = 2 * mp + mi, row = row0 + ai * HALF + m * 16; const size_t off = (size_t)row * D_MODEL + col0; float ss = 0.f;
#pragma unroll
                    for (int bj = 0; bj < 2; ++bj)
#pragma unroll
                        for (int n = 0; n < 2; ++n) { const f32x4 v = xin[mi][bj][n] + acc[ai][bj][m][n];
                            ss += (v[0] * v[0] + v[1] * v[1]) + (v[2] * v[2] + v[3] * v[3]);
                            u32x2_t w; w.x = cvt_pk_bf16(v[0], v[1]); w.y = cvt_pk_bf16(v[2], v[3]); *(u32x2_t*)(X1b + off + bj * HALF + n * 16) = w; }
                    ss += __shfl_xor(ss, 16); ss += __shfl_xor(ss, 32);
                    if (fq == 0) SSQ[(size_t)row * 32 + u.pn * 4 + wc] = ss; }
                __builtin_amdgcn_sched_barrier(0);
            }
    }
};
struct EpiUpV1 {
    static constexpr bool PERM = true, AFTER_DRAIN = false;
    bf16_t* HID; const float* R2;
    __device__ __forceinline__ void operator()(const f32x4 (&acc)[2][2][4][2], const Unit& u, int wr, int wc, int fr, int fq) const {
        const int row0 = u.pm * BM + wr * 64 + fr, col0 = u.pn * BM + wc * 32 + 8 * fq;
#pragma unroll
        for (int ai = 0; ai < 2; ++ai)
#pragma unroll
            for (int m = 0; m < 4; ++m) { const int row = row0 + ai * HALF + m * 16; const float r = R2[row]; bf16_t* rowp = HID + (size_t)row * N_UP + col0;
#pragma unroll
                for (int bj = 0; bj < 2; ++bj) { const f32x4 v0 = acc[ai][bj][m][0] * r, v1 = acc[ai][bj][m][1] * r;
                    u32x4 o; o.x = cvt_pk_bf16(v0[0], v0[1]); o.y = cvt_pk_bf16(v0[2], v0[3]); o.z = cvt_pk_bf16(v1[0], v1[1]); o.w = cvt_pk_bf16(v1[2], v1[3]);
                    *(u32x4*)(rowp + bj * HALF) = o; } }
    }
};
struct EpiDown {
    static constexpr bool PERM = false, AFTER_DRAIN = false;
    float* out; const bf16_t* X1b;
    __device__ __forceinline__ void operator()(const f32x4 (&acc)[2][2][4][2], const Unit& u, int wr, int wc, int fr, int fq) const {
        const int row0 = u.pm * BM + wr * 64 + fr, col0 = u.pn * BM + wc * 32 + 4 * fq;
#pragma unroll
        for (int ai = 0; ai < 2; ++ai) {
            u32x2_t xin[4][2][2];
#pragma unroll
            for (int m = 0; m < 4; ++m)
#pragma unroll
                for (int bj = 0; bj < 2; ++bj)
#pragma unroll
                    for (int n = 0; n < 2; ++n) xin[m][bj][n] = *(const u32x2_t*)(X1b + (size_t)(row0 + ai * HALF + m * 16) * D_MODEL + col0 + bj * HALF + n * 16);
            __builtin_amdgcn_sched_barrier(0);
#pragma unroll
            for (int m = 0; m < 4; ++m) { const size_t off = (size_t)(row0 + ai * HALF + m * 16) * D_MODEL + col0;
#pragma unroll
                for (int bj = 0; bj < 2; ++bj)
#pragma unroll
                    for (int n = 0; n < 2; ++n) { const u32x2_t w = xin[m][bj][n];
                        f32x4 v; v[0] = __uint_as_float(w.x << 16); v[1] = __uint_as_float(w.x & 0xffff0000u); v[2] = __uint_as_float(w.y << 16); v[3] = __uint_as_float(w.y & 0xffff0000u);
                        *(f32x4*)(out + off + bj * HALF + n * 16) = v + acc[ai][bj][m][n]; } }
            __builtin_amdgcn_sched_barrier(0);
        }
    }
};
__device__ __forceinline__ unsigned f2bf_(float f) { unsigned u = __float_as_uint(f); return (u + 0x7fffu + ((u >> 16) & 1u)) >> 16; }
struct EpiUpConv {
    static constexpr bool PERM = true, AFTER_DRAIN = false;
    bf16_t* G; const float* R2; const float* cw; const float* cb; float* HLAST; float* FIRST; PG8_LAS unsigned char* xlds;
    __device__ __forceinline__ void operator()(const f32x4 (&acc)[2][2][4][2], const Unit& u, int wr, int wc, int fr_in, int fq_in) const {
        (void)fr_in; (void)fq_in;
        unsigned z_ = 0u; asm volatile("" : "+v"(z_));
        const int lane_ = (int)__builtin_amdgcn_mbcnt_hi(~0u, __builtin_amdgcn_mbcnt_lo(~0u, z_)); const int fr = lane_ & 15, fq = lane_ >> 4;
        const int row0 = u.pm * BM + wr * 64 + fr;
        PG8_LAS float* X = (PG8_LAS float*)xlds;
        const unsigned tile = (unsigned)(u.pm * (N_UP / 256) + u.pn);
        if (fr >= 14) {
#pragma unroll
            for (int ai = 0; ai < 2; ++ai) { const int sg = 2 * ai + wr; const float r3 = R2[row0 + ai * HALF + 48];
#pragma unroll
                for (int bj = 0; bj < 2; ++bj)
#pragma unroll
                    for (int n = 0; n < 2; ++n) { const f32x4 h = acc[ai][bj][3][n] * r3;
                        *(PG8_LAS f32x4*)(X + ((sg * 4 + wc) * 2 + (fr - 14)) * 64 + bj * 32 + 8 * fq + 4 * n) = h;
                        if (ai == 1 && wr == 1) *(f32x4*)(HLAST + (unsigned)((tile * 2 + (fr - 14)) * 256 + bj * HALF + wc * 32 + 8 * fq + 4 * n)) = h; } }
        }
        PG8_LAS float* R2L = X + 3072;
        PG8_LAS float* Wl = X + 2048;
        { const int t_ = (wr * 4 + wc) * 64 + fq * 16 + fr;
#pragma unroll
          for (int i2 = 0; i2 < 2; ++i2) { const int i = t_ + 512 * i2, k = i >> 8, p = i & 255, c = (p < 128 ? 0 : D_FF - 128) + u.pn * 128 + p;
              Wl[i] = k < 3 ? cw[(unsigned)(k * N_UP + c)] : cb[(unsigned)c]; }
          if (t_ < 256) R2L[t_] = R2[u.pm * BM + t_]; }
        asm volatile("s_waitcnt vmcnt(0) lgkmcnt(0)" ::: "memory"); __builtin_amdgcn_s_barrier(); asm volatile("" ::: "memory");
        const int cbase = u.pn * 128 + wc * 32 + 8 * fq;
        const bool seq_start = (u.pm & 15) == 0;
#pragma unroll
        for (int ai = 0; ai < 2; ++ai) {
            const int sg = 2 * ai + wr;
            float rs[4];
#pragma unroll
            for (int m = 0; m < 4; ++m) rs[m] = R2L[wr * 64 + fr + ai * HALF + m * 16];
            const bool defer = (ai == 0) && (wr == 0) && !seq_start && (fr < 2);
#pragma unroll
            for (int n = 0; n < 2; ++n) {
                unsigned pk[4][2];
#pragma unroll
                for (int e = 0; e < 4; ++e) {
                    asm volatile("" ::: "memory"); __builtin_amdgcn_sched_barrier(0);
                    PG8_LAS const float* wp = Wl + wc * 32 + 8 * fq + 4 * n + e;
                    const float wg0 = wp[0], wg1 = wp[256], wg2 = wp[512], bg = wp[768], wu0 = wp[128], wu1 = wp[384], wu2 = wp[640], bu = wp[896];
                    float hg1 = 0.f, hg2 = 0.f, hu1 = 0.f, hu2 = 0.f;
                    if (ai == 1 || wr == 1) { PG8_LAS const float* xp = X + (((sg - 1) * 4 + wc) * 2) * 64 + 8 * fq + 4 * n + e; hg2 = xp[0]; hg1 = xp[64]; hu2 = xp[32]; hu1 = xp[96]; }
                    float ag = hg1, bgp = fr == 0 ? hg2 : hg1, au = hu1, bup = fr == 0 ? hu2 : hu1;
#pragma unroll
                    for (int m = 0; m < 4; ++m) {
                        const float vg = acc[ai][0][m][n][e] * rs[m], vu = acc[ai][1][m][n][e] * rs[m];
                        const float rg1 = __uint_as_float(__builtin_amdgcn_update_dpp(0u, __float_as_uint(vg), 0x121, 0xf, 0xf, false)), rg2 = __uint_as_float(__builtin_amdgcn_update_dpp(0u, __float_as_uint(vg), 0x122, 0xf, 0xf, false));
                        const float ru1 = __uint_as_float(__builtin_amdgcn_update_dpp(0u, __float_as_uint(vu), 0x121, 0xf, 0xf, false)), ru2 = __uint_as_float(__builtin_amdgcn_update_dpp(0u, __float_as_uint(vu), 0x122, 0xf, 0xf, false));
                        const float pg1 = fr >= 1 ? rg1 : ag, pg2 = fr >= 2 ? rg2 : bgp, pu1 = fr >= 1 ? ru1 : au, pu2 = fr >= 2 ? ru2 : bup;
                        const float cg = bg + wg0 * pg2 + wg1 * pg1 + wg2 * vg, cu = bu + wu0 * pu2 + wu1 * pu1 + wu2 * vu;
                        if (m == 0 && defer) { float* fp = FIRST + (unsigned)((tile * 2 + fr) * 256 + wc * 32 + 8 * fq + 4 * n + e); fp[0] = cg; fp[HALF] = cu; }
                        const unsigned hb = cvt_pk_bf16(cg * sigmoidf_(cg) * cu, 0.f);
                        if ((e & 1) == 0) pk[m][e >> 1] = hb; else pk[m][e >> 1] |= hb << 16;
                        ag = rg1; bgp = rg2; au = ru1; bup = ru2;
                    }
                }
#pragma unroll
                for (int m = 0; m < 4; ++m)
                    if (!(m == 0 && defer)) { u32x2_t o; o.x = pk[m][0]; o.y = pk[m][1]; *(u32x2_t*)(G + (unsigned)((row0 + ai * HALF + m * 16) * D_FF + cbase + 4 * n)) = o; }
            }
        }
    }
};
template <class Epi, class Sched, bool ALIGN_EPI = false, bool SP2 = false>
__device__ __forceinline__ void gemm_phase(PG8_LAS unsigned char* lds, const Gemm g, const Sched& S, const Epi& E, const int wave_s) {
    const int tid = fresh_tid(wave_s), wid = wave_s, lane = tid & 63,
          wr = wid >> 2, wc = wid & 3, fr = lane & 15, fq = lane >> 4;
    const int K = g.K, nt = K / BK;
    unsigned voffA[2], voffB[2];
#pragma unroll
    for (int i = 0; i < 2; ++i) { int R, C; stage_rc(tid * 16 + i * 8192, R, C); const int Rb = Epi::PERM ? ((R & ~31) + perm32(R & 31)) : R;
        voffA[i] = (unsigned)(R * g.lda + C) * 2u; voffB[i] = (unsigned)(Rb * K + C) * 2u; }
    const size_t kstep = (size_t)(BK * 2);
    const size_t hstepA = (size_t)HALF * g.lda * 2, hstepB = (size_t)HALF * K * 2;
    const size_t tstepA = 2 * hstepA, tstepB = 2 * hstepB;
    const unsigned ldsw = (unsigned)wid * 1024u;
    const int aoff = lds_byte(wr * 64 + fr, fq * 8), boff = lds_byte(wc * 32 + fr, fq * 8);
#define PG8_SA(b, h) (((b) * 2 + (h)) * HTB)
#define PG8_SB(b, h) ((4 + (b) * 2 + (h)) * HTB)
#define PG8_STAGE(bufoff, gbase, voff) do { _Pragma("unroll") for (int _i = 0; _i < 2; ++_i) \
        __builtin_amdgcn_global_load_lds((const unsigned*)((const char*)(gbase) + (voff)[_i]), (PG8_LAS unsigned*)(lds + (bufoff) + ldsw + _i * 8192), 16, 0, 0); } while (0)
#define PG8_LDA(dst, b, h) do { _Pragma("unroll") for (int m = 0; m < 4; ++m) _Pragma("unroll") for (int k = 0; k < 2; ++k) dst[m][k] = *(const PG8_LAS bf16x8*)(lds + PG8_SA(b, h) + aoff + m * 2048 + k * 1024); } while (0)
#define PG8_LDB(dst, b, h) do { _Pragma("unroll") for (int n = 0; n < 2; ++n) _Pragma("unroll") for (int k = 0; k < 2; ++k) dst[n][k] = *(const PG8_LAS bf16x8*)(lds + PG8_SB(b, h) + boff + n * 2048 + k * 1024); } while (0)
#define PG8_MMA(ai, bj, At, Bt) do { __builtin_amdgcn_s_setprio(1); _Pragma("unroll") for (int m = 0; m < 4; ++m) _Pragma("unroll") for (int n = 0; n < 2; ++n) _Pragma("unroll") for (int k = 0; k < 2; ++k) \
        acc[ai][bj][m][n] = __builtin_amdgcn_mfma_f32_16x16x32_bf16(Bt[n][k], At[m][k], acc[ai][bj][m][n], 0, 0, 0); __builtin_amdgcn_s_setprio(0); } while (0)
#define PG8_WAIT_V(n) asm volatile("s_waitcnt vmcnt(" #n ")" ::: "memory")
#define PG8_WAIT_L(n) asm volatile("s_waitcnt lgkmcnt(" #n ")" ::: "memory")
#define PG8_BAR __builtin_amdgcn_s_barrier()
#define PG8_SCHED __builtin_amdgcn_sched_barrier(0)
    Unit cur, nxt; int ui = 0;
    if (!S.next(0, cur)) return;
    f32x4 acc[2][2][4][2];
#pragma unroll
    for (int a = 0; a < 2; ++a)
#pragma unroll
        for (int b = 0; b < 2; ++b)
#pragma unroll
            for (int m = 0; m < 4; ++m)
#pragma unroll
                for (int n = 0; n < 2; ++n) acc[a][b][m][n] = (f32x4){0.f, 0.f, 0.f, 0.f};
    bf16x8 At[4][2], B0[2][2], B1[2][2];
    const char* cA = (const char*)g.A + (size_t)cur.pm * tstepA; const char* cB = (const char*)g.Bt + (size_t)cur.pn * tstepB;
    S.a_ready(cur);
    if constexpr (SP2) {
        PG8_STAGE(PG8_SB(0, 0), cB, voffB); PG8_STAGE(PG8_SB(0, 1), cB + hstepB, voffB); PG8_STAGE(PG8_SA(0, 0), cA, voffA); PG8_STAGE(PG8_SA(0, 1), cA + hstepA, voffA);
        if (wr == 1) PG8_BAR;
        PG8_WAIT_V(2); PG8_BAR;
        PG8_STAGE(PG8_SB(1, 0), cB + kstep, voffB); PG8_STAGE(PG8_SA(1, 0), cA + kstep, voffA); PG8_STAGE(PG8_SB(1, 1), cB + hstepB + kstep, voffB);
        PG8_WAIT_V(6); PG8_BAR;
    } else {
        PG8_STAGE(PG8_SB(0, 0), cB, voffB); PG8_STAGE(PG8_SA(0, 0), cA, voffA); PG8_STAGE(PG8_SB(0, 1), cB + hstepB, voffB); PG8_STAGE(PG8_SA(0, 1), cA + hstepA, voffA);
        if (wr == 1) PG8_BAR;
        PG8_WAIT_V(4); PG8_BAR;
        PG8_STAGE(PG8_SB(1, 0), cB + kstep, voffB); PG8_STAGE(PG8_SA(1, 0), cA + kstep, voffA); PG8_STAGE(PG8_SB(1, 1), cB + hstepB + kstep, voffB);
        PG8_WAIT_V(6); PG8_BAR;
    }
    for (;;) {
        const bool has_next = S.next(ui + 1, nxt);
        const char* nA = has_next ? (const char*)g.A + (size_t)nxt.pm * tstepA : cA; const char* nB = has_next ? (const char*)g.Bt + (size_t)nxt.pn * tstepB : cB;
        for (int t = 0; t < nt; t += 2) {
            const bool last = (t == nt - 2);
            const char* a1 = cA + (size_t)(t + 1) * kstep;
            const char* a2 = last ? nA : cA + (size_t)(t + 2) * kstep; const char* b2 = last ? nB : cB + (size_t)(t + 2) * kstep;
            const char* a3 = a2 + kstep; const char* b3 = b2 + kstep;
            if (last && has_next) S.a_ready(nxt);
            if constexpr (SP2) {
            PG8_LDB(B0, 0, 0); PG8_LDB(B1, 0, 1); PG8_SCHED; PG8_LDA(At, 0, 0); PG8_STAGE(PG8_SA(1, 1), a1 + hstepA, voffA);
            PG8_WAIT_V(8); PG8_WAIT_L(0); PG8_BAR; PG8_MMA(0, 0, At, B0); PG8_MMA(0, 1, At, B1); PG8_BAR; PG8_SCHED;
            PG8_LDA(At, 0, 1); PG8_STAGE(PG8_SB(0, 0), b2, voffB); PG8_STAGE(PG8_SB(0, 1), b2 + hstepB, voffB); PG8_STAGE(PG8_SA(0, 0), a2, voffA);
            PG8_WAIT_V(8); PG8_WAIT_L(0); PG8_BAR; PG8_MMA(1, 0, At, B0); PG8_MMA(1, 1, At, B1); PG8_BAR; PG8_SCHED;
            PG8_LDB(B0, 1, 0); PG8_LDB(B1, 1, 1); PG8_SCHED; PG8_LDA(At, 1, 0); PG8_STAGE(PG8_SA(0, 1), a2 + hstepA, voffA);
            PG8_WAIT_V(8); PG8_WAIT_L(0); PG8_BAR; PG8_MMA(0, 0, At, B0); PG8_MMA(0, 1, At, B1); PG8_BAR; PG8_SCHED;
            PG8_LDA(At, 1, 1); PG8_STAGE(PG8_SB(1, 0), b3, voffB); PG8_STAGE(PG8_SB(1, 1), b3 + hstepB, voffB); PG8_STAGE(PG8_SA(1, 0), a3, voffA);
            PG8_WAIT_V(8); PG8_WAIT_L(0); PG8_BAR; PG8_MMA(1, 0, At, B0); PG8_MMA(1, 1, At, B1); PG8_BAR; PG8_SCHED;
            } else {
            PG8_LDB(B0, 0, 0); PG8_SCHED; PG8_LDA(At, 0, 0); PG8_STAGE(PG8_SA(1, 1), a1 + hstepA, voffA);
            PG8_WAIT_L(8); PG8_BAR; PG8_WAIT_L(0); PG8_MMA(0, 0, At, B0); PG8_BAR; PG8_SCHED;
            PG8_LDB(B1, 0, 1); PG8_STAGE(PG8_SB(0, 0), b2, voffB);
            PG8_BAR; PG8_WAIT_L(0); PG8_MMA(0, 1, At, B1); PG8_BAR;
            PG8_LDA(At, 0, 1); PG8_STAGE(PG8_SA(0, 0), a2, voffA);
            PG8_BAR; PG8_WAIT_L(0); PG8_MMA(1, 0, At, B0); PG8_BAR; PG8_SCHED;
            PG8_STAGE(PG8_SB(0, 1), b2 + hstepB, voffB);
            PG8_WAIT_V(6); PG8_BAR; PG8_MMA(1, 1, At, B1); PG8_BAR;
            PG8_LDB(B0, 1, 0); PG8_SCHED; PG8_LDA(At, 1, 0); PG8_STAGE(PG8_SA(0, 1), a2 + hstepA, voffA);
            PG8_WAIT_L(8); PG8_BAR; PG8_WAIT_L(0); PG8_MMA(0, 0, At, B0); PG8_BAR; PG8_SCHED;
            PG8_LDB(B1, 1, 1); PG8_STAGE(PG8_SB(1, 0), b3, voffB);
            PG8_BAR; PG8_WAIT_L(0); PG8_MMA(0, 1, At, B1); PG8_BAR;
            PG8_LDA(At, 1, 1); PG8_STAGE(PG8_SA(1, 0), a3, voffA);
            PG8_BAR; PG8_WAIT_L(0); PG8_MMA(1, 0, At, B0); PG8_BAR; PG8_SCHED;
            PG8_STAGE(PG8_SB(1, 1), b3 + hstepB, voffB);
            PG8_WAIT_V(6); PG8_BAR; PG8_MMA(1, 1, At, B1); PG8_BAR;
            }
        }
        if constexpr (ALIGN_EPI) { if (wr == 0) PG8_BAR; }
        if constexpr (!Epi::AFTER_DRAIN) { E(acc, cur, wr, wc, fr, fq); S.done(cur); }
        if (!has_next) break;
#pragma unroll
        for (int a = 0; a < 2; ++a)
#pragma unroll
            for (int b = 0; b < 2; ++b)
#pragma unroll
                for (int m = 0; m < 4; ++m)
#pragma unroll
                    for (int n = 0; n < 2; ++n) acc[a][b][m][n] = (f32x4){0.f, 0.f, 0.f, 0.f};
        cur = nxt; cA = nA; cB = nB; ++ui;
        if constexpr (ALIGN_EPI) { if (wr == 1) PG8_BAR; }
    }
    PG8_WAIT_V(0);
    if constexpr (!ALIGN_EPI) { if (wr == 0) PG8_BAR; }
    PG8_BAR;
    if constexpr (Epi::AFTER_DRAIN) { E.fused(acc, cur, wr, wc, fr, fq, lds, wid, lane); S.done(cur); }
#undef PG8_SA
#undef PG8_SB
#undef PG8_STAGE
#undef PG8_LDA
#undef PG8_LDB
#undef PG8_MMA
#undef PG8_WAIT_V
#undef PG8_WAIT_L
#undef PG8_BAR
#undef PG8_SCHED
}
}
constexpr int NWAVES = 8;
template <class RowMap>
__device__ __forceinline__ void transpose_item(const float* __restrict__ W, int K, int N, bf16_t* WT, const float* __restrict__ kscale, RowMap rm, LAS float* scr, int item, int lane) {
    const int nblk = (N + 31) / 32, kb = item / nblk, nb = item % nblk, k0 = 64 * kb, n0 = 32 * nb;
    const int nr = n0 + (lane & 31);
    float v[32];
#pragma unroll
    for (int i = 0; i < 32; ++i) { const int kk = 2 * i + (lane >> 5); v[i] = (nr < N) ? W[(size_t)(k0 + kk) * N + nr] : 0.f; }
    if (kscale) {
#pragma unroll
        for (int i = 0; i < 32; ++i) v[i] *= kscale[k0 + 2 * i + (lane >> 5)];
    }
#pragma unroll
    for (int i = 0; i < 32; ++i) scr[(2 * i + (lane >> 5)) * 33 + (lane & 31)] = v[i];
    asm volatile("s_waitcnt lgkmcnt(0)" ::: "memory");
    const int c = lane & 7;
#pragma unroll
    for (int j = 0; j < 4; ++j) { const int nl = (lane >> 3) + 8 * j, n = n0 + nl;
        if (n < N) { const LAS float* s = scr + (8 * c) * 33 + nl;
            u32x4_t o; o.x = pk2(s[0 * 33], s[1 * 33]); o.y = pk2(s[2 * 33], s[3 * 33]); o.z = pk2(s[4 * 33], s[5 * 33]); o.w = pk2(s[6 * 33], s[7 * 33]);
            *(u32x4_t*)(WT + (size_t)rm(n) * K + k0 + 8 * c) = o; } }
    asm volatile("s_waitcnt lgkmcnt(0)" ::: "memory");
}
struct RmIdent { __device__ __forceinline__ int operator()(int n) const { return n; } };
struct RmWin {
    __device__ __forceinline__ int operator()(int c) const {
        const int nc = c < 2560 ? c : (c < 2608 ? 4608 + (c - 2560) : 2560 + (c - 2608));
        const int tile = nc >> 8, L = nc & 255, wc = L >> 6, bj = (L >> 5) & 1, j = L & 31;
        return tile * 256 + 128 * bj + 32 * wc + j;
    }
};
struct RmWup {
    __device__ __forceinline__ int operator()(int c) const { const int up = c >= D_FF, cc = up ? c - D_FF : c; return (cc >> 7) * 256 + up * 128 + (cc & 127); }
};

struct Ptrs {
    const float* in[18]; float* out; unsigned char* ws;
};

__device__ __forceinline__ void p0_prologue(const Ptrs& P, LAS unsigned char* lds, int vcu, int G, const int wave) {
    const int lane = fresh_lane();
    LAS float* scr = (LAS float*)(lds + wave * 16384);
    const int gw = vcu * NWAVES + wave, NGW = G * NWAVES;
    unsigned char* ws = P.ws;
    bf16_t* WinT = (bf16_t*)(ws + WS_WIN); bf16_t* WoutT = (bf16_t*)(ws + WS_WOUT); bf16_t* WupT = (bf16_t*)(ws + WS_WUP); bf16_t* WdownT = (bf16_t*)(ws + WS_WDOWN); bf16_t* W1cT = (bf16_t*)(ws + WS_W1C);
    const float* x = P.in[0]; const float* attn_norm_w = P.in[1]; const float* w_in = P.in[2]; const float* cmp_pos = P.in[5]; const float* cmp_w1 = P.in[6];
    const float* w_out = P.in[12]; const float* ffn_norm_w = P.in[13]; const float* w_up = P.in[14]; const float* w_down = P.in[17];
    constexpr int I_IN = 32 * 146, I_W1 = 32 * 8, I_W2 = 4 * 2;
    constexpr int NITEMS = I_IN + 2 * I_W1 + 2 * I_W2;
    (void)w_out; (void)w_up; (void)w_down; (void)ffn_norm_w; (void)WoutT; (void)WupT; (void)WdownT;
    for (int it = gw; it < NITEMS; it += NGW) {
        int r = it;
        if (r < I_IN) { transpose_item(w_in, 2048, IN_COLS, WinT, nullptr, RmWin(), scr, r, lane); continue; } r -= I_IN;
        if (r < I_W1) { transpose_item(cmp_w1, 2048, 256, W1cT, nullptr, RmIdent(), scr, r, lane); continue; } r -= I_W1;
        if (r < I_W1) { transpose_item(cmp_w1 + (size_t)2048 * 256, 2048, 256, W1cT + (size_t)256 * 2048, nullptr, RmIdent(), scr, r, lane); continue; } r -= I_W1;
        { const int kv = r >= I_W2 ? 1 : 0; transpose_item(P.in[7] + (size_t)kv * 256 * 64, 256, 64, (bf16_t*)(ws + WS_SMALL + SM_W2T) + (size_t)kv * 64 * 256, nullptr, RmIdent(), scr, r - kv * I_W2, lane); }
    }
    for (int i = gw * 64 + lane; i < 8 * 16384; i += NGW * 64) { const int t = (i >> 7) & 127, sx = i & 127; ((bf16_t*)(ws + WS_SMALL + SM_SWB))[i] = (bf16_t)(sx <= t ? f2bf(P.in[10][i]) : 0u); }
    for (int p = gw; p < 256; p += NGW) {
        const int L = 64 * ((p >> 5) & 3) + 32 * (p >> 7) + (p & 31);
        if (L >= 48) { u32x4_t z = {0u, 0u, 0u, 0u}; u32x4_t* d = (u32x4_t*)(WinT + (size_t)(18 * 256 + p) * 2048);
#pragma unroll
            for (int j = 0; j < 4; ++j) d[lane + 64 * j] = z; }
    }
    bf16_t* XN = (bf16_t*)(ws + WS_XN);
    for (int m = gw; m < MTOK; m += 2 * NGW) {
        const int m2 = m + NGW;
        const f32x4_t* xr = (const f32x4_t*)(x + (size_t)m * D_MODEL) + lane;
        const f32x4_t* xr2 = (const f32x4_t*)(x + (size_t)(m2 < MTOK ? m2 : m) * D_MODEL) + lane;
        f32x4_t v[8], v2[8]; float s = 0.f, s2 = 0.f;
#pragma unroll
        for (int j = 0; j < 8; ++j) { v[j] = xr[64 * j]; v2[j] = xr2[64 * j]; }
#pragma unroll
        for (int j = 0; j < 8; ++j) { s += (v[j][0] * v[j][0] + v[j][1] * v[j][1]) + (v[j][2] * v[j][2] + v[j][3] * v[j][3]); s2 += (v2[j][0] * v2[j][0] + v2[j][1] * v2[j][1]) + (v2[j][2] * v2[j][2] + v2[j][3] * v2[j][3]); }
        const float r = __builtin_amdgcn_rsqf(wave_sum(s) * (1.0f / D_MODEL) + 1e-6f), r2 = __builtin_amdgcn_rsqf(wave_sum(s2) * (1.0f / D_MODEL) + 1e-6f);
        u32x2_t* o8 = (u32x2_t*)(XN + (size_t)m * D_MODEL) + lane; u32x2_t* o82 = (u32x2_t*)(XN + (size_t)m2 * D_MODEL) + lane;
#pragma unroll
        for (int j = 0; j < 8; ++j) { const f32x4_t w = ((const f32x4_t*)attn_norm_w)[lane + 64 * j];
            u32x2_t o; o.x = pk2(v[j][0] * r * w[0], v[j][1] * r * w[1]); o.y = pk2(v[j][2] * r * w[2], v[j][3] * r * w[3]); o8[64 * j] = o;
            if (m2 < MTOK) { u32x2_t q; q.x = pk2(v2[j][0] * r2 * w[0], v2[j][1] * r2 * w[1]); q.y = pk2(v2[j][2] * r2 * w[2], v2[j][3] * r2 * w[3]); o82[64 * j] = q; } }
    }
    float* BIASP = (float*)(ws + WS_SMALL + SM_BIASP);
    for (int it = gw; it < 64; it += NGW) {
        const int kv = it >> 5, kc = it & 31; f32x4_t a = {0.f, 0.f, 0.f, 0.f};
        const float* pp = cmp_pos + kv * 2048 + kc * 64; const float* w1 = cmp_w1 + ((size_t)kv * 2048 + kc * 64) * 256;
        for (int k = 0; k < 64; ++k) { const f32x4_t w = ((const f32x4_t*)(w1 + (size_t)k * 256))[lane]; a += w * pp[k]; }
        ((f32x4_t*)(BIASP + (size_t)it * 256))[lane] = a;
    }
}

__device__ __forceinline__ void bias1_stage(unsigned char* ws, int idx  ) {
    const float* BIASP = (const float*)(ws + WS_SMALL + SM_BIASP); float* BIAS1 = (float*)(ws + WS_SMALL + SM_BIAS1);
    const int kv = idx >> 8, j = idx & 255; float s = 0.f;
    for (int kc = 0; kc < 32; ++kc) s += BIASP[(size_t)(kv * 32 + kc) * 256 + j];
    BIAS1[idx] = s;
}
__device__ __forceinline__ void cmp2_row(const Ptrs& P, int R, int lane) {
    unsigned char* ws = P.ws; const bf16_t* HC = (const bf16_t*)(ws + WS_HC);
    const int kv = R >> 12, rr = R & 4095, n = rr & 255;
    bf16_t* dst = (bf16_t*)(ws + (kv ? WS_VC : WS_KC)) + (size_t)rr * 64 + lane;
    if (n == 255) { *dst = 0; return; }
    const float* w2 = P.in[7] + (size_t)kv * 256 * 64;
    const u32x2_t hr = *(const u32x2_t*)(HC + (size_t)R * 256 + 4 * lane);
    float h[4] = {__uint_as_float(hr.x << 16), __uint_as_float(hr.x & 0xffff0000u), __uint_as_float(hr.y << 16), __uint_as_float(hr.y & 0xffff0000u)};
    float o = 0.f;
    for (int jj = 0; jj < 64; ++jj) {
#pragma unroll
        for (int i = 0; i < 4; ++i) o += __shfl(h[i], jj) * w2[(size_t)(4 * jj + i) * 64 + lane];
    }
    if (kv == 0) { const float ss = wave_sum(o * o); o *= __builtin_amdgcn_rsqf(ss * (1.0f / 64.0f) + 1e-6f) * P.in[4][lane]; }
    *dst = (bf16_t)f2bf(o);
}

__device__ __forceinline__ void gmlp_unit_v1(const Ptrs& P, LAS unsigned char* lds, int unit, const int wave_s) {
    unsigned char* ws = P.ws; const int tid = fresh_tid(wave_s);
    const int g = unit & 7, chunk = (unit >> 3) & 31, b = unit >> 8; const int m0 = b * SEQ + chunk * 128;
    LAS float* vn = (LAS float*)lds; LAS float* Wl = (LAS float*)(lds + 65536); LAS float* st = (LAS float*)(lds + 131072);
    const bf16_t* GV = (const bf16_t*)(ws + WS_GV); const bf16_t* U = (const bf16_t*)(ws + WS_U); const float* VSTAT = (const float*)(ws + WS_VSTAT);
    bf16_t* AB = (bf16_t*)(ws + WS_AB);
    const float* ln_w = P.in[8]; const float* ln_b = P.in[9]; const float* sw = P.in[10]; const float* sb = P.in[11];
    if (tid < 128) { const float* p = VSTAT + (size_t)(m0 + tid) * 32; float s1 = 0.f, s2 = 0.f;
#pragma unroll
        for (int i = 0; i < 16; ++i) { s1 += p[2 * i]; s2 += p[2 * i + 1]; }
        const float mean = s1 * (1.0f / 1024.0f); float var = s2 * (1.0f / 1024.0f) - mean * mean; var = var < 0.f ? 0.f : var;
        st[2 * tid] = mean; st[2 * tid + 1] = __builtin_amdgcn_rsqf(var + 1e-5f); }
    for (int i = 0; i < 32; ++i) { const int idx = tid + 512 * i, t = idx >> 7, s = idx & 127; Wl[idx] = (s <= t) ? sw[(size_t)g * 16384 + idx] : 0.f; }
    __syncthreads();
#pragma unroll
    for (int i = 0; i < 4; ++i) { const int idx = tid + 512 * i, s = idx >> 4, c8 = idx & 15;
        const u32x4_t raw = *(const u32x4_t*)(GV + (size_t)(m0 + s) * 1024 + g * 128 + 8 * c8); float f[8]; unpack8(raw, f);
        const float mean = st[2 * s], rstd = st[2 * s + 1];
#pragma unroll
        for (int e = 0; e < 8; ++e) { const int c = g * 128 + 8 * c8 + e; vn[s * 128 + 8 * c8 + e] = (f[e] - mean) * rstd * ln_w[c] + ln_b[c]; } }
    __syncthreads();
    const int c = tid & 127, tq = tid >> 7;
    for (int i = 0; i < 8; ++i) {
        const int t0 = 4 * (tq + 4 * i); float a0 = 0.f, a1 = 0.f, a2 = 0.f, a3 = 0.f;
        for (int s4 = 0; s4 <= t0; s4 += 4) {
            const f32x4_t w0 = *(const LAS f32x4_t*)(Wl + (t0 + 0) * 128 + s4), w1 = *(const LAS f32x4_t*)(Wl + (t0 + 1) * 128 + s4), w2 = *(const LAS f32x4_t*)(Wl + (t0 + 2) * 128 + s4), w3 = *(const LAS f32x4_t*)(Wl + (t0 + 3) * 128 + s4);
#pragma unroll
            for (int k = 0; k < 4; ++k) { const float v = vn[(s4 + k) * 128 + c]; a0 += w0[k] * v; a1 += w1[k] * v; a2 += w2[k] * v; a3 += w3[k] * v; }
        }
        const float av[4] = {a0, a1, a2, a3};
#pragma unroll
        for (int k = 0; k < 4; ++k) { const int t = t0 + k; const size_t row = (size_t)(m0 + t);
            const float uu = bf2f(U[row * 1024 + g * 128 + c]); AB[row * 2048 + 1024 + g * 128 + c] = (bf16_t)f2bf(uu * (av[k] + sb[g * 128 + t])); }
    }
    __syncthreads();
}

__device__ __forceinline__ void conv_item(const Ptrs& P, int b, int idx) {
    const int t = idx / 704, c8 = idx % 704, c0 = 8 * c8, j = c0 >> 7, i0 = c0 & 127;
    const bf16_t* HID = (const bf16_t*)(P.ws + WS_HID); const float* cw = P.in[15]; const float* cb = P.in[16];
    float gt[8], up[8];
#pragma unroll
    for (int e = 0; e < 8; ++e) { gt[e] = cb[c0 + e]; up[e] = cb[D_FF + c0 + e]; }
#pragma unroll
    for (int k = 0; k < 3; ++k) { const int tt = t - 2 + k; if (tt < 0) continue;
        float hg[8], hu[8]; unpack8(*(const u32x4_t*)(HID + (size_t)tt * N_UP + 256 * j + i0), hg); unpack8(*(const u32x4_t*)(HID + (size_t)tt * N_UP + 256 * j + 128 + i0), hu);
#pragma unroll
        for (int e = 0; e < 8; ++e) { gt[e] += cw[(size_t)k * N_UP + c0 + e] * hg[e]; up[e] += cw[(size_t)k * N_UP + D_FF + c0 + e] * hu[e]; } }
    float r[8];
#pragma unroll
    for (int e = 0; e < 8; ++e) r[e] = gt[e] * sigmoidf_(gt[e]) * up[e];
    u32x4_t o; o.x = pk2(r[0], r[1]); o.y = pk2(r[2], r[3]); o.z = pk2(r[4], r[5]); o.w = pk2(r[6], r[7]);
    *(u32x4_t*)((bf16_t*)(P.ws + WS_G) + ((size_t)b * SEQ + t) * D_FF + c0) = o;
}

constexpr int LW_CH = 32;
constexpr int LW_OUT = 32 * 64, LW_UP = 32 * 352, LW_DOWN = 88 * 64, LW_C_OUT = LW_OUT / LW_CH, LW_C_UP = LW_UP / LW_CH, LW_C_DOWN = LW_DOWN / LW_CH, LW_CHUNKS = LW_C_OUT + LW_C_UP + LW_C_DOWN;
static_assert(LW_OUT % LW_CH == 0 && LW_UP % LW_CH == 0 && LW_DOWN % LW_CH == 0, "late weight items per chunk");
template <class RowMap>
__device__ __forceinline__ void lw_load(float (&v)[32], const float* __restrict__ W, int N, int item, int lane) {
    const int nblk = N / 32, kb = item / nblk, nb = item % nblk;
    const float* p = W + (size_t)(64 * kb + (lane >> 5)) * N + 32 * nb + (lane & 31);
#pragma unroll
    for (int i = 0; i < 32; ++i) v[i] = p[(size_t)(2 * i) * N];
}
template <class RowMap>
__device__ __forceinline__ void lw_store(const float (&v)[32], int K, int N, bf16_t* WT, const float* __restrict__ kscale, RowMap rm, LAS float* scr, int item, int lane) {
    const int nblk = N / 32, kb = item / nblk, nb = item % nblk, k0 = 64 * kb, n0 = 32 * nb;
#pragma unroll
    for (int i = 0; i < 32; ++i) { const int kk = 2 * i + (lane >> 5); scr[kk * 33 + (lane & 31)] = kscale ? v[i] * kscale[k0 + kk] : v[i]; }
    asm volatile("s_waitcnt lgkmcnt(0)" ::: "memory");
    const int c = lane & 7;
#pragma unroll
    for (int j = 0; j < 4; ++j) { const int nl = (lane >> 3) + 8 * j; const LAS float* s = scr + (8 * c) * 33 + nl;
        u32x4_t o; o.x = pk2(s[0 * 33], s[1 * 33]); o.y = pk2(s[2 * 33], s[3 * 33]); o.z = pk2(s[4 * 33], s[5 * 33]); o.w = pk2(s[6 * 33], s[7 * 33]);
        *(u32x4_t*)(WT + (size_t)rm(n0 + nl) * K + k0 + 8 * c) = o; }
    asm volatile("s_waitcnt lgkmcnt(0)" ::: "memory");
}
template <class RowMap>
__device__ __forceinline__ void lw_run(const float* __restrict__ W, int K, int N, bf16_t* WT, const float* __restrict__ kscale, RowMap rm, LAS float* scr, int item0, int wave, int lane) {
    float va[32], vb[32];
    lw_load<RowMap>(va, W, N, item0 + wave, lane);
    lw_load<RowMap>(vb, W, N, item0 + wave + 8, lane);  lw_store(va, K, N, WT, kscale, rm, scr, item0 + wave, lane);
    lw_load<RowMap>(va, W, N, item0 + wave + 16, lane); lw_store(vb, K, N, WT, kscale, rm, scr, item0 + wave + 8, lane);
    lw_load<RowMap>(vb, W, N, item0 + wave + 24, lane); lw_store(va, K, N, WT, kscale, rm, scr, item0 + wave + 16, lane);
    lw_store(vb, K, N, WT, kscale, rm, scr, item0 + wave + 24, lane);
}
__device__ __forceinline__ void late_weight_chunk(const Ptrs& P, LAS unsigned char* lds, int chunk, const int wave) {
    const int lane = fresh_lane();
    LAS float* scr = (LAS float*)(lds + wave * 16384);
    unsigned char* ws = P.ws;
    if (chunk < LW_C_UP) lw_run(P.in[14], 2048, N_UP, (bf16_t*)(ws + WS_WUP), P.in[13], RmWup(), scr, chunk * LW_CH, wave, lane);
    else if (chunk < LW_C_UP + LW_C_DOWN) lw_run(P.in[17], D_FF, 2048, (bf16_t*)(ws + WS_WDOWN), nullptr, RmIdent(), scr, (chunk - LW_C_UP) * LW_CH, wave, lane);
    else lw_run(P.in[12], 2048, 2048, (bf16_t*)(ws + WS_WOUT), nullptr, RmIdent(), scr, (chunk - LW_C_UP - LW_C_DOWN) * LW_CH, wave, lane);
}

namespace nsa {
using bf16x8 = __attribute__((ext_vector_type(8))) short;
using s16x4 = __attribute__((ext_vector_type(4))) short;
using f32x16 = __attribute__((ext_vector_type(16))) float;
typedef float f32x2_t __attribute__((ext_vector_type(2))); typedef __bf16 bf16x2_t __attribute__((ext_vector_type(2)));
constexpr int L_K = 0, L_V = 16384, L_WSF = 32768, L_OST = 34816, L_IMP = 100352, L_MASK = 116736, L_WU = 117248, L_END = 117312;
constexpr int SLOTB = 8192;
constexpr float THR = 8.0f;
#define NSA_SBAR() __builtin_amdgcn_sched_barrier(0)
__device__ __forceinline__ int crow(int r, int hi) { return (r & 3) + 8 * (r >> 2) + 4 * hi; }
__device__ __forceinline__ void glds16(const void* gbase  , unsigned voff  , unsigned lds_dst) { unsigned keep;
    asm volatile("s_mov_b32 %0, m0\n\ts_mov_b32 m0, %3\n\ts_nop 0\n\tglobal_load_lds_dwordx4 %1, %2\n\ts_mov_b32 m0, %0" : "=&s"(keep) : "v"(voff), "s"(gbase), "s"(lds_dst) : "memory"); }
__device__ __forceinline__ unsigned cvtpk_s(float lo, float hi) { f32x2_t v = {lo, hi}; bf16x2_t b = __builtin_convertvector(v, bf16x2_t); return __builtin_bit_cast(unsigned, b); }
#define NSA_WAIT_BAR() asm volatile("s_waitcnt vmcnt(0) lgkmcnt(0)\n\ts_barrier" ::: "memory")

__device__ __forceinline__ void qkt(f32x16& p0, f32x16& p1, LAS const char* Kslot, const bf16x8 (&qr)[4], int r32, int hi) {
    LAS const char* kb = Kslot + hi * 1024 + r32 * 16;
#pragma unroll
    for (int d0 = 0; d0 < 4; ++d0) {
        const bf16x8 b0 = *(LAS const bf16x8*)(kb + d0 * 2048);
        const bf16x8 b1 = *(LAS const bf16x8*)(kb + d0 * 2048 + 512);
        p0 = __builtin_amdgcn_mfma_f32_32x32x16_bf16(b0, qr[d0], p0, 0, 0, 0); p1 = __builtin_amdgcn_mfma_f32_32x32x16_bf16(b1, qr[d0], p1, 0, 0, 0);
    }
}
struct VFrag { s16x4 lo[2][4], hi[2][4]; };
__device__ __forceinline__ void vload(VFrag& f, int vb) {
#pragma unroll
    for (int d0 = 0; d0 < 2; ++d0)
#pragma unroll
        for (int ks = 0; ks < 4; ++ks) {
            asm volatile("ds_read_b64_tr_b16 %0,%1 offset:%c2" : "=&v"(f.lo[d0][ks]) : "v"(vb), "i"(d0 * 4096 + ks * 1024) : "memory");
            asm volatile("ds_read_b64_tr_b16 %0,%1 offset:%c2" : "=&v"(f.hi[d0][ks]) : "v"(vb), "i"(d0 * 4096 + ks * 1024 + 512) : "memory"); }
}
__device__ __forceinline__ void pvmma(f32x16 (&o)[2], VFrag& f, bf16x8 pa0, bf16x8 pa1, bf16x8 pa2, bf16x8 pa3) {
    asm volatile("s_waitcnt lgkmcnt(0)" : "+v"(f.lo[0][0]), "+v"(f.lo[0][1]), "+v"(f.lo[0][2]), "+v"(f.lo[0][3]), "+v"(f.hi[0][0]), "+v"(f.hi[0][1]), "+v"(f.hi[0][2]), "+v"(f.hi[0][3]) :: "memory");
    asm volatile("" : "+v"(f.lo[1][0]), "+v"(f.lo[1][1]), "+v"(f.lo[1][2]), "+v"(f.lo[1][3]), "+v"(f.hi[1][0]), "+v"(f.hi[1][1]), "+v"(f.hi[1][2]), "+v"(f.hi[1][3]));
    NSA_SBAR();
#pragma unroll
    for (int d0 = 0; d0 < 2; ++d0) {
#define NSA_PK(k) (bf16x8){f.lo[d0][k][0], f.lo[d0][k][1], f.lo[d0][k][2], f.lo[d0][k][3], f.hi[d0][k][0], f.hi[d0][k][1], f.hi[d0][k][2], f.hi[d0][k][3]}
        o[d0] = __builtin_amdgcn_mfma_f32_32x32x16_bf16(pa0, NSA_PK(0), o[d0], 0, 0, 0);
        o[d0] = __builtin_amdgcn_mfma_f32_32x32x16_bf16(pa1, NSA_PK(1), o[d0], 0, 0, 0);
        o[d0] = __builtin_amdgcn_mfma_f32_32x32x16_bf16(pa2, NSA_PK(2), o[d0], 0, 0, 0);
        o[d0] = __builtin_amdgcn_mfma_f32_32x32x16_bf16(pa3, NSA_PK(3), o[d0], 0, 0, 0);
#undef NSA_PK
    }
}
__device__ __forceinline__ void pv(f32x16 (&o)[2], int vb, bf16x8 pa0, bf16x8 pa1, bf16x8 pa2, bf16x8 pa3) { VFrag f; vload(f, vb); pvmma(o, f, pa0, pa1, pa2, pa3); }
__device__ __forceinline__ float rowmax32(const f32x16& p0, const f32x16& p1) {
    float a = __builtin_fmaxf(p0[0], p1[0]);
#pragma unroll
    for (int r = 1; r < 16; ++r) a = __builtin_fmaxf(a, __builtin_fmaxf(p0[r], p1[r]));
    auto rr = __builtin_amdgcn_permlane32_swap(__float_as_uint(a), __float_as_uint(a), false, false);
    return __builtin_fmaxf(__uint_as_float(rr[0]), __uint_as_float(rr[1]));
}
struct State { float m, l; f32x16 o[2]; };
__device__ __forceinline__ void state_init(State& s) { s.m = -1e30f; s.l = 0.f; s.o[0] = f32x16{}; s.o[1] = f32x16{}; }

template <int BMUL, int MASK, bool LOADV>
__device__ __forceinline__ void tile_scores(f32x16& p0, f32x16& p1, LAS const char* Kslot, const bf16x8 (&qr)[4], const f32x16& bk, float c0, float b32, int lim, int r32, int hi, VFrag& vf, int vb) {
#pragma unroll
    for (int r = 0; r < 16; ++r) { const float b = (BMUL == 1) ? bk[r] + c0 : __builtin_fmaf(bk[r], (float)BMUL, c0); p0[r] = b; p1[r] = b + b32; }
    qkt(p0, p1, Kslot, qr, r32, hi);
    if (LOADV) vload(vf, vb);
    const int limh = lim - 4 * hi;
#pragma unroll
    for (int r = 0; r < 16; ++r) {
        const int kk = (r & 3) + 8 * (r >> 2);
        if (MASK == 1) { if (!(kk <= limh)) p0[r] = -INFINITY; if (!(kk + 32 <= limh)) p1[r] = -INFINITY; }
        if (MASK == 2) { if (!(kk > limh)) p0[r] = -INFINITY; if (!(kk + 32 > limh)) p1[r] = -INFINITY; }
        if (MASK == 3) { if (!(kk < limh)) p0[r] = -INFINITY; if (!(kk + 32 < limh)) p1[r] = -INFINITY; }
    }
}
__device__ __forceinline__ float tile_ref(const State& st, float rb0, bool rowlive) { return (st.m < -1e29f && rowlive) ? rb0 : st.m; }
__device__ __forceinline__ void tile_softmax_pv(State& st, f32x16& p0, f32x16& p1, float mref, VFrag& vf, LAS float* wsf, int r32, int hi) {
    float a0 = p0[0], a1 = p1[0];
#pragma unroll
    for (int r = 1; r < 16; ++r) { a0 = __builtin_fmaxf(a0, p0[r]); a1 = __builtin_fmaxf(a1, p1[r]); }
    float mx = __builtin_fmaxf(a0, a1);
    { auto rr = __builtin_amdgcn_permlane32_swap(__float_as_uint(mx), __float_as_uint(mx), false, false); mx = __builtin_fmaxf(__uint_as_float(rr[0]), __uint_as_float(rr[1])); }
    if (__any(mx > THR)) {
        const float dl = __builtin_fmaxf(mx, 0.f), alpha = __builtin_amdgcn_exp2f(-dl);
        mref += dl; st.l *= alpha;
        if (hi == 0) wsf[r32] = alpha;
        asm volatile("s_waitcnt lgkmcnt(0)" ::: "memory");
#pragma unroll
        for (int r = 0; r < 16; ++r) { const float a = wsf[crow(r, hi)]; st.o[0][r] *= a; st.o[1][r] *= a; p0[r] -= dl; p1[r] -= dl; }
    }
    st.m = mref;
    float ls = 0.f;
#pragma unroll
    for (int r = 0; r < 16; ++r) { p0[r] = __builtin_amdgcn_exp2f(p0[r]); p1[r] = __builtin_amdgcn_exp2f(p1[r]); ls += p0[r] + p1[r]; }
    st.l += ls;
    u32x4_t pw0, pw1, pw2, pw3;
    pw0 = (u32x4_t){cvtpk_s(p0[0], p0[1]), cvtpk_s(p0[2], p0[3]), cvtpk_s(p0[4], p0[5]), cvtpk_s(p0[6], p0[7])};
    pw1 = (u32x4_t){cvtpk_s(p0[8], p0[9]), cvtpk_s(p0[10], p0[11]), cvtpk_s(p0[12], p0[13]), cvtpk_s(p0[14], p0[15])};
    pw2 = (u32x4_t){cvtpk_s(p1[0], p1[1]), cvtpk_s(p1[2], p1[3]), cvtpk_s(p1[4], p1[5]), cvtpk_s(p1[6], p1[7])};
    pw3 = (u32x4_t){cvtpk_s(p1[8], p1[9]), cvtpk_s(p1[10], p1[11]), cvtpk_s(p1[12], p1[13]), cvtpk_s(p1[14], p1[15])};
    pvmma(st.o, vf, __builtin_bit_cast(bf16x8, pw0), __builtin_bit_cast(bf16x8, pw1), __builtin_bit_cast(bf16x8, pw2), __builtin_bit_cast(bf16x8, pw3));
}
template <bool FIRST>
__device__ __forceinline__ void fold_branch(LAS float* ostg, State& st, float gate, LAS float* wsf, int r32, int hi) {
    float l = st.l;
    { auto rr = __builtin_amdgcn_permlane32_swap(__float_as_uint(l), __float_as_uint(l), false, false); l = __uint_as_float(rr[0]) + __uint_as_float(rr[1]); }
    const float f = l > 0.f ? gate / l : 0.f;
    asm volatile("s_waitcnt lgkmcnt(0)" ::: "memory");
    if (hi == 0) wsf[r32] = f;
    asm volatile("s_waitcnt lgkmcnt(0)" ::: "memory");
#pragma unroll
    for (int r = 0; r < 16; ++r) { const int orow = crow(r, hi); const float a = wsf[orow];
#pragma unroll
        for (int d0 = 0; d0 < 2; ++d0) { LAS float* p = ostg + orow * 64 + d0 * 32 + r32; if (FIRST) *p = st.o[d0][r] * a; else *p += st.o[d0][r] * a; } }
    asm volatile("s_waitcnt lgkmcnt(0)" ::: "memory");
}

__device__ __forceinline__ int nsa_unit(const Ptrs& P, LAS unsigned char* lds, int bg, int qt, const int wave_s, unsigned* qctr, int qbase) {
    unsigned char* ws = P.ws;
    const int lane = fresh_lane(), r32 = lane & 31, hi = lane >> 5; const int wid = wave_s;
    const int b = bg >> 2, g = bg & 3, t0 = 64 * qt;
    const int tl = 8 * wid + (r32 >> 2), hq = r32 & 3;
    const size_t m0 = (size_t)b * SEQ + t0;
    const bf16_t* Q = (const bf16_t*)(ws + WS_Q); const bf16_t* KV6 = (const bf16_t*)(ws + WS_KV6);
    const bf16_t* KSb = KV6 + 2 * KVSZ + (size_t)bg * SEQ * 64; const bf16_t* VSb = KV6 + 3 * KVSZ + (size_t)bg * SEQ * 64;
    const bf16_t* KWb = KV6 + 4 * KVSZ + (size_t)bg * SEQ * 64; const bf16_t* VWb = KV6 + 5 * KVSZ + (size_t)bg * SEQ * 64;
    const bf16_t* KCb = (const bf16_t*)(ws + WS_KC) + (size_t)bg * 256 * 64; const bf16_t* VCb = (const bf16_t*)(ws + WS_VC) + (size_t)bg * 256 * 64;
    const float* GATES = (const float*)(ws + WS_GATES); bf16_t* AB = (bf16_t*)(ws + WS_AB);
    const unsigned lds0 = (unsigned)(uintptr_t)lds;
    LAS float* wsf = (LAS float*)(lds + L_WSF) + wid * 64;
    LAS float* IMP = (LAS float*)(lds + L_IMP);
    LAS unsigned* MASK = (LAS unsigned*)(lds + L_MASK); LAS unsigned* WU = (LAS unsigned*)(lds + L_WU);
    const int koff = lane * 64 + wid * 8, voff = (16 * (wid & 3) + (lane >> 2)) * 64 + (wid >> 2) * 32 + (lane & 3) * 8;
    const unsigned kdst = lds0 + L_K + wid * 1024, vdst = lds0 + L_V + wid * 1024;
#define NSA_DMA_K(base, tile, slot) glds16((base) + (size_t)(tile) * 4096, (unsigned)koff * 2u, (unsigned)__builtin_amdgcn_readfirstlane(kdst + (slot) * SLOTB))
#define NSA_DMA_V(base, tile, slot) glds16((base) + (size_t)(tile) * 4096, (unsigned)voff * 2u, (unsigned)__builtin_amdgcn_readfirstlane(vdst + (slot) * SLOTB))
    const int vb0 = (int)(lds0 + L_V) + ((lane >> 4) & 1) * 32 + (lane & 3) * 8 + (4 * hi + ((lane & 15) >> 2)) * 64;
    LAS const char* Kbase = (LAS const char*)(lds + L_K);
    bf16x8 qr[4];
    { const bf16_t* qp = Q + (m0 + tl) * 1024 + (4 * g + hq) * 64 + hi * 8;
#pragma unroll
      for (int d0 = 0; d0 < 4; ++d0) qr[d0] = *(const bf16x8*)(qp + d0 * 16); }
    const float sl2 = __builtin_amdgcn_exp2f(-0.5f * (float)(4 * g + hq + 1)) * LOG2E;
    f32x16 bk;
#pragma unroll
    for (int r = 0; r < 16; ++r) bk[r] = sl2 * (float)((r & 3) + 8 * (r >> 2));
    const float b32t = 32.0f * sl2, b32c = 512.0f * sl2, hoff_t = 4.0f * (float)hi * sl2, hoff_c = 64.0f * (float)hi * sl2;
    float gate[3];
    { const float* gp = GATES + (m0 + tl) * 48 + (4 * g + hq) * 3; gate[0] = gp[0]; gate[1] = gp[1]; gate[2] = gp[2]; }
    LAS float* ostg = (LAS float*)(lds + L_OST) + wid * 2048;
    State st;
    f32x16 p0, p1;
    int nxt_ticket = 0;

    int tc = 0;
    VFrag vf;
    const int nvmax = (t0 + 63 >= 31) ? ((t0 + 63 - 31) >> 4) + 1 : 0;
    const int nct = (nvmax + 63) >> 6;
    const int tq = t0 + tl, nv = tq >= 31 ? ((tq - 31) >> 4) + 1 : 0;
    {
        state_init(st);
        const int j0 = qt >= 8 ? qt - 8 : 0, nt = qt - j0 + 1;
        NSA_DMA_K(KWb, qt, 0); NSA_DMA_V(VWb, qt, 0); NSA_WAIT_BAR();
        for (int i = 0; i < nt; ++i) {
            const int j = qt - i, slot = (tc + i) & 1;
            if (i + 1 < nt) { NSA_DMA_K(KWb, j - 1, slot ^ 1); NSA_DMA_V(VWb, j - 1, slot ^ 1); }
            else { NSA_DMA_K(KCb, nct - 1, slot ^ 1); NSA_DMA_V(VCb, nct - 1, slot ^ 1); }
            const float rb0 = sl2 * (float)(64 * j - t0), mref = tile_ref(st, rb0, true), c0 = rb0 + hoff_t - mref;
            if (j == qt) tile_scores<1, 1, true>(p0, p1, Kbase + slot * SLOTB, qr, bk, c0, b32t, tl, r32, hi, vf, vb0 + slot * SLOTB);
            else if (j == qt - 8) tile_scores<1, 2, true>(p0, p1, Kbase + slot * SLOTB, qr, bk, c0, b32t, tl, r32, hi, vf, vb0 + slot * SLOTB);
            else tile_scores<1, 0, true>(p0, p1, Kbase + slot * SLOTB, qr, bk, c0, b32t, 0, r32, hi, vf, vb0 + slot * SLOTB);
            tile_softmax_pv(st, p0, p1, mref, vf, wsf, r32, hi);
            NSA_WAIT_BAR();
        }
        tc += nt;
        fold_branch<true>(ostg, st, gate[2], wsf, r32, hi);
    }
    {
        state_init(st);
        for (int ci = 0; ci < nct; ++ci) {
            const int c = nct - 1 - ci, slot = (tc + ci) & 1;
            if (ci + 1 < nct) { NSA_DMA_K(KCb, c - 1, slot ^ 1); NSA_DMA_V(VCb, c - 1, slot ^ 1); }
            else if (qt >= 16) { NSA_DMA_K(KCb, 0, slot ^ 1); }
            else { NSA_DMA_K(KSb, qt, slot ^ 1); NSA_DMA_V(VSb, qt, slot ^ 1); }
            const float rb0 = sl2 * ((float)(1024 * c - t0) + 15.5f), mref = tile_ref(st, rb0, true), c0 = rb0 + hoff_c - mref;
            tile_scores<16, 3, true>(p0, p1, Kbase + slot * SLOTB, qr, bk, c0, b32c, nv - 64 * c, r32, hi, vf, vb0 + slot * SLOTB);
            tile_softmax_pv(st, p0, p1, mref, vf, wsf, r32, hi);
            NSA_WAIT_BAR();
        }
        tc += nct;
    }
    const float mc_fin = st.m; float lc = st.l;
    fold_branch<false>(ostg, st, gate[0], wsf, r32, hi);
    if (qt >= 16) {
        { auto rr = __builtin_amdgcn_permlane32_swap(__float_as_uint(lc), __float_as_uint(lc), false, false); lc = __uint_as_float(rr[0]) + __uint_as_float(rr[1]); }
        const float invl = lc > 0.f ? 1.0f / lc : 0.f;
        float carry = 0.f;
        for (int c = 0; c < nct; ++c) {
            const int slot = (tc + c) & 1;
            if (c + 1 < nct) { NSA_DMA_K(KCb, c + 1, slot ^ 1); }
            else { NSA_DMA_K(KSb, qt, slot ^ 1); NSA_DMA_V(VSb, qt, slot ^ 1); }
            const float c0 = sl2 * ((float)(1024 * c - t0) + 15.5f) + hoff_c - mc_fin;
            tile_scores<16, 3, false>(p0, p1, Kbase + slot * SLOTB, qr, bk, c0, b32c, nv - 64 * c, r32, hi, vf, 0);
#pragma unroll
            for (int r = 0; r < 16; ++r) { p0[r] = __builtin_amdgcn_exp2f(p0[r]) * invl; p1[r] = __builtin_amdgcn_exp2f(p1[r]) * invl; }
            float imp0[4], imp1[4], pl0[4], pl1[4];
#pragma unroll
            for (int a = 0; a < 4; ++a) {
                imp0[a] = (p0[4 * a] + p0[4 * a + 1]) + (p0[4 * a + 2] + p0[4 * a + 3]); imp1[a] = (p1[4 * a] + p1[4 * a + 1]) + (p1[4 * a + 2] + p1[4 * a + 3]);
                pl0[a] = __shfl_xor(p0[4 * a + 3], 32); pl1[a] = __shfl_xor(p1[4 * a + 3], 32);
            }
            if (hi) {
#pragma unroll
                for (int a = 0; a < 4; ++a) { imp0[a] += pl0[a]; imp1[a] += pl1[a]; }
            } else {
                imp0[0] += carry; imp1[0] += pl0[3];
#pragma unroll
                for (int a = 1; a < 4; ++a) { imp0[a] += pl0[a - 1]; imp1[a] += pl1[a - 1]; }
            }
            carry = pl1[3];
#pragma unroll
            for (int a = 0; a < 4; ++a) {
                imp0[a] += __shfl_xor(imp0[a], 1); imp0[a] += __shfl_xor(imp0[a], 2); imp1[a] += __shfl_xor(imp1[a], 1); imp1[a] += __shfl_xor(imp1[a], 2);
                if (hq == 0) { IMP[tl * 64 + 16 * c + 2 * a + hi] = imp0[a]; IMP[tl * 64 + 16 * c + 8 + 2 * a + hi] = imp1[a]; }
            }
            NSA_WAIT_BAR();
        }
        tc += nct;
    }
    unsigned long long wu = 0ull;
    if (qt < 16) {
        wu = (2ull << qt) - 1ull;
        if (lane < 8) { MASK[2 * (8 * wid + lane)] = (unsigned)wu; MASK[2 * (8 * wid + lane) + 1] = (unsigned)(wu >> 32); }
    } else {
        const int j = lane; const bool valid = j <= qt, forced = (j == 0) || (j == qt) || (j == qt - 1);
        for (int k = 0; k < 8; ++k) {
            const float imp = IMP[(8 * wid + k) * 64 + j];
            const float scv = valid ? (forced ? 1e9f : imp) : -1e9f;
            const unsigned fb = __float_as_uint(scv), key = fb ^ ((fb >> 31) ? 0xffffffffu : 0x80000000u);
            unsigned T = 0u;
#pragma unroll
            for (int bit = 31; bit >= 0; --bit) { const unsigned cand = T | (1u << bit); if (__builtin_popcountll(__ballot(key >= cand)) >= 16) T = cand; }
            const unsigned long long gt = __ballot(key > T), eq = __ballot(key == T);
            const int need = 16 - __builtin_popcountll(gt);
            const int before = (int)__builtin_amdgcn_mbcnt_hi((unsigned)(eq >> 32), __builtin_amdgcn_mbcnt_lo((unsigned)eq, 0u));
            const bool sel = (key > T) || ((key == T) && (before < need));
            const unsigned long long mk = __ballot(sel && (scv > -0.5e9f));
            wu |= mk;
            if (lane == 0) { MASK[2 * (8 * wid + k)] = (unsigned)mk; MASK[2 * (8 * wid + k) + 1] = (unsigned)(mk >> 32); }
        }
    }
    if (lane == 0) { WU[2 * wid] = (unsigned)wu; WU[2 * wid + 1] = (unsigned)(wu >> 32); }
    NSA_WAIT_BAR();
    unsigned long long uni = 0ull;
#pragma unroll
    for (int w = 0; w < 8; ++w) uni |= ((unsigned long long)WU[2 * w]) | (((unsigned long long)WU[2 * w + 1]) << 32);
    uni = ((unsigned long long)__builtin_amdgcn_readfirstlane((unsigned)uni)) | (((unsigned long long)__builtin_amdgcn_readfirstlane((unsigned)(uni >> 32))) << 32);
    const unsigned long long mymask = ((unsigned long long)MASK[2 * tl]) | (((unsigned long long)MASK[2 * tl + 1]) << 32);
    {
        state_init(st);
        unsigned long long rem = uni;
        int j = 63 - __builtin_clzll(rem); rem &= ~(1ull << j);
        for (int i = 0;; ++i) {
            const int slot = (tc + i) & 1; const bool more = rem != 0ull;
            int jn = 0;
            if (more) { jn = 63 - __builtin_clzll(rem); rem &= ~(1ull << jn); NSA_DMA_K(KSb, jn, slot ^ 1); NSA_DMA_V(VSb, jn, slot ^ 1); }
            if ((wu >> j) & 1ull) {
                const bool live = ((mymask >> j) & 1ull) != 0ull;
                const float rb0 = sl2 * (float)(64 * j - t0), mref = tile_ref(st, rb0, live), c0 = live ? rb0 + hoff_t - mref : -INFINITY;
                if (j == qt) tile_scores<1, 1, true>(p0, p1, Kbase + slot * SLOTB, qr, bk, c0, b32t, tl, r32, hi, vf, vb0 + slot * SLOTB);
                else tile_scores<1, 0, true>(p0, p1, Kbase + slot * SLOTB, qr, bk, c0, b32t, 0, r32, hi, vf, vb0 + slot * SLOTB);
                tile_softmax_pv(st, p0, p1, mref, vf, wsf, r32, hi);
            }
            NSA_WAIT_BAR();
            if (!more) break;
            j = jn;
        }
        if (wid == 0 && lane == 0) nxt_ticket = qbase + (int)__hip_atomic_fetch_add(qctr, 1u, __ATOMIC_RELAXED, __HIP_MEMORY_SCOPE_AGENT);
        fold_branch<false>(ostg, st, gate[1], wsf, r32, hi);
    }
    {
#pragma unroll
        for (int i = 0; i < 4; ++i) { const int row = i * 8 + (lane >> 3), ch = lane & 7;
            const f32x4_t v0 = *(LAS const f32x4_t*)(ostg + row * 64 + ch * 8), v1 = *(LAS const f32x4_t*)(ostg + row * 64 + ch * 8 + 4);
            u32x4_t v; v.x = cvtpk_s(v0[0], v0[1]); v.y = cvtpk_s(v0[2], v0[3]); v.z = cvtpk_s(v1[0], v1[1]); v.w = cvtpk_s(v1[2], v1[3]);
            *(u32x4_t*)(AB + (m0 + 8 * wid + (row >> 2)) * 2048 + 256 * g + (row & 3) * 64 + ch * 8) = v; }
    }
    NSA_WAIT_BAR();
#undef NSA_DMA_K
#undef NSA_DMA_V
    return nxt_ticket;
}
constexpr int L_QS = 145416;
__device__ __forceinline__ void nsa_phase(const Ptrs& P, LAS unsigned char* lds, int bid, int G, const int wave_s) {
    unsigned* qctr = (unsigned*)(P.ws + WS_CTL) + 3584;
    LAS int* qs = (LAS int*)(lds + L_QS);
    int k = bid;
    while (k < 1024 + LW_CHUNKS) {
        int nxt;
        if (k < 1024) {
            const int qt = 63 - (k >> 4), g = 3 - ((k >> 2) & 3), b = k & 3;
            nxt = nsa_unit(P, lds, b * 4 + g, qt, wave_s, qctr, G);
        } else {
            nxt = 0;
            if (wave_s == 0 && fresh_lane() == 0) nxt = G + (int)__hip_atomic_fetch_add(qctr, 1u, __ATOMIC_RELAXED, __HIP_MEMORY_SCOPE_AGENT);
            late_weight_chunk(P, lds, k - 1024, wave_s);
        }
        if (wave_s == 0 && fresh_lane() == 0) *qs = nxt;
        NSA_WAIT_BAR();
        k = __builtin_amdgcn_readfirstlane(*qs);
    }
}
}

namespace p2 {
using nsa::bf16x8; using nsa::f32x16; using nsa::s16x4; using nsa::crow; using nsa::glds16; using nsa::cvtpk_s;
#define P2_WAIT_BAR() asm volatile("s_waitcnt vmcnt(0) lgkmcnt(0)\n\ts_barrier" ::: "memory")
constexpr int CB_BUF = 40960;
constexpr int CP_STRIDE = 65;
__device__ __forceinline__ void compress_unit(const Ptrs& P, LAS unsigned char* lds, int u, const int wave_s) {
    unsigned char* ws = P.ws;
    const int lane = fresh_lane(), r32 = lane & 31, hi = lane >> 5, wid = wave_s;
    const int kv = u >> 6, bg = (u >> 2) & 15, n0 = 64 * (u & 3);
    const bf16_t* Ag = (const bf16_t*)(ws + WS_KV6) + (size_t)kv * KVSZ + (size_t)bg * SEQ * 64 + (size_t)n0 * 1024;
    const bf16_t* Bg = (const bf16_t*)(ws + WS_W1C) + (size_t)kv * 256 * 2048;
    const unsigned lds0 = (unsigned)(uintptr_t)lds;
    const unsigned aoff = (unsigned)(lane * 1024 + wid * 8) * 2u, boff = (unsigned)(lane * 2048 + wid * 8) * 2u;
    const unsigned dstw = lds0 + wid * 1024;
#define P2_DMA_TILE(kt, buf) do { const unsigned d_ = (unsigned)__builtin_amdgcn_readfirstlane(dstw + (buf) * CB_BUF); \
        glds16(Ag + (kt) * 64, aoff, d_); \
        _Pragma("unroll") for (int ct_ = 0; ct_ < 4; ++ct_) glds16(Bg + (size_t)ct_ * 64 * 2048 + (kt) * 64, boff, d_ + 8192u * (ct_ + 1)); } while (0)
    const int ct = wid >> 1, half = wid & 1, ncol0 = 64 * ct + 32 * half;
    f32x16 hT[2]; hT[0] = f32x16{}; hT[1] = f32x16{};
    P2_DMA_TILE(0, 0); P2_WAIT_BAR();
    for (int kt = 0; kt < 32; ++kt) {
        const int buf = kt & 1;
        if (kt + 1 < 32) P2_DMA_TILE(kt + 1, buf ^ 1);
        LAS const char* sa = (LAS const char*)(lds + buf * CB_BUF) + hi * 1024 + r32 * 16;
        LAS const char* sb = (LAS const char*)(lds + buf * CB_BUF + 8192 * (ct + 1)) + half * 512 + hi * 1024 + r32 * 16;
#pragma unroll
        for (int d0 = 0; d0 < 4; ++d0) {
            const bf16x8 bf = *(LAS const bf16x8*)(sb + d0 * 2048), a0 = *(LAS const bf16x8*)(sa + d0 * 2048), a1 = *(LAS const bf16x8*)(sa + d0 * 2048 + 512);
            hT[0] = __builtin_amdgcn_mfma_f32_32x32x16_bf16(bf, a0, hT[0], 0, 0, 0);
            hT[1] = __builtin_amdgcn_mfma_f32_32x32x16_bf16(bf, a1, hT[1], 0, 0, 0);
        }
        P2_WAIT_BAR();
    }
    const float* bias1 = (const float*)(ws + WS_SMALL + SM_BIAS1) + kv * 256 + ncol0;
    bf16x8 hb[2][2];
#pragma unroll
    for (int mt = 0; mt < 2; ++mt) {
        float g[16];
#pragma unroll
        for (int r = 0; r < 16; ++r) g[r] = gelu_tanh(hT[mt][r] + bias1[crow(r, hi)]);
#pragma unroll
        for (int s = 0; s < 2; ++s) { u32x4_t w; w.x = cvtpk_s(g[8 * s], g[8 * s + 1]); w.y = cvtpk_s(g[8 * s + 2], g[8 * s + 3]); w.z = cvtpk_s(g[8 * s + 4], g[8 * s + 5]); w.w = cvtpk_s(g[8 * s + 6], g[8 * s + 7]);
            hb[mt][s] = __builtin_bit_cast(bf16x8, w); }
    }
    const bf16_t* w2t = (const bf16_t*)(ws + WS_SMALL + SM_W2T) + (size_t)kv * 64 * 256;
    f32x16 oT[2][2];
#pragma unroll
    for (int dt = 0; dt < 2; ++dt)
#pragma unroll
        for (int mt = 0; mt < 2; ++mt) oT[dt][mt] = f32x16{};
#pragma unroll
    for (int dt = 0; dt < 2; ++dt)
#pragma unroll
        for (int s = 0; s < 2; ++s) {
            const bf16_t* wp = w2t + (size_t)(32 * dt + r32) * 256 + ncol0 + 16 * s + 4 * hi;
            const u32x2_t lo = *(const u32x2_t*)wp, hi2 = *(const u32x2_t*)(wp + 8);
            const u32x4_t wv = {lo.x, lo.y, hi2.x, hi2.y}; const bf16x8 wf = __builtin_bit_cast(bf16x8, wv);
#pragma unroll
            for (int mt = 0; mt < 2; ++mt) oT[dt][mt] = __builtin_amdgcn_mfma_f32_32x32x16_bf16(wf, hb[mt][s], oT[dt][mt], 0, 0, 0);
        }
    LAS float* part = (LAS float*)lds + wid * 64 * CP_STRIDE;
#pragma unroll
    for (int dt = 0; dt < 2; ++dt)
#pragma unroll
        for (int mt = 0; mt < 2; ++mt)
#pragma unroll
            for (int r = 0; r < 16; ++r) part[(32 * mt + r32) * CP_STRIDE + 32 * dt + crow(r, hi)] = oT[dt][mt][r];
    P2_WAIT_BAR();
    {
        const int tid = wid * 64 + lane, m = tid >> 3, dg = tid & 7;
        float o[8];
#pragma unroll
        for (int e = 0; e < 8; ++e) { float s = 0.f;
#pragma unroll
            for (int w = 0; w < 8; ++w) s += ((LAS const float*)lds)[(w * 64 + m) * CP_STRIDE + 8 * dg + e];
            o[e] = s; }
        if (kv == 0) {
            float ss = 0.f;
#pragma unroll
            for (int e = 0; e < 8; ++e) ss += o[e] * o[e];
            ss += __shfl_xor(ss, 1); ss += __shfl_xor(ss, 2); ss += __shfl_xor(ss, 4);
            const float rr = __builtin_amdgcn_rsqf(ss * (1.0f / 64.0f) + 1e-6f);
#pragma unroll
            for (int e = 0; e < 8; ++e) o[e] *= rr * P.in[4][8 * dg + e];
        }
        const int n = n0 + m;
        u32x4_t v = {0u, 0u, 0u, 0u};
        if (n < 255) { v.x = cvtpk_s(o[0], o[1]); v.y = cvtpk_s(o[2], o[3]); v.z = cvtpk_s(o[4], o[5]); v.w = cvtpk_s(o[6], o[7]); }
        *(u32x4_t*)((bf16_t*)(ws + (kv ? WS_VC : WS_KC)) + ((size_t)bg * 256 + n) * 64 + 8 * dg) = v;
    }
    P2_WAIT_BAR();
#undef P2_DMA_TILE
}

constexpr int G_V = 0, G_ST = 32768, G_OST = 33792, G_END = 33792 + 65536;
__device__ __forceinline__ void gmlp_unit(const Ptrs& P, LAS unsigned char* lds, int unit, const int wave_s) {
    unsigned char* ws = P.ws;
    const int lane = fresh_lane(), r32 = lane & 31, hi = lane >> 5, wid = wave_s, tid = wid * 64 + lane;
    const int g = unit & 7, chunk = (unit >> 3) & 31, b = unit >> 8; const int m0 = b * SEQ + chunk * 128;
    const bf16_t* GV = (const bf16_t*)(ws + WS_GV); const bf16_t* U = (const bf16_t*)(ws + WS_U); const float* VSTAT = (const float*)(ws + WS_VSTAT);
    const bf16_t* SWB = (const bf16_t*)(ws + WS_SMALL + SM_SWB) + (size_t)g * 16384;
    bf16_t* AB = (bf16_t*)(ws + WS_AB);
    const float* ln_w = P.in[8]; const float* ln_b = P.in[9]; const float* sbp = P.in[11];
    LAS float* st = (LAS float*)(lds + G_ST);
    if (tid < 128) { const float* p = VSTAT + (size_t)(m0 + tid) * 32; float s1 = 0.f, s2 = 0.f;
#pragma unroll
        for (int i = 0; i < 16; ++i) { s1 += p[2 * i]; s2 += p[2 * i + 1]; }
        const float mean = s1 * (1.0f / 1024.0f); float var = s2 * (1.0f / 1024.0f) - mean * mean; var = var < 0.f ? 0.f : var;
        st[2 * tid] = mean; st[2 * tid + 1] = __builtin_amdgcn_rsqf(var + 1e-5f); }
    P2_WAIT_BAR();
#pragma unroll
    for (int i = 0; i < 4; ++i) { const int idx = tid + 512 * i, s = idx >> 4, c8 = idx & 15;
        const u32x4_t raw = *(const u32x4_t*)(GV + (size_t)(m0 + s) * 1024 + g * 128 + 8 * c8); float f[8]; unpack8(raw, f);
        const float mean = st[2 * s], rstd = st[2 * s + 1];
        const f32x4_t w0 = *(const f32x4_t*)(ln_w + g * 128 + 8 * c8), w1 = *(const f32x4_t*)(ln_w + g * 128 + 8 * c8 + 4), b0 = *(const f32x4_t*)(ln_b + g * 128 + 8 * c8), b1 = *(const f32x4_t*)(ln_b + g * 128 + 8 * c8 + 4);
        float y[8];
#pragma unroll
        for (int e = 0; e < 4; ++e) { y[e] = (f[e] - mean) * rstd * w0[e] + b0[e]; y[4 + e] = (f[4 + e] - mean) * rstd * w1[e] + b1[e]; }
        u32x4_t o; o.x = cvtpk_s(y[0], y[1]); o.y = cvtpk_s(y[2], y[3]); o.z = cvtpk_s(y[4], y[5]); o.w = cvtpk_s(y[6], y[7]);
        const int st_ = s >> 6, sk = s & 63, ch = c8 >> 3, x = c8 & 7;
        *(LAS u32x4_t*)(lds + G_V + (st_ * 2 + ch) * 8192 + (x >> 2) * 4096 + (sk >> 4) * 1024 + (sk & 15) * 64 + (x & 3) * 16) = o; }
    P2_WAIT_BAR();
    const int tb = wid >> 1, ch = wid & 1;
    f32x16 o[2]; o[0] = f32x16{}; o[1] = f32x16{};
    const int vb0 = (int)((unsigned)(uintptr_t)lds + G_V) + ((lane >> 4) & 1) * 32 + (lane & 3) * 8 + (4 * hi + ((lane & 15) >> 2)) * 64;
    const int nst = tb >= 2 ? 2 : 1;
    for (int st_ = 0; st_ < nst; ++st_) {
        bf16x8 pa[4];
#pragma unroll
        for (int ks = 0; ks < 4; ++ks) {
            const bf16_t* wp = SWB + (size_t)(32 * tb + r32) * 128 + 64 * st_ + 16 * ks + 4 * hi;
            const u32x2_t lo = *(const u32x2_t*)wp, hi2 = *(const u32x2_t*)(wp + 8);
            const u32x4_t wv = {lo.x, lo.y, hi2.x, hi2.y}; pa[ks] = __builtin_bit_cast(bf16x8, wv); }
        nsa::pv(o, vb0 + (st_ * 2 + ch) * 8192, pa[0], pa[1], pa[2], pa[3]);
    }
    LAS float* ostg = (LAS float*)(lds + G_OST) + wid * 2048;
#pragma unroll
    for (int r = 0; r < 16; ++r) { const int orow = crow(r, hi);
#pragma unroll
        for (int d0 = 0; d0 < 2; ++d0) ostg[orow * 64 + d0 * 32 + r32] = o[d0][r]; }
    asm volatile("s_waitcnt lgkmcnt(0)" ::: "memory");
#pragma unroll
    for (int i = 0; i < 4; ++i) { const int row = i * 8 + (lane >> 3), c8 = lane & 7, t = 32 * tb + row;
        const f32x4_t v0 = *(LAS const f32x4_t*)(ostg + row * 64 + c8 * 8), v1 = *(LAS const f32x4_t*)(ostg + row * 64 + c8 * 8 + 4);
        const size_t grow = (size_t)(m0 + t); const int col = g * 128 + 64 * ch + 8 * c8;
        float uf[8]; unpack8(*(const u32x4_t*)(U + grow * 1024 + col), uf);
        const float sbv = sbp[g * 128 + t];
        u32x4_t w; w.x = cvtpk_s(uf[0] * (v0[0] + sbv), uf[1] * (v0[1] + sbv)); w.y = cvtpk_s(uf[2] * (v0[2] + sbv), uf[3] * (v0[3] + sbv));
        w.z = cvtpk_s(uf[4] * (v1[0] + sbv), uf[5] * (v1[1] + sbv)); w.w = cvtpk_s(uf[6] * (v1[2] + sbv), uf[7] * (v1[3] + sbv));
        *(u32x4_t*)(AB + grow * 2048 + 1024 + col) = w; }
    P2_WAIT_BAR();
}
#undef P2_WAIT_BAR
}

#define XB_TMO      128
#define XB_XCNT(j)  (256  + 64 * (j))
#define XB_XSUB(j)  (1280 + 64 * (j))
#define XB_XGEN(j)  (2304 + 64 * (j))
#define XB_TOP      3328
#define XB_TOPGEN   3392
#define XCD_BAR_WORDS 3456
#define XB_SPIN_CAP (1u << 18)

__device__ __forceinline__ unsigned xb_ld(unsigned* p)              { return __hip_atomic_load(p, __ATOMIC_RELAXED, __HIP_MEMORY_SCOPE_AGENT); }
__device__ __forceinline__ unsigned xb_add(unsigned* p, unsigned v) { return __hip_atomic_fetch_add(p, v, __ATOMIC_RELAXED, __HIP_MEMORY_SCOPE_AGENT); }
__device__ __forceinline__ unsigned xb_xcc_id() { return (unsigned)__builtin_amdgcn_s_getreg((3 << 11) | 20) & 0xFu; }
#define XB_SPIN(cond, bar) do { unsigned _sp = 0; while (cond) { __builtin_amdgcn_s_sleep(1); \
    if ((++_sp & 255u) == 0u) { if (xb_ld(&(bar)[XB_TMO])) break; if (_sp > XB_SPIN_CAP) { atomicAdd(&(bar)[XB_TMO], 1u); break; } } } } while (0)

struct XcdBarrier {
    unsigned* bar; unsigned x; unsigned w0;
    volatile LAS unsigned* st;
};

__device__ __forceinline__ XcdBarrier xcd_barrier_post(unsigned* bar, volatile LAS unsigned* st, int wave_s) {
    XcdBarrier b; b.bar = bar; b.x = xb_xcc_id(); b.st = st; b.w0 = wave_s == 0 ? 1u : 0u;
    if (b.w0 && fresh_lane() == 0) (void)xb_add(&bar[XB_XCNT(b.x)], 1u);
    return b;
}
__device__ __forceinline__ void xcd_barrier_complete(unsigned* bar, unsigned x, unsigned& nloc, unsigned& nx) {
    const unsigned G = gridDim.x * gridDim.y * gridDim.z;
    unsigned sum, cnt, mine, sp = 0u;
    for (;;) {
        sum = 0u; cnt = 0u; mine = 0u;
#pragma unroll
        for (unsigned j = 0; j < 16; ++j) { const unsigned c = xb_ld(&bar[XB_XCNT(j)]); sum += c; cnt += (c > 0u) ? 1u : 0u; mine = (j == x) ? c : mine; }
        if (sum == G) break;
        __builtin_amdgcn_s_sleep(1);
        if ((++sp & 255u) == 0u) { if (xb_ld(&bar[XB_TMO])) break; if (sp > XB_SPIN_CAP) { atomicAdd(&bar[XB_TMO], 1u); break; } }
    }
    nloc = mine > 0u ? mine : 1u; nx = cnt > 0u ? cnt : 1u;
}

__device__ __forceinline__ void xcd_barrier(const XcdBarrier& b) {
    asm volatile("s_waitcnt vmcnt(0)" ::: "memory");
    __syncthreads();
    if (b.w0 && fresh_lane() == 0) {
        unsigned* bar = b.bar;
        __builtin_amdgcn_s_waitcnt(0);
        unsigned nloc = b.st[0], nx = b.st[1];
        if (nloc == 0u) { xcd_barrier_complete(bar, b.x, nloc, nx); b.st[0] = nloc; b.st[1] = nx; }
        const unsigned old = xb_add(&bar[XB_XSUB(b.x)], 1u);
        const unsigned gen = old / nloc;
        if (old + 1u == (gen + 1u) * nloc) {
            __builtin_amdgcn_fence(__ATOMIC_RELEASE, "agent");
            asm volatile("s_waitcnt vmcnt(0)" ::: "memory");
            const unsigned og = xb_add(&bar[XB_TOP], 1u);
            const unsigned tg = og / nx;
            if (og + 1u == (tg + 1u) * nx) xb_add(&bar[XB_TOPGEN], 1u);
            else XB_SPIN(xb_ld(&bar[XB_TOPGEN]) == tg, bar);
            __builtin_amdgcn_fence(__ATOMIC_ACQUIRE, "agent");
            xb_add(&bar[XB_XGEN(b.x)], 1u);
            asm volatile("s_waitcnt vmcnt(0)" ::: "memory");
        } else {
            XB_SPIN(xb_ld(&bar[XB_XGEN(b.x)]) == gen, bar);
            __builtin_amdgcn_fence(__ATOMIC_ACQUIRE, "agent");
            asm volatile("s_waitcnt vmcnt(0)" ::: "memory");
        }
    }
    __syncthreads();
}

constexpr int LDS_BYTES = 147456;
constexpr int LDS_XCH = 132096;
constexpr int LDS_MISC = 145408;
__global__ void __launch_bounds__(512, 2) mega_fwd(Ptrs P) {
    extern __shared__ __attribute__((aligned(16))) unsigned char lds_raw[];
    LAS unsigned char* lds = (LAS unsigned char*)lds_raw;
    unsigned char* ws = P.ws;
    const int wave = __builtin_amdgcn_readfirstlane(threadIdx.x >> 6);
    const int G = gridDim.x, bid = blockIdx.x;
    if (wave == 0) { const int l_ = fresh_lane(); if (l_ < 2) ((LAS unsigned*)(lds + LDS_MISC))[l_] = 0u; }
    __syncthreads();
    const XcdBarrier bar = xcd_barrier_post((unsigned*)(ws + WS_CTL), (volatile LAS unsigned*)(lds + LDS_MISC), wave);
    p0_prologue(P, lds, bid, G, wave);
    xcd_barrier(bar);
    if (bid == 0) bias1_stage(ws, fresh_tid(wave));
    {
        pg8::Gemm g{(const bf16_t*)(ws + WS_XN), (const bf16_t*)(ws + WS_WIN), MTOK, NPROJ, 2048, 2048};
        pg8::StaticOrder S; S.init(MTOK, NPROJ, G, bid);
        pg8::EpiProj E{(bf16_t*)(ws + WS_Q), (bf16_t*)(ws + WS_KV6), (bf16_t*)(ws + WS_U), (bf16_t*)(ws + WS_GV), (float*)(ws + WS_GATES), (float*)(ws + WS_VSTAT), P.in[3], P.in[4]};
        pg8::gemm_phase<pg8::EpiProj, pg8::StaticOrder, true, true>(lds, g, S, E, wave);
    }
    xcd_barrier(bar);
    if (bid < 128 && G >= 256) p2::compress_unit(P, lds, bid, wave);
    else if (G >= 256) { for (int u = bid - 128; u < 1024; u += G - 128) p2::gmlp_unit(P, lds, u, wave); }
    xcd_barrier(bar);
    nsa::nsa_phase(P, lds, bid, G, wave);
    xcd_barrier(bar);
    {
        pg8::Gemm g{(const bf16_t*)(ws + WS_AB), (const bf16_t*)(ws + WS_WOUT), MTOK, 2048, 2048, 2048};
        pg8::StaticOrder S; S.init(MTOK, 2048, G, bid);
        pg8::EpiRes1 E{P.in[0], P.out, (bf16_t*)(ws + WS_XN), (float*)(ws + WS_SSQ)};
        pg8::gemm_phase<pg8::EpiRes1, pg8::StaticOrder, true, true>(lds, g, S, E, wave);
    }
    xcd_barrier(bar);
    for (int m = bid * 512 + fresh_tid(wave); m < MTOK; m += G * 512) {
        const float* p = (const float*)(ws + WS_SSQ) + (size_t)m * 32; float s = 0.f;
#pragma unroll
        for (int i = 0; i < 32; ++i) s += p[i];
        ((float*)(ws + WS_SMALL + SM_R2))[m] = __builtin_amdgcn_rsqf(s * (1.0f / D_MODEL) + 1e-6f);
    }
    xcd_barrier(bar);
    {
        pg8::Gemm g{(const bf16_t*)(ws + WS_XN), (const bf16_t*)(ws + WS_WUP), MTOK, N_UP, 2048, 2048};
        pg8::StaticOrder S; S.init(MTOK, N_UP, G, bid);
        pg8::EpiUpConv E{(bf16_t*)(ws + WS_G), (const float*)(ws + WS_SMALL + SM_R2), P.in[15], P.in[16], (float*)(ws + WS_HLAST), (float*)(ws + WS_FIRST), lds + LDS_XCH};
        pg8::gemm_phase<pg8::EpiUpConv, pg8::StaticOrder, true, true>(lds, g, S, E, wave);
    }
    xcd_barrier(bar);
    for (int it = bid * 512 + fresh_tid(wave); it < 60 * 44 * 2 * 16; it += G * 512) {
        const int c8 = it & 15, row = (it >> 4) & 1, tl_ = it >> 5, pn = tl_ % 44, pmi = tl_ / 44, pm = pmi + pmi / 15 + 1;
        const float* cw = P.in[15]; const float* cb = P.in[16]; (void)cb;
        const float* fp = (const float*)(ws + WS_FIRST) + ((size_t)(pm * 44 + pn) * 2 + row) * 256 + 8 * c8;
        const float* lp = (const float*)(ws + WS_HLAST) + ((size_t)((pm - 1) * 44 + pn) * 2) * 256 + 8 * c8;
        const int ch = pn * 128 + 8 * c8;
        float r[8];
#pragma unroll
        for (int e = 0; e < 8; ++e) {
            const float l0g = lp[e], l1g = lp[256 + e], l0u = lp[128 + e], l1u = lp[256 + 128 + e];
            const float w0g = cw[ch + e], w1g = cw[N_UP + ch + e], w0u = cw[D_FF + ch + e], w1u = cw[N_UP + D_FF + ch + e];
            const float cg = fp[e] + (row == 0 ? w1g * l1g + w0g * l0g : w0g * l1g), cu = fp[128 + e] + (row == 0 ? w1u * l1u + w0u * l0u : w0u * l1u);
            r[e] = cg * sigmoidf_(cg) * cu;
        }
        u32x4_t o; o.x = pk2(r[0], r[1]); o.y = pk2(r[2], r[3]); o.z = pk2(r[4], r[5]); o.w = pk2(r[6], r[7]);
        *(u32x4_t*)((bf16_t*)(ws + WS_G) + (size_t)(pm * 256 + row) * D_FF + ch) = o;
    }
    xcd_barrier(bar);
    {
        pg8::Gemm g{(const bf16_t*)(ws + WS_G), (const bf16_t*)(ws + WS_WDOWN), MTOK, 2048, D_FF, D_FF};
        pg8::StaticOrder S; S.init(MTOK, 2048, G, bid);
        pg8::EpiDown E{P.out, (const bf16_t*)(ws + WS_XN)};
        pg8::gemm_phase<pg8::EpiDown, pg8::StaticOrder, true, true>(lds, g, S, E, wave);
    }
}

extern "C" void kernel_launch(void* const* d_in, const int* in_sizes, int n_in, void* d_out, int out_size, void* d_ws, size_t ws_size, hipStream_t stream) {
    static int grid_blocks = 0;
    if (!grid_blocks) {
        int dev = 0, cus = 0, per_cu = 0;
        (void)hipGetDevice(&dev);
        (void)hipDeviceGetAttribute(&cus, hipDeviceAttributeMultiprocessorCount, dev);
        (void)hipFuncSetAttribute((const void*)mega_fwd, hipFuncAttributeMaxDynamicSharedMemorySize, LDS_BYTES);
        (void)hipOccupancyMaxActiveBlocksPerMultiprocessor(&per_cu, (const void*)mega_fwd, 512, LDS_BYTES);
        if (per_cu < 1) { fprintf(stderr, "kernel_launch: occupancy query says %d blocks/CU\n", per_cu); per_cu = 1; }
        grid_blocks = cus * 1;
        (void)hipGetLastError();
    }
    if (n_in != 18 || ws_size < WS_END) { fprintf(stderr, "kernel_launch: unexpected n_in %d / ws %zu\n", n_in, ws_size); return; }
    Ptrs P{};
    for (int i = 0; i < 18; ++i) P.in[i] = (const float*)d_in[i];
    P.out = (float*)d_out; P.ws = (unsigned char*)d_ws;
    (void)hipMemsetAsync((char*)d_ws + WS_CTL, 0, 16384, stream);
    mega_fwd<<<dim3(grid_blocks), dim3(512), LDS_BYTES, stream>>>(P);
}
```

```cpp
#include <hip/hip_runtime.h>
#include <cstdio>
#include <cstdint>

constexpr int D_MODEL = 2048, BATCH = 4, SEQ = 4096, MTOK = BATCH * SEQ;
constexpr int IN_COLS = 4656, NPROJ = 4864;
constexpr int D_FF = 5632, N_UP = 2 * D_FF;
constexpr int NBG = 16;
constexpr size_t KVSZ = (size_t)NBG * SEQ * 64;
constexpr float LOG2E = 1.4426950408889634f;

constexpr size_t MiB = 1u << 20;
constexpr size_t WS_CTL = 0;
constexpr size_t WS_WIN = 1 * MiB, WS_WOUT = 20 * MiB, WS_WUP = 28 * MiB, WS_WDOWN = 72 * MiB, WS_W1C = 94 * MiB;
constexpr size_t WS_SMALL = 96 * MiB;
constexpr size_t SM_BIASP = 0, SM_BIAS1 = 65536, SM_R2 = 131072, SM_W2T = 196608  , SM_SWB = 262144  ;
constexpr size_t WS_XN = 97 * MiB;
constexpr size_t WS_Q = 161 * MiB;
constexpr size_t WS_KV6 = 193 * MiB;
constexpr size_t WS_U = 241 * MiB, WS_GV = 273 * MiB;
constexpr size_t WS_GATES = 305 * MiB;
constexpr size_t WS_VSTAT = 308 * MiB;
constexpr size_t WS_KC = 310 * MiB, WS_VC = 310 * MiB + 524288;
constexpr size_t WS_HC = 311 * MiB;
constexpr size_t WS_AB = 315 * MiB;
constexpr size_t WS_SSQ = 379 * MiB;
constexpr size_t WS_G = 161 * MiB;
constexpr size_t WS_HID = 381 * MiB;
constexpr size_t WS_HLAST = 381 * MiB, WS_FIRST = 388 * MiB;
constexpr size_t WS_END = 469 * MiB;

#define LAS __attribute__((address_space(3)))
typedef unsigned short bf16_t;
typedef unsigned u32x4_t __attribute__((ext_vector_type(4)));
typedef unsigned u32x2_t __attribute__((ext_vector_type(2)));
typedef float f32x4_t __attribute__((ext_vector_type(4)));

__device__ __forceinline__ float bf2f(unsigned short h) { return __uint_as_float(((unsigned)h) << 16); }
__device__ __forceinline__ unsigned f2bf(float f) { unsigned u = __float_as_uint(f); return (u + 0x7fffu + ((u >> 16) & 1u)) >> 16; }
__device__ __forceinline__ unsigned pk2(float lo, float hi) { return f2bf(lo) | (f2bf(hi) << 16); }
__device__ __forceinline__ float gelu_tanh(float x) {
    const float u = 0.7978845608028654f * (x + 0.044715f * x * x * x);
    const float e = __builtin_amdgcn_exp2f(-2.8853900817779268f * u);
    return x * __builtin_amdgcn_rcpf(1.0f + e);
}
__device__ __forceinline__ float sigmoidf_(float x) { return __builtin_amdgcn_rcpf(1.0f + __builtin_amdgcn_exp2f(-LOG2E * x)); }
__device__ __forceinline__ float wave_sum(float v) {
#pragma unroll
    for (int o = 1; o < 64; o <<= 1) v += __shfl_xor(v, o);
    return v;
}
__device__ __forceinline__ void unpack8(u32x4_t r, float (&f)[8]) {
    f[0] = __uint_as_float(r.x << 16); f[1] = __uint_as_float(r.x & 0xffff0000u);
    f[2] = __uint_as_float(r.y << 16); f[3] = __uint_as_float(r.y & 0xffff0000u);
    f[4] = __uint_as_float(r.z << 16); f[5] = __uint_as_float(r.z & 0xffff0000u);
    f[6] = __uint_as_float(r.w << 16); f[7] = __uint_as_float(r.w & 0xffff0000u);
}

__device__ __forceinline__ int fresh_lane() { unsigned z_ = 0u; asm volatile("" : "+v"(z_)); return (int)__builtin_amdgcn_mbcnt_hi(~0u, __builtin_amdgcn_mbcnt_lo(~0u, z_)); }
__device__ __forceinline__ int fresh_tid(int wave_s) { return wave_s * 64 + fresh_lane(); }
namespace pg8 {
#define PG8_LAS __attribute__((address_space(3)))
typedef unsigned short bf16_t;
typedef short bf16x8 __attribute__((ext_vector_type(8)));
typedef float f32x4 __attribute__((ext_vector_type(4)));
typedef unsigned u32x4 __attribute__((ext_vector_type(4)));
constexpr int BM = 256, BK = 64, HALF = 128, HTB = HALF * BK * 2  , STAGE_BYTES = 8 * HTB, NXCD = 8, WGM = 8;

__host__ __device__ __forceinline__ int lds_byte(int r, int c) { const int st = (r >> 4) * 2 + (c >> 5), rr = r & 15, cc = c & 31, ob = rr * 64 + cc * 2; return st * 1024 + (ob ^ (((ob >> 9) & 1) << 5)); }
__host__ __device__ __forceinline__ void stage_rc(int b, int& R, int& C) { const int st = b / 1024, sb = b % 1024, swz = sb ^ (((sb >> 9) & 1) << 5); R = (st >> 1) * 16 + swz / 64; C = (st & 1) * 32 + (swz % 64) / 2; }
__host__ __device__ __forceinline__ int perm32(int rho) { const int n = rho >> 4, i = rho & 15; return 8 * (i >> 2) + 4 * n + (i & 3); }

struct Unit { int pm, pn; };
struct Gemm { const bf16_t* A; const bf16_t* Bt; int M, N, K, lda; };

struct StaticOrder {
    int nM, nN, nwg, G, c;
    __host__ __device__ void init(int M, int N, int G_, int c_) { nM = M / BM; nN = N / BM; nwg = nM * nN; G = G_; c = c_; }
    __host__ __device__ bool next(int i, Unit& u) const {
        const long L = (long)i * G + c; if (L >= nwg) return false;
        int wgid = (int)L; { const int q = nwg / NXCD, r = nwg % NXCD, xcd = wgid % NXCD, off = wgid / NXCD; wgid = (xcd < r ? xcd * (q + 1) : r * (q + 1) + (xcd - r) * q) + off; }
        const int nig = WGM * nN, gid = wgid / nig, fm = gid * WGM, gsz = (nM - fm) < WGM ? (nM - fm) : WGM;
        u.pm = fm + ((wgid % nig) % gsz); u.pn = (wgid % nig) / gsz; return true;
    }
    __device__ __forceinline__ void a_ready(const Unit&) const {}
    __device__ __forceinline__ void done(const Unit&) const {}
};

__device__ __forceinline__ unsigned cvt_pk_bf16(float lo, float hi) { unsigned r; asm volatile("v_cvt_pk_bf16_f32 %0, %1, %2" : "=v"(r) : "v"(lo), "v"(hi)); return r; }

struct EpiProj {
    static constexpr bool PERM = true, AFTER_DRAIN = false;
    bf16_t* Q; bf16_t* KV6; bf16_t* U; bf16_t* GV; float* GATES; float* VSTAT; const float* q_norm_w; const float* k_norm_w;
    __device__ __forceinline__ void operator()(const f32x4 (&acc)[2][2][4][2], const Unit& u, int wr, int wc, int fr, int fq) const {
        const int pn = u.pn, row0 = u.pm * BM + wr * 64 + fr;
        if (pn < 10) {
            const bool normed = (pn < 4) || pn == 6 || pn == 8;
            const float* w = pn < 4 ? q_norm_w : (k_norm_w + (pn == 6 ? 64 : 128));
            const float sc = pn < 4 ? 0.125f * LOG2E : 1.0f;
            f32x4 wv[2][2];
#pragma unroll
            for (int bj = 0; bj < 2; ++bj)
#pragma unroll
                for (int n = 0; n < 2; ++n) wv[bj][n] = normed ? (*(const f32x4*)(w + 32 * bj + 8 * fq + 4 * n)) * sc : (f32x4){1.f, 1.f, 1.f, 1.f};
#pragma unroll
            for (int ai = 0; ai < 2; ++ai)
#pragma unroll
                for (int m = 0; m < 4; ++m) {
                    const int row = row0 + ai * HALF + m * 16;
                    float r = 1.f;
                    if (normed) {
                        float ss = 0.f;
#pragma unroll
                        for (int bj = 0; bj < 2; ++bj)
#pragma unroll
                            for (int n = 0; n < 2; ++n) { const f32x4 x = acc[ai][bj][m][n]; ss += (x[0] * x[0] + x[1] * x[1]) + (x[2] * x[2] + x[3] * x[3]); }
                        ss += __shfl_xor(ss, 16); ss += __shfl_xor(ss, 32);
                        r = __builtin_amdgcn_rsqf(ss * (1.0f / 64.0f) + 1e-6f);
                    }
                    bf16_t* dst;
                    if (pn < 4) dst = Q + (size_t)row * 1024 + pn * 256 + wc * 64 + 8 * fq;
                    else { const int b = row >> 12, t = row & 4095; dst = KV6 + (size_t)(pn - 4) * KVSZ + ((size_t)((b * 4 + wc) * 4096 + t)) * 64 + 8 * fq; }
#pragma unroll
                    for (int bj = 0; bj < 2; ++bj) {
                        const f32x4 v0 = acc[ai][bj][m][0] * r * wv[bj][0], v1 = acc[ai][bj][m][1] * r * wv[bj][1];
                        u32x4 o; o.x = cvt_pk_bf16(v0[0], v0[1]); o.y = cvt_pk_bf16(v0[2], v0[3]); o.z = cvt_pk_bf16(v1[0], v1[1]); o.w = cvt_pk_bf16(v1[2], v1[3]);
                        *(u32x4*)(dst + 32 * bj) = o;
                    }
                }
        } else if (pn < 18) {
            const bool isv = pn >= 14; const int ct = isv ? pn - 14 : pn - 10;
            bf16_t* base = (isv ? GV : U) + ct * 256 + wc * 64 + 8 * fq;
#pragma unroll
            for (int ai = 0; ai < 2; ++ai)
#pragma unroll
                for (int m = 0; m < 4; ++m) {
                    const int row = row0 + ai * HALF + m * 16; float s1 = 0.f, s2 = 0.f;
#pragma unroll
                    for (int bj = 0; bj < 2; ++bj) {
                        f32x4 v0 = acc[ai][bj][m][0], v1 = acc[ai][bj][m][1];
#pragma unroll
                        for (int e = 0; e < 4; ++e) { v0[e] = gelu_tanh(v0[e]); v1[e] = gelu_tanh(v1[e]); s1 += v0[e] + v1[e]; s2 += v0[e] * v0[e] + v1[e] * v1[e]; }
                        u32x4 o; o.x = cvt_pk_bf16(v0[0], v0[1]); o.y = cvt_pk_bf16(v0[2], v0[3]); o.z = cvt_pk_bf16(v1[0], v1[1]); o.w = cvt_pk_bf16(v1[2], v1[3]);
                        *(u32x4*)(base + (size_t)row * 1024 + 32 * bj) = o;
                    }
                    if (isv) {
                        s1 += __shfl_xor(s1, 16); s1 += __shfl_xor(s1, 32); s2 += __shfl_xor(s2, 16); s2 += __shfl_xor(s2, 32);
                        if (fq == 0) { float* p = VSTAT + ((size_t)row * 16 + ct * 4 + wc) * 2; p[0] = s1; p[1] = s2; }
                    }
                }
        } else {
            if (wc == 0) {
#pragma unroll
                for (int ai = 0; ai < 2; ++ai)
#pragma unroll
                    for (int m = 0; m < 4; ++m) {
                        const int row = row0 + ai * HALF + m * 16;
#pragma unroll
                        for (int bj = 0; bj < 2; ++bj)
#pragma unroll
                            for (int n = 0; n < 2; ++n) {
                                const int L = 32 * bj + 8 * fq + 4 * n;
                                if (L < 48) { f32x4 v = acc[ai][bj][m][n]; f32x4 o; o[0] = sigmoidf_(v[0]); o[1] = sigmoidf_(v[1]); o[2] = sigmoidf_(v[2]); o[3] = sigmoidf_(v[3]); *(f32x4*)(GATES + (size_t)row * 48 + L) = o; }
                            }
                    }
            }
        }
    }
};
struct EpiCmp {
    static constexpr bool PERM = true, AFTER_DRAIN = false;
    bf16_t* HC; const float* bias1;
    __device__ __forceinline__ void operator()(const f32x4 (&acc)[2][2][4][2], const Unit& u, int wr, int wc, int fr, int fq) const {
        const int row0 = u.pm * BM + wr * 64 + fr, col0 = wc * 32 + 8 * fq;
        f32x4 bv[2][2];
#pragma unroll
        for (int bj = 0; bj < 2; ++bj)
#pragma unroll
            for (int n = 0; n < 2; ++n) bv[bj][n] = *(const f32x4*)(bias1 + u.pn * 256 + col0 + bj * HALF + 4 * n);
#pragma unroll
        for (int ai = 0; ai < 2; ++ai)
#pragma unroll
            for (int m = 0; m < 4; ++m) { bf16_t* rowp = HC + (size_t)(row0 + ai * HALF + m * 16) * 256 + col0;
#pragma unroll
                for (int bj = 0; bj < 2; ++bj) { f32x4 v0 = acc[ai][bj][m][0] + bv[bj][0], v1 = acc[ai][bj][m][1] + bv[bj][1];
#pragma unroll
                    for (int e = 0; e < 4; ++e) { v0[e] = gelu_tanh(v0[e]); v1[e] = gelu_tanh(v1[e]); }
                    u32x4 o; o.x = cvt_pk_bf16(v0[0], v0[1]); o.y = cvt_pk_bf16(v0[2], v0[3]); o.z = cvt_pk_bf16(v1[0], v1[1]); o.w = cvt_pk_bf16(v1[2], v1[3]);
                    *(u32x4*)(rowp + bj * HALF) = o; } }
    }
};
struct CmpOrder {
    int c, G;
    __device__ bool next(int i, Unit& u) const { const int L = i * G + c; if (L >= 32) return false; u.pm = L; u.pn = L >> 4; return true; }
    __device__ __forceinline__ void a_ready(const Unit&) const {}
    __device__ __forceinline__ void done(const Unit&) const {}
};
struct EpiRes1 {
    static constexpr bool PERM = false, AFTER_DRAIN = false;
    const float* x; float* out; bf16_t* X1b; float* SSQ;
    __device__ __forceinline__ void operator()(const f32x4 (&acc)[2][2][4][2], const Unit& u, int wr, int wc, int fr, int fq) const {
        const int row0 = u.pm * BM + wr * 64 + fr, col0 = u.pn * BM + wc * 32 + 4 * fq;
#pragma unroll
        for (int ai = 0; ai < 2; ++ai) {
            f32x4 xin[4][2][2];
#pragma unroll
            for (int m = 0; m < 4; ++m)
#pragma unroll
                for (int bj = 0; bj < 2; ++bj)
#pragma unroll
                    for (int n = 0; n < 2; ++n) xin[m][bj][n] = *(const f32x4*)(x + (size_t)(row0 + ai * HALF + m * 16) * D_MODEL + col0 + bj * HALF + n * 16);
            __builtin_amdgcn_sched_barrier(0);
#pragma unroll
            for (int m = 0; m < 4; ++m) { const int row = row0 + ai * HALF + m * 16; const size_t off = (size_t)row * D_MODEL + col0; float ss = 0.f;
#pragma unroll
                for (int bj = 0; bj < 2; ++bj)
#pragma unroll
                    for (int n = 0; n < 2; ++n) { const f32x4 v = xin[m][bj][n] + acc[ai][bj][m][n];
                        ss += (v[0] * v[0] + v[1] * v[1]) + (v[2] * v[2] + v[3] * v[3]);
                        u32x2_t w; w.x = cvt_pk_bf16(v[0], v[1]); w.y = cvt_pk_bf16(v[2], v[3]); *(u32x2_t*)(X1b + off + bj * HALF + n * 16) = w; }
                ss += __shfl_xor(ss, 16); ss += __shfl_xor(ss, 32);
                if (fq == 0) SSQ[(size_t)row * 32 + u.pn * 4 + wc] = ss; }
            __builtin_amdgcn_sched_barrier(0);
        }
    }
};
struct EpiUpV1 {
    static constexpr bool PERM = true, AFTER_DRAIN = false;
    bf16_t* HID; const float* R2;
    __device__ __forceinline__ void operator()(const f32x4 (&acc)[2][2][4][2], const Unit& u, int wr, int wc, int fr, int fq) const {
        const int row0 = u.pm * BM + wr * 64 + fr, col0 = u.pn * BM + wc * 32 + 8 * fq;
#pragma unroll
        for (int ai = 0; ai < 2; ++ai)
#pragma unroll
            for (int m = 0; m < 4; ++m) { const int row = row0 + ai * HALF + m * 16; const float r = R2[row]; bf16_t* rowp = HID + (size_t)row * N_UP + col0;
#pragma unroll
                for (int bj = 0; bj < 2; ++bj) { const f32x4 v0 = acc[ai][bj][m][0] * r, v1 = acc[ai][bj][m][1] * r;
                    u32x4 o; o.x = cvt_pk_bf16(v0[0], v0[1]); o.y = cvt_pk_bf16(v0[2], v0[3]); o.z = cvt_pk_bf16(v1[0], v1[1]); o.w = cvt_pk_bf16(v1[2], v1[3]);
                    *(u32x4*)(rowp + bj * HALF) = o; } }
    }
};
struct EpiDown {
    static constexpr bool PERM = false, AFTER_DRAIN = false;
    float* out; const bf16_t* X1b;
    __device__ __forceinline__ void operator()(const f32x4 (&acc)[2][2][4][2], const Unit& u, int wr, int wc, int fr, int fq) const {
        const int row0 = u.pm * BM + wr * 64 + fr, col0 = u.pn * BM + wc * 32 + 4 * fq;
#pragma unroll
        for (int ai = 0; ai < 2; ++ai) {
            u32x2_t xin[4][2][2];
#pragma unroll
            for (int m = 0; m < 4; ++m)
#pragma unroll
                for (int bj = 0; bj < 2; ++bj)
#pragma unroll
                    for (int n = 0; n < 2; ++n) xin[m][bj][n] = *(const u32x2_t*)(X1b + (size_t)(row0 + ai * HALF + m * 16) * D_MODEL + col0 + bj * HALF + n * 16);
            __builtin_amdgcn_sched_barrier(0);
#pragma unroll
            for (int m = 0; m < 4; ++m) { const size_t off = (size_t)(row0 + ai * HALF + m * 16) * D_MODEL + col0;
#pragma unroll
                for (int bj = 0; bj < 2; ++bj)
#pragma unroll
                    for (int n = 0; n < 2; ++n) { const u32x2_t w = xin[m][bj][n];
                        f32x4 v; v[0] = __uint_as_float(w.x << 16); v[1] = __uint_as_float(w.x & 0xffff0000u); v[2] = __uint_as_float(w.y << 16); v[3] = __uint_as_float(w.y & 0xffff0000u);
                        *(f32x4*)(out + off + bj * HALF + n * 16) = v + acc[ai][bj][m][n]; } }
            __builtin_amdgcn_sched_barrier(0);
        }
    }
};
__device__ __forceinline__ unsigned f2bf_(float f) { unsigned u = __float_as_uint(f); return (u + 0x7fffu + ((u >> 16) & 1u)) >> 16; }
struct EpiUpConv {
    static constexpr bool PERM = true, AFTER_DRAIN = false;
    bf16_t* G; const float* R2; const float* cw; const float* cb; float* HLAST; float* FIRST; PG8_LAS unsigned char* xlds;
    __device__ __forceinline__ void operator()(const f32x4 (&acc)[2][2][4][2], const Unit& u, int wr, int wc, int fr_in, int fq_in) const {
        (void)fr_in; (void)fq_in;
        unsigned z_ = 0u; asm volatile("" : "+v"(z_));
        const int lane_ = (int)__builtin_amdgcn_mbcnt_hi(~0u, __builtin_amdgcn_mbcnt_lo(~0u, z_)); const int fr = lane_ & 15, fq = lane_ >> 4;
        const int row0 = u.pm * BM + wr * 64 + fr;
        PG8_LAS float* X = (PG8_LAS float*)xlds;
        const unsigned tile = (unsigned)(u.pm * (N_UP / 256) + u.pn);
        if (fr >= 14) {
#pragma unroll
            for (int ai = 0; ai < 2; ++ai) { const int sg = 2 * ai + wr; const float r3 = R2[row0 + ai * HALF + 48];
#pragma unroll
                for (int bj = 0; bj < 2; ++bj)
#pragma unroll
                    for (int n = 0; n < 2; ++n) { const f32x4 h = acc[ai][bj][3][n] * r3;
                        *(PG8_LAS f32x4*)(X + ((sg * 4 + wc) * 2 + (fr - 14)) * 64 + bj * 32 + 8 * fq + 4 * n) = h;
                        if (ai == 1 && wr == 1) *(f32x4*)(HLAST + (unsigned)((tile * 2 + (fr - 14)) * 256 + bj * HALF + wc * 32 + 8 * fq + 4 * n)) = h; } }
        }
        PG8_LAS float* R2L = X + 3072;
        PG8_LAS float* Wl = X + 2048;
        { const int t_ = (wr * 4 + wc) * 64 + fq * 16 + fr;
#pragma unroll
          for (int i2 = 0; i2 < 2; ++i2) { const int i = t_ + 512 * i2, k = i >> 8, p = i & 255, c = (p < 128 ? 0 : D_FF - 128) + u.pn * 128 + p;
              Wl[i] = k < 3 ? cw[(unsigned)(k * N_UP + c)] : cb[(unsigned)c]; }
          if (t_ < 256) R2L[t_] = R2[u.pm * BM + t_]; }
        asm volatile("s_waitcnt vmcnt(0) lgkmcnt(0)" ::: "memory"); __builtin_amdgcn_s_barrier(); asm volatile("" ::: "memory");
        const int cbase = u.pn * 128 + wc * 32 + 8 * fq;
        const bool seq_start = (u.pm & 15) == 0;
#pragma unroll
        for (int ai = 0; ai < 2; ++ai) {
            const int sg = 2 * ai + wr;
            float rs[4];
#pragma unroll
            for (int m = 0; m < 4; ++m) rs[m] = R2L[wr * 64 + fr + ai * HALF + m * 16];
            const bool defer = (ai == 0) && (wr == 0) && !seq_start && (fr < 2);
#pragma unroll
            for (int n = 0; n < 2; ++n) {
                unsigned pk[4][2];
#pragma unroll
                for (int e = 0; e < 4; ++e) {
                    asm volatile("" ::: "memory"); __builtin_amdgcn_sched_barrier(0);
                    PG8_LAS const float* wp = Wl + wc * 32 + 8 * fq + 4 * n + e;
                    const float wg0 = wp[0], wg1 = wp[256], wg2 = wp[512], bg = wp[768], wu0 = wp[128], wu1 = wp[384], wu2 = wp[640], bu = wp[896];
                    float hg1 = 0.f, hg2 = 0.f, hu1 = 0.f, hu2 = 0.f;
                    if (ai == 1 || wr == 1) { PG8_LAS const float* xp = X + (((sg - 1) * 4 + wc) * 2) * 64 + 8 * fq + 4 * n + e; hg2 = xp[0]; hg1 = xp[64]; hu2 = xp[32]; hu1 = xp[96]; }
                    float ag = hg1, bgp = fr == 0 ? hg2 : hg1, au = hu1, bup = fr == 0 ? hu2 : hu1;
#pragma unroll
                    for (int m = 0; m < 4; ++m) {
                        const float vg = acc[ai][0][m][n][e] * rs[m], vu = acc[ai][1][m][n][e] * rs[m];
                        const float rg1 = __uint_as_float(__builtin_amdgcn_update_dpp(0u, __float_as_uint(vg), 0x121, 0xf, 0xf, false)), rg2 = __uint_as_float(__builtin_amdgcn_update_dpp(0u, __float_as_uint(vg), 0x122, 0xf, 0xf, false));
                        const float ru1 = __uint_as_float(__builtin_amdgcn_update_dpp(0u, __float_as_uint(vu), 0x121, 0xf, 0xf, false)), ru2 = __uint_as_float(__builtin_amdgcn_update_dpp(0u, __float_as_uint(vu), 0x122, 0xf, 0xf, false));
                        const float pg1 = fr >= 1 ? rg1 : ag, pg2 = fr >= 2 ? rg2 : bgp, pu1 = fr >= 1 ? ru1 : au, pu2 = fr >= 2 ? ru2 : bup;
                        const float cg = bg + wg0 * pg2 + wg1 * pg1 + wg2 * vg, cu = bu + wu0 * pu2 + wu1 * pu1 + wu2 * vu;
                        if (m == 0 && defer) { float* fp = FIRST + (unsigned)((tile * 2 + fr) * 256 + wc * 32 + 8 * fq + 4 * n + e); fp[0] = cg; fp[HALF] = cu; }
                        const unsigned hb = cvt_pk_bf16(cg * sigmoidf_(cg) * cu, 0.f);
                        if ((e & 1) == 0) pk[m][e >> 1] = hb; else pk[m][e >> 1] |= hb << 16;
                        ag = rg1; bgp = rg2; au = ru1; bup = ru2;
                    }
                }
#pragma unroll
                for (int m = 0; m < 4; ++m)
                    if (!(m == 0 && defer)) { u32x2_t o; o.x = pk[m][0]; o.y = pk[m][1]; *(u32x2_t*)(G + (unsigned)((row0 + ai * HALF + m * 16) * D_FF + cbase + 4 * n)) = o; }
            }
        }
    }
};
template <class Epi, class Sched, bool ALIGN_EPI = false, bool SP2 = false>
__device__ __forceinline__ void gemm_phase(PG8_LAS unsigned char* lds, const Gemm g, const Sched& S, const Epi& E, const int wave_s) {
    const int tid = fresh_tid(wave_s), wid = wave_s, lane = tid & 63,
          wr = wid >> 2, wc = wid & 3, fr = lane & 15, fq = lane >> 4;
    const int K = g.K, nt = K / BK;
    unsigned voffA[2], voffB[2];
#pragma unroll
    for (int i = 0; i < 2; ++i) { int R, C; stage_rc(tid * 16 + i * 8192, R, C); const int Rb = Epi::PERM ? ((R & ~31) + perm32(R & 31)) : R;
        voffA[i] = (unsigned)(R * g.lda + C) * 2u; voffB[i] = (unsigned)(Rb * K + C) * 2u; }
    const size_t kstep = (size_t)(BK * 2);
    const size_t hstepA = (size_t)HALF * g.lda * 2, hstepB = (size_t)HALF * K * 2;
    const size_t tstepA = 2 * hstepA, tstepB = 2 * hstepB;
    const unsigned ldsw = (unsigned)wid * 1024u;
    const int aoff = lds_byte(wr * 64 + fr, fq * 8), boff = lds_byte(wc * 32 + fr, fq * 8);
#define PG8_SA(b, h) (((b) * 2 + (h)) * HTB)
#define PG8_SB(b, h) ((4 + (b) * 2 + (h)) * HTB)
#define PG8_STAGE(bufoff, gbase, voff) do { _Pragma("unroll") for (int _i = 0; _i < 2; ++_i) \
        __builtin_amdgcn_global_load_lds((const unsigned*)((const char*)(gbase) + (voff)[_i]), (PG8_LAS unsigned*)(lds + (bufoff) + ldsw + _i * 8192), 16, 0, 0); } while (0)
#define PG8_LDA(dst, b, h) do { _Pragma("unroll") for (int m = 0; m < 4; ++m) _Pragma("unroll") for (int k = 0; k < 2; ++k) dst[m][k] = *(const PG8_LAS bf16x8*)(lds + PG8_SA(b, h) + aoff + m * 2048 + k * 1024); } while (0)
#define PG8_LDB(dst, b, h) do { _Pragma("unroll") for (int n = 0; n < 2; ++n) _Pragma("unroll") for (int k = 0; k < 2; ++k) dst[n][k] = *(const PG8_LAS bf16x8*)(lds + PG8_SB(b, h) + boff + n * 2048 + k * 1024); } while (0)
#define PG8_MMA(ai, bj, At, Bt) do { __builtin_amdgcn_s_setprio(1); _Pragma("unroll") for (int m = 0; m < 4; ++m) _Pragma("unroll") for (int n = 0; n < 2; ++n) _Pragma("unroll") for (int k = 0; k < 2; ++k) \
        acc[ai][bj][m][n] = __builtin_amdgcn_mfma_f32_16x16x32_bf16(Bt[n][k], At[m][k], acc[ai][bj][m][n], 0, 0, 0); __builtin_amdgcn_s_setprio(0); } while (0)
#define PG8_WAIT_V(n) asm volatile("s_waitcnt vmcnt(" #n ")" ::: "memory")
#define PG8_WAIT_L(n) asm volatile("s_waitcnt lgkmcnt(" #n ")" ::: "memory")
#define PG8_BAR __builtin_amdgcn_s_barrier()
#define PG8_SCHED __builtin_amdgcn_sched_barrier(0)
    Unit cur, nxt; int ui = 0;
    if (!S.next(0, cur)) return;
    f32x4 acc[2][2][4][2];
#pragma unroll
    for (int a = 0; a < 2; ++a)
#pragma unroll
        for (int b = 0; b < 2; ++b)
#pragma unroll
            for (int m = 0; m < 4; ++m)
#pragma unroll
                for (int n = 0; n < 2; ++n) acc[a][b][m][n] = (f32x4){0.f, 0.f, 0.f, 0.f};
    bf16x8 At[4][2], B0[2][2], B1[2][2];
    const char* cA = (const char*)g.A + (size_t)cur.pm * tstepA; const char* cB = (const char*)g.Bt + (size_t)cur.pn * tstepB;
    S.a_ready(cur);
    if constexpr (SP2) {
        PG8_STAGE(PG8_SB(0, 0), cB, voffB); PG8_STAGE(PG8_SB(0, 1), cB + hstepB, voffB); PG8_STAGE(PG8_SA(0, 0), cA, voffA); PG8_STAGE(PG8_SA(0, 1), cA + hstepA, voffA);
        if (wr == 1) PG8_BAR;
        PG8_WAIT_V(2); PG8_BAR;
        PG8_STAGE(PG8_SB(1, 0), cB + kstep, voffB); PG8_STAGE(PG8_SA(1, 0), cA + kstep, voffA); PG8_STAGE(PG8_SB(1, 1), cB + hstepB + kstep, voffB);
        PG8_WAIT_V(6); PG8_BAR;
    } else {
        PG8_STAGE(PG8_SB(0, 0), cB, voffB); PG8_STAGE(PG8_SA(0, 0), cA, voffA); PG8_STAGE(PG8_SB(0, 1), cB + hstepB, voffB); PG8_STAGE(PG8_SA(0, 1), cA + hstepA, voffA);
        if (wr == 1) PG8_BAR;
        PG8_WAIT_V(4); PG8_BAR;
        PG8_STAGE(PG8_SB(1, 0), cB + kstep, voffB); PG8_STAGE(PG8_SA(1, 0), cA + kstep, voffA); PG8_STAGE(PG8_SB(1, 1), cB + hstepB + kstep, voffB);
        PG8_WAIT_V(6); PG8_BAR;
    }
    for (;;) {
        const bool has_next = S.next(ui + 1, nxt);
        const char* nA = has_next ? (const char*)g.A + (size_t)nxt.pm * tstepA : cA; const char* nB = has_next ? (const char*)g.Bt + (size_t)nxt.pn * tstepB : cB;
        for (int t = 0; t < nt; t += 2) {
            const bool last = (t == nt - 2);
            const char* a1 = cA + (size_t)(t + 1) * kstep;
            const char* a2 = last ? nA : cA + (size_t)(t + 2) * kstep; const char* b2 = last ? nB : cB + (size_t)(t + 2) * kstep;
            const char* a3 = a2 + kstep; const char* b3 = b2 + kstep;
            if (last && has_next) S.a_ready(nxt);
            if constexpr (SP2) {
            PG8_LDB(B0, 0, 0); PG8_LDB(B1, 0, 1); PG8_SCHED; PG8_LDA(At, 0, 0); PG8_STAGE(PG8_SA(1, 1), a1 + hstepA, voffA);
            PG8_WAIT_V(8); PG8_WAIT_L(0); PG8_BAR; PG8_MMA(0, 0, At, B0); PG8_MMA(0, 1, At, B1); PG8_BAR; PG8_SCHED;
            PG8_LDA(At, 0, 1); PG8_STAGE(PG8_SB(0, 0), b2, voffB); PG8_STAGE(PG8_SB(0, 1), b2 + hstepB, voffB); PG8_STAGE(PG8_SA(0, 0), a2, voffA);
            PG8_WAIT_V(8); PG8_WAIT_L(0); PG8_BAR; PG8_MMA(1, 0, At, B0); PG8_MMA(1, 1, At, B1); PG8_BAR; PG8_SCHED;
            PG8_LDB(B0, 1, 0); PG8_LDB(B1, 1, 1); PG8_SCHED; PG8_LDA(At, 1, 0); PG8_STAGE(PG8_SA(0, 1), a2 + hstepA, voffA);
            PG8_WAIT_V(8); PG8_WAIT_L(0); PG8_BAR; PG8_MMA(0, 0, At, B0); PG8_MMA(0, 1, At, B1); PG8_BAR; PG8_SCHED;
            PG8_LDA(At, 1, 1); PG8_STAGE(PG8_SB(1, 0), b3, voffB); PG8_STAGE(PG8_SB(1, 1), b3 + hstepB, voffB); PG8_STAGE(PG8_SA(1, 0), a3, voffA);
            PG8_WAIT_V(8); PG8_WAIT_L(0); PG8_BAR; PG8_MMA(1, 0, At, B0); PG8_MMA(1, 1, At, B1); PG8_BAR; PG8_SCHED;
            } else {
            PG8_LDB(B0, 0, 0); PG8_SCHED; PG8_LDA(At, 0, 0); PG8_STAGE(PG8_SA(1, 1), a1 + hstepA, voffA);
            PG8_WAIT_L(8); PG8_BAR; PG8_WAIT_L(0); PG8_MMA(0, 0, At, B0); PG8_BAR; PG8_SCHED;
            PG8_LDB(B1, 0, 1); PG8_STAGE(PG8_SB(0, 0), b2, voffB);
            PG8_BAR; PG8_WAIT_L(0); PG8_MMA(0, 1, At, B1); PG8_BAR;
            PG8_LDA(At, 0, 1); PG8_STAGE(PG8_SA(0, 0), a2, voffA);
            PG8_BAR; PG8_WAIT_L(0); PG8_MMA(1, 0, At, B0); PG8_BAR; PG8_SCHED;
            PG8_STAGE(PG8_SB(0, 1), b2 + hstepB, voffB);
            PG8_WAIT_V(6); PG8_BAR; PG8_MMA(1, 1, At, B1); PG8_BAR;
            PG8_LDB(B0, 1, 0); PG8_SCHED; PG8_LDA(At, 1, 0); PG8_STAGE(PG8_SA(0, 1), a2 + hstepA, voffA);
            PG8_WAIT_L(8); PG8_BAR; PG8_WAIT_L(0); PG8_MMA(0, 0, At, B0); PG8_BAR; PG8_SCHED;
            PG8_LDB(B1, 1, 1); PG8_STAGE(PG8_SB(1, 0), b3, voffB);
            PG8_BAR; PG8_WAIT_L(0); PG8_MMA(0, 1, At, B1); PG8_BAR;
            PG8_LDA(At, 1, 1); PG8_STAGE(PG8_SA(1, 0), a3, voffA);
            PG8_BAR; PG8_WAIT_L(0); PG8_MMA(1, 0, At, B0); PG8_BAR; PG8_SCHED;
            PG8_STAGE(PG8_SB(1, 1), b3 + hstepB, voffB);
            PG8_WAIT_V(6); PG8_BAR; PG8_MMA(1, 1, At, B1); PG8_BAR;
            }
        }
        if constexpr (ALIGN_EPI) { if (wr == 0) PG8_BAR; }
        if constexpr (!Epi::AFTER_DRAIN) { E(acc, cur, wr, wc, fr, fq); S.done(cur); }
        if (!has_next) break;
#pragma unroll
        for (int a = 0; a < 2; ++a)
#pragma unroll
            for (int b = 0; b < 2; ++b)
#pragma unroll
                for (int m = 0; m < 4; ++m)
#pragma unroll
                    for (int n = 0; n < 2; ++n) acc[a][b][m][n] = (f32x4){0.f, 0.f, 0.f, 0.f};
        cur = nxt; cA = nA; cB = nB; ++ui;
        if constexpr (ALIGN_EPI) { if (wr == 1) PG8_BAR; }
    }
    PG8_WAIT_V(0);
    if constexpr (!ALIGN_EPI) { if (wr == 0) PG8_BAR; }
    PG8_BAR;
    if constexpr (Epi::AFTER_DRAIN) { E.fused(acc, cur, wr, wc, fr, fq, lds, wid, lane); S.done(cur); }
#undef PG8_SA
#undef PG8_SB
#undef PG8_STAGE
#undef PG8_LDA
#undef PG8_LDB
#undef PG8_MMA
#undef PG8_WAIT_V
#undef PG8_WAIT_L
#undef PG8_BAR
#undef PG8_SCHED
}
}
constexpr int NWAVES = 8;
template <class RowMap>
__device__ __forceinline__ void transpose_item(const float* __restrict__ W, int K, int N, bf16_t* WT, const float* __restrict__ kscale, RowMap rm, LAS float* scr, int item, int lane) {
    const int nblk = (N + 31) / 32, kb = item / nblk, nb = item % nblk, k0 = 64 * kb, n0 = 32 * nb;
    const int nr = n0 + (lane & 31);
    float v[32];
#pragma unroll
    for (int i = 0; i < 32; ++i) { const int kk = 2 * i + (lane >> 5); v[i] = (nr < N) ? W[(size_t)(k0 + kk) * N + nr] : 0.f; }
    if (kscale) {
#pragma unroll
        for (int i = 0; i < 32; ++i) v[i] *= kscale[k0 + 2 * i + (lane >> 5)];
    }
#pragma unroll
    for (int i = 0; i < 32; ++i) scr[(2 * i + (lane >> 5)) * 33 + (lane & 31)] = v[i];
    asm volatile("s_waitcnt lgkmcnt(0)" ::: "memory");
    const int c = lane & 7;
#pragma unroll
    for (int j = 0; j < 4; ++j) { const int nl = (lane >> 3) + 8 * j, n = n0 + nl;
        if (n < N) { const LAS float* s = scr + (8 * c) * 33 + nl;
            u32x4_t o; o.x = pk2(s[0 * 33], s[1 * 33]); o.y = pk2(s[2 * 33], s[3 * 33]); o.z = pk2(s[4 * 33], s[5 * 33]); o.w = pk2(s[6 * 33], s[7 * 33]);
            *(u32x4_t*)(WT + (size_t)rm(n) * K + k0 + 8 * c) = o; } }
    asm volatile("s_waitcnt lgkmcnt(0)" ::: "memory");
}
struct RmIdent { __device__ __forceinline__ int operator()(int n) const { return n; } };
struct RmWin {
    __device__ __forceinline__ int operator()(int c) const {
        const int nc = c < 2560 ? c : (c < 2608 ? 4608 + (c - 2560) : 2560 + (c - 2608));
        const int tile = nc >> 8, L = nc & 255, wc = L >> 6, bj = (L >> 5) & 1, j = L & 31;
        return tile * 256 + 128 * bj + 32 * wc + j;
    }
};
struct RmWup {
    __device__ __forceinline__ int operator()(int c) const { const int up = c >= D_FF, cc = up ? c - D_FF : c; return (cc >> 7) * 256 + up * 128 + (cc & 127); }
};

struct Ptrs {
    const float* in[18]; float* out; unsigned char* ws;
};

__device__ __forceinline__ void p0_prologue(const Ptrs& P, LAS unsigned char* lds, int vcu, int G, const int wave) {
    const int lane = fresh_lane();
    LAS float* scr = (LAS float*)(lds + wave * 16384);
    const int gw = vcu * NWAVES + wave, NGW = G * NWAVES;
    unsigned char* ws = P.ws;
    bf16_t* WinT = (bf16_t*)(ws + WS_WIN); bf16_t* WoutT = (bf16_t*)(ws + WS_WOUT); bf16_t* WupT = (bf16_t*)(ws + WS_WUP); bf16_t* WdownT = (bf16_t*)(ws + WS_WDOWN); bf16_t* W1cT = (bf16_t*)(ws + WS_W1C);
    const float* x = P.in[0]; const float* attn_norm_w = P.in[1]; const float* w_in = P.in[2]; const float* cmp_pos = P.in[5]; const float* cmp_w1 = P.in[6];
    const float* w_out = P.in[12]; const float* ffn_norm_w = P.in[13]; const float* w_up = P.in[14]; const float* w_down = P.in[17];
    constexpr int I_IN = 32 * 146, I_W1 = 32 * 8, I_W2 = 4 * 2;
    constexpr int NITEMS = I_IN + 2 * I_W1 + 2 * I_W2;
    (void)w_out; (void)w_up; (void)w_down; (void)ffn_norm_w; (void)WoutT; (void)WupT; (void)WdownT;
    for (int it = gw; it < NITEMS; it += NGW) {
        int r = it;
        if (r < I_IN) { transpose_item(w_in, 2048, IN_COLS, WinT, nullptr, RmWin(), scr, r, lane); continue; } r -= I_IN;
        if (r < I_W1) { transpose_item(cmp_w1, 2048, 256, W1cT, nullptr, RmIdent(), scr, r, lane); continue; } r -= I_W1;
        if (r < I_W1) { transpose_item(cmp_w1 + (size_t)2048 * 256, 2048, 256, W1cT + (size_t)256 * 2048, nullptr, RmIdent(), scr, r, lane); continue; } r -= I_W1;
        { const int kv = r >= I_W2 ? 1 : 0; transpose_item(P.in[7] + (size_t)kv * 256 * 64, 256, 64, (bf16_t*)(ws + WS_SMALL + SM_W2T) + (size_t)kv * 64 * 256, nullptr, RmIdent(), scr, r - kv * I_W2, lane); }
    }
    for (int i = gw * 64 + lane; i < 8 * 16384; i += NGW * 64) { const int t = (i >> 7) & 127, sx = i & 127; ((bf16_t*)(ws + WS_SMALL + SM_SWB))[i] = (bf16_t)(sx <= t ? f2bf(P.in[10][i]) : 0u); }
    for (int p = gw; p < 256; p += NGW) {
        const int L = 64 * ((p >> 5) & 3) + 32 * (p >> 7) + (p & 31);
        if (L >= 48) { u32x4_t z = {0u, 0u, 0u, 0u}; u32x4_t* d = (u32x4_t*)(WinT + (size_t)(18 * 256 + p) * 2048);
#pragma unroll
            for (int j = 0; j < 4; ++j) d[lane + 64 * j] = z; }
    }
    bf16_t* XN = (bf16_t*)(ws + WS_XN);
    for (int m = gw; m < MTOK; m += 2 * NGW) {
        const int m2 = m + NGW;
        const f32x4_t* xr = (const f32x4_t*)(x + (size_t)m * D_MODEL) + lane;
        const f32x4_t* xr2 = (const f32x4_t*)(x + (size_t)(m2 < MTOK ? m2 : m) * D_MODEL) + lane;
        f32x4_t v[8], v2[8]; float s = 0.f, s2 = 0.f;
#pragma unroll
        for (int j = 0; j < 8; ++j) { v[j] = xr[64 * j]; v2[j] = xr2[64 * j]; }
#pragma unroll
        for (int j = 0; j < 8; ++j) { s += (v[j][0] * v[j][0] + v[j][1] * v[j][1]) + (v[j][2] * v[j][2] + v[j][3] * v[j][3]); s2 += (v2[j][0] * v2[j][0] + v2[j][1] * v2[j][1]) + (v2[j][2] * v2[j][2] + v2[j][3] * v2[j][3]); }
        const float r = __builtin_amdgcn_rsqf(wave_sum(s) * (1.0f / D_MODEL) + 1e-6f), r2 = __builtin_amdgcn_rsqf(wave_sum(s2) * (1.0f / D_MODEL) + 1e-6f);
        u32x2_t* o8 = (u32x2_t*)(XN + (size_t)m * D_MODEL) + lane; u32x2_t* o82 = (u32x2_t*)(XN + (size_t)m2 * D_MODEL) + lane;
#pragma unroll
        for (int j = 0; j < 8; ++j) { const f32x4_t w = ((const f32x4_t*)attn_norm_w)[lane + 64 * j];
            u32x2_t o; o.x = pk2(v[j][0] * r * w[0], v[j][1] * r * w[1]); o.y = pk2(v[j][2] * r * w[2], v[j][3] * r * w[3]); o8[64 * j] = o;
            if (m2 < MTOK) { u32x2_t q; q.x = pk2(v2[j][0] * r2 * w[0], v2[j][1] * r2 * w[1]); q.y = pk2(v2[j][2] * r2 * w[2], v2[j][3] * r2 * w[3]); o82[64 * j] = q; } }
    }
    float* BIASP = (float*)(ws + WS_SMALL + SM_BIASP);
    for (int it = gw; it < 64; it += NGW) {
        const int kv = it >> 5, kc = it & 31; f32x4_t a = {0.f, 0.f, 0.f, 0.f};
        const float* pp = cmp_pos + kv * 2048 + kc * 64; const float* w1 = cmp_w1 + ((size_t)kv * 2048 + kc * 64) * 256;
        for (int k = 0; k < 64; ++k) { const f32x4_t w = ((const f32x4_t*)(w1 + (size_t)k * 256))[lane]; a += w * pp[k]; }
        ((f32x4_t*)(BIASP + (size_t)it * 256))[lane] = a;
    }
}

__device__ __forceinline__ void bias1_stage(unsigned char* ws, int idx  ) {
    const float* BIASP = (const float*)(ws + WS_SMALL + SM_BIASP); float* BIAS1 = (float*)(ws + WS_SMALL + SM_BIAS1);
    const int kv = idx >> 8, j = idx & 255; float s = 0.f;
    for (int kc = 0; kc < 32; ++kc) s += BIASP[(size_t)(kv * 32 + kc) * 256 + j];
    BIAS1[idx] = s;
}
__device__ __forceinline__ void cmp2_row(const Ptrs& P, int R, int lane) {
    unsigned char* ws = P.ws; const bf16_t* HC = (const bf16_t*)(ws + WS_HC);
    const int kv = R >> 12, rr = R & 4095, n = rr & 255;
    bf16_t* dst = (bf16_t*)(ws + (kv ? WS_VC : WS_KC)) + (size_t)rr * 64 + lane;
    if (n == 255) { *dst = 0; return; }
    const float* w2 = P.in[7] + (size_t)kv * 256 * 64;
    const u32x2_t hr = *(const u32x2_t*)(HC + (size_t)R * 256 + 4 * lane);
    float h[4] = {__uint_as_float(hr.x << 16), __uint_as_float(hr.x & 0xffff0000u), __uint_as_float(hr.y << 16), __uint_as_float(hr.y & 0xffff0000u)};
    float o = 0.f;
    for (int jj = 0; jj < 64; ++jj) {
#pragma unroll
        for (int i = 0; i < 4; ++i) o += __shfl(h[i], jj) * w2[(size_t)(4 * jj + i) * 64 + lane];
    }
    if (kv == 0) { const float ss = wave_sum(o * o); o *= __builtin_amdgcn_rsqf(ss * (1.0f / 64.0f) + 1e-6f) * P.in[4][lane]; }
    *dst = (bf16_t)f2bf(o);
}

__device__ __forceinline__ void gmlp_unit_v1(const Ptrs& P, LAS unsigned char* lds, int unit, const int wave_s) {
    unsigned char* ws = P.ws; const int tid = fresh_tid(wave_s);
    const int g = unit & 7, chunk = (unit >> 3) & 31, b = unit >> 8; const int m0 = b * SEQ + chunk * 128;
    LAS float* vn = (LAS float*)lds; LAS float* Wl = (LAS float*)(lds + 65536); LAS float* st = (LAS float*)(lds + 131072);
    const bf16_t* GV = (const bf16_t*)(ws + WS_GV); const bf16_t* U = (const bf16_t*)(ws + WS_U); const float* VSTAT = (const float*)(ws + WS_VSTAT);
    bf16_t* AB = (bf16_t*)(ws + WS_AB);
    const float* ln_w = P.in[8]; const float* ln_b = P.in[9]; const float* sw = P.in[10]; const float* sb = P.in[11];
    if (tid < 128) { const float* p = VSTAT + (size_t)(m0 + tid) * 32; float s1 = 0.f, s2 = 0.f;
#pragma unroll
        for (int i = 0; i < 16; ++i) { s1 += p[2 * i]; s2 += p[2 * i + 1]; }
        const float mean = s1 * (1.0f / 1024.0f); float var = s2 * (1.0f / 1024.0f) - mean * mean; var = var < 0.f ? 0.f : var;
        st[2 * tid] = mean; st[2 * tid + 1] = __builtin_amdgcn_rsqf(var + 1e-5f); }
    for (int i = 0; i < 32; ++i) { const int idx = tid + 512 * i, t = idx >> 7, s = idx & 127; Wl[idx] = (s <= t) ? sw[(size_t)g * 16384 + idx] : 0.f; }
    __syncthreads();
#pragma unroll
    for (int i = 0; i < 4; ++i) { const int idx = tid + 512 * i, s = idx >> 4, c8 = idx & 15;
        const u32x4_t raw = *(const u32x4_t*)(GV + (size_t)(m0 + s) * 1024 + g * 128 + 8 * c8); float f[8]; unpack8(raw, f);
        const float mean = st[2 * s], rstd = st[2 * s + 1];
#pragma unroll
        for (int e = 0; e < 8; ++e) { const int c = g * 128 + 8 * c8 + e; vn[s * 128 + 8 * c8 + e] = (f[e] - mean) * rstd * ln_w[c] + ln_b[c]; } }
    __syncthreads();
    const int c = tid & 127, tq = tid >> 7;
    for (int i = 0; i < 8; ++i) {
        const int t0 = 4 * (tq + 4 * i); float a0 = 0.f, a1 = 0.f, a2 = 0.f, a3 = 0.f;
        for (int s4 = 0; s4 <= t0; s4 += 4) {
            const f32x4_t w0 = *(const LAS f32x4_t*)(Wl + (t0 + 0) * 128 + s4), w1 = *(const LAS f32x4_t*)(Wl + (t0 + 1) * 128 + s4), w2 = *(const LAS f32x4_t*)(Wl + (t0 + 2) * 128 + s4), w3 = *(const LAS f32x4_t*)(Wl + (t0 + 3) * 128 + s4);
#pragma unroll
            for (int k = 0; k < 4; ++k) { const float v = vn[(s4 + k) * 128 + c]; a0 += w0[k] * v; a1 += w1[k] * v; a2 += w2[k] * v; a3 += w3[k] * v; }
        }
        const float av[4] = {a0, a1, a2, a3};
#pragma unroll
        for (int k = 0; k < 4; ++k) { const int t = t0 + k; const size_t row = (size_t)(m0 + t);
            const float uu = bf2f(U[row * 1024 + g * 128 + c]); AB[row * 2048 + 1024 + g * 128 + c] = (bf16_t)f2bf(uu * (av[k] + sb[g * 128 + t])); }
    }
    __syncthreads();
}

__device__ __forceinline__ void conv_item(const Ptrs& P, int b, int idx) {
    const int t = idx / 704, c8 = idx % 704, c0 = 8 * c8, j = c0 >> 7, i0 = c0 & 127;
    const bf16_t* HID = (const bf16_t*)(P.ws + WS_HID); const float* cw = P.in[15]; const float* cb = P.in[16];
    float gt[8], up[8];
#pragma unroll
    for (int e = 0; e < 8; ++e) { gt[e] = cb[c0 + e]; up[e] = cb[D_FF + c0 + e]; }
#pragma unroll
    for (int k = 0; k < 3; ++k) { const int tt = t - 2 + k; if (tt < 0) continue;
        float hg[8], hu[8]; unpack8(*(const u32x4_t*)(HID + (size_t)tt * N_UP + 256 * j + i0), hg); unpack8(*(const u32x4_t*)(HID + (size_t)tt * N_UP + 256 * j + 128 + i0), hu);
#pragma unroll
        for (int e = 0; e < 8; ++e) { gt[e] += cw[(size_t)k * N_UP + c0 + e] * hg[e]; up[e] += cw[(size_t)k * N_UP + D_FF + c0 + e] * hu[e]; } }
    float r[8];
#pragma unroll
    for (int e = 0; e < 8; ++e) r[e] = gt[e] * sigmoidf_(gt[e]) * up[e];
    u32x4_t o; o.x = pk2(r[0], r[1]); o.y = pk2(r[2], r[3]); o.z = pk2(r[4], r[5]); o.w = pk2(r[6], r[7]);
    *(u32x4_t*)((bf16_t*)(P.ws + WS_G) + ((size_t)b * SEQ + t) * D_FF + c0) = o;
}

constexpr int LW_CH = 32;
constexpr int LW_OUT = 32 * 64, LW_UP = 32 * 352, LW_DOWN = 88 * 64, LW_C_OUT = LW_OUT / LW_CH, LW_C_UP = LW_UP / LW_CH, LW_C_DOWN = LW_DOWN / LW_CH, LW_CHUNKS = LW_C_OUT + LW_C_UP + LW_C_DOWN;
static_assert(LW_OUT % LW_CH == 0 && LW_UP % LW_CH == 0 && LW_DOWN % LW_CH == 0, "late weight items per chunk");
template <class RowMap>
__device__ __forceinline__ void lw_load(float (&v)[32], const float* __restrict__ W, int N, int item, int lane) {
    const int nblk = N / 32, kb = item / nblk, nb = item % nblk;
    const float* p = W + (size_t)(64 * kb + (lane >> 5)) * N + 32 * nb + (lane & 31);
#pragma unroll
    for (int i = 0; i < 32; ++i) v[i] = p[(size_t)(2 * i) * N];
}
template <class RowMap>
__device__ __forceinline__ void lw_store(const float (&v)[32], int K, int N, bf16_t* WT, const float* __restrict__ kscale, RowMap rm, LAS float* scr, int item, int lane) {
    const int nblk = N / 32, kb = item / nblk, nb = item % nblk, k0 = 64 * kb, n0 = 32 * nb;
    const int c = lane & 7;
    f32x4_t sc0 = {1.f, 1.f, 1.f, 1.f}, sc1 = sc0;
    if (kscale) { sc0 = *(const f32x4_t*)(kscale + k0 + 8 * c); sc1 = *(const f32x4_t*)(kscale + k0 + 8 * c + 4); }
#pragma unroll
    for (int i = 0; i < 32; ++i) scr[(2 * i + (lane >> 5)) * 33 + (lane & 31)] = v[i];
    asm volatile("s_waitcnt lgkmcnt(0)" ::: "memory");
#pragma unroll
    for (int j = 0; j < 4; ++j) { const int nl = (lane >> 3) + 8 * j; const LAS float* s = scr + (8 * c) * 33 + nl;
        u32x4_t o; o.x = pk2(s[0 * 33] * sc0[0], s[1 * 33] * sc0[1]); o.y = pk2(s[2 * 33] * sc0[2], s[3 * 33] * sc0[3]); o.z = pk2(s[4 * 33] * sc1[0], s[5 * 33] * sc1[1]); o.w = pk2(s[6 * 33] * sc1[2], s[7 * 33] * sc1[3]);
        *(u32x4_t*)(WT + (size_t)rm(n0 + nl) * K + k0 + 8 * c) = o; }
    asm volatile("s_waitcnt lgkmcnt(0)" ::: "memory");
}
template <class RowMap>
__device__ __forceinline__ void lw_run(const float* __restrict__ W, int K, int N, bf16_t* WT, const float* __restrict__ kscale, RowMap rm, LAS float* scr, int item0, int wave, int lane) {
    float va[32], vb[32];
    lw_load<RowMap>(va, W, N, item0 + wave, lane);
    lw_load<RowMap>(vb, W, N, item0 + wave + 8, lane);  lw_store(va, K, N, WT, kscale, rm, scr, item0 + wave, lane);
    lw_load<RowMap>(va, W, N, item0 + wave + 16, lane); lw_store(vb, K, N, WT, kscale, rm, scr, item0 + wave + 8, lane);
    lw_load<RowMap>(vb, W, N, item0 + wave + 24, lane); lw_store(va, K, N, WT, kscale, rm, scr, item0 + wave + 16, lane);
    lw_store(vb, K, N, WT, kscale, rm, scr, item0 + wave + 24, lane);
}
__device__ __forceinline__ void late_weight_chunk(const Ptrs& P, LAS unsigned char* lds, int chunk, const int wave) {
    const int lane = fresh_lane();
    LAS float* scr = (LAS float*)(lds + wave * 16384);
    unsigned char* ws = P.ws;
    if (chunk < LW_C_UP) lw_run(P.in[14], 2048, N_UP, (bf16_t*)(ws + WS_WUP), P.in[13], RmWup(), scr, chunk * LW_CH, wave, lane);
    else if (chunk < LW_C_UP + LW_C_DOWN) lw_run(P.in[17], D_FF, 2048, (bf16_t*)(ws + WS_WDOWN), nullptr, RmIdent(), scr, (chunk - LW_C_UP) * LW_CH, wave, lane);
    else lw_run(P.in[12], 2048, 2048, (bf16_t*)(ws + WS_WOUT), nullptr, RmIdent(), scr, (chunk - LW_C_UP - LW_C_DOWN) * LW_CH, wave, lane);
}

namespace nsa {
using bf16x8 = __attribute__((ext_vector_type(8))) short;
using s16x4 = __attribute__((ext_vector_type(4))) short;
using f32x16 = __attribute__((ext_vector_type(16))) float;
typedef float f32x2_t __attribute__((ext_vector_type(2))); typedef __bf16 bf16x2_t __attribute__((ext_vector_type(2)));
constexpr int L_K = 0, L_V = 16384, L_WSF = 32768, L_OST = 34816, L_IMP = 100352, L_MASK = 116736, L_WU = 117248, L_END = 117312;
constexpr int SLOTB = 8192;
constexpr float THR = 8.0f;
#define NSA_SBAR() __builtin_amdgcn_sched_barrier(0)
__device__ __forceinline__ int crow(int r, int hi) { return (r & 3) + 8 * (r >> 2) + 4 * hi; }
__device__ __forceinline__ void glds16(const void* gbase  , unsigned voff  , unsigned lds_dst) { unsigned keep;
    asm volatile("s_mov_b32 %0, m0\n\ts_mov_b32 m0, %3\n\ts_nop 0\n\tglobal_load_lds_dwordx4 %1, %2\n\ts_mov_b32 m0, %0" : "=&s"(keep) : "v"(voff), "s"(gbase), "s"(lds_dst) : "memory"); }
__device__ __forceinline__ unsigned cvtpk_s(float lo, float hi) { f32x2_t v = {lo, hi}; bf16x2_t b = __builtin_convertvector(v, bf16x2_t); return __builtin_bit_cast(unsigned, b); }
#define NSA_WAIT_BAR() asm volatile("s_waitcnt vmcnt(0) lgkmcnt(0)\n\ts_barrier" ::: "memory")

__device__ __forceinline__ void qkt(f32x16& p0, f32x16& p1, LAS const char* Kslot, const bf16x8 (&qr)[4], int r32, int hi) {
    LAS const char* kb = Kslot + hi * 1024 + r32 * 16;
#pragma unroll
    for (int d0 = 0; d0 < 4; ++d0) {
        const bf16x8 b0 = *(LAS const bf16x8*)(kb + d0 * 2048);
        const bf16x8 b1 = *(LAS const bf16x8*)(kb + d0 * 2048 + 512);
        p0 = __builtin_amdgcn_mfma_f32_32x32x16_bf16(b0, qr[d0], p0, 0, 0, 0); p1 = __builtin_amdgcn_mfma_f32_32x32x16_bf16(b1, qr[d0], p1, 0, 0, 0);
    }
}
struct VFrag { s16x4 lo[2][4], hi[2][4]; };
__device__ __forceinline__ void vload(VFrag& f, int vb) {
#pragma unroll
    for (int d0 = 0; d0 < 2; ++d0)
#pragma unroll
        for (int ks = 0; ks < 4; ++ks) {
            asm volatile("ds_read_b64_tr_b16 %0,%1 offset:%c2" : "=&v"(f.lo[d0][ks]) : "v"(vb), "i"(d0 * 4096 + ks * 1024) : "memory");
            asm volatile("ds_read_b64_tr_b16 %0,%1 offset:%c2" : "=&v"(f.hi[d0][ks]) : "v"(vb), "i"(d0 * 4096 + ks * 1024 + 512) : "memory"); }
}
__device__ __forceinline__ void pvmma(f32x16 (&o)[2], VFrag& f, bf16x8 pa0, bf16x8 pa1, bf16x8 pa2, bf16x8 pa3) {
    asm volatile("s_waitcnt lgkmcnt(0)" : "+v"(f.lo[0][0]), "+v"(f.lo[0][1]), "+v"(f.lo[0][2]), "+v"(f.lo[0][3]), "+v"(f.hi[0][0]), "+v"(f.hi[0][1]), "+v"(f.hi[0][2]), "+v"(f.hi[0][3]) :: "memory");
    asm volatile("" : "+v"(f.lo[1][0]), "+v"(f.lo[1][1]), "+v"(f.lo[1][2]), "+v"(f.lo[1][3]), "+v"(f.hi[1][0]), "+v"(f.hi[1][1]), "+v"(f.hi[1][2]), "+v"(f.hi[1][3]));
    NSA_SBAR();
#pragma unroll
    for (int d0 = 0; d0 < 2; ++d0) {
#define NSA_PK(k) (bf16x8){f.lo[d0][k][0], f.lo[d0][k][1], f.lo[d0][k][2], f.lo[d0][k][3], f.hi[d0][k][0], f.hi[d0][k][1], f.hi[d0][k][2], f.hi[d0][k][3]}
        o[d0] = __builtin_amdgcn_mfma_f32_32x32x16_bf16(pa0, NSA_PK(0), o[d0], 0, 0, 0);
        o[d0] = __builtin_amdgcn_mfma_f32_32x32x16_bf16(pa1, NSA_PK(1), o[d0], 0, 0, 0);
        o[d0] = __builtin_amdgcn_mfma_f32_32x32x16_bf16(pa2, NSA_PK(2), o[d0], 0, 0, 0);
        o[d0] = __builtin_amdgcn_mfma_f32_32x32x16_bf16(pa3, NSA_PK(3), o[d0], 0, 0, 0);
#undef NSA_PK
    }
}
__device__ __forceinline__ void pv(f32x16 (&o)[2], int vb, bf16x8 pa0, bf16x8 pa1, bf16x8 pa2, bf16x8 pa3) { VFrag f; vload(f, vb); pvmma(o, f, pa0, pa1, pa2, pa3); }
__device__ __forceinline__ float rowmax32(const f32x16& p0, const f32x16& p1) {
    float a = __builtin_fmaxf(p0[0], p1[0]);
#pragma unroll
    for (int r = 1; r < 16; ++r) a = __builtin_fmaxf(a, __builtin_fmaxf(p0[r], p1[r]));
    auto rr = __builtin_amdgcn_permlane32_swap(__float_as_uint(a), __float_as_uint(a), false, false);
    return __builtin_fmaxf(__uint_as_float(rr[0]), __uint_as_float(rr[1]));
}
struct State { float m, l; f32x16 o[2]; };
__device__ __forceinline__ void state_init(State& s) { s.m = -1e30f; s.l = 0.f; s.o[0] = f32x16{}; s.o[1] = f32x16{}; }

template <int BMUL, int MASK, bool LOADV>
__device__ __forceinline__ void tile_scores(f32x16& p0, f32x16& p1, LAS const char* Kslot, const bf16x8 (&qr)[4], const f32x16& bk, float c0, float b32, int lim, int r32, int hi, VFrag& vf, int vb) {
#pragma unroll
    for (int r = 0; r < 16; ++r) { const float b = (BMUL == 1) ? bk[r] + c0 : __builtin_fmaf(bk[r], (float)BMUL, c0); p0[r] = b; p1[r] = b + b32; }
    qkt(p0, p1, Kslot, qr, r32, hi);
    if (LOADV) vload(vf, vb);
    const int limh = lim - 4 * hi;
#pragma unroll
    for (int r = 0; r < 16; ++r) {
        const int kk = (r & 3) + 8 * (r >> 2);
        if (MASK == 1) { if (!(kk <= limh)) p0[r] = -INFINITY; if (!(kk + 32 <= limh)) p1[r] = -INFINITY; }
        if (MASK == 2) { if (!(kk > limh)) p0[r] = -INFINITY; if (!(kk + 32 > limh)) p1[r] = -INFINITY; }
        if (MASK == 3) { if (!(kk < limh)) p0[r] = -INFINITY; if (!(kk + 32 < limh)) p1[r] = -INFINITY; }
    }
}
__device__ __forceinline__ float tile_ref(const State& st, float rb0, bool rowlive) { return (st.m < -1e29f && rowlive) ? rb0 : st.m; }
__device__ __forceinline__ void tile_softmax_pv(State& st, f32x16& p0, f32x16& p1, float mref, VFrag& vf, LAS float* wsf, int r32, int hi) {
    float a0 = p0[0], a1 = p1[0];
#pragma unroll
    for (int r = 1; r < 16; ++r) { a0 = __builtin_fmaxf(a0, p0[r]); a1 = __builtin_fmaxf(a1, p1[r]); }
    float mx = __builtin_fmaxf(a0, a1);
    { auto rr = __builtin_amdgcn_permlane32_swap(__float_as_uint(mx), __float_as_uint(mx), false, false); mx = __builtin_fmaxf(__uint_as_float(rr[0]), __uint_as_float(rr[1])); }
    if (__any(mx > THR)) {
        const float dl = __builtin_fmaxf(mx, 0.f), alpha = __builtin_amdgcn_exp2f(-dl);
        mref += dl; st.l *= alpha;
        if (hi == 0) wsf[r32] = alpha;
        asm volatile("s_waitcnt lgkmcnt(0)" ::: "memory");
#pragma unroll
        for (int r = 0; r < 16; ++r) { const float a = wsf[crow(r, hi)]; st.o[0][r] *= a; st.o[1][r] *= a; p0[r] -= dl; p1[r] -= dl; }
    }
    st.m = mref;
    float ls = 0.f;
#pragma unroll
    for (int r = 0; r < 16; ++r) { p0[r] = __builtin_amdgcn_exp2f(p0[r]); p1[r] = __builtin_amdgcn_exp2f(p1[r]); ls += p0[r] + p1[r]; }
    st.l += ls;
    u32x4_t pw0, pw1, pw2, pw3;
    pw0 = (u32x4_t){cvtpk_s(p0[0], p0[1]), cvtpk_s(p0[2], p0[3]), cvtpk_s(p0[4], p0[5]), cvtpk_s(p0[6], p0[7])};
    pw1 = (u32x4_t){cvtpk_s(p0[8], p0[9]), cvtpk_s(p0[10], p0[11]), cvtpk_s(p0[12], p0[13]), cvtpk_s(p0[14], p0[15])};
    pw2 = (u32x4_t){cvtpk_s(p1[0], p1[1]), cvtpk_s(p1[2], p1[3]), cvtpk_s(p1[4], p1[5]), cvtpk_s(p1[6], p1[7])};
    pw3 = (u32x4_t){cvtpk_s(p1[8], p1[9]), cvtpk_s(p1[10], p1[11]), cvtpk_s(p1[12], p1[13]), cvtpk_s(p1[14], p1[15])};
    pvmma(st.o, vf, __builtin_bit_cast(bf16x8, pw0), __builtin_bit_cast(bf16x8, pw1), __builtin_bit_cast(bf16x8, pw2), __builtin_bit_cast(bf16x8, pw3));
}
template <bool FIRST>
__device__ __forceinline__ void fold_branch(LAS float* ostg, State& st, float gate, LAS float* wsf, int r32, int hi) {
    float l = st.l;
    { auto rr = __builtin_amdgcn_permlane32_swap(__float_as_uint(l), __float_as_uint(l), false, false); l = __uint_as_float(rr[0]) + __uint_as_float(rr[1]); }
    const float f = l > 0.f ? gate / l : 0.f;
    asm volatile("s_waitcnt lgkmcnt(0)" ::: "memory");
    if (hi == 0) wsf[r32] = f;
    asm volatile("s_waitcnt lgkmcnt(0)" ::: "memory");
#pragma unroll
    for (int r = 0; r < 16; ++r) { const int orow = crow(r, hi); const float a = wsf[orow];
#pragma unroll
        for (int d0 = 0; d0 < 2; ++d0) { LAS float* p = ostg + orow * 64 + d0 * 32 + r32; if (FIRST) *p = st.o[d0][r] * a; else *p += st.o[d0][r] * a; } }
    asm volatile("s_waitcnt lgkmcnt(0)" ::: "memory");
}

__device__ __forceinline__ int nsa_unit(const Ptrs& P, LAS unsigned char* lds, int bg, int qt, const int wave_s, unsigned* qctr, int qbase) {
    unsigned char* ws = P.ws;
    const int lane = fresh_lane(), r32 = lane & 31, hi = lane >> 5; const int wid = wave_s;
    const int b = bg >> 2, g = bg & 3, t0 = 64 * qt;
    const int tl = 8 * wid + (r32 >> 2), hq = r32 & 3;
    const size_t m0 = (size_t)b * SEQ + t0;
    const bf16_t* Q = (const bf16_t*)(ws + WS_Q); const bf16_t* KV6 = (const bf16_t*)(ws + WS_KV6);
    const bf16_t* KSb = KV6 + 2 * KVSZ + (size_t)bg * SEQ * 64; const bf16_t* VSb = KV6 + 3 * KVSZ + (size_t)bg * SEQ * 64;
    const bf16_t* KWb = KV6 + 4 * KVSZ + (size_t)bg * SEQ * 64; const bf16_t* VWb = KV6 + 5 * KVSZ + (size_t)bg * SEQ * 64;
    const bf16_t* KCb = (const bf16_t*)(ws + WS_KC) + (size_t)bg * 256 * 64; const bf16_t* VCb = (const bf16_t*)(ws + WS_VC) + (size_t)bg * 256 * 64;
    const float* GATES = (const float*)(ws + WS_GATES); bf16_t* AB = (bf16_t*)(ws + WS_AB);
    const unsigned lds0 = (unsigned)(uintptr_t)lds;
    LAS float* wsf = (LAS float*)(lds + L_WSF) + wid * 64;
    LAS float* IMP = (LAS float*)(lds + L_IMP);
    LAS unsigned* MASK = (LAS unsigned*)(lds + L_MASK); LAS unsigned* WU = (LAS unsigned*)(lds + L_WU);
    const int koff = lane * 64 + wid * 8, voff = (16 * (wid & 3) + (lane >> 2)) * 64 + (wid >> 2) * 32 + (lane & 3) * 8;
    const unsigned kdst = lds0 + L_K + wid * 1024, vdst = lds0 + L_V + wid * 1024;
#define NSA_DMA_K(base, tile, slot) glds16((base) + (size_t)(tile) * 4096, (unsigned)koff * 2u, (unsigned)__builtin_amdgcn_readfirstlane(kdst + (slot) * SLOTB))
#define NSA_DMA_V(base, tile, slot) glds16((base) + (size_t)(tile) * 4096, (unsigned)voff * 2u, (unsigned)__builtin_amdgcn_readfirstlane(vdst + (slot) * SLOTB))
    const int vb0 = (int)(lds0 + L_V) + ((lane >> 4) & 1) * 32 + (lane & 3) * 8 + (4 * hi + ((lane & 15) >> 2)) * 64;
    LAS const char* Kbase = (LAS const char*)(lds + L_K);
    bf16x8 qr[4];
    { const bf16_t* qp = Q + (m0 + tl) * 1024 + (4 * g + hq) * 64 + hi * 8;
#pragma unroll
      for (int d0 = 0; d0 < 4; ++d0) qr[d0] = *(const bf16x8*)(qp + d0 * 16); }
    const float sl2 = __builtin_amdgcn_exp2f(-0.5f * (float)(4 * g + hq + 1)) * LOG2E;
    f32x16 bk;
#pragma unroll
    for (int r = 0; r < 16; ++r) bk[r] = sl2 * (float)((r & 3) + 8 * (r >> 2));
    const float b32t = 32.0f * sl2, b32c = 512.0f * sl2, hoff_t = 4.0f * (float)hi * sl2, hoff_c = 64.0f * (float)hi * sl2;
    float gate[3];
    { const float* gp = GATES + (m0 + tl) * 48 + (4 * g + hq) * 3; gate[0] = gp[0]; gate[1] = gp[1]; gate[2] = gp[2]; }
    LAS float* ostg = (LAS float*)(lds + L_OST) + wid * 2048;
    State st;
    f32x16 p0, p1;
    int nxt_ticket = 0;

    int tc = 0;
    VFrag vf;
    const int nvmax = (t0 + 63 >= 31) ? ((t0 + 63 - 31) >> 4) + 1 : 0;
    const int nct = (nvmax + 63) >> 6;
    const int tq = t0 + tl, nv = tq >= 31 ? ((tq - 31) >> 4) + 1 : 0;
    {
        state_init(st);
        const int j0 = qt >= 8 ? qt - 8 : 0, nt = qt - j0 + 1;
        NSA_DMA_K(KWb, qt, 0); NSA_DMA_V(VWb, qt, 0); NSA_WAIT_BAR();
        for (int i = 0; i < nt; ++i) {
            const int j = qt - i, slot = (tc + i) & 1;
            if (i + 1 < nt) { NSA_DMA_K(KWb, j - 1, slot ^ 1); NSA_DMA_V(VWb, j - 1, slot ^ 1); }
            else { NSA_DMA_K(KCb, nct - 1, slot ^ 1); NSA_DMA_V(VCb, nct - 1, slot ^ 1); }
            const float rb0 = sl2 * (float)(64 * j - t0), mref = tile_ref(st, rb0, true), c0 = rb0 + hoff_t - mref;
            if (j == qt) tile_scores<1, 1, true>(p0, p1, Kbase + slot * SLOTB, qr, bk, c0, b32t, tl, r32, hi, vf, vb0 + slot * SLOTB);
            else if (j == qt - 8) tile_scores<1, 2, true>(p0, p1, Kbase + slot * SLOTB, qr, bk, c0, b32t, tl, r32, hi, vf, vb0 + slot * SLOTB);
            else tile_scores<1, 0, true>(p0, p1, Kbase + slot * SLOTB, qr, bk, c0, b32t, 0, r32, hi, vf, vb0 + slot * SLOTB);
            tile_softmax_pv(st, p0, p1, mref, vf, wsf, r32, hi);
            NSA_WAIT_BAR();
        }
        tc += nt;
        fold_branch<true>(ostg, st, gate[2], wsf, r32, hi);
    }
    {
        state_init(st);
        for (int ci = 0; ci < nct; ++ci) {
            const int c = nct - 1 - ci, slot = (tc + ci) & 1;
            if (ci + 1 < nct) { NSA_DMA_K(KCb, c - 1, slot ^ 1); NSA_DMA_V(VCb, c - 1, slot ^ 1); }
            else if (qt >= 16) { NSA_DMA_K(KCb, 0, slot ^ 1); }
            else { NSA_DMA_K(KSb, qt, slot ^ 1); NSA_DMA_V(VSb, qt, slot ^ 1); }
            const float rb0 = sl2 * ((float)(1024 * c - t0) + 15.5f), mref = tile_ref(st, rb0, true), c0 = rb0 + hoff_c - mref;
            tile_scores<16, 3, true>(p0, p1, Kbase + slot * SLOTB, qr, bk, c0, b32c, nv - 64 * c, r32, hi, vf, vb0 + slot * SLOTB);
            tile_softmax_pv(st, p0, p1, mref, vf, wsf, r32, hi);
            NSA_WAIT_BAR();
        }
        tc += nct;
    }
    const float mc_fin = st.m; float lc = st.l;
    fold_branch<false>(ostg, st, gate[0], wsf, r32, hi);
    if (qt >= 16) {
        { auto rr = __builtin_amdgcn_permlane32_swap(__float_as_uint(lc), __float_as_uint(lc), false, false); lc = __uint_as_float(rr[0]) + __uint_as_float(rr[1]); }
        const float invl = lc > 0.f ? 1.0f / lc : 0.f;
        float carry = 0.f;
        for (int c = 0; c < nct; ++c) {
            const int slot = (tc + c) & 1;
            if (c + 1 < nct) { NSA_DMA_K(KCb, c + 1, slot ^ 1); }
            else { NSA_DMA_K(KSb, qt, slot ^ 1); NSA_DMA_V(VSb, qt, slot ^ 1); }
            const float c0 = sl2 * ((float)(1024 * c - t0) + 15.5f) + hoff_c - mc_fin;
            tile_scores<16, 3, false>(p0, p1, Kbase + slot * SLOTB, qr, bk, c0, b32c, nv - 64 * c, r32, hi, vf, 0);
#pragma unroll
            for (int r = 0; r < 16; ++r) { p0[r] = __builtin_amdgcn_exp2f(p0[r]) * invl; p1[r] = __builtin_amdgcn_exp2f(p1[r]) * invl; }
            float imp0[4], imp1[4], pl0[4], pl1[4];
#pragma unroll
            for (int a = 0; a < 4; ++a) {
                imp0[a] = (p0[4 * a] + p0[4 * a + 1]) + (p0[4 * a + 2] + p0[4 * a + 3]); imp1[a] = (p1[4 * a] + p1[4 * a + 1]) + (p1[4 * a + 2] + p1[4 * a + 3]);
                pl0[a] = __shfl_xor(p0[4 * a + 3], 32); pl1[a] = __shfl_xor(p1[4 * a + 3], 32);
            }
            if (hi) {
#pragma unroll
                for (int a = 0; a < 4; ++a) { imp0[a] += pl0[a]; imp1[a] += pl1[a]; }
            } else {
                imp0[0] += carry; imp1[0] += pl0[3];
#pragma unroll
                for (int a = 1; a < 4; ++a) { imp0[a] += pl0[a - 1]; imp1[a] += pl1[a - 1]; }
            }
            carry = pl1[3];
#pragma unroll
            for (int a = 0; a < 4; ++a) {
                imp0[a] += __shfl_xor(imp0[a], 1); imp0[a] += __shfl_xor(imp0[a], 2); imp1[a] += __shfl_xor(imp1[a], 1); imp1[a] += __shfl_xor(imp1[a], 2);
                if (hq == 0) { IMP[tl * 64 + 16 * c + 2 * a + hi] = imp0[a]; IMP[tl * 64 + 16 * c + 8 + 2 * a + hi] = imp1[a]; }
            }
            NSA_WAIT_BAR();
        }
        tc += nct;
    }
    unsigned long long wu = 0ull;
    if (qt < 16) {
        wu = (2ull << qt) - 1ull;
        if (lane < 8) { MASK[2 * (8 * wid + lane)] = (unsigned)wu; MASK[2 * (8 * wid + lane) + 1] = (unsigned)(wu >> 32); }
    } else {
        const int j = lane; const bool valid = j <= qt, forced = (j == 0) || (j == qt) || (j == qt - 1);
        for (int k = 0; k < 8; ++k) {
            const float imp = IMP[(8 * wid + k) * 64 + j];
            const float scv = valid ? (forced ? 1e9f : imp) : -1e9f;
            const unsigned fb = __float_as_uint(scv), key = fb ^ ((fb >> 31) ? 0xffffffffu : 0x80000000u);
            unsigned T = 0u;
#pragma unroll
            for (int bit = 31; bit >= 0; --bit) { const unsigned cand = T | (1u << bit); if (__builtin_popcountll(__ballot(key >= cand)) >= 16) T = cand; }
            const unsigned long long gt = __ballot(key > T), eq = __ballot(key == T);
            const int need = 16 - __builtin_popcountll(gt);
            const int before = (int)__builtin_amdgcn_mbcnt_hi((unsigned)(eq >> 32), __builtin_amdgcn_mbcnt_lo((unsigned)eq, 0u));
            const bool sel = (key > T) || ((key == T) && (before < need));
            const unsigned long long mk = __ballot(sel && (scv > -0.5e9f));
            wu |= mk;
            if (lane == 0) { MASK[2 * (8 * wid + k)] = (unsigned)mk; MASK[2 * (8 * wid + k) + 1] = (unsigned)(mk >> 32); }
        }
    }
    if (lane == 0) { WU[2 * wid] = (unsigned)wu; WU[2 * wid + 1] = (unsigned)(wu >> 32); }
    NSA_WAIT_BAR();
    unsigned long long uni = 0ull;
#pragma unroll
    for (int w = 0; w < 8; ++w) uni |= ((unsigned long long)WU[2 * w]) | (((unsigned long long)WU[2 * w + 1]) << 32);
    uni = ((unsigned long long)__builtin_amdgcn_readfirstlane((unsigned)uni)) | (((unsigned long long)__builtin_amdgcn_readfirstlane((unsigned)(uni >> 32))) << 32);
    const unsigned long long mymask = ((unsigned long long)MASK[2 * tl]) | (((unsigned long long)MASK[2 * tl + 1]) << 32);
    {
        state_init(st);
        unsigned long long rem = uni;
        int j = 63 - __builtin_clzll(rem); rem &= ~(1ull << j);
        for (int i = 0;; ++i) {
            const int slot = (tc + i) & 1; const bool more = rem != 0ull;
            int jn = 0;
            if (more) { jn = 63 - __builtin_clzll(rem); rem &= ~(1ull << jn); NSA_DMA_K(KSb, jn, slot ^ 1); NSA_DMA_V(VSb, jn, slot ^ 1); }
            if ((wu >> j) & 1ull) {
                const bool live = ((mymask >> j) & 1ull) != 0ull;
                const float rb0 = sl2 * (float)(64 * j - t0), mref = tile_ref(st, rb0, live), c0 = live ? rb0 + hoff_t - mref : -INFINITY;
                if (j == qt) tile_scores<1, 1, true>(p0, p1, Kbase + slot * SLOTB, qr, bk, c0, b32t, tl, r32, hi, vf, vb0 + slot * SLOTB);
                else tile_scores<1, 0, true>(p0, p1, Kbase + slot * SLOTB, qr, bk, c0, b32t, 0, r32, hi, vf, vb0 + slot * SLOTB);
                tile_softmax_pv(st, p0, p1, mref, vf, wsf, r32, hi);
            }
            NSA_WAIT_BAR();
            if (!more) break;
            j = jn;
        }
        if (wid == 0 && lane == 0) nxt_ticket = qbase + (int)__hip_atomic_fetch_add(qctr, 1u, __ATOMIC_RELAXED, __HIP_MEMORY_SCOPE_AGENT);
        fold_branch<false>(ostg, st, gate[1], wsf, r32, hi);
    }
    {
#pragma unroll
        for (int i = 0; i < 4; ++i) { const int row = i * 8 + (lane >> 3), ch = lane & 7;
            const f32x4_t v0 = *(LAS const f32x4_t*)(ostg + row * 64 + ch * 8), v1 = *(LAS const f32x4_t*)(ostg + row * 64 + ch * 8 + 4);
            u32x4_t v; v.x = cvtpk_s(v0[0], v0[1]); v.y = cvtpk_s(v0[2], v0[3]); v.z = cvtpk_s(v1[0], v1[1]); v.w = cvtpk_s(v1[2], v1[3]);
            *(u32x4_t*)(AB + (m0 + 8 * wid + (row >> 2)) * 2048 + 256 * g + (row & 3) * 64 + ch * 8) = v; }
    }
    NSA_WAIT_BAR();
#undef NSA_DMA_K
#undef NSA_DMA_V
    return nxt_ticket;
}
constexpr int L_QS = 145416;
__device__ __forceinline__ void nsa_phase(const Ptrs& P, LAS unsigned char* lds, int bid, int G, const int wave_s) {
    unsigned* qctr = (unsigned*)(P.ws + WS_CTL) + 3584;
    LAS int* qs = (LAS int*)(lds + L_QS);
    int k = bid;
    while (k < 1024 + LW_CHUNKS) {
        int nxt;
        if (k < 1024) {
            const int qt = 63 - (k >> 4), g = 3 - ((k >> 2) & 3), b = k & 3;
            nxt = nsa_unit(P, lds, b * 4 + g, qt, wave_s, qctr, G);
        } else {
            nxt = 0;
            if (wave_s == 0 && fresh_lane() == 0) nxt = G + (int)__hip_atomic_fetch_add(qctr, 1u, __ATOMIC_RELAXED, __HIP_MEMORY_SCOPE_AGENT);
            late_weight_chunk(P, lds, k - 1024, wave_s);
        }
        if (wave_s == 0 && fresh_lane() == 0) *qs = nxt;
        NSA_WAIT_BAR();
        k = __builtin_amdgcn_readfirstlane(*qs);
    }
}
}

namespace p2 {
using nsa::bf16x8; using nsa::f32x16; using nsa::s16x4; using nsa::crow; using nsa::glds16; using nsa::cvtpk_s;
#define P2_WAIT_BAR() asm volatile("s_waitcnt vmcnt(0) lgkmcnt(0)\n\ts_barrier" ::: "memory")
constexpr int CB_BUF = 40960;
constexpr int CP_STRIDE = 65;
__device__ __forceinline__ void compress_unit(const Ptrs& P, LAS unsigned char* lds, int u, const int wave_s) {
    unsigned char* ws = P.ws;
    const int lane = fresh_lane(), r32 = lane & 31, hi = lane >> 5, wid = wave_s;
    const int kv = u >> 6, bg = (u >> 2) & 15, n0 = 64 * (u & 3);
    const bf16_t* Ag = (const bf16_t*)(ws + WS_KV6) + (size_t)kv * KVSZ + (size_t)bg * SEQ * 64 + (size_t)n0 * 1024;
    const bf16_t* Bg = (const bf16_t*)(ws + WS_W1C) + (size_t)kv * 256 * 2048;
    const unsigned lds0 = (unsigned)(uintptr_t)lds;
    const unsigned aoff = (unsigned)(lane * 1024 + wid * 8) * 2u, boff = (unsigned)(lane * 2048 + wid * 8) * 2u;
    const unsigned dstw = lds0 + wid * 1024;
#define P2_DMA_TILE(kt, buf) do { const unsigned d_ = (unsigned)__builtin_amdgcn_readfirstlane(dstw + (buf) * CB_BUF); \
        glds16(Ag + (kt) * 64, aoff, d_); \
        _Pragma("unroll") for (int ct_ = 0; ct_ < 4; ++ct_) glds16(Bg + (size_t)ct_ * 64 * 2048 + (kt) * 64, boff, d_ + 8192u * (ct_ + 1)); } while (0)
    const int ct = wid >> 1, half = wid & 1, ncol0 = 64 * ct + 32 * half;
    f32x16 hT[2]; hT[0] = f32x16{}; hT[1] = f32x16{};
    P2_DMA_TILE(0, 0); P2_DMA_TILE(1, 1);
    asm volatile("s_waitcnt vmcnt(5) lgkmcnt(0)\n\ts_barrier" ::: "memory");
    for (int kt = 0; kt < 32; ++kt) {
        const int buf = kt % 3;
        if (kt + 2 < 32) P2_DMA_TILE(kt + 2, (kt + 2) % 3);
        LAS const char* sa = (LAS const char*)(lds + buf * CB_BUF) + hi * 1024 + r32 * 16;
        LAS const char* sb = (LAS const char*)(lds + buf * CB_BUF + 8192 * (ct + 1)) + half * 512 + hi * 1024 + r32 * 16;
#pragma unroll
        for (int d0 = 0; d0 < 4; ++d0) {
            const bf16x8 bf = *(LAS const bf16x8*)(sb + d0 * 2048), a0 = *(LAS const bf16x8*)(sa + d0 * 2048), a1 = *(LAS const bf16x8*)(sa + d0 * 2048 + 512);
            hT[0] = __builtin_amdgcn_mfma_f32_32x32x16_bf16(bf, a0, hT[0], 0, 0, 0);
            hT[1] = __builtin_amdgcn_mfma_f32_32x32x16_bf16(bf, a1, hT[1], 0, 0, 0);
        }
        if (kt + 2 < 32) asm volatile("s_waitcnt vmcnt(5) lgkmcnt(0)\n\ts_barrier" ::: "memory");
        else asm volatile("s_waitcnt vmcnt(0) lgkmcnt(0)\n\ts_barrier" ::: "memory");
    }
    const float* bias1 = (const float*)(ws + WS_SMALL + SM_BIAS1) + kv * 256 + ncol0;
    bf16x8 hb[2][2];
#pragma unroll
    for (int mt = 0; mt < 2; ++mt) {
        float g[16];
#pragma unroll
        for (int r = 0; r < 16; ++r) g[r] = gelu_tanh(hT[mt][r] + bias1[crow(r, hi)]);
#pragma unroll
        for (int s = 0; s < 2; ++s) { u32x4_t w; w.x = cvtpk_s(g[8 * s], g[8 * s + 1]); w.y = cvtpk_s(g[8 * s + 2], g[8 * s + 3]); w.z = cvtpk_s(g[8 * s + 4], g[8 * s + 5]); w.w = cvtpk_s(g[8 * s + 6], g[8 * s + 7]);
            hb[mt][s] = __builtin_bit_cast(bf16x8, w); }
    }
    const bf16_t* w2t = (const bf16_t*)(ws + WS_SMALL + SM_W2T) + (size_t)kv * 64 * 256;
    f32x16 oT[2][2];
#pragma unroll
    for (int dt = 0; dt < 2; ++dt)
#pragma unroll
        for (int mt = 0; mt < 2; ++mt) oT[dt][mt] = f32x16{};
#pragma unroll
    for (int dt = 0; dt < 2; ++dt)
#pragma unroll
        for (int s = 0; s < 2; ++s) {
            const bf16_t* wp = w2t + (size_t)(32 * dt + r32) * 256 + ncol0 + 16 * s + 4 * hi;
            const u32x2_t lo = *(const u32x2_t*)wp, hi2 = *(const u32x2_t*)(wp + 8);
            const u32x4_t wv = {lo.x, lo.y, hi2.x, hi2.y}; const bf16x8 wf = __builtin_bit_cast(bf16x8, wv);
#pragma unroll
            for (int mt = 0; mt < 2; ++mt) oT[dt][mt] = __builtin_amdgcn_mfma_f32_32x32x16_bf16(wf, hb[mt][s], oT[dt][mt], 0, 0, 0);
        }
    LAS float* part = (LAS float*)lds + wid * 64 * CP_STRIDE;
#pragma unroll
    for (int dt = 0; dt < 2; ++dt)
#pragma unroll
        for (int mt = 0; mt < 2; ++mt)
#pragma unroll
            for (int r = 0; r < 16; ++r) part[(32 * mt + r32) * CP_STRIDE + 32 * dt + crow(r, hi)] = oT[dt][mt][r];
    P2_WAIT_BAR();
    {
        const int tid = wid * 64 + lane, m = tid >> 3, dg = tid & 7;
        float o[8];
#pragma unroll
        for (int e = 0; e < 8; ++e) { float s = 0.f;
#pragma unroll
            for (int w = 0; w < 8; ++w) s += ((LAS const float*)lds)[(w * 64 + m) * CP_STRIDE + 8 * dg + e];
            o[e] = s; }
        if (kv == 0) {
            float ss = 0.f;
#pragma unroll
            for (int e = 0; e < 8; ++e) ss += o[e] * o[e];
            ss += __shfl_xor(ss, 1); ss += __shfl_xor(ss, 2); ss += __shfl_xor(ss, 4);
            const float rr = __builtin_amdgcn_rsqf(ss * (1.0f / 64.0f) + 1e-6f);
#pragma unroll
            for (int e = 0; e < 8; ++e) o[e] *= rr * P.in[4][8 * dg + e];
        }
        const int n = n0 + m;
        u32x4_t v = {0u, 0u, 0u, 0u};
        if (n < 255) { v.x = cvtpk_s(o[0], o[1]); v.y = cvtpk_s(o[2], o[3]); v.z = cvtpk_s(o[4], o[5]); v.w = cvtpk_s(o[6], o[7]); }
        *(u32x4_t*)((bf16_t*)(ws + (kv ? WS_VC : WS_KC)) + ((size_t)bg * 256 + n) * 64 + 8 * dg) = v;
    }
    P2_WAIT_BAR();
#undef P2_DMA_TILE
}

constexpr int G_V = 0, G_ST = 32768, G_OST = 33792, G_END = 33792 + 65536;
struct GmlpIn { u32x4_t raw[4]; u32x4_t uraw[4]; float sbv[4]; };
__device__ __forceinline__ void gmlp_load(GmlpIn& in, const Ptrs& P, int unit, int tid, int lane, int r32, int hi, int wid) {
    unsigned char* ws = P.ws;
    const int g = unit & 7, chunk = (unit >> 3) & 31, b = unit >> 8; const int m0 = b * SEQ + chunk * 128;
    const bf16_t* GV = (const bf16_t*)(ws + WS_GV); const bf16_t* U = (const bf16_t*)(ws + WS_U);
    const int tb = wid >> 1, ch = wid & 1; (void)r32; (void)hi;
#pragma unroll
    for (int i = 0; i < 4; ++i) { const int idx = tid + 512 * i, s = idx >> 4, c8 = idx & 15; in.raw[i] = *(const u32x4_t*)(GV + (size_t)(m0 + s) * 1024 + g * 128 + 8 * c8); }
#pragma unroll
    for (int i = 0; i < 4; ++i) { const int row = i * 8 + (lane >> 3), t = 32 * tb + row; in.uraw[i] = *(const u32x4_t*)(U + (size_t)(m0 + t) * 1024 + g * 128 + 64 * ch + 8 * (lane & 7)); in.sbv[i] = P.in[11][g * 128 + t]; }
}
__device__ __forceinline__ void gmlp_compute(const GmlpIn& in, const f32x4_t (&sv)[8], const bf16x8 (&pa)[2][4], const f32x4_t w0, const f32x4_t w1, const f32x4_t b0, const f32x4_t b1, const Ptrs& P, LAS unsigned char* lds, int unit, int tid, int lane, int r32, int hi, int wid) {
    unsigned char* ws = P.ws;
    const int g = unit & 7, chunk = (unit >> 3) & 31, b = unit >> 8; const int m0 = b * SEQ + chunk * 128;
    bf16_t* AB = (bf16_t*)(ws + WS_AB);
    LAS float* st = (LAS float*)(lds + G_ST);
    const int tb = wid >> 1, ch = wid & 1;
    if (tid < 128) { float s1 = 0.f, s2 = 0.f;
#pragma unroll
        for (int i = 0; i < 8; ++i) { s1 += sv[i][0] + sv[i][2]; s2 += sv[i][1] + sv[i][3]; }
        const float mean = s1 * (1.0f / 1024.0f); float var = s2 * (1.0f / 1024.0f) - mean * mean; var = var < 0.f ? 0.f : var;
        st[2 * tid] = mean; st[2 * tid + 1] = __builtin_amdgcn_rsqf(var + 1e-5f); }
    asm volatile("s_waitcnt lgkmcnt(0)\n\ts_barrier" ::: "memory");
#pragma unroll
    for (int i = 0; i < 4; ++i) { const int idx = tid + 512 * i, s = idx >> 4, c8 = idx & 15;
        float f[8]; unpack8(in.raw[i], f);
        const float mean = st[2 * s], rstd = st[2 * s + 1];
        float y[8];
#pragma unroll
        for (int e = 0; e < 4; ++e) { y[e] = (f[e] - mean) * rstd * w0[e] + b0[e]; y[4 + e] = (f[4 + e] - mean) * rstd * w1[e] + b1[e]; }
        u32x4_t o; o.x = cvtpk_s(y[0], y[1]); o.y = cvtpk_s(y[2], y[3]); o.z = cvtpk_s(y[4], y[5]); o.w = cvtpk_s(y[6], y[7]);
        const int st_ = s >> 6, sk = s & 63, chh = c8 >> 3, x = c8 & 7;
        *(LAS u32x4_t*)(lds + G_V + (st_ * 2 + chh) * 8192 + (x >> 2) * 4096 + (sk >> 4) * 1024 + (sk & 15) * 64 + (x & 3) * 16) = o; }
    asm volatile("s_waitcnt lgkmcnt(0)\n\ts_barrier" ::: "memory");
    f32x16 o[2]; o[0] = f32x16{}; o[1] = f32x16{};
    const int vb0 = (int)((unsigned)(uintptr_t)lds + G_V) + ((lane >> 4) & 1) * 32 + (lane & 3) * 8 + (4 * hi + ((lane & 15) >> 2)) * 64;
    nsa::pv(o, vb0 + ch * 8192, pa[0][0], pa[0][1], pa[0][2], pa[0][3]);
    if (tb >= 2) nsa::pv(o, vb0 + (2 + ch) * 8192, pa[1][0], pa[1][1], pa[1][2], pa[1][3]);
    LAS float* ostg = (LAS float*)(lds + G_OST) + wid * 2048;
#pragma unroll
    for (int r = 0; r < 16; ++r) { const int orow = crow(r, hi);
#pragma unroll
        for (int d0 = 0; d0 < 2; ++d0) ostg[orow * 64 + d0 * 32 + r32] = o[d0][r]; }
    asm volatile("s_waitcnt lgkmcnt(0)" ::: "memory");
#pragma unroll
    for (int i = 0; i < 4; ++i) { const int row = i * 8 + (lane >> 3), c8 = lane & 7, t = 32 * tb + row;
        const f32x4_t v0 = *(LAS const f32x4_t*)(ostg + row * 64 + c8 * 8), v1 = *(LAS const f32x4_t*)(ostg + row * 64 + c8 * 8 + 4);
        const size_t grow = (size_t)(m0 + t); const int col = g * 128 + 64 * ch + 8 * c8;
        float uf[8]; unpack8(in.uraw[i], uf);
        const float sb_ = in.sbv[i];
        u32x4_t w; w.x = cvtpk_s(uf[0] * (v0[0] + sb_), uf[1] * (v0[1] + sb_)); w.y = cvtpk_s(uf[2] * (v0[2] + sb_), uf[3] * (v0[3] + sb_));
        w.z = cvtpk_s(uf[4] * (v1[0] + sb_), uf[5] * (v1[1] + sb_)); w.w = cvtpk_s(uf[6] * (v1[2] + sb_), uf[7] * (v1[3] + sb_));
        *(u32x4_t*)(AB + grow * 2048 + 1024 + col) = w; }
    asm volatile("s_waitcnt lgkmcnt(0)\n\ts_barrier" ::: "memory");
}
__device__ __forceinline__ void gmlp_run(const Ptrs& P, LAS unsigned char* lds, int u0, int stride, int nunits, const int wave_s) {
    const int lane = fresh_lane(), r32 = lane & 31, hi = lane >> 5, wid = wave_s, tid = wid * 64 + lane;
    GmlpIn A, B;
    int u = u0;
    bf16x8 pa[2][4];
    { const bf16_t* SWB = (const bf16_t*)(P.ws + WS_SMALL + SM_SWB) + (size_t)(u0 & 7) * 16384; const int tb = wid >> 1;
#pragma unroll
      for (int st_ = 0; st_ < 2; ++st_)
#pragma unroll
        for (int ks = 0; ks < 4; ++ks) {
            const bf16_t* wp = SWB + (size_t)(32 * tb + r32) * 128 + 64 * st_ + 16 * ks + 4 * hi;
            const u32x2_t lo = *(const u32x2_t*)wp, hi2 = *(const u32x2_t*)(wp + 8);
            const u32x4_t wv = {lo.x, lo.y, hi2.x, hi2.y}; pa[st_][ks] = __builtin_bit_cast(bf16x8, wv); } }
    const int c8v = tid & 15, g0 = u0 & 7;
    const f32x4_t w0 = *(const f32x4_t*)(P.in[8] + g0 * 128 + 8 * c8v), w1 = *(const f32x4_t*)(P.in[8] + g0 * 128 + 8 * c8v + 4), b0 = *(const f32x4_t*)(P.in[9] + g0 * 128 + 8 * c8v), b1 = *(const f32x4_t*)(P.in[9] + g0 * 128 + 8 * c8v + 4);
    const float* VSTAT = (const float*)(P.ws + WS_VSTAT);
#define GMLP_STATS(sv_, unit_) do { const int m0_ = ((unit_) >> 8) * SEQ + (((unit_) >> 3) & 31) * 128; const f32x4_t* p_ = (const f32x4_t*)(VSTAT + (size_t)(m0_ + (tid & 127)) * 32); \
        _Pragma("unroll") for (int i_ = 0; i_ < 8; ++i_) sv_[i_] = p_[i_]; } while (0)
    f32x4_t sv[8];
    if (u < nunits) gmlp_load(A, P, u, tid, lane, r32, hi, wid);
    while (u < nunits) {
        GMLP_STATS(sv, u);
        if (u + stride < nunits) gmlp_load(B, P, u + stride, tid, lane, r32, hi, wid);
        gmlp_compute(A, sv, pa, w0, w1, b0, b1, P, lds, u, tid, lane, r32, hi, wid);
        u += stride; if (u >= nunits) break;
        GMLP_STATS(sv, u);
        if (u + stride < nunits) gmlp_load(A, P, u + stride, tid, lane, r32, hi, wid);
        gmlp_compute(B, sv, pa, w0, w1, b0, b1, P, lds, u, tid, lane, r32, hi, wid);
        u += stride;
    }
#undef GMLP_STATS
    asm volatile("s_waitcnt vmcnt(0) lgkmcnt(0)\n\ts_barrier" ::: "memory");
}
#undef P2_WAIT_BAR
}

#define XB_TMO      128
#define XB_XCNT(j)  (256  + 64 * (j))
#define XB_XSUB(j)  (1280 + 64 * (j))
#define XB_XGEN(j)  (2304 + 64 * (j))
#define XB_TOP      3328
#define XB_TOPGEN   3392
#define XCD_BAR_WORDS 3456
#define XB_SPIN_CAP (1u << 18)

__device__ __forceinline__ unsigned xb_ld(unsigned* p)              { return __hip_atomic_load(p, __ATOMIC_RELAXED, __HIP_MEMORY_SCOPE_AGENT); }
__device__ __forceinline__ unsigned xb_add(unsigned* p, unsigned v) { return __hip_atomic_fetch_add(p, v, __ATOMIC_RELAXED, __HIP_MEMORY_SCOPE_AGENT); }
__device__ __forceinline__ unsigned xb_xcc_id() { return (unsigned)__builtin_amdgcn_s_getreg((3 << 11) | 20) & 0xFu; }
#define XB_SPIN(cond, bar) do { unsigned _sp = 0; while (cond) { __builtin_amdgcn_s_sleep(1); \
    if ((++_sp & 255u) == 0u) { if (xb_ld(&(bar)[XB_TMO])) break; if (_sp > XB_SPIN_CAP) { atomicAdd(&(bar)[XB_TMO], 1u); break; } } } } while (0)

struct XcdBarrier {
    unsigned* bar; unsigned x; unsigned w0;
    volatile LAS unsigned* st;
};

__device__ __forceinline__ XcdBarrier xcd_barrier_post(unsigned* bar, volatile LAS unsigned* st, int wave_s) {
    XcdBarrier b; b.bar = bar; b.x = xb_xcc_id(); b.st = st; b.w0 = wave_s == 0 ? 1u : 0u;
    if (b.w0 && fresh_lane() == 0) (void)xb_add(&bar[XB_XCNT(b.x)], 1u);
    return b;
}
__device__ __forceinline__ void xcd_barrier_complete(unsigned* bar, unsigned x, unsigned& nloc, unsigned& nx) {
    const unsigned G = gridDim.x * gridDim.y * gridDim.z;
    unsigned sum, cnt, mine, sp = 0u;
    for (;;) {
        sum = 0u; cnt = 0u; mine = 0u;
#pragma unroll
        for (unsigned j = 0; j < 16; ++j) { const unsigned c = xb_ld(&bar[XB_XCNT(j)]); sum += c; cnt += (c > 0u) ? 1u : 0u; mine = (j == x) ? c : mine; }
        if (sum == G) break;
        __builtin_amdgcn_s_sleep(1);
        if ((++sp & 255u) == 0u) { if (xb_ld(&bar[XB_TMO])) break; if (sp > XB_SPIN_CAP) { atomicAdd(&bar[XB_TMO], 1u); break; } }
    }
    nloc = mine > 0u ? mine : 1u; nx = cnt > 0u ? cnt : 1u;
}

__device__ __forceinline__ void xcd_barrier(const XcdBarrier& b) {
    asm volatile("s_waitcnt vmcnt(0)" ::: "memory");
    __syncthreads();
    if (b.w0 && fresh_lane() == 0) {
        unsigned* bar = b.bar;
        __builtin_amdgcn_s_waitcnt(0);
        unsigned nloc = b.st[0], nx = b.st[1];
        if (nloc == 0u) { xcd_barrier_complete(bar, b.x, nloc, nx); b.st[0] = nloc; b.st[1] = nx; }
        const unsigned old = xb_add(&bar[XB_XSUB(b.x)], 1u);
        const unsigned gen = old / nloc;
        if (old + 1u == (gen + 1u) * nloc) {
            __builtin_amdgcn_fence(__ATOMIC_RELEASE, "agent");
            asm volatile("s_waitcnt vmcnt(0)" ::: "memory");
            const unsigned og = xb_add(&bar[XB_TOP], 1u);
            const unsigned tg = og / nx;
            if (og + 1u == (tg + 1u) * nx) xb_add(&bar[XB_TOPGEN], 1u);
            else XB_SPIN(xb_ld(&bar[XB_TOPGEN]) == tg, bar);
            __builtin_amdgcn_fence(__ATOMIC_ACQUIRE, "agent");
            xb_add(&bar[XB_XGEN(b.x)], 1u);
            asm volatile("s_waitcnt vmcnt(0)" ::: "memory");
        } else {
            XB_SPIN(xb_ld(&bar[XB_XGEN(b.x)]) == gen, bar);
            __builtin_amdgcn_fence(__ATOMIC_ACQUIRE, "agent");
            asm volatile("s_waitcnt vmcnt(0)" ::: "memory");
        }
    }
    __syncthreads();
}

constexpr int LDS_BYTES = 147456;
constexpr int LDS_XCH = 132096;
constexpr int LDS_MISC = 145408;
__global__ void __launch_bounds__(512, 2) mega_fwd(Ptrs P) {
    extern __shared__ __attribute__((aligned(16))) unsigned char lds_raw[];
    LAS unsigned char* lds = (LAS unsigned char*)lds_raw;
    unsigned char* ws = P.ws;
    const int wave = __builtin_amdgcn_readfirstlane(threadIdx.x >> 6);
    const int G = gridDim.x, bid = blockIdx.x;
    if (wave == 0) { const int l_ = fresh_lane(); if (l_ < 2) ((LAS unsigned*)(lds + LDS_MISC))[l_] = 0u; }
    __syncthreads();
    const XcdBarrier bar = xcd_barrier_post((unsigned*)(ws + WS_CTL), (volatile LAS unsigned*)(lds + LDS_MISC), wave);
    p0_prologue(P, lds, bid, G, wave);
    xcd_barrier(bar);
    if (bid == 0) bias1_stage(ws, fresh_tid(wave));
    {
        pg8::Gemm g{(const bf16_t*)(ws + WS_XN), (const bf16_t*)(ws + WS_WIN), MTOK, NPROJ, 2048, 2048};
        pg8::StaticOrder S; S.init(MTOK, NPROJ, G, bid);
        pg8::EpiProj E{(bf16_t*)(ws + WS_Q), (bf16_t*)(ws + WS_KV6), (bf16_t*)(ws + WS_U), (bf16_t*)(ws + WS_GV), (float*)(ws + WS_GATES), (float*)(ws + WS_VSTAT), P.in[3], P.in[4]};
        pg8::gemm_phase<pg8::EpiProj, pg8::StaticOrder, true, true>(lds, g, S, E, wave);
    }
    xcd_barrier(bar);
    if (bid < 128 && G >= 256) p2::compress_unit(P, lds, bid, wave);
    else if (G >= 256) p2::gmlp_run(P, lds, bid - 128, G - 128, 1024, wave);
    xcd_barrier(bar);
    nsa::nsa_phase(P, lds, bid, G, wave);
    xcd_barrier(bar);
    {
        pg8::Gemm g{(const bf16_t*)(ws + WS_AB), (const bf16_t*)(ws + WS_WOUT), MTOK, 2048, 2048, 2048};
        pg8::StaticOrder S; S.init(MTOK, 2048, G, bid);
        pg8::EpiRes1 E{P.in[0], P.out, (bf16_t*)(ws + WS_XN), (float*)(ws + WS_SSQ)};
        pg8::gemm_phase<pg8::EpiRes1, pg8::StaticOrder, true, true>(lds, g, S, E, wave);
    }
    xcd_barrier(bar);
    for (int m = bid * 512 + fresh_tid(wave); m < MTOK; m += G * 512) {
        const float* p = (const float*)(ws + WS_SSQ) + (size_t)m * 32; float s = 0.f;
#pragma unroll
        for (int i = 0; i < 32; ++i) s += p[i];
        ((float*)(ws + WS_SMALL + SM_R2))[m] = __builtin_amdgcn_rsqf(s * (1.0f / D_MODEL) + 1e-6f);
    }
    xcd_barrier(bar);
    {
        pg8::Gemm g{(const bf16_t*)(ws + WS_XN), (const bf16_t*)(ws + WS_WUP), MTOK, N_UP, 2048, 2048};
        pg8::StaticOrder S; S.init(MTOK, N_UP, G, bid);
        pg8::EpiUpConv E{(bf16_t*)(ws + WS_G), (const float*)(ws + WS_SMALL + SM_R2), P.in[15], P.in[16], (float*)(ws + WS_HLAST), (float*)(ws + WS_FIRST), lds + LDS_XCH};
        pg8::gemm_phase<pg8::EpiUpConv, pg8::StaticOrder, true, true>(lds, g, S, E, wave);
    }
    xcd_barrier(bar);
    for (int it = bid * 512 + fresh_tid(wave); it < 60 * 44 * 2 * 16; it += G * 512) {
        const int c8 = it & 15, row = (it >> 4) & 1, tl_ = it >> 5, pn = tl_ % 44, pmi = tl_ / 44, pm = pmi + pmi / 15 + 1;
        const float* cw = P.in[15]; const float* cb = P.in[16]; (void)cb;
        const float* fp = (const float*)(ws + WS_FIRST) + ((size_t)(pm * 44 + pn) * 2 + row) * 256 + 8 * c8;
        const float* lp = (const float*)(ws + WS_HLAST) + ((size_t)((pm - 1) * 44 + pn) * 2) * 256 + 8 * c8;
        const int ch = pn * 128 + 8 * c8;
        float r[8];
#pragma unroll
        for (int e = 0; e < 8; ++e) {
            const float l0g = lp[e], l1g = lp[256 + e], l0u = lp[128 + e], l1u = lp[256 + 128 + e];
            const float w0g = cw[ch + e], w1g = cw[N_UP + ch + e], w0u = cw[D_FF + ch + e], w1u = cw[N_UP + D_FF + ch + e];
            const float cg = fp[e] + (row == 0 ? w1g * l1g + w0g * l0g : w0g * l1g), cu = fp[128 + e] + (row == 0 ? w1u * l1u + w0u * l0u : w0u * l1u);
            r[e] = cg * sigmoidf_(cg) * cu;
        }
        u32x4_t o; o.x = pk2(r[0], r[1]); o.y = pk2(r[2], r[3]); o.z = pk2(r[4], r[5]); o.w = pk2(r[6], r[7]);
        *(u32x4_t*)((bf16_t*)(ws + WS_G) + (size_t)(pm * 256 + row) * D_FF + ch) = o;
    }
    xcd_barrier(bar);
    {
        pg8::Gemm g{(const bf16_t*)(ws + WS_G), (const bf16_t*)(ws + WS_WDOWN), MTOK, 2048, D_FF, D_FF};
        pg8::StaticOrder S; S.init(MTOK, 2048, G, bid);
        pg8::EpiDown E{P.out, (const bf16_t*)(ws + WS_XN)};
        pg8::gemm_phase<pg8::EpiDown, pg8::StaticOrder, true, true>(lds, g, S, E, wave);
    }
}

extern "C" void kernel_launch(void* const* d_in, const int* in_sizes, int n_in, void* d_out, int out_size, void* d_ws, size_t ws_size, hipStream_t stream) {
    static int grid_blocks = 0;
    if (!grid_blocks) {
        int dev = 0, cus = 0, per_cu = 0;
        (void)hipGetDevice(&dev);
        (void)hipDeviceGetAttribute(&cus, hipDeviceAttributeMultiprocessorCount, dev);
        (void)hipFuncSetAttribute((const void*)mega_fwd, hipFuncAttributeMaxDynamicSharedMemorySize, LDS_BYTES);
        (void)hipOccupancyMaxActiveBlocksPerMultiprocessor(&per_cu, (const void*)mega_fwd, 512, LDS_BYTES);
        if (per_cu < 1) { fprintf(stderr, "kernel_launch: occupancy query says %d blocks/CU\n", per_cu); per_cu = 1; }
        grid_blocks = cus * 1;
        (void)hipGetLastError();
    }
    if (n_in != 18 || ws_size < WS_END) { fprintf(stderr, "kernel_launch: unexpected n_in %d / ws %zu\n", n_in, ws_size); return; }
    Ptrs P{};
    for (int i = 0; i < 18; ++i) P.in[i] = (const float*)d_in[i];
    P.out = (float*)d_out; P.ws = (unsigned char*)d_ws;
    (void)hipMemsetAsync((char*)d_ws + WS_CTL, 0, 16384, stream);
    mega_fwd<<<dim3(grid_blocks), dim3(512), LDS_BYTES, stream>>>(P);
}
```

```cpp
#include <hip/hip_runtime.h>
#include <cstdio>
#include <cstdint>

constexpr int D_MODEL = 2048, BATCH = 4, SEQ = 4096, MTOK = BATCH * SEQ;
constexpr int IN_COLS = 4656, NPROJ = 4864;
constexpr int D_FF = 5632, N_UP = 2 * D_FF;
constexpr int NBG = 16;
constexpr size_t KVSZ = (size_t)NBG * SEQ * 64;
constexpr float LOG2E = 1.4426950408889634f;

constexpr size_t MiB = 1u << 20;
constexpr size_t WS_CTL = 0;
constexpr size_t WS_WIN = 1 * MiB, WS_WOUT = 20 * MiB, WS_WUP = 28 * MiB, WS_WDOWN = 72 * MiB, WS_W1C = 94 * MiB;
constexpr size_t WS_SMALL = 96 * MiB;
constexpr size_t SM_BIASP = 0, SM_BIAS1 = 65536, SM_R2 = 131072, SM_W2T = 196608  , SM_SWB = 262144  , SM_RINV = 524288  , SM_INVW = 589824  ;
constexpr size_t WS_XN = 97 * MiB;
constexpr size_t WS_Q = 161 * MiB;
constexpr size_t WS_KV6 = 193 * MiB;
constexpr size_t WS_U = 241 * MiB, WS_GV = 273 * MiB;
constexpr size_t WS_GATES = 305 * MiB;
constexpr size_t WS_VSTAT = 308 * MiB;
constexpr size_t WS_KC = 310 * MiB, WS_VC = 310 * MiB + 524288;
constexpr size_t WS_HC = 311 * MiB;
constexpr size_t WS_AB = 315 * MiB;
constexpr size_t WS_SSQ = 379 * MiB;
constexpr size_t WS_G = 161 * MiB;
constexpr size_t WS_HID = 381 * MiB;
constexpr size_t WS_HLAST = 381 * MiB, WS_FIRST = 388 * MiB;
constexpr size_t WS_END = 469 * MiB;

#define LAS __attribute__((address_space(3)))
typedef unsigned short bf16_t;
typedef unsigned u32x4_t __attribute__((ext_vector_type(4)));
typedef unsigned u32x2_t __attribute__((ext_vector_type(2)));
typedef float f32x4_t __attribute__((ext_vector_type(4)));

__device__ __forceinline__ float bf2f(unsigned short h) { return __uint_as_float(((unsigned)h) << 16); }
__device__ __forceinline__ unsigned f2bf(float f) { unsigned u = __float_as_uint(f); return (u + 0x7fffu + ((u >> 16) & 1u)) >> 16; }
__device__ __forceinline__ unsigned pk2(float lo, float hi) { return f2bf(lo) | (f2bf(hi) << 16); }
__device__ __forceinline__ float gelu_tanh(float x) {
    const float u = 0.7978845608028654f * (x + 0.044715f * x * x * x);
    const float e = __builtin_amdgcn_exp2f(-2.8853900817779268f * u);
    return x * __builtin_amdgcn_rcpf(1.0f + e);
}
__device__ __forceinline__ float sigmoidf_(float x) { return __builtin_amdgcn_rcpf(1.0f + __builtin_amdgcn_exp2f(-LOG2E * x)); }
__device__ __forceinline__ float wave_sum(float v) {
#pragma unroll
    for (int o = 1; o < 64; o <<= 1) v += __shfl_xor(v, o);
    return v;
}
__device__ __forceinline__ void unpack8(u32x4_t r, float (&f)[8]) {
    f[0] = __uint_as_float(r.x << 16); f[1] = __uint_as_float(r.x & 0xffff0000u);
    f[2] = __uint_as_float(r.y << 16); f[3] = __uint_as_float(r.y & 0xffff0000u);
    f[4] = __uint_as_float(r.z << 16); f[5] = __uint_as_float(r.z & 0xffff0000u);
    f[6] = __uint_as_float(r.w << 16); f[7] = __uint_as_float(r.w & 0xffff0000u);
}

__device__ __forceinline__ int fresh_lane() { unsigned z_ = 0u; asm volatile("" : "+v"(z_)); return (int)__builtin_amdgcn_mbcnt_hi(~0u, __builtin_amdgcn_mbcnt_lo(~0u, z_)); }
__device__ __forceinline__ int fresh_tid(int wave_s) { return wave_s * 64 + fresh_lane(); }
namespace pg8 {
#define PG8_LAS __attribute__((address_space(3)))
typedef unsigned short bf16_t;
typedef short bf16x8 __attribute__((ext_vector_type(8)));
typedef float f32x4 __attribute__((ext_vector_type(4)));
typedef unsigned u32x4 __attribute__((ext_vector_type(4)));
constexpr int BM = 256, BK = 64, HALF = 128, HTB = HALF * BK * 2  , STAGE_BYTES = 8 * HTB, NXCD = 8, WGM = 8;

__host__ __device__ __forceinline__ int lds_byte(int r, int c) { const int st = (r >> 4) * 2 + (c >> 5), rr = r & 15, cc = c & 31, ob = rr * 64 + cc * 2; return st * 1024 + (ob ^ (((ob >> 9) & 1) << 5)); }
__host__ __device__ __forceinline__ void stage_rc(int b, int& R, int& C) { const int st = b / 1024, sb = b % 1024, swz = sb ^ (((sb >> 9) & 1) << 5); R = (st >> 1) * 16 + swz / 64; C = (st & 1) * 32 + (swz % 64) / 2; }
__host__ __device__ __forceinline__ int perm32(int rho) { const int n = rho >> 4, i = rho & 15; return 8 * (i >> 2) + 4 * n + (i & 3); }

struct Unit { int pm, pn; };
struct Gemm { const bf16_t* A; const bf16_t* Bt; int M, N, K, lda; };

struct StaticOrder {
    int nM, nN, nwg, G, c;
    __host__ __device__ void init(int M, int N, int G_, int c_) { nM = M / BM; nN = N / BM; nwg = nM * nN; G = G_; c = c_; }
    __host__ __device__ bool next(int i, Unit& u) const {
        const long L = (long)i * G + c; if (L >= nwg) return false;
        int wgid = (int)L; { const int q = nwg / NXCD, r = nwg % NXCD, xcd = wgid % NXCD, off = wgid / NXCD; wgid = (xcd < r ? xcd * (q + 1) : r * (q + 1) + (xcd - r) * q) + off; }
        const int nig = WGM * nN, gid = wgid / nig, fm = gid * WGM, gsz = (nM - fm) < WGM ? (nM - fm) : WGM;
        u.pm = fm + ((wgid % nig) % gsz); u.pn = (wgid % nig) / gsz; return true;
    }
    __device__ __forceinline__ void a_ready(const Unit&) const {}
    __device__ __forceinline__ void done(const Unit&) const {}
};

__device__ __forceinline__ unsigned cvt_pk_bf16(float lo, float hi) { unsigned r; asm volatile("v_cvt_pk_bf16_f32 %0, %1, %2" : "=v"(r) : "v"(lo), "v"(hi)); return r; }

struct EpiProj {
    static constexpr bool PERM = true, AFTER_DRAIN = false;
    bf16_t* Q; bf16_t* KV6; bf16_t* U; bf16_t* GV; float* GATES; float* VSTAT; const float* q_norm_w; const float* k_norm_w;
    __device__ __forceinline__ void operator()(const f32x4 (&acc)[2][2][4][2], const Unit& u, int wr, int wc, int fr, int fq) const {
        const int pn = u.pn, row0 = u.pm * BM + wr * 64 + fr;
        if (pn < 10) {
            const bool normed = (pn < 4) || pn == 6 || pn == 8;
            const float* w = pn < 4 ? q_norm_w : (k_norm_w + (pn == 6 ? 64 : 128));
            const float sc = pn < 4 ? 0.125f * LOG2E : 1.0f;
            f32x4 wv[2][2];
#pragma unroll
            for (int bj = 0; bj < 2; ++bj)
#pragma unroll
                for (int n = 0; n < 2; ++n) wv[bj][n] = normed ? (*(const f32x4*)(w + 32 * bj + 8 * fq + 4 * n)) * sc : (f32x4){1.f, 1.f, 1.f, 1.f};
#pragma unroll
            for (int ai = 0; ai < 2; ++ai)
#pragma unroll
                for (int m = 0; m < 4; ++m) {
                    const int row = row0 + ai * HALF + m * 16;
                    float r = 1.f;
                    if (normed) {
                        float ss = 0.f;
#pragma unroll
                        for (int bj = 0; bj < 2; ++bj)
#pragma unroll
                            for (int n = 0; n < 2; ++n) { const f32x4 x = acc[ai][bj][m][n]; ss += (x[0] * x[0] + x[1] * x[1]) + (x[2] * x[2] + x[3] * x[3]); }
                        ss += __shfl_xor(ss, 16); ss += __shfl_xor(ss, 32);
                        r = __builtin_amdgcn_rsqf(ss * (1.0f / 64.0f) + 1e-6f);
                    }
                    bf16_t* dst;
                    if (pn < 4) dst = Q + (size_t)row * 1024 + pn * 256 + wc * 64 + 8 * fq;
                    else { const int b = row >> 12, t = row & 4095; dst = KV6 + (size_t)(pn - 4) * KVSZ + ((size_t)((b * 4 + wc) * 4096 + t)) * 64 + 8 * fq; }
#pragma unroll
                    for (int bj = 0; bj < 2; ++bj) {
                        const f32x4 v0 = acc[ai][bj][m][0] * r * wv[bj][0], v1 = acc[ai][bj][m][1] * r * wv[bj][1];
                        u32x4 o; o.x = cvt_pk_bf16(v0[0], v0[1]); o.y = cvt_pk_bf16(v0[2], v0[3]); o.z = cvt_pk_bf16(v1[0], v1[1]); o.w = cvt_pk_bf16(v1[2], v1[3]);
                        *(u32x4*)(dst + 32 * bj) = o;
                    }
                }
        } else if (pn < 18) {
            const bool isv = pn >= 14; const int ct = isv ? pn - 14 : pn - 10;
            bf16_t* base = (isv ? GV : U) + ct * 256 + wc * 64 + 8 * fq;
#pragma unroll
            for (int ai = 0; ai < 2; ++ai)
#pragma unroll
                for (int m = 0; m < 4; ++m) {
                    const int row = row0 + ai * HALF + m * 16; float s1 = 0.f, s2 = 0.f;
#pragma unroll
                    for (int bj = 0; bj < 2; ++bj) {
                        f32x4 v0 = acc[ai][bj][m][0], v1 = acc[ai][bj][m][1];
#pragma unroll
                        for (int e = 0; e < 4; ++e) { v0[e] = gelu_tanh(v0[e]); v1[e] = gelu_tanh(v1[e]); s1 += v0[e] + v1[e]; s2 += v0[e] * v0[e] + v1[e] * v1[e]; }
                        u32x4 o; o.x = cvt_pk_bf16(v0[0], v0[1]); o.y = cvt_pk_bf16(v0[2], v0[3]); o.z = cvt_pk_bf16(v1[0], v1[1]); o.w = cvt_pk_bf16(v1[2], v1[3]);
                        *(u32x4*)(base + (size_t)row * 1024 + 32 * bj) = o;
                    }
                    if (isv) {
                        s1 += __shfl_xor(s1, 16); s1 += __shfl_xor(s1, 32); s2 += __shfl_xor(s2, 16); s2 += __shfl_xor(s2, 32);
                        if (fq == 0) { float* p = VSTAT + ((size_t)row * 16 + ct * 4 + wc) * 2; p[0] = s1; p[1] = s2; }
                    }
                }
        } else {
            if (wc == 0) {
#pragma unroll
                for (int ai = 0; ai < 2; ++ai)
#pragma unroll
                    for (int m = 0; m < 4; ++m) {
                        const int row = row0 + ai * HALF + m * 16;
#pragma unroll
                        for (int bj = 0; bj < 2; ++bj)
#pragma unroll
                            for (int n = 0; n < 2; ++n) {
                                const int L = 32 * bj + 8 * fq + 4 * n;
                                if (L < 48) { f32x4 v = acc[ai][bj][m][n]; f32x4 o; o[0] = sigmoidf_(v[0]); o[1] = sigmoidf_(v[1]); o[2] = sigmoidf_(v[2]); o[3] = sigmoidf_(v[3]); *(f32x4*)(GATES + (size_t)row * 48 + L) = o; }
                            }
                    }
            }
        }
    }
};
struct EpiCmp {
    static constexpr bool PERM = true, AFTER_DRAIN = false;
    bf16_t* HC; const float* bias1;
    __device__ __forceinline__ void operator()(const f32x4 (&acc)[2][2][4][2], const Unit& u, int wr, int wc, int fr, int fq) const {
        const int row0 = u.pm * BM + wr * 64 + fr, col0 = wc * 32 + 8 * fq;
        f32x4 bv[2][2];
#pragma unroll
        for (int bj = 0; bj < 2; ++bj)
#pragma unroll
            for (int n = 0; n < 2; ++n) bv[bj][n] = *(const f32x4*)(bias1 + u.pn * 256 + col0 + bj * HALF + 4 * n);
#pragma unroll
        for (int ai = 0; ai < 2; ++ai)
#pragma unroll
            for (int m = 0; m < 4; ++m) { bf16_t* rowp = HC + (size_t)(row0 + ai * HALF + m * 16) * 256 + col0;
#pragma unroll
                for (int bj = 0; bj < 2; ++bj) { f32x4 v0 = acc[ai][bj][m][0] + bv[bj][0], v1 = acc[ai][bj][m][1] + bv[bj][1];
#pragma unroll
                    for (int e = 0; e < 4; ++e) { v0[e] = gelu_tanh(v0[e]); v1[e] = gelu_tanh(v1[e]); }
                    u32x4 o; o.x = cvt_pk_bf16(v0[0], v0[1]); o.y = cvt_pk_bf16(v0[2], v0[3]); o.z = cvt_pk_bf16(v1[0], v1[1]); o.w = cvt_pk_bf16(v1[2], v1[3]);
                    *(u32x4*)(rowp + bj * HALF) = o; } }
    }
};
struct CmpOrder {
    int c, G;
    __device__ bool next(int i, Unit& u) const { const int L = i * G + c; if (L >= 32) return false; u.pm = L; u.pn = L >> 4; return true; }
    __device__ __forceinline__ void a_ready(const Unit&) const {}
    __device__ __forceinline__ void done(const Unit&) const {}
};
struct EpiRes1 {
    static constexpr bool PERM = false, AFTER_DRAIN = false;
    const float* RINV; const float* INVW; bf16_t* X1b; float* SSQ;
    __device__ __forceinline__ void operator()(const f32x4 (&acc)[2][2][4][2], const Unit& u, int wr, int wc, int fr, int fq) const {
        const int row0 = u.pm * BM + wr * 64 + fr, col0 = u.pn * BM + wc * 32 + 4 * fq;
        f32x4 iw[2][2];
#pragma unroll
        for (int bj = 0; bj < 2; ++bj)
#pragma unroll
            for (int n = 0; n < 2; ++n) iw[bj][n] = *(const f32x4*)(INVW + col0 + bj * HALF + n * 16);
#pragma unroll
        for (int ai = 0; ai < 2; ++ai) {
            u32x2_t xin[4][2][2]; float ri[4];
#pragma unroll
            for (int m = 0; m < 4; ++m) { ri[m] = RINV[row0 + ai * HALF + m * 16];
#pragma unroll
                for (int bj = 0; bj < 2; ++bj)
#pragma unroll
                    for (int n = 0; n < 2; ++n) xin[m][bj][n] = *(const u32x2_t*)(X1b + (size_t)(row0 + ai * HALF + m * 16) * D_MODEL + col0 + bj * HALF + n * 16); }
            __builtin_amdgcn_sched_barrier(0);
#pragma unroll
            for (int m = 0; m < 4; ++m) { const int row = row0 + ai * HALF + m * 16; const size_t off = (size_t)row * D_MODEL + col0; float ss = 0.f;
#pragma unroll
                for (int bj = 0; bj < 2; ++bj)
#pragma unroll
                    for (int n = 0; n < 2; ++n) { const u32x2_t w_ = xin[m][bj][n];
                        f32x4 xv; xv[0] = __uint_as_float(w_.x << 16); xv[1] = __uint_as_float(w_.x & 0xffff0000u); xv[2] = __uint_as_float(w_.y << 16); xv[3] = __uint_as_float(w_.y & 0xffff0000u);
                        const f32x4 v = xv * ri[m] * iw[bj][n] + acc[ai][bj][m][n];
                        ss += (v[0] * v[0] + v[1] * v[1]) + (v[2] * v[2] + v[3] * v[3]);
                        u32x2_t w; w.x = cvt_pk_bf16(v[0], v[1]); w.y = cvt_pk_bf16(v[2], v[3]); *(u32x2_t*)(X1b + off + bj * HALF + n * 16) = w; }
                ss += __shfl_xor(ss, 16); ss += __shfl_xor(ss, 32);
                if (fq == 0) SSQ[(size_t)row * 32 + u.pn * 4 + wc] = ss; }
            __builtin_amdgcn_sched_barrier(0);
        }
    }
};
struct EpiUpV1 {
    static constexpr bool PERM = true, AFTER_DRAIN = false;
    bf16_t* HID; const float* R2;
    __device__ __forceinline__ void operator()(const f32x4 (&acc)[2][2][4][2], const Unit& u, int wr, int wc, int fr, int fq) const {
        const int row0 = u.pm * BM + wr * 64 + fr, col0 = u.pn * BM + wc * 32 + 8 * fq;
#pragma unroll
        for (int ai = 0; ai < 2; ++ai)
#pragma unroll
            for (int m = 0; m < 4; ++m) { const int row = row0 + ai * HALF + m * 16; const float r = R2[row]; bf16_t* rowp = HID + (size_t)row * N_UP + col0;
#pragma unroll
                for (int bj = 0; bj < 2; ++bj) { const f32x4 v0 = acc[ai][bj][m][0] * r, v1 = acc[ai][bj][m][1] * r;
                    u32x4 o; o.x = cvt_pk_bf16(v0[0], v0[1]); o.y = cvt_pk_bf16(v0[2], v0[3]); o.z = cvt_pk_bf16(v1[0], v1[1]); o.w = cvt_pk_bf16(v1[2], v1[3]);
                    *(u32x4*)(rowp + bj * HALF) = o; } }
    }
};
struct EpiDown {
    static constexpr bool PERM = false, AFTER_DRAIN = false;
    float* out; const bf16_t* X1b;
    __device__ __forceinline__ void operator()(const f32x4 (&acc)[2][2][4][2], const Unit& u, int wr, int wc, int fr, int fq) const {
        const int row0 = u.pm * BM + wr * 64 + fr, col0 = u.pn * BM + wc * 32 + 4 * fq;
#pragma unroll
        for (int ai = 0; ai < 2; ++ai) {
            u32x2_t xin[4][2][2];
#pragma unroll
            for (int m = 0; m < 4; ++m)
#pragma unroll
                for (int bj = 0; bj < 2; ++bj)
#pragma unroll
                    for (int n = 0; n < 2; ++n) xin[m][bj][n] = *(const u32x2_t*)(X1b + (size_t)(row0 + ai * HALF + m * 16) * D_MODEL + col0 + bj * HALF + n * 16);
            __builtin_amdgcn_sched_barrier(0);
#pragma unroll
            for (int m = 0; m < 4; ++m) { const size_t off = (size_t)(row0 + ai * HALF + m * 16) * D_MODEL + col0;
#pragma unroll
                for (int bj = 0; bj < 2; ++bj)
#pragma unroll
                    for (int n = 0; n < 2; ++n) { const u32x2_t w = xin[m][bj][n];
                        f32x4 v; v[0] = __uint_as_float(w.x << 16); v[1] = __uint_as_float(w.x & 0xffff0000u); v[2] = __uint_as_float(w.y << 16); v[3] = __uint_as_float(w.y & 0xffff0000u);
                        *(f32x4*)(out + off + bj * HALF + n * 16) = v + acc[ai][bj][m][n]; } }
            __builtin_amdgcn_sched_barrier(0);
        }
    }
};
__device__ __forceinline__ unsigned f2bf_(float f) { unsigned u = __float_as_uint(f); return (u + 0x7fffu + ((u >> 16) & 1u)) >> 16; }
struct EpiUpConv {
    static constexpr bool PERM = true, AFTER_DRAIN = false;
    bf16_t* G; const float* R2; const float* cw; const float* cb; float* HLAST; float* FIRST; PG8_LAS unsigned char* xlds;
    __device__ __forceinline__ void operator()(const f32x4 (&acc)[2][2][4][2], const Unit& u, int wr, int wc, int fr_in, int fq_in) const {
        (void)fr_in; (void)fq_in;
        unsigned z_ = 0u; asm volatile("" : "+v"(z_));
        const int lane_ = (int)__builtin_amdgcn_mbcnt_hi(~0u, __builtin_amdgcn_mbcnt_lo(~0u, z_)); const int fr = lane_ & 15, fq = lane_ >> 4;
        const int row0 = u.pm * BM + wr * 64 + fr;
        PG8_LAS float* X = (PG8_LAS float*)xlds;
        const unsigned tile = (unsigned)(u.pm * (N_UP / 256) + u.pn);
        if (fr >= 14) {
#pragma unroll
            for (int ai = 0; ai < 2; ++ai) { const int sg = 2 * ai + wr; const float r3 = R2[row0 + ai * HALF + 48];
#pragma unroll
                for (int bj = 0; bj < 2; ++bj)
#pragma unroll
                    for (int n = 0; n < 2; ++n) { const f32x4 h = acc[ai][bj][3][n] * r3;
                        *(PG8_LAS f32x4*)(X + ((sg * 4 + wc) * 2 + (fr - 14)) * 64 + bj * 32 + 8 * fq + 4 * n) = h;
                        if (ai == 1 && wr == 1) *(f32x4*)(HLAST + (unsigned)((tile * 2 + (fr - 14)) * 256 + bj * HALF + wc * 32 + 8 * fq + 4 * n)) = h; } }
        }
        PG8_LAS float* R2L = X + 3072;
        PG8_LAS float* Wl = X + 2048;
        { const int t_ = (wr * 4 + wc) * 64 + fq * 16 + fr;
#pragma unroll
          for (int i2 = 0; i2 < 2; ++i2) { const int i = t_ + 512 * i2, k = i >> 8, p = i & 255, c = (p < 128 ? 0 : D_FF - 128) + u.pn * 128 + p;
              Wl[i] = k < 3 ? cw[(unsigned)(k * N_UP + c)] : cb[(unsigned)c]; }
          if (t_ < 256) R2L[t_] = R2[u.pm * BM + t_]; }
        asm volatile("s_waitcnt vmcnt(0) lgkmcnt(0)" ::: "memory"); __builtin_amdgcn_s_barrier(); asm volatile("" ::: "memory");
        const int cbase = u.pn * 128 + wc * 32 + 8 * fq;
        const bool seq_start = (u.pm & 15) == 0;
#pragma unroll
        for (int ai = 0; ai < 2; ++ai) {
            const int sg = 2 * ai + wr;
            float rs[4];
#pragma unroll
            for (int m = 0; m < 4; ++m) rs[m] = R2L[wr * 64 + fr + ai * HALF + m * 16];
            const bool defer = (ai == 0) && (wr == 0) && !seq_start && (fr < 2);
#pragma unroll
            for (int n = 0; n < 2; ++n) {
                unsigned pk[4][2];
#pragma unroll
                for (int e = 0; e < 4; ++e) {
                    asm volatile("" ::: "memory"); __builtin_amdgcn_sched_barrier(0);
                    PG8_LAS const float* wp = Wl + wc * 32 + 8 * fq + 4 * n + e;
                    const float wg0 = wp[0], wg1 = wp[256], wg2 = wp[512], bg = wp[768], wu0 = wp[128], wu1 = wp[384], wu2 = wp[640], bu = wp[896];
                    float hg1 = 0.f, hg2 = 0.f, hu1 = 0.f, hu2 = 0.f;
                    if (ai == 1 || wr == 1) { PG8_LAS const float* xp = X + (((sg - 1) * 4 + wc) * 2) * 64 + 8 * fq + 4 * n + e; hg2 = xp[0]; hg1 = xp[64]; hu2 = xp[32]; hu1 = xp[96]; }
                    float ag = hg1, bgp = fr == 0 ? hg2 : hg1, au = hu1, bup = fr == 0 ? hu2 : hu1;
#pragma unroll
                    for (int m = 0; m < 4; ++m) {
                        const float vg = acc[ai][0][m][n][e] * rs[m], vu = acc[ai][1][m][n][e] * rs[m];
                        const float rg1 = __uint_as_float(__builtin_amdgcn_mov_dpp(__float_as_uint(vg), 0x121, 0xf, 0xf, true)), rg2 = __uint_as_float(__builtin_amdgcn_mov_dpp(__float_as_uint(vg), 0x122, 0xf, 0xf, true));
                        const float ru1 = __uint_as_float(__builtin_amdgcn_mov_dpp(__float_as_uint(vu), 0x121, 0xf, 0xf, true)), ru2 = __uint_as_float(__builtin_amdgcn_mov_dpp(__float_as_uint(vu), 0x122, 0xf, 0xf, true));
                        const float pg1 = fr >= 1 ? rg1 : ag, pg2 = fr >= 2 ? rg2 : bgp, pu1 = fr >= 1 ? ru1 : au, pu2 = fr >= 2 ? ru2 : bup;
                        const float cg = bg + wg0 * pg2 + wg1 * pg1 + wg2 * vg, cu = bu + wu0 * pu2 + wu1 * pu1 + wu2 * vu;
                        if (m == 0 && defer) { float* fp = FIRST + (unsigned)((tile * 2 + fr) * 256 + wc * 32 + 8 * fq + 4 * n + e); fp[0] = cg; fp[HALF] = cu; }
                        const unsigned hb = cvt_pk_bf16(cg * sigmoidf_(cg) * cu, 0.f);
                        if ((e & 1) == 0) pk[m][e >> 1] = hb; else pk[m][e >> 1] |= hb << 16;
                        ag = rg1; bgp = rg2; au = ru1; bup = ru2;
                    }
                }
#pragma unroll
                for (int m = 0; m < 4; ++m)
                    if (!(m == 0 && defer)) { u32x2_t o; o.x = pk[m][0]; o.y = pk[m][1]; *(u32x2_t*)(G + (unsigned)((row0 + ai * HALF + m * 16) * D_FF + cbase + 4 * n)) = o; }
            }
        }
    }
};
template <class Epi, class Sched, bool ALIGN_EPI = false, bool SP2 = false>
__device__ __forceinline__ void gemm_phase(PG8_LAS unsigned char* lds, const Gemm g, const Sched& S, const Epi& E, const int wave_s) {
    const int tid = fresh_tid(wave_s), wid = wave_s, lane = tid & 63,
          wr = wid >> 2, wc = wid & 3, fr = lane & 15, fq = lane >> 4;
    const int K = g.K, nt = K / BK;
    unsigned voffA[2], voffB[2];
#pragma unroll
    for (int i = 0; i < 2; ++i) { int R, C; stage_rc(tid * 16 + i * 8192, R, C); const int Rb = Epi::PERM ? ((R & ~31) + perm32(R & 31)) : R;
        voffA[i] = (unsigned)(R * g.lda + C) * 2u; voffB[i] = (unsigned)(Rb * K + C) * 2u; }
    const size_t kstep = (size_t)(BK * 2);
    const size_t hstepA = (size_t)HALF * g.lda * 2, hstepB = (size_t)HALF * K * 2;
    const size_t tstepA = 2 * hstepA, tstepB = 2 * hstepB;
    const unsigned ldsw = (unsigned)wid * 1024u;
    const int aoff = lds_byte(wr * 64 + fr, fq * 8), boff = lds_byte(wc * 32 + fr, fq * 8);
#define PG8_SA(b, h) (((b) * 2 + (h)) * HTB)
#define PG8_SB(b, h) ((4 + (b) * 2 + (h)) * HTB)
#define PG8_STAGE(bufoff, gbase, voff) do { _Pragma("unroll") for (int _i = 0; _i < 2; ++_i) \
        __builtin_amdgcn_global_load_lds((const unsigned*)((const char*)(gbase) + (voff)[_i]), (PG8_LAS unsigned*)(lds + (bufoff) + ldsw + _i * 8192), 16, 0, 0); } while (0)
#define PG8_LDA(dst, b, h) do { _Pragma("unroll") for (int m = 0; m < 4; ++m) _Pragma("unroll") for (int k = 0; k < 2; ++k) dst[m][k] = *(const PG8_LAS bf16x8*)(lds + PG8_SA(b, h) + aoff + m * 2048 + k * 1024); } while (0)
#define PG8_LDB(dst, b, h) do { _Pragma("unroll") for (int n = 0; n < 2; ++n) _Pragma("unroll") for (int k = 0; k < 2; ++k) dst[n][k] = *(const PG8_LAS bf16x8*)(lds + PG8_SB(b, h) + boff + n * 2048 + k * 1024); } while (0)
#define PG8_MMA(ai, bj, At, Bt) do { __builtin_amdgcn_s_setprio(1); _Pragma("unroll") for (int m = 0; m < 4; ++m) _Pragma("unroll") for (int n = 0; n < 2; ++n) _Pragma("unroll") for (int k = 0; k < 2; ++k) \
        acc[ai][bj][m][n] = __builtin_amdgcn_mfma_f32_16x16x32_bf16(Bt[n][k], At[m][k], acc[ai][bj][m][n], 0, 0, 0); __builtin_amdgcn_s_setprio(0); } while (0)
#define PG8_WAIT_V(n) asm volatile("s_waitcnt vmcnt(" #n ")" ::: "memory")
#define PG8_WAIT_L(n) asm volatile("s_waitcnt lgkmcnt(" #n ")" ::: "memory")
#define PG8_BAR __builtin_amdgcn_s_barrier()
#define PG8_SCHED __builtin_amdgcn_sched_barrier(0)
    Unit cur, nxt; int ui = 0;
    if (!S.next(0, cur)) return;
    f32x4 acc[2][2][4][2];
#pragma unroll
    for (int a = 0; a < 2; ++a)
#pragma unroll
        for (int b = 0; b < 2; ++b)
#pragma unroll
            for (int m = 0; m < 4; ++m)
#pragma unroll
                for (int n = 0; n < 2; ++n) acc[a][b][m][n] = (f32x4){0.f, 0.f, 0.f, 0.f};
    bf16x8 At[4][2], B0[2][2], B1[2][2];
    const char* cA = (const char*)g.A + (size_t)cur.pm * tstepA; const char* cB = (const char*)g.Bt + (size_t)cur.pn * tstepB;
    S.a_ready(cur);
    if constexpr (SP2) {
        PG8_STAGE(PG8_SB(0, 0), cB, voffB); PG8_STAGE(PG8_SB(0, 1), cB + hstepB, voffB); PG8_STAGE(PG8_SA(0, 0), cA, voffA); PG8_STAGE(PG8_SA(0, 1), cA + hstepA, voffA);
        if (wr == 1) PG8_BAR;
        PG8_WAIT_V(2); PG8_BAR;
        PG8_STAGE(PG8_SB(1, 0), cB + kstep, voffB); PG8_STAGE(PG8_SA(1, 0), cA + kstep, voffA); PG8_STAGE(PG8_SB(1, 1), cB + hstepB + kstep, voffB);
        PG8_WAIT_V(6); PG8_BAR;
    } else {
        PG8_STAGE(PG8_SB(0, 0), cB, voffB); PG8_STAGE(PG8_SA(0, 0), cA, voffA); PG8_STAGE(PG8_SB(0, 1), cB + hstepB, voffB); PG8_STAGE(PG8_SA(0, 1), cA + hstepA, voffA);
        if (wr == 1) PG8_BAR;
        PG8_WAIT_V(4); PG8_BAR;
        PG8_STAGE(PG8_SB(1, 0), cB + kstep, voffB); PG8_STAGE(PG8_SA(1, 0), cA + kstep, voffA); PG8_STAGE(PG8_SB(1, 1), cB + hstepB + kstep, voffB);
        PG8_WAIT_V(6); PG8_BAR;
    }
    for (;;) {
        const bool has_next = S.next(ui + 1, nxt);
        const char* nA = has_next ? (const char*)g.A + (size_t)nxt.pm * tstepA : cA; const char* nB = has_next ? (const char*)g.Bt + (size_t)nxt.pn * tstepB : cB;
        for (int t = 0; t < nt; t += 2) {
            const bool last = (t == nt - 2);
            const char* a1 = cA + (size_t)(t + 1) * kstep;
            const char* a2 = last ? nA : cA + (size_t)(t + 2) * kstep; const char* b2 = last ? nB : cB + (size_t)(t + 2) * kstep;
            const char* a3 = a2 + kstep; const char* b3 = b2 + kstep;
            if (last && has_next) S.a_ready(nxt);
            if constexpr (SP2) {
            PG8_LDB(B0, 0, 0); PG8_LDB(B1, 0, 1); PG8_SCHED; PG8_LDA(At, 0, 0); PG8_STAGE(PG8_SA(1, 1), a1 + hstepA, voffA);
            PG8_WAIT_V(8); PG8_WAIT_L(0); PG8_BAR; PG8_MMA(0, 0, At, B0); PG8_MMA(0, 1, At, B1); PG8_BAR; PG8_SCHED;
            PG8_LDA(At, 0, 1); PG8_STAGE(PG8_SB(0, 0), b2, voffB); PG8_STAGE(PG8_SB(0, 1), b2 + hstepB, voffB); PG8_STAGE(PG8_SA(0, 0), a2, voffA);
            PG8_WAIT_V(8); PG8_WAIT_L(0); PG8_BAR; PG8_MMA(1, 0, At, B0); PG8_MMA(1, 1, At, B1); PG8_BAR; PG8_SCHED;
            PG8_LDB(B0, 1, 0); PG8_LDB(B1, 1, 1); PG8_SCHED; PG8_LDA(At, 1, 0); PG8_STAGE(PG8_SA(0, 1), a2 + hstepA, voffA);
            PG8_WAIT_V(8); PG8_WAIT_L(0); PG8_BAR; PG8_MMA(0, 0, At, B0); PG8_MMA(0, 1, At, B1); PG8_BAR; PG8_SCHED;
            PG8_LDA(At, 1, 1); PG8_STAGE(PG8_SB(1, 0), b3, voffB); PG8_STAGE(PG8_SB(1, 1), b3 + hstepB, voffB); PG8_STAGE(PG8_SA(1, 0), a3, voffA);
            PG8_WAIT_V(8); PG8_WAIT_L(0); PG8_BAR; PG8_MMA(1, 0, At, B0); PG8_MMA(1, 1, At, B1); PG8_BAR; PG8_SCHED;
            } else {
            PG8_LDB(B0, 0, 0); PG8_SCHED; PG8_LDA(At, 0, 0); PG8_STAGE(PG8_SA(1, 1), a1 + hstepA, voffA);
            PG8_WAIT_L(8); PG8_BAR; PG8_WAIT_L(0); PG8_MMA(0, 0, At, B0); PG8_BAR; PG8_SCHED;
            PG8_LDB(B1, 0, 1); PG8_STAGE(PG8_SB(0, 0), b2, voffB);
            PG8_BAR; PG8_WAIT_L(0); PG8_MMA(0, 1, At, B1); PG8_BAR;
            PG8_LDA(At, 0, 1); PG8_STAGE(PG8_SA(0, 0), a2, voffA);
            PG8_BAR; PG8_WAIT_L(0); PG8_MMA(1, 0, At, B0); PG8_BAR; PG8_SCHED;
            PG8_STAGE(PG8_SB(0, 1), b2 + hstepB, voffB);
            PG8_WAIT_V(6); PG8_BAR; PG8_MMA(1, 1, At, B1); PG8_BAR;
            PG8_LDB(B0, 1, 0); PG8_SCHED; PG8_LDA(At, 1, 0); PG8_STAGE(PG8_SA(0, 1), a2 + hstepA, voffA);
            PG8_WAIT_L(8); PG8_BAR; PG8_WAIT_L(0); PG8_MMA(0, 0, At, B0); PG8_BAR; PG8_SCHED;
            PG8_LDB(B1, 1, 1); PG8_STAGE(PG8_SB(1, 0), b3, voffB);
            PG8_BAR; PG8_WAIT_L(0); PG8_MMA(0, 1, At, B1); PG8_BAR;
            PG8_LDA(At, 1, 1); PG8_STAGE(PG8_SA(1, 0), a3, voffA);
            PG8_BAR; PG8_WAIT_L(0); PG8_MMA(1, 0, At, B0); PG8_BAR; PG8_SCHED;
            PG8_STAGE(PG8_SB(1, 1), b3 + hstepB, voffB);
            PG8_WAIT_V(6); PG8_BAR; PG8_MMA(1, 1, At, B1); PG8_BAR;
            }
        }
        if constexpr (ALIGN_EPI) { if (wr == 0) PG8_BAR; }
        if constexpr (!Epi::AFTER_DRAIN) { E(acc, cur, wr, wc, fr, fq); S.done(cur); }
        if (!has_next) break;
#pragma unroll
        for (int a = 0; a < 2; ++a)
#pragma unroll
            for (int b = 0; b < 2; ++b)
#pragma unroll
                for (int m = 0; m < 4; ++m)
#pragma unroll
                    for (int n = 0; n < 2; ++n) acc[a][b][m][n] = (f32x4){0.f, 0.f, 0.f, 0.f};
        cur = nxt; cA = nA; cB = nB; ++ui;
        if constexpr (ALIGN_EPI) { if (wr == 1) PG8_BAR; }
    }
    PG8_WAIT_V(0);
    if constexpr (!ALIGN_EPI) { if (wr == 0) PG8_BAR; }
    PG8_BAR;
    if constexpr (Epi::AFTER_DRAIN) { E.fused(acc, cur, wr, wc, fr, fq, lds, wid, lane); S.done(cur); }
#undef PG8_SA
#undef PG8_SB
#undef PG8_STAGE
#undef PG8_LDA
#undef PG8_LDB
#undef PG8_MMA
#undef PG8_WAIT_V
#undef PG8_WAIT_L
#undef PG8_BAR
#undef PG8_SCHED
}
}
constexpr int NWAVES = 8;
template <class RowMap>
__device__ __forceinline__ void transpose_item(const float* __restrict__ W, int K, int N, bf16_t* WT, const float* __restrict__ kscale, RowMap rm, LAS float* scr, int item, int lane) {
    const int nblk = (N + 31) / 32, kb = item / nblk, nb = item % nblk, k0 = 64 * kb, n0 = 32 * nb;
    const int nr = n0 + (lane & 31);
    float v[32];
#pragma unroll
    for (int i = 0; i < 32; ++i) { const int kk = 2 * i + (lane >> 5); v[i] = (nr < N) ? W[(size_t)(k0 + kk) * N + nr] : 0.f; }
    if (kscale) {
#pragma unroll
        for (int i = 0; i < 32; ++i) v[i] *= kscale[k0 + 2 * i + (lane >> 5)];
    }
#pragma unroll
    for (int i = 0; i < 32; ++i) scr[(2 * i + (lane >> 5)) * 33 + (lane & 31)] = v[i];
    asm volatile("s_waitcnt lgkmcnt(0)" ::: "memory");
    const int c = lane & 7;
#pragma unroll
    for (int j = 0; j < 4; ++j) { const int nl = (lane >> 3) + 8 * j, n = n0 + nl;
        if (n < N) { const LAS float* s = scr + (8 * c) * 33 + nl;
            u32x4_t o; o.x = pk2(s[0 * 33], s[1 * 33]); o.y = pk2(s[2 * 33], s[3 * 33]); o.z = pk2(s[4 * 33], s[5 * 33]); o.w = pk2(s[6 * 33], s[7 * 33]);
            *(u32x4_t*)(WT + (size_t)rm(n) * K + k0 + 8 * c) = o; } }
    asm volatile("s_waitcnt lgkmcnt(0)" ::: "memory");
}
struct RmIdent { __device__ __forceinline__ int operator()(int n) const { return n; } };
struct RmWin {
    __device__ __forceinline__ int operator()(int c) const {
        const int nc = c < 2560 ? c : (c < 2608 ? 4608 + (c - 2560) : 2560 + (c - 2608));
        const int tile = nc >> 8, L = nc & 255, wc = L >> 6, bj = (L >> 5) & 1, j = L & 31;
        return tile * 256 + 128 * bj + 32 * wc + j;
    }
};
struct RmWup {
    __device__ __forceinline__ int operator()(int c) const { const int up = c >= D_FF, cc = up ? c - D_FF : c; return (cc >> 7) * 256 + up * 128 + (cc & 127); }
};

struct Ptrs {
    const float* in[18]; float* out; unsigned char* ws;
};

__device__ __forceinline__ void p0_prologue(const Ptrs& P, LAS unsigned char* lds, int vcu, int G, const int wave) {
    const int lane = fresh_lane();
    LAS float* scr = (LAS float*)(lds + wave * 16384);
    const int gw = vcu * NWAVES + wave, NGW = G * NWAVES;
    unsigned char* ws = P.ws;
    bf16_t* WinT = (bf16_t*)(ws + WS_WIN); bf16_t* WoutT = (bf16_t*)(ws + WS_WOUT); bf16_t* WupT = (bf16_t*)(ws + WS_WUP); bf16_t* WdownT = (bf16_t*)(ws + WS_WDOWN); bf16_t* W1cT = (bf16_t*)(ws + WS_W1C);
    const float* x = P.in[0]; const float* attn_norm_w = P.in[1]; const float* w_in = P.in[2]; const float* cmp_pos = P.in[5]; const float* cmp_w1 = P.in[6];
    const float* w_out = P.in[12]; const float* ffn_norm_w = P.in[13]; const float* w_up = P.in[14]; const float* w_down = P.in[17];
    constexpr int I_IN = 32 * 146, I_W1 = 32 * 8, I_W2 = 4 * 2;
    constexpr int NITEMS = I_IN + 2 * I_W1 + 2 * I_W2;
    (void)w_out; (void)w_up; (void)w_down; (void)ffn_norm_w; (void)WoutT; (void)WupT; (void)WdownT;
    for (int it = gw; it < NITEMS; it += NGW) {
        int r = it;
        if (r < I_IN) { transpose_item(w_in, 2048, IN_COLS, WinT, nullptr, RmWin(), scr, r, lane); continue; } r -= I_IN;
        if (r < I_W1) { transpose_item(cmp_w1, 2048, 256, W1cT, nullptr, RmIdent(), scr, r, lane); continue; } r -= I_W1;
        if (r < I_W1) { transpose_item(cmp_w1 + (size_t)2048 * 256, 2048, 256, W1cT + (size_t)256 * 2048, nullptr, RmIdent(), scr, r, lane); continue; } r -= I_W1;
        { const int kv = r >= I_W2 ? 1 : 0; transpose_item(P.in[7] + (size_t)kv * 256 * 64, 256, 64, (bf16_t*)(ws + WS_SMALL + SM_W2T) + (size_t)kv * 64 * 256, nullptr, RmIdent(), scr, r - kv * I_W2, lane); }
    }
    for (int i = gw * 64 + lane; i < 8 * 16384; i += NGW * 64) { const int t = (i >> 7) & 127, sx = i & 127; ((bf16_t*)(ws + WS_SMALL + SM_SWB))[i] = (bf16_t)(sx <= t ? f2bf(P.in[10][i]) : 0u); }
    for (int p = gw; p < 256; p += NGW) {
        const int L = 64 * ((p >> 5) & 3) + 32 * (p >> 7) + (p & 31);
        if (L >= 48) { u32x4_t z = {0u, 0u, 0u, 0u}; u32x4_t* d = (u32x4_t*)(WinT + (size_t)(18 * 256 + p) * 2048);
#pragma unroll
            for (int j = 0; j < 4; ++j) d[lane + 64 * j] = z; }
    }
    bf16_t* XN = (bf16_t*)(ws + WS_XN);
    for (int m = gw; m < MTOK; m += 2 * NGW) {
        const int m2 = m + NGW;
        const f32x4_t* xr = (const f32x4_t*)(x + (size_t)m * D_MODEL) + lane;
        const f32x4_t* xr2 = (const f32x4_t*)(x + (size_t)(m2 < MTOK ? m2 : m) * D_MODEL) + lane;
        f32x4_t v[8], v2[8]; float s = 0.f, s2 = 0.f;
#pragma unroll
        for (int j = 0; j < 8; ++j) { v[j] = xr[64 * j]; v2[j] = xr2[64 * j]; }
#pragma unroll
        for (int j = 0; j < 8; ++j) { s += (v[j][0] * v[j][0] + v[j][1] * v[j][1]) + (v[j][2] * v[j][2] + v[j][3] * v[j][3]); s2 += (v2[j][0] * v2[j][0] + v2[j][1] * v2[j][1]) + (v2[j][2] * v2[j][2] + v2[j][3] * v2[j][3]); }
        const float ms1 = wave_sum(s) * (1.0f / D_MODEL) + 1e-6f, ms2 = wave_sum(s2) * (1.0f / D_MODEL) + 1e-6f;
        const float r = __builtin_amdgcn_rsqf(ms1), r2 = __builtin_amdgcn_rsqf(ms2);
        if (lane == 0) { float* rinv = (float*)(ws + WS_SMALL + SM_RINV); rinv[m] = ms1 * r; if (m2 < MTOK) rinv[m2] = ms2 * r2; }
        u32x2_t* o8 = (u32x2_t*)(XN + (size_t)m * D_MODEL) + lane; u32x2_t* o82 = (u32x2_t*)(XN + (size_t)m2 * D_MODEL) + lane;
#pragma unroll
        for (int j = 0; j < 8; ++j) { const f32x4_t w = ((const f32x4_t*)attn_norm_w)[lane + 64 * j];
            u32x2_t o; o.x = pk2(v[j][0] * r * w[0], v[j][1] * r * w[1]); o.y = pk2(v[j][2] * r * w[2], v[j][3] * r * w[3]); o8[64 * j] = o;
            if (m2 < MTOK) { u32x2_t q; q.x = pk2(v2[j][0] * r2 * w[0], v2[j][1] * r2 * w[1]); q.y = pk2(v2[j][2] * r2 * w[2], v2[j][3] * r2 * w[3]); o82[64 * j] = q; } }
    }
    for (int i = gw * 64 + lane; i < D_MODEL; i += NGW * 64) ((float*)(ws + WS_SMALL + SM_INVW))[i] = 1.0f / attn_norm_w[i];
    float* BIASP = (float*)(ws + WS_SMALL + SM_BIASP);
    for (int it = gw; it < 64; it += NGW) {
        const int kv = it >> 5, kc = it & 31; f32x4_t a = {0.f, 0.f, 0.f, 0.f};
        const float* pp = cmp_pos + kv * 2048 + kc * 64; const float* w1 = cmp_w1 + ((size_t)kv * 2048 + kc * 64) * 256;
        for (int k = 0; k < 64; ++k) { const f32x4_t w = ((const f32x4_t*)(w1 + (size_t)k * 256))[lane]; a += w * pp[k]; }
        ((f32x4_t*)(BIASP + (size_t)it * 256))[lane] = a;
    }
}

__device__ __forceinline__ void bias1_stage(unsigned char* ws, int idx  ) {
    const float* BIASP = (const float*)(ws + WS_SMALL + SM_BIASP); float* BIAS1 = (float*)(ws + WS_SMALL + SM_BIAS1);
    const int kv = idx >> 8, j = idx & 255; float s = 0.f;
    for (int kc = 0; kc < 32; ++kc) s += BIASP[(size_t)(kv * 32 + kc) * 256 + j];
    BIAS1[idx] = s;
}
__device__ __forceinline__ void cmp2_row(const Ptrs& P, int R, int lane) {
    unsigned char* ws = P.ws; const bf16_t* HC = (const bf16_t*)(ws + WS_HC);
    const int kv = R >> 12, rr = R & 4095, n = rr & 255;
    bf16_t* dst = (bf16_t*)(ws + (kv ? WS_VC : WS_KC)) + (size_t)rr * 64 + lane;
    if (n == 255) { *dst = 0; return; }
    const float* w2 = P.in[7] + (size_t)kv * 256 * 64;
    const u32x2_t hr = *(const u32x2_t*)(HC + (size_t)R * 256 + 4 * lane);
    float h[4] = {__uint_as_float(hr.x << 16), __uint_as_float(hr.x & 0xffff0000u), __uint_as_float(hr.y << 16), __uint_as_float(hr.y & 0xffff0000u)};
    float o = 0.f;
    for (int jj = 0; jj < 64; ++jj) {
#pragma unroll
        for (int i = 0; i < 4; ++i) o += __shfl(h[i], jj) * w2[(size_t)(4 * jj + i) * 64 + lane];
    }
    if (kv == 0) { const float ss = wave_sum(o * o); o *= __builtin_amdgcn_rsqf(ss * (1.0f / 64.0f) + 1e-6f) * P.in[4][lane]; }
    *dst = (bf16_t)f2bf(o);
}

__device__ __forceinline__ void gmlp_unit_v1(const Ptrs& P, LAS unsigned char* lds, int unit, const int wave_s) {
    unsigned char* ws = P.ws; const int tid = fresh_tid(wave_s);
    const int g = unit & 7, chunk = (unit >> 3) & 31, b = unit >> 8; const int m0 = b * SEQ + chunk * 128;
    LAS float* vn = (LAS float*)lds; LAS float* Wl = (LAS float*)(lds + 65536); LAS float* st = (LAS float*)(lds + 131072);
    const bf16_t* GV = (const bf16_t*)(ws + WS_GV); const bf16_t* U = (const bf16_t*)(ws + WS_U); const float* VSTAT = (const float*)(ws + WS_VSTAT);
    bf16_t* AB = (bf16_t*)(ws + WS_AB);
    const float* ln_w = P.in[8]; const float* ln_b = P.in[9]; const float* sw = P.in[10]; const float* sb = P.in[11];
    if (tid < 128) { const float* p = VSTAT + (size_t)(m0 + tid) * 32; float s1 = 0.f, s2 = 0.f;
#pragma unroll
        for (int i = 0; i < 16; ++i) { s1 += p[2 * i]; s2 += p[2 * i + 1]; }
        const float mean = s1 * (1.0f / 1024.0f); float var = s2 * (1.0f / 1024.0f) - mean * mean; var = var < 0.f ? 0.f : var;
        st[2 * tid] = mean; st[2 * tid + 1] = __builtin_amdgcn_rsqf(var + 1e-5f); }
    for (int i = 0; i < 32; ++i) { const int idx = tid + 512 * i, t = idx >> 7, s = idx & 127; Wl[idx] = (s <= t) ? sw[(size_t)g * 16384 + idx] : 0.f; }
    __syncthreads();
#pragma unroll
    for (int i = 0; i < 4; ++i) { const int idx = tid + 512 * i, s = idx >> 4, c8 = idx & 15;
        const u32x4_t raw = *(const u32x4_t*)(GV + (size_t)(m0 + s) * 1024 + g * 128 + 8 * c8); float f[8]; unpack8(raw, f);
        const float mean = st[2 * s], rstd = st[2 * s + 1];
#pragma unroll
        for (int e = 0; e < 8; ++e) { const int c = g * 128 + 8 * c8 + e; vn[s * 128 + 8 * c8 + e] = (f[e] - mean) * rstd * ln_w[c] + ln_b[c]; } }
    __syncthreads();
    const int c = tid & 127, tq = tid >> 7;
    for (int i = 0; i < 8; ++i) {
        const int t0 = 4 * (tq + 4 * i); float a0 = 0.f, a1 = 0.f, a2 = 0.f, a3 = 0.f;
        for (int s4 = 0; s4 <= t0; s4 += 4) {
            const f32x4_t w0 = *(const LAS f32x4_t*)(Wl + (t0 + 0) * 128 + s4), w1 = *(const LAS f32x4_t*)(Wl + (t0 + 1) * 128 + s4), w2 = *(const LAS f32x4_t*)(Wl + (t0 + 2) * 128 + s4), w3 = *(const LAS f32x4_t*)(Wl + (t0 + 3) * 128 + s4);
#pragma unroll
            for (int k = 0; k < 4; ++k) { const float v = vn[(s4 + k) * 128 + c]; a0 += w0[k] * v; a1 += w1[k] * v; a2 += w2[k] * v; a3 += w3[k] * v; }
        }
        const float av[4] = {a0, a1, a2, a3};
#pragma unroll
        for (int k = 0; k < 4; ++k) { const int t = t0 + k; const size_t row = (size_t)(m0 + t);
            const float uu = bf2f(U[row * 1024 + g * 128 + c]); AB[row * 2048 + 1024 + g * 128 + c] = (bf16_t)f2bf(uu * (av[k] + sb[g * 128 + t])); }
    }
    __syncthreads();
}

__device__ __forceinline__ void conv_item(const Ptrs& P, int b, int idx) {
    const int t = idx / 704, c8 = idx % 704, c0 = 8 * c8, j = c0 >> 7, i0 = c0 & 127;
    const bf16_t* HID = (const bf16_t*)(P.ws + WS_HID); const float* cw = P.in[15]; const float* cb = P.in[16];
    float gt[8], up[8];
#pragma unroll
    for (int e = 0; e < 8; ++e) { gt[e] = cb[c0 + e]; up[e] = cb[D_FF + c0 + e]; }
#pragma unroll
    for (int k = 0; k < 3; ++k) { const int tt = t - 2 + k; if (tt < 0) continue;
        float hg[8], hu[8]; unpack8(*(const u32x4_t*)(HID + (size_t)tt * N_UP + 256 * j + i0), hg); unpack8(*(const u32x4_t*)(HID + (size_t)tt * N_UP + 256 * j + 128 + i0), hu);
#pragma unroll
        for (int e = 0; e < 8; ++e) { gt[e] += cw[(size_t)k * N_UP + c0 + e] * hg[e]; up[e] += cw[(size_t)k * N_UP + D_FF + c0 + e] * hu[e]; } }
    float r[8];
#pragma unroll
    for (int e = 0; e < 8; ++e) r[e] = gt[e] * sigmoidf_(gt[e]) * up[e];
    u32x4_t o; o.x = pk2(r[0], r[1]); o.y = pk2(r[2], r[3]); o.z = pk2(r[4], r[5]); o.w = pk2(r[6], r[7]);
    *(u32x4_t*)((bf16_t*)(P.ws + WS_G) + ((size_t)b * SEQ + t) * D_FF + c0) = o;
}

constexpr int LW_CH = 32;
constexpr int LW_OUT = 32 * 64, LW_UP = 32 * 352, LW_DOWN = 88 * 64, LW_C_OUT = LW_OUT / LW_CH, LW_C_UP = LW_UP / LW_CH, LW_C_DOWN = LW_DOWN / LW_CH, LW_CHUNKS = LW_C_OUT + LW_C_UP + LW_C_DOWN;
static_assert(LW_OUT % LW_CH == 0 && LW_UP % LW_CH == 0 && LW_DOWN % LW_CH == 0, "late weight items per chunk");
template <class RowMap>
__device__ __forceinline__ void lw_load(float (&v)[32], const float* __restrict__ W, int N, int item, int lane) {
    const int nblk = N / 32, kb = item / nblk, nb = item % nblk;
    const float* p = W + (size_t)(64 * kb + (lane >> 5)) * N + 32 * nb + (lane & 31);
#pragma unroll
    for (int i = 0; i < 32; ++i) v[i] = p[(size_t)(2 * i) * N];
}
template <class RowMap>
__device__ __forceinline__ void lw_store(const float (&v)[32], int K, int N, bf16_t* WT, const float* __restrict__ kscale, RowMap rm, LAS float* scr, int item, int lane) {
    const int nblk = N / 32, kb = item / nblk, nb = item % nblk, k0 = 64 * kb, n0 = 32 * nb;
    const int c = lane & 7;
    f32x4_t sc0 = {1.f, 1.f, 1.f, 1.f}, sc1 = sc0;
    if (kscale) { sc0 = *(const f32x4_t*)(kscale + k0 + 8 * c); sc1 = *(const f32x4_t*)(kscale + k0 + 8 * c + 4); }
#pragma unroll
    for (int i = 0; i < 32; ++i) scr[(2 * i + (lane >> 5)) * 33 + (lane & 31)] = v[i];
    asm volatile("s_waitcnt lgkmcnt(0)" ::: "memory");
#pragma unroll
    for (int j = 0; j < 4; ++j) { const int nl = (lane >> 3) + 8 * j; const LAS float* s = scr + (8 * c) * 33 + nl;
        u32x4_t o; o.x = pk2(s[0 * 33] * sc0[0], s[1 * 33] * sc0[1]); o.y = pk2(s[2 * 33] * sc0[2], s[3 * 33] * sc0[3]); o.z = pk2(s[4 * 33] * sc1[0], s[5 * 33] * sc1[1]); o.w = pk2(s[6 * 33] * sc1[2], s[7 * 33] * sc1[3]);
        *(u32x4_t*)(WT + (size_t)rm(n0 + nl) * K + k0 + 8 * c) = o; }
    asm volatile("s_waitcnt lgkmcnt(0)" ::: "memory");
}
template <class RowMap>
__device__ __forceinline__ void lw_run(const float* __restrict__ W, int K, int N, bf16_t* WT, const float* __restrict__ kscale, RowMap rm, LAS float* scr, int item0, int wave, int lane) {
    float va[32], vb[32];
    lw_load<RowMap>(va, W, N, item0 + wave, lane);
    lw_load<RowMap>(vb, W, N, item0 + wave + 8, lane);  lw_store(va, K, N, WT, kscale, rm, scr, item0 + wave, lane);
    lw_load<RowMap>(va, W, N, item0 + wave + 16, lane); lw_store(vb, K, N, WT, kscale, rm, scr, item0 + wave + 8, lane);
    lw_load<RowMap>(vb, W, N, item0 + wave + 24, lane); lw_store(va, K, N, WT, kscale, rm, scr, item0 + wave + 16, lane);
    lw_store(vb, K, N, WT, kscale, rm, scr, item0 + wave + 24, lane);
}
__device__ __forceinline__ void late_weight_chunk(const Ptrs& P, LAS unsigned char* lds, int chunk, const int wave) {
    const int lane = fresh_lane();
    LAS float* scr = (LAS float*)(lds + wave * 16384);
    unsigned char* ws = P.ws;
    if (chunk < LW_C_UP) lw_run(P.in[14], 2048, N_UP, (bf16_t*)(ws + WS_WUP), P.in[13], RmWup(), scr, chunk * LW_CH, wave, lane);
    else if (chunk < LW_C_UP + LW_C_DOWN) lw_run(P.in[17], D_FF, 2048, (bf16_t*)(ws + WS_WDOWN), nullptr, RmIdent(), scr, (chunk - LW_C_UP) * LW_CH, wave, lane);
    else lw_run(P.in[12], 2048, 2048, (bf16_t*)(ws + WS_WOUT), nullptr, RmIdent(), scr, (chunk - LW_C_UP - LW_C_DOWN) * LW_CH, wave, lane);
}

namespace nsa {
using bf16x8 = __attribute__((ext_vector_type(8))) short;
using s16x4 = __attribute__((ext_vector_type(4))) short;
using f32x16 = __attribute__((ext_vector_type(16))) float;
typedef float f32x2_t __attribute__((ext_vector_type(2))); typedef __bf16 bf16x2_t __attribute__((ext_vector_type(2)));
constexpr int L_K = 0, L_V = 16384, L_WSF = 32768, L_OST = 34816, L_IMP = 100352, L_MASK = 116736, L_WU = 117248, L_END = 117312;
constexpr int SLOTB = 8192;
constexpr float THR = 8.0f;
#define NSA_SBAR() __builtin_amdgcn_sched_barrier(0)
__device__ __forceinline__ int crow(int r, int hi) { return (r & 3) + 8 * (r >> 2) + 4 * hi; }
__device__ __forceinline__ void glds16(const void* gbase  , unsigned voff  , unsigned lds_dst) { unsigned keep;
    asm volatile("s_mov_b32 %0, m0\n\ts_mov_b32 m0, %3\n\ts_nop 0\n\tglobal_load_lds_dwordx4 %1, %2\n\ts_mov_b32 m0, %0" : "=&s"(keep) : "v"(voff), "s"(gbase), "s"(lds_dst) : "memory"); }
__device__ __forceinline__ unsigned cvtpk_s(float lo, float hi) { f32x2_t v = {lo, hi}; bf16x2_t b = __builtin_convertvector(v, bf16x2_t); return __builtin_bit_cast(unsigned, b); }
#define NSA_WAIT_BAR() asm volatile("s_waitcnt vmcnt(0) lgkmcnt(0)\n\ts_barrier" ::: "memory")

__device__ __forceinline__ void qkt(f32x16& p0, f32x16& p1, LAS const char* Kslot, const bf16x8 (&qr)[4], int r32, int hi) {
    LAS const char* kb = Kslot + hi * 1024 + r32 * 16;
#pragma unroll
    for (int d0 = 0; d0 < 4; ++d0) {
        const bf16x8 b0 = *(LAS const bf16x8*)(kb + d0 * 2048);
        const bf16x8 b1 = *(LAS const bf16x8*)(kb + d0 * 2048 + 512);
        p0 = __builtin_amdgcn_mfma_f32_32x32x16_bf16(b0, qr[d0], p0, 0, 0, 0); p1 = __builtin_amdgcn_mfma_f32_32x32x16_bf16(b1, qr[d0], p1, 0, 0, 0);
    }
}
struct VFrag { s16x4 lo[2][4], hi[2][4]; };
__device__ __forceinline__ void vload(VFrag& f, int vb) {
#pragma unroll
    for (int d0 = 0; d0 < 2; ++d0)
#pragma unroll
        for (int ks = 0; ks < 4; ++ks) {
            asm volatile("ds_read_b64_tr_b16 %0,%1 offset:%c2" : "=&v"(f.lo[d0][ks]) : "v"(vb), "i"(d0 * 4096 + ks * 1024) : "memory");
            asm volatile("ds_read_b64_tr_b16 %0,%1 offset:%c2" : "=&v"(f.hi[d0][ks]) : "v"(vb), "i"(d0 * 4096 + ks * 1024 + 512) : "memory"); }
}
__device__ __forceinline__ void pvmma(f32x16 (&o)[2], VFrag& f, bf16x8 pa0, bf16x8 pa1, bf16x8 pa2, bf16x8 pa3) {
    asm volatile("s_waitcnt lgkmcnt(0)" : "+v"(f.lo[0][0]), "+v"(f.lo[0][1]), "+v"(f.lo[0][2]), "+v"(f.lo[0][3]), "+v"(f.hi[0][0]), "+v"(f.hi[0][1]), "+v"(f.hi[0][2]), "+v"(f.hi[0][3]) :: "memory");
    asm volatile("" : "+v"(f.lo[1][0]), "+v"(f.lo[1][1]), "+v"(f.lo[1][2]), "+v"(f.lo[1][3]), "+v"(f.hi[1][0]), "+v"(f.hi[1][1]), "+v"(f.hi[1][2]), "+v"(f.hi[1][3]));
    NSA_SBAR();
#pragma unroll
    for (int d0 = 0; d0 < 2; ++d0) {
#define NSA_PK(k) (bf16x8){f.lo[d0][k][0], f.lo[d0][k][1], f.lo[d0][k][2], f.lo[d0][k][3], f.hi[d0][k][0], f.hi[d0][k][1], f.hi[d0][k][2], f.hi[d0][k][3]}
        o[d0] = __builtin_amdgcn_mfma_f32_32x32x16_bf16(pa0, NSA_PK(0), o[d0], 0, 0, 0);
        o[d0] = __builtin_amdgcn_mfma_f32_32x32x16_bf16(pa1, NSA_PK(1), o[d0], 0, 0, 0);
        o[d0] = __builtin_amdgcn_mfma_f32_32x32x16_bf16(pa2, NSA_PK(2), o[d0], 0, 0, 0);
        o[d0] = __builtin_amdgcn_mfma_f32_32x32x16_bf16(pa3, NSA_PK(3), o[d0], 0, 0, 0);
#undef NSA_PK
    }
}
__device__ __forceinline__ void pv(f32x16 (&o)[2], int vb, bf16x8 pa0, bf16x8 pa1, bf16x8 pa2, bf16x8 pa3) { VFrag f; vload(f, vb); pvmma(o, f, pa0, pa1, pa2, pa3); }
__device__ __forceinline__ float rowmax32(const f32x16& p0, const f32x16& p1) {
    float a = __builtin_fmaxf(p0[0], p1[0]);
#pragma unroll
    for (int r = 1; r < 16; ++r) a = __builtin_fmaxf(a, __builtin_fmaxf(p0[r], p1[r]));
    auto rr = __builtin_amdgcn_permlane32_swap(__float_as_uint(a), __float_as_uint(a), false, false);
    return __builtin_fmaxf(__uint_as_float(rr[0]), __uint_as_float(rr[1]));
}
struct State { float m, l; f32x16 o[2]; };
__device__ __forceinline__ void state_init(State& s) { s.m = -1e30f; s.l = 0.f; s.o[0] = f32x16{}; s.o[1] = f32x16{}; }

template <int BMUL, int MASK, bool LOADV>
__device__ __forceinline__ void tile_scores(f32x16& p0, f32x16& p1, LAS const char* Kslot, const bf16x8 (&qr)[4], const f32x16& bk, float c0, float b32, int lim, int r32, int hi, VFrag& vf, int vb) {
#pragma unroll
    for (int r = 0; r < 16; ++r) { const float b = (BMUL == 1) ? bk[r] + c0 : __builtin_fmaf(bk[r], (float)BMUL, c0); p0[r] = b; p1[r] = b + b32; }
    qkt(p0, p1, Kslot, qr, r32, hi);
    if (LOADV) vload(vf, vb);
    const int limh = lim - 4 * hi;
#pragma unroll
    for (int r = 0; r < 16; ++r) {
        const int kk = (r & 3) + 8 * (r >> 2);
        if (MASK == 1) { if (!(kk <= limh)) p0[r] = -INFINITY; if (!(kk + 32 <= limh)) p1[r] = -INFINITY; }
        if (MASK == 2) { if (!(kk > limh)) p0[r] = -INFINITY; if (!(kk + 32 > limh)) p1[r] = -INFINITY; }
        if (MASK == 3) { if (!(kk < limh)) p0[r] = -INFINITY; if (!(kk + 32 < limh)) p1[r] = -INFINITY; }
    }
}
__device__ __forceinline__ float tile_ref(const State& st, float rb0, bool rowlive) { return (st.m < -1e29f && rowlive) ? rb0 : st.m; }
__device__ __forceinline__ void tile_softmax_pv(State& st, f32x16& p0, f32x16& p1, float mref, VFrag& vf, LAS float* wsf, int r32, int hi) {
    float a0 = p0[0], a1 = p1[0];
#pragma unroll
    for (int r = 1; r < 16; ++r) { a0 = __builtin_fmaxf(a0, p0[r]); a1 = __builtin_fmaxf(a1, p1[r]); }
    float mx = __builtin_fmaxf(a0, a1);
    { auto rr = __builtin_amdgcn_permlane32_swap(__float_as_uint(mx), __float_as_uint(mx), false, false); mx = __builtin_fmaxf(__uint_as_float(rr[0]), __uint_as_float(rr[1])); }
    if (__any(mx > THR)) {
        const float dl = __builtin_fmaxf(mx, 0.f), alpha = __builtin_amdgcn_exp2f(-dl);
        mref += dl; st.l *= alpha;
        if (hi == 0) wsf[r32] = alpha;
        asm volatile("s_waitcnt lgkmcnt(0)" ::: "memory");
#pragma unroll
        for (int r = 0; r < 16; ++r) { const float a = wsf[crow(r, hi)]; st.o[0][r] *= a; st.o[1][r] *= a; p0[r] -= dl; p1[r] -= dl; }
    }
    st.m = mref;
    float ls = 0.f;
#pragma unroll
    for (int r = 0; r < 16; ++r) { p0[r] = __builtin_amdgcn_exp2f(p0[r]); p1[r] = __builtin_amdgcn_exp2f(p1[r]); ls += p0[r] + p1[r]; }
    st.l += ls;
    u32x4_t pw0, pw1, pw2, pw3;
    pw0 = (u32x4_t){cvtpk_s(p0[0], p0[1]), cvtpk_s(p0[2], p0[3]), cvtpk_s(p0[4], p0[5]), cvtpk_s(p0[6], p0[7])};
    pw1 = (u32x4_t){cvtpk_s(p0[8], p0[9]), cvtpk_s(p0[10], p0[11]), cvtpk_s(p0[12], p0[13]), cvtpk_s(p0[14], p0[15])};
    pw2 = (u32x4_t){cvtpk_s(p1[0], p1[1]), cvtpk_s(p1[2], p1[3]), cvtpk_s(p1[4], p1[5]), cvtpk_s(p1[6], p1[7])};
    pw3 = (u32x4_t){cvtpk_s(p1[8], p1[9]), cvtpk_s(p1[10], p1[11]), cvtpk_s(p1[12], p1[13]), cvtpk_s(p1[14], p1[15])};
    pvmma(st.o, vf, __builtin_bit_cast(bf16x8, pw0), __builtin_bit_cast(bf16x8, pw1), __builtin_bit_cast(bf16x8, pw2), __builtin_bit_cast(bf16x8, pw3));
}
template <bool FIRST>
__device__ __forceinline__ void fold_branch(LAS float* ostg, State& st, float gate, LAS float* wsf, int r32, int hi) {
    float l = st.l;
    { auto rr = __builtin_amdgcn_permlane32_swap(__float_as_uint(l), __float_as_uint(l), false, false); l = __uint_as_float(rr[0]) + __uint_as_float(rr[1]); }
    const float f = l > 0.f ? gate / l : 0.f;
    asm volatile("s_waitcnt lgkmcnt(0)" ::: "memory");
    if (hi == 0) wsf[r32] = f;
    asm volatile("s_waitcnt lgkmcnt(0)" ::: "memory");
#pragma unroll
    for (int r = 0; r < 16; ++r) { const int orow = crow(r, hi); const float a = wsf[orow];
#pragma unroll
        for (int d0 = 0; d0 < 2; ++d0) { LAS float* p = ostg + orow * 64 + d0 * 32 + r32; if (FIRST) *p = st.o[d0][r] * a; else *p += st.o[d0][r] * a; } }
    asm volatile("s_waitcnt lgkmcnt(0)" ::: "memory");
}

__device__ __forceinline__ int nsa_unit(const Ptrs& P, LAS unsigned char* lds, int bg, int qt, const int wave_s, unsigned* qctr, int qbase) {
    unsigned char* ws = P.ws;
    const int lane = fresh_lane(), r32 = lane & 31, hi = lane >> 5; const int wid = wave_s;
    const int b = bg >> 2, g = bg & 3, t0 = 64 * qt;
    const int tl = 8 * wid + (r32 >> 2), hq = r32 & 3;
    const size_t m0 = (size_t)b * SEQ + t0;
    const bf16_t* Q = (const bf16_t*)(ws + WS_Q); const bf16_t* KV6 = (const bf16_t*)(ws + WS_KV6);
    const bf16_t* KSb = KV6 + 2 * KVSZ + (size_t)bg * SEQ * 64; const bf16_t* VSb = KV6 + 3 * KVSZ + (size_t)bg * SEQ * 64;
    const bf16_t* KWb = KV6 + 4 * KVSZ + (size_t)bg * SEQ * 64; const bf16_t* VWb = KV6 + 5 * KVSZ + (size_t)bg * SEQ * 64;
    const bf16_t* KCb = (const bf16_t*)(ws + WS_KC) + (size_t)bg * 256 * 64; const bf16_t* VCb = (const bf16_t*)(ws + WS_VC) + (size_t)bg * 256 * 64;
    const float* GATES = (const float*)(ws + WS_GATES); bf16_t* AB = (bf16_t*)(ws + WS_AB);
    const unsigned lds0 = (unsigned)(uintptr_t)lds;
    LAS float* wsf = (LAS float*)(lds + L_WSF) + wid * 64;
    LAS float* IMP = (LAS float*)(lds + L_IMP);
    LAS unsigned* MASK = (LAS unsigned*)(lds + L_MASK); LAS unsigned* WU = (LAS unsigned*)(lds + L_WU);
    const int koff = lane * 64 + wid * 8, voff = (16 * (wid & 3) + (lane >> 2)) * 64 + (wid >> 2) * 32 + (lane & 3) * 8;
    const unsigned kdst = lds0 + L_K + wid * 1024, vdst = lds0 + L_V + wid * 1024;
#define NSA_DMA_K(base, tile, slot) glds16((base) + (size_t)(tile) * 4096, (unsigned)koff * 2u, (unsigned)__builtin_amdgcn_readfirstlane(kdst + (slot) * SLOTB))
#define NSA_DMA_V(base, tile, slot) glds16((base) + (size_t)(tile) * 4096, (unsigned)voff * 2u, (unsigned)__builtin_amdgcn_readfirstlane(vdst + (slot) * SLOTB))
    const int vb0 = (int)(lds0 + L_V) + ((lane >> 4) & 1) * 32 + (lane & 3) * 8 + (4 * hi + ((lane & 15) >> 2)) * 64;
    LAS const char* Kbase = (LAS const char*)(lds + L_K);
    bf16x8 qr[4];
    { const bf16_t* qp = Q + (m0 + tl) * 1024 + (4 * g + hq) * 64 + hi * 8;
#pragma unroll
      for (int d0 = 0; d0 < 4; ++d0) qr[d0] = *(const bf16x8*)(qp + d0 * 16); }
    const float sl2 = __builtin_amdgcn_exp2f(-0.5f * (float)(4 * g + hq + 1)) * LOG2E;
    f32x16 bk;
#pragma unroll
    for (int r = 0; r < 16; ++r) bk[r] = sl2 * (float)((r & 3) + 8 * (r >> 2));
    const float b32t = 32.0f * sl2, b32c = 512.0f * sl2, hoff_t = 4.0f * (float)hi * sl2, hoff_c = 64.0f * (float)hi * sl2;
    float gate[3];
    { const float* gp = GATES + (m0 + tl) * 48 + (4 * g + hq) * 3; gate[0] = gp[0]; gate[1] = gp[1]; gate[2] = gp[2]; }
    LAS float* ostg = (LAS float*)(lds + L_OST) + wid * 2048;
    State st;
    f32x16 p0, p1;
    int nxt_ticket = 0;

    int tc = 0;
    VFrag vf;
    const int nvmax = (t0 + 63 >= 31) ? ((t0 + 63 - 31) >> 4) + 1 : 0;
    const int nct = (nvmax + 63) >> 6;
    const int tq = t0 + tl, nv = tq >= 31 ? ((tq - 31) >> 4) + 1 : 0;
    {
        state_init(st);
        const int j0 = qt >= 8 ? qt - 8 : 0, nt = qt - j0 + 1;
        NSA_DMA_K(KWb, qt, 0); NSA_DMA_V(VWb, qt, 0); NSA_WAIT_BAR();
        for (int i = 0; i < nt; ++i) {
            const int j = qt - i, slot = (tc + i) & 1;
            if (i + 1 < nt) { NSA_DMA_K(KWb, j - 1, slot ^ 1); NSA_DMA_V(VWb, j - 1, slot ^ 1); }
            else { NSA_DMA_K(KCb, nct - 1, slot ^ 1); NSA_DMA_V(VCb, nct - 1, slot ^ 1); }
            const float rb0 = sl2 * (float)(64 * j - t0), mref = tile_ref(st, rb0, true), c0 = rb0 + hoff_t - mref;
            if (j == qt) tile_scores<1, 1, true>(p0, p1, Kbase + slot * SLOTB, qr, bk, c0, b32t, tl, r32, hi, vf, vb0 + slot * SLOTB);
            else if (j == qt - 8) tile_scores<1, 2, true>(p0, p1, Kbase + slot * SLOTB, qr, bk, c0, b32t, tl, r32, hi, vf, vb0 + slot * SLOTB);
            else tile_scores<1, 0, true>(p0, p1, Kbase + slot * SLOTB, qr, bk, c0, b32t, 0, r32, hi, vf, vb0 + slot * SLOTB);
            tile_softmax_pv(st, p0, p1, mref, vf, wsf, r32, hi);
            NSA_WAIT_BAR();
        }
        tc += nt;
        fold_branch<true>(ostg, st, gate[2], wsf, r32, hi);
    }
    {
        state_init(st);
        for (int ci = 0; ci < nct; ++ci) {
            const int c = nct - 1 - ci, slot = (tc + ci) & 1;
            if (ci + 1 < nct) { NSA_DMA_K(KCb, c - 1, slot ^ 1); NSA_DMA_V(VCb, c - 1, slot ^ 1); }
            else if (qt >= 16) { NSA_DMA_K(KCb, 0, slot ^ 1); }
            else { NSA_DMA_K(KSb, qt, slot ^ 1); NSA_DMA_V(VSb, qt, slot ^ 1); }
            const float rb0 = sl2 * ((float)(1024 * c - t0) + 15.5f), mref = tile_ref(st, rb0, true), c0 = rb0 + hoff_c - mref;
            tile_scores<16, 3, true>(p0, p1, Kbase + slot * SLOTB, qr, bk, c0, b32c, nv - 64 * c, r32, hi, vf, vb0 + slot * SLOTB);
            tile_softmax_pv(st, p0, p1, mref, vf, wsf, r32, hi);
            NSA_WAIT_BAR();
        }
        tc += nct;
    }
    const float mc_fin = st.m; float lc = st.l;
    fold_branch<false>(ostg, st, gate[0], wsf, r32, hi);
    if (qt >= 16) {
        { auto rr = __builtin_amdgcn_permlane32_swap(__float_as_uint(lc), __float_as_uint(lc), false, false); lc = __uint_as_float(rr[0]) + __uint_as_float(rr[1]); }
        const float invl = lc > 0.f ? 1.0f / lc : 0.f;
        float carry = 0.f;
        for (int c = 0; c < nct; ++c) {
            const int slot = (tc + c) & 1;
            if (c + 1 < nct) { NSA_DMA_K(KCb, c + 1, slot ^ 1); }
            else { NSA_DMA_K(KSb, qt, slot ^ 1); NSA_DMA_V(VSb, qt, slot ^ 1); }
            const float c0 = sl2 * ((float)(1024 * c - t0) + 15.5f) + hoff_c - mc_fin;
            tile_scores<16, 3, false>(p0, p1, Kbase + slot * SLOTB, qr, bk, c0, b32c, nv - 64 * c, r32, hi, vf, 0);
#pragma unroll
            for (int r = 0; r < 16; ++r) { p0[r] = __builtin_amdgcn_exp2f(p0[r]) * invl; p1[r] = __builtin_amdgcn_exp2f(p1[r]) * invl; }
            float imp0[4], imp1[4], pl0[4], pl1[4];
#pragma unroll
            for (int a = 0; a < 4; ++a) {
                imp0[a] = (p0[4 * a] + p0[4 * a + 1]) + (p0[4 * a + 2] + p0[4 * a + 3]); imp1[a] = (p1[4 * a] + p1[4 * a + 1]) + (p1[4 * a + 2] + p1[4 * a + 3]);
                pl0[a] = __shfl_xor(p0[4 * a + 3], 32); pl1[a] = __shfl_xor(p1[4 * a + 3], 32);
            }
            if (hi) {
#pragma unroll
                for (int a = 0; a < 4; ++a) { imp0[a] += pl0[a]; imp1[a] += pl1[a]; }
            } else {
                imp0[0] += carry; imp1[0] += pl0[3];
#pragma unroll
                for (int a = 1; a < 4; ++a) { imp0[a] += pl0[a - 1]; imp1[a] += pl1[a - 1]; }
            }
            carry = pl1[3];
#pragma unroll
            for (int a = 0; a < 4; ++a) {
                imp0[a] += __shfl_xor(imp0[a], 1); imp0[a] += __shfl_xor(imp0[a], 2); imp1[a] += __shfl_xor(imp1[a], 1); imp1[a] += __shfl_xor(imp1[a], 2);
                if (hq == 0) { IMP[tl * 64 + 16 * c + 2 * a + hi] = imp0[a]; IMP[tl * 64 + 16 * c + 8 + 2 * a + hi] = imp1[a]; }
            }
            NSA_WAIT_BAR();
        }
        tc += nct;
    }
    unsigned long long wu = 0ull;
    if (qt < 16) {
        wu = (2ull << qt) - 1ull;
        if (lane < 8) { MASK[2 * (8 * wid + lane)] = (unsigned)wu; MASK[2 * (8 * wid + lane) + 1] = (unsigned)(wu >> 32); }
    } else {
        const int j = lane; const bool valid = j <= qt, forced = (j == 0) || (j == qt) || (j == qt - 1);
        for (int k = 0; k < 8; ++k) {
            const float imp = IMP[(8 * wid + k) * 64 + j];
            const float scv = valid ? (forced ? 1e9f : imp) : -1e9f;
            const unsigned fb = __float_as_uint(scv), key = fb ^ ((fb >> 31) ? 0xffffffffu : 0x80000000u);
            unsigned T = 0u;
#pragma unroll
            for (int bit = 31; bit >= 0; --bit) { const unsigned cand = T | (1u << bit); if (__builtin_popcountll(__ballot(key >= cand)) >= 16) T = cand; }
            const unsigned long long gt = __ballot(key > T), eq = __ballot(key == T);
            const int need = 16 - __builtin_popcountll(gt);
            const int before = (int)__builtin_amdgcn_mbcnt_hi((unsigned)(eq >> 32), __builtin_amdgcn_mbcnt_lo((unsigned)eq, 0u));
            const bool sel = (key > T) || ((key == T) && (before < need));
            const unsigned long long mk = __ballot(sel && (scv > -0.5e9f));
            wu |= mk;
            if (lane == 0) { MASK[2 * (8 * wid + k)] = (unsigned)mk; MASK[2 * (8 * wid + k) + 1] = (unsigned)(mk >> 32); }
        }
    }
    if (lane == 0) { WU[2 * wid] = (unsigned)wu; WU[2 * wid + 1] = (unsigned)(wu >> 32); }
    NSA_WAIT_BAR();
    unsigned long long uni = 0ull;
#pragma unroll
    for (int w = 0; w < 8; ++w) uni |= ((unsigned long long)WU[2 * w]) | (((unsigned long long)WU[2 * w + 1]) << 32);
    uni = ((unsigned long long)__builtin_amdgcn_readfirstlane((unsigned)uni)) | (((unsigned long long)__builtin_amdgcn_readfirstlane((unsigned)(uni >> 32))) << 32);
    const unsigned long long mymask = ((unsigned long long)MASK[2 * tl]) | (((unsigned long long)MASK[2 * tl + 1]) << 32);
    {
        state_init(st);
        unsigned long long rem = uni;
        int j = 63 - __builtin_clzll(rem); rem &= ~(1ull << j);
        for (int i = 0;; ++i) {
            const int slot = (tc + i) & 1; const bool more = rem != 0ull;
            int jn = 0;
            if (more) { jn = 63 - __builtin_clzll(rem); rem &= ~(1ull << jn); NSA_DMA_K(KSb, jn, slot ^ 1); NSA_DMA_V(VSb, jn, slot ^ 1); }
            if ((wu >> j) & 1ull) {
                const bool live = ((mymask >> j) & 1ull) != 0ull;
                const float rb0 = sl2 * (float)(64 * j - t0), mref = tile_ref(st, rb0, live), c0 = live ? rb0 + hoff_t - mref : -INFINITY;
                if (j == qt) tile_scores<1, 1, true>(p0, p1, Kbase + slot * SLOTB, qr, bk, c0, b32t, tl, r32, hi, vf, vb0 + slot * SLOTB);
                else tile_scores<1, 0, true>(p0, p1, Kbase + slot * SLOTB, qr, bk, c0, b32t, 0, r32, hi, vf, vb0 + slot * SLOTB);
                tile_softmax_pv(st, p0, p1, mref, vf, wsf, r32, hi);
            }
            NSA_WAIT_BAR();
            if (!more) break;
            j = jn;
        }
        if (wid == 0 && lane == 0) nxt_ticket = qbase + (int)__hip_atomic_fetch_add(qctr, 1u, __ATOMIC_RELAXED, __HIP_MEMORY_SCOPE_AGENT);
        fold_branch<false>(ostg, st, gate[1], wsf, r32, hi);
    }
    {
#pragma unroll
        for (int i = 0; i < 4; ++i) { const int row = i * 8 + (lane >> 3), ch = lane & 7;
            const f32x4_t v0 = *(LAS const f32x4_t*)(ostg + row * 64 + ch * 8), v1 = *(LAS const f32x4_t*)(ostg + row * 64 + ch * 8 + 4);
            u32x4_t v; v.x = cvtpk_s(v0[0], v0[1]); v.y = cvtpk_s(v0[2], v0[3]); v.z = cvtpk_s(v1[0], v1[1]); v.w = cvtpk_s(v1[2], v1[3]);
            *(u32x4_t*)(AB + (m0 + 8 * wid + (row >> 2)) * 2048 + 256 * g + (row & 3) * 64 + ch * 8) = v; }
    }
    NSA_WAIT_BAR();
#undef NSA_DMA_K
#undef NSA_DMA_V
    return nxt_ticket;
}
constexpr int L_QS = 145416;
__device__ __forceinline__ void nsa_phase(const Ptrs& P, LAS unsigned char* lds, int bid, int G, const int wave_s) {
    unsigned* qctr = (unsigned*)(P.ws + WS_CTL) + 3584;
    LAS int* qs = (LAS int*)(lds + L_QS);
    int k = bid;
    while (k < 1024 + LW_CHUNKS) {
        int nxt;
        if (k < 1024) {
            const int qt = 63 - (k >> 4), g = 3 - ((k >> 2) & 3), b = k & 3;
            nxt = nsa_unit(P, lds, b * 4 + g, qt, wave_s, qctr, G);
        } else {
            nxt = 0;
            if (wave_s == 0 && fresh_lane() == 0) nxt = G + (int)__hip_atomic_fetch_add(qctr, 1u, __ATOMIC_RELAXED, __HIP_MEMORY_SCOPE_AGENT);
            late_weight_chunk(P, lds, k - 1024, wave_s);
        }
        if (wave_s == 0 && fresh_lane() == 0) *qs = nxt;
        NSA_WAIT_BAR();
        k = __builtin_amdgcn_readfirstlane(*qs);
    }
}
}

namespace p2 {
using nsa::bf16x8; using nsa::f32x16; using nsa::s16x4; using nsa::crow; using nsa::glds16; using nsa::cvtpk_s;
#define P2_WAIT_BAR() asm volatile("s_waitcnt vmcnt(0) lgkmcnt(0)\n\ts_barrier" ::: "memory")
constexpr int CB_BUF = 40960;
constexpr int CP_STRIDE = 65;
__device__ __forceinline__ void compress_unit(const Ptrs& P, LAS unsigned char* lds, int u, const int wave_s) {
    unsigned char* ws = P.ws;
    const int lane = fresh_lane(), r32 = lane & 31, hi = lane >> 5, wid = wave_s;
    const int kv = u >> 6, bg = (u >> 2) & 15, n0 = 64 * (u & 3);
    const bf16_t* Ag = (const bf16_t*)(ws + WS_KV6) + (size_t)kv * KVSZ + (size_t)bg * SEQ * 64 + (size_t)n0 * 1024;
    const bf16_t* Bg = (const bf16_t*)(ws + WS_W1C) + (size_t)kv * 256 * 2048;
    const unsigned lds0 = (unsigned)(uintptr_t)lds;
    const unsigned aoff = (unsigned)(lane * 1024 + wid * 8) * 2u, boff = (unsigned)(lane * 2048 + wid * 8) * 2u;
    const unsigned dstw = lds0 + wid * 1024;
#define P2_DMA_TILE(kt, buf) do { const unsigned d_ = (unsigned)__builtin_amdgcn_readfirstlane(dstw + (buf) * CB_BUF); \
        glds16(Ag + (kt) * 64, aoff, d_); \
        _Pragma("unroll") for (int ct_ = 0; ct_ < 4; ++ct_) glds16(Bg + (size_t)ct_ * 64 * 2048 + (kt) * 64, boff, d_ + 8192u * (ct_ + 1)); } while (0)
    const int ct = wid >> 1, half = wid & 1, ncol0 = 64 * ct + 32 * half;
    f32x16 hT[2]; hT[0] = f32x16{}; hT[1] = f32x16{};
    P2_DMA_TILE(0, 0); P2_DMA_TILE(1, 1);
    asm volatile("s_waitcnt vmcnt(5) lgkmcnt(0)\n\ts_barrier" ::: "memory");
    for (int kt = 0; kt < 32; ++kt) {
        const int buf = kt % 3;
        if (kt + 2 < 32) P2_DMA_TILE(kt + 2, (kt + 2) % 3);
        LAS const char* sa = (LAS const char*)(lds + buf * CB_BUF) + hi * 1024 + r32 * 16;
        LAS const char* sb = (LAS const char*)(lds + buf * CB_BUF + 8192 * (ct + 1)) + half * 512 + hi * 1024 + r32 * 16;
#pragma unroll
        for (int d0 = 0; d0 < 4; ++d0) {
            const bf16x8 bf = *(LAS const bf16x8*)(sb + d0 * 2048), a0 = *(LAS const bf16x8*)(sa + d0 * 2048), a1 = *(LAS const bf16x8*)(sa + d0 * 2048 + 512);
            hT[0] = __builtin_amdgcn_mfma_f32_32x32x16_bf16(bf, a0, hT[0], 0, 0, 0);
            hT[1] = __builtin_amdgcn_mfma_f32_32x32x16_bf16(bf, a1, hT[1], 0, 0, 0);
        }
        if (kt + 2 < 32) asm volatile("s_waitcnt vmcnt(5) lgkmcnt(0)\n\ts_barrier" ::: "memory");
        else asm volatile("s_waitcnt vmcnt(0) lgkmcnt(0)\n\ts_barrier" ::: "memory");
    }
    const float* bias1 = (const float*)(ws + WS_SMALL + SM_BIAS1) + kv * 256 + ncol0;
    bf16x8 hb[2][2];
#pragma unroll
    for (int mt = 0; mt < 2; ++mt) {
        float g[16];
#pragma unroll
        for (int r = 0; r < 16; ++r) g[r] = gelu_tanh(hT[mt][r] + bias1[crow(r, hi)]);
#pragma unroll
        for (int s = 0; s < 2; ++s) { u32x4_t w; w.x = cvtpk_s(g[8 * s], g[8 * s + 1]); w.y = cvtpk_s(g[8 * s + 2], g[8 * s + 3]); w.z = cvtpk_s(g[8 * s + 4], g[8 * s + 5]); w.w = cvtpk_s(g[8 * s + 6], g[8 * s + 7]);
            hb[mt][s] = __builtin_bit_cast(bf16x8, w); }
    }
    const bf16_t* w2t = (const bf16_t*)(ws + WS_SMALL + SM_W2T) + (size_t)kv * 64 * 256;
    f32x16 oT[2][2];
#pragma unroll
    for (int dt = 0; dt < 2; ++dt)
#pragma unroll
        for (int mt = 0; mt < 2; ++mt) oT[dt][mt] = f32x16{};
#pragma unroll
    for (int dt = 0; dt < 2; ++dt)
#pragma unroll
        for (int s = 0; s < 2; ++s) {
            const bf16_t* wp = w2t + (size_t)(32 * dt + r32) * 256 + ncol0 + 16 * s + 4 * hi;
            const u32x2_t lo = *(const u32x2_t*)wp, hi2 = *(const u32x2_t*)(wp + 8);
            const u32x4_t wv = {lo.x, lo.y, hi2.x, hi2.y}; const bf16x8 wf = __builtin_bit_cast(bf16x8, wv);
#pragma unroll
            for (int mt = 0; mt < 2; ++mt) oT[dt][mt] = __builtin_amdgcn_mfma_f32_32x32x16_bf16(wf, hb[mt][s], oT[dt][mt], 0, 0, 0);
        }
    LAS float* part = (LAS float*)lds + wid * 64 * CP_STRIDE;
#pragma unroll
    for (int dt = 0; dt < 2; ++dt)
#pragma unroll
        for (int mt = 0; mt < 2; ++mt)
#pragma unroll
            for (int r = 0; r < 16; ++r) part[(32 * mt + r32) * CP_STRIDE + 32 * dt + crow(r, hi)] = oT[dt][mt][r];
    P2_WAIT_BAR();
    {
        const int tid = wid * 64 + lane, m = tid >> 3, dg = tid & 7;
        float o[8];
#pragma unroll
        for (int e = 0; e < 8; ++e) { float s = 0.f;
#pragma unroll
            for (int w = 0; w < 8; ++w) s += ((LAS const float*)lds)[(w * 64 + m) * CP_STRIDE + 8 * dg + e];
            o[e] = s; }
        if (kv == 0) {
            float ss = 0.f;
#pragma unroll
            for (int e = 0; e < 8; ++e) ss += o[e] * o[e];
            ss += __shfl_xor(ss, 1); ss += __shfl_xor(ss, 2); ss += __shfl_xor(ss, 4);
            const float rr = __builtin_amdgcn_rsqf(ss * (1.0f / 64.0f) + 1e-6f);
#pragma unroll
            for (int e = 0; e < 8; ++e) o[e] *= rr * P.in[4][8 * dg + e];
        }
        const int n = n0 + m;
        u32x4_t v = {0u, 0u, 0u, 0u};
        if (n < 255) { v.x = cvtpk_s(o[0], o[1]); v.y = cvtpk_s(o[2], o[3]); v.z = cvtpk_s(o[4], o[5]); v.w = cvtpk_s(o[6], o[7]); }
        *(u32x4_t*)((bf16_t*)(ws + (kv ? WS_VC : WS_KC)) + ((size_t)bg * 256 + n) * 64 + 8 * dg) = v;
    }
    P2_WAIT_BAR();
#undef P2_DMA_TILE
}

constexpr int G_V = 0, G_ST = 32768, G_OST = 33792, G_END = 33792 + 65536;
struct GmlpIn { u32x4_t raw[4]; u32x4_t uraw[4]; float sbv[4]; };
__device__ __forceinline__ void gmlp_load(GmlpIn& in, const Ptrs& P, int unit, int tid, int lane, int r32, int hi, int wid) {
    unsigned char* ws = P.ws;
    const int g = unit & 7, chunk = (unit >> 3) & 31, b = unit >> 8; const int m0 = b * SEQ + chunk * 128;
    const bf16_t* GV = (const bf16_t*)(ws + WS_GV); const bf16_t* U = (const bf16_t*)(ws + WS_U);
    const int tb = wid >> 1, ch = wid & 1; (void)r32; (void)hi;
#pragma unroll
    for (int i = 0; i < 4; ++i) { const int idx = tid + 512 * i, s = idx >> 4, c8 = idx & 15; in.raw[i] = *(const u32x4_t*)(GV + (size_t)(m0 + s) * 1024 + g * 128 + 8 * c8); }
#pragma unroll
    for (int i = 0; i < 4; ++i) { const int row = i * 8 + (lane >> 3), t = 32 * tb + row; in.uraw[i] = *(const u32x4_t*)(U + (size_t)(m0 + t) * 1024 + g * 128 + 64 * ch + 8 * (lane & 7)); in.sbv[i] = P.in[11][g * 128 + t]; }
}
__device__ __forceinline__ void gmlp_compute(const GmlpIn& in, const f32x4_t (&sv)[8], const bf16x8 (&pa)[2][4], const f32x4_t w0, const f32x4_t w1, const f32x4_t b0, const f32x4_t b1, const Ptrs& P, LAS unsigned char* lds, int unit, int tid, int lane, int r32, int hi, int wid) {
    unsigned char* ws = P.ws;
    const int g = unit & 7, chunk = (unit >> 3) & 31, b = unit >> 8; const int m0 = b * SEQ + chunk * 128;
    bf16_t* AB = (bf16_t*)(ws + WS_AB);
    LAS float* st = (LAS float*)(lds + G_ST);
    const int tb = wid >> 1, ch = wid & 1;
    if (tid < 128) { float s1 = 0.f, s2 = 0.f;
#pragma unroll
        for (int i = 0; i < 8; ++i) { s1 += sv[i][0] + sv[i][2]; s2 += sv[i][1] + sv[i][3]; }
        const float mean = s1 * (1.0f / 1024.0f); float var = s2 * (1.0f / 1024.0f) - mean * mean; var = var < 0.f ? 0.f : var;
        st[2 * tid] = mean; st[2 * tid + 1] = __builtin_amdgcn_rsqf(var + 1e-5f); }
    asm volatile("s_waitcnt lgkmcnt(0)\n\ts_barrier" ::: "memory");
#pragma unroll
    for (int i = 0; i < 4; ++i) { const int idx = tid + 512 * i, s = idx >> 4, c8 = idx & 15;
        float f[8]; unpack8(in.raw[i], f);
        const float mean = st[2 * s], rstd = st[2 * s + 1];
        float y[8];
#pragma unroll
        for (int e = 0; e < 4; ++e) { y[e] = (f[e] - mean) * rstd * w0[e] + b0[e]; y[4 + e] = (f[4 + e] - mean) * rstd * w1[e] + b1[e]; }
        u32x4_t o; o.x = cvtpk_s(y[0], y[1]); o.y = cvtpk_s(y[2], y[3]); o.z = cvtpk_s(y[4], y[5]); o.w = cvtpk_s(y[6], y[7]);
        const int st_ = s >> 6, sk = s & 63, chh = c8 >> 3, x = c8 & 7;
        *(LAS u32x4_t*)(lds + G_V + (st_ * 2 + chh) * 8192 + (x >> 2) * 4096 + (sk >> 4) * 1024 + (sk & 15) * 64 + (x & 3) * 16) = o; }
    asm volatile("s_waitcnt lgkmcnt(0)\n\ts_barrier" ::: "memory");
    f32x16 o[2]; o[0] = f32x16{}; o[1] = f32x16{};
    const int vb0 = (int)((unsigned)(uintptr_t)lds + G_V) + ((lane >> 4) & 1) * 32 + (lane & 3) * 8 + (4 * hi + ((lane & 15) >> 2)) * 64;
    nsa::pv(o, vb0 + ch * 8192, pa[0][0], pa[0][1], pa[0][2], pa[0][3]);
    if (tb >= 2) nsa::pv(o, vb0 + (2 + ch) * 8192, pa[1][0], pa[1][1], pa[1][2], pa[1][3]);
    LAS float* ostg = (LAS float*)(lds + G_OST) + wid * 2048;
#pragma unroll
    for (int r = 0; r < 16; ++r) { const int orow = crow(r, hi);
#pragma unroll
        for (int d0 = 0; d0 < 2; ++d0) ostg[orow * 64 + d0 * 32 + r32] = o[d0][r]; }
    asm volatile("s_waitcnt lgkmcnt(0)" ::: "memory");
#pragma unroll
    for (int i = 0; i < 4; ++i) { const int row = i * 8 + (lane >> 3), c8 = lane & 7, t = 32 * tb + row;
        const f32x4_t v0 = *(LAS const f32x4_t*)(ostg + row * 64 + c8 * 8), v1 = *(LAS const f32x4_t*)(ostg + row * 64 + c8 * 8 + 4);
        const size_t grow = (size_t)(m0 + t); const int col = g * 128 + 64 * ch + 8 * c8;
        float uf[8]; unpack8(in.uraw[i], uf);
        const float sb_ = in.sbv[i];
        u32x4_t w; w.x = cvtpk_s(uf[0] * (v0[0] + sb_), uf[1] * (v0[1] + sb_)); w.y = cvtpk_s(uf[2] * (v0[2] + sb_), uf[3] * (v0[3] + sb_));
        w.z = cvtpk_s(uf[4] * (v1[0] + sb_), uf[5] * (v1[1] + sb_)); w.w = cvtpk_s(uf[6] * (v1[2] + sb_), uf[7] * (v1[3] + sb_));
        *(u32x4_t*)(AB + grow * 2048 + 1024 + col) = w; }
    asm volatile("s_waitcnt lgkmcnt(0)\n\ts_barrier" ::: "memory");
}
__device__ __forceinline__ void gmlp_run(const Ptrs& P, LAS unsigned char* lds, int u0, int stride, int nunits, const int wave_s) {
    const int lane = fresh_lane(), r32 = lane & 31, hi = lane >> 5, wid = wave_s, tid = wid * 64 + lane;
    GmlpIn A, B;
    int u = u0;
    bf16x8 pa[2][4];
    { const bf16_t* SWB = (const bf16_t*)(P.ws + WS_SMALL + SM_SWB) + (size_t)(u0 & 7) * 16384; const int tb = wid >> 1;
#pragma unroll
      for (int st_ = 0; st_ < 2; ++st_)
#pragma unroll
        for (int ks = 0; ks < 4; ++ks) {
            const bf16_t* wp = SWB + (size_t)(32 * tb + r32) * 128 + 64 * st_ + 16 * ks + 4 * hi;
            const u32x2_t lo = *(const u32x2_t*)wp, hi2 = *(const u32x2_t*)(wp + 8);
            const u32x4_t wv = {lo.x, lo.y, hi2.x, hi2.y}; pa[st_][ks] = __builtin_bit_cast(bf16x8, wv); } }
    const int c8v = tid & 15, g0 = u0 & 7;
    const f32x4_t w0 = *(const f32x4_t*)(P.in[8] + g0 * 128 + 8 * c8v), w1 = *(const f32x4_t*)(P.in[8] + g0 * 128 + 8 * c8v + 4), b0 = *(const f32x4_t*)(P.in[9] + g0 * 128 + 8 * c8v), b1 = *(const f32x4_t*)(P.in[9] + g0 * 128 + 8 * c8v + 4);
    const float* VSTAT = (const float*)(P.ws + WS_VSTAT);
#define GMLP_STATS(sv_, unit_) do { const int m0_ = ((unit_) >> 8) * SEQ + (((unit_) >> 3) & 31) * 128; const f32x4_t* p_ = (const f32x4_t*)(VSTAT + (size_t)(m0_ + (tid & 127)) * 32); \
        _Pragma("unroll") for (int i_ = 0; i_ < 8; ++i_) sv_[i_] = p_[i_]; } while (0)
    f32x4_t sv[8];
    if (u < nunits) gmlp_load(A, P, u, tid, lane, r32, hi, wid);
    while (u < nunits) {
        GMLP_STATS(sv, u);
        if (u + stride < nunits) gmlp_load(B, P, u + stride, tid, lane, r32, hi, wid);
        gmlp_compute(A, sv, pa, w0, w1, b0, b1, P, lds, u, tid, lane, r32, hi, wid);
        u += stride; if (u >= nunits) break;
        GMLP_STATS(sv, u);
        if (u + stride < nunits) gmlp_load(A, P, u + stride, tid, lane, r32, hi, wid);
        gmlp_compute(B, sv, pa, w0, w1, b0, b1, P, lds, u, tid, lane, r32, hi, wid);
        u += stride;
    }
#undef GMLP_STATS
    asm volatile("s_waitcnt vmcnt(0) lgkmcnt(0)\n\ts_barrier" ::: "memory");
}
#undef P2_WAIT_BAR
}

#define XB_TMO      128
#define XB_XCNT(j)  (256  + 64 * (j))
#define XB_XSUB(j)  (1280 + 64 * (j))
#define XB_XGEN(j)  (2304 + 64 * (j))
#define XB_TOP      3328
#define XB_TOPGEN   3392
#define XCD_BAR_WORDS 3456
#define XB_SPIN_CAP (1u << 18)

__device__ __forceinline__ unsigned xb_ld(unsigned* p)              { return __hip_atomic_load(p, __ATOMIC_RELAXED, __HIP_MEMORY_SCOPE_AGENT); }
__device__ __forceinline__ unsigned xb_add(unsigned* p, unsigned v) { return __hip_atomic_fetch_add(p, v, __ATOMIC_RELAXED, __HIP_MEMORY_SCOPE_AGENT); }
__device__ __forceinline__ unsigned xb_xcc_id() { return (unsigned)__builtin_amdgcn_s_getreg((3 << 11) | 20) & 0xFu; }
#define XB_SPIN(cond, bar) do { unsigned _sp = 0; while (cond) { __builtin_amdgcn_s_sleep(1); \
    if ((++_sp & 255u) == 0u) { if (xb_ld(&(bar)[XB_TMO])) break; if (_sp > XB_SPIN_CAP) { atomicAdd(&(bar)[XB_TMO], 1u); break; } } } } while (0)

struct XcdBarrier {
    unsigned* bar; unsigned x; unsigned w0;
    volatile LAS unsigned* st;
};

__device__ __forceinline__ XcdBarrier xcd_barrier_post(unsigned* bar, volatile LAS unsigned* st, int wave_s) {
    XcdBarrier b; b.bar = bar; b.x = xb_xcc_id(); b.st = st; b.w0 = wave_s == 0 ? 1u : 0u;
    if (b.w0 && fresh_lane() == 0) (void)xb_add(&bar[XB_XCNT(b.x)], 1u);
    return b;
}
__device__ __forceinline__ void xcd_barrier_complete(unsigned* bar, unsigned x, unsigned& nloc, unsigned& nx) {
    const unsigned G = gridDim.x * gridDim.y * gridDim.z;
    unsigned sum, cnt, mine, sp = 0u;
    for (;;) {
        sum = 0u; cnt = 0u; mine = 0u;
#pragma unroll
        for (unsigned j = 0; j < 16; ++j) { const unsigned c = xb_ld(&bar[XB_XCNT(j)]); sum += c; cnt += (c > 0u) ? 1u : 0u; mine = (j == x) ? c : mine; }
        if (sum == G) break;
        __builtin_amdgcn_s_sleep(1);
        if ((++sp & 255u) == 0u) { if (xb_ld(&bar[XB_TMO])) break; if (sp > XB_SPIN_CAP) { atomicAdd(&bar[XB_TMO], 1u); break; } }
    }
    nloc = mine > 0u ? mine : 1u; nx = cnt > 0u ? cnt : 1u;
}

__device__ __forceinline__ void xcd_barrier(const XcdBarrier& b) {
    asm volatile("s_waitcnt vmcnt(0)" ::: "memory");
    __syncthreads();
    if (b.w0 && fresh_lane() == 0) {
        unsigned* bar = b.bar;
        __builtin_amdgcn_s_waitcnt(0);
        unsigned nloc = b.st[0], nx = b.st[1];
        if (nloc == 0u) { xcd_barrier_complete(bar, b.x, nloc, nx); b.st[0] = nloc; b.st[1] = nx; }
        const unsigned old = xb_add(&bar[XB_XSUB(b.x)], 1u);
        const unsigned gen = old / nloc;
        if (old + 1u == (gen + 1u) * nloc) {
            __builtin_amdgcn_fence(__ATOMIC_RELEASE, "agent");
            asm volatile("s_waitcnt vmcnt(0)" ::: "memory");
            const unsigned og = xb_add(&bar[XB_TOP], 1u);
            const unsigned tg = og / nx;
            if (og + 1u == (tg + 1u) * nx) xb_add(&bar[XB_TOPGEN], 1u);
            else XB_SPIN(xb_ld(&bar[XB_TOPGEN]) == tg, bar);
            __builtin_amdgcn_fence(__ATOMIC_ACQUIRE, "agent");
            xb_add(&bar[XB_XGEN(b.x)], 1u);
            asm volatile("s_waitcnt vmcnt(0)" ::: "memory");
        } else {
            XB_SPIN(xb_ld(&bar[XB_XGEN(b.x)]) == gen, bar);
            __builtin_amdgcn_fence(__ATOMIC_ACQUIRE, "agent");
            asm volatile("s_waitcnt vmcnt(0)" ::: "memory");
        }
    }
    __syncthreads();
}

constexpr int LDS_BYTES = 147456;
constexpr int LDS_XCH = 132096;
constexpr int LDS_MISC = 145408;
__global__ void __launch_bounds__(512, 2) mega_fwd(Ptrs P) {
    extern __shared__ __attribute__((aligned(16))) unsigned char lds_raw[];
    LAS unsigned char* lds = (LAS unsigned char*)lds_raw;
    unsigned char* ws = P.ws;
    const int wave = __builtin_amdgcn_readfirstlane(threadIdx.x >> 6);
    const int G = gridDim.x, bid = blockIdx.x;
    if (wave == 0) { const int l_ = fresh_lane(); if (l_ < 2) ((LAS unsigned*)(lds + LDS_MISC))[l_] = 0u; }
    __syncthreads();
    const XcdBarrier bar = xcd_barrier_post((unsigned*)(ws + WS_CTL), (volatile LAS unsigned*)(lds + LDS_MISC), wave);
    p0_prologue(P, lds, bid, G, wave);
    xcd_barrier(bar);
    if (bid == 0) bias1_stage(ws, fresh_tid(wave));
    {
        pg8::Gemm g{(const bf16_t*)(ws + WS_XN), (const bf16_t*)(ws + WS_WIN), MTOK, NPROJ, 2048, 2048};
        pg8::StaticOrder S; S.init(MTOK, NPROJ, G, bid);
        pg8::EpiProj E{(bf16_t*)(ws + WS_Q), (bf16_t*)(ws + WS_KV6), (bf16_t*)(ws + WS_U), (bf16_t*)(ws + WS_GV), (float*)(ws + WS_GATES), (float*)(ws + WS_VSTAT), P.in[3], P.in[4]};
        pg8::gemm_phase<pg8::EpiProj, pg8::StaticOrder, true, true>(lds, g, S, E, wave);
    }
    xcd_barrier(bar);
    if (bid < 128 && G >= 256) p2::compress_unit(P, lds, bid, wave);
    else if (G >= 256) p2::gmlp_run(P, lds, bid - 128, G - 128, 1024, wave);
    xcd_barrier(bar);
    nsa::nsa_phase(P, lds, bid, G, wave);
    xcd_barrier(bar);
    {
        pg8::Gemm g{(const bf16_t*)(ws + WS_AB), (const bf16_t*)(ws + WS_WOUT), MTOK, 2048, 2048, 2048};
        pg8::StaticOrder S; S.init(MTOK, 2048, G, bid);
        pg8::EpiRes1 E{(const float*)(ws + WS_SMALL + SM_RINV), (const float*)(ws + WS_SMALL + SM_INVW), (bf16_t*)(ws + WS_XN), (float*)(ws + WS_SSQ)};
        pg8::gemm_phase<pg8::EpiRes1, pg8::StaticOrder, true, true>(lds, g, S, E, wave);
    }
    xcd_barrier(bar);
    for (int m = bid * 512 + fresh_tid(wave); m < MTOK; m += G * 512) {
        const float* p = (const float*)(ws + WS_SSQ) + (size_t)m * 32; float s = 0.f;
#pragma unroll
        for (int i = 0; i < 32; ++i) s += p[i];
        ((float*)(ws + WS_SMALL + SM_R2))[m] = __builtin_amdgcn_rsqf(s * (1.0f / D_MODEL) + 1e-6f);
    }
    xcd_barrier(bar);
    {
        pg8::Gemm g{(const bf16_t*)(ws + WS_XN), (const bf16_t*)(ws + WS_WUP), MTOK, N_UP, 2048, 2048};
        pg8::StaticOrder S; S.init(MTOK, N_UP, G, bid);
        pg8::EpiUpConv E{(bf16_t*)(ws + WS_G), (const float*)(ws + WS_SMALL + SM_R2), P.in[15], P.in[16], (float*)(ws + WS_HLAST), (float*)(ws + WS_FIRST), lds + LDS_XCH};
        pg8::gemm_phase<pg8::EpiUpConv, pg8::StaticOrder, true, true>(lds, g, S, E, wave);
    }
    xcd_barrier(bar);
    for (int it = bid * 512 + fresh_tid(wave); it < 60 * 44 * 2 * 16; it += G * 512) {
        const int c8 = it & 15, row = (it >> 4) & 1, tl_ = it >> 5, pn = tl_ % 44, pmi = tl_ / 44, pm = pmi + pmi / 15 + 1;
        const float* cw = P.in[15]; const float* cb = P.in[16]; (void)cb;
        const float* fp = (const float*)(ws + WS_FIRST) + ((size_t)(pm * 44 + pn) * 2 + row) * 256 + 8 * c8;
        const float* lp = (const float*)(ws + WS_HLAST) + ((size_t)((pm - 1) * 44 + pn) * 2) * 256 + 8 * c8;
        const int ch = pn * 128 + 8 * c8;
        float r[8];
#pragma unroll
        for (int e = 0; e < 8; ++e) {
            const float l0g = lp[e], l1g = lp[256 + e], l0u = lp[128 + e], l1u = lp[256 + 128 + e];
            const float w0g = cw[ch + e], w1g = cw[N_UP + ch + e], w0u = cw[D_FF + ch + e], w1u = cw[N_UP + D_FF + ch + e];
            const float cg = fp[e] + (row == 0 ? w1g * l1g + w0g * l0g : w0g * l1g), cu = fp[128 + e] + (row == 0 ? w1u * l1u + w0u * l0u : w0u * l1u);
            r[e] = cg * sigmoidf_(cg) * cu;
        }
        u32x4_t o; o.x = pk2(r[0], r[1]); o.y = pk2(r[2], r[3]); o.z = pk2(r[4], r[5]); o.w = pk2(r[6], r[7]);
        *(u32x4_t*)((bf16_t*)(ws + WS_G) + (size_t)(pm * 256 + row) * D_FF + ch) = o;
    }
    xcd_barrier(bar);
    {
        pg8::Gemm g{(const bf16_t*)(ws + WS_G), (const bf16_t*)(ws + WS_WDOWN), MTOK, 2048, D_FF, D_FF};
        pg8::StaticOrder S; S.init(MTOK, 2048, G, bid);
        pg8::EpiDown E{P.out, (const bf16_t*)(ws + WS_XN)};
        pg8::gemm_phase<pg8::EpiDown, pg8::StaticOrder, true, true>(lds, g, S, E, wave);
    }
}

extern "C" void kernel_launch(void* const* d_in, const int* in_sizes, int n_in, void* d_out, int out_size, void* d_ws, size_t ws_size, hipStream_t stream) {
    static int grid_blocks = 0;
    if (!grid_blocks) {
        int dev = 0, cus = 0, per_cu = 0;
        (void)hipGetDevice(&dev);
        (void)hipDeviceGetAttribute(&cus, hipDeviceAttributeMultiprocessorCount, dev);
        (void)hipFuncSetAttribute((const void*)mega_fwd, hipFuncAttributeMaxDynamicSharedMemorySize, LDS_BYTES);
        (void)hipOccupancyMaxActiveBlocksPerMultiprocessor(&per_cu, (const void*)mega_fwd, 512, LDS_BYTES);
        if (per_cu < 1) { fprintf(stderr, "kernel_launch: occupancy query says %d blocks/CU\n", per_cu); per_cu = 1; }
        grid_blocks = cus * 1;
        (void)hipGetLastError();
    }
    if (n_in != 18 || ws_size < WS_END) { fprintf(stderr, "kernel_launch: unexpected n_in %d / ws %zu\n", n_in, ws_size); return; }
    Ptrs P{};
    for (int i = 0; i < 18; ++i) P.in[i] = (const float*)d_in[i];
    P.out = (float*)d_out; P.ws = (unsigned char*)d_ws;
    (void)hipMemsetAsync((char*)d_ws + WS_CTL, 0, 16384, stream);
    mega_fwd<<<dim3(grid_blocks), dim3(512), LDS_BYTES, stream>>>(P);
}
```

```cpp
#include <hip/hip_runtime.h>
#include <cstdio>
#include <cstdint>

constexpr int D_MODEL = 2048, BATCH = 4, SEQ = 4096, MTOK = BATCH * SEQ;
constexpr int IN_COLS = 4656, NPROJ = 4864;
constexpr int D_FF = 5632, N_UP = 2 * D_FF;
constexpr int NBG = 16;
constexpr size_t KVSZ = (size_t)NBG * SEQ * 64;
constexpr float LOG2E = 1.4426950408889634f;

constexpr size_t MiB = 1u << 20;
constexpr size_t WS_CTL = 0;
constexpr size_t WS_WIN = 1 * MiB, WS_WOUT = 20 * MiB, WS_WUP = 28 * MiB, WS_WDOWN = 72 * MiB, WS_W1C = 94 * MiB;
constexpr size_t WS_SMALL = 96 * MiB;
constexpr size_t SM_BIASP = 0, SM_BIAS1 = 65536, SM_R2 = 131072, SM_W2T = 196608  , SM_SWB = 262144  , SM_RINV = 524288  , SM_INVW = 589824  ;
constexpr size_t WS_XN = 97 * MiB;
constexpr size_t WS_Q = 161 * MiB;
constexpr size_t WS_KV6 = 193 * MiB;
constexpr size_t WS_U = 241 * MiB, WS_GV = 273 * MiB;
constexpr size_t WS_GATES = 305 * MiB;
constexpr size_t WS_VSTAT = 308 * MiB;
constexpr size_t WS_KC = 310 * MiB, WS_VC = 310 * MiB + 524288;
constexpr size_t WS_HC = 311 * MiB;
constexpr size_t WS_AB = 315 * MiB;
constexpr size_t WS_SSQ = 379 * MiB;
constexpr size_t WS_G = 161 * MiB;
constexpr size_t WS_HID = 381 * MiB;
constexpr size_t WS_HLAST = 381 * MiB, WS_FIRST = 388 * MiB;
constexpr size_t WS_END = 469 * MiB;

#define LAS __attribute__((address_space(3)))
typedef unsigned short bf16_t;
typedef unsigned u32x4_t __attribute__((ext_vector_type(4)));
typedef unsigned u32x2_t __attribute__((ext_vector_type(2)));
typedef float f32x4_t __attribute__((ext_vector_type(4)));

__device__ __forceinline__ float bf2f(unsigned short h) { return __uint_as_float(((unsigned)h) << 16); }
__device__ __forceinline__ unsigned f2bf(float f) { unsigned u = __float_as_uint(f); return (u + 0x7fffu + ((u >> 16) & 1u)) >> 16; }
__device__ __forceinline__ unsigned pk2(float lo, float hi) { return f2bf(lo) | (f2bf(hi) << 16); }
__device__ __forceinline__ float gelu_tanh(float x) {
    const float u = 0.7978845608028654f * (x + 0.044715f * x * x * x);
    const float e = __builtin_amdgcn_exp2f(-2.8853900817779268f * u);
    return x * __builtin_amdgcn_rcpf(1.0f + e);
}
__device__ __forceinline__ float sigmoidf_(float x) { return __builtin_amdgcn_rcpf(1.0f + __builtin_amdgcn_exp2f(-LOG2E * x)); }
__device__ __forceinline__ float wave_sum(float v) {
#pragma unroll
    for (int o = 1; o < 64; o <<= 1) v += __shfl_xor(v, o);
    return v;
}
__device__ __forceinline__ void unpack8(u32x4_t r, float (&f)[8]) {
    f[0] = __uint_as_float(r.x << 16); f[1] = __uint_as_float(r.x & 0xffff0000u);
    f[2] = __uint_as_float(r.y << 16); f[3] = __uint_as_float(r.y & 0xffff0000u);
    f[4] = __uint_as_float(r.z << 16); f[5] = __uint_as_float(r.z & 0xffff0000u);
    f[6] = __uint_as_float(r.w << 16); f[7] = __uint_as_float(r.w & 0xffff0000u);
}

__device__ __forceinline__ int fresh_lane() { unsigned z_ = 0u; asm volatile("" : "+v"(z_)); return (int)__builtin_amdgcn_mbcnt_hi(~0u, __builtin_amdgcn_mbcnt_lo(~0u, z_)); }
__device__ __forceinline__ int fresh_tid(int wave_s) { return wave_s * 64 + fresh_lane(); }
namespace pg8 {
#define PG8_LAS __attribute__((address_space(3)))
typedef unsigned short bf16_t;
typedef short bf16x8 __attribute__((ext_vector_type(8)));
typedef float f32x4 __attribute__((ext_vector_type(4)));
typedef unsigned u32x4 __attribute__((ext_vector_type(4)));
constexpr int BM = 256, BK = 64, HALF = 128, HTB = HALF * BK * 2  , STAGE_BYTES = 8 * HTB, NXCD = 8, WGM = 8;

__host__ __device__ __forceinline__ int lds_byte(int r, int c) { const int st = (r >> 4) * 2 + (c >> 5), rr = r & 15, cc = c & 31, ob = rr * 64 + cc * 2; return st * 1024 + (ob ^ (((ob >> 9) & 1) << 5)); }
__host__ __device__ __forceinline__ void stage_rc(int b, int& R, int& C) { const int st = b / 1024, sb = b % 1024, swz = sb ^ (((sb >> 9) & 1) << 5); R = (st >> 1) * 16 + swz / 64; C = (st & 1) * 32 + (swz % 64) / 2; }
__host__ __device__ __forceinline__ int perm32(int rho) { const int n = rho >> 4, i = rho & 15; return 8 * (i >> 2) + 4 * n + (i & 3); }

struct Unit { int pm, pn; };
struct Gemm { const bf16_t* A; const bf16_t* Bt; int M, N, K, lda; };

struct StaticOrder {
    int nM, nN, nwg, G, c;
    __host__ __device__ void init(int M, int N, int G_, int c_) { nM = M / BM; nN = N / BM; nwg = nM * nN; G = G_; c = c_; }
    __host__ __device__ bool next(int i, Unit& u) const {
        const long L = (long)i * G + c; if (L >= nwg) return false;
        int wgid = (int)L; { const int q = nwg / NXCD, r = nwg % NXCD, xcd = wgid % NXCD, off = wgid / NXCD; wgid = (xcd < r ? xcd * (q + 1) : r * (q + 1) + (xcd - r) * q) + off; }
        const int nig = WGM * nN, gid = wgid / nig, fm = gid * WGM, gsz = (nM - fm) < WGM ? (nM - fm) : WGM;
        u.pm = fm + ((wgid % nig) % gsz); u.pn = (wgid % nig) / gsz; return true;
    }
    __device__ __forceinline__ void a_ready(const Unit&) const {}
    __device__ __forceinline__ void done(const Unit&) const {}
};

__device__ __forceinline__ unsigned cvt_pk_bf16(float lo, float hi) { unsigned r; asm volatile("v_cvt_pk_bf16_f32 %0, %1, %2" : "=v"(r) : "v"(lo), "v"(hi)); return r; }

struct EpiProj {
    static constexpr bool PERM = true, AFTER_DRAIN = false;
    bf16_t* Q; bf16_t* KV6; bf16_t* U; bf16_t* GV; float* GATES; float* VSTAT; const float* q_norm_w; const float* k_norm_w;
    __device__ __forceinline__ void operator()(const f32x4 (&acc)[2][2][4][2], const Unit& u, int wr, int wc, int fr, int fq) const {
        const int pn = u.pn, row0 = u.pm * BM + wr * 64 + fr;
        if (pn < 10) {
            const bool normed = (pn < 4) || pn == 6 || pn == 8;
            const float* w = pn < 4 ? q_norm_w : (k_norm_w + (pn == 6 ? 64 : 128));
            const float sc = pn < 4 ? 0.125f * LOG2E : 1.0f;
            f32x4 wv[2][2];
#pragma unroll
            for (int bj = 0; bj < 2; ++bj)
#pragma unroll
                for (int n = 0; n < 2; ++n) wv[bj][n] = normed ? (*(const f32x4*)(w + 32 * bj + 8 * fq + 4 * n)) * sc : (f32x4){1.f, 1.f, 1.f, 1.f};
#pragma unroll
            for (int ai = 0; ai < 2; ++ai)
#pragma unroll
                for (int m = 0; m < 4; ++m) {
                    const int row = row0 + ai * HALF + m * 16;
                    float r = 1.f;
                    if (normed) {
                        float ss = 0.f;
#pragma unroll
                        for (int bj = 0; bj < 2; ++bj)
#pragma unroll
                            for (int n = 0; n < 2; ++n) { const f32x4 x = acc[ai][bj][m][n]; ss += (x[0] * x[0] + x[1] * x[1]) + (x[2] * x[2] + x[3] * x[3]); }
                        ss += __shfl_xor(ss, 16); ss += __shfl_xor(ss, 32);
                        r = __builtin_amdgcn_rsqf(ss * (1.0f / 64.0f) + 1e-6f);
                    }
                    bf16_t* dst;
                    if (pn < 4) dst = Q + (size_t)row * 1024 + pn * 256 + wc * 64 + 8 * fq;
                    else { const int b = row >> 12, t = row & 4095; dst = KV6 + (size_t)(pn - 4) * KVSZ + ((size_t)((b * 4 + wc) * 4096 + t)) * 64 + 8 * fq; }
#pragma unroll
                    for (int bj = 0; bj < 2; ++bj) {
                        const f32x4 v0 = acc[ai][bj][m][0] * r * wv[bj][0], v1 = acc[ai][bj][m][1] * r * wv[bj][1];
                        u32x4 o; o.x = cvt_pk_bf16(v0[0], v0[1]); o.y = cvt_pk_bf16(v0[2], v0[3]); o.z = cvt_pk_bf16(v1[0], v1[1]); o.w = cvt_pk_bf16(v1[2], v1[3]);
                        *(u32x4*)(dst + 32 * bj) = o;
                    }
                }
        } else if (pn < 18) {
            const bool isv = pn >= 14; const int ct = isv ? pn - 14 : pn - 10;
            bf16_t* base = (isv ? GV : U) + ct * 256 + wc * 64 + 8 * fq;
#pragma unroll
            for (int ai = 0; ai < 2; ++ai)
#pragma unroll
                for (int m = 0; m < 4; ++m) {
                    const int row = row0 + ai * HALF + m * 16; float s1 = 0.f, s2 = 0.f;
#pragma unroll
                    for (int bj = 0; bj < 2; ++bj) {
                        f32x4 v0 = acc[ai][bj][m][0], v1 = acc[ai][bj][m][1];
#pragma unroll
                        for (int e = 0; e < 4; ++e) { v0[e] = gelu_tanh(v0[e]); v1[e] = gelu_tanh(v1[e]); s1 += v0[e] + v1[e]; s2 += v0[e] * v0[e] + v1[e] * v1[e]; }
                        u32x4 o; o.x = cvt_pk_bf16(v0[0], v0[1]); o.y = cvt_pk_bf16(v0[2], v0[3]); o.z = cvt_pk_bf16(v1[0], v1[1]); o.w = cvt_pk_bf16(v1[2], v1[3]);
                        *(u32x4*)(base + (size_t)row * 1024 + 32 * bj) = o;
                    }
                    if (isv) {
                        s1 += __shfl_xor(s1, 16); s1 += __shfl_xor(s1, 32); s2 += __shfl_xor(s2, 16); s2 += __shfl_xor(s2, 32);
                        if (fq == 0) { float* p = VSTAT + ((size_t)row * 16 + ct * 4 + wc) * 2; p[0] = s1; p[1] = s2; }
                    }
                }
        } else {
            if (wc == 0) {
#pragma unroll
                for (int ai = 0; ai < 2; ++ai)
#pragma unroll
                    for (int m = 0; m < 4; ++m) {
                        const int row = row0 + ai * HALF + m * 16;
#pragma unroll
                        for (int bj = 0; bj < 2; ++bj)
#pragma unroll
                            for (int n = 0; n < 2; ++n) {
                                const int L = 32 * bj + 8 * fq + 4 * n;
                                if (L < 48) { f32x4 v = acc[ai][bj][m][n]; f32x4 o; o[0] = sigmoidf_(v[0]); o[1] = sigmoidf_(v[1]); o[2] = sigmoidf_(v[2]); o[3] = sigmoidf_(v[3]); *(f32x4*)(GATES + (size_t)row * 48 + L) = o; }
                            }
                    }
            }
        }
    }
};
struct EpiCmp {
    static constexpr bool PERM = true, AFTER_DRAIN = false;
    bf16_t* HC; const float* bias1;
    __device__ __forceinline__ void operator()(const f32x4 (&acc)[2][2][4][2], const Unit& u, int wr, int wc, int fr, int fq) const {
        const int row0 = u.pm * BM + wr * 64 + fr, col0 = wc * 32 + 8 * fq;
        f32x4 bv[2][2];
#pragma unroll
        for (int bj = 0; bj < 2; ++bj)
#pragma unroll
            for (int n = 0; n < 2; ++n) bv[bj][n] = *(const f32x4*)(bias1 + u.pn * 256 + col0 + bj * HALF + 4 * n);
#pragma unroll
        for (int ai = 0; ai < 2; ++ai)
#pragma unroll
            for (int m = 0; m < 4; ++m) { bf16_t* rowp = HC + (size_t)(row0 + ai * HALF + m * 16) * 256 + col0;
#pragma unroll
                for (int bj = 0; bj < 2; ++bj) { f32x4 v0 = acc[ai][bj][m][0] + bv[bj][0], v1 = acc[ai][bj][m][1] + bv[bj][1];
#pragma unroll
                    for (int e = 0; e < 4; ++e) { v0[e] = gelu_tanh(v0[e]); v1[e] = gelu_tanh(v1[e]); }
                    u32x4 o; o.x = cvt_pk_bf16(v0[0], v0[1]); o.y = cvt_pk_bf16(v0[2], v0[3]); o.z = cvt_pk_bf16(v1[0], v1[1]); o.w = cvt_pk_bf16(v1[2], v1[3]);
                    *(u32x4*)(rowp + bj * HALF) = o; } }
    }
};
struct CmpOrder {
    int c, G;
    __device__ bool next(int i, Unit& u) const { const int L = i * G + c; if (L >= 32) return false; u.pm = L; u.pn = L >> 4; return true; }
    __device__ __forceinline__ void a_ready(const Unit&) const {}
    __device__ __forceinline__ void done(const Unit&) const {}
};
struct EpiRes1 {
    static constexpr bool PERM = false, AFTER_DRAIN = false;
    const float* RINV; const float* INVW; bf16_t* X1b; float* SSQ;
    __device__ __forceinline__ void operator()(const f32x4 (&acc)[2][2][4][2], const Unit& u, int wr, int wc, int fr, int fq) const {
        const int row0 = u.pm * BM + wr * 64 + fr, col0 = u.pn * BM + wc * 32 + 4 * fq;
        f32x4 iw[2][2];
#pragma unroll
        for (int bj = 0; bj < 2; ++bj)
#pragma unroll
            for (int n = 0; n < 2; ++n) iw[bj][n] = *(const f32x4*)(INVW + col0 + bj * HALF + n * 16);
#pragma unroll
        for (int ai = 0; ai < 2; ++ai) {
            u32x2_t xin[4][2][2]; float ri[4];
#pragma unroll
            for (int m = 0; m < 4; ++m) { ri[m] = RINV[row0 + ai * HALF + m * 16];
#pragma unroll
                for (int bj = 0; bj < 2; ++bj)
#pragma unroll
                    for (int n = 0; n < 2; ++n) xin[m][bj][n] = *(const u32x2_t*)(X1b + (size_t)(row0 + ai * HALF + m * 16) * D_MODEL + col0 + bj * HALF + n * 16); }
            __builtin_amdgcn_sched_barrier(0);
#pragma unroll
            for (int m = 0; m < 4; ++m) { const int row = row0 + ai * HALF + m * 16; const size_t off = (size_t)row * D_MODEL + col0; float ss = 0.f;
#pragma unroll
                for (int bj = 0; bj < 2; ++bj)
#pragma unroll
                    for (int n = 0; n < 2; ++n) { const u32x2_t w_ = xin[m][bj][n];
                        f32x4 xv; xv[0] = __uint_as_float(w_.x << 16); xv[1] = __uint_as_float(w_.x & 0xffff0000u); xv[2] = __uint_as_float(w_.y << 16); xv[3] = __uint_as_float(w_.y & 0xffff0000u);
                        const f32x4 v = xv * ri[m] * iw[bj][n] + acc[ai][bj][m][n];
                        ss += (v[0] * v[0] + v[1] * v[1]) + (v[2] * v[2] + v[3] * v[3]);
                        u32x2_t w; w.x = cvt_pk_bf16(v[0], v[1]); w.y = cvt_pk_bf16(v[2], v[3]); *(u32x2_t*)(X1b + off + bj * HALF + n * 16) = w; }
                ss += __shfl_xor(ss, 16); ss += __shfl_xor(ss, 32);
                if (fq == 0) SSQ[(size_t)row * 32 + u.pn * 4 + wc] = ss; }
            __builtin_amdgcn_sched_barrier(0);
        }
    }
};
struct EpiUpV1 {
    static constexpr bool PERM = true, AFTER_DRAIN = false;
    bf16_t* HID; const float* R2;
    __device__ __forceinline__ void operator()(const f32x4 (&acc)[2][2][4][2], const Unit& u, int wr, int wc, int fr, int fq) const {
        const int row0 = u.pm * BM + wr * 64 + fr, col0 = u.pn * BM + wc * 32 + 8 * fq;
#pragma unroll
        for (int ai = 0; ai < 2; ++ai)
#pragma unroll
            for (int m = 0; m < 4; ++m) { const int row = row0 + ai * HALF + m * 16; const float r = R2[row]; bf16_t* rowp = HID + (size_t)row * N_UP + col0;
#pragma unroll
                for (int bj = 0; bj < 2; ++bj) { const f32x4 v0 = acc[ai][bj][m][0] * r, v1 = acc[ai][bj][m][1] * r;
                    u32x4 o; o.x = cvt_pk_bf16(v0[0], v0[1]); o.y = cvt_pk_bf16(v0[2], v0[3]); o.z = cvt_pk_bf16(v1[0], v1[1]); o.w = cvt_pk_bf16(v1[2], v1[3]);
                    *(u32x4*)(rowp + bj * HALF) = o; } }
    }
};
struct EpiDown {
    static constexpr bool PERM = false, AFTER_DRAIN = false;
    float* out; const bf16_t* X1b;
    __device__ __forceinline__ void operator()(const f32x4 (&acc)[2][2][4][2], const Unit& u, int wr, int wc, int fr, int fq) const {
        const int row0 = u.pm * BM + wr * 64 + fr, col0 = u.pn * BM + wc * 32 + 4 * fq;
#pragma unroll
        for (int ai = 0; ai < 2; ++ai) {
            u32x2_t xin[4][2][2];
#pragma unroll
            for (int m = 0; m < 4; ++m)
#pragma unroll
                for (int bj = 0; bj < 2; ++bj)
#pragma unroll
                    for (int n = 0; n < 2; ++n) xin[m][bj][n] = *(const u32x2_t*)(X1b + (size_t)(row0 + ai * HALF + m * 16) * D_MODEL + col0 + bj * HALF + n * 16);
            __builtin_amdgcn_sched_barrier(0);
#pragma unroll
            for (int m = 0; m < 4; ++m) { const size_t off = (size_t)(row0 + ai * HALF + m * 16) * D_MODEL + col0;
#pragma unroll
                for (int bj = 0; bj < 2; ++bj)
#pragma unroll
                    for (int n = 0; n < 2; ++n) { const u32x2_t w = xin[m][bj][n];
                        f32x4 v; v[0] = __uint_as_float(w.x << 16); v[1] = __uint_as_float(w.x & 0xffff0000u); v[2] = __uint_as_float(w.y << 16); v[3] = __uint_as_float(w.y & 0xffff0000u);
                        *(f32x4*)(out + off + bj * HALF + n * 16) = v + acc[ai][bj][m][n]; } }
            __builtin_amdgcn_sched_barrier(0);
        }
    }
};
__device__ __forceinline__ unsigned f2bf_(float f) { unsigned u = __float_as_uint(f); return (u + 0x7fffu + ((u >> 16) & 1u)) >> 16; }
struct EpiUpConv {
    static constexpr bool PERM = true, AFTER_DRAIN = false;
    bf16_t* G; const float* R2; const float* cw; const float* cb; float* HLAST; float* FIRST; PG8_LAS unsigned char* xlds;
    __device__ __forceinline__ void operator()(const f32x4 (&acc)[2][2][4][2], const Unit& u, int wr, int wc, int fr_in, int fq_in) const {
        (void)fr_in; (void)fq_in;
        unsigned z_ = 0u; asm volatile("" : "+v"(z_));
        const int lane_ = (int)__builtin_amdgcn_mbcnt_hi(~0u, __builtin_amdgcn_mbcnt_lo(~0u, z_)); const int fr = lane_ & 15, fq = lane_ >> 4;
        const int row0 = u.pm * BM + wr * 64 + fr;
        PG8_LAS float* X = (PG8_LAS float*)xlds;
        const unsigned tile = (unsigned)(u.pm * (N_UP / 256) + u.pn);
        if (fr >= 14) {
#pragma unroll
            for (int ai = 0; ai < 2; ++ai) { const int sg = 2 * ai + wr; const float r3 = R2[row0 + ai * HALF + 48];
#pragma unroll
                for (int bj = 0; bj < 2; ++bj)
#pragma unroll
                    for (int n = 0; n < 2; ++n) { const f32x4 h = acc[ai][bj][3][n] * r3;
                        *(PG8_LAS f32x4*)(X + ((sg * 4 + wc) * 2 + (fr - 14)) * 64 + bj * 32 + 8 * fq + 4 * n) = h;
                        if (ai == 1 && wr == 1) *(f32x4*)(HLAST + (unsigned)((tile * 2 + (fr - 14)) * 256 + bj * HALF + wc * 32 + 8 * fq + 4 * n)) = h; } }
        }
        PG8_LAS float* R2L = X + 3072;
        PG8_LAS float* Wl = X + 2048;
        { const int t_ = (wr * 4 + wc) * 64 + fq * 16 + fr;
#pragma unroll
          for (int i2 = 0; i2 < 2; ++i2) { const int i = t_ + 512 * i2, k = i >> 8, p = i & 255, c = (p < 128 ? 0 : D_FF - 128) + u.pn * 128 + p;
              Wl[i] = k < 3 ? cw[(unsigned)(k * N_UP + c)] : cb[(unsigned)c]; }
          if (t_ < 256) R2L[t_] = R2[u.pm * BM + t_]; }
        asm volatile("s_waitcnt vmcnt(0) lgkmcnt(0)" ::: "memory"); __builtin_amdgcn_s_barrier(); asm volatile("" ::: "memory");
        const int cbase = u.pn * 128 + wc * 32 + 8 * fq;
        const bool seq_start = (u.pm & 15) == 0;
#pragma unroll
        for (int ai = 0; ai < 2; ++ai) {
            const int sg = 2 * ai + wr;
            float rs[4];
#pragma unroll
            for (int m = 0; m < 4; ++m) rs[m] = R2L[wr * 64 + fr + ai * HALF + m * 16];
            const bool defer = (ai == 0) && (wr == 0) && !seq_start && (fr < 2);
#pragma unroll
            for (int n = 0; n < 2; ++n) {
                unsigned pk[4][2];
#pragma unroll
                for (int e = 0; e < 4; ++e) {
                    asm volatile("" ::: "memory"); __builtin_amdgcn_sched_barrier(0);
                    PG8_LAS const float* wp = Wl + wc * 32 + 8 * fq + 4 * n + e;
                    const float wg0 = wp[0], wg1 = wp[256], wg2 = wp[512], bg = wp[768], wu0 = wp[128], wu1 = wp[384], wu2 = wp[640], bu = wp[896];
                    float hg1 = 0.f, hg2 = 0.f, hu1 = 0.f, hu2 = 0.f;
                    if (ai == 1 || wr == 1) { PG8_LAS const float* xp = X + (((sg - 1) * 4 + wc) * 2) * 64 + 8 * fq + 4 * n + e; hg2 = xp[0]; hg1 = xp[64]; hu2 = xp[32]; hu1 = xp[96]; }
                    float ag = hg1, bgp = fr == 0 ? hg2 : hg1, au = hu1, bup = fr == 0 ? hu2 : hu1;
#pragma unroll
                    for (int m = 0; m < 4; ++m) {
                        const float vg = acc[ai][0][m][n][e] * rs[m], vu = acc[ai][1][m][n][e] * rs[m];
                        const float rg1 = __uint_as_float(__builtin_amdgcn_mov_dpp(__float_as_uint(vg), 0x121, 0xf, 0xf, true)), rg2 = __uint_as_float(__builtin_amdgcn_mov_dpp(__float_as_uint(vg), 0x122, 0xf, 0xf, true));
                        const float ru1 = __uint_as_float(__builtin_amdgcn_mov_dpp(__float_as_uint(vu), 0x121, 0xf, 0xf, true)), ru2 = __uint_as_float(__builtin_amdgcn_mov_dpp(__float_as_uint(vu), 0x122, 0xf, 0xf, true));
                        const float pg1 = fr >= 1 ? rg1 : ag, pg2 = fr >= 2 ? rg2 : bgp, pu1 = fr >= 1 ? ru1 : au, pu2 = fr >= 2 ? ru2 : bup;
                        const float cg = bg + wg0 * pg2 + wg1 * pg1 + wg2 * vg, cu = bu + wu0 * pu2 + wu1 * pu1 + wu2 * vu;
                        if (m == 0 && defer) { float* fp = FIRST + (unsigned)((tile * 2 + fr) * 256 + wc * 32 + 8 * fq + 4 * n + e); fp[0] = cg; fp[HALF] = cu; }
                        const unsigned hb = cvt_pk_bf16(cg * sigmoidf_(cg) * cu, 0.f);
                        if ((e & 1) == 0) pk[m][e >> 1] = hb; else pk[m][e >> 1] |= hb << 16;
                        ag = rg1; bgp = rg2; au = ru1; bup = ru2;
                    }
                }
#pragma unroll
                for (int m = 0; m < 4; ++m)
                    if (!(m == 0 && defer)) { u32x2_t o; o.x = pk[m][0]; o.y = pk[m][1]; *(u32x2_t*)(G + (unsigned)((row0 + ai * HALF + m * 16) * D_FF + cbase + 4 * n)) = o; }
            }
        }
    }
};
template <class Epi, class Sched, bool ALIGN_EPI = false, bool SP2 = false>
__device__ __forceinline__ void gemm_phase(PG8_LAS unsigned char* lds, const Gemm g, const Sched& S, const Epi& E, const int wave_s) {
    const int tid = fresh_tid(wave_s), wid = wave_s, lane = tid & 63,
          wr = wid >> 2, wc = wid & 3, fr = lane & 15, fq = lane >> 4;
    const int K = g.K, nt = K / BK;
    unsigned voffA[2], voffB[2];
#pragma unroll
    for (int i = 0; i < 2; ++i) { int R, C; stage_rc(tid * 16 + i * 8192, R, C); const int Rb = Epi::PERM ? ((R & ~31) + perm32(R & 31)) : R;
        voffA[i] = (unsigned)(R * g.lda + C) * 2u; voffB[i] = (unsigned)(Rb * K + C) * 2u; }
    const size_t kstep = (size_t)(BK * 2);
    const size_t hstepA = (size_t)HALF * g.lda * 2, hstepB = (size_t)HALF * K * 2;
    const size_t tstepA = 2 * hstepA, tstepB = 2 * hstepB;
    const unsigned ldsw = (unsigned)wid * 1024u;
    const int aoff = lds_byte(wr * 64 + fr, fq * 8), boff = lds_byte(wc * 32 + fr, fq * 8);
#define PG8_SA(b, h) (((b) * 2 + (h)) * HTB)
#define PG8_SB(b, h) ((4 + (b) * 2 + (h)) * HTB)
#define PG8_STAGE(bufoff, gbase, voff) do { _Pragma("unroll") for (int _i = 0; _i < 2; ++_i) \
        __builtin_amdgcn_global_load_lds((const unsigned*)((const char*)(gbase) + (voff)[_i]), (PG8_LAS unsigned*)(lds + (bufoff) + ldsw + _i * 8192), 16, 0, 0); } while (0)
#define PG8_LDA(dst, b, h) do { _Pragma("unroll") for (int m = 0; m < 4; ++m) _Pragma("unroll") for (int k = 0; k < 2; ++k) dst[m][k] = *(const PG8_LAS bf16x8*)(lds + PG8_SA(b, h) + aoff + m * 2048 + k * 1024); } while (0)
#define PG8_LDB(dst, b, h) do { _Pragma("unroll") for (int n = 0; n < 2; ++n) _Pragma("unroll") for (int k = 0; k < 2; ++k) dst[n][k] = *(const PG8_LAS bf16x8*)(lds + PG8_SB(b, h) + boff + n * 2048 + k * 1024); } while (0)
#define PG8_MMA(ai, bj, At, Bt) do { __builtin_amdgcn_s_setprio(1); _Pragma("unroll") for (int m = 0; m < 4; ++m) _Pragma("unroll") for (int n = 0; n < 2; ++n) _Pragma("unroll") for (int k = 0; k < 2; ++k) \
        acc[ai][bj][m][n] = __builtin_amdgcn_mfma_f32_16x16x32_bf16(Bt[n][k], At[m][k], acc[ai][bj][m][n], 0, 0, 0); __builtin_amdgcn_s_setprio(0); } while (0)
#define PG8_WAIT_V(n) asm volatile("s_waitcnt vmcnt(" #n ")" ::: "memory")
#define PG8_WAIT_L(n) asm volatile("s_waitcnt lgkmcnt(" #n ")" ::: "memory")
#define PG8_BAR __builtin_amdgcn_s_barrier()
#define PG8_SCHED __builtin_amdgcn_sched_barrier(0)
    Unit cur, nxt; int ui = 0;
    if (!S.next(0, cur)) return;
    f32x4 acc[2][2][4][2];
#pragma unroll
    for (int a = 0; a < 2; ++a)
#pragma unroll
        for (int b = 0; b < 2; ++b)
#pragma unroll
            for (int m = 0; m < 4; ++m)
#pragma unroll
                for (int n = 0; n < 2; ++n) acc[a][b][m][n] = (f32x4){0.f, 0.f, 0.f, 0.f};
    bf16x8 At[4][2], B0[2][2], B1[2][2];
    const char* cA = (const char*)g.A + (size_t)cur.pm * tstepA; const char* cB = (const char*)g.Bt + (size_t)cur.pn * tstepB;
    S.a_ready(cur);
    if constexpr (SP2) {
        PG8_STAGE(PG8_SB(0, 0), cB, voffB); PG8_STAGE(PG8_SB(0, 1), cB + hstepB, voffB); PG8_STAGE(PG8_SA(0, 0), cA, voffA); PG8_STAGE(PG8_SA(0, 1), cA + hstepA, voffA);
        if (wr == 1) PG8_BAR;
        PG8_WAIT_V(2); PG8_BAR;
        PG8_STAGE(PG8_SB(1, 0), cB + kstep, voffB); PG8_STAGE(PG8_SA(1, 0), cA + kstep, voffA); PG8_STAGE(PG8_SB(1, 1), cB + hstepB + kstep, voffB);
        PG8_WAIT_V(6); PG8_BAR;
    } else {
        PG8_STAGE(PG8_SB(0, 0), cB, voffB); PG8_STAGE(PG8_SA(0, 0), cA, voffA); PG8_STAGE(PG8_SB(0, 1), cB + hstepB, voffB); PG8_STAGE(PG8_SA(0, 1), cA + hstepA, voffA);
        if (wr == 1) PG8_BAR;
        PG8_WAIT_V(4); PG8_BAR;
        PG8_STAGE(PG8_SB(1, 0), cB + kstep, voffB); PG8_STAGE(PG8_SA(1, 0), cA + kstep, voffA); PG8_STAGE(PG8_SB(1, 1), cB + hstepB + kstep, voffB);
        PG8_WAIT_V(6); PG8_BAR;
    }
    for (;;) {
        const bool has_next = S.next(ui + 1, nxt);
        const char* nA = has_next ? (const char*)g.A + (size_t)nxt.pm * tstepA : cA; const char* nB = has_next ? (const char*)g.Bt + (size_t)nxt.pn * tstepB : cB;
        for (int t = 0; t < nt; t += 2) {
            const bool last = (t == nt - 2);
            const char* a1 = cA + (size_t)(t + 1) * kstep;
            const char* a2 = last ? nA : cA + (size_t)(t + 2) * kstep; const char* b2 = last ? nB : cB + (size_t)(t + 2) * kstep;
            const char* a3 = a2 + kstep; const char* b3 = b2 + kstep;
            if (last && has_next) S.a_ready(nxt);
            if constexpr (SP2) {
            PG8_LDB(B0, 0, 0); PG8_LDB(B1, 0, 1); PG8_SCHED; PG8_LDA(At, 0, 0); PG8_STAGE(PG8_SA(1, 1), a1 + hstepA, voffA);
            PG8_WAIT_V(8); PG8_WAIT_L(0); PG8_BAR; PG8_MMA(0, 0, At, B0); PG8_MMA(0, 1, At, B1); PG8_BAR; PG8_SCHED;
            PG8_LDA(At, 0, 1); PG8_STAGE(PG8_SB(0, 0), b2, voffB); PG8_STAGE(PG8_SB(0, 1), b2 + hstepB, voffB); PG8_STAGE(PG8_SA(0, 0), a2, voffA);
            PG8_WAIT_V(8); PG8_WAIT_L(0); PG8_BAR; PG8_MMA(1, 0, At, B0); PG8_MMA(1, 1, At, B1); PG8_BAR; PG8_SCHED;
            PG8_LDB(B0, 1, 0); PG8_LDB(B1, 1, 1); PG8_SCHED; PG8_LDA(At, 1, 0); PG8_STAGE(PG8_SA(0, 1), a2 + hstepA, voffA);
            PG8_WAIT_V(8); PG8_WAIT_L(0); PG8_BAR; PG8_MMA(0, 0, At, B0); PG8_MMA(0, 1, At, B1); PG8_BAR; PG8_SCHED;
            PG8_LDA(At, 1, 1); PG8_STAGE(PG8_SB(1, 0), b3, voffB); PG8_STAGE(PG8_SB(1, 1), b3 + hstepB, voffB); PG8_STAGE(PG8_SA(1, 0), a3, voffA);
            PG8_WAIT_V(8); PG8_WAIT_L(0); PG8_BAR; PG8_MMA(1, 0, At, B0); PG8_MMA(1, 1, At, B1); PG8_BAR; PG8_SCHED;
            } else {
            PG8_LDB(B0, 0, 0); PG8_SCHED; PG8_LDA(At, 0, 0); PG8_STAGE(PG8_SA(1, 1), a1 + hstepA, voffA);
            PG8_WAIT_L(8); PG8_BAR; PG8_WAIT_L(0); PG8_MMA(0, 0, At, B0); PG8_BAR; PG8_SCHED;
            PG8_LDB(B1, 0, 1); PG8_STAGE(PG8_SB(0, 0), b2, voffB);
            PG8_BAR; PG8_WAIT_L(0); PG8_MMA(0, 1, At, B1); PG8_BAR;
            PG8_LDA(At, 0, 1); PG8_STAGE(PG8_SA(0, 0), a2, voffA);
            PG8_BAR; PG8_WAIT_L(0); PG8_MMA(1, 0, At, B0); PG8_BAR; PG8_SCHED;
            PG8_STAGE(PG8_SB(0, 1), b2 + hstepB, voffB);
            PG8_WAIT_V(6); PG8_BAR; PG8_MMA(1, 1, At, B1); PG8_BAR;
            PG8_LDB(B0, 1, 0); PG8_SCHED; PG8_LDA(At, 1, 0); PG8_STAGE(PG8_SA(0, 1), a2 + hstepA, voffA);
            PG8_WAIT_L(8); PG8_BAR; PG8_WAIT_L(0); PG8_MMA(0, 0, At, B0); PG8_BAR; PG8_SCHED;
            PG8_LDB(B1, 1, 1); PG8_STAGE(PG8_SB(1, 0), b3, voffB);
            PG8_BAR; PG8_WAIT_L(0); PG8_MMA(0, 1, At, B1); PG8_BAR;
            PG8_LDA(At, 1, 1); PG8_STAGE(PG8_SA(1, 0), a3, voffA);
            PG8_BAR; PG8_WAIT_L(0); PG8_MMA(1, 0, At, B0); PG8_BAR; PG8_SCHED;
            PG8_STAGE(PG8_SB(1, 1), b3 + hstepB, voffB);
            PG8_WAIT_V(6); PG8_BAR; PG8_MMA(1, 1, At, B1); PG8_BAR;
            }
        }
        if constexpr (ALIGN_EPI) { if (wr == 0) PG8_BAR; }
        if constexpr (!Epi::AFTER_DRAIN) { E(acc, cur, wr, wc, fr, fq); S.done(cur); }
        if (!has_next) break;
#pragma unroll
        for (int a = 0; a < 2; ++a)
#pragma unroll
            for (int b = 0; b < 2; ++b)
#pragma unroll
                for (int m = 0; m < 4; ++m)
#pragma unroll
                    for (int n = 0; n < 2; ++n) acc[a][b][m][n] = (f32x4){0.f, 0.f, 0.f, 0.f};
        cur = nxt; cA = nA; cB = nB; ++ui;
        if constexpr (ALIGN_EPI) { if (wr == 1) PG8_BAR; }
    }
    PG8_WAIT_V(0);
    if constexpr (!ALIGN_EPI) { if (wr == 0) PG8_BAR; }
    PG8_BAR;
    if constexpr (Epi::AFTER_DRAIN) { E.fused(acc, cur, wr, wc, fr, fq, lds, wid, lane); S.done(cur); }
#undef PG8_SA
#undef PG8_SB
#undef PG8_STAGE
#undef PG8_LDA
#undef PG8_LDB
#undef PG8_MMA
#undef PG8_WAIT_V
#undef PG8_WAIT_L
#undef PG8_BAR
#undef PG8_SCHED
}
}
constexpr int NWAVES = 8;
template <class RowMap>
__device__ __forceinline__ void transpose_item(const float* __restrict__ W, int K, int N, bf16_t* WT, const float* __restrict__ kscale, RowMap rm, LAS float* scr, int item, int lane) {
    const int nblk = (N + 31) / 32, kb = item / nblk, nb = item % nblk, k0 = 64 * kb, n0 = 32 * nb;
    const int nr = n0 + (lane & 31);
    float v[32];
#pragma unroll
    for (int i = 0; i < 32; ++i) { const int kk = 2 * i + (lane >> 5); v[i] = (nr < N) ? W[(size_t)(k0 + kk) * N + nr] : 0.f; }
    if (kscale) {
#pragma unroll
        for (int i = 0; i < 32; ++i) v[i] *= kscale[k0 + 2 * i + (lane >> 5)];
    }
#pragma unroll
    for (int i = 0; i < 32; ++i) scr[(2 * i + (lane >> 5)) * 33 + (lane & 31)] = v[i];
    asm volatile("s_waitcnt lgkmcnt(0)" ::: "memory");
    const int c = lane & 7;
#pragma unroll
    for (int j = 0; j < 4; ++j) { const int nl = (lane >> 3) + 8 * j, n = n0 + nl;
        if (n < N) { const LAS float* s = scr + (8 * c) * 33 + nl;
            u32x4_t o; o.x = pk2(s[0 * 33], s[1 * 33]); o.y = pk2(s[2 * 33], s[3 * 33]); o.z = pk2(s[4 * 33], s[5 * 33]); o.w = pk2(s[6 * 33], s[7 * 33]);
            *(u32x4_t*)(WT + (size_t)rm(n) * K + k0 + 8 * c) = o; } }
    asm volatile("s_waitcnt lgkmcnt(0)" ::: "memory");
}
struct RmIdent { __device__ __forceinline__ int operator()(int n) const { return n; } };
struct RmWin {
    __device__ __forceinline__ int operator()(int c) const {
        const int nc = c < 2560 ? c : (c < 2608 ? 4608 + (c - 2560) : 2560 + (c - 2608));
        const int tile = nc >> 8, L = nc & 255, wc = L >> 6, bj = (L >> 5) & 1, j = L & 31;
        return tile * 256 + 128 * bj + 32 * wc + j;
    }
};
struct RmWup {
    __device__ __forceinline__ int operator()(int c) const { const int up = c >= D_FF, cc = up ? c - D_FF : c; return (cc >> 7) * 256 + up * 128 + (cc & 127); }
};

struct Ptrs {
    const float* in[18]; float* out; unsigned char* ws;
};

__device__ __forceinline__ void p0_prologue(const Ptrs& P, LAS unsigned char* lds, int vcu, int G, const int wave) {
    const int lane = fresh_lane();
    LAS float* scr = (LAS float*)(lds + wave * 16384);
    const int gw = vcu * NWAVES + wave, NGW = G * NWAVES;
    unsigned char* ws = P.ws;
    bf16_t* WinT = (bf16_t*)(ws + WS_WIN); bf16_t* WoutT = (bf16_t*)(ws + WS_WOUT); bf16_t* WupT = (bf16_t*)(ws + WS_WUP); bf16_t* WdownT = (bf16_t*)(ws + WS_WDOWN); bf16_t* W1cT = (bf16_t*)(ws + WS_W1C);
    const float* x = P.in[0]; const float* attn_norm_w = P.in[1]; const float* w_in = P.in[2]; const float* cmp_pos = P.in[5]; const float* cmp_w1 = P.in[6];
    const float* w_out = P.in[12]; const float* ffn_norm_w = P.in[13]; const float* w_up = P.in[14]; const float* w_down = P.in[17];
    constexpr int I_IN = 32 * 146, I_W1 = 32 * 8, I_W2 = 4 * 2;
    constexpr int NITEMS = I_IN + 2 * I_W1 + 2 * I_W2;
    (void)w_out; (void)w_up; (void)w_down; (void)ffn_norm_w; (void)WoutT; (void)WupT; (void)WdownT;
    for (int it = gw; it < NITEMS; it += NGW) {
        int r = it;
        if (r < I_IN) { transpose_item(w_in, 2048, IN_COLS, WinT, nullptr, RmWin(), scr, r, lane); continue; } r -= I_IN;
        if (r < I_W1) { transpose_item(cmp_w1, 2048, 256, W1cT, nullptr, RmIdent(), scr, r, lane); continue; } r -= I_W1;
        if (r < I_W1) { transpose_item(cmp_w1 + (size_t)2048 * 256, 2048, 256, W1cT + (size_t)256 * 2048, nullptr, RmIdent(), scr, r, lane); continue; } r -= I_W1;
        { const int kv = r >= I_W2 ? 1 : 0; transpose_item(P.in[7] + (size_t)kv * 256 * 64, 256, 64, (bf16_t*)(ws + WS_SMALL + SM_W2T) + (size_t)kv * 64 * 256, nullptr, RmIdent(), scr, r - kv * I_W2, lane); }
    }
    for (int i = gw * 64 + lane; i < 8 * 16384; i += NGW * 64) { const int t = (i >> 7) & 127, sx = i & 127; ((bf16_t*)(ws + WS_SMALL + SM_SWB))[i] = (bf16_t)(sx <= t ? f2bf(P.in[10][i]) : 0u); }
    for (int p = gw; p < 256; p += NGW) {
        const int L = 64 * ((p >> 5) & 3) + 32 * (p >> 7) + (p & 31);
        if (L >= 48) { u32x4_t z = {0u, 0u, 0u, 0u}; u32x4_t* d = (u32x4_t*)(WinT + (size_t)(18 * 256 + p) * 2048);
#pragma unroll
            for (int j = 0; j < 4; ++j) d[lane + 64 * j] = z; }
    }
    bf16_t* XN = (bf16_t*)(ws + WS_XN);
    for (int m = gw; m < MTOK; m += 2 * NGW) {
        const int m2 = m + NGW;
        const f32x4_t* xr = (const f32x4_t*)(x + (size_t)m * D_MODEL) + lane;
        const f32x4_t* xr2 = (const f32x4_t*)(x + (size_t)(m2 < MTOK ? m2 : m) * D_MODEL) + lane;
        f32x4_t v[8], v2[8]; float s = 0.f, s2 = 0.f;
#pragma unroll
        for (int j = 0; j < 8; ++j) { v[j] = xr[64 * j]; v2[j] = xr2[64 * j]; }
#pragma unroll
        for (int j = 0; j < 8; ++j) { s += (v[j][0] * v[j][0] + v[j][1] * v[j][1]) + (v[j][2] * v[j][2] + v[j][3] * v[j][3]); s2 += (v2[j][0] * v2[j][0] + v2[j][1] * v2[j][1]) + (v2[j][2] * v2[j][2] + v2[j][3] * v2[j][3]); }
        const float ms1 = wave_sum(s) * (1.0f / D_MODEL) + 1e-6f, ms2 = wave_sum(s2) * (1.0f / D_MODEL) + 1e-6f;
        const float r = __builtin_amdgcn_rsqf(ms1), r2 = __builtin_amdgcn_rsqf(ms2);
        if (lane == 0) { float* rinv = (float*)(ws + WS_SMALL + SM_RINV); rinv[m] = ms1 * r; if (m2 < MTOK) rinv[m2] = ms2 * r2; }
        u32x2_t* o8 = (u32x2_t*)(XN + (size_t)m * D_MODEL) + lane; u32x2_t* o82 = (u32x2_t*)(XN + (size_t)m2 * D_MODEL) + lane;
#pragma unroll
        for (int j = 0; j < 8; ++j) { const f32x4_t w = ((const f32x4_t*)attn_norm_w)[lane + 64 * j];
            u32x2_t o; o.x = pk2(v[j][0] * r * w[0], v[j][1] * r * w[1]); o.y = pk2(v[j][2] * r * w[2], v[j][3] * r * w[3]); o8[64 * j] = o;
            if (m2 < MTOK) { u32x2_t q; q.x = pk2(v2[j][0] * r2 * w[0], v2[j][1] * r2 * w[1]); q.y = pk2(v2[j][2] * r2 * w[2], v2[j][3] * r2 * w[3]); o82[64 * j] = q; } }
    }
    for (int i = gw * 64 + lane; i < D_MODEL; i += NGW * 64) ((float*)(ws + WS_SMALL + SM_INVW))[i] = 1.0f / attn_norm_w[i];
    float* BIASP = (float*)(ws + WS_SMALL + SM_BIASP);
    for (int it = gw; it < 64; it += NGW) {
        const int kv = it >> 5, kc = it & 31; f32x4_t a = {0.f, 0.f, 0.f, 0.f};
        const float* pp = cmp_pos + kv * 2048 + kc * 64; const float* w1 = cmp_w1 + ((size_t)kv * 2048 + kc * 64) * 256;
        for (int k = 0; k < 64; ++k) { const f32x4_t w = ((const f32x4_t*)(w1 + (size_t)k * 256))[lane]; a += w * pp[k]; }
        ((f32x4_t*)(BIASP + (size_t)it * 256))[lane] = a;
    }
}

__device__ __forceinline__ void bias1_stage(unsigned char* ws, int idx  ) {
    const float* BIASP = (const float*)(ws + WS_SMALL + SM_BIASP); float* BIAS1 = (float*)(ws + WS_SMALL + SM_BIAS1);
    const int kv = idx >> 8, j = idx & 255; float s = 0.f;
    for (int kc = 0; kc < 32; ++kc) s += BIASP[(size_t)(kv * 32 + kc) * 256 + j];
    BIAS1[idx] = s;
}
__device__ __forceinline__ void cmp2_row(const Ptrs& P, int R, int lane) {
    unsigned char* ws = P.ws; const bf16_t* HC = (const bf16_t*)(ws + WS_HC);
    const int kv = R >> 12, rr = R & 4095, n = rr & 255;
    bf16_t* dst = (bf16_t*)(ws + (kv ? WS_VC : WS_KC)) + (size_t)rr * 64 + lane;
    if (n == 255) { *dst = 0; return; }
    const float* w2 = P.in[7] + (size_t)kv * 256 * 64;
    const u32x2_t hr = *(const u32x2_t*)(HC + (size_t)R * 256 + 4 * lane);
    float h[4] = {__uint_as_float(hr.x << 16), __uint_as_float(hr.x & 0xffff0000u), __uint_as_float(hr.y << 16), __uint_as_float(hr.y & 0xffff0000u)};
    float o = 0.f;
    for (int jj = 0; jj < 64; ++jj) {
#pragma unroll
        for (int i = 0; i < 4; ++i) o += __shfl(h[i], jj) * w2[(size_t)(4 * jj + i) * 64 + lane];
    }
    if (kv == 0) { const float ss = wave_sum(o * o); o *= __builtin_amdgcn_rsqf(ss * (1.0f / 64.0f) + 1e-6f) * P.in[4][lane]; }
    *dst = (bf16_t)f2bf(o);
}

__device__ __forceinline__ void gmlp_unit_v1(const Ptrs& P, LAS unsigned char* lds, int unit, const int wave_s) {
    unsigned char* ws = P.ws; const int tid = fresh_tid(wave_s);
    const int g = unit & 7, chunk = (unit >> 3) & 31, b = unit >> 8; const int m0 = b * SEQ + chunk * 128;
    LAS float* vn = (LAS float*)lds; LAS float* Wl = (LAS float*)(lds + 65536); LAS float* st = (LAS float*)(lds + 131072);
    const bf16_t* GV = (const bf16_t*)(ws + WS_GV); const bf16_t* U = (const bf16_t*)(ws + WS_U); const float* VSTAT = (const float*)(ws + WS_VSTAT);
    bf16_t* AB = (bf16_t*)(ws + WS_AB);
    const float* ln_w = P.in[8]; const float* ln_b = P.in[9]; const float* sw = P.in[10]; const float* sb = P.in[11];
    if (tid < 128) { const float* p = VSTAT + (size_t)(m0 + tid) * 32; float s1 = 0.f, s2 = 0.f;
#pragma unroll
        for (int i = 0; i < 16; ++i) { s1 += p[2 * i]; s2 += p[2 * i + 1]; }
        const float mean = s1 * (1.0f / 1024.0f); float var = s2 * (1.0f / 1024.0f) - mean * mean; var = var < 0.f ? 0.f : var;
        st[2 * tid] = mean; st[2 * tid + 1] = __builtin_amdgcn_rsqf(var + 1e-5f); }
    for (int i = 0; i < 32; ++i) { const int idx = tid + 512 * i, t = idx >> 7, s = idx & 127; Wl[idx] = (s <= t) ? sw[(size_t)g * 16384 + idx] : 0.f; }
    __syncthreads();
#pragma unroll
    for (int i = 0; i < 4; ++i) { const int idx = tid + 512 * i, s = idx >> 4, c8 = idx & 15;
        const u32x4_t raw = *(const u32x4_t*)(GV + (size_t)(m0 + s) * 1024 + g * 128 + 8 * c8); float f[8]; unpack8(raw, f);
        const float mean = st[2 * s], rstd = st[2 * s + 1];
#pragma unroll
        for (int e = 0; e < 8; ++e) { const int c = g * 128 + 8 * c8 + e; vn[s * 128 + 8 * c8 + e] = (f[e] - mean) * rstd * ln_w[c] + ln_b[c]; } }
    __syncthreads();
    const int c = tid & 127, tq = tid >> 7;
    for (int i = 0; i < 8; ++i) {
        const int t0 = 4 * (tq + 4 * i); float a0 = 0.f, a1 = 0.f, a2 = 0.f, a3 = 0.f;
        for (int s4 = 0; s4 <= t0; s4 += 4) {
            const f32x4_t w0 = *(const LAS f32x4_t*)(Wl + (t0 + 0) * 128 + s4), w1 = *(const LAS f32x4_t*)(Wl + (t0 + 1) * 128 + s4), w2 = *(const LAS f32x4_t*)(Wl + (t0 + 2) * 128 + s4), w3 = *(const LAS f32x4_t*)(Wl + (t0 + 3) * 128 + s4);
#pragma unroll
            for (int k = 0; k < 4; ++k) { const float v = vn[(s4 + k) * 128 + c]; a0 += w0[k] * v; a1 += w1[k] * v; a2 += w2[k] * v; a3 += w3[k] * v; }
        }
        const float av[4] = {a0, a1, a2, a3};
#pragma unroll
        for (int k = 0; k < 4; ++k) { const int t = t0 + k; const size_t row = (size_t)(m0 + t);
            const float uu = bf2f(U[row * 1024 + g * 128 + c]); AB[row * 2048 + 1024 + g * 128 + c] = (bf16_t)f2bf(uu * (av[k] + sb[g * 128 + t])); }
    }
    __syncthreads();
}

__device__ __forceinline__ void conv_item(const Ptrs& P, int b, int idx) {
    const int t = idx / 704, c8 = idx % 704, c0 = 8 * c8, j = c0 >> 7, i0 = c0 & 127;
    const bf16_t* HID = (const bf16_t*)(P.ws + WS_HID); const float* cw = P.in[15]; const float* cb = P.in[16];
    float gt[8], up[8];
#pragma unroll
    for (int e = 0; e < 8; ++e) { gt[e] = cb[c0 + e]; up[e] = cb[D_FF + c0 + e]; }
#pragma unroll
    for (int k = 0; k < 3; ++k) { const int tt = t - 2 + k; if (tt < 0) continue;
        float hg[8], hu[8]; unpack8(*(const u32x4_t*)(HID + (size_t)tt * N_UP + 256 * j + i0), hg); unpack8(*(const u32x4_t*)(HID + (size_t)tt * N_UP + 256 * j + 128 + i0), hu);
#pragma unroll
        for (int e = 0; e < 8; ++e) { gt[e] += cw[(size_t)k * N_UP + c0 + e] * hg[e]; up[e] += cw[(size_t)k * N_UP + D_FF + c0 + e] * hu[e]; } }
    float r[8];
#pragma unroll
    for (int e = 0; e < 8; ++e) r[e] = gt[e] * sigmoidf_(gt[e]) * up[e];
    u32x4_t o; o.x = pk2(r[0], r[1]); o.y = pk2(r[2], r[3]); o.z = pk2(r[4], r[5]); o.w = pk2(r[6], r[7]);
    *(u32x4_t*)((bf16_t*)(P.ws + WS_G) + ((size_t)b * SEQ + t) * D_FF + c0) = o;
}

constexpr int LW_CH = 32;
constexpr int LW_OUT = 32 * 64, LW_UP = 32 * 352, LW_DOWN = 88 * 64, LW_C_OUT = LW_OUT / LW_CH, LW_C_UP = LW_UP / LW_CH, LW_C_DOWN = LW_DOWN / LW_CH, LW_CHUNKS = LW_C_OUT + LW_C_UP + LW_C_DOWN;
static_assert(LW_OUT % LW_CH == 0 && LW_UP % LW_CH == 0 && LW_DOWN % LW_CH == 0, "late weight items per chunk");
template <class RowMap>
__device__ __forceinline__ void lw_load(float (&v)[32], const float* __restrict__ W, int N, int item, int lane) {
    const int nblk = N / 32, kb = item / nblk, nb = item % nblk;
    const float* p = W + (size_t)(64 * kb + (lane >> 5)) * N + 32 * nb + (lane & 31);
#pragma unroll
    for (int i = 0; i < 32; ++i) v[i] = p[(size_t)(2 * i) * N];
}
template <class RowMap>
__device__ __forceinline__ void lw_store(const float (&v)[32], int K, int N, bf16_t* WT, const float* __restrict__ kscale, RowMap rm, LAS float* scr, int item, int lane) {
    const int nblk = N / 32, kb = item / nblk, nb = item % nblk, k0 = 64 * kb, n0 = 32 * nb;
    const int c = lane & 7;
    f32x4_t sc0 = {1.f, 1.f, 1.f, 1.f}, sc1 = sc0;
    if (kscale) { sc0 = *(const f32x4_t*)(kscale + k0 + 8 * c); sc1 = *(const f32x4_t*)(kscale + k0 + 8 * c + 4); }
#pragma unroll
    for (int i = 0; i < 32; ++i) scr[(2 * i + (lane >> 5)) * 33 + (lane & 31)] = v[i];
    asm volatile("s_waitcnt lgkmcnt(0)" ::: "memory");
#pragma unroll
    for (int j = 0; j < 4; ++j) { const int nl = (lane >> 3) + 8 * j; const LAS float* s = scr + (8 * c) * 33 + nl;
        u32x4_t o; o.x = pk2(s[0 * 33] * sc0[0], s[1 * 33] * sc0[1]); o.y = pk2(s[2 * 33] * sc0[2], s[3 * 33] * sc0[3]); o.z = pk2(s[4 * 33] * sc1[0], s[5 * 33] * sc1[1]); o.w = pk2(s[6 * 33] * sc1[2], s[7 * 33] * sc1[3]);
        *(u32x4_t*)(WT + (size_t)rm(n0 + nl) * K + k0 + 8 * c) = o; }
    asm volatile("s_waitcnt lgkmcnt(0)" ::: "memory");
}
template <class RowMap>
__device__ __forceinline__ void lw_run(const float* __restrict__ W, int K, int N, bf16_t* WT, const float* __restrict__ kscale, RowMap rm, LAS float* scr, int item0, int wave, int lane) {
    float va[32], vb[32];
    lw_load<RowMap>(va, W, N, item0 + wave, lane);
    lw_load<RowMap>(vb, W, N, item0 + wave + 8, lane);  lw_store(va, K, N, WT, kscale, rm, scr, item0 + wave, lane);
    lw_load<RowMap>(va, W, N, item0 + wave + 16, lane); lw_store(vb, K, N, WT, kscale, rm, scr, item0 + wave + 8, lane);
    lw_load<RowMap>(vb, W, N, item0 + wave + 24, lane); lw_store(va, K, N, WT, kscale, rm, scr, item0 + wave + 16, lane);
    lw_store(vb, K, N, WT, kscale, rm, scr, item0 + wave + 24, lane);
}
__device__ __forceinline__ void late_weight_chunk(const Ptrs& P, LAS unsigned char* lds, int chunk, const int wave) {
    const int lane = fresh_lane();
    LAS float* scr = (LAS float*)(lds + wave * 16384);
    unsigned char* ws = P.ws;
    if (chunk < LW_C_UP) lw_run(P.in[14], 2048, N_UP, (bf16_t*)(ws + WS_WUP), P.in[13], RmWup(), scr, chunk * LW_CH, wave, lane);
    else if (chunk < LW_C_UP + LW_C_DOWN) lw_run(P.in[17], D_FF, 2048, (bf16_t*)(ws + WS_WDOWN), nullptr, RmIdent(), scr, (chunk - LW_C_UP) * LW_CH, wave, lane);
    else lw_run(P.in[12], 2048, 2048, (bf16_t*)(ws + WS_WOUT), nullptr, RmIdent(), scr, (chunk - LW_C_UP - LW_C_DOWN) * LW_CH, wave, lane);
}

namespace nsa {
using bf16x8 = __attribute__((ext_vector_type(8))) short;
using s16x4 = __attribute__((ext_vector_type(4))) short;
using f32x16 = __attribute__((ext_vector_type(16))) float;
typedef float f32x2_t __attribute__((ext_vector_type(2))); typedef __bf16 bf16x2_t __attribute__((ext_vector_type(2)));
constexpr int L_K = 0, L_V = 16384, L_WSF = 32768, L_OST = 34816, L_IMP = 100352, L_MASK = 116736, L_WU = 117248, L_END = 117312;
constexpr int SLOTB = 8192;
constexpr float THR = 8.0f;
#define NSA_SBAR() __builtin_amdgcn_sched_barrier(0)
__device__ __forceinline__ int crow(int r, int hi) { return (r & 3) + 8 * (r >> 2) + 4 * hi; }
__device__ __forceinline__ void glds16(const void* gbase  , unsigned voff  , unsigned lds_dst) { unsigned keep;
    asm volatile("s_mov_b32 %0, m0\n\ts_mov_b32 m0, %3\n\ts_nop 0\n\tglobal_load_lds_dwordx4 %1, %2\n\ts_mov_b32 m0, %0" : "=&s"(keep) : "v"(voff), "s"(gbase), "s"(lds_dst) : "memory"); }
__device__ __forceinline__ unsigned cvtpk_s(float lo, float hi) { f32x2_t v = {lo, hi}; bf16x2_t b = __builtin_convertvector(v, bf16x2_t); return __builtin_bit_cast(unsigned, b); }
#define NSA_WAIT_BAR() asm volatile("s_waitcnt vmcnt(0) lgkmcnt(0)\n\ts_barrier" ::: "memory")

__device__ __forceinline__ void qkt(f32x16& p0, f32x16& p1, LAS const char* Kslot, const bf16x8 (&qr)[4], int r32, int hi) {
    LAS const char* kb = Kslot + hi * 1024 + r32 * 16;
#pragma unroll
    for (int d0 = 0; d0 < 4; ++d0) {
        const bf16x8 b0 = *(LAS const bf16x8*)(kb + d0 * 2048);
        const bf16x8 b1 = *(LAS const bf16x8*)(kb + d0 * 2048 + 512);
        p0 = __builtin_amdgcn_mfma_f32_32x32x16_bf16(b0, qr[d0], p0, 0, 0, 0); p1 = __builtin_amdgcn_mfma_f32_32x32x16_bf16(b1, qr[d0], p1, 0, 0, 0);
    }
}
struct VFrag { s16x4 lo[2][4], hi[2][4]; };
__device__ __forceinline__ void vload(VFrag& f, int vb) {
#pragma unroll
    for (int d0 = 0; d0 < 2; ++d0)
#pragma unroll
        for (int ks = 0; ks < 4; ++ks) {
            asm volatile("ds_read_b64_tr_b16 %0,%1 offset:%c2" : "=&v"(f.lo[d0][ks]) : "v"(vb), "i"(d0 * 4096 + ks * 1024) : "memory");
            asm volatile("ds_read_b64_tr_b16 %0,%1 offset:%c2" : "=&v"(f.hi[d0][ks]) : "v"(vb), "i"(d0 * 4096 + ks * 1024 + 512) : "memory"); }
}
__device__ __forceinline__ void pvmma(f32x16 (&o)[2], VFrag& f, bf16x8 pa0, bf16x8 pa1, bf16x8 pa2, bf16x8 pa3) {
    asm volatile("s_waitcnt lgkmcnt(0)" : "+v"(f.lo[0][0]), "+v"(f.lo[0][1]), "+v"(f.lo[0][2]), "+v"(f.lo[0][3]), "+v"(f.hi[0][0]), "+v"(f.hi[0][1]), "+v"(f.hi[0][2]), "+v"(f.hi[0][3]) :: "memory");
    asm volatile("" : "+v"(f.lo[1][0]), "+v"(f.lo[1][1]), "+v"(f.lo[1][2]), "+v"(f.lo[1][3]), "+v"(f.hi[1][0]), "+v"(f.hi[1][1]), "+v"(f.hi[1][2]), "+v"(f.hi[1][3]));
    NSA_SBAR();
#pragma unroll
    for (int d0 = 0; d0 < 2; ++d0) {
#define NSA_PK(k) (bf16x8){f.lo[d0][k][0], f.lo[d0][k][1], f.lo[d0][k][2], f.lo[d0][k][3], f.hi[d0][k][0], f.hi[d0][k][1], f.hi[d0][k][2], f.hi[d0][k][3]}
        o[d0] = __builtin_amdgcn_mfma_f32_32x32x16_bf16(pa0, NSA_PK(0), o[d0], 0, 0, 0);
        o[d0] = __builtin_amdgcn_mfma_f32_32x32x16_bf16(pa1, NSA_PK(1), o[d0], 0, 0, 0);
        o[d0] = __builtin_amdgcn_mfma_f32_32x32x16_bf16(pa2, NSA_PK(2), o[d0], 0, 0, 0);
        o[d0] = __builtin_amdgcn_mfma_f32_32x32x16_bf16(pa3, NSA_PK(3), o[d0], 0, 0, 0);
#undef NSA_PK
    }
}
__device__ __forceinline__ void pv(f32x16 (&o)[2], int vb, bf16x8 pa0, bf16x8 pa1, bf16x8 pa2, bf16x8 pa3) { VFrag f; vload(f, vb); pvmma(o, f, pa0, pa1, pa2, pa3); }
__device__ __forceinline__ float rowmax32(const f32x16& p0, const f32x16& p1) {
    float a = __builtin_fmaxf(p0[0], p1[0]);
#pragma unroll
    for (int r = 1; r < 16; ++r) a = __builtin_fmaxf(a, __builtin_fmaxf(p0[r], p1[r]));
    auto rr = __builtin_amdgcn_permlane32_swap(__float_as_uint(a), __float_as_uint(a), false, false);
    return __builtin_fmaxf(__uint_as_float(rr[0]), __uint_as_float(rr[1]));
}
struct State { float m, l; f32x16 o[2]; };
__device__ __forceinline__ void state_init(State& s) { s.m = -1e30f; s.l = 0.f; s.o[0] = f32x16{}; s.o[1] = f32x16{}; }

template <int BMUL, int MASK, bool LOADV>
__device__ __forceinline__ void tile_scores(f32x16& p0, f32x16& p1, LAS const char* Kslot, const bf16x8 (&qr)[4], const f32x16& bk, float c0, float b32, int lim, int r32, int hi, VFrag& vf, int vb) {
#pragma unroll
    for (int r = 0; r < 16; ++r) { const float b = (BMUL == 1) ? bk[r] + c0 : __builtin_fmaf(bk[r], (float)BMUL, c0); p0[r] = b; p1[r] = b + b32; }
    qkt(p0, p1, Kslot, qr, r32, hi);
    if (LOADV) vload(vf, vb);
    const int limh = lim - 4 * hi;
#pragma unroll
    for (int r = 0; r < 16; ++r) {
        const int kk = (r & 3) + 8 * (r >> 2);
        if (MASK == 1) { if (!(kk <= limh)) p0[r] = -INFINITY; if (!(kk + 32 <= limh)) p1[r] = -INFINITY; }
        if (MASK == 2) { if (!(kk > limh)) p0[r] = -INFINITY; if (!(kk + 32 > limh)) p1[r] = -INFINITY; }
        if (MASK == 3) { if (!(kk < limh)) p0[r] = -INFINITY; if (!(kk + 32 < limh)) p1[r] = -INFINITY; }
    }
}
__device__ __forceinline__ float tile_ref(const State& st, float rb0, bool rowlive) { return (st.m < -1e29f && rowlive) ? rb0 : st.m; }
__device__ __forceinline__ void tile_softmax_pv(State& st, f32x16& p0, f32x16& p1, float mref, VFrag& vf, LAS float* wsf, int r32, int hi) {
    float a0 = p0[0], a1 = p1[0];
#pragma unroll
    for (int r = 1; r < 16; ++r) { a0 = __builtin_fmaxf(a0, p0[r]); a1 = __builtin_fmaxf(a1, p1[r]); }
    float mx = __builtin_fmaxf(a0, a1);
    { auto rr = __builtin_amdgcn_permlane32_swap(__float_as_uint(mx), __float_as_uint(mx), false, false); mx = __builtin_fmaxf(__uint_as_float(rr[0]), __uint_as_float(rr[1])); }
    if (__any(mx > THR)) {
        const float dl = __builtin_fmaxf(mx, 0.f), alpha = __builtin_amdgcn_exp2f(-dl);
        mref += dl; st.l *= alpha;
        if (hi == 0) wsf[r32] = alpha;
        asm volatile("s_waitcnt lgkmcnt(0)" ::: "memory");
#pragma unroll
        for (int r = 0; r < 16; ++r) { const float a = wsf[crow(r, hi)]; st.o[0][r] *= a; st.o[1][r] *= a; p0[r] -= dl; p1[r] -= dl; }
    }
    st.m = mref;
    float ls = 0.f;
#pragma unroll
    for (int r = 0; r < 16; ++r) { p0[r] = __builtin_amdgcn_exp2f(p0[r]); p1[r] = __builtin_amdgcn_exp2f(p1[r]); ls += p0[r] + p1[r]; }
    st.l += ls;
    u32x4_t pw0, pw1, pw2, pw3;
    pw0 = (u32x4_t){cvtpk_s(p0[0], p0[1]), cvtpk_s(p0[2], p0[3]), cvtpk_s(p0[4], p0[5]), cvtpk_s(p0[6], p0[7])};
    pw1 = (u32x4_t){cvtpk_s(p0[8], p0[9]), cvtpk_s(p0[10], p0[11]), cvtpk_s(p0[12], p0[13]), cvtpk_s(p0[14], p0[15])};
    pw2 = (u32x4_t){cvtpk_s(p1[0], p1[1]), cvtpk_s(p1[2], p1[3]), cvtpk_s(p1[4], p1[5]), cvtpk_s(p1[6], p1[7])};
    pw3 = (u32x4_t){cvtpk_s(p1[8], p1[9]), cvtpk_s(p1[10], p1[11]), cvtpk_s(p1[12], p1[13]), cvtpk_s(p1[14], p1[15])};
    pvmma(st.o, vf, __builtin_bit_cast(bf16x8, pw0), __builtin_bit_cast(bf16x8, pw1), __builtin_bit_cast(bf16x8, pw2), __builtin_bit_cast(bf16x8, pw3));
}
template <bool FIRST>
__device__ __forceinline__ void fold_branch(LAS float* ostg, State& st, float gate, LAS float* wsf, int r32, int hi) {
    float l = st.l;
    { auto rr = __builtin_amdgcn_permlane32_swap(__float_as_uint(l), __float_as_uint(l), false, false); l = __uint_as_float(rr[0]) + __uint_as_float(rr[1]); }
    const float f = l > 0.f ? gate / l : 0.f;
    asm volatile("s_waitcnt lgkmcnt(0)" ::: "memory");
    if (hi == 0) wsf[r32] = f;
    asm volatile("s_waitcnt lgkmcnt(0)" ::: "memory");
#pragma unroll
    for (int r = 0; r < 16; ++r) { const int orow = crow(r, hi); const float a = wsf[orow];
#pragma unroll
        for (int d0 = 0; d0 < 2; ++d0) { LAS float* p = ostg + orow * 64 + d0 * 32 + r32; if (FIRST) *p = st.o[d0][r] * a; else *p += st.o[d0][r] * a; } }
    asm volatile("s_waitcnt lgkmcnt(0)" ::: "memory");
}

__device__ __forceinline__ int nsa_unit(const Ptrs& P, LAS unsigned char* lds, int bg, int qt, const int wave_s, unsigned* qctr, int qbase) {
    unsigned char* ws = P.ws;
    const int lane = fresh_lane(), r32 = lane & 31, hi = lane >> 5; const int wid = wave_s;
    const int b = bg >> 2, g = bg & 3, t0 = 64 * qt;
    const int tl = 8 * wid + (r32 >> 2), hq = r32 & 3;
    const size_t m0 = (size_t)b * SEQ + t0;
    const bf16_t* Q = (const bf16_t*)(ws + WS_Q); const bf16_t* KV6 = (const bf16_t*)(ws + WS_KV6);
    const bf16_t* KSb = KV6 + 2 * KVSZ + (size_t)bg * SEQ * 64; const bf16_t* VSb = KV6 + 3 * KVSZ + (size_t)bg * SEQ * 64;
    const bf16_t* KWb = KV6 + 4 * KVSZ + (size_t)bg * SEQ * 64; const bf16_t* VWb = KV6 + 5 * KVSZ + (size_t)bg * SEQ * 64;
    const bf16_t* KCb = (const bf16_t*)(ws + WS_KC) + (size_t)bg * 256 * 64; const bf16_t* VCb = (const bf16_t*)(ws + WS_VC) + (size_t)bg * 256 * 64;
    const float* GATES = (const float*)(ws + WS_GATES); bf16_t* AB = (bf16_t*)(ws + WS_AB);
    const unsigned lds0 = (unsigned)(uintptr_t)lds;
    LAS float* wsf = (LAS float*)(lds + L_WSF) + wid * 64;
    LAS float* IMP = (LAS float*)(lds + L_IMP);
    LAS unsigned* MASK = (LAS unsigned*)(lds + L_MASK); LAS unsigned* WU = (LAS unsigned*)(lds + L_WU);
    const int koff = lane * 64 + wid * 8, voff = (16 * (wid & 3) + (lane >> 2)) * 64 + (wid >> 2) * 32 + (lane & 3) * 8;
    const unsigned kdst = lds0 + L_K + wid * 1024, vdst = lds0 + L_V + wid * 1024;
#define NSA_DMA_K(base, tile, slot) glds16((base) + (size_t)(tile) * 4096, (unsigned)koff * 2u, (unsigned)__builtin_amdgcn_readfirstlane(kdst + (slot) * SLOTB))
#define NSA_DMA_V(base, tile, slot) glds16((base) + (size_t)(tile) * 4096, (unsigned)voff * 2u, (unsigned)__builtin_amdgcn_readfirstlane(vdst + (slot) * SLOTB))
    const int vb0 = (int)(lds0 + L_V) + ((lane >> 4) & 1) * 32 + (lane & 3) * 8 + (4 * hi + ((lane & 15) >> 2)) * 64;
    LAS const char* Kbase = (LAS const char*)(lds + L_K);
    bf16x8 qr[4];
    { const bf16_t* qp = Q + (m0 + tl) * 1024 + (4 * g + hq) * 64 + hi * 8;
#pragma unroll
      for (int d0 = 0; d0 < 4; ++d0) qr[d0] = *(const bf16x8*)(qp + d0 * 16); }
    const float sl2 = __builtin_amdgcn_exp2f(-0.5f * (float)(4 * g + hq + 1)) * LOG2E;
    f32x16 bk;
#pragma unroll
    for (int r = 0; r < 16; ++r) bk[r] = sl2 * (float)((r & 3) + 8 * (r >> 2));
    const float b32t = 32.0f * sl2, b32c = 512.0f * sl2, hoff_t = 4.0f * (float)hi * sl2, hoff_c = 64.0f * (float)hi * sl2;
    float gate[3];
    { const float* gp = GATES + (m0 + tl) * 48 + (4 * g + hq) * 3; gate[0] = gp[0]; gate[1] = gp[1]; gate[2] = gp[2]; }
    LAS float* ostg = (LAS float*)(lds + L_OST) + wid * 2048;
    State st;
    f32x16 p0, p1;
    int nxt_ticket = 0;

    int tc = 0;
    VFrag vf;
    const int nvmax = (t0 + 63 >= 31) ? ((t0 + 63 - 31) >> 4) + 1 : 0;
    const int nct = (nvmax + 63) >> 6;
    const int tq = t0 + tl, nv = tq >= 31 ? ((tq - 31) >> 4) + 1 : 0;
    {
        state_init(st);
        const int j0 = qt >= 8 ? qt - 8 : 0, nt = qt - j0 + 1;
        NSA_DMA_K(KWb, qt, 0); NSA_DMA_V(VWb, qt, 0); NSA_WAIT_BAR();
        for (int i = 0; i < nt; ++i) {
            const int j = qt - i, slot = (tc + i) & 1;
            if (i + 1 < nt) { NSA_DMA_K(KWb, j - 1, slot ^ 1); NSA_DMA_V(VWb, j - 1, slot ^ 1); }
            else { NSA_DMA_K(KCb, nct - 1, slot ^ 1); NSA_DMA_V(VCb, nct - 1, slot ^ 1); }
            const float rb0 = sl2 * (float)(64 * j - t0), mref = tile_ref(st, rb0, true), c0 = rb0 + hoff_t - mref;
            if (j == qt) tile_scores<1, 1, true>(p0, p1, Kbase + slot * SLOTB, qr, bk, c0, b32t, tl, r32, hi, vf, vb0 + slot * SLOTB);
            else if (j == qt - 8) tile_scores<1, 2, true>(p0, p1, Kbase + slot * SLOTB, qr, bk, c0, b32t, tl, r32, hi, vf, vb0 + slot * SLOTB);
            else tile_scores<1, 0, true>(p0, p1, Kbase + slot * SLOTB, qr, bk, c0, b32t, 0, r32, hi, vf, vb0 + slot * SLOTB);
            tile_softmax_pv(st, p0, p1, mref, vf, wsf, r32, hi);
            NSA_WAIT_BAR();
        }
        tc += nt;
        fold_branch<true>(ostg, st, gate[2], wsf, r32, hi);
    }
    {
        state_init(st);
        for (int ci = 0; ci < nct; ++ci) {
            const int c = nct - 1 - ci, slot = (tc + ci) & 1;
            if (ci + 1 < nct) { NSA_DMA_K(KCb, c - 1, slot ^ 1); NSA_DMA_V(VCb, c - 1, slot ^ 1); }
            else if (qt >= 16) { NSA_DMA_K(KCb, 0, slot ^ 1); }
            else { NSA_DMA_K(KSb, qt, slot ^ 1); NSA_DMA_V(VSb, qt, slot ^ 1); }
            const float rb0 = sl2 * ((float)(1024 * c - t0) + 15.5f), mref = tile_ref(st, rb0, true), c0 = rb0 + hoff_c - mref;
            tile_scores<16, 3, true>(p0, p1, Kbase + slot * SLOTB, qr, bk, c0, b32c, nv - 64 * c, r32, hi, vf, vb0 + slot * SLOTB);
            tile_softmax_pv(st, p0, p1, mref, vf, wsf, r32, hi);
            NSA_WAIT_BAR();
        }
        tc += nct;
    }
    const float mc_fin = st.m; float lc = st.l;
    fold_branch<false>(ostg, st, gate[0], wsf, r32, hi);
    if (qt >= 16) {
        { auto rr = __builtin_amdgcn_permlane32_swap(__float_as_uint(lc), __float_as_uint(lc), false, false); lc = __uint_as_float(rr[0]) + __uint_as_float(rr[1]); }
        const float invl = lc > 0.f ? 1.0f / lc : 0.f;
        float carry = 0.f;
        for (int c = 0; c < nct; ++c) {
            const int slot = (tc + c) & 1;
            if (c + 1 < nct) { NSA_DMA_K(KCb, c + 1, slot ^ 1); }
            else { NSA_DMA_K(KSb, qt, slot ^ 1); NSA_DMA_V(VSb, qt, slot ^ 1); }
            const float c0 = sl2 * ((float)(1024 * c - t0) + 15.5f) + hoff_c - mc_fin;
            tile_scores<16, 3, false>(p0, p1, Kbase + slot * SLOTB, qr, bk, c0, b32c, nv - 64 * c, r32, hi, vf, 0);
#pragma unroll
            for (int r = 0; r < 16; ++r) { p0[r] = __builtin_amdgcn_exp2f(p0[r]) * invl; p1[r] = __builtin_amdgcn_exp2f(p1[r]) * invl; }
            float imp0[4], imp1[4], pl0[4], pl1[4];
#pragma unroll
            for (int a = 0; a < 4; ++a) {
                imp0[a] = (p0[4 * a] + p0[4 * a + 1]) + (p0[4 * a + 2] + p0[4 * a + 3]); imp1[a] = (p1[4 * a] + p1[4 * a + 1]) + (p1[4 * a + 2] + p1[4 * a + 3]);
                pl0[a] = __shfl_xor(p0[4 * a + 3], 32); pl1[a] = __shfl_xor(p1[4 * a + 3], 32);
            }
            if (hi) {
#pragma unroll
                for (int a = 0; a < 4; ++a) { imp0[a] += pl0[a]; imp1[a] += pl1[a]; }
            } else {
                imp0[0] += carry; imp1[0] += pl0[3];
#pragma unroll
                for (int a = 1; a < 4; ++a) { imp0[a] += pl0[a - 1]; imp1[a] += pl1[a - 1]; }
            }
            carry = pl1[3];
#pragma unroll
            for (int a = 0; a < 4; ++a) {
                imp0[a] += __shfl_xor(imp0[a], 1); imp0[a] += __shfl_xor(imp0[a], 2); imp1[a] += __shfl_xor(imp1[a], 1); imp1[a] += __shfl_xor(imp1[a], 2);
                if (hq == 0) { IMP[tl * 64 + 16 * c + 2 * a + hi] = imp0[a]; IMP[tl * 64 + 16 * c + 8 + 2 * a + hi] = imp1[a]; }
            }
            NSA_WAIT_BAR();
        }
        tc += nct;
    }
    unsigned long long wu = 0ull;
    if (qt < 16) {
        wu = (2ull << qt) - 1ull;
        if (lane < 8) { MASK[2 * (8 * wid + lane)] = (unsigned)wu; MASK[2 * (8 * wid + lane) + 1] = (unsigned)(wu >> 32); }
    } else {
        const int j = lane; const bool valid = j <= qt, forced = (j == 0) || (j == qt) || (j == qt - 1);
        for (int k = 0; k < 8; ++k) {
            const float imp = IMP[(8 * wid + k) * 64 + j];
            const float scv = valid ? (forced ? 1e9f : imp) : -1e9f;
            const unsigned fb = __float_as_uint(scv), key = fb ^ ((fb >> 31) ? 0xffffffffu : 0x80000000u);
            unsigned T = 0u;
#pragma unroll
            for (int bit = 31; bit >= 0; --bit) { const unsigned cand = T | (1u << bit); if (__builtin_popcountll(__ballot(key >= cand)) >= 16) T = cand; }
            const unsigned long long gt = __ballot(key > T), eq = __ballot(key == T);
            const int need = 16 - __builtin_popcountll(gt);
            const int before = (int)__builtin_amdgcn_mbcnt_hi((unsigned)(eq >> 32), __builtin_amdgcn_mbcnt_lo((unsigned)eq, 0u));
            const bool sel = (key > T) || ((key == T) && (before < need));
            const unsigned long long mk = __ballot(sel && (scv > -0.5e9f));
            wu |= mk;
            if (lane == 0) { MASK[2 * (8 * wid + k)] = (unsigned)mk; MASK[2 * (8 * wid + k) + 1] = (unsigned)(mk >> 32); }
        }
    }
    if (lane == 0) { WU[2 * wid] = (unsigned)wu; WU[2 * wid + 1] = (unsigned)(wu >> 32); }
    NSA_WAIT_BAR();
    unsigned long long uni = 0ull;
#pragma unroll
    for (int w = 0; w < 8; ++w) uni |= ((unsigned long long)WU[2 * w]) | (((unsigned long long)WU[2 * w + 1]) << 32);
    uni = ((unsigned long long)(unsigned)__builtin_amdgcn_readfirstlane((unsigned)uni)) | (((unsigned long long)(unsigned)__builtin_amdgcn_readfirstlane((unsigned)(uni >> 32))) << 32);
    const unsigned long long mymask = ((unsigned long long)MASK[2 * tl]) | (((unsigned long long)MASK[2 * tl + 1]) << 32);
    {
        state_init(st);
        unsigned long long rem = uni;
        int j = 63 - __builtin_clzll(rem); rem &= ~(1ull << j);
        for (int i = 0;; ++i) {
            const int slot = (tc + i) & 1; const bool more = rem != 0ull;
            int jn = 0;
            if (more) { jn = 63 - __builtin_clzll(rem); rem &= ~(1ull << jn); NSA_DMA_K(KSb, jn, slot ^ 1); NSA_DMA_V(VSb, jn, slot ^ 1); }
            if ((wu >> j) & 1ull) {
                const bool live = ((mymask >> j) & 1ull) != 0ull;
                const float rb0 = sl2 * (float)(64 * j - t0), mref = tile_ref(st, rb0, live), c0 = live ? rb0 + hoff_t - mref : -INFINITY;
                if (j == qt) tile_scores<1, 1, true>(p0, p1, Kbase + slot * SLOTB, qr, bk, c0, b32t, tl, r32, hi, vf, vb0 + slot * SLOTB);
                else tile_scores<1, 0, true>(p0, p1, Kbase + slot * SLOTB, qr, bk, c0, b32t, 0, r32, hi, vf, vb0 + slot * SLOTB);
                tile_softmax_pv(st, p0, p1, mref, vf, wsf, r32, hi);
            }
            NSA_WAIT_BAR();
            if (!more) break;
            j = jn;
        }
        if (wid == 0 && lane == 0) nxt_ticket = qbase + (int)__hip_atomic_fetch_add(qctr, 1u, __ATOMIC_RELAXED, __HIP_MEMORY_SCOPE_AGENT);
        fold_branch<false>(ostg, st, gate[1], wsf, r32, hi);
    }
    {
#pragma unroll
        for (int i = 0; i < 4; ++i) { const int row = i * 8 + (lane >> 3), ch = lane & 7;
            const f32x4_t v0 = *(LAS const f32x4_t*)(ostg + row * 64 + ch * 8), v1 = *(LAS const f32x4_t*)(ostg + row * 64 + ch * 8 + 4);
            u32x4_t v; v.x = cvtpk_s(v0[0], v0[1]); v.y = cvtpk_s(v0[2], v0[3]); v.z = cvtpk_s(v1[0], v1[1]); v.w = cvtpk_s(v1[2], v1[3]);
            *(u32x4_t*)(AB + (m0 + 8 * wid + (row >> 2)) * 2048 + 256 * g + (row & 3) * 64 + ch * 8) = v; }
    }
    NSA_WAIT_BAR();
#undef NSA_DMA_K
#undef NSA_DMA_V
    return nxt_ticket;
}
constexpr int L_QS = 145416;
__device__ __forceinline__ void nsa_phase(const Ptrs& P, LAS unsigned char* lds, int bid, int G, const int wave_s) {
    unsigned* qctr = (unsigned*)(P.ws + WS_CTL) + 3584;
    LAS int* qs = (LAS int*)(lds + L_QS);
    int k = bid;
    while (k < 1024 + LW_CHUNKS) {
        int nxt;
        if (k < 1024) {
            const int qt = 63 - (k >> 4), g = 3 - ((k >> 2) & 3), b = k & 3;
            nxt = nsa_unit(P, lds, b * 4 + g, qt, wave_s, qctr, G);
        } else {
            nxt = 0;
            if (wave_s == 0 && fresh_lane() == 0) nxt = G + (int)__hip_atomic_fetch_add(qctr, 1u, __ATOMIC_RELAXED, __HIP_MEMORY_SCOPE_AGENT);
            late_weight_chunk(P, lds, k - 1024, wave_s);
        }
        if (wave_s == 0 && fresh_lane() == 0) *qs = nxt;
        NSA_WAIT_BAR();
        k = __builtin_amdgcn_readfirstlane(*qs);
    }
}
}

namespace p2 {
using nsa::bf16x8; using nsa::f32x16; using nsa::s16x4; using nsa::crow; using nsa::glds16; using nsa::cvtpk_s;
#define P2_WAIT_BAR() asm volatile("s_waitcnt vmcnt(0) lgkmcnt(0)\n\ts_barrier" ::: "memory")
constexpr int CB_BUF = 40960;
constexpr int CP_STRIDE = 65;
__device__ __forceinline__ void compress_unit(const Ptrs& P, LAS unsigned char* lds, int u, const int wave_s) {
    unsigned char* ws = P.ws;
    const int lane = fresh_lane(), r32 = lane & 31, hi = lane >> 5, wid = wave_s;
    const int kv = u >> 6, bg = (u >> 2) & 15, n0 = 64 * (u & 3);
    const bf16_t* Ag = (const bf16_t*)(ws + WS_KV6) + (size_t)kv * KVSZ + (size_t)bg * SEQ * 64 + (size_t)n0 * 1024;
    const bf16_t* Bg = (const bf16_t*)(ws + WS_W1C) + (size_t)kv * 256 * 2048;
    const unsigned lds0 = (unsigned)(uintptr_t)lds;
    const unsigned aoff = (unsigned)(lane * 1024 + wid * 8) * 2u, boff = (unsigned)(lane * 2048 + wid * 8) * 2u;
    const unsigned dstw = lds0 + wid * 1024;
#define P2_DMA_TILE(kt, buf) do { const unsigned d_ = (unsigned)__builtin_amdgcn_readfirstlane(dstw + (buf) * CB_BUF); \
        glds16(Ag + (kt) * 64, aoff, d_); \
        _Pragma("unroll") for (int ct_ = 0; ct_ < 4; ++ct_) glds16(Bg + (size_t)ct_ * 64 * 2048 + (kt) * 64, boff, d_ + 8192u * (ct_ + 1)); } while (0)
    const int ct = wid >> 1, half = wid & 1, ncol0 = 64 * ct + 32 * half;
    f32x16 hT[2]; hT[0] = f32x16{}; hT[1] = f32x16{};
    P2_DMA_TILE(0, 0); P2_DMA_TILE(1, 1);
    asm volatile("s_waitcnt vmcnt(5) lgkmcnt(0)\n\ts_barrier" ::: "memory");
    for (int kt = 0; kt < 32; ++kt) {
        const int buf = kt % 3;
        if (kt + 2 < 32) P2_DMA_TILE(kt + 2, (kt + 2) % 3);
        LAS const char* sa = (LAS const char*)(lds + buf * CB_BUF) + hi * 1024 + r32 * 16;
        LAS const char* sb = (LAS const char*)(lds + buf * CB_BUF + 8192 * (ct + 1)) + half * 512 + hi * 1024 + r32 * 16;
#pragma unroll
        for (int d0 = 0; d0 < 4; ++d0) {
            const bf16x8 bf = *(LAS const bf16x8*)(sb + d0 * 2048), a0 = *(LAS const bf16x8*)(sa + d0 * 2048), a1 = *(LAS const bf16x8*)(sa + d0 * 2048 + 512);
            hT[0] = __builtin_amdgcn_mfma_f32_32x32x16_bf16(bf, a0, hT[0], 0, 0, 0);
            hT[1] = __builtin_amdgcn_mfma_f32_32x32x16_bf16(bf, a1, hT[1], 0, 0, 0);
        }
        if (kt + 2 < 32) asm volatile("s_waitcnt vmcnt(5) lgkmcnt(0)\n\ts_barrier" ::: "memory");
        else asm volatile("s_waitcnt vmcnt(0) lgkmcnt(0)\n\ts_barrier" ::: "memory");
    }
    const float* bias1 = (const float*)(ws + WS_SMALL + SM_BIAS1) + kv * 256 + ncol0;
    bf16x8 hb[2][2];
#pragma unroll
    for (int mt = 0; mt < 2; ++mt) {
        float g[16];
#pragma unroll
        for (int r = 0; r < 16; ++r) g[r] = gelu_tanh(hT[mt][r] + bias1[crow(r, hi)]);
#pragma unroll
        for (int s = 0; s < 2; ++s) { u32x4_t w; w.x = cvtpk_s(g[8 * s], g[8 * s + 1]); w.y = cvtpk_s(g[8 * s + 2], g[8 * s + 3]); w.z = cvtpk_s(g[8 * s + 4], g[8 * s + 5]); w.w = cvtpk_s(g[8 * s + 6], g[8 * s + 7]);
            hb[mt][s] = __builtin_bit_cast(bf16x8, w); }
    }
    const bf16_t* w2t = (const bf16_t*)(ws + WS_SMALL + SM_W2T) + (size_t)kv * 64 * 256;
    f32x16 oT[2][2];
#pragma unroll
    for (int dt = 0; dt < 2; ++dt)
#pragma unroll
        for (int mt = 0; mt < 2; ++mt) oT[dt][mt] = f32x16{};
#pragma unroll
    for (int dt = 0; dt < 2; ++dt)
#pragma unroll
        for (int s = 0; s < 2; ++s) {
            const bf16_t* wp = w2t + (size_t)(32 * dt + r32) * 256 + ncol0 + 16 * s + 4 * hi;
            const u32x2_t lo = *(const u32x2_t*)wp, hi2 = *(const u32x2_t*)(wp + 8);
            const u32x4_t wv = {lo.x, lo.y, hi2.x, hi2.y}; const bf16x8 wf = __builtin_bit_cast(bf16x8, wv);
#pragma unroll
            for (int mt = 0; mt < 2; ++mt) oT[dt][mt] = __builtin_amdgcn_mfma_f32_32x32x16_bf16(wf, hb[mt][s], oT[dt][mt], 0, 0, 0);
        }
    LAS float* part = (LAS float*)lds + wid * 64 * CP_STRIDE;
#pragma unroll
    for (int dt = 0; dt < 2; ++dt)
#pragma unroll
        for (int mt = 0; mt < 2; ++mt)
#pragma unroll
            for (int r = 0; r < 16; ++r) part[(32 * mt + r32) * CP_STRIDE + 32 * dt + crow(r, hi)] = oT[dt][mt][r];
    P2_WAIT_BAR();
    {
        const int tid = wid * 64 + lane, m = tid >> 3, dg = tid & 7;
        float o[8];
#pragma unroll
        for (int e = 0; e < 8; ++e) { float s = 0.f;
#pragma unroll
            for (int w = 0; w < 8; ++w) s += ((LAS const float*)lds)[(w * 64 + m) * CP_STRIDE + 8 * dg + e];
            o[e] = s; }
        if (kv == 0) {
            float ss = 0.f;
#pragma unroll
            for (int e = 0; e < 8; ++e) ss += o[e] * o[e];
            ss += __shfl_xor(ss, 1); ss += __shfl_xor(ss, 2); ss += __shfl_xor(ss, 4);
            const float rr = __builtin_amdgcn_rsqf(ss * (1.0f / 64.0f) + 1e-6f);
#pragma unroll
            for (int e = 0; e < 8; ++e) o[e] *= rr * P.in[4][8 * dg + e];
        }
        const int n = n0 + m;
        u32x4_t v = {0u, 0u, 0u, 0u};
        if (n < 255) { v.x = cvtpk_s(o[0], o[1]); v.y = cvtpk_s(o[2], o[3]); v.z = cvtpk_s(o[4], o[5]); v.w = cvtpk_s(o[6], o[7]); }
        *(u32x4_t*)((bf16_t*)(ws + (kv ? WS_VC : WS_KC)) + ((size_t)bg * 256 + n) * 64 + 8 * dg) = v;
    }
    P2_WAIT_BAR();
#undef P2_DMA_TILE
}

constexpr int G_V = 0, G_ST = 32768, G_OST = 33792, G_END = 33792 + 65536;
struct GmlpIn { u32x4_t raw[4]; u32x4_t uraw[4]; float sbv[4]; };
__device__ __forceinline__ void gmlp_load(GmlpIn& in, const Ptrs& P, int unit, int tid, int lane, int r32, int hi, int wid) {
    unsigned char* ws = P.ws;
    const int g = unit & 7, chunk = (unit >> 3) & 31, b = unit >> 8; const int m0 = b * SEQ + chunk * 128;
    const bf16_t* GV = (const bf16_t*)(ws + WS_GV); const bf16_t* U = (const bf16_t*)(ws + WS_U);
    const int tb = wid >> 1, ch = wid & 1; (void)r32; (void)hi;
#pragma unroll
    for (int i = 0; i < 4; ++i) { const int idx = tid + 512 * i, s = idx >> 4, c8 = idx & 15; in.raw[i] = *(const u32x4_t*)(GV + (size_t)(m0 + s) * 1024 + g * 128 + 8 * c8); }
#pragma unroll
    for (int i = 0; i < 4; ++i) { const int row = i * 8 + (lane >> 3), t = 32 * tb + row; in.uraw[i] = *(const u32x4_t*)(U + (size_t)(m0 + t) * 1024 + g * 128 + 64 * ch + 8 * (lane & 7)); in.sbv[i] = P.in[11][g * 128 + t]; }
}
__device__ __forceinline__ void gmlp_compute(const GmlpIn& in, const f32x4_t (&sv)[8], const bf16x8 (&pa)[2][4], const f32x4_t w0, const f32x4_t w1, const f32x4_t b0, const f32x4_t b1, const Ptrs& P, LAS unsigned char* lds, int unit, int tid, int lane, int r32, int hi, int wid) {
    unsigned char* ws = P.ws;
    const int g = unit & 7, chunk = (unit >> 3) & 31, b = unit >> 8; const int m0 = b * SEQ + chunk * 128;
    bf16_t* AB = (bf16_t*)(ws + WS_AB);
    LAS float* st = (LAS float*)(lds + G_ST);
    const int tb = wid >> 1, ch = wid & 1;
    if (tid < 128) { float s1 = 0.f, s2 = 0.f;
#pragma unroll
        for (int i = 0; i < 8; ++i) { s1 += sv[i][0] + sv[i][2]; s2 += sv[i][1] + sv[i][3]; }
        const float mean = s1 * (1.0f / 1024.0f); float var = s2 * (1.0f / 1024.0f) - mean * mean; var = var < 0.f ? 0.f : var;
        st[2 * tid] = mean; st[2 * tid + 1] = __builtin_amdgcn_rsqf(var + 1e-5f); }
    asm volatile("s_waitcnt lgkmcnt(0)\n\ts_barrier" ::: "memory");
#pragma unroll
    for (int i = 0; i < 4; ++i) { const int idx = tid + 512 * i, s = idx >> 4, c8 = idx & 15;
        float f[8]; unpack8(in.raw[i], f);
        const float mean = st[2 * s], rstd = st[2 * s + 1];
        float y[8];
#pragma unroll
        for (int e = 0; e < 4; ++e) { y[e] = (f[e] - mean) * rstd * w0[e] + b0[e]; y[4 + e] = (f[4 + e] - mean) * rstd * w1[e] + b1[e]; }
        u32x4_t o; o.x = cvtpk_s(y[0], y[1]); o.y = cvtpk_s(y[2], y[3]); o.z = cvtpk_s(y[4], y[5]); o.w = cvtpk_s(y[6], y[7]);
        const int st_ = s >> 6, sk = s & 63, chh = c8 >> 3, x = c8 & 7;
        *(LAS u32x4_t*)(lds + G_V + (st_ * 2 + chh) * 8192 + (x >> 2) * 4096 + (sk >> 4) * 1024 + (sk & 15) * 64 + (x & 3) * 16) = o; }
    asm volatile("s_waitcnt lgkmcnt(0)\n\ts_barrier" ::: "memory");
    f32x16 o[2]; o[0] = f32x16{}; o[1] = f32x16{};
    const int vb0 = (int)((unsigned)(uintptr_t)lds + G_V) + ((lane >> 4) & 1) * 32 + (lane & 3) * 8 + (4 * hi + ((lane & 15) >> 2)) * 64;
    nsa::pv(o, vb0 + ch * 8192, pa[0][0], pa[0][1], pa[0][2], pa[0][3]);
    if (tb >= 2) nsa::pv(o, vb0 + (2 + ch) * 8192, pa[1][0], pa[1][1], pa[1][2], pa[1][3]);
    LAS float* ostg = (LAS float*)(lds + G_OST) + wid * 2048;
#pragma unroll
    for (int r = 0; r < 16; ++r) { const int orow = crow(r, hi);
#pragma unroll
        for (int d0 = 0; d0 < 2; ++d0) ostg[orow * 64 + d0 * 32 + r32] = o[d0][r]; }
    asm volatile("s_waitcnt lgkmcnt(0)" ::: "memory");
#pragma unroll
    for (int i = 0; i < 4; ++i) { const int row = i * 8 + (lane >> 3), c8 = lane & 7, t = 32 * tb + row;
        const f32x4_t v0 = *(LAS const f32x4_t*)(ostg + row * 64 + c8 * 8), v1 = *(LAS const f32x4_t*)(ostg + row * 64 + c8 * 8 + 4);
        const size_t grow = (size_t)(m0 + t); const int col = g * 128 + 64 * ch + 8 * c8;
        float uf[8]; unpack8(in.uraw[i], uf);
        const float sb_ = in.sbv[i];
        u32x4_t w; w.x = cvtpk_s(uf[0] * (v0[0] + sb_), uf[1] * (v0[1] + sb_)); w.y = cvtpk_s(uf[2] * (v0[2] + sb_), uf[3] * (v0[3] + sb_));
        w.z = cvtpk_s(uf[4] * (v1[0] + sb_), uf[5] * (v1[1] + sb_)); w.w = cvtpk_s(uf[6] * (v1[2] + sb_), uf[7] * (v1[3] + sb_));
        *(u32x4_t*)(AB + grow * 2048 + 1024 + col) = w; }
    asm volatile("s_waitcnt lgkmcnt(0)\n\ts_barrier" ::: "memory");
}
__device__ __forceinline__ void gmlp_run(const Ptrs& P, LAS unsigned char* lds, int u0, int stride, int nunits, const int wave_s) {
    const int lane = fresh_lane(), r32 = lane & 31, hi = lane >> 5, wid = wave_s, tid = wid * 64 + lane;
    GmlpIn A, B;
    int u = u0;
    bf16x8 pa[2][4];
    { const bf16_t* SWB = (const bf16_t*)(P.ws + WS_SMALL + SM_SWB) + (size_t)(u0 & 7) * 16384; const int tb = wid >> 1;
#pragma unroll
      for (int st_ = 0; st_ < 2; ++st_)
#pragma unroll
        for (int ks = 0; ks < 4; ++ks) {
            const bf16_t* wp = SWB + (size_t)(32 * tb + r32) * 128 + 64 * st_ + 16 * ks + 4 * hi;
            const u32x2_t lo = *(const u32x2_t*)wp, hi2 = *(const u32x2_t*)(wp + 8);
            const u32x4_t wv = {lo.x, lo.y, hi2.x, hi2.y}; pa[st_][ks] = __builtin_bit_cast(bf16x8, wv); } }
    const int c8v = tid & 15, g0 = u0 & 7;
    const f32x4_t w0 = *(const f32x4_t*)(P.in[8] + g0 * 128 + 8 * c8v), w1 = *(const f32x4_t*)(P.in[8] + g0 * 128 + 8 * c8v + 4), b0 = *(const f32x4_t*)(P.in[9] + g0 * 128 + 8 * c8v), b1 = *(const f32x4_t*)(P.in[9] + g0 * 128 + 8 * c8v + 4);
    const float* VSTAT = (const float*)(P.ws + WS_VSTAT);
#define GMLP_STATS(sv_, unit_) do { const int m0_ = ((unit_) >> 8) * SEQ + (((unit_) >> 3) & 31) * 128; const f32x4_t* p_ = (const f32x4_t*)(VSTAT + (size_t)(m0_ + (tid & 127)) * 32); \
        _Pragma("unroll") for (int i_ = 0; i_ < 8; ++i_) sv_[i_] = p_[i_]; } while (0)
    f32x4_t sv[8];
    if (u < nunits) gmlp_load(A, P, u, tid, lane, r32, hi, wid);
    while (u < nunits) {
        GMLP_STATS(sv, u);
        if (u + stride < nunits) gmlp_load(B, P, u + stride, tid, lane, r32, hi, wid);
        gmlp_compute(A, sv, pa, w0, w1, b0, b1, P, lds, u, tid, lane, r32, hi, wid);
        u += stride; if (u >= nunits) break;
        GMLP_STATS(sv, u);
        if (u + stride < nunits) gmlp_load(A, P, u + stride, tid, lane, r32, hi, wid);
        gmlp_compute(B, sv, pa, w0, w1, b0, b1, P, lds, u, tid, lane, r32, hi, wid);
        u += stride;
    }
#undef GMLP_STATS
    asm volatile("s_waitcnt vmcnt(0) lgkmcnt(0)\n\ts_barrier" ::: "memory");
}
#undef P2_WAIT_BAR
}

#define XB_TMO      128
#define XB_XCNT(j)  (256  + 64 * (j))
#define XB_XSUB(j)  (1280 + 64 * (j))
#define XB_XGEN(j)  (2304 + 64 * (j))
#define XB_TOP      3328
#define XB_TOPGEN   3392
#define XCD_BAR_WORDS 3456
#define XB_SPIN_CAP (1u << 18)

__device__ __forceinline__ unsigned xb_ld(unsigned* p)              { return __hip_atomic_load(p, __ATOMIC_RELAXED, __HIP_MEMORY_SCOPE_AGENT); }
__device__ __forceinline__ unsigned xb_add(unsigned* p, unsigned v) { return __hip_atomic_fetch_add(p, v, __ATOMIC_RELAXED, __HIP_MEMORY_SCOPE_AGENT); }
__device__ __forceinline__ unsigned xb_xcc_id() { return (unsigned)__builtin_amdgcn_s_getreg((3 << 11) | 20) & 0xFu; }
#define XB_SPIN(cond, bar) do { unsigned _sp = 0; while (cond) { __builtin_amdgcn_s_sleep(1); \
    if ((++_sp & 255u) == 0u) { if (xb_ld(&(bar)[XB_TMO])) break; if (_sp > XB_SPIN_CAP) { atomicAdd(&(bar)[XB_TMO], 1u); break; } } } } while (0)

struct XcdBarrier {
    unsigned* bar; unsigned x; unsigned w0;
    volatile LAS unsigned* st;
};

__device__ __forceinline__ XcdBarrier xcd_barrier_post(unsigned* bar, volatile LAS unsigned* st, int wave_s) {
    XcdBarrier b; b.bar = bar; b.x = xb_xcc_id(); b.st = st; b.w0 = wave_s == 0 ? 1u : 0u;
    if (b.w0 && fresh_lane() == 0) (void)xb_add(&bar[XB_XCNT(b.x)], 1u);
    return b;
}
__device__ __forceinline__ void xcd_barrier_complete(unsigned* bar, unsigned x, unsigned& nloc, unsigned& nx) {
    const unsigned G = gridDim.x * gridDim.y * gridDim.z;
    unsigned sum, cnt, mine, sp = 0u;
    for (;;) {
        sum = 0u; cnt = 0u; mine = 0u;
#pragma unroll
        for (unsigned j = 0; j < 16; ++j) { const unsigned c = xb_ld(&bar[XB_XCNT(j)]); sum += c; cnt += (c > 0u) ? 1u : 0u; mine = (j == x) ? c : mine; }
        if (sum == G) break;
        __builtin_amdgcn_s_sleep(1);
        if ((++sp & 255u) == 0u) { if (xb_ld(&bar[XB_TMO])) break; if (sp > XB_SPIN_CAP) { atomicAdd(&bar[XB_TMO], 1u); break; } }
    }
    nloc = mine > 0u ? mine : 1u; nx = cnt > 0u ? cnt : 1u;
}

__device__ __forceinline__ void xcd_barrier(const XcdBarrier& b) {
    asm volatile("s_waitcnt vmcnt(0)" ::: "memory");
    __syncthreads();
    if (b.w0 && fresh_lane() == 0) {
        unsigned* bar = b.bar;
        __builtin_amdgcn_s_waitcnt(0);
        unsigned nloc = b.st[0], nx = b.st[1];
        if (nloc == 0u) { xcd_barrier_complete(bar, b.x, nloc, nx); b.st[0] = nloc; b.st[1] = nx; }
        const unsigned old = xb_add(&bar[XB_XSUB(b.x)], 1u);
        const unsigned gen = old / nloc;
        if (old + 1u == (gen + 1u) * nloc) {
            __builtin_amdgcn_fence(__ATOMIC_RELEASE, "agent");
            asm volatile("s_waitcnt vmcnt(0)" ::: "memory");
            const unsigned og = xb_add(&bar[XB_TOP], 1u);
            const unsigned tg = og / nx;
            if (og + 1u == (tg + 1u) * nx) xb_add(&bar[XB_TOPGEN], 1u);
            else XB_SPIN(xb_ld(&bar[XB_TOPGEN]) == tg, bar);
            __builtin_amdgcn_fence(__ATOMIC_ACQUIRE, "agent");
            xb_add(&bar[XB_XGEN(b.x)], 1u);
            asm volatile("s_waitcnt vmcnt(0)" ::: "memory");
        } else {
            XB_SPIN(xb_ld(&bar[XB_XGEN(b.x)]) == gen, bar);
            __builtin_amdgcn_fence(__ATOMIC_ACQUIRE, "agent");
            asm volatile("s_waitcnt vmcnt(0)" ::: "memory");
        }
    }
    __syncthreads();
}

constexpr int LDS_BYTES = 147456;
constexpr int LDS_XCH = 132096;
constexpr int LDS_MISC = 145408;
__global__ void __launch_bounds__(512, 2) mega_fwd(Ptrs P) {
    extern __shared__ __attribute__((aligned(16))) unsigned char lds_raw[];
    LAS unsigned char* lds = (LAS unsigned char*)lds_raw;
    unsigned char* ws = P.ws;
    const int wave = __builtin_amdgcn_readfirstlane(threadIdx.x >> 6);
    const int G = gridDim.x, bid = blockIdx.x;
    if (wave == 0) { const int l_ = fresh_lane(); if (l_ < 2) ((LAS unsigned*)(lds + LDS_MISC))[l_] = 0u; }
    __syncthreads();
    const XcdBarrier bar = xcd_barrier_post((unsigned*)(ws + WS_CTL), (volatile LAS unsigned*)(lds + LDS_MISC), wave);
    p0_prologue(P, lds, bid, G, wave);
    xcd_barrier(bar);
    if (bid == 0) bias1_stage(ws, fresh_tid(wave));
    {
        pg8::Gemm g{(const bf16_t*)(ws + WS_XN), (const bf16_t*)(ws + WS_WIN), MTOK, NPROJ, 2048, 2048};
        pg8::StaticOrder S; S.init(MTOK, NPROJ, G, bid);
        pg8::EpiProj E{(bf16_t*)(ws + WS_Q), (bf16_t*)(ws + WS_KV6), (bf16_t*)(ws + WS_U), (bf16_t*)(ws + WS_GV), (float*)(ws + WS_GATES), (float*)(ws + WS_VSTAT), P.in[3], P.in[4]};
        pg8::gemm_phase<pg8::EpiProj, pg8::StaticOrder, true, true>(lds, g, S, E, wave);
    }
    xcd_barrier(bar);
    if (bid < 128 && G >= 256) p2::compress_unit(P, lds, bid, wave);
    else if (G >= 256) p2::gmlp_run(P, lds, bid - 128, G - 128, 1024, wave);
    xcd_barrier(bar);
    nsa::nsa_phase(P, lds, bid, G, wave);
    xcd_barrier(bar);
    {
        pg8::Gemm g{(const bf16_t*)(ws + WS_AB), (const bf16_t*)(ws + WS_WOUT), MTOK, 2048, 2048, 2048};
        pg8::StaticOrder S; S.init(MTOK, 2048, G, bid);
        pg8::EpiRes1 E{(const float*)(ws + WS_SMALL + SM_RINV), (const float*)(ws + WS_SMALL + SM_INVW), (bf16_t*)(ws + WS_XN), (float*)(ws + WS_SSQ)};
        pg8::gemm_phase<pg8::EpiRes1, pg8::StaticOrder, true, true>(lds, g, S, E, wave);
    }
    xcd_barrier(bar);
    for (int m = bid * 512 + fresh_tid(wave); m < MTOK; m += G * 512) {
        const float* p = (const float*)(ws + WS_SSQ) + (size_t)m * 32; float s = 0.f;
#pragma unroll
        for (int i = 0; i < 32; ++i) s += p[i];
        ((float*)(ws + WS_SMALL + SM_R2))[m] = __builtin_amdgcn_rsqf(s * (1.0f / D_MODEL) + 1e-6f);
    }
    xcd_barrier(bar);
    {
        pg8::Gemm g{(const bf16_t*)(ws + WS_XN), (const bf16_t*)(ws + WS_WUP), MTOK, N_UP, 2048, 2048};
        pg8::StaticOrder S; S.init(MTOK, N_UP, G, bid);
        pg8::EpiUpConv E{(bf16_t*)(ws + WS_G), (const float*)(ws + WS_SMALL + SM_R2), P.in[15], P.in[16], (float*)(ws + WS_HLAST), (float*)(ws + WS_FIRST), lds + LDS_XCH};
        pg8::gemm_phase<pg8::EpiUpConv, pg8::StaticOrder, true, true>(lds, g, S, E, wave);
    }
    xcd_barrier(bar);
    for (int it = bid * 512 + fresh_tid(wave); it < 60 * 44 * 2 * 16; it += G * 512) {
        const int c8 = it & 15, row = (it >> 4) & 1, tl_ = it >> 5, pn = tl_ % 44, pmi = tl_ / 44, pm = pmi + pmi / 15 + 1;
        const float* cw = P.in[15]; const float* cb = P.in[16]; (void)cb;
        const float* fp = (const float*)(ws + WS_FIRST) + ((size_t)(pm * 44 + pn) * 2 + row) * 256 + 8 * c8;
        const float* lp = (const float*)(ws + WS_HLAST) + ((size_t)((pm - 1) * 44 + pn) * 2) * 256 + 8 * c8;
        const int ch = pn * 128 + 8 * c8;
        float r[8];
#pragma unroll
        for (int e = 0; e < 8; ++e) {
            const float l0g = lp[e], l1g = lp[256 + e], l0u = lp[128 + e], l1u = lp[256 + 128 + e];
            const float w0g = cw[ch + e], w1g = cw[N_UP + ch + e], w0u = cw[D_FF + ch + e], w1u = cw[N_UP + D_FF + ch + e];
            const float cg = fp[e] + (row == 0 ? w1g * l1g + w0g * l0g : w0g * l1g), cu = fp[128 + e] + (row == 0 ? w1u * l1u + w0u * l0u : w0u * l1u);
            r[e] = cg * sigmoidf_(cg) * cu;
        }
        u32x4_t o; o.x = pk2(r[0], r[1]); o.y = pk2(r[2], r[3]); o.z = pk2(r[4], r[5]); o.w = pk2(r[6], r[7]);
        *(u32x4_t*)((bf16_t*)(ws + WS_G) + (size_t)(pm * 256 + row) * D_FF + ch) = o;
    }
    xcd_barrier(bar);
    {
        pg8::Gemm g{(const bf16_t*)(ws + WS_G), (const bf16_t*)(ws + WS_WDOWN), MTOK, 2048, D_FF, D_FF};
        pg8::StaticOrder S; S.init(MTOK, 2048, G, bid);
        pg8::EpiDown E{P.out, (const bf16_t*)(ws + WS_XN)};
        pg8::gemm_phase<pg8::EpiDown, pg8::StaticOrder, true, true>(lds, g, S, E, wave);
    }
}

extern "C" void kernel_launch(void* const* d_in, const int* in_sizes, int n_in, void* d_out, int out_size, void* d_ws, size_t ws_size, hipStream_t stream) {
    static int grid_blocks = 0;
    if (!grid_blocks) {
        int dev = 0, cus = 0, per_cu = 0;
        (void)hipGetDevice(&dev);
        (void)hipDeviceGetAttribute(&cus, hipDeviceAttributeMultiprocessorCount, dev);
        (void)hipFuncSetAttribute((const void*)mega_fwd, hipFuncAttributeMaxDynamicSharedMemorySize, LDS_BYTES);
        (void)hipOccupancyMaxActiveBlocksPerMultiprocessor(&per_cu, (const void*)mega_fwd, 512, LDS_BYTES);
        if (per_cu < 1) { fprintf(stderr, "kernel_launch: occupancy query says %d blocks/CU\n", per_cu); per_cu = 1; }
        grid_blocks = cus * 1;
        (void)hipGetLastError();
    }
    if (n_in != 18 || ws_size < WS_END) { fprintf(stderr, "kernel_launch: unexpected n_in %d / ws %zu\n", n_in, ws_size); return; }
    Ptrs P{};
    for (int i = 0; i < 18; ++i) P.in[i] = (const float*)d_in[i];
    P.out = (float*)d_out; P.ws = (unsigned char*)d_ws;
    (void)hipMemsetAsync((char*)d_ws + WS_CTL, 0, 16384, stream);
    mega_fwd<<<dim3(grid_blocks), dim3(512), LDS_BYTES, stream>>>(P);
}
```

```cpp
#include <hip/hip_runtime.h>
#include <cstdio>
#include <cstdint>

constexpr int D_MODEL = 2048, BATCH = 4, SEQ = 4096, MTOK = BATCH * SEQ;
constexpr int IN_COLS = 4656, NPROJ = 4864;
constexpr int D_FF = 5632, N_UP = 2 * D_FF;
constexpr int NBG = 16;
constexpr size_t KVSZ = (size_t)NBG * SEQ * 64;
constexpr float LOG2E = 1.4426950408889634f;

constexpr size_t MiB = 1u << 20;
constexpr size_t WS_CTL = 0;
constexpr size_t WS_WIN = 1 * MiB, WS_WOUT = 20 * MiB, WS_WUP = 28 * MiB, WS_WDOWN = 72 * MiB, WS_W1C = 94 * MiB;
constexpr size_t WS_SMALL = 96 * MiB;
constexpr size_t SM_BIASP = 0, SM_BIAS1 = 65536, SM_R2 = 131072, SM_W2T = 196608  , SM_SWB = 262144  , SM_RINV = 524288  , SM_INVW = 589824  ;
constexpr size_t WS_XN = 97 * MiB;
constexpr size_t WS_Q = 161 * MiB;
constexpr size_t WS_KV6 = 193 * MiB;
constexpr size_t WS_U = 241 * MiB, WS_GV = 273 * MiB;
constexpr size_t WS_GATES = 305 * MiB;
constexpr size_t WS_VSTAT = 308 * MiB;
constexpr size_t WS_KC = 310 * MiB, WS_VC = 310 * MiB + 524288;
constexpr size_t WS_HC = 311 * MiB;
constexpr size_t WS_AB = 315 * MiB;
constexpr size_t WS_SSQ = 379 * MiB;
constexpr size_t WS_G = 161 * MiB;
constexpr size_t WS_HID = 381 * MiB;
constexpr size_t WS_HLAST = 381 * MiB, WS_FIRST = 388 * MiB;
constexpr size_t WS_END = 469 * MiB;

#define LAS __attribute__((address_space(3)))
typedef unsigned short bf16_t;
typedef unsigned u32x4_t __attribute__((ext_vector_type(4)));
typedef unsigned u32x2_t __attribute__((ext_vector_type(2)));
typedef float f32x4_t __attribute__((ext_vector_type(4)));

__device__ __forceinline__ float bf2f(unsigned short h) { return __uint_as_float(((unsigned)h) << 16); }
__device__ __forceinline__ unsigned f2bf(float f) { unsigned u = __float_as_uint(f); return (u + 0x7fffu + ((u >> 16) & 1u)) >> 16; }
__device__ __forceinline__ unsigned pk2(float lo, float hi) { return f2bf(lo) | (f2bf(hi) << 16); }
__device__ __forceinline__ float gelu_tanh(float x) {
    const float u = 0.7978845608028654f * (x + 0.044715f * x * x * x);
    const float e = __builtin_amdgcn_exp2f(-2.8853900817779268f * u);
    return x * __builtin_amdgcn_rcpf(1.0f + e);
}
__device__ __forceinline__ float sigmoidf_(float x) { return __builtin_amdgcn_rcpf(1.0f + __builtin_amdgcn_exp2f(-LOG2E * x)); }
__device__ __forceinline__ float wave_sum(float v) {
#pragma unroll
    for (int o = 1; o < 64; o <<= 1) v += __shfl_xor(v, o);
    return v;
}
__device__ __forceinline__ void unpack8(u32x4_t r, float (&f)[8]) {
    f[0] = __uint_as_float(r.x << 16); f[1] = __uint_as_float(r.x & 0xffff0000u);
    f[2] = __uint_as_float(r.y << 16); f[3] = __uint_as_float(r.y & 0xffff0000u);
    f[4] = __uint_as_float(r.z << 16); f[5] = __uint_as_float(r.z & 0xffff0000u);
    f[6] = __uint_as_float(r.w << 16); f[7] = __uint_as_float(r.w & 0xffff0000u);
}

__device__ __forceinline__ int fresh_lane() { unsigned z_ = 0u; asm volatile("" : "+v"(z_)); return (int)__builtin_amdgcn_mbcnt_hi(~0u, __builtin_amdgcn_mbcnt_lo(~0u, z_)); }
__device__ __forceinline__ int fresh_tid(int wave_s) { return wave_s * 64 + fresh_lane(); }
namespace pg8 {
#define PG8_LAS __attribute__((address_space(3)))
typedef unsigned short bf16_t;
typedef short bf16x8 __attribute__((ext_vector_type(8)));
typedef float f32x4 __attribute__((ext_vector_type(4)));
typedef unsigned u32x4 __attribute__((ext_vector_type(4)));
constexpr int BM = 256, BK = 64, HALF = 128, HTB = HALF * BK * 2  , STAGE_BYTES = 8 * HTB, NXCD = 8, WGM = 8;

__host__ __device__ __forceinline__ int lds_byte(int r, int c) { const int st = (r >> 4) * 2 + (c >> 5), rr = r & 15, cc = c & 31, ob = rr * 64 + cc * 2; return st * 1024 + (ob ^ (((ob >> 9) & 1) << 5)); }
__host__ __device__ __forceinline__ void stage_rc(int b, int& R, int& C) { const int st = b / 1024, sb = b % 1024, swz = sb ^ (((sb >> 9) & 1) << 5); R = (st >> 1) * 16 + swz / 64; C = (st & 1) * 32 + (swz % 64) / 2; }
__host__ __device__ __forceinline__ int perm32(int rho) { const int n = rho >> 4, i = rho & 15; return 8 * (i >> 2) + 4 * n + (i & 3); }

struct Unit { int pm, pn; };
struct Gemm { const bf16_t* A; const bf16_t* Bt; int M, N, K, lda; };

struct StaticOrder {
    int nM, nN, nwg, G, c;
    __host__ __device__ void init(int M, int N, int G_, int c_) { nM = M / BM; nN = N / BM; nwg = nM * nN; G = G_; c = c_; }
    __host__ __device__ bool next(int i, Unit& u) const {
        const long L = (long)i * G + c; if (L >= nwg) return false;
        int wgid = (int)L; { const int q = nwg / NXCD, r = nwg % NXCD, xcd = wgid % NXCD, off = wgid / NXCD; wgid = (xcd < r ? xcd * (q + 1) : r * (q + 1) + (xcd - r) * q) + off; }
        const int nig = WGM * nN, gid = wgid / nig, fm = gid * WGM, gsz = (nM - fm) < WGM ? (nM - fm) : WGM;
        u.pm = fm + ((wgid % nig) % gsz); u.pn = (wgid % nig) / gsz; return true;
    }
    __device__ __forceinline__ void a_ready(const Unit&) const {}
    __device__ __forceinline__ void done(const Unit&) const {}
};

__device__ __forceinline__ unsigned cvt_pk_bf16(float lo, float hi) { unsigned r; asm volatile("v_cvt_pk_bf16_f32 %0, %1, %2" : "=v"(r) : "v"(lo), "v"(hi)); return r; }

struct EpiProj {
    static constexpr bool PERM = true, AFTER_DRAIN = false, PERMA = false;
    bf16_t* Q; bf16_t* KV6; bf16_t* U; bf16_t* GV; float* GATES; float* VSTAT; const float* q_norm_w; const float* k_norm_w;
    __device__ __forceinline__ void operator()(const f32x4 (&acc)[2][2][4][2], const Unit& u, int wr, int wc, int fr, int fq) const {
        const int pn = u.pn, row0 = u.pm * BM + wr * 64 + fr;
        if (pn < 10) {
            const bool normed = (pn < 4) || pn == 6 || pn == 8;
            const float* w = pn < 4 ? q_norm_w : (k_norm_w + (pn == 6 ? 64 : 128));
            const float sc = pn < 4 ? 0.125f * LOG2E : 1.0f;
            f32x4 wv[2][2];
#pragma unroll
            for (int bj = 0; bj < 2; ++bj)
#pragma unroll
                for (int n = 0; n < 2; ++n) wv[bj][n] = normed ? (*(const f32x4*)(w + 32 * bj + 8 * fq + 4 * n)) * sc : (f32x4){1.f, 1.f, 1.f, 1.f};
#pragma unroll
            for (int ai = 0; ai < 2; ++ai)
#pragma unroll
                for (int m = 0; m < 4; ++m) {
                    const int row = row0 + ai * HALF + m * 16;
                    float r = 1.f;
                    if (normed) {
                        float ss = 0.f;
#pragma unroll
                        for (int bj = 0; bj < 2; ++bj)
#pragma unroll
                            for (int n = 0; n < 2; ++n) { const f32x4 x = acc[ai][bj][m][n]; ss += (x[0] * x[0] + x[1] * x[1]) + (x[2] * x[2] + x[3] * x[3]); }
                        ss += __shfl_xor(ss, 16); ss += __shfl_xor(ss, 32);
                        r = __builtin_amdgcn_rsqf(ss * (1.0f / 64.0f) + 1e-6f);
                    }
                    bf16_t* dst;
                    if (pn < 4) dst = Q + (size_t)row * 1024 + pn * 256 + wc * 64 + 8 * fq;
                    else { const int b = row >> 12, t = row & 4095; dst = KV6 + (size_t)(pn - 4) * KVSZ + ((size_t)((b * 4 + wc) * 4096 + t)) * 64 + 8 * fq; }
#pragma unroll
                    for (int bj = 0; bj < 2; ++bj) {
                        const f32x4 v0 = acc[ai][bj][m][0] * r * wv[bj][0], v1 = acc[ai][bj][m][1] * r * wv[bj][1];
                        u32x4 o; o.x = cvt_pk_bf16(v0[0], v0[1]); o.y = cvt_pk_bf16(v0[2], v0[3]); o.z = cvt_pk_bf16(v1[0], v1[1]); o.w = cvt_pk_bf16(v1[2], v1[3]);
                        *(u32x4*)(dst + 32 * bj) = o;
                    }
                }
        } else if (pn < 18) {
            const bool isv = pn >= 14; const int ct = isv ? pn - 14 : pn - 10;
            bf16_t* base = (isv ? GV : U) + ct * 256 + wc * 64 + 8 * fq;
#pragma unroll
            for (int ai = 0; ai < 2; ++ai)
#pragma unroll
                for (int m = 0; m < 4; ++m) {
                    const int row = row0 + ai * HALF + m * 16; float s1 = 0.f, s2 = 0.f;
#pragma unroll
                    for (int bj = 0; bj < 2; ++bj) {
                        f32x4 v0 = acc[ai][bj][m][0], v1 = acc[ai][bj][m][1];
#pragma unroll
                        for (int e = 0; e < 4; ++e) { v0[e] = gelu_tanh(v0[e]); v1[e] = gelu_tanh(v1[e]); s1 += v0[e] + v1[e]; s2 += v0[e] * v0[e] + v1[e] * v1[e]; }
                        u32x4 o; o.x = cvt_pk_bf16(v0[0], v0[1]); o.y = cvt_pk_bf16(v0[2], v0[3]); o.z = cvt_pk_bf16(v1[0], v1[1]); o.w = cvt_pk_bf16(v1[2], v1[3]);
                        *(u32x4*)(base + (size_t)row * 1024 + 32 * bj) = o;
                    }
                    if (isv) {
                        s1 += __shfl_xor(s1, 16); s1 += __shfl_xor(s1, 32); s2 += __shfl_xor(s2, 16); s2 += __shfl_xor(s2, 32);
                        if (fq == 0) { float* p = VSTAT + ((size_t)row * 16 + ct * 4 + wc) * 2; p[0] = s1; p[1] = s2; }
                    }
                }
        } else {
            if (wc == 0) {
#pragma unroll
                for (int ai = 0; ai < 2; ++ai)
#pragma unroll
                    for (int m = 0; m < 4; ++m) {
                        const int row = row0 + ai * HALF + m * 16;
#pragma unroll
                        for (int bj = 0; bj < 2; ++bj)
#pragma unroll
                            for (int n = 0; n < 2; ++n) {
                                const int L = 32 * bj + 8 * fq + 4 * n;
                                if (L < 48) { f32x4 v = acc[ai][bj][m][n]; f32x4 o; o[0] = sigmoidf_(v[0]); o[1] = sigmoidf_(v[1]); o[2] = sigmoidf_(v[2]); o[3] = sigmoidf_(v[3]); *(f32x4*)(GATES + (size_t)row * 48 + L) = o; }
                            }
                    }
            }
        }
    }
};
struct EpiCmp {
    static constexpr bool PERM = true, AFTER_DRAIN = false, PERMA = false;
    bf16_t* HC; const float* bias1;
    __device__ __forceinline__ void operator()(const f32x4 (&acc)[2][2][4][2], const Unit& u, int wr, int wc, int fr, int fq) const {
        const int row0 = u.pm * BM + wr * 64 + fr, col0 = wc * 32 + 8 * fq;
        f32x4 bv[2][2];
#pragma unroll
        for (int bj = 0; bj < 2; ++bj)
#pragma unroll
            for (int n = 0; n < 2; ++n) bv[bj][n] = *(const f32x4*)(bias1 + u.pn * 256 + col0 + bj * HALF + 4 * n);
#pragma unroll
        for (int ai = 0; ai < 2; ++ai)
#pragma unroll
            for (int m = 0; m < 4; ++m) { bf16_t* rowp = HC + (size_t)(row0 + ai * HALF + m * 16) * 256 + col0;
#pragma unroll
                for (int bj = 0; bj < 2; ++bj) { f32x4 v0 = acc[ai][bj][m][0] + bv[bj][0], v1 = acc[ai][bj][m][1] + bv[bj][1];
#pragma unroll
                    for (int e = 0; e < 4; ++e) { v0[e] = gelu_tanh(v0[e]); v1[e] = gelu_tanh(v1[e]); }
                    u32x4 o; o.x = cvt_pk_bf16(v0[0], v0[1]); o.y = cvt_pk_bf16(v0[2], v0[3]); o.z = cvt_pk_bf16(v1[0], v1[1]); o.w = cvt_pk_bf16(v1[2], v1[3]);
                    *(u32x4*)(rowp + bj * HALF) = o; } }
    }
};
struct CmpOrder {
    int c, G;
    __device__ bool next(int i, Unit& u) const { const int L = i * G + c; if (L >= 32) return false; u.pm = L; u.pn = L >> 4; return true; }
    __device__ __forceinline__ void a_ready(const Unit&) const {}
    __device__ __forceinline__ void done(const Unit&) const {}
};
struct EpiRes1 {
    static constexpr bool PERM = false, AFTER_DRAIN = false, PERMA = false;
    const float* RINV; const float* INVW; bf16_t* X1b; float* SSQ;
    __device__ __forceinline__ void operator()(const f32x4 (&acc)[2][2][4][2], const Unit& u, int wr, int wc, int fr, int fq) const {
        const int row0 = u.pm * BM + wr * 64 + fr, col0 = u.pn * BM + wc * 32 + 4 * fq;
        f32x4 iw[2][2];
#pragma unroll
        for (int bj = 0; bj < 2; ++bj)
#pragma unroll
            for (int n = 0; n < 2; ++n) iw[bj][n] = *(const f32x4*)(INVW + col0 + bj * HALF + n * 16);
#pragma unroll
        for (int ai = 0; ai < 2; ++ai) {
            u32x2_t xin[4][2][2]; float ri[4];
#pragma unroll
            for (int m = 0; m < 4; ++m) { ri[m] = RINV[row0 + ai * HALF + m * 16];
#pragma unroll
                for (int bj = 0; bj < 2; ++bj)
#pragma unroll
                    for (int n = 0; n < 2; ++n) xin[m][bj][n] = *(const u32x2_t*)(X1b + (size_t)(row0 + ai * HALF + m * 16) * D_MODEL + col0 + bj * HALF + n * 16); }
            __builtin_amdgcn_sched_barrier(0);
#pragma unroll
            for (int m = 0; m < 4; ++m) { const int row = row0 + ai * HALF + m * 16; const size_t off = (size_t)row * D_MODEL + col0; float ss = 0.f;
#pragma unroll
                for (int bj = 0; bj < 2; ++bj)
#pragma unroll
                    for (int n = 0; n < 2; ++n) { const u32x2_t w_ = xin[m][bj][n];
                        f32x4 xv; xv[0] = __uint_as_float(w_.x << 16); xv[1] = __uint_as_float(w_.x & 0xffff0000u); xv[2] = __uint_as_float(w_.y << 16); xv[3] = __uint_as_float(w_.y & 0xffff0000u);
                        const f32x4 v = xv * ri[m] * iw[bj][n] + acc[ai][bj][m][n];
                        ss += (v[0] * v[0] + v[1] * v[1]) + (v[2] * v[2] + v[3] * v[3]);
                        u32x2_t w; w.x = cvt_pk_bf16(v[0], v[1]); w.y = cvt_pk_bf16(v[2], v[3]); *(u32x2_t*)(X1b + off + bj * HALF + n * 16) = w; }
                ss += __shfl_xor(ss, 16); ss += __shfl_xor(ss, 32);
                if (fq == 0) SSQ[(size_t)row * 32 + u.pn * 4 + wc] = ss; }
            __builtin_amdgcn_sched_barrier(0);
        }
    }
};
struct EpiUpV1 {
    static constexpr bool PERM = true, AFTER_DRAIN = false, PERMA = false;
    bf16_t* HID; const float* R2;
    __device__ __forceinline__ void operator()(const f32x4 (&acc)[2][2][4][2], const Unit& u, int wr, int wc, int fr, int fq) const {
        const int row0 = u.pm * BM + wr * 64 + fr, col0 = u.pn * BM + wc * 32 + 8 * fq;
#pragma unroll
        for (int ai = 0; ai < 2; ++ai)
#pragma unroll
            for (int m = 0; m < 4; ++m) { const int row = row0 + ai * HALF + m * 16; const float r = R2[row]; bf16_t* rowp = HID + (size_t)row * N_UP + col0;
#pragma unroll
                for (int bj = 0; bj < 2; ++bj) { const f32x4 v0 = acc[ai][bj][m][0] * r, v1 = acc[ai][bj][m][1] * r;
                    u32x4 o; o.x = cvt_pk_bf16(v0[0], v0[1]); o.y = cvt_pk_bf16(v0[2], v0[3]); o.z = cvt_pk_bf16(v1[0], v1[1]); o.w = cvt_pk_bf16(v1[2], v1[3]);
                    *(u32x4*)(rowp + bj * HALF) = o; } }
    }
};
struct EpiDown {
    static constexpr bool PERM = false, AFTER_DRAIN = false, PERMA = false;
    float* out; const bf16_t* X1b;
    __device__ __forceinline__ void operator()(const f32x4 (&acc)[2][2][4][2], const Unit& u, int wr, int wc, int fr, int fq) const {
        const int row0 = u.pm * BM + wr * 64 + fr, col0 = u.pn * BM + wc * 32 + 4 * fq;
#pragma unroll
        for (int ai = 0; ai < 2; ++ai) {
            u32x2_t xin[4][2][2];
#pragma unroll
            for (int m = 0; m < 4; ++m)
#pragma unroll
                for (int bj = 0; bj < 2; ++bj)
#pragma unroll
                    for (int n = 0; n < 2; ++n) xin[m][bj][n] = *(const u32x2_t*)(X1b + (size_t)(row0 + ai * HALF + m * 16) * D_MODEL + col0 + bj * HALF + n * 16);
            __builtin_amdgcn_sched_barrier(0);
#pragma unroll
            for (int m = 0; m < 4; ++m) { const size_t off = (size_t)(row0 + ai * HALF + m * 16) * D_MODEL + col0;
#pragma unroll
                for (int bj = 0; bj < 2; ++bj)
#pragma unroll
                    for (int n = 0; n < 2; ++n) { const u32x2_t w = xin[m][bj][n];
                        f32x4 v; v[0] = __uint_as_float(w.x << 16); v[1] = __uint_as_float(w.x & 0xffff0000u); v[2] = __uint_as_float(w.y << 16); v[3] = __uint_as_float(w.y & 0xffff0000u);
                        *(f32x4*)(out + off + bj * HALF + n * 16) = v + acc[ai][bj][m][n]; } }
            __builtin_amdgcn_sched_barrier(0);
        }
    }
};
__device__ __forceinline__ unsigned f2bf_(float f) { unsigned u = __float_as_uint(f); return (u + 0x7fffu + ((u >> 16) & 1u)) >> 16; }
struct EpiUpConv {
    static constexpr bool PERM = true, AFTER_DRAIN = false, PERMA = true;
    bf16_t* G; const float* R2; const float* cw; const float* cb; float* HLAST; float* FIRST; PG8_LAS unsigned char* xlds;
    __device__ __forceinline__ void operator()(const f32x4 (&acc)[2][2][4][2], const Unit& u, int wr, int wc, int fr_in, int fq_in) const {
        (void)fr_in; (void)fq_in;
        unsigned z_ = 0u; asm volatile("" : "+v"(z_));
        const int lane_ = (int)__builtin_amdgcn_mbcnt_hi(~0u, __builtin_amdgcn_mbcnt_lo(~0u, z_)); const int fr = lane_ & 15, fq = lane_ >> 4;
        const int row0 = u.pm * BM + wr * 64 + 4 * fr;
        PG8_LAS float* X = (PG8_LAS float*)xlds;
        const unsigned tile = (unsigned)(u.pm * (N_UP / 256) + u.pn);
        if (fr == 15) {
#pragma unroll
            for (int ai = 0; ai < 2; ++ai) { const int sg = 2 * ai + wr; const float r2a = R2[row0 + ai * HALF + 2], r2b = R2[row0 + ai * HALF + 3];
#pragma unroll
                for (int mm = 0; mm < 2; ++mm)
#pragma unroll
                for (int bj = 0; bj < 2; ++bj)
#pragma unroll
                    for (int n = 0; n < 2; ++n) { const f32x4 h = acc[ai][bj][2 + mm][n] * (mm ? r2b : r2a);
                        *(PG8_LAS f32x4*)(X + ((sg * 4 + wc) * 2 + mm) * 64 + bj * 32 + 8 * fq + 4 * n) = h;
                        if (ai == 1 && wr == 1) *(f32x4*)(HLAST + (unsigned)((tile * 2 + mm) * 256 + bj * HALF + wc * 32 + 8 * fq + 4 * n)) = h; } }
        }
        PG8_LAS float* R2L = X + 3072;
        PG8_LAS float* Wl = X + 2048;
        { const int t_ = (wr * 4 + wc) * 64 + fq * 16 + fr;
#pragma unroll
          for (int i2 = 0; i2 < 2; ++i2) { const int i = t_ + 512 * i2, k = i >> 8, p = i & 255, c = (p < 128 ? 0 : D_FF - 128) + u.pn * 128 + p;
              Wl[i] = k < 3 ? cw[(unsigned)(k * N_UP + c)] : cb[(unsigned)c]; }
          if (t_ < 256) R2L[t_] = R2[u.pm * BM + t_]; }
        asm volatile("s_waitcnt vmcnt(0) lgkmcnt(0)" ::: "memory"); __builtin_amdgcn_s_barrier(); asm volatile("" ::: "memory");
        const int cbase = u.pn * 128 + wc * 32 + 8 * fq;
        const bool seq_start = (u.pm & 15) == 0;
#pragma unroll
        for (int ai = 0; ai < 2; ++ai) {
            const int sg = 2 * ai + wr;
            const f32x4 rs = *(PG8_LAS const f32x4*)(R2L + ai * HALF + wr * 64 + 4 * fr);
            const bool defer = (ai == 0) && (wr == 0) && !seq_start && (fr == 0);
#pragma unroll
            for (int n = 0; n < 2; ++n) {
                unsigned pk[4][2];
#pragma unroll
                for (int e = 0; e < 4; ++e) {
                    asm volatile("" ::: "memory"); __builtin_amdgcn_sched_barrier(0);
                    PG8_LAS const float* wp = Wl + wc * 32 + 8 * fq + 4 * n + e;
                    const float wg0 = wp[0], wg1 = wp[256], wg2 = wp[512], bg = wp[768], wu0 = wp[128], wu1 = wp[384], wu2 = wp[640], bu = wp[896];
                    float hg1 = 0.f, hg2 = 0.f, hu1 = 0.f, hu2 = 0.f;
                    if (ai == 1 || wr == 1) { PG8_LAS const float* xp = X + (((sg - 1) * 4 + wc) * 2) * 64 + 8 * fq + 4 * n + e; hg2 = xp[0]; hg1 = xp[64]; hu2 = xp[32]; hu1 = xp[96]; }
                    float vg[4], vu[4], cg[4], cu[4];
#pragma unroll
                    for (int m = 0; m < 4; ++m) { vg[m] = acc[ai][0][m][n][e] * rs[m]; vu[m] = acc[ai][1][m][n][e] * rs[m]; }
                    const float pg1 = __uint_as_float(__builtin_amdgcn_update_dpp(__float_as_uint(hg1), __float_as_uint(vg[3]), 0x111, 0xf, 0xf, false));
                    const float pg2 = __uint_as_float(__builtin_amdgcn_update_dpp(__float_as_uint(hg2), __float_as_uint(vg[2]), 0x111, 0xf, 0xf, false));
                    const float pu1 = __uint_as_float(__builtin_amdgcn_update_dpp(__float_as_uint(hu1), __float_as_uint(vu[3]), 0x111, 0xf, 0xf, false));
                    const float pu2 = __uint_as_float(__builtin_amdgcn_update_dpp(__float_as_uint(hu2), __float_as_uint(vu[2]), 0x111, 0xf, 0xf, false));
                    cg[0] = bg + wg0 * pg2 + wg1 * pg1 + wg2 * vg[0]; cu[0] = bu + wu0 * pu2 + wu1 * pu1 + wu2 * vu[0];
                    cg[1] = bg + wg0 * pg1 + wg1 * vg[0] + wg2 * vg[1]; cu[1] = bu + wu0 * pu1 + wu1 * vu[0] + wu2 * vu[1];
                    cg[2] = bg + wg0 * vg[0] + wg1 * vg[1] + wg2 * vg[2]; cu[2] = bu + wu0 * vu[0] + wu1 * vu[1] + wu2 * vu[2];
                    cg[3] = bg + wg0 * vg[1] + wg1 * vg[2] + wg2 * vg[3]; cu[3] = bu + wu0 * vu[1] + wu1 * vu[2] + wu2 * vu[3];
                    if (defer) {
#pragma unroll
                        for (int m = 0; m < 2; ++m) { float* fp = FIRST + (unsigned)((tile * 2 + m) * 256 + wc * 32 + 8 * fq + 4 * n + e); fp[0] = cg[m]; fp[HALF] = cu[m]; }
                    }
#pragma unroll
                    for (int m = 0; m < 4; ++m) {
                        const unsigned hb = cvt_pk_bf16(cg[m] * sigmoidf_(cg[m]) * cu[m], 0.f);
                        if ((e & 1) == 0) pk[m][e >> 1] = hb; else pk[m][e >> 1] |= hb << 16;
                    }
                }
#pragma unroll
                for (int m = 0; m < 4; ++m)
                    if (!(m < 2 && defer)) { u32x2_t o; o.x = pk[m][0]; o.y = pk[m][1]; *(u32x2_t*)(G + (unsigned)((row0 + ai * HALF + m) * D_FF + cbase + 4 * n)) = o; }
            }
        }
    }
};
template <class Epi, class Sched, bool ALIGN_EPI = false, bool SP2 = false>
__device__ __forceinline__ void gemm_phase(PG8_LAS unsigned char* lds, const Gemm g, const Sched& S, const Epi& E, const int wave_s) {
    const int tid = fresh_tid(wave_s), wid = wave_s, lane = tid & 63,
          wr = wid >> 2, wc = wid & 3, fr = lane & 15, fq = lane >> 4;
    const int K = g.K, nt = K / BK;
    unsigned voffA[2], voffB[2];
#pragma unroll
    for (int i = 0; i < 2; ++i) { int R, C; stage_rc(tid * 16 + i * 8192, R, C); const int Rb = Epi::PERM ? ((R & ~31) + perm32(R & 31)) : R;
        const int Ra = Epi::PERMA ? ((R & ~63) + 4 * (R & 15) + ((R >> 4) & 3)) : R;
        voffA[i] = (unsigned)(Ra * g.lda + C) * 2u; voffB[i] = (unsigned)(Rb * K + C) * 2u; }
    const size_t kstep = (size_t)(BK * 2);
    const size_t hstepA = (size_t)HALF * g.lda * 2, hstepB = (size_t)HALF * K * 2;
    const size_t tstepA = 2 * hstepA, tstepB = 2 * hstepB;
    const unsigned ldsw = (unsigned)wid * 1024u;
    const int aoff = lds_byte(wr * 64 + fr, fq * 8), boff = lds_byte(wc * 32 + fr, fq * 8);
#define PG8_SA(b, h) (((b) * 2 + (h)) * HTB)
#define PG8_SB(b, h) ((4 + (b) * 2 + (h)) * HTB)
#define PG8_STAGE(bufoff, gbase, voff) do { _Pragma("unroll") for (int _i = 0; _i < 2; ++_i) \
        __builtin_amdgcn_global_load_lds((const unsigned*)((const char*)(gbase) + (voff)[_i]), (PG8_LAS unsigned*)(lds + (bufoff) + ldsw + _i * 8192), 16, 0, 0); } while (0)
#define PG8_LDA(dst, b, h) do { _Pragma("unroll") for (int m = 0; m < 4; ++m) _Pragma("unroll") for (int k = 0; k < 2; ++k) dst[m][k] = *(const PG8_LAS bf16x8*)(lds + PG8_SA(b, h) + aoff + m * 2048 + k * 1024); } while (0)
#define PG8_LDB(dst, b, h) do { _Pragma("unroll") for (int n = 0; n < 2; ++n) _Pragma("unroll") for (int k = 0; k < 2; ++k) dst[n][k] = *(const PG8_LAS bf16x8*)(lds + PG8_SB(b, h) + boff + n * 2048 + k * 1024); } while (0)
#define PG8_MMA(ai, bj, At, Bt) do { __builtin_amdgcn_s_setprio(1); _Pragma("unroll") for (int m = 0; m < 4; ++m) _Pragma("unroll") for (int n = 0; n < 2; ++n) _Pragma("unroll") for (int k = 0; k < 2; ++k) \
        acc[ai][bj][m][n] = __builtin_amdgcn_mfma_f32_16x16x32_bf16(Bt[n][k], At[m][k], acc[ai][bj][m][n], 0, 0, 0); __builtin_amdgcn_s_setprio(0); } while (0)
#define PG8_WAIT_V(n) asm volatile("s_waitcnt vmcnt(" #n ")" ::: "memory")
#define PG8_WAIT_L(n) asm volatile("s_waitcnt lgkmcnt(" #n ")" ::: "memory")
#define PG8_BAR __builtin_amdgcn_s_barrier()
#define PG8_SCHED __builtin_amdgcn_sched_barrier(0)
    Unit cur, nxt; int ui = 0;
    if (!S.next(0, cur)) return;
    f32x4 acc[2][2][4][2];
#pragma unroll
    for (int a = 0; a < 2; ++a)
#pragma unroll
        for (int b = 0; b < 2; ++b)
#pragma unroll
            for (int m = 0; m < 4; ++m)
#pragma unroll
                for (int n = 0; n < 2; ++n) acc[a][b][m][n] = (f32x4){0.f, 0.f, 0.f, 0.f};
    bf16x8 At[4][2], B0[2][2], B1[2][2];
    const char* cA = (const char*)g.A + (size_t)cur.pm * tstepA; const char* cB = (const char*)g.Bt + (size_t)cur.pn * tstepB;
    S.a_ready(cur);
    if constexpr (SP2) {
        PG8_STAGE(PG8_SB(0, 0), cB, voffB); PG8_STAGE(PG8_SB(0, 1), cB + hstepB, voffB); PG8_STAGE(PG8_SA(0, 0), cA, voffA); PG8_STAGE(PG8_SA(0, 1), cA + hstepA, voffA);
        if (wr == 1) PG8_BAR;
        PG8_WAIT_V(2); PG8_BAR;
        PG8_STAGE(PG8_SB(1, 0), cB + kstep, voffB); PG8_STAGE(PG8_SA(1, 0), cA + kstep, voffA); PG8_STAGE(PG8_SB(1, 1), cB + hstepB + kstep, voffB);
        PG8_WAIT_V(6); PG8_BAR;
    } else {
        PG8_STAGE(PG8_SB(0, 0), cB, voffB); PG8_STAGE(PG8_SA(0, 0), cA, voffA); PG8_STAGE(PG8_SB(0, 1), cB + hstepB, voffB); PG8_STAGE(PG8_SA(0, 1), cA + hstepA, voffA);
        if (wr == 1) PG8_BAR;
        PG8_WAIT_V(4); PG8_BAR;
        PG8_STAGE(PG8_SB(1, 0), cB + kstep, voffB); PG8_STAGE(PG8_SA(1, 0), cA + kstep, voffA); PG8_STAGE(PG8_SB(1, 1), cB + hstepB + kstep, voffB);
        PG8_WAIT_V(6); PG8_BAR;
    }
    for (;;) {
        const bool has_next = S.next(ui + 1, nxt);
        const char* nA = has_next ? (const char*)g.A + (size_t)nxt.pm * tstepA : cA; const char* nB = has_next ? (const char*)g.Bt + (size_t)nxt.pn * tstepB : cB;
        for (int t = 0; t < nt; t += 2) {
            const bool last = (t == nt - 2);
            const char* a1 = cA + (size_t)(t + 1) * kstep;
            const char* a2 = last ? nA : cA + (size_t)(t + 2) * kstep; const char* b2 = last ? nB : cB + (size_t)(t + 2) * kstep;
            const char* a3 = a2 + kstep; const char* b3 = b2 + kstep;
            if (last && has_next) S.a_ready(nxt);
            if constexpr (SP2) {
            PG8_LDB(B0, 0, 0); PG8_LDB(B1, 0, 1); PG8_SCHED; PG8_LDA(At, 0, 0); PG8_STAGE(PG8_SA(1, 1), a1 + hstepA, voffA);
            PG8_WAIT_V(8); PG8_WAIT_L(0); PG8_BAR; PG8_MMA(0, 0, At, B0); PG8_MMA(0, 1, At, B1); PG8_BAR; PG8_SCHED;
            PG8_LDA(At, 0, 1); PG8_STAGE(PG8_SB(0, 0), b2, voffB); PG8_STAGE(PG8_SB(0, 1), b2 + hstepB, voffB); PG8_STAGE(PG8_SA(0, 0), a2, voffA);
            PG8_WAIT_V(8); PG8_WAIT_L(0); PG8_BAR; PG8_MMA(1, 0, At, B0); PG8_MMA(1, 1, At, B1); PG8_BAR; PG8_SCHED;
            PG8_LDB(B0, 1, 0); PG8_LDB(B1, 1, 1); PG8_SCHED; PG8_LDA(At, 1, 0); PG8_STAGE(PG8_SA(0, 1), a2 + hstepA, voffA);
            PG8_WAIT_V(8); PG8_WAIT_L(0); PG8_BAR; PG8_MMA(0, 0, At, B0); PG8_MMA(0, 1, At, B1); PG8_BAR; PG8_SCHED;
            PG8_LDA(At, 1, 1); PG8_STAGE(PG8_SB(1, 0), b3, voffB); PG8_STAGE(PG8_SB(1, 1), b3 + hstepB, voffB); PG8_STAGE(PG8_SA(1, 0), a3, voffA);
            PG8_WAIT_V(8); PG8_WAIT_L(0); PG8_BAR; PG8_MMA(1, 0, At, B0); PG8_MMA(1, 1, At, B1); PG8_BAR; PG8_SCHED;
            } else {
            PG8_LDB(B0, 0, 0); PG8_SCHED; PG8_LDA(At, 0, 0); PG8_STAGE(PG8_SA(1, 1), a1 + hstepA, voffA);
            PG8_WAIT_L(8); PG8_BAR; PG8_WAIT_L(0); PG8_MMA(0, 0, At, B0); PG8_BAR; PG8_SCHED;
            PG8_LDB(B1, 0, 1); PG8_STAGE(PG8_SB(0, 0), b2, voffB);
            PG8_BAR; PG8_WAIT_L(0); PG8_MMA(0, 1, At, B1); PG8_BAR;
            PG8_LDA(At, 0, 1); PG8_STAGE(PG8_SA(0, 0), a2, voffA);
            PG8_BAR; PG8_WAIT_L(0); PG8_MMA(1, 0, At, B0); PG8_BAR; PG8_SCHED;
            PG8_STAGE(PG8_SB(0, 1), b2 + hstepB, voffB);
            PG8_WAIT_V(6); PG8_BAR; PG8_MMA(1, 1, At, B1); PG8_BAR;
            PG8_LDB(B0, 1, 0); PG8_SCHED; PG8_LDA(At, 1, 0); PG8_STAGE(PG8_SA(0, 1), a2 + hstepA, voffA);
            PG8_WAIT_L(8); PG8_BAR; PG8_WAIT_L(0); PG8_MMA(0, 0, At, B0); PG8_BAR; PG8_SCHED;
            PG8_LDB(B1, 1, 1); PG8_STAGE(PG8_SB(1, 0), b3, voffB);
            PG8_BAR; PG8_WAIT_L(0); PG8_MMA(0, 1, At, B1); PG8_BAR;
            PG8_LDA(At, 1, 1); PG8_STAGE(PG8_SA(1, 0), a3, voffA);
            PG8_BAR; PG8_WAIT_L(0); PG8_MMA(1, 0, At, B0); PG8_BAR; PG8_SCHED;
            PG8_STAGE(PG8_SB(1, 1), b3 + hstepB, voffB);
            PG8_WAIT_V(6); PG8_BAR; PG8_MMA(1, 1, At, B1); PG8_BAR;
            }
        }
        if constexpr (ALIGN_EPI) { if (wr == 0) PG8_BAR; }
        if constexpr (!Epi::AFTER_DRAIN) { E(acc, cur, wr, wc, fr, fq); S.done(cur); }
        if (!has_next) break;
#pragma unroll
        for (int a = 0; a < 2; ++a)
#pragma unroll
            for (int b = 0; b < 2; ++b)
#pragma unroll
                for (int m = 0; m < 4; ++m)
#pragma unroll
                    for (int n = 0; n < 2; ++n) acc[a][b][m][n] = (f32x4){0.f, 0.f, 0.f, 0.f};
        cur = nxt; cA = nA; cB = nB; ++ui;
        if constexpr (ALIGN_EPI) { if (wr == 1) PG8_BAR; }
    }
    PG8_WAIT_V(0);
    if constexpr (!ALIGN_EPI) { if (wr == 0) PG8_BAR; }
    PG8_BAR;
    if constexpr (Epi::AFTER_DRAIN) { E.fused(acc, cur, wr, wc, fr, fq, lds, wid, lane); S.done(cur); }
#undef PG8_SA
#undef PG8_SB
#undef PG8_STAGE
#undef PG8_LDA
#undef PG8_LDB
#undef PG8_MMA
#undef PG8_WAIT_V
#undef PG8_WAIT_L
#undef PG8_BAR
#undef PG8_SCHED
}
}
constexpr int NWAVES = 8;
template <class RowMap>
__device__ __forceinline__ void transpose_item(const float* __restrict__ W, int K, int N, bf16_t* WT, const float* __restrict__ kscale, RowMap rm, LAS float* scr, int item, int lane) {
    const int nblk = (N + 31) / 32, kb = item / nblk, nb = item % nblk, k0 = 64 * kb, n0 = 32 * nb;
    const int nr = n0 + (lane & 31);
    float v[32];
#pragma unroll
    for (int i = 0; i < 32; ++i) { const int kk = 2 * i + (lane >> 5); v[i] = (nr < N) ? W[(size_t)(k0 + kk) * N + nr] : 0.f; }
    if (kscale) {
#pragma unroll
        for (int i = 0; i < 32; ++i) v[i] *= kscale[k0 + 2 * i + (lane >> 5)];
    }
#pragma unroll
    for (int i = 0; i < 32; ++i) scr[(2 * i + (lane >> 5)) * 33 + (lane & 31)] = v[i];
    asm volatile("s_waitcnt lgkmcnt(0)" ::: "memory");
    const int c = lane & 7;
#pragma unroll
    for (int j = 0; j < 4; ++j) { const int nl = (lane >> 3) + 8 * j, n = n0 + nl;
        if (n < N) { const LAS float* s = scr + (8 * c) * 33 + nl;
            u32x4_t o; o.x = pk2(s[0 * 33], s[1 * 33]); o.y = pk2(s[2 * 33], s[3 * 33]); o.z = pk2(s[4 * 33], s[5 * 33]); o.w = pk2(s[6 * 33], s[7 * 33]);
            *(u32x4_t*)(WT + (size_t)rm(n) * K + k0 + 8 * c) = o; } }
    asm volatile("s_waitcnt lgkmcnt(0)" ::: "memory");
}
struct RmIdent { __device__ __forceinline__ int operator()(int n) const { return n; } };
struct RmWin {
    __device__ __forceinline__ int operator()(int c) const {
        const int nc = c < 2560 ? c : (c < 2608 ? 4608 + (c - 2560) : 2560 + (c - 2608));
        const int tile = nc >> 8, L = nc & 255, wc = L >> 6, bj = (L >> 5) & 1, j = L & 31;
        return tile * 256 + 128 * bj + 32 * wc + j;
    }
};
struct RmWup {
    __device__ __forceinline__ int operator()(int c) const { const int up = c >= D_FF, cc = up ? c - D_FF : c; return (cc >> 7) * 256 + up * 128 + (cc & 127); }
};

struct Ptrs {
    const float* in[18]; float* out; unsigned char* ws;
};

__device__ __forceinline__ void p0_prologue(const Ptrs& P, LAS unsigned char* lds, int vcu, int G, const int wave) {
    const int lane = fresh_lane();
    LAS float* scr = (LAS float*)(lds + wave * 16384);
    const int gw = vcu * NWAVES + wave, NGW = G * NWAVES;
    unsigned char* ws = P.ws;
    bf16_t* WinT = (bf16_t*)(ws + WS_WIN); bf16_t* WoutT = (bf16_t*)(ws + WS_WOUT); bf16_t* WupT = (bf16_t*)(ws + WS_WUP); bf16_t* WdownT = (bf16_t*)(ws + WS_WDOWN); bf16_t* W1cT = (bf16_t*)(ws + WS_W1C);
    const float* x = P.in[0]; const float* attn_norm_w = P.in[1]; const float* w_in = P.in[2]; const float* cmp_pos = P.in[5]; const float* cmp_w1 = P.in[6];
    const float* w_out = P.in[12]; const float* ffn_norm_w = P.in[13]; const float* w_up = P.in[14]; const float* w_down = P.in[17];
    constexpr int I_IN = 32 * 146, I_W1 = 32 * 8, I_W2 = 4 * 2;
    constexpr int NITEMS = I_IN + 2 * I_W1 + 2 * I_W2;
    (void)w_out; (void)w_up; (void)w_down; (void)ffn_norm_w; (void)WoutT; (void)WupT; (void)WdownT;
    for (int it = gw; it < NITEMS; it += NGW) {
        int r = it;
        if (r < I_IN) { transpose_item(w_in, 2048, IN_COLS, WinT, nullptr, RmWin(), scr, r, lane); continue; } r -= I_IN;
        if (r < I_W1) { transpose_item(cmp_w1, 2048, 256, W1cT, nullptr, RmIdent(), scr, r, lane); continue; } r -= I_W1;
        if (r < I_W1) { transpose_item(cmp_w1 + (size_t)2048 * 256, 2048, 256, W1cT + (size_t)256 * 2048, nullptr, RmIdent(), scr, r, lane); continue; } r -= I_W1;
        { const int kv = r >= I_W2 ? 1 : 0; transpose_item(P.in[7] + (size_t)kv * 256 * 64, 256, 64, (bf16_t*)(ws + WS_SMALL + SM_W2T) + (size_t)kv * 64 * 256, nullptr, RmIdent(), scr, r - kv * I_W2, lane); }
    }
    for (int i = gw * 64 + lane; i < 8 * 16384; i += NGW * 64) { const int t = (i >> 7) & 127, sx = i & 127; ((bf16_t*)(ws + WS_SMALL + SM_SWB))[i] = (bf16_t)(sx <= t ? f2bf(P.in[10][i]) : 0u); }
    for (int p = gw; p < 256; p += NGW) {
        const int L = 64 * ((p >> 5) & 3) + 32 * (p >> 7) + (p & 31);
        if (L >= 48) { u32x4_t z = {0u, 0u, 0u, 0u}; u32x4_t* d = (u32x4_t*)(WinT + (size_t)(18 * 256 + p) * 2048);
#pragma unroll
            for (int j = 0; j < 4; ++j) d[lane + 64 * j] = z; }
    }
    bf16_t* XN = (bf16_t*)(ws + WS_XN);
    for (int m = gw; m < MTOK; m += 2 * NGW) {
        const int m2 = m + NGW;
        const f32x4_t* xr = (const f32x4_t*)(x + (size_t)m * D_MODEL) + lane;
        const f32x4_t* xr2 = (const f32x4_t*)(x + (size_t)(m2 < MTOK ? m2 : m) * D_MODEL) + lane;
        f32x4_t v[8], v2[8]; float s = 0.f, s2 = 0.f;
#pragma unroll
        for (int j = 0; j < 8; ++j) { v[j] = xr[64 * j]; v2[j] = xr2[64 * j]; }
#pragma unroll
        for (int j = 0; j < 8; ++j) { s += (v[j][0] * v[j][0] + v[j][1] * v[j][1]) + (v[j][2] * v[j][2] + v[j][3] * v[j][3]); s2 += (v2[j][0] * v2[j][0] + v2[j][1] * v2[j][1]) + (v2[j][2] * v2[j][2] + v2[j][3] * v2[j][3]); }
        const float ms1 = wave_sum(s) * (1.0f / D_MODEL) + 1e-6f, ms2 = wave_sum(s2) * (1.0f / D_MODEL) + 1e-6f;
        const float r = __builtin_amdgcn_rsqf(ms1), r2 = __builtin_amdgcn_rsqf(ms2);
        if (lane == 0) { float* rinv = (float*)(ws + WS_SMALL + SM_RINV); rinv[m] = ms1 * r; if (m2 < MTOK) rinv[m2] = ms2 * r2; }
        u32x2_t* o8 = (u32x2_t*)(XN + (size_t)m * D_MODEL) + lane; u32x2_t* o82 = (u32x2_t*)(XN + (size_t)m2 * D_MODEL) + lane;
#pragma unroll
        for (int j = 0; j < 8; ++j) { const f32x4_t w = ((const f32x4_t*)attn_norm_w)[lane + 64 * j];
            u32x2_t o; o.x = pk2(v[j][0] * r * w[0], v[j][1] * r * w[1]); o.y = pk2(v[j][2] * r * w[2], v[j][3] * r * w[3]); o8[64 * j] = o;
            if (m2 < MTOK) { u32x2_t q; q.x = pk2(v2[j][0] * r2 * w[0], v2[j][1] * r2 * w[1]); q.y = pk2(v2[j][2] * r2 * w[2], v2[j][3] * r2 * w[3]); o82[64 * j] = q; } }
    }
    for (int i = gw * 64 + lane; i < D_MODEL; i += NGW * 64) ((float*)(ws + WS_SMALL + SM_INVW))[i] = 1.0f / attn_norm_w[i];
    float* BIASP = (float*)(ws + WS_SMALL + SM_BIASP);
    for (int it = gw; it < 64; it += NGW) {
        const int kv = it >> 5, kc = it & 31; f32x4_t a = {0.f, 0.f, 0.f, 0.f};
        const float* pp = cmp_pos + kv * 2048 + kc * 64; const float* w1 = cmp_w1 + ((size_t)kv * 2048 + kc * 64) * 256;
        for (int k = 0; k < 64; ++k) { const f32x4_t w = ((const f32x4_t*)(w1 + (size_t)k * 256))[lane]; a += w * pp[k]; }
        ((f32x4_t*)(BIASP + (size_t)it * 256))[lane] = a;
    }
}

__device__ __forceinline__ void bias1_stage(unsigned char* ws, int idx  ) {
    const float* BIASP = (const float*)(ws + WS_SMALL + SM_BIASP); float* BIAS1 = (float*)(ws + WS_SMALL + SM_BIAS1);
    const int kv = idx >> 8, j = idx & 255; float s = 0.f;
    for (int kc = 0; kc < 32; ++kc) s += BIASP[(size_t)(kv * 32 + kc) * 256 + j];
    BIAS1[idx] = s;
}
__device__ __forceinline__ void cmp2_row(const Ptrs& P, int R, int lane) {
    unsigned char* ws = P.ws; const bf16_t* HC = (const bf16_t*)(ws + WS_HC);
    const int kv = R >> 12, rr = R & 4095, n = rr & 255;
    bf16_t* dst = (bf16_t*)(ws + (kv ? WS_VC : WS_KC)) + (size_t)rr * 64 + lane;
    if (n == 255) { *dst = 0; return; }
    const float* w2 = P.in[7] + (size_t)kv * 256 * 64;
    const u32x2_t hr = *(const u32x2_t*)(HC + (size_t)R * 256 + 4 * lane);
    float h[4] = {__uint_as_float(hr.x << 16), __uint_as_float(hr.x & 0xffff0000u), __uint_as_float(hr.y << 16), __uint_as_float(hr.y & 0xffff0000u)};
    float o = 0.f;
    for (int jj = 0; jj < 64; ++jj) {
#pragma unroll
        for (int i = 0; i < 4; ++i) o += __shfl(h[i], jj) * w2[(size_t)(4 * jj + i) * 64 + lane];
    }
    if (kv == 0) { const float ss = wave_sum(o * o); o *= __builtin_amdgcn_rsqf(ss * (1.0f / 64.0f) + 1e-6f) * P.in[4][lane]; }
    *dst = (bf16_t)f2bf(o);
}

__device__ __forceinline__ void gmlp_unit_v1(const Ptrs& P, LAS unsigned char* lds, int unit, const int wave_s) {
    unsigned char* ws = P.ws; const int tid = fresh_tid(wave_s);
    const int g = unit & 7, chunk = (unit >> 3) & 31, b = unit >> 8; const int m0 = b * SEQ + chunk * 128;
    LAS float* vn = (LAS float*)lds; LAS float* Wl = (LAS float*)(lds + 65536); LAS float* st = (LAS float*)(lds + 131072);
    const bf16_t* GV = (const bf16_t*)(ws + WS_GV); const bf16_t* U = (const bf16_t*)(ws + WS_U); const float* VSTAT = (const float*)(ws + WS_VSTAT);
    bf16_t* AB = (bf16_t*)(ws + WS_AB);
    const float* ln_w = P.in[8]; const float* ln_b = P.in[9]; const float* sw = P.in[10]; const float* sb = P.in[11];
    if (tid < 128) { const float* p = VSTAT + (size_t)(m0 + tid) * 32; float s1 = 0.f, s2 = 0.f;
#pragma unroll
        for (int i = 0; i < 16; ++i) { s1 += p[2 * i]; s2 += p[2 * i + 1]; }
        const float mean = s1 * (1.0f / 1024.0f); float var = s2 * (1.0f / 1024.0f) - mean * mean; var = var < 0.f ? 0.f : var;
        st[2 * tid] = mean; st[2 * tid + 1] = __builtin_amdgcn_rsqf(var + 1e-5f); }
    for (int i = 0; i < 32; ++i) { const int idx = tid + 512 * i, t = idx >> 7, s = idx & 127; Wl[idx] = (s <= t) ? sw[(size_t)g * 16384 + idx] : 0.f; }
    __syncthreads();
#pragma unroll
    for (int i = 0; i < 4; ++i) { const int idx = tid + 512 * i, s = idx >> 4, c8 = idx & 15;
        const u32x4_t raw = *(const u32x4_t*)(GV + (size_t)(m0 + s) * 1024 + g * 128 + 8 * c8); float f[8]; unpack8(raw, f);
        const float mean = st[2 * s], rstd = st[2 * s + 1];
#pragma unroll
        for (int e = 0; e < 8; ++e) { const int c = g * 128 + 8 * c8 + e; vn[s * 128 + 8 * c8 + e] = (f[e] - mean) * rstd * ln_w[c] + ln_b[c]; } }
    __syncthreads();
    const int c = tid & 127, tq = tid >> 7;
    for (int i = 0; i < 8; ++i) {
        const int t0 = 4 * (tq + 4 * i); float a0 = 0.f, a1 = 0.f, a2 = 0.f, a3 = 0.f;
        for (int s4 = 0; s4 <= t0; s4 += 4) {
            const f32x4_t w0 = *(const LAS f32x4_t*)(Wl + (t0 + 0) * 128 + s4), w1 = *(const LAS f32x4_t*)(Wl + (t0 + 1) * 128 + s4), w2 = *(const LAS f32x4_t*)(Wl + (t0 + 2) * 128 + s4), w3 = *(const LAS f32x4_t*)(Wl + (t0 + 3) * 128 + s4);
#pragma unroll
            for (int k = 0; k < 4; ++k) { const float v = vn[(s4 + k) * 128 + c]; a0 += w0[k] * v; a1 += w1[k] * v; a2 += w2[k] * v; a3 += w3[k] * v; }
        }
        const float av[4] = {a0, a1, a2, a3};
#pragma unroll
        for (int k = 0; k < 4; ++k) { const int t = t0 + k; const size_t row = (size_t)(m0 + t);
            const float uu = bf2f(U[row * 1024 + g * 128 + c]); AB[row * 2048 + 1024 + g * 128 + c] = (bf16_t)f2bf(uu * (av[k] + sb[g * 128 + t])); }
    }
    __syncthreads();
}

__device__ __forceinline__ void conv_item(const Ptrs& P, int b, int idx) {
    const int t = idx / 704, c8 = idx % 704, c0 = 8 * c8, j = c0 >> 7, i0 = c0 & 127;
    const bf16_t* HID = (const bf16_t*)(P.ws + WS_HID); const float* cw = P.in[15]; const float* cb = P.in[16];
    float gt[8], up[8];
#pragma unroll
    for (int e = 0; e < 8; ++e) { gt[e] = cb[c0 + e]; up[e] = cb[D_FF + c0 + e]; }
#pragma unroll
    for (int k = 0; k < 3; ++k) { const int tt = t - 2 + k; if (tt < 0) continue;
        float hg[8], hu[8]; unpack8(*(const u32x4_t*)(HID + (size_t)tt * N_UP + 256 * j + i0), hg); unpack8(*(const u32x4_t*)(HID + (size_t)tt * N_UP + 256 * j + 128 + i0), hu);
#pragma unroll
        for (int e = 0; e < 8; ++e) { gt[e] += cw[(size_t)k * N_UP + c0 + e] * hg[e]; up[e] += cw[(size_t)k * N_UP + D_FF + c0 + e] * hu[e]; } }
    float r[8];
#pragma unroll
    for (int e = 0; e < 8; ++e) r[e] = gt[e] * sigmoidf_(gt[e]) * up[e];
    u32x4_t o; o.x = pk2(r[0], r[1]); o.y = pk2(r[2], r[3]); o.z = pk2(r[4], r[5]); o.w = pk2(r[6], r[7]);
    *(u32x4_t*)((bf16_t*)(P.ws + WS_G) + ((size_t)b * SEQ + t) * D_FF + c0) = o;
}

constexpr int LW_CH = 32;
constexpr int LW_OUT = 32 * 64, LW_UP = 32 * 352, LW_DOWN = 88 * 64, LW_C_OUT = LW_OUT / LW_CH, LW_C_UP = LW_UP / LW_CH, LW_C_DOWN = LW_DOWN / LW_CH, LW_CHUNKS = LW_C_OUT + LW_C_UP + LW_C_DOWN;
static_assert(LW_OUT % LW_CH == 0 && LW_UP % LW_CH == 0 && LW_DOWN % LW_CH == 0, "late weight items per chunk");
template <class RowMap>
__device__ __forceinline__ void lw_load(float (&v)[32], const float* __restrict__ W, int N, int item, int lane) {
    const int nblk = N / 32, kb = item / nblk, nb = item % nblk;
    const float* p = W + (size_t)(64 * kb + (lane >> 5)) * N + 32 * nb + (lane & 31);
#pragma unroll
    for (int i = 0; i < 32; ++i) v[i] = p[(size_t)(2 * i) * N];
}
template <class RowMap>
__device__ __forceinline__ void lw_store(const float (&v)[32], int K, int N, bf16_t* WT, const float* __restrict__ kscale, RowMap rm, LAS float* scr, int item, int lane) {
    const int nblk = N / 32, kb = item / nblk, nb = item % nblk, k0 = 64 * kb, n0 = 32 * nb;
    const int c = lane & 7;
    f32x4_t sc0 = {1.f, 1.f, 1.f, 1.f}, sc1 = sc0;
    if (kscale) { sc0 = *(const f32x4_t*)(kscale + k0 + 8 * c); sc1 = *(const f32x4_t*)(kscale + k0 + 8 * c + 4); }
#pragma unroll
    for (int i = 0; i < 32; ++i) scr[(2 * i + (lane >> 5)) * 33 + (lane & 31)] = v[i];
    asm volatile("s_waitcnt lgkmcnt(0)" ::: "memory");
#pragma unroll
    for (int j = 0; j < 4; ++j) { const int nl = (lane >> 3) + 8 * j; const LAS float* s = scr + (8 * c) * 33 + nl;
        u32x4_t o; o.x = pk2(s[0 * 33] * sc0[0], s[1 * 33] * sc0[1]); o.y = pk2(s[2 * 33] * sc0[2], s[3 * 33] * sc0[3]); o.z = pk2(s[4 * 33] * sc1[0], s[5 * 33] * sc1[1]); o.w = pk2(s[6 * 33] * sc1[2], s[7 * 33] * sc1[3]);
        *(u32x4_t*)(WT + (size_t)rm(n0 + nl) * K + k0 + 8 * c) = o; }
    asm volatile("s_waitcnt lgkmcnt(0)" ::: "memory");
}
template <class RowMap>
__device__ __forceinline__ void lw_run(const float* __restrict__ W, int K, int N, bf16_t* WT, const float* __restrict__ kscale, RowMap rm, LAS float* scr, int item0, int wave, int lane) {
    float va[32], vb[32];
    lw_load<RowMap>(va, W, N, item0 + wave, lane);
    lw_load<RowMap>(vb, W, N, item0 + wave + 8, lane);  lw_store(va, K, N, WT, kscale, rm, scr, item0 + wave, lane);
    lw_load<RowMap>(va, W, N, item0 + wave + 16, lane); lw_store(vb, K, N, WT, kscale, rm, scr, item0 + wave + 8, lane);
    lw_load<RowMap>(vb, W, N, item0 + wave + 24, lane); lw_store(va, K, N, WT, kscale, rm, scr, item0 + wave + 16, lane);
    lw_store(vb, K, N, WT, kscale, rm, scr, item0 + wave + 24, lane);
}
__device__ __forceinline__ void late_weight_chunk(const Ptrs& P, LAS unsigned char* lds, int chunk, const int wave) {
    const int lane = fresh_lane();
    LAS float* scr = (LAS float*)(lds + wave * 16384);
    unsigned char* ws = P.ws;
    if (chunk < LW_C_UP) lw_run(P.in[14], 2048, N_UP, (bf16_t*)(ws + WS_WUP), P.in[13], RmWup(), scr, chunk * LW_CH, wave, lane);
    else if (chunk < LW_C_UP + LW_C_DOWN) lw_run(P.in[17], D_FF, 2048, (bf16_t*)(ws + WS_WDOWN), nullptr, RmIdent(), scr, (chunk - LW_C_UP) * LW_CH, wave, lane);
    else lw_run(P.in[12], 2048, 2048, (bf16_t*)(ws + WS_WOUT), nullptr, RmIdent(), scr, (chunk - LW_C_UP - LW_C_DOWN) * LW_CH, wave, lane);
}

namespace nsa {
using bf16x8 = __attribute__((ext_vector_type(8))) short;
using s16x4 = __attribute__((ext_vector_type(4))) short;
using f32x16 = __attribute__((ext_vector_type(16))) float;
typedef float f32x2_t __attribute__((ext_vector_type(2))); typedef __bf16 bf16x2_t __attribute__((ext_vector_type(2)));
constexpr int L_K = 0, L_V = 16384, L_WSF = 32768, L_OST = 34816, L_IMP = 100352, L_MASK = 116736, L_WU = 117248, L_END = 117312;
constexpr int SLOTB = 8192;
constexpr float THR = 8.0f;
#define NSA_SBAR() __builtin_amdgcn_sched_barrier(0)
__device__ __forceinline__ int crow(int r, int hi) { return (r & 3) + 8 * (r >> 2) + 4 * hi; }
__device__ __forceinline__ void glds16(const void* gbase  , unsigned voff  , unsigned lds_dst) { unsigned keep;
    asm volatile("s_mov_b32 %0, m0\n\ts_mov_b32 m0, %3\n\ts_nop 0\n\tglobal_load_lds_dwordx4 %1, %2\n\ts_mov_b32 m0, %0" : "=&s"(keep) : "v"(voff), "s"(gbase), "s"(lds_dst) : "memory"); }
__device__ __forceinline__ unsigned cvtpk_s(float lo, float hi) { f32x2_t v = {lo, hi}; bf16x2_t b = __builtin_convertvector(v, bf16x2_t); return __builtin_bit_cast(unsigned, b); }
#define NSA_WAIT_BAR() asm volatile("s_waitcnt vmcnt(0) lgkmcnt(0)\n\ts_barrier" ::: "memory")

__device__ __forceinline__ void qkt(f32x16& p0, f32x16& p1, LAS const char* Kslot, const bf16x8 (&qr)[4], int r32, int hi) {
    LAS const char* kb = Kslot + hi * 1024 + r32 * 16;
#pragma unroll
    for (int d0 = 0; d0 < 4; ++d0) {
        const bf16x8 b0 = *(LAS const bf16x8*)(kb + d0 * 2048);
        const bf16x8 b1 = *(LAS const bf16x8*)(kb + d0 * 2048 + 512);
        p0 = __builtin_amdgcn_mfma_f32_32x32x16_bf16(b0, qr[d0], p0, 0, 0, 0); p1 = __builtin_amdgcn_mfma_f32_32x32x16_bf16(b1, qr[d0], p1, 0, 0, 0);
    }
}
struct VFrag { s16x4 lo[2][4], hi[2][4]; };
__device__ __forceinline__ void vload(VFrag& f, int vb) {
#pragma unroll
    for (int d0 = 0; d0 < 2; ++d0)
#pragma unroll
        for (int ks = 0; ks < 4; ++ks) {
            asm volatile("ds_read_b64_tr_b16 %0,%1 offset:%c2" : "=&v"(f.lo[d0][ks]) : "v"(vb), "i"(d0 * 4096 + ks * 1024) : "memory");
            asm volatile("ds_read_b64_tr_b16 %0,%1 offset:%c2" : "=&v"(f.hi[d0][ks]) : "v"(vb), "i"(d0 * 4096 + ks * 1024 + 512) : "memory"); }
}
__device__ __forceinline__ void pvmma(f32x16 (&o)[2], VFrag& f, bf16x8 pa0, bf16x8 pa1, bf16x8 pa2, bf16x8 pa3) {
    asm volatile("s_waitcnt lgkmcnt(0)" : "+v"(f.lo[0][0]), "+v"(f.lo[0][1]), "+v"(f.lo[0][2]), "+v"(f.lo[0][3]), "+v"(f.hi[0][0]), "+v"(f.hi[0][1]), "+v"(f.hi[0][2]), "+v"(f.hi[0][3]) :: "memory");
    asm volatile("" : "+v"(f.lo[1][0]), "+v"(f.lo[1][1]), "+v"(f.lo[1][2]), "+v"(f.lo[1][3]), "+v"(f.hi[1][0]), "+v"(f.hi[1][1]), "+v"(f.hi[1][2]), "+v"(f.hi[1][3]));
    NSA_SBAR();
#pragma unroll
    for (int d0 = 0; d0 < 2; ++d0) {
#define NSA_PK(k) (bf16x8){f.lo[d0][k][0], f.lo[d0][k][1], f.lo[d0][k][2], f.lo[d0][k][3], f.hi[d0][k][0], f.hi[d0][k][1], f.hi[d0][k][2], f.hi[d0][k][3]}
        o[d0] = __builtin_amdgcn_mfma_f32_32x32x16_bf16(pa0, NSA_PK(0), o[d0], 0, 0, 0);
        o[d0] = __builtin_amdgcn_mfma_f32_32x32x16_bf16(pa1, NSA_PK(1), o[d0], 0, 0, 0);
        o[d0] = __builtin_amdgcn_mfma_f32_32x32x16_bf16(pa2, NSA_PK(2), o[d0], 0, 0, 0);
        o[d0] = __builtin_amdgcn_mfma_f32_32x32x16_bf16(pa3, NSA_PK(3), o[d0], 0, 0, 0);
#undef NSA_PK
    }
}
__device__ __forceinline__ void pv(f32x16 (&o)[2], int vb, bf16x8 pa0, bf16x8 pa1, bf16x8 pa2, bf16x8 pa3) { VFrag f; vload(f, vb); pvmma(o, f, pa0, pa1, pa2, pa3); }
__device__ __forceinline__ float rowmax32(const f32x16& p0, const f32x16& p1) {
    float a = __builtin_fmaxf(p0[0], p1[0]);
#pragma unroll
    for (int r = 1; r < 16; ++r) a = __builtin_fmaxf(a, __builtin_fmaxf(p0[r], p1[r]));
    auto rr = __builtin_amdgcn_permlane32_swap(__float_as_uint(a), __float_as_uint(a), false, false);
    return __builtin_fmaxf(__uint_as_float(rr[0]), __uint_as_float(rr[1]));
}
struct State { float m, l; f32x16 o[2]; };
__device__ __forceinline__ void state_init(State& s) { s.m = -1e30f; s.l = 0.f; s.o[0] = f32x16{}; s.o[1] = f32x16{}; }

template <int BMUL, int MASK, bool LOADV>
__device__ __forceinline__ void tile_scores(f32x16& p0, f32x16& p1, LAS const char* Kslot, const bf16x8 (&qr)[4], const f32x16& bk, float c0, float b32, int lim, int r32, int hi, VFrag& vf, int vb) {
#pragma unroll
    for (int r = 0; r < 16; ++r) { const float b = (BMUL == 1) ? bk[r] + c0 : __builtin_fmaf(bk[r], (float)BMUL, c0); p0[r] = b; p1[r] = b + b32; }
    qkt(p0, p1, Kslot, qr, r32, hi);
    if (LOADV) vload(vf, vb);
    const int limh = lim - 4 * hi;
#pragma unroll
    for (int r = 0; r < 16; ++r) {
        const int kk = (r & 3) + 8 * (r >> 2);
        if (MASK == 1) { if (!(kk <= limh)) p0[r] = -INFINITY; if (!(kk + 32 <= limh)) p1[r] = -INFINITY; }
        if (MASK == 2) { if (!(kk > limh)) p0[r] = -INFINITY; if (!(kk + 32 > limh)) p1[r] = -INFINITY; }
        if (MASK == 3) { if (!(kk < limh)) p0[r] = -INFINITY; if (!(kk + 32 < limh)) p1[r] = -INFINITY; }
    }
}
__device__ __forceinline__ float tile_ref(const State& st, float rb0, bool rowlive) { return (st.m < -1e29f && rowlive) ? rb0 : st.m; }
__device__ __forceinline__ void tile_softmax_pv(State& st, f32x16& p0, f32x16& p1, float mref, VFrag& vf, LAS float* wsf, int r32, int hi) {
    float a0 = p0[0], a1 = p1[0];
#pragma unroll
    for (int r = 1; r < 16; ++r) { a0 = __builtin_fmaxf(a0, p0[r]); a1 = __builtin_fmaxf(a1, p1[r]); }
    float mx = __builtin_fmaxf(a0, a1);
    { auto rr = __builtin_amdgcn_permlane32_swap(__float_as_uint(mx), __float_as_uint(mx), false, false); mx = __builtin_fmaxf(__uint_as_float(rr[0]), __uint_as_float(rr[1])); }
    if (__any(mx > THR)) {
        const float dl = __builtin_fmaxf(mx, 0.f), alpha = __builtin_amdgcn_exp2f(-dl);
        mref += dl; st.l *= alpha;
        if (hi == 0) wsf[r32] = alpha;
        asm volatile("s_waitcnt lgkmcnt(0)" ::: "memory");
#pragma unroll
        for (int r = 0; r < 16; ++r) { const float a = wsf[crow(r, hi)]; st.o[0][r] *= a; st.o[1][r] *= a; p0[r] -= dl; p1[r] -= dl; }
    }
    st.m = mref;
    float ls = 0.f;
#pragma unroll
    for (int r = 0; r < 16; ++r) { p0[r] = __builtin_amdgcn_exp2f(p0[r]); p1[r] = __builtin_amdgcn_exp2f(p1[r]); ls += p0[r] + p1[r]; }
    st.l += ls;
    u32x4_t pw0, pw1, pw2, pw3;
    pw0 = (u32x4_t){cvtpk_s(p0[0], p0[1]), cvtpk_s(p0[2], p0[3]), cvtpk_s(p0[4], p0[5]), cvtpk_s(p0[6], p0[7])};
    pw1 = (u32x4_t){cvtpk_s(p0[8], p0[9]), cvtpk_s(p0[10], p0[11]), cvtpk_s(p0[12], p0[13]), cvtpk_s(p0[14], p0[15])};
    pw2 = (u32x4_t){cvtpk_s(p1[0], p1[1]), cvtpk_s(p1[2], p1[3]), cvtpk_s(p1[4], p1[5]), cvtpk_s(p1[6], p1[7])};
    pw3 = (u32x4_t){cvtpk_s(p1[8], p1[9]), cvtpk_s(p1[10], p1[11]), cvtpk_s(p1[12], p1[13]), cvtpk_s(p1[14], p1[15])};
    pvmma(st.o, vf, __builtin_bit_cast(bf16x8, pw0), __builtin_bit_cast(bf16x8, pw1), __builtin_bit_cast(bf16x8, pw2), __builtin_bit_cast(bf16x8, pw3));
}
template <bool FIRST>
__device__ __forceinline__ void fold_branch(LAS float* ostg, State& st, float gate, LAS float* wsf, int r32, int hi) {
    float l = st.l;
    { auto rr = __builtin_amdgcn_permlane32_swap(__float_as_uint(l), __float_as_uint(l), false, false); l = __uint_as_float(rr[0]) + __uint_as_float(rr[1]); }
    const float f = l > 0.f ? gate / l : 0.f;
    asm volatile("s_waitcnt lgkmcnt(0)" ::: "memory");
    if (hi == 0) wsf[r32] = f;
    asm volatile("s_waitcnt lgkmcnt(0)" ::: "memory");
#pragma unroll
    for (int r = 0; r < 16; ++r) { const int orow = crow(r, hi); const float a = wsf[orow];
#pragma unroll
        for (int d0 = 0; d0 < 2; ++d0) { LAS float* p = ostg + orow * 64 + d0 * 32 + r32; if (FIRST) *p = st.o[d0][r] * a; else *p += st.o[d0][r] * a; } }
    asm volatile("s_waitcnt lgkmcnt(0)" ::: "memory");
}

__device__ __forceinline__ int nsa_unit(const Ptrs& P, LAS unsigned char* lds, int bg, int qt, const int wave_s, unsigned* qctr, int qbase) {
    unsigned char* ws = P.ws;
    const int lane = fresh_lane(), r32 = lane & 31, hi = lane >> 5; const int wid = wave_s;
    const int b = bg >> 2, g = bg & 3, t0 = 64 * qt;
    const int tl = 8 * wid + (r32 >> 2), hq = r32 & 3;
    const size_t m0 = (size_t)b * SEQ + t0;
    const bf16_t* Q = (const bf16_t*)(ws + WS_Q); const bf16_t* KV6 = (const bf16_t*)(ws + WS_KV6);
    const bf16_t* KSb = KV6 + 2 * KVSZ + (size_t)bg * SEQ * 64; const bf16_t* VSb = KV6 + 3 * KVSZ + (size_t)bg * SEQ * 64;
    const bf16_t* KWb = KV6 + 4 * KVSZ + (size_t)bg * SEQ * 64; const bf16_t* VWb = KV6 + 5 * KVSZ + (size_t)bg * SEQ * 64;
    const bf16_t* KCb = (const bf16_t*)(ws + WS_KC) + (size_t)bg * 256 * 64; const bf16_t* VCb = (const bf16_t*)(ws + WS_VC) + (size_t)bg * 256 * 64;
    const float* GATES = (const float*)(ws + WS_GATES); bf16_t* AB = (bf16_t*)(ws + WS_AB);
    const unsigned lds0 = (unsigned)(uintptr_t)lds;
    LAS float* wsf = (LAS float*)(lds + L_WSF) + wid * 64;
    LAS float* IMP = (LAS float*)(lds + L_IMP);
    LAS unsigned* MASK = (LAS unsigned*)(lds + L_MASK); LAS unsigned* WU = (LAS unsigned*)(lds + L_WU);
    const int koff = lane * 64 + wid * 8, voff = (16 * (wid & 3) + (lane >> 2)) * 64 + (wid >> 2) * 32 + (lane & 3) * 8;
    const unsigned kdst = lds0 + L_K + wid * 1024, vdst = lds0 + L_V + wid * 1024;
#define NSA_DMA_K(base, tile, slot) glds16((base) + (size_t)(tile) * 4096, (unsigned)koff * 2u, (unsigned)__builtin_amdgcn_readfirstlane(kdst + (slot) * SLOTB))
#define NSA_DMA_V(base, tile, slot) glds16((base) + (size_t)(tile) * 4096, (unsigned)voff * 2u, (unsigned)__builtin_amdgcn_readfirstlane(vdst + (slot) * SLOTB))
    const int vb0 = (int)(lds0 + L_V) + ((lane >> 4) & 1) * 32 + (lane & 3) * 8 + (4 * hi + ((lane & 15) >> 2)) * 64;
    LAS const char* Kbase = (LAS const char*)(lds + L_K);
    bf16x8 qr[4];
    { const bf16_t* qp = Q + (m0 + tl) * 1024 + (4 * g + hq) * 64 + hi * 8;
#pragma unroll
      for (int d0 = 0; d0 < 4; ++d0) qr[d0] = *(const bf16x8*)(qp + d0 * 16); }
    const float sl2 = __builtin_amdgcn_exp2f(-0.5f * (float)(4 * g + hq + 1)) * LOG2E;
    f32x16 bk;
#pragma unroll
    for (int r = 0; r < 16; ++r) bk[r] = sl2 * (float)((r & 3) + 8 * (r >> 2));
    const float b32t = 32.0f * sl2, b32c = 512.0f * sl2, hoff_t = 4.0f * (float)hi * sl2, hoff_c = 64.0f * (float)hi * sl2;
    float gate[3];
    { const float* gp = GATES + (m0 + tl) * 48 + (4 * g + hq) * 3; gate[0] = gp[0]; gate[1] = gp[1]; gate[2] = gp[2]; }
    LAS float* ostg = (LAS float*)(lds + L_OST) + wid * 2048;
    State st;
    f32x16 p0, p1;
    int nxt_ticket = 0;

    int tc = 0;
    VFrag vf;
    const int nvmax = (t0 + 63 >= 31) ? ((t0 + 63 - 31) >> 4) + 1 : 0;
    const int nct = (nvmax + 63) >> 6;
    const int tq = t0 + tl, nv = tq >= 31 ? ((tq - 31) >> 4) + 1 : 0;
    {
        state_init(st);
        const int j0 = qt >= 8 ? qt - 8 : 0, nt = qt - j0 + 1;
        NSA_DMA_K(KWb, qt, 0); NSA_DMA_V(VWb, qt, 0); NSA_WAIT_BAR();
        for (int i = 0; i < nt; ++i) {
            const int j = qt - i, slot = (tc + i) & 1;
            if (i + 1 < nt) { NSA_DMA_K(KWb, j - 1, slot ^ 1); NSA_DMA_V(VWb, j - 1, slot ^ 1); }
            else { NSA_DMA_K(KCb, nct - 1, slot ^ 1); NSA_DMA_V(VCb, nct - 1, slot ^ 1); }
            const float rb0 = sl2 * (float)(64 * j - t0), mref = tile_ref(st, rb0, true), c0 = rb0 + hoff_t - mref;
            if (j == qt) tile_scores<1, 1, true>(p0, p1, Kbase + slot * SLOTB, qr, bk, c0, b32t, tl, r32, hi, vf, vb0 + slot * SLOTB);
            else if (j == qt - 8) tile_scores<1, 2, true>(p0, p1, Kbase + slot * SLOTB, qr, bk, c0, b32t, tl, r32, hi, vf, vb0 + slot * SLOTB);
            else tile_scores<1, 0, true>(p0, p1, Kbase + slot * SLOTB, qr, bk, c0, b32t, 0, r32, hi, vf, vb0 + slot * SLOTB);
            tile_softmax_pv(st, p0, p1, mref, vf, wsf, r32, hi);
            NSA_WAIT_BAR();
        }
        tc += nt;
        fold_branch<true>(ostg, st, gate[2], wsf, r32, hi);
    }
    {
        state_init(st);
        for (int ci = 0; ci < nct; ++ci) {
            const int c = nct - 1 - ci, slot = (tc + ci) & 1;
            if (ci + 1 < nct) { NSA_DMA_K(KCb, c - 1, slot ^ 1); NSA_DMA_V(VCb, c - 1, slot ^ 1); }
            else if (qt >= 16) { NSA_DMA_K(KCb, 0, slot ^ 1); }
            else { NSA_DMA_K(KSb, qt, slot ^ 1); NSA_DMA_V(VSb, qt, slot ^ 1); }
            const float rb0 = sl2 * ((float)(1024 * c - t0) + 15.5f), mref = tile_ref(st, rb0, true), c0 = rb0 + hoff_c - mref;
            tile_scores<16, 3, true>(p0, p1, Kbase + slot * SLOTB, qr, bk, c0, b32c, nv - 64 * c, r32, hi, vf, vb0 + slot * SLOTB);
            tile_softmax_pv(st, p0, p1, mref, vf, wsf, r32, hi);
            NSA_WAIT_BAR();
        }
        tc += nct;
    }
    const float mc_fin = st.m; float lc = st.l;
    fold_branch<false>(ostg, st, gate[0], wsf, r32, hi);
    if (qt >= 16) {
        { auto rr = __builtin_amdgcn_permlane32_swap(__float_as_uint(lc), __float_as_uint(lc), false, false); lc = __uint_as_float(rr[0]) + __uint_as_float(rr[1]); }
        const float invl = lc > 0.f ? 1.0f / lc : 0.f;
        float carry = 0.f;
        for (int c = 0; c < nct; ++c) {
            const int slot = (tc + c) & 1;
            if (c + 1 < nct) { NSA_DMA_K(KCb, c + 1, slot ^ 1); }
            else { NSA_DMA_K(KSb, qt, slot ^ 1); NSA_DMA_V(VSb, qt, slot ^ 1); }
            const float c0 = sl2 * ((float)(1024 * c - t0) + 15.5f) + hoff_c - mc_fin;
            tile_scores<16, 3, false>(p0, p1, Kbase + slot * SLOTB, qr, bk, c0, b32c, nv - 64 * c, r32, hi, vf, 0);
#pragma unroll
            for (int r = 0; r < 16; ++r) { p0[r] = __builtin_amdgcn_exp2f(p0[r]) * invl; p1[r] = __builtin_amdgcn_exp2f(p1[r]) * invl; }
            float imp0[4], imp1[4], pl0[4], pl1[4];
#pragma unroll
            for (int a = 0; a < 4; ++a) {
                imp0[a] = (p0[4 * a] + p0[4 * a + 1]) + (p0[4 * a + 2] + p0[4 * a + 3]); imp1[a] = (p1[4 * a] + p1[4 * a + 1]) + (p1[4 * a + 2] + p1[4 * a + 3]);
                pl0[a] = __shfl_xor(p0[4 * a + 3], 32); pl1[a] = __shfl_xor(p1[4 * a + 3], 32);
            }
            if (hi) {
#pragma unroll
                for (int a = 0; a < 4; ++a) { imp0[a] += pl0[a]; imp1[a] += pl1[a]; }
            } else {
                imp0[0] += carry; imp1[0] += pl0[3];
#pragma unroll
                for (int a = 1; a < 4; ++a) { imp0[a] += pl0[a - 1]; imp1[a] += pl1[a - 1]; }
            }
            carry = pl1[3];
#pragma unroll
            for (int a = 0; a < 4; ++a) {
                imp0[a] += __shfl_xor(imp0[a], 1); imp0[a] += __shfl_xor(imp0[a], 2); imp1[a] += __shfl_xor(imp1[a], 1); imp1[a] += __shfl_xor(imp1[a], 2);
                if (hq == 0) { IMP[tl * 64 + 16 * c + 2 * a + hi] = imp0[a]; IMP[tl * 64 + 16 * c + 8 + 2 * a + hi] = imp1[a]; }
            }
            NSA_WAIT_BAR();
        }
        tc += nct;
    }
    unsigned long long wu = 0ull;
    if (qt < 16) {
        wu = (2ull << qt) - 1ull;
        if (lane < 8) { MASK[2 * (8 * wid + lane)] = (unsigned)wu; MASK[2 * (8 * wid + lane) + 1] = (unsigned)(wu >> 32); }
    } else {
        const int j = lane; const bool valid = j <= qt, forced = (j == 0) || (j == qt) || (j == qt - 1);
        for (int k = 0; k < 8; ++k) {
            const float imp = IMP[(8 * wid + k) * 64 + j];
            const float scv = valid ? (forced ? 1e9f : imp) : -1e9f;
            const unsigned fb = __float_as_uint(scv), key = fb ^ ((fb >> 31) ? 0xffffffffu : 0x80000000u);
            unsigned T = 0u;
#pragma unroll
            for (int bit = 31; bit >= 0; --bit) { const unsigned cand = T | (1u << bit); if (__builtin_popcountll(__ballot(key >= cand)) >= 16) T = cand; }
            const unsigned long long gt = __ballot(key > T), eq = __ballot(key == T);
            const int need = 16 - __builtin_popcountll(gt);
            const int before = (int)__builtin_amdgcn_mbcnt_hi((unsigned)(eq >> 32), __builtin_amdgcn_mbcnt_lo((unsigned)eq, 0u));
            const bool sel = (key > T) || ((key == T) && (before < need));
            const unsigned long long mk = __ballot(sel && (scv > -0.5e9f));
            wu |= mk;
            if (lane == 0) { MASK[2 * (8 * wid + k)] = (unsigned)mk; MASK[2 * (8 * wid + k) + 1] = (unsigned)(mk >> 32); }
        }
    }
    if (lane == 0) { WU[2 * wid] = (unsigned)wu; WU[2 * wid + 1] = (unsigned)(wu >> 32); }
    NSA_WAIT_BAR();
    unsigned long long uni = 0ull;
#pragma unroll
    for (int w = 0; w < 8; ++w) uni |= ((unsigned long long)WU[2 * w]) | (((unsigned long long)WU[2 * w + 1]) << 32);
    uni = ((unsigned long long)(unsigned)__builtin_amdgcn_readfirstlane((unsigned)uni)) | (((unsigned long long)(unsigned)__builtin_amdgcn_readfirstlane((unsigned)(uni >> 32))) << 32);
    const unsigned long long mymask = ((unsigned long long)MASK[2 * tl]) | (((unsigned long long)MASK[2 * tl + 1]) << 32);
    {
        state_init(st);
        unsigned long long rem = uni;
        int j = 63 - __builtin_clzll(rem); rem &= ~(1ull << j);
        for (int i = 0;; ++i) {
            const int slot = (tc + i) & 1; const bool more = rem != 0ull;
            int jn = 0;
            if (more) { jn = 63 - __builtin_clzll(rem); rem &= ~(1ull << jn); NSA_DMA_K(KSb, jn, slot ^ 1); NSA_DMA_V(VSb, jn, slot ^ 1); }
            if ((wu >> j) & 1ull) {
                const bool live = ((mymask >> j) & 1ull) != 0ull;
                const float rb0 = sl2 * (float)(64 * j - t0), mref = tile_ref(st, rb0, live), c0 = live ? rb0 + hoff_t - mref : -INFINITY;
                if (j == qt) tile_scores<1, 1, true>(p0, p1, Kbase + slot * SLOTB, qr, bk, c0, b32t, tl, r32, hi, vf, vb0 + slot * SLOTB);
                else tile_scores<1, 0, true>(p0, p1, Kbase + slot * SLOTB, qr, bk, c0, b32t, 0, r32, hi, vf, vb0 + slot * SLOTB);
                tile_softmax_pv(st, p0, p1, mref, vf, wsf, r32, hi);
            }
            NSA_WAIT_BAR();
            if (!more) break;
            j = jn;
        }
        if (wid == 0 && lane == 0) nxt_ticket = qbase + (int)__hip_atomic_fetch_add(qctr, 1u, __ATOMIC_RELAXED, __HIP_MEMORY_SCOPE_AGENT);
        fold_branch<false>(ostg, st, gate[1], wsf, r32, hi);
    }
    {
#pragma unroll
        for (int i = 0; i < 4; ++i) { const int row = i * 8 + (lane >> 3), ch = lane & 7;
            const f32x4_t v0 = *(LAS const f32x4_t*)(ostg + row * 64 + ch * 8), v1 = *(LAS const f32x4_t*)(ostg + row * 64 + ch * 8 + 4);
            u32x4_t v; v.x = cvtpk_s(v0[0], v0[1]); v.y = cvtpk_s(v0[2], v0[3]); v.z = cvtpk_s(v1[0], v1[1]); v.w = cvtpk_s(v1[2], v1[3]);
            *(u32x4_t*)(AB + (m0 + 8 * wid + (row >> 2)) * 2048 + 256 * g + (row & 3) * 64 + ch * 8) = v; }
    }
    NSA_WAIT_BAR();
#undef NSA_DMA_K
#undef NSA_DMA_V
    return nxt_ticket;
}
constexpr int L_QS = 145416;
__device__ __forceinline__ void nsa_phase(const Ptrs& P, LAS unsigned char* lds, int bid, int G, const int wave_s) {
    unsigned* qctr = (unsigned*)(P.ws + WS_CTL) + 3584;
    LAS int* qs = (LAS int*)(lds + L_QS);
    int k = bid;
    while (k < 1024 + LW_CHUNKS) {
        int nxt;
        if (k < 1024) {
            const int qt = 63 - (k >> 4), g = 3 - ((k >> 2) & 3), b = k & 3;
            nxt = nsa_unit(P, lds, b * 4 + g, qt, wave_s, qctr, G);
        } else {
            nxt = 0;
            if (wave_s == 0 && fresh_lane() == 0) nxt = G + (int)__hip_atomic_fetch_add(qctr, 1u, __ATOMIC_RELAXED, __HIP_MEMORY_SCOPE_AGENT);
            late_weight_chunk(P, lds, k - 1024, wave_s);
        }
        if (wave_s == 0 && fresh_lane() == 0) *qs = nxt;
        NSA_WAIT_BAR();
        k = __builtin_amdgcn_readfirstlane(*qs);
    }
}
}

namespace p2 {
using nsa::bf16x8; using nsa::f32x16; using nsa::s16x4; using nsa::crow; using nsa::glds16; using nsa::cvtpk_s;
#define P2_WAIT_BAR() asm volatile("s_waitcnt vmcnt(0) lgkmcnt(0)\n\ts_barrier" ::: "memory")
constexpr int CB_BUF = 40960;
constexpr int CP_STRIDE = 65;
__device__ __forceinline__ void compress_unit(const Ptrs& P, LAS unsigned char* lds, int u, const int wave_s) {
    unsigned char* ws = P.ws;
    const int lane = fresh_lane(), r32 = lane & 31, hi = lane >> 5, wid = wave_s;
    const int kv = u >> 6, bg = (u >> 2) & 15, n0 = 64 * (u & 3);
    const bf16_t* Ag = (const bf16_t*)(ws + WS_KV6) + (size_t)kv * KVSZ + (size_t)bg * SEQ * 64 + (size_t)n0 * 1024;
    const bf16_t* Bg = (const bf16_t*)(ws + WS_W1C) + (size_t)kv * 256 * 2048;
    const unsigned lds0 = (unsigned)(uintptr_t)lds;
    const unsigned aoff = (unsigned)(lane * 1024 + wid * 8) * 2u, boff = (unsigned)(lane * 2048 + wid * 8) * 2u;
    const unsigned dstw = lds0 + wid * 1024;
#define P2_DMA_TILE(kt, buf) do { const unsigned d_ = (unsigned)__builtin_amdgcn_readfirstlane(dstw + (buf) * CB_BUF); \
        glds16(Ag + (kt) * 64, aoff, d_); \
        _Pragma("unroll") for (int ct_ = 0; ct_ < 4; ++ct_) glds16(Bg + (size_t)ct_ * 64 * 2048 + (kt) * 64, boff, d_ + 8192u * (ct_ + 1)); } while (0)
    const int ct = wid >> 1, half = wid & 1, ncol0 = 64 * ct + 32 * half;
    f32x16 hT[2]; hT[0] = f32x16{}; hT[1] = f32x16{};
    P2_DMA_TILE(0, 0); P2_DMA_TILE(1, 1);
    asm volatile("s_waitcnt vmcnt(5) lgkmcnt(0)\n\ts_barrier" ::: "memory");
    for (int kt = 0; kt < 32; ++kt) {
        const int buf = kt % 3;
        if (kt + 2 < 32) P2_DMA_TILE(kt + 2, (kt + 2) % 3);
        LAS const char* sa = (LAS const char*)(lds + buf * CB_BUF) + hi * 1024 + r32 * 16;
        LAS const char* sb = (LAS const char*)(lds + buf * CB_BUF + 8192 * (ct + 1)) + half * 512 + hi * 1024 + r32 * 16;
#pragma unroll
        for (int d0 = 0; d0 < 4; ++d0) {
            const bf16x8 bf = *(LAS const bf16x8*)(sb + d0 * 2048), a0 = *(LAS const bf16x8*)(sa + d0 * 2048), a1 = *(LAS const bf16x8*)(sa + d0 * 2048 + 512);
            hT[0] = __builtin_amdgcn_mfma_f32_32x32x16_bf16(bf, a0, hT[0], 0, 0, 0);
            hT[1] = __builtin_amdgcn_mfma_f32_32x32x16_bf16(bf, a1, hT[1], 0, 0, 0);
        }
        if (kt + 2 < 32) asm volatile("s_waitcnt vmcnt(5) lgkmcnt(0)\n\ts_barrier" ::: "memory");
        else asm volatile("s_waitcnt vmcnt(0) lgkmcnt(0)\n\ts_barrier" ::: "memory");
    }
    const float* bias1 = (const float*)(ws + WS_SMALL + SM_BIAS1) + kv * 256 + ncol0;
    bf16x8 hb[2][2];
#pragma unroll
    for (int mt = 0; mt < 2; ++mt) {
        float g[16];
#pragma unroll
        for (int r = 0; r < 16; ++r) g[r] = gelu_tanh(hT[mt][r] + bias1[crow(r, hi)]);
#pragma unroll
        for (int s = 0; s < 2; ++s) { u32x4_t w; w.x = cvtpk_s(g[8 * s], g[8 * s + 1]); w.y = cvtpk_s(g[8 * s + 2], g[8 * s + 3]); w.z = cvtpk_s(g[8 * s + 4], g[8 * s + 5]); w.w = cvtpk_s(g[8 * s + 6], g[8 * s + 7]);
            hb[mt][s] = __builtin_bit_cast(bf16x8, w); }
    }
    const bf16_t* w2t = (const bf16_t*)(ws + WS_SMALL + SM_W2T) + (size_t)kv * 64 * 256;
    f32x16 oT[2][2];
#pragma unroll
    for (int dt = 0; dt < 2; ++dt)
#pragma unroll
        for (int mt = 0; mt < 2; ++mt) oT[dt][mt] = f32x16{};
#pragma unroll
    for (int dt = 0; dt < 2; ++dt)
#pragma unroll
        for (int s = 0; s < 2; ++s) {
            const bf16_t* wp = w2t + (size_t)(32 * dt + r32) * 256 + ncol0 + 16 * s + 4 * hi;
            const u32x2_t lo = *(const u32x2_t*)wp, hi2 = *(const u32x2_t*)(wp + 8);
            const u32x4_t wv = {lo.x, lo.y, hi2.x, hi2.y}; const bf16x8 wf = __builtin_bit_cast(bf16x8, wv);
#pragma unroll
            for (int mt = 0; mt < 2; ++mt) oT[dt][mt] = __builtin_amdgcn_mfma_f32_32x32x16_bf16(wf, hb[mt][s], oT[dt][mt], 0, 0, 0);
        }
    LAS float* part = (LAS float*)lds + wid * 64 * CP_STRIDE;
#pragma unroll
    for (int dt = 0; dt < 2; ++dt)
#pragma unroll
        for (int mt = 0; mt < 2; ++mt)
#pragma unroll
            for (int r = 0; r < 16; ++r) part[(32 * mt + r32) * CP_STRIDE + 32 * dt + crow(r, hi)] = oT[dt][mt][r];
    P2_WAIT_BAR();
    {
        const int tid = wid * 64 + lane, m = tid >> 3, dg = tid & 7;
        float o[8];
#pragma unroll
        for (int e = 0; e < 8; ++e) { float s = 0.f;
#pragma unroll
            for (int w = 0; w < 8; ++w) s += ((LAS const float*)lds)[(w * 64 + m) * CP_STRIDE + 8 * dg + e];
            o[e] = s; }
        if (kv == 0) {
            float ss = 0.f;
#pragma unroll
            for (int e = 0; e < 8; ++e) ss += o[e] * o[e];
            ss += __shfl_xor(ss, 1); ss += __shfl_xor(ss, 2); ss += __shfl_xor(ss, 4);
            const float rr = __builtin_amdgcn_rsqf(ss * (1.0f / 64.0f) + 1e-6f);
#pragma unroll
            for (int e = 0; e < 8; ++e) o[e] *= rr * P.in[4][8 * dg + e];
        }
        const int n = n0 + m;
        u32x4_t v = {0u, 0u, 0u, 0u};
        if (n < 255) { v.x = cvtpk_s(o[0], o[1]); v.y = cvtpk_s(o[2], o[3]); v.z = cvtpk_s(o[4], o[5]); v.w = cvtpk_s(o[6], o[7]); }
        *(u32x4_t*)((bf16_t*)(ws + (kv ? WS_VC : WS_KC)) + ((size_t)bg * 256 + n) * 64 + 8 * dg) = v;
    }
    P2_WAIT_BAR();
#undef P2_DMA_TILE
}

constexpr int G_V = 0, G_ST = 32768, G_OST = 33792, G_END = 33792 + 65536;
struct GmlpIn { u32x4_t raw[4]; u32x4_t uraw[4]; float sbv[4]; };
__device__ __forceinline__ void gmlp_load(GmlpIn& in, const Ptrs& P, int unit, int tid, int lane, int r32, int hi, int wid) {
    unsigned char* ws = P.ws;
    const int g = unit & 7, chunk = (unit >> 3) & 31, b = unit >> 8; const int m0 = b * SEQ + chunk * 128;
    const bf16_t* GV = (const bf16_t*)(ws + WS_GV); const bf16_t* U = (const bf16_t*)(ws + WS_U);
    const int tb = wid >> 1, ch = wid & 1; (void)r32; (void)hi;
#pragma unroll
    for (int i = 0; i < 4; ++i) { const int idx = tid + 512 * i, s = idx >> 4, c8 = idx & 15; in.raw[i] = *(const u32x4_t*)(GV + (size_t)(m0 + s) * 1024 + g * 128 + 8 * c8); }
#pragma unroll
    for (int i = 0; i < 4; ++i) { const int row = i * 8 + (lane >> 3), t = 32 * tb + row; in.uraw[i] = *(const u32x4_t*)(U + (size_t)(m0 + t) * 1024 + g * 128 + 64 * ch + 8 * (lane & 7)); in.sbv[i] = P.in[11][g * 128 + t]; }
}
__device__ __forceinline__ void gmlp_compute(const GmlpIn& in, const f32x4_t (&sv)[8], const bf16x8 (&pa)[2][4], const f32x4_t w0, const f32x4_t w1, const f32x4_t b0, const f32x4_t b1, const Ptrs& P, LAS unsigned char* lds, int unit, int tid, int lane, int r32, int hi, int wid) {
    unsigned char* ws = P.ws;
    const int g = unit & 7, chunk = (unit >> 3) & 31, b = unit >> 8; const int m0 = b * SEQ + chunk * 128;
    bf16_t* AB = (bf16_t*)(ws + WS_AB);
    LAS float* st = (LAS float*)(lds + G_ST);
    const int tb = wid >> 1, ch = wid & 1;
    if (tid < 128) { float s1 = 0.f, s2 = 0.f;
#pragma unroll
        for (int i = 0; i < 8; ++i) { s1 += sv[i][0] + sv[i][2]; s2 += sv[i][1] + sv[i][3]; }
        const float mean = s1 * (1.0f / 1024.0f); float var = s2 * (1.0f / 1024.0f) - mean * mean; var = var < 0.f ? 0.f : var;
        st[2 * tid] = mean; st[2 * tid + 1] = __builtin_amdgcn_rsqf(var + 1e-5f); }
    asm volatile("s_waitcnt lgkmcnt(0)\n\ts_barrier" ::: "memory");
#pragma unroll
    for (int i = 0; i < 4; ++i) { const int idx = tid + 512 * i, s = idx >> 4, c8 = idx & 15;
        float f[8]; unpack8(in.raw[i], f);
        const float mean = st[2 * s], rstd = st[2 * s + 1];
        float y[8];
#pragma unroll
        for (int e = 0; e < 4; ++e) { y[e] = (f[e] - mean) * rstd * w0[e] + b0[e]; y[4 + e] = (f[4 + e] - mean) * rstd * w1[e] + b1[e]; }
        u32x4_t o; o.x = cvtpk_s(y[0], y[1]); o.y = cvtpk_s(y[2], y[3]); o.z = cvtpk_s(y[4], y[5]); o.w = cvtpk_s(y[6], y[7]);
        const int st_ = s >> 6, sk = s & 63, chh = c8 >> 3, x = c8 & 7;
        *(LAS u32x4_t*)(lds + G_V + (st_ * 2 + chh) * 8192 + (x >> 2) * 4096 + (sk >> 4) * 1024 + (sk & 15) * 64 + (x & 3) * 16) = o; }
    asm volatile("s_waitcnt lgkmcnt(0)\n\ts_barrier" ::: "memory");
    f32x16 o[2]; o[0] = f32x16{}; o[1] = f32x16{};
    const int vb0 = (int)((unsigned)(uintptr_t)lds + G_V) + ((lane >> 4) & 1) * 32 + (lane & 3) * 8 + (4 * hi + ((lane & 15) >> 2)) * 64;
    nsa::pv(o, vb0 + ch * 8192, pa[0][0], pa[0][1], pa[0][2], pa[0][3]);
    if (tb >= 2) nsa::pv(o, vb0 + (2 + ch) * 8192, pa[1][0], pa[1][1], pa[1][2], pa[1][3]);
    LAS float* ostg = (LAS float*)(lds + G_OST) + wid * 2048;
#pragma unroll
    for (int r = 0; r < 16; ++r) { const int orow = crow(r, hi);
#pragma unroll
        for (int d0 = 0; d0 < 2; ++d0) ostg[orow * 64 + d0 * 32 + r32] = o[d0][r]; }
    asm volatile("s_waitcnt lgkmcnt(0)" ::: "memory");
#pragma unroll
    for (int i = 0; i < 4; ++i) { const int row = i * 8 + (lane >> 3), c8 = lane & 7, t = 32 * tb + row;
        const f32x4_t v0 = *(LAS const f32x4_t*)(ostg + row * 64 + c8 * 8), v1 = *(LAS const f32x4_t*)(ostg + row * 64 + c8 * 8 + 4);
        const size_t grow = (size_t)(m0 + t); const int col = g * 128 + 64 * ch + 8 * c8;
        float uf[8]; unpack8(in.uraw[i], uf);
        const float sb_ = in.sbv[i];
        u32x4_t w; w.x = cvtpk_s(uf[0] * (v0[0] + sb_), uf[1] * (v0[1] + sb_)); w.y = cvtpk_s(uf[2] * (v0[2] + sb_), uf[3] * (v0[3] + sb_));
        w.z = cvtpk_s(uf[4] * (v1[0] + sb_), uf[5] * (v1[1] + sb_)); w.w = cvtpk_s(uf[6] * (v1[2] + sb_), uf[7] * (v1[3] + sb_));
        *(u32x4_t*)(AB + grow * 2048 + 1024 + col) = w; }
    asm volatile("s_waitcnt lgkmcnt(0)\n\ts_barrier" ::: "memory");
}
__device__ __forceinline__ void gmlp_run(const Ptrs& P, LAS unsigned char* lds, int u0, int stride, int nunits, const int wave_s) {
    const int lane = fresh_lane(), r32 = lane & 31, hi = lane >> 5, wid = wave_s, tid = wid * 64 + lane;
    GmlpIn A, B;
    int u = u0;
    bf16x8 pa[2][4];
    { const bf16_t* SWB = (const bf16_t*)(P.ws + WS_SMALL + SM_SWB) + (size_t)(u0 & 7) * 16384; const int tb = wid >> 1;
#pragma unroll
      for (int st_ = 0; st_ < 2; ++st_)
#pragma unroll
        for (int ks = 0; ks < 4; ++ks) {
            const bf16_t* wp = SWB + (size_t)(32 * tb + r32) * 128 + 64 * st_ + 16 * ks + 4 * hi;
            const u32x2_t lo = *(const u32x2_t*)wp, hi2 = *(const u32x2_t*)(wp + 8);
            const u32x4_t wv = {lo.x, lo.y, hi2.x, hi2.y}; pa[st_][ks] = __builtin_bit_cast(bf16x8, wv); } }
    const int c8v = tid & 15, g0 = u0 & 7;
    const f32x4_t w0 = *(const f32x4_t*)(P.in[8] + g0 * 128 + 8 * c8v), w1 = *(const f32x4_t*)(P.in[8] + g0 * 128 + 8 * c8v + 4), b0 = *(const f32x4_t*)(P.in[9] + g0 * 128 + 8 * c8v), b1 = *(const f32x4_t*)(P.in[9] + g0 * 128 + 8 * c8v + 4);
    const float* VSTAT = (const float*)(P.ws + WS_VSTAT);
#define GMLP_STATS(sv_, unit_) do { const int m0_ = ((unit_) >> 8) * SEQ + (((unit_) >> 3) & 31) * 128; const f32x4_t* p_ = (const f32x4_t*)(VSTAT + (size_t)(m0_ + (tid & 127)) * 32); \
        _Pragma("unroll") for (int i_ = 0; i_ < 8; ++i_) sv_[i_] = p_[i_]; } while (0)
    f32x4_t sv[8];
    if (u < nunits) gmlp_load(A, P, u, tid, lane, r32, hi, wid);
    while (u < nunits) {
        GMLP_STATS(sv, u);
        if (u + stride < nunits) gmlp_load(B, P, u + stride, tid, lane, r32, hi, wid);
        gmlp_compute(A, sv, pa, w0, w1, b0, b1, P, lds, u, tid, lane, r32, hi, wid);
        u += stride; if (u >= nunits) break;
        GMLP_STATS(sv, u);
        if (u + stride < nunits) gmlp_load(A, P, u + stride, tid, lane, r32, hi, wid);
        gmlp_compute(B, sv, pa, w0, w1, b0, b1, P, lds, u, tid, lane, r32, hi, wid);
        u += stride;
    }
#undef GMLP_STATS
    asm volatile("s_waitcnt vmcnt(0) lgkmcnt(0)\n\ts_barrier" ::: "memory");
}
#undef P2_WAIT_BAR
}

#define XB_TMO      128
#define XB_XCNT(j)  (256  + 64 * (j))
#define XB_XSUB(j)  (1280 + 64 * (j))
#define XB_XGEN(j)  (2304 + 64 * (j))
#define XB_TOP      3328
#define XB_TOPGEN   3392
#define XCD_BAR_WORDS 3456
#define XB_SPIN_CAP (1u << 18)

__device__ __forceinline__ unsigned xb_ld(unsigned* p)              { return __hip_atomic_load(p, __ATOMIC_RELAXED, __HIP_MEMORY_SCOPE_AGENT); }
__device__ __forceinline__ unsigned xb_add(unsigned* p, unsigned v) { return __hip_atomic_fetch_add(p, v, __ATOMIC_RELAXED, __HIP_MEMORY_SCOPE_AGENT); }
__device__ __forceinline__ unsigned xb_xcc_id() { return (unsigned)__builtin_amdgcn_s_getreg((3 << 11) | 20) & 0xFu; }
#define XB_SPIN(cond, bar) do { unsigned _sp = 0; while (cond) { __builtin_amdgcn_s_sleep(1); \
    if ((++_sp & 255u) == 0u) { if (xb_ld(&(bar)[XB_TMO])) break; if (_sp > XB_SPIN_CAP) { atomicAdd(&(bar)[XB_TMO], 1u); break; } } } } while (0)

struct XcdBarrier {
    unsigned* bar; unsigned x; unsigned w0;
    volatile LAS unsigned* st;
};

__device__ __forceinline__ XcdBarrier xcd_barrier_post(unsigned* bar, volatile LAS unsigned* st, int wave_s) {
    XcdBarrier b; b.bar = bar; b.x = xb_xcc_id(); b.st = st; b.w0 = wave_s == 0 ? 1u : 0u;
    if (b.w0 && fresh_lane() == 0) (void)xb_add(&bar[XB_XCNT(b.x)], 1u);
    return b;
}
__device__ __forceinline__ void xcd_barrier_complete(unsigned* bar, unsigned x, unsigned& nloc, unsigned& nx) {
    const unsigned G = gridDim.x * gridDim.y * gridDim.z;
    unsigned sum, cnt, mine, sp = 0u;
    for (;;) {
        sum = 0u; cnt = 0u; mine = 0u;
#pragma unroll
        for (unsigned j = 0; j < 16; ++j) { const unsigned c = xb_ld(&bar[XB_XCNT(j)]); sum += c; cnt += (c > 0u) ? 1u : 0u; mine = (j == x) ? c : mine; }
        if (sum == G) break;
        __builtin_amdgcn_s_sleep(1);
        if ((++sp & 255u) == 0u) { if (xb_ld(&bar[XB_TMO])) break; if (sp > XB_SPIN_CAP) { atomicAdd(&bar[XB_TMO], 1u); break; } }
    }
    nloc = mine > 0u ? mine : 1u; nx = cnt > 0u ? cnt : 1u;
}

__device__ __forceinline__ void xcd_barrier(const XcdBarrier& b) {
    asm volatile("s_waitcnt vmcnt(0)" ::: "memory");
    __syncthreads();
    if (b.w0 && fresh_lane() == 0) {
        unsigned* bar = b.bar;
        __builtin_amdgcn_s_waitcnt(0);
        unsigned nloc = b.st[0], nx = b.st[1];
        if (nloc == 0u) { xcd_barrier_complete(bar, b.x, nloc, nx); b.st[0] = nloc; b.st[1] = nx; }
        const unsigned old = xb_add(&bar[XB_XSUB(b.x)], 1u);
        const unsigned gen = old / nloc;
        if (old + 1u == (gen + 1u) * nloc) {
            __builtin_amdgcn_fence(__ATOMIC_RELEASE, "agent");
            asm volatile("s_waitcnt vmcnt(0)" ::: "memory");
            const unsigned og = xb_add(&bar[XB_TOP], 1u);
            const unsigned tg = og / nx;
            if (og + 1u == (tg + 1u) * nx) xb_add(&bar[XB_TOPGEN], 1u);
            else XB_SPIN(xb_ld(&bar[XB_TOPGEN]) == tg, bar);
            __builtin_amdgcn_fence(__ATOMIC_ACQUIRE, "agent");
            xb_add(&bar[XB_XGEN(b.x)], 1u);
            asm volatile("s_waitcnt vmcnt(0)" ::: "memory");
        } else {
            XB_SPIN(xb_ld(&bar[XB_XGEN(b.x)]) == gen, bar);
            __builtin_amdgcn_fence(__ATOMIC_ACQUIRE, "agent");
            asm volatile("s_waitcnt vmcnt(0)" ::: "memory");
        }
    }
    __syncthreads();
}

constexpr int LDS_BYTES = 147456;
constexpr int LDS_XCH = 132096;
constexpr int LDS_MISC = 145408;
__global__ void __launch_bounds__(512, 2) mega_fwd(Ptrs P) {
    extern __shared__ __attribute__((aligned(16))) unsigned char lds_raw[];
    LAS unsigned char* lds = (LAS unsigned char*)lds_raw;
    unsigned char* ws = P.ws;
    const int wave = __builtin_amdgcn_readfirstlane(threadIdx.x >> 6);
    const int G = gridDim.x, bid = blockIdx.x;
    if (wave == 0) { const int l_ = fresh_lane(); if (l_ < 2) ((LAS unsigned*)(lds + LDS_MISC))[l_] = 0u; }
    __syncthreads();
    const XcdBarrier bar = xcd_barrier_post((unsigned*)(ws + WS_CTL), (volatile LAS unsigned*)(lds + LDS_MISC), wave);
    p0_prologue(P, lds, bid, G, wave);
    xcd_barrier(bar);
    if (bid == 0) bias1_stage(ws, fresh_tid(wave));
    {
        pg8::Gemm g{(const bf16_t*)(ws + WS_XN), (const bf16_t*)(ws + WS_WIN), MTOK, NPROJ, 2048, 2048};
        pg8::StaticOrder S; S.init(MTOK, NPROJ, G, bid);
        pg8::EpiProj E{(bf16_t*)(ws + WS_Q), (bf16_t*)(ws + WS_KV6), (bf16_t*)(ws + WS_U), (bf16_t*)(ws + WS_GV), (float*)(ws + WS_GATES), (float*)(ws + WS_VSTAT), P.in[3], P.in[4]};
        pg8::gemm_phase<pg8::EpiProj, pg8::StaticOrder, true, true>(lds, g, S, E, wave);
    }
    xcd_barrier(bar);
    if (bid < 128 && G >= 256) p2::compress_unit(P, lds, bid, wave);
    else if (G >= 256) p2::gmlp_run(P, lds, bid - 128, G - 128, 1024, wave);
    xcd_barrier(bar);
    nsa::nsa_phase(P, lds, bid, G, wave);
    xcd_barrier(bar);
    {
        pg8::Gemm g{(const bf16_t*)(ws + WS_AB), (const bf16_t*)(ws + WS_WOUT), MTOK, 2048, 2048, 2048};
        pg8::StaticOrder S; S.init(MTOK, 2048, G, bid);
        pg8::EpiRes1 E{(const float*)(ws + WS_SMALL + SM_RINV), (const float*)(ws + WS_SMALL + SM_INVW), (bf16_t*)(ws + WS_XN), (float*)(ws + WS_SSQ)};
        pg8::gemm_phase<pg8::EpiRes1, pg8::StaticOrder, true, true>(lds, g, S, E, wave);
    }
    xcd_barrier(bar);
    for (int m = bid * 512 + fresh_tid(wave); m < MTOK; m += G * 512) {
        const float* p = (const float*)(ws + WS_SSQ) + (size_t)m * 32; float s = 0.f;
#pragma unroll
        for (int i = 0; i < 32; ++i) s += p[i];
        ((float*)(ws + WS_SMALL + SM_R2))[m] = __builtin_amdgcn_rsqf(s * (1.0f / D_MODEL) + 1e-6f);
    }
    xcd_barrier(bar);
    {
        pg8::Gemm g{(const bf16_t*)(ws + WS_XN), (const bf16_t*)(ws + WS_WUP), MTOK, N_UP, 2048, 2048};
        pg8::StaticOrder S; S.init(MTOK, N_UP, G, bid);
        pg8::EpiUpConv E{(bf16_t*)(ws + WS_G), (const float*)(ws + WS_SMALL + SM_R2), P.in[15], P.in[16], (float*)(ws + WS_HLAST), (float*)(ws + WS_FIRST), lds + LDS_XCH};
        pg8::gemm_phase<pg8::EpiUpConv, pg8::StaticOrder, true, true>(lds, g, S, E, wave);
    }
    xcd_barrier(bar);
    for (int it = bid * 512 + fresh_tid(wave); it < 60 * 44 * 2 * 16; it += G * 512) {
        const int c8 = it & 15, row = (it >> 4) & 1, tl_ = it >> 5, pn = tl_ % 44, pmi = tl_ / 44, pm = pmi + pmi / 15 + 1;
        const float* cw = P.in[15]; const float* cb = P.in[16]; (void)cb;
        const float* fp = (const float*)(ws + WS_FIRST) + ((size_t)(pm * 44 + pn) * 2 + row) * 256 + 8 * c8;
        const float* lp = (const float*)(ws + WS_HLAST) + ((size_t)((pm - 1) * 44 + pn) * 2) * 256 + 8 * c8;
        const int ch = pn * 128 + 8 * c8;
        float r[8];
#pragma unroll
        for (int e = 0; e < 8; ++e) {
            const float l0g = lp[e], l1g = lp[256 + e], l0u = lp[128 + e], l1u = lp[256 + 128 + e];
            const float w0g = cw[ch + e], w1g = cw[N_UP + ch + e], w0u = cw[D_FF + ch + e], w1u = cw[N_UP + D_FF + ch + e];
            const float cg = fp[e] + (row == 0 ? w1g * l1g + w0g * l0g : w0g * l1g), cu = fp[128 + e] + (row == 0 ? w1u * l1u + w0u * l0u : w0u * l1u);
            r[e] = cg * sigmoidf_(cg) * cu;
        }
        u32x4_t o; o.x = pk2(r[0], r[1]); o.y = pk2(r[2], r[3]); o.z = pk2(r[4], r[5]); o.w = pk2(r[6], r[7]);
        *(u32x4_t*)((bf16_t*)(ws + WS_G) + (size_t)(pm * 256 + row) * D_FF + ch) = o;
    }
    xcd_barrier(bar);
    {
        pg8::Gemm g{(const bf16_t*)(ws + WS_G), (const bf16_t*)(ws + WS_WDOWN), MTOK, 2048, D_FF, D_FF};
        pg8::StaticOrder S; S.init(MTOK, 2048, G, bid);
        pg8::EpiDown E{P.out, (const bf16_t*)(ws + WS_XN)};
        pg8::gemm_phase<pg8::EpiDown, pg8::StaticOrder, true, true>(lds, g, S, E, wave);
    }
}

extern "C" void kernel_launch(void* const* d_in, const int* in_sizes, int n_in, void* d_out, int out_size, void* d_ws, size_t ws_size, hipStream_t stream) {
    static int grid_blocks = 0;
    if (!grid_blocks) {
        int dev = 0, cus = 0, per_cu = 0;
        (void)hipGetDevice(&dev);
        (void)hipDeviceGetAttribute(&cus, hipDeviceAttributeMultiprocessorCount, dev);
        (void)hipFuncSetAttribute((const void*)mega_fwd, hipFuncAttributeMaxDynamicSharedMemorySize, LDS_BYTES);
        (void)hipOccupancyMaxActiveBlocksPerMultiprocessor(&per_cu, (const void*)mega_fwd, 512, LDS_BYTES);
        if (per_cu < 1) { fprintf(stderr, "kernel_launch: occupancy query says %d blocks/CU\n", per_cu); per_cu = 1; }
        grid_blocks = cus * 1;
        (void)hipGetLastError();
    }
    if (n_in != 18 || ws_size < WS_END) { fprintf(stderr, "kernel_launch: unexpected n_in %d / ws %zu\n", n_in, ws_size); return; }
    Ptrs P{};
    for (int i = 0; i < 18; ++i) P.in[i] = (const float*)d_in[i];
    P.out = (float*)d_out; P.ws = (unsigned char*)d_ws;
    (void)hipMemsetAsync((char*)d_ws + WS_CTL, 0, 16384, stream);
    mega_fwd<<<dim3(grid_blocks), dim3(512), LDS_BYTES, stream>>>(P);
}
```

```cpp
#include <hip/hip_runtime.h>
#include <cstdio>
#include <cstdint>

constexpr int D_MODEL = 2048, BATCH = 4, SEQ = 4096, MTOK = BATCH * SEQ;
constexpr int IN_COLS = 4656, NPROJ = 4864;
constexpr int D_FF = 5632, N_UP = 2 * D_FF;
constexpr int NBG = 16;
constexpr size_t KVSZ = (size_t)NBG * SEQ * 64;
constexpr float LOG2E = 1.4426950408889634f;

constexpr size_t MiB = 1u << 20;
constexpr size_t WS_CTL = 0;
constexpr size_t WS_WIN = 1 * MiB, WS_WOUT = 20 * MiB, WS_WUP = 28 * MiB, WS_WDOWN = 72 * MiB, WS_W1C = 94 * MiB;
constexpr size_t WS_SMALL = 96 * MiB;
constexpr size_t SM_BIASP = 0, SM_BIAS1 = 65536, SM_R2 = 131072, SM_W2T = 196608  , SM_SWB = 262144  , SM_RINV = 524288  , SM_INVW = 589824  ;
constexpr size_t WS_XN = 97 * MiB;
constexpr size_t WS_Q = 161 * MiB;
constexpr size_t WS_KV6 = 193 * MiB;
constexpr size_t WS_U = 241 * MiB, WS_GV = 273 * MiB;
constexpr size_t WS_GATES = 305 * MiB;
constexpr size_t WS_VSTAT = 308 * MiB;
constexpr size_t WS_KC = 310 * MiB, WS_VC = 310 * MiB + 524288;
constexpr size_t WS_HC = 311 * MiB;
constexpr size_t WS_AB = 315 * MiB;
constexpr size_t WS_SSQ = 379 * MiB;
constexpr size_t WS_G = 161 * MiB;
constexpr size_t WS_HID = 381 * MiB;
constexpr size_t WS_HLAST = 381 * MiB, WS_FIRST = 388 * MiB;
constexpr size_t WS_END = 469 * MiB;

#define LAS __attribute__((address_space(3)))
typedef unsigned short bf16_t;
typedef unsigned u32x4_t __attribute__((ext_vector_type(4)));
typedef unsigned u32x2_t __attribute__((ext_vector_type(2)));
typedef float f32x4_t __attribute__((ext_vector_type(4)));

__device__ __forceinline__ float bf2f(unsigned short h) { return __uint_as_float(((unsigned)h) << 16); }
__device__ __forceinline__ unsigned f2bf(float f) { unsigned u = __float_as_uint(f); return (u + 0x7fffu + ((u >> 16) & 1u)) >> 16; }
__device__ __forceinline__ unsigned pk2(float lo, float hi) { return f2bf(lo) | (f2bf(hi) << 16); }
__device__ __forceinline__ float gelu_tanh(float x) {
    const float u = 0.7978845608028654f * (x + 0.044715f * x * x * x);
    const float e = __builtin_amdgcn_exp2f(-2.8853900817779268f * u);
    return x * __builtin_amdgcn_rcpf(1.0f + e);
}
__device__ __forceinline__ float sigmoidf_(float x) { return __builtin_amdgcn_rcpf(1.0f + __builtin_amdgcn_exp2f(-LOG2E * x)); }
__device__ __forceinline__ float wave_sum(float v) {
#pragma unroll
    for (int o = 1; o < 64; o <<= 1) v += __shfl_xor(v, o);
    return v;
}
__device__ __forceinline__ void unpack8(u32x4_t r, float (&f)[8]) {
    f[0] = __uint_as_float(r.x << 16); f[1] = __uint_as_float(r.x & 0xffff0000u);
    f[2] = __uint_as_float(r.y << 16); f[3] = __uint_as_float(r.y & 0xffff0000u);
    f[4] = __uint_as_float(r.z << 16); f[5] = __uint_as_float(r.z & 0xffff0000u);
    f[6] = __uint_as_float(r.w << 16); f[7] = __uint_as_float(r.w & 0xffff0000u);
}

__device__ __forceinline__ int fresh_lane() { unsigned z_ = 0u; asm volatile("" : "+v"(z_)); return (int)__builtin_amdgcn_mbcnt_hi(~0u, __builtin_amdgcn_mbcnt_lo(~0u, z_)); }
__device__ __forceinline__ int fresh_tid(int wave_s) { return wave_s * 64 + fresh_lane(); }
namespace pg8 {
#define PG8_LAS __attribute__((address_space(3)))
typedef unsigned short bf16_t;
typedef short bf16x8 __attribute__((ext_vector_type(8)));
typedef float f32x4 __attribute__((ext_vector_type(4)));
typedef unsigned u32x4 __attribute__((ext_vector_type(4)));
constexpr int BM = 256, BK = 64, HALF = 128, HTB = HALF * BK * 2  , STAGE_BYTES = 8 * HTB, NXCD = 8, WGM = 8;

__host__ __device__ __forceinline__ int lds_byte(int r, int c) { const int st = (r >> 4) * 2 + (c >> 5), rr = r & 15, cc = c & 31, ob = rr * 64 + cc * 2; return st * 1024 + (ob ^ (((ob >> 9) & 1) << 5)); }
__host__ __device__ __forceinline__ void stage_rc(int b, int& R, int& C) { const int st = b / 1024, sb = b % 1024, swz = sb ^ (((sb >> 9) & 1) << 5); R = (st >> 1) * 16 + swz / 64; C = (st & 1) * 32 + (swz % 64) / 2; }
__host__ __device__ __forceinline__ int perm32(int rho) { const int n = rho >> 4, i = rho & 15; return 8 * (i >> 2) + 4 * n + (i & 3); }

struct Unit { int pm, pn; };
struct Gemm { const bf16_t* A; const bf16_t* Bt; int M, N, K, lda; };

struct StaticOrder {
    int nM, nN, nwg, G, c;
    __host__ __device__ void init(int M, int N, int G_, int c_) { nM = M / BM; nN = N / BM; nwg = nM * nN; G = G_; c = c_; }
    __host__ __device__ bool next(int i, Unit& u) const {
        const long L = (long)i * G + c; if (L >= nwg) return false;
        int wgid = (int)L; { const int q = nwg / NXCD, r = nwg % NXCD, xcd = wgid % NXCD, off = wgid / NXCD; wgid = (xcd < r ? xcd * (q + 1) : r * (q + 1) + (xcd - r) * q) + off; }
        const int nig = WGM * nN, gid = wgid / nig, fm = gid * WGM, gsz = (nM - fm) < WGM ? (nM - fm) : WGM;
        u.pm = fm + ((wgid % nig) % gsz); u.pn = (wgid % nig) / gsz; return true;
    }
    __device__ __forceinline__ void a_ready(const Unit&) const {}
    __device__ __forceinline__ void done(const Unit&) const {}
};

__device__ __forceinline__ unsigned cvt_pk_bf16(float lo, float hi) { unsigned r; asm volatile("v_cvt_pk_bf16_f32 %0, %1, %2" : "=v"(r) : "v"(lo), "v"(hi)); return r; }

struct EpiProj {
    static constexpr bool PERM = true, AFTER_DRAIN = false, PERMA = false;
    bf16_t* Q; bf16_t* KV6; bf16_t* U; bf16_t* GV; float* GATES; float* VSTAT; const float* q_norm_w; const float* k_norm_w;
    __device__ __forceinline__ void operator()(const f32x4 (&acc)[2][2][4][2], const Unit& u, int wr, int wc, int fr, int fq) const {
        const int pn = u.pn, row0 = u.pm * BM + wr * 64 + fr;
        if (pn < 10) {
            const bool normed = (pn < 4) || pn == 6 || pn == 8;
            const float* w = pn < 4 ? q_norm_w : (k_norm_w + (pn == 6 ? 64 : 128));
            const float sc = pn < 4 ? 0.125f * LOG2E : 1.0f;
            f32x4 wv[2][2];
#pragma unroll
            for (int bj = 0; bj < 2; ++bj)
#pragma unroll
                for (int n = 0; n < 2; ++n) wv[bj][n] = normed ? (*(const f32x4*)(w + 32 * bj + 8 * fq + 4 * n)) * sc : (f32x4){1.f, 1.f, 1.f, 1.f};
#pragma unroll
            for (int ai = 0; ai < 2; ++ai)
#pragma unroll
                for (int m = 0; m < 4; ++m) {
                    const int row = row0 + ai * HALF + m * 16;
                    float r = 1.f;
                    if (normed) {
                        float ss = 0.f;
#pragma unroll
                        for (int bj = 0; bj < 2; ++bj)
#pragma unroll
                            for (int n = 0; n < 2; ++n) { const f32x4 x = acc[ai][bj][m][n]; ss += (x[0] * x[0] + x[1] * x[1]) + (x[2] * x[2] + x[3] * x[3]); }
                        ss += __shfl_xor(ss, 16); ss += __shfl_xor(ss, 32);
                        r = __builtin_amdgcn_rsqf(ss * (1.0f / 64.0f) + 1e-6f);
                    }
                    bf16_t* dst;
                    if (pn < 4) dst = Q + (size_t)row * 1024 + pn * 256 + wc * 64 + 8 * fq;
                    else { const int b = row >> 12, t = row & 4095; dst = KV6 + (size_t)(pn - 4) * KVSZ + ((size_t)((b * 4 + wc) * 4096 + t)) * 64 + 8 * fq; }
#pragma unroll
                    for (int bj = 0; bj < 2; ++bj) {
                        const f32x4 v0 = acc[ai][bj][m][0] * r * wv[bj][0], v1 = acc[ai][bj][m][1] * r * wv[bj][1];
                        u32x4 o; o.x = cvt_pk_bf16(v0[0], v0[1]); o.y = cvt_pk_bf16(v0[2], v0[3]); o.z = cvt_pk_bf16(v1[0], v1[1]); o.w = cvt_pk_bf16(v1[2], v1[3]);
                        *(u32x4*)(dst + 32 * bj) = o;
                    }
                }
        } else if (pn < 18) {
            const bool isv = pn >= 14; const int ct = isv ? pn - 14 : pn - 10;
            bf16_t* base = (isv ? GV : U) + ct * 256 + wc * 64 + 8 * fq;
#pragma unroll
            for (int ai = 0; ai < 2; ++ai)
#pragma unroll
                for (int m = 0; m < 4; ++m) {
                    const int row = row0 + ai * HALF + m * 16; float s1 = 0.f, s2 = 0.f;
#pragma unroll
                    for (int bj = 0; bj < 2; ++bj) {
                        f32x4 v0 = acc[ai][bj][m][0], v1 = acc[ai][bj][m][1];
#pragma unroll
                        for (int e = 0; e < 4; ++e) { v0[e] = gelu_tanh(v0[e]); v1[e] = gelu_tanh(v1[e]); s1 += v0[e] + v1[e]; s2 += v0[e] * v0[e] + v1[e] * v1[e]; }
                        u32x4 o; o.x = cvt_pk_bf16(v0[0], v0[1]); o.y = cvt_pk_bf16(v0[2], v0[3]); o.z = cvt_pk_bf16(v1[0], v1[1]); o.w = cvt_pk_bf16(v1[2], v1[3]);
                        *(u32x4*)(base + (size_t)row * 1024 + 32 * bj) = o;
                    }
                    if (isv) {
                        s1 += __shfl_xor(s1, 16); s1 += __shfl_xor(s1, 32); s2 += __shfl_xor(s2, 16); s2 += __shfl_xor(s2, 32);
                        if (fq == 0) { float* p = VSTAT + ((size_t)row * 16 + ct * 4 + wc) * 2; p[0] = s1; p[1] = s2; }
                    }
                }
        } else {
            if (wc == 0) {
#pragma unroll
                for (int ai = 0; ai < 2; ++ai)
#pragma unroll
                    for (int m = 0; m < 4; ++m) {
                        const int row = row0 + ai * HALF + m * 16;
#pragma unroll
                        for (int bj = 0; bj < 2; ++bj)
#pragma unroll
                            for (int n = 0; n < 2; ++n) {
                                const int L = 32 * bj + 8 * fq + 4 * n;
                                if (L < 48) { f32x4 v = acc[ai][bj][m][n]; f32x4 o; o[0] = sigmoidf_(v[0]); o[1] = sigmoidf_(v[1]); o[2] = sigmoidf_(v[2]); o[3] = sigmoidf_(v[3]); *(f32x4*)(GATES + (size_t)row * 48 + L) = o; }
                            }
                    }
            }
        }
    }
};
struct EpiCmp {
    static constexpr bool PERM = true, AFTER_DRAIN = false, PERMA = false;
    bf16_t* HC; const float* bias1;
    __device__ __forceinline__ void operator()(const f32x4 (&acc)[2][2][4][2], const Unit& u, int wr, int wc, int fr, int fq) const {
        const int row0 = u.pm * BM + wr * 64 + fr, col0 = wc * 32 + 8 * fq;
        f32x4 bv[2][2];
#pragma unroll
        for (int bj = 0; bj < 2; ++bj)
#pragma unroll
            for (int n = 0; n < 2; ++n) bv[bj][n] = *(const f32x4*)(bias1 + u.pn * 256 + col0 + bj * HALF + 4 * n);
#pragma unroll
        for (int ai = 0; ai < 2; ++ai)
#pragma unroll
            for (int m = 0; m < 4; ++m) { bf16_t* rowp = HC + (size_t)(row0 + ai * HALF + m * 16) * 256 + col0;
#pragma unroll
                for (int bj = 0; bj < 2; ++bj) { f32x4 v0 = acc[ai][bj][m][0] + bv[bj][0], v1 = acc[ai][bj][m][1] + bv[bj][1];
#pragma unroll
                    for (int e = 0; e < 4; ++e) { v0[e] = gelu_tanh(v0[e]); v1[e] = gelu_tanh(v1[e]); }
                    u32x4 o; o.x = cvt_pk_bf16(v0[0], v0[1]); o.y = cvt_pk_bf16(v0[2], v0[3]); o.z = cvt_pk_bf16(v1[0], v1[1]); o.w = cvt_pk_bf16(v1[2], v1[3]);
                    *(u32x4*)(rowp + bj * HALF) = o; } }
    }
};
struct CmpOrder {
    int c, G;
    __device__ bool next(int i, Unit& u) const { const int L = i * G + c; if (L >= 32) return false; u.pm = L; u.pn = L >> 4; return true; }
    __device__ __forceinline__ void a_ready(const Unit&) const {}
    __device__ __forceinline__ void done(const Unit&) const {}
};
struct EpiRes1 {
    static constexpr bool PERM = false, AFTER_DRAIN = false, PERMA = false;
    const float* RINV; const float* INVW; bf16_t* X1b; float* SSQ;
    __device__ __forceinline__ void operator()(const f32x4 (&acc)[2][2][4][2], const Unit& u, int wr, int wc, int fr, int fq) const {
        const int row0 = u.pm * BM + wr * 64 + fr, col0 = u.pn * BM + wc * 32 + 4 * fq;
        f32x4 iw[2][2];
#pragma unroll
        for (int bj = 0; bj < 2; ++bj)
#pragma unroll
            for (int n = 0; n < 2; ++n) iw[bj][n] = *(const f32x4*)(INVW + col0 + bj * HALF + n * 16);
#pragma unroll
        for (int ai = 0; ai < 2; ++ai) {
            u32x2_t xin[4][2][2]; float ri[4];
#pragma unroll
            for (int m = 0; m < 4; ++m) { ri[m] = RINV[row0 + ai * HALF + m * 16];
#pragma unroll
                for (int bj = 0; bj < 2; ++bj)
#pragma unroll
                    for (int n = 0; n < 2; ++n) xin[m][bj][n] = *(const u32x2_t*)(X1b + (size_t)(row0 + ai * HALF + m * 16) * D_MODEL + col0 + bj * HALF + n * 16); }
            __builtin_amdgcn_sched_barrier(0);
#pragma unroll
            for (int m = 0; m < 4; ++m) { const int row = row0 + ai * HALF + m * 16; const size_t off = (size_t)row * D_MODEL + col0; float ss = 0.f;
#pragma unroll
                for (int bj = 0; bj < 2; ++bj)
#pragma unroll
                    for (int n = 0; n < 2; ++n) { const u32x2_t w_ = xin[m][bj][n];
                        f32x4 xv; xv[0] = __uint_as_float(w_.x << 16); xv[1] = __uint_as_float(w_.x & 0xffff0000u); xv[2] = __uint_as_float(w_.y << 16); xv[3] = __uint_as_float(w_.y & 0xffff0000u);
                        const f32x4 v = xv * ri[m] * iw[bj][n] + acc[ai][bj][m][n];
                        ss += (v[0] * v[0] + v[1] * v[1]) + (v[2] * v[2] + v[3] * v[3]);
                        u32x2_t w; w.x = cvt_pk_bf16(v[0], v[1]); w.y = cvt_pk_bf16(v[2], v[3]); *(u32x2_t*)(X1b + off + bj * HALF + n * 16) = w; }
                ss += __shfl_xor(ss, 16); ss += __shfl_xor(ss, 32);
                if (fq == 0) SSQ[(size_t)row * 32 + u.pn * 4 + wc] = ss; }
            __builtin_amdgcn_sched_barrier(0);
        }
    }
};
struct EpiUpV1 {
    static constexpr bool PERM = true, AFTER_DRAIN = false, PERMA = false;
    bf16_t* HID; const float* R2;
    __device__ __forceinline__ void operator()(const f32x4 (&acc)[2][2][4][2], const Unit& u, int wr, int wc, int fr, int fq) const {
        const int row0 = u.pm * BM + wr * 64 + fr, col0 = u.pn * BM + wc * 32 + 8 * fq;
#pragma unroll
        for (int ai = 0; ai < 2; ++ai)
#pragma unroll
            for (int m = 0; m < 4; ++m) { const int row = row0 + ai * HALF + m * 16; const float r = R2[row]; bf16_t* rowp = HID + (size_t)row * N_UP + col0;
#pragma unroll
                for (int bj = 0; bj < 2; ++bj) { const f32x4 v0 = acc[ai][bj][m][0] * r, v1 = acc[ai][bj][m][1] * r;
                    u32x4 o; o.x = cvt_pk_bf16(v0[0], v0[1]); o.y = cvt_pk_bf16(v0[2], v0[3]); o.z = cvt_pk_bf16(v1[0], v1[1]); o.w = cvt_pk_bf16(v1[2], v1[3]);
                    *(u32x4*)(rowp + bj * HALF) = o; } }
    }
};
struct EpiDown {
    static constexpr bool PERM = false, AFTER_DRAIN = false, PERMA = false;
    float* out; const bf16_t* X1b;
    __device__ __forceinline__ void operator()(const f32x4 (&acc)[2][2][4][2], const Unit& u, int wr, int wc, int fr, int fq) const {
        const int row0 = u.pm * BM + wr * 64 + fr, col0 = u.pn * BM + wc * 32 + 4 * fq;
#pragma unroll
        for (int ai = 0; ai < 2; ++ai) {
            u32x2_t xin[4][2][2];
#pragma unroll
            for (int m = 0; m < 4; ++m)
#pragma unroll
                for (int bj = 0; bj < 2; ++bj)
#pragma unroll
                    for (int n = 0; n < 2; ++n) xin[m][bj][n] = *(const u32x2_t*)(X1b + (size_t)(row0 + ai * HALF + m * 16) * D_MODEL + col0 + bj * HALF + n * 16);
            __builtin_amdgcn_sched_barrier(0);
#pragma unroll
            for (int m = 0; m < 4; ++m) { const size_t off = (size_t)(row0 + ai * HALF + m * 16) * D_MODEL + col0;
#pragma unroll
                for (int bj = 0; bj < 2; ++bj)
#pragma unroll
                    for (int n = 0; n < 2; ++n) { const u32x2_t w = xin[m][bj][n];
                        f32x4 v; v[0] = __uint_as_float(w.x << 16); v[1] = __uint_as_float(w.x & 0xffff0000u); v[2] = __uint_as_float(w.y << 16); v[3] = __uint_as_float(w.y & 0xffff0000u);
                        *(f32x4*)(out + off + bj * HALF + n * 16) = v + acc[ai][bj][m][n]; } }
            __builtin_amdgcn_sched_barrier(0);
        }
    }
};
__device__ __forceinline__ unsigned f2bf_(float f) { unsigned u = __float_as_uint(f); return (u + 0x7fffu + ((u >> 16) & 1u)) >> 16; }
typedef float f32x2 __attribute__((ext_vector_type(2)));
struct EpiUpConv {
    static constexpr bool PERM = true, AFTER_DRAIN = false, PERMA = true;
    bf16_t* G; const float* R2; const float* cw; const float* cb; float* HLAST; float* FIRST; PG8_LAS unsigned char* xlds;
    __device__ __forceinline__ void operator()(const f32x4 (&acc)[2][2][4][2], const Unit& u, int wr, int wc, int fr_in, int fq_in) const {
        (void)fr_in; (void)fq_in;
        unsigned z_ = 0u; asm volatile("" : "+v"(z_));
        const int lane_ = (int)__builtin_amdgcn_mbcnt_hi(~0u, __builtin_amdgcn_mbcnt_lo(~0u, z_)); const int fr = lane_ & 15, fq = lane_ >> 4;
        const int row0 = u.pm * BM + wr * 64 + 4 * fr;
        PG8_LAS float* X = (PG8_LAS float*)xlds;
        const unsigned tile = (unsigned)(u.pm * (N_UP / 256) + u.pn);
        if (fr == 15) {
#pragma unroll
            for (int ai = 0; ai < 2; ++ai) { const int sg = 2 * ai + wr; const float r2a = R2[row0 + ai * HALF + 2], r2b = R2[row0 + ai * HALF + 3];
#pragma unroll
                for (int mm = 0; mm < 2; ++mm)
#pragma unroll
                for (int bj = 0; bj < 2; ++bj)
#pragma unroll
                    for (int n = 0; n < 2; ++n) { const f32x4 h = acc[ai][bj][2 + mm][n] * (mm ? r2b : r2a);
                        *(PG8_LAS f32x4*)(X + ((sg * 4 + wc) * 2 + mm) * 64 + bj * 32 + 8 * fq + 4 * n) = h;
                        if (ai == 1 && wr == 1) *(f32x4*)(HLAST + (unsigned)((tile * 2 + mm) * 256 + bj * HALF + wc * 32 + 8 * fq + 4 * n)) = h; } }
        }
        PG8_LAS float* R2L = X + 3072;
        PG8_LAS float* Wl = X + 2048;
        { const int t_ = (wr * 4 + wc) * 64 + fq * 16 + fr;
#pragma unroll
          for (int i2 = 0; i2 < 2; ++i2) { const int i = t_ + 512 * i2, k = i >> 8, p = i & 255, c = (p < 128 ? 0 : D_FF - 128) + u.pn * 128 + p;
              Wl[i] = k < 3 ? cw[(unsigned)(k * N_UP + c)] : cb[(unsigned)c]; }
          if (t_ < 256) R2L[t_] = R2[u.pm * BM + t_]; }
        asm volatile("s_waitcnt vmcnt(0) lgkmcnt(0)" ::: "memory"); __builtin_amdgcn_s_barrier(); asm volatile("" ::: "memory");
        const int cbase = u.pn * 128 + wc * 32 + 8 * fq;
        const bool seq_start = (u.pm & 15) == 0;
#pragma unroll
        for (int ai = 0; ai < 2; ++ai) {
            const int sg = 2 * ai + wr;
            const f32x4 rs = *(PG8_LAS const f32x4*)(R2L + ai * HALF + wr * 64 + 4 * fr);
            const bool defer = (ai == 0) && (wr == 0) && !seq_start && (fr == 0);
#pragma unroll
            for (int n = 0; n < 2; ++n) {
                unsigned pk[4][2];
#pragma unroll
                for (int e2 = 0; e2 < 2; ++e2) {
                    asm volatile("" ::: "memory"); __builtin_amdgcn_sched_barrier(0);
                    PG8_LAS const f32x2* wp = (PG8_LAS const f32x2*)(Wl + wc * 32 + 8 * fq + 4 * n + 2 * e2);
                    const f32x2 wg0 = wp[0], wg1 = wp[128], wg2 = wp[256], bg = wp[384], wu0 = wp[64], wu1 = wp[192], wu2 = wp[320], bu = wp[448];
                    f32x2 hg1 = {0.f, 0.f}, hg2 = {0.f, 0.f}, hu1 = {0.f, 0.f}, hu2 = {0.f, 0.f};
                    if (ai == 1 || wr == 1) { PG8_LAS const f32x2* xp = (PG8_LAS const f32x2*)(X + (((sg - 1) * 4 + wc) * 2) * 64 + 8 * fq + 4 * n + 2 * e2); hg2 = xp[0]; hg1 = xp[32]; hu2 = xp[16]; hu1 = xp[48]; }
                    f32x2 vg[4], vu[4], cg[4], cu[4];
#pragma unroll
                    for (int m = 0; m < 4; ++m) { const f32x2 r2 = {rs[m], rs[m]};
                        vg[m] = (f32x2){acc[ai][0][m][n][2 * e2], acc[ai][0][m][n][2 * e2 + 1]} * r2; vu[m] = (f32x2){acc[ai][1][m][n][2 * e2], acc[ai][1][m][n][2 * e2 + 1]} * r2; }
#define EPI_SHR1(old_, v_) (f32x2){__uint_as_float(__builtin_amdgcn_update_dpp(__float_as_uint((old_).x), __float_as_uint((v_).x), 0x111, 0xf, 0xf, false)), __uint_as_float(__builtin_amdgcn_update_dpp(__float_as_uint((old_).y), __float_as_uint((v_).y), 0x111, 0xf, 0xf, false))}
                    const f32x2 pg1 = EPI_SHR1(hg1, vg[3]), pg2 = EPI_SHR1(hg2, vg[2]), pu1 = EPI_SHR1(hu1, vu[3]), pu2 = EPI_SHR1(hu2, vu[2]);
#undef EPI_SHR1
                    cg[0] = bg + wg0 * pg2 + wg1 * pg1 + wg2 * vg[0]; cu[0] = bu + wu0 * pu2 + wu1 * pu1 + wu2 * vu[0];
                    cg[1] = bg + wg0 * pg1 + wg1 * vg[0] + wg2 * vg[1]; cu[1] = bu + wu0 * pu1 + wu1 * vu[0] + wu2 * vu[1];
                    cg[2] = bg + wg0 * vg[0] + wg1 * vg[1] + wg2 * vg[2]; cu[2] = bu + wu0 * vu[0] + wu1 * vu[1] + wu2 * vu[2];
                    cg[3] = bg + wg0 * vg[1] + wg1 * vg[2] + wg2 * vg[3]; cu[3] = bu + wu0 * vu[1] + wu1 * vu[2] + wu2 * vu[3];
                    if (defer) {
#pragma unroll
                        for (int m = 0; m < 2; ++m) { float* fp = FIRST + (unsigned)((tile * 2 + m) * 256 + wc * 32 + 8 * fq + 4 * n + 2 * e2); *(f32x2*)fp = cg[m]; *(f32x2*)(fp + HALF) = cu[m]; }
                    }
#pragma unroll
                    for (int m = 0; m < 4; ++m) {
                        const f32x2 t = cg[m] * (f32x2){-LOG2E, -LOG2E};
                        f32x2 sg_ = {__builtin_amdgcn_exp2f(t.x), __builtin_amdgcn_exp2f(t.y)};
                        sg_ = sg_ + (f32x2){1.0f, 1.0f};
                        const f32x2 rc = {__builtin_amdgcn_rcpf(sg_.x), __builtin_amdgcn_rcpf(sg_.y)};
                        const f32x2 gv = cg[m] * rc * cu[m];
                        pk[m][e2] = cvt_pk_bf16(gv.x, gv.y);
                    }
                }
#pragma unroll
                for (int m = 0; m < 4; ++m)
                    if (!(m < 2 && defer)) { u32x2_t o; o.x = pk[m][0]; o.y = pk[m][1]; *(u32x2_t*)(G + (unsigned)((row0 + ai * HALF + m) * D_FF + cbase + 4 * n)) = o; }
            }
        }
    }
};
template <class Epi, class Sched, bool ALIGN_EPI = false, bool SP2 = false>
__device__ __forceinline__ void gemm_phase(PG8_LAS unsigned char* lds, const Gemm g, const Sched& S, const Epi& E, const int wave_s) {
    const int tid = fresh_tid(wave_s), wid = wave_s, lane = tid & 63,
          wr = wid >> 2, wc = wid & 3, fr = lane & 15, fq = lane >> 4;
    const int K = g.K, nt = K / BK;
    unsigned voffA[2], voffB[2];
#pragma unroll
    for (int i = 0; i < 2; ++i) { int R, C; stage_rc(tid * 16 + i * 8192, R, C); const int Rb = Epi::PERM ? ((R & ~31) + perm32(R & 31)) : R;
        const int Ra = Epi::PERMA ? ((R & ~63) + 4 * (R & 15) + ((R >> 4) & 3)) : R;
        voffA[i] = (unsigned)(Ra * g.lda + C) * 2u; voffB[i] = (unsigned)(Rb * K + C) * 2u; }
    const size_t kstep = (size_t)(BK * 2);
    const size_t hstepA = (size_t)HALF * g.lda * 2, hstepB = (size_t)HALF * K * 2;
    const size_t tstepA = 2 * hstepA, tstepB = 2 * hstepB;
    const unsigned ldsw = (unsigned)wid * 1024u;
    const int aoff = lds_byte(wr * 64 + fr, fq * 8), boff = lds_byte(wc * 32 + fr, fq * 8);
#define PG8_SA(b, h) (((b) * 2 + (h)) * HTB)
#define PG8_SB(b, h) ((4 + (b) * 2 + (h)) * HTB)
#define PG8_STAGE(bufoff, gbase, voff) do { _Pragma("unroll") for (int _i = 0; _i < 2; ++_i) \
        __builtin_amdgcn_global_load_lds((const unsigned*)((const char*)(gbase) + (voff)[_i]), (PG8_LAS unsigned*)(lds + (bufoff) + ldsw + _i * 8192), 16, 0, 0); } while (0)
#define PG8_LDA(dst, b, h) do { _Pragma("unroll") for (int m = 0; m < 4; ++m) _Pragma("unroll") for (int k = 0; k < 2; ++k) dst[m][k] = *(const PG8_LAS bf16x8*)(lds + PG8_SA(b, h) + aoff + m * 2048 + k * 1024); } while (0)
#define PG8_LDB(dst, b, h) do { _Pragma("unroll") for (int n = 0; n < 2; ++n) _Pragma("unroll") for (int k = 0; k < 2; ++k) dst[n][k] = *(const PG8_LAS bf16x8*)(lds + PG8_SB(b, h) + boff + n * 2048 + k * 1024); } while (0)
#define PG8_MMA(ai, bj, At, Bt) do { __builtin_amdgcn_s_setprio(1); _Pragma("unroll") for (int m = 0; m < 4; ++m) _Pragma("unroll") for (int n = 0; n < 2; ++n) _Pragma("unroll") for (int k = 0; k < 2; ++k) \
        acc[ai][bj][m][n] = __builtin_amdgcn_mfma_f32_16x16x32_bf16(Bt[n][k], At[m][k], acc[ai][bj][m][n], 0, 0, 0); __builtin_amdgcn_s_setprio(0); } while (0)
#define PG8_WAIT_V(n) asm volatile("s_waitcnt vmcnt(" #n ")" ::: "memory")
#define PG8_WAIT_L(n) asm volatile("s_waitcnt lgkmcnt(" #n ")" ::: "memory")
#define PG8_BAR __builtin_amdgcn_s_barrier()
#define PG8_SCHED __builtin_amdgcn_sched_barrier(0)
    Unit cur, nxt; int ui = 0;
    if (!S.next(0, cur)) return;
    f32x4 acc[2][2][4][2];
#pragma unroll
    for (int a = 0; a < 2; ++a)
#pragma unroll
        for (int b = 0; b < 2; ++b)
#pragma unroll
            for (int m = 0; m < 4; ++m)
#pragma unroll
                for (int n = 0; n < 2; ++n) acc[a][b][m][n] = (f32x4){0.f, 0.f, 0.f, 0.f};
    bf16x8 At[4][2], B0[2][2], B1[2][2];
    const char* cA = (const char*)g.A + (size_t)cur.pm * tstepA; const char* cB = (const char*)g.Bt + (size_t)cur.pn * tstepB;
    S.a_ready(cur);
    if constexpr (SP2) {
        PG8_STAGE(PG8_SB(0, 0), cB, voffB); PG8_STAGE(PG8_SB(0, 1), cB + hstepB, voffB); PG8_STAGE(PG8_SA(0, 0), cA, voffA); PG8_STAGE(PG8_SA(0, 1), cA + hstepA, voffA);
        if (wr == 1) PG8_BAR;
        PG8_WAIT_V(2); PG8_BAR;
        PG8_STAGE(PG8_SB(1, 0), cB + kstep, voffB); PG8_STAGE(PG8_SA(1, 0), cA + kstep, voffA); PG8_STAGE(PG8_SB(1, 1), cB + hstepB + kstep, voffB);
        PG8_WAIT_V(6); PG8_BAR;
    } else {
        PG8_STAGE(PG8_SB(0, 0), cB, voffB); PG8_STAGE(PG8_SA(0, 0), cA, voffA); PG8_STAGE(PG8_SB(0, 1), cB + hstepB, voffB); PG8_STAGE(PG8_SA(0, 1), cA + hstepA, voffA);
        if (wr == 1) PG8_BAR;
        PG8_WAIT_V(4); PG8_BAR;
        PG8_STAGE(PG8_SB(1, 0), cB + kstep, voffB); PG8_STAGE(PG8_SA(1, 0), cA + kstep, voffA); PG8_STAGE(PG8_SB(1, 1), cB + hstepB + kstep, voffB);
        PG8_WAIT_V(6); PG8_BAR;
    }
    for (;;) {
        const bool has_next = S.next(ui + 1, nxt);
        const char* nA = has_next ? (const char*)g.A + (size_t)nxt.pm * tstepA : cA; const char* nB = has_next ? (const char*)g.Bt + (size_t)nxt.pn * tstepB : cB;
        for (int t = 0; t < nt; t += 2) {
            const bool last = (t == nt - 2);
            const char* a1 = cA + (size_t)(t + 1) * kstep;
            const char* a2 = last ? nA : cA + (size_t)(t + 2) * kstep; const char* b2 = last ? nB : cB + (size_t)(t + 2) * kstep;
            const char* a3 = a2 + kstep; const char* b3 = b2 + kstep;
            if (last && has_next) S.a_ready(nxt);
            if constexpr (SP2) {
            PG8_LDB(B0, 0, 0); PG8_LDB(B1, 0, 1); PG8_SCHED; PG8_LDA(At, 0, 0); PG8_STAGE(PG8_SA(1, 1), a1 + hstepA, voffA);
            PG8_WAIT_V(8); PG8_WAIT_L(0); PG8_BAR; PG8_MMA(0, 0, At, B0); PG8_MMA(0, 1, At, B1); PG8_BAR; PG8_SCHED;
            PG8_LDA(At, 0, 1); PG8_STAGE(PG8_SB(0, 0), b2, voffB); PG8_STAGE(PG8_SB(0, 1), b2 + hstepB, voffB); PG8_STAGE(PG8_SA(0, 0), a2, voffA);
            PG8_WAIT_V(8); PG8_WAIT_L(0); PG8_BAR; PG8_MMA(1, 0, At, B0); PG8_MMA(1, 1, At, B1); PG8_BAR; PG8_SCHED;
            PG8_LDB(B0, 1, 0); PG8_LDB(B1, 1, 1); PG8_SCHED; PG8_LDA(At, 1, 0); PG8_STAGE(PG8_SA(0, 1), a2 + hstepA, voffA);
            PG8_WAIT_V(8); PG8_WAIT_L(0); PG8_BAR; PG8_MMA(0, 0, At, B0); PG8_MMA(0, 1, At, B1); PG8_BAR; PG8_SCHED;
            PG8_LDA(At, 1, 1); PG8_STAGE(PG8_SB(1, 0), b3, voffB); PG8_STAGE(PG8_SB(1, 1), b3 + hstepB, voffB); PG8_STAGE(PG8_SA(1, 0), a3, voffA);
            PG8_WAIT_V(8); PG8_WAIT_L(0); PG8_BAR; PG8_MMA(1, 0, At, B0); PG8_MMA(1, 1, At, B1); PG8_BAR; PG8_SCHED;
            } else {
            PG8_LDB(B0, 0, 0); PG8_SCHED; PG8_LDA(At, 0, 0); PG8_STAGE(PG8_SA(1, 1), a1 + hstepA, voffA);
            PG8_WAIT_L(8); PG8_BAR; PG8_WAIT_L(0); PG8_MMA(0, 0, At, B0); PG8_BAR; PG8_SCHED;
            PG8_LDB(B1, 0, 1); PG8_STAGE(PG8_SB(0, 0), b2, voffB);
            PG8_BAR; PG8_WAIT_L(0); PG8_MMA(0, 1, At, B1); PG8_BAR;
            PG8_LDA(At, 0, 1); PG8_STAGE(PG8_SA(0, 0), a2, voffA);
            PG8_BAR; PG8_WAIT_L(0); PG8_MMA(1, 0, At, B0); PG8_BAR; PG8_SCHED;
            PG8_STAGE(PG8_SB(0, 1), b2 + hstepB, voffB);
            PG8_WAIT_V(6); PG8_BAR; PG8_MMA(1, 1, At, B1); PG8_BAR;
            PG8_LDB(B0, 1, 0); PG8_SCHED; PG8_LDA(At, 1, 0); PG8_STAGE(PG8_SA(0, 1), a2 + hstepA, voffA);
            PG8_WAIT_L(8); PG8_BAR; PG8_WAIT_L(0); PG8_MMA(0, 0, At, B0); PG8_BAR; PG8_SCHED;
            PG8_LDB(B1, 1, 1); PG8_STAGE(PG8_SB(1, 0), b3, voffB);
            PG8_BAR; PG8_WAIT_L(0); PG8_MMA(0, 1, At, B1); PG8_BAR;
            PG8_LDA(At, 1, 1); PG8_STAGE(PG8_SA(1, 0), a3, voffA);
            PG8_BAR; PG8_WAIT_L(0); PG8_MMA(1, 0, At, B0); PG8_BAR; PG8_SCHED;
            PG8_STAGE(PG8_SB(1, 1), b3 + hstepB, voffB);
            PG8_WAIT_V(6); PG8_BAR; PG8_MMA(1, 1, At, B1); PG8_BAR;
            }
        }
        if constexpr (ALIGN_EPI) { if (wr == 0) PG8_BAR; }
        if constexpr (!Epi::AFTER_DRAIN) { E(acc, cur, wr, wc, fr, fq); S.done(cur); }
        if (!has_next) break;
#pragma unroll
        for (int a = 0; a < 2; ++a)
#pragma unroll
            for (int b = 0; b < 2; ++b)
#pragma unroll
                for (int m = 0; m < 4; ++m)
#pragma unroll
                    for (int n = 0; n < 2; ++n) acc[a][b][m][n] = (f32x4){0.f, 0.f, 0.f, 0.f};
        cur = nxt; cA = nA; cB = nB; ++ui;
        if constexpr (ALIGN_EPI) { if (wr == 1) PG8_BAR; }
    }
    PG8_WAIT_V(0);
    if constexpr (!ALIGN_EPI) { if (wr == 0) PG8_BAR; }
    PG8_BAR;
    if constexpr (Epi::AFTER_DRAIN) { E.fused(acc, cur, wr, wc, fr, fq, lds, wid, lane); S.done(cur); }
#undef PG8_SA
#undef PG8_SB
#undef PG8_STAGE
#undef PG8_LDA
#undef PG8_LDB
#undef PG8_MMA
#undef PG8_WAIT_V
#undef PG8_WAIT_L
#undef PG8_BAR
#undef PG8_SCHED
}
}
constexpr int NWAVES = 8;
template <class RowMap>
__device__ __forceinline__ void transpose_item(const float* __restrict__ W, int K, int N, bf16_t* WT, const float* __restrict__ kscale, RowMap rm, LAS float* scr, int item, int lane) {
    const int nblk = (N + 31) / 32, kb = item / nblk, nb = item % nblk, k0 = 64 * kb, n0 = 32 * nb;
    const int nr = n0 + (lane & 31);
    float v[32];
#pragma unroll
    for (int i = 0; i < 32; ++i) { const int kk = 2 * i + (lane >> 5); v[i] = (nr < N) ? W[(size_t)(k0 + kk) * N + nr] : 0.f; }
    if (kscale) {
#pragma unroll
        for (int i = 0; i < 32; ++i) v[i] *= kscale[k0 + 2 * i + (lane >> 5)];
    }
#pragma unroll
    for (int i = 0; i < 32; ++i) scr[(2 * i + (lane >> 5)) * 33 + (lane & 31)] = v[i];
    asm volatile("s_waitcnt lgkmcnt(0)" ::: "memory");
    const int c = lane & 7;
#pragma unroll
    for (int j = 0; j < 4; ++j) { const int nl = (lane >> 3) + 8 * j, n = n0 + nl;
        if (n < N) { const LAS float* s = scr + (8 * c) * 33 + nl;
            u32x4_t o; o.x = pk2(s[0 * 33], s[1 * 33]); o.y = pk2(s[2 * 33], s[3 * 33]); o.z = pk2(s[4 * 33], s[5 * 33]); o.w = pk2(s[6 * 33], s[7 * 33]);
            *(u32x4_t*)(WT + (size_t)rm(n) * K + k0 + 8 * c) = o; } }
    asm volatile("s_waitcnt lgkmcnt(0)" ::: "memory");
}
struct RmIdent { __device__ __forceinline__ int operator()(int n) const { return n; } };
struct RmWin {
    __device__ __forceinline__ int operator()(int c) const {
        const int nc = c < 2560 ? c : (c < 2608 ? 4608 + (c - 2560) : 2560 + (c - 2608));
        const int tile = nc >> 8, L = nc & 255, wc = L >> 6, bj = (L >> 5) & 1, j = L & 31;
        return tile * 256 + 128 * bj + 32 * wc + j;
    }
};
struct RmWup {
    __device__ __forceinline__ int operator()(int c) const { const int up = c >= D_FF, cc = up ? c - D_FF : c; return (cc >> 7) * 256 + up * 128 + (cc & 127); }
};

struct Ptrs {
    const float* in[18]; float* out; unsigned char* ws;
};

__device__ __forceinline__ void p0_prologue(const Ptrs& P, LAS unsigned char* lds, int vcu, int G, const int wave) {
    const int lane = fresh_lane();
    LAS float* scr = (LAS float*)(lds + wave * 16384);
    const int gw = vcu * NWAVES + wave, NGW = G * NWAVES;
    unsigned char* ws = P.ws;
    bf16_t* WinT = (bf16_t*)(ws + WS_WIN); bf16_t* WoutT = (bf16_t*)(ws + WS_WOUT); bf16_t* WupT = (bf16_t*)(ws + WS_WUP); bf16_t* WdownT = (bf16_t*)(ws + WS_WDOWN); bf16_t* W1cT = (bf16_t*)(ws + WS_W1C);
    const float* x = P.in[0]; const float* attn_norm_w = P.in[1]; const float* w_in = P.in[2]; const float* cmp_pos = P.in[5]; const float* cmp_w1 = P.in[6];
    const float* w_out = P.in[12]; const float* ffn_norm_w = P.in[13]; const float* w_up = P.in[14]; const float* w_down = P.in[17];
    constexpr int I_IN = 32 * 146, I_W1 = 32 * 8, I_W2 = 4 * 2;
    constexpr int NITEMS = I_IN + 2 * I_W1 + 2 * I_W2;
    (void)w_out; (void)w_up; (void)w_down; (void)ffn_norm_w; (void)WoutT; (void)WupT; (void)WdownT;
    for (int it = gw; it < NITEMS; it += NGW) {
        int r = it;
        if (r < I_IN) { transpose_item(w_in, 2048, IN_COLS, WinT, nullptr, RmWin(), scr, r, lane); continue; } r -= I_IN;
        if (r < I_W1) { transpose_item(cmp_w1, 2048, 256, W1cT, nullptr, RmIdent(), scr, r, lane); continue; } r -= I_W1;
        if (r < I_W1) { transpose_item(cmp_w1 + (size_t)2048 * 256, 2048, 256, W1cT + (size_t)256 * 2048, nullptr, RmIdent(), scr, r, lane); continue; } r -= I_W1;
        { const int kv = r >= I_W2 ? 1 : 0; transpose_item(P.in[7] + (size_t)kv * 256 * 64, 256, 64, (bf16_t*)(ws + WS_SMALL + SM_W2T) + (size_t)kv * 64 * 256, nullptr, RmIdent(), scr, r - kv * I_W2, lane); }
    }
    for (int i = gw * 64 + lane; i < 8 * 16384; i += NGW * 64) { const int t = (i >> 7) & 127, sx = i & 127; ((bf16_t*)(ws + WS_SMALL + SM_SWB))[i] = (bf16_t)(sx <= t ? f2bf(P.in[10][i]) : 0u); }
    for (int p = gw; p < 256; p += NGW) {
        const int L = 64 * ((p >> 5) & 3) + 32 * (p >> 7) + (p & 31);
        if (L >= 48) { u32x4_t z = {0u, 0u, 0u, 0u}; u32x4_t* d = (u32x4_t*)(WinT + (size_t)(18 * 256 + p) * 2048);
#pragma unroll
            for (int j = 0; j < 4; ++j) d[lane + 64 * j] = z; }
    }
    bf16_t* XN = (bf16_t*)(ws + WS_XN);
    for (int m = gw; m < MTOK; m += 2 * NGW) {
        const int m2 = m + NGW;
        const f32x4_t* xr = (const f32x4_t*)(x + (size_t)m * D_MODEL) + lane;
        const f32x4_t* xr2 = (const f32x4_t*)(x + (size_t)(m2 < MTOK ? m2 : m) * D_MODEL) + lane;
        f32x4_t v[8], v2[8]; float s = 0.f, s2 = 0.f;
#pragma unroll
        for (int j = 0; j < 8; ++j) { v[j] = xr[64 * j]; v2[j] = xr2[64 * j]; }
#pragma unroll
        for (int j = 0; j < 8; ++j) { s += (v[j][0] * v[j][0] + v[j][1] * v[j][1]) + (v[j][2] * v[j][2] + v[j][3] * v[j][3]); s2 += (v2[j][0] * v2[j][0] + v2[j][1] * v2[j][1]) + (v2[j][2] * v2[j][2] + v2[j][3] * v2[j][3]); }
        const float ms1 = wave_sum(s) * (1.0f / D_MODEL) + 1e-6f, ms2 = wave_sum(s2) * (1.0f / D_MODEL) + 1e-6f;
        const float r = __builtin_amdgcn_rsqf(ms1), r2 = __builtin_amdgcn_rsqf(ms2);
        if (lane == 0) { float* rinv = (float*)(ws + WS_SMALL + SM_RINV); rinv[m] = ms1 * r; if (m2 < MTOK) rinv[m2] = ms2 * r2; }
        u32x2_t* o8 = (u32x2_t*)(XN + (size_t)m * D_MODEL) + lane; u32x2_t* o82 = (u32x2_t*)(XN + (size_t)m2 * D_MODEL) + lane;
#pragma unroll
        for (int j = 0; j < 8; ++j) { const f32x4_t w = ((const f32x4_t*)attn_norm_w)[lane + 64 * j];
            u32x2_t o; o.x = pk2(v[j][0] * r * w[0], v[j][1] * r * w[1]); o.y = pk2(v[j][2] * r * w[2], v[j][3] * r * w[3]); o8[64 * j] = o;
            if (m2 < MTOK) { u32x2_t q; q.x = pk2(v2[j][0] * r2 * w[0], v2[j][1] * r2 * w[1]); q.y = pk2(v2[j][2] * r2 * w[2], v2[j][3] * r2 * w[3]); o82[64 * j] = q; } }
    }
    for (int i = gw * 64 + lane; i < D_MODEL; i += NGW * 64) ((float*)(ws + WS_SMALL + SM_INVW))[i] = 1.0f / attn_norm_w[i];
    float* BIASP = (float*)(ws + WS_SMALL + SM_BIASP);
    for (int it = gw; it < 64; it += NGW) {
        const int kv = it >> 5, kc = it & 31; f32x4_t a = {0.f, 0.f, 0.f, 0.f};
        const float* pp = cmp_pos + kv * 2048 + kc * 64; const float* w1 = cmp_w1 + ((size_t)kv * 2048 + kc * 64) * 256;
        for (int k = 0; k < 64; ++k) { const f32x4_t w = ((const f32x4_t*)(w1 + (size_t)k * 256))[lane]; a += w * pp[k]; }
        ((f32x4_t*)(BIASP + (size_t)it * 256))[lane] = a;
    }
}

__device__ __forceinline__ void bias1_stage(unsigned char* ws, int idx  ) {
    const float* BIASP = (const float*)(ws + WS_SMALL + SM_BIASP); float* BIAS1 = (float*)(ws + WS_SMALL + SM_BIAS1);
    const int kv = idx >> 8, j = idx & 255; float s = 0.f;
    for (int kc = 0; kc < 32; ++kc) s += BIASP[(size_t)(kv * 32 + kc) * 256 + j];
    BIAS1[idx] = s;
}
__device__ __forceinline__ void cmp2_row(const Ptrs& P, int R, int lane) {
    unsigned char* ws = P.ws; const bf16_t* HC = (const bf16_t*)(ws + WS_HC);
    const int kv = R >> 12, rr = R & 4095, n = rr & 255;
    bf16_t* dst = (bf16_t*)(ws + (kv ? WS_VC : WS_KC)) + (size_t)rr * 64 + lane;
    if (n == 255) { *dst = 0; return; }
    const float* w2 = P.in[7] + (size_t)kv * 256 * 64;
    const u32x2_t hr = *(const u32x2_t*)(HC + (size_t)R * 256 + 4 * lane);
    float h[4] = {__uint_as_float(hr.x << 16), __uint_as_float(hr.x & 0xffff0000u), __uint_as_float(hr.y << 16), __uint_as_float(hr.y & 0xffff0000u)};
    float o = 0.f;
    for (int jj = 0; jj < 64; ++jj) {
#pragma unroll
        for (int i = 0; i < 4; ++i) o += __shfl(h[i], jj) * w2[(size_t)(4 * jj + i) * 64 + lane];
    }
    if (kv == 0) { const float ss = wave_sum(o * o); o *= __builtin_amdgcn_rsqf(ss * (1.0f / 64.0f) + 1e-6f) * P.in[4][lane]; }
    *dst = (bf16_t)f2bf(o);
}

__device__ __forceinline__ void gmlp_unit_v1(const Ptrs& P, LAS unsigned char* lds, int unit, const int wave_s) {
    unsigned char* ws = P.ws; const int tid = fresh_tid(wave_s);
    const int g = unit & 7, chunk = (unit >> 3) & 31, b = unit >> 8; const int m0 = b * SEQ + chunk * 128;
    LAS float* vn = (LAS float*)lds; LAS float* Wl = (LAS float*)(lds + 65536); LAS float* st = (LAS float*)(lds + 131072);
    const bf16_t* GV = (const bf16_t*)(ws + WS_GV); const bf16_t* U = (const bf16_t*)(ws + WS_U); const float* VSTAT = (const float*)(ws + WS_VSTAT);
    bf16_t* AB = (bf16_t*)(ws + WS_AB);
    const float* ln_w = P.in[8]; const float* ln_b = P.in[9]; const float* sw = P.in[10]; const float* sb = P.in[11];
    if (tid < 128) { const float* p = VSTAT + (size_t)(m0 + tid) * 32; float s1 = 0.f, s2 = 0.f;
#pragma unroll
        for (int i = 0; i < 16; ++i) { s1 += p[2 * i]; s2 += p[2 * i + 1]; }
        const float mean = s1 * (1.0f / 1024.0f); float var = s2 * (1.0f / 1024.0f) - mean * mean; var = var < 0.f ? 0.f : var;
        st[2 * tid] = mean; st[2 * tid + 1] = __builtin_amdgcn_rsqf(var + 1e-5f); }
    for (int i = 0; i < 32; ++i) { const int idx = tid + 512 * i, t = idx >> 7, s = idx & 127; Wl[idx] = (s <= t) ? sw[(size_t)g * 16384 + idx] : 0.f; }
    __syncthreads();
#pragma unroll
    for (int i = 0; i < 4; ++i) { const int idx = tid + 512 * i, s = idx >> 4, c8 = idx & 15;
        const u32x4_t raw = *(const u32x4_t*)(GV + (size_t)(m0 + s) * 1024 + g * 128 + 8 * c8); float f[8]; unpack8(raw, f);
        const float mean = st[2 * s], rstd = st[2 * s + 1];
#pragma unroll
        for (int e = 0; e < 8; ++e) { const int c = g * 128 + 8 * c8 + e; vn[s * 128 + 8 * c8 + e] = (f[e] - mean) * rstd * ln_w[c] + ln_b[c]; } }
    __syncthreads();
    const int c = tid & 127, tq = tid >> 7;
    for (int i = 0; i < 8; ++i) {
        const int t0 = 4 * (tq + 4 * i); float a0 = 0.f, a1 = 0.f, a2 = 0.f, a3 = 0.f;
        for (int s4 = 0; s4 <= t0; s4 += 4) {
            const f32x4_t w0 = *(const LAS f32x4_t*)(Wl + (t0 + 0) * 128 + s4), w1 = *(const LAS f32x4_t*)(Wl + (t0 + 1) * 128 + s4), w2 = *(const LAS f32x4_t*)(Wl + (t0 + 2) * 128 + s4), w3 = *(const LAS f32x4_t*)(Wl + (t0 + 3) * 128 + s4);
#pragma unroll
            for (int k = 0; k < 4; ++k) { const float v = vn[(s4 + k) * 128 + c]; a0 += w0[k] * v; a1 += w1[k] * v; a2 += w2[k] * v; a3 += w3[k] * v; }
        }
        const float av[4] = {a0, a1, a2, a3};
#pragma unroll
        for (int k = 0; k < 4; ++k) { const int t = t0 + k; const size_t row = (size_t)(m0 + t);
            const float uu = bf2f(U[row * 1024 + g * 128 + c]); AB[row * 2048 + 1024 + g * 128 + c] = (bf16_t)f2bf(uu * (av[k] + sb[g * 128 + t])); }
    }
    __syncthreads();
}

__device__ __forceinline__ void conv_item(const Ptrs& P, int b, int idx) {
    const int t = idx / 704, c8 = idx % 704, c0 = 8 * c8, j = c0 >> 7, i0 = c0 & 127;
    const bf16_t* HID = (const bf16_t*)(P.ws + WS_HID); const float* cw = P.in[15]; const float* cb = P.in[16];
    float gt[8], up[8];
#pragma unroll
    for (int e = 0; e < 8; ++e) { gt[e] = cb[c0 + e]; up[e] = cb[D_FF + c0 + e]; }
#pragma unroll
    for (int k = 0; k < 3; ++k) { const int tt = t - 2 + k; if (tt < 0) continue;
        float hg[8], hu[8]; unpack8(*(const u32x4_t*)(HID + (size_t)tt * N_UP + 256 * j + i0), hg); unpack8(*(const u32x4_t*)(HID + (size_t)tt * N_UP + 256 * j + 128 + i0), hu);
#pragma unroll
        for (int e = 0; e < 8; ++e) { gt[e] += cw[(size_t)k * N_UP + c0 + e] * hg[e]; up[e] += cw[(size_t)k * N_UP + D_FF + c0 + e] * hu[e]; } }
    float r[8];
#pragma unroll
    for (int e = 0; e < 8; ++e) r[e] = gt[e] * sigmoidf_(gt[e]) * up[e];
    u32x4_t o; o.x = pk2(r[0], r[1]); o.y = pk2(r[2], r[3]); o.z = pk2(r[4], r[5]); o.w = pk2(r[6], r[7]);
    *(u32x4_t*)((bf16_t*)(P.ws + WS_G) + ((size_t)b * SEQ + t) * D_FF + c0) = o;
}

constexpr int LW_CH = 32;
constexpr int LW_OUT = 32 * 64, LW_UP = 32 * 352, LW_DOWN = 88 * 64, LW_C_OUT = LW_OUT / LW_CH, LW_C_UP = LW_UP / LW_CH, LW_C_DOWN = LW_DOWN / LW_CH, LW_CHUNKS = LW_C_OUT + LW_C_UP + LW_C_DOWN;
static_assert(LW_OUT % LW_CH == 0 && LW_UP % LW_CH == 0 && LW_DOWN % LW_CH == 0, "late weight items per chunk");
template <class RowMap>
__device__ __forceinline__ void lw_load(float (&v)[32], const float* __restrict__ W, int N, int item, int lane) {
    const int nblk = N / 32, kb = item / nblk, nb = item % nblk;
    const float* p = W + (size_t)(64 * kb + (lane >> 5)) * N + 32 * nb + (lane & 31);
#pragma unroll
    for (int i = 0; i < 32; ++i) v[i] = p[(size_t)(2 * i) * N];
}
template <class RowMap>
__device__ __forceinline__ void lw_store(const float (&v)[32], int K, int N, bf16_t* WT, const float* __restrict__ kscale, RowMap rm, LAS float* scr, int item, int lane) {
    const int nblk = N / 32, kb = item / nblk, nb = item % nblk, k0 = 64 * kb, n0 = 32 * nb;
    const int c = lane & 7;
    f32x4_t sc0 = {1.f, 1.f, 1.f, 1.f}, sc1 = sc0;
    if (kscale) { sc0 = *(const f32x4_t*)(kscale + k0 + 8 * c); sc1 = *(const f32x4_t*)(kscale + k0 + 8 * c + 4); }
#pragma unroll
    for (int i = 0; i < 32; ++i) scr[(2 * i + (lane >> 5)) * 33 + (lane & 31)] = v[i];
    asm volatile("s_waitcnt lgkmcnt(0)" ::: "memory");
#pragma unroll
    for (int j = 0; j < 4; ++j) { const int nl = (lane >> 3) + 8 * j; const LAS float* s = scr + (8 * c) * 33 + nl;
        u32x4_t o; o.x = pk2(s[0 * 33] * sc0[0], s[1 * 33] * sc0[1]); o.y = pk2(s[2 * 33] * sc0[2], s[3 * 33] * sc0[3]); o.z = pk2(s[4 * 33] * sc1[0], s[5 * 33] * sc1[1]); o.w = pk2(s[6 * 33] * sc1[2], s[7 * 33] * sc1[3]);
        *(u32x4_t*)(WT + (size_t)rm(n0 + nl) * K + k0 + 8 * c) = o; }
    asm volatile("s_waitcnt lgkmcnt(0)" ::: "memory");
}
template <class RowMap>
__device__ __forceinline__ void lw_run(const float* __restrict__ W, int K, int N, bf16_t* WT, const float* __restrict__ kscale, RowMap rm, LAS float* scr, int item0, int wave, int lane) {
    float va[32], vb[32];
    lw_load<RowMap>(va, W, N, item0 + wave, lane);
    lw_load<RowMap>(vb, W, N, item0 + wave + 8, lane);  lw_store(va, K, N, WT, kscale, rm, scr, item0 + wave, lane);
    lw_load<RowMap>(va, W, N, item0 + wave + 16, lane); lw_store(vb, K, N, WT, kscale, rm, scr, item0 + wave + 8, lane);
    lw_load<RowMap>(vb, W, N, item0 + wave + 24, lane); lw_store(va, K, N, WT, kscale, rm, scr, item0 + wave + 16, lane);
    lw_store(vb, K, N, WT, kscale, rm, scr, item0 + wave + 24, lane);
}
__device__ __forceinline__ void late_weight_chunk(const Ptrs& P, LAS unsigned char* lds, int chunk, const int wave) {
    const int lane = fresh_lane();
    LAS float* scr = (LAS float*)(lds + wave * 16384);
    unsigned char* ws = P.ws;
    if (chunk < LW_C_UP) lw_run(P.in[14], 2048, N_UP, (bf16_t*)(ws + WS_WUP), P.in[13], RmWup(), scr, chunk * LW_CH, wave, lane);
    else if (chunk < LW_C_UP + LW_C_DOWN) lw_run(P.in[17], D_FF, 2048, (bf16_t*)(ws + WS_WDOWN), nullptr, RmIdent(), scr, (chunk - LW_C_UP) * LW_CH, wave, lane);
    else lw_run(P.in[12], 2048, 2048, (bf16_t*)(ws + WS_WOUT), nullptr, RmIdent(), scr, (chunk - LW_C_UP - LW_C_DOWN) * LW_CH, wave, lane);
}

namespace nsa {
using bf16x8 = __attribute__((ext_vector_type(8))) short;
using s16x4 = __attribute__((ext_vector_type(4))) short;
using f32x16 = __attribute__((ext_vector_type(16))) float;
typedef float f32x2_t __attribute__((ext_vector_type(2))); typedef __bf16 bf16x2_t __attribute__((ext_vector_type(2)));
constexpr int L_K = 0, L_V = 16384, L_WSF = 32768, L_OST = 34816, L_IMP = 100352, L_MASK = 116736, L_WU = 117248, L_END = 117312;
constexpr int SLOTB = 8192;
constexpr float THR = 8.0f;
#define NSA_SBAR() __builtin_amdgcn_sched_barrier(0)
__device__ __forceinline__ int crow(int r, int hi) { return (r & 3) + 8 * (r >> 2) + 4 * hi; }
__device__ __forceinline__ void glds16(const void* gbase  , unsigned voff  , unsigned lds_dst) { unsigned keep;
    asm volatile("s_mov_b32 %0, m0\n\ts_mov_b32 m0, %3\n\ts_nop 0\n\tglobal_load_lds_dwordx4 %1, %2\n\ts_mov_b32 m0, %0" : "=&s"(keep) : "v"(voff), "s"(gbase), "s"(lds_dst) : "memory"); }
__device__ __forceinline__ unsigned cvtpk_s(float lo, float hi) { f32x2_t v = {lo, hi}; bf16x2_t b = __builtin_convertvector(v, bf16x2_t); return __builtin_bit_cast(unsigned, b); }
#define NSA_WAIT_BAR() asm volatile("s_waitcnt vmcnt(0) lgkmcnt(0)\n\ts_barrier" ::: "memory")

__device__ __forceinline__ void qkt(f32x16& p0, f32x16& p1, LAS const char* Kslot, const bf16x8 (&qr)[4], int r32, int hi) {
    LAS const char* kb = Kslot + hi * 1024 + r32 * 16;
#pragma unroll
    for (int d0 = 0; d0 < 4; ++d0) {
        const bf16x8 b0 = *(LAS const bf16x8*)(kb + d0 * 2048);
        const bf16x8 b1 = *(LAS const bf16x8*)(kb + d0 * 2048 + 512);
        p0 = __builtin_amdgcn_mfma_f32_32x32x16_bf16(b0, qr[d0], p0, 0, 0, 0); p1 = __builtin_amdgcn_mfma_f32_32x32x16_bf16(b1, qr[d0], p1, 0, 0, 0);
    }
}
struct VFrag { s16x4 lo[2][4], hi[2][4]; };
__device__ __forceinline__ void vload(VFrag& f, int vb) {
#pragma unroll
    for (int d0 = 0; d0 < 2; ++d0)
#pragma unroll
        for (int ks = 0; ks < 4; ++ks) {
            asm volatile("ds_read_b64_tr_b16 %0,%1 offset:%c2" : "=&v"(f.lo[d0][ks]) : "v"(vb), "i"(d0 * 4096 + ks * 1024) : "memory");
            asm volatile("ds_read_b64_tr_b16 %0,%1 offset:%c2" : "=&v"(f.hi[d0][ks]) : "v"(vb), "i"(d0 * 4096 + ks * 1024 + 512) : "memory"); }
}
__device__ __forceinline__ void pvmma(f32x16 (&o)[2], VFrag& f, bf16x8 pa0, bf16x8 pa1, bf16x8 pa2, bf16x8 pa3) {
    asm volatile("s_waitcnt lgkmcnt(0)" : "+v"(f.lo[0][0]), "+v"(f.lo[0][1]), "+v"(f.lo[0][2]), "+v"(f.lo[0][3]), "+v"(f.hi[0][0]), "+v"(f.hi[0][1]), "+v"(f.hi[0][2]), "+v"(f.hi[0][3]) :: "memory");
    asm volatile("" : "+v"(f.lo[1][0]), "+v"(f.lo[1][1]), "+v"(f.lo[1][2]), "+v"(f.lo[1][3]), "+v"(f.hi[1][0]), "+v"(f.hi[1][1]), "+v"(f.hi[1][2]), "+v"(f.hi[1][3]));
    NSA_SBAR();
#pragma unroll
    for (int d0 = 0; d0 < 2; ++d0) {
#define NSA_PK(k) (bf16x8){f.lo[d0][k][0], f.lo[d0][k][1], f.lo[d0][k][2], f.lo[d0][k][3], f.hi[d0][k][0], f.hi[d0][k][1], f.hi[d0][k][2], f.hi[d0][k][3]}
        o[d0] = __builtin_amdgcn_mfma_f32_32x32x16_bf16(pa0, NSA_PK(0), o[d0], 0, 0, 0);
        o[d0] = __builtin_amdgcn_mfma_f32_32x32x16_bf16(pa1, NSA_PK(1), o[d0], 0, 0, 0);
        o[d0] = __builtin_amdgcn_mfma_f32_32x32x16_bf16(pa2, NSA_PK(2), o[d0], 0, 0, 0);
        o[d0] = __builtin_amdgcn_mfma_f32_32x32x16_bf16(pa3, NSA_PK(3), o[d0], 0, 0, 0);
#undef NSA_PK
    }
}
__device__ __forceinline__ void pv(f32x16 (&o)[2], int vb, bf16x8 pa0, bf16x8 pa1, bf16x8 pa2, bf16x8 pa3) { VFrag f; vload(f, vb); pvmma(o, f, pa0, pa1, pa2, pa3); }
__device__ __forceinline__ float rowmax32(const f32x16& p0, const f32x16& p1) {
    float a = __builtin_fmaxf(p0[0], p1[0]);
#pragma unroll
    for (int r = 1; r < 16; ++r) a = __builtin_fmaxf(a, __builtin_fmaxf(p0[r], p1[r]));
    auto rr = __builtin_amdgcn_permlane32_swap(__float_as_uint(a), __float_as_uint(a), false, false);
    return __builtin_fmaxf(__uint_as_float(rr[0]), __uint_as_float(rr[1]));
}
struct State { float m, l; f32x16 o[2]; };
__device__ __forceinline__ void state_init(State& s) { s.m = -1e30f; s.l = 0.f; s.o[0] = f32x16{}; s.o[1] = f32x16{}; }

template <int BMUL, int MASK, bool LOADV>
__device__ __forceinline__ void tile_scores(f32x16& p0, f32x16& p1, LAS const char* Kslot, const bf16x8 (&qr)[4], const f32x16& bk, float c0, float b32, int lim, int r32, int hi, VFrag& vf, int vb) {
#pragma unroll
    for (int r = 0; r < 16; ++r) { const float b = (BMUL == 1) ? bk[r] + c0 : __builtin_fmaf(bk[r], (float)BMUL, c0); p0[r] = b; p1[r] = b + b32; }
    qkt(p0, p1, Kslot, qr, r32, hi);
    if (LOADV) vload(vf, vb);
    const int limh = lim - 4 * hi;
#pragma unroll
    for (int r = 0; r < 16; ++r) {
        const int kk = (r & 3) + 8 * (r >> 2);
        if (MASK == 1) { if (!(kk <= limh)) p0[r] = -INFINITY; if (!(kk + 32 <= limh)) p1[r] = -INFINITY; }
        if (MASK == 2) { if (!(kk > limh)) p0[r] = -INFINITY; if (!(kk + 32 > limh)) p1[r] = -INFINITY; }
        if (MASK == 3) { if (!(kk < limh)) p0[r] = -INFINITY; if (!(kk + 32 < limh)) p1[r] = -INFINITY; }
    }
}
__device__ __forceinline__ float tile_ref(const State& st, float rb0, bool rowlive) { return (st.m < -1e29f && rowlive) ? rb0 : st.m; }
__device__ __forceinline__ void tile_softmax_pv(State& st, f32x16& p0, f32x16& p1, float mref, VFrag& vf, LAS float* wsf, int r32, int hi) {
    float a0 = p0[0], a1 = p1[0];
#pragma unroll
    for (int r = 1; r < 16; ++r) { a0 = __builtin_fmaxf(a0, p0[r]); a1 = __builtin_fmaxf(a1, p1[r]); }
    float mx = __builtin_fmaxf(a0, a1);
    { auto rr = __builtin_amdgcn_permlane32_swap(__float_as_uint(mx), __float_as_uint(mx), false, false); mx = __builtin_fmaxf(__uint_as_float(rr[0]), __uint_as_float(rr[1])); }
    if (__any(mx > THR)) {
        const float dl = __builtin_fmaxf(mx, 0.f), alpha = __builtin_amdgcn_exp2f(-dl);
        mref += dl; st.l *= alpha;
        if (hi == 0) wsf[r32] = alpha;
        asm volatile("s_waitcnt lgkmcnt(0)" ::: "memory");
#pragma unroll
        for (int r = 0; r < 16; ++r) { const float a = wsf[crow(r, hi)]; st.o[0][r] *= a; st.o[1][r] *= a; p0[r] -= dl; p1[r] -= dl; }
    }
    st.m = mref;
    float ls = 0.f;
#pragma unroll
    for (int r = 0; r < 16; ++r) { p0[r] = __builtin_amdgcn_exp2f(p0[r]); p1[r] = __builtin_amdgcn_exp2f(p1[r]); ls += p0[r] + p1[r]; }
    st.l += ls;
    u32x4_t pw0, pw1, pw2, pw3;
    pw0 = (u32x4_t){cvtpk_s(p0[0], p0[1]), cvtpk_s(p0[2], p0[3]), cvtpk_s(p0[4], p0[5]), cvtpk_s(p0[6], p0[7])};
    pw1 = (u32x4_t){cvtpk_s(p0[8], p0[9]), cvtpk_s(p0[10], p0[11]), cvtpk_s(p0[12], p0[13]), cvtpk_s(p0[14], p0[15])};
    pw2 = (u32x4_t){cvtpk_s(p1[0], p1[1]), cvtpk_s(p1[2], p1[3]), cvtpk_s(p1[4], p1[5]), cvtpk_s(p1[6], p1[7])};
    pw3 = (u32x4_t){cvtpk_s(p1[8], p1[9]), cvtpk_s(p1[10], p1[11]), cvtpk_s(p1[12], p1[13]), cvtpk_s(p1[14], p1[15])};
    pvmma(st.o, vf, __builtin_bit_cast(bf16x8, pw0), __builtin_bit_cast(bf16x8, pw1), __builtin_bit_cast(bf16x8, pw2), __builtin_bit_cast(bf16x8, pw3));
}
template <bool FIRST>
__device__ __forceinline__ void fold_branch(LAS float* ostg, State& st, float gate, LAS float* wsf, int r32, int hi) {
    float l = st.l;
    { auto rr = __builtin_amdgcn_permlane32_swap(__float_as_uint(l), __float_as_uint(l), false, false); l = __uint_as_float(rr[0]) + __uint_as_float(rr[1]); }
    const float f = l > 0.f ? gate / l : 0.f;
    asm volatile("s_waitcnt lgkmcnt(0)" ::: "memory");
    if (hi == 0) wsf[r32] = f;
    asm volatile("s_waitcnt lgkmcnt(0)" ::: "memory");
#pragma unroll
    for (int r = 0; r < 16; ++r) { const int orow = crow(r, hi); const float a = wsf[orow];
#pragma unroll
        for (int d0 = 0; d0 < 2; ++d0) { LAS float* p = ostg + orow * 64 + d0 * 32 + r32; if (FIRST) *p = st.o[d0][r] * a; else *p += st.o[d0][r] * a; } }
    asm volatile("s_waitcnt lgkmcnt(0)" ::: "memory");
}

__device__ __forceinline__ int nsa_unit(const Ptrs& P, LAS unsigned char* lds, int bg, int qt, const int wave_s, unsigned* qctr, int qbase) {
    unsigned char* ws = P.ws;
    const int lane = fresh_lane(), r32 = lane & 31, hi = lane >> 5; const int wid = wave_s;
    const int b = bg >> 2, g = bg & 3, t0 = 64 * qt;
    const int tl = 8 * wid + (r32 >> 2), hq = r32 & 3;
    const size_t m0 = (size_t)b * SEQ + t0;
    const bf16_t* Q = (const bf16_t*)(ws + WS_Q); const bf16_t* KV6 = (const bf16_t*)(ws + WS_KV6);
    const bf16_t* KSb = KV6 + 2 * KVSZ + (size_t)bg * SEQ * 64; const bf16_t* VSb = KV6 + 3 * KVSZ + (size_t)bg * SEQ * 64;
    const bf16_t* KWb = KV6 + 4 * KVSZ + (size_t)bg * SEQ * 64; const bf16_t* VWb = KV6 + 5 * KVSZ + (size_t)bg * SEQ * 64;
    const bf16_t* KCb = (const bf16_t*)(ws + WS_KC) + (size_t)bg * 256 * 64; const bf16_t* VCb = (const bf16_t*)(ws + WS_VC) + (size_t)bg * 256 * 64;
    const float* GATES = (const float*)(ws + WS_GATES); bf16_t* AB = (bf16_t*)(ws + WS_AB);
    const unsigned lds0 = (unsigned)(uintptr_t)lds;
    LAS float* wsf = (LAS float*)(lds + L_WSF) + wid * 64;
    LAS float* IMP = (LAS float*)(lds + L_IMP);
    LAS unsigned* MASK = (LAS unsigned*)(lds + L_MASK); LAS unsigned* WU = (LAS unsigned*)(lds + L_WU);
    const int koff = lane * 64 + wid * 8, voff = (16 * (wid & 3) + (lane >> 2)) * 64 + (wid >> 2) * 32 + (lane & 3) * 8;
    const unsigned kdst = lds0 + L_K + wid * 1024, vdst = lds0 + L_V + wid * 1024;
#define NSA_DMA_K(base, tile, slot) glds16((base) + (size_t)(tile) * 4096, (unsigned)koff * 2u, (unsigned)__builtin_amdgcn_readfirstlane(kdst + (slot) * SLOTB))
#define NSA_DMA_V(base, tile, slot) glds16((base) + (size_t)(tile) * 4096, (unsigned)voff * 2u, (unsigned)__builtin_amdgcn_readfirstlane(vdst + (slot) * SLOTB))
    const int vb0 = (int)(lds0 + L_V) + ((lane >> 4) & 1) * 32 + (lane & 3) * 8 + (4 * hi + ((lane & 15) >> 2)) * 64;
    LAS const char* Kbase = (LAS const char*)(lds + L_K);
    bf16x8 qr[4];
    { const bf16_t* qp = Q + (m0 + tl) * 1024 + (4 * g + hq) * 64 + hi * 8;
#pragma unroll
      for (int d0 = 0; d0 < 4; ++d0) qr[d0] = *(const bf16x8*)(qp + d0 * 16); }
    const float sl2 = __builtin_amdgcn_exp2f(-0.5f * (float)(4 * g + hq + 1)) * LOG2E;
    f32x16 bk;
#pragma unroll
    for (int r = 0; r < 16; ++r) bk[r] = sl2 * (float)((r & 3) + 8 * (r >> 2));
    const float b32t = 32.0f * sl2, b32c = 512.0f * sl2, hoff_t = 4.0f * (float)hi * sl2, hoff_c = 64.0f * (float)hi * sl2;
    float gate[3];
    { const float* gp = GATES + (m0 + tl) * 48 + (4 * g + hq) * 3; gate[0] = gp[0]; gate[1] = gp[1]; gate[2] = gp[2]; }
    LAS float* ostg = (LAS float*)(lds + L_OST) + wid * 2048;
    State st;
    f32x16 p0, p1;
    int nxt_ticket = 0;

    int tc = 0;
    VFrag vf;
    const int nvmax = (t0 + 63 >= 31) ? ((t0 + 63 - 31) >> 4) + 1 : 0;
    const int nct = (nvmax + 63) >> 6;
    const int tq = t0 + tl, nv = tq >= 31 ? ((tq - 31) >> 4) + 1 : 0;
    {
        state_init(st);
        const int j0 = qt >= 8 ? qt - 8 : 0, nt = qt - j0 + 1;
        NSA_DMA_K(KWb, qt, 0); NSA_DMA_V(VWb, qt, 0); NSA_WAIT_BAR();
        for (int i = 0; i < nt; ++i) {
            const int j = qt - i, slot = (tc + i) & 1;
            if (i + 1 < nt) { NSA_DMA_K(KWb, j - 1, slot ^ 1); NSA_DMA_V(VWb, j - 1, slot ^ 1); }
            else { NSA_DMA_K(KCb, nct - 1, slot ^ 1); NSA_DMA_V(VCb, nct - 1, slot ^ 1); }
            const float rb0 = sl2 * (float)(64 * j - t0), mref = tile_ref(st, rb0, true), c0 = rb0 + hoff_t - mref;
            if (j == qt) tile_scores<1, 1, true>(p0, p1, Kbase + slot * SLOTB, qr, bk, c0, b32t, tl, r32, hi, vf, vb0 + slot * SLOTB);
            else if (j == qt - 8) tile_scores<1, 2, true>(p0, p1, Kbase + slot * SLOTB, qr, bk, c0, b32t, tl, r32, hi, vf, vb0 + slot * SLOTB);
            else tile_scores<1, 0, true>(p0, p1, Kbase + slot * SLOTB, qr, bk, c0, b32t, 0, r32, hi, vf, vb0 + slot * SLOTB);
            tile_softmax_pv(st, p0, p1, mref, vf, wsf, r32, hi);
            NSA_WAIT_BAR();
        }
        tc += nt;
        fold_branch<true>(ostg, st, gate[2], wsf, r32, hi);
    }
    {
        state_init(st);
        for (int ci = 0; ci < nct; ++ci) {
            const int c = nct - 1 - ci, slot = (tc + ci) & 1;
            if (ci + 1 < nct) { NSA_DMA_K(KCb, c - 1, slot ^ 1); NSA_DMA_V(VCb, c - 1, slot ^ 1); }
            else if (qt >= 16) { NSA_DMA_K(KCb, 0, slot ^ 1); }
            else { NSA_DMA_K(KSb, qt, slot ^ 1); NSA_DMA_V(VSb, qt, slot ^ 1); }
            const float rb0 = sl2 * ((float)(1024 * c - t0) + 15.5f), mref = tile_ref(st, rb0, true), c0 = rb0 + hoff_c - mref;
            tile_scores<16, 3, true>(p0, p1, Kbase + slot * SLOTB, qr, bk, c0, b32c, nv - 64 * c, r32, hi, vf, vb0 + slot * SLOTB);
            tile_softmax_pv(st, p0, p1, mref, vf, wsf, r32, hi);
            NSA_WAIT_BAR();
        }
        tc += nct;
    }
    const float mc_fin = st.m; float lc = st.l;
    fold_branch<false>(ostg, st, gate[0], wsf, r32, hi);
    if (qt >= 16) {
        { auto rr = __builtin_amdgcn_permlane32_swap(__float_as_uint(lc), __float_as_uint(lc), false, false); lc = __uint_as_float(rr[0]) + __uint_as_float(rr[1]); }
        const float invl = lc > 0.f ? 1.0f / lc : 0.f;
        float carry = 0.f;
        for (int c = 0; c < nct; ++c) {
            const int slot = (tc + c) & 1;
            if (c + 1 < nct) { NSA_DMA_K(KCb, c + 1, slot ^ 1); }
            else { NSA_DMA_K(KSb, qt, slot ^ 1); NSA_DMA_V(VSb, qt, slot ^ 1); }
            const float c0 = sl2 * ((float)(1024 * c - t0) + 15.5f) + hoff_c - mc_fin;
            tile_scores<16, 3, false>(p0, p1, Kbase + slot * SLOTB, qr, bk, c0, b32c, nv - 64 * c, r32, hi, vf, 0);
#pragma unroll
            for (int r = 0; r < 16; ++r) { p0[r] = __builtin_amdgcn_exp2f(p0[r]) * invl; p1[r] = __builtin_amdgcn_exp2f(p1[r]) * invl; }
            float imp0[4], imp1[4], pl0[4], pl1[4];
#pragma unroll
            for (int a = 0; a < 4; ++a) {
                imp0[a] = (p0[4 * a] + p0[4 * a + 1]) + (p0[4 * a + 2] + p0[4 * a + 3]); imp1[a] = (p1[4 * a] + p1[4 * a + 1]) + (p1[4 * a + 2] + p1[4 * a + 3]);
                pl0[a] = __shfl_xor(p0[4 * a + 3], 32); pl1[a] = __shfl_xor(p1[4 * a + 3], 32);
            }
            if (hi) {
#pragma unroll
                for (int a = 0; a < 4; ++a) { imp0[a] += pl0[a]; imp1[a] += pl1[a]; }
            } else {
                imp0[0] += carry; imp1[0] += pl0[3];
#pragma unroll
                for (int a = 1; a < 4; ++a) { imp0[a] += pl0[a - 1]; imp1[a] += pl1[a - 1]; }
            }
            carry = pl1[3];
#pragma unroll
            for (int a = 0; a < 4; ++a) {
                imp0[a] += __shfl_xor(imp0[a], 1); imp0[a] += __shfl_xor(imp0[a], 2); imp1[a] += __shfl_xor(imp1[a], 1); imp1[a] += __shfl_xor(imp1[a], 2);
                if (hq == 0) { IMP[tl * 64 + 16 * c + 2 * a + hi] = imp0[a]; IMP[tl * 64 + 16 * c + 8 + 2 * a + hi] = imp1[a]; }
            }
            NSA_WAIT_BAR();
        }
        tc += nct;
    }
    unsigned long long wu = 0ull;
    if (qt < 16) {
        wu = (2ull << qt) - 1ull;
        if (lane < 8) { MASK[2 * (8 * wid + lane)] = (unsigned)wu; MASK[2 * (8 * wid + lane) + 1] = (unsigned)(wu >> 32); }
    } else {
        const int j = lane; const bool valid = j <= qt, forced = (j == 0) || (j == qt) || (j == qt - 1);
        for (int k = 0; k < 8; ++k) {
            const float imp = IMP[(8 * wid + k) * 64 + j];
            const float scv = valid ? (forced ? 1e9f : imp) : -1e9f;
            const unsigned fb = __float_as_uint(scv), key = fb ^ ((fb >> 31) ? 0xffffffffu : 0x80000000u);
            unsigned T = 0u;
#pragma unroll
            for (int bit = 31; bit >= 0; --bit) { const unsigned cand = T | (1u << bit); if (__builtin_popcountll(__ballot(key >= cand)) >= 16) T = cand; }
            const unsigned long long gt = __ballot(key > T), eq = __ballot(key == T);
            const int need = 16 - __builtin_popcountll(gt);
            const int before = (int)__builtin_amdgcn_mbcnt_hi((unsigned)(eq >> 32), __builtin_amdgcn_mbcnt_lo((unsigned)eq, 0u));
            const bool sel = (key > T) || ((key == T) && (before < need));
            const unsigned long long mk = __ballot(sel && (scv > -0.5e9f));
            wu |= mk;
            if (lane == 0) { MASK[2 * (8 * wid + k)] = (unsigned)mk; MASK[2 * (8 * wid + k) + 1] = (unsigned)(mk >> 32); }
        }
    }
    if (lane == 0) { WU[2 * wid] = (unsigned)wu; WU[2 * wid + 1] = (unsigned)(wu >> 32); }
    NSA_WAIT_BAR();
    unsigned long long uni = 0ull;
#pragma unroll
    for (int w = 0; w < 8; ++w) uni |= ((unsigned long long)WU[2 * w]) | (((unsigned long long)WU[2 * w + 1]) << 32);
    uni = ((unsigned long long)(unsigned)__builtin_amdgcn_readfirstlane((unsigned)uni)) | (((unsigned long long)(unsigned)__builtin_amdgcn_readfirstlane((unsigned)(uni >> 32))) << 32);
    const unsigned long long mymask = ((unsigned long long)MASK[2 * tl]) | (((unsigned long long)MASK[2 * tl + 1]) << 32);
    {
        state_init(st);
        unsigned long long rem = uni;
        int j = 63 - __builtin_clzll(rem); rem &= ~(1ull << j);
        for (int i = 0;; ++i) {
            const int slot = (tc + i) & 1; const bool more = rem != 0ull;
            int jn = 0;
            if (more) { jn = 63 - __builtin_clzll(rem); rem &= ~(1ull << jn); NSA_DMA_K(KSb, jn, slot ^ 1); NSA_DMA_V(VSb, jn, slot ^ 1); }
            if ((wu >> j) & 1ull) {
                const bool live = ((mymask >> j) & 1ull) != 0ull;
                const float rb0 = sl2 * (float)(64 * j - t0), mref = tile_ref(st, rb0, live), c0 = live ? rb0 + hoff_t - mref : -INFINITY;
                if (j == qt) tile_scores<1, 1, true>(p0, p1, Kbase + slot * SLOTB, qr, bk, c0, b32t, tl, r32, hi, vf, vb0 + slot * SLOTB);
                else tile_scores<1, 0, true>(p0, p1, Kbase + slot * SLOTB, qr, bk, c0, b32t, 0, r32, hi, vf, vb0 + slot * SLOTB);
                tile_softmax_pv(st, p0, p1, mref, vf, wsf, r32, hi);
            }
            NSA_WAIT_BAR();
            if (!more) break;
            j = jn;
        }
        if (wid == 0 && lane == 0) nxt_ticket = qbase + (int)__hip_atomic_fetch_add(qctr, 1u, __ATOMIC_RELAXED, __HIP_MEMORY_SCOPE_AGENT);
        fold_branch<false>(ostg, st, gate[1], wsf, r32, hi);
    }
    {
#pragma unroll
        for (int i = 0; i < 4; ++i) { const int row = i * 8 + (lane >> 3), ch = lane & 7;
            const f32x4_t v0 = *(LAS const f32x4_t*)(ostg + row * 64 + ch * 8), v1 = *(LAS const f32x4_t*)(ostg + row * 64 + ch * 8 + 4);
            u32x4_t v; v.x = cvtpk_s(v0[0], v0[1]); v.y = cvtpk_s(v0[2], v0[3]); v.z = cvtpk_s(v1[0], v1[1]); v.w = cvtpk_s(v1[2], v1[3]);
            *(u32x4_t*)(AB + (m0 + 8 * wid + (row >> 2)) * 2048 + 256 * g + (row & 3) * 64 + ch * 8) = v; }
    }
    NSA_WAIT_BAR();
#undef NSA_DMA_K
#undef NSA_DMA_V
    return nxt_ticket;
}
constexpr int L_QS = 145416;
__device__ __forceinline__ void nsa_phase(const Ptrs& P, LAS unsigned char* lds, int bid, int G, const int wave_s) {
    unsigned* qctr = (unsigned*)(P.ws + WS_CTL) + 3584;
    LAS int* qs = (LAS int*)(lds + L_QS);
    int k = bid;
    while (k < 1024 + LW_CHUNKS) {
        int nxt;
        if (k < 1024) {
            const int qt = 63 - (k >> 4), g = 3 - ((k >> 2) & 3), b = k & 3;
            nxt = nsa_unit(P, lds, b * 4 + g, qt, wave_s, qctr, G);
        } else {
            nxt = 0;
            if (wave_s == 0 && fresh_lane() == 0) nxt = G + (int)__hip_atomic_fetch_add(qctr, 1u, __ATOMIC_RELAXED, __HIP_MEMORY_SCOPE_AGENT);
            late_weight_chunk(P, lds, k - 1024, wave_s);
        }
        if (wave_s == 0 && fresh_lane() == 0) *qs = nxt;
        NSA_WAIT_BAR();
        k = __builtin_amdgcn_readfirstlane(*qs);
    }
}
}

namespace p2 {
using nsa::bf16x8; using nsa::f32x16; using nsa::s16x4; using nsa::crow; using nsa::glds16; using nsa::cvtpk_s;
#define P2_WAIT_BAR() asm volatile("s_waitcnt vmcnt(0) lgkmcnt(0)\n\ts_barrier" ::: "memory")
constexpr int CB_BUF = 40960;
constexpr int CP_STRIDE = 65;
__device__ __forceinline__ void compress_unit(const Ptrs& P, LAS unsigned char* lds, int u, const int wave_s) {
    unsigned char* ws = P.ws;
    const int lane = fresh_lane(), r32 = lane & 31, hi = lane >> 5, wid = wave_s;
    const int kv = u >> 6, bg = (u >> 2) & 15, n0 = 64 * (u & 3);
    const bf16_t* Ag = (const bf16_t*)(ws + WS_KV6) + (size_t)kv * KVSZ + (size_t)bg * SEQ * 64 + (size_t)n0 * 1024;
    const bf16_t* Bg = (const bf16_t*)(ws + WS_W1C) + (size_t)kv * 256 * 2048;
    const unsigned lds0 = (unsigned)(uintptr_t)lds;
    const unsigned aoff = (unsigned)(lane * 1024 + wid * 8) * 2u, boff = (unsigned)(lane * 2048 + wid * 8) * 2u;
    const unsigned dstw = lds0 + wid * 1024;
#define P2_DMA_TILE(kt, buf) do { const unsigned d_ = (unsigned)__builtin_amdgcn_readfirstlane(dstw + (buf) * CB_BUF); \
        glds16(Ag + (kt) * 64, aoff, d_); \
        _Pragma("unroll") for (int ct_ = 0; ct_ < 4; ++ct_) glds16(Bg + (size_t)ct_ * 64 * 2048 + (kt) * 64, boff, d_ + 8192u * (ct_ + 1)); } while (0)
    const int ct = wid >> 1, half = wid & 1, ncol0 = 64 * ct + 32 * half;
    f32x16 hT[2]; hT[0] = f32x16{}; hT[1] = f32x16{};
    P2_DMA_TILE(0, 0); P2_DMA_TILE(1, 1);
    asm volatile("s_waitcnt vmcnt(5) lgkmcnt(0)\n\ts_barrier" ::: "memory");
    for (int kt = 0; kt < 32; ++kt) {
        const int buf = kt % 3;
        if (kt + 2 < 32) P2_DMA_TILE(kt + 2, (kt + 2) % 3);
        LAS const char* sa = (LAS const char*)(lds + buf * CB_BUF) + hi * 1024 + r32 * 16;
        LAS const char* sb = (LAS const char*)(lds + buf * CB_BUF + 8192 * (ct + 1)) + half * 512 + hi * 1024 + r32 * 16;
#pragma unroll
        for (int d0 = 0; d0 < 4; ++d0) {
            const bf16x8 bf = *(LAS const bf16x8*)(sb + d0 * 2048), a0 = *(LAS const bf16x8*)(sa + d0 * 2048), a1 = *(LAS const bf16x8*)(sa + d0 * 2048 + 512);
            hT[0] = __builtin_amdgcn_mfma_f32_32x32x16_bf16(bf, a0, hT[0], 0, 0, 0);
            hT[1] = __builtin_amdgcn_mfma_f32_32x32x16_bf16(bf, a1, hT[1], 0, 0, 0);
        }
        if (kt + 2 < 32) asm volatile("s_waitcnt vmcnt(5) lgkmcnt(0)\n\ts_barrier" ::: "memory");
        else asm volatile("s_waitcnt vmcnt(0) lgkmcnt(0)\n\ts_barrier" ::: "memory");
    }
    const float* bias1 = (const float*)(ws + WS_SMALL + SM_BIAS1) + kv * 256 + ncol0;
    bf16x8 hb[2][2];
#pragma unroll
    for (int mt = 0; mt < 2; ++mt) {
        float g[16];
#pragma unroll
        for (int r = 0; r < 16; ++r) g[r] = gelu_tanh(hT[mt][r] + bias1[crow(r, hi)]);
#pragma unroll
        for (int s = 0; s < 2; ++s) { u32x4_t w; w.x = cvtpk_s(g[8 * s], g[8 * s + 1]); w.y = cvtpk_s(g[8 * s + 2], g[8 * s + 3]); w.z = cvtpk_s(g[8 * s + 4], g[8 * s + 5]); w.w = cvtpk_s(g[8 * s + 6], g[8 * s + 7]);
            hb[mt][s] = __builtin_bit_cast(bf16x8, w); }
    }
    const bf16_t* w2t = (const bf16_t*)(ws + WS_SMALL + SM_W2T) + (size_t)kv * 64 * 256;
    f32x16 oT[2][2];
#pragma unroll
    for (int dt = 0; dt < 2; ++dt)
#pragma unroll
        for (int mt = 0; mt < 2; ++mt) oT[dt][mt] = f32x16{};
#pragma unroll
    for (int dt = 0; dt < 2; ++dt)
#pragma unroll
        for (int s = 0; s < 2; ++s) {
            const bf16_t* wp = w2t + (size_t)(32 * dt + r32) * 256 + ncol0 + 16 * s + 4 * hi;
            const u32x2_t lo = *(const u32x2_t*)wp, hi2 = *(const u32x2_t*)(wp + 8);
            const u32x4_t wv = {lo.x, lo.y, hi2.x, hi2.y}; const bf16x8 wf = __builtin_bit_cast(bf16x8, wv);
#pragma unroll
            for (int mt = 0; mt < 2; ++mt) oT[dt][mt] = __builtin_amdgcn_mfma_f32_32x32x16_bf16(wf, hb[mt][s], oT[dt][mt], 0, 0, 0);
        }
    LAS float* part = (LAS float*)lds + wid * 64 * CP_STRIDE;
#pragma unroll
    for (int dt = 0; dt < 2; ++dt)
#pragma unroll
        for (int mt = 0; mt < 2; ++mt)
#pragma unroll
            for (int r = 0; r < 16; ++r) part[(32 * mt + r32) * CP_STRIDE + 32 * dt + crow(r, hi)] = oT[dt][mt][r];
    P2_WAIT_BAR();
    {
        const int tid = wid * 64 + lane, m = tid >> 3, dg = tid & 7;
        float o[8];
#pragma unroll
        for (int e = 0; e < 8; ++e) { float s = 0.f;
#pragma unroll
            for (int w = 0; w < 8; ++w) s += ((LAS const float*)lds)[(w * 64 + m) * CP_STRIDE + 8 * dg + e];
            o[e] = s; }
        if (kv == 0) {
            float ss = 0.f;
#pragma unroll
            for (int e = 0; e < 8; ++e) ss += o[e] * o[e];
            ss += __shfl_xor(ss, 1); ss += __shfl_xor(ss, 2); ss += __shfl_xor(ss, 4);
            const float rr = __builtin_amdgcn_rsqf(ss * (1.0f / 64.0f) + 1e-6f);
#pragma unroll
            for (int e = 0; e < 8; ++e) o[e] *= rr * P.in[4][8 * dg + e];
        }
        const int n = n0 + m;
        u32x4_t v = {0u, 0u, 0u, 0u};
        if (n < 255) { v.x = cvtpk_s(o[0], o[1]); v.y = cvtpk_s(o[2], o[3]); v.z = cvtpk_s(o[4], o[5]); v.w = cvtpk_s(o[6], o[7]); }
        *(u32x4_t*)((bf16_t*)(ws + (kv ? WS_VC : WS_KC)) + ((size_t)bg * 256 + n) * 64 + 8 * dg) = v;
    }
    P2_WAIT_BAR();
#undef P2_DMA_TILE
}

constexpr int G_V = 0, G_ST = 32768, G_OST = 33792, G_END = 33792 + 65536;
struct GmlpIn { u32x4_t raw[4]; u32x4_t uraw[4]; float sbv[4]; };
__device__ __forceinline__ void gmlp_load(GmlpIn& in, const Ptrs& P, int unit, int tid, int lane, int r32, int hi, int wid) {
    unsigned char* ws = P.ws;
    const int g = unit & 7, chunk = (unit >> 3) & 31, b = unit >> 8; const int m0 = b * SEQ + chunk * 128;
    const bf16_t* GV = (const bf16_t*)(ws + WS_GV); const bf16_t* U = (const bf16_t*)(ws + WS_U);
    const int tb = wid >> 1, ch = wid & 1; (void)r32; (void)hi;
#pragma unroll
    for (int i = 0; i < 4; ++i) { const int idx = tid + 512 * i, s = idx >> 4, c8 = idx & 15; in.raw[i] = *(const u32x4_t*)(GV + (size_t)(m0 + s) * 1024 + g * 128 + 8 * c8); }
#pragma unroll
    for (int i = 0; i < 4; ++i) { const int row = i * 8 + (lane >> 3), t = 32 * tb + row; in.uraw[i] = *(const u32x4_t*)(U + (size_t)(m0 + t) * 1024 + g * 128 + 64 * ch + 8 * (lane & 7)); in.sbv[i] = P.in[11][g * 128 + t]; }
}
__device__ __forceinline__ void gmlp_compute(const GmlpIn& in, const f32x4_t (&sv)[8], const bf16x8 (&pa)[2][4], const f32x4_t w0, const f32x4_t w1, const f32x4_t b0, const f32x4_t b1, const Ptrs& P, LAS unsigned char* lds, int unit, int tid, int lane, int r32, int hi, int wid) {
    unsigned char* ws = P.ws;
    const int g = unit & 7, chunk = (unit >> 3) & 31, b = unit >> 8; const int m0 = b * SEQ + chunk * 128;
    bf16_t* AB = (bf16_t*)(ws + WS_AB);
    LAS float* st = (LAS float*)(lds + G_ST);
    const int tb = wid >> 1, ch = wid & 1;
    if (tid < 128) { float s1 = 0.f, s2 = 0.f;
#pragma unroll
        for (int i = 0; i < 8; ++i) { s1 += sv[i][0] + sv[i][2]; s2 += sv[i][1] + sv[i][3]; }
        const float mean = s1 * (1.0f / 1024.0f); float var = s2 * (1.0f / 1024.0f) - mean * mean; var = var < 0.f ? 0.f : var;
        st[2 * tid] = mean; st[2 * tid + 1] = __builtin_amdgcn_rsqf(var + 1e-5f); }
    asm volatile("s_waitcnt lgkmcnt(0)\n\ts_barrier" ::: "memory");
#pragma unroll
    for (int i = 0; i < 4; ++i) { const int idx = tid + 512 * i, s = idx >> 4, c8 = idx & 15;
        float f[8]; unpack8(in.raw[i], f);
        const float mean = st[2 * s], rstd = st[2 * s + 1];
        float y[8];
#pragma unroll
        for (int e = 0; e < 4; ++e) { y[e] = (f[e] - mean) * rstd * w0[e] + b0[e]; y[4 + e] = (f[4 + e] - mean) * rstd * w1[e] + b1[e]; }
        u32x4_t o; o.x = cvtpk_s(y[0], y[1]); o.y = cvtpk_s(y[2], y[3]); o.z = cvtpk_s(y[4], y[5]); o.w = cvtpk_s(y[6], y[7]);
        const int st_ = s >> 6, sk = s & 63, chh = c8 >> 3, x = c8 & 7;
        *(LAS u32x4_t*)(lds + G_V + (st_ * 2 + chh) * 8192 + (x >> 2) * 4096 + (sk >> 4) * 1024 + (sk & 15) * 64 + (x & 3) * 16) = o; }
    asm volatile("s_waitcnt lgkmcnt(0)\n\ts_barrier" ::: "memory");
    f32x16 o[2]; o[0] = f32x16{}; o[1] = f32x16{};
    const int vb0 = (int)((unsigned)(uintptr_t)lds + G_V) + ((lane >> 4) & 1) * 32 + (lane & 3) * 8 + (4 * hi + ((lane & 15) >> 2)) * 64;
    nsa::pv(o, vb0 + ch * 8192, pa[0][0], pa[0][1], pa[0][2], pa[0][3]);
    if (tb >= 2) nsa::pv(o, vb0 + (2 + ch) * 8192, pa[1][0], pa[1][1], pa[1][2], pa[1][3]);
    LAS float* ostg = (LAS float*)(lds + G_OST) + wid * 2048;
#pragma unroll
    for (int r = 0; r < 16; ++r) { const int orow = crow(r, hi);
#pragma unroll
        for (int d0 = 0; d0 < 2; ++d0) ostg[orow * 64 + d0 * 32 + r32] = o[d0][r]; }
    asm volatile("s_waitcnt lgkmcnt(0)" ::: "memory");
#pragma unroll
    for (int i = 0; i < 4; ++i) { const int row = i * 8 + (lane >> 3), c8 = lane & 7, t = 32 * tb + row;
        const f32x4_t v0 = *(LAS const f32x4_t*)(ostg + row * 64 + c8 * 8), v1 = *(LAS const f32x4_t*)(ostg + row * 64 + c8 * 8 + 4);
        const size_t grow = (size_t)(m0 + t); const int col = g * 128 + 64 * ch + 8 * c8;
        float uf[8]; unpack8(in.uraw[i], uf);
        const float sb_ = in.sbv[i];
        u32x4_t w; w.x = cvtpk_s(uf[0] * (v0[0] + sb_), uf[1] * (v0[1] + sb_)); w.y = cvtpk_s(uf[2] * (v0[2] + sb_), uf[3] * (v0[3] + sb_));
        w.z = cvtpk_s(uf[4] * (v1[0] + sb_), uf[5] * (v1[1] + sb_)); w.w = cvtpk_s(uf[6] * (v1[2] + sb_), uf[7] * (v1[3] + sb_));
        *(u32x4_t*)(AB + grow * 2048 + 1024 + col) = w; }
    asm volatile("s_waitcnt lgkmcnt(0)\n\ts_barrier" ::: "memory");
}
__device__ __forceinline__ void gmlp_run(const Ptrs& P, LAS unsigned char* lds, int u0, int stride, int nunits, const int wave_s) {
    const int lane = fresh_lane(), r32 = lane & 31, hi = lane >> 5, wid = wave_s, tid = wid * 64 + lane;
    GmlpIn A, B;
    int u = u0;
    bf16x8 pa[2][4];
    { const bf16_t* SWB = (const bf16_t*)(P.ws + WS_SMALL + SM_SWB) + (size_t)(u0 & 7) * 16384; const int tb = wid >> 1;
#pragma unroll
      for (int st_ = 0; st_ < 2; ++st_)
#pragma unroll
        for (int ks = 0; ks < 4; ++ks) {
            const bf16_t* wp = SWB + (size_t)(32 * tb + r32) * 128 + 64 * st_ + 16 * ks + 4 * hi;
            const u32x2_t lo = *(const u32x2_t*)wp, hi2 = *(const u32x2_t*)(wp + 8);
            const u32x4_t wv = {lo.x, lo.y, hi2.x, hi2.y}; pa[st_][ks] = __builtin_bit_cast(bf16x8, wv); } }
    const int c8v = tid & 15, g0 = u0 & 7;
    const f32x4_t w0 = *(const f32x4_t*)(P.in[8] + g0 * 128 + 8 * c8v), w1 = *(const f32x4_t*)(P.in[8] + g0 * 128 + 8 * c8v + 4), b0 = *(const f32x4_t*)(P.in[9] + g0 * 128 + 8 * c8v), b1 = *(const f32x4_t*)(P.in[9] + g0 * 128 + 8 * c8v + 4);
    const float* VSTAT = (const float*)(P.ws + WS_VSTAT);
#define GMLP_STATS(sv_, unit_) do { const int m0_ = ((unit_) >> 8) * SEQ + (((unit_) >> 3) & 31) * 128; const f32x4_t* p_ = (const f32x4_t*)(VSTAT + (size_t)(m0_ + (tid & 127)) * 32); \
        _Pragma("unroll") for (int i_ = 0; i_ < 8; ++i_) sv_[i_] = p_[i_]; } while (0)
    f32x4_t sv[8];
    if (u < nunits) gmlp_load(A, P, u, tid, lane, r32, hi, wid);
    while (u < nunits) {
        GMLP_STATS(sv, u);
        if (u + stride < nunits) gmlp_load(B, P, u + stride, tid, lane, r32, hi, wid);
        gmlp_compute(A, sv, pa, w0, w1, b0, b1, P, lds, u, tid, lane, r32, hi, wid);
        u += stride; if (u >= nunits) break;
        GMLP_STATS(sv, u);
        if (u + stride < nunits) gmlp_load(A, P, u + stride, tid, lane, r32, hi, wid);
        gmlp_compute(B, sv, pa, w0, w1, b0, b1, P, lds, u, tid, lane, r32, hi, wid);
        u += stride;
    }
#undef GMLP_STATS
    asm volatile("s_waitcnt vmcnt(0) lgkmcnt(0)\n\ts_barrier" ::: "memory");
}
#undef P2_WAIT_BAR
}

#define XB_TMO      128
#define XB_XCNT(j)  (256  + 64 * (j))
#define XB_XSUB(j)  (1280 + 64 * (j))
#define XB_XGEN(j)  (2304 + 64 * (j))
#define XB_TOP      3328
#define XB_TOPGEN   3392
#define XCD_BAR_WORDS 3456
#define XB_SPIN_CAP (1u << 18)

__device__ __forceinline__ unsigned xb_ld(unsigned* p)              { return __hip_atomic_load(p, __ATOMIC_RELAXED, __HIP_MEMORY_SCOPE_AGENT); }
__device__ __forceinline__ unsigned xb_add(unsigned* p, unsigned v) { return __hip_atomic_fetch_add(p, v, __ATOMIC_RELAXED, __HIP_MEMORY_SCOPE_AGENT); }
__device__ __forceinline__ unsigned xb_xcc_id() { return (unsigned)__builtin_amdgcn_s_getreg((3 << 11) | 20) & 0xFu; }
#define XB_SPIN(cond, bar) do { unsigned _sp = 0; while (cond) { __builtin_amdgcn_s_sleep(1); \
    if ((++_sp & 255u) == 0u) { if (xb_ld(&(bar)[XB_TMO])) break; if (_sp > XB_SPIN_CAP) { atomicAdd(&(bar)[XB_TMO], 1u); break; } } } } while (0)

struct XcdBarrier {
    unsigned* bar; unsigned x; unsigned w0;
    volatile LAS unsigned* st;
};

__device__ __forceinline__ XcdBarrier xcd_barrier_post(unsigned* bar, volatile LAS unsigned* st, int wave_s) {
    XcdBarrier b; b.bar = bar; b.x = xb_xcc_id(); b.st = st; b.w0 = wave_s == 0 ? 1u : 0u;
    if (b.w0 && fresh_lane() == 0) (void)xb_add(&bar[XB_XCNT(b.x)], 1u);
    return b;
}
__device__ __forceinline__ void xcd_barrier_complete(unsigned* bar, unsigned x, unsigned& nloc, unsigned& nx) {
    const unsigned G = gridDim.x * gridDim.y * gridDim.z;
    unsigned sum, cnt, mine, sp = 0u;
    for (;;) {
        sum = 0u; cnt = 0u; mine = 0u;
#pragma unroll
        for (unsigned j = 0; j < 16; ++j) { const unsigned c = xb_ld(&bar[XB_XCNT(j)]); sum += c; cnt += (c > 0u) ? 1u : 0u; mine = (j == x) ? c : mine; }
        if (sum == G) break;
        __builtin_amdgcn_s_sleep(1);
        if ((++sp & 255u) == 0u) { if (xb_ld(&bar[XB_TMO])) break; if (sp > XB_SPIN_CAP) { atomicAdd(&bar[XB_TMO], 1u); break; } }
    }
    nloc = mine > 0u ? mine : 1u; nx = cnt > 0u ? cnt : 1u;
}

__device__ __forceinline__ void xcd_barrier(const XcdBarrier& b) {
    asm volatile("s_waitcnt vmcnt(0)" ::: "memory");
    __syncthreads();
    if (b.w0 && fresh_lane() == 0) {
        unsigned* bar = b.bar;
        __builtin_amdgcn_s_waitcnt(0);
        unsigned nloc = b.st[0], nx = b.st[1];
        if (nloc == 0u) { xcd_barrier_complete(bar, b.x, nloc, nx); b.st[0] = nloc; b.st[1] = nx; }
        const unsigned old = xb_add(&bar[XB_XSUB(b.x)], 1u);
        const unsigned gen = old / nloc;
        if (old + 1u == (gen + 1u) * nloc) {
            __builtin_amdgcn_fence(__ATOMIC_RELEASE, "agent");
            asm volatile("s_waitcnt vmcnt(0)" ::: "memory");
            const unsigned og = xb_add(&bar[XB_TOP], 1u);
            const unsigned tg = og / nx;
            if (og + 1u == (tg + 1u) * nx) xb_add(&bar[XB_TOPGEN], 1u);
            else XB_SPIN(xb_ld(&bar[XB_TOPGEN]) == tg, bar);
            __builtin_amdgcn_fence(__ATOMIC_ACQUIRE, "agent");
            xb_add(&bar[XB_XGEN(b.x)], 1u);
            asm volatile("s_waitcnt vmcnt(0)" ::: "memory");
        } else {
            XB_SPIN(xb_ld(&bar[XB_XGEN(b.x)]) == gen, bar);
            __builtin_amdgcn_fence(__ATOMIC_ACQUIRE, "agent");
            asm volatile("s_waitcnt vmcnt(0)" ::: "memory");
        }
    }
    __syncthreads();
}

constexpr int LDS_BYTES = 147456;
constexpr int LDS_XCH = 132096;
constexpr int LDS_MISC = 145408;
__global__ void __launch_bounds__(512, 2) mega_fwd(Ptrs P) {
    extern __shared__ __attribute__((aligned(16))) unsigned char lds_raw[];
    LAS unsigned char* lds = (LAS unsigned char*)lds_raw;
    unsigned char* ws = P.ws;
    const int wave = __builtin_amdgcn_readfirstlane(threadIdx.x >> 6);
    const int G = gridDim.x, bid = blockIdx.x;
    if (wave == 0) { const int l_ = fresh_lane(); if (l_ < 2) ((LAS unsigned*)(lds + LDS_MISC))[l_] = 0u; }
    __syncthreads();
    const XcdBarrier bar = xcd_barrier_post((unsigned*)(ws + WS_CTL), (volatile LAS unsigned*)(lds + LDS_MISC), wave);
    p0_prologue(P, lds, bid, G, wave);
    xcd_barrier(bar);
    if (bid == 0) bias1_stage(ws, fresh_tid(wave));
    {
        pg8::Gemm g{(const bf16_t*)(ws + WS_XN), (const bf16_t*)(ws + WS_WIN), MTOK, NPROJ, 2048, 2048};
        pg8::StaticOrder S; S.init(MTOK, NPROJ, G, bid);
        pg8::EpiProj E{(bf16_t*)(ws + WS_Q), (bf16_t*)(ws + WS_KV6), (bf16_t*)(ws + WS_U), (bf16_t*)(ws + WS_GV), (float*)(ws + WS_GATES), (float*)(ws + WS_VSTAT), P.in[3], P.in[4]};
        pg8::gemm_phase<pg8::EpiProj, pg8::StaticOrder, true, true>(lds, g, S, E, wave);
    }
    xcd_barrier(bar);
    if (bid < 128 && G >= 256) p2::compress_unit(P, lds, bid, wave);
    else if (G >= 256) p2::gmlp_run(P, lds, bid - 128, G - 128, 1024, wave);
    xcd_barrier(bar);
    nsa::nsa_phase(P, lds, bid, G, wave);
    xcd_barrier(bar);
    {
        pg8::Gemm g{(const bf16_t*)(ws + WS_AB), (const bf16_t*)(ws + WS_WOUT), MTOK, 2048, 2048, 2048};
        pg8::StaticOrder S; S.init(MTOK, 2048, G, bid);
        pg8::EpiRes1 E{(const float*)(ws + WS_SMALL + SM_RINV), (const float*)(ws + WS_SMALL + SM_INVW), (bf16_t*)(ws + WS_XN), (float*)(ws + WS_SSQ)};
        pg8::gemm_phase<pg8::EpiRes1, pg8::StaticOrder, true, true>(lds, g, S, E, wave);
    }
    xcd_barrier(bar);
    for (int m = bid * 512 + fresh_tid(wave); m < MTOK; m += G * 512) {
        const float* p = (const float*)(ws + WS_SSQ) + (size_t)m * 32; float s = 0.f;
#pragma unroll
        for (int i = 0; i < 32; ++i) s += p[i];
        ((float*)(ws + WS_SMALL + SM_R2))[m] = __builtin_amdgcn_rsqf(s * (1.0f / D_MODEL) + 1e-6f);
    }
    xcd_barrier(bar);
    {
        pg8::Gemm g{(const bf16_t*)(ws + WS_XN), (const bf16_t*)(ws + WS_WUP), MTOK, N_UP, 2048, 2048};
        pg8::StaticOrder S; S.init(MTOK, N_UP, G, bid);
        pg8::EpiUpConv E{(bf16_t*)(ws + WS_G), (const float*)(ws + WS_SMALL + SM_R2), P.in[15], P.in[16], (float*)(ws + WS_HLAST), (float*)(ws + WS_FIRST), lds + LDS_XCH};
        pg8::gemm_phase<pg8::EpiUpConv, pg8::StaticOrder, true, true>(lds, g, S, E, wave);
    }
    xcd_barrier(bar);
    for (int it = bid * 512 + fresh_tid(wave); it < 60 * 44 * 2 * 16; it += G * 512) {
        const int c8 = it & 15, row = (it >> 4) & 1, tl_ = it >> 5, pn = tl_ % 44, pmi = tl_ / 44, pm = pmi + pmi / 15 + 1;
        const float* cw = P.in[15]; const float* cb = P.in[16]; (void)cb;
        const float* fp = (const float*)(ws + WS_FIRST) + ((size_t)(pm * 44 + pn) * 2 + row) * 256 + 8 * c8;
        const float* lp = (const float*)(ws + WS_HLAST) + ((size_t)((pm - 1) * 44 + pn) * 2) * 256 + 8 * c8;
        const int ch = pn * 128 + 8 * c8;
        float r[8];
#pragma unroll
        for (int e = 0; e < 8; ++e) {
            const float l0g = lp[e], l1g = lp[256 + e], l0u = lp[128 + e], l1u = lp[256 + 128 + e];
            const float w0g = cw[ch + e], w1g = cw[N_UP + ch + e], w0u = cw[D_FF + ch + e], w1u = cw[N_UP + D_FF + ch + e];
            const float cg = fp[e] + (row == 0 ? w1g * l1g + w0g * l0g : w0g * l1g), cu = fp[128 + e] + (row == 0 ? w1u * l1u + w0u * l0u : w0u * l1u);
            r[e] = cg * sigmoidf_(cg) * cu;
        }
        u32x4_t o; o.x = pk2(r[0], r[1]); o.y = pk2(r[2], r[3]); o.z = pk2(r[4], r[5]); o.w = pk2(r[6], r[7]);
        *(u32x4_t*)((bf16_t*)(ws + WS_G) + (size_t)(pm * 256 + row) * D_FF + ch) = o;
    }
    xcd_barrier(bar);
    {
        pg8::Gemm g{(const bf16_t*)(ws + WS_G), (const bf16_t*)(ws + WS_WDOWN), MTOK, 2048, D_FF, D_FF};
        pg8::StaticOrder S; S.init(MTOK, 2048, G, bid);
        pg8::EpiDown E{P.out, (const bf16_t*)(ws + WS_XN)};
        pg8::gemm_phase<pg8::EpiDown, pg8::StaticOrder, true, true>(lds, g, S, E, wave);
    }
}

extern "C" void kernel_launch(void* const* d_in, const int* in_sizes, int n_in, void* d_out, int out_size, void* d_ws, size_t ws_size, hipStream_t stream) {
    static int grid_blocks = 0;
    if (!grid_blocks) {
        int dev = 0, cus = 0, per_cu = 0;
        (void)hipGetDevice(&dev);
        (void)hipDeviceGetAttribute(&cus, hipDeviceAttributeMultiprocessorCount, dev);
        (void)hipFuncSetAttribute((const void*)mega_fwd, hipFuncAttributeMaxDynamicSharedMemorySize, LDS_BYTES);
        (void)hipOccupancyMaxActiveBlocksPerMultiprocessor(&per_cu, (const void*)mega_fwd, 512, LDS_BYTES);
        if (per_cu < 1) { fprintf(stderr, "kernel_launch: occupancy query says %d blocks/CU\n", per_cu); per_cu = 1; }
        grid_blocks = cus * 1;
        (void)hipGetLastError();
    }
    if (n_in != 18 || ws_size < WS_END) { fprintf(stderr, "kernel_launch: unexpected n_in %d / ws %zu\n", n_in, ws_size); return; }
    Ptrs P{};
    for (int i = 0; i < 18; ++i) P.in[i] = (const float*)d_in[i];
    P.out = (float*)d_out; P.ws = (unsigned char*)d_ws;
    (void)hipMemsetAsync((char*)d_ws + WS_CTL, 0, 16384, stream);
    mega_fwd<<<dim3(grid_blocks), dim3(512), LDS_BYTES, stream>>>(P);
}
```

```cpp
#include <hip/hip_runtime.h>
#include <cstdio>
#include <cstdint>

constexpr int D_MODEL = 2048, BATCH = 4, SEQ = 4096, MTOK = BATCH * SEQ;
constexpr int IN_COLS = 4656, NPROJ = 4864;
constexpr int D_FF = 5632, N_UP = 2 * D_FF;
constexpr int NBG = 16;
constexpr size_t KVSZ = (size_t)NBG * SEQ * 64;
constexpr float LOG2E = 1.4426950408889634f;

constexpr size_t MiB = 1u << 20;
constexpr size_t WS_CTL = 0;
constexpr size_t WS_WIN = 1 * MiB, WS_WOUT = 20 * MiB, WS_WUP = 28 * MiB, WS_WDOWN = 72 * MiB, WS_W1C = 94 * MiB;
constexpr size_t WS_SMALL = 96 * MiB;
constexpr size_t SM_BIASP = 0, SM_BIAS1 = 65536, SM_R2 = 131072, SM_W2T = 196608  , SM_SWB = 262144  , SM_RINV = 524288  , SM_INVW = 589824  ;
constexpr size_t WS_XN = 97 * MiB;
constexpr size_t WS_Q = 161 * MiB;
constexpr size_t WS_KV6 = 193 * MiB;
constexpr size_t WS_U = 241 * MiB, WS_GV = 273 * MiB;
constexpr size_t WS_GATES = 305 * MiB;
constexpr size_t WS_VSTAT = 308 * MiB;
constexpr size_t WS_KC = 310 * MiB, WS_VC = 310 * MiB + 524288;
constexpr size_t WS_HC = 311 * MiB;
constexpr size_t WS_AB = 315 * MiB;
constexpr size_t WS_SSQ = 379 * MiB;
constexpr size_t WS_G = 161 * MiB;
constexpr size_t WS_HID = 381 * MiB;
constexpr size_t WS_HLAST = 381 * MiB, WS_FIRST = 388 * MiB;
constexpr size_t WS_END = 469 * MiB;

#define LAS __attribute__((address_space(3)))
typedef unsigned short bf16_t;
typedef unsigned u32x4_t __attribute__((ext_vector_type(4)));
typedef unsigned u32x2_t __attribute__((ext_vector_type(2)));
typedef float f32x4_t __attribute__((ext_vector_type(4)));

__device__ __forceinline__ float bf2f(unsigned short h) { return __uint_as_float(((unsigned)h) << 16); }
__device__ __forceinline__ unsigned f2bf(float f) { unsigned u = __float_as_uint(f); return (u + 0x7fffu + ((u >> 16) & 1u)) >> 16; }
__device__ __forceinline__ unsigned pk2(float lo, float hi) { return f2bf(lo) | (f2bf(hi) << 16); }
__device__ __forceinline__ float gelu_tanh(float x) {
    const float u = 0.7978845608028654f * (x + 0.044715f * x * x * x);
    const float e = __builtin_amdgcn_exp2f(-2.8853900817779268f * u);
    return x * __builtin_amdgcn_rcpf(1.0f + e);
}
__device__ __forceinline__ float sigmoidf_(float x) { return __builtin_amdgcn_rcpf(1.0f + __builtin_amdgcn_exp2f(-LOG2E * x)); }
__device__ __forceinline__ float wave_sum(float v) {
#pragma unroll
    for (int o = 1; o < 64; o <<= 1) v += __shfl_xor(v, o);
    return v;
}
__device__ __forceinline__ void unpack8(u32x4_t r, float (&f)[8]) {
    f[0] = __uint_as_float(r.x << 16); f[1] = __uint_as_float(r.x & 0xffff0000u);
    f[2] = __uint_as_float(r.y << 16); f[3] = __uint_as_float(r.y & 0xffff0000u);
    f[4] = __uint_as_float(r.z << 16); f[5] = __uint_as_float(r.z & 0xffff0000u);
    f[6] = __uint_as_float(r.w << 16); f[7] = __uint_as_float(r.w & 0xffff0000u);
}

__device__ __forceinline__ int fresh_lane() { unsigned z_ = 0u; asm volatile("" : "+v"(z_)); return (int)__builtin_amdgcn_mbcnt_hi(~0u, __builtin_amdgcn_mbcnt_lo(~0u, z_)); }
__device__ __forceinline__ int fresh_tid(int wave_s) { return wave_s * 64 + fresh_lane(); }
namespace pg8 {
#define PG8_LAS __attribute__((address_space(3)))
typedef unsigned short bf16_t;
typedef short bf16x8 __attribute__((ext_vector_type(8)));
typedef float f32x4 __attribute__((ext_vector_type(4)));
typedef unsigned u32x4 __attribute__((ext_vector_type(4)));
constexpr int BM = 256, BK = 64, HALF = 128, HTB = HALF * BK * 2  , STAGE_BYTES = 8 * HTB, NXCD = 8, WGM = 8;

__host__ __device__ __forceinline__ int lds_byte(int r, int c) { const int st = (r >> 4) * 2 + (c >> 5), rr = r & 15, cc = c & 31, ob = rr * 64 + cc * 2; return st * 1024 + (ob ^ (((ob >> 9) & 1) << 5)); }
__host__ __device__ __forceinline__ void stage_rc(int b, int& R, int& C) { const int st = b / 1024, sb = b % 1024, swz = sb ^ (((sb >> 9) & 1) << 5); R = (st >> 1) * 16 + swz / 64; C = (st & 1) * 32 + (swz % 64) / 2; }
__host__ __device__ __forceinline__ int perm32(int rho) { const int n = rho >> 4, i = rho & 15; return 8 * (i >> 2) + 4 * n + (i & 3); }

struct Unit { int pm, pn; };
struct Gemm { const bf16_t* A; const bf16_t* Bt; int M, N, K, lda; };

struct StaticOrder {
    int nM, nN, nwg, G, c;
    __host__ __device__ void init(int M, int N, int G_, int c_) { nM = M / BM; nN = N / BM; nwg = nM * nN; G = G_; c = c_; }
    __host__ __device__ bool next(int i, Unit& u) const {
        const long L = (long)i * G + c; if (L >= nwg) return false;
        int wgid = (int)L; { const int q = nwg / NXCD, r = nwg % NXCD, xcd = wgid % NXCD, off = wgid / NXCD; wgid = (xcd < r ? xcd * (q + 1) : r * (q + 1) + (xcd - r) * q) + off; }
        const int nig = WGM * nN, gid = wgid / nig, fm = gid * WGM, gsz = (nM - fm) < WGM ? (nM - fm) : WGM;
        u.pm = fm + ((wgid % nig) % gsz); u.pn = (wgid % nig) / gsz; return true;
    }
    __device__ __forceinline__ void a_ready(const Unit&) const {}
    __device__ __forceinline__ void done(const Unit&) const {}
};

__device__ __forceinline__ unsigned cvt_pk_bf16(float lo, float hi) { unsigned r; asm volatile("v_cvt_pk_bf16_f32 %0, %1, %2" : "=v"(r) : "v"(lo), "v"(hi)); return r; }

struct EpiProj {
    static constexpr bool PERM = true, AFTER_DRAIN = false, PERMA = false;
    bf16_t* Q; bf16_t* KV6; bf16_t* U; bf16_t* GV; float* GATES; float* VSTAT; const float* q_norm_w; const float* k_norm_w;
    __device__ __forceinline__ void operator()(const f32x4 (&acc)[2][2][4][2], const Unit& u, int wr, int wc, int fr, int fq) const {
        const int pn = u.pn, row0 = u.pm * BM + wr * 64 + fr;
        if (pn < 10) {
            const bool normed = (pn < 4) || pn == 6 || pn == 8;
            const float* w = pn < 4 ? q_norm_w : (k_norm_w + (pn == 6 ? 64 : 128));
            const float sc = pn < 4 ? 0.125f * LOG2E : 1.0f;
            f32x4 wv[2][2];
#pragma unroll
            for (int bj = 0; bj < 2; ++bj)
#pragma unroll
                for (int n = 0; n < 2; ++n) wv[bj][n] = normed ? (*(const f32x4*)(w + 32 * bj + 8 * fq + 4 * n)) * sc : (f32x4){1.f, 1.f, 1.f, 1.f};
#pragma unroll
            for (int ai = 0; ai < 2; ++ai)
#pragma unroll
                for (int m = 0; m < 4; ++m) {
                    const int row = row0 + ai * HALF + m * 16;
                    float r = 1.f;
                    if (normed) {
                        float ss = 0.f;
#pragma unroll
                        for (int bj = 0; bj < 2; ++bj)
#pragma unroll
                            for (int n = 0; n < 2; ++n) { const f32x4 x = acc[ai][bj][m][n]; ss += (x[0] * x[0] + x[1] * x[1]) + (x[2] * x[2] + x[3] * x[3]); }
                        ss += __shfl_xor(ss, 16); ss += __shfl_xor(ss, 32);
                        r = __builtin_amdgcn_rsqf(ss * (1.0f / 64.0f) + 1e-6f);
                    }
                    bf16_t* dst;
                    if (pn < 4) dst = Q + (size_t)row * 1024 + pn * 256 + wc * 64 + 8 * fq;
                    else { const int b = row >> 12, t = row & 4095; dst = KV6 + (size_t)(pn - 4) * KVSZ + ((size_t)((b * 4 + wc) * 4096 + t)) * 64 + 8 * fq; }
#pragma unroll
                    for (int bj = 0; bj < 2; ++bj) {
                        const f32x4 v0 = acc[ai][bj][m][0] * r * wv[bj][0], v1 = acc[ai][bj][m][1] * r * wv[bj][1];
                        u32x4 o; o.x = cvt_pk_bf16(v0[0], v0[1]); o.y = cvt_pk_bf16(v0[2], v0[3]); o.z = cvt_pk_bf16(v1[0], v1[1]); o.w = cvt_pk_bf16(v1[2], v1[3]);
                        *(u32x4*)(dst + 32 * bj) = o;
                    }
                }
        } else if (pn < 18) {
            const bool isv = pn >= 14; const int ct = isv ? pn - 14 : pn - 10;
            bf16_t* base = (isv ? GV : U) + ct * 256 + wc * 64 + 8 * fq;
#pragma unroll
            for (int ai = 0; ai < 2; ++ai)
#pragma unroll
                for (int m = 0; m < 4; ++m) {
                    const int row = row0 + ai * HALF + m * 16; float s1 = 0.f, s2 = 0.f;
#pragma unroll
                    for (int bj = 0; bj < 2; ++bj) {
                        f32x4 v0 = acc[ai][bj][m][0], v1 = acc[ai][bj][m][1];
#pragma unroll
                        for (int e = 0; e < 4; ++e) { v0[e] = gelu_tanh(v0[e]); v1[e] = gelu_tanh(v1[e]); s1 += v0[e] + v1[e]; s2 += v0[e] * v0[e] + v1[e] * v1[e]; }
                        u32x4 o; o.x = cvt_pk_bf16(v0[0], v0[1]); o.y = cvt_pk_bf16(v0[2], v0[3]); o.z = cvt_pk_bf16(v1[0], v1[1]); o.w = cvt_pk_bf16(v1[2], v1[3]);
                        *(u32x4*)(base + (size_t)row * 1024 + 32 * bj) = o;
                    }
                    if (isv) {
                        s1 += __shfl_xor(s1, 16); s1 += __shfl_xor(s1, 32); s2 += __shfl_xor(s2, 16); s2 += __shfl_xor(s2, 32);
                        if (fq == 0) { float* p = VSTAT + ((size_t)row * 16 + ct * 4 + wc) * 2; p[0] = s1; p[1] = s2; }
                    }
                }
        } else {
            if (wc == 0) {
#pragma unroll
                for (int ai = 0; ai < 2; ++ai)
#pragma unroll
                    for (int m = 0; m < 4; ++m) {
                        const int row = row0 + ai * HALF + m * 16;
#pragma unroll
                        for (int bj = 0; bj < 2; ++bj)
#pragma unroll
                            for (int n = 0; n < 2; ++n) {
                                const int L = 32 * bj + 8 * fq + 4 * n;
                                if (L < 48) { f32x4 v = acc[ai][bj][m][n]; f32x4 o; o[0] = sigmoidf_(v[0]); o[1] = sigmoidf_(v[1]); o[2] = sigmoidf_(v[2]); o[3] = sigmoidf_(v[3]); *(f32x4*)(GATES + (size_t)row * 48 + L) = o; }
                            }
                    }
            }
        }
    }
};
struct EpiCmp {
    static constexpr bool PERM = true, AFTER_DRAIN = false, PERMA = false;
    bf16_t* HC; const float* bias1;
    __device__ __forceinline__ void operator()(const f32x4 (&acc)[2][2][4][2], const Unit& u, int wr, int wc, int fr, int fq) const {
        const int row0 = u.pm * BM + wr * 64 + fr, col0 = wc * 32 + 8 * fq;
        f32x4 bv[2][2];
#pragma unroll
        for (int bj = 0; bj < 2; ++bj)
#pragma unroll
            for (int n = 0; n < 2; ++n) bv[bj][n] = *(const f32x4*)(bias1 + u.pn * 256 + col0 + bj * HALF + 4 * n);
#pragma unroll
        for (int ai = 0; ai < 2; ++ai)
#pragma unroll
            for (int m = 0; m < 4; ++m) { bf16_t* rowp = HC + (size_t)(row0 + ai * HALF + m * 16) * 256 + col0;
#pragma unroll
                for (int bj = 0; bj < 2; ++bj) { f32x4 v0 = acc[ai][bj][m][0] + bv[bj][0], v1 = acc[ai][bj][m][1] + bv[bj][1];
#pragma unroll
                    for (int e = 0; e < 4; ++e) { v0[e] = gelu_tanh(v0[e]); v1[e] = gelu_tanh(v1[e]); }
                    u32x4 o; o.x = cvt_pk_bf16(v0[0], v0[1]); o.y = cvt_pk_bf16(v0[2], v0[3]); o.z = cvt_pk_bf16(v1[0], v1[1]); o.w = cvt_pk_bf16(v1[2], v1[3]);
                    *(u32x4*)(rowp + bj * HALF) = o; } }
    }
};
struct CmpOrder {
    int c, G;
    __device__ bool next(int i, Unit& u) const { const int L = i * G + c; if (L >= 32) return false; u.pm = L; u.pn = L >> 4; return true; }
    __device__ __forceinline__ void a_ready(const Unit&) const {}
    __device__ __forceinline__ void done(const Unit&) const {}
};
struct EpiRes1 {
    static constexpr bool PERM = false, AFTER_DRAIN = false, PERMA = false;
    const float* RINV; const float* INVW; bf16_t* X1b; float* SSQ;
    __device__ __forceinline__ void operator()(const f32x4 (&acc)[2][2][4][2], const Unit& u, int wr, int wc, int fr, int fq) const {
        const int row0 = u.pm * BM + wr * 64 + fr, col0 = u.pn * BM + wc * 32 + 4 * fq;
        f32x4 iw[2][2];
#pragma unroll
        for (int bj = 0; bj < 2; ++bj)
#pragma unroll
            for (int n = 0; n < 2; ++n) iw[bj][n] = *(const f32x4*)(INVW + col0 + bj * HALF + n * 16);
#pragma unroll
        for (int ai = 0; ai < 2; ++ai) {
            u32x2_t xin[4][2][2]; float ri[4];
#pragma unroll
            for (int m = 0; m < 4; ++m) { ri[m] = RINV[row0 + ai * HALF + m * 16];
#pragma unroll
                for (int bj = 0; bj < 2; ++bj)
#pragma unroll
                    for (int n = 0; n < 2; ++n) xin[m][bj][n] = *(const u32x2_t*)(X1b + (size_t)(row0 + ai * HALF + m * 16) * D_MODEL + col0 + bj * HALF + n * 16); }
            __builtin_amdgcn_sched_barrier(0);
#pragma unroll
            for (int m = 0; m < 4; ++m) { const int row = row0 + ai * HALF + m * 16; const size_t off = (size_t)row * D_MODEL + col0; float ss = 0.f;
#pragma unroll
                for (int bj = 0; bj < 2; ++bj)
#pragma unroll
                    for (int n = 0; n < 2; ++n) { const u32x2_t w_ = xin[m][bj][n];
                        f32x4 xv; xv[0] = __uint_as_float(w_.x << 16); xv[1] = __uint_as_float(w_.x & 0xffff0000u); xv[2] = __uint_as_float(w_.y << 16); xv[3] = __uint_as_float(w_.y & 0xffff0000u);
                        const f32x4 v = xv * ri[m] * iw[bj][n] + acc[ai][bj][m][n];
                        ss += (v[0] * v[0] + v[1] * v[1]) + (v[2] * v[2] + v[3] * v[3]);
                        u32x2_t w; w.x = cvt_pk_bf16(v[0], v[1]); w.y = cvt_pk_bf16(v[2], v[3]); *(u32x2_t*)(X1b + off + bj * HALF + n * 16) = w; }
                ss += __shfl_xor(ss, 16); ss += __shfl_xor(ss, 32);
                if (fq == 0) SSQ[(size_t)row * 32 + u.pn * 4 + wc] = ss; }
            __builtin_amdgcn_sched_barrier(0);
        }
    }
};
struct EpiUpV1 {
    static constexpr bool PERM = true, AFTER_DRAIN = false, PERMA = false;
    bf16_t* HID; const float* R2;
    __device__ __forceinline__ void operator()(const f32x4 (&acc)[2][2][4][2], const Unit& u, int wr, int wc, int fr, int fq) const {
        const int row0 = u.pm * BM + wr * 64 + fr, col0 = u.pn * BM + wc * 32 + 8 * fq;
#pragma unroll
        for (int ai = 0; ai < 2; ++ai)
#pragma unroll
            for (int m = 0; m < 4; ++m) { const int row = row0 + ai * HALF + m * 16; const float r = R2[row]; bf16_t* rowp = HID + (size_t)row * N_UP + col0;
#pragma unroll
                for (int bj = 0; bj < 2; ++bj) { const f32x4 v0 = acc[ai][bj][m][0] * r, v1 = acc[ai][bj][m][1] * r;
                    u32x4 o; o.x = cvt_pk_bf16(v0[0], v0[1]); o.y = cvt_pk_bf16(v0[2], v0[3]); o.z = cvt_pk_bf16(v1[0], v1[1]); o.w = cvt_pk_bf16(v1[2], v1[3]);
                    *(u32x4*)(rowp + bj * HALF) = o; } }
    }
};
struct EpiDown {
    static constexpr bool PERM = false, AFTER_DRAIN = false, PERMA = false;
    float* out; const bf16_t* X1b;
    __device__ __forceinline__ void operator()(const f32x4 (&acc)[2][2][4][2], const Unit& u, int wr, int wc, int fr, int fq) const {
        const int row0 = u.pm * BM + wr * 64 + fr, col0 = u.pn * BM + wc * 32 + 4 * fq;
#pragma unroll
        for (int ai = 0; ai < 2; ++ai) {
            u32x2_t xin[4][2][2];
#pragma unroll
            for (int m = 0; m < 4; ++m)
#pragma unroll
                for (int bj = 0; bj < 2; ++bj)
#pragma unroll
                    for (int n = 0; n < 2; ++n) xin[m][bj][n] = *(const u32x2_t*)(X1b + (size_t)(row0 + ai * HALF + m * 16) * D_MODEL + col0 + bj * HALF + n * 16);
            __builtin_amdgcn_sched_barrier(0);
#pragma unroll
            for (int m = 0; m < 4; ++m) { const size_t off = (size_t)(row0 + ai * HALF + m * 16) * D_MODEL + col0;
#pragma unroll
                for (int bj = 0; bj < 2; ++bj)
#pragma unroll
                    for (int n = 0; n < 2; ++n) { const u32x2_t w = xin[m][bj][n];
                        f32x4 v; v[0] = __uint_as_float(w.x << 16); v[1] = __uint_as_float(w.x & 0xffff0000u); v[2] = __uint_as_float(w.y << 16); v[3] = __uint_as_float(w.y & 0xffff0000u);
                        *(f32x4*)(out + off + bj * HALF + n * 16) = v + acc[ai][bj][m][n]; } }
            __builtin_amdgcn_sched_barrier(0);
        }
    }
};
__device__ __forceinline__ unsigned f2bf_(float f) { unsigned u = __float_as_uint(f); return (u + 0x7fffu + ((u >> 16) & 1u)) >> 16; }
typedef float f32x2 __attribute__((ext_vector_type(2)));
struct EpiUpConv {
    static constexpr bool PERM = true, AFTER_DRAIN = false, PERMA = true;
    bf16_t* G; const float* R2; const float* cw; const float* cb; float* HLAST; float* FIRST; PG8_LAS unsigned char* xlds;
    __device__ __forceinline__ void prefetch(const Unit& u, int par, const int wave_s) const {
        const int lane_ = fresh_lane();
        PG8_LAS float* Wl = (PG8_LAS float*)xlds + (par ? 3344 : 2048);
#pragma unroll
        for (int i2 = 0; i2 < 2; ++i2) { const int i = wave_s * 64 + lane_ + 512 * i2, k = i >> 8, p = i & 255, c = (p < 128 ? 0 : D_FF - 128) + u.pn * 128 + p;
            const float* src = k < 3 ? cw + (unsigned)(k * N_UP + c) : cb + (unsigned)c;
            __builtin_amdgcn_global_load_lds((const unsigned*)src, (PG8_LAS unsigned*)(Wl + wave_s * 64 + 512 * i2), 4, 0, 0); }
        if (wave_s < 4) __builtin_amdgcn_global_load_lds((const unsigned*)(R2 + u.pm * BM + wave_s * 64 + lane_), (PG8_LAS unsigned*)(Wl + 1024 + wave_s * 64), 4, 0, 0);
    }
    __device__ __forceinline__ void run(const f32x4 (&acc)[2][2][4][2], const Unit& u, const Unit& nxt, const bool has_next, const int par, int wr, int wc, const int wave_s) const {
        unsigned z_ = 0u; asm volatile("" : "+v"(z_));
        const int lane_ = (int)__builtin_amdgcn_mbcnt_hi(~0u, __builtin_amdgcn_mbcnt_lo(~0u, z_)); const int fr = lane_ & 15, fq = lane_ >> 4;
        const int row0 = u.pm * BM + wr * 64 + 4 * fr;
        PG8_LAS float* X = (PG8_LAS float*)xlds;
        PG8_LAS float* Wl = X + (par ? 3344 : 2048);
        PG8_LAS float* R2L = Wl + 1024;
        const unsigned tile = (unsigned)(u.pm * (N_UP / 256) + u.pn);
        asm volatile("s_waitcnt vmcnt(8)" ::: "memory"); __builtin_amdgcn_s_barrier(); asm volatile("" ::: "memory");
        if (has_next) prefetch(nxt, par ^ 1, wave_s);
        if (fr == 15) {
#pragma unroll
            for (int ai = 0; ai < 2; ++ai) { const int sg = 2 * ai + wr; const float r2a = R2L[ai * HALF + wr * 64 + 62], r2b = R2L[ai * HALF + wr * 64 + 63];
#pragma unroll
                for (int mm = 0; mm < 2; ++mm)
#pragma unroll
                for (int bj = 0; bj < 2; ++bj)
#pragma unroll
                    for (int n = 0; n < 2; ++n) { const f32x4 h = acc[ai][bj][2 + mm][n] * (mm ? r2b : r2a);
                        *(PG8_LAS f32x4*)(X + ((sg * 4 + wc) * 2 + mm) * 64 + bj * 32 + 8 * fq + 4 * n) = h;
                        if (ai == 1 && wr == 1) *(f32x4*)(HLAST + (unsigned)((tile * 2 + mm) * 256 + bj * HALF + wc * 32 + 8 * fq + 4 * n)) = h; } }
        }
        asm volatile("s_waitcnt lgkmcnt(0)" ::: "memory"); __builtin_amdgcn_s_barrier(); asm volatile("" ::: "memory");
        const int cbase = u.pn * 128 + wc * 32 + 8 * fq;
        const bool seq_start = (u.pm & 15) == 0;
#pragma unroll
        for (int ai = 0; ai < 2; ++ai) {
            const int sg = 2 * ai + wr;
            const f32x4 rs = *(PG8_LAS const f32x4*)(R2L + ai * HALF + wr * 64 + 4 * fr);
            const bool defer = (ai == 0) && (wr == 0) && !seq_start && (fr == 0);
#pragma unroll
            for (int n = 0; n < 2; ++n) {
                unsigned pk[4][2];
#pragma unroll
                for (int e2 = 0; e2 < 2; ++e2) {
                    asm volatile("" ::: "memory"); __builtin_amdgcn_sched_barrier(0);
                    PG8_LAS const f32x2* wp = (PG8_LAS const f32x2*)(Wl + wc * 32 + 8 * fq + 4 * n + 2 * e2);
                    const f32x2 wg0 = wp[0], wg1 = wp[128], wg2 = wp[256], bg = wp[384], wu0 = wp[64], wu1 = wp[192], wu2 = wp[320], bu = wp[448];
                    f32x2 hg1 = {0.f, 0.f}, hg2 = {0.f, 0.f}, hu1 = {0.f, 0.f}, hu2 = {0.f, 0.f};
                    if (ai == 1 || wr == 1) { PG8_LAS const f32x2* xp = (PG8_LAS const f32x2*)(X + (((sg - 1) * 4 + wc) * 2) * 64 + 8 * fq + 4 * n + 2 * e2); hg2 = xp[0]; hg1 = xp[32]; hu2 = xp[16]; hu1 = xp[48]; }
                    f32x2 vg[4], vu[4], cg[4], cu[4];
#pragma unroll
                    for (int m = 0; m < 4; ++m) { const f32x2 r2 = {rs[m], rs[m]};
                        vg[m] = (f32x2){acc[ai][0][m][n][2 * e2], acc[ai][0][m][n][2 * e2 + 1]} * r2; vu[m] = (f32x2){acc[ai][1][m][n][2 * e2], acc[ai][1][m][n][2 * e2 + 1]} * r2; }
#define EPI_SHR1(old_, v_) (f32x2){__uint_as_float(__builtin_amdgcn_update_dpp(__float_as_uint((old_).x), __float_as_uint((v_).x), 0x111, 0xf, 0xf, false)), __uint_as_float(__builtin_amdgcn_update_dpp(__float_as_uint((old_).y), __float_as_uint((v_).y), 0x111, 0xf, 0xf, false))}
                    const f32x2 pg1 = EPI_SHR1(hg1, vg[3]), pg2 = EPI_SHR1(hg2, vg[2]), pu1 = EPI_SHR1(hu1, vu[3]), pu2 = EPI_SHR1(hu2, vu[2]);
#undef EPI_SHR1
                    cg[0] = bg + wg0 * pg2 + wg1 * pg1 + wg2 * vg[0]; cu[0] = bu + wu0 * pu2 + wu1 * pu1 + wu2 * vu[0];
                    cg[1] = bg + wg0 * pg1 + wg1 * vg[0] + wg2 * vg[1]; cu[1] = bu + wu0 * pu1 + wu1 * vu[0] + wu2 * vu[1];
                    cg[2] = bg + wg0 * vg[0] + wg1 * vg[1] + wg2 * vg[2]; cu[2] = bu + wu0 * vu[0] + wu1 * vu[1] + wu2 * vu[2];
                    cg[3] = bg + wg0 * vg[1] + wg1 * vg[2] + wg2 * vg[3]; cu[3] = bu + wu0 * vu[1] + wu1 * vu[2] + wu2 * vu[3];
                    if (defer) {
#pragma unroll
                        for (int m = 0; m < 2; ++m) { float* fp = FIRST + (unsigned)((tile * 2 + m) * 256 + wc * 32 + 8 * fq + 4 * n + 2 * e2); *(f32x2*)fp = cg[m]; *(f32x2*)(fp + HALF) = cu[m]; }
                    }
#pragma unroll
                    for (int m = 0; m < 4; ++m) {
                        const f32x2 t = cg[m] * (f32x2){-LOG2E, -LOG2E};
                        f32x2 sg_ = {__builtin_amdgcn_exp2f(t.x), __builtin_amdgcn_exp2f(t.y)};
                        sg_ = sg_ + (f32x2){1.0f, 1.0f};
                        const f32x2 rc = {__builtin_amdgcn_rcpf(sg_.x), __builtin_amdgcn_rcpf(sg_.y)};
                        const f32x2 gv = cg[m] * rc * cu[m];
                        pk[m][e2] = cvt_pk_bf16(gv.x, gv.y);
                    }
                }
#pragma unroll
                for (int m = 0; m < 4; ++m)
                    if (!(m < 2 && defer)) { u32x2_t o; o.x = pk[m][0]; o.y = pk[m][1]; *(u32x2_t*)(G + (unsigned)((row0 + ai * HALF + m) * D_FF + cbase + 4 * n)) = o; }
            }
        }
    }
};
template <class Epi, class Sched, bool ALIGN_EPI = false, bool SP2 = false>
__device__ __forceinline__ void gemm_phase(PG8_LAS unsigned char* lds, const Gemm g, const Sched& S, const Epi& E, const int wave_s) {
    const int tid = fresh_tid(wave_s), wid = wave_s, lane = tid & 63,
          wr = wid >> 2, wc = wid & 3, fr = lane & 15, fq = lane >> 4;
    const int K = g.K, nt = K / BK;
    unsigned voffA[2], voffB[2];
#pragma unroll
    for (int i = 0; i < 2; ++i) { int R, C; stage_rc(tid * 16 + i * 8192, R, C); const int Rb = Epi::PERM ? ((R & ~31) + perm32(R & 31)) : R;
        const int Ra = Epi::PERMA ? ((R & ~63) + 4 * (R & 15) + ((R >> 4) & 3)) : R;
        voffA[i] = (unsigned)(Ra * g.lda + C) * 2u; voffB[i] = (unsigned)(Rb * K + C) * 2u; }
    const size_t kstep = (size_t)(BK * 2);
    const size_t hstepA = (size_t)HALF * g.lda * 2, hstepB = (size_t)HALF * K * 2;
    const size_t tstepA = 2 * hstepA, tstepB = 2 * hstepB;
    const unsigned ldsw = (unsigned)wid * 1024u;
    const int aoff = lds_byte(wr * 64 + fr, fq * 8), boff = lds_byte(wc * 32 + fr, fq * 8);
#define PG8_SA(b, h) (((b) * 2 + (h)) * HTB)
#define PG8_SB(b, h) ((4 + (b) * 2 + (h)) * HTB)
#define PG8_STAGE(bufoff, gbase, voff) do { _Pragma("unroll") for (int _i = 0; _i < 2; ++_i) \
        __builtin_amdgcn_global_load_lds((const unsigned*)((const char*)(gbase) + (voff)[_i]), (PG8_LAS unsigned*)(lds + (bufoff) + ldsw + _i * 8192), 16, 0, 0); } while (0)
#define PG8_LDA(dst, b, h) do { _Pragma("unroll") for (int m = 0; m < 4; ++m) _Pragma("unroll") for (int k = 0; k < 2; ++k) dst[m][k] = *(const PG8_LAS bf16x8*)(lds + PG8_SA(b, h) + aoff + m * 2048 + k * 1024); } while (0)
#define PG8_LDB(dst, b, h) do { _Pragma("unroll") for (int n = 0; n < 2; ++n) _Pragma("unroll") for (int k = 0; k < 2; ++k) dst[n][k] = *(const PG8_LAS bf16x8*)(lds + PG8_SB(b, h) + boff + n * 2048 + k * 1024); } while (0)
#define PG8_MMA(ai, bj, At, Bt) do { __builtin_amdgcn_s_setprio(1); _Pragma("unroll") for (int m = 0; m < 4; ++m) _Pragma("unroll") for (int n = 0; n < 2; ++n) _Pragma("unroll") for (int k = 0; k < 2; ++k) \
        acc[ai][bj][m][n] = __builtin_amdgcn_mfma_f32_16x16x32_bf16(Bt[n][k], At[m][k], acc[ai][bj][m][n], 0, 0, 0); __builtin_amdgcn_s_setprio(0); } while (0)
#define PG8_WAIT_V(n) asm volatile("s_waitcnt vmcnt(" #n ")" ::: "memory")
#define PG8_WAIT_L(n) asm volatile("s_waitcnt lgkmcnt(" #n ")" ::: "memory")
#define PG8_BAR __builtin_amdgcn_s_barrier()
#define PG8_SCHED __builtin_amdgcn_sched_barrier(0)
    Unit cur, nxt; int ui = 0;
    if (!S.next(0, cur)) return;
    f32x4 acc[2][2][4][2];
#pragma unroll
    for (int a = 0; a < 2; ++a)
#pragma unroll
        for (int b = 0; b < 2; ++b)
#pragma unroll
            for (int m = 0; m < 4; ++m)
#pragma unroll
                for (int n = 0; n < 2; ++n) acc[a][b][m][n] = (f32x4){0.f, 0.f, 0.f, 0.f};
    bf16x8 At[4][2], B0[2][2], B1[2][2];
    const char* cA = (const char*)g.A + (size_t)cur.pm * tstepA; const char* cB = (const char*)g.Bt + (size_t)cur.pn * tstepB;
    S.a_ready(cur);
    if constexpr (Epi::PERMA) E.prefetch(cur, 0, wave_s);
    if constexpr (SP2) {
        PG8_STAGE(PG8_SB(0, 0), cB, voffB); PG8_STAGE(PG8_SB(0, 1), cB + hstepB, voffB); PG8_STAGE(PG8_SA(0, 0), cA, voffA); PG8_STAGE(PG8_SA(0, 1), cA + hstepA, voffA);
        if (wr == 1) PG8_BAR;
        PG8_WAIT_V(2); PG8_BAR;
        PG8_STAGE(PG8_SB(1, 0), cB + kstep, voffB); PG8_STAGE(PG8_SA(1, 0), cA + kstep, voffA); PG8_STAGE(PG8_SB(1, 1), cB + hstepB + kstep, voffB);
        PG8_WAIT_V(6); PG8_BAR;
    } else {
        PG8_STAGE(PG8_SB(0, 0), cB, voffB); PG8_STAGE(PG8_SA(0, 0), cA, voffA); PG8_STAGE(PG8_SB(0, 1), cB + hstepB, voffB); PG8_STAGE(PG8_SA(0, 1), cA + hstepA, voffA);
        if (wr == 1) PG8_BAR;
        PG8_WAIT_V(4); PG8_BAR;
        PG8_STAGE(PG8_SB(1, 0), cB + kstep, voffB); PG8_STAGE(PG8_SA(1, 0), cA + kstep, voffA); PG8_STAGE(PG8_SB(1, 1), cB + hstepB + kstep, voffB);
        PG8_WAIT_V(6); PG8_BAR;
    }
    for (;;) {
        const bool has_next = S.next(ui + 1, nxt);
        const char* nA = has_next ? (const char*)g.A + (size_t)nxt.pm * tstepA : cA; const char* nB = has_next ? (const char*)g.Bt + (size_t)nxt.pn * tstepB : cB;
        for (int t = 0; t < nt; t += 2) {
            const bool last = (t == nt - 2);
            const char* a1 = cA + (size_t)(t + 1) * kstep;
            const char* a2 = last ? nA : cA + (size_t)(t + 2) * kstep; const char* b2 = last ? nB : cB + (size_t)(t + 2) * kstep;
            const char* a3 = a2 + kstep; const char* b3 = b2 + kstep;
            if (last && has_next) S.a_ready(nxt);
            if constexpr (SP2) {
            PG8_LDB(B0, 0, 0); PG8_LDB(B1, 0, 1); PG8_SCHED; PG8_LDA(At, 0, 0); PG8_STAGE(PG8_SA(1, 1), a1 + hstepA, voffA);
            PG8_WAIT_V(8); PG8_WAIT_L(0); PG8_BAR; PG8_MMA(0, 0, At, B0); PG8_MMA(0, 1, At, B1); PG8_BAR; PG8_SCHED;
            PG8_LDA(At, 0, 1); PG8_STAGE(PG8_SB(0, 0), b2, voffB); PG8_STAGE(PG8_SB(0, 1), b2 + hstepB, voffB); PG8_STAGE(PG8_SA(0, 0), a2, voffA);
            PG8_WAIT_V(8); PG8_WAIT_L(0); PG8_BAR; PG8_MMA(1, 0, At, B0); PG8_MMA(1, 1, At, B1); PG8_BAR; PG8_SCHED;
            PG8_LDB(B0, 1, 0); PG8_LDB(B1, 1, 1); PG8_SCHED; PG8_LDA(At, 1, 0); PG8_STAGE(PG8_SA(0, 1), a2 + hstepA, voffA);
            PG8_WAIT_V(8); PG8_WAIT_L(0); PG8_BAR; PG8_MMA(0, 0, At, B0); PG8_MMA(0, 1, At, B1); PG8_BAR; PG8_SCHED;
            PG8_LDA(At, 1, 1); PG8_STAGE(PG8_SB(1, 0), b3, voffB); PG8_STAGE(PG8_SB(1, 1), b3 + hstepB, voffB); PG8_STAGE(PG8_SA(1, 0), a3, voffA);
            PG8_WAIT_V(8); PG8_WAIT_L(0); PG8_BAR; PG8_MMA(1, 0, At, B0); PG8_MMA(1, 1, At, B1); PG8_BAR; PG8_SCHED;
            } else {
            PG8_LDB(B0, 0, 0); PG8_SCHED; PG8_LDA(At, 0, 0); PG8_STAGE(PG8_SA(1, 1), a1 + hstepA, voffA);
            PG8_WAIT_L(8); PG8_BAR; PG8_WAIT_L(0); PG8_MMA(0, 0, At, B0); PG8_BAR; PG8_SCHED;
            PG8_LDB(B1, 0, 1); PG8_STAGE(PG8_SB(0, 0), b2, voffB);
            PG8_BAR; PG8_WAIT_L(0); PG8_MMA(0, 1, At, B1); PG8_BAR;
            PG8_LDA(At, 0, 1); PG8_STAGE(PG8_SA(0, 0), a2, voffA);
            PG8_BAR; PG8_WAIT_L(0); PG8_MMA(1, 0, At, B0); PG8_BAR; PG8_SCHED;
            PG8_STAGE(PG8_SB(0, 1), b2 + hstepB, voffB);
            PG8_WAIT_V(6); PG8_BAR; PG8_MMA(1, 1, At, B1); PG8_BAR;
            PG8_LDB(B0, 1, 0); PG8_SCHED; PG8_LDA(At, 1, 0); PG8_STAGE(PG8_SA(0, 1), a2 + hstepA, voffA);
            PG8_WAIT_L(8); PG8_BAR; PG8_WAIT_L(0); PG8_MMA(0, 0, At, B0); PG8_BAR; PG8_SCHED;
            PG8_LDB(B1, 1, 1); PG8_STAGE(PG8_SB(1, 0), b3, voffB);
            PG8_BAR; PG8_WAIT_L(0); PG8_MMA(0, 1, At, B1); PG8_BAR;
            PG8_LDA(At, 1, 1); PG8_STAGE(PG8_SA(1, 0), a3, voffA);
            PG8_BAR; PG8_WAIT_L(0); PG8_MMA(1, 0, At, B0); PG8_BAR; PG8_SCHED;
            PG8_STAGE(PG8_SB(1, 1), b3 + hstepB, voffB);
            PG8_WAIT_V(6); PG8_BAR; PG8_MMA(1, 1, At, B1); PG8_BAR;
            }
        }
        if constexpr (ALIGN_EPI) { if (wr == 0) PG8_BAR; }
        if constexpr (Epi::PERMA) { E.run(acc, cur, nxt, has_next, ui & 1, wr, wc, wave_s); S.done(cur); }
        else if constexpr (!Epi::AFTER_DRAIN) { E(acc, cur, wr, wc, fr, fq); S.done(cur); }
        if (!has_next) break;
#pragma unroll
        for (int a = 0; a < 2; ++a)
#pragma unroll
            for (int b = 0; b < 2; ++b)
#pragma unroll
                for (int m = 0; m < 4; ++m)
#pragma unroll
                    for (int n = 0; n < 2; ++n) acc[a][b][m][n] = (f32x4){0.f, 0.f, 0.f, 0.f};
        cur = nxt; cA = nA; cB = nB; ++ui;
        if constexpr (ALIGN_EPI) { if (wr == 1) PG8_BAR; }
    }
    PG8_WAIT_V(0);
    if constexpr (!ALIGN_EPI) { if (wr == 0) PG8_BAR; }
    PG8_BAR;
    if constexpr (Epi::AFTER_DRAIN) { E.fused(acc, cur, wr, wc, fr, fq, lds, wid, lane); S.done(cur); }
#undef PG8_SA
#undef PG8_SB
#undef PG8_STAGE
#undef PG8_LDA
#undef PG8_LDB
#undef PG8_MMA
#undef PG8_WAIT_V
#undef PG8_WAIT_L
#undef PG8_BAR
#undef PG8_SCHED
}
}
constexpr int NWAVES = 8;
template <class RowMap>
__device__ __forceinline__ void transpose_item(const float* __restrict__ W, int K, int N, bf16_t* WT, const float* __restrict__ kscale, RowMap rm, LAS float* scr, int item, int lane) {
    const int nblk = (N + 31) / 32, kb = item / nblk, nb = item % nblk, k0 = 64 * kb, n0 = 32 * nb;
    const int nr = n0 + (lane & 31);
    float v[32];
#pragma unroll
    for (int i = 0; i < 32; ++i) { const int kk = 2 * i + (lane >> 5); v[i] = (nr < N) ? W[(size_t)(k0 + kk) * N + nr] : 0.f; }
    if (kscale) {
#pragma unroll
        for (int i = 0; i < 32; ++i) v[i] *= kscale[k0 + 2 * i + (lane >> 5)];
    }
#pragma unroll
    for (int i = 0; i < 32; ++i) scr[(2 * i + (lane >> 5)) * 33 + (lane & 31)] = v[i];
    asm volatile("s_waitcnt lgkmcnt(0)" ::: "memory");
    const int c = lane & 7;
#pragma unroll
    for (int j = 0; j < 4; ++j) { const int nl = (lane >> 3) + 8 * j, n = n0 + nl;
        if (n < N) { const LAS float* s = scr + (8 * c) * 33 + nl;
            u32x4_t o; o.x = pk2(s[0 * 33], s[1 * 33]); o.y = pk2(s[2 * 33], s[3 * 33]); o.z = pk2(s[4 * 33], s[5 * 33]); o.w = pk2(s[6 * 33], s[7 * 33]);
            *(u32x4_t*)(WT + (size_t)rm(n) * K + k0 + 8 * c) = o; } }
    asm volatile("s_waitcnt lgkmcnt(0)" ::: "memory");
}
struct RmIdent { __device__ __forceinline__ int operator()(int n) const { return n; } };
struct RmWin {
    __device__ __forceinline__ int operator()(int c) const {
        const int nc = c < 2560 ? c : (c < 2608 ? 4608 + (c - 2560) : 2560 + (c - 2608));
        const int tile = nc >> 8, L = nc & 255, wc = L >> 6, bj = (L >> 5) & 1, j = L & 31;
        return tile * 256 + 128 * bj + 32 * wc + j;
    }
};
struct RmWup {
    __device__ __forceinline__ int operator()(int c) const { const int up = c >= D_FF, cc = up ? c - D_FF : c; return (cc >> 7) * 256 + up * 128 + (cc & 127); }
};

struct Ptrs {
    const float* in[18]; float* out; unsigned char* ws;
};

__device__ __forceinline__ void p0_prologue(const Ptrs& P, LAS unsigned char* lds, int vcu, int G, const int wave) {
    const int lane = fresh_lane();
    LAS float* scr = (LAS float*)(lds + wave * 16384);
    const int gw = vcu * NWAVES + wave, NGW = G * NWAVES;
    unsigned char* ws = P.ws;
    bf16_t* WinT = (bf16_t*)(ws + WS_WIN); bf16_t* WoutT = (bf16_t*)(ws + WS_WOUT); bf16_t* WupT = (bf16_t*)(ws + WS_WUP); bf16_t* WdownT = (bf16_t*)(ws + WS_WDOWN); bf16_t* W1cT = (bf16_t*)(ws + WS_W1C);
    const float* x = P.in[0]; const float* attn_norm_w = P.in[1]; const float* w_in = P.in[2]; const float* cmp_pos = P.in[5]; const float* cmp_w1 = P.in[6];
    const float* w_out = P.in[12]; const float* ffn_norm_w = P.in[13]; const float* w_up = P.in[14]; const float* w_down = P.in[17];
    constexpr int I_IN = 32 * 146, I_W1 = 32 * 8, I_W2 = 4 * 2;
    constexpr int NITEMS = I_IN + 2 * I_W1 + 2 * I_W2;
    (void)w_out; (void)w_up; (void)w_down; (void)ffn_norm_w; (void)WoutT; (void)WupT; (void)WdownT;
    for (int it = gw; it < NITEMS; it += NGW) {
        int r = it;
        if (r < I_IN) { transpose_item(w_in, 2048, IN_COLS, WinT, nullptr, RmWin(), scr, r, lane); continue; } r -= I_IN;
        if (r < I_W1) { transpose_item(cmp_w1, 2048, 256, W1cT, nullptr, RmIdent(), scr, r, lane); continue; } r -= I_W1;
        if (r < I_W1) { transpose_item(cmp_w1 + (size_t)2048 * 256, 2048, 256, W1cT + (size_t)256 * 2048, nullptr, RmIdent(), scr, r, lane); continue; } r -= I_W1;
        { const int kv = r >= I_W2 ? 1 : 0; transpose_item(P.in[7] + (size_t)kv * 256 * 64, 256, 64, (bf16_t*)(ws + WS_SMALL + SM_W2T) + (size_t)kv * 64 * 256, nullptr, RmIdent(), scr, r - kv * I_W2, lane); }
    }
    for (int i = gw * 64 + lane; i < 8 * 16384; i += NGW * 64) { const int t = (i >> 7) & 127, sx = i & 127; ((bf16_t*)(ws + WS_SMALL + SM_SWB))[i] = (bf16_t)(sx <= t ? f2bf(P.in[10][i]) : 0u); }
    for (int p = gw; p < 256; p += NGW) {
        const int L = 64 * ((p >> 5) & 3) + 32 * (p >> 7) + (p & 31);
        if (L >= 48) { u32x4_t z = {0u, 0u, 0u, 0u}; u32x4_t* d = (u32x4_t*)(WinT + (size_t)(18 * 256 + p) * 2048);
#pragma unroll
            for (int j = 0; j < 4; ++j) d[lane + 64 * j] = z; }
    }
    bf16_t* XN = (bf16_t*)(ws + WS_XN);
    for (int m = gw; m < MTOK; m += 2 * NGW) {
        const int m2 = m + NGW;
        const f32x4_t* xr = (const f32x4_t*)(x + (size_t)m * D_MODEL) + lane;
        const f32x4_t* xr2 = (const f32x4_t*)(x + (size_t)(m2 < MTOK ? m2 : m) * D_MODEL) + lane;
        f32x4_t v[8], v2[8]; float s = 0.f, s2 = 0.f;
#pragma unroll
        for (int j = 0; j < 8; ++j) { v[j] = xr[64 * j]; v2[j] = xr2[64 * j]; }
#pragma unroll
        for (int j = 0; j < 8; ++j) { s += (v[j][0] * v[j][0] + v[j][1] * v[j][1]) + (v[j][2] * v[j][2] + v[j][3] * v[j][3]); s2 += (v2[j][0] * v2[j][0] + v2[j][1] * v2[j][1]) + (v2[j][2] * v2[j][2] + v2[j][3] * v2[j][3]); }
        const float ms1 = wave_sum(s) * (1.0f / D_MODEL) + 1e-6f, ms2 = wave_sum(s2) * (1.0f / D_MODEL) + 1e-6f;
        const float r = __builtin_amdgcn_rsqf(ms1), r2 = __builtin_amdgcn_rsqf(ms2);
        if (lane == 0) { float* rinv = (float*)(ws + WS_SMALL + SM_RINV); rinv[m] = ms1 * r; if (m2 < MTOK) rinv[m2] = ms2 * r2; }
        u32x2_t* o8 = (u32x2_t*)(XN + (size_t)m * D_MODEL) + lane; u32x2_t* o82 = (u32x2_t*)(XN + (size_t)m2 * D_MODEL) + lane;
#pragma unroll
        for (int j = 0; j < 8; ++j) { const f32x4_t w = ((const f32x4_t*)attn_norm_w)[lane + 64 * j];
            u32x2_t o; o.x = pk2(v[j][0] * r * w[0], v[j][1] * r * w[1]); o.y = pk2(v[j][2] * r * w[2], v[j][3] * r * w[3]); o8[64 * j] = o;
            if (m2 < MTOK) { u32x2_t q; q.x = pk2(v2[j][0] * r2 * w[0], v2[j][1] * r2 * w[1]); q.y = pk2(v2[j][2] * r2 * w[2], v2[j][3] * r2 * w[3]); o82[64 * j] = q; } }
    }
    for (int i = gw * 64 + lane; i < D_MODEL; i += NGW * 64) ((float*)(ws + WS_SMALL + SM_INVW))[i] = 1.0f / attn_norm_w[i];
    float* BIASP = (float*)(ws + WS_SMALL + SM_BIASP);
    for (int it = gw; it < 64; it += NGW) {
        const int kv = it >> 5, kc = it & 31; f32x4_t a = {0.f, 0.f, 0.f, 0.f};
        const float* pp = cmp_pos + kv * 2048 + kc * 64; const float* w1 = cmp_w1 + ((size_t)kv * 2048 + kc * 64) * 256;
        for (int k = 0; k < 64; ++k) { const f32x4_t w = ((const f32x4_t*)(w1 + (size_t)k * 256))[lane]; a += w * pp[k]; }
        ((f32x4_t*)(BIASP + (size_t)it * 256))[lane] = a;
    }
}

__device__ __forceinline__ void bias1_stage(unsigned char* ws, int idx  ) {
    const float* BIASP = (const float*)(ws + WS_SMALL + SM_BIASP); float* BIAS1 = (float*)(ws + WS_SMALL + SM_BIAS1);
    const int kv = idx >> 8, j = idx & 255; float s = 0.f;
    for (int kc = 0; kc < 32; ++kc) s += BIASP[(size_t)(kv * 32 + kc) * 256 + j];
    BIAS1[idx] = s;
}
__device__ __forceinline__ void cmp2_row(const Ptrs& P, int R, int lane) {
    unsigned char* ws = P.ws; const bf16_t* HC = (const bf16_t*)(ws + WS_HC);
    const int kv = R >> 12, rr = R & 4095, n = rr & 255;
    bf16_t* dst = (bf16_t*)(ws + (kv ? WS_VC : WS_KC)) + (size_t)rr * 64 + lane;
    if (n == 255) { *dst = 0; return; }
    const float* w2 = P.in[7] + (size_t)kv * 256 * 64;
    const u32x2_t hr = *(const u32x2_t*)(HC + (size_t)R * 256 + 4 * lane);
    float h[4] = {__uint_as_float(hr.x << 16), __uint_as_float(hr.x & 0xffff0000u), __uint_as_float(hr.y << 16), __uint_as_float(hr.y & 0xffff0000u)};
    float o = 0.f;
    for (int jj = 0; jj < 64; ++jj) {
#pragma unroll
        for (int i = 0; i < 4; ++i) o += __shfl(h[i], jj) * w2[(size_t)(4 * jj + i) * 64 + lane];
    }
    if (kv == 0) { const float ss = wave_sum(o * o); o *= __builtin_amdgcn_rsqf(ss * (1.0f / 64.0f) + 1e-6f) * P.in[4][lane]; }
    *dst = (bf16_t)f2bf(o);
}

__device__ __forceinline__ void gmlp_unit_v1(const Ptrs& P, LAS unsigned char* lds, int unit, const int wave_s) {
    unsigned char* ws = P.ws; const int tid = fresh_tid(wave_s);
    const int g = unit & 7, chunk = (unit >> 3) & 31, b = unit >> 8; const int m0 = b * SEQ + chunk * 128;
    LAS float* vn = (LAS float*)lds; LAS float* Wl = (LAS float*)(lds + 65536); LAS float* st = (LAS float*)(lds + 131072);
    const bf16_t* GV = (const bf16_t*)(ws + WS_GV); const bf16_t* U = (const bf16_t*)(ws + WS_U); const float* VSTAT = (const float*)(ws + WS_VSTAT);
    bf16_t* AB = (bf16_t*)(ws + WS_AB);
    const float* ln_w = P.in[8]; const float* ln_b = P.in[9]; const float* sw = P.in[10]; const float* sb = P.in[11];
    if (tid < 128) { const float* p = VSTAT + (size_t)(m0 + tid) * 32; float s1 = 0.f, s2 = 0.f;
#pragma unroll
        for (int i = 0; i < 16; ++i) { s1 += p[2 * i]; s2 += p[2 * i + 1]; }
        const float mean = s1 * (1.0f / 1024.0f); float var = s2 * (1.0f / 1024.0f) - mean * mean; var = var < 0.f ? 0.f : var;
        st[2 * tid] = mean; st[2 * tid + 1] = __builtin_amdgcn_rsqf(var + 1e-5f); }
    for (int i = 0; i < 32; ++i) { const int idx = tid + 512 * i, t = idx >> 7, s = idx & 127; Wl[idx] = (s <= t) ? sw[(size_t)g * 16384 + idx] : 0.f; }
    __syncthreads();
#pragma unroll
    for (int i = 0; i < 4; ++i) { const int idx = tid + 512 * i, s = idx >> 4, c8 = idx & 15;
        const u32x4_t raw = *(const u32x4_t*)(GV + (size_t)(m0 + s) * 1024 + g * 128 + 8 * c8); float f[8]; unpack8(raw, f);
        const float mean = st[2 * s], rstd = st[2 * s + 1];
#pragma unroll
        for (int e = 0; e < 8; ++e) { const int c = g * 128 + 8 * c8 + e; vn[s * 128 + 8 * c8 + e] = (f[e] - mean) * rstd * ln_w[c] + ln_b[c]; } }
    __syncthreads();
    const int c = tid & 127, tq = tid >> 7;
    for (int i = 0; i < 8; ++i) {
        const int t0 = 4 * (tq + 4 * i); float a0 = 0.f, a1 = 0.f, a2 = 0.f, a3 = 0.f;
        for (int s4 = 0; s4 <= t0; s4 += 4) {
            const f32x4_t w0 = *(const LAS f32x4_t*)(Wl + (t0 + 0) * 128 + s4), w1 = *(const LAS f32x4_t*)(Wl + (t0 + 1) * 128 + s4), w2 = *(const LAS f32x4_t*)(Wl + (t0 + 2) * 128 + s4), w3 = *(const LAS f32x4_t*)(Wl + (t0 + 3) * 128 + s4);
#pragma unroll
            for (int k = 0; k < 4; ++k) { const float v = vn[(s4 + k) * 128 + c]; a0 += w0[k] * v; a1 += w1[k] * v; a2 += w2[k] * v; a3 += w3[k] * v; }
        }
        const float av[4] = {a0, a1, a2, a3};
#pragma unroll
        for (int k = 0; k < 4; ++k) { const int t = t0 + k; const size_t row = (size_t)(m0 + t);
            const float uu = bf2f(U[row * 1024 + g * 128 + c]); AB[row * 2048 + 1024 + g * 128 + c] = (bf16_t)f2bf(uu * (av[k] + sb[g * 128 + t])); }
    }
    __syncthreads();
}

__device__ __forceinline__ void conv_item(const Ptrs& P, int b, int idx) {
    const int t = idx / 704, c8 = idx % 704, c0 = 8 * c8, j = c0 >> 7, i0 = c0 & 127;
    const bf16_t* HID = (const bf16_t*)(P.ws + WS_HID); const float* cw = P.in[15]; const float* cb = P.in[16];
    float gt[8], up[8];
#pragma unroll
    for (int e = 0; e < 8; ++e) { gt[e] = cb[c0 + e]; up[e] = cb[D_FF + c0 + e]; }
#pragma unroll
    for (int k = 0; k < 3; ++k) { const int tt = t - 2 + k; if (tt < 0) continue;
        float hg[8], hu[8]; unpack8(*(const u32x4_t*)(HID + (size_t)tt * N_UP + 256 * j + i0), hg); unpack8(*(const u32x4_t*)(HID + (size_t)tt * N_UP + 256 * j + 128 + i0), hu);
#pragma unroll
        for (int e = 0; e < 8; ++e) { gt[e] += cw[(size_t)k * N_UP + c0 + e] * hg[e]; up[e] += cw[(size_t)k * N_UP + D_FF + c0 + e] * hu[e]; } }
    float r[8];
#pragma unroll
    for (int e = 0; e < 8; ++e) r[e] = gt[e] * sigmoidf_(gt[e]) * up[e];
    u32x4_t o; o.x = pk2(r[0], r[1]); o.y = pk2(r[2], r[3]); o.z = pk2(r[4], r[5]); o.w = pk2(r[6], r[7]);
    *(u32x4_t*)((bf16_t*)(P.ws + WS_G) + ((size_t)b * SEQ + t) * D_FF + c0) = o;
}

constexpr int LW_CH = 32;
constexpr int LW_OUT = 32 * 64, LW_UP = 32 * 352, LW_DOWN = 88 * 64, LW_C_OUT = LW_OUT / LW_CH, LW_C_UP = LW_UP / LW_CH, LW_C_DOWN = LW_DOWN / LW_CH, LW_CHUNKS = LW_C_OUT + LW_C_UP + LW_C_DOWN;
static_assert(LW_OUT % LW_CH == 0 && LW_UP % LW_CH == 0 && LW_DOWN % LW_CH == 0, "late weight items per chunk");
template <class RowMap>
__device__ __forceinline__ void lw_load(float (&v)[32], const float* __restrict__ W, int N, int item, int lane) {
    const int nblk = N / 32, kb = item / nblk, nb = item % nblk;
    const float* p = W + (size_t)(64 * kb + (lane >> 5)) * N + 32 * nb + (lane & 31);
#pragma unroll
    for (int i = 0; i < 32; ++i) v[i] = p[(size_t)(2 * i) * N];
}
template <class RowMap>
__device__ __forceinline__ void lw_store(const float (&v)[32], int K, int N, bf16_t* WT, const float* __restrict__ kscale, RowMap rm, LAS float* scr, int item, int lane) {
    const int nblk = N / 32, kb = item / nblk, nb = item % nblk, k0 = 64 * kb, n0 = 32 * nb;
    const int c = lane & 7;
    f32x4_t sc0 = {1.f, 1.f, 1.f, 1.f}, sc1 = sc0;
    if (kscale) { sc0 = *(const f32x4_t*)(kscale + k0 + 8 * c); sc1 = *(const f32x4_t*)(kscale + k0 + 8 * c + 4); }
#pragma unroll
    for (int i = 0; i < 32; ++i) scr[(2 * i + (lane >> 5)) * 33 + (lane & 31)] = v[i];
    asm volatile("s_waitcnt lgkmcnt(0)" ::: "memory");
#pragma unroll
    for (int j = 0; j < 4; ++j) { const int nl = (lane >> 3) + 8 * j; const LAS float* s = scr + (8 * c) * 33 + nl;
        u32x4_t o; o.x = pk2(s[0 * 33] * sc0[0], s[1 * 33] * sc0[1]); o.y = pk2(s[2 * 33] * sc0[2], s[3 * 33] * sc0[3]); o.z = pk2(s[4 * 33] * sc1[0], s[5 * 33] * sc1[1]); o.w = pk2(s[6 * 33] * sc1[2], s[7 * 33] * sc1[3]);
        *(u32x4_t*)(WT + (size_t)rm(n0 + nl) * K + k0 + 8 * c) = o; }
    asm volatile("s_waitcnt lgkmcnt(0)" ::: "memory");
}
template <class RowMap>
__device__ __forceinline__ void lw_run(const float* __restrict__ W, int K, int N, bf16_t* WT, const float* __restrict__ kscale, RowMap rm, LAS float* scr, int item0, int wave, int lane) {
    float va[32], vb[32];
    lw_load<RowMap>(va, W, N, item0 + wave, lane);
    lw_load<RowMap>(vb, W, N, item0 + wave + 8, lane);  lw_store(va, K, N, WT, kscale, rm, scr, item0 + wave, lane);
    lw_load<RowMap>(va, W, N, item0 + wave + 16, lane); lw_store(vb, K, N, WT, kscale, rm, scr, item0 + wave + 8, lane);
    lw_load<RowMap>(vb, W, N, item0 + wave + 24, lane); lw_store(va, K, N, WT, kscale, rm, scr, item0 + wave + 16, lane);
    lw_store(vb, K, N, WT, kscale, rm, scr, item0 + wave + 24, lane);
}
__device__ __forceinline__ void late_weight_chunk(const Ptrs& P, LAS unsigned char* lds, int chunk, const int wave) {
    const int lane = fresh_lane();
    LAS float* scr = (LAS float*)(lds + wave * 16384);
    unsigned char* ws = P.ws;
    if (chunk < LW_C_UP) lw_run(P.in[14], 2048, N_UP, (bf16_t*)(ws + WS_WUP), P.in[13], RmWup(), scr, chunk * LW_CH, wave, lane);
    else if (chunk < LW_C_UP + LW_C_DOWN) lw_run(P.in[17], D_FF, 2048, (bf16_t*)(ws + WS_WDOWN), nullptr, RmIdent(), scr, (chunk - LW_C_UP) * LW_CH, wave, lane);
    else lw_run(P.in[12], 2048, 2048, (bf16_t*)(ws + WS_WOUT), nullptr, RmIdent(), scr, (chunk - LW_C_UP - LW_C_DOWN) * LW_CH, wave, lane);
}

namespace nsa {
using bf16x8 = __attribute__((ext_vector_type(8))) short;
using s16x4 = __attribute__((ext_vector_type(4))) short;
using f32x16 = __attribute__((ext_vector_type(16))) float;
typedef float f32x2_t __attribute__((ext_vector_type(2))); typedef __bf16 bf16x2_t __attribute__((ext_vector_type(2)));
constexpr int L_K = 0, L_V = 16384, L_WSF = 32768, L_OST = 34816, L_IMP = 100352, L_MASK = 116736, L_WU = 117248, L_END = 117312;
constexpr int SLOTB = 8192;
constexpr float THR = 8.0f;
#define NSA_SBAR() __builtin_amdgcn_sched_barrier(0)
__device__ __forceinline__ int crow(int r, int hi) { return (r & 3) + 8 * (r >> 2) + 4 * hi; }
__device__ __forceinline__ void glds16(const void* gbase  , unsigned voff  , unsigned lds_dst) { unsigned keep;
    asm volatile("s_mov_b32 %0, m0\n\ts_mov_b32 m0, %3\n\ts_nop 0\n\tglobal_load_lds_dwordx4 %1, %2\n\ts_mov_b32 m0, %0" : "=&s"(keep) : "v"(voff), "s"(gbase), "s"(lds_dst) : "memory"); }
__device__ __forceinline__ unsigned cvtpk_s(float lo, float hi) { f32x2_t v = {lo, hi}; bf16x2_t b = __builtin_convertvector(v, bf16x2_t); return __builtin_bit_cast(unsigned, b); }
#define NSA_WAIT_BAR() asm volatile("s_waitcnt vmcnt(0) lgkmcnt(0)\n\ts_barrier" ::: "memory")

__device__ __forceinline__ void qkt(f32x16& p0, f32x16& p1, LAS const char* Kslot, const bf16x8 (&qr)[4], int r32, int hi) {
    LAS const char* kb = Kslot + hi * 1024 + r32 * 16;
#pragma unroll
    for (int d0 = 0; d0 < 4; ++d0) {
        const bf16x8 b0 = *(LAS const bf16x8*)(kb + d0 * 2048);
        const bf16x8 b1 = *(LAS const bf16x8*)(kb + d0 * 2048 + 512);
        p0 = __builtin_amdgcn_mfma_f32_32x32x16_bf16(b0, qr[d0], p0, 0, 0, 0); p1 = __builtin_amdgcn_mfma_f32_32x32x16_bf16(b1, qr[d0], p1, 0, 0, 0);
    }
}
struct VFrag { s16x4 lo[2][4], hi[2][4]; };
__device__ __forceinline__ void vload(VFrag& f, int vb) {
#pragma unroll
    for (int d0 = 0; d0 < 2; ++d0)
#pragma unroll
        for (int ks = 0; ks < 4; ++ks) {
            asm volatile("ds_read_b64_tr_b16 %0,%1 offset:%c2" : "=&v"(f.lo[d0][ks]) : "v"(vb), "i"(d0 * 4096 + ks * 1024) : "memory");
            asm volatile("ds_read_b64_tr_b16 %0,%1 offset:%c2" : "=&v"(f.hi[d0][ks]) : "v"(vb), "i"(d0 * 4096 + ks * 1024 + 512) : "memory"); }
}
__device__ __forceinline__ void pvmma(f32x16 (&o)[2], VFrag& f, bf16x8 pa0, bf16x8 pa1, bf16x8 pa2, bf16x8 pa3) {
    asm volatile("s_waitcnt lgkmcnt(0)" : "+v"(f.lo[0][0]), "+v"(f.lo[0][1]), "+v"(f.lo[0][2]), "+v"(f.lo[0][3]), "+v"(f.hi[0][0]), "+v"(f.hi[0][1]), "+v"(f.hi[0][2]), "+v"(f.hi[0][3]) :: "memory");
    asm volatile("" : "+v"(f.lo[1][0]), "+v"(f.lo[1][1]), "+v"(f.lo[1][2]), "+v"(f.lo[1][3]), "+v"(f.hi[1][0]), "+v"(f.hi[1][1]), "+v"(f.hi[1][2]), "+v"(f.hi[1][3]));
    NSA_SBAR();
#pragma unroll
    for (int d0 = 0; d0 < 2; ++d0) {
#define NSA_PK(k) (bf16x8){f.lo[d0][k][0], f.lo[d0][k][1], f.lo[d0][k][2], f.lo[d0][k][3], f.hi[d0][k][0], f.hi[d0][k][1], f.hi[d0][k][2], f.hi[d0][k][3]}
        o[d0] = __builtin_amdgcn_mfma_f32_32x32x16_bf16(pa0, NSA_PK(0), o[d0], 0, 0, 0);
        o[d0] = __builtin_amdgcn_mfma_f32_32x32x16_bf16(pa1, NSA_PK(1), o[d0], 0, 0, 0);
        o[d0] = __builtin_amdgcn_mfma_f32_32x32x16_bf16(pa2, NSA_PK(2), o[d0], 0, 0, 0);
        o[d0] = __builtin_amdgcn_mfma_f32_32x32x16_bf16(pa3, NSA_PK(3), o[d0], 0, 0, 0);
#undef NSA_PK
    }
}
__device__ __forceinline__ void pv(f32x16 (&o)[2], int vb, bf16x8 pa0, bf16x8 pa1, bf16x8 pa2, bf16x8 pa3) { VFrag f; vload(f, vb); pvmma(o, f, pa0, pa1, pa2, pa3); }
__device__ __forceinline__ float rowmax32(const f32x16& p0, const f32x16& p1) {
    float a = __builtin_fmaxf(p0[0], p1[0]);
#pragma unroll
    for (int r = 1; r < 16; ++r) a = __builtin_fmaxf(a, __builtin_fmaxf(p0[r], p1[r]));
    auto rr = __builtin_amdgcn_permlane32_swap(__float_as_uint(a), __float_as_uint(a), false, false);
    return __builtin_fmaxf(__uint_as_float(rr[0]), __uint_as_float(rr[1]));
}
struct State { float m, l; f32x16 o[2]; };
__device__ __forceinline__ void state_init(State& s) { s.m = -1e30f; s.l = 0.f; s.o[0] = f32x16{}; s.o[1] = f32x16{}; }

template <int BMUL, int MASK, bool LOADV>
__device__ __forceinline__ void tile_scores(f32x16& p0, f32x16& p1, LAS const char* Kslot, const bf16x8 (&qr)[4], const f32x16& bk, float c0, float b32, int lim, int r32, int hi, VFrag& vf, int vb) {
#pragma unroll
    for (int r = 0; r < 16; ++r) { const float b = (BMUL == 1) ? bk[r] + c0 : __builtin_fmaf(bk[r], (float)BMUL, c0); p0[r] = b; p1[r] = b + b32; }
    qkt(p0, p1, Kslot, qr, r32, hi);
    if (LOADV) vload(vf, vb);
    const int limh = lim - 4 * hi;
#pragma unroll
    for (int r = 0; r < 16; ++r) {
        const int kk = (r & 3) + 8 * (r >> 2);
        if (MASK == 1) { if (!(kk <= limh)) p0[r] = -INFINITY; if (!(kk + 32 <= limh)) p1[r] = -INFINITY; }
        if (MASK == 2) { if (!(kk > limh)) p0[r] = -INFINITY; if (!(kk + 32 > limh)) p1[r] = -INFINITY; }
        if (MASK == 3) { if (!(kk < limh)) p0[r] = -INFINITY; if (!(kk + 32 < limh)) p1[r] = -INFINITY; }
    }
}
__device__ __forceinline__ float tile_ref(const State& st, float rb0, bool rowlive) { return (st.m < -1e29f && rowlive) ? rb0 : st.m; }
__device__ __forceinline__ void tile_softmax_pv(State& st, f32x16& p0, f32x16& p1, float mref, VFrag& vf, LAS float* wsf, int r32, int hi) {
    float a0 = p0[0], a1 = p1[0];
#pragma unroll
    for (int r = 1; r < 16; ++r) { a0 = __builtin_fmaxf(a0, p0[r]); a1 = __builtin_fmaxf(a1, p1[r]); }
    float mx = __builtin_fmaxf(a0, a1);
    { auto rr = __builtin_amdgcn_permlane32_swap(__float_as_uint(mx), __float_as_uint(mx), false, false); mx = __builtin_fmaxf(__uint_as_float(rr[0]), __uint_as_float(rr[1])); }
    if (__any(mx > THR)) {
        const float dl = __builtin_fmaxf(mx, 0.f), alpha = __builtin_amdgcn_exp2f(-dl);
        mref += dl; st.l *= alpha;
        if (hi == 0) wsf[r32] = alpha;
        asm volatile("s_waitcnt lgkmcnt(0)" ::: "memory");
#pragma unroll
        for (int r = 0; r < 16; ++r) { const float a = wsf[crow(r, hi)]; st.o[0][r] *= a; st.o[1][r] *= a; p0[r] -= dl; p1[r] -= dl; }
    }
    st.m = mref;
    float ls = 0.f;
#pragma unroll
    for (int r = 0; r < 16; ++r) { p0[r] = __builtin_amdgcn_exp2f(p0[r]); p1[r] = __builtin_amdgcn_exp2f(p1[r]); ls += p0[r] + p1[r]; }
    st.l += ls;
    u32x4_t pw0, pw1, pw2, pw3;
    pw0 = (u32x4_t){cvtpk_s(p0[0], p0[1]), cvtpk_s(p0[2], p0[3]), cvtpk_s(p0[4], p0[5]), cvtpk_s(p0[6], p0[7])};
    pw1 = (u32x4_t){cvtpk_s(p0[8], p0[9]), cvtpk_s(p0[10], p0[11]), cvtpk_s(p0[12], p0[13]), cvtpk_s(p0[14], p0[15])};
    pw2 = (u32x4_t){cvtpk_s(p1[0], p1[1]), cvtpk_s(p1[2], p1[3]), cvtpk_s(p1[4], p1[5]), cvtpk_s(p1[6], p1[7])};
    pw3 = (u32x4_t){cvtpk_s(p1[8], p1[9]), cvtpk_s(p1[10], p1[11]), cvtpk_s(p1[12], p1[13]), cvtpk_s(p1[14], p1[15])};
    pvmma(st.o, vf, __builtin_bit_cast(bf16x8, pw0), __builtin_bit_cast(bf16x8, pw1), __builtin_bit_cast(bf16x8, pw2), __builtin_bit_cast(bf16x8, pw3));
}
template <bool FIRST>
__device__ __forceinline__ void fold_branch(LAS float* ostg, State& st, float gate, LAS float* wsf, int r32, int hi) {
    float l = st.l;
    { auto rr = __builtin_amdgcn_permlane32_swap(__float_as_uint(l), __float_as_uint(l), false, false); l = __uint_as_float(rr[0]) + __uint_as_float(rr[1]); }
    const float f = l > 0.f ? gate / l : 0.f;
    asm volatile("s_waitcnt lgkmcnt(0)" ::: "memory");
    if (hi == 0) wsf[r32] = f;
    asm volatile("s_waitcnt lgkmcnt(0)" ::: "memory");
#pragma unroll
    for (int r = 0; r < 16; ++r) { const int orow = crow(r, hi); const float a = wsf[orow];
#pragma unroll
        for (int d0 = 0; d0 < 2; ++d0) { LAS float* p = ostg + orow * 64 + d0 * 32 + r32; if (FIRST) *p = st.o[d0][r] * a; else *p += st.o[d0][r] * a; } }
    asm volatile("s_waitcnt lgkmcnt(0)" ::: "memory");
}

__device__ __forceinline__ int nsa_unit(const Ptrs& P, LAS unsigned char* lds, int bg, int qt, const int wave_s, unsigned* qctr, int qbase) {
    unsigned char* ws = P.ws;
    const int lane = fresh_lane(), r32 = lane & 31, hi = lane >> 5; const int wid = wave_s;
    const int b = bg >> 2, g = bg & 3, t0 = 64 * qt;
    const int tl = 8 * wid + (r32 >> 2), hq = r32 & 3;
    const size_t m0 = (size_t)b * SEQ + t0;
    const bf16_t* Q = (const bf16_t*)(ws + WS_Q); const bf16_t* KV6 = (const bf16_t*)(ws + WS_KV6);
    const bf16_t* KSb = KV6 + 2 * KVSZ + (size_t)bg * SEQ * 64; const bf16_t* VSb = KV6 + 3 * KVSZ + (size_t)bg * SEQ * 64;
    const bf16_t* KWb = KV6 + 4 * KVSZ + (size_t)bg * SEQ * 64; const bf16_t* VWb = KV6 + 5 * KVSZ + (size_t)bg * SEQ * 64;
    const bf16_t* KCb = (const bf16_t*)(ws + WS_KC) + (size_t)bg * 256 * 64; const bf16_t* VCb = (const bf16_t*)(ws + WS_VC) + (size_t)bg * 256 * 64;
    const float* GATES = (const float*)(ws + WS_GATES); bf16_t* AB = (bf16_t*)(ws + WS_AB);
    const unsigned lds0 = (unsigned)(uintptr_t)lds;
    LAS float* wsf = (LAS float*)(lds + L_WSF) + wid * 64;
    LAS float* IMP = (LAS float*)(lds + L_IMP);
    LAS unsigned* MASK = (LAS unsigned*)(lds + L_MASK); LAS unsigned* WU = (LAS unsigned*)(lds + L_WU);
    const int koff = lane * 64 + wid * 8, voff = (16 * (wid & 3) + (lane >> 2)) * 64 + (wid >> 2) * 32 + (lane & 3) * 8;
    const unsigned kdst = lds0 + L_K + wid * 1024, vdst = lds0 + L_V + wid * 1024;
#define NSA_DMA_K(base, tile, slot) glds16((base) + (size_t)(tile) * 4096, (unsigned)koff * 2u, (unsigned)__builtin_amdgcn_readfirstlane(kdst + (slot) * SLOTB))
#define NSA_DMA_V(base, tile, slot) glds16((base) + (size_t)(tile) * 4096, (unsigned)voff * 2u, (unsigned)__builtin_amdgcn_readfirstlane(vdst + (slot) * SLOTB))
    const int vb0 = (int)(lds0 + L_V) + ((lane >> 4) & 1) * 32 + (lane & 3) * 8 + (4 * hi + ((lane & 15) >> 2)) * 64;
    LAS const char* Kbase = (LAS const char*)(lds + L_K);
    bf16x8 qr[4];
    { const bf16_t* qp = Q + (m0 + tl) * 1024 + (4 * g + hq) * 64 + hi * 8;
#pragma unroll
      for (int d0 = 0; d0 < 4; ++d0) qr[d0] = *(const bf16x8*)(qp + d0 * 16); }
    const float sl2 = __builtin_amdgcn_exp2f(-0.5f * (float)(4 * g + hq + 1)) * LOG2E;
    f32x16 bk;
#pragma unroll
    for (int r = 0; r < 16; ++r) bk[r] = sl2 * (float)((r & 3) + 8 * (r >> 2));
    const float b32t = 32.0f * sl2, b32c = 512.0f * sl2, hoff_t = 4.0f * (float)hi * sl2, hoff_c = 64.0f * (float)hi * sl2;
    float gate[3];
    { const float* gp = GATES + (m0 + tl) * 48 + (4 * g + hq) * 3; gate[0] = gp[0]; gate[1] = gp[1]; gate[2] = gp[2]; }
    LAS float* ostg = (LAS float*)(lds + L_OST) + wid * 2048;
    State st;
    f32x16 p0, p1;
    int nxt_ticket = 0;

    int tc = 0;
    VFrag vf;
    const int nvmax = (t0 + 63 >= 31) ? ((t0 + 63 - 31) >> 4) + 1 : 0;
    const int nct = (nvmax + 63) >> 6;
    const int tq = t0 + tl, nv = tq >= 31 ? ((tq - 31) >> 4) + 1 : 0;
    {
        state_init(st);
        const int j0 = qt >= 8 ? qt - 8 : 0, nt = qt - j0 + 1;
        NSA_DMA_K(KWb, qt, 0); NSA_DMA_V(VWb, qt, 0); NSA_WAIT_BAR();
        for (int i = 0; i < nt; ++i) {
            const int j = qt - i, slot = (tc + i) & 1;
            if (i + 1 < nt) { NSA_DMA_K(KWb, j - 1, slot ^ 1); NSA_DMA_V(VWb, j - 1, slot ^ 1); }
            else { NSA_DMA_K(KCb, nct - 1, slot ^ 1); NSA_DMA_V(VCb, nct - 1, slot ^ 1); }
            const float rb0 = sl2 * (float)(64 * j - t0), mref = tile_ref(st, rb0, true), c0 = rb0 + hoff_t - mref;
            if (j == qt) tile_scores<1, 1, true>(p0, p1, Kbase + slot * SLOTB, qr, bk, c0, b32t, tl, r32, hi, vf, vb0 + slot * SLOTB);
            else if (j == qt - 8) tile_scores<1, 2, true>(p0, p1, Kbase + slot * SLOTB, qr, bk, c0, b32t, tl, r32, hi, vf, vb0 + slot * SLOTB);
            else tile_scores<1, 0, true>(p0, p1, Kbase + slot * SLOTB, qr, bk, c0, b32t, 0, r32, hi, vf, vb0 + slot * SLOTB);
            tile_softmax_pv(st, p0, p1, mref, vf, wsf, r32, hi);
            NSA_WAIT_BAR();
        }
        tc += nt;
        fold_branch<true>(ostg, st, gate[2], wsf, r32, hi);
    }
    {
        state_init(st);
        for (int ci = 0; ci < nct; ++ci) {
            const int c = nct - 1 - ci, slot = (tc + ci) & 1;
            if (ci + 1 < nct) { NSA_DMA_K(KCb, c - 1, slot ^ 1); NSA_DMA_V(VCb, c - 1, slot ^ 1); }
            else if (qt >= 16) { NSA_DMA_K(KCb, 0, slot ^ 1); }
            else { NSA_DMA_K(KSb, qt, slot ^ 1); NSA_DMA_V(VSb, qt, slot ^ 1); }
            const float rb0 = sl2 * ((float)(1024 * c - t0) + 15.5f), mref = tile_ref(st, rb0, true), c0 = rb0 + hoff_c - mref;
            tile_scores<16, 3, true>(p0, p1, Kbase + slot * SLOTB, qr, bk, c0, b32c, nv - 64 * c, r32, hi, vf, vb0 + slot * SLOTB);
            tile_softmax_pv(st, p0, p1, mref, vf, wsf, r32, hi);
            NSA_WAIT_BAR();
        }
        tc += nct;
    }
    const float mc_fin = st.m; float lc = st.l;
    fold_branch<false>(ostg, st, gate[0], wsf, r32, hi);
    if (qt >= 16) {
        { auto rr = __builtin_amdgcn_permlane32_swap(__float_as_uint(lc), __float_as_uint(lc), false, false); lc = __uint_as_float(rr[0]) + __uint_as_float(rr[1]); }
        const float invl = lc > 0.f ? 1.0f / lc : 0.f;
        float carry = 0.f;
        for (int c = 0; c < nct; ++c) {
            const int slot = (tc + c) & 1;
            if (c + 1 < nct) { NSA_DMA_K(KCb, c + 1, slot ^ 1); }
            else { NSA_DMA_K(KSb, qt, slot ^ 1); NSA_DMA_V(VSb, qt, slot ^ 1); }
            const float c0 = sl2 * ((float)(1024 * c - t0) + 15.5f) + hoff_c - mc_fin;
            tile_scores<16, 3, false>(p0, p1, Kbase + slot * SLOTB, qr, bk, c0, b32c, nv - 64 * c, r32, hi, vf, 0);
#pragma unroll
            for (int r = 0; r < 16; ++r) { p0[r] = __builtin_amdgcn_exp2f(p0[r]) * invl; p1[r] = __builtin_amdgcn_exp2f(p1[r]) * invl; }
            float imp0[4], imp1[4], pl0[4], pl1[4];
#pragma unroll
            for (int a = 0; a < 4; ++a) {
                imp0[a] = (p0[4 * a] + p0[4 * a + 1]) + (p0[4 * a + 2] + p0[4 * a + 3]); imp1[a] = (p1[4 * a] + p1[4 * a + 1]) + (p1[4 * a + 2] + p1[4 * a + 3]);
                pl0[a] = __shfl_xor(p0[4 * a + 3], 32); pl1[a] = __shfl_xor(p1[4 * a + 3], 32);
            }
            if (hi) {
#pragma unroll
                for (int a = 0; a < 4; ++a) { imp0[a] += pl0[a]; imp1[a] += pl1[a]; }
            } else {
                imp0[0] += carry; imp1[0] += pl0[3];
#pragma unroll
                for (int a = 1; a < 4; ++a) { imp0[a] += pl0[a - 1]; imp1[a] += pl1[a - 1]; }
            }
            carry = pl1[3];
#pragma unroll
            for (int a = 0; a < 4; ++a) {
                imp0[a] += __shfl_xor(imp0[a], 1); imp0[a] += __shfl_xor(imp0[a], 2); imp1[a] += __shfl_xor(imp1[a], 1); imp1[a] += __shfl_xor(imp1[a], 2);
                if (hq == 0) { IMP[tl * 64 + 16 * c + 2 * a + hi] = imp0[a]; IMP[tl * 64 + 16 * c + 8 + 2 * a + hi] = imp1[a]; }
            }
            NSA_WAIT_BAR();
        }
        tc += nct;
    }
    unsigned long long wu = 0ull;
    if (qt < 16) {
        wu = (2ull << qt) - 1ull;
        if (lane < 8) { MASK[2 * (8 * wid + lane)] = (unsigned)wu; MASK[2 * (8 * wid + lane) + 1] = (unsigned)(wu >> 32); }
    } else {
        const int j = lane; const bool valid = j <= qt, forced = (j == 0) || (j == qt) || (j == qt - 1);
        for (int k = 0; k < 8; ++k) {
            const float imp = IMP[(8 * wid + k) * 64 + j];
            const float scv = valid ? (forced ? 1e9f : imp) : -1e9f;
            const unsigned fb = __float_as_uint(scv), key = fb ^ ((fb >> 31) ? 0xffffffffu : 0x80000000u);
            unsigned T = 0u;
#pragma unroll
            for (int bit = 31; bit >= 0; --bit) { const unsigned cand = T | (1u << bit); if (__builtin_popcountll(__ballot(key >= cand)) >= 16) T = cand; }
            const unsigned long long gt = __ballot(key > T), eq = __ballot(key == T);
            const int need = 16 - __builtin_popcountll(gt);
            const int before = (int)__builtin_amdgcn_mbcnt_hi((unsigned)(eq >> 32), __builtin_amdgcn_mbcnt_lo((unsigned)eq, 0u));
            const bool sel = (key > T) || ((key == T) && (before < need));
            const unsigned long long mk = __ballot(sel && (scv > -0.5e9f));
            wu |= mk;
            if (lane == 0) { MASK[2 * (8 * wid + k)] = (unsigned)mk; MASK[2 * (8 * wid + k) + 1] = (unsigned)(mk >> 32); }
        }
    }
    if (lane == 0) { WU[2 * wid] = (unsigned)wu; WU[2 * wid + 1] = (unsigned)(wu >> 32); }
    NSA_WAIT_BAR();
    unsigned long long uni = 0ull;
#pragma unroll
    for (int w = 0; w < 8; ++w) uni |= ((unsigned long long)WU[2 * w]) | (((unsigned long long)WU[2 * w + 1]) << 32);
    uni = ((unsigned long long)(unsigned)__builtin_amdgcn_readfirstlane((unsigned)uni)) | (((unsigned long long)(unsigned)__builtin_amdgcn_readfirstlane((unsigned)(uni >> 32))) << 32);
    const unsigned long long mymask = ((unsigned long long)MASK[2 * tl]) | (((unsigned long long)MASK[2 * tl + 1]) << 32);
    {
        state_init(st);
        unsigned long long rem = uni;
        int j = 63 - __builtin_clzll(rem); rem &= ~(1ull << j);
        for (int i = 0;; ++i) {
            const int slot = (tc + i) & 1; const bool more = rem != 0ull;
            int jn = 0;
            if (more) { jn = 63 - __builtin_clzll(rem); rem &= ~(1ull << jn); NSA_DMA_K(KSb, jn, slot ^ 1); NSA_DMA_V(VSb, jn, slot ^ 1); }
            if ((wu >> j) & 1ull) {
                const bool live = ((mymask >> j) & 1ull) != 0ull;
                const float rb0 = sl2 * (float)(64 * j - t0), mref = tile_ref(st, rb0, live), c0 = live ? rb0 + hoff_t - mref : -INFINITY;
                if (j == qt) tile_scores<1, 1, true>(p0, p1, Kbase + slot * SLOTB, qr, bk, c0, b32t, tl, r32, hi, vf, vb0 + slot * SLOTB);
                else tile_scores<1, 0, true>(p0, p1, Kbase + slot * SLOTB, qr, bk, c0, b32t, 0, r32, hi, vf, vb0 + slot * SLOTB);
                tile_softmax_pv(st, p0, p1, mref, vf, wsf, r32, hi);
            }
            NSA_WAIT_BAR();
            if (!more) break;
            j = jn;
        }
        if (wid == 0 && lane == 0) nxt_ticket = qbase + (int)__hip_atomic_fetch_add(qctr, 1u, __ATOMIC_RELAXED, __HIP_MEMORY_SCOPE_AGENT);
        fold_branch<false>(ostg, st, gate[1], wsf, r32, hi);
    }
    {
#pragma unroll
        for (int i = 0; i < 4; ++i) { const int row = i * 8 + (lane >> 3), ch = lane & 7;
            const f32x4_t v0 = *(LAS const f32x4_t*)(ostg + row * 64 + ch * 8), v1 = *(LAS const f32x4_t*)(ostg + row * 64 + ch * 8 + 4);
            u32x4_t v; v.x = cvtpk_s(v0[0], v0[1]); v.y = cvtpk_s(v0[2], v0[3]); v.z = cvtpk_s(v1[0], v1[1]); v.w = cvtpk_s(v1[2], v1[3]);
            *(u32x4_t*)(AB + (m0 + 8 * wid + (row >> 2)) * 2048 + 256 * g + (row & 3) * 64 + ch * 8) = v; }
    }
    NSA_WAIT_BAR();
#undef NSA_DMA_K
#undef NSA_DMA_V
    return nxt_ticket;
}
constexpr int L_QS = 145416;
__device__ __forceinline__ void nsa_phase(const Ptrs& P, LAS unsigned char* lds, int bid, int G, const int wave_s) {
    unsigned* qctr = (unsigned*)(P.ws + WS_CTL) + 3584;
    LAS int* qs = (LAS int*)(lds + L_QS);
    int k = bid;
    while (k < 1024 + LW_CHUNKS) {
        int nxt;
        if (k < 1024) {
            const int qt = 63 - (k >> 4), g = 3 - ((k >> 2) & 3), b = k & 3;
            nxt = nsa_unit(P, lds, b * 4 + g, qt, wave_s, qctr, G);
        } else {
            nxt = 0;
            if (wave_s == 0 && fresh_lane() == 0) nxt = G + (int)__hip_atomic_fetch_add(qctr, 1u, __ATOMIC_RELAXED, __HIP_MEMORY_SCOPE_AGENT);
            late_weight_chunk(P, lds, k - 1024, wave_s);
        }
        if (wave_s == 0 && fresh_lane() == 0) *qs = nxt;
        NSA_WAIT_BAR();
        k = __builtin_amdgcn_readfirstlane(*qs);
    }
}
}

namespace p2 {
using nsa::bf16x8; using nsa::f32x16; using nsa::s16x4; using nsa::crow; using nsa::glds16; using nsa::cvtpk_s;
#define P2_WAIT_BAR() asm volatile("s_waitcnt vmcnt(0) lgkmcnt(0)\n\ts_barrier" ::: "memory")
constexpr int CB_BUF = 40960;
constexpr int CP_STRIDE = 65;
__device__ __forceinline__ void compress_unit(const Ptrs& P, LAS unsigned char* lds, int u, const int wave_s) {
    unsigned char* ws = P.ws;
    const int lane = fresh_lane(), r32 = lane & 31, hi = lane >> 5, wid = wave_s;
    const int kv = u >> 6, bg = (u >> 2) & 15, n0 = 64 * (u & 3);
    const bf16_t* Ag = (const bf16_t*)(ws + WS_KV6) + (size_t)kv * KVSZ + (size_t)bg * SEQ * 64 + (size_t)n0 * 1024;
    const bf16_t* Bg = (const bf16_t*)(ws + WS_W1C) + (size_t)kv * 256 * 2048;
    const unsigned lds0 = (unsigned)(uintptr_t)lds;
    const unsigned aoff = (unsigned)(lane * 1024 + wid * 8) * 2u, boff = (unsigned)(lane * 2048 + wid * 8) * 2u;
    const unsigned dstw = lds0 + wid * 1024;
#define P2_DMA_TILE(kt, buf) do { const unsigned d_ = (unsigned)__builtin_amdgcn_readfirstlane(dstw + (buf) * CB_BUF); \
        glds16(Ag + (kt) * 64, aoff, d_); \
        _Pragma("unroll") for (int ct_ = 0; ct_ < 4; ++ct_) glds16(Bg + (size_t)ct_ * 64 * 2048 + (kt) * 64, boff, d_ + 8192u * (ct_ + 1)); } while (0)
    const int ct = wid >> 1, half = wid & 1, ncol0 = 64 * ct + 32 * half;
    f32x16 hT[2]; hT[0] = f32x16{}; hT[1] = f32x16{};
    P2_DMA_TILE(0, 0); P2_DMA_TILE(1, 1);
    asm volatile("s_waitcnt vmcnt(5) lgkmcnt(0)\n\ts_barrier" ::: "memory");
    for (int kt = 0; kt < 32; ++kt) {
        const int buf = kt % 3;
        if (kt + 2 < 32) P2_DMA_TILE(kt + 2, (kt + 2) % 3);
        LAS const char* sa = (LAS const char*)(lds + buf * CB_BUF) + hi * 1024 + r32 * 16;
        LAS const char* sb = (LAS const char*)(lds + buf * CB_BUF + 8192 * (ct + 1)) + half * 512 + hi * 1024 + r32 * 16;
#pragma unroll
        for (int d0 = 0; d0 < 4; ++d0) {
            const bf16x8 bf = *(LAS const bf16x8*)(sb + d0 * 2048), a0 = *(LAS const bf16x8*)(sa + d0 * 2048), a1 = *(LAS const bf16x8*)(sa + d0 * 2048 + 512);
            hT[0] = __builtin_amdgcn_mfma_f32_32x32x16_bf16(bf, a0, hT[0], 0, 0, 0);
            hT[1] = __builtin_amdgcn_mfma_f32_32x32x16_bf16(bf, a1, hT[1], 0, 0, 0);
        }
        if (kt + 2 < 32) asm volatile("s_waitcnt vmcnt(5) lgkmcnt(0)\n\ts_barrier" ::: "memory");
        else asm volatile("s_waitcnt vmcnt(0) lgkmcnt(0)\n\ts_barrier" ::: "memory");
    }
    const float* bias1 = (const float*)(ws + WS_SMALL + SM_BIAS1) + kv * 256 + ncol0;
    bf16x8 hb[2][2];
#pragma unroll
    for (int mt = 0; mt < 2; ++mt) {
        float g[16];
#pragma unroll
        for (int r = 0; r < 16; ++r) g[r] = gelu_tanh(hT[mt][r] + bias1[crow(r, hi)]);
#pragma unroll
        for (int s = 0; s < 2; ++s) { u32x4_t w; w.x = cvtpk_s(g[8 * s], g[8 * s + 1]); w.y = cvtpk_s(g[8 * s + 2], g[8 * s + 3]); w.z = cvtpk_s(g[8 * s + 4], g[8 * s + 5]); w.w = cvtpk_s(g[8 * s + 6], g[8 * s + 7]);
            hb[mt][s] = __builtin_bit_cast(bf16x8, w); }
    }
    const bf16_t* w2t = (const bf16_t*)(ws + WS_SMALL + SM_W2T) + (size_t)kv * 64 * 256;
    f32x16 oT[2][2];
#pragma unroll
    for (int dt = 0; dt < 2; ++dt)
#pragma unroll
        for (int mt = 0; mt < 2; ++mt) oT[dt][mt] = f32x16{};
#pragma unroll
    for (int dt = 0; dt < 2; ++dt)
#pragma unroll
        for (int s = 0; s < 2; ++s) {
            const bf16_t* wp = w2t + (size_t)(32 * dt + r32) * 256 + ncol0 + 16 * s + 4 * hi;
            const u32x2_t lo = *(const u32x2_t*)wp, hi2 = *(const u32x2_t*)(wp + 8);
            const u32x4_t wv = {lo.x, lo.y, hi2.x, hi2.y}; const bf16x8 wf = __builtin_bit_cast(bf16x8, wv);
#pragma unroll
            for (int mt = 0; mt < 2; ++mt) oT[dt][mt] = __builtin_amdgcn_mfma_f32_32x32x16_bf16(wf, hb[mt][s], oT[dt][mt], 0, 0, 0);
        }
    LAS float* part = (LAS float*)lds + wid * 64 * CP_STRIDE;
#pragma unroll
    for (int dt = 0; dt < 2; ++dt)
#pragma unroll
        for (int mt = 0; mt < 2; ++mt)
#pragma unroll
            for (int r = 0; r < 16; ++r) part[(32 * mt + r32) * CP_STRIDE + 32 * dt + crow(r, hi)] = oT[dt][mt][r];
    P2_WAIT_BAR();
    {
        const int tid = wid * 64 + lane, m = tid >> 3, dg = tid & 7;
        float o[8];
#pragma unroll
        for (int e = 0; e < 8; ++e) { float s = 0.f;
#pragma unroll
            for (int w = 0; w < 8; ++w) s += ((LAS const float*)lds)[(w * 64 + m) * CP_STRIDE + 8 * dg + e];
            o[e] = s; }
        if (kv == 0) {
            float ss = 0.f;
#pragma unroll
            for (int e = 0; e < 8; ++e) ss += o[e] * o[e];
            ss += __shfl_xor(ss, 1); ss += __shfl_xor(ss, 2); ss += __shfl_xor(ss, 4);
            const float rr = __builtin_amdgcn_rsqf(ss * (1.0f / 64.0f) + 1e-6f);
#pragma unroll
            for (int e = 0; e < 8; ++e) o[e] *= rr * P.in[4][8 * dg + e];
        }
        const int n = n0 + m;
        u32x4_t v = {0u, 0u, 0u, 0u};
        if (n < 255) { v.x = cvtpk_s(o[0], o[1]); v.y = cvtpk_s(o[2], o[3]); v.z = cvtpk_s(o[4], o[5]); v.w = cvtpk_s(o[6], o[7]); }
        *(u32x4_t*)((bf16_t*)(ws + (kv ? WS_VC : WS_KC)) + ((size_t)bg * 256 + n) * 64 + 8 * dg) = v;
    }
    P2_WAIT_BAR();
#undef P2_DMA_TILE
}

constexpr int G_V = 0, G_ST = 32768, G_OST = 33792, G_END = 33792 + 65536;
struct GmlpIn { u32x4_t raw[4]; u32x4_t uraw[4]; float sbv[4]; };
__device__ __forceinline__ void gmlp_load(GmlpIn& in, const Ptrs& P, int unit, int tid, int lane, int r32, int hi, int wid) {
    unsigned char* ws = P.ws;
    const int g = unit & 7, chunk = (unit >> 3) & 31, b = unit >> 8; const int m0 = b * SEQ + chunk * 128;
    const bf16_t* GV = (const bf16_t*)(ws + WS_GV); const bf16_t* U = (const bf16_t*)(ws + WS_U);
    const int tb = wid >> 1, ch = wid & 1; (void)r32; (void)hi;
#pragma unroll
    for (int i = 0; i < 4; ++i) { const int idx = tid + 512 * i, s = idx >> 4, c8 = idx & 15; in.raw[i] = *(const u32x4_t*)(GV + (size_t)(m0 + s) * 1024 + g * 128 + 8 * c8); }
#pragma unroll
    for (int i = 0; i < 4; ++i) { const int row = i * 8 + (lane >> 3), t = 32 * tb + row; in.uraw[i] = *(const u32x4_t*)(U + (size_t)(m0 + t) * 1024 + g * 128 + 64 * ch + 8 * (lane & 7)); in.sbv[i] = P.in[11][g * 128 + t]; }
}
__device__ __forceinline__ void gmlp_compute(const GmlpIn& in, const f32x4_t (&sv)[8], const bf16x8 (&pa)[2][4], const f32x4_t w0, const f32x4_t w1, const f32x4_t b0, const f32x4_t b1, const Ptrs& P, LAS unsigned char* lds, int unit, int tid, int lane, int r32, int hi, int wid) {
    unsigned char* ws = P.ws;
    const int g = unit & 7, chunk = (unit >> 3) & 31, b = unit >> 8; const int m0 = b * SEQ + chunk * 128;
    bf16_t* AB = (bf16_t*)(ws + WS_AB);
    LAS float* st = (LAS float*)(lds + G_ST);
    const int tb = wid >> 1, ch = wid & 1;
    if (tid < 128) { float s1 = 0.f, s2 = 0.f;
#pragma unroll
        for (int i = 0; i < 8; ++i) { s1 += sv[i][0] + sv[i][2]; s2 += sv[i][1] + sv[i][3]; }
        const float mean = s1 * (1.0f / 1024.0f); float var = s2 * (1.0f / 1024.0f) - mean * mean; var = var < 0.f ? 0.f : var;
        st[2 * tid] = mean; st[2 * tid + 1] = __builtin_amdgcn_rsqf(var + 1e-5f); }
    asm volatile("s_waitcnt lgkmcnt(0)\n\ts_barrier" ::: "memory");
#pragma unroll
    for (int i = 0; i < 4; ++i) { const int idx = tid + 512 * i, s = idx >> 4, c8 = idx & 15;
        float f[8]; unpack8(in.raw[i], f);
        const float mean = st[2 * s], rstd = st[2 * s + 1];
        float y[8];
#pragma unroll
        for (int e = 0; e < 4; ++e) { y[e] = (f[e] - mean) * rstd * w0[e] + b0[e]; y[4 + e] = (f[4 + e] - mean) * rstd * w1[e] + b1[e]; }
        u32x4_t o; o.x = cvtpk_s(y[0], y[1]); o.y = cvtpk_s(y[2], y[3]); o.z = cvtpk_s(y[4], y[5]); o.w = cvtpk_s(y[6], y[7]);
        const int st_ = s >> 6, sk = s & 63, chh = c8 >> 3, x = c8 & 7;
        *(LAS u32x4_t*)(lds + G_V + (st_ * 2 + chh) * 8192 + (x >> 2) * 4096 + (sk >> 4) * 1024 + (sk & 15) * 64 + (x & 3) * 16) = o; }
    asm volatile("s_waitcnt lgkmcnt(0)\n\ts_barrier" ::: "memory");
    f32x16 o[2]; o[0] = f32x16{}; o[1] = f32x16{};
    const int vb0 = (int)((unsigned)(uintptr_t)lds + G_V) + ((lane >> 4) & 1) * 32 + (lane & 3) * 8 + (4 * hi + ((lane & 15) >> 2)) * 64;
    nsa::pv(o, vb0 + ch * 8192, pa[0][0], pa[0][1], pa[0][2], pa[0][3]);
    if (tb >= 2) nsa::pv(o, vb0 + (2 + ch) * 8192, pa[1][0], pa[1][1], pa[1][2], pa[1][3]);
    LAS float* ostg = (LAS float*)(lds + G_OST) + wid * 2048;
#pragma unroll
    for (int r = 0; r < 16; ++r) { const int orow = crow(r, hi);
#pragma unroll
        for (int d0 = 0; d0 < 2; ++d0) ostg[orow * 64 + d0 * 32 + r32] = o[d0][r]; }
    asm volatile("s_waitcnt lgkmcnt(0)" ::: "memory");
#pragma unroll
    for (int i = 0; i < 4; ++i) { const int row = i * 8 + (lane >> 3), c8 = lane & 7, t = 32 * tb + row;
        const f32x4_t v0 = *(LAS const f32x4_t*)(ostg + row * 64 + c8 * 8), v1 = *(LAS const f32x4_t*)(ostg + row * 64 + c8 * 8 + 4);
        const size_t grow = (size_t)(m0 + t); const int col = g * 128 + 64 * ch + 8 * c8;
        float uf[8]; unpack8(in.uraw[i], uf);
        const float sb_ = in.sbv[i];
        u32x4_t w; w.x = cvtpk_s(uf[0] * (v0[0] + sb_), uf[1] * (v0[1] + sb_)); w.y = cvtpk_s(uf[2] * (v0[2] + sb_), uf[3] * (v0[3] + sb_));
        w.z = cvtpk_s(uf[4] * (v1[0] + sb_), uf[5] * (v1[1] + sb_)); w.w = cvtpk_s(uf[6] * (v1[2] + sb_), uf[7] * (v1[3] + sb_));
        *(u32x4_t*)(AB + grow * 2048 + 1024 + col) = w; }
    asm volatile("s_waitcnt lgkmcnt(0)\n\ts_barrier" ::: "memory");
}
__device__ __forceinline__ void gmlp_run(const Ptrs& P, LAS unsigned char* lds, int u0, int stride, int nunits, const int wave_s) {
    const int lane = fresh_lane(), r32 = lane & 31, hi = lane >> 5, wid = wave_s, tid = wid * 64 + lane;
    GmlpIn A, B;
    int u = u0;
    bf16x8 pa[2][4];
    { const bf16_t* SWB = (const bf16_t*)(P.ws + WS_SMALL + SM_SWB) + (size_t)(u0 & 7) * 16384; const int tb = wid >> 1;
#pragma unroll
      for (int st_ = 0; st_ < 2; ++st_)
#pragma unroll
        for (int ks = 0; ks < 4; ++ks) {
            const bf16_t* wp = SWB + (size_t)(32 * tb + r32) * 128 + 64 * st_ + 16 * ks + 4 * hi;
            const u32x2_t lo = *(const u32x2_t*)wp, hi2 = *(const u32x2_t*)(wp + 8);
            const u32x4_t wv = {lo.x, lo.y, hi2.x, hi2.y}; pa[st_][ks] = __builtin_bit_cast(bf16x8, wv); } }
    const int c8v = tid & 15, g0 = u0 & 7;
    const f32x4_t w0 = *(const f32x4_t*)(P.in[8] + g0 * 128 + 8 * c8v), w1 = *(const f32x4_t*)(P.in[8] + g0 * 128 + 8 * c8v + 4), b0 = *(const f32x4_t*)(P.in[9] + g0 * 128 + 8 * c8v), b1 = *(const f32x4_t*)(P.in[9] + g0 * 128 + 8 * c8v + 4);
    const float* VSTAT = (const float*)(P.ws + WS_VSTAT);
#define GMLP_STATS(sv_, unit_) do { const int m0_ = ((unit_) >> 8) * SEQ + (((unit_) >> 3) & 31) * 128; const f32x4_t* p_ = (const f32x4_t*)(VSTAT + (size_t)(m0_ + (tid & 127)) * 32); \
        _Pragma("unroll") for (int i_ = 0; i_ < 8; ++i_) sv_[i_] = p_[i_]; } while (0)
    f32x4_t sv[8];
    if (u < nunits) gmlp_load(A, P, u, tid, lane, r32, hi, wid);
    while (u < nunits) {
        GMLP_STATS(sv, u);
        if (u + stride < nunits) gmlp_load(B, P, u + stride, tid, lane, r32, hi, wid);
        gmlp_compute(A, sv, pa, w0, w1, b0, b1, P, lds, u, tid, lane, r32, hi, wid);
        u += stride; if (u >= nunits) break;
        GMLP_STATS(sv, u);
        if (u + stride < nunits) gmlp_load(A, P, u + stride, tid, lane, r32, hi, wid);
        gmlp_compute(B, sv, pa, w0, w1, b0, b1, P, lds, u, tid, lane, r32, hi, wid);
        u += stride;
    }
#undef GMLP_STATS
    asm volatile("s_waitcnt vmcnt(0) lgkmcnt(0)\n\ts_barrier" ::: "memory");
}
#undef P2_WAIT_BAR
}

#define XB_TMO      128
#define XB_XCNT(j)  (256  + 64 * (j))
#define XB_XSUB(j)  (1280 + 64 * (j))
#define XB_XGEN(j)  (2304 + 64 * (j))
#define XB_TOP      3328
#define XB_TOPGEN   3392
#define XCD_BAR_WORDS 3456
#define XB_SPIN_CAP (1u << 18)

__device__ __forceinline__ unsigned xb_ld(unsigned* p)              { return __hip_atomic_load(p, __ATOMIC_RELAXED, __HIP_MEMORY_SCOPE_AGENT); }
__device__ __forceinline__ unsigned xb_add(unsigned* p, unsigned v) { return __hip_atomic_fetch_add(p, v, __ATOMIC_RELAXED, __HIP_MEMORY_SCOPE_AGENT); }
__device__ __forceinline__ unsigned xb_xcc_id() { return (unsigned)__builtin_amdgcn_s_getreg((3 << 11) | 20) & 0xFu; }
#define XB_SPIN(cond, bar) do { unsigned _sp = 0; while (cond) { __builtin_amdgcn_s_sleep(1); \
    if ((++_sp & 255u) == 0u) { if (xb_ld(&(bar)[XB_TMO])) break; if (_sp > XB_SPIN_CAP) { atomicAdd(&(bar)[XB_TMO], 1u); break; } } } } while (0)

struct XcdBarrier {
    unsigned* bar; unsigned x; unsigned w0;
    volatile LAS unsigned* st;
};

__device__ __forceinline__ XcdBarrier xcd_barrier_post(unsigned* bar, volatile LAS unsigned* st, int wave_s) {
    XcdBarrier b; b.bar = bar; b.x = xb_xcc_id(); b.st = st; b.w0 = wave_s == 0 ? 1u : 0u;
    if (b.w0 && fresh_lane() == 0) (void)xb_add(&bar[XB_XCNT(b.x)], 1u);
    return b;
}
__device__ __forceinline__ void xcd_barrier_complete(unsigned* bar, unsigned x, unsigned& nloc, unsigned& nx) {
    const unsigned G = gridDim.x * gridDim.y * gridDim.z;
    unsigned sum, cnt, mine, sp = 0u;
    for (;;) {
        sum = 0u; cnt = 0u; mine = 0u;
#pragma unroll
        for (unsigned j = 0; j < 16; ++j) { const unsigned c = xb_ld(&bar[XB_XCNT(j)]); sum += c; cnt += (c > 0u) ? 1u : 0u; mine = (j == x) ? c : mine; }
        if (sum == G) break;
        __builtin_amdgcn_s_sleep(1);
        if ((++sp & 255u) == 0u) { if (xb_ld(&bar[XB_TMO])) break; if (sp > XB_SPIN_CAP) { atomicAdd(&bar[XB_TMO], 1u); break; } }
    }
    nloc = mine > 0u ? mine : 1u; nx = cnt > 0u ? cnt : 1u;
}

__device__ __forceinline__ void xcd_barrier(const XcdBarrier& b) {
    asm volatile("s_waitcnt vmcnt(0)" ::: "memory");
    __syncthreads();
    if (b.w0 && fresh_lane() == 0) {
        unsigned* bar = b.bar;
        __builtin_amdgcn_s_waitcnt(0);
        unsigned nloc = b.st[0], nx = b.st[1];
        if (nloc == 0u) { xcd_barrier_complete(bar, b.x, nloc, nx); b.st[0] = nloc; b.st[1] = nx; }
        const unsigned old = xb_add(&bar[XB_XSUB(b.x)], 1u);
        const unsigned gen = old / nloc;
        if (old + 1u == (gen + 1u) * nloc) {
            __builtin_amdgcn_fence(__ATOMIC_RELEASE, "agent");
            asm volatile("s_waitcnt vmcnt(0)" ::: "memory");
            const unsigned og = xb_add(&bar[XB_TOP], 1u);
            const unsigned tg = og / nx;
            if (og + 1u == (tg + 1u) * nx) xb_add(&bar[XB_TOPGEN], 1u);
            else XB_SPIN(xb_ld(&bar[XB_TOPGEN]) == tg, bar);
            __builtin_amdgcn_fence(__ATOMIC_ACQUIRE, "agent");
            xb_add(&bar[XB_XGEN(b.x)], 1u);
            asm volatile("s_waitcnt vmcnt(0)" ::: "memory");
        } else {
            XB_SPIN(xb_ld(&bar[XB_XGEN(b.x)]) == gen, bar);
            __builtin_amdgcn_fence(__ATOMIC_ACQUIRE, "agent");
            asm volatile("s_waitcnt vmcnt(0)" ::: "memory");
        }
    }
    __syncthreads();
}

constexpr int LDS_BYTES = 151552;
constexpr int LDS_XCH = 132096;
constexpr int LDS_MISC = 145408;
__global__ void __launch_bounds__(512, 2) mega_fwd(Ptrs P) {
    extern __shared__ __attribute__((aligned(16))) unsigned char lds_raw[];
    LAS unsigned char* lds = (LAS unsigned char*)lds_raw;
    unsigned char* ws = P.ws;
    const int wave = __builtin_amdgcn_readfirstlane(threadIdx.x >> 6);
    const int G = gridDim.x, bid = blockIdx.x;
    if (wave == 0) { const int l_ = fresh_lane(); if (l_ < 2) ((LAS unsigned*)(lds + LDS_MISC))[l_] = 0u; }
    __syncthreads();
    const XcdBarrier bar = xcd_barrier_post((unsigned*)(ws + WS_CTL), (volatile LAS unsigned*)(lds + LDS_MISC), wave);
    p0_prologue(P, lds, bid, G, wave);
    xcd_barrier(bar);
    if (bid == 0) bias1_stage(ws, fresh_tid(wave));
    {
        pg8::Gemm g{(const bf16_t*)(ws + WS_XN), (const bf16_t*)(ws + WS_WIN), MTOK, NPROJ, 2048, 2048};
        pg8::StaticOrder S; S.init(MTOK, NPROJ, G, bid);
        pg8::EpiProj E{(bf16_t*)(ws + WS_Q), (bf16_t*)(ws + WS_KV6), (bf16_t*)(ws + WS_U), (bf16_t*)(ws + WS_GV), (float*)(ws + WS_GATES), (float*)(ws + WS_VSTAT), P.in[3], P.in[4]};
        pg8::gemm_phase<pg8::EpiProj, pg8::StaticOrder, true, true>(lds, g, S, E, wave);
    }
    xcd_barrier(bar);
    if (bid < 128 && G >= 256) p2::compress_unit(P, lds, bid, wave);
    else if (G >= 256) p2::gmlp_run(P, lds, bid - 128, G - 128, 1024, wave);
    xcd_barrier(bar);
    nsa::nsa_phase(P, lds, bid, G, wave);
    xcd_barrier(bar);
    {
        pg8::Gemm g{(const bf16_t*)(ws + WS_AB), (const bf16_t*)(ws + WS_WOUT), MTOK, 2048, 2048, 2048};
        pg8::StaticOrder S; S.init(MTOK, 2048, G, bid);
        pg8::EpiRes1 E{(const float*)(ws + WS_SMALL + SM_RINV), (const float*)(ws + WS_SMALL + SM_INVW), (bf16_t*)(ws + WS_XN), (float*)(ws + WS_SSQ)};
        pg8::gemm_phase<pg8::EpiRes1, pg8::StaticOrder, true, true>(lds, g, S, E, wave);
    }
    xcd_barrier(bar);
    for (int m = bid * 512 + fresh_tid(wave); m < MTOK; m += G * 512) {
        const float* p = (const float*)(ws + WS_SSQ) + (size_t)m * 32; float s = 0.f;
#pragma unroll
        for (int i = 0; i < 32; ++i) s += p[i];
        ((float*)(ws + WS_SMALL + SM_R2))[m] = __builtin_amdgcn_rsqf(s * (1.0f / D_MODEL) + 1e-6f);
    }
    xcd_barrier(bar);
    {
        pg8::Gemm g{(const bf16_t*)(ws + WS_XN), (const bf16_t*)(ws + WS_WUP), MTOK, N_UP, 2048, 2048};
        pg8::StaticOrder S; S.init(MTOK, N_UP, G, bid);
        pg8::EpiUpConv E{(bf16_t*)(ws + WS_G), (const float*)(ws + WS_SMALL + SM_R2), P.in[15], P.in[16], (float*)(ws + WS_HLAST), (float*)(ws + WS_FIRST), lds + LDS_XCH};
        pg8::gemm_phase<pg8::EpiUpConv, pg8::StaticOrder, true, true>(lds, g, S, E, wave);
    }
    xcd_barrier(bar);
    for (int it = bid * 512 + fresh_tid(wave); it < 60 * 44 * 2 * 16; it += G * 512) {
        const int c8 = it & 15, row = (it >> 4) & 1, tl_ = it >> 5, pn = tl_ % 44, pmi = tl_ / 44, pm = pmi + pmi / 15 + 1;
        const float* cw = P.in[15]; const float* cb = P.in[16]; (void)cb;
        const float* fp = (const float*)(ws + WS_FIRST) + ((size_t)(pm * 44 + pn) * 2 + row) * 256 + 8 * c8;
        const float* lp = (const float*)(ws + WS_HLAST) + ((size_t)((pm - 1) * 44 + pn) * 2) * 256 + 8 * c8;
        const int ch = pn * 128 + 8 * c8;
        float r[8];
#pragma unroll
        for (int e = 0; e < 8; ++e) {
            const float l0g = lp[e], l1g = lp[256 + e], l0u = lp[128 + e], l1u = lp[256 + 128 + e];
            const float w0g = cw[ch + e], w1g = cw[N_UP + ch + e], w0u = cw[D_FF + ch + e], w1u = cw[N_UP + D_FF + ch + e];
            const float cg = fp[e] + (row == 0 ? w1g * l1g + w0g * l0g : w0g * l1g), cu = fp[128 + e] + (row == 0 ? w1u * l1u + w0u * l0u : w0u * l1u);
            r[e] = cg * sigmoidf_(cg) * cu;
        }
        u32x4_t o; o.x = pk2(r[0], r[1]); o.y = pk2(r[2], r[3]); o.z = pk2(r[4], r[5]); o.w = pk2(r[6], r[7]);
        *(u32x4_t*)((bf16_t*)(ws + WS_G) + (size_t)(pm * 256 + row) * D_FF + ch) = o;
    }
    xcd_barrier(bar);
    {
        pg8::Gemm g{(const bf16_t*)(ws + WS_G), (const bf16_t*)(ws + WS_WDOWN), MTOK, 2048, D_FF, D_FF};
        pg8::StaticOrder S; S.init(MTOK, 2048, G, bid);
        pg8::EpiDown E{P.out, (const bf16_t*)(ws + WS_XN)};
        pg8::gemm_phase<pg8::EpiDown, pg8::StaticOrder, true, true>(lds, g, S, E, wave);
    }
}

extern "C" void kernel_launch(void* const* d_in, const int* in_sizes, int n_in, void* d_out, int out_size, void* d_ws, size_t ws_size, hipStream_t stream) {
    static int grid_blocks = 0;
    if (!grid_blocks) {
        int dev = 0, cus = 0, per_cu = 0;
        (void)hipGetDevice(&dev);
        (void)hipDeviceGetAttribute(&cus, hipDeviceAttributeMultiprocessorCount, dev);
        (void)hipFuncSetAttribute((const void*)mega_fwd, hipFuncAttributeMaxDynamicSharedMemorySize, LDS_BYTES);
        (void)hipOccupancyMaxActiveBlocksPerMultiprocessor(&per_cu, (const void*)mega_fwd, 512, LDS_BYTES);
        if (per_cu < 1) { fprintf(stderr, "kernel_launch: occupancy query says %d blocks/CU\n", per_cu); per_cu = 1; }
        grid_blocks = cus * 1;
        (void)hipGetLastError();
    }
    if (n_in != 18 || ws_size < WS_END) { fprintf(stderr, "kernel_launch: unexpected n_in %d / ws %zu\n", n_in, ws_size); return; }
    Ptrs P{};
    for (int i = 0; i < 18; ++i) P.in[i] = (const float*)d_in[i];
    P.out = (float*)d_out; P.ws = (unsigned char*)d_ws;
    (void)hipMemsetAsync((char*)d_ws + WS_CTL, 0, 16384, stream);
    mega_fwd<<<dim3(grid_blocks), dim3(512), LDS_BYTES, stream>>>(P);
}
```

```cpp
#include <hip/hip_runtime.h>
#include <cstdio>
#include <cstdint>

constexpr int D_MODEL = 2048, BATCH = 4, SEQ = 4096, MTOK = BATCH * SEQ;
constexpr int IN_COLS = 4656, NPROJ = 4864;
constexpr int D_FF = 5632, N_UP = 2 * D_FF;
constexpr int NBG = 16;
constexpr size_t KVSZ = (size_t)NBG * SEQ * 64;
constexpr float LOG2E = 1.4426950408889634f;

constexpr size_t MiB = 1u << 20;
constexpr size_t WS_CTL = 0;
constexpr size_t WS_WIN = 1 * MiB, WS_WOUT = 20 * MiB, WS_WUP = 28 * MiB, WS_WDOWN = 72 * MiB, WS_W1C = 94 * MiB;
constexpr size_t WS_SMALL = 96 * MiB;
constexpr size_t SM_BIASP = 0, SM_BIAS1 = 65536, SM_R2 = 131072, SM_W2T = 196608  , SM_SWB = 262144  , SM_RINV = 524288  , SM_INVW = 589824  ;
constexpr size_t WS_XN = 97 * MiB;
constexpr size_t WS_Q = 161 * MiB;
constexpr size_t WS_KV6 = 193 * MiB;
constexpr size_t WS_U = 241 * MiB, WS_GV = 273 * MiB;
constexpr size_t WS_GATES = 305 * MiB;
constexpr size_t WS_VSTAT = 308 * MiB;
constexpr size_t WS_KC = 310 * MiB, WS_VC = 310 * MiB + 524288;
constexpr size_t WS_HC = 311 * MiB;
constexpr size_t WS_AB = 315 * MiB;
constexpr size_t WS_SSQ = 379 * MiB;
constexpr size_t WS_G = 161 * MiB;
constexpr size_t WS_HID = 381 * MiB;
constexpr size_t WS_HLAST = 381 * MiB, WS_FIRST = 388 * MiB;
constexpr size_t WS_END = 469 * MiB;

#define LAS __attribute__((address_space(3)))
typedef unsigned short bf16_t;
typedef unsigned u32x4_t __attribute__((ext_vector_type(4)));
typedef unsigned u32x2_t __attribute__((ext_vector_type(2)));
typedef float f32x4_t __attribute__((ext_vector_type(4)));

__device__ __forceinline__ float bf2f(unsigned short h) { return __uint_as_float(((unsigned)h) << 16); }
__device__ __forceinline__ unsigned f2bf(float f) { unsigned u = __float_as_uint(f); return (u + 0x7fffu + ((u >> 16) & 1u)) >> 16; }
__device__ __forceinline__ unsigned pk2(float lo, float hi) { return f2bf(lo) | (f2bf(hi) << 16); }
__device__ __forceinline__ float gelu_tanh(float x) {
    const float u = 0.7978845608028654f * (x + 0.044715f * x * x * x);
    const float e = __builtin_amdgcn_exp2f(-2.8853900817779268f * u);
    return x * __builtin_amdgcn_rcpf(1.0f + e);
}
__device__ __forceinline__ float sigmoidf_(float x) { return __builtin_amdgcn_rcpf(1.0f + __builtin_amdgcn_exp2f(-LOG2E * x)); }
__device__ __forceinline__ float wave_sum(float v) {
#pragma unroll
    for (int o = 1; o < 64; o <<= 1) v += __shfl_xor(v, o);
    return v;
}
__device__ __forceinline__ void unpack8(u32x4_t r, float (&f)[8]) {
    f[0] = __uint_as_float(r.x << 16); f[1] = __uint_as_float(r.x & 0xffff0000u);
    f[2] = __uint_as_float(r.y << 16); f[3] = __uint_as_float(r.y & 0xffff0000u);
    f[4] = __uint_as_float(r.z << 16); f[5] = __uint_as_float(r.z & 0xffff0000u);
    f[6] = __uint_as_float(r.w << 16); f[7] = __uint_as_float(r.w & 0xffff0000u);
}

__device__ __forceinline__ int fresh_lane() { unsigned z_ = 0u; asm volatile("" : "+v"(z_)); return (int)__builtin_amdgcn_mbcnt_hi(~0u, __builtin_amdgcn_mbcnt_lo(~0u, z_)); }
__device__ __forceinline__ int fresh_tid(int wave_s) { return wave_s * 64 + fresh_lane(); }
namespace pg8 {
#define PG8_LAS __attribute__((address_space(3)))
typedef unsigned short bf16_t;
typedef short bf16x8 __attribute__((ext_vector_type(8)));
typedef float f32x4 __attribute__((ext_vector_type(4)));
typedef unsigned u32x4 __attribute__((ext_vector_type(4)));
constexpr int BM = 256, BK = 64, HALF = 128, HTB = HALF * BK * 2  , STAGE_BYTES = 8 * HTB, NXCD = 8, WGM = 8;

__host__ __device__ __forceinline__ int lds_byte(int r, int c) { const int st = (r >> 4) * 2 + (c >> 5), rr = r & 15, cc = c & 31, ob = rr * 64 + cc * 2; return st * 1024 + (ob ^ (((ob >> 9) & 1) << 5)); }
__host__ __device__ __forceinline__ void stage_rc(int b, int& R, int& C) { const int st = b / 1024, sb = b % 1024, swz = sb ^ (((sb >> 9) & 1) << 5); R = (st >> 1) * 16 + swz / 64; C = (st & 1) * 32 + (swz % 64) / 2; }
__host__ __device__ __forceinline__ int perm32(int rho) { const int n = rho >> 4, i = rho & 15; return 8 * (i >> 2) + 4 * n + (i & 3); }

struct Unit { int pm, pn; };
struct Gemm { const bf16_t* A; const bf16_t* Bt; int M, N, K, lda; };

struct StaticOrder {
    int nM, nN, nwg, G, c;
    __host__ __device__ void init(int M, int N, int G_, int c_) { nM = M / BM; nN = N / BM; nwg = nM * nN; G = G_; c = c_; }
    __host__ __device__ bool next(int i, Unit& u) const {
        const long L = (long)i * G + c; if (L >= nwg) return false;
        int wgid = (int)L; { const int q = nwg / NXCD, r = nwg % NXCD, xcd = wgid % NXCD, off = wgid / NXCD; wgid = (xcd < r ? xcd * (q + 1) : r * (q + 1) + (xcd - r) * q) + off; }
        const int nig = WGM * nN, gid = wgid / nig, fm = gid * WGM, gsz = (nM - fm) < WGM ? (nM - fm) : WGM;
        u.pm = fm + ((wgid % nig) % gsz); u.pn = (wgid % nig) / gsz; return true;
    }
    __device__ __forceinline__ void a_ready(const Unit&) const {}
    __device__ __forceinline__ void done(const Unit&) const {}
};

__device__ __forceinline__ unsigned cvt_pk_bf16(float lo, float hi) { unsigned r; asm volatile("v_cvt_pk_bf16_f32 %0, %1, %2" : "=v"(r) : "v"(lo), "v"(hi)); return r; }

struct EpiProj {
    static constexpr bool PERM = true, AFTER_DRAIN = false, PERMA = false;
    bf16_t* Q; bf16_t* KV6; bf16_t* U; bf16_t* GV; float* GATES; float* VSTAT; const float* q_norm_w; const float* k_norm_w;
    __device__ __forceinline__ void operator()(const f32x4 (&acc)[2][2][4][2], const Unit& u, int wr, int wc, int fr, int fq) const {
        const int pn = u.pn, row0 = u.pm * BM + wr * 64 + fr;
        if (pn < 10) {
            const bool normed = (pn < 4) || pn == 6 || pn == 8;
            const float* w = pn < 4 ? q_norm_w : (k_norm_w + (pn == 6 ? 64 : 128));
            const float sc = pn < 4 ? 0.125f * LOG2E : 1.0f;
            f32x4 wv[2][2];
#pragma unroll
            for (int bj = 0; bj < 2; ++bj)
#pragma unroll
                for (int n = 0; n < 2; ++n) wv[bj][n] = normed ? (*(const f32x4*)(w + 32 * bj + 8 * fq + 4 * n)) * sc : (f32x4){1.f, 1.f, 1.f, 1.f};
#pragma unroll
            for (int ai = 0; ai < 2; ++ai)
#pragma unroll
                for (int m = 0; m < 4; ++m) {
                    const int row = row0 + ai * HALF + m * 16;
                    float r = 1.f;
                    if (normed) {
                        float ss = 0.f;
#pragma unroll
                        for (int bj = 0; bj < 2; ++bj)
#pragma unroll
                            for (int n = 0; n < 2; ++n) { const f32x4 x = acc[ai][bj][m][n]; ss += (x[0] * x[0] + x[1] * x[1]) + (x[2] * x[2] + x[3] * x[3]); }
                        ss += __shfl_xor(ss, 16); ss += __shfl_xor(ss, 32);
                        r = __builtin_amdgcn_rsqf(ss * (1.0f / 64.0f) + 1e-6f);
                    }
                    bf16_t* dst;
                    if (pn < 4) dst = Q + (size_t)row * 1024 + pn * 256 + wc * 64 + 8 * fq;
                    else { const int b = row >> 12, t = row & 4095; dst = KV6 + (size_t)(pn - 4) * KVSZ + ((size_t)((b * 4 + wc) * 4096 + t)) * 64 + 8 * fq; }
#pragma unroll
                    for (int bj = 0; bj < 2; ++bj) {
                        const f32x4 v0 = acc[ai][bj][m][0] * r * wv[bj][0], v1 = acc[ai][bj][m][1] * r * wv[bj][1];
                        u32x4 o; o.x = cvt_pk_bf16(v0[0], v0[1]); o.y = cvt_pk_bf16(v0[2], v0[3]); o.z = cvt_pk_bf16(v1[0], v1[1]); o.w = cvt_pk_bf16(v1[2], v1[3]);
                        *(u32x4*)(dst + 32 * bj) = o;
                    }
                }
        } else if (pn < 18) {
            const bool isv = pn >= 14; const int ct = isv ? pn - 14 : pn - 10;
            bf16_t* base = (isv ? GV : U) + ct * 256 + wc * 64 + 8 * fq;
#pragma unroll
            for (int ai = 0; ai < 2; ++ai)
#pragma unroll
                for (int m = 0; m < 4; ++m) {
                    const int row = row0 + ai * HALF + m * 16; float s1 = 0.f, s2 = 0.f;
#pragma unroll
                    for (int bj = 0; bj < 2; ++bj) {
                        f32x4 v0 = acc[ai][bj][m][0], v1 = acc[ai][bj][m][1];
#pragma unroll
                        for (int e = 0; e < 4; ++e) { v0[e] = gelu_tanh(v0[e]); v1[e] = gelu_tanh(v1[e]); s1 += v0[e] + v1[e]; s2 += v0[e] * v0[e] + v1[e] * v1[e]; }
                        u32x4 o; o.x = cvt_pk_bf16(v0[0], v0[1]); o.y = cvt_pk_bf16(v0[2], v0[3]); o.z = cvt_pk_bf16(v1[0], v1[1]); o.w = cvt_pk_bf16(v1[2], v1[3]);
                        *(u32x4*)(base + (size_t)row * 1024 + 32 * bj) = o;
                    }
                    if (isv) {
                        s1 += __shfl_xor(s1, 16); s1 += __shfl_xor(s1, 32); s2 += __shfl_xor(s2, 16); s2 += __shfl_xor(s2, 32);
                        if (fq == 0) { float* p = VSTAT + ((size_t)row * 16 + ct * 4 + wc) * 2; p[0] = s1; p[1] = s2; }
                    }
                }
        } else {
            if (wc == 0) {
#pragma unroll
                for (int ai = 0; ai < 2; ++ai)
#pragma unroll
                    for (int m = 0; m < 4; ++m) {
                        const int row = row0 + ai * HALF + m * 16;
#pragma unroll
                        for (int bj = 0; bj < 2; ++bj)
#pragma unroll
                            for (int n = 0; n < 2; ++n) {
                                const int L = 32 * bj + 8 * fq + 4 * n;
                                if (L < 48) { f32x4 v = acc[ai][bj][m][n]; f32x4 o; o[0] = sigmoidf_(v[0]); o[1] = sigmoidf_(v[1]); o[2] = sigmoidf_(v[2]); o[3] = sigmoidf_(v[3]); *(f32x4*)(GATES + (size_t)row * 48 + L) = o; }
                            }
                    }
            }
        }
    }
};
struct EpiCmp {
    static constexpr bool PERM = true, AFTER_DRAIN = false, PERMA = false;
    bf16_t* HC; const float* bias1;
    __device__ __forceinline__ void operator()(const f32x4 (&acc)[2][2][4][2], const Unit& u, int wr, int wc, int fr, int fq) const {
        const int row0 = u.pm * BM + wr * 64 + fr, col0 = wc * 32 + 8 * fq;
        f32x4 bv[2][2];
#pragma unroll
        for (int bj = 0; bj < 2; ++bj)
#pragma unroll
            for (int n = 0; n < 2; ++n) bv[bj][n] = *(const f32x4*)(bias1 + u.pn * 256 + col0 + bj * HALF + 4 * n);
#pragma unroll
        for (int ai = 0; ai < 2; ++ai)
#pragma unroll
            for (int m = 0; m < 4; ++m) { bf16_t* rowp = HC + (size_t)(row0 + ai * HALF + m * 16) * 256 + col0;
#pragma unroll
                for (int bj = 0; bj < 2; ++bj) { f32x4 v0 = acc[ai][bj][m][0] + bv[bj][0], v1 = acc[ai][bj][m][1] + bv[bj][1];
#pragma unroll
                    for (int e = 0; e < 4; ++e) { v0[e] = gelu_tanh(v0[e]); v1[e] = gelu_tanh(v1[e]); }
                    u32x4 o; o.x = cvt_pk_bf16(v0[0], v0[1]); o.y = cvt_pk_bf16(v0[2], v0[3]); o.z = cvt_pk_bf16(v1[0], v1[1]); o.w = cvt_pk_bf16(v1[2], v1[3]);
                    *(u32x4*)(rowp + bj * HALF) = o; } }
    }
};
struct CmpOrder {
    int c, G;
    __device__ bool next(int i, Unit& u) const { const int L = i * G + c; if (L >= 32) return false; u.pm = L; u.pn = L >> 4; return true; }
    __device__ __forceinline__ void a_ready(const Unit&) const {}
    __device__ __forceinline__ void done(const Unit&) const {}
};
struct EpiRes1 {
    static constexpr bool PERM = false, AFTER_DRAIN = false, PERMA = false;
    const float* RINV; const float* INVW; bf16_t* X1b; float* SSQ;
    __device__ __forceinline__ void operator()(const f32x4 (&acc)[2][2][4][2], const Unit& u, int wr, int wc, int fr, int fq) const {
        const int row0 = u.pm * BM + wr * 64 + fr, col0 = u.pn * BM + wc * 32 + 4 * fq;
        f32x4 iw[2][2];
#pragma unroll
        for (int bj = 0; bj < 2; ++bj)
#pragma unroll
            for (int n = 0; n < 2; ++n) iw[bj][n] = *(const f32x4*)(INVW + col0 + bj * HALF + n * 16);
#pragma unroll
        for (int ai = 0; ai < 2; ++ai) {
            u32x2_t xin[4][2][2]; float ri[4];
#pragma unroll
            for (int m = 0; m < 4; ++m) { ri[m] = RINV[row0 + ai * HALF + m * 16];
#pragma unroll
                for (int bj = 0; bj < 2; ++bj)
#pragma unroll
                    for (int n = 0; n < 2; ++n) xin[m][bj][n] = *(const u32x2_t*)(X1b + (size_t)(row0 + ai * HALF + m * 16) * D_MODEL + col0 + bj * HALF + n * 16); }
            __builtin_amdgcn_sched_barrier(0);
#pragma unroll
            for (int m = 0; m < 4; ++m) { const int row = row0 + ai * HALF + m * 16; const size_t off = (size_t)row * D_MODEL + col0; float ss = 0.f;
#pragma unroll
                for (int bj = 0; bj < 2; ++bj)
#pragma unroll
                    for (int n = 0; n < 2; ++n) { const u32x2_t w_ = xin[m][bj][n];
                        f32x4 xv; xv[0] = __uint_as_float(w_.x << 16); xv[1] = __uint_as_float(w_.x & 0xffff0000u); xv[2] = __uint_as_float(w_.y << 16); xv[3] = __uint_as_float(w_.y & 0xffff0000u);
                        const f32x4 v = xv * ri[m] * iw[bj][n] + acc[ai][bj][m][n];
                        ss += (v[0] * v[0] + v[1] * v[1]) + (v[2] * v[2] + v[3] * v[3]);
                        u32x2_t w; w.x = cvt_pk_bf16(v[0], v[1]); w.y = cvt_pk_bf16(v[2], v[3]); *(u32x2_t*)(X1b + off + bj * HALF + n * 16) = w; }
                ss += __shfl_xor(ss, 16); ss += __shfl_xor(ss, 32);
                if (fq == 0) SSQ[(size_t)row * 32 + u.pn * 4 + wc] = ss; }
            __builtin_amdgcn_sched_barrier(0);
        }
    }
};
struct EpiUpV1 {
    static constexpr bool PERM = true, AFTER_DRAIN = false, PERMA = false;
    bf16_t* HID; const float* R2;
    __device__ __forceinline__ void operator()(const f32x4 (&acc)[2][2][4][2], const Unit& u, int wr, int wc, int fr, int fq) const {
        const int row0 = u.pm * BM + wr * 64 + fr, col0 = u.pn * BM + wc * 32 + 8 * fq;
#pragma unroll
        for (int ai = 0; ai < 2; ++ai)
#pragma unroll
            for (int m = 0; m < 4; ++m) { const int row = row0 + ai * HALF + m * 16; const float r = R2[row]; bf16_t* rowp = HID + (size_t)row * N_UP + col0;
#pragma unroll
                for (int bj = 0; bj < 2; ++bj) { const f32x4 v0 = acc[ai][bj][m][0] * r, v1 = acc[ai][bj][m][1] * r;
                    u32x4 o; o.x = cvt_pk_bf16(v0[0], v0[1]); o.y = cvt_pk_bf16(v0[2], v0[3]); o.z = cvt_pk_bf16(v1[0], v1[1]); o.w = cvt_pk_bf16(v1[2], v1[3]);
                    *(u32x4*)(rowp + bj * HALF) = o; } }
    }
};
struct EpiDown {
    static constexpr bool PERM = false, AFTER_DRAIN = false, PERMA = false;
    float* out; const bf16_t* X1b;
    __device__ __forceinline__ void operator()(const f32x4 (&acc)[2][2][4][2], const Unit& u, int wr, int wc, int fr, int fq) const {
        const int row0 = u.pm * BM + wr * 64 + fr, col0 = u.pn * BM + wc * 32 + 4 * fq;
#pragma unroll
        for (int ai = 0; ai < 2; ++ai) {
            u32x2_t xin[4][2][2];
#pragma unroll
            for (int m = 0; m < 4; ++m)
#pragma unroll
                for (int bj = 0; bj < 2; ++bj)
#pragma unroll
                    for (int n = 0; n < 2; ++n) xin[m][bj][n] = *(const u32x2_t*)(X1b + (size_t)(row0 + ai * HALF + m * 16) * D_MODEL + col0 + bj * HALF + n * 16);
            __builtin_amdgcn_sched_barrier(0);
#pragma unroll
            for (int m = 0; m < 4; ++m) { const size_t off = (size_t)(row0 + ai * HALF + m * 16) * D_MODEL + col0;
#pragma unroll
                for (int bj = 0; bj < 2; ++bj)
#pragma unroll
                    for (int n = 0; n < 2; ++n) { const u32x2_t w = xin[m][bj][n];
                        f32x4 v; v[0] = __uint_as_float(w.x << 16); v[1] = __uint_as_float(w.x & 0xffff0000u); v[2] = __uint_as_float(w.y << 16); v[3] = __uint_as_float(w.y & 0xffff0000u);
                        *(f32x4*)(out + off + bj * HALF + n * 16) = v + acc[ai][bj][m][n]; } }
            __builtin_amdgcn_sched_barrier(0);
        }
    }
};
__device__ __forceinline__ unsigned f2bf_(float f) { unsigned u = __float_as_uint(f); return (u + 0x7fffu + ((u >> 16) & 1u)) >> 16; }
typedef float f32x2 __attribute__((ext_vector_type(2)));
struct EpiUpConv {
    static constexpr bool PERM = true, AFTER_DRAIN = false, PERMA = true;
    bf16_t* G; const float* R2; const float* cw; const float* cb; float* HLAST; float* FIRST; PG8_LAS unsigned char* xlds;
    __device__ __forceinline__ void prefetch(const Unit& u, int par, const int wave_s) const {
        const int lane_ = fresh_lane();
        PG8_LAS float* Wl = (PG8_LAS float*)xlds + (par ? 3344 : 2048);
#pragma unroll
        for (int i2 = 0; i2 < 2; ++i2) { const int i = wave_s * 64 + lane_ + 512 * i2, k = i >> 8, p = i & 255, c = (p < 128 ? 0 : D_FF - 128) + u.pn * 128 + p;
            const float* src = k < 3 ? cw + (unsigned)(k * N_UP + c) : cb + (unsigned)c;
            __builtin_amdgcn_global_load_lds((const unsigned*)src, (PG8_LAS unsigned*)(Wl + wave_s * 64 + 512 * i2), 4, 0, 0); }
        if (wave_s < 4) __builtin_amdgcn_global_load_lds((const unsigned*)(R2 + u.pm * BM + wave_s * 64 + lane_), (PG8_LAS unsigned*)(Wl + 1024 + wave_s * 64), 4, 0, 0);
    }
    __device__ __forceinline__ void run(const f32x4 (&acc)[2][2][4][2], const Unit& u, const Unit& nxt, const bool has_next, const int par, int wr, int wc, const int wave_s) const {
        unsigned z_ = 0u; asm volatile("" : "+v"(z_));
        const int lane_ = (int)__builtin_amdgcn_mbcnt_hi(~0u, __builtin_amdgcn_mbcnt_lo(~0u, z_)); const int fr = lane_ & 15, fq = lane_ >> 4;
        const int row0 = u.pm * BM + wr * 64 + 4 * fr;
        PG8_LAS float* X = (PG8_LAS float*)xlds;
        PG8_LAS float* Wl = X + (par ? 3344 : 2048);
        PG8_LAS float* R2L = Wl + 1024;
        const unsigned tile = (unsigned)(u.pm * (N_UP / 256) + u.pn);
        asm volatile("s_waitcnt vmcnt(8)" ::: "memory"); __builtin_amdgcn_s_barrier(); asm volatile("" ::: "memory");
        if (has_next) prefetch(nxt, par ^ 1, wave_s);
        if (fr == 15) {
#pragma unroll
            for (int ai = 0; ai < 2; ++ai) { const int sg = 2 * ai + wr; const float r2a = R2L[ai * HALF + wr * 64 + 62], r2b = R2L[ai * HALF + wr * 64 + 63];
#pragma unroll
                for (int mm = 0; mm < 2; ++mm)
#pragma unroll
                for (int bj = 0; bj < 2; ++bj)
#pragma unroll
                    for (int n = 0; n < 2; ++n) { const f32x4 h = acc[ai][bj][2 + mm][n] * (mm ? r2b : r2a);
                        *(PG8_LAS f32x4*)(X + ((sg * 4 + wc) * 2 + mm) * 64 + bj * 32 + 8 * fq + 4 * n) = h;
                        if (ai == 1 && wr == 1) *(f32x4*)(HLAST + (unsigned)((tile * 2 + mm) * 256 + bj * HALF + wc * 32 + 8 * fq + 4 * n)) = h; } }
        }
        asm volatile("s_waitcnt lgkmcnt(0)" ::: "memory"); __builtin_amdgcn_s_barrier(); asm volatile("" ::: "memory");
        const int cbase = u.pn * 128 + wc * 32 + 8 * fq;
        const bool seq_start = (u.pm & 15) == 0;
#pragma unroll
        for (int ai = 0; ai < 2; ++ai) {
            const int sg = 2 * ai + wr;
            const f32x4 rs = *(PG8_LAS const f32x4*)(R2L + ai * HALF + wr * 64 + 4 * fr);
            const bool defer = (ai == 0) && (wr == 0) && !seq_start && (fr == 0);
            unsigned pk[2][4][2];
#pragma unroll
            for (int n = 0; n < 2; ++n) {
#pragma unroll
                for (int e2 = 0; e2 < 2; ++e2) {
                    asm volatile("" ::: "memory"); __builtin_amdgcn_sched_barrier(0);
                    PG8_LAS const f32x2* wp = (PG8_LAS const f32x2*)(Wl + wc * 32 + 8 * fq + 4 * n + 2 * e2);
                    const f32x2 wg0 = wp[0], wg1 = wp[128], wg2 = wp[256], bg = wp[384], wu0 = wp[64], wu1 = wp[192], wu2 = wp[320], bu = wp[448];
                    f32x2 hg1 = {0.f, 0.f}, hg2 = {0.f, 0.f}, hu1 = {0.f, 0.f}, hu2 = {0.f, 0.f};
                    if (ai == 1 || wr == 1) { PG8_LAS const f32x2* xp = (PG8_LAS const f32x2*)(X + (((sg - 1) * 4 + wc) * 2) * 64 + 8 * fq + 4 * n + 2 * e2); hg2 = xp[0]; hg1 = xp[32]; hu2 = xp[16]; hu1 = xp[48]; }
                    f32x2 vg[4], vu[4], cg[4], cu[4];
#pragma unroll
                    for (int m = 0; m < 4; ++m) { const f32x2 r2 = {rs[m], rs[m]};
                        vg[m] = (f32x2){acc[ai][0][m][n][2 * e2], acc[ai][0][m][n][2 * e2 + 1]} * r2; vu[m] = (f32x2){acc[ai][1][m][n][2 * e2], acc[ai][1][m][n][2 * e2 + 1]} * r2; }
#define EPI_SHR1(old_, v_) (f32x2){__uint_as_float(__builtin_amdgcn_update_dpp(__float_as_uint((old_).x), __float_as_uint((v_).x), 0x111, 0xf, 0xf, false)), __uint_as_float(__builtin_amdgcn_update_dpp(__float_as_uint((old_).y), __float_as_uint((v_).y), 0x111, 0xf, 0xf, false))}
                    const f32x2 pg1 = EPI_SHR1(hg1, vg[3]), pg2 = EPI_SHR1(hg2, vg[2]), pu1 = EPI_SHR1(hu1, vu[3]), pu2 = EPI_SHR1(hu2, vu[2]);
#undef EPI_SHR1
                    cg[0] = bg + wg0 * pg2 + wg1 * pg1 + wg2 * vg[0]; cu[0] = bu + wu0 * pu2 + wu1 * pu1 + wu2 * vu[0];
                    cg[1] = bg + wg0 * pg1 + wg1 * vg[0] + wg2 * vg[1]; cu[1] = bu + wu0 * pu1 + wu1 * vu[0] + wu2 * vu[1];
                    cg[2] = bg + wg0 * vg[0] + wg1 * vg[1] + wg2 * vg[2]; cu[2] = bu + wu0 * vu[0] + wu1 * vu[1] + wu2 * vu[2];
                    cg[3] = bg + wg0 * vg[1] + wg1 * vg[2] + wg2 * vg[3]; cu[3] = bu + wu0 * vu[1] + wu1 * vu[2] + wu2 * vu[3];
                    if (defer) {
#pragma unroll
                        for (int m = 0; m < 2; ++m) { float* fp = FIRST + (unsigned)((tile * 2 + m) * 256 + wc * 32 + 8 * fq + 4 * n + 2 * e2); *(f32x2*)fp = cg[m]; *(f32x2*)(fp + HALF) = cu[m]; }
                    }
#pragma unroll
                    for (int m = 0; m < 4; ++m) {
                        const f32x2 t = cg[m] * (f32x2){-LOG2E, -LOG2E};
                        f32x2 sg_ = {__builtin_amdgcn_exp2f(t.x), __builtin_amdgcn_exp2f(t.y)};
                        sg_ = sg_ + (f32x2){1.0f, 1.0f};
                        const f32x2 rc = {__builtin_amdgcn_rcpf(sg_.x), __builtin_amdgcn_rcpf(sg_.y)};
                        const f32x2 gv = cg[m] * rc * cu[m];
                        pk[n][m][e2] = cvt_pk_bf16(gv.x, gv.y);
                    }
                }
            }
#pragma unroll
            for (int m = 0; m < 4; ++m)
                if (!(m < 2 && defer)) { u32x4 o; o.x = pk[0][m][0]; o.y = pk[0][m][1]; o.z = pk[1][m][0]; o.w = pk[1][m][1]; *(u32x4*)(G + (unsigned)((row0 + ai * HALF + m) * D_FF + cbase)) = o; }
        }
    }
};
template <class Epi, class Sched, bool ALIGN_EPI = false, bool SP2 = false>
__device__ __forceinline__ void gemm_phase(PG8_LAS unsigned char* lds, const Gemm g, const Sched& S, const Epi& E, const int wave_s) {
    const int tid = fresh_tid(wave_s), wid = wave_s, lane = tid & 63,
          wr = wid >> 2, wc = wid & 3, fr = lane & 15, fq = lane >> 4;
    const int K = g.K, nt = K / BK;
    unsigned voffA[2], voffB[2];
#pragma unroll
    for (int i = 0; i < 2; ++i) { int R, C; stage_rc(tid * 16 + i * 8192, R, C); const int Rb = Epi::PERM ? ((R & ~31) + perm32(R & 31)) : R;
        const int Ra = Epi::PERMA ? ((R & ~63) + 4 * (R & 15) + ((R >> 4) & 3)) : R;
        voffA[i] = (unsigned)(Ra * g.lda + C) * 2u; voffB[i] = (unsigned)(Rb * K + C) * 2u; }
    const size_t kstep = (size_t)(BK * 2);
    const size_t hstepA = (size_t)HALF * g.lda * 2, hstepB = (size_t)HALF * K * 2;
    const size_t tstepA = 2 * hstepA, tstepB = 2 * hstepB;
    const unsigned ldsw = (unsigned)wid * 1024u;
    const int aoff = lds_byte(wr * 64 + fr, fq * 8), boff = lds_byte(wc * 32 + fr, fq * 8);
#define PG8_SA(b, h) (((b) * 2 + (h)) * HTB)
#define PG8_SB(b, h) ((4 + (b) * 2 + (h)) * HTB)
#define PG8_STAGE(bufoff, gbase, voff) do { _Pragma("unroll") for (int _i = 0; _i < 2; ++_i) \
        __builtin_amdgcn_global_load_lds((const unsigned*)((const char*)(gbase) + (voff)[_i]), (PG8_LAS unsigned*)(lds + (bufoff) + ldsw + _i * 8192), 16, 0, 0); } while (0)
#define PG8_LDA(dst, b, h) do { _Pragma("unroll") for (int m = 0; m < 4; ++m) _Pragma("unroll") for (int k = 0; k < 2; ++k) dst[m][k] = *(const PG8_LAS bf16x8*)(lds + PG8_SA(b, h) + aoff + m * 2048 + k * 1024); } while (0)
#define PG8_LDB(dst, b, h) do { _Pragma("unroll") for (int n = 0; n < 2; ++n) _Pragma("unroll") for (int k = 0; k < 2; ++k) dst[n][k] = *(const PG8_LAS bf16x8*)(lds + PG8_SB(b, h) + boff + n * 2048 + k * 1024); } while (0)
#define PG8_MMA(ai, bj, At, Bt) do { __builtin_amdgcn_s_setprio(1); _Pragma("unroll") for (int m = 0; m < 4; ++m) _Pragma("unroll") for (int n = 0; n < 2; ++n) _Pragma("unroll") for (int k = 0; k < 2; ++k) \
        acc[ai][bj][m][n] = __builtin_amdgcn_mfma_f32_16x16x32_bf16(Bt[n][k], At[m][k], acc[ai][bj][m][n], 0, 0, 0); __builtin_amdgcn_s_setprio(0); } while (0)
#define PG8_WAIT_V(n) asm volatile("s_waitcnt vmcnt(" #n ")" ::: "memory")
#define PG8_WAIT_L(n) asm volatile("s_waitcnt lgkmcnt(" #n ")" ::: "memory")
#define PG8_BAR __builtin_amdgcn_s_barrier()
#define PG8_SCHED __builtin_amdgcn_sched_barrier(0)
    Unit cur, nxt; int ui = 0;
    if (!S.next(0, cur)) return;
    f32x4 acc[2][2][4][2];
#pragma unroll
    for (int a = 0; a < 2; ++a)
#pragma unroll
        for (int b = 0; b < 2; ++b)
#pragma unroll
            for (int m = 0; m < 4; ++m)
#pragma unroll
                for (int n = 0; n < 2; ++n) acc[a][b][m][n] = (f32x4){0.f, 0.f, 0.f, 0.f};
    bf16x8 At[4][2], B0[2][2], B1[2][2];
    const char* cA = (const char*)g.A + (size_t)cur.pm * tstepA; const char* cB = (const char*)g.Bt + (size_t)cur.pn * tstepB;
    S.a_ready(cur);
    if constexpr (Epi::PERMA) E.prefetch(cur, 0, wave_s);
    if constexpr (SP2) {
        PG8_STAGE(PG8_SB(0, 0), cB, voffB); PG8_STAGE(PG8_SB(0, 1), cB + hstepB, voffB); PG8_STAGE(PG8_SA(0, 0), cA, voffA); PG8_STAGE(PG8_SA(0, 1), cA + hstepA, voffA);
        if (wr == 1) PG8_BAR;
        PG8_WAIT_V(2); PG8_BAR;
        PG8_STAGE(PG8_SB(1, 0), cB + kstep, voffB); PG8_STAGE(PG8_SA(1, 0), cA + kstep, voffA); PG8_STAGE(PG8_SB(1, 1), cB + hstepB + kstep, voffB);
        PG8_WAIT_V(6); PG8_BAR;
    } else {
        PG8_STAGE(PG8_SB(0, 0), cB, voffB); PG8_STAGE(PG8_SA(0, 0), cA, voffA); PG8_STAGE(PG8_SB(0, 1), cB + hstepB, voffB); PG8_STAGE(PG8_SA(0, 1), cA + hstepA, voffA);
        if (wr == 1) PG8_BAR;
        PG8_WAIT_V(4); PG8_BAR;
        PG8_STAGE(PG8_SB(1, 0), cB + kstep, voffB); PG8_STAGE(PG8_SA(1, 0), cA + kstep, voffA); PG8_STAGE(PG8_SB(1, 1), cB + hstepB + kstep, voffB);
        PG8_WAIT_V(6); PG8_BAR;
    }
    for (;;) {
        const bool has_next = S.next(ui + 1, nxt);
        const char* nA = has_next ? (const char*)g.A + (size_t)nxt.pm * tstepA : cA; const char* nB = has_next ? (const char*)g.Bt + (size_t)nxt.pn * tstepB : cB;
        for (int t = 0; t < nt; t += 2) {
            const bool last = (t == nt - 2);
            const char* a1 = cA + (size_t)(t + 1) * kstep;
            const char* a2 = last ? nA : cA + (size_t)(t + 2) * kstep; const char* b2 = last ? nB : cB + (size_t)(t + 2) * kstep;
            const char* a3 = a2 + kstep; const char* b3 = b2 + kstep;
            if (last && has_next) S.a_ready(nxt);
            if constexpr (SP2) {
            PG8_LDB(B0, 0, 0); PG8_LDB(B1, 0, 1); PG8_SCHED; PG8_LDA(At, 0, 0); PG8_STAGE(PG8_SA(1, 1), a1 + hstepA, voffA);
            PG8_WAIT_V(8); PG8_WAIT_L(0); PG8_BAR; PG8_MMA(0, 0, At, B0); PG8_MMA(0, 1, At, B1); PG8_BAR; PG8_SCHED;
            PG8_LDA(At, 0, 1); PG8_STAGE(PG8_SB(0, 0), b2, voffB); PG8_STAGE(PG8_SB(0, 1), b2 + hstepB, voffB); PG8_STAGE(PG8_SA(0, 0), a2, voffA);
            PG8_WAIT_V(8); PG8_WAIT_L(0); PG8_BAR; PG8_MMA(1, 0, At, B0); PG8_MMA(1, 1, At, B1); PG8_BAR; PG8_SCHED;
            PG8_LDB(B0, 1, 0); PG8_LDB(B1, 1, 1); PG8_SCHED; PG8_LDA(At, 1, 0); PG8_STAGE(PG8_SA(0, 1), a2 + hstepA, voffA);
            PG8_WAIT_V(8); PG8_WAIT_L(0); PG8_BAR; PG8_MMA(0, 0, At, B0); PG8_MMA(0, 1, At, B1); PG8_BAR; PG8_SCHED;
            PG8_LDA(At, 1, 1); PG8_STAGE(PG8_SB(1, 0), b3, voffB); PG8_STAGE(PG8_SB(1, 1), b3 + hstepB, voffB); PG8_STAGE(PG8_SA(1, 0), a3, voffA);
            PG8_WAIT_V(8); PG8_WAIT_L(0); PG8_BAR; PG8_MMA(1, 0, At, B0); PG8_MMA(1, 1, At, B1); PG8_BAR; PG8_SCHED;
            } else {
            PG8_LDB(B0, 0, 0); PG8_SCHED; PG8_LDA(At, 0, 0); PG8_STAGE(PG8_SA(1, 1), a1 + hstepA, voffA);
            PG8_WAIT_L(8); PG8_BAR; PG8_WAIT_L(0); PG8_MMA(0, 0, At, B0); PG8_BAR; PG8_SCHED;
            PG8_LDB(B1, 0, 1); PG8_STAGE(PG8_SB(0, 0), b2, voffB);
            PG8_BAR; PG8_WAIT_L(0); PG8_MMA(0, 1, At, B1); PG8_BAR;
            PG8_LDA(At, 0, 1); PG8_STAGE(PG8_SA(0, 0), a2, voffA);
            PG8_BAR; PG8_WAIT_L(0); PG8_MMA(1, 0, At, B0); PG8_BAR; PG8_SCHED;
            PG8_STAGE(PG8_SB(0, 1), b2 + hstepB, voffB);
            PG8_WAIT_V(6); PG8_BAR; PG8_MMA(1, 1, At, B1); PG8_BAR;
            PG8_LDB(B0, 1, 0); PG8_SCHED; PG8_LDA(At, 1, 0); PG8_STAGE(PG8_SA(0, 1), a2 + hstepA, voffA);
            PG8_WAIT_L(8); PG8_BAR; PG8_WAIT_L(0); PG8_MMA(0, 0, At, B0); PG8_BAR; PG8_SCHED;
            PG8_LDB(B1, 1, 1); PG8_STAGE(PG8_SB(1, 0), b3, voffB);
            PG8_BAR; PG8_WAIT_L(0); PG8_MMA(0, 1, At, B1); PG8_BAR;
            PG8_LDA(At, 1, 1); PG8_STAGE(PG8_SA(1, 0), a3, voffA);
            PG8_BAR; PG8_WAIT_L(0); PG8_MMA(1, 0, At, B0); PG8_BAR; PG8_SCHED;
            PG8_STAGE(PG8_SB(1, 1), b3 + hstepB, voffB);
            PG8_WAIT_V(6); PG8_BAR; PG8_MMA(1, 1, At, B1); PG8_BAR;
            }
        }
        if constexpr (ALIGN_EPI) { if (wr == 0) PG8_BAR; }
        if constexpr (Epi::PERMA) { E.run(acc, cur, nxt, has_next, ui & 1, wr, wc, wave_s); S.done(cur); }
        else if constexpr (!Epi::AFTER_DRAIN) { E(acc, cur, wr, wc, fr, fq); S.done(cur); }
        if (!has_next) break;
#pragma unroll
        for (int a = 0; a < 2; ++a)
#pragma unroll
            for (int b = 0; b < 2; ++b)
#pragma unroll
                for (int m = 0; m < 4; ++m)
#pragma unroll
                    for (int n = 0; n < 2; ++n) acc[a][b][m][n] = (f32x4){0.f, 0.f, 0.f, 0.f};
        cur = nxt; cA = nA; cB = nB; ++ui;
        if constexpr (ALIGN_EPI) { if (wr == 1) PG8_BAR; }
    }
    PG8_WAIT_V(0);
    if constexpr (!ALIGN_EPI) { if (wr == 0) PG8_BAR; }
    PG8_BAR;
    if constexpr (Epi::AFTER_DRAIN) { E.fused(acc, cur, wr, wc, fr, fq, lds, wid, lane); S.done(cur); }
#undef PG8_SA
#undef PG8_SB
#undef PG8_STAGE
#undef PG8_LDA
#undef PG8_LDB
#undef PG8_MMA
#undef PG8_WAIT_V
#undef PG8_WAIT_L
#undef PG8_BAR
#undef PG8_SCHED
}
}
constexpr int NWAVES = 8;
template <class RowMap>
__device__ __forceinline__ void transpose_item(const float* __restrict__ W, int K, int N, bf16_t* WT, const float* __restrict__ kscale, RowMap rm, LAS float* scr, int item, int lane) {
    const int nblk = (N + 31) / 32, kb = item / nblk, nb = item % nblk, k0 = 64 * kb, n0 = 32 * nb;
    const int nr = n0 + (lane & 31);
    float v[32];
#pragma unroll
    for (int i = 0; i < 32; ++i) { const int kk = 2 * i + (lane >> 5); v[i] = (nr < N) ? W[(size_t)(k0 + kk) * N + nr] : 0.f; }
    if (kscale) {
#pragma unroll
        for (int i = 0; i < 32; ++i) v[i] *= kscale[k0 + 2 * i + (lane >> 5)];
    }
#pragma unroll
    for (int i = 0; i < 32; ++i) scr[(2 * i + (lane >> 5)) * 33 + (lane & 31)] = v[i];
    asm volatile("s_waitcnt lgkmcnt(0)" ::: "memory");
    const int c = lane & 7;
#pragma unroll
    for (int j = 0; j < 4; ++j) { const int nl = (lane >> 3) + 8 * j, n = n0 + nl;
        if (n < N) { const LAS float* s = scr + (8 * c) * 33 + nl;
            u32x4_t o; o.x = pk2(s[0 * 33], s[1 * 33]); o.y = pk2(s[2 * 33], s[3 * 33]); o.z = pk2(s[4 * 33], s[5 * 33]); o.w = pk2(s[6 * 33], s[7 * 33]);
            *(u32x4_t*)(WT + (size_t)rm(n) * K + k0 + 8 * c) = o; } }
    asm volatile("s_waitcnt lgkmcnt(0)" ::: "memory");
}
struct RmIdent { __device__ __forceinline__ int operator()(int n) const { return n; } };
struct RmWin {
    __device__ __forceinline__ int operator()(int c) const {
        const int nc = c < 2560 ? c : (c < 2608 ? 4608 + (c - 2560) : 2560 + (c - 2608));
        const int tile = nc >> 8, L = nc & 255, wc = L >> 6, bj = (L >> 5) & 1, j = L & 31;
        return tile * 256 + 128 * bj + 32 * wc + j;
    }
};
struct RmWup {
    __device__ __forceinline__ int operator()(int c) const { const int up = c >= D_FF, cc = up ? c - D_FF : c; return (cc >> 7) * 256 + up * 128 + (cc & 127); }
};

struct Ptrs {
    const float* in[18]; float* out; unsigned char* ws;
};

__device__ __forceinline__ void p0_prologue(const Ptrs& P, LAS unsigned char* lds, int vcu, int G, const int wave) {
    const int lane = fresh_lane();
    LAS float* scr = (LAS float*)(lds + wave * 16384);
    const int gw = vcu * NWAVES + wave, NGW = G * NWAVES;
    unsigned char* ws = P.ws;
    bf16_t* WinT = (bf16_t*)(ws + WS_WIN); bf16_t* WoutT = (bf16_t*)(ws + WS_WOUT); bf16_t* WupT = (bf16_t*)(ws + WS_WUP); bf16_t* WdownT = (bf16_t*)(ws + WS_WDOWN); bf16_t* W1cT = (bf16_t*)(ws + WS_W1C);
    const float* x = P.in[0]; const float* attn_norm_w = P.in[1]; const float* w_in = P.in[2]; const float* cmp_pos = P.in[5]; const float* cmp_w1 = P.in[6];
    const float* w_out = P.in[12]; const float* ffn_norm_w = P.in[13]; const float* w_up = P.in[14]; const float* w_down = P.in[17];
    constexpr int I_IN = 32 * 146, I_W1 = 32 * 8, I_W2 = 4 * 2;
    constexpr int NITEMS = I_IN + 2 * I_W1 + 2 * I_W2;
    (void)w_out; (void)w_up; (void)w_down; (void)ffn_norm_w; (void)WoutT; (void)WupT; (void)WdownT;
    for (int it = gw; it < NITEMS; it += NGW) {
        int r = it;
        if (r < I_IN) { transpose_item(w_in, 2048, IN_COLS, WinT, nullptr, RmWin(), scr, r, lane); continue; } r -= I_IN;
        if (r < I_W1) { transpose_item(cmp_w1, 2048, 256, W1cT, nullptr, RmIdent(), scr, r, lane); continue; } r -= I_W1;
        if (r < I_W1) { transpose_item(cmp_w1 + (size_t)2048 * 256, 2048, 256, W1cT + (size_t)256 * 2048, nullptr, RmIdent(), scr, r, lane); continue; } r -= I_W1;
        { const int kv = r >= I_W2 ? 1 : 0; transpose_item(P.in[7] + (size_t)kv * 256 * 64, 256, 64, (bf16_t*)(ws + WS_SMALL + SM_W2T) + (size_t)kv * 64 * 256, nullptr, RmIdent(), scr, r - kv * I_W2, lane); }
    }
    for (int i = gw * 64 + lane; i < 8 * 16384; i += NGW * 64) { const int t = (i >> 7) & 127, sx = i & 127; ((bf16_t*)(ws + WS_SMALL + SM_SWB))[i] = (bf16_t)(sx <= t ? f2bf(P.in[10][i]) : 0u); }
    for (int p = gw; p < 256; p += NGW) {
        const int L = 64 * ((p >> 5) & 3) + 32 * (p >> 7) + (p & 31);
        if (L >= 48) { u32x4_t z = {0u, 0u, 0u, 0u}; u32x4_t* d = (u32x4_t*)(WinT + (size_t)(18 * 256 + p) * 2048);
#pragma unroll
            for (int j = 0; j < 4; ++j) d[lane + 64 * j] = z; }
    }
    bf16_t* XN = (bf16_t*)(ws + WS_XN);
    for (int m = gw; m < MTOK; m += 2 * NGW) {
        const int m2 = m + NGW;
        const f32x4_t* xr = (const f32x4_t*)(x + (size_t)m * D_MODEL) + lane;
        const f32x4_t* xr2 = (const f32x4_t*)(x + (size_t)(m2 < MTOK ? m2 : m) * D_MODEL) + lane;
        f32x4_t v[8], v2[8]; float s = 0.f, s2 = 0.f;
#pragma unroll
        for (int j = 0; j < 8; ++j) { v[j] = xr[64 * j]; v2[j] = xr2[64 * j]; }
#pragma unroll
        for (int j = 0; j < 8; ++j) { s += (v[j][0] * v[j][0] + v[j][1] * v[j][1]) + (v[j][2] * v[j][2] + v[j][3] * v[j][3]); s2 += (v2[j][0] * v2[j][0] + v2[j][1] * v2[j][1]) + (v2[j][2] * v2[j][2] + v2[j][3] * v2[j][3]); }
        const float ms1 = wave_sum(s) * (1.0f / D_MODEL) + 1e-6f, ms2 = wave_sum(s2) * (1.0f / D_MODEL) + 1e-6f;
        const float r = __builtin_amdgcn_rsqf(ms1), r2 = __builtin_amdgcn_rsqf(ms2);
        if (lane == 0) { float* rinv = (float*)(ws + WS_SMALL + SM_RINV); rinv[m] = ms1 * r; if (m2 < MTOK) rinv[m2] = ms2 * r2; }
        u32x2_t* o8 = (u32x2_t*)(XN + (size_t)m * D_MODEL) + lane; u32x2_t* o82 = (u32x2_t*)(XN + (size_t)m2 * D_MODEL) + lane;
#pragma unroll
        for (int j = 0; j < 8; ++j) { const f32x4_t w = ((const f32x4_t*)attn_norm_w)[lane + 64 * j];
            u32x2_t o; o.x = pk2(v[j][0] * r * w[0], v[j][1] * r * w[1]); o.y = pk2(v[j][2] * r * w[2], v[j][3] * r * w[3]); o8[64 * j] = o;
            if (m2 < MTOK) { u32x2_t q; q.x = pk2(v2[j][0] * r2 * w[0], v2[j][1] * r2 * w[1]); q.y = pk2(v2[j][2] * r2 * w[2], v2[j][3] * r2 * w[3]); o82[64 * j] = q; } }
    }
    for (int i = gw * 64 + lane; i < D_MODEL; i += NGW * 64) ((float*)(ws + WS_SMALL + SM_INVW))[i] = 1.0f / attn_norm_w[i];
    float* BIASP = (float*)(ws + WS_SMALL + SM_BIASP);
    for (int it = gw; it < 64; it += NGW) {
        const int kv = it >> 5, kc = it & 31; f32x4_t a = {0.f, 0.f, 0.f, 0.f};
        const float* pp = cmp_pos + kv * 2048 + kc * 64; const float* w1 = cmp_w1 + ((size_t)kv * 2048 + kc * 64) * 256;
        for (int k = 0; k < 64; ++k) { const f32x4_t w = ((const f32x4_t*)(w1 + (size_t)k * 256))[lane]; a += w * pp[k]; }
        ((f32x4_t*)(BIASP + (size_t)it * 256))[lane] = a;
    }
}

__device__ __forceinline__ void bias1_stage(unsigned char* ws, int idx  ) {
    const float* BIASP = (const float*)(ws + WS_SMALL + SM_BIASP); float* BIAS1 = (float*)(ws + WS_SMALL + SM_BIAS1);
    const int kv = idx >> 8, j = idx & 255; float s = 0.f;
    for (int kc = 0; kc < 32; ++kc) s += BIASP[(size_t)(kv * 32 + kc) * 256 + j];
    BIAS1[idx] = s;
}
__device__ __forceinline__ void cmp2_row(const Ptrs& P, int R, int lane) {
    unsigned char* ws = P.ws; const bf16_t* HC = (const bf16_t*)(ws + WS_HC);
    const int kv = R >> 12, rr = R & 4095, n = rr & 255;
    bf16_t* dst = (bf16_t*)(ws + (kv ? WS_VC : WS_KC)) + (size_t)rr * 64 + lane;
    if (n == 255) { *dst = 0; return; }
    const float* w2 = P.in[7] + (size_t)kv * 256 * 64;
    const u32x2_t hr = *(const u32x2_t*)(HC + (size_t)R * 256 + 4 * lane);
    float h[4] = {__uint_as_float(hr.x << 16), __uint_as_float(hr.x & 0xffff0000u), __uint_as_float(hr.y << 16), __uint_as_float(hr.y & 0xffff0000u)};
    float o = 0.f;
    for (int jj = 0; jj < 64; ++jj) {
#pragma unroll
        for (int i = 0; i < 4; ++i) o += __shfl(h[i], jj) * w2[(size_t)(4 * jj + i) * 64 + lane];
    }
    if (kv == 0) { const float ss = wave_sum(o * o); o *= __builtin_amdgcn_rsqf(ss * (1.0f / 64.0f) + 1e-6f) * P.in[4][lane]; }
    *dst = (bf16_t)f2bf(o);
}

__device__ __forceinline__ void gmlp_unit_v1(const Ptrs& P, LAS unsigned char* lds, int unit, const int wave_s) {
    unsigned char* ws = P.ws; const int tid = fresh_tid(wave_s);
    const int g = unit & 7, chunk = (unit >> 3) & 31, b = unit >> 8; const int m0 = b * SEQ + chunk * 128;
    LAS float* vn = (LAS float*)lds; LAS float* Wl = (LAS float*)(lds + 65536); LAS float* st = (LAS float*)(lds + 131072);
    const bf16_t* GV = (const bf16_t*)(ws + WS_GV); const bf16_t* U = (const bf16_t*)(ws + WS_U); const float* VSTAT = (const float*)(ws + WS_VSTAT);
    bf16_t* AB = (bf16_t*)(ws + WS_AB);
    const float* ln_w = P.in[8]; const float* ln_b = P.in[9]; const float* sw = P.in[10]; const float* sb = P.in[11];
    if (tid < 128) { const float* p = VSTAT + (size_t)(m0 + tid) * 32; float s1 = 0.f, s2 = 0.f;
#pragma unroll
        for (int i = 0; i < 16; ++i) { s1 += p[2 * i]; s2 += p[2 * i + 1]; }
        const float mean = s1 * (1.0f / 1024.0f); float var = s2 * (1.0f / 1024.0f) - mean * mean; var = var < 0.f ? 0.f : var;
        st[2 * tid] = mean; st[2 * tid + 1] = __builtin_amdgcn_rsqf(var + 1e-5f); }
    for (int i = 0; i < 32; ++i) { const int idx = tid + 512 * i, t = idx >> 7, s = idx & 127; Wl[idx] = (s <= t) ? sw[(size_t)g * 16384 + idx] : 0.f; }
    __syncthreads();
#pragma unroll
    for (int i = 0; i < 4; ++i) { const int idx = tid + 512 * i, s = idx >> 4, c8 = idx & 15;
        const u32x4_t raw = *(const u32x4_t*)(GV + (size_t)(m0 + s) * 1024 + g * 128 + 8 * c8); float f[8]; unpack8(raw, f);
        const float mean = st[2 * s], rstd = st[2 * s + 1];
#pragma unroll
        for (int e = 0; e < 8; ++e) { const int c = g * 128 + 8 * c8 + e; vn[s * 128 + 8 * c8 + e] = (f[e] - mean) * rstd * ln_w[c] + ln_b[c]; } }
    __syncthreads();
    const int c = tid & 127, tq = tid >> 7;
    for (int i = 0; i < 8; ++i) {
        const int t0 = 4 * (tq + 4 * i); float a0 = 0.f, a1 = 0.f, a2 = 0.f, a3 = 0.f;
        for (int s4 = 0; s4 <= t0; s4 += 4) {
            const f32x4_t w0 = *(const LAS f32x4_t*)(Wl + (t0 + 0) * 128 + s4), w1 = *(const LAS f32x4_t*)(Wl + (t0 + 1) * 128 + s4), w2 = *(const LAS f32x4_t*)(Wl + (t0 + 2) * 128 + s4), w3 = *(const LAS f32x4_t*)(Wl + (t0 + 3) * 128 + s4);
#pragma unroll
            for (int k = 0; k < 4; ++k) { const float v = vn[(s4 + k) * 128 + c]; a0 += w0[k] * v; a1 += w1[k] * v; a2 += w2[k] * v; a3 += w3[k] * v; }
        }
        const float av[4] = {a0, a1, a2, a3};
#pragma unroll
        for (int k = 0; k < 4; ++k) { const int t = t0 + k; const size_t row = (size_t)(m0 + t);
            const float uu = bf2f(U[row * 1024 + g * 128 + c]); AB[row * 2048 + 1024 + g * 128 + c] = (bf16_t)f2bf(uu * (av[k] + sb[g * 128 + t])); }
    }
    __syncthreads();
}

__device__ __forceinline__ void conv_item(const Ptrs& P, int b, int idx) {
    const int t = idx / 704, c8 = idx % 704, c0 = 8 * c8, j = c0 >> 7, i0 = c0 & 127;
    const bf16_t* HID = (const bf16_t*)(P.ws + WS_HID); const float* cw = P.in[15]; const float* cb = P.in[16];
    float gt[8], up[8];
#pragma unroll
    for (int e = 0; e < 8; ++e) { gt[e] = cb[c0 + e]; up[e] = cb[D_FF + c0 + e]; }
#pragma unroll
    for (int k = 0; k < 3; ++k) { const int tt = t - 2 + k; if (tt < 0) continue;
        float hg[8], hu[8]; unpack8(*(const u32x4_t*)(HID + (size_t)tt * N_UP + 256 * j + i0), hg); unpack8(*(const u32x4_t*)(HID + (size_t)tt * N_UP + 256 * j + 128 + i0), hu);
#pragma unroll
        for (int e = 0; e < 8; ++e) { gt[e] += cw[(size_t)k * N_UP + c0 + e] * hg[e]; up[e] += cw[(size_t)k * N_UP + D_FF + c0 + e] * hu[e]; } }
    float r[8];
#pragma unroll
    for (int e = 0; e < 8; ++e) r[e] = gt[e] * sigmoidf_(gt[e]) * up[e];
    u32x4_t o; o.x = pk2(r[0], r[1]); o.y = pk2(r[2], r[3]); o.z = pk2(r[4], r[5]); o.w = pk2(r[6], r[7]);
    *(u32x4_t*)((bf16_t*)(P.ws + WS_G) + ((size_t)b * SEQ + t) * D_FF + c0) = o;
}

constexpr int LW_CH = 32;
constexpr int LW_OUT = 32 * 64, LW_UP = 32 * 352, LW_DOWN = 88 * 64, LW_C_OUT = LW_OUT / LW_CH, LW_C_UP = LW_UP / LW_CH, LW_C_DOWN = LW_DOWN / LW_CH, LW_CHUNKS = LW_C_OUT + LW_C_UP + LW_C_DOWN;
static_assert(LW_OUT % LW_CH == 0 && LW_UP % LW_CH == 0 && LW_DOWN % LW_CH == 0, "late weight items per chunk");
template <class RowMap>
__device__ __forceinline__ void lw_load(float (&v)[32], const float* __restrict__ W, int N, int item, int lane) {
    const int nblk = N / 32, kb = item / nblk, nb = item % nblk;
    const float* p = W + (size_t)(64 * kb + (lane >> 5)) * N + 32 * nb + (lane & 31);
#pragma unroll
    for (int i = 0; i < 32; ++i) v[i] = p[(size_t)(2 * i) * N];
}
template <class RowMap>
__device__ __forceinline__ void lw_store(const float (&v)[32], int K, int N, bf16_t* WT, const float* __restrict__ kscale, RowMap rm, LAS float* scr, int item, int lane) {
    const int nblk = N / 32, kb = item / nblk, nb = item % nblk, k0 = 64 * kb, n0 = 32 * nb;
    const int c = lane & 7;
    f32x4_t sc0 = {1.f, 1.f, 1.f, 1.f}, sc1 = sc0;
    if (kscale) { sc0 = *(const f32x4_t*)(kscale + k0 + 8 * c); sc1 = *(const f32x4_t*)(kscale + k0 + 8 * c + 4); }
#pragma unroll
    for (int i = 0; i < 32; ++i) scr[(2 * i + (lane >> 5)) * 33 + (lane & 31)] = v[i];
    asm volatile("s_waitcnt lgkmcnt(0)" ::: "memory");
#pragma unroll
    for (int j = 0; j < 4; ++j) { const int nl = (lane >> 3) + 8 * j; const LAS float* s = scr + (8 * c) * 33 + nl;
        u32x4_t o; o.x = pk2(s[0 * 33] * sc0[0], s[1 * 33] * sc0[1]); o.y = pk2(s[2 * 33] * sc0[2], s[3 * 33] * sc0[3]); o.z = pk2(s[4 * 33] * sc1[0], s[5 * 33] * sc1[1]); o.w = pk2(s[6 * 33] * sc1[2], s[7 * 33] * sc1[3]);
        *(u32x4_t*)(WT + (size_t)rm(n0 + nl) * K + k0 + 8 * c) = o; }
    asm volatile("s_waitcnt lgkmcnt(0)" ::: "memory");
}
template <class RowMap>
__device__ __forceinline__ void lw_run(const float* __restrict__ W, int K, int N, bf16_t* WT, const float* __restrict__ kscale, RowMap rm, LAS float* scr, int item0, int wave, int lane) {
    float va[32], vb[32];
    lw_load<RowMap>(va, W, N, item0 + wave, lane);
    lw_load<RowMap>(vb, W, N, item0 + wave + 8, lane);  lw_store(va, K, N, WT, kscale, rm, scr, item0 + wave, lane);
    lw_load<RowMap>(va, W, N, item0 + wave + 16, lane); lw_store(vb, K, N, WT, kscale, rm, scr, item0 + wave + 8, lane);
    lw_load<RowMap>(vb, W, N, item0 + wave + 24, lane); lw_store(va, K, N, WT, kscale, rm, scr, item0 + wave + 16, lane);
    lw_store(vb, K, N, WT, kscale, rm, scr, item0 + wave + 24, lane);
}
__device__ __forceinline__ void late_weight_chunk(const Ptrs& P, LAS unsigned char* lds, int chunk, const int wave) {
    const int lane = fresh_lane();
    LAS float* scr = (LAS float*)(lds + wave * 16384);
    unsigned char* ws = P.ws;
    if (chunk < LW_C_UP) lw_run(P.in[14], 2048, N_UP, (bf16_t*)(ws + WS_WUP), P.in[13], RmWup(), scr, chunk * LW_CH, wave, lane);
    else if (chunk < LW_C_UP + LW_C_DOWN) lw_run(P.in[17], D_FF, 2048, (bf16_t*)(ws + WS_WDOWN), nullptr, RmIdent(), scr, (chunk - LW_C_UP) * LW_CH, wave, lane);
    else lw_run(P.in[12], 2048, 2048, (bf16_t*)(ws + WS_WOUT), nullptr, RmIdent(), scr, (chunk - LW_C_UP - LW_C_DOWN) * LW_CH, wave, lane);
}

namespace nsa {
using bf16x8 = __attribute__((ext_vector_type(8))) short;
using s16x4 = __attribute__((ext_vector_type(4))) short;
using f32x16 = __attribute__((ext_vector_type(16))) float;
typedef float f32x2_t __attribute__((ext_vector_type(2))); typedef __bf16 bf16x2_t __attribute__((ext_vector_type(2)));
constexpr int L_K = 0, L_V = 16384, L_WSF = 32768, L_OST = 34816, L_IMP = 100352, L_MASK = 116736, L_WU = 117248, L_END = 117312;
constexpr int SLOTB = 8192;
constexpr float THR = 8.0f;
#define NSA_SBAR() __builtin_amdgcn_sched_barrier(0)
__device__ __forceinline__ int crow(int r, int hi) { return (r & 3) + 8 * (r >> 2) + 4 * hi; }
__device__ __forceinline__ void glds16(const void* gbase  , unsigned voff  , unsigned lds_dst) { unsigned keep;
    asm volatile("s_mov_b32 %0, m0\n\ts_mov_b32 m0, %3\n\ts_nop 0\n\tglobal_load_lds_dwordx4 %1, %2\n\ts_mov_b32 m0, %0" : "=&s"(keep) : "v"(voff), "s"(gbase), "s"(lds_dst) : "memory"); }
__device__ __forceinline__ unsigned cvtpk_s(float lo, float hi) { f32x2_t v = {lo, hi}; bf16x2_t b = __builtin_convertvector(v, bf16x2_t); return __builtin_bit_cast(unsigned, b); }
#define NSA_WAIT_BAR() asm volatile("s_waitcnt vmcnt(0) lgkmcnt(0)\n\ts_barrier" ::: "memory")

__device__ __forceinline__ void qkt(f32x16& p0, f32x16& p1, LAS const char* Kslot, const bf16x8 (&qr)[4], int r32, int hi) {
    LAS const char* kb = Kslot + hi * 1024 + r32 * 16;
#pragma unroll
    for (int d0 = 0; d0 < 4; ++d0) {
        const bf16x8 b0 = *(LAS const bf16x8*)(kb + d0 * 2048);
        const bf16x8 b1 = *(LAS const bf16x8*)(kb + d0 * 2048 + 512);
        p0 = __builtin_amdgcn_mfma_f32_32x32x16_bf16(b0, qr[d0], p0, 0, 0, 0); p1 = __builtin_amdgcn_mfma_f32_32x32x16_bf16(b1, qr[d0], p1, 0, 0, 0);
    }
}
struct VFrag { s16x4 lo[2][4], hi[2][4]; };
__device__ __forceinline__ void vload(VFrag& f, int vb) {
#pragma unroll
    for (int d0 = 0; d0 < 2; ++d0)
#pragma unroll
        for (int ks = 0; ks < 4; ++ks) {
            asm volatile("ds_read_b64_tr_b16 %0,%1 offset:%c2" : "=&v"(f.lo[d0][ks]) : "v"(vb), "i"(d0 * 4096 + ks * 1024) : "memory");
            asm volatile("ds_read_b64_tr_b16 %0,%1 offset:%c2" : "=&v"(f.hi[d0][ks]) : "v"(vb), "i"(d0 * 4096 + ks * 1024 + 512) : "memory"); }
}
__device__ __forceinline__ void pvmma(f32x16 (&o)[2], VFrag& f, bf16x8 pa0, bf16x8 pa1, bf16x8 pa2, bf16x8 pa3) {
    asm volatile("s_waitcnt lgkmcnt(0)" : "+v"(f.lo[0][0]), "+v"(f.lo[0][1]), "+v"(f.lo[0][2]), "+v"(f.lo[0][3]), "+v"(f.hi[0][0]), "+v"(f.hi[0][1]), "+v"(f.hi[0][2]), "+v"(f.hi[0][3]) :: "memory");
    asm volatile("" : "+v"(f.lo[1][0]), "+v"(f.lo[1][1]), "+v"(f.lo[1][2]), "+v"(f.lo[1][3]), "+v"(f.hi[1][0]), "+v"(f.hi[1][1]), "+v"(f.hi[1][2]), "+v"(f.hi[1][3]));
    NSA_SBAR();
#pragma unroll
    for (int d0 = 0; d0 < 2; ++d0) {
#define NSA_PK(k) (bf16x8){f.lo[d0][k][0], f.lo[d0][k][1], f.lo[d0][k][2], f.lo[d0][k][3], f.hi[d0][k][0], f.hi[d0][k][1], f.hi[d0][k][2], f.hi[d0][k][3]}
        o[d0] = __builtin_amdgcn_mfma_f32_32x32x16_bf16(pa0, NSA_PK(0), o[d0], 0, 0, 0);
        o[d0] = __builtin_amdgcn_mfma_f32_32x32x16_bf16(pa1, NSA_PK(1), o[d0], 0, 0, 0);
        o[d0] = __builtin_amdgcn_mfma_f32_32x32x16_bf16(pa2, NSA_PK(2), o[d0], 0, 0, 0);
        o[d0] = __builtin_amdgcn_mfma_f32_32x32x16_bf16(pa3, NSA_PK(3), o[d0], 0, 0, 0);
#undef NSA_PK
    }
}
__device__ __forceinline__ void pv(f32x16 (&o)[2], int vb, bf16x8 pa0, bf16x8 pa1, bf16x8 pa2, bf16x8 pa3) { VFrag f; vload(f, vb); pvmma(o, f, pa0, pa1, pa2, pa3); }
__device__ __forceinline__ float rowmax32(const f32x16& p0, const f32x16& p1) {
    float a = __builtin_fmaxf(p0[0], p1[0]);
#pragma unroll
    for (int r = 1; r < 16; ++r) a = __builtin_fmaxf(a, __builtin_fmaxf(p0[r], p1[r]));
    auto rr = __builtin_amdgcn_permlane32_swap(__float_as_uint(a), __float_as_uint(a), false, false);
    return __builtin_fmaxf(__uint_as_float(rr[0]), __uint_as_float(rr[1]));
}
struct State { float m, l; f32x16 o[2]; };
__device__ __forceinline__ void state_init(State& s) { s.m = -1e30f; s.l = 0.f; s.o[0] = f32x16{}; s.o[1] = f32x16{}; }

template <int BMUL, int MASK, bool LOADV>
__device__ __forceinline__ void tile_scores(f32x16& p0, f32x16& p1, LAS const char* Kslot, const bf16x8 (&qr)[4], const f32x16& bk, float c0, float b32, int lim, int r32, int hi, VFrag& vf, int vb) {
#pragma unroll
    for (int r = 0; r < 16; ++r) { const float b = (BMUL == 1) ? bk[r] + c0 : __builtin_fmaf(bk[r], (float)BMUL, c0); p0[r] = b; p1[r] = b + b32; }
    qkt(p0, p1, Kslot, qr, r32, hi);
    if (LOADV) vload(vf, vb);
    const int limh = lim - 4 * hi;
#pragma unroll
    for (int r = 0; r < 16; ++r) {
        const int kk = (r & 3) + 8 * (r >> 2);
        if (MASK == 1) { if (!(kk <= limh)) p0[r] = -INFINITY; if (!(kk + 32 <= limh)) p1[r] = -INFINITY; }
        if (MASK == 2) { if (!(kk > limh)) p0[r] = -INFINITY; if (!(kk + 32 > limh)) p1[r] = -INFINITY; }
        if (MASK == 3) { if (!(kk < limh)) p0[r] = -INFINITY; if (!(kk + 32 < limh)) p1[r] = -INFINITY; }
    }
}
__device__ __forceinline__ float tile_ref(const State& st, float rb0, bool rowlive) { return (st.m < -1e29f && rowlive) ? rb0 : st.m; }
__device__ __forceinline__ void tile_softmax_pv(State& st, f32x16& p0, f32x16& p1, float mref, VFrag& vf, LAS float* wsf, int r32, int hi) {
    float a0 = p0[0], a1 = p1[0];
#pragma unroll
    for (int r = 1; r < 16; ++r) { a0 = __builtin_fmaxf(a0, p0[r]); a1 = __builtin_fmaxf(a1, p1[r]); }
    float mx = __builtin_fmaxf(a0, a1);
    { auto rr = __builtin_amdgcn_permlane32_swap(__float_as_uint(mx), __float_as_uint(mx), false, false); mx = __builtin_fmaxf(__uint_as_float(rr[0]), __uint_as_float(rr[1])); }
    if (__any(mx > THR)) {
        const float dl = __builtin_fmaxf(mx, 0.f), alpha = __builtin_amdgcn_exp2f(-dl);
        mref += dl; st.l *= alpha;
        if (hi == 0) wsf[r32] = alpha;
        asm volatile("s_waitcnt lgkmcnt(0)" ::: "memory");
#pragma unroll
        for (int r = 0; r < 16; ++r) { const float a = wsf[crow(r, hi)]; st.o[0][r] *= a; st.o[1][r] *= a; p0[r] -= dl; p1[r] -= dl; }
    }
    st.m = mref;
    float ls = 0.f;
#pragma unroll
    for (int r = 0; r < 16; ++r) { p0[r] = __builtin_amdgcn_exp2f(p0[r]); p1[r] = __builtin_amdgcn_exp2f(p1[r]); ls += p0[r] + p1[r]; }
    st.l += ls;
    u32x4_t pw0, pw1, pw2, pw3;
    pw0 = (u32x4_t){cvtpk_s(p0[0], p0[1]), cvtpk_s(p0[2], p0[3]), cvtpk_s(p0[4], p0[5]), cvtpk_s(p0[6], p0[7])};
    pw1 = (u32x4_t){cvtpk_s(p0[8], p0[9]), cvtpk_s(p0[10], p0[11]), cvtpk_s(p0[12], p0[13]), cvtpk_s(p0[14], p0[15])};
    pw2 = (u32x4_t){cvtpk_s(p1[0], p1[1]), cvtpk_s(p1[2], p1[3]), cvtpk_s(p1[4], p1[5]), cvtpk_s(p1[6], p1[7])};
    pw3 = (u32x4_t){cvtpk_s(p1[8], p1[9]), cvtpk_s(p1[10], p1[11]), cvtpk_s(p1[12], p1[13]), cvtpk_s(p1[14], p1[15])};
    pvmma(st.o, vf, __builtin_bit_cast(bf16x8, pw0), __builtin_bit_cast(bf16x8, pw1), __builtin_bit_cast(bf16x8, pw2), __builtin_bit_cast(bf16x8, pw3));
}
template <bool FIRST>
__device__ __forceinline__ void fold_branch(LAS float* ostg, State& st, float gate, LAS float* wsf, int r32, int hi) {
    float l = st.l;
    { auto rr = __builtin_amdgcn_permlane32_swap(__float_as_uint(l), __float_as_uint(l), false, false); l = __uint_as_float(rr[0]) + __uint_as_float(rr[1]); }
    const float f = l > 0.f ? gate / l : 0.f;
    asm volatile("s_waitcnt lgkmcnt(0)" ::: "memory");
    if (hi == 0) wsf[r32] = f;
    asm volatile("s_waitcnt lgkmcnt(0)" ::: "memory");
#pragma unroll
    for (int r = 0; r < 16; ++r) { const int orow = crow(r, hi); const float a = wsf[orow];
#pragma unroll
        for (int d0 = 0; d0 < 2; ++d0) { LAS float* p = ostg + orow * 64 + d0 * 32 + r32; if (FIRST) *p = st.o[d0][r] * a; else *p += st.o[d0][r] * a; } }
    asm volatile("s_waitcnt lgkmcnt(0)" ::: "memory");
}

__device__ __forceinline__ int nsa_unit(const Ptrs& P, LAS unsigned char* lds, int bg, int qt, const int wave_s, unsigned* qctr, int qbase) {
    unsigned char* ws = P.ws;
    const int lane = fresh_lane(), r32 = lane & 31, hi = lane >> 5; const int wid = wave_s;
    const int b = bg >> 2, g = bg & 3, t0 = 64 * qt;
    const int tl = 8 * wid + (r32 >> 2), hq = r32 & 3;
    const size_t m0 = (size_t)b * SEQ + t0;
    const bf16_t* Q = (const bf16_t*)(ws + WS_Q); const bf16_t* KV6 = (const bf16_t*)(ws + WS_KV6);
    const bf16_t* KSb = KV6 + 2 * KVSZ + (size_t)bg * SEQ * 64; const bf16_t* VSb = KV6 + 3 * KVSZ + (size_t)bg * SEQ * 64;
    const bf16_t* KWb = KV6 + 4 * KVSZ + (size_t)bg * SEQ * 64; const bf16_t* VWb = KV6 + 5 * KVSZ + (size_t)bg * SEQ * 64;
    const bf16_t* KCb = (const bf16_t*)(ws + WS_KC) + (size_t)bg * 256 * 64; const bf16_t* VCb = (const bf16_t*)(ws + WS_VC) + (size_t)bg * 256 * 64;
    const float* GATES = (const float*)(ws + WS_GATES); bf16_t* AB = (bf16_t*)(ws + WS_AB);
    const unsigned lds0 = (unsigned)(uintptr_t)lds;
    LAS float* wsf = (LAS float*)(lds + L_WSF) + wid * 64;
    LAS float* IMP = (LAS float*)(lds + L_IMP);
    LAS unsigned* MASK = (LAS unsigned*)(lds + L_MASK); LAS unsigned* WU = (LAS unsigned*)(lds + L_WU);
    const int koff = lane * 64 + wid * 8, voff = (16 * (wid & 3) + (lane >> 2)) * 64 + (wid >> 2) * 32 + (lane & 3) * 8;
    const unsigned kdst = lds0 + L_K + wid * 1024, vdst = lds0 + L_V + wid * 1024;
#define NSA_DMA_K(base, tile, slot) glds16((base) + (size_t)(tile) * 4096, (unsigned)koff * 2u, (unsigned)__builtin_amdgcn_readfirstlane(kdst + (slot) * SLOTB))
#define NSA_DMA_V(base, tile, slot) glds16((base) + (size_t)(tile) * 4096, (unsigned)voff * 2u, (unsigned)__builtin_amdgcn_readfirstlane(vdst + (slot) * SLOTB))
    const int vb0 = (int)(lds0 + L_V) + ((lane >> 4) & 1) * 32 + (lane & 3) * 8 + (4 * hi + ((lane & 15) >> 2)) * 64;
    LAS const char* Kbase = (LAS const char*)(lds + L_K);
    bf16x8 qr[4];
    { const bf16_t* qp = Q + (m0 + tl) * 1024 + (4 * g + hq) * 64 + hi * 8;
#pragma unroll
      for (int d0 = 0; d0 < 4; ++d0) qr[d0] = *(const bf16x8*)(qp + d0 * 16); }
    const float sl2 = __builtin_amdgcn_exp2f(-0.5f * (float)(4 * g + hq + 1)) * LOG2E;
    f32x16 bk;
#pragma unroll
    for (int r = 0; r < 16; ++r) bk[r] = sl2 * (float)((r & 3) + 8 * (r >> 2));
    const float b32t = 32.0f * sl2, b32c = 512.0f * sl2, hoff_t = 4.0f * (float)hi * sl2, hoff_c = 64.0f * (float)hi * sl2;
    float gate[3];
    { const float* gp = GATES + (m0 + tl) * 48 + (4 * g + hq) * 3; gate[0] = gp[0]; gate[1] = gp[1]; gate[2] = gp[2]; }
    LAS float* ostg = (LAS float*)(lds + L_OST) + wid * 2048;
    State st;
    f32x16 p0, p1;
    int nxt_ticket = 0;

    int tc = 0;
    VFrag vf;
    const int nvmax = (t0 + 63 >= 31) ? ((t0 + 63 - 31) >> 4) + 1 : 0;
    const int nct = (nvmax + 63) >> 6;
    const int tq = t0 + tl, nv = tq >= 31 ? ((tq - 31) >> 4) + 1 : 0;
    {
        state_init(st);
        const int j0 = qt >= 8 ? qt - 8 : 0, nt = qt - j0 + 1;
        NSA_DMA_K(KWb, qt, 0); NSA_DMA_V(VWb, qt, 0); NSA_WAIT_BAR();
        for (int i = 0; i < nt; ++i) {
            const int j = qt - i, slot = (tc + i) & 1;
            if (i + 1 < nt) { NSA_DMA_K(KWb, j - 1, slot ^ 1); NSA_DMA_V(VWb, j - 1, slot ^ 1); }
            else { NSA_DMA_K(KCb, nct - 1, slot ^ 1); NSA_DMA_V(VCb, nct - 1, slot ^ 1); }
            const float rb0 = sl2 * (float)(64 * j - t0), mref = tile_ref(st, rb0, true), c0 = rb0 + hoff_t - mref;
            if (j == qt) tile_scores<1, 1, true>(p0, p1, Kbase + slot * SLOTB, qr, bk, c0, b32t, tl, r32, hi, vf, vb0 + slot * SLOTB);
            else if (j == qt - 8) tile_scores<1, 2, true>(p0, p1, Kbase + slot * SLOTB, qr, bk, c0, b32t, tl, r32, hi, vf, vb0 + slot * SLOTB);
            else tile_scores<1, 0, true>(p0, p1, Kbase + slot * SLOTB, qr, bk, c0, b32t, 0, r32, hi, vf, vb0 + slot * SLOTB);
            tile_softmax_pv(st, p0, p1, mref, vf, wsf, r32, hi);
            NSA_WAIT_BAR();
        }
        tc += nt;
        fold_branch<true>(ostg, st, gate[2], wsf, r32, hi);
    }
    {
        state_init(st);
        for (int ci = 0; ci < nct; ++ci) {
            const int c = nct - 1 - ci, slot = (tc + ci) & 1;
            if (ci + 1 < nct) { NSA_DMA_K(KCb, c - 1, slot ^ 1); NSA_DMA_V(VCb, c - 1, slot ^ 1); }
            else if (qt >= 16) { NSA_DMA_K(KCb, 0, slot ^ 1); }
            else { NSA_DMA_K(KSb, qt, slot ^ 1); NSA_DMA_V(VSb, qt, slot ^ 1); }
            const float rb0 = sl2 * ((float)(1024 * c - t0) + 15.5f), mref = tile_ref(st, rb0, true), c0 = rb0 + hoff_c - mref;
            tile_scores<16, 3, true>(p0, p1, Kbase + slot * SLOTB, qr, bk, c0, b32c, nv - 64 * c, r32, hi, vf, vb0 + slot * SLOTB);
            tile_softmax_pv(st, p0, p1, mref, vf, wsf, r32, hi);
            NSA_WAIT_BAR();
        }
        tc += nct;
    }
    const float mc_fin = st.m; float lc = st.l;
    fold_branch<false>(ostg, st, gate[0], wsf, r32, hi);
    if (qt >= 16) {
        { auto rr = __builtin_amdgcn_permlane32_swap(__float_as_uint(lc), __float_as_uint(lc), false, false); lc = __uint_as_float(rr[0]) + __uint_as_float(rr[1]); }
        const float invl = lc > 0.f ? 1.0f / lc : 0.f;
        float carry = 0.f;
        for (int c = 0; c < nct; ++c) {
            const int slot = (tc + c) & 1;
            if (c + 1 < nct) { NSA_DMA_K(KCb, c + 1, slot ^ 1); }
            else { NSA_DMA_K(KSb, qt, slot ^ 1); NSA_DMA_V(VSb, qt, slot ^ 1); }
            const float c0 = sl2 * ((float)(1024 * c - t0) + 15.5f) + hoff_c - mc_fin;
            tile_scores<16, 3, false>(p0, p1, Kbase + slot * SLOTB, qr, bk, c0, b32c, nv - 64 * c, r32, hi, vf, 0);
#pragma unroll
            for (int r = 0; r < 16; ++r) { p0[r] = __builtin_amdgcn_exp2f(p0[r]) * invl; p1[r] = __builtin_amdgcn_exp2f(p1[r]) * invl; }
            float imp0[4], imp1[4], pl0[4], pl1[4];
#pragma unroll
            for (int a = 0; a < 4; ++a) {
                imp0[a] = (p0[4 * a] + p0[4 * a + 1]) + (p0[4 * a + 2] + p0[4 * a + 3]); imp1[a] = (p1[4 * a] + p1[4 * a + 1]) + (p1[4 * a + 2] + p1[4 * a + 3]);
                pl0[a] = __shfl_xor(p0[4 * a + 3], 32); pl1[a] = __shfl_xor(p1[4 * a + 3], 32);
            }
            if (hi) {
#pragma unroll
                for (int a = 0; a < 4; ++a) { imp0[a] += pl0[a]; imp1[a] += pl1[a]; }
            } else {
                imp0[0] += carry; imp1[0] += pl0[3];
#pragma unroll
                for (int a = 1; a < 4; ++a) { imp0[a] += pl0[a - 1]; imp1[a] += pl1[a - 1]; }
            }
            carry = pl1[3];
#pragma unroll
            for (int a = 0; a < 4; ++a) {
                imp0[a] += __shfl_xor(imp0[a], 1); imp0[a] += __shfl_xor(imp0[a], 2); imp1[a] += __shfl_xor(imp1[a], 1); imp1[a] += __shfl_xor(imp1[a], 2);
                if (hq == 0) { IMP[tl * 64 + 16 * c + 2 * a + hi] = imp0[a]; IMP[tl * 64 + 16 * c + 8 + 2 * a + hi] = imp1[a]; }
            }
            NSA_WAIT_BAR();
        }
        tc += nct;
    }
    unsigned long long wu = 0ull;
    if (qt < 16) {
        wu = (2ull << qt) - 1ull;
        if (lane < 8) { MASK[2 * (8 * wid + lane)] = (unsigned)wu; MASK[2 * (8 * wid + lane) + 1] = (unsigned)(wu >> 32); }
    } else {
        const int j = lane; const bool valid = j <= qt, forced = (j == 0) || (j == qt) || (j == qt - 1);
        for (int k = 0; k < 8; ++k) {
            const float imp = IMP[(8 * wid + k) * 64 + j];
            const float scv = valid ? (forced ? 1e9f : imp) : -1e9f;
            const unsigned fb = __float_as_uint(scv), key = fb ^ ((fb >> 31) ? 0xffffffffu : 0x80000000u);
            unsigned T = 0u;
#pragma unroll
            for (int bit = 31; bit >= 0; --bit) { const unsigned cand = T | (1u << bit); if (__builtin_popcountll(__ballot(key >= cand)) >= 16) T = cand; }
            const unsigned long long gt = __ballot(key > T), eq = __ballot(key == T);
            const int need = 16 - __builtin_popcountll(gt);
            const int before = (int)__builtin_amdgcn_mbcnt_hi((unsigned)(eq >> 32), __builtin_amdgcn_mbcnt_lo((unsigned)eq, 0u));
            const bool sel = (key > T) || ((key == T) && (before < need));
            const unsigned long long mk = __ballot(sel && (scv > -0.5e9f));
            wu |= mk;
            if (lane == 0) { MASK[2 * (8 * wid + k)] = (unsigned)mk; MASK[2 * (8 * wid + k) + 1] = (unsigned)(mk >> 32); }
        }
    }
    if (lane == 0) { WU[2 * wid] = (unsigned)wu; WU[2 * wid + 1] = (unsigned)(wu >> 32); }
    NSA_WAIT_BAR();
    unsigned long long uni = 0ull;
#pragma unroll
    for (int w = 0; w < 8; ++w) uni |= ((unsigned long long)WU[2 * w]) | (((unsigned long long)WU[2 * w + 1]) << 32);
    uni = ((unsigned long long)(unsigned)__builtin_amdgcn_readfirstlane((unsigned)uni)) | (((unsigned long long)(unsigned)__builtin_amdgcn_readfirstlane((unsigned)(uni >> 32))) << 32);
    const unsigned long long mymask = ((unsigned long long)MASK[2 * tl]) | (((unsigned long long)MASK[2 * tl + 1]) << 32);
    {
        state_init(st);
        unsigned long long rem = uni;
        int j = 63 - __builtin_clzll(rem); rem &= ~(1ull << j);
        for (int i = 0;; ++i) {
            const int slot = (tc + i) & 1; const bool more = rem != 0ull;
            int jn = 0;
            if (more) { jn = 63 - __builtin_clzll(rem); rem &= ~(1ull << jn); NSA_DMA_K(KSb, jn, slot ^ 1); NSA_DMA_V(VSb, jn, slot ^ 1); }
            if ((wu >> j) & 1ull) {
                const bool live = ((mymask >> j) & 1ull) != 0ull;
                const float rb0 = sl2 * (float)(64 * j - t0), mref = tile_ref(st, rb0, live), c0 = live ? rb0 + hoff_t - mref : -INFINITY;
                if (j == qt) tile_scores<1, 1, true>(p0, p1, Kbase + slot * SLOTB, qr, bk, c0, b32t, tl, r32, hi, vf, vb0 + slot * SLOTB);
                else tile_scores<1, 0, true>(p0, p1, Kbase + slot * SLOTB, qr, bk, c0, b32t, 0, r32, hi, vf, vb0 + slot * SLOTB);
                tile_softmax_pv(st, p0, p1, mref, vf, wsf, r32, hi);
            }
            NSA_WAIT_BAR();
            if (!more) break;
            j = jn;
        }
        if (wid == 0 && lane == 0) nxt_ticket = qbase + (int)__hip_atomic_fetch_add(qctr, 1u, __ATOMIC_RELAXED, __HIP_MEMORY_SCOPE_AGENT);
        fold_branch<false>(ostg, st, gate[1], wsf, r32, hi);
    }
    {
#pragma unroll
        for (int i = 0; i < 4; ++i) { const int row = i * 8 + (lane >> 3), ch = lane & 7;
            const f32x4_t v0 = *(LAS const f32x4_t*)(ostg + row * 64 + ch * 8), v1 = *(LAS const f32x4_t*)(ostg + row * 64 + ch * 8 + 4);
            u32x4_t v; v.x = cvtpk_s(v0[0], v0[1]); v.y = cvtpk_s(v0[2], v0[3]); v.z = cvtpk_s(v1[0], v1[1]); v.w = cvtpk_s(v1[2], v1[3]);
            *(u32x4_t*)(AB + (m0 + 8 * wid + (row >> 2)) * 2048 + 256 * g + (row & 3) * 64 + ch * 8) = v; }
    }
    NSA_WAIT_BAR();
#undef NSA_DMA_K
#undef NSA_DMA_V
    return nxt_ticket;
}
constexpr int L_QS = 145416;
__device__ __forceinline__ void nsa_phase(const Ptrs& P, LAS unsigned char* lds, int bid, int G, const int wave_s) {
    unsigned* qctr = (unsigned*)(P.ws + WS_CTL) + 3584;
    LAS int* qs = (LAS int*)(lds + L_QS);
    int k = bid;
    while (k < 1024 + LW_CHUNKS) {
        int nxt;
        if (k < 1024) {
            const int qt = 63 - (k >> 4), g = 3 - ((k >> 2) & 3), b = k & 3;
            nxt = nsa_unit(P, lds, b * 4 + g, qt, wave_s, qctr, G);
        } else {
            nxt = 0;
            if (wave_s == 0 && fresh_lane() == 0) nxt = G + (int)__hip_atomic_fetch_add(qctr, 1u, __ATOMIC_RELAXED, __HIP_MEMORY_SCOPE_AGENT);
            late_weight_chunk(P, lds, k - 1024, wave_s);
        }
        if (wave_s == 0 && fresh_lane() == 0) *qs = nxt;
        NSA_WAIT_BAR();
        k = __builtin_amdgcn_readfirstlane(*qs);
    }
}
}

namespace p2 {
using nsa::bf16x8; using nsa::f32x16; using nsa::s16x4; using nsa::crow; using nsa::glds16; using nsa::cvtpk_s;
#define P2_WAIT_BAR() asm volatile("s_waitcnt vmcnt(0) lgkmcnt(0)\n\ts_barrier" ::: "memory")
constexpr int CB_BUF = 40960;
constexpr int CP_STRIDE = 65;
__device__ __forceinline__ void compress_unit(const Ptrs& P, LAS unsigned char* lds, int u, const int wave_s) {
    unsigned char* ws = P.ws;
    const int lane = fresh_lane(), r32 = lane & 31, hi = lane >> 5, wid = wave_s;
    const int kv = u >> 6, bg = (u >> 2) & 15, n0 = 64 * (u & 3);
    const bf16_t* Ag = (const bf16_t*)(ws + WS_KV6) + (size_t)kv * KVSZ + (size_t)bg * SEQ * 64 + (size_t)n0 * 1024;
    const bf16_t* Bg = (const bf16_t*)(ws + WS_W1C) + (size_t)kv * 256 * 2048;
    const unsigned lds0 = (unsigned)(uintptr_t)lds;
    const int drow = 8 * wid + (lane >> 3), dchk = (lane & 7) ^ ((drow >> 1) & 7);
    const unsigned aoff = (unsigned)(drow * 1024 + dchk * 8) * 2u, boff = (unsigned)(drow * 2048 + dchk * 8) * 2u;
    const unsigned dstw = lds0 + wid * 1024;
#define P2_DMA_TILE(kt, buf) do { const unsigned d_ = (unsigned)__builtin_amdgcn_readfirstlane(dstw + (buf) * CB_BUF); \
        glds16(Ag + (kt) * 64, aoff, d_); \
        _Pragma("unroll") for (int ct_ = 0; ct_ < 4; ++ct_) glds16(Bg + (size_t)ct_ * 64 * 2048 + (kt) * 64, boff, d_ + 8192u * (ct_ + 1)); } while (0)
    const int ct = wid >> 1, half = wid & 1, ncol0 = 64 * ct + 32 * half;
    f32x16 hT[2]; hT[0] = f32x16{}; hT[1] = f32x16{};
    P2_DMA_TILE(0, 0); P2_DMA_TILE(1, 1);
    asm volatile("s_waitcnt vmcnt(5) lgkmcnt(0)\n\ts_barrier" ::: "memory");
    for (int kt = 0; kt < 32; ++kt) {
        const int buf = kt % 3;
        if (kt + 2 < 32) P2_DMA_TILE(kt + 2, (kt + 2) % 3);
        LAS const char* sa = (LAS const char*)(lds + buf * CB_BUF) + r32 * 128;
        LAS const char* sb = (LAS const char*)(lds + buf * CB_BUF + 8192 * (ct + 1)) + (32 * half + r32) * 128;
        const int sw = (r32 >> 1) & 7;
#pragma unroll
        for (int d0 = 0; d0 < 4; ++d0) {
            const int co = ((2 * d0 + hi) ^ sw) * 16;
            const bf16x8 bf = *(LAS const bf16x8*)(sb + co), a0 = *(LAS const bf16x8*)(sa + co), a1 = *(LAS const bf16x8*)(sa + 4096 + co);
            hT[0] = __builtin_amdgcn_mfma_f32_32x32x16_bf16(bf, a0, hT[0], 0, 0, 0);
            hT[1] = __builtin_amdgcn_mfma_f32_32x32x16_bf16(bf, a1, hT[1], 0, 0, 0);
        }
        if (kt + 2 < 32) asm volatile("s_waitcnt vmcnt(5) lgkmcnt(0)\n\ts_barrier" ::: "memory");
        else asm volatile("s_waitcnt vmcnt(0) lgkmcnt(0)\n\ts_barrier" ::: "memory");
    }
    const float* bias1 = (const float*)(ws + WS_SMALL + SM_BIAS1) + kv * 256 + ncol0;
    bf16x8 hb[2][2];
#pragma unroll
    for (int mt = 0; mt < 2; ++mt) {
        float g[16];
#pragma unroll
        for (int r = 0; r < 16; ++r) g[r] = gelu_tanh(hT[mt][r] + bias1[crow(r, hi)]);
#pragma unroll
        for (int s = 0; s < 2; ++s) { u32x4_t w; w.x = cvtpk_s(g[8 * s], g[8 * s + 1]); w.y = cvtpk_s(g[8 * s + 2], g[8 * s + 3]); w.z = cvtpk_s(g[8 * s + 4], g[8 * s + 5]); w.w = cvtpk_s(g[8 * s + 6], g[8 * s + 7]);
            hb[mt][s] = __builtin_bit_cast(bf16x8, w); }
    }
    const bf16_t* w2t = (const bf16_t*)(ws + WS_SMALL + SM_W2T) + (size_t)kv * 64 * 256;
    f32x16 oT[2][2];
#pragma unroll
    for (int dt = 0; dt < 2; ++dt)
#pragma unroll
        for (int mt = 0; mt < 2; ++mt) oT[dt][mt] = f32x16{};
#pragma unroll
    for (int dt = 0; dt < 2; ++dt)
#pragma unroll
        for (int s = 0; s < 2; ++s) {
            const bf16_t* wp = w2t + (size_t)(32 * dt + r32) * 256 + ncol0 + 16 * s + 4 * hi;
            const u32x2_t lo = *(const u32x2_t*)wp, hi2 = *(const u32x2_t*)(wp + 8);
            const u32x4_t wv = {lo.x, lo.y, hi2.x, hi2.y}; const bf16x8 wf = __builtin_bit_cast(bf16x8, wv);
#pragma unroll
            for (int mt = 0; mt < 2; ++mt) oT[dt][mt] = __builtin_amdgcn_mfma_f32_32x32x16_bf16(wf, hb[mt][s], oT[dt][mt], 0, 0, 0);
        }
    LAS float* part = (LAS float*)lds + wid * 64 * CP_STRIDE;
#pragma unroll
    for (int dt = 0; dt < 2; ++dt)
#pragma unroll
        for (int mt = 0; mt < 2; ++mt)
#pragma unroll
            for (int r = 0; r < 16; ++r) part[(32 * mt + r32) * CP_STRIDE + 32 * dt + crow(r, hi)] = oT[dt][mt][r];
    P2_WAIT_BAR();
    {
        const int tid = wid * 64 + lane, m = tid >> 3, dg = tid & 7;
        float o[8];
#pragma unroll
        for (int e = 0; e < 8; ++e) { float s = 0.f;
#pragma unroll
            for (int w = 0; w < 8; ++w) s += ((LAS const float*)lds)[(w * 64 + m) * CP_STRIDE + 8 * dg + e];
            o[e] = s; }
        if (kv == 0) {
            float ss = 0.f;
#pragma unroll
            for (int e = 0; e < 8; ++e) ss += o[e] * o[e];
            ss += __shfl_xor(ss, 1); ss += __shfl_xor(ss, 2); ss += __shfl_xor(ss, 4);
            const float rr = __builtin_amdgcn_rsqf(ss * (1.0f / 64.0f) + 1e-6f);
#pragma unroll
            for (int e = 0; e < 8; ++e) o[e] *= rr * P.in[4][8 * dg + e];
        }
        const int n = n0 + m;
        u32x4_t v = {0u, 0u, 0u, 0u};
        if (n < 255) { v.x = cvtpk_s(o[0], o[1]); v.y = cvtpk_s(o[2], o[3]); v.z = cvtpk_s(o[4], o[5]); v.w = cvtpk_s(o[6], o[7]); }
        *(u32x4_t*)((bf16_t*)(ws + (kv ? WS_VC : WS_KC)) + ((size_t)bg * 256 + n) * 64 + 8 * dg) = v;
    }
    P2_WAIT_BAR();
#undef P2_DMA_TILE
}

constexpr int G_V = 0, G_ST = 32768, G_OST = 33792, G_END = 33792 + 65536;
struct GmlpIn { u32x4_t raw[4]; u32x4_t uraw[4]; float sbv[4]; };
__device__ __forceinline__ void gmlp_load(GmlpIn& in, const Ptrs& P, int unit, int tid, int lane, int r32, int hi, int wid) {
    unsigned char* ws = P.ws;
    const int g = unit & 7, chunk = (unit >> 3) & 31, b = unit >> 8; const int m0 = b * SEQ + chunk * 128;
    const bf16_t* GV = (const bf16_t*)(ws + WS_GV); const bf16_t* U = (const bf16_t*)(ws + WS_U);
    const int tb = wid >> 1, ch = wid & 1; (void)r32; (void)hi;
#pragma unroll
    for (int i = 0; i < 4; ++i) { const int idx = tid + 512 * i, s = idx >> 4, c8 = idx & 15; in.raw[i] = *(const u32x4_t*)(GV + (size_t)(m0 + s) * 1024 + g * 128 + 8 * c8); }
#pragma unroll
    for (int i = 0; i < 4; ++i) { const int row = i * 8 + (lane >> 3), t = 32 * tb + row; in.uraw[i] = *(const u32x4_t*)(U + (size_t)(m0 + t) * 1024 + g * 128 + 64 * ch + 8 * (lane & 7)); in.sbv[i] = P.in[11][g * 128 + t]; }
}
__device__ __forceinline__ void gmlp_compute(const GmlpIn& in, const f32x4_t (&sv)[8], const bf16x8 (&pa)[2][4], const f32x4_t w0, const f32x4_t w1, const f32x4_t b0, const f32x4_t b1, const Ptrs& P, LAS unsigned char* lds, int unit, int tid, int lane, int r32, int hi, int wid) {
    unsigned char* ws = P.ws;
    const int g = unit & 7, chunk = (unit >> 3) & 31, b = unit >> 8; const int m0 = b * SEQ + chunk * 128;
    bf16_t* AB = (bf16_t*)(ws + WS_AB);
    LAS float* st = (LAS float*)(lds + G_ST);
    const int tb = wid >> 1, ch = wid & 1;
    if (tid < 128) { float s1 = 0.f, s2 = 0.f;
#pragma unroll
        for (int i = 0; i < 8; ++i) { s1 += sv[i][0] + sv[i][2]; s2 += sv[i][1] + sv[i][3]; }
        const float mean = s1 * (1.0f / 1024.0f); float var = s2 * (1.0f / 1024.0f) - mean * mean; var = var < 0.f ? 0.f : var;
        st[2 * tid] = mean; st[2 * tid + 1] = __builtin_amdgcn_rsqf(var + 1e-5f); }
    asm volatile("s_waitcnt lgkmcnt(0)\n\ts_barrier" ::: "memory");
#pragma unroll
    for (int i = 0; i < 4; ++i) { const int idx = tid + 512 * i, s = idx >> 4, c8 = idx & 15;
        float f[8]; unpack8(in.raw[i], f);
        const float mean = st[2 * s], rstd = st[2 * s + 1];
        float y[8];
#pragma unroll
        for (int e = 0; e < 4; ++e) { y[e] = (f[e] - mean) * rstd * w0[e] + b0[e]; y[4 + e] = (f[4 + e] - mean) * rstd * w1[e] + b1[e]; }
        u32x4_t o; o.x = cvtpk_s(y[0], y[1]); o.y = cvtpk_s(y[2], y[3]); o.z = cvtpk_s(y[4], y[5]); o.w = cvtpk_s(y[6], y[7]);
        const int st_ = s >> 6, sk = s & 63, chh = c8 >> 3, x = c8 & 7;
        *(LAS u32x4_t*)(lds + G_V + (st_ * 2 + chh) * 8192 + (x >> 2) * 4096 + (sk >> 4) * 1024 + (sk & 15) * 64 + (x & 3) * 16) = o; }
    asm volatile("s_waitcnt lgkmcnt(0)\n\ts_barrier" ::: "memory");
    f32x16 o[2]; o[0] = f32x16{}; o[1] = f32x16{};
    const int vb0 = (int)((unsigned)(uintptr_t)lds + G_V) + ((lane >> 4) & 1) * 32 + (lane & 3) * 8 + (4 * hi + ((lane & 15) >> 2)) * 64;
    nsa::pv(o, vb0 + ch * 8192, pa[0][0], pa[0][1], pa[0][2], pa[0][3]);
    if (tb >= 2) nsa::pv(o, vb0 + (2 + ch) * 8192, pa[1][0], pa[1][1], pa[1][2], pa[1][3]);
    LAS float* ostg = (LAS float*)(lds + G_OST) + wid * 2048;
#pragma unroll
    for (int r = 0; r < 16; ++r) { const int orow = crow(r, hi);
#pragma unroll
        for (int d0 = 0; d0 < 2; ++d0) ostg[orow * 64 + d0 * 32 + r32] = o[d0][r]; }
    asm volatile("s_waitcnt lgkmcnt(0)" ::: "memory");
#pragma unroll
    for (int i = 0; i < 4; ++i) { const int row = i * 8 + (lane >> 3), c8 = lane & 7, t = 32 * tb + row;
        const f32x4_t v0 = *(LAS const f32x4_t*)(ostg + row * 64 + c8 * 8), v1 = *(LAS const f32x4_t*)(ostg + row * 64 + c8 * 8 + 4);
        const size_t grow = (size_t)(m0 + t); const int col = g * 128 + 64 * ch + 8 * c8;
        float uf[8]; unpack8(in.uraw[i], uf);
        const float sb_ = in.sbv[i];
        u32x4_t w; w.x = cvtpk_s(uf[0] * (v0[0] + sb_), uf[1] * (v0[1] + sb_)); w.y = cvtpk_s(uf[2] * (v0[2] + sb_), uf[3] * (v0[3] + sb_));
        w.z = cvtpk_s(uf[4] * (v1[0] + sb_), uf[5] * (v1[1] + sb_)); w.w = cvtpk_s(uf[6] * (v1[2] + sb_), uf[7] * (v1[3] + sb_));
        *(u32x4_t*)(AB + grow * 2048 + 1024 + col) = w; }
    asm volatile("s_waitcnt lgkmcnt(0)\n\ts_barrier" ::: "memory");
}
__device__ __forceinline__ void gmlp_run(const Ptrs& P, LAS unsigned char* lds, int u0, int stride, int nunits, const int wave_s) {
    const int lane = fresh_lane(), r32 = lane & 31, hi = lane >> 5, wid = wave_s, tid = wid * 64 + lane;
    GmlpIn A, B;
    int u = u0;
    bf16x8 pa[2][4];
    { const bf16_t* SWB = (const bf16_t*)(P.ws + WS_SMALL + SM_SWB) + (size_t)(u0 & 7) * 16384; const int tb = wid >> 1;
#pragma unroll
      for (int st_ = 0; st_ < 2; ++st_)
#pragma unroll
        for (int ks = 0; ks < 4; ++ks) {
            const bf16_t* wp = SWB + (size_t)(32 * tb + r32) * 128 + 64 * st_ + 16 * ks + 4 * hi;
            const u32x2_t lo = *(const u32x2_t*)wp, hi2 = *(const u32x2_t*)(wp + 8);
            const u32x4_t wv = {lo.x, lo.y, hi2.x, hi2.y}; pa[st_][ks] = __builtin_bit_cast(bf16x8, wv); } }
    const int c8v = tid & 15, g0 = u0 & 7;
    const f32x4_t w0 = *(const f32x4_t*)(P.in[8] + g0 * 128 + 8 * c8v), w1 = *(const f32x4_t*)(P.in[8] + g0 * 128 + 8 * c8v + 4), b0 = *(const f32x4_t*)(P.in[9] + g0 * 128 + 8 * c8v), b1 = *(const f32x4_t*)(P.in[9] + g0 * 128 + 8 * c8v + 4);
    const float* VSTAT = (const float*)(P.ws + WS_VSTAT);
#define GMLP_STATS(sv_, unit_) do { const int m0_ = ((unit_) >> 8) * SEQ + (((unit_) >> 3) & 31) * 128; const f32x4_t* p_ = (const f32x4_t*)(VSTAT + (size_t)(m0_ + (tid & 127)) * 32); \
        _Pragma("unroll") for (int i_ = 0; i_ < 8; ++i_) sv_[i_] = p_[i_]; } while (0)
    f32x4_t sv[8];
    if (u < nunits) gmlp_load(A, P, u, tid, lane, r32, hi, wid);
    while (u < nunits) {
        GMLP_STATS(sv, u);
        if (u + stride < nunits) gmlp_load(B, P, u + stride, tid, lane, r32, hi, wid);
        gmlp_compute(A, sv, pa, w0, w1, b0, b1, P, lds, u, tid, lane, r32, hi, wid);
        u += stride; if (u >= nunits) break;
        GMLP_STATS(sv, u);
        if (u + stride < nunits) gmlp_load(A, P, u + stride, tid, lane, r32, hi, wid);
        gmlp_compute(B, sv, pa, w0, w1, b0, b1, P, lds, u, tid, lane, r32, hi, wid);
        u += stride;
    }
#undef GMLP_STATS
    asm volatile("s_waitcnt vmcnt(0) lgkmcnt(0)\n\ts_barrier" ::: "memory");
}
#undef P2_WAIT_BAR
}

#define XB_TMO      128
#define XB_XCNT(j)  (256  + 64 * (j))
#define XB_XSUB(j)  (1280 + 64 * (j))
#define XB_XGEN(j)  (2304 + 64 * (j))
#define XB_TOP      3328
#define XB_TOPGEN   3392
#define XCD_BAR_WORDS 3456
#define XB_SPIN_CAP (1u << 18)

__device__ __forceinline__ unsigned xb_ld(unsigned* p)              { return __hip_atomic_load(p, __ATOMIC_RELAXED, __HIP_MEMORY_SCOPE_AGENT); }
__device__ __forceinline__ unsigned xb_add(unsigned* p, unsigned v) { return __hip_atomic_fetch_add(p, v, __ATOMIC_RELAXED, __HIP_MEMORY_SCOPE_AGENT); }
__device__ __forceinline__ unsigned xb_xcc_id() { return (unsigned)__builtin_amdgcn_s_getreg((3 << 11) | 20) & 0xFu; }
#define XB_SPIN(cond, bar) do { unsigned _sp = 0; while (cond) { __builtin_amdgcn_s_sleep(1); \
    if ((++_sp & 255u) == 0u) { if (xb_ld(&(bar)[XB_TMO])) break; if (_sp > XB_SPIN_CAP) { atomicAdd(&(bar)[XB_TMO], 1u); break; } } } } while (0)

struct XcdBarrier {
    unsigned* bar; unsigned x; unsigned w0;
    volatile LAS unsigned* st;
};

__device__ __forceinline__ XcdBarrier xcd_barrier_post(unsigned* bar, volatile LAS unsigned* st, int wave_s) {
    XcdBarrier b; b.bar = bar; b.x = xb_xcc_id(); b.st = st; b.w0 = wave_s == 0 ? 1u : 0u;
    if (b.w0 && fresh_lane() == 0) (void)xb_add(&bar[XB_XCNT(b.x)], 1u);
    return b;
}
__device__ __forceinline__ void xcd_barrier_complete(unsigned* bar, unsigned x, unsigned& nloc, unsigned& nx) {
    const unsigned G = gridDim.x * gridDim.y * gridDim.z;
    unsigned sum, cnt, mine, sp = 0u;
    for (;;) {
        sum = 0u; cnt = 0u; mine = 0u;
#pragma unroll
        for (unsigned j = 0; j < 16; ++j) { const unsigned c = xb_ld(&bar[XB_XCNT(j)]); sum += c; cnt += (c > 0u) ? 1u : 0u; mine = (j == x) ? c : mine; }
        if (sum == G) break;
        __builtin_amdgcn_s_sleep(1);
        if ((++sp & 255u) == 0u) { if (xb_ld(&bar[XB_TMO])) break; if (sp > XB_SPIN_CAP) { atomicAdd(&bar[XB_TMO], 1u); break; } }
    }
    nloc = mine > 0u ? mine : 1u; nx = cnt > 0u ? cnt : 1u;
}

__device__ __forceinline__ void xcd_barrier(const XcdBarrier& b) {
    asm volatile("s_waitcnt vmcnt(0)" ::: "memory");
    __syncthreads();
    if (b.w0 && fresh_lane() == 0) {
        unsigned* bar = b.bar;
        __builtin_amdgcn_s_waitcnt(0);
        unsigned nloc = b.st[0], nx = b.st[1];
        if (nloc == 0u) { xcd_barrier_complete(bar, b.x, nloc, nx); b.st[0] = nloc; b.st[1] = nx; }
        const unsigned old = xb_add(&bar[XB_XSUB(b.x)], 1u);
        const unsigned gen = old / nloc;
        if (old + 1u == (gen + 1u) * nloc) {
            __builtin_amdgcn_fence(__ATOMIC_RELEASE, "agent");
            asm volatile("s_waitcnt vmcnt(0)" ::: "memory");
            const unsigned og = xb_add(&bar[XB_TOP], 1u);
            const unsigned tg = og / nx;
            if (og + 1u == (tg + 1u) * nx) xb_add(&bar[XB_TOPGEN], 1u);
            else XB_SPIN(xb_ld(&bar[XB_TOPGEN]) == tg, bar);
            __builtin_amdgcn_fence(__ATOMIC_ACQUIRE, "agent");
            xb_add(&bar[XB_XGEN(b.x)], 1u);
            asm volatile("s_waitcnt vmcnt(0)" ::: "memory");
        } else {
            XB_SPIN(xb_ld(&bar[XB_XGEN(b.x)]) == gen, bar);
            __builtin_amdgcn_fence(__ATOMIC_ACQUIRE, "agent");
            asm volatile("s_waitcnt vmcnt(0)" ::: "memory");
        }
    }
    __syncthreads();
}

constexpr int LDS_BYTES = 151552;
constexpr int LDS_XCH = 132096;
constexpr int LDS_MISC = 145408;
__global__ void __launch_bounds__(512, 2) mega_fwd(Ptrs P) {
    extern __shared__ __attribute__((aligned(16))) unsigned char lds_raw[];
    LAS unsigned char* lds = (LAS unsigned char*)lds_raw;
    unsigned char* ws = P.ws;
    const int wave = __builtin_amdgcn_readfirstlane(threadIdx.x >> 6);
    const int G = gridDim.x, bid = blockIdx.x;
    if (wave == 0) { const int l_ = fresh_lane(); if (l_ < 2) ((LAS unsigned*)(lds + LDS_MISC))[l_] = 0u; }
    __syncthreads();
    const XcdBarrier bar = xcd_barrier_post((unsigned*)(ws + WS_CTL), (volatile LAS unsigned*)(lds + LDS_MISC), wave);
    p0_prologue(P, lds, bid, G, wave);
    xcd_barrier(bar);
    if (bid == 0) bias1_stage(ws, fresh_tid(wave));
    {
        pg8::Gemm g{(const bf16_t*)(ws + WS_XN), (const bf16_t*)(ws + WS_WIN), MTOK, NPROJ, 2048, 2048};
        pg8::StaticOrder S; S.init(MTOK, NPROJ, G, bid);
        pg8::EpiProj E{(bf16_t*)(ws + WS_Q), (bf16_t*)(ws + WS_KV6), (bf16_t*)(ws + WS_U), (bf16_t*)(ws + WS_GV), (float*)(ws + WS_GATES), (float*)(ws + WS_VSTAT), P.in[3], P.in[4]};
        pg8::gemm_phase<pg8::EpiProj, pg8::StaticOrder, true, true>(lds, g, S, E, wave);
    }
    xcd_barrier(bar);
    if (bid < 128 && G >= 256) p2::compress_unit(P, lds, bid, wave);
    else if (G >= 256) p2::gmlp_run(P, lds, bid - 128, G - 128, 1024, wave);
    xcd_barrier(bar);
    nsa::nsa_phase(P, lds, bid, G, wave);
    xcd_barrier(bar);
    {
        pg8::Gemm g{(const bf16_t*)(ws + WS_AB), (const bf16_t*)(ws + WS_WOUT), MTOK, 2048, 2048, 2048};
        pg8::StaticOrder S; S.init(MTOK, 2048, G, bid);
        pg8::EpiRes1 E{(const float*)(ws + WS_SMALL + SM_RINV), (const float*)(ws + WS_SMALL + SM_INVW), (bf16_t*)(ws + WS_XN), (float*)(ws + WS_SSQ)};
        pg8::gemm_phase<pg8::EpiRes1, pg8::StaticOrder, true, true>(lds, g, S, E, wave);
    }
    xcd_barrier(bar);
    for (int m = bid * 512 + fresh_tid(wave); m < MTOK; m += G * 512) {
        const float* p = (const float*)(ws + WS_SSQ) + (size_t)m * 32; float s = 0.f;
#pragma unroll
        for (int i = 0; i < 32; ++i) s += p[i];
        ((float*)(ws + WS_SMALL + SM_R2))[m] = __builtin_amdgcn_rsqf(s * (1.0f / D_MODEL) + 1e-6f);
    }
    xcd_barrier(bar);
    {
        pg8::Gemm g{(const bf16_t*)(ws + WS_XN), (const bf16_t*)(ws + WS_WUP), MTOK, N_UP, 2048, 2048};
        pg8::StaticOrder S; S.init(MTOK, N_UP, G, bid);
        pg8::EpiUpConv E{(bf16_t*)(ws + WS_G), (const float*)(ws + WS_SMALL + SM_R2), P.in[15], P.in[16], (float*)(ws + WS_HLAST), (float*)(ws + WS_FIRST), lds + LDS_XCH};
        pg8::gemm_phase<pg8::EpiUpConv, pg8::StaticOrder, true, true>(lds, g, S, E, wave);
    }
    xcd_barrier(bar);
    for (int it = bid * 512 + fresh_tid(wave); it < 60 * 44 * 2 * 16; it += G * 512) {
        const int c8 = it & 15, row = (it >> 4) & 1, tl_ = it >> 5, pn = tl_ % 44, pmi = tl_ / 44, pm = pmi + pmi / 15 + 1;
        const float* cw = P.in[15]; const float* cb = P.in[16]; (void)cb;
        const float* fp = (const float*)(ws + WS_FIRST) + ((size_t)(pm * 44 + pn) * 2 + row) * 256 + 8 * c8;
        const float* lp = (const float*)(ws + WS_HLAST) + ((size_t)((pm - 1) * 44 + pn) * 2) * 256 + 8 * c8;
        const int ch = pn * 128 + 8 * c8;
        float r[8];
#pragma unroll
        for (int e = 0; e < 8; ++e) {
            const float l0g = lp[e], l1g = lp[256 + e], l0u = lp[128 + e], l1u = lp[256 + 128 + e];
            const float w0g = cw[ch + e], w1g = cw[N_UP + ch + e], w0u = cw[D_FF + ch + e], w1u = cw[N_UP + D_FF + ch + e];
            const float cg = fp[e] + (row == 0 ? w1g * l1g + w0g * l0g : w0g * l1g), cu = fp[128 + e] + (row == 0 ? w1u * l1u + w0u * l0u : w0u * l1u);
            r[e] = cg * sigmoidf_(cg) * cu;
        }
        u32x4_t o; o.x = pk2(r[0], r[1]); o.y = pk2(r[2], r[3]); o.z = pk2(r[4], r[5]); o.w = pk2(r[6], r[7]);
        *(u32x4_t*)((bf16_t*)(ws + WS_G) + (size_t)(pm * 256 + row) * D_FF + ch) = o;
    }
    xcd_barrier(bar);
    {
        pg8::Gemm g{(const bf16_t*)(ws + WS_G), (const bf16_t*)(ws + WS_WDOWN), MTOK, 2048, D_FF, D_FF};
        pg8::StaticOrder S; S.init(MTOK, 2048, G, bid);
        pg8::EpiDown E{P.out, (const bf16_t*)(ws + WS_XN)};
        pg8::gemm_phase<pg8::EpiDown, pg8::StaticOrder, true, true>(lds, g, S, E, wave);
    }
}

extern "C" void kernel_launch(void* const* d_in, const int* in_sizes, int n_in, void* d_out, int out_size, void* d_ws, size_t ws_size, hipStream_t stream) {
    static int grid_blocks = 0;
    if (!grid_blocks) {
        int dev = 0, cus = 0, per_cu = 0;
        (void)hipGetDevice(&dev);
        (void)hipDeviceGetAttribute(&cus, hipDeviceAttributeMultiprocessorCount, dev);
        (void)hipFuncSetAttribute((const void*)mega_fwd, hipFuncAttributeMaxDynamicSharedMemorySize, LDS_BYTES);
        (void)hipOccupancyMaxActiveBlocksPerMultiprocessor(&per_cu, (const void*)mega_fwd, 512, LDS_BYTES);
        if (per_cu < 1) { fprintf(stderr, "kernel_launch: occupancy query says %d blocks/CU\n", per_cu); per_cu = 1; }
        grid_blocks = cus * 1;
        (void)hipGetLastError();
    }
    if (n_in != 18 || ws_size < WS_END) { fprintf(stderr, "kernel_launch: unexpected n_in %d / ws %zu\n", n_in, ws_size); return; }
    Ptrs P{};
    for (int i = 0; i < 18; ++i) P.in[i] = (const float*)d_in[i];
    P.out = (float*)d_out; P.ws = (unsigned char*)d_ws;
    (void)hipMemsetAsync((char*)d_ws + WS_CTL, 0, 16384, stream);
    mega_fwd<<<dim3(grid_blocks), dim3(512), LDS_BYTES, stream>>>(P);
}
```

```cpp
#include <hip/hip_runtime.h>
#include <cstdio>
#include <cstdint>

constexpr int D_MODEL = 2048, BATCH = 4, SEQ = 4096, MTOK = BATCH * SEQ;
constexpr int IN_COLS = 4656, NPROJ = 4864;
constexpr int D_FF = 5632, N_UP = 2 * D_FF;
constexpr int NBG = 16;
constexpr size_t KVSZ = (size_t)NBG * SEQ * 64;
constexpr float LOG2E = 1.4426950408889634f;

constexpr size_t MiB = 1u << 20;
constexpr size_t WS_CTL = 0;
constexpr size_t WS_WIN = 1 * MiB, WS_WOUT = 20 * MiB, WS_WUP = 28 * MiB, WS_WDOWN = 72 * MiB, WS_W1C = 94 * MiB;
constexpr size_t WS_SMALL = 96 * MiB;
constexpr size_t SM_BIASP = 0, SM_BIAS1 = 65536, SM_R2 = 131072, SM_W2T = 196608  , SM_SWB = 262144  , SM_RINV = 524288  , SM_INVW = 589824  ;
constexpr size_t WS_XN = 97 * MiB;
constexpr size_t WS_Q = 161 * MiB;
constexpr size_t WS_KV6 = 193 * MiB;
constexpr size_t WS_U = 241 * MiB, WS_GV = 273 * MiB;
constexpr size_t WS_GATES = 305 * MiB;
constexpr size_t WS_VSTAT = 308 * MiB;
constexpr size_t WS_KC = 310 * MiB, WS_VC = 310 * MiB + 524288;
constexpr size_t WS_HC = 311 * MiB;
constexpr size_t WS_AB = 315 * MiB;
constexpr size_t WS_SSQ = 379 * MiB;
constexpr size_t WS_G = 161 * MiB;
constexpr size_t WS_HID = 381 * MiB;
constexpr size_t WS_HLAST = 381 * MiB, WS_FIRST = 388 * MiB;
constexpr size_t WS_END = 469 * MiB;

#define LAS __attribute__((address_space(3)))
typedef unsigned short bf16_t;
typedef unsigned u32x4_t __attribute__((ext_vector_type(4)));
typedef unsigned u32x2_t __attribute__((ext_vector_type(2)));
typedef float f32x4_t __attribute__((ext_vector_type(4)));

__device__ __forceinline__ float bf2f(unsigned short h) { return __uint_as_float(((unsigned)h) << 16); }
__device__ __forceinline__ unsigned f2bf(float f) { unsigned u = __float_as_uint(f); return (u + 0x7fffu + ((u >> 16) & 1u)) >> 16; }
__device__ __forceinline__ unsigned pk2(float lo, float hi) { return f2bf(lo) | (f2bf(hi) << 16); }
__device__ __forceinline__ float gelu_tanh(float x) {
    const float u = 0.7978845608028654f * (x + 0.044715f * x * x * x);
    const float e = __builtin_amdgcn_exp2f(-2.8853900817779268f * u);
    return x * __builtin_amdgcn_rcpf(1.0f + e);
}
__device__ __forceinline__ float sigmoidf_(float x) { return __builtin_amdgcn_rcpf(1.0f + __builtin_amdgcn_exp2f(-LOG2E * x)); }
__device__ __forceinline__ float wave_sum(float v) {
#pragma unroll
    for (int o = 1; o < 64; o <<= 1) v += __shfl_xor(v, o);
    return v;
}
__device__ __forceinline__ void unpack8(u32x4_t r, float (&f)[8]) {
    f[0] = __uint_as_float(r.x << 16); f[1] = __uint_as_float(r.x & 0xffff0000u);
    f[2] = __uint_as_float(r.y << 16); f[3] = __uint_as_float(r.y & 0xffff0000u);
    f[4] = __uint_as_float(r.z << 16); f[5] = __uint_as_float(r.z & 0xffff0000u);
    f[6] = __uint_as_float(r.w << 16); f[7] = __uint_as_float(r.w & 0xffff0000u);
}

__device__ __forceinline__ int fresh_lane() { unsigned z_ = 0u; asm volatile("" : "+v"(z_)); return (int)__builtin_amdgcn_mbcnt_hi(~0u, __builtin_amdgcn_mbcnt_lo(~0u, z_)); }
__device__ __forceinline__ int fresh_tid(int wave_s) { return wave_s * 64 + fresh_lane(); }
namespace pg8 {
#define PG8_LAS __attribute__((address_space(3)))
typedef unsigned short bf16_t;
typedef short bf16x8 __attribute__((ext_vector_type(8)));
typedef float f32x4 __attribute__((ext_vector_type(4)));
typedef unsigned u32x4 __attribute__((ext_vector_type(4)));
constexpr int BM = 256, BK = 64, HALF = 128, HTB = HALF * BK * 2  , STAGE_BYTES = 8 * HTB, NXCD = 8, WGM = 8;

__host__ __device__ __forceinline__ int lds_byte(int r, int c) { const int st = (r >> 4) * 2 + (c >> 5), rr = r & 15, cc = c & 31, ob = rr * 64 + cc * 2; return st * 1024 + (ob ^ (((ob >> 9) & 1) << 5)); }
__host__ __device__ __forceinline__ void stage_rc(int b, int& R, int& C) { const int st = b / 1024, sb = b % 1024, swz = sb ^ (((sb >> 9) & 1) << 5); R = (st >> 1) * 16 + swz / 64; C = (st & 1) * 32 + (swz % 64) / 2; }
__host__ __device__ __forceinline__ int perm32(int rho) { const int n = rho >> 4, i = rho & 15; return 8 * (i >> 2) + 4 * n + (i & 3); }

struct Unit { int pm, pn; };
struct Gemm { const bf16_t* A; const bf16_t* Bt; int M, N, K, lda; };

struct StaticOrder {
    int nM, nN, nwg, G, c;
    __host__ __device__ void init(int M, int N, int G_, int c_) { nM = M / BM; nN = N / BM; nwg = nM * nN; G = G_; c = c_; }
    __host__ __device__ bool next(int i, Unit& u) const {
        const long L = (long)i * G + c; if (L >= nwg) return false;
        int wgid = (int)L; { const int q = nwg / NXCD, r = nwg % NXCD, xcd = wgid % NXCD, off = wgid / NXCD; wgid = (xcd < r ? xcd * (q + 1) : r * (q + 1) + (xcd - r) * q) + off; }
        const int nig = WGM * nN, gid = wgid / nig, fm = gid * WGM, gsz = (nM - fm) < WGM ? (nM - fm) : WGM;
        u.pm = fm + ((wgid % nig) % gsz); u.pn = (wgid % nig) / gsz; return true;
    }
    __device__ __forceinline__ void a_ready(const Unit&) const {}
    __device__ __forceinline__ void done(const Unit&) const {}
};

__device__ __forceinline__ unsigned cvt_pk_bf16(float lo, float hi) { unsigned r; asm volatile("v_cvt_pk_bf16_f32 %0, %1, %2" : "=v"(r) : "v"(lo), "v"(hi)); return r; }

struct EpiProj {
    static constexpr bool PERM = true, AFTER_DRAIN = false, PERMA = false;
    bf16_t* Q; bf16_t* KV6; bf16_t* U; bf16_t* GV; float* GATES; float* VSTAT; const float* q_norm_w; const float* k_norm_w;
    __device__ __forceinline__ void operator()(const f32x4 (&acc)[2][2][4][2], const Unit& u, int wr, int wc, int fr, int fq) const {
        const int pn = u.pn, row0 = u.pm * BM + wr * 64 + fr;
        if (pn < 10) {
            const bool normed = (pn < 4) || pn == 6 || pn == 8;
            const float* w = pn < 4 ? q_norm_w : (k_norm_w + (pn == 6 ? 64 : 128));
            const float sc = pn < 4 ? 0.125f * LOG2E : 1.0f;
            f32x4 wv[2][2];
#pragma unroll
            for (int bj = 0; bj < 2; ++bj)
#pragma unroll
                for (int n = 0; n < 2; ++n) wv[bj][n] = normed ? (*(const f32x4*)(w + 32 * bj + 8 * fq + 4 * n)) * sc : (f32x4){1.f, 1.f, 1.f, 1.f};
#pragma unroll
            for (int ai = 0; ai < 2; ++ai)
#pragma unroll
                for (int m = 0; m < 4; ++m) {
                    const int row = row0 + ai * HALF + m * 16;
                    float r = 1.f;
                    if (normed) {
                        float ss = 0.f;
#pragma unroll
                        for (int bj = 0; bj < 2; ++bj)
#pragma unroll
                            for (int n = 0; n < 2; ++n) { const f32x4 x = acc[ai][bj][m][n]; ss += (x[0] * x[0] + x[1] * x[1]) + (x[2] * x[2] + x[3] * x[3]); }
                        ss += __shfl_xor(ss, 16); ss += __shfl_xor(ss, 32);
                        r = __builtin_amdgcn_rsqf(ss * (1.0f / 64.0f) + 1e-6f);
                    }
                    bf16_t* dst;
                    if (pn < 4) dst = Q + (size_t)row * 1024 + pn * 256 + wc * 64 + 8 * fq;
                    else { const int b = row >> 12, t = row & 4095; dst = KV6 + (size_t)(pn - 4) * KVSZ + ((size_t)((b * 4 + wc) * 4096 + t)) * 64 + 8 * fq; }
#pragma unroll
                    for (int bj = 0; bj < 2; ++bj) {
                        const f32x4 v0 = acc[ai][bj][m][0] * r * wv[bj][0], v1 = acc[ai][bj][m][1] * r * wv[bj][1];
                        u32x4 o; o.x = cvt_pk_bf16(v0[0], v0[1]); o.y = cvt_pk_bf16(v0[2], v0[3]); o.z = cvt_pk_bf16(v1[0], v1[1]); o.w = cvt_pk_bf16(v1[2], v1[3]);
                        *(u32x4*)(dst + 32 * bj) = o;
                    }
                }
        } else if (pn < 18) {
            const bool isv = pn >= 14; const int ct = isv ? pn - 14 : pn - 10;
            bf16_t* base = (isv ? GV : U) + ct * 256 + wc * 64 + 8 * fq;
#pragma unroll
            for (int ai = 0; ai < 2; ++ai)
#pragma unroll
                for (int m = 0; m < 4; ++m) {
                    const int row = row0 + ai * HALF + m * 16; float s1 = 0.f, s2 = 0.f;
#pragma unroll
                    for (int bj = 0; bj < 2; ++bj) {
                        f32x4 v0 = acc[ai][bj][m][0], v1 = acc[ai][bj][m][1];
#pragma unroll
                        for (int e = 0; e < 4; ++e) { v0[e] = gelu_tanh(v0[e]); v1[e] = gelu_tanh(v1[e]); s1 += v0[e] + v1[e]; s2 += v0[e] * v0[e] + v1[e] * v1[e]; }
                        u32x4 o; o.x = cvt_pk_bf16(v0[0], v0[1]); o.y = cvt_pk_bf16(v0[2], v0[3]); o.z = cvt_pk_bf16(v1[0], v1[1]); o.w = cvt_pk_bf16(v1[2], v1[3]);
                        *(u32x4*)(base + (size_t)row * 1024 + 32 * bj) = o;
                    }
                    if (isv) {
                        s1 += __shfl_xor(s1, 16); s1 += __shfl_xor(s1, 32); s2 += __shfl_xor(s2, 16); s2 += __shfl_xor(s2, 32);
                        if (fq == 0) { float* p = VSTAT + ((size_t)row * 16 + ct * 4 + wc) * 2; p[0] = s1; p[1] = s2; }
                    }
                }
        } else {
            if (wc == 0) {
#pragma unroll
                for (int ai = 0; ai < 2; ++ai)
#pragma unroll
                    for (int m = 0; m < 4; ++m) {
                        const int row = row0 + ai * HALF + m * 16;
#pragma unroll
                        for (int bj = 0; bj < 2; ++bj)
#pragma unroll
                            for (int n = 0; n < 2; ++n) {
                                const int L = 32 * bj + 8 * fq + 4 * n;
                                if (L < 48) { f32x4 v = acc[ai][bj][m][n]; f32x4 o; o[0] = sigmoidf_(v[0]); o[1] = sigmoidf_(v[1]); o[2] = sigmoidf_(v[2]); o[3] = sigmoidf_(v[3]); *(f32x4*)(GATES + (size_t)row * 48 + L) = o; }
                            }
                    }
            }
        }
    }
};
struct EpiCmp {
    static constexpr bool PERM = true, AFTER_DRAIN = false, PERMA = false;
    bf16_t* HC; const float* bias1;
    __device__ __forceinline__ void operator()(const f32x4 (&acc)[2][2][4][2], const Unit& u, int wr, int wc, int fr, int fq) const {
        const int row0 = u.pm * BM + wr * 64 + fr, col0 = wc * 32 + 8 * fq;
        f32x4 bv[2][2];
#pragma unroll
        for (int bj = 0; bj < 2; ++bj)
#pragma unroll
            for (int n = 0; n < 2; ++n) bv[bj][n] = *(const f32x4*)(bias1 + u.pn * 256 + col0 + bj * HALF + 4 * n);
#pragma unroll
        for (int ai = 0; ai < 2; ++ai)
#pragma unroll
            for (int m = 0; m < 4; ++m) { bf16_t* rowp = HC + (size_t)(row0 + ai * HALF + m * 16) * 256 + col0;
#pragma unroll
                for (int bj = 0; bj < 2; ++bj) { f32x4 v0 = acc[ai][bj][m][0] + bv[bj][0], v1 = acc[ai][bj][m][1] + bv[bj][1];
#pragma unroll
                    for (int e = 0; e < 4; ++e) { v0[e] = gelu_tanh(v0[e]); v1[e] = gelu_tanh(v1[e]); }
                    u32x4 o; o.x = cvt_pk_bf16(v0[0], v0[1]); o.y = cvt_pk_bf16(v0[2], v0[3]); o.z = cvt_pk_bf16(v1[0], v1[1]); o.w = cvt_pk_bf16(v1[2], v1[3]);
                    *(u32x4*)(rowp + bj * HALF) = o; } }
    }
};
struct CmpOrder {
    int c, G;
    __device__ bool next(int i, Unit& u) const { const int L = i * G + c; if (L >= 32) return false; u.pm = L; u.pn = L >> 4; return true; }
    __device__ __forceinline__ void a_ready(const Unit&) const {}
    __device__ __forceinline__ void done(const Unit&) const {}
};
struct EpiRes1 {
    static constexpr bool PERM = false, AFTER_DRAIN = false, PERMA = false;
    const float* RINV; const float* INVW; bf16_t* X1b; float* SSQ;
    __device__ __forceinline__ void operator()(const f32x4 (&acc)[2][2][4][2], const Unit& u, int wr, int wc, int fr, int fq) const {
        const int row0 = u.pm * BM + wr * 64 + fr, col0 = u.pn * BM + wc * 32 + 4 * fq;
        f32x4 iw[2][2];
#pragma unroll
        for (int bj = 0; bj < 2; ++bj)
#pragma unroll
            for (int n = 0; n < 2; ++n) iw[bj][n] = *(const f32x4*)(INVW + col0 + bj * HALF + n * 16);
#pragma unroll
        for (int ai = 0; ai < 2; ++ai) {
            u32x2_t xin[4][2][2]; float ri[4];
#pragma unroll
            for (int m = 0; m < 4; ++m) { ri[m] = RINV[row0 + ai * HALF + m * 16];
#pragma unroll
                for (int bj = 0; bj < 2; ++bj)
#pragma unroll
                    for (int n = 0; n < 2; ++n) xin[m][bj][n] = *(const u32x2_t*)(X1b + (size_t)(row0 + ai * HALF + m * 16) * D_MODEL + col0 + bj * HALF + n * 16); }
            __builtin_amdgcn_sched_barrier(0);
#pragma unroll
            for (int m = 0; m < 4; ++m) { const int row = row0 + ai * HALF + m * 16; const size_t off = (size_t)row * D_MODEL + col0; float ss = 0.f;
#pragma unroll
                for (int bj = 0; bj < 2; ++bj)
#pragma unroll
                    for (int n = 0; n < 2; ++n) { const u32x2_t w_ = xin[m][bj][n];
                        f32x4 xv; xv[0] = __uint_as_float(w_.x << 16); xv[1] = __uint_as_float(w_.x & 0xffff0000u); xv[2] = __uint_as_float(w_.y << 16); xv[3] = __uint_as_float(w_.y & 0xffff0000u);
                        const f32x4 v = xv * ri[m] * iw[bj][n] + acc[ai][bj][m][n];
                        ss += (v[0] * v[0] + v[1] * v[1]) + (v[2] * v[2] + v[3] * v[3]);
                        u32x2_t w; w.x = cvt_pk_bf16(v[0], v[1]); w.y = cvt_pk_bf16(v[2], v[3]); *(u32x2_t*)(X1b + off + bj * HALF + n * 16) = w; }
                ss += __shfl_xor(ss, 16); ss += __shfl_xor(ss, 32);
                if (fq == 0) SSQ[(size_t)row * 32 + u.pn * 4 + wc] = ss; }
            __builtin_amdgcn_sched_barrier(0);
        }
    }
};
struct EpiUpV1 {
    static constexpr bool PERM = true, AFTER_DRAIN = false, PERMA = false;
    bf16_t* HID; const float* R2;
    __device__ __forceinline__ void operator()(const f32x4 (&acc)[2][2][4][2], const Unit& u, int wr, int wc, int fr, int fq) const {
        const int row0 = u.pm * BM + wr * 64 + fr, col0 = u.pn * BM + wc * 32 + 8 * fq;
#pragma unroll
        for (int ai = 0; ai < 2; ++ai)
#pragma unroll
            for (int m = 0; m < 4; ++m) { const int row = row0 + ai * HALF + m * 16; const float r = R2[row]; bf16_t* rowp = HID + (size_t)row * N_UP + col0;
#pragma unroll
                for (int bj = 0; bj < 2; ++bj) { const f32x4 v0 = acc[ai][bj][m][0] * r, v1 = acc[ai][bj][m][1] * r;
                    u32x4 o; o.x = cvt_pk_bf16(v0[0], v0[1]); o.y = cvt_pk_bf16(v0[2], v0[3]); o.z = cvt_pk_bf16(v1[0], v1[1]); o.w = cvt_pk_bf16(v1[2], v1[3]);
                    *(u32x4*)(rowp + bj * HALF) = o; } }
    }
};
struct EpiDown {
    static constexpr bool PERM = false, AFTER_DRAIN = false, PERMA = false;
    float* out; const bf16_t* X1b;
    __device__ __forceinline__ void operator()(const f32x4 (&acc)[2][2][4][2], const Unit& u, int wr, int wc, int fr, int fq) const {
        const int row0 = u.pm * BM + wr * 64 + fr, col0 = u.pn * BM + wc * 32 + 4 * fq;
#pragma unroll
        for (int ai = 0; ai < 2; ++ai) {
            u32x2_t xin[4][2][2];
#pragma unroll
            for (int m = 0; m < 4; ++m)
#pragma unroll
                for (int bj = 0; bj < 2; ++bj)
#pragma unroll
                    for (int n = 0; n < 2; ++n) xin[m][bj][n] = *(const u32x2_t*)(X1b + (size_t)(row0 + ai * HALF + m * 16) * D_MODEL + col0 + bj * HALF + n * 16);
            __builtin_amdgcn_sched_barrier(0);
#pragma unroll
            for (int m = 0; m < 4; ++m) { const size_t off = (size_t)(row0 + ai * HALF + m * 16) * D_MODEL + col0;
#pragma unroll
                for (int bj = 0; bj < 2; ++bj)
#pragma unroll
                    for (int n = 0; n < 2; ++n) { const u32x2_t w = xin[m][bj][n];
                        f32x4 v; v[0] = __uint_as_float(w.x << 16); v[1] = __uint_as_float(w.x & 0xffff0000u); v[2] = __uint_as_float(w.y << 16); v[3] = __uint_as_float(w.y & 0xffff0000u);
                        *(f32x4*)(out + off + bj * HALF + n * 16) = v + acc[ai][bj][m][n]; } }
            __builtin_amdgcn_sched_barrier(0);
        }
    }
};
__device__ __forceinline__ unsigned f2bf_(float f) { unsigned u = __float_as_uint(f); return (u + 0x7fffu + ((u >> 16) & 1u)) >> 16; }
typedef float f32x2 __attribute__((ext_vector_type(2)));
struct EpiUpConv {
    static constexpr bool PERM = true, AFTER_DRAIN = false, PERMA = true;
    bf16_t* G; const float* R2; const float* cw; const float* cb; float* HLAST; float* FIRST; PG8_LAS unsigned char* xlds;
    __device__ __forceinline__ void prefetch(const Unit& u, int par, const int wave_s) const {
        const int lane_ = fresh_lane();
        PG8_LAS float* Wl = (PG8_LAS float*)xlds + (par ? 3344 : 2048);
#pragma unroll
        for (int i2 = 0; i2 < 2; ++i2) { const int i = wave_s * 64 + lane_ + 512 * i2, k = i >> 8, p = i & 255, c = (p < 128 ? 0 : D_FF - 128) + u.pn * 128 + p;
            const float* src = k < 3 ? cw + (unsigned)(k * N_UP + c) : cb + (unsigned)c;
            __builtin_amdgcn_global_load_lds((const unsigned*)src, (PG8_LAS unsigned*)(Wl + wave_s * 64 + 512 * i2), 4, 0, 0); }
        if (wave_s < 4) __builtin_amdgcn_global_load_lds((const unsigned*)(R2 + u.pm * BM + wave_s * 64 + lane_), (PG8_LAS unsigned*)(Wl + 1024 + wave_s * 64), 4, 0, 0);
    }
    __device__ __forceinline__ void run(const f32x4 (&acc)[2][2][4][2], const Unit& u, const Unit& nxt, const bool has_next, const int par, int wr, int wc, const int wave_s) const {
        unsigned z_ = 0u; asm volatile("" : "+v"(z_));
        const int lane_ = (int)__builtin_amdgcn_mbcnt_hi(~0u, __builtin_amdgcn_mbcnt_lo(~0u, z_)); const int fr = lane_ & 15, fq = lane_ >> 4;
        const int row0 = u.pm * BM + wr * 64 + 4 * fr;
        PG8_LAS float* X = (PG8_LAS float*)xlds;
        PG8_LAS float* Wl = X + (par ? 3344 : 2048);
        PG8_LAS float* R2L = Wl + 1024;
        const unsigned tile = (unsigned)(u.pm * (N_UP / 256) + u.pn);
        asm volatile("s_waitcnt vmcnt(8)" ::: "memory"); __builtin_amdgcn_s_barrier(); asm volatile("" ::: "memory");
        if (has_next) prefetch(nxt, par ^ 1, wave_s);
        if (fr == 15) {
#pragma unroll
            for (int ai = 0; ai < 2; ++ai) { const int sg = 2 * ai + wr; const float r2a = R2L[ai * HALF + wr * 64 + 62], r2b = R2L[ai * HALF + wr * 64 + 63];
#pragma unroll
                for (int mm = 0; mm < 2; ++mm)
#pragma unroll
                for (int bj = 0; bj < 2; ++bj)
#pragma unroll
                    for (int n = 0; n < 2; ++n) { const f32x4 h = acc[ai][bj][2 + mm][n] * (mm ? r2b : r2a);
                        *(PG8_LAS f32x4*)(X + ((sg * 4 + wc) * 2 + mm) * 64 + bj * 32 + 8 * fq + 4 * n) = h;
                        if (ai == 1 && wr == 1) *(f32x4*)(HLAST + (unsigned)((tile * 2 + mm) * 256 + bj * HALF + wc * 32 + 8 * fq + 4 * n)) = h; } }
        }
        asm volatile("s_waitcnt lgkmcnt(0)" ::: "memory"); __builtin_amdgcn_s_barrier(); asm volatile("" ::: "memory");
        const int cbase = u.pn * 128 + wc * 32 + 8 * fq;
        const bool seq_start = (u.pm & 15) == 0;
#pragma unroll
        for (int ai = 0; ai < 2; ++ai) {
            const int sg = 2 * ai + wr;
            const f32x4 rs = *(PG8_LAS const f32x4*)(R2L + ai * HALF + wr * 64 + 4 * fr);
            const bool defer = (ai == 0) && (wr == 0) && !seq_start && (fr == 0);
            unsigned pk[2][4][2];
#pragma unroll
            for (int n = 0; n < 2; ++n) {
#pragma unroll
                for (int e2 = 0; e2 < 2; ++e2) {
                    asm volatile("" ::: "memory"); __builtin_amdgcn_sched_barrier(0);
                    PG8_LAS const f32x2* wp = (PG8_LAS const f32x2*)(Wl + wc * 32 + 8 * fq + 4 * n + 2 * e2);
                    const f32x2 wg0 = wp[0], wg1 = wp[128], wg2 = wp[256], bg = wp[384], wu0 = wp[64], wu1 = wp[192], wu2 = wp[320], bu = wp[448];
                    f32x2 hg1 = {0.f, 0.f}, hg2 = {0.f, 0.f}, hu1 = {0.f, 0.f}, hu2 = {0.f, 0.f};
                    if (ai == 1 || wr == 1) { PG8_LAS const f32x2* xp = (PG8_LAS const f32x2*)(X + (((sg - 1) * 4 + wc) * 2) * 64 + 8 * fq + 4 * n + 2 * e2); hg2 = xp[0]; hg1 = xp[32]; hu2 = xp[16]; hu1 = xp[48]; }
                    f32x2 vg[4], vu[4], cg[4], cu[4];
#pragma unroll
                    for (int m = 0; m < 4; ++m) { const f32x2 r2 = {rs[m], rs[m]};
                        vg[m] = (f32x2){acc[ai][0][m][n][2 * e2], acc[ai][0][m][n][2 * e2 + 1]} * r2; vu[m] = (f32x2){acc[ai][1][m][n][2 * e2], acc[ai][1][m][n][2 * e2 + 1]} * r2; }
#define EPI_SHR1(old_, v_) (f32x2){__uint_as_float(__builtin_amdgcn_update_dpp(__float_as_uint((old_).x), __float_as_uint((v_).x), 0x111, 0xf, 0xf, false)), __uint_as_float(__builtin_amdgcn_update_dpp(__float_as_uint((old_).y), __float_as_uint((v_).y), 0x111, 0xf, 0xf, false))}
                    const f32x2 pg1 = EPI_SHR1(hg1, vg[3]), pg2 = EPI_SHR1(hg2, vg[2]), pu1 = EPI_SHR1(hu1, vu[3]), pu2 = EPI_SHR1(hu2, vu[2]);
#undef EPI_SHR1
                    cg[0] = bg + wg0 * pg2 + wg1 * pg1 + wg2 * vg[0]; cu[0] = bu + wu0 * pu2 + wu1 * pu1 + wu2 * vu[0];
                    cg[1] = bg + wg0 * pg1 + wg1 * vg[0] + wg2 * vg[1]; cu[1] = bu + wu0 * pu1 + wu1 * vu[0] + wu2 * vu[1];
                    cg[2] = bg + wg0 * vg[0] + wg1 * vg[1] + wg2 * vg[2]; cu[2] = bu + wu0 * vu[0] + wu1 * vu[1] + wu2 * vu[2];
                    cg[3] = bg + wg0 * vg[1] + wg1 * vg[2] + wg2 * vg[3]; cu[3] = bu + wu0 * vu[1] + wu1 * vu[2] + wu2 * vu[3];
                    if (defer) {
#pragma unroll
                        for (int m = 0; m < 2; ++m) { float* fp = FIRST + (unsigned)((tile * 2 + m) * 256 + wc * 32 + 8 * fq + 4 * n + 2 * e2); *(f32x2*)fp = cg[m]; *(f32x2*)(fp + HALF) = cu[m]; }
                    }
#pragma unroll
                    for (int m = 0; m < 4; ++m) {
                        const f32x2 t = cg[m] * (f32x2){-LOG2E, -LOG2E};
                        f32x2 sg_ = {__builtin_amdgcn_exp2f(t.x), __builtin_amdgcn_exp2f(t.y)};
                        sg_ = sg_ + (f32x2){1.0f, 1.0f};
                        const f32x2 rc = {__builtin_amdgcn_rcpf(sg_.x), __builtin_amdgcn_rcpf(sg_.y)};
                        const f32x2 gv = cg[m] * rc * cu[m];
                        pk[n][m][e2] = cvt_pk_bf16(gv.x, gv.y);
                    }
                }
            }
#pragma unroll
            for (int m = 0; m < 4; ++m)
                if (!(m < 2 && defer)) { u32x4 o; o.x = pk[0][m][0]; o.y = pk[0][m][1]; o.z = pk[1][m][0]; o.w = pk[1][m][1]; *(u32x4*)(G + (unsigned)((row0 + ai * HALF + m) * D_FF + cbase)) = o; }
        }
    }
};
template <class Epi, class Sched, bool ALIGN_EPI = false, bool SP2 = false>
__device__ __forceinline__ void gemm_phase(PG8_LAS unsigned char* lds, const Gemm g, const Sched& S, const Epi& E, const int wave_s) {
    const int tid = fresh_tid(wave_s), wid = wave_s, lane = tid & 63,
          wr = wid >> 2, wc = wid & 3, fr = lane & 15, fq = lane >> 4;
    const int K = g.K, nt = K / BK;
    unsigned voffA[2], voffB[2];
#pragma unroll
    for (int i = 0; i < 2; ++i) { int R, C; stage_rc(tid * 16 + i * 8192, R, C); const int Rb = Epi::PERM ? ((R & ~31) + perm32(R & 31)) : R;
        const int Ra = Epi::PERMA ? ((R & ~63) + 4 * (R & 15) + ((R >> 4) & 3)) : R;
        voffA[i] = (unsigned)(Ra * g.lda + C) * 2u; voffB[i] = (unsigned)(Rb * K + C) * 2u; }
    const size_t kstep = (size_t)(BK * 2);
    const size_t hstepA = (size_t)HALF * g.lda * 2, hstepB = (size_t)HALF * K * 2;
    const size_t tstepA = 2 * hstepA, tstepB = 2 * hstepB;
    const unsigned ldsw = (unsigned)wid * 1024u;
    const int aoff = lds_byte(wr * 64 + fr, fq * 8), boff = lds_byte(wc * 32 + fr, fq * 8);
#define PG8_SA(b, h) (((b) * 2 + (h)) * HTB)
#define PG8_SB(b, h) ((4 + (b) * 2 + (h)) * HTB)
#define PG8_STAGE(bufoff, gbase, voff) do { _Pragma("unroll") for (int _i = 0; _i < 2; ++_i) \
        __builtin_amdgcn_global_load_lds((const unsigned*)((const char*)(gbase) + (voff)[_i]), (PG8_LAS unsigned*)(lds + (bufoff) + ldsw + _i * 8192), 16, 0, 0); } while (0)
#define PG8_LDA(dst, b, h) do { _Pragma("unroll") for (int m = 0; m < 4; ++m) _Pragma("unroll") for (int k = 0; k < 2; ++k) dst[m][k] = *(const PG8_LAS bf16x8*)(lds + PG8_SA(b, h) + aoff + m * 2048 + k * 1024); } while (0)
#define PG8_LDB(dst, b, h) do { _Pragma("unroll") for (int n = 0; n < 2; ++n) _Pragma("unroll") for (int k = 0; k < 2; ++k) dst[n][k] = *(const PG8_LAS bf16x8*)(lds + PG8_SB(b, h) + boff + n * 2048 + k * 1024); } while (0)
#define PG8_MMA(ai, bj, At, Bt) do { __builtin_amdgcn_s_setprio(1); _Pragma("unroll") for (int m = 0; m < 4; ++m) _Pragma("unroll") for (int n = 0; n < 2; ++n) _Pragma("unroll") for (int k = 0; k < 2; ++k) \
        acc[ai][bj][m][n] = __builtin_amdgcn_mfma_f32_16x16x32_bf16(Bt[n][k], At[m][k], acc[ai][bj][m][n], 0, 0, 0); __builtin_amdgcn_s_setprio(0); } while (0)
#define PG8_WAIT_V(n) asm volatile("s_waitcnt vmcnt(" #n ")" ::: "memory")
#define PG8_WAIT_L(n) asm volatile("s_waitcnt lgkmcnt(" #n ")" ::: "memory")
#define PG8_BAR __builtin_amdgcn_s_barrier()
#define PG8_SCHED __builtin_amdgcn_sched_barrier(0)
    Unit cur, nxt; int ui = 0;
    if (!S.next(0, cur)) return;
    f32x4 acc[2][2][4][2];
#pragma unroll
    for (int a = 0; a < 2; ++a)
#pragma unroll
        for (int b = 0; b < 2; ++b)
#pragma unroll
            for (int m = 0; m < 4; ++m)
#pragma unroll
                for (int n = 0; n < 2; ++n) acc[a][b][m][n] = (f32x4){0.f, 0.f, 0.f, 0.f};
    bf16x8 At[4][2], B0[2][2], B1[2][2];
    const char* cA = (const char*)g.A + (size_t)cur.pm * tstepA; const char* cB = (const char*)g.Bt + (size_t)cur.pn * tstepB;
    S.a_ready(cur);
    if constexpr (Epi::PERMA) E.prefetch(cur, 0, wave_s);
    if constexpr (SP2) {
        PG8_STAGE(PG8_SB(0, 0), cB, voffB); PG8_STAGE(PG8_SB(0, 1), cB + hstepB, voffB); PG8_STAGE(PG8_SA(0, 0), cA, voffA); PG8_STAGE(PG8_SA(0, 1), cA + hstepA, voffA);
        if (wr == 1) PG8_BAR;
        PG8_WAIT_V(2); PG8_BAR;
        PG8_STAGE(PG8_SB(1, 0), cB + kstep, voffB); PG8_STAGE(PG8_SA(1, 0), cA + kstep, voffA); PG8_STAGE(PG8_SB(1, 1), cB + hstepB + kstep, voffB);
        PG8_WAIT_V(6); PG8_BAR;
    } else {
        PG8_STAGE(PG8_SB(0, 0), cB, voffB); PG8_STAGE(PG8_SA(0, 0), cA, voffA); PG8_STAGE(PG8_SB(0, 1), cB + hstepB, voffB); PG8_STAGE(PG8_SA(0, 1), cA + hstepA, voffA);
        if (wr == 1) PG8_BAR;
        PG8_WAIT_V(4); PG8_BAR;
        PG8_STAGE(PG8_SB(1, 0), cB + kstep, voffB); PG8_STAGE(PG8_SA(1, 0), cA + kstep, voffA); PG8_STAGE(PG8_SB(1, 1), cB + hstepB + kstep, voffB);
        PG8_WAIT_V(6); PG8_BAR;
    }
    for (;;) {
        const bool has_next = S.next(ui + 1, nxt);
        const char* nA = has_next ? (const char*)g.A + (size_t)nxt.pm * tstepA : cA; const char* nB = has_next ? (const char*)g.Bt + (size_t)nxt.pn * tstepB : cB;
        for (int t = 0; t < nt; t += 2) {
            const bool last = (t == nt - 2);
            const char* a1 = cA + (size_t)(t + 1) * kstep;
            const char* a2 = last ? nA : cA + (size_t)(t + 2) * kstep; const char* b2 = last ? nB : cB + (size_t)(t + 2) * kstep;
            const char* a3 = a2 + kstep; const char* b3 = b2 + kstep;
            if (last && has_next) S.a_ready(nxt);
            if constexpr (SP2) {
            PG8_LDB(B0, 0, 0); PG8_LDB(B1, 0, 1); PG8_SCHED; PG8_LDA(At, 0, 0); PG8_STAGE(PG8_SA(1, 1), a1 + hstepA, voffA);
            PG8_WAIT_V(8); PG8_WAIT_L(0); PG8_BAR; PG8_MMA(0, 0, At, B0); PG8_MMA(0, 1, At, B1); PG8_BAR; PG8_SCHED;
            PG8_LDA(At, 0, 1); PG8_STAGE(PG8_SB(0, 0), b2, voffB); PG8_STAGE(PG8_SB(0, 1), b2 + hstepB, voffB); PG8_STAGE(PG8_SA(0, 0), a2, voffA);
            PG8_WAIT_V(8); PG8_WAIT_L(0); PG8_BAR; PG8_MMA(1, 0, At, B0); PG8_MMA(1, 1, At, B1); PG8_BAR; PG8_SCHED;
            PG8_LDB(B0, 1, 0); PG8_LDB(B1, 1, 1); PG8_SCHED; PG8_LDA(At, 1, 0); PG8_STAGE(PG8_SA(0, 1), a2 + hstepA, voffA);
            PG8_WAIT_V(8); PG8_WAIT_L(0); PG8_BAR; PG8_MMA(0, 0, At, B0); PG8_MMA(0, 1, At, B1); PG8_BAR; PG8_SCHED;
            PG8_LDA(At, 1, 1); PG8_STAGE(PG8_SB(1, 0), b3, voffB); PG8_STAGE(PG8_SB(1, 1), b3 + hstepB, voffB); PG8_STAGE(PG8_SA(1, 0), a3, voffA);
            PG8_WAIT_V(8); PG8_WAIT_L(0); PG8_BAR; PG8_MMA(1, 0, At, B0); PG8_MMA(1, 1, At, B1); PG8_BAR; PG8_SCHED;
            } else {
            PG8_LDB(B0, 0, 0); PG8_SCHED; PG8_LDA(At, 0, 0); PG8_STAGE(PG8_SA(1, 1), a1 + hstepA, voffA);
            PG8_WAIT_L(8); PG8_BAR; PG8_WAIT_L(0); PG8_MMA(0, 0, At, B0); PG8_BAR; PG8_SCHED;
            PG8_LDB(B1, 0, 1); PG8_STAGE(PG8_SB(0, 0), b2, voffB);
            PG8_BAR; PG8_WAIT_L(0); PG8_MMA(0, 1, At, B1); PG8_BAR;
            PG8_LDA(At, 0, 1); PG8_STAGE(PG8_SA(0, 0), a2, voffA);
            PG8_BAR; PG8_WAIT_L(0); PG8_MMA(1, 0, At, B0); PG8_BAR; PG8_SCHED;
            PG8_STAGE(PG8_SB(0, 1), b2 + hstepB, voffB);
            PG8_WAIT_V(6); PG8_BAR; PG8_MMA(1, 1, At, B1); PG8_BAR;
            PG8_LDB(B0, 1, 0); PG8_SCHED; PG8_LDA(At, 1, 0); PG8_STAGE(PG8_SA(0, 1), a2 + hstepA, voffA);
            PG8_WAIT_L(8); PG8_BAR; PG8_WAIT_L(0); PG8_MMA(0, 0, At, B0); PG8_BAR; PG8_SCHED;
            PG8_LDB(B1, 1, 1); PG8_STAGE(PG8_SB(1, 0), b3, voffB);
            PG8_BAR; PG8_WAIT_L(0); PG8_MMA(0, 1, At, B1); PG8_BAR;
            PG8_LDA(At, 1, 1); PG8_STAGE(PG8_SA(1, 0), a3, voffA);
            PG8_BAR; PG8_WAIT_L(0); PG8_MMA(1, 0, At, B0); PG8_BAR; PG8_SCHED;
            PG8_STAGE(PG8_SB(1, 1), b3 + hstepB, voffB);
            PG8_WAIT_V(6); PG8_BAR; PG8_MMA(1, 1, At, B1); PG8_BAR;
            }
        }
        if constexpr (ALIGN_EPI) { if (wr == 0) PG8_BAR; }
        if constexpr (Epi::PERMA) { E.run(acc, cur, nxt, has_next, ui & 1, wr, wc, wave_s); S.done(cur); }
        else if constexpr (!Epi::AFTER_DRAIN) { E(acc, cur, wr, wc, fr, fq); S.done(cur); }
        if (!has_next) break;
#pragma unroll
        for (int a = 0; a < 2; ++a)
#pragma unroll
            for (int b = 0; b < 2; ++b)
#pragma unroll
                for (int m = 0; m < 4; ++m)
#pragma unroll
                    for (int n = 0; n < 2; ++n) acc[a][b][m][n] = (f32x4){0.f, 0.f, 0.f, 0.f};
        cur = nxt; cA = nA; cB = nB; ++ui;
        if constexpr (ALIGN_EPI) { if (wr == 1) PG8_BAR; }
    }
    PG8_WAIT_V(0);
    if constexpr (!ALIGN_EPI) { if (wr == 0) PG8_BAR; }
    PG8_BAR;
    if constexpr (Epi::AFTER_DRAIN) { E.fused(acc, cur, wr, wc, fr, fq, lds, wid, lane); S.done(cur); }
#undef PG8_SA
#undef PG8_SB
#undef PG8_STAGE
#undef PG8_LDA
#undef PG8_LDB
#undef PG8_MMA
#undef PG8_WAIT_V
#undef PG8_WAIT_L
#undef PG8_BAR
#undef PG8_SCHED
}
}
constexpr int NWAVES = 8;
template <class RowMap>
__device__ __forceinline__ void transpose_item(const float* __restrict__ W, int K, int N, bf16_t* WT, const float* __restrict__ kscale, RowMap rm, LAS float* scr, int item, int lane) {
    const int nblk = (N + 31) / 32, kb = item / nblk, nb = item % nblk, k0 = 64 * kb, n0 = 32 * nb;
    const int nr = n0 + (lane & 31);
    float v[32];
#pragma unroll
    for (int i = 0; i < 32; ++i) { const int kk = 2 * i + (lane >> 5); v[i] = (nr < N) ? W[(size_t)(k0 + kk) * N + nr] : 0.f; }
    if (kscale) {
#pragma unroll
        for (int i = 0; i < 32; ++i) v[i] *= kscale[k0 + 2 * i + (lane >> 5)];
    }
#pragma unroll
    for (int i = 0; i < 32; ++i) scr[(2 * i + (lane >> 5)) * 33 + (lane & 31)] = v[i];
    asm volatile("s_waitcnt lgkmcnt(0)" ::: "memory");
    const int c = lane & 7;
#pragma unroll
    for (int j = 0; j < 4; ++j) { const int nl = (lane >> 3) + 8 * j, n = n0 + nl;
        if (n < N) { const LAS float* s = scr + (8 * c) * 33 + nl;
            u32x4_t o; o.x = pk2(s[0 * 33], s[1 * 33]); o.y = pk2(s[2 * 33], s[3 * 33]); o.z = pk2(s[4 * 33], s[5 * 33]); o.w = pk2(s[6 * 33], s[7 * 33]);
            *(u32x4_t*)(WT + (size_t)rm(n) * K + k0 + 8 * c) = o; } }
    asm volatile("s_waitcnt lgkmcnt(0)" ::: "memory");
}
struct RmIdent { __device__ __forceinline__ int operator()(int n) const { return n; } };
struct RmWin {
    __device__ __forceinline__ int operator()(int c) const {
        const int nc = c < 2560 ? c : (c < 2608 ? 4608 + (c - 2560) : 2560 + (c - 2608));
        const int tile = nc >> 8, L = nc & 255, wc = L >> 6, bj = (L >> 5) & 1, j = L & 31;
        return tile * 256 + 128 * bj + 32 * wc + j;
    }
};
struct RmWup {
    __device__ __forceinline__ int operator()(int c) const { const int up = c >= D_FF, cc = up ? c - D_FF : c; return (cc >> 7) * 256 + up * 128 + (cc & 127); }
};

struct Ptrs {
    const float* in[18]; float* out; unsigned char* ws;
};

__device__ __forceinline__ void p0_prologue(const Ptrs& P, LAS unsigned char* lds, int vcu, int G, const int wave) {
    const int lane = fresh_lane();
    LAS float* scr = (LAS float*)(lds + wave * 16384);
    const int gw = vcu * NWAVES + wave, NGW = G * NWAVES;
    unsigned char* ws = P.ws;
    bf16_t* WinT = (bf16_t*)(ws + WS_WIN); bf16_t* WoutT = (bf16_t*)(ws + WS_WOUT); bf16_t* WupT = (bf16_t*)(ws + WS_WUP); bf16_t* WdownT = (bf16_t*)(ws + WS_WDOWN); bf16_t* W1cT = (bf16_t*)(ws + WS_W1C);
    const float* x = P.in[0]; const float* attn_norm_w = P.in[1]; const float* w_in = P.in[2]; const float* cmp_pos = P.in[5]; const float* cmp_w1 = P.in[6];
    const float* w_out = P.in[12]; const float* ffn_norm_w = P.in[13]; const float* w_up = P.in[14]; const float* w_down = P.in[17];
    constexpr int I_IN = 32 * 146, I_W1 = 32 * 8, I_W2 = 4 * 2;
    constexpr int NITEMS = I_IN + 2 * I_W1 + 2 * I_W2;
    (void)w_out; (void)w_up; (void)w_down; (void)ffn_norm_w; (void)WoutT; (void)WupT; (void)WdownT;
    for (int it = gw; it < NITEMS; it += NGW) {
        int r = it;
        if (r < I_IN) { transpose_item(w_in, 2048, IN_COLS, WinT, nullptr, RmWin(), scr, r, lane); continue; } r -= I_IN;
        if (r < I_W1) { transpose_item(cmp_w1, 2048, 256, W1cT, nullptr, RmIdent(), scr, r, lane); continue; } r -= I_W1;
        if (r < I_W1) { transpose_item(cmp_w1 + (size_t)2048 * 256, 2048, 256, W1cT + (size_t)256 * 2048, nullptr, RmIdent(), scr, r, lane); continue; } r -= I_W1;
        { const int kv = r >= I_W2 ? 1 : 0; transpose_item(P.in[7] + (size_t)kv * 256 * 64, 256, 64, (bf16_t*)(ws + WS_SMALL + SM_W2T) + (size_t)kv * 64 * 256, nullptr, RmIdent(), scr, r - kv * I_W2, lane); }
    }
    for (int i = gw * 64 + lane; i < 8 * 16384; i += NGW * 64) { const int t = (i >> 7) & 127, sx = i & 127; ((bf16_t*)(ws + WS_SMALL + SM_SWB))[i] = (bf16_t)(sx <= t ? f2bf(P.in[10][i]) : 0u); }
    for (int p = gw; p < 256; p += NGW) {
        const int L = 64 * ((p >> 5) & 3) + 32 * (p >> 7) + (p & 31);
        if (L >= 48) { u32x4_t z = {0u, 0u, 0u, 0u}; u32x4_t* d = (u32x4_t*)(WinT + (size_t)(18 * 256 + p) * 2048);
#pragma unroll
            for (int j = 0; j < 4; ++j) d[lane + 64 * j] = z; }
    }
    bf16_t* XN = (bf16_t*)(ws + WS_XN);
    for (int m = gw; m < MTOK; m += 2 * NGW) {
        const int m2 = m + NGW;
        const f32x4_t* xr = (const f32x4_t*)(x + (size_t)m * D_MODEL) + lane;
        const f32x4_t* xr2 = (const f32x4_t*)(x + (size_t)(m2 < MTOK ? m2 : m) * D_MODEL) + lane;
        f32x4_t v[8], v2[8]; float s = 0.f, s2 = 0.f;
#pragma unroll
        for (int j = 0; j < 8; ++j) { v[j] = xr[64 * j]; v2[j] = xr2[64 * j]; }
#pragma unroll
        for (int j = 0; j < 8; ++j) { s += (v[j][0] * v[j][0] + v[j][1] * v[j][1]) + (v[j][2] * v[j][2] + v[j][3] * v[j][3]); s2 += (v2[j][0] * v2[j][0] + v2[j][1] * v2[j][1]) + (v2[j][2] * v2[j][2] + v2[j][3] * v2[j][3]); }
        const float ms1 = wave_sum(s) * (1.0f / D_MODEL) + 1e-6f, ms2 = wave_sum(s2) * (1.0f / D_MODEL) + 1e-6f;
        const float r = __builtin_amdgcn_rsqf(ms1), r2 = __builtin_amdgcn_rsqf(ms2);
        if (lane == 0) { float* rinv = (float*)(ws + WS_SMALL + SM_RINV); rinv[m] = ms1 * r; if (m2 < MTOK) rinv[m2] = ms2 * r2; }
        u32x2_t* o8 = (u32x2_t*)(XN + (size_t)m * D_MODEL) + lane; u32x2_t* o82 = (u32x2_t*)(XN + (size_t)m2 * D_MODEL) + lane;
#pragma unroll
        for (int j = 0; j < 8; ++j) { const f32x4_t w = ((const f32x4_t*)attn_norm_w)[lane + 64 * j];
            u32x2_t o; o.x = pk2(v[j][0] * r * w[0], v[j][1] * r * w[1]); o.y = pk2(v[j][2] * r * w[2], v[j][3] * r * w[3]); o8[64 * j] = o;
            if (m2 < MTOK) { u32x2_t q; q.x = pk2(v2[j][0] * r2 * w[0], v2[j][1] * r2 * w[1]); q.y = pk2(v2[j][2] * r2 * w[2], v2[j][3] * r2 * w[3]); o82[64 * j] = q; } }
    }
    for (int i = gw * 64 + lane; i < D_MODEL; i += NGW * 64) ((float*)(ws + WS_SMALL + SM_INVW))[i] = 1.0f / attn_norm_w[i];
    float* BIASP = (float*)(ws + WS_SMALL + SM_BIASP);
    for (int it = gw; it < 64; it += NGW) {
        const int kv = it >> 5, kc = it & 31; f32x4_t a = {0.f, 0.f, 0.f, 0.f};
        const float* pp = cmp_pos + kv * 2048 + kc * 64; const float* w1 = cmp_w1 + ((size_t)kv * 2048 + kc * 64) * 256;
        for (int k = 0; k < 64; ++k) { const f32x4_t w = ((const f32x4_t*)(w1 + (size_t)k * 256))[lane]; a += w * pp[k]; }
        ((f32x4_t*)(BIASP + (size_t)it * 256))[lane] = a;
    }
}

__device__ __forceinline__ void bias1_stage(unsigned char* ws, int idx  ) {
    const float* BIASP = (const float*)(ws + WS_SMALL + SM_BIASP); float* BIAS1 = (float*)(ws + WS_SMALL + SM_BIAS1);
    const int kv = idx >> 8, j = idx & 255; float s = 0.f;
    for (int kc = 0; kc < 32; ++kc) s += BIASP[(size_t)(kv * 32 + kc) * 256 + j];
    BIAS1[idx] = s;
}
__device__ __forceinline__ void cmp2_row(const Ptrs& P, int R, int lane) {
    unsigned char* ws = P.ws; const bf16_t* HC = (const bf16_t*)(ws + WS_HC);
    const int kv = R >> 12, rr = R & 4095, n = rr & 255;
    bf16_t* dst = (bf16_t*)(ws + (kv ? WS_VC : WS_KC)) + (size_t)rr * 64 + lane;
    if (n == 255) { *dst = 0; return; }
    const float* w2 = P.in[7] + (size_t)kv * 256 * 64;
    const u32x2_t hr = *(const u32x2_t*)(HC + (size_t)R * 256 + 4 * lane);
    float h[4] = {__uint_as_float(hr.x << 16), __uint_as_float(hr.x & 0xffff0000u), __uint_as_float(hr.y << 16), __uint_as_float(hr.y & 0xffff0000u)};
    float o = 0.f;
    for (int jj = 0; jj < 64; ++jj) {
#pragma unroll
        for (int i = 0; i < 4; ++i) o += __shfl(h[i], jj) * w2[(size_t)(4 * jj + i) * 64 + lane];
    }
    if (kv == 0) { const float ss = wave_sum(o * o); o *= __builtin_amdgcn_rsqf(ss * (1.0f / 64.0f) + 1e-6f) * P.in[4][lane]; }
    *dst = (bf16_t)f2bf(o);
}

__device__ __forceinline__ void gmlp_unit_v1(const Ptrs& P, LAS unsigned char* lds, int unit, const int wave_s) {
    unsigned char* ws = P.ws; const int tid = fresh_tid(wave_s);
    const int g = unit & 7, chunk = (unit >> 3) & 31, b = unit >> 8; const int m0 = b * SEQ + chunk * 128;
    LAS float* vn = (LAS float*)lds; LAS float* Wl = (LAS float*)(lds + 65536); LAS float* st = (LAS float*)(lds + 131072);
    const bf16_t* GV = (const bf16_t*)(ws + WS_GV); const bf16_t* U = (const bf16_t*)(ws + WS_U); const float* VSTAT = (const float*)(ws + WS_VSTAT);
    bf16_t* AB = (bf16_t*)(ws + WS_AB);
    const float* ln_w = P.in[8]; const float* ln_b = P.in[9]; const float* sw = P.in[10]; const float* sb = P.in[11];
    if (tid < 128) { const float* p = VSTAT + (size_t)(m0 + tid) * 32; float s1 = 0.f, s2 = 0.f;
#pragma unroll
        for (int i = 0; i < 16; ++i) { s1 += p[2 * i]; s2 += p[2 * i + 1]; }
        const float mean = s1 * (1.0f / 1024.0f); float var = s2 * (1.0f / 1024.0f) - mean * mean; var = var < 0.f ? 0.f : var;
        st[2 * tid] = mean; st[2 * tid + 1] = __builtin_amdgcn_rsqf(var + 1e-5f); }
    for (int i = 0; i < 32; ++i) { const int idx = tid + 512 * i, t = idx >> 7, s = idx & 127; Wl[idx] = (s <= t) ? sw[(size_t)g * 16384 + idx] : 0.f; }
    __syncthreads();
#pragma unroll
    for (int i = 0; i < 4; ++i) { const int idx = tid + 512 * i, s = idx >> 4, c8 = idx & 15;
        const u32x4_t raw = *(const u32x4_t*)(GV + (size_t)(m0 + s) * 1024 + g * 128 + 8 * c8); float f[8]; unpack8(raw, f);
        const float mean = st[2 * s], rstd = st[2 * s + 1];
#pragma unroll
        for (int e = 0; e < 8; ++e) { const int c = g * 128 + 8 * c8 + e; vn[s * 128 + 8 * c8 + e] = (f[e] - mean) * rstd * ln_w[c] + ln_b[c]; } }
    __syncthreads();
    const int c = tid & 127, tq = tid >> 7;
    for (int i = 0; i < 8; ++i) {
        const int t0 = 4 * (tq + 4 * i); float a0 = 0.f, a1 = 0.f, a2 = 0.f, a3 = 0.f;
        for (int s4 = 0; s4 <= t0; s4 += 4) {
            const f32x4_t w0 = *(const LAS f32x4_t*)(Wl + (t0 + 0) * 128 + s4), w1 = *(const LAS f32x4_t*)(Wl + (t0 + 1) * 128 + s4), w2 = *(const LAS f32x4_t*)(Wl + (t0 + 2) * 128 + s4), w3 = *(const LAS f32x4_t*)(Wl + (t0 + 3) * 128 + s4);
#pragma unroll
            for (int k = 0; k < 4; ++k) { const float v = vn[(s4 + k) * 128 + c]; a0 += w0[k] * v; a1 += w1[k] * v; a2 += w2[k] * v; a3 += w3[k] * v; }
        }
        const float av[4] = {a0, a1, a2, a3};
#pragma unroll
        for (int k = 0; k < 4; ++k) { const int t = t0 + k; const size_t row = (size_t)(m0 + t);
            const float uu = bf2f(U[row * 1024 + g * 128 + c]); AB[row * 2048 + 1024 + g * 128 + c] = (bf16_t)f2bf(uu * (av[k] + sb[g * 128 + t])); }
    }
    __syncthreads();
}

__device__ __forceinline__ void conv_item(const Ptrs& P, int b, int idx) {
    const int t = idx / 704, c8 = idx % 704, c0 = 8 * c8, j = c0 >> 7, i0 = c0 & 127;
    const bf16_t* HID = (const bf16_t*)(P.ws + WS_HID); const float* cw = P.in[15]; const float* cb = P.in[16];
    float gt[8], up[8];
#pragma unroll
    for (int e = 0; e < 8; ++e) { gt[e] = cb[c0 + e]; up[e] = cb[D_FF + c0 + e]; }
#pragma unroll
    for (int k = 0; k < 3; ++k) { const int tt = t - 2 + k; if (tt < 0) continue;
        float hg[8], hu[8]; unpack8(*(const u32x4_t*)(HID + (size_t)tt * N_UP + 256 * j + i0), hg); unpack8(*(const u32x4_t*)(HID + (size_t)tt * N_UP + 256 * j + 128 + i0), hu);
#pragma unroll
        for (int e = 0; e < 8; ++e) { gt[e] += cw[(size_t)k * N_UP + c0 + e] * hg[e]; up[e] += cw[(size_t)k * N_UP + D_FF + c0 + e] * hu[e]; } }
    float r[8];
#pragma unroll
    for (int e = 0; e < 8; ++e) r[e] = gt[e] * sigmoidf_(gt[e]) * up[e];
    u32x4_t o; o.x = pk2(r[0], r[1]); o.y = pk2(r[2], r[3]); o.z = pk2(r[4], r[5]); o.w = pk2(r[6], r[7]);
    *(u32x4_t*)((bf16_t*)(P.ws + WS_G) + ((size_t)b * SEQ + t) * D_FF + c0) = o;
}

constexpr int LW_CH = 32;
constexpr int LW_OUT = 32 * 64, LW_UP = 32 * 352, LW_DOWN = 88 * 64, LW_C_OUT = LW_OUT / LW_CH, LW_C_UP = LW_UP / LW_CH, LW_C_DOWN = LW_DOWN / LW_CH, LW_CHUNKS = LW_C_OUT + LW_C_UP + LW_C_DOWN;
static_assert(LW_OUT % LW_CH == 0 && LW_UP % LW_CH == 0 && LW_DOWN % LW_CH == 0, "late weight items per chunk");
template <class RowMap>
__device__ __forceinline__ void lw_load(float (&v)[32], const float* __restrict__ W, int N, int item, int lane) {
    const int nblk = N / 32, kb = item / nblk, nb = item % nblk;
    const float* p = W + (size_t)(64 * kb + (lane >> 5)) * N + 32 * nb + (lane & 31);
#pragma unroll
    for (int i = 0; i < 32; ++i) v[i] = p[(size_t)(2 * i) * N];
}
template <class RowMap>
__device__ __forceinline__ void lw_store(const float (&v)[32], int K, int N, bf16_t* WT, const float* __restrict__ kscale, RowMap rm, LAS float* scr, int item, int lane) {
    const int nblk = N / 32, kb = item / nblk, nb = item % nblk, k0 = 64 * kb, n0 = 32 * nb;
    const int c = lane & 7;
    f32x4_t sc0 = {1.f, 1.f, 1.f, 1.f}, sc1 = sc0;
    if (kscale) { sc0 = *(const f32x4_t*)(kscale + k0 + 8 * c); sc1 = *(const f32x4_t*)(kscale + k0 + 8 * c + 4); }
#pragma unroll
    for (int i = 0; i < 32; ++i) scr[(2 * i + (lane >> 5)) * 33 + (lane & 31)] = v[i];
    asm volatile("s_waitcnt lgkmcnt(0)" ::: "memory");
#pragma unroll
    for (int j = 0; j < 4; ++j) { const int nl = (lane >> 3) + 8 * j; const LAS float* s = scr + (8 * c) * 33 + nl;
        u32x4_t o; o.x = pk2(s[0 * 33] * sc0[0], s[1 * 33] * sc0[1]); o.y = pk2(s[2 * 33] * sc0[2], s[3 * 33] * sc0[3]); o.z = pk2(s[4 * 33] * sc1[0], s[5 * 33] * sc1[1]); o.w = pk2(s[6 * 33] * sc1[2], s[7 * 33] * sc1[3]);
        *(u32x4_t*)(WT + (size_t)rm(n0 + nl) * K + k0 + 8 * c) = o; }
    asm volatile("s_waitcnt lgkmcnt(0)" ::: "memory");
}
template <class RowMap>
__device__ __forceinline__ void lw_run(const float* __restrict__ W, int K, int N, bf16_t* WT, const float* __restrict__ kscale, RowMap rm, LAS float* scr, int item0, int wave, int lane) {
    float va[32], vb[32];
    lw_load<RowMap>(va, W, N, item0 + wave, lane);
    lw_load<RowMap>(vb, W, N, item0 + wave + 8, lane);  lw_store(va, K, N, WT, kscale, rm, scr, item0 + wave, lane);
    lw_load<RowMap>(va, W, N, item0 + wave + 16, lane); lw_store(vb, K, N, WT, kscale, rm, scr, item0 + wave + 8, lane);
    lw_load<RowMap>(vb, W, N, item0 + wave + 24, lane); lw_store(va, K, N, WT, kscale, rm, scr, item0 + wave + 16, lane);
    lw_store(vb, K, N, WT, kscale, rm, scr, item0 + wave + 24, lane);
}
__device__ __forceinline__ void late_weight_chunk(const Ptrs& P, LAS unsigned char* lds, int chunk, const int wave) {
    const int lane = fresh_lane();
    LAS float* scr = (LAS float*)(lds + wave * 16384);
    unsigned char* ws = P.ws;
    if (chunk < LW_C_UP) lw_run(P.in[14], 2048, N_UP, (bf16_t*)(ws + WS_WUP), P.in[13], RmWup(), scr, chunk * LW_CH, wave, lane);
    else if (chunk < LW_C_UP + LW_C_DOWN) lw_run(P.in[17], D_FF, 2048, (bf16_t*)(ws + WS_WDOWN), nullptr, RmIdent(), scr, (chunk - LW_C_UP) * LW_CH, wave, lane);
    else lw_run(P.in[12], 2048, 2048, (bf16_t*)(ws + WS_WOUT), nullptr, RmIdent(), scr, (chunk - LW_C_UP - LW_C_DOWN) * LW_CH, wave, lane);
}

namespace nsa {
using bf16x8 = __attribute__((ext_vector_type(8))) short;
using s16x4 = __attribute__((ext_vector_type(4))) short;
using f32x16 = __attribute__((ext_vector_type(16))) float;
typedef float f32x2_t __attribute__((ext_vector_type(2))); typedef __bf16 bf16x2_t __attribute__((ext_vector_type(2)));
constexpr int L_K = 0, L_V = 16384, L_WSF = 32768, L_OST = 34816, L_IMP = 100352, L_MASK = 116736, L_WU = 117248, L_END = 117312;
constexpr int SLOTB = 8192;
constexpr float THR = 8.0f;
#define NSA_SBAR() __builtin_amdgcn_sched_barrier(0)
__device__ __forceinline__ int crow(int r, int hi) { return (r & 3) + 8 * (r >> 2) + 4 * hi; }
__device__ __forceinline__ void glds16(const void* gbase  , unsigned voff  , unsigned lds_dst) { unsigned keep;
    asm volatile("s_mov_b32 %0, m0\n\ts_mov_b32 m0, %3\n\ts_nop 0\n\tglobal_load_lds_dwordx4 %1, %2\n\ts_mov_b32 m0, %0" : "=&s"(keep) : "v"(voff), "s"(gbase), "s"(lds_dst) : "memory"); }
__device__ __forceinline__ unsigned cvtpk_s(float lo, float hi) { f32x2_t v = {lo, hi}; bf16x2_t b = __builtin_convertvector(v, bf16x2_t); return __builtin_bit_cast(unsigned, b); }
#define NSA_WAIT_BAR() asm volatile("s_waitcnt vmcnt(0) lgkmcnt(0)\n\ts_barrier" ::: "memory")

__device__ __forceinline__ void qkt(f32x16& p0, f32x16& p1, LAS const char* Kslot, const bf16x8 (&qr)[4], int r32, int hi) {
    LAS const char* kb = Kslot + hi * 1024 + r32 * 16;
#pragma unroll
    for (int d0 = 0; d0 < 4; ++d0) {
        const bf16x8 b0 = *(LAS const bf16x8*)(kb + d0 * 2048);
        const bf16x8 b1 = *(LAS const bf16x8*)(kb + d0 * 2048 + 512);
        p0 = __builtin_amdgcn_mfma_f32_32x32x16_bf16(b0, qr[d0], p0, 0, 0, 0); p1 = __builtin_amdgcn_mfma_f32_32x32x16_bf16(b1, qr[d0], p1, 0, 0, 0);
    }
}
struct VFrag { s16x4 lo[2][4], hi[2][4]; };
__device__ __forceinline__ void vload(VFrag& f, int vb) {
#pragma unroll
    for (int d0 = 0; d0 < 2; ++d0)
#pragma unroll
        for (int ks = 0; ks < 4; ++ks) {
            asm volatile("ds_read_b64_tr_b16 %0,%1 offset:%c2" : "=&v"(f.lo[d0][ks]) : "v"(vb), "i"(d0 * 4096 + ks * 1024) : "memory");
            asm volatile("ds_read_b64_tr_b16 %0,%1 offset:%c2" : "=&v"(f.hi[d0][ks]) : "v"(vb), "i"(d0 * 4096 + ks * 1024 + 512) : "memory"); }
}
__device__ __forceinline__ void pvmma(f32x16 (&o)[2], VFrag& f, bf16x8 pa0, bf16x8 pa1, bf16x8 pa2, bf16x8 pa3) {
    asm volatile("s_waitcnt lgkmcnt(0)" : "+v"(f.lo[0][0]), "+v"(f.lo[0][1]), "+v"(f.lo[0][2]), "+v"(f.lo[0][3]), "+v"(f.hi[0][0]), "+v"(f.hi[0][1]), "+v"(f.hi[0][2]), "+v"(f.hi[0][3]) :: "memory");
    asm volatile("" : "+v"(f.lo[1][0]), "+v"(f.lo[1][1]), "+v"(f.lo[1][2]), "+v"(f.lo[1][3]), "+v"(f.hi[1][0]), "+v"(f.hi[1][1]), "+v"(f.hi[1][2]), "+v"(f.hi[1][3]));
    NSA_SBAR();
#pragma unroll
    for (int d0 = 0; d0 < 2; ++d0) {
#define NSA_PK(k) (bf16x8){f.lo[d0][k][0], f.lo[d0][k][1], f.lo[d0][k][2], f.lo[d0][k][3], f.hi[d0][k][0], f.hi[d0][k][1], f.hi[d0][k][2], f.hi[d0][k][3]}
        o[d0] = __builtin_amdgcn_mfma_f32_32x32x16_bf16(pa0, NSA_PK(0), o[d0], 0, 0, 0);
        o[d0] = __builtin_amdgcn_mfma_f32_32x32x16_bf16(pa1, NSA_PK(1), o[d0], 0, 0, 0);
        o[d0] = __builtin_amdgcn_mfma_f32_32x32x16_bf16(pa2, NSA_PK(2), o[d0], 0, 0, 0);
        o[d0] = __builtin_amdgcn_mfma_f32_32x32x16_bf16(pa3, NSA_PK(3), o[d0], 0, 0, 0);
#undef NSA_PK
    }
}
__device__ __forceinline__ void pv(f32x16 (&o)[2], int vb, bf16x8 pa0, bf16x8 pa1, bf16x8 pa2, bf16x8 pa3) { VFrag f; vload(f, vb); pvmma(o, f, pa0, pa1, pa2, pa3); }
__device__ __forceinline__ float rowmax32(const f32x16& p0, const f32x16& p1) {
    float a = __builtin_fmaxf(p0[0], p1[0]);
#pragma unroll
    for (int r = 1; r < 16; ++r) a = __builtin_fmaxf(a, __builtin_fmaxf(p0[r], p1[r]));
    auto rr = __builtin_amdgcn_permlane32_swap(__float_as_uint(a), __float_as_uint(a), false, false);
    return __builtin_fmaxf(__uint_as_float(rr[0]), __uint_as_float(rr[1]));
}
struct State { float m, l; f32x16 o[2]; };
__device__ __forceinline__ void state_init(State& s) { s.m = -1e30f; s.l = 0.f; s.o[0] = f32x16{}; s.o[1] = f32x16{}; }

template <int BMUL, int MASK, bool LOADV>
__device__ __forceinline__ void tile_scores(f32x16& p0, f32x16& p1, LAS const char* Kslot, const bf16x8 (&qr)[4], const f32x16& bk, float c0, float b32, int lim, int r32, int hi, VFrag& vf, int vb) {
#pragma unroll
    for (int r = 0; r < 16; ++r) { const float b = (BMUL == 1) ? bk[r] + c0 : __builtin_fmaf(bk[r], (float)BMUL, c0); p0[r] = b; p1[r] = b + b32; }
    qkt(p0, p1, Kslot, qr, r32, hi);
    if (LOADV) vload(vf, vb);
    const int limh = lim - 4 * hi;
#pragma unroll
    for (int r = 0; r < 16; ++r) {
        const int kk = (r & 3) + 8 * (r >> 2);
        if (MASK == 1) { if (!(kk <= limh)) p0[r] = -INFINITY; if (!(kk + 32 <= limh)) p1[r] = -INFINITY; }
        if (MASK == 2) { if (!(kk > limh)) p0[r] = -INFINITY; if (!(kk + 32 > limh)) p1[r] = -INFINITY; }
        if (MASK == 3) { if (!(kk < limh)) p0[r] = -INFINITY; if (!(kk + 32 < limh)) p1[r] = -INFINITY; }
    }
}
__device__ __forceinline__ float tile_ref(const State& st, float rb0, bool rowlive) { return (st.m < -1e29f && rowlive) ? rb0 : st.m; }
__device__ __forceinline__ void tile_softmax_pv(State& st, f32x16& p0, f32x16& p1, float mref, VFrag& vf, LAS float* wsf, int r32, int hi) {
    float a0 = p0[0], a1 = p1[0];
#pragma unroll
    for (int r = 1; r < 16; ++r) { a0 = __builtin_fmaxf(a0, p0[r]); a1 = __builtin_fmaxf(a1, p1[r]); }
    float mx = __builtin_fmaxf(a0, a1);
    { auto rr = __builtin_amdgcn_permlane32_swap(__float_as_uint(mx), __float_as_uint(mx), false, false); mx = __builtin_fmaxf(__uint_as_float(rr[0]), __uint_as_float(rr[1])); }
    if (__any(mx > THR)) {
        const float dl = __builtin_fmaxf(mx, 0.f), alpha = __builtin_amdgcn_exp2f(-dl);
        mref += dl; st.l *= alpha;
        if (hi == 0) wsf[r32] = alpha;
        asm volatile("s_waitcnt lgkmcnt(0)" ::: "memory");
#pragma unroll
        for (int r = 0; r < 16; ++r) { const float a = wsf[crow(r, hi)]; st.o[0][r] *= a; st.o[1][r] *= a; p0[r] -= dl; p1[r] -= dl; }
    }
    st.m = mref;
    float ls = 0.f;
#pragma unroll
    for (int r = 0; r < 16; ++r) { p0[r] = __builtin_amdgcn_exp2f(p0[r]); p1[r] = __builtin_amdgcn_exp2f(p1[r]); ls += p0[r] + p1[r]; }
    st.l += ls;
    u32x4_t pw0, pw1, pw2, pw3;
    pw0 = (u32x4_t){cvtpk_s(p0[0], p0[1]), cvtpk_s(p0[2], p0[3]), cvtpk_s(p0[4], p0[5]), cvtpk_s(p0[6], p0[7])};
    pw1 = (u32x4_t){cvtpk_s(p0[8], p0[9]), cvtpk_s(p0[10], p0[11]), cvtpk_s(p0[12], p0[13]), cvtpk_s(p0[14], p0[15])};
    pw2 = (u32x4_t){cvtpk_s(p1[0], p1[1]), cvtpk_s(p1[2], p1[3]), cvtpk_s(p1[4], p1[5]), cvtpk_s(p1[6], p1[7])};
    pw3 = (u32x4_t){cvtpk_s(p1[8], p1[9]), cvtpk_s(p1[10], p1[11]), cvtpk_s(p1[12], p1[13]), cvtpk_s(p1[14], p1[15])};
    pvmma(st.o, vf, __builtin_bit_cast(bf16x8, pw0), __builtin_bit_cast(bf16x8, pw1), __builtin_bit_cast(bf16x8, pw2), __builtin_bit_cast(bf16x8, pw3));
}
template <bool FIRST>
__device__ __forceinline__ void fold_branch(LAS float* ostg, State& st, float gate, LAS float* wsf, int r32, int hi) {
    float l = st.l;
    { auto rr = __builtin_amdgcn_permlane32_swap(__float_as_uint(l), __float_as_uint(l), false, false); l = __uint_as_float(rr[0]) + __uint_as_float(rr[1]); }
    const float f = l > 0.f ? gate / l : 0.f;
    asm volatile("s_waitcnt lgkmcnt(0)" ::: "memory");
    if (hi == 0) wsf[r32] = f;
    asm volatile("s_waitcnt lgkmcnt(0)" ::: "memory");
#pragma unroll
    for (int r = 0; r < 16; ++r) { const int orow = crow(r, hi); const float a = wsf[orow];
#pragma unroll
        for (int d0 = 0; d0 < 2; ++d0) { LAS float* p = ostg + orow * 64 + d0 * 32 + r32; if (FIRST) *p = st.o[d0][r] * a; else *p += st.o[d0][r] * a; } }
    asm volatile("s_waitcnt lgkmcnt(0)" ::: "memory");
}

__device__ __forceinline__ int nsa_unit(const Ptrs& P, LAS unsigned char* lds, int bg, int qt, const int wave_s, unsigned* qctr, int qbase) {
    unsigned char* ws = P.ws;
    const int lane = fresh_lane(), r32 = lane & 31, hi = lane >> 5; const int wid = wave_s;
    const int b = bg >> 2, g = bg & 3, t0 = 64 * qt;
    const int tl = 8 * wid + (r32 >> 2), hq = r32 & 3;
    const size_t m0 = (size_t)b * SEQ + t0;
    const bf16_t* Q = (const bf16_t*)(ws + WS_Q); const bf16_t* KV6 = (const bf16_t*)(ws + WS_KV6);
    const bf16_t* KSb = KV6 + 2 * KVSZ + (size_t)bg * SEQ * 64; const bf16_t* VSb = KV6 + 3 * KVSZ + (size_t)bg * SEQ * 64;
    const bf16_t* KWb = KV6 + 4 * KVSZ + (size_t)bg * SEQ * 64; const bf16_t* VWb = KV6 + 5 * KVSZ + (size_t)bg * SEQ * 64;
    const bf16_t* KCb = (const bf16_t*)(ws + WS_KC) + (size_t)bg * 256 * 64; const bf16_t* VCb = (const bf16_t*)(ws + WS_VC) + (size_t)bg * 256 * 64;
    const float* GATES = (const float*)(ws + WS_GATES); bf16_t* AB = (bf16_t*)(ws + WS_AB);
    const unsigned lds0 = (unsigned)(uintptr_t)lds;
    LAS float* wsf = (LAS float*)(lds + L_WSF) + wid * 64;
    LAS float* IMP = (LAS float*)(lds + L_IMP);
    LAS unsigned* MASK = (LAS unsigned*)(lds + L_MASK); LAS unsigned* WU = (LAS unsigned*)(lds + L_WU);
    const int koff = lane * 64 + wid * 8, voff = (16 * (wid & 3) + (lane >> 2)) * 64 + (wid >> 2) * 32 + (lane & 3) * 8;
    const unsigned kdst = lds0 + L_K + wid * 1024, vdst = lds0 + L_V + wid * 1024;
#define NSA_DMA_K(base, tile, slot) glds16((base) + (size_t)(tile) * 4096, (unsigned)koff * 2u, (unsigned)__builtin_amdgcn_readfirstlane(kdst + (slot) * SLOTB))
#define NSA_DMA_V(base, tile, slot) glds16((base) + (size_t)(tile) * 4096, (unsigned)voff * 2u, (unsigned)__builtin_amdgcn_readfirstlane(vdst + (slot) * SLOTB))
    const int vb0 = (int)(lds0 + L_V) + ((lane >> 4) & 1) * 32 + (lane & 3) * 8 + (4 * hi + ((lane & 15) >> 2)) * 64;
    LAS const char* Kbase = (LAS const char*)(lds + L_K);
    bf16x8 qr[4];
    { const bf16_t* qp = Q + (m0 + tl) * 1024 + (4 * g + hq) * 64 + hi * 8;
#pragma unroll
      for (int d0 = 0; d0 < 4; ++d0) qr[d0] = *(const bf16x8*)(qp + d0 * 16); }
    const float sl2 = __builtin_amdgcn_exp2f(-0.5f * (float)(4 * g + hq + 1)) * LOG2E;
    f32x16 bk;
#pragma unroll
    for (int r = 0; r < 16; ++r) bk[r] = sl2 * (float)((r & 3) + 8 * (r >> 2));
    const float b32t = 32.0f * sl2, b32c = 512.0f * sl2, hoff_t = 4.0f * (float)hi * sl2, hoff_c = 64.0f * (float)hi * sl2;
    float gate[3];
    { const float* gp = GATES + (m0 + tl) * 48 + (4 * g + hq) * 3; gate[0] = gp[0]; gate[1] = gp[1]; gate[2] = gp[2]; }
    LAS float* ostg = (LAS float*)(lds + L_OST) + wid * 2048;
    State st;
    f32x16 p0, p1;
    int nxt_ticket = 0;

    int tc = 0;
    VFrag vf;
    const int nvmax = (t0 + 63 >= 31) ? ((t0 + 63 - 31) >> 4) + 1 : 0;
    const int nct = (nvmax + 63) >> 6;
    const int tq = t0 + tl, nv = tq >= 31 ? ((tq - 31) >> 4) + 1 : 0;
    {
        state_init(st);
        const int j0 = qt >= 8 ? qt - 8 : 0, nt = qt - j0 + 1;
        NSA_DMA_K(KWb, qt, 0); NSA_DMA_V(VWb, qt, 0); NSA_WAIT_BAR();
        for (int i = 0; i < nt; ++i) {
            const int j = qt - i, slot = (tc + i) & 1;
            if (i + 1 < nt) { NSA_DMA_K(KWb, j - 1, slot ^ 1); NSA_DMA_V(VWb, j - 1, slot ^ 1); }
            else { NSA_DMA_K(KCb, nct - 1, slot ^ 1); NSA_DMA_V(VCb, nct - 1, slot ^ 1); }
            const float rb0 = sl2 * (float)(64 * j - t0), mref = tile_ref(st, rb0, true), c0 = rb0 + hoff_t - mref;
            if (j == qt) tile_scores<1, 1, true>(p0, p1, Kbase + slot * SLOTB, qr, bk, c0, b32t, tl, r32, hi, vf, vb0 + slot * SLOTB);
            else if (j == qt - 8) tile_scores<1, 2, true>(p0, p1, Kbase + slot * SLOTB, qr, bk, c0, b32t, tl, r32, hi, vf, vb0 + slot * SLOTB);
            else tile_scores<1, 0, true>(p0, p1, Kbase + slot * SLOTB, qr, bk, c0, b32t, 0, r32, hi, vf, vb0 + slot * SLOTB);
            tile_softmax_pv(st, p0, p1, mref, vf, wsf, r32, hi);
            NSA_WAIT_BAR();
        }
        tc += nt;
        fold_branch<true>(ostg, st, gate[2], wsf, r32, hi);
    }
    {
        state_init(st);
        for (int ci = 0; ci < nct; ++ci) {
            const int c = nct - 1 - ci, slot = (tc + ci) & 1;
            if (ci + 1 < nct) { NSA_DMA_K(KCb, c - 1, slot ^ 1); NSA_DMA_V(VCb, c - 1, slot ^ 1); }
            else if (qt >= 16) { NSA_DMA_K(KCb, 0, slot ^ 1); }
            else { NSA_DMA_K(KSb, qt, slot ^ 1); NSA_DMA_V(VSb, qt, slot ^ 1); }
            const float rb0 = sl2 * ((float)(1024 * c - t0) + 15.5f), mref = tile_ref(st, rb0, true), c0 = rb0 + hoff_c - mref;
            tile_scores<16, 3, true>(p0, p1, Kbase + slot * SLOTB, qr, bk, c0, b32c, nv - 64 * c, r32, hi, vf, vb0 + slot * SLOTB);
            tile_softmax_pv(st, p0, p1, mref, vf, wsf, r32, hi);
            NSA_WAIT_BAR();
        }
        tc += nct;
    }
    const float mc_fin = st.m; float lc = st.l;
    fold_branch<false>(ostg, st, gate[0], wsf, r32, hi);
    if (qt >= 16) {
        { auto rr = __builtin_amdgcn_permlane32_swap(__float_as_uint(lc), __float_as_uint(lc), false, false); lc = __uint_as_float(rr[0]) + __uint_as_float(rr[1]); }
        const float invl = lc > 0.f ? 1.0f / lc : 0.f;
        float carry = 0.f;
        for (int c = 0; c < nct; ++c) {
            const int slot = (tc + c) & 1;
            if (c + 1 < nct) { NSA_DMA_K(KCb, c + 1, slot ^ 1); }
            else { NSA_DMA_K(KSb, qt, slot ^ 1); NSA_DMA_V(VSb, qt, slot ^ 1); }
            const float c0 = sl2 * ((float)(1024 * c - t0) + 15.5f) + hoff_c - mc_fin;
            tile_scores<16, 3, false>(p0, p1, Kbase + slot * SLOTB, qr, bk, c0, b32c, nv - 64 * c, r32, hi, vf, 0);
#pragma unroll
            for (int r = 0; r < 16; ++r) { p0[r] = __builtin_amdgcn_exp2f(p0[r]) * invl; p1[r] = __builtin_amdgcn_exp2f(p1[r]) * invl; }
            float imp0[4], imp1[4], pl0[4], pl1[4];
#pragma unroll
            for (int a = 0; a < 4; ++a) {
                imp0[a] = (p0[4 * a] + p0[4 * a + 1]) + (p0[4 * a + 2] + p0[4 * a + 3]); imp1[a] = (p1[4 * a] + p1[4 * a + 1]) + (p1[4 * a + 2] + p1[4 * a + 3]);
                pl0[a] = __shfl_xor(p0[4 * a + 3], 32); pl1[a] = __shfl_xor(p1[4 * a + 3], 32);
            }
            if (hi) {
#pragma unroll
                for (int a = 0; a < 4; ++a) { imp0[a] += pl0[a]; imp1[a] += pl1[a]; }
            } else {
                imp0[0] += carry; imp1[0] += pl0[3];
#pragma unroll
                for (int a = 1; a < 4; ++a) { imp0[a] += pl0[a - 1]; imp1[a] += pl1[a - 1]; }
            }
            carry = pl1[3];
#pragma unroll
            for (int a = 0; a < 4; ++a) {
                imp0[a] += __shfl_xor(imp0[a], 1); imp0[a] += __shfl_xor(imp0[a], 2); imp1[a] += __shfl_xor(imp1[a], 1); imp1[a] += __shfl_xor(imp1[a], 2);
                if (hq == 0) { IMP[tl * 64 + 16 * c + 2 * a + hi] = imp0[a]; IMP[tl * 64 + 16 * c + 8 + 2 * a + hi] = imp1[a]; }
            }
            NSA_WAIT_BAR();
        }
        tc += nct;
    }
    unsigned long long wu = 0ull;
    if (qt < 16) {
        wu = (2ull << qt) - 1ull;
        if (lane < 8) { MASK[2 * (8 * wid + lane)] = (unsigned)wu; MASK[2 * (8 * wid + lane) + 1] = (unsigned)(wu >> 32); }
    } else {
        const int j = lane; const bool valid = j <= qt, forced = (j == 0) || (j == qt) || (j == qt - 1);
        for (int k = 0; k < 8; ++k) {
            const float imp = IMP[(8 * wid + k) * 64 + j];
            const float scv = valid ? (forced ? 1e9f : imp) : -1e9f;
            const unsigned fb = __float_as_uint(scv), key = fb ^ ((fb >> 31) ? 0xffffffffu : 0x80000000u);
            unsigned T = 0u;
#pragma unroll
            for (int bit = 31; bit >= 0; --bit) { const unsigned cand = T | (1u << bit); if (__builtin_popcountll(__ballot(key >= cand)) >= 16) T = cand; }
            const unsigned long long gt = __ballot(key > T), eq = __ballot(key == T);
            const int need = 16 - __builtin_popcountll(gt);
            const int before = (int)__builtin_amdgcn_mbcnt_hi((unsigned)(eq >> 32), __builtin_amdgcn_mbcnt_lo((unsigned)eq, 0u));
            const bool sel = (key > T) || ((key == T) && (before < need));
            const unsigned long long mk = __ballot(sel && (scv > -0.5e9f));
            wu |= mk;
            if (lane == 0) { MASK[2 * (8 * wid + k)] = (unsigned)mk; MASK[2 * (8 * wid + k) + 1] = (unsigned)(mk >> 32); }
        }
    }
    if (lane == 0) { WU[2 * wid] = (unsigned)wu; WU[2 * wid + 1] = (unsigned)(wu >> 32); }
    NSA_WAIT_BAR();
    unsigned long long uni = 0ull;
#pragma unroll
    for (int w = 0; w < 8; ++w) uni |= ((unsigned long long)WU[2 * w]) | (((unsigned long long)WU[2 * w + 1]) << 32);
    uni = ((unsigned long long)(unsigned)__builtin_amdgcn_readfirstlane((unsigned)uni)) | (((unsigned long long)(unsigned)__builtin_amdgcn_readfirstlane((unsigned)(uni >> 32))) << 32);
    const unsigned long long mymask = ((unsigned long long)MASK[2 * tl]) | (((unsigned long long)MASK[2 * tl + 1]) << 32);
    {
        state_init(st);
        unsigned long long rem = uni;
        int j = 63 - __builtin_clzll(rem); rem &= ~(1ull << j);
        for (int i = 0;; ++i) {
            const int slot = (tc + i) & 1; const bool more = rem != 0ull;
            int jn = 0;
            if (more) { jn = 63 - __builtin_clzll(rem); rem &= ~(1ull << jn); NSA_DMA_K(KSb, jn, slot ^ 1); NSA_DMA_V(VSb, jn, slot ^ 1); }
            if ((wu >> j) & 1ull) {
                const bool live = ((mymask >> j) & 1ull) != 0ull;
                const float rb0 = sl2 * (float)(64 * j - t0), mref = tile_ref(st, rb0, live), c0 = live ? rb0 + hoff_t - mref : -INFINITY;
                if (j == qt) tile_scores<1, 1, true>(p0, p1, Kbase + slot * SLOTB, qr, bk, c0, b32t, tl, r32, hi, vf, vb0 + slot * SLOTB);
                else tile_scores<1, 0, true>(p0, p1, Kbase + slot * SLOTB, qr, bk, c0, b32t, 0, r32, hi, vf, vb0 + slot * SLOTB);
                tile_softmax_pv(st, p0, p1, mref, vf, wsf, r32, hi);
            }
            NSA_WAIT_BAR();
            if (!more) break;
            j = jn;
        }
        if (wid == 0 && lane == 0) nxt_ticket = qbase + (int)__hip_atomic_fetch_add(qctr, 1u, __ATOMIC_RELAXED, __HIP_MEMORY_SCOPE_AGENT);
        fold_branch<false>(ostg, st, gate[1], wsf, r32, hi);
    }
    {
#pragma unroll
        for (int i = 0; i < 4; ++i) { const int row = i * 8 + (lane >> 3), ch = lane & 7;
            const f32x4_t v0 = *(LAS const f32x4_t*)(ostg + row * 64 + ch * 8), v1 = *(LAS const f32x4_t*)(ostg + row * 64 + ch * 8 + 4);
            u32x4_t v; v.x = cvtpk_s(v0[0], v0[1]); v.y = cvtpk_s(v0[2], v0[3]); v.z = cvtpk_s(v1[0], v1[1]); v.w = cvtpk_s(v1[2], v1[3]);
            *(u32x4_t*)(AB + (m0 + 8 * wid + (row >> 2)) * 2048 + 256 * g + (row & 3) * 64 + ch * 8) = v; }
    }
    NSA_WAIT_BAR();
#undef NSA_DMA_K
#undef NSA_DMA_V
    return nxt_ticket;
}
constexpr int L_QS = 145416;
__device__ __forceinline__ void nsa_phase(const Ptrs& P, LAS unsigned char* lds, int bid, int G, const int wave_s) {
    unsigned* qctr = (unsigned*)(P.ws + WS_CTL) + 3584;
    LAS int* qs = (LAS int*)(lds + L_QS);
    const int nrest = 1024 - G + LW_CHUNKS;
    int k = bid;
    while (k < 1024 + LW_CHUNKS) {
        int nxt, unit = k, chunk = -1;
        if (k >= G) { const int t = k - G, cb = (t * LW_CHUNKS) / nrest, ca = ((t + 1) * LW_CHUNKS) / nrest;
            if (ca > cb) chunk = cb; else unit = G + t - cb; }
        if (chunk < 0) {
            const int qt = 63 - (unit >> 4), g = 3 - ((unit >> 2) & 3), b = unit & 3;
            nxt = nsa_unit(P, lds, b * 4 + g, qt, wave_s, qctr, G);
        } else {
            nxt = 0;
            if (wave_s == 0 && fresh_lane() == 0) nxt = G + (int)__hip_atomic_fetch_add(qctr, 1u, __ATOMIC_RELAXED, __HIP_MEMORY_SCOPE_AGENT);
            late_weight_chunk(P, lds, chunk, wave_s);
        }
        if (wave_s == 0 && fresh_lane() == 0) *qs = nxt;
        NSA_WAIT_BAR();
        k = __builtin_amdgcn_readfirstlane(*qs);
    }
}
}

namespace p2 {
using nsa::bf16x8; using nsa::f32x16; using nsa::s16x4; using nsa::crow; using nsa::glds16; using nsa::cvtpk_s;
#define P2_WAIT_BAR() asm volatile("s_waitcnt vmcnt(0) lgkmcnt(0)\n\ts_barrier" ::: "memory")
constexpr int CB_BUF = 40960;
constexpr int CP_STRIDE = 65;
__device__ __forceinline__ void compress_unit(const Ptrs& P, LAS unsigned char* lds, int u, const int wave_s) {
    unsigned char* ws = P.ws;
    const int lane = fresh_lane(), r32 = lane & 31, hi = lane >> 5, wid = wave_s;
    const int kv = u >> 6, bg = (u >> 2) & 15, n0 = 64 * (u & 3);
    const bf16_t* Ag = (const bf16_t*)(ws + WS_KV6) + (size_t)kv * KVSZ + (size_t)bg * SEQ * 64 + (size_t)n0 * 1024;
    const bf16_t* Bg = (const bf16_t*)(ws + WS_W1C) + (size_t)kv * 256 * 2048;
    const unsigned lds0 = (unsigned)(uintptr_t)lds;
    const int drow = 8 * wid + (lane >> 3), dchk = (lane & 7) ^ ((drow >> 1) & 7);
    const unsigned aoff = (unsigned)(drow * 1024 + dchk * 8) * 2u, boff = (unsigned)(drow * 2048 + dchk * 8) * 2u;
    const unsigned dstw = lds0 + wid * 1024;
#define P2_DMA_TILE(kt, buf) do { const unsigned d_ = (unsigned)__builtin_amdgcn_readfirstlane(dstw + (buf) * CB_BUF); \
        glds16(Ag + (kt) * 64, aoff, d_); \
        _Pragma("unroll") for (int ct_ = 0; ct_ < 4; ++ct_) glds16(Bg + (size_t)ct_ * 64 * 2048 + (kt) * 64, boff, d_ + 8192u * (ct_ + 1)); } while (0)
    const int ct = wid >> 1, half = wid & 1, ncol0 = 64 * ct + 32 * half;
    f32x16 hT[2]; hT[0] = f32x16{}; hT[1] = f32x16{};
    P2_DMA_TILE(0, 0); P2_DMA_TILE(1, 1);
    asm volatile("s_waitcnt vmcnt(5) lgkmcnt(0)\n\ts_barrier" ::: "memory");
    for (int kt = 0; kt < 32; ++kt) {
        const int buf = kt % 3;
        if (kt + 2 < 32) P2_DMA_TILE(kt + 2, (kt + 2) % 3);
        LAS const char* sa = (LAS const char*)(lds + buf * CB_BUF) + r32 * 128;
        LAS const char* sb = (LAS const char*)(lds + buf * CB_BUF + 8192 * (ct + 1)) + (32 * half + r32) * 128;
        const int sw = (r32 >> 1) & 7;
#pragma unroll
        for (int d0 = 0; d0 < 4; ++d0) {
            const int co = ((2 * d0 + hi) ^ sw) * 16;
            const bf16x8 bf = *(LAS const bf16x8*)(sb + co), a0 = *(LAS const bf16x8*)(sa + co), a1 = *(LAS const bf16x8*)(sa + 4096 + co);
            hT[0] = __builtin_amdgcn_mfma_f32_32x32x16_bf16(bf, a0, hT[0], 0, 0, 0);
            hT[1] = __builtin_amdgcn_mfma_f32_32x32x16_bf16(bf, a1, hT[1], 0, 0, 0);
        }
        if (kt + 2 < 32) asm volatile("s_waitcnt vmcnt(5) lgkmcnt(0)\n\ts_barrier" ::: "memory");
        else asm volatile("s_waitcnt vmcnt(0) lgkmcnt(0)\n\ts_barrier" ::: "memory");
    }
    const float* bias1 = (const float*)(ws + WS_SMALL + SM_BIAS1) + kv * 256 + ncol0;
    bf16x8 hb[2][2];
#pragma unroll
    for (int mt = 0; mt < 2; ++mt) {
        float g[16];
#pragma unroll
        for (int r = 0; r < 16; ++r) g[r] = gelu_tanh(hT[mt][r] + bias1[crow(r, hi)]);
#pragma unroll
        for (int s = 0; s < 2; ++s) { u32x4_t w; w.x = cvtpk_s(g[8 * s], g[8 * s + 1]); w.y = cvtpk_s(g[8 * s + 2], g[8 * s + 3]); w.z = cvtpk_s(g[8 * s + 4], g[8 * s + 5]); w.w = cvtpk_s(g[8 * s + 6], g[8 * s + 7]);
            hb[mt][s] = __builtin_bit_cast(bf16x8, w); }
    }
    const bf16_t* w2t = (const bf16_t*)(ws + WS_SMALL + SM_W2T) + (size_t)kv * 64 * 256;
    f32x16 oT[2][2];
#pragma unroll
    for (int dt = 0; dt < 2; ++dt)
#pragma unroll
        for (int mt = 0; mt < 2; ++mt) oT[dt][mt] = f32x16{};
#pragma unroll
    for (int dt = 0; dt < 2; ++dt)
#pragma unroll
        for (int s = 0; s < 2; ++s) {
            const bf16_t* wp = w2t + (size_t)(32 * dt + r32) * 256 + ncol0 + 16 * s + 4 * hi;
            const u32x2_t lo = *(const u32x2_t*)wp, hi2 = *(const u32x2_t*)(wp + 8);
            const u32x4_t wv = {lo.x, lo.y, hi2.x, hi2.y}; const bf16x8 wf = __builtin_bit_cast(bf16x8, wv);
#pragma unroll
            for (int mt = 0; mt < 2; ++mt) oT[dt][mt] = __builtin_amdgcn_mfma_f32_32x32x16_bf16(wf, hb[mt][s], oT[dt][mt], 0, 0, 0);
        }
    LAS float* part = (LAS float*)lds + wid * 64 * CP_STRIDE;
#pragma unroll
    for (int dt = 0; dt < 2; ++dt)
#pragma unroll
        for (int mt = 0; mt < 2; ++mt)
#pragma unroll
            for (int r = 0; r < 16; ++r) part[(32 * mt + r32) * CP_STRIDE + 32 * dt + crow(r, hi)] = oT[dt][mt][r];
    P2_WAIT_BAR();
    {
        const int tid = wid * 64 + lane, m = tid >> 3, dg = tid & 7;
        float o[8];
#pragma unroll
        for (int e = 0; e < 8; ++e) { float s = 0.f;
#pragma unroll
            for (int w = 0; w < 8; ++w) s += ((LAS const float*)lds)[(w * 64 + m) * CP_STRIDE + 8 * dg + e];
            o[e] = s; }
        if (kv == 0) {
            float ss = 0.f;
#pragma unroll
            for (int e = 0; e < 8; ++e) ss += o[e] * o[e];
            ss += __shfl_xor(ss, 1); ss += __shfl_xor(ss, 2); ss += __shfl_xor(ss, 4);
            const float rr = __builtin_amdgcn_rsqf(ss * (1.0f / 64.0f) + 1e-6f);
#pragma unroll
            for (int e = 0; e < 8; ++e) o[e] *= rr * P.in[4][8 * dg + e];
        }
        const int n = n0 + m;
        u32x4_t v = {0u, 0u, 0u, 0u};
        if (n < 255) { v.x = cvtpk_s(o[0], o[1]); v.y = cvtpk_s(o[2], o[3]); v.z = cvtpk_s(o[4], o[5]); v.w = cvtpk_s(o[6], o[7]); }
        *(u32x4_t*)((bf16_t*)(ws + (kv ? WS_VC : WS_KC)) + ((size_t)bg * 256 + n) * 64 + 8 * dg) = v;
    }
    P2_WAIT_BAR();
#undef P2_DMA_TILE
}

constexpr int G_V = 0, G_ST = 32768, G_OST = 33792, G_END = 33792 + 65536;
struct GmlpIn { u32x4_t raw[4]; u32x4_t uraw[4]; float sbv[4]; };
__device__ __forceinline__ void gmlp_load(GmlpIn& in, const Ptrs& P, int unit, int tid, int lane, int r32, int hi, int wid) {
    unsigned char* ws = P.ws;
    const int g = unit & 7, chunk = (unit >> 3) & 31, b = unit >> 8; const int m0 = b * SEQ + chunk * 128;
    const bf16_t* GV = (const bf16_t*)(ws + WS_GV); const bf16_t* U = (const bf16_t*)(ws + WS_U);
    const int tb = wid >> 1, ch = wid & 1; (void)r32; (void)hi;
#pragma unroll
    for (int i = 0; i < 4; ++i) { const int idx = tid + 512 * i, s = idx >> 4, c8 = idx & 15; in.raw[i] = *(const u32x4_t*)(GV + (size_t)(m0 + s) * 1024 + g * 128 + 8 * c8); }
#pragma unroll
    for (int i = 0; i < 4; ++i) { const int row = i * 8 + (lane >> 3), t = 32 * tb + row; in.uraw[i] = *(const u32x4_t*)(U + (size_t)(m0 + t) * 1024 + g * 128 + 64 * ch + 8 * (lane & 7)); in.sbv[i] = P.in[11][g * 128 + t]; }
}
__device__ __forceinline__ void gmlp_compute(const GmlpIn& in, const f32x4_t (&sv)[8], const bf16x8 (&pa)[2][4], const f32x4_t w0, const f32x4_t w1, const f32x4_t b0, const f32x4_t b1, const Ptrs& P, LAS unsigned char* lds, int unit, int tid, int lane, int r32, int hi, int wid) {
    unsigned char* ws = P.ws;
    const int g = unit & 7, chunk = (unit >> 3) & 31, b = unit >> 8; const int m0 = b * SEQ + chunk * 128;
    bf16_t* AB = (bf16_t*)(ws + WS_AB);
    LAS float* st = (LAS float*)(lds + G_ST);
    const int tb = wid >> 1, ch = wid & 1;
    if (tid < 128) { float s1 = 0.f, s2 = 0.f;
#pragma unroll
        for (int i = 0; i < 8; ++i) { s1 += sv[i][0] + sv[i][2]; s2 += sv[i][1] + sv[i][3]; }
        const float mean = s1 * (1.0f / 1024.0f); float var = s2 * (1.0f / 1024.0f) - mean * mean; var = var < 0.f ? 0.f : var;
        st[2 * tid] = mean; st[2 * tid + 1] = __builtin_amdgcn_rsqf(var + 1e-5f); }
    asm volatile("s_waitcnt lgkmcnt(0)\n\ts_barrier" ::: "memory");
#pragma unroll
    for (int i = 0; i < 4; ++i) { const int idx = tid + 512 * i, s = idx >> 4, c8 = idx & 15;
        float f[8]; unpack8(in.raw[i], f);
        const float mean = st[2 * s], rstd = st[2 * s + 1];
        float y[8];
#pragma unroll
        for (int e = 0; e < 4; ++e) { y[e] = (f[e] - mean) * rstd * w0[e] + b0[e]; y[4 + e] = (f[4 + e] - mean) * rstd * w1[e] + b1[e]; }
        u32x4_t o; o.x = cvtpk_s(y[0], y[1]); o.y = cvtpk_s(y[2], y[3]); o.z = cvtpk_s(y[4], y[5]); o.w = cvtpk_s(y[6], y[7]);
        const int st_ = s >> 6, sk = s & 63, chh = c8 >> 3, x = c8 & 7;
        *(LAS u32x4_t*)(lds + G_V + (st_ * 2 + chh) * 8192 + (x >> 2) * 4096 + (sk >> 4) * 1024 + (sk & 15) * 64 + (x & 3) * 16) = o; }
    asm volatile("s_waitcnt lgkmcnt(0)\n\ts_barrier" ::: "memory");
    f32x16 o[2]; o[0] = f32x16{}; o[1] = f32x16{};
    const int vb0 = (int)((unsigned)(uintptr_t)lds + G_V) + ((lane >> 4) & 1) * 32 + (lane & 3) * 8 + (4 * hi + ((lane & 15) >> 2)) * 64;
    nsa::pv(o, vb0 + ch * 8192, pa[0][0], pa[0][1], pa[0][2], pa[0][3]);
    if (tb >= 2) nsa::pv(o, vb0 + (2 + ch) * 8192, pa[1][0], pa[1][1], pa[1][2], pa[1][3]);
    LAS float* ostg = (LAS float*)(lds + G_OST) + wid * 2048;
#pragma unroll
    for (int r = 0; r < 16; ++r) { const int orow = crow(r, hi);
#pragma unroll
        for (int d0 = 0; d0 < 2; ++d0) ostg[orow * 64 + d0 * 32 + r32] = o[d0][r]; }
    asm volatile("s_waitcnt lgkmcnt(0)" ::: "memory");
#pragma unroll
    for (int i = 0; i < 4; ++i) { const int row = i * 8 + (lane >> 3), c8 = lane & 7, t = 32 * tb + row;
        const f32x4_t v0 = *(LAS const f32x4_t*)(ostg + row * 64 + c8 * 8), v1 = *(LAS const f32x4_t*)(ostg + row * 64 + c8 * 8 + 4);
        const size_t grow = (size_t)(m0 + t); const int col = g * 128 + 64 * ch + 8 * c8;
        float uf[8]; unpack8(in.uraw[i], uf);
        const float sb_ = in.sbv[i];
        u32x4_t w; w.x = cvtpk_s(uf[0] * (v0[0] + sb_), uf[1] * (v0[1] + sb_)); w.y = cvtpk_s(uf[2] * (v0[2] + sb_), uf[3] * (v0[3] + sb_));
        w.z = cvtpk_s(uf[4] * (v1[0] + sb_), uf[5] * (v1[1] + sb_)); w.w = cvtpk_s(uf[6] * (v1[2] + sb_), uf[7] * (v1[3] + sb_));
        *(u32x4_t*)(AB + grow * 2048 + 1024 + col) = w; }
    asm volatile("s_waitcnt lgkmcnt(0)\n\ts_barrier" ::: "memory");
}
__device__ __forceinline__ void gmlp_run(const Ptrs& P, LAS unsigned char* lds, int u0, int stride, int nunits, const int wave_s) {
    const int lane = fresh_lane(), r32 = lane & 31, hi = lane >> 5, wid = wave_s, tid = wid * 64 + lane;
    GmlpIn A, B;
    int u = u0;
    bf16x8 pa[2][4];
    { const bf16_t* SWB = (const bf16_t*)(P.ws + WS_SMALL + SM_SWB) + (size_t)(u0 & 7) * 16384; const int tb = wid >> 1;
#pragma unroll
      for (int st_ = 0; st_ < 2; ++st_)
#pragma unroll
        for (int ks = 0; ks < 4; ++ks) {
            const bf16_t* wp = SWB + (size_t)(32 * tb + r32) * 128 + 64 * st_ + 16 * ks + 4 * hi;
            const u32x2_t lo = *(const u32x2_t*)wp, hi2 = *(const u32x2_t*)(wp + 8);
            const u32x4_t wv = {lo.x, lo.y, hi2.x, hi2.y}; pa[st_][ks] = __builtin_bit_cast(bf16x8, wv); } }
    const int c8v = tid & 15, g0 = u0 & 7;
    const f32x4_t w0 = *(const f32x4_t*)(P.in[8] + g0 * 128 + 8 * c8v), w1 = *(const f32x4_t*)(P.in[8] + g0 * 128 + 8 * c8v + 4), b0 = *(const f32x4_t*)(P.in[9] + g0 * 128 + 8 * c8v), b1 = *(const f32x4_t*)(P.in[9] + g0 * 128 + 8 * c8v + 4);
    const float* VSTAT = (const float*)(P.ws + WS_VSTAT);
#define GMLP_STATS(sv_, unit_) do { const int m0_ = ((unit_) >> 8) * SEQ + (((unit_) >> 3) & 31) * 128; const f32x4_t* p_ = (const f32x4_t*)(VSTAT + (size_t)(m0_ + (tid & 127)) * 32); \
        _Pragma("unroll") for (int i_ = 0; i_ < 8; ++i_) sv_[i_] = p_[i_]; } while (0)
    f32x4_t sv[8];
    if (u < nunits) gmlp_load(A, P, u, tid, lane, r32, hi, wid);
    while (u < nunits) {
        GMLP_STATS(sv, u);
        if (u + stride < nunits) gmlp_load(B, P, u + stride, tid, lane, r32, hi, wid);
        gmlp_compute(A, sv, pa, w0, w1, b0, b1, P, lds, u, tid, lane, r32, hi, wid);
        u += stride; if (u >= nunits) break;
        GMLP_STATS(sv, u);
        if (u + stride < nunits) gmlp_load(A, P, u + stride, tid, lane, r32, hi, wid);
        gmlp_compute(B, sv, pa, w0, w1, b0, b1, P, lds, u, tid, lane, r32, hi, wid);
        u += stride;
    }
#undef GMLP_STATS
    asm volatile("s_waitcnt vmcnt(0) lgkmcnt(0)\n\ts_barrier" ::: "memory");
}
#undef P2_WAIT_BAR
}

#define XB_TMO      128
#define XB_XCNT(j)  (256  + 64 * (j))
#define XB_XSUB(j)  (1280 + 64 * (j))
#define XB_XGEN(j)  (2304 + 64 * (j))
#define XB_TOP      3328
#define XB_TOPGEN   3392
#define XCD_BAR_WORDS 3456
#define XB_SPIN_CAP (1u << 18)

__device__ __forceinline__ unsigned xb_ld(unsigned* p)              { return __hip_atomic_load(p, __ATOMIC_RELAXED, __HIP_MEMORY_SCOPE_AGENT); }
__device__ __forceinline__ unsigned xb_add(unsigned* p, unsigned v) { return __hip_atomic_fetch_add(p, v, __ATOMIC_RELAXED, __HIP_MEMORY_SCOPE_AGENT); }
__device__ __forceinline__ unsigned xb_xcc_id() { return (unsigned)__builtin_amdgcn_s_getreg((3 << 11) | 20) & 0xFu; }
#define XB_SPIN(cond, bar) do { unsigned _sp = 0; while (cond) { __builtin_amdgcn_s_sleep(1); \
    if ((++_sp & 255u) == 0u) { if (xb_ld(&(bar)[XB_TMO])) break; if (_sp > XB_SPIN_CAP) { atomicAdd(&(bar)[XB_TMO], 1u); break; } } } } while (0)

struct XcdBarrier {
    unsigned* bar; unsigned x; unsigned w0;
    volatile LAS unsigned* st;
};

__device__ __forceinline__ XcdBarrier xcd_barrier_post(unsigned* bar, volatile LAS unsigned* st, int wave_s) {
    XcdBarrier b; b.bar = bar; b.x = xb_xcc_id(); b.st = st; b.w0 = wave_s == 0 ? 1u : 0u;
    if (b.w0 && fresh_lane() == 0) (void)xb_add(&bar[XB_XCNT(b.x)], 1u);
    return b;
}
__device__ __forceinline__ void xcd_barrier_complete(unsigned* bar, unsigned x, unsigned& nloc, unsigned& nx) {
    const unsigned G = gridDim.x * gridDim.y * gridDim.z;
    unsigned sum, cnt, mine, sp = 0u;
    for (;;) {
        sum = 0u; cnt = 0u; mine = 0u;
#pragma unroll
        for (unsigned j = 0; j < 16; ++j) { const unsigned c = xb_ld(&bar[XB_XCNT(j)]); sum += c; cnt += (c > 0u) ? 1u : 0u; mine = (j == x) ? c : mine; }
        if (sum == G) break;
        __builtin_amdgcn_s_sleep(1);
        if ((++sp & 255u) == 0u) { if (xb_ld(&bar[XB_TMO])) break; if (sp > XB_SPIN_CAP) { atomicAdd(&bar[XB_TMO], 1u); break; } }
    }
    nloc = mine > 0u ? mine : 1u; nx = cnt > 0u ? cnt : 1u;
}

__device__ __forceinline__ void xcd_barrier(const XcdBarrier& b) {
    asm volatile("s_waitcnt vmcnt(0)" ::: "memory");
    __syncthreads();
    if (b.w0 && fresh_lane() == 0) {
        unsigned* bar = b.bar;
        __builtin_amdgcn_s_waitcnt(0);
        unsigned nloc = b.st[0], nx = b.st[1];
        if (nloc == 0u) { xcd_barrier_complete(bar, b.x, nloc, nx); b.st[0] = nloc; b.st[1] = nx; }
        const unsigned old = xb_add(&bar[XB_XSUB(b.x)], 1u);
        const unsigned gen = old / nloc;
        if (old + 1u == (gen + 1u) * nloc) {
            __builtin_amdgcn_fence(__ATOMIC_RELEASE, "agent");
            asm volatile("s_waitcnt vmcnt(0)" ::: "memory");
            const unsigned og = xb_add(&bar[XB_TOP], 1u);
            const unsigned tg = og / nx;
            if (og + 1u == (tg + 1u) * nx) xb_add(&bar[XB_TOPGEN], 1u);
            else XB_SPIN(xb_ld(&bar[XB_TOPGEN]) == tg, bar);
            __builtin_amdgcn_fence(__ATOMIC_ACQUIRE, "agent");
            xb_add(&bar[XB_XGEN(b.x)], 1u);
            asm volatile("s_waitcnt vmcnt(0)" ::: "memory");
        } else {
            XB_SPIN(xb_ld(&bar[XB_XGEN(b.x)]) == gen, bar);
            __builtin_amdgcn_fence(__ATOMIC_ACQUIRE, "agent");
            asm volatile("s_waitcnt vmcnt(0)" ::: "memory");
        }
    }
    __syncthreads();
}

constexpr int LDS_BYTES = 151552;
constexpr int LDS_XCH = 132096;
constexpr int LDS_MISC = 145408;
__global__ void __launch_bounds__(512, 2) mega_fwd(Ptrs P) {
    extern __shared__ __attribute__((aligned(16))) unsigned char lds_raw[];
    LAS unsigned char* lds = (LAS unsigned char*)lds_raw;
    unsigned char* ws = P.ws;
    const int wave = __builtin_amdgcn_readfirstlane(threadIdx.x >> 6);
    const int G = gridDim.x, bid = blockIdx.x;
    if (wave == 0) { const int l_ = fresh_lane(); if (l_ < 2) ((LAS unsigned*)(lds + LDS_MISC))[l_] = 0u; }
    __syncthreads();
    const XcdBarrier bar = xcd_barrier_post((unsigned*)(ws + WS_CTL), (volatile LAS unsigned*)(lds + LDS_MISC), wave);
    p0_prologue(P, lds, bid, G, wave);
    xcd_barrier(bar);
    if (bid == 0) bias1_stage(ws, fresh_tid(wave));
    {
        pg8::Gemm g{(const bf16_t*)(ws + WS_XN), (const bf16_t*)(ws + WS_WIN), MTOK, NPROJ, 2048, 2048};
        pg8::StaticOrder S; S.init(MTOK, NPROJ, G, bid);
        pg8::EpiProj E{(bf16_t*)(ws + WS_Q), (bf16_t*)(ws + WS_KV6), (bf16_t*)(ws + WS_U), (bf16_t*)(ws + WS_GV), (float*)(ws + WS_GATES), (float*)(ws + WS_VSTAT), P.in[3], P.in[4]};
        pg8::gemm_phase<pg8::EpiProj, pg8::StaticOrder, true, true>(lds, g, S, E, wave);
    }
    xcd_barrier(bar);
    if (bid < 128 && G >= 256) p2::compress_unit(P, lds, bid, wave);
    else if (G >= 256) p2::gmlp_run(P, lds, bid - 128, G - 128, 1024, wave);
    xcd_barrier(bar);
    nsa::nsa_phase(P, lds, bid, G, wave);
    xcd_barrier(bar);
    {
        pg8::Gemm g{(const bf16_t*)(ws + WS_AB), (const bf16_t*)(ws + WS_WOUT), MTOK, 2048, 2048, 2048};
        pg8::StaticOrder S; S.init(MTOK, 2048, G, bid);
        pg8::EpiRes1 E{(const float*)(ws + WS_SMALL + SM_RINV), (const float*)(ws + WS_SMALL + SM_INVW), (bf16_t*)(ws + WS_XN), (float*)(ws + WS_SSQ)};
        pg8::gemm_phase<pg8::EpiRes1, pg8::StaticOrder, true, true>(lds, g, S, E, wave);
    }
    xcd_barrier(bar);
    for (int m = bid * 512 + fresh_tid(wave); m < MTOK; m += G * 512) {
        const float* p = (const float*)(ws + WS_SSQ) + (size_t)m * 32; float s = 0.f;
#pragma unroll
        for (int i = 0; i < 32; ++i) s += p[i];
        ((float*)(ws + WS_SMALL + SM_R2))[m] = __builtin_amdgcn_rsqf(s * (1.0f / D_MODEL) + 1e-6f);
    }
    xcd_barrier(bar);
    {
        pg8::Gemm g{(const bf16_t*)(ws + WS_XN), (const bf16_t*)(ws + WS_WUP), MTOK, N_UP, 2048, 2048};
        pg8::StaticOrder S; S.init(MTOK, N_UP, G, bid);
        pg8::EpiUpConv E{(bf16_t*)(ws + WS_G), (const float*)(ws + WS_SMALL + SM_R2), P.in[15], P.in[16], (float*)(ws + WS_HLAST), (float*)(ws + WS_FIRST), lds + LDS_XCH};
        pg8::gemm_phase<pg8::EpiUpConv, pg8::StaticOrder, true, true>(lds, g, S, E, wave);
    }
    xcd_barrier(bar);
    for (int it = bid * 512 + fresh_tid(wave); it < 60 * 44 * 2 * 16; it += G * 512) {
        const int c8 = it & 15, row = (it >> 4) & 1, tl_ = it >> 5, pn = tl_ % 44, pmi = tl_ / 44, pm = pmi + pmi / 15 + 1;
        const float* cw = P.in[15]; const float* cb = P.in[16]; (void)cb;
        const float* fp = (const float*)(ws + WS_FIRST) + ((size_t)(pm * 44 + pn) * 2 + row) * 256 + 8 * c8;
        const float* lp = (const float*)(ws + WS_HLAST) + ((size_t)((pm - 1) * 44 + pn) * 2) * 256 + 8 * c8;
        const int ch = pn * 128 + 8 * c8;
        float r[8];
#pragma unroll
        for (int e = 0; e < 8; ++e) {
            const float l0g = lp[e], l1g = lp[256 + e], l0u = lp[128 + e], l1u = lp[256 + 128 + e];
            const float w0g = cw[ch + e], w1g = cw[N_UP + ch + e], w0u = cw[D_FF + ch + e], w1u = cw[N_UP + D_FF + ch + e];
            const float cg = fp[e] + (row == 0 ? w1g * l1g + w0g * l0g : w0g * l1g), cu = fp[128 + e] + (row == 0 ? w1u * l1u + w0u * l0u : w0u * l1u);
            r[e] = cg * sigmoidf_(cg) * cu;
        }
        u32x4_t o; o.x = pk2(r[0], r[1]); o.y = pk2(r[2], r[3]); o.z = pk2(r[4], r[5]); o.w = pk2(r[6], r[7]);
        *(u32x4_t*)((bf16_t*)(ws + WS_G) + (size_t)(pm * 256 + row) * D_FF + ch) = o;
    }
    xcd_barrier(bar);
    {
        pg8::Gemm g{(const bf16_t*)(ws + WS_G), (const bf16_t*)(ws + WS_WDOWN), MTOK, 2048, D_FF, D_FF};
        pg8::StaticOrder S; S.init(MTOK, 2048, G, bid);
        pg8::EpiDown E{P.out, (const bf16_t*)(ws + WS_XN)};
        pg8::gemm_phase<pg8::EpiDown, pg8::StaticOrder, true, true>(lds, g, S, E, wave);
    }
}

extern "C" void kernel_launch(void* const* d_in, const int* in_sizes, int n_in, void* d_out, int out_size, void* d_ws, size_t ws_size, hipStream_t stream) {
    static int grid_blocks = 0;
    if (!grid_blocks) {
        int dev = 0, cus = 0, per_cu = 0;
        (void)hipGetDevice(&dev);
        (void)hipDeviceGetAttribute(&cus, hipDeviceAttributeMultiprocessorCount, dev);
        (void)hipFuncSetAttribute((const void*)mega_fwd, hipFuncAttributeMaxDynamicSharedMemorySize, LDS_BYTES);
        (void)hipOccupancyMaxActiveBlocksPerMultiprocessor(&per_cu, (const void*)mega_fwd, 512, LDS_BYTES);
        if (per_cu < 1) { fprintf(stderr, "kernel_launch: occupancy query says %d blocks/CU\n", per_cu); per_cu = 1; }
        grid_blocks = cus * 1;
        (void)hipGetLastError();
    }
    if (n_in != 18 || ws_size < WS_END) { fprintf(stderr, "kernel_launch: unexpected n_in %d / ws %zu\n", n_in, ws_size); return; }
    Ptrs P{};
    for (int i = 0; i < 18; ++i) P.in[i] = (const float*)d_in[i];
    P.out = (float*)d_out; P.ws = (unsigned char*)d_ws;
    (void)hipMemsetAsync((char*)d_ws + WS_CTL, 0, 16384, stream);
    mega_fwd<<<dim3(grid_blocks), dim3(512), LDS_BYTES, stream>>>(P);
}
```

```cpp
#include <hip/hip_runtime.h>
#include <cstdio>
#include <cstdint>

constexpr int D_MODEL = 2048, BATCH = 4, SEQ = 4096, MTOK = BATCH * SEQ;
constexpr int IN_COLS = 4656, NPROJ = 4864;
constexpr int D_FF = 5632, N_UP = 2 * D_FF;
constexpr int NBG = 16;
constexpr size_t KVSZ = (size_t)NBG * SEQ * 64;
constexpr float LOG2E = 1.4426950408889634f;

constexpr size_t MiB = 1u << 20;
constexpr size_t WS_CTL = 0;
constexpr size_t WS_WIN = 1 * MiB, WS_WOUT = 20 * MiB, WS_WUP = 28 * MiB, WS_WDOWN = 72 * MiB, WS_W1C = 94 * MiB;
constexpr size_t WS_SMALL = 96 * MiB;
constexpr size_t SM_BIASP = 0, SM_BIAS1 = 65536, SM_R2 = 131072, SM_W2T = 196608  , SM_SWB = 262144  , SM_RINV = 524288  , SM_INVW = 589824  ;
constexpr size_t WS_XN = 97 * MiB;
constexpr size_t WS_Q = 161 * MiB;
constexpr size_t WS_KV6 = 193 * MiB;
constexpr size_t WS_U = 241 * MiB, WS_GV = 273 * MiB;
constexpr size_t WS_GATES = 305 * MiB;
constexpr size_t WS_VSTAT = 308 * MiB;
constexpr size_t WS_KC = 310 * MiB, WS_VC = 310 * MiB + 524288;
constexpr size_t WS_HC = 311 * MiB;
constexpr size_t WS_AB = 315 * MiB;
constexpr size_t WS_SSQ = 379 * MiB;
constexpr size_t WS_G = 161 * MiB;
constexpr size_t WS_HID = 381 * MiB;
constexpr size_t WS_HLAST = 381 * MiB, WS_FIRST = 388 * MiB;
constexpr size_t WS_END = 469 * MiB;

#define LAS __attribute__((address_space(3)))
typedef unsigned short bf16_t;
typedef unsigned u32x4_t __attribute__((ext_vector_type(4)));
typedef unsigned u32x2_t __attribute__((ext_vector_type(2)));
typedef float f32x4_t __attribute__((ext_vector_type(4)));

__device__ __forceinline__ float bf2f(unsigned short h) { return __uint_as_float(((unsigned)h) << 16); }
__device__ __forceinline__ unsigned f2bf(float f) { unsigned u = __float_as_uint(f); return (u + 0x7fffu + ((u >> 16) & 1u)) >> 16; }
__device__ __forceinline__ unsigned pk2(float lo, float hi) { return f2bf(lo) | (f2bf(hi) << 16); }
__device__ __forceinline__ float gelu_tanh(float x) {
    const float u = 0.7978845608028654f * (x + 0.044715f * x * x * x);
    const float e = __builtin_amdgcn_exp2f(-2.8853900817779268f * u);
    return x * __builtin_amdgcn_rcpf(1.0f + e);
}
__device__ __forceinline__ float sigmoidf_(float x) { return __builtin_amdgcn_rcpf(1.0f + __builtin_amdgcn_exp2f(-LOG2E * x)); }
__device__ __forceinline__ float wave_sum(float v) {
#pragma unroll
    for (int o = 1; o < 64; o <<= 1) v += __shfl_xor(v, o);
    return v;
}
__device__ __forceinline__ void unpack8(u32x4_t r, float (&f)[8]) {
    f[0] = __uint_as_float(r.x << 16); f[1] = __uint_as_float(r.x & 0xffff0000u);
    f[2] = __uint_as_float(r.y << 16); f[3] = __uint_as_float(r.y & 0xffff0000u);
    f[4] = __uint_as_float(r.z << 16); f[5] = __uint_as_float(r.z & 0xffff0000u);
    f[6] = __uint_as_float(r.w << 16); f[7] = __uint_as_float(r.w & 0xffff0000u);
}

__device__ __forceinline__ int fresh_lane() { unsigned z_ = 0u; asm volatile("" : "+v"(z_)); return (int)__builtin_amdgcn_mbcnt_hi(~0u, __builtin_amdgcn_mbcnt_lo(~0u, z_)); }
__device__ __forceinline__ int fresh_tid(int wave_s) { return wave_s * 64 + fresh_lane(); }
namespace pg8 {
#define PG8_LAS __attribute__((address_space(3)))
typedef unsigned short bf16_t;
typedef short bf16x8 __attribute__((ext_vector_type(8)));
typedef float f32x4 __attribute__((ext_vector_type(4)));
typedef unsigned u32x4 __attribute__((ext_vector_type(4)));
constexpr int BM = 256, BK = 64, HALF = 128, HTB = HALF * BK * 2  , STAGE_BYTES = 8 * HTB, NXCD = 8, WGM = 8;

__host__ __device__ __forceinline__ int lds_byte(int r, int c) { const int st = (r >> 4) * 2 + (c >> 5), rr = r & 15, cc = c & 31, ob = rr * 64 + cc * 2; return st * 1024 + (ob ^ (((ob >> 9) & 1) << 5)); }
__host__ __device__ __forceinline__ void stage_rc(int b, int& R, int& C) { const int st = b / 1024, sb = b % 1024, swz = sb ^ (((sb >> 9) & 1) << 5); R = (st >> 1) * 16 + swz / 64; C = (st & 1) * 32 + (swz % 64) / 2; }
__host__ __device__ __forceinline__ int perm32(int rho) { const int n = rho >> 4, i = rho & 15; return 8 * (i >> 2) + 4 * n + (i & 3); }

struct Unit { int pm, pn; };
struct Gemm { const bf16_t* A; const bf16_t* Bt; int M, N, K, lda; };

struct StaticOrder {
    int nM, nN, nwg, G, c;
    __host__ __device__ void init(int M, int N, int G_, int c_) { nM = M / BM; nN = N / BM; nwg = nM * nN; G = G_; c = c_; }
    __host__ __device__ bool next(int i, Unit& u) const {
        const long L = (long)i * G + c; if (L >= nwg) return false;
        int wgid = (int)L; { const int q = nwg / NXCD, r = nwg % NXCD, xcd = wgid % NXCD, off = wgid / NXCD; wgid = (xcd < r ? xcd * (q + 1) : r * (q + 1) + (xcd - r) * q) + off; }
        const int nig = WGM * nN, gid = wgid / nig, fm = gid * WGM, gsz = (nM - fm) < WGM ? (nM - fm) : WGM;
        u.pm = fm + ((wgid % nig) % gsz); u.pn = (wgid % nig) / gsz; return true;
    }
    __device__ __forceinline__ void a_ready(const Unit&) const {}
    __device__ __forceinline__ void done(const Unit&) const {}
};

__device__ __forceinline__ unsigned cvt_pk_bf16(float lo, float hi) { unsigned r; asm volatile("v_cvt_pk_bf16_f32 %0, %1, %2" : "=v"(r) : "v"(lo), "v"(hi)); return r; }

struct EpiProj {
    static constexpr bool PERM = true, AFTER_DRAIN = false, PERMA = false;
    bf16_t* Q; bf16_t* KV6; bf16_t* U; bf16_t* GV; float* GATES; float* VSTAT; const float* q_norm_w; const float* k_norm_w;
    __device__ __forceinline__ void operator()(const f32x4 (&acc)[2][2][4][2], const Unit& u, int wr, int wc, int fr, int fq) const {
        const int pn = u.pn, row0 = u.pm * BM + wr * 64 + fr;
        if (pn < 10) {
            const bool normed = (pn < 4) || pn == 6 || pn == 8;
            const float* w = pn < 4 ? q_norm_w : (k_norm_w + (pn == 6 ? 64 : 128));
            const float sc = pn < 4 ? 0.125f * LOG2E : 1.0f;
            f32x4 wv[2][2];
#pragma unroll
            for (int bj = 0; bj < 2; ++bj)
#pragma unroll
                for (int n = 0; n < 2; ++n) wv[bj][n] = normed ? (*(const f32x4*)(w + 32 * bj + 8 * fq + 4 * n)) * sc : (f32x4){1.f, 1.f, 1.f, 1.f};
#pragma unroll
            for (int ai = 0; ai < 2; ++ai)
#pragma unroll
                for (int m = 0; m < 4; ++m) {
                    const int row = row0 + ai * HALF + m * 16;
                    float r = 1.f;
                    if (normed) {
                        float ss = 0.f;
#pragma unroll
                        for (int bj = 0; bj < 2; ++bj)
#pragma unroll
                            for (int n = 0; n < 2; ++n) { const f32x4 x = acc[ai][bj][m][n]; ss += (x[0] * x[0] + x[1] * x[1]) + (x[2] * x[2] + x[3] * x[3]); }
                        ss += __shfl_xor(ss, 16); ss += __shfl_xor(ss, 32);
                        r = __builtin_amdgcn_rsqf(ss * (1.0f / 64.0f) + 1e-6f);
                    }
                    bf16_t* dst;
                    if (pn < 4) dst = Q + (size_t)row * 1024 + pn * 256 + wc * 64 + 8 * fq;
                    else { const int b = row >> 12, t = row & 4095; dst = KV6 + (size_t)(pn - 4) * KVSZ + ((size_t)((b * 4 + wc) * 4096 + t)) * 64 + 8 * fq; }
#pragma unroll
                    for (int bj = 0; bj < 2; ++bj) {
                        const f32x4 v0 = acc[ai][bj][m][0] * r * wv[bj][0], v1 = acc[ai][bj][m][1] * r * wv[bj][1];
                        u32x4 o; o.x = cvt_pk_bf16(v0[0], v0[1]); o.y = cvt_pk_bf16(v0[2], v0[3]); o.z = cvt_pk_bf16(v1[0], v1[1]); o.w = cvt_pk_bf16(v1[2], v1[3]);
                        *(u32x4*)(dst + 32 * bj) = o;
                    }
                }
        } else if (pn < 18) {
            const bool isv = pn >= 14; const int ct = isv ? pn - 14 : pn - 10;
            bf16_t* base = (isv ? GV : U) + ct * 256 + wc * 64 + 8 * fq;
#pragma unroll
            for (int ai = 0; ai < 2; ++ai)
#pragma unroll
                for (int m = 0; m < 4; ++m) {
                    const int row = row0 + ai * HALF + m * 16; float s1 = 0.f, s2 = 0.f;
#pragma unroll
                    for (int bj = 0; bj < 2; ++bj) {
                        f32x4 v0 = acc[ai][bj][m][0], v1 = acc[ai][bj][m][1];
#pragma unroll
                        for (int e = 0; e < 4; ++e) { v0[e] = gelu_tanh(v0[e]); v1[e] = gelu_tanh(v1[e]); s1 += v0[e] + v1[e]; s2 += v0[e] * v0[e] + v1[e] * v1[e]; }
                        u32x4 o; o.x = cvt_pk_bf16(v0[0], v0[1]); o.y = cvt_pk_bf16(v0[2], v0[3]); o.z = cvt_pk_bf16(v1[0], v1[1]); o.w = cvt_pk_bf16(v1[2], v1[3]);
                        *(u32x4*)(base + (size_t)row * 1024 + 32 * bj) = o;
                    }
                    if (isv) {
                        s1 += __shfl_xor(s1, 16); s1 += __shfl_xor(s1, 32); s2 += __shfl_xor(s2, 16); s2 += __shfl_xor(s2, 32);
                        if (fq == 0) { float* p = VSTAT + ((size_t)row * 16 + ct * 4 + wc) * 2; p[0] = s1; p[1] = s2; }
                    }
                }
        } else {
            if (wc == 0) {
#pragma unroll
                for (int ai = 0; ai < 2; ++ai)
#pragma unroll
                    for (int m = 0; m < 4; ++m) {
                        const int row = row0 + ai * HALF + m * 16;
#pragma unroll
                        for (int bj = 0; bj < 2; ++bj)
#pragma unroll
                            for (int n = 0; n < 2; ++n) {
                                const int L = 32 * bj + 8 * fq + 4 * n;
                                if (L < 48) { f32x4 v = acc[ai][bj][m][n]; f32x4 o; o[0] = sigmoidf_(v[0]); o[1] = sigmoidf_(v[1]); o[2] = sigmoidf_(v[2]); o[3] = sigmoidf_(v[3]); *(f32x4*)(GATES + (size_t)row * 48 + L) = o; }
                            }
                    }
            }
        }
    }
};
struct EpiCmp {
    static constexpr bool PERM = true, AFTER_DRAIN = false, PERMA = false;
    bf16_t* HC; const float* bias1;
    __device__ __forceinline__ void operator()(const f32x4 (&acc)[2][2][4][2], const Unit& u, int wr, int wc, int fr, int fq) const {
        const int row0 = u.pm * BM + wr * 64 + fr, col0 = wc * 32 + 8 * fq;
        f32x4 bv[2][2];
#pragma unroll
        for (int bj = 0; bj < 2; ++bj)
#pragma unroll
            for (int n = 0; n < 2; ++n) bv[bj][n] = *(const f32x4*)(bias1 + u.pn * 256 + col0 + bj * HALF + 4 * n);
#pragma unroll
        for (int ai = 0; ai < 2; ++ai)
#pragma unroll
            for (int m = 0; m < 4; ++m) { bf16_t* rowp = HC + (size_t)(row0 + ai * HALF + m * 16) * 256 + col0;
#pragma unroll
                for (int bj = 0; bj < 2; ++bj) { f32x4 v0 = acc[ai][bj][m][0] + bv[bj][0], v1 = acc[ai][bj][m][1] + bv[bj][1];
#pragma unroll
                    for (int e = 0; e < 4; ++e) { v0[e] = gelu_tanh(v0[e]); v1[e] = gelu_tanh(v1[e]); }
                    u32x4 o; o.x = cvt_pk_bf16(v0[0], v0[1]); o.y = cvt_pk_bf16(v0[2], v0[3]); o.z = cvt_pk_bf16(v1[0], v1[1]); o.w = cvt_pk_bf16(v1[2], v1[3]);
                    *(u32x4*)(rowp + bj * HALF) = o; } }
    }
};
struct CmpOrder {
    int c, G;
    __device__ bool next(int i, Unit& u) const { const int L = i * G + c; if (L >= 32) return false; u.pm = L; u.pn = L >> 4; return true; }
    __device__ __forceinline__ void a_ready(const Unit&) const {}
    __device__ __forceinline__ void done(const Unit&) const {}
};
struct EpiRes1 {
    static constexpr bool PERM = false, AFTER_DRAIN = false, PERMA = false;
    const float* RINV; const float* INVW; bf16_t* X1b; float* SSQ;
    __device__ __forceinline__ void operator()(const f32x4 (&acc)[2][2][4][2], const Unit& u, int wr, int wc, int fr, int fq) const {
        const int row0 = u.pm * BM + wr * 64 + fr, col0 = u.pn * BM + wc * 32 + 4 * fq;
        f32x4 iw[2][2];
#pragma unroll
        for (int bj = 0; bj < 2; ++bj)
#pragma unroll
            for (int n = 0; n < 2; ++n) iw[bj][n] = *(const f32x4*)(INVW + col0 + bj * HALF + n * 16);
#pragma unroll
        for (int ai = 0; ai < 2; ++ai) {
            u32x2_t xin[4][2][2]; float ri[4];
#pragma unroll
            for (int m = 0; m < 4; ++m) { ri[m] = RINV[row0 + ai * HALF + m * 16];
#pragma unroll
                for (int bj = 0; bj < 2; ++bj)
#pragma unroll
                    for (int n = 0; n < 2; ++n) xin[m][bj][n] = *(const u32x2_t*)(X1b + (size_t)(row0 + ai * HALF + m * 16) * D_MODEL + col0 + bj * HALF + n * 16); }
            __builtin_amdgcn_sched_barrier(0);
#pragma unroll
            for (int m = 0; m < 4; ++m) { const int row = row0 + ai * HALF + m * 16; const size_t off = (size_t)row * D_MODEL + col0; float ss = 0.f;
#pragma unroll
                for (int bj = 0; bj < 2; ++bj)
#pragma unroll
                    for (int n = 0; n < 2; ++n) { const u32x2_t w_ = xin[m][bj][n];
                        f32x4 xv; xv[0] = __uint_as_float(w_.x << 16); xv[1] = __uint_as_float(w_.x & 0xffff0000u); xv[2] = __uint_as_float(w_.y << 16); xv[3] = __uint_as_float(w_.y & 0xffff0000u);
                        const f32x4 v = xv * ri[m] * iw[bj][n] + acc[ai][bj][m][n];
                        ss += (v[0] * v[0] + v[1] * v[1]) + (v[2] * v[2] + v[3] * v[3]);
                        u32x2_t w; w.x = cvt_pk_bf16(v[0], v[1]); w.y = cvt_pk_bf16(v[2], v[3]); *(u32x2_t*)(X1b + off + bj * HALF + n * 16) = w; }
                ss += __shfl_xor(ss, 16); ss += __shfl_xor(ss, 32);
                if (fq == 0) SSQ[(size_t)row * 32 + u.pn * 4 + wc] = ss; }
            __builtin_amdgcn_sched_barrier(0);
        }
    }
};
struct EpiUpV1 {
    static constexpr bool PERM = true, AFTER_DRAIN = false, PERMA = false;
    bf16_t* HID; const float* R2;
    __device__ __forceinline__ void operator()(const f32x4 (&acc)[2][2][4][2], const Unit& u, int wr, int wc, int fr, int fq) const {
        const int row0 = u.pm * BM + wr * 64 + fr, col0 = u.pn * BM + wc * 32 + 8 * fq;
#pragma unroll
        for (int ai = 0; ai < 2; ++ai)
#pragma unroll
            for (int m = 0; m < 4; ++m) { const int row = row0 + ai * HALF + m * 16; const float r = R2[row]; bf16_t* rowp = HID + (size_t)row * N_UP + col0;
#pragma unroll
                for (int bj = 0; bj < 2; ++bj) { const f32x4 v0 = acc[ai][bj][m][0] * r, v1 = acc[ai][bj][m][1] * r;
                    u32x4 o; o.x = cvt_pk_bf16(v0[0], v0[1]); o.y = cvt_pk_bf16(v0[2], v0[3]); o.z = cvt_pk_bf16(v1[0], v1[1]); o.w = cvt_pk_bf16(v1[2], v1[3]);
                    *(u32x4*)(rowp + bj * HALF) = o; } }
    }
};
struct EpiDown {
    static constexpr bool PERM = false, AFTER_DRAIN = false, PERMA = false;
    float* out; const bf16_t* X1b;
    __device__ __forceinline__ void operator()(const f32x4 (&acc)[2][2][4][2], const Unit& u, int wr, int wc, int fr, int fq) const {
        const int row0 = u.pm * BM + wr * 64 + fr, col0 = u.pn * BM + wc * 32 + 4 * fq;
#pragma unroll
        for (int ai = 0; ai < 2; ++ai) {
            u32x2_t xin[4][2][2];
#pragma unroll
            for (int m = 0; m < 4; ++m)
#pragma unroll
                for (int bj = 0; bj < 2; ++bj)
#pragma unroll
                    for (int n = 0; n < 2; ++n) xin[m][bj][n] = *(const u32x2_t*)(X1b + (size_t)(row0 + ai * HALF + m * 16) * D_MODEL + col0 + bj * HALF + n * 16);
            __builtin_amdgcn_sched_barrier(0);
#pragma unroll
            for (int m = 0; m < 4; ++m) { const size_t off = (size_t)(row0 + ai * HALF + m * 16) * D_MODEL + col0;
#pragma unroll
                for (int bj = 0; bj < 2; ++bj)
#pragma unroll
                    for (int n = 0; n < 2; ++n) { const u32x2_t w = xin[m][bj][n];
                        f32x4 v; v[0] = __uint_as_float(w.x << 16); v[1] = __uint_as_float(w.x & 0xffff0000u); v[2] = __uint_as_float(w.y << 16); v[3] = __uint_as_float(w.y & 0xffff0000u);
                        *(f32x4*)(out + off + bj * HALF + n * 16) = v + acc[ai][bj][m][n]; } }
            __builtin_amdgcn_sched_barrier(0);
        }
    }
};
__device__ __forceinline__ unsigned f2bf_(float f) { unsigned u = __float_as_uint(f); return (u + 0x7fffu + ((u >> 16) & 1u)) >> 16; }
typedef float f32x2 __attribute__((ext_vector_type(2)));
struct EpiUpConv {
    static constexpr bool PERM = true, AFTER_DRAIN = false, PERMA = true;
    bf16_t* G; const float* R2; const float* cw; const float* cb; float* HLAST; float* FIRST; PG8_LAS unsigned char* xlds;
    __device__ __forceinline__ void prefetch(const Unit& u, int par, const int wave_s) const {
        const int lane_ = fresh_lane();
        PG8_LAS float* Wl = (PG8_LAS float*)xlds + (par ? 3344 : 2048);
#pragma unroll
        for (int i2 = 0; i2 < 2; ++i2) { const int i = wave_s * 64 + lane_ + 512 * i2, k = i >> 8, p = i & 255, c = (p < 128 ? 0 : D_FF - 128) + u.pn * 128 + p;
            const float* src = k < 3 ? cw + (unsigned)(k * N_UP + c) : cb + (unsigned)c;
            __builtin_amdgcn_global_load_lds((const unsigned*)src, (PG8_LAS unsigned*)(Wl + wave_s * 64 + 512 * i2), 4, 0, 0); }
        if (wave_s < 4) __builtin_amdgcn_global_load_lds((const unsigned*)(R2 + u.pm * BM + wave_s * 64 + lane_), (PG8_LAS unsigned*)(Wl + 1024 + wave_s * 64), 4, 0, 0);
    }
    __device__ __forceinline__ void run(const f32x4 (&acc)[2][2][4][2], const Unit& u, const Unit& nxt, const bool has_next, const int par, int wr, int wc, const int wave_s) const {
        unsigned z_ = 0u; asm volatile("" : "+v"(z_));
        const int lane_ = (int)__builtin_amdgcn_mbcnt_hi(~0u, __builtin_amdgcn_mbcnt_lo(~0u, z_)); const int fr = lane_ & 15, fq = lane_ >> 4;
        const int row0 = u.pm * BM + wr * 64 + 4 * fr;
        PG8_LAS float* X = (PG8_LAS float*)xlds;
        PG8_LAS float* Wl = X + (par ? 3344 : 2048);
        PG8_LAS float* R2L = Wl + 1024;
        const unsigned tile = (unsigned)(u.pm * (N_UP / 256) + u.pn);
        asm volatile("s_waitcnt vmcnt(8)" ::: "memory"); __builtin_amdgcn_s_barrier(); asm volatile("" ::: "memory");
        if (has_next) prefetch(nxt, par ^ 1, wave_s);
        if (fr == 15) {
#pragma unroll
            for (int ai = 0; ai < 2; ++ai) { const int sg = 2 * ai + wr; const float r2a = R2L[ai * HALF + wr * 64 + 62], r2b = R2L[ai * HALF + wr * 64 + 63];
#pragma unroll
                for (int mm = 0; mm < 2; ++mm)
#pragma unroll
                for (int bj = 0; bj < 2; ++bj)
#pragma unroll
                    for (int n = 0; n < 2; ++n) { const f32x4 h = acc[ai][bj][2 + mm][n] * (mm ? r2b : r2a);
                        *(PG8_LAS f32x4*)(X + ((sg * 4 + wc) * 2 + mm) * 64 + bj * 32 + 8 * fq + 4 * n) = h;
                        if (ai == 1 && wr == 1) *(f32x4*)(HLAST + (unsigned)((tile * 2 + mm) * 256 + bj * HALF + wc * 32 + 8 * fq + 4 * n)) = h; } }
        }
        asm volatile("s_waitcnt lgkmcnt(0)" ::: "memory"); __builtin_amdgcn_s_barrier(); asm volatile("" ::: "memory");
        const int cbase = u.pn * 128 + wc * 32 + 8 * fq;
        const bool seq_start = (u.pm & 15) == 0;
#pragma unroll
        for (int ai = 0; ai < 2; ++ai) {
            const int sg = 2 * ai + wr;
            const f32x4 rs = *(PG8_LAS const f32x4*)(R2L + ai * HALF + wr * 64 + 4 * fr);
            const bool defer = (ai == 0) && (wr == 0) && !seq_start && (fr == 0);
            unsigned pk[2][4][2];
#pragma unroll
            for (int n = 0; n < 2; ++n) {
#pragma unroll
                for (int e2 = 0; e2 < 2; ++e2) {
                    asm volatile("" ::: "memory"); __builtin_amdgcn_sched_barrier(0);
                    PG8_LAS const f32x2* wp = (PG8_LAS const f32x2*)(Wl + wc * 32 + 8 * fq + 4 * n + 2 * e2);
                    const f32x2 wg0 = wp[0], wg1 = wp[128], wg2 = wp[256], bg = wp[384], wu0 = wp[64], wu1 = wp[192], wu2 = wp[320], bu = wp[448];
                    f32x2 hg1 = {0.f, 0.f}, hg2 = {0.f, 0.f}, hu1 = {0.f, 0.f}, hu2 = {0.f, 0.f};
                    if (ai == 1 || wr == 1) { PG8_LAS const f32x2* xp = (PG8_LAS const f32x2*)(X + (((sg - 1) * 4 + wc) * 2) * 64 + 8 * fq + 4 * n + 2 * e2); hg2 = xp[0]; hg1 = xp[32]; hu2 = xp[16]; hu1 = xp[48]; }
                    f32x2 vg[4], vu[4], cg[4], cu[4];
#pragma unroll
                    for (int m = 0; m < 4; ++m) { const f32x2 r2 = {rs[m], rs[m]};
                        vg[m] = (f32x2){acc[ai][0][m][n][2 * e2], acc[ai][0][m][n][2 * e2 + 1]} * r2; vu[m] = (f32x2){acc[ai][1][m][n][2 * e2], acc[ai][1][m][n][2 * e2 + 1]} * r2; }
#define EPI_SHR1(old_, v_) (f32x2){__uint_as_float(__builtin_amdgcn_update_dpp(__float_as_uint((old_).x), __float_as_uint((v_).x), 0x111, 0xf, 0xf, false)), __uint_as_float(__builtin_amdgcn_update_dpp(__float_as_uint((old_).y), __float_as_uint((v_).y), 0x111, 0xf, 0xf, false))}
                    const f32x2 pg1 = EPI_SHR1(hg1, vg[3]), pg2 = EPI_SHR1(hg2, vg[2]), pu1 = EPI_SHR1(hu1, vu[3]), pu2 = EPI_SHR1(hu2, vu[2]);
#undef EPI_SHR1
                    cg[0] = bg + wg0 * pg2 + wg1 * pg1 + wg2 * vg[0]; cu[0] = bu + wu0 * pu2 + wu1 * pu1 + wu2 * vu[0];
                    cg[1] = bg + wg0 * pg1 + wg1 * vg[0] + wg2 * vg[1]; cu[1] = bu + wu0 * pu1 + wu1 * vu[0] + wu2 * vu[1];
                    cg[2] = bg + wg0 * vg[0] + wg1 * vg[1] + wg2 * vg[2]; cu[2] = bu + wu0 * vu[0] + wu1 * vu[1] + wu2 * vu[2];
                    cg[3] = bg + wg0 * vg[1] + wg1 * vg[2] + wg2 * vg[3]; cu[3] = bu + wu0 * vu[1] + wu1 * vu[2] + wu2 * vu[3];
                    if (defer) {
#pragma unroll
                        for (int m = 0; m < 2; ++m) { float* fp = FIRST + (unsigned)((tile * 2 + m) * 256 + wc * 32 + 8 * fq + 4 * n + 2 * e2); *(f32x2*)fp = cg[m]; *(f32x2*)(fp + HALF) = cu[m]; }
                    }
#pragma unroll
                    for (int m = 0; m < 4; ++m) {
                        const f32x2 t = cg[m] * (f32x2){-LOG2E, -LOG2E};
                        f32x2 sg_ = {__builtin_amdgcn_exp2f(t.x), __builtin_amdgcn_exp2f(t.y)};
                        sg_ = sg_ + (f32x2){1.0f, 1.0f};
                        const f32x2 rc = {__builtin_amdgcn_rcpf(sg_.x), __builtin_amdgcn_rcpf(sg_.y)};
                        const f32x2 gv = cg[m] * rc * cu[m];
                        pk[n][m][e2] = cvt_pk_bf16(gv.x, gv.y);
                    }
                }
            }
#pragma unroll
            for (int m = 0; m < 4; ++m)
                if (!(m < 2 && defer)) { u32x4 o; o.x = pk[0][m][0]; o.y = pk[0][m][1]; o.z = pk[1][m][0]; o.w = pk[1][m][1]; *(u32x4*)(G + (unsigned)((row0 + ai * HALF + m) * D_FF + cbase)) = o; }
        }
    }
};
template <class Epi, class Sched, bool ALIGN_EPI = false, bool SP2 = false>
__device__ __forceinline__ void gemm_phase(PG8_LAS unsigned char* lds, const Gemm g, const Sched& S, const Epi& E, const int wave_s) {
    const int tid = fresh_tid(wave_s), wid = wave_s, lane = tid & 63,
          wr = wid >> 2, wc = wid & 3, fr = lane & 15, fq = lane >> 4;
    const int K = g.K, nt = K / BK;
    unsigned voffA[2], voffB[2];
#pragma unroll
    for (int i = 0; i < 2; ++i) { int R, C; stage_rc(tid * 16 + i * 8192, R, C); const int Rb = Epi::PERM ? ((R & ~31) + perm32(R & 31)) : R;
        const int Ra = Epi::PERMA ? ((R & ~63) + 4 * (R & 15) + ((R >> 4) & 3)) : R;
        voffA[i] = (unsigned)(Ra * g.lda + C) * 2u; voffB[i] = (unsigned)(Rb * K + C) * 2u; }
    const size_t kstep = (size_t)(BK * 2);
    const size_t hstepA = (size_t)HALF * g.lda * 2, hstepB = (size_t)HALF * K * 2;
    const size_t tstepA = 2 * hstepA, tstepB = 2 * hstepB;
    const unsigned ldsw = (unsigned)wid * 1024u;
    const int aoff = lds_byte(wr * 64 + fr, fq * 8), boff = lds_byte(wc * 32 + fr, fq * 8);
#define PG8_SA(b, h) (((b) * 2 + (h)) * HTB)
#define PG8_SB(b, h) ((4 + (b) * 2 + (h)) * HTB)
#define PG8_STAGE(bufoff, gbase, voff) do { _Pragma("unroll") for (int _i = 0; _i < 2; ++_i) \
        __builtin_amdgcn_global_load_lds((const unsigned*)((const char*)(gbase) + (voff)[_i]), (PG8_LAS unsigned*)(lds + (bufoff) + ldsw + _i * 8192), 16, 0, 0); } while (0)
#define PG8_LDA(dst, b, h) do { _Pragma("unroll") for (int m = 0; m < 4; ++m) _Pragma("unroll") for (int k = 0; k < 2; ++k) dst[m][k] = *(const PG8_LAS bf16x8*)(lds + PG8_SA(b, h) + aoff + m * 2048 + k * 1024); } while (0)
#define PG8_LDB(dst, b, h) do { _Pragma("unroll") for (int n = 0; n < 2; ++n) _Pragma("unroll") for (int k = 0; k < 2; ++k) dst[n][k] = *(const PG8_LAS bf16x8*)(lds + PG8_SB(b, h) + boff + n * 2048 + k * 1024); } while (0)
#define PG8_MMA(ai, bj, At, Bt) do { __builtin_amdgcn_s_setprio(1); _Pragma("unroll") for (int m = 0; m < 4; ++m) _Pragma("unroll") for (int n = 0; n < 2; ++n) _Pragma("unroll") for (int k = 0; k < 2; ++k) \
        acc[ai][bj][m][n] = __builtin_amdgcn_mfma_f32_16x16x32_bf16(Bt[n][k], At[m][k], acc[ai][bj][m][n], 0, 0, 0); __builtin_amdgcn_s_setprio(0); } while (0)
#define PG8_WAIT_V(n) asm volatile("s_waitcnt vmcnt(" #n ")" ::: "memory")
#define PG8_WAIT_L(n) asm volatile("s_waitcnt lgkmcnt(" #n ")" ::: "memory")
#define PG8_BAR __builtin_amdgcn_s_barrier()
#define PG8_SCHED __builtin_amdgcn_sched_barrier(0)
    Unit cur, nxt; int ui = 0;
    if (!S.next(0, cur)) return;
    f32x4 acc[2][2][4][2];
#pragma unroll
    for (int a = 0; a < 2; ++a)
#pragma unroll
        for (int b = 0; b < 2; ++b)
#pragma unroll
            for (int m = 0; m < 4; ++m)
#pragma unroll
                for (int n = 0; n < 2; ++n) acc[a][b][m][n] = (f32x4){0.f, 0.f, 0.f, 0.f};
    bf16x8 At[4][2], B0[2][2], B1[2][2];
    const char* cA = (const char*)g.A + (size_t)cur.pm * tstepA; const char* cB = (const char*)g.Bt + (size_t)cur.pn * tstepB;
    S.a_ready(cur);
    if constexpr (Epi::PERMA) E.prefetch(cur, 0, wave_s);
    if constexpr (SP2) {
        PG8_STAGE(PG8_SB(0, 0), cB, voffB); PG8_STAGE(PG8_SB(0, 1), cB + hstepB, voffB); PG8_STAGE(PG8_SA(0, 0), cA, voffA); PG8_STAGE(PG8_SA(0, 1), cA + hstepA, voffA);
        if (wr == 1) PG8_BAR;
        PG8_WAIT_V(2); PG8_BAR;
        PG8_STAGE(PG8_SB(1, 0), cB + kstep, voffB); PG8_STAGE(PG8_SA(1, 0), cA + kstep, voffA); PG8_STAGE(PG8_SB(1, 1), cB + hstepB + kstep, voffB);
        PG8_WAIT_V(6); PG8_BAR;
    } else {
        PG8_STAGE(PG8_SB(0, 0), cB, voffB); PG8_STAGE(PG8_SA(0, 0), cA, voffA); PG8_STAGE(PG8_SB(0, 1), cB + hstepB, voffB); PG8_STAGE(PG8_SA(0, 1), cA + hstepA, voffA);
        if (wr == 1) PG8_BAR;
        PG8_WAIT_V(4); PG8_BAR;
        PG8_STAGE(PG8_SB(1, 0), cB + kstep, voffB); PG8_STAGE(PG8_SA(1, 0), cA + kstep, voffA); PG8_STAGE(PG8_SB(1, 1), cB + hstepB + kstep, voffB);
        PG8_WAIT_V(6); PG8_BAR;
    }
    for (;;) {
        const bool has_next = S.next(ui + 1, nxt);
        const char* nA = has_next ? (const char*)g.A + (size_t)nxt.pm * tstepA : cA; const char* nB = has_next ? (const char*)g.Bt + (size_t)nxt.pn * tstepB : cB;
        for (int t = 0; t < nt; t += 2) {
            const bool last = (t == nt - 2);
            const char* a1 = cA + (size_t)(t + 1) * kstep;
            const char* a2 = last ? nA : cA + (size_t)(t + 2) * kstep; const char* b2 = last ? nB : cB + (size_t)(t + 2) * kstep;
            const char* a3 = a2 + kstep; const char* b3 = b2 + kstep;
            if (last && has_next) S.a_ready(nxt);
            if constexpr (SP2) {
            PG8_LDB(B0, 0, 0); PG8_LDB(B1, 0, 1); PG8_SCHED; PG8_LDA(At, 0, 0); PG8_STAGE(PG8_SA(1, 1), a1 + hstepA, voffA);
            PG8_WAIT_V(8); PG8_WAIT_L(0); PG8_BAR; PG8_MMA(0, 0, At, B0); PG8_MMA(0, 1, At, B1); PG8_BAR; PG8_SCHED;
            PG8_LDA(At, 0, 1); PG8_STAGE(PG8_SB(0, 0), b2, voffB); PG8_STAGE(PG8_SB(0, 1), b2 + hstepB, voffB); PG8_STAGE(PG8_SA(0, 0), a2, voffA);
            PG8_WAIT_V(8); PG8_WAIT_L(0); PG8_BAR; PG8_MMA(1, 0, At, B0); PG8_MMA(1, 1, At, B1); PG8_BAR; PG8_SCHED;
            PG8_LDB(B0, 1, 0); PG8_LDB(B1, 1, 1); PG8_SCHED; PG8_LDA(At, 1, 0); PG8_STAGE(PG8_SA(0, 1), a2 + hstepA, voffA);
            PG8_WAIT_V(8); PG8_WAIT_L(0); PG8_BAR; PG8_MMA(0, 0, At, B0); PG8_MMA(0, 1, At, B1); PG8_BAR; PG8_SCHED;
            PG8_LDA(At, 1, 1); PG8_STAGE(PG8_SB(1, 0), b3, voffB); PG8_STAGE(PG8_SB(1, 1), b3 + hstepB, voffB); PG8_STAGE(PG8_SA(1, 0), a3, voffA);
            PG8_WAIT_V(8); PG8_WAIT_L(0); PG8_BAR; PG8_MMA(1, 0, At, B0); PG8_MMA(1, 1, At, B1); PG8_BAR; PG8_SCHED;
            } else {
            PG8_LDB(B0, 0, 0); PG8_SCHED; PG8_LDA(At, 0, 0); PG8_STAGE(PG8_SA(1, 1), a1 + hstepA, voffA);
            PG8_WAIT_L(8); PG8_BAR; PG8_WAIT_L(0); PG8_MMA(0, 0, At, B0); PG8_BAR; PG8_SCHED;
            PG8_LDB(B1, 0, 1); PG8_STAGE(PG8_SB(0, 0), b2, voffB);
            PG8_BAR; PG8_WAIT_L(0); PG8_MMA(0, 1, At, B1); PG8_BAR;
            PG8_LDA(At, 0, 1); PG8_STAGE(PG8_SA(0, 0), a2, voffA);
            PG8_BAR; PG8_WAIT_L(0); PG8_MMA(1, 0, At, B0); PG8_BAR; PG8_SCHED;
            PG8_STAGE(PG8_SB(0, 1), b2 + hstepB, voffB);
            PG8_WAIT_V(6); PG8_BAR; PG8_MMA(1, 1, At, B1); PG8_BAR;
            PG8_LDB(B0, 1, 0); PG8_SCHED; PG8_LDA(At, 1, 0); PG8_STAGE(PG8_SA(0, 1), a2 + hstepA, voffA);
            PG8_WAIT_L(8); PG8_BAR; PG8_WAIT_L(0); PG8_MMA(0, 0, At, B0); PG8_BAR; PG8_SCHED;
            PG8_LDB(B1, 1, 1); PG8_STAGE(PG8_SB(1, 0), b3, voffB);
            PG8_BAR; PG8_WAIT_L(0); PG8_MMA(0, 1, At, B1); PG8_BAR;
            PG8_LDA(At, 1, 1); PG8_STAGE(PG8_SA(1, 0), a3, voffA);
            PG8_BAR; PG8_WAIT_L(0); PG8_MMA(1, 0, At, B0); PG8_BAR; PG8_SCHED;
            PG8_STAGE(PG8_SB(1, 1), b3 + hstepB, voffB);
            PG8_WAIT_V(6); PG8_BAR; PG8_MMA(1, 1, At, B1); PG8_BAR;
            }
        }
        if constexpr (ALIGN_EPI) { if (wr == 0) PG8_BAR; }
        if constexpr (Epi::PERMA) { E.run(acc, cur, nxt, has_next, ui & 1, wr, wc, wave_s); S.done(cur); }
        else if constexpr (!Epi::AFTER_DRAIN) { E(acc, cur, wr, wc, fr, fq); S.done(cur); }
        if (!has_next) break;
#pragma unroll
        for (int a = 0; a < 2; ++a)
#pragma unroll
            for (int b = 0; b < 2; ++b)
#pragma unroll
                for (int m = 0; m < 4; ++m)
#pragma unroll
                    for (int n = 0; n < 2; ++n) acc[a][b][m][n] = (f32x4){0.f, 0.f, 0.f, 0.f};
        cur = nxt; cA = nA; cB = nB; ++ui;
        if constexpr (ALIGN_EPI) { if (wr == 1) PG8_BAR; }
    }
    PG8_WAIT_V(0);
    if constexpr (!ALIGN_EPI) { if (wr == 0) PG8_BAR; }
    PG8_BAR;
    if constexpr (Epi::AFTER_DRAIN) { E.fused(acc, cur, wr, wc, fr, fq, lds, wid, lane); S.done(cur); }
#undef PG8_SA
#undef PG8_SB
#undef PG8_STAGE
#undef PG8_LDA
#undef PG8_LDB
#undef PG8_MMA
#undef PG8_WAIT_V
#undef PG8_WAIT_L
#undef PG8_BAR
#undef PG8_SCHED
}
}
constexpr int NWAVES = 8;
template <class RowMap>
__device__ __forceinline__ void transpose_item(const float* __restrict__ W, int K, int N, bf16_t* WT, const float* __restrict__ kscale, RowMap rm, LAS float* scr, int item, int lane) {
    const int nblk = (N + 31) / 32, kb = item / nblk, nb = item % nblk, k0 = 64 * kb, n0 = 32 * nb;
    const int nr = n0 + (lane & 31);
    float v[32];
#pragma unroll
    for (int i = 0; i < 32; ++i) { const int kk = 2 * i + (lane >> 5); v[i] = (nr < N) ? __builtin_nontemporal_load(W + (size_t)(k0 + kk) * N + nr) : 0.f; }
    if (kscale) {
#pragma unroll
        for (int i = 0; i < 32; ++i) v[i] *= kscale[k0 + 2 * i + (lane >> 5)];
    }
#pragma unroll
    for (int i = 0; i < 32; ++i) scr[(2 * i + (lane >> 5)) * 33 + (lane & 31)] = v[i];
    asm volatile("s_waitcnt lgkmcnt(0)" ::: "memory");
    const int c = lane & 7;
#pragma unroll
    for (int j = 0; j < 4; ++j) { const int nl = (lane >> 3) + 8 * j, n = n0 + nl;
        if (n < N) { const LAS float* s = scr + (8 * c) * 33 + nl;
            u32x4_t o; o.x = pk2(s[0 * 33], s[1 * 33]); o.y = pk2(s[2 * 33], s[3 * 33]); o.z = pk2(s[4 * 33], s[5 * 33]); o.w = pk2(s[6 * 33], s[7 * 33]);
            *(u32x4_t*)(WT + (size_t)rm(n) * K + k0 + 8 * c) = o; } }
    asm volatile("s_waitcnt lgkmcnt(0)" ::: "memory");
}
struct RmIdent { __device__ __forceinline__ int operator()(int n) const { return n; } };
struct RmWin {
    __device__ __forceinline__ int operator()(int c) const {
        const int nc = c < 2560 ? c : (c < 2608 ? 4608 + (c - 2560) : 2560 + (c - 2608));
        const int tile = nc >> 8, L = nc & 255, wc = L >> 6, bj = (L >> 5) & 1, j = L & 31;
        return tile * 256 + 128 * bj + 32 * wc + j;
    }
};
struct RmWup {
    __device__ __forceinline__ int operator()(int c) const { const int up = c >= D_FF, cc = up ? c - D_FF : c; return (cc >> 7) * 256 + up * 128 + (cc & 127); }
};

struct Ptrs {
    const float* in[18]; float* out; unsigned char* ws;
};

__device__ __forceinline__ void p0_prologue(const Ptrs& P, LAS unsigned char* lds, int vcu, int G, const int wave) {
    const int lane = fresh_lane();
    LAS float* scr = (LAS float*)(lds + wave * 16384);
    const int gw = vcu * NWAVES + wave, NGW = G * NWAVES;
    unsigned char* ws = P.ws;
    bf16_t* WinT = (bf16_t*)(ws + WS_WIN); bf16_t* WoutT = (bf16_t*)(ws + WS_WOUT); bf16_t* WupT = (bf16_t*)(ws + WS_WUP); bf16_t* WdownT = (bf16_t*)(ws + WS_WDOWN); bf16_t* W1cT = (bf16_t*)(ws + WS_W1C);
    const float* x = P.in[0]; const float* attn_norm_w = P.in[1]; const float* w_in = P.in[2]; const float* cmp_pos = P.in[5]; const float* cmp_w1 = P.in[6];
    const float* w_out = P.in[12]; const float* ffn_norm_w = P.in[13]; const float* w_up = P.in[14]; const float* w_down = P.in[17];
    constexpr int I_IN = 32 * 146, I_W1 = 32 * 8, I_W2 = 4 * 2;
    constexpr int NITEMS = I_IN + 2 * I_W1 + 2 * I_W2;
    (void)w_out; (void)w_up; (void)w_down; (void)ffn_norm_w; (void)WoutT; (void)WupT; (void)WdownT;
    for (int it = gw; it < NITEMS; it += NGW) {
        int r = it;
        if (r < I_IN) { transpose_item(w_in, 2048, IN_COLS, WinT, nullptr, RmWin(), scr, r, lane); continue; } r -= I_IN;
        if (r < I_W1) { transpose_item(cmp_w1, 2048, 256, W1cT, nullptr, RmIdent(), scr, r, lane); continue; } r -= I_W1;
        if (r < I_W1) { transpose_item(cmp_w1 + (size_t)2048 * 256, 2048, 256, W1cT + (size_t)256 * 2048, nullptr, RmIdent(), scr, r, lane); continue; } r -= I_W1;
        { const int kv = r >= I_W2 ? 1 : 0; transpose_item(P.in[7] + (size_t)kv * 256 * 64, 256, 64, (bf16_t*)(ws + WS_SMALL + SM_W2T) + (size_t)kv * 64 * 256, nullptr, RmIdent(), scr, r - kv * I_W2, lane); }
    }
    for (int i = gw * 64 + lane; i < 8 * 16384; i += NGW * 64) { const int t = (i >> 7) & 127, sx = i & 127; ((bf16_t*)(ws + WS_SMALL + SM_SWB))[i] = (bf16_t)(sx <= t ? f2bf(P.in[10][i]) : 0u); }
    for (int p = gw; p < 256; p += NGW) {
        const int L = 64 * ((p >> 5) & 3) + 32 * (p >> 7) + (p & 31);
        if (L >= 48) { u32x4_t z = {0u, 0u, 0u, 0u}; u32x4_t* d = (u32x4_t*)(WinT + (size_t)(18 * 256 + p) * 2048);
#pragma unroll
            for (int j = 0; j < 4; ++j) d[lane + 64 * j] = z; }
    }
    bf16_t* XN = (bf16_t*)(ws + WS_XN);
    for (int m = gw; m < MTOK; m += 2 * NGW) {
        const int m2 = m + NGW;
        const f32x4_t* xr = (const f32x4_t*)(x + (size_t)m * D_MODEL) + lane;
        const f32x4_t* xr2 = (const f32x4_t*)(x + (size_t)(m2 < MTOK ? m2 : m) * D_MODEL) + lane;
        f32x4_t v[8], v2[8]; float s = 0.f, s2 = 0.f;
#pragma unroll
        for (int j = 0; j < 8; ++j) { v[j] = __builtin_nontemporal_load(xr + 64 * j); v2[j] = __builtin_nontemporal_load(xr2 + 64 * j); }
#pragma unroll
        for (int j = 0; j < 8; ++j) { s += (v[j][0] * v[j][0] + v[j][1] * v[j][1]) + (v[j][2] * v[j][2] + v[j][3] * v[j][3]); s2 += (v2[j][0] * v2[j][0] + v2[j][1] * v2[j][1]) + (v2[j][2] * v2[j][2] + v2[j][3] * v2[j][3]); }
        const float ms1 = wave_sum(s) * (1.0f / D_MODEL) + 1e-6f, ms2 = wave_sum(s2) * (1.0f / D_MODEL) + 1e-6f;
        const float r = __builtin_amdgcn_rsqf(ms1), r2 = __builtin_amdgcn_rsqf(ms2);
        if (lane == 0) { float* rinv = (float*)(ws + WS_SMALL + SM_RINV); rinv[m] = ms1 * r; if (m2 < MTOK) rinv[m2] = ms2 * r2; }
        u32x2_t* o8 = (u32x2_t*)(XN + (size_t)m * D_MODEL) + lane; u32x2_t* o82 = (u32x2_t*)(XN + (size_t)m2 * D_MODEL) + lane;
#pragma unroll
        for (int j = 0; j < 8; ++j) { const f32x4_t w = ((const f32x4_t*)attn_norm_w)[lane + 64 * j];
            u32x2_t o; o.x = pk2(v[j][0] * r * w[0], v[j][1] * r * w[1]); o.y = pk2(v[j][2] * r * w[2], v[j][3] * r * w[3]); o8[64 * j] = o;
            if (m2 < MTOK) { u32x2_t q; q.x = pk2(v2[j][0] * r2 * w[0], v2[j][1] * r2 * w[1]); q.y = pk2(v2[j][2] * r2 * w[2], v2[j][3] * r2 * w[3]); o82[64 * j] = q; } }
    }
    for (int i = gw * 64 + lane; i < D_MODEL; i += NGW * 64) ((float*)(ws + WS_SMALL + SM_INVW))[i] = 1.0f / attn_norm_w[i];
    float* BIASP = (float*)(ws + WS_SMALL + SM_BIASP);
    for (int it = gw; it < 64; it += NGW) {
        const int kv = it >> 5, kc = it & 31; f32x4_t a = {0.f, 0.f, 0.f, 0.f};
        const float* pp = cmp_pos + kv * 2048 + kc * 64; const float* w1 = cmp_w1 + ((size_t)kv * 2048 + kc * 64) * 256;
        for (int k = 0; k < 64; ++k) { const f32x4_t w = ((const f32x4_t*)(w1 + (size_t)k * 256))[lane]; a += w * pp[k]; }
        ((f32x4_t*)(BIASP + (size_t)it * 256))[lane] = a;
    }
}

__device__ __forceinline__ void bias1_stage(unsigned char* ws, int idx  ) {
    const float* BIASP = (const float*)(ws + WS_SMALL + SM_BIASP); float* BIAS1 = (float*)(ws + WS_SMALL + SM_BIAS1);
    const int kv = idx >> 8, j = idx & 255; float s = 0.f;
    for (int kc = 0; kc < 32; ++kc) s += BIASP[(size_t)(kv * 32 + kc) * 256 + j];
    BIAS1[idx] = s;
}
__device__ __forceinline__ void cmp2_row(const Ptrs& P, int R, int lane) {
    unsigned char* ws = P.ws; const bf16_t* HC = (const bf16_t*)(ws + WS_HC);
    const int kv = R >> 12, rr = R & 4095, n = rr & 255;
    bf16_t* dst = (bf16_t*)(ws + (kv ? WS_VC : WS_KC)) + (size_t)rr * 64 + lane;
    if (n == 255) { *dst = 0; return; }
    const float* w2 = P.in[7] + (size_t)kv * 256 * 64;
    const u32x2_t hr = *(const u32x2_t*)(HC + (size_t)R * 256 + 4 * lane);
    float h[4] = {__uint_as_float(hr.x << 16), __uint_as_float(hr.x & 0xffff0000u), __uint_as_float(hr.y << 16), __uint_as_float(hr.y & 0xffff0000u)};
    float o = 0.f;
    for (int jj = 0; jj < 64; ++jj) {
#pragma unroll
        for (int i = 0; i < 4; ++i) o += __shfl(h[i], jj) * w2[(size_t)(4 * jj + i) * 64 + lane];
    }
    if (kv == 0) { const float ss = wave_sum(o * o); o *= __builtin_amdgcn_rsqf(ss * (1.0f / 64.0f) + 1e-6f) * P.in[4][lane]; }
    *dst = (bf16_t)f2bf(o);
}

__device__ __forceinline__ void gmlp_unit_v1(const Ptrs& P, LAS unsigned char* lds, int unit, const int wave_s) {
    unsigned char* ws = P.ws; const int tid = fresh_tid(wave_s);
    const int g = unit & 7, chunk = (unit >> 3) & 31, b = unit >> 8; const int m0 = b * SEQ + chunk * 128;
    LAS float* vn = (LAS float*)lds; LAS float* Wl = (LAS float*)(lds + 65536); LAS float* st = (LAS float*)(lds + 131072);
    const bf16_t* GV = (const bf16_t*)(ws + WS_GV); const bf16_t* U = (const bf16_t*)(ws + WS_U); const float* VSTAT = (const float*)(ws + WS_VSTAT);
    bf16_t* AB = (bf16_t*)(ws + WS_AB);
    const float* ln_w = P.in[8]; const float* ln_b = P.in[9]; const float* sw = P.in[10]; const float* sb = P.in[11];
    if (tid < 128) { const float* p = VSTAT + (size_t)(m0 + tid) * 32; float s1 = 0.f, s2 = 0.f;
#pragma unroll
        for (int i = 0; i < 16; ++i) { s1 += p[2 * i]; s2 += p[2 * i + 1]; }
        const float mean = s1 * (1.0f / 1024.0f); float var = s2 * (1.0f / 1024.0f) - mean * mean; var = var < 0.f ? 0.f : var;
        st[2 * tid] = mean; st[2 * tid + 1] = __builtin_amdgcn_rsqf(var + 1e-5f); }
    for (int i = 0; i < 32; ++i) { const int idx = tid + 512 * i, t = idx >> 7, s = idx & 127; Wl[idx] = (s <= t) ? sw[(size_t)g * 16384 + idx] : 0.f; }
    __syncthreads();
#pragma unroll
    for (int i = 0; i < 4; ++i) { const int idx = tid + 512 * i, s = idx >> 4, c8 = idx & 15;
        const u32x4_t raw = *(const u32x4_t*)(GV + (size_t)(m0 + s) * 1024 + g * 128 + 8 * c8); float f[8]; unpack8(raw, f);
        const float mean = st[2 * s], rstd = st[2 * s + 1];
#pragma unroll
        for (int e = 0; e < 8; ++e) { const int c = g * 128 + 8 * c8 + e; vn[s * 128 + 8 * c8 + e] = (f[e] - mean) * rstd * ln_w[c] + ln_b[c]; } }
    __syncthreads();
    const int c = tid & 127, tq = tid >> 7;
    for (int i = 0; i < 8; ++i) {
        const int t0 = 4 * (tq + 4 * i); float a0 = 0.f, a1 = 0.f, a2 = 0.f, a3 = 0.f;
        for (int s4 = 0; s4 <= t0; s4 += 4) {
            const f32x4_t w0 = *(const LAS f32x4_t*)(Wl + (t0 + 0) * 128 + s4), w1 = *(const LAS f32x4_t*)(Wl + (t0 + 1) * 128 + s4), w2 = *(const LAS f32x4_t*)(Wl + (t0 + 2) * 128 + s4), w3 = *(const LAS f32x4_t*)(Wl + (t0 + 3) * 128 + s4);
#pragma unroll
            for (int k = 0; k < 4; ++k) { const float v = vn[(s4 + k) * 128 + c]; a0 += w0[k] * v; a1 += w1[k] * v; a2 += w2[k] * v; a3 += w3[k] * v; }
        }
        const float av[4] = {a0, a1, a2, a3};
#pragma unroll
        for (int k = 0; k < 4; ++k) { const int t = t0 + k; const size_t row = (size_t)(m0 + t);
            const float uu = bf2f(U[row * 1024 + g * 128 + c]); AB[row * 2048 + 1024 + g * 128 + c] = (bf16_t)f2bf(uu * (av[k] + sb[g * 128 + t])); }
    }
    __syncthreads();
}

__device__ __forceinline__ void conv_item(const Ptrs& P, int b, int idx) {
    const int t = idx / 704, c8 = idx % 704, c0 = 8 * c8, j = c0 >> 7, i0 = c0 & 127;
    const bf16_t* HID = (const bf16_t*)(P.ws + WS_HID); const float* cw = P.in[15]; const float* cb = P.in[16];
    float gt[8], up[8];
#pragma unroll
    for (int e = 0; e < 8; ++e) { gt[e] = cb[c0 + e]; up[e] = cb[D_FF + c0 + e]; }
#pragma unroll
    for (int k = 0; k < 3; ++k) { const int tt = t - 2 + k; if (tt < 0) continue;
        float hg[8], hu[8]; unpack8(*(const u32x4_t*)(HID + (size_t)tt * N_UP + 256 * j + i0), hg); unpack8(*(const u32x4_t*)(HID + (size_t)tt * N_UP + 256 * j + 128 + i0), hu);
#pragma unroll
        for (int e = 0; e < 8; ++e) { gt[e] += cw[(size_t)k * N_UP + c0 + e] * hg[e]; up[e] += cw[(size_t)k * N_UP + D_FF + c0 + e] * hu[e]; } }
    float r[8];
#pragma unroll
    for (int e = 0; e < 8; ++e) r[e] = gt[e] * sigmoidf_(gt[e]) * up[e];
    u32x4_t o; o.x = pk2(r[0], r[1]); o.y = pk2(r[2], r[3]); o.z = pk2(r[4], r[5]); o.w = pk2(r[6], r[7]);
    *(u32x4_t*)((bf16_t*)(P.ws + WS_G) + ((size_t)b * SEQ + t) * D_FF + c0) = o;
}

constexpr int LW_CH = 32;
constexpr int LW_OUT = 32 * 64, LW_UP = 32 * 352, LW_DOWN = 88 * 64, LW_C_OUT = LW_OUT / LW_CH, LW_C_UP = LW_UP / LW_CH, LW_C_DOWN = LW_DOWN / LW_CH, LW_CHUNKS = LW_C_OUT + LW_C_UP + LW_C_DOWN;
static_assert(LW_OUT % LW_CH == 0 && LW_UP % LW_CH == 0 && LW_DOWN % LW_CH == 0, "late weight items per chunk");
template <class RowMap>
__device__ __forceinline__ void lw_load(float (&v)[32], const float* __restrict__ W, int N, int item, int lane) {
    const int nblk = N / 32, kb = item / nblk, nb = item % nblk;
    const float* p = W + (size_t)(64 * kb + (lane >> 5)) * N + 32 * nb + (lane & 31);
#pragma unroll
    for (int i = 0; i < 32; ++i) v[i] = __builtin_nontemporal_load(p + (size_t)(2 * i) * N);
}
template <class RowMap>
__device__ __forceinline__ void lw_store(const float (&v)[32], int K, int N, bf16_t* WT, const float* __restrict__ kscale, RowMap rm, LAS float* scr, int item, int lane) {
    const int nblk = N / 32, kb = item / nblk, nb = item % nblk, k0 = 64 * kb, n0 = 32 * nb;
    const int c = lane & 7;
    f32x4_t sc0 = {1.f, 1.f, 1.f, 1.f}, sc1 = sc0;
    if (kscale) { sc0 = *(const f32x4_t*)(kscale + k0 + 8 * c); sc1 = *(const f32x4_t*)(kscale + k0 + 8 * c + 4); }
#pragma unroll
    for (int i = 0; i < 32; ++i) scr[(2 * i + (lane >> 5)) * 33 + (lane & 31)] = v[i];
    asm volatile("s_waitcnt lgkmcnt(0)" ::: "memory");
#pragma unroll
    for (int j = 0; j < 4; ++j) { const int nl = (lane >> 3) + 8 * j; const LAS float* s = scr + (8 * c) * 33 + nl;
        u32x4_t o; o.x = pk2(s[0 * 33] * sc0[0], s[1 * 33] * sc0[1]); o.y = pk2(s[2 * 33] * sc0[2], s[3 * 33] * sc0[3]); o.z = pk2(s[4 * 33] * sc1[0], s[5 * 33] * sc1[1]); o.w = pk2(s[6 * 33] * sc1[2], s[7 * 33] * sc1[3]);
        *(u32x4_t*)(WT + (size_t)rm(n0 + nl) * K + k0 + 8 * c) = o; }
    asm volatile("s_waitcnt lgkmcnt(0)" ::: "memory");
}
template <class RowMap>
__device__ __forceinline__ void lw_run(const float* __restrict__ W, int K, int N, bf16_t* WT, const float* __restrict__ kscale, RowMap rm, LAS float* scr, int item0, int wave, int lane) {
    float va[32], vb[32];
    lw_load<RowMap>(va, W, N, item0 + wave, lane);
    lw_load<RowMap>(vb, W, N, item0 + wave + 8, lane);  lw_store(va, K, N, WT, kscale, rm, scr, item0 + wave, lane);
    lw_load<RowMap>(va, W, N, item0 + wave + 16, lane); lw_store(vb, K, N, WT, kscale, rm, scr, item0 + wave + 8, lane);
    lw_load<RowMap>(vb, W, N, item0 + wave + 24, lane); lw_store(va, K, N, WT, kscale, rm, scr, item0 + wave + 16, lane);
    lw_store(vb, K, N, WT, kscale, rm, scr, item0 + wave + 24, lane);
}
__device__ __forceinline__ void late_weight_chunk(const Ptrs& P, LAS unsigned char* lds, int chunk, const int wave) {
    const int lane = fresh_lane();
    LAS float* scr = (LAS float*)(lds + wave * 16384);
    unsigned char* ws = P.ws;
    if (chunk < LW_C_UP) lw_run(P.in[14], 2048, N_UP, (bf16_t*)(ws + WS_WUP), P.in[13], RmWup(), scr, chunk * LW_CH, wave, lane);
    else if (chunk < LW_C_UP + LW_C_DOWN) lw_run(P.in[17], D_FF, 2048, (bf16_t*)(ws + WS_WDOWN), nullptr, RmIdent(), scr, (chunk - LW_C_UP) * LW_CH, wave, lane);
    else lw_run(P.in[12], 2048, 2048, (bf16_t*)(ws + WS_WOUT), nullptr, RmIdent(), scr, (chunk - LW_C_UP - LW_C_DOWN) * LW_CH, wave, lane);
}

namespace nsa {
using bf16x8 = __attribute__((ext_vector_type(8))) short;
using s16x4 = __attribute__((ext_vector_type(4))) short;
using f32x16 = __attribute__((ext_vector_type(16))) float;
typedef float f32x2_t __attribute__((ext_vector_type(2))); typedef __bf16 bf16x2_t __attribute__((ext_vector_type(2)));
constexpr int L_K = 0, L_V = 16384, L_WSF = 32768, L_OST = 34816, L_IMP = 100352, L_MASK = 116736, L_WU = 117248, L_END = 117312;
constexpr int SLOTB = 8192;
constexpr float THR = 8.0f;
#define NSA_SBAR() __builtin_amdgcn_sched_barrier(0)
__device__ __forceinline__ int crow(int r, int hi) { return (r & 3) + 8 * (r >> 2) + 4 * hi; }
__device__ __forceinline__ void glds16(const void* gbase  , unsigned voff  , unsigned lds_dst) { unsigned keep;
    asm volatile("s_mov_b32 %0, m0\n\ts_mov_b32 m0, %3\n\ts_nop 0\n\tglobal_load_lds_dwordx4 %1, %2\n\ts_mov_b32 m0, %0" : "=&s"(keep) : "v"(voff), "s"(gbase), "s"(lds_dst) : "memory"); }
__device__ __forceinline__ unsigned cvtpk_s(float lo, float hi) { f32x2_t v = {lo, hi}; bf16x2_t b = __builtin_convertvector(v, bf16x2_t); return __builtin_bit_cast(unsigned, b); }
#define NSA_WAIT_BAR() asm volatile("s_waitcnt vmcnt(0) lgkmcnt(0)\n\ts_barrier" ::: "memory")

__device__ __forceinline__ void qkt(f32x16& p0, f32x16& p1, LAS const char* Kslot, const bf16x8 (&qr)[4], int r32, int hi) {
    LAS const char* kb = Kslot + hi * 1024 + r32 * 16;
#pragma unroll
    for (int d0 = 0; d0 < 4; ++d0) {
        const bf16x8 b0 = *(LAS const bf16x8*)(kb + d0 * 2048);
        const bf16x8 b1 = *(LAS const bf16x8*)(kb + d0 * 2048 + 512);
        p0 = __builtin_amdgcn_mfma_f32_32x32x16_bf16(b0, qr[d0], p0, 0, 0, 0); p1 = __builtin_amdgcn_mfma_f32_32x32x16_bf16(b1, qr[d0], p1, 0, 0, 0);
    }
}
struct VFrag { s16x4 lo[2][4], hi[2][4]; };
__device__ __forceinline__ void vload(VFrag& f, int vb) {
#pragma unroll
    for (int d0 = 0; d0 < 2; ++d0)
#pragma unroll
        for (int ks = 0; ks < 4; ++ks) {
            asm volatile("ds_read_b64_tr_b16 %0,%1 offset:%c2" : "=&v"(f.lo[d0][ks]) : "v"(vb), "i"(d0 * 4096 + ks * 1024) : "memory");
            asm volatile("ds_read_b64_tr_b16 %0,%1 offset:%c2" : "=&v"(f.hi[d0][ks]) : "v"(vb), "i"(d0 * 4096 + ks * 1024 + 512) : "memory"); }
}
__device__ __forceinline__ void pvmma(f32x16 (&o)[2], VFrag& f, bf16x8 pa0, bf16x8 pa1, bf16x8 pa2, bf16x8 pa3) {
    asm volatile("s_waitcnt lgkmcnt(0)" : "+v"(f.lo[0][0]), "+v"(f.lo[0][1]), "+v"(f.lo[0][2]), "+v"(f.lo[0][3]), "+v"(f.hi[0][0]), "+v"(f.hi[0][1]), "+v"(f.hi[0][2]), "+v"(f.hi[0][3]) :: "memory");
    asm volatile("" : "+v"(f.lo[1][0]), "+v"(f.lo[1][1]), "+v"(f.lo[1][2]), "+v"(f.lo[1][3]), "+v"(f.hi[1][0]), "+v"(f.hi[1][1]), "+v"(f.hi[1][2]), "+v"(f.hi[1][3]));
    NSA_SBAR();
#pragma unroll
    for (int d0 = 0; d0 < 2; ++d0) {
#define NSA_PK(k) (bf16x8){f.lo[d0][k][0], f.lo[d0][k][1], f.lo[d0][k][2], f.lo[d0][k][3], f.hi[d0][k][0], f.hi[d0][k][1], f.hi[d0][k][2], f.hi[d0][k][3]}
        o[d0] = __builtin_amdgcn_mfma_f32_32x32x16_bf16(pa0, NSA_PK(0), o[d0], 0, 0, 0);
        o[d0] = __builtin_amdgcn_mfma_f32_32x32x16_bf16(pa1, NSA_PK(1), o[d0], 0, 0, 0);
        o[d0] = __builtin_amdgcn_mfma_f32_32x32x16_bf16(pa2, NSA_PK(2), o[d0], 0, 0, 0);
        o[d0] = __builtin_amdgcn_mfma_f32_32x32x16_bf16(pa3, NSA_PK(3), o[d0], 0, 0, 0);
#undef NSA_PK
    }
}
__device__ __forceinline__ void pv(f32x16 (&o)[2], int vb, bf16x8 pa0, bf16x8 pa1, bf16x8 pa2, bf16x8 pa3) { VFrag f; vload(f, vb); pvmma(o, f, pa0, pa1, pa2, pa3); }
__device__ __forceinline__ float rowmax32(const f32x16& p0, const f32x16& p1) {
    float a = __builtin_fmaxf(p0[0], p1[0]);
#pragma unroll
    for (int r = 1; r < 16; ++r) a = __builtin_fmaxf(a, __builtin_fmaxf(p0[r], p1[r]));
    auto rr = __builtin_amdgcn_permlane32_swap(__float_as_uint(a), __float_as_uint(a), false, false);
    return __builtin_fmaxf(__uint_as_float(rr[0]), __uint_as_float(rr[1]));
}
struct State { float m, l; f32x16 o[2]; };
__device__ __forceinline__ void state_init(State& s) { s.m = -1e30f; s.l = 0.f; s.o[0] = f32x16{}; s.o[1] = f32x16{}; }

template <int BMUL, int MASK, bool LOADV>
__device__ __forceinline__ void tile_scores(f32x16& p0, f32x16& p1, LAS const char* Kslot, const bf16x8 (&qr)[4], const f32x16& bk, float c0, float b32, int lim, int r32, int hi, VFrag& vf, int vb) {
#pragma unroll
    for (int r = 0; r < 16; ++r) { const float b = (BMUL == 1) ? bk[r] + c0 : __builtin_fmaf(bk[r], (float)BMUL, c0); p0[r] = b; p1[r] = b + b32; }
    qkt(p0, p1, Kslot, qr, r32, hi);
    if (LOADV) vload(vf, vb);
    const int limh = lim - 4 * hi;
#pragma unroll
    for (int r = 0; r < 16; ++r) {
        const int kk = (r & 3) + 8 * (r >> 2);
        if (MASK == 1) { if (!(kk <= limh)) p0[r] = -INFINITY; if (!(kk + 32 <= limh)) p1[r] = -INFINITY; }
        if (MASK == 2) { if (!(kk > limh)) p0[r] = -INFINITY; if (!(kk + 32 > limh)) p1[r] = -INFINITY; }
        if (MASK == 3) { if (!(kk < limh)) p0[r] = -INFINITY; if (!(kk + 32 < limh)) p1[r] = -INFINITY; }
    }
}
__device__ __forceinline__ float tile_ref(const State& st, float rb0, bool rowlive) { return (st.m < -1e29f && rowlive) ? rb0 : st.m; }
__device__ __forceinline__ void tile_softmax_pv(State& st, f32x16& p0, f32x16& p1, float mref, VFrag& vf, LAS float* wsf, int r32, int hi) {
    float a0 = p0[0], a1 = p1[0];
#pragma unroll
    for (int r = 1; r < 16; ++r) { a0 = __builtin_fmaxf(a0, p0[r]); a1 = __builtin_fmaxf(a1, p1[r]); }
    float mx = __builtin_fmaxf(a0, a1);
    { auto rr = __builtin_amdgcn_permlane32_swap(__float_as_uint(mx), __float_as_uint(mx), false, false); mx = __builtin_fmaxf(__uint_as_float(rr[0]), __uint_as_float(rr[1])); }
    if (__any(mx > THR)) {
        const float dl = __builtin_fmaxf(mx, 0.f), alpha = __builtin_amdgcn_exp2f(-dl);
        mref += dl; st.l *= alpha;
        if (hi == 0) wsf[r32] = alpha;
        asm volatile("s_waitcnt lgkmcnt(0)" ::: "memory");
#pragma unroll
        for (int r = 0; r < 16; ++r) { const float a = wsf[crow(r, hi)]; st.o[0][r] *= a; st.o[1][r] *= a; p0[r] -= dl; p1[r] -= dl; }
    }
    st.m = mref;
    float ls = 0.f;
#pragma unroll
    for (int r = 0; r < 16; ++r) { p0[r] = __builtin_amdgcn_exp2f(p0[r]); p1[r] = __builtin_amdgcn_exp2f(p1[r]); ls += p0[r] + p1[r]; }
    st.l += ls;
    u32x4_t pw0, pw1, pw2, pw3;
    pw0 = (u32x4_t){cvtpk_s(p0[0], p0[1]), cvtpk_s(p0[2], p0[3]), cvtpk_s(p0[4], p0[5]), cvtpk_s(p0[6], p0[7])};
    pw1 = (u32x4_t){cvtpk_s(p0[8], p0[9]), cvtpk_s(p0[10], p0[11]), cvtpk_s(p0[12], p0[13]), cvtpk_s(p0[14], p0[15])};
    pw2 = (u32x4_t){cvtpk_s(p1[0], p1[1]), cvtpk_s(p1[2], p1[3]), cvtpk_s(p1[4], p1[5]), cvtpk_s(p1[6], p1[7])};
    pw3 = (u32x4_t){cvtpk_s(p1[8], p1[9]), cvtpk_s(p1[10], p1[11]), cvtpk_s(p1[12], p1[13]), cvtpk_s(p1[14], p1[15])};
    pvmma(st.o, vf, __builtin_bit_cast(bf16x8, pw0), __builtin_bit_cast(bf16x8, pw1), __builtin_bit_cast(bf16x8, pw2), __builtin_bit_cast(bf16x8, pw3));
}
template <bool FIRST>
__device__ __forceinline__ void fold_branch(LAS float* ostg, State& st, float gate, LAS float* wsf, int r32, int hi) {
    float l = st.l;
    { auto rr = __builtin_amdgcn_permlane32_swap(__float_as_uint(l), __float_as_uint(l), false, false); l = __uint_as_float(rr[0]) + __uint_as_float(rr[1]); }
    const float f = l > 0.f ? gate / l : 0.f;
    asm volatile("s_waitcnt lgkmcnt(0)" ::: "memory");
    if (hi == 0) wsf[r32] = f;
    asm volatile("s_waitcnt lgkmcnt(0)" ::: "memory");
#pragma unroll
    for (int r = 0; r < 16; ++r) { const int orow = crow(r, hi); const float a = wsf[orow];
#pragma unroll
        for (int d0 = 0; d0 < 2; ++d0) { LAS float* p = ostg + orow * 64 + d0 * 32 + r32; if (FIRST) *p = st.o[d0][r] * a; else *p += st.o[d0][r] * a; } }
    asm volatile("s_waitcnt lgkmcnt(0)" ::: "memory");
}

__device__ __forceinline__ int nsa_unit(const Ptrs& P, LAS unsigned char* lds, int bg, int qt, const int wave_s, unsigned* qctr, int qbase) {
    unsigned char* ws = P.ws;
    const int lane = fresh_lane(), r32 = lane & 31, hi = lane >> 5; const int wid = wave_s;
    const int b = bg >> 2, g = bg & 3, t0 = 64 * qt;
    const int tl = 8 * wid + (r32 >> 2), hq = r32 & 3;
    const size_t m0 = (size_t)b * SEQ + t0;
    const bf16_t* Q = (const bf16_t*)(ws + WS_Q); const bf16_t* KV6 = (const bf16_t*)(ws + WS_KV6);
    const bf16_t* KSb = KV6 + 2 * KVSZ + (size_t)bg * SEQ * 64; const bf16_t* VSb = KV6 + 3 * KVSZ + (size_t)bg * SEQ * 64;
    const bf16_t* KWb = KV6 + 4 * KVSZ + (size_t)bg * SEQ * 64; const bf16_t* VWb = KV6 + 5 * KVSZ + (size_t)bg * SEQ * 64;
    const bf16_t* KCb = (const bf16_t*)(ws + WS_KC) + (size_t)bg * 256 * 64; const bf16_t* VCb = (const bf16_t*)(ws + WS_VC) + (size_t)bg * 256 * 64;
    const float* GATES = (const float*)(ws + WS_GATES); bf16_t* AB = (bf16_t*)(ws + WS_AB);
    const unsigned lds0 = (unsigned)(uintptr_t)lds;
    LAS float* wsf = (LAS float*)(lds + L_WSF) + wid * 64;
    LAS float* IMP = (LAS float*)(lds + L_IMP);
    LAS unsigned* MASK = (LAS unsigned*)(lds + L_MASK); LAS unsigned* WU = (LAS unsigned*)(lds + L_WU);
    const int koff = lane * 64 + wid * 8, voff = (16 * (wid & 3) + (lane >> 2)) * 64 + (wid >> 2) * 32 + (lane & 3) * 8;
    const unsigned kdst = lds0 + L_K + wid * 1024, vdst = lds0 + L_V + wid * 1024;
#define NSA_DMA_K(base, tile, slot) glds16((base) + (size_t)(tile) * 4096, (unsigned)koff * 2u, (unsigned)__builtin_amdgcn_readfirstlane(kdst + (slot) * SLOTB))
#define NSA_DMA_V(base, tile, slot) glds16((base) + (size_t)(tile) * 4096, (unsigned)voff * 2u, (unsigned)__builtin_amdgcn_readfirstlane(vdst + (slot) * SLOTB))
    const int vb0 = (int)(lds0 + L_V) + ((lane >> 4) & 1) * 32 + (lane & 3) * 8 + (4 * hi + ((lane & 15) >> 2)) * 64;
    LAS const char* Kbase = (LAS const char*)(lds + L_K);
    bf16x8 qr[4];
    { const bf16_t* qp = Q + (m0 + tl) * 1024 + (4 * g + hq) * 64 + hi * 8;
#pragma unroll
      for (int d0 = 0; d0 < 4; ++d0) qr[d0] = *(const bf16x8*)(qp + d0 * 16); }
    const float sl2 = __builtin_amdgcn_exp2f(-0.5f * (float)(4 * g + hq + 1)) * LOG2E;
    f32x16 bk;
#pragma unroll
    for (int r = 0; r < 16; ++r) bk[r] = sl2 * (float)((r & 3) + 8 * (r >> 2));
    const float b32t = 32.0f * sl2, b32c = 512.0f * sl2, hoff_t = 4.0f * (float)hi * sl2, hoff_c = 64.0f * (float)hi * sl2;
    float gate[3];
    { const float* gp = GATES + (m0 + tl) * 48 + (4 * g + hq) * 3; gate[0] = gp[0]; gate[1] = gp[1]; gate[2] = gp[2]; }
    LAS float* ostg = (LAS float*)(lds + L_OST) + wid * 2048;
    State st;
    f32x16 p0, p1;
    int nxt_ticket = 0;

    int tc = 0;
    VFrag vf;
    const int nvmax = (t0 + 63 >= 31) ? ((t0 + 63 - 31) >> 4) + 1 : 0;
    const int nct = (nvmax + 63) >> 6;
    const int tq = t0 + tl, nv = tq >= 31 ? ((tq - 31) >> 4) + 1 : 0;
    {
        state_init(st);
        const int j0 = qt >= 8 ? qt - 8 : 0, nt = qt - j0 + 1;
        NSA_DMA_K(KWb, qt, 0); NSA_DMA_V(VWb, qt, 0); NSA_WAIT_BAR();
        for (int i = 0; i < nt; ++i) {
            const int j = qt - i, slot = (tc + i) & 1;
            if (i + 1 < nt) { NSA_DMA_K(KWb, j - 1, slot ^ 1); NSA_DMA_V(VWb, j - 1, slot ^ 1); }
            else { NSA_DMA_K(KCb, nct - 1, slot ^ 1); NSA_DMA_V(VCb, nct - 1, slot ^ 1); }
            const float rb0 = sl2 * (float)(64 * j - t0), mref = tile_ref(st, rb0, true), c0 = rb0 + hoff_t - mref;
            if (j == qt) tile_scores<1, 1, true>(p0, p1, Kbase + slot * SLOTB, qr, bk, c0, b32t, tl, r32, hi, vf, vb0 + slot * SLOTB);
            else if (j == qt - 8) tile_scores<1, 2, true>(p0, p1, Kbase + slot * SLOTB, qr, bk, c0, b32t, tl, r32, hi, vf, vb0 + slot * SLOTB);
            else tile_scores<1, 0, true>(p0, p1, Kbase + slot * SLOTB, qr, bk, c0, b32t, 0, r32, hi, vf, vb0 + slot * SLOTB);
            tile_softmax_pv(st, p0, p1, mref, vf, wsf, r32, hi);
            NSA_WAIT_BAR();
        }
        tc += nt;
        fold_branch<true>(ostg, st, gate[2], wsf, r32, hi);
    }
    {
        state_init(st);
        for (int ci = 0; ci < nct; ++ci) {
            const int c = nct - 1 - ci, slot = (tc + ci) & 1;
            if (ci + 1 < nct) { NSA_DMA_K(KCb, c - 1, slot ^ 1); NSA_DMA_V(VCb, c - 1, slot ^ 1); }
            else if (qt >= 16) { NSA_DMA_K(KCb, 0, slot ^ 1); }
            else { NSA_DMA_K(KSb, qt, slot ^ 1); NSA_DMA_V(VSb, qt, slot ^ 1); }
            const float rb0 = sl2 * ((float)(1024 * c - t0) + 15.5f), mref = tile_ref(st, rb0, true), c0 = rb0 + hoff_c - mref;
            tile_scores<16, 3, true>(p0, p1, Kbase + slot * SLOTB, qr, bk, c0, b32c, nv - 64 * c, r32, hi, vf, vb0 + slot * SLOTB);
            tile_softmax_pv(st, p0, p1, mref, vf, wsf, r32, hi);
            NSA_WAIT_BAR();
        }
        tc += nct;
    }
    const float mc_fin = st.m; float lc = st.l;
    fold_branch<false>(ostg, st, gate[0], wsf, r32, hi);
    if (qt >= 16) {
        { auto rr = __builtin_amdgcn_permlane32_swap(__float_as_uint(lc), __float_as_uint(lc), false, false); lc = __uint_as_float(rr[0]) + __uint_as_float(rr[1]); }
        const float invl = lc > 0.f ? 1.0f / lc : 0.f;
        float carry = 0.f;
        for (int c = 0; c < nct; ++c) {
            const int slot = (tc + c) & 1;
            if (c + 1 < nct) { NSA_DMA_K(KCb, c + 1, slot ^ 1); }
            else { NSA_DMA_K(KSb, qt, slot ^ 1); NSA_DMA_V(VSb, qt, slot ^ 1); }
            const float c0 = sl2 * ((float)(1024 * c - t0) + 15.5f) + hoff_c - mc_fin;
            tile_scores<16, 3, false>(p0, p1, Kbase + slot * SLOTB, qr, bk, c0, b32c, nv - 64 * c, r32, hi, vf, 0);
#pragma unroll
            for (int r = 0; r < 16; ++r) { p0[r] = __builtin_amdgcn_exp2f(p0[r]) * invl; p1[r] = __builtin_amdgcn_exp2f(p1[r]) * invl; }
            float imp0[4], imp1[4], pl0[4], pl1[4];
#pragma unroll
            for (int a = 0; a < 4; ++a) {
                imp0[a] = (p0[4 * a] + p0[4 * a + 1]) + (p0[4 * a + 2] + p0[4 * a + 3]); imp1[a] = (p1[4 * a] + p1[4 * a + 1]) + (p1[4 * a + 2] + p1[4 * a + 3]);
                pl0[a] = __shfl_xor(p0[4 * a + 3], 32); pl1[a] = __shfl_xor(p1[4 * a + 3], 32);
            }
            if (hi) {
#pragma unroll
                for (int a = 0; a < 4; ++a) { imp0[a] += pl0[a]; imp1[a] += pl1[a]; }
            } else {
                imp0[0] += carry; imp1[0] += pl0[3];
#pragma unroll
                for (int a = 1; a < 4; ++a) { imp0[a] += pl0[a - 1]; imp1[a] += pl1[a - 1]; }
            }
            carry = pl1[3];
#pragma unroll
            for (int a = 0; a < 4; ++a) {
                imp0[a] += __shfl_xor(imp0[a], 1); imp0[a] += __shfl_xor(imp0[a], 2); imp1[a] += __shfl_xor(imp1[a], 1); imp1[a] += __shfl_xor(imp1[a], 2);
                if (hq == 0) { IMP[tl * 64 + 16 * c + 2 * a + hi] = imp0[a]; IMP[tl * 64 + 16 * c + 8 + 2 * a + hi] = imp1[a]; }
            }
            NSA_WAIT_BAR();
        }
        tc += nct;
    }
    unsigned long long wu = 0ull;
    if (qt < 16) {
        wu = (2ull << qt) - 1ull;
        if (lane < 8) { MASK[2 * (8 * wid + lane)] = (unsigned)wu; MASK[2 * (8 * wid + lane) + 1] = (unsigned)(wu >> 32); }
    } else {
        const int j = lane; const bool valid = j <= qt, forced = (j == 0) || (j == qt) || (j == qt - 1);
        for (int k = 0; k < 8; ++k) {
            const float imp = IMP[(8 * wid + k) * 64 + j];
            const float scv = valid ? (forced ? 1e9f : imp) : -1e9f;
            const unsigned fb = __float_as_uint(scv), key = fb ^ ((fb >> 31) ? 0xffffffffu : 0x80000000u);
            unsigned T = 0u;
#pragma unroll
            for (int bit = 31; bit >= 0; --bit) { const unsigned cand = T | (1u << bit); if (__builtin_popcountll(__ballot(key >= cand)) >= 16) T = cand; }
            const unsigned long long gt = __ballot(key > T), eq = __ballot(key == T);
            const int need = 16 - __builtin_popcountll(gt);
            const int before = (int)__builtin_amdgcn_mbcnt_hi((unsigned)(eq >> 32), __builtin_amdgcn_mbcnt_lo((unsigned)eq, 0u));
            const bool sel = (key > T) || ((key == T) && (before < need));
            const unsigned long long mk = __ballot(sel && (scv > -0.5e9f));
            wu |= mk;
            if (lane == 0) { MASK[2 * (8 * wid + k)] = (unsigned)mk; MASK[2 * (8 * wid + k) + 1] = (unsigned)(mk >> 32); }
        }
    }
    if (lane == 0) { WU[2 * wid] = (unsigned)wu; WU[2 * wid + 1] = (unsigned)(wu >> 32); }
    NSA_WAIT_BAR();
    unsigned long long uni = 0ull;
#pragma unroll
    for (int w = 0; w < 8; ++w) uni |= ((unsigned long long)WU[2 * w]) | (((unsigned long long)WU[2 * w + 1]) << 32);
    uni = ((unsigned long long)(unsigned)__builtin_amdgcn_readfirstlane((unsigned)uni)) | (((unsigned long long)(unsigned)__builtin_amdgcn_readfirstlane((unsigned)(uni >> 32))) << 32);
    const unsigned long long mymask = ((unsigned long long)MASK[2 * tl]) | (((unsigned long long)MASK[2 * tl + 1]) << 32);
    {
        state_init(st);
        unsigned long long rem = uni;
        int j = 63 - __builtin_clzll(rem); rem &= ~(1ull << j);
        for (int i = 0;; ++i) {
            const int slot = (tc + i) & 1; const bool more = rem != 0ull;
            int jn = 0;
            if (more) { jn = 63 - __builtin_clzll(rem); rem &= ~(1ull << jn); NSA_DMA_K(KSb, jn, slot ^ 1); NSA_DMA_V(VSb, jn, slot ^ 1); }
            if ((wu >> j) & 1ull) {
                const bool live = ((mymask >> j) & 1ull) != 0ull;
                const float rb0 = sl2 * (float)(64 * j - t0), mref = tile_ref(st, rb0, live), c0 = live ? rb0 + hoff_t - mref : -INFINITY;
                if (j == qt) tile_scores<1, 1, true>(p0, p1, Kbase + slot * SLOTB, qr, bk, c0, b32t, tl, r32, hi, vf, vb0 + slot * SLOTB);
                else tile_scores<1, 0, true>(p0, p1, Kbase + slot * SLOTB, qr, bk, c0, b32t, 0, r32, hi, vf, vb0 + slot * SLOTB);
                tile_softmax_pv(st, p0, p1, mref, vf, wsf, r32, hi);
            }
            NSA_WAIT_BAR();
            if (!more) break;
            j = jn;
        }
        if (wid == 0 && lane == 0) nxt_ticket = qbase + (int)__hip_atomic_fetch_add(qctr, 1u, __ATOMIC_RELAXED, __HIP_MEMORY_SCOPE_AGENT);
        fold_branch<false>(ostg, st, gate[1], wsf, r32, hi);
    }
    {
#pragma unroll
        for (int i = 0; i < 4; ++i) { const int row = i * 8 + (lane >> 3), ch = lane & 7;
            const f32x4_t v0 = *(LAS const f32x4_t*)(ostg + row * 64 + ch * 8), v1 = *(LAS const f32x4_t*)(ostg + row * 64 + ch * 8 + 4);
            u32x4_t v; v.x = cvtpk_s(v0[0], v0[1]); v.y = cvtpk_s(v0[2], v0[3]); v.z = cvtpk_s(v1[0], v1[1]); v.w = cvtpk_s(v1[2], v1[3]);
            *(u32x4_t*)(AB + (m0 + 8 * wid + (row >> 2)) * 2048 + 256 * g + (row & 3) * 64 + ch * 8) = v; }
    }
    NSA_WAIT_BAR();
#undef NSA_DMA_K
#undef NSA_DMA_V
    return nxt_ticket;
}
constexpr int L_QS = 145416;
__device__ __forceinline__ void nsa_phase(const Ptrs& P, LAS unsigned char* lds, int bid, int G, const int wave_s) {
    unsigned* qctr = (unsigned*)(P.ws + WS_CTL) + 3584;
    LAS int* qs = (LAS int*)(lds + L_QS);
    const int nrest = 1024 - G + LW_CHUNKS;
    int k = bid;
    while (k < 1024 + LW_CHUNKS) {
        int nxt, unit = k, chunk = -1;
        if (k >= G) { const int t = k - G, cb = (t * LW_CHUNKS) / nrest, ca = ((t + 1) * LW_CHUNKS) / nrest;
            if (ca > cb) chunk = cb; else unit = G + t - cb; }
        if (chunk < 0) {
            const int qt = 63 - (unit >> 4), g = 3 - ((unit >> 2) & 3), b = unit & 3;
            nxt = nsa_unit(P, lds, b * 4 + g, qt, wave_s, qctr, G);
        } else {
            nxt = 0;
            if (wave_s == 0 && fresh_lane() == 0) nxt = G + (int)__hip_atomic_fetch_add(qctr, 1u, __ATOMIC_RELAXED, __HIP_MEMORY_SCOPE_AGENT);
            late_weight_chunk(P, lds, chunk, wave_s);
        }
        if (wave_s == 0 && fresh_lane() == 0) *qs = nxt;
        NSA_WAIT_BAR();
        k = __builtin_amdgcn_readfirstlane(*qs);
    }
}
}

namespace p2 {
using nsa::bf16x8; using nsa::f32x16; using nsa::s16x4; using nsa::crow; using nsa::glds16; using nsa::cvtpk_s;
#define P2_WAIT_BAR() asm volatile("s_waitcnt vmcnt(0) lgkmcnt(0)\n\ts_barrier" ::: "memory")
constexpr int CB_BUF = 40960;
constexpr int CP_STRIDE = 65;
__device__ __forceinline__ void compress_unit(const Ptrs& P, LAS unsigned char* lds, int u, const int wave_s) {
    unsigned char* ws = P.ws;
    const int lane = fresh_lane(), r32 = lane & 31, hi = lane >> 5, wid = wave_s;
    const int kv = u >> 6, bg = (u >> 2) & 15, n0 = 64 * (u & 3);
    const bf16_t* Ag = (const bf16_t*)(ws + WS_KV6) + (size_t)kv * KVSZ + (size_t)bg * SEQ * 64 + (size_t)n0 * 1024;
    const bf16_t* Bg = (const bf16_t*)(ws + WS_W1C) + (size_t)kv * 256 * 2048;
    const unsigned lds0 = (unsigned)(uintptr_t)lds;
    const int drow = 8 * wid + (lane >> 3), dchk = (lane & 7) ^ ((drow >> 1) & 7);
    const unsigned aoff = (unsigned)(drow * 1024 + dchk * 8) * 2u, boff = (unsigned)(drow * 2048 + dchk * 8) * 2u;
    const unsigned dstw = lds0 + wid * 1024;
#define P2_DMA_TILE(kt, buf) do { const unsigned d_ = (unsigned)__builtin_amdgcn_readfirstlane(dstw + (buf) * CB_BUF); \
        glds16(Ag + (kt) * 64, aoff, d_); \
        _Pragma("unroll") for (int ct_ = 0; ct_ < 4; ++ct_) glds16(Bg + (size_t)ct_ * 64 * 2048 + (kt) * 64, boff, d_ + 8192u * (ct_ + 1)); } while (0)
    const int ct = wid >> 1, half = wid & 1, ncol0 = 64 * ct + 32 * half;
    f32x16 hT[2]; hT[0] = f32x16{}; hT[1] = f32x16{};
    P2_DMA_TILE(0, 0); P2_DMA_TILE(1, 1);
    asm volatile("s_waitcnt vmcnt(5) lgkmcnt(0)\n\ts_barrier" ::: "memory");
    for (int kt = 0; kt < 32; ++kt) {
        const int buf = kt % 3;
        if (kt + 2 < 32) P2_DMA_TILE(kt + 2, (kt + 2) % 3);
        LAS const char* sa = (LAS const char*)(lds + buf * CB_BUF) + r32 * 128;
        LAS const char* sb = (LAS const char*)(lds + buf * CB_BUF + 8192 * (ct + 1)) + (32 * half + r32) * 128;
        const int sw = (r32 >> 1) & 7;
#pragma unroll
        for (int d0 = 0; d0 < 4; ++d0) {
            const int co = ((2 * d0 + hi) ^ sw) * 16;
            const bf16x8 bf = *(LAS const bf16x8*)(sb + co), a0 = *(LAS const bf16x8*)(sa + co), a1 = *(LAS const bf16x8*)(sa + 4096 + co);
            hT[0] = __builtin_amdgcn_mfma_f32_32x32x16_bf16(bf, a0, hT[0], 0, 0, 0);
            hT[1] = __builtin_amdgcn_mfma_f32_32x32x16_bf16(bf, a1, hT[1], 0, 0, 0);
        }
        if (kt + 2 < 32) asm volatile("s_waitcnt vmcnt(5) lgkmcnt(0)\n\ts_barrier" ::: "memory");
        else asm volatile("s_waitcnt vmcnt(0) lgkmcnt(0)\n\ts_barrier" ::: "memory");
    }
    const float* bias1 = (const float*)(ws + WS_SMALL + SM_BIAS1) + kv * 256 + ncol0;
    bf16x8 hb[2][2];
#pragma unroll
    for (int mt = 0; mt < 2; ++mt) {
        float g[16];
#pragma unroll
        for (int r = 0; r < 16; ++r) g[r] = gelu_tanh(hT[mt][r] + bias1[crow(r, hi)]);
#pragma unroll
        for (int s = 0; s < 2; ++s) { u32x4_t w; w.x = cvtpk_s(g[8 * s], g[8 * s + 1]); w.y = cvtpk_s(g[8 * s + 2], g[8 * s + 3]); w.z = cvtpk_s(g[8 * s + 4], g[8 * s + 5]); w.w = cvtpk_s(g[8 * s + 6], g[8 * s + 7]);
            hb[mt][s] = __builtin_bit_cast(bf16x8, w); }
    }
    const bf16_t* w2t = (const bf16_t*)(ws + WS_SMALL + SM_W2T) + (size_t)kv * 64 * 256;
    f32x16 oT[2][2];
#pragma unroll
    for (int dt = 0; dt < 2; ++dt)
#pragma unroll
        for (int mt = 0; mt < 2; ++mt) oT[dt][mt] = f32x16{};
#pragma unroll
    for (int dt = 0; dt < 2; ++dt)
#pragma unroll
        for (int s = 0; s < 2; ++s) {
            const bf16_t* wp = w2t + (size_t)(32 * dt + r32) * 256 + ncol0 + 16 * s + 4 * hi;
            const u32x2_t lo = *(const u32x2_t*)wp, hi2 = *(const u32x2_t*)(wp + 8);
            const u32x4_t wv = {lo.x, lo.y, hi2.x, hi2.y}; const bf16x8 wf = __builtin_bit_cast(bf16x8, wv);
#pragma unroll
            for (int mt = 0; mt < 2; ++mt) oT[dt][mt] = __builtin_amdgcn_mfma_f32_32x32x16_bf16(wf, hb[mt][s], oT[dt][mt], 0, 0, 0);
        }
    LAS float* part = (LAS float*)lds + wid * 64 * CP_STRIDE;
#pragma unroll
    for (int dt = 0; dt < 2; ++dt)
#pragma unroll
        for (int mt = 0; mt < 2; ++mt)
#pragma unroll
            for (int r = 0; r < 16; ++r) part[(32 * mt + r32) * CP_STRIDE + 32 * dt + crow(r, hi)] = oT[dt][mt][r];
    P2_WAIT_BAR();
    {
        const int tid = wid * 64 + lane, m = tid >> 3, dg = tid & 7;
        float o[8];
#pragma unroll
        for (int e = 0; e < 8; ++e) { float s = 0.f;
#pragma unroll
            for (int w = 0; w < 8; ++w) s += ((LAS const float*)lds)[(w * 64 + m) * CP_STRIDE + 8 * dg + e];
            o[e] = s; }
        if (kv == 0) {
            float ss = 0.f;
#pragma unroll
            for (int e = 0; e < 8; ++e) ss += o[e] * o[e];
            ss += __shfl_xor(ss, 1); ss += __shfl_xor(ss, 2); ss += __shfl_xor(ss, 4);
            const float rr = __builtin_amdgcn_rsqf(ss * (1.0f / 64.0f) + 1e-6f);
#pragma unroll
            for (int e = 0; e < 8; ++e) o[e] *= rr * P.in[4][8 * dg + e];
        }
        const int n = n0 + m;
        u32x4_t v = {0u, 0u, 0u, 0u};
        if (n < 255) { v.x = cvtpk_s(o[0], o[1]); v.y = cvtpk_s(o[2], o[3]); v.z = cvtpk_s(o[4], o[5]); v.w = cvtpk_s(o[6], o[7]); }
        *(u32x4_t*)((bf16_t*)(ws + (kv ? WS_VC : WS_KC)) + ((size_t)bg * 256 + n) * 64 + 8 * dg) = v;
    }
    P2_WAIT_BAR();
#undef P2_DMA_TILE
}

constexpr int G_V = 0, G_ST = 32768, G_OST = 33792, G_END = 33792 + 65536;
struct GmlpIn { u32x4_t raw[4]; u32x4_t uraw[4]; float sbv[4]; };
__device__ __forceinline__ void gmlp_load(GmlpIn& in, const Ptrs& P, int unit, int tid, int lane, int r32, int hi, int wid) {
    unsigned char* ws = P.ws;
    const int g = unit & 7, chunk = (unit >> 3) & 31, b = unit >> 8; const int m0 = b * SEQ + chunk * 128;
    const bf16_t* GV = (const bf16_t*)(ws + WS_GV); const bf16_t* U = (const bf16_t*)(ws + WS_U);
    const int tb = wid >> 1, ch = wid & 1; (void)r32; (void)hi;
#pragma unroll
    for (int i = 0; i < 4; ++i) { const int idx = tid + 512 * i, s = idx >> 4, c8 = idx & 15; in.raw[i] = *(const u32x4_t*)(GV + (size_t)(m0 + s) * 1024 + g * 128 + 8 * c8); }
#pragma unroll
    for (int i = 0; i < 4; ++i) { const int row = i * 8 + (lane >> 3), t = 32 * tb + row; in.uraw[i] = *(const u32x4_t*)(U + (size_t)(m0 + t) * 1024 + g * 128 + 64 * ch + 8 * (lane & 7)); in.sbv[i] = P.in[11][g * 128 + t]; }
}
__device__ __forceinline__ void gmlp_compute(const GmlpIn& in, const f32x4_t (&sv)[8], const bf16x8 (&pa)[2][4], const f32x4_t w0, const f32x4_t w1, const f32x4_t b0, const f32x4_t b1, const Ptrs& P, LAS unsigned char* lds, int unit, int tid, int lane, int r32, int hi, int wid) {
    unsigned char* ws = P.ws;
    const int g = unit & 7, chunk = (unit >> 3) & 31, b = unit >> 8; const int m0 = b * SEQ + chunk * 128;
    bf16_t* AB = (bf16_t*)(ws + WS_AB);
    LAS float* st = (LAS float*)(lds + G_ST);
    const int tb = wid >> 1, ch = wid & 1;
    if (tid < 128) { float s1 = 0.f, s2 = 0.f;
#pragma unroll
        for (int i = 0; i < 8; ++i) { s1 += sv[i][0] + sv[i][2]; s2 += sv[i][1] + sv[i][3]; }
        const float mean = s1 * (1.0f / 1024.0f); float var = s2 * (1.0f / 1024.0f) - mean * mean; var = var < 0.f ? 0.f : var;
        st[2 * tid] = mean; st[2 * tid + 1] = __builtin_amdgcn_rsqf(var + 1e-5f); }
    asm volatile("s_waitcnt lgkmcnt(0)\n\ts_barrier" ::: "memory");
#pragma unroll
    for (int i = 0; i < 4; ++i) { const int idx = tid + 512 * i, s = idx >> 4, c8 = idx & 15;
        float f[8]; unpack8(in.raw[i], f);
        const float mean = st[2 * s], rstd = st[2 * s + 1];
        float y[8];
#pragma unroll
        for (int e = 0; e < 4; ++e) { y[e] = (f[e] - mean) * rstd * w0[e] + b0[e]; y[4 + e] = (f[4 + e] - mean) * rstd * w1[e] + b1[e]; }
        u32x4_t o; o.x = cvtpk_s(y[0], y[1]); o.y = cvtpk_s(y[2], y[3]); o.z = cvtpk_s(y[4], y[5]); o.w = cvtpk_s(y[6], y[7]);
        const int st_ = s >> 6, sk = s & 63, chh = c8 >> 3, x = c8 & 7;
        *(LAS u32x4_t*)(lds + G_V + (st_ * 2 + chh) * 8192 + (x >> 2) * 4096 + (sk >> 4) * 1024 + (sk & 15) * 64 + (x & 3) * 16) = o; }
    asm volatile("s_waitcnt lgkmcnt(0)\n\ts_barrier" ::: "memory");
    f32x16 o[2]; o[0] = f32x16{}; o[1] = f32x16{};
    const int vb0 = (int)((unsigned)(uintptr_t)lds + G_V) + ((lane >> 4) & 1) * 32 + (lane & 3) * 8 + (4 * hi + ((lane & 15) >> 2)) * 64;
    nsa::pv(o, vb0 + ch * 8192, pa[0][0], pa[0][1], pa[0][2], pa[0][3]);
    if (tb >= 2) nsa::pv(o, vb0 + (2 + ch) * 8192, pa[1][0], pa[1][1], pa[1][2], pa[1][3]);
    LAS float* ostg = (LAS float*)(lds + G_OST) + wid * 2048;
#pragma unroll
    for (int r = 0; r < 16; ++r) { const int orow = crow(r, hi);
#pragma unroll
        for (int d0 = 0; d0 < 2; ++d0) ostg[orow * 64 + d0 * 32 + r32] = o[d0][r]; }
    asm volatile("s_waitcnt lgkmcnt(0)" ::: "memory");
#pragma unroll
    for (int i = 0; i < 4; ++i) { const int row = i * 8 + (lane >> 3), c8 = lane & 7, t = 32 * tb + row;
        const f32x4_t v0 = *(LAS const f32x4_t*)(ostg + row * 64 + c8 * 8), v1 = *(LAS const f32x4_t*)(ostg + row * 64 + c8 * 8 + 4);
        const size_t grow = (size_t)(m0 + t); const int col = g * 128 + 64 * ch + 8 * c8;
        float uf[8]; unpack8(in.uraw[i], uf);
        const float sb_ = in.sbv[i];
        u32x4_t w; w.x = cvtpk_s(uf[0] * (v0[0] + sb_), uf[1] * (v0[1] + sb_)); w.y = cvtpk_s(uf[2] * (v0[2] + sb_), uf[3] * (v0[3] + sb_));
        w.z = cvtpk_s(uf[4] * (v1[0] + sb_), uf[5] * (v1[1] + sb_)); w.w = cvtpk_s(uf[6] * (v1[2] + sb_), uf[7] * (v1[3] + sb_));
        *(u32x4_t*)(AB + grow * 2048 + 1024 + col) = w; }
    asm volatile("s_waitcnt lgkmcnt(0)\n\ts_barrier" ::: "memory");
}
__device__ __forceinline__ void gmlp_run(const Ptrs& P, LAS unsigned char* lds, int u0, int stride, int nunits, const int wave_s) {
    const int lane = fresh_lane(), r32 = lane & 31, hi = lane >> 5, wid = wave_s, tid = wid * 64 + lane;
    GmlpIn A, B;
    int u = u0;
    bf16x8 pa[2][4];
    { const bf16_t* SWB = (const bf16_t*)(P.ws + WS_SMALL + SM_SWB) + (size_t)(u0 & 7) * 16384; const int tb = wid >> 1;
#pragma unroll
      for (int st_ = 0; st_ < 2; ++st_)
#pragma unroll
        for (int ks = 0; ks < 4; ++ks) {
            const bf16_t* wp = SWB + (size_t)(32 * tb + r32) * 128 + 64 * st_ + 16 * ks + 4 * hi;
            const u32x2_t lo = *(const u32x2_t*)wp, hi2 = *(const u32x2_t*)(wp + 8);
            const u32x4_t wv = {lo.x, lo.y, hi2.x, hi2.y}; pa[st_][ks] = __builtin_bit_cast(bf16x8, wv); } }
    const int c8v = tid & 15, g0 = u0 & 7;
    const f32x4_t w0 = *(const f32x4_t*)(P.in[8] + g0 * 128 + 8 * c8v), w1 = *(const f32x4_t*)(P.in[8] + g0 * 128 + 8 * c8v + 4), b0 = *(const f32x4_t*)(P.in[9] + g0 * 128 + 8 * c8v), b1 = *(const f32x4_t*)(P.in[9] + g0 * 128 + 8 * c8v + 4);
    const float* VSTAT = (const float*)(P.ws + WS_VSTAT);
#define GMLP_STATS(sv_, unit_) do { const int m0_ = ((unit_) >> 8) * SEQ + (((unit_) >> 3) & 31) * 128; const f32x4_t* p_ = (const f32x4_t*)(VSTAT + (size_t)(m0_ + (tid & 127)) * 32); \
        _Pragma("unroll") for (int i_ = 0; i_ < 8; ++i_) sv_[i_] = p_[i_]; } while (0)
    f32x4_t sv[8];
    if (u < nunits) gmlp_load(A, P, u, tid, lane, r32, hi, wid);
    while (u < nunits) {
        GMLP_STATS(sv, u);
        if (u + stride < nunits) gmlp_load(B, P, u + stride, tid, lane, r32, hi, wid);
        gmlp_compute(A, sv, pa, w0, w1, b0, b1, P, lds, u, tid, lane, r32, hi, wid);
        u += stride; if (u >= nunits) break;
        GMLP_STATS(sv, u);
        if (u + stride < nunits) gmlp_load(A, P, u + stride, tid, lane, r32, hi, wid);
        gmlp_compute(B, sv, pa, w0, w1, b0, b1, P, lds, u, tid, lane, r32, hi, wid);
        u += stride;
    }
#undef GMLP_STATS
    asm volatile("s_waitcnt vmcnt(0) lgkmcnt(0)\n\ts_barrier" ::: "memory");
}
#undef P2_WAIT_BAR
}

#define XB_TMO      128
#define XB_XCNT(j)  (256  + 64 * (j))
#define XB_XSUB(j)  (1280 + 64 * (j))
#define XB_XGEN(j)  (2304 + 64 * (j))
#define XB_TOP      3328
#define XB_TOPGEN   3392
#define XCD_BAR_WORDS 3456
#define XB_SPIN_CAP (1u << 18)

__device__ __forceinline__ unsigned xb_ld(unsigned* p)              { return __hip_atomic_load(p, __ATOMIC_RELAXED, __HIP_MEMORY_SCOPE_AGENT); }
__device__ __forceinline__ unsigned xb_add(unsigned* p, unsigned v) { return __hip_atomic_fetch_add(p, v, __ATOMIC_RELAXED, __HIP_MEMORY_SCOPE_AGENT); }
__device__ __forceinline__ unsigned xb_xcc_id() { return (unsigned)__builtin_amdgcn_s_getreg((3 << 11) | 20) & 0xFu; }
#define XB_SPIN(cond, bar) do { unsigned _sp = 0; while (cond) { __builtin_amdgcn_s_sleep(1); \
    if ((++_sp & 255u) == 0u) { if (xb_ld(&(bar)[XB_TMO])) break; if (_sp > XB_SPIN_CAP) { atomicAdd(&(bar)[XB_TMO], 1u); break; } } } } while (0)

struct XcdBarrier {
    unsigned* bar; unsigned x; unsigned w0;
    volatile LAS unsigned* st;
};

__device__ __forceinline__ XcdBarrier xcd_barrier_post(unsigned* bar, volatile LAS unsigned* st, int wave_s) {
    XcdBarrier b; b.bar = bar; b.x = xb_xcc_id(); b.st = st; b.w0 = wave_s == 0 ? 1u : 0u;
    if (b.w0 && fresh_lane() == 0) (void)xb_add(&bar[XB_XCNT(b.x)], 1u);
    return b;
}
__device__ __forceinline__ void xcd_barrier_complete(unsigned* bar, unsigned x, unsigned& nloc, unsigned& nx) {
    const unsigned G = gridDim.x * gridDim.y * gridDim.z;
    unsigned sum, cnt, mine, sp = 0u;
    for (;;) {
        sum = 0u; cnt = 0u; mine = 0u;
#pragma unroll
        for (unsigned j = 0; j < 16; ++j) { const unsigned c = xb_ld(&bar[XB_XCNT(j)]); sum += c; cnt += (c > 0u) ? 1u : 0u; mine = (j == x) ? c : mine; }
        if (sum == G) break;
        __builtin_amdgcn_s_sleep(1);
        if ((++sp & 255u) == 0u) { if (xb_ld(&bar[XB_TMO])) break; if (sp > XB_SPIN_CAP) { atomicAdd(&bar[XB_TMO], 1u); break; } }
    }
    nloc = mine > 0u ? mine : 1u; nx = cnt > 0u ? cnt : 1u;
}

__device__ __forceinline__ void xcd_barrier(const XcdBarrier& b) {
    asm volatile("s_waitcnt vmcnt(0)" ::: "memory");
    __syncthreads();
    if (b.w0 && fresh_lane() == 0) {
        unsigned* bar = b.bar;
        __builtin_amdgcn_s_waitcnt(0);
        unsigned nloc = b.st[0], nx = b.st[1];
        if (nloc == 0u) { xcd_barrier_complete(bar, b.x, nloc, nx); b.st[0] = nloc; b.st[1] = nx; }
        const unsigned old = xb_add(&bar[XB_XSUB(b.x)], 1u);
        const unsigned gen = old / nloc;
        if (old + 1u == (gen + 1u) * nloc) {
            __builtin_amdgcn_fence(__ATOMIC_RELEASE, "agent");
            asm volatile("s_waitcnt vmcnt(0)" ::: "memory");
            const unsigned og = xb_add(&bar[XB_TOP], 1u);
            const unsigned tg = og / nx;
            if (og + 1u == (tg + 1u) * nx) xb_add(&bar[XB_TOPGEN], 1u);
            else XB_SPIN(xb_ld(&bar[XB_TOPGEN]) == tg, bar);
            __builtin_amdgcn_fence(__ATOMIC_ACQUIRE, "agent");
            xb_add(&bar[XB_XGEN(b.x)], 1u);
            asm volatile("s_waitcnt vmcnt(0)" ::: "memory");
        } else {
            XB_SPIN(xb_ld(&bar[XB_XGEN(b.x)]) == gen, bar);
            __builtin_amdgcn_fence(__ATOMIC_ACQUIRE, "agent");
            asm volatile("s_waitcnt vmcnt(0)" ::: "memory");
        }
    }
    __syncthreads();
}

constexpr int LDS_BYTES = 151552;
constexpr int LDS_XCH = 132096;
constexpr int LDS_MISC = 145408;
__global__ void __launch_bounds__(512, 2) mega_fwd(Ptrs P) {
    extern __shared__ __attribute__((aligned(16))) unsigned char lds_raw[];
    LAS unsigned char* lds = (LAS unsigned char*)lds_raw;
    unsigned char* ws = P.ws;
    const int wave = __builtin_amdgcn_readfirstlane(threadIdx.x >> 6);
    const int G = gridDim.x, bid = blockIdx.x;
    if (wave == 0) { const int l_ = fresh_lane(); if (l_ < 2) ((LAS unsigned*)(lds + LDS_MISC))[l_] = 0u; }
    __syncthreads();
    const XcdBarrier bar = xcd_barrier_post((unsigned*)(ws + WS_CTL), (volatile LAS unsigned*)(lds + LDS_MISC), wave);
    p0_prologue(P, lds, bid, G, wave);
    xcd_barrier(bar);
    if (bid == 0) bias1_stage(ws, fresh_tid(wave));
    {
        pg8::Gemm g{(const bf16_t*)(ws + WS_XN), (const bf16_t*)(ws + WS_WIN), MTOK, NPROJ, 2048, 2048};
        pg8::StaticOrder S; S.init(MTOK, NPROJ, G, bid);
        pg8::EpiProj E{(bf16_t*)(ws + WS_Q), (bf16_t*)(ws + WS_KV6), (bf16_t*)(ws + WS_U), (bf16_t*)(ws + WS_GV), (float*)(ws + WS_GATES), (float*)(ws + WS_VSTAT), P.in[3], P.in[4]};
        pg8::gemm_phase<pg8::EpiProj, pg8::StaticOrder, true, true>(lds, g, S, E, wave);
    }
    xcd_barrier(bar);
    if (bid < 128 && G >= 256) p2::compress_unit(P, lds, bid, wave);
    else if (G >= 256) p2::gmlp_run(P, lds, bid - 128, G - 128, 1024, wave);
    xcd_barrier(bar);
    nsa::nsa_phase(P, lds, bid, G, wave);
    xcd_barrier(bar);
    {
        pg8::Gemm g{(const bf16_t*)(ws + WS_AB), (const bf16_t*)(ws + WS_WOUT), MTOK, 2048, 2048, 2048};
        pg8::StaticOrder S; S.init(MTOK, 2048, G, bid);
        pg8::EpiRes1 E{(const float*)(ws + WS_SMALL + SM_RINV), (const float*)(ws + WS_SMALL + SM_INVW), (bf16_t*)(ws + WS_XN), (float*)(ws + WS_SSQ)};
        pg8::gemm_phase<pg8::EpiRes1, pg8::StaticOrder, true, true>(lds, g, S, E, wave);
    }
    xcd_barrier(bar);
    for (int m = bid * 512 + fresh_tid(wave); m < MTOK; m += G * 512) {
        const float* p = (const float*)(ws + WS_SSQ) + (size_t)m * 32; float s = 0.f;
#pragma unroll
        for (int i = 0; i < 32; ++i) s += p[i];
        ((float*)(ws + WS_SMALL + SM_R2))[m] = __builtin_amdgcn_rsqf(s * (1.0f / D_MODEL) + 1e-6f);
    }
    xcd_barrier(bar);
    {
        pg8::Gemm g{(const bf16_t*)(ws + WS_XN), (const bf16_t*)(ws + WS_WUP), MTOK, N_UP, 2048, 2048};
        pg8::StaticOrder S; S.init(MTOK, N_UP, G, bid);
        pg8::EpiUpConv E{(bf16_t*)(ws + WS_G), (const float*)(ws + WS_SMALL + SM_R2), P.in[15], P.in[16], (float*)(ws + WS_HLAST), (float*)(ws + WS_FIRST), lds + LDS_XCH};
        pg8::gemm_phase<pg8::EpiUpConv, pg8::StaticOrder, true, true>(lds, g, S, E, wave);
    }
    xcd_barrier(bar);
    for (int it = bid * 512 + fresh_tid(wave); it < 60 * 44 * 2 * 16; it += G * 512) {
        const int c8 = it & 15, row = (it >> 4) & 1, tl_ = it >> 5, pn = tl_ % 44, pmi = tl_ / 44, pm = pmi + pmi / 15 + 1;
        const float* cw = P.in[15]; const float* cb = P.in[16]; (void)cb;
        const float* fp = (const float*)(ws + WS_FIRST) + ((size_t)(pm * 44 + pn) * 2 + row) * 256 + 8 * c8;
        const float* lp = (const float*)(ws + WS_HLAST) + ((size_t)((pm - 1) * 44 + pn) * 2) * 256 + 8 * c8;
        const int ch = pn * 128 + 8 * c8;
        float r[8];
#pragma unroll
        for (int e = 0; e < 8; ++e) {
            const float l0g = lp[e], l1g = lp[256 + e], l0u = lp[128 + e], l1u = lp[256 + 128 + e];
            const float w0g = cw[ch + e], w1g = cw[N_UP + ch + e], w0u = cw[D_FF + ch + e], w1u = cw[N_UP + D_FF + ch + e];
            const float cg = fp[e] + (row == 0 ? w1g * l1g + w0g * l0g : w0g * l1g), cu = fp[128 + e] + (row == 0 ? w1u * l1u + w0u * l0u : w0u * l1u);
            r[e] = cg * sigmoidf_(cg) * cu;
        }
        u32x4_t o; o.x = pk2(r[0], r[1]); o.y = pk2(r[2], r[3]); o.z = pk2(r[4], r[5]); o.w = pk2(r[6], r[7]);
        *(u32x4_t*)((bf16_t*)(ws + WS_G) + (size_t)(pm * 256 + row) * D_FF + ch) = o;
    }
    xcd_barrier(bar);
    {
        pg8::Gemm g{(const bf16_t*)(ws + WS_G), (const bf16_t*)(ws + WS_WDOWN), MTOK, 2048, D_FF, D_FF};
        pg8::StaticOrder S; S.init(MTOK, 2048, G, bid);
        pg8::EpiDown E{P.out, (const bf16_t*)(ws + WS_XN)};
        pg8::gemm_phase<pg8::EpiDown, pg8::StaticOrder, true, true>(lds, g, S, E, wave);
    }
}

extern "C" void kernel_launch(void* const* d_in, const int* in_sizes, int n_in, void* d_out, int out_size, void* d_ws, size_t ws_size, hipStream_t stream) {
    static int grid_blocks = 0;
    if (!grid_blocks) {
        int dev = 0, cus = 0, per_cu = 0;
        (void)hipGetDevice(&dev);
        (void)hipDeviceGetAttribute(&cus, hipDeviceAttributeMultiprocessorCount, dev);
        (void)hipFuncSetAttribute((const void*)mega_fwd, hipFuncAttributeMaxDynamicSharedMemorySize, LDS_BYTES);
        (void)hipOccupancyMaxActiveBlocksPerMultiprocessor(&per_cu, (const void*)mega_fwd, 512, LDS_BYTES);
        if (per_cu < 1) { fprintf(stderr, "kernel_launch: occupancy query says %d blocks/CU\n", per_cu); per_cu = 1; }
        grid_blocks = cus * 1;
        (void)hipGetLastError();
    }
    if (n_in != 18 || ws_size < WS_END) { fprintf(stderr, "kernel_launch: unexpected n_in %d / ws %zu\n", n_in, ws_size); return; }
    Ptrs P{};
    for (int i = 0; i < 18; ++i) P.in[i] = (const float*)d_in[i];
    P.out = (float*)d_out; P.ws = (unsigned char*)d_ws;
    (void)hipMemsetAsync((char*)d_ws + WS_CTL, 0, 16384, stream);
    mega_fwd<<<dim3(grid_blocks), dim3(512), LDS_BYTES, stream>>>(P);
}
```

```cpp
#include <hip/hip_runtime.h>
#include <cstdio>
#include <cstdint>

constexpr int D_MODEL = 2048, BATCH = 4, SEQ = 4096, MTOK = BATCH * SEQ;
constexpr int IN_COLS = 4656, NPROJ = 4864;
constexpr int D_FF = 5632, N_UP = 2 * D_FF;
constexpr int NBG = 16;
constexpr size_t KVSZ = (size_t)NBG * SEQ * 64;
constexpr float LOG2E = 1.4426950408889634f;

constexpr size_t MiB = 1u << 20;
constexpr size_t WS_CTL = 0;
constexpr size_t WS_WIN = 1 * MiB, WS_WOUT = 20 * MiB, WS_WUP = 28 * MiB, WS_WDOWN = 72 * MiB, WS_W1C = 94 * MiB;
constexpr size_t WS_SMALL = 96 * MiB;
constexpr size_t SM_BIASP = 0, SM_BIAS1 = 65536, SM_R2 = 131072, SM_W2T = 196608  , SM_SWB = 262144  , SM_RINV = 524288  , SM_INVW = 589824  ;
constexpr size_t WS_XN = 97 * MiB;
constexpr size_t WS_Q = 161 * MiB;
constexpr size_t WS_KV6 = 193 * MiB;
constexpr size_t WS_U = 241 * MiB, WS_GV = 273 * MiB;
constexpr size_t WS_GATES = 305 * MiB;
constexpr size_t WS_VSTAT = 308 * MiB;
constexpr size_t WS_KC = 310 * MiB, WS_VC = 310 * MiB + 524288;
constexpr size_t WS_HC = 311 * MiB;
constexpr size_t WS_AB = 315 * MiB;
constexpr size_t WS_SSQ = 379 * MiB;
constexpr size_t WS_G = 161 * MiB;
constexpr size_t WS_HID = 381 * MiB;
constexpr size_t WS_HLAST = 381 * MiB, WS_FIRST = 388 * MiB;
constexpr size_t WS_END = 469 * MiB;

#define LAS __attribute__((address_space(3)))
typedef unsigned short bf16_t;
typedef unsigned u32x4_t __attribute__((ext_vector_type(4)));
typedef unsigned u32x2_t __attribute__((ext_vector_type(2)));
typedef float f32x4_t __attribute__((ext_vector_type(4)));

__device__ __forceinline__ float bf2f(unsigned short h) { return __uint_as_float(((unsigned)h) << 16); }
__device__ __forceinline__ unsigned f2bf(float f) { unsigned u = __float_as_uint(f); return (u + 0x7fffu + ((u >> 16) & 1u)) >> 16; }
__device__ __forceinline__ unsigned pk2(float lo, float hi) { return f2bf(lo) | (f2bf(hi) << 16); }
__device__ __forceinline__ float gelu_tanh(float x) {
    const float u = 0.7978845608028654f * (x + 0.044715f * x * x * x);
    const float e = __builtin_amdgcn_exp2f(-2.8853900817779268f * u);
    return x * __builtin_amdgcn_rcpf(1.0f + e);
}
__device__ __forceinline__ float sigmoidf_(float x) { return __builtin_amdgcn_rcpf(1.0f + __builtin_amdgcn_exp2f(-LOG2E * x)); }
__device__ __forceinline__ float wave_sum(float v) {
#pragma unroll
    for (int o = 1; o < 64; o <<= 1) v += __shfl_xor(v, o);
    return v;
}
__device__ __forceinline__ void unpack8(u32x4_t r, float (&f)[8]) {
    f[0] = __uint_as_float(r.x << 16); f[1] = __uint_as_float(r.x & 0xffff0000u);
    f[2] = __uint_as_float(r.y << 16); f[3] = __uint_as_float(r.y & 0xffff0000u);
    f[4] = __uint_as_float(r.z << 16); f[5] = __uint_as_float(r.z & 0xffff0000u);
    f[6] = __uint_as_float(r.w << 16); f[7] = __uint_as_float(r.w & 0xffff0000u);
}

__device__ __forceinline__ int fresh_lane() { unsigned z_ = 0u; asm volatile("" : "+v"(z_)); return (int)__builtin_amdgcn_mbcnt_hi(~0u, __builtin_amdgcn_mbcnt_lo(~0u, z_)); }
__device__ __forceinline__ int fresh_tid(int wave_s) { return wave_s * 64 + fresh_lane(); }
namespace pg8 {
#define PG8_LAS __attribute__((address_space(3)))
typedef unsigned short bf16_t;
typedef short bf16x8 __attribute__((ext_vector_type(8)));
typedef float f32x4 __attribute__((ext_vector_type(4)));
typedef unsigned u32x4 __attribute__((ext_vector_type(4)));
constexpr int BM = 256, BK = 64, HALF = 128, HTB = HALF * BK * 2  , STAGE_BYTES = 8 * HTB, NXCD = 8, WGM = 8;

__host__ __device__ __forceinline__ int lds_byte(int r, int c) { const int st = (r >> 4) * 2 + (c >> 5), rr = r & 15, cc = c & 31, ob = rr * 64 + cc * 2; return st * 1024 + (ob ^ (((ob >> 9) & 1) << 5)); }
__host__ __device__ __forceinline__ void stage_rc(int b, int& R, int& C) { const int st = b / 1024, sb = b % 1024, swz = sb ^ (((sb >> 9) & 1) << 5); R = (st >> 1) * 16 + swz / 64; C = (st & 1) * 32 + (swz % 64) / 2; }
__host__ __device__ __forceinline__ int perm32(int rho) { const int n = rho >> 4, i = rho & 15; return 8 * (i >> 2) + 4 * n + (i & 3); }

struct Unit { int pm, pn; };
struct Gemm { const bf16_t* A; const bf16_t* Bt; int M, N, K, lda; };

struct StaticOrder {
    int nM, nN, nwg, G, c;
    __host__ __device__ void init(int M, int N, int G_, int c_) { nM = M / BM; nN = N / BM; nwg = nM * nN; G = G_; c = c_; }
    __host__ __device__ bool next(int i, Unit& u) const {
        const long L = (long)i * G + c; if (L >= nwg) return false;
        int wgid = (int)L; { const int q = nwg / NXCD, r = nwg % NXCD, xcd = wgid % NXCD, off = wgid / NXCD; wgid = (xcd < r ? xcd * (q + 1) : r * (q + 1) + (xcd - r) * q) + off; }
        const int nig = WGM * nN, gid = wgid / nig, fm = gid * WGM, gsz = (nM - fm) < WGM ? (nM - fm) : WGM;
        u.pm = fm + ((wgid % nig) % gsz); u.pn = (wgid % nig) / gsz; return true;
    }
    __device__ __forceinline__ void a_ready(const Unit&) const {}
    __device__ __forceinline__ void done(const Unit&) const {}
};

__device__ __forceinline__ unsigned cvt_pk_bf16(float lo, float hi) { unsigned r; asm volatile("v_cvt_pk_bf16_f32 %0, %1, %2" : "=v"(r) : "v"(lo), "v"(hi)); return r; }

struct EpiProj {
    static constexpr bool PERM = true, AFTER_DRAIN = false, PERMA = false;
    bf16_t* Q; bf16_t* KV6; bf16_t* U; bf16_t* GV; float* GATES; float* VSTAT; const float* q_norm_w; const float* k_norm_w;
    __device__ __forceinline__ void operator()(const f32x4 (&acc)[2][2][4][2], const Unit& u, int wr, int wc, int fr, int fq) const {
        const int pn = u.pn, row0 = u.pm * BM + wr * 64 + fr;
        if (pn < 10) {
            const bool normed = (pn < 4) || pn == 6 || pn == 8;
            const float* w = pn < 4 ? q_norm_w : (k_norm_w + (pn == 6 ? 64 : 128));
            const float sc = pn < 4 ? 0.125f * LOG2E : 1.0f;
            f32x4 wv[2][2];
#pragma unroll
            for (int bj = 0; bj < 2; ++bj)
#pragma unroll
                for (int n = 0; n < 2; ++n) wv[bj][n] = normed ? (*(const f32x4*)(w + 32 * bj + 8 * fq + 4 * n)) * sc : (f32x4){1.f, 1.f, 1.f, 1.f};
#pragma unroll
            for (int ai = 0; ai < 2; ++ai)
#pragma unroll
                for (int m = 0; m < 4; ++m) {
                    const int row = row0 + ai * HALF + m * 16;
                    float r = 1.f;
                    if (normed) {
                        float ss = 0.f;
#pragma unroll
                        for (int bj = 0; bj < 2; ++bj)
#pragma unroll
                            for (int n = 0; n < 2; ++n) { const f32x4 x = acc[ai][bj][m][n]; ss += (x[0] * x[0] + x[1] * x[1]) + (x[2] * x[2] + x[3] * x[3]); }
                        ss += __shfl_xor(ss, 16); ss += __shfl_xor(ss, 32);
                        r = __builtin_amdgcn_rsqf(ss * (1.0f / 64.0f) + 1e-6f);
                    }
                    bf16_t* dst;
                    if (pn < 4) dst = Q + (size_t)row * 1024 + pn * 256 + wc * 64 + 8 * fq;
                    else { const int b = row >> 12, t = row & 4095; dst = KV6 + (size_t)(pn - 4) * KVSZ + ((size_t)((b * 4 + wc) * 4096 + t)) * 64 + 8 * fq; }
#pragma unroll
                    for (int bj = 0; bj < 2; ++bj) {
                        const f32x4 v0 = acc[ai][bj][m][0] * r * wv[bj][0], v1 = acc[ai][bj][m][1] * r * wv[bj][1];
                        u32x4 o; o.x = cvt_pk_bf16(v0[0], v0[1]); o.y = cvt_pk_bf16(v0[2], v0[3]); o.z = cvt_pk_bf16(v1[0], v1[1]); o.w = cvt_pk_bf16(v1[2], v1[3]);
                        *(u32x4*)(dst + 32 * bj) = o;
                    }
                }
        } else if (pn < 18) {
            const bool isv = pn >= 14; const int ct = isv ? pn - 14 : pn - 10;
            bf16_t* base = (isv ? GV : U) + ct * 256 + wc * 64 + 8 * fq;
#pragma unroll
            for (int ai = 0; ai < 2; ++ai)
#pragma unroll
                for (int m = 0; m < 4; ++m) {
                    const int row = row0 + ai * HALF + m * 16; float s1 = 0.f, s2 = 0.f;
#pragma unroll
                    for (int bj = 0; bj < 2; ++bj) {
                        f32x4 v0 = acc[ai][bj][m][0], v1 = acc[ai][bj][m][1];
#pragma unroll
                        for (int e = 0; e < 4; ++e) { v0[e] = gelu_tanh(v0[e]); v1[e] = gelu_tanh(v1[e]); s1 += v0[e] + v1[e]; s2 += v0[e] * v0[e] + v1[e] * v1[e]; }
                        u32x4 o; o.x = cvt_pk_bf16(v0[0], v0[1]); o.y = cvt_pk_bf16(v0[2], v0[3]); o.z = cvt_pk_bf16(v1[0], v1[1]); o.w = cvt_pk_bf16(v1[2], v1[3]);
                        *(u32x4*)(base + (size_t)row * 1024 + 32 * bj) = o;
                    }
                    if (isv) {
                        s1 += __shfl_xor(s1, 16); s1 += __shfl_xor(s1, 32); s2 += __shfl_xor(s2, 16); s2 += __shfl_xor(s2, 32);
                        if (fq == 0) { float* p = VSTAT + ((size_t)row * 16 + ct * 4 + wc) * 2; p[0] = s1; p[1] = s2; }
                    }
                }
        } else {
            if (wc == 0) {
#pragma unroll
                for (int ai = 0; ai < 2; ++ai)
#pragma unroll
                    for (int m = 0; m < 4; ++m) {
                        const int row = row0 + ai * HALF + m * 16;
#pragma unroll
                        for (int bj = 0; bj < 2; ++bj)
#pragma unroll
                            for (int n = 0; n < 2; ++n) {
                                const int L = 32 * bj + 8 * fq + 4 * n;
                                if (L < 48) { f32x4 v = acc[ai][bj][m][n]; f32x4 o; o[0] = sigmoidf_(v[0]); o[1] = sigmoidf_(v[1]); o[2] = sigmoidf_(v[2]); o[3] = sigmoidf_(v[3]); *(f32x4*)(GATES + (size_t)row * 48 + L) = o; }
                            }
                    }
            }
        }
    }
};
struct EpiCmp {
    static constexpr bool PERM = true, AFTER_DRAIN = false, PERMA = false;
    bf16_t* HC; const float* bias1;
    __device__ __forceinline__ void operator()(const f32x4 (&acc)[2][2][4][2], const Unit& u, int wr, int wc, int fr, int fq) const {
        const int row0 = u.pm * BM + wr * 64 + fr, col0 = wc * 32 + 8 * fq;
        f32x4 bv[2][2];
#pragma unroll
        for (int bj = 0; bj < 2; ++bj)
#pragma unroll
            for (int n = 0; n < 2; ++n) bv[bj][n] = *(const f32x4*)(bias1 + u.pn * 256 + col0 + bj * HALF + 4 * n);
#pragma unroll
        for (int ai = 0; ai < 2; ++ai)
#pragma unroll
            for (int m = 0; m < 4; ++m) { bf16_t* rowp = HC + (size_t)(row0 + ai * HALF + m * 16) * 256 + col0;
#pragma unroll
                for (int bj = 0; bj < 2; ++bj) { f32x4 v0 = acc[ai][bj][m][0] + bv[bj][0], v1 = acc[ai][bj][m][1] + bv[bj][1];
#pragma unroll
                    for (int e = 0; e < 4; ++e) { v0[e] = gelu_tanh(v0[e]); v1[e] = gelu_tanh(v1[e]); }
                    u32x4 o; o.x = cvt_pk_bf16(v0[0], v0[1]); o.y = cvt_pk_bf16(v0[2], v0[3]); o.z = cvt_pk_bf16(v1[0], v1[1]); o.w = cvt_pk_bf16(v1[2], v1[3]);
                    *(u32x4*)(rowp + bj * HALF) = o; } }
    }
};
struct CmpOrder {
    int c, G;
    __device__ bool next(int i, Unit& u) const { const int L = i * G + c; if (L >= 32) return false; u.pm = L; u.pn = L >> 4; return true; }
    __device__ __forceinline__ void a_ready(const Unit&) const {}
    __device__ __forceinline__ void done(const Unit&) const {}
};
struct EpiRes1 {
    static constexpr bool PERM = true, AFTER_DRAIN = false, PERMA = false;
    const float* RINV; const float* INVW; bf16_t* X1b; float* SSQ;
    __device__ __forceinline__ void operator()(const f32x4 (&acc)[2][2][4][2], const Unit& u, int wr, int wc, int fr, int fq) const {
        const int row0 = u.pm * BM + wr * 64 + fr, col0 = u.pn * BM + wc * 32 + 8 * fq;
        f32x4 iw[2][2];
#pragma unroll
        for (int bj = 0; bj < 2; ++bj)
#pragma unroll
            for (int n = 0; n < 2; ++n) iw[bj][n] = *(const f32x4*)(INVW + col0 + bj * HALF + n * 4);
#pragma unroll
        for (int ai = 0; ai < 2; ++ai) {
            u32x4 xin[4][2]; float ri[4];
#pragma unroll
            for (int m = 0; m < 4; ++m) { ri[m] = RINV[row0 + ai * HALF + m * 16];
#pragma unroll
                for (int bj = 0; bj < 2; ++bj) xin[m][bj] = *(const u32x4*)(X1b + (size_t)(row0 + ai * HALF + m * 16) * D_MODEL + col0 + bj * HALF); }
            __builtin_amdgcn_sched_barrier(0);
#pragma unroll
            for (int m = 0; m < 4; ++m) { const int row = row0 + ai * HALF + m * 16; const size_t off = (size_t)row * D_MODEL + col0; float ss = 0.f;
#pragma unroll
                for (int bj = 0; bj < 2; ++bj) { const u32x4 w_ = xin[m][bj];
                    f32x4 x0, x1; x0[0] = __uint_as_float(w_.x << 16); x0[1] = __uint_as_float(w_.x & 0xffff0000u); x0[2] = __uint_as_float(w_.y << 16); x0[3] = __uint_as_float(w_.y & 0xffff0000u);
                    x1[0] = __uint_as_float(w_.z << 16); x1[1] = __uint_as_float(w_.z & 0xffff0000u); x1[2] = __uint_as_float(w_.w << 16); x1[3] = __uint_as_float(w_.w & 0xffff0000u);
                    const f32x4 v0 = x0 * ri[m] * iw[bj][0] + acc[ai][bj][m][0], v1 = x1 * ri[m] * iw[bj][1] + acc[ai][bj][m][1];
                    ss += ((v0[0] * v0[0] + v0[1] * v0[1]) + (v0[2] * v0[2] + v0[3] * v0[3])) + ((v1[0] * v1[0] + v1[1] * v1[1]) + (v1[2] * v1[2] + v1[3] * v1[3]));
                    u32x4 w; w.x = cvt_pk_bf16(v0[0], v0[1]); w.y = cvt_pk_bf16(v0[2], v0[3]); w.z = cvt_pk_bf16(v1[0], v1[1]); w.w = cvt_pk_bf16(v1[2], v1[3]); *(u32x4*)(X1b + off + bj * HALF) = w; }
                ss += __shfl_xor(ss, 16); ss += __shfl_xor(ss, 32);
                if (fq == 0) SSQ[(size_t)row * 32 + u.pn * 4 + wc] = ss; }
            __builtin_amdgcn_sched_barrier(0);
        }
    }
};
struct EpiUpV1 {
    static constexpr bool PERM = true, AFTER_DRAIN = false, PERMA = false;
    bf16_t* HID; const float* R2;
    __device__ __forceinline__ void operator()(const f32x4 (&acc)[2][2][4][2], const Unit& u, int wr, int wc, int fr, int fq) const {
        const int row0 = u.pm * BM + wr * 64 + fr, col0 = u.pn * BM + wc * 32 + 8 * fq;
#pragma unroll
        for (int ai = 0; ai < 2; ++ai)
#pragma unroll
            for (int m = 0; m < 4; ++m) { const int row = row0 + ai * HALF + m * 16; const float r = R2[row]; bf16_t* rowp = HID + (size_t)row * N_UP + col0;
#pragma unroll
                for (int bj = 0; bj < 2; ++bj) { const f32x4 v0 = acc[ai][bj][m][0] * r, v1 = acc[ai][bj][m][1] * r;
                    u32x4 o; o.x = cvt_pk_bf16(v0[0], v0[1]); o.y = cvt_pk_bf16(v0[2], v0[3]); o.z = cvt_pk_bf16(v1[0], v1[1]); o.w = cvt_pk_bf16(v1[2], v1[3]);
                    *(u32x4*)(rowp + bj * HALF) = o; } }
    }
};
struct EpiDown {
    static constexpr bool PERM = true, AFTER_DRAIN = false, PERMA = false;
    float* out; const bf16_t* X1b;
    __device__ __forceinline__ void operator()(const f32x4 (&acc)[2][2][4][2], const Unit& u, int wr, int wc, int fr, int fq) const {
        const int row0 = u.pm * BM + wr * 64 + fr, col0 = u.pn * BM + wc * 32 + 8 * fq;
#pragma unroll
        for (int ai = 0; ai < 2; ++ai) {
            u32x4 xin[4][2];
#pragma unroll
            for (int m = 0; m < 4; ++m)
#pragma unroll
                for (int bj = 0; bj < 2; ++bj) xin[m][bj] = *(const u32x4*)(X1b + (size_t)(row0 + ai * HALF + m * 16) * D_MODEL + col0 + bj * HALF);
            __builtin_amdgcn_sched_barrier(0);
#pragma unroll
            for (int m = 0; m < 4; ++m) { const size_t off = (size_t)(row0 + ai * HALF + m * 16) * D_MODEL + col0;
#pragma unroll
                for (int bj = 0; bj < 2; ++bj) { const u32x4 w = xin[m][bj];
                    f32x4 v0, v1; v0[0] = __uint_as_float(w.x << 16); v0[1] = __uint_as_float(w.x & 0xffff0000u); v0[2] = __uint_as_float(w.y << 16); v0[3] = __uint_as_float(w.y & 0xffff0000u);
                    v1[0] = __uint_as_float(w.z << 16); v1[1] = __uint_as_float(w.z & 0xffff0000u); v1[2] = __uint_as_float(w.w << 16); v1[3] = __uint_as_float(w.w & 0xffff0000u);
                    *(f32x4*)(out + off + bj * HALF) = v0 + acc[ai][bj][m][0]; *(f32x4*)(out + off + bj * HALF + 4) = v1 + acc[ai][bj][m][1]; } }
            __builtin_amdgcn_sched_barrier(0);
        }
    }
};
__device__ __forceinline__ unsigned f2bf_(float f) { unsigned u = __float_as_uint(f); return (u + 0x7fffu + ((u >> 16) & 1u)) >> 16; }
typedef float f32x2 __attribute__((ext_vector_type(2)));
struct EpiUpConv {
    static constexpr bool PERM = true, AFTER_DRAIN = false, PERMA = true;
    bf16_t* G; const float* R2; const float* cw; const float* cb; float* HLAST; float* FIRST; PG8_LAS unsigned char* xlds;
    __device__ __forceinline__ void prefetch(const Unit& u, int par, const int wave_s) const {
        const int lane_ = fresh_lane();
        PG8_LAS float* Wl = (PG8_LAS float*)xlds + (par ? 3344 : 2048);
#pragma unroll
        for (int i2 = 0; i2 < 2; ++i2) { const int i = wave_s * 64 + lane_ + 512 * i2, k = i >> 8, p = i & 255, c = (p < 128 ? 0 : D_FF - 128) + u.pn * 128 + p;
            const float* src = k < 3 ? cw + (unsigned)(k * N_UP + c) : cb + (unsigned)c;
            __builtin_amdgcn_global_load_lds((const unsigned*)src, (PG8_LAS unsigned*)(Wl + wave_s * 64 + 512 * i2), 4, 0, 0); }
        if (wave_s < 4) __builtin_amdgcn_global_load_lds((const unsigned*)(R2 + u.pm * BM + wave_s * 64 + lane_), (PG8_LAS unsigned*)(Wl + 1024 + wave_s * 64), 4, 0, 0);
    }
    __device__ __forceinline__ void run(const f32x4 (&acc)[2][2][4][2], const Unit& u, const Unit& nxt, const bool has_next, const int par, int wr, int wc, const int wave_s) const {
        unsigned z_ = 0u; asm volatile("" : "+v"(z_));
        const int lane_ = (int)__builtin_amdgcn_mbcnt_hi(~0u, __builtin_amdgcn_mbcnt_lo(~0u, z_)); const int fr = lane_ & 15, fq = lane_ >> 4;
        const int row0 = u.pm * BM + wr * 64 + 4 * fr;
        PG8_LAS float* X = (PG8_LAS float*)xlds;
        PG8_LAS float* Wl = X + (par ? 3344 : 2048);
        PG8_LAS float* R2L = Wl + 1024;
        const unsigned tile = (unsigned)(u.pm * (N_UP / 256) + u.pn);
        asm volatile("s_waitcnt vmcnt(8)" ::: "memory"); __builtin_amdgcn_s_barrier(); asm volatile("" ::: "memory");
        if (has_next) prefetch(nxt, par ^ 1, wave_s);
        if (fr == 15) {
#pragma unroll
            for (int ai = 0; ai < 2; ++ai) { const int sg = 2 * ai + wr; const float r2a = R2L[ai * HALF + wr * 64 + 62], r2b = R2L[ai * HALF + wr * 64 + 63];
#pragma unroll
                for (int mm = 0; mm < 2; ++mm)
#pragma unroll
                for (int bj = 0; bj < 2; ++bj)
#pragma unroll
                    for (int n = 0; n < 2; ++n) { const f32x4 h = acc[ai][bj][2 + mm][n] * (mm ? r2b : r2a);
                        *(PG8_LAS f32x4*)(X + ((sg * 4 + wc) * 2 + mm) * 64 + bj * 32 + 8 * fq + 4 * n) = h;
                        if (ai == 1 && wr == 1) *(f32x4*)(HLAST + (unsigned)((tile * 2 + mm) * 256 + bj * HALF + wc * 32 + 8 * fq + 4 * n)) = h; } }
        }
        asm volatile("s_waitcnt lgkmcnt(0)" ::: "memory"); __builtin_amdgcn_s_barrier(); asm volatile("" ::: "memory");
        const int cbase = u.pn * 128 + wc * 32 + 8 * fq;
        const bool seq_start = (u.pm & 15) == 0;
#pragma unroll
        for (int ai = 0; ai < 2; ++ai) {
            const int sg = 2 * ai + wr;
            const f32x4 rs = *(PG8_LAS const f32x4*)(R2L + ai * HALF + wr * 64 + 4 * fr);
            const bool defer = (ai == 0) && (wr == 0) && !seq_start && (fr == 0);
            unsigned pk[2][4][2];
#pragma unroll
            for (int n = 0; n < 2; ++n) {
#pragma unroll
                for (int e2 = 0; e2 < 2; ++e2) {
                    asm volatile("" ::: "memory"); __builtin_amdgcn_sched_barrier(0);
                    PG8_LAS const f32x2* wp = (PG8_LAS const f32x2*)(Wl + wc * 32 + 8 * fq + 4 * n + 2 * e2);
                    const f32x2 wg0 = wp[0], wg1 = wp[128], wg2 = wp[256], bg = wp[384], wu0 = wp[64], wu1 = wp[192], wu2 = wp[320], bu = wp[448];
                    f32x2 hg1 = {0.f, 0.f}, hg2 = {0.f, 0.f}, hu1 = {0.f, 0.f}, hu2 = {0.f, 0.f};
                    if (ai == 1 || wr == 1) { PG8_LAS const f32x2* xp = (PG8_LAS const f32x2*)(X + (((sg - 1) * 4 + wc) * 2) * 64 + 8 * fq + 4 * n + 2 * e2); hg2 = xp[0]; hg1 = xp[32]; hu2 = xp[16]; hu1 = xp[48]; }
                    f32x2 vg[4], vu[4], cg[4], cu[4];
#pragma unroll
                    for (int m = 0; m < 4; ++m) { const f32x2 r2 = {rs[m], rs[m]};
                        vg[m] = (f32x2){acc[ai][0][m][n][2 * e2], acc[ai][0][m][n][2 * e2 + 1]} * r2; vu[m] = (f32x2){acc[ai][1][m][n][2 * e2], acc[ai][1][m][n][2 * e2 + 1]} * r2; }
#define EPI_SHR1(old_, v_) (f32x2){__uint_as_float(__builtin_amdgcn_update_dpp(__float_as_uint((old_).x), __float_as_uint((v_).x), 0x111, 0xf, 0xf, false)), __uint_as_float(__builtin_amdgcn_update_dpp(__float_as_uint((old_).y), __float_as_uint((v_).y), 0x111, 0xf, 0xf, false))}
                    const f32x2 pg1 = EPI_SHR1(hg1, vg[3]), pg2 = EPI_SHR1(hg2, vg[2]), pu1 = EPI_SHR1(hu1, vu[3]), pu2 = EPI_SHR1(hu2, vu[2]);
#undef EPI_SHR1
                    cg[0] = bg + wg0 * pg2 + wg1 * pg1 + wg2 * vg[0]; cu[0] = bu + wu0 * pu2 + wu1 * pu1 + wu2 * vu[0];
                    cg[1] = bg + wg0 * pg1 + wg1 * vg[0] + wg2 * vg[1]; cu[1] = bu + wu0 * pu1 + wu1 * vu[0] + wu2 * vu[1];
                    cg[2] = bg + wg0 * vg[0] + wg1 * vg[1] + wg2 * vg[2]; cu[2] = bu + wu0 * vu[0] + wu1 * vu[1] + wu2 * vu[2];
                    cg[3] = bg + wg0 * vg[1] + wg1 * vg[2] + wg2 * vg[3]; cu[3] = bu + wu0 * vu[1] + wu1 * vu[2] + wu2 * vu[3];
                    if (defer) {
#pragma unroll
                        for (int m = 0; m < 2; ++m) { float* fp = FIRST + (unsigned)((tile * 2 + m) * 256 + wc * 32 + 8 * fq + 4 * n + 2 * e2); *(f32x2*)fp = cg[m]; *(f32x2*)(fp + HALF) = cu[m]; }
                    }
#pragma unroll
                    for (int m = 0; m < 4; ++m) {
                        const f32x2 t = cg[m] * (f32x2){-LOG2E, -LOG2E};
                        f32x2 sg_ = {__builtin_amdgcn_exp2f(t.x), __builtin_amdgcn_exp2f(t.y)};
                        sg_ = sg_ + (f32x2){1.0f, 1.0f};
                        const f32x2 rc = {__builtin_amdgcn_rcpf(sg_.x), __builtin_amdgcn_rcpf(sg_.y)};
                        const f32x2 gv = cg[m] * rc * cu[m];
                        pk[n][m][e2] = cvt_pk_bf16(gv.x, gv.y);
                    }
                }
            }
#pragma unroll
            for (int m = 0; m < 4; ++m)
                if (!(m < 2 && defer)) { u32x4 o; o.x = pk[0][m][0]; o.y = pk[0][m][1]; o.z = pk[1][m][0]; o.w = pk[1][m][1]; *(u32x4*)(G + (unsigned)((row0 + ai * HALF + m) * D_FF + cbase)) = o; }
        }
    }
};
template <class Epi, class Sched, bool ALIGN_EPI = false, bool SP2 = false>
__device__ __forceinline__ void gemm_phase(PG8_LAS unsigned char* lds, const Gemm g, const Sched& S, const Epi& E, const int wave_s) {
    const int tid = fresh_tid(wave_s), wid = wave_s, lane = tid & 63,
          wr = wid >> 2, wc = wid & 3, fr = lane & 15, fq = lane >> 4;
    const int K = g.K, nt = K / BK;
    unsigned voffA[2], voffB[2];
#pragma unroll
    for (int i = 0; i < 2; ++i) { int R, C; stage_rc(tid * 16 + i * 8192, R, C); const int Rb = Epi::PERM ? ((R & ~31) + perm32(R & 31)) : R;
        const int Ra = Epi::PERMA ? ((R & ~63) + 4 * (R & 15) + ((R >> 4) & 3)) : R;
        voffA[i] = (unsigned)(Ra * g.lda + C) * 2u; voffB[i] = (unsigned)(Rb * K + C) * 2u; }
    const size_t kstep = (size_t)(BK * 2);
    const size_t hstepA = (size_t)HALF * g.lda * 2, hstepB = (size_t)HALF * K * 2;
    const size_t tstepA = 2 * hstepA, tstepB = 2 * hstepB;
    const unsigned ldsw = (unsigned)wid * 1024u;
    const int aoff = lds_byte(wr * 64 + fr, fq * 8), boff = lds_byte(wc * 32 + fr, fq * 8);
#define PG8_SA(b, h) (((b) * 2 + (h)) * HTB)
#define PG8_SB(b, h) ((4 + (b) * 2 + (h)) * HTB)
#define PG8_STAGE(bufoff, gbase, voff) do { _Pragma("unroll") for (int _i = 0; _i < 2; ++_i) \
        __builtin_amdgcn_global_load_lds((const unsigned*)((const char*)(gbase) + (voff)[_i]), (PG8_LAS unsigned*)(lds + (bufoff) + ldsw + _i * 8192), 16, 0, 0); } while (0)
#define PG8_LDA(dst, b, h) do { _Pragma("unroll") for (int m = 0; m < 4; ++m) _Pragma("unroll") for (int k = 0; k < 2; ++k) dst[m][k] = *(const PG8_LAS bf16x8*)(lds + PG8_SA(b, h) + aoff + m * 2048 + k * 1024); } while (0)
#define PG8_LDB(dst, b, h) do { _Pragma("unroll") for (int n = 0; n < 2; ++n) _Pragma("unroll") for (int k = 0; k < 2; ++k) dst[n][k] = *(const PG8_LAS bf16x8*)(lds + PG8_SB(b, h) + boff + n * 2048 + k * 1024); } while (0)
#define PG8_MMA(ai, bj, At, Bt) do { __builtin_amdgcn_s_setprio(1); _Pragma("unroll") for (int m = 0; m < 4; ++m) _Pragma("unroll") for (int n = 0; n < 2; ++n) _Pragma("unroll") for (int k = 0; k < 2; ++k) \
        acc[ai][bj][m][n] = __builtin_amdgcn_mfma_f32_16x16x32_bf16(Bt[n][k], At[m][k], acc[ai][bj][m][n], 0, 0, 0); __builtin_amdgcn_s_setprio(0); } while (0)
#define PG8_WAIT_V(n) asm volatile("s_waitcnt vmcnt(" #n ")" ::: "memory")
#define PG8_WAIT_L(n) asm volatile("s_waitcnt lgkmcnt(" #n ")" ::: "memory")
#define PG8_BAR __builtin_amdgcn_s_barrier()
#define PG8_SCHED __builtin_amdgcn_sched_barrier(0)
    Unit cur, nxt; int ui = 0;
    if (!S.next(0, cur)) return;
    f32x4 acc[2][2][4][2];
#pragma unroll
    for (int a = 0; a < 2; ++a)
#pragma unroll
        for (int b = 0; b < 2; ++b)
#pragma unroll
            for (int m = 0; m < 4; ++m)
#pragma unroll
                for (int n = 0; n < 2; ++n) acc[a][b][m][n] = (f32x4){0.f, 0.f, 0.f, 0.f};
    bf16x8 At[4][2], B0[2][2], B1[2][2];
    const char* cA = (const char*)g.A + (size_t)cur.pm * tstepA; const char* cB = (const char*)g.Bt + (size_t)cur.pn * tstepB;
    S.a_ready(cur);
    if constexpr (Epi::PERMA) E.prefetch(cur, 0, wave_s);
    if constexpr (SP2) {
        PG8_STAGE(PG8_SB(0, 0), cB, voffB); PG8_STAGE(PG8_SB(0, 1), cB + hstepB, voffB); PG8_STAGE(PG8_SA(0, 0), cA, voffA); PG8_STAGE(PG8_SA(0, 1), cA + hstepA, voffA);
        if (wr == 1) PG8_BAR;
        PG8_WAIT_V(2); PG8_BAR;
        PG8_STAGE(PG8_SB(1, 0), cB + kstep, voffB); PG8_STAGE(PG8_SA(1, 0), cA + kstep, voffA); PG8_STAGE(PG8_SB(1, 1), cB + hstepB + kstep, voffB);
        PG8_WAIT_V(6); PG8_BAR;
    } else {
        PG8_STAGE(PG8_SB(0, 0), cB, voffB); PG8_STAGE(PG8_SA(0, 0), cA, voffA); PG8_STAGE(PG8_SB(0, 1), cB + hstepB, voffB); PG8_STAGE(PG8_SA(0, 1), cA + hstepA, voffA);
        if (wr == 1) PG8_BAR;
        PG8_WAIT_V(4); PG8_BAR;
        PG8_STAGE(PG8_SB(1, 0), cB + kstep, voffB); PG8_STAGE(PG8_SA(1, 0), cA + kstep, voffA); PG8_STAGE(PG8_SB(1, 1), cB + hstepB + kstep, voffB);
        PG8_WAIT_V(6); PG8_BAR;
    }
    for (;;) {
        const bool has_next = S.next(ui + 1, nxt);
        const char* nA = has_next ? (const char*)g.A + (size_t)nxt.pm * tstepA : cA; const char* nB = has_next ? (const char*)g.Bt + (size_t)nxt.pn * tstepB : cB;
        for (int t = 0; t < nt; t += 2) {
            const bool last = (t == nt - 2);
            const char* a1 = cA + (size_t)(t + 1) * kstep;
            const char* a2 = last ? nA : cA + (size_t)(t + 2) * kstep; const char* b2 = last ? nB : cB + (size_t)(t + 2) * kstep;
            const char* a3 = a2 + kstep; const char* b3 = b2 + kstep;
            if (last && has_next) S.a_ready(nxt);
            if constexpr (SP2) {
            PG8_LDB(B0, 0, 0); PG8_LDB(B1, 0, 1); PG8_SCHED; PG8_LDA(At, 0, 0); PG8_STAGE(PG8_SA(1, 1), a1 + hstepA, voffA);
            PG8_WAIT_V(8); PG8_WAIT_L(0); PG8_BAR; PG8_MMA(0, 0, At, B0); PG8_MMA(0, 1, At, B1); PG8_BAR; PG8_SCHED;
            PG8_LDA(At, 0, 1); PG8_STAGE(PG8_SB(0, 0), b2, voffB); PG8_STAGE(PG8_SB(0, 1), b2 + hstepB, voffB); PG8_STAGE(PG8_SA(0, 0), a2, voffA);
            PG8_WAIT_V(8); PG8_WAIT_L(0); PG8_BAR; PG8_MMA(1, 0, At, B0); PG8_MMA(1, 1, At, B1); PG8_BAR; PG8_SCHED;
            PG8_LDB(B0, 1, 0); PG8_LDB(B1, 1, 1); PG8_SCHED; PG8_LDA(At, 1, 0); PG8_STAGE(PG8_SA(0, 1), a2 + hstepA, voffA);
            PG8_WAIT_V(8); PG8_WAIT_L(0); PG8_BAR; PG8_MMA(0, 0, At, B0); PG8_MMA(0, 1, At, B1); PG8_BAR; PG8_SCHED;
            PG8_LDA(At, 1, 1); PG8_STAGE(PG8_SB(1, 0), b3, voffB); PG8_STAGE(PG8_SB(1, 1), b3 + hstepB, voffB); PG8_STAGE(PG8_SA(1, 0), a3, voffA);
            PG8_WAIT_V(8); PG8_WAIT_L(0); PG8_BAR; PG8_MMA(1, 0, At, B0); PG8_MMA(1, 1, At, B1); PG8_BAR; PG8_SCHED;
            } else {
            PG8_LDB(B0, 0, 0); PG8_SCHED; PG8_LDA(At, 0, 0); PG8_STAGE(PG8_SA(1, 1), a1 + hstepA, voffA);
            PG8_WAIT_L(8); PG8_BAR; PG8_WAIT_L(0); PG8_MMA(0, 0, At, B0); PG8_BAR; PG8_SCHED;
            PG8_LDB(B1, 0, 1); PG8_STAGE(PG8_SB(0, 0), b2, voffB);
            PG8_BAR; PG8_WAIT_L(0); PG8_MMA(0, 1, At, B1); PG8_BAR;
            PG8_LDA(At, 0, 1); PG8_STAGE(PG8_SA(0, 0), a2, voffA);
            PG8_BAR; PG8_WAIT_L(0); PG8_MMA(1, 0, At, B0); PG8_BAR; PG8_SCHED;
            PG8_STAGE(PG8_SB(0, 1), b2 + hstepB, voffB);
            PG8_WAIT_V(6); PG8_BAR; PG8_MMA(1, 1, At, B1); PG8_BAR;
            PG8_LDB(B0, 1, 0); PG8_SCHED; PG8_LDA(At, 1, 0); PG8_STAGE(PG8_SA(0, 1), a2 + hstepA, voffA);
            PG8_WAIT_L(8); PG8_BAR; PG8_WAIT_L(0); PG8_MMA(0, 0, At, B0); PG8_BAR; PG8_SCHED;
            PG8_LDB(B1, 1, 1); PG8_STAGE(PG8_SB(1, 0), b3, voffB);
            PG8_BAR; PG8_WAIT_L(0); PG8_MMA(0, 1, At, B1); PG8_BAR;
            PG8_LDA(At, 1, 1); PG8_STAGE(PG8_SA(1, 0), a3, voffA);
            PG8_BAR; PG8_WAIT_L(0); PG8_MMA(1, 0, At, B0); PG8_BAR; PG8_SCHED;
            PG8_STAGE(PG8_SB(1, 1), b3 + hstepB, voffB);
            PG8_WAIT_V(6); PG8_BAR; PG8_MMA(1, 1, At, B1); PG8_BAR;
            }
        }
        if constexpr (ALIGN_EPI) { if (wr == 0) PG8_BAR; }
        if constexpr (Epi::PERMA) { E.run(acc, cur, nxt, has_next, ui & 1, wr, wc, wave_s); S.done(cur); }
        else if constexpr (!Epi::AFTER_DRAIN) { E(acc, cur, wr, wc, fr, fq); S.done(cur); }
        if (!has_next) break;
#pragma unroll
        for (int a = 0; a < 2; ++a)
#pragma unroll
            for (int b = 0; b < 2; ++b)
#pragma unroll
                for (int m = 0; m < 4; ++m)
#pragma unroll
                    for (int n = 0; n < 2; ++n) acc[a][b][m][n] = (f32x4){0.f, 0.f, 0.f, 0.f};
        cur = nxt; cA = nA; cB = nB; ++ui;
        if constexpr (ALIGN_EPI) { if (wr == 1) PG8_BAR; }
    }
    PG8_WAIT_V(0);
    if constexpr (!ALIGN_EPI) { if (wr == 0) PG8_BAR; }
    PG8_BAR;
    if constexpr (Epi::AFTER_DRAIN) { E.fused(acc, cur, wr, wc, fr, fq, lds, wid, lane); S.done(cur); }
#undef PG8_SA
#undef PG8_SB
#undef PG8_STAGE
#undef PG8_LDA
#undef PG8_LDB
#undef PG8_MMA
#undef PG8_WAIT_V
#undef PG8_WAIT_L
#undef PG8_BAR
#undef PG8_SCHED
}
}
constexpr int NWAVES = 8;
template <class RowMap>
__device__ __forceinline__ void transpose_item(const float* __restrict__ W, int K, int N, bf16_t* WT, const float* __restrict__ kscale, RowMap rm, LAS float* scr, int item, int lane) {
    const int nblk = (N + 31) / 32, kb = item / nblk, nb = item % nblk, k0 = 64 * kb, n0 = 32 * nb;
    const int nr = n0 + (lane & 31);
    float v[32];
#pragma unroll
    for (int i = 0; i < 32; ++i) { const int kk = 2 * i + (lane >> 5); v[i] = (nr < N) ? __builtin_nontemporal_load(W + (size_t)(k0 + kk) * N + nr) : 0.f; }
    if (kscale) {
#pragma unroll
        for (int i = 0; i < 32; ++i) v[i] *= kscale[k0 + 2 * i + (lane >> 5)];
    }
#pragma unroll
    for (int i = 0; i < 32; ++i) scr[(2 * i + (lane >> 5)) * 33 + (lane & 31)] = v[i];
    asm volatile("s_waitcnt lgkmcnt(0)" ::: "memory");
    const int c = lane & 7;
#pragma unroll
    for (int j = 0; j < 4; ++j) { const int nl = (lane >> 3) + 8 * j, n = n0 + nl;
        if (n < N) { const LAS float* s = scr + (8 * c) * 33 + nl;
            u32x4_t o; o.x = pk2(s[0 * 33], s[1 * 33]); o.y = pk2(s[2 * 33], s[3 * 33]); o.z = pk2(s[4 * 33], s[5 * 33]); o.w = pk2(s[6 * 33], s[7 * 33]);
            *(u32x4_t*)(WT + (size_t)rm(n) * K + k0 + 8 * c) = o; } }
    asm volatile("s_waitcnt lgkmcnt(0)" ::: "memory");
}
struct RmIdent { __device__ __forceinline__ int operator()(int n) const { return n; } };
struct RmWin {
    __device__ __forceinline__ int operator()(int c) const {
        const int nc = c < 2560 ? c : (c < 2608 ? 4608 + (c - 2560) : 2560 + (c - 2608));
        const int tile = nc >> 8, L = nc & 255, wc = L >> 6, bj = (L >> 5) & 1, j = L & 31;
        return tile * 256 + 128 * bj + 32 * wc + j;
    }
};
struct RmWup {
    __device__ __forceinline__ int operator()(int c) const { const int up = c >= D_FF, cc = up ? c - D_FF : c; return (cc >> 7) * 256 + up * 128 + (cc & 127); }
};

struct Ptrs {
    const float* in[18]; float* out; unsigned char* ws;
};

__device__ __forceinline__ void p0_prologue(const Ptrs& P, LAS unsigned char* lds, int vcu, int G, const int wave) {
    const int lane = fresh_lane();
    LAS float* scr = (LAS float*)(lds + wave * 16384);
    const int gw = vcu * NWAVES + wave, NGW = G * NWAVES;
    unsigned char* ws = P.ws;
    bf16_t* WinT = (bf16_t*)(ws + WS_WIN); bf16_t* WoutT = (bf16_t*)(ws + WS_WOUT); bf16_t* WupT = (bf16_t*)(ws + WS_WUP); bf16_t* WdownT = (bf16_t*)(ws + WS_WDOWN); bf16_t* W1cT = (bf16_t*)(ws + WS_W1C);
    const float* x = P.in[0]; const float* attn_norm_w = P.in[1]; const float* w_in = P.in[2]; const float* cmp_pos = P.in[5]; const float* cmp_w1 = P.in[6];
    const float* w_out = P.in[12]; const float* ffn_norm_w = P.in[13]; const float* w_up = P.in[14]; const float* w_down = P.in[17];
    constexpr int I_IN = 32 * 146, I_W1 = 32 * 8, I_W2 = 4 * 2;
    constexpr int NITEMS = I_IN + 2 * I_W1 + 2 * I_W2;
    (void)w_out; (void)w_up; (void)w_down; (void)ffn_norm_w; (void)WoutT; (void)WupT; (void)WdownT;
    for (int it = gw; it < NITEMS; it += NGW) {
        int r = it;
        if (r < I_IN) { transpose_item(w_in, 2048, IN_COLS, WinT, nullptr, RmWin(), scr, r, lane); continue; } r -= I_IN;
        if (r < I_W1) { transpose_item(cmp_w1, 2048, 256, W1cT, nullptr, RmIdent(), scr, r, lane); continue; } r -= I_W1;
        if (r < I_W1) { transpose_item(cmp_w1 + (size_t)2048 * 256, 2048, 256, W1cT + (size_t)256 * 2048, nullptr, RmIdent(), scr, r, lane); continue; } r -= I_W1;
        { const int kv = r >= I_W2 ? 1 : 0; transpose_item(P.in[7] + (size_t)kv * 256 * 64, 256, 64, (bf16_t*)(ws + WS_SMALL + SM_W2T) + (size_t)kv * 64 * 256, nullptr, RmIdent(), scr, r - kv * I_W2, lane); }
    }
    for (int i = gw * 64 + lane; i < 8 * 16384; i += NGW * 64) { const int t = (i >> 7) & 127, sx = i & 127; ((bf16_t*)(ws + WS_SMALL + SM_SWB))[i] = (bf16_t)(sx <= t ? f2bf(P.in[10][i]) : 0u); }
    for (int p = gw; p < 256; p += NGW) {
        const int L = 64 * ((p >> 5) & 3) + 32 * (p >> 7) + (p & 31);
        if (L >= 48) { u32x4_t z = {0u, 0u, 0u, 0u}; u32x4_t* d = (u32x4_t*)(WinT + (size_t)(18 * 256 + p) * 2048);
#pragma unroll
            for (int j = 0; j < 4; ++j) d[lane + 64 * j] = z; }
    }
    bf16_t* XN = (bf16_t*)(ws + WS_XN);
    for (int m = gw; m < MTOK; m += 2 * NGW) {
        const int m2 = m + NGW;
        const f32x4_t* xr = (const f32x4_t*)(x + (size_t)m * D_MODEL) + lane;
        const f32x4_t* xr2 = (const f32x4_t*)(x + (size_t)(m2 < MTOK ? m2 : m) * D_MODEL) + lane;
        f32x4_t v[8], v2[8]; float s = 0.f, s2 = 0.f;
#pragma unroll
        for (int j = 0; j < 8; ++j) { v[j] = __builtin_nontemporal_load(xr + 64 * j); v2[j] = __builtin_nontemporal_load(xr2 + 64 * j); }
#pragma unroll
        for (int j = 0; j < 8; ++j) { s += (v[j][0] * v[j][0] + v[j][1] * v[j][1]) + (v[j][2] * v[j][2] + v[j][3] * v[j][3]); s2 += (v2[j][0] * v2[j][0] + v2[j][1] * v2[j][1]) + (v2[j][2] * v2[j][2] + v2[j][3] * v2[j][3]); }
        const float ms1 = wave_sum(s) * (1.0f / D_MODEL) + 1e-6f, ms2 = wave_sum(s2) * (1.0f / D_MODEL) + 1e-6f;
        const float r = __builtin_amdgcn_rsqf(ms1), r2 = __builtin_amdgcn_rsqf(ms2);
        if (lane == 0) { float* rinv = (float*)(ws + WS_SMALL + SM_RINV); rinv[m] = ms1 * r; if (m2 < MTOK) rinv[m2] = ms2 * r2; }
        u32x2_t* o8 = (u32x2_t*)(XN + (size_t)m * D_MODEL) + lane; u32x2_t* o82 = (u32x2_t*)(XN + (size_t)m2 * D_MODEL) + lane;
#pragma unroll
        for (int j = 0; j < 8; ++j) { const f32x4_t w = ((const f32x4_t*)attn_norm_w)[lane + 64 * j];
            u32x2_t o; o.x = pk2(v[j][0] * r * w[0], v[j][1] * r * w[1]); o.y = pk2(v[j][2] * r * w[2], v[j][3] * r * w[3]); o8[64 * j] = o;
            if (m2 < MTOK) { u32x2_t q; q.x = pk2(v2[j][0] * r2 * w[0], v2[j][1] * r2 * w[1]); q.y = pk2(v2[j][2] * r2 * w[2], v2[j][3] * r2 * w[3]); o82[64 * j] = q; } }
    }
    for (int i = gw * 64 + lane; i < D_MODEL; i += NGW * 64) ((float*)(ws + WS_SMALL + SM_INVW))[i] = 1.0f / attn_norm_w[i];
    float* BIASP = (float*)(ws + WS_SMALL + SM_BIASP);
    for (int it = gw; it < 64; it += NGW) {
        const int kv = it >> 5, kc = it & 31; f32x4_t a = {0.f, 0.f, 0.f, 0.f};
        const float* pp = cmp_pos + kv * 2048 + kc * 64; const float* w1 = cmp_w1 + ((size_t)kv * 2048 + kc * 64) * 256;
        for (int k = 0; k < 64; ++k) { const f32x4_t w = ((const f32x4_t*)(w1 + (size_t)k * 256))[lane]; a += w * pp[k]; }
        ((f32x4_t*)(BIASP + (size_t)it * 256))[lane] = a;
    }
}

__device__ __forceinline__ void bias1_stage(unsigned char* ws, int idx  ) {
    const float* BIASP = (const float*)(ws + WS_SMALL + SM_BIASP); float* BIAS1 = (float*)(ws + WS_SMALL + SM_BIAS1);
    const int kv = idx >> 8, j = idx & 255; float s = 0.f;
    for (int kc = 0; kc < 32; ++kc) s += BIASP[(size_t)(kv * 32 + kc) * 256 + j];
    BIAS1[idx] = s;
}
__device__ __forceinline__ void cmp2_row(const Ptrs& P, int R, int lane) {
    unsigned char* ws = P.ws; const bf16_t* HC = (const bf16_t*)(ws + WS_HC);
    const int kv = R >> 12, rr = R & 4095, n = rr & 255;
    bf16_t* dst = (bf16_t*)(ws + (kv ? WS_VC : WS_KC)) + (size_t)rr * 64 + lane;
    if (n == 255) { *dst = 0; return; }
    const float* w2 = P.in[7] + (size_t)kv * 256 * 64;
    const u32x2_t hr = *(const u32x2_t*)(HC + (size_t)R * 256 + 4 * lane);
    float h[4] = {__uint_as_float(hr.x << 16), __uint_as_float(hr.x & 0xffff0000u), __uint_as_float(hr.y << 16), __uint_as_float(hr.y & 0xffff0000u)};
    float o = 0.f;
    for (int jj = 0; jj < 64; ++jj) {
#pragma unroll
        for (int i = 0; i < 4; ++i) o += __shfl(h[i], jj) * w2[(size_t)(4 * jj + i) * 64 + lane];
    }
    if (kv == 0) { const float ss = wave_sum(o * o); o *= __builtin_amdgcn_rsqf(ss * (1.0f / 64.0f) + 1e-6f) * P.in[4][lane]; }
    *dst = (bf16_t)f2bf(o);
}

__device__ __forceinline__ void gmlp_unit_v1(const Ptrs& P, LAS unsigned char* lds, int unit, const int wave_s) {
    unsigned char* ws = P.ws; const int tid = fresh_tid(wave_s);
    const int g = unit & 7, chunk = (unit >> 3) & 31, b = unit >> 8; const int m0 = b * SEQ + chunk * 128;
    LAS float* vn = (LAS float*)lds; LAS float* Wl = (LAS float*)(lds + 65536); LAS float* st = (LAS float*)(lds + 131072);
    const bf16_t* GV = (const bf16_t*)(ws + WS_GV); const bf16_t* U = (const bf16_t*)(ws + WS_U); const float* VSTAT = (const float*)(ws + WS_VSTAT);
    bf16_t* AB = (bf16_t*)(ws + WS_AB);
    const float* ln_w = P.in[8]; const float* ln_b = P.in[9]; const float* sw = P.in[10]; const float* sb = P.in[11];
    if (tid < 128) { const float* p = VSTAT + (size_t)(m0 + tid) * 32; float s1 = 0.f, s2 = 0.f;
#pragma unroll
        for (int i = 0; i < 16; ++i) { s1 += p[2 * i]; s2 += p[2 * i + 1]; }
        const float mean = s1 * (1.0f / 1024.0f); float var = s2 * (1.0f / 1024.0f) - mean * mean; var = var < 0.f ? 0.f : var;
        st[2 * tid] = mean; st[2 * tid + 1] = __builtin_amdgcn_rsqf(var + 1e-5f); }
    for (int i = 0; i < 32; ++i) { const int idx = tid + 512 * i, t = idx >> 7, s = idx & 127; Wl[idx] = (s <= t) ? sw[(size_t)g * 16384 + idx] : 0.f; }
    __syncthreads();
#pragma unroll
    for (int i = 0; i < 4; ++i) { const int idx = tid + 512 * i, s = idx >> 4, c8 = idx & 15;
        const u32x4_t raw = *(const u32x4_t*)(GV + (size_t)(m0 + s) * 1024 + g * 128 + 8 * c8); float f[8]; unpack8(raw, f);
        const float mean = st[2 * s], rstd = st[2 * s + 1];
#pragma unroll
        for (int e = 0; e < 8; ++e) { const int c = g * 128 + 8 * c8 + e; vn[s * 128 + 8 * c8 + e] = (f[e] - mean) * rstd * ln_w[c] + ln_b[c]; } }
    __syncthreads();
    const int c = tid & 127, tq = tid >> 7;
    for (int i = 0; i < 8; ++i) {
        const int t0 = 4 * (tq + 4 * i); float a0 = 0.f, a1 = 0.f, a2 = 0.f, a3 = 0.f;
        for (int s4 = 0; s4 <= t0; s4 += 4) {
            const f32x4_t w0 = *(const LAS f32x4_t*)(Wl + (t0 + 0) * 128 + s4), w1 = *(const LAS f32x4_t*)(Wl + (t0 + 1) * 128 + s4), w2 = *(const LAS f32x4_t*)(Wl + (t0 + 2) * 128 + s4), w3 = *(const LAS f32x4_t*)(Wl + (t0 + 3) * 128 + s4);
#pragma unroll
            for (int k = 0; k < 4; ++k) { const float v = vn[(s4 + k) * 128 + c]; a0 += w0[k] * v; a1 += w1[k] * v; a2 += w2[k] * v; a3 += w3[k] * v; }
        }
        const float av[4] = {a0, a1, a2, a3};
#pragma unroll
        for (int k = 0; k < 4; ++k) { const int t = t0 + k; const size_t row = (size_t)(m0 + t);
            const float uu = bf2f(U[row * 1024 + g * 128 + c]); AB[row * 2048 + 1024 + g * 128 + c] = (bf16_t)f2bf(uu * (av[k] + sb[g * 128 + t])); }
    }
    __syncthreads();
}

__device__ __forceinline__ void conv_item(const Ptrs& P, int b, int idx) {
    const int t = idx / 704, c8 = idx % 704, c0 = 8 * c8, j = c0 >> 7, i0 = c0 & 127;
    const bf16_t* HID = (const bf16_t*)(P.ws + WS_HID); const float* cw = P.in[15]; const float* cb = P.in[16];
    float gt[8], up[8];
#pragma unroll
    for (int e = 0; e < 8; ++e) { gt[e] = cb[c0 + e]; up[e] = cb[D_FF + c0 + e]; }
#pragma unroll
    for (int k = 0; k < 3; ++k) { const int tt = t - 2 + k; if (tt < 0) continue;
        float hg[8], hu[8]; unpack8(*(const u32x4_t*)(HID + (size_t)tt * N_UP + 256 * j + i0), hg); unpack8(*(const u32x4_t*)(HID + (size_t)tt * N_UP + 256 * j + 128 + i0), hu);
#pragma unroll
        for (int e = 0; e < 8; ++e) { gt[e] += cw[(size_t)k * N_UP + c0 + e] * hg[e]; up[e] += cw[(size_t)k * N_UP + D_FF + c0 + e] * hu[e]; } }
    float r[8];
#pragma unroll
    for (int e = 0; e < 8; ++e) r[e] = gt[e] * sigmoidf_(gt[e]) * up[e];
    u32x4_t o; o.x = pk2(r[0], r[1]); o.y = pk2(r[2], r[3]); o.z = pk2(r[4], r[5]); o.w = pk2(r[6], r[7]);
    *(u32x4_t*)((bf16_t*)(P.ws + WS_G) + ((size_t)b * SEQ + t) * D_FF + c0) = o;
}

constexpr int LW_CH = 32;
constexpr int LW_OUT = 32 * 64, LW_UP = 32 * 352, LW_DOWN = 88 * 64, LW_C_OUT = LW_OUT / LW_CH, LW_C_UP = LW_UP / LW_CH, LW_C_DOWN = LW_DOWN / LW_CH, LW_CHUNKS = LW_C_OUT + LW_C_UP + LW_C_DOWN;
static_assert(LW_OUT % LW_CH == 0 && LW_UP % LW_CH == 0 && LW_DOWN % LW_CH == 0, "late weight items per chunk");
template <class RowMap>
__device__ __forceinline__ void lw_load(float (&v)[32], const float* __restrict__ W, int N, int item, int lane) {
    const int nblk = N / 32, kb = item / nblk, nb = item % nblk;
    const float* p = W + (size_t)(64 * kb + (lane >> 5)) * N + 32 * nb + (lane & 31);
#pragma unroll
    for (int i = 0; i < 32; ++i) v[i] = __builtin_nontemporal_load(p + (size_t)(2 * i) * N);
}
template <class RowMap>
__device__ __forceinline__ void lw_store(const float (&v)[32], int K, int N, bf16_t* WT, const float* __restrict__ kscale, RowMap rm, LAS float* scr, int item, int lane) {
    const int nblk = N / 32, kb = item / nblk, nb = item % nblk, k0 = 64 * kb, n0 = 32 * nb;
    const int c = lane & 7;
    f32x4_t sc0 = {1.f, 1.f, 1.f, 1.f}, sc1 = sc0;
    if (kscale) { sc0 = *(const f32x4_t*)(kscale + k0 + 8 * c); sc1 = *(const f32x4_t*)(kscale + k0 + 8 * c + 4); }
#pragma unroll
    for (int i = 0; i < 32; ++i) scr[(2 * i + (lane >> 5)) * 33 + (lane & 31)] = v[i];
    asm volatile("s_waitcnt lgkmcnt(0)" ::: "memory");
#pragma unroll
    for (int j = 0; j < 4; ++j) { const int nl = (lane >> 3) + 8 * j; const LAS float* s = scr + (8 * c) * 33 + nl;
        u32x4_t o; o.x = pk2(s[0 * 33] * sc0[0], s[1 * 33] * sc0[1]); o.y = pk2(s[2 * 33] * sc0[2], s[3 * 33] * sc0[3]); o.z = pk2(s[4 * 33] * sc1[0], s[5 * 33] * sc1[1]); o.w = pk2(s[6 * 33] * sc1[2], s[7 * 33] * sc1[3]);
        *(u32x4_t*)(WT + (size_t)rm(n0 + nl) * K + k0 + 8 * c) = o; }
    asm volatile("s_waitcnt lgkmcnt(0)" ::: "memory");
}
template <class RowMap>
__device__ __forceinline__ void lw_run(const float* __restrict__ W, int K, int N, bf16_t* WT, const float* __restrict__ kscale, RowMap rm, LAS float* scr, int item0, int wave, int lane) {
    float va[32], vb[32];
    lw_load<RowMap>(va, W, N, item0 + wave, lane);
    lw_load<RowMap>(vb, W, N, item0 + wave + 8, lane);  lw_store(va, K, N, WT, kscale, rm, scr, item0 + wave, lane);
    lw_load<RowMap>(va, W, N, item0 + wave + 16, lane); lw_store(vb, K, N, WT, kscale, rm, scr, item0 + wave + 8, lane);
    lw_load<RowMap>(vb, W, N, item0 + wave + 24, lane); lw_store(va, K, N, WT, kscale, rm, scr, item0 + wave + 16, lane);
    lw_store(vb, K, N, WT, kscale, rm, scr, item0 + wave + 24, lane);
}
__device__ __forceinline__ void late_weight_chunk(const Ptrs& P, LAS unsigned char* lds, int chunk, const int wave) {
    const int lane = fresh_lane();
    LAS float* scr = (LAS float*)(lds + wave * 16384);
    unsigned char* ws = P.ws;
    if (chunk < LW_C_UP) lw_run(P.in[14], 2048, N_UP, (bf16_t*)(ws + WS_WUP), P.in[13], RmWup(), scr, chunk * LW_CH, wave, lane);
    else if (chunk < LW_C_UP + LW_C_DOWN) lw_run(P.in[17], D_FF, 2048, (bf16_t*)(ws + WS_WDOWN), nullptr, RmIdent(), scr, (chunk - LW_C_UP) * LW_CH, wave, lane);
    else lw_run(P.in[12], 2048, 2048, (bf16_t*)(ws + WS_WOUT), nullptr, RmIdent(), scr, (chunk - LW_C_UP - LW_C_DOWN) * LW_CH, wave, lane);
}

namespace nsa {
using bf16x8 = __attribute__((ext_vector_type(8))) short;
using s16x4 = __attribute__((ext_vector_type(4))) short;
using f32x16 = __attribute__((ext_vector_type(16))) float;
typedef float f32x2_t __attribute__((ext_vector_type(2))); typedef __bf16 bf16x2_t __attribute__((ext_vector_type(2)));
constexpr int L_K = 0, L_V = 16384, L_WSF = 32768, L_OST = 34816, L_IMP = 100352, L_MASK = 116736, L_WU = 117248, L_END = 117312;
constexpr int SLOTB = 8192;
constexpr float THR = 8.0f;
#define NSA_SBAR() __builtin_amdgcn_sched_barrier(0)
__device__ __forceinline__ int crow(int r, int hi) { return (r & 3) + 8 * (r >> 2) + 4 * hi; }
__device__ __forceinline__ void glds16(const void* gbase  , unsigned voff  , unsigned lds_dst) { unsigned keep;
    asm volatile("s_mov_b32 %0, m0\n\ts_mov_b32 m0, %3\n\ts_nop 0\n\tglobal_load_lds_dwordx4 %1, %2\n\ts_mov_b32 m0, %0" : "=&s"(keep) : "v"(voff), "s"(gbase), "s"(lds_dst) : "memory"); }
__device__ __forceinline__ unsigned cvtpk_s(float lo, float hi) { f32x2_t v = {lo, hi}; bf16x2_t b = __builtin_convertvector(v, bf16x2_t); return __builtin_bit_cast(unsigned, b); }
#define NSA_WAIT_BAR() asm volatile("s_waitcnt vmcnt(0) lgkmcnt(0)\n\ts_barrier" ::: "memory")

__device__ __forceinline__ void qkt(f32x16& p0, f32x16& p1, LAS const char* Kslot, const bf16x8 (&qr)[4], int r32, int hi) {
    LAS const char* kb = Kslot + hi * 1024 + r32 * 16;
#pragma unroll
    for (int d0 = 0; d0 < 4; ++d0) {
        const bf16x8 b0 = *(LAS const bf16x8*)(kb + d0 * 2048);
        const bf16x8 b1 = *(LAS const bf16x8*)(kb + d0 * 2048 + 512);
        p0 = __builtin_amdgcn_mfma_f32_32x32x16_bf16(b0, qr[d0], p0, 0, 0, 0); p1 = __builtin_amdgcn_mfma_f32_32x32x16_bf16(b1, qr[d0], p1, 0, 0, 0);
    }
}
struct VFrag { s16x4 lo[2][4], hi[2][4]; };
__device__ __forceinline__ void vload(VFrag& f, int vb) {
#pragma unroll
    for (int d0 = 0; d0 < 2; ++d0)
#pragma unroll
        for (int ks = 0; ks < 4; ++ks) {
            asm volatile("ds_read_b64_tr_b16 %0,%1 offset:%c2" : "=&v"(f.lo[d0][ks]) : "v"(vb), "i"(d0 * 4096 + ks * 1024) : "memory");
            asm volatile("ds_read_b64_tr_b16 %0,%1 offset:%c2" : "=&v"(f.hi[d0][ks]) : "v"(vb), "i"(d0 * 4096 + ks * 1024 + 512) : "memory"); }
}
__device__ __forceinline__ void pvmma(f32x16 (&o)[2], VFrag& f, bf16x8 pa0, bf16x8 pa1, bf16x8 pa2, bf16x8 pa3) {
    asm volatile("s_waitcnt lgkmcnt(0)" : "+v"(f.lo[0][0]), "+v"(f.lo[0][1]), "+v"(f.lo[0][2]), "+v"(f.lo[0][3]), "+v"(f.hi[0][0]), "+v"(f.hi[0][1]), "+v"(f.hi[0][2]), "+v"(f.hi[0][3]) :: "memory");
    asm volatile("" : "+v"(f.lo[1][0]), "+v"(f.lo[1][1]), "+v"(f.lo[1][2]), "+v"(f.lo[1][3]), "+v"(f.hi[1][0]), "+v"(f.hi[1][1]), "+v"(f.hi[1][2]), "+v"(f.hi[1][3]));
    NSA_SBAR();
#pragma unroll
    for (int d0 = 0; d0 < 2; ++d0) {
#define NSA_PK(k) (bf16x8){f.lo[d0][k][0], f.lo[d0][k][1], f.lo[d0][k][2], f.lo[d0][k][3], f.hi[d0][k][0], f.hi[d0][k][1], f.hi[d0][k][2], f.hi[d0][k][3]}
        o[d0] = __builtin_amdgcn_mfma_f32_32x32x16_bf16(pa0, NSA_PK(0), o[d0], 0, 0, 0);
        o[d0] = __builtin_amdgcn_mfma_f32_32x32x16_bf16(pa1, NSA_PK(1), o[d0], 0, 0, 0);
        o[d0] = __builtin_amdgcn_mfma_f32_32x32x16_bf16(pa2, NSA_PK(2), o[d0], 0, 0, 0);
        o[d0] = __builtin_amdgcn_mfma_f32_32x32x16_bf16(pa3, NSA_PK(3), o[d0], 0, 0, 0);
#undef NSA_PK
    }
}
__device__ __forceinline__ void pv(f32x16 (&o)[2], int vb, bf16x8 pa0, bf16x8 pa1, bf16x8 pa2, bf16x8 pa3) { VFrag f; vload(f, vb); pvmma(o, f, pa0, pa1, pa2, pa3); }
__device__ __forceinline__ float rowmax32(const f32x16& p0, const f32x16& p1) {
    float a = __builtin_fmaxf(p0[0], p1[0]);
#pragma unroll
    for (int r = 1; r < 16; ++r) a = __builtin_fmaxf(a, __builtin_fmaxf(p0[r], p1[r]));
    auto rr = __builtin_amdgcn_permlane32_swap(__float_as_uint(a), __float_as_uint(a), false, false);
    return __builtin_fmaxf(__uint_as_float(rr[0]), __uint_as_float(rr[1]));
}
struct State { float m, l; f32x16 o[2]; };
__device__ __forceinline__ void state_init(State& s) { s.m = -1e30f; s.l = 0.f; s.o[0] = f32x16{}; s.o[1] = f32x16{}; }

template <int BMUL, int MASK, bool LOADV>
__device__ __forceinline__ void tile_scores(f32x16& p0, f32x16& p1, LAS const char* Kslot, const bf16x8 (&qr)[4], const f32x16& bk, float c0, float b32, int lim, int r32, int hi, VFrag& vf, int vb) {
#pragma unroll
    for (int r = 0; r < 16; ++r) { const float b = (BMUL == 1) ? bk[r] + c0 : __builtin_fmaf(bk[r], (float)BMUL, c0); p0[r] = b; p1[r] = b + b32; }
    qkt(p0, p1, Kslot, qr, r32, hi);
    if (LOADV) vload(vf, vb);
    const int limh = lim - 4 * hi;
#pragma unroll
    for (int r = 0; r < 16; ++r) {
        const int kk = (r & 3) + 8 * (r >> 2);
        if (MASK == 1) { if (!(kk <= limh)) p0[r] = -INFINITY; if (!(kk + 32 <= limh)) p1[r] = -INFINITY; }
        if (MASK == 2) { if (!(kk > limh)) p0[r] = -INFINITY; if (!(kk + 32 > limh)) p1[r] = -INFINITY; }
        if (MASK == 3) { if (!(kk < limh)) p0[r] = -INFINITY; if (!(kk + 32 < limh)) p1[r] = -INFINITY; }
    }
}
__device__ __forceinline__ float tile_ref(const State& st, float rb0, bool rowlive) { return (st.m < -1e29f && rowlive) ? rb0 : st.m; }
__device__ __forceinline__ void tile_softmax_pv(State& st, f32x16& p0, f32x16& p1, float mref, VFrag& vf, LAS float* wsf, int r32, int hi) {
    float a0 = p0[0], a1 = p1[0];
#pragma unroll
    for (int r = 1; r < 16; ++r) { a0 = __builtin_fmaxf(a0, p0[r]); a1 = __builtin_fmaxf(a1, p1[r]); }
    float mx = __builtin_fmaxf(a0, a1);
    { auto rr = __builtin_amdgcn_permlane32_swap(__float_as_uint(mx), __float_as_uint(mx), false, false); mx = __builtin_fmaxf(__uint_as_float(rr[0]), __uint_as_float(rr[1])); }
    if (__any(mx > THR)) {
        const float dl = __builtin_fmaxf(mx, 0.f), alpha = __builtin_amdgcn_exp2f(-dl);
        mref += dl; st.l *= alpha;
        if (hi == 0) wsf[r32] = alpha;
        asm volatile("s_waitcnt lgkmcnt(0)" ::: "memory");
#pragma unroll
        for (int r = 0; r < 16; ++r) { const float a = wsf[crow(r, hi)]; st.o[0][r] *= a; st.o[1][r] *= a; p0[r] -= dl; p1[r] -= dl; }
    }
    st.m = mref;
    float ls = 0.f;
#pragma unroll
    for (int r = 0; r < 16; ++r) { p0[r] = __builtin_amdgcn_exp2f(p0[r]); p1[r] = __builtin_amdgcn_exp2f(p1[r]); ls += p0[r] + p1[r]; }
    st.l += ls;
    u32x4_t pw0, pw1, pw2, pw3;
    pw0 = (u32x4_t){cvtpk_s(p0[0], p0[1]), cvtpk_s(p0[2], p0[3]), cvtpk_s(p0[4], p0[5]), cvtpk_s(p0[6], p0[7])};
    pw1 = (u32x4_t){cvtpk_s(p0[8], p0[9]), cvtpk_s(p0[10], p0[11]), cvtpk_s(p0[12], p0[13]), cvtpk_s(p0[14], p0[15])};
    pw2 = (u32x4_t){cvtpk_s(p1[0], p1[1]), cvtpk_s(p1[2], p1[3]), cvtpk_s(p1[4], p1[5]), cvtpk_s(p1[6], p1[7])};
    pw3 = (u32x4_t){cvtpk_s(p1[8], p1[9]), cvtpk_s(p1[10], p1[11]), cvtpk_s(p1[12], p1[13]), cvtpk_s(p1[14], p1[15])};
    pvmma(st.o, vf, __builtin_bit_cast(bf16x8, pw0), __builtin_bit_cast(bf16x8, pw1), __builtin_bit_cast(bf16x8, pw2), __builtin_bit_cast(bf16x8, pw3));
}
template <bool FIRST>
__device__ __forceinline__ void fold_branch(LAS float* ostg, State& st, float gate, LAS float* wsf, int r32, int hi) {
    float l = st.l;
    { auto rr = __builtin_amdgcn_permlane32_swap(__float_as_uint(l), __float_as_uint(l), false, false); l = __uint_as_float(rr[0]) + __uint_as_float(rr[1]); }
    const float f = l > 0.f ? gate / l : 0.f;
    asm volatile("s_waitcnt lgkmcnt(0)" ::: "memory");
    if (hi == 0) wsf[r32] = f;
    asm volatile("s_waitcnt lgkmcnt(0)" ::: "memory");
#pragma unroll
    for (int r = 0; r < 16; ++r) { const int orow = crow(r, hi); const float a = wsf[orow];
#pragma unroll
        for (int d0 = 0; d0 < 2; ++d0) { LAS float* p = ostg + orow * 64 + d0 * 32 + r32; if (FIRST) *p = st.o[d0][r] * a; else *p += st.o[d0][r] * a; } }
    asm volatile("s_waitcnt lgkmcnt(0)" ::: "memory");
}

__device__ __forceinline__ int nsa_unit(const Ptrs& P, LAS unsigned char* lds, int bg, int qt, const int wave_s, unsigned* qctr, int qbase) {
    unsigned char* ws = P.ws;
    const int lane = fresh_lane(), r32 = lane & 31, hi = lane >> 5; const int wid = wave_s;
    const int b = bg >> 2, g = bg & 3, t0 = 64 * qt;
    const int tl = 8 * wid + (r32 >> 2), hq = r32 & 3;
    const size_t m0 = (size_t)b * SEQ + t0;
    const bf16_t* Q = (const bf16_t*)(ws + WS_Q); const bf16_t* KV6 = (const bf16_t*)(ws + WS_KV6);
    const bf16_t* KSb = KV6 + 2 * KVSZ + (size_t)bg * SEQ * 64; const bf16_t* VSb = KV6 + 3 * KVSZ + (size_t)bg * SEQ * 64;
    const bf16_t* KWb = KV6 + 4 * KVSZ + (size_t)bg * SEQ * 64; const bf16_t* VWb = KV6 + 5 * KVSZ + (size_t)bg * SEQ * 64;
    const bf16_t* KCb = (const bf16_t*)(ws + WS_KC) + (size_t)bg * 256 * 64; const bf16_t* VCb = (const bf16_t*)(ws + WS_VC) + (size_t)bg * 256 * 64;
    const float* GATES = (const float*)(ws + WS_GATES); bf16_t* AB = (bf16_t*)(ws + WS_AB);
    const unsigned lds0 = (unsigned)(uintptr_t)lds;
    LAS float* wsf = (LAS float*)(lds + L_WSF) + wid * 64;
    LAS float* IMP = (LAS float*)(lds + L_IMP);
    LAS unsigned* MASK = (LAS unsigned*)(lds + L_MASK); LAS unsigned* WU = (LAS unsigned*)(lds + L_WU);
    const int koff = lane * 64 + wid * 8, voff = (16 * (wid & 3) + (lane >> 2)) * 64 + (wid >> 2) * 32 + (lane & 3) * 8;
    const unsigned kdst = lds0 + L_K + wid * 1024, vdst = lds0 + L_V + wid * 1024;
#define NSA_DMA_K(base, tile, slot) glds16((base) + (size_t)(tile) * 4096, (unsigned)koff * 2u, (unsigned)__builtin_amdgcn_readfirstlane(kdst + (slot) * SLOTB))
#define NSA_DMA_V(base, tile, slot) glds16((base) + (size_t)(tile) * 4096, (unsigned)voff * 2u, (unsigned)__builtin_amdgcn_readfirstlane(vdst + (slot) * SLOTB))
    const int vb0 = (int)(lds0 + L_V) + ((lane >> 4) & 1) * 32 + (lane & 3) * 8 + (4 * hi + ((lane & 15) >> 2)) * 64;
    LAS const char* Kbase = (LAS const char*)(lds + L_K);
    bf16x8 qr[4];
    { const bf16_t* qp = Q + (m0 + tl) * 1024 + (4 * g + hq) * 64 + hi * 8;
#pragma unroll
      for (int d0 = 0; d0 < 4; ++d0) qr[d0] = *(const bf16x8*)(qp + d0 * 16); }
    const float sl2 = __builtin_amdgcn_exp2f(-0.5f * (float)(4 * g + hq + 1)) * LOG2E;
    f32x16 bk;
#pragma unroll
    for (int r = 0; r < 16; ++r) bk[r] = sl2 * (float)((r & 3) + 8 * (r >> 2));
    const float b32t = 32.0f * sl2, b32c = 512.0f * sl2, hoff_t = 4.0f * (float)hi * sl2, hoff_c = 64.0f * (float)hi * sl2;
    float gate[3];
    { const float* gp = GATES + (m0 + tl) * 48 + (4 * g + hq) * 3; gate[0] = gp[0]; gate[1] = gp[1]; gate[2] = gp[2]; }
    LAS float* ostg = (LAS float*)(lds + L_OST) + wid * 2048;
    State st;
    f32x16 p0, p1;
    int nxt_ticket = 0;

    int tc = 0;
    VFrag vf;
    const int nvmax = (t0 + 63 >= 31) ? ((t0 + 63 - 31) >> 4) + 1 : 0;
    const int nct = (nvmax + 63) >> 6;
    const int tq = t0 + tl, nv = tq >= 31 ? ((tq - 31) >> 4) + 1 : 0;
    {
        state_init(st);
        const int j0 = qt >= 8 ? qt - 8 : 0, nt = qt - j0 + 1;
        NSA_DMA_K(KWb, qt, 0); NSA_DMA_V(VWb, qt, 0); NSA_WAIT_BAR();
        for (int i = 0; i < nt; ++i) {
            const int j = qt - i, slot = (tc + i) & 1;
            if (i + 1 < nt) { NSA_DMA_K(KWb, j - 1, slot ^ 1); NSA_DMA_V(VWb, j - 1, slot ^ 1); }
            else { NSA_DMA_K(KCb, nct - 1, slot ^ 1); NSA_DMA_V(VCb, nct - 1, slot ^ 1); }
            const float rb0 = sl2 * (float)(64 * j - t0), mref = tile_ref(st, rb0, true), c0 = rb0 + hoff_t - mref;
            if (j == qt) tile_scores<1, 1, true>(p0, p1, Kbase + slot * SLOTB, qr, bk, c0, b32t, tl, r32, hi, vf, vb0 + slot * SLOTB);
            else if (j == qt - 8) tile_scores<1, 2, true>(p0, p1, Kbase + slot * SLOTB, qr, bk, c0, b32t, tl, r32, hi, vf, vb0 + slot * SLOTB);
            else tile_scores<1, 0, true>(p0, p1, Kbase + slot * SLOTB, qr, bk, c0, b32t, 0, r32, hi, vf, vb0 + slot * SLOTB);
            tile_softmax_pv(st, p0, p1, mref, vf, wsf, r32, hi);
            NSA_WAIT_BAR();
        }
        tc += nt;
        fold_branch<true>(ostg, st, gate[2], wsf, r32, hi);
    }
    {
        state_init(st);
        for (int ci = 0; ci < nct; ++ci) {
            const int c = nct - 1 - ci, slot = (tc + ci) & 1;
            if (ci + 1 < nct) { NSA_DMA_K(KCb, c - 1, slot ^ 1); NSA_DMA_V(VCb, c - 1, slot ^ 1); }
            else if (qt >= 16) { NSA_DMA_K(KCb, 0, slot ^ 1); }
            else { NSA_DMA_K(KSb, qt, slot ^ 1); NSA_DMA_V(VSb, qt, slot ^ 1); }
            const float rb0 = sl2 * ((float)(1024 * c - t0) + 15.5f), mref = tile_ref(st, rb0, true), c0 = rb0 + hoff_c - mref;
            tile_scores<16, 3, true>(p0, p1, Kbase + slot * SLOTB, qr, bk, c0, b32c, nv - 64 * c, r32, hi, vf, vb0 + slot * SLOTB);
            tile_softmax_pv(st, p0, p1, mref, vf, wsf, r32, hi);
            NSA_WAIT_BAR();
        }
        tc += nct;
    }
    const float mc_fin = st.m; float lc = st.l;
    fold_branch<false>(ostg, st, gate[0], wsf, r32, hi);
    if (qt >= 16) {
        { auto rr = __builtin_amdgcn_permlane32_swap(__float_as_uint(lc), __float_as_uint(lc), false, false); lc = __uint_as_float(rr[0]) + __uint_as_float(rr[1]); }
        const float invl = lc > 0.f ? 1.0f / lc : 0.f;
        float carry = 0.f;
        for (int c = 0; c < nct; ++c) {
            const int slot = (tc + c) & 1;
            if (c + 1 < nct) { NSA_DMA_K(KCb, c + 1, slot ^ 1); }
            else { NSA_DMA_K(KSb, qt, slot ^ 1); NSA_DMA_V(VSb, qt, slot ^ 1); }
            const float c0 = sl2 * ((float)(1024 * c - t0) + 15.5f) + hoff_c - mc_fin;
            tile_scores<16, 3, false>(p0, p1, Kbase + slot * SLOTB, qr, bk, c0, b32c, nv - 64 * c, r32, hi, vf, 0);
#pragma unroll
            for (int r = 0; r < 16; ++r) { p0[r] = __builtin_amdgcn_exp2f(p0[r]) * invl; p1[r] = __builtin_amdgcn_exp2f(p1[r]) * invl; }
            float imp0[4], imp1[4], pl0[4], pl1[4];
#pragma unroll
            for (int a = 0; a < 4; ++a) {
                imp0[a] = (p0[4 * a] + p0[4 * a + 1]) + (p0[4 * a + 2] + p0[4 * a + 3]); imp1[a] = (p1[4 * a] + p1[4 * a + 1]) + (p1[4 * a + 2] + p1[4 * a + 3]);
                pl0[a] = __shfl_xor(p0[4 * a + 3], 32); pl1[a] = __shfl_xor(p1[4 * a + 3], 32);
            }
            if (hi) {
#pragma unroll
                for (int a = 0; a < 4; ++a) { imp0[a] += pl0[a]; imp1[a] += pl1[a]; }
            } else {
                imp0[0] += carry; imp1[0] += pl0[3];
#pragma unroll
                for (int a = 1; a < 4; ++a) { imp0[a] += pl0[a - 1]; imp1[a] += pl1[a - 1]; }
            }
            carry = pl1[3];
#pragma unroll
            for (int a = 0; a < 4; ++a) {
                imp0[a] += __shfl_xor(imp0[a], 1); imp0[a] += __shfl_xor(imp0[a], 2); imp1[a] += __shfl_xor(imp1[a], 1); imp1[a] += __shfl_xor(imp1[a], 2);
                if (hq == 0) { IMP[tl * 64 + 16 * c + 2 * a + hi] = imp0[a]; IMP[tl * 64 + 16 * c + 8 + 2 * a + hi] = imp1[a]; }
            }
            NSA_WAIT_BAR();
        }
        tc += nct;
    }
    unsigned long long wu = 0ull;
    if (qt < 16) {
        wu = (2ull << qt) - 1ull;
        if (lane < 8) { MASK[2 * (8 * wid + lane)] = (unsigned)wu; MASK[2 * (8 * wid + lane) + 1] = (unsigned)(wu >> 32); }
    } else {
        const int j = lane; const bool valid = j <= qt, forced = (j == 0) || (j == qt) || (j == qt - 1);
        for (int k = 0; k < 8; ++k) {
            const float imp = IMP[(8 * wid + k) * 64 + j];
            const float scv = valid ? (forced ? 1e9f : imp) : -1e9f;
            const unsigned fb = __float_as_uint(scv), key = fb ^ ((fb >> 31) ? 0xffffffffu : 0x80000000u);
            unsigned T = 0u;
#pragma unroll
            for (int bit = 31; bit >= 0; --bit) { const unsigned cand = T | (1u << bit); if (__builtin_popcountll(__ballot(key >= cand)) >= 16) T = cand; }
            const unsigned long long gt = __ballot(key > T), eq = __ballot(key == T);
            const int need = 16 - __builtin_popcountll(gt);
            const int before = (int)__builtin_amdgcn_mbcnt_hi((unsigned)(eq >> 32), __builtin_amdgcn_mbcnt_lo((unsigned)eq, 0u));
            const bool sel = (key > T) || ((key == T) && (before < need));
            const unsigned long long mk = __ballot(sel && (scv > -0.5e9f));
            wu |= mk;
            if (lane == 0) { MASK[2 * (8 * wid + k)] = (unsigned)mk; MASK[2 * (8 * wid + k) + 1] = (unsigned)(mk >> 32); }
        }
    }
    if (lane == 0) { WU[2 * wid] = (unsigned)wu; WU[2 * wid + 1] = (unsigned)(wu >> 32); }
    NSA_WAIT_BAR();
    unsigned long long uni = 0ull;
#pragma unroll
    for (int w = 0; w < 8; ++w) uni |= ((unsigned long long)WU[2 * w]) | (((unsigned long long)WU[2 * w + 1]) << 32);
    uni = ((unsigned long long)(unsigned)__builtin_amdgcn_readfirstlane((unsigned)uni)) | (((unsigned long long)(unsigned)__builtin_amdgcn_readfirstlane((unsigned)(uni >> 32))) << 32);
    const unsigned long long mymask = ((unsigned long long)MASK[2 * tl]) | (((unsigned long long)MASK[2 * tl + 1]) << 32);
    {
        state_init(st);
        unsigned long long rem = uni;
        int j = 63 - __builtin_clzll(rem); rem &= ~(1ull << j);
        for (int i = 0;; ++i) {
            const int slot = (tc + i) & 1; const bool more = rem != 0ull;
            int jn = 0;
            if (more) { jn = 63 - __builtin_clzll(rem); rem &= ~(1ull << jn); NSA_DMA_K(KSb, jn, slot ^ 1); NSA_DMA_V(VSb, jn, slot ^ 1); }
            if ((wu >> j) & 1ull) {
                const bool live = ((mymask >> j) & 1ull) != 0ull;
                const float rb0 = sl2 * (float)(64 * j - t0), mref = tile_ref(st, rb0, live), c0 = live ? rb0 + hoff_t - mref : -INFINITY;
                if (j == qt) tile_scores<1, 1, true>(p0, p1, Kbase + slot * SLOTB, qr, bk, c0, b32t, tl, r32, hi, vf, vb0 + slot * SLOTB);
                else tile_scores<1, 0, true>(p0, p1, Kbase + slot * SLOTB, qr, bk, c0, b32t, 0, r32, hi, vf, vb0 + slot * SLOTB);
                tile_softmax_pv(st, p0, p1, mref, vf, wsf, r32, hi);
            }
            NSA_WAIT_BAR();
            if (!more) break;
            j = jn;
        }
        if (wid == 0 && lane == 0) nxt_ticket = qbase + (int)__hip_atomic_fetch_add(qctr, 1u, __ATOMIC_RELAXED, __HIP_MEMORY_SCOPE_AGENT);
        fold_branch<false>(ostg, st, gate[1], wsf, r32, hi);
    }
    {
#pragma unroll
        for (int i = 0; i < 4; ++i) { const int row = i * 8 + (lane >> 3), ch = lane & 7;
            const f32x4_t v0 = *(LAS const f32x4_t*)(ostg + row * 64 + ch * 8), v1 = *(LAS const f32x4_t*)(ostg + row * 64 + ch * 8 + 4);
            u32x4_t v; v.x = cvtpk_s(v0[0], v0[1]); v.y = cvtpk_s(v0[2], v0[3]); v.z = cvtpk_s(v1[0], v1[1]); v.w = cvtpk_s(v1[2], v1[3]);
            *(u32x4_t*)(AB + (m0 + 8 * wid + (row >> 2)) * 2048 + 256 * g + (row & 3) * 64 + ch * 8) = v; }
    }
    NSA_WAIT_BAR();
#undef NSA_DMA_K
#undef NSA_DMA_V
    return nxt_ticket;
}
constexpr int L_QS = 145416;
__device__ __forceinline__ void nsa_phase(const Ptrs& P, LAS unsigned char* lds, int bid, int G, const int wave_s) {
    unsigned* qctr = (unsigned*)(P.ws + WS_CTL) + 3584;
    LAS int* qs = (LAS int*)(lds + L_QS);
    const int nrest = 1024 - G + LW_CHUNKS;
    int k = bid;
    while (k < 1024 + LW_CHUNKS) {
        int nxt, unit = k, chunk = -1;
        if (k >= G) { const int t = k - G, cb = (t * LW_CHUNKS) / nrest, ca = ((t + 1) * LW_CHUNKS) / nrest;
            if (ca > cb) chunk = cb; else unit = G + t - cb; }
        if (chunk < 0) {
            const int qt = 63 - (unit >> 4), g = 3 - ((unit >> 2) & 3), b = unit & 3;
            nxt = nsa_unit(P, lds, b * 4 + g, qt, wave_s, qctr, G);
        } else {
            nxt = 0;
            if (wave_s == 0 && fresh_lane() == 0) nxt = G + (int)__hip_atomic_fetch_add(qctr, 1u, __ATOMIC_RELAXED, __HIP_MEMORY_SCOPE_AGENT);
            late_weight_chunk(P, lds, chunk, wave_s);
        }
        if (wave_s == 0 && fresh_lane() == 0) *qs = nxt;
        NSA_WAIT_BAR();
        k = __builtin_amdgcn_readfirstlane(*qs);
    }
}
}

namespace p2 {
using nsa::bf16x8; using nsa::f32x16; using nsa::s16x4; using nsa::crow; using nsa::glds16; using nsa::cvtpk_s;
#define P2_WAIT_BAR() asm volatile("s_waitcnt vmcnt(0) lgkmcnt(0)\n\ts_barrier" ::: "memory")
constexpr int CB_BUF = 40960;
constexpr int CP_STRIDE = 65;
__device__ __forceinline__ void compress_unit(const Ptrs& P, LAS unsigned char* lds, int u, const int wave_s) {
    unsigned char* ws = P.ws;
    const int lane = fresh_lane(), r32 = lane & 31, hi = lane >> 5, wid = wave_s;
    const int kv = u >> 6, bg = (u >> 2) & 15, n0 = 64 * (u & 3);
    const bf16_t* Ag = (const bf16_t*)(ws + WS_KV6) + (size_t)kv * KVSZ + (size_t)bg * SEQ * 64 + (size_t)n0 * 1024;
    const bf16_t* Bg = (const bf16_t*)(ws + WS_W1C) + (size_t)kv * 256 * 2048;
    const unsigned lds0 = (unsigned)(uintptr_t)lds;
    const int drow = 8 * wid + (lane >> 3), dchk = (lane & 7) ^ ((drow >> 1) & 7);
    const unsigned aoff = (unsigned)(drow * 1024 + dchk * 8) * 2u, boff = (unsigned)(drow * 2048 + dchk * 8) * 2u;
    const unsigned dstw = lds0 + wid * 1024;
#define P2_DMA_TILE(kt, buf) do { const unsigned d_ = (unsigned)__builtin_amdgcn_readfirstlane(dstw + (buf) * CB_BUF); \
        glds16(Ag + (kt) * 64, aoff, d_); \
        _Pragma("unroll") for (int ct_ = 0; ct_ < 4; ++ct_) glds16(Bg + (size_t)ct_ * 64 * 2048 + (kt) * 64, boff, d_ + 8192u * (ct_ + 1)); } while (0)
    const int ct = wid >> 1, half = wid & 1, ncol0 = 64 * ct + 32 * half;
    f32x16 hT[2]; hT[0] = f32x16{}; hT[1] = f32x16{};
    P2_DMA_TILE(0, 0); P2_DMA_TILE(1, 1);
    asm volatile("s_waitcnt vmcnt(5) lgkmcnt(0)\n\ts_barrier" ::: "memory");
    for (int kt = 0; kt < 32; ++kt) {
        const int buf = kt % 3;
        if (kt + 2 < 32) P2_DMA_TILE(kt + 2, (kt + 2) % 3);
        LAS const char* sa = (LAS const char*)(lds + buf * CB_BUF) + r32 * 128;
        LAS const char* sb = (LAS const char*)(lds + buf * CB_BUF + 8192 * (ct + 1)) + (32 * half + r32) * 128;
        const int sw = (r32 >> 1) & 7;
#pragma unroll
        for (int d0 = 0; d0 < 4; ++d0) {
            const int co = ((2 * d0 + hi) ^ sw) * 16;
            const bf16x8 bf = *(LAS const bf16x8*)(sb + co), a0 = *(LAS const bf16x8*)(sa + co), a1 = *(LAS const bf16x8*)(sa + 4096 + co);
            hT[0] = __builtin_amdgcn_mfma_f32_32x32x16_bf16(bf, a0, hT[0], 0, 0, 0);
            hT[1] = __builtin_amdgcn_mfma_f32_32x32x16_bf16(bf, a1, hT[1], 0, 0, 0);
        }
        if (kt + 2 < 32) asm volatile("s_waitcnt vmcnt(5) lgkmcnt(0)\n\ts_barrier" ::: "memory");
        else asm volatile("s_waitcnt vmcnt(0) lgkmcnt(0)\n\ts_barrier" ::: "memory");
    }
    const float* bias1 = (const float*)(ws + WS_SMALL + SM_BIAS1) + kv * 256 + ncol0;
    bf16x8 hb[2][2];
#pragma unroll
    for (int mt = 0; mt < 2; ++mt) {
        float g[16];
#pragma unroll
        for (int r = 0; r < 16; ++r) g[r] = gelu_tanh(hT[mt][r] + bias1[crow(r, hi)]);
#pragma unroll
        for (int s = 0; s < 2; ++s) { u32x4_t w; w.x = cvtpk_s(g[8 * s], g[8 * s + 1]); w.y = cvtpk_s(g[8 * s + 2], g[8 * s + 3]); w.z = cvtpk_s(g[8 * s + 4], g[8 * s + 5]); w.w = cvtpk_s(g[8 * s + 6], g[8 * s + 7]);
            hb[mt][s] = __builtin_bit_cast(bf16x8, w); }
    }
    const bf16_t* w2t = (const bf16_t*)(ws + WS_SMALL + SM_W2T) + (size_t)kv * 64 * 256;
    f32x16 oT[2][2];
#pragma unroll
    for (int dt = 0; dt < 2; ++dt)
#pragma unroll
        for (int mt = 0; mt < 2; ++mt) oT[dt][mt] = f32x16{};
#pragma unroll
    for (int dt = 0; dt < 2; ++dt)
#pragma unroll
        for (int s = 0; s < 2; ++s) {
            const bf16_t* wp = w2t + (size_t)(32 * dt + r32) * 256 + ncol0 + 16 * s + 4 * hi;
            const u32x2_t lo = *(const u32x2_t*)wp, hi2 = *(const u32x2_t*)(wp + 8);
            const u32x4_t wv = {lo.x, lo.y, hi2.x, hi2.y}; const bf16x8 wf = __builtin_bit_cast(bf16x8, wv);
#pragma unroll
            for (int mt = 0; mt < 2; ++mt) oT[dt][mt] = __builtin_amdgcn_mfma_f32_32x32x16_bf16(wf, hb[mt][s], oT[dt][mt], 0, 0, 0);
        }
    LAS float* part = (LAS float*)lds + wid * 64 * CP_STRIDE;
#pragma unroll
    for (int dt = 0; dt < 2; ++dt)
#pragma unroll
        for (int mt = 0; mt < 2; ++mt)
#pragma unroll
            for (int r = 0; r < 16; ++r) part[(32 * mt + r32) * CP_STRIDE + 32 * dt + crow(r, hi)] = oT[dt][mt][r];
    P2_WAIT_BAR();
    {
        const int tid = wid * 64 + lane, m = tid >> 3, dg = tid & 7;
        float o[8];
#pragma unroll
        for (int e = 0; e < 8; ++e) { float s = 0.f;
#pragma unroll
            for (int w = 0; w < 8; ++w) s += ((LAS const float*)lds)[(w * 64 + m) * CP_STRIDE + 8 * dg + e];
            o[e] = s; }
        if (kv == 0) {
            float ss = 0.f;
#pragma unroll
            for (int e = 0; e < 8; ++e) ss += o[e] * o[e];
            ss += __shfl_xor(ss, 1); ss += __shfl_xor(ss, 2); ss += __shfl_xor(ss, 4);
            const float rr = __builtin_amdgcn_rsqf(ss * (1.0f / 64.0f) + 1e-6f);
#pragma unroll
            for (int e = 0; e < 8; ++e) o[e] *= rr * P.in[4][8 * dg + e];
        }
        const int n = n0 + m;
        u32x4_t v = {0u, 0u, 0u, 0u};
        if (n < 255) { v.x = cvtpk_s(o[0], o[1]); v.y = cvtpk_s(o[2], o[3]); v.z = cvtpk_s(o[4], o[5]); v.w = cvtpk_s(o[6], o[7]); }
        *(u32x4_t*)((bf16_t*)(ws + (kv ? WS_VC : WS_KC)) + ((size_t)bg * 256 + n) * 64 + 8 * dg) = v;
    }
    P2_WAIT_BAR();
#undef P2_DMA_TILE
}

constexpr int G_V = 0, G_ST = 32768, G_OST = 33792, G_END = 33792 + 65536;
struct GmlpIn { u32x4_t raw[4]; u32x4_t uraw[4]; float sbv[4]; };
__device__ __forceinline__ void gmlp_load(GmlpIn& in, const Ptrs& P, int unit, int tid, int lane, int r32, int hi, int wid) {
    unsigned char* ws = P.ws;
    const int g = unit & 7, chunk = (unit >> 3) & 31, b = unit >> 8; const int m0 = b * SEQ + chunk * 128;
    const bf16_t* GV = (const bf16_t*)(ws + WS_GV); const bf16_t* U = (const bf16_t*)(ws + WS_U);
    const int tb = wid >> 1, ch = wid & 1; (void)r32; (void)hi;
#pragma unroll
    for (int i = 0; i < 4; ++i) { const int idx = tid + 512 * i, s = idx >> 4, c8 = idx & 15; in.raw[i] = *(const u32x4_t*)(GV + (size_t)(m0 + s) * 1024 + g * 128 + 8 * c8); }
#pragma unroll
    for (int i = 0; i < 4; ++i) { const int row = i * 8 + (lane >> 3), t = 32 * tb + row; in.uraw[i] = *(const u32x4_t*)(U + (size_t)(m0 + t) * 1024 + g * 128 + 64 * ch + 8 * (lane & 7)); in.sbv[i] = P.in[11][g * 128 + t]; }
}
__device__ __forceinline__ void gmlp_compute(const GmlpIn& in, const f32x4_t (&sv)[8], const bf16x8 (&pa)[2][4], const f32x4_t w0, const f32x4_t w1, const f32x4_t b0, const f32x4_t b1, const Ptrs& P, LAS unsigned char* lds, int unit, int tid, int lane, int r32, int hi, int wid) {
    unsigned char* ws = P.ws;
    const int g = unit & 7, chunk = (unit >> 3) & 31, b = unit >> 8; const int m0 = b * SEQ + chunk * 128;
    bf16_t* AB = (bf16_t*)(ws + WS_AB);
    LAS float* st = (LAS float*)(lds + G_ST);
    const int tb = wid >> 1, ch = wid & 1;
    if (tid < 128) { float s1 = 0.f, s2 = 0.f;
#pragma unroll
        for (int i = 0; i < 8; ++i) { s1 += sv[i][0] + sv[i][2]; s2 += sv[i][1] + sv[i][3]; }
        const float mean = s1 * (1.0f / 1024.0f); float var = s2 * (1.0f / 1024.0f) - mean * mean; var = var < 0.f ? 0.f : var;
        st[2 * tid] = mean; st[2 * tid + 1] = __builtin_amdgcn_rsqf(var + 1e-5f); }
    asm volatile("s_waitcnt lgkmcnt(0)\n\ts_barrier" ::: "memory");
#pragma unroll
    for (int i = 0; i < 4; ++i) { const int idx = tid + 512 * i, s = idx >> 4, c8 = idx & 15;
        float f[8]; unpack8(in.raw[i], f);
        const float mean = st[2 * s], rstd = st[2 * s + 1];
        float y[8];
#pragma unroll
        for (int e = 0; e < 4; ++e) { y[e] = (f[e] - mean) * rstd * w0[e] + b0[e]; y[4 + e] = (f[4 + e] - mean) * rstd * w1[e] + b1[e]; }
        u32x4_t o; o.x = cvtpk_s(y[0], y[1]); o.y = cvtpk_s(y[2], y[3]); o.z = cvtpk_s(y[4], y[5]); o.w = cvtpk_s(y[6], y[7]);
        const int st_ = s >> 6, sk = s & 63, chh = c8 >> 3, x = c8 & 7;
        *(LAS u32x4_t*)(lds + G_V + (st_ * 2 + chh) * 8192 + (x >> 2) * 4096 + (sk >> 4) * 1024 + (sk & 15) * 64 + (x & 3) * 16) = o; }
    asm volatile("s_waitcnt lgkmcnt(0)\n\ts_barrier" ::: "memory");
    f32x16 o[2]; o[0] = f32x16{}; o[1] = f32x16{};
    const int vb0 = (int)((unsigned)(uintptr_t)lds + G_V) + ((lane >> 4) & 1) * 32 + (lane & 3) * 8 + (4 * hi + ((lane & 15) >> 2)) * 64;
    nsa::pv(o, vb0 + ch * 8192, pa[0][0], pa[0][1], pa[0][2], pa[0][3]);
    if (tb >= 2) nsa::pv(o, vb0 + (2 + ch) * 8192, pa[1][0], pa[1][1], pa[1][2], pa[1][3]);
    LAS float* ostg = (LAS float*)(lds + G_OST) + wid * 2048;
#pragma unroll
    for (int r = 0; r < 16; ++r) { const int orow = crow(r, hi);
#pragma unroll
        for (int d0 = 0; d0 < 2; ++d0) ostg[orow * 64 + d0 * 32 + r32] = o[d0][r]; }
    asm volatile("s_waitcnt lgkmcnt(0)" ::: "memory");
#pragma unroll
    for (int i = 0; i < 4; ++i) { const int row = i * 8 + (lane >> 3), c8 = lane & 7, t = 32 * tb + row;
        const f32x4_t v0 = *(LAS const f32x4_t*)(ostg + row * 64 + c8 * 8), v1 = *(LAS const f32x4_t*)(ostg + row * 64 + c8 * 8 + 4);
        const size_t grow = (size_t)(m0 + t); const int col = g * 128 + 64 * ch + 8 * c8;
        float uf[8]; unpack8(in.uraw[i], uf);
        const float sb_ = in.sbv[i];
        u32x4_t w; w.x = cvtpk_s(uf[0] * (v0[0] + sb_), uf[1] * (v0[1] + sb_)); w.y = cvtpk_s(uf[2] * (v0[2] + sb_), uf[3] * (v0[3] + sb_));
        w.z = cvtpk_s(uf[4] * (v1[0] + sb_), uf[5] * (v1[1] + sb_)); w.w = cvtpk_s(uf[6] * (v1[2] + sb_), uf[7] * (v1[3] + sb_));
        *(u32x4_t*)(AB + grow * 2048 + 1024 + col) = w; }
    asm volatile("s_waitcnt lgkmcnt(0)\n\ts_barrier" ::: "memory");
}
__device__ __forceinline__ void gmlp_run(const Ptrs& P, LAS unsigned char* lds, int u0, int stride, int nunits, const int wave_s) {
    const int lane = fresh_lane(), r32 = lane & 31, hi = lane >> 5, wid = wave_s, tid = wid * 64 + lane;
    GmlpIn A, B;
    int u = u0;
    bf16x8 pa[2][4];
    { const bf16_t* SWB = (const bf16_t*)(P.ws + WS_SMALL + SM_SWB) + (size_t)(u0 & 7) * 16384; const int tb = wid >> 1;
#pragma unroll
      for (int st_ = 0; st_ < 2; ++st_)
#pragma unroll
        for (int ks = 0; ks < 4; ++ks) {
            const bf16_t* wp = SWB + (size_t)(32 * tb + r32) * 128 + 64 * st_ + 16 * ks + 4 * hi;
            const u32x2_t lo = *(const u32x2_t*)wp, hi2 = *(const u32x2_t*)(wp + 8);
            const u32x4_t wv = {lo.x, lo.y, hi2.x, hi2.y}; pa[st_][ks] = __builtin_bit_cast(bf16x8, wv); } }
    const int c8v = tid & 15, g0 = u0 & 7;
    const f32x4_t w0 = *(const f32x4_t*)(P.in[8] + g0 * 128 + 8 * c8v), w1 = *(const f32x4_t*)(P.in[8] + g0 * 128 + 8 * c8v + 4), b0 = *(const f32x4_t*)(P.in[9] + g0 * 128 + 8 * c8v), b1 = *(const f32x4_t*)(P.in[9] + g0 * 128 + 8 * c8v + 4);
    const float* VSTAT = (const float*)(P.ws + WS_VSTAT);
#define GMLP_STATS(sv_, unit_) do { const int m0_ = ((unit_) >> 8) * SEQ + (((unit_) >> 3) & 31) * 128; const f32x4_t* p_ = (const f32x4_t*)(VSTAT + (size_t)(m0_ + (tid & 127)) * 32); \
        _Pragma("unroll") for (int i_ = 0; i_ < 8; ++i_) sv_[i_] = p_[i_]; } while (0)
    f32x4_t sv[8];
    if (u < nunits) gmlp_load(A, P, u, tid, lane, r32, hi, wid);
    while (u < nunits) {
        GMLP_STATS(sv, u);
        if (u + stride < nunits) gmlp_load(B, P, u + stride, tid, lane, r32, hi, wid);
        gmlp_compute(A, sv, pa, w0, w1, b0, b1, P, lds, u, tid, lane, r32, hi, wid);
        u += stride; if (u >= nunits) break;
        GMLP_STATS(sv, u);
        if (u + stride < nunits) gmlp_load(A, P, u + stride, tid, lane, r32, hi, wid);
        gmlp_compute(B, sv, pa, w0, w1, b0, b1, P, lds, u, tid, lane, r32, hi, wid);
        u += stride;
    }
#undef GMLP_STATS
    asm volatile("s_waitcnt vmcnt(0) lgkmcnt(0)\n\ts_barrier" ::: "memory");
}
#undef P2_WAIT_BAR
}

#define XB_TMO      128
#define XB_XCNT(j)  (256  + 64 * (j))
#define XB_XSUB(j)  (1280 + 64 * (j))
#define XB_XGEN(j)  (2304 + 64 * (j))
#define XB_TOP      3328
#define XB_TOPGEN   3392
#define XCD_BAR_WORDS 3456
#define XB_SPIN_CAP (1u << 18)

__device__ __forceinline__ unsigned xb_ld(unsigned* p)              { return __hip_atomic_load(p, __ATOMIC_RELAXED, __HIP_MEMORY_SCOPE_AGENT); }
__device__ __forceinline__ unsigned xb_add(unsigned* p, unsigned v) { return __hip_atomic_fetch_add(p, v, __ATOMIC_RELAXED, __HIP_MEMORY_SCOPE_AGENT); }
__device__ __forceinline__ unsigned xb_xcc_id() { return (unsigned)__builtin_amdgcn_s_getreg((3 << 11) | 20) & 0xFu; }
#define XB_SPIN(cond, bar) do { unsigned _sp = 0; while (cond) { __builtin_amdgcn_s_sleep(1); \
    if ((++_sp & 255u) == 0u) { if (xb_ld(&(bar)[XB_TMO])) break; if (_sp > XB_SPIN_CAP) { atomicAdd(&(bar)[XB_TMO], 1u); break; } } } } while (0)

struct XcdBarrier {
    unsigned* bar; unsigned x; unsigned w0;
    volatile LAS unsigned* st;
};

__device__ __forceinline__ XcdBarrier xcd_barrier_post(unsigned* bar, volatile LAS unsigned* st, int wave_s) {
    XcdBarrier b; b.bar = bar; b.x = xb_xcc_id(); b.st = st; b.w0 = wave_s == 0 ? 1u : 0u;
    if (b.w0 && fresh_lane() == 0) (void)xb_add(&bar[XB_XCNT(b.x)], 1u);
    return b;
}
__device__ __forceinline__ void xcd_barrier_complete(unsigned* bar, unsigned x, unsigned& nloc, unsigned& nx) {
    const unsigned G = gridDim.x * gridDim.y * gridDim.z;
    unsigned sum, cnt, mine, sp = 0u;
    for (;;) {
        sum = 0u; cnt = 0u; mine = 0u;
#pragma unroll
        for (unsigned j = 0; j < 16; ++j) { const unsigned c = xb_ld(&bar[XB_XCNT(j)]); sum += c; cnt += (c > 0u) ? 1u : 0u; mine = (j == x) ? c : mine; }
        if (sum == G) break;
        __builtin_amdgcn_s_sleep(1);
        if ((++sp & 255u) == 0u) { if (xb_ld(&bar[XB_TMO])) break; if (sp > XB_SPIN_CAP) { atomicAdd(&bar[XB_TMO], 1u); break; } }
    }
    nloc = mine > 0u ? mine : 1u; nx = cnt > 0u ? cnt : 1u;
}

__device__ __forceinline__ void xcd_barrier(const XcdBarrier& b) {
    asm volatile("s_waitcnt vmcnt(0)" ::: "memory");
    __syncthreads();
    if (b.w0 && fresh_lane() == 0) {
        unsigned* bar = b.bar;
        __builtin_amdgcn_s_waitcnt(0);
        unsigned nloc = b.st[0], nx = b.st[1];
        if (nloc == 0u) { xcd_barrier_complete(bar, b.x, nloc, nx); b.st[0] = nloc; b.st[1] = nx; }
        const unsigned old = xb_add(&bar[XB_XSUB(b.x)], 1u);
        const unsigned gen = old / nloc;
        if (old + 1u == (gen + 1u) * nloc) {
            __builtin_amdgcn_fence(__ATOMIC_RELEASE, "agent");
            asm volatile("s_waitcnt vmcnt(0)" ::: "memory");
            const unsigned og = xb_add(&bar[XB_TOP], 1u);
            const unsigned tg = og / nx;
            if (og + 1u == (tg + 1u) * nx) xb_add(&bar[XB_TOPGEN], 1u);
            else XB_SPIN(xb_ld(&bar[XB_TOPGEN]) == tg, bar);
            __builtin_amdgcn_fence(__ATOMIC_ACQUIRE, "agent");
            xb_add(&bar[XB_XGEN(b.x)], 1u);
            asm volatile("s_waitcnt vmcnt(0)" ::: "memory");
        } else {
            XB_SPIN(xb_ld(&bar[XB_XGEN(b.x)]) == gen, bar);
            __builtin_amdgcn_fence(__ATOMIC_ACQUIRE, "agent");
            asm volatile("s_waitcnt vmcnt(0)" ::: "memory");
        }
    }
    __syncthreads();
}

constexpr int LDS_BYTES = 151552;
constexpr int LDS_XCH = 132096;
constexpr int LDS_MISC = 145408;
__global__ void __launch_bounds__(512, 2) mega_fwd(Ptrs P) {
    extern __shared__ __attribute__((aligned(16))) unsigned char lds_raw[];
    LAS unsigned char* lds = (LAS unsigned char*)lds_raw;
    unsigned char* ws = P.ws;
    const int wave = __builtin_amdgcn_readfirstlane(threadIdx.x >> 6);
    const int G = gridDim.x, bid = blockIdx.x;
    if (wave == 0) { const int l_ = fresh_lane(); if (l_ < 2) ((LAS unsigned*)(lds + LDS_MISC))[l_] = 0u; }
    __syncthreads();
    const XcdBarrier bar = xcd_barrier_post((unsigned*)(ws + WS_CTL), (volatile LAS unsigned*)(lds + LDS_MISC), wave);
    p0_prologue(P, lds, bid, G, wave);
    xcd_barrier(bar);
    if (bid == 0) bias1_stage(ws, fresh_tid(wave));
    {
        pg8::Gemm g{(const bf16_t*)(ws + WS_XN), (const bf16_t*)(ws + WS_WIN), MTOK, NPROJ, 2048, 2048};
        pg8::StaticOrder S; S.init(MTOK, NPROJ, G, bid);
        pg8::EpiProj E{(bf16_t*)(ws + WS_Q), (bf16_t*)(ws + WS_KV6), (bf16_t*)(ws + WS_U), (bf16_t*)(ws + WS_GV), (float*)(ws + WS_GATES), (float*)(ws + WS_VSTAT), P.in[3], P.in[4]};
        pg8::gemm_phase<pg8::EpiProj, pg8::StaticOrder, true, true>(lds, g, S, E, wave);
    }
    xcd_barrier(bar);
    if (bid < 128 && G >= 256) p2::compress_unit(P, lds, bid, wave);
    else if (G >= 256) p2::gmlp_run(P, lds, bid - 128, G - 128, 1024, wave);
    xcd_barrier(bar);
    nsa::nsa_phase(P, lds, bid, G, wave);
    xcd_barrier(bar);
    {
        pg8::Gemm g{(const bf16_t*)(ws + WS_AB), (const bf16_t*)(ws + WS_WOUT), MTOK, 2048, 2048, 2048};
        pg8::StaticOrder S; S.init(MTOK, 2048, G, bid);
        pg8::EpiRes1 E{(const float*)(ws + WS_SMALL + SM_RINV), (const float*)(ws + WS_SMALL + SM_INVW), (bf16_t*)(ws + WS_XN), (float*)(ws + WS_SSQ)};
        pg8::gemm_phase<pg8::EpiRes1, pg8::StaticOrder, true, true>(lds, g, S, E, wave);
    }
    xcd_barrier(bar);
    for (int m = bid * 512 + fresh_tid(wave); m < MTOK; m += G * 512) {
        const float* p = (const float*)(ws + WS_SSQ) + (size_t)m * 32; float s = 0.f;
#pragma unroll
        for (int i = 0; i < 32; ++i) s += p[i];
        ((float*)(ws + WS_SMALL + SM_R2))[m] = __builtin_amdgcn_rsqf(s * (1.0f / D_MODEL) + 1e-6f);
    }
    xcd_barrier(bar);
    {
        pg8::Gemm g{(const bf16_t*)(ws + WS_XN), (const bf16_t*)(ws + WS_WUP), MTOK, N_UP, 2048, 2048};
        pg8::StaticOrder S; S.init(MTOK, N_UP, G, bid);
        pg8::EpiUpConv E{(bf16_t*)(ws + WS_G), (const float*)(ws + WS_SMALL + SM_R2), P.in[15], P.in[16], (float*)(ws + WS_HLAST), (float*)(ws + WS_FIRST), lds + LDS_XCH};
        pg8::gemm_phase<pg8::EpiUpConv, pg8::StaticOrder, true, true>(lds, g, S, E, wave);
    }
    xcd_barrier(bar);
    for (int it = bid * 512 + fresh_tid(wave); it < 60 * 44 * 2 * 16; it += G * 512) {
        const int c8 = it & 15, row = (it >> 4) & 1, tl_ = it >> 5, pn = tl_ % 44, pmi = tl_ / 44, pm = pmi + pmi / 15 + 1;
        const float* cw = P.in[15]; const float* cb = P.in[16]; (void)cb;
        const float* fp = (const float*)(ws + WS_FIRST) + ((size_t)(pm * 44 + pn) * 2 + row) * 256 + 8 * c8;
        const float* lp = (const float*)(ws + WS_HLAST) + ((size_t)((pm - 1) * 44 + pn) * 2) * 256 + 8 * c8;
        const int ch = pn * 128 + 8 * c8;
        float r[8];
#pragma unroll
        for (int e = 0; e < 8; ++e) {
            const float l0g = lp[e], l1g = lp[256 + e], l0u = lp[128 + e], l1u = lp[256 + 128 + e];
            const float w0g = cw[ch + e], w1g = cw[N_UP + ch + e], w0u = cw[D_FF + ch + e], w1u = cw[N_UP + D_FF + ch + e];
            const float cg = fp[e] + (row == 0 ? w1g * l1g + w0g * l0g : w0g * l1g), cu = fp[128 + e] + (row == 0 ? w1u * l1u + w0u * l0u : w0u * l1u);
            r[e] = cg * sigmoidf_(cg) * cu;
        }
        u32x4_t o; o.x = pk2(r[0], r[1]); o.y = pk2(r[2], r[3]); o.z = pk2(r[4], r[5]); o.w = pk2(r[6], r[7]);
        *(u32x4_t*)((bf16_t*)(ws + WS_G) + (size_t)(pm * 256 + row) * D_FF + ch) = o;
    }
    xcd_barrier(bar);
    {
        pg8::Gemm g{(const bf16_t*)(ws + WS_G), (const bf16_t*)(ws + WS_WDOWN), MTOK, 2048, D_FF, D_FF};
        pg8::StaticOrder S; S.init(MTOK, 2048, G, bid);
        pg8::EpiDown E{P.out, (const bf16_t*)(ws + WS_XN)};
        pg8::gemm_phase<pg8::EpiDown, pg8::StaticOrder, true, true>(lds, g, S, E, wave);
    }
}

extern "C" void kernel_launch(void* const* d_in, const int* in_sizes, int n_in, void* d_out, int out_size, void* d_ws, size_t ws_size, hipStream_t stream) {
    static int grid_blocks = 0;
    if (!grid_blocks) {
        int dev = 0, cus = 0, per_cu = 0;
        (void)hipGetDevice(&dev);
        (void)hipDeviceGetAttribute(&cus, hipDeviceAttributeMultiprocessorCount, dev);
        (void)hipFuncSetAttribute((const void*)mega_fwd, hipFuncAttributeMaxDynamicSharedMemorySize, LDS_BYTES);
        (void)hipOccupancyMaxActiveBlocksPerMultiprocessor(&per_cu, (const void*)mega_fwd, 512, LDS_BYTES);
        if (per_cu < 1) { fprintf(stderr, "kernel_launch: occupancy query says %d blocks/CU\n", per_cu); per_cu = 1; }
        grid_blocks = cus * 1;
        (void)hipGetLastError();
    }
    if (n_in != 18 || ws_size < WS_END) { fprintf(stderr, "kernel_launch: unexpected n_in %d / ws %zu\n", n_in, ws_size); return; }
    Ptrs P{};
    for (int i = 0; i < 18; ++i) P.in[i] = (const float*)d_in[i];
    P.out = (float*)d_out; P.ws = (unsigned char*)d_ws;
    (void)hipMemsetAsync((char*)d_ws + WS_CTL, 0, 16384, stream);
    mega_fwd<<<dim3(grid_blocks), dim3(512), LDS_BYTES, stream>>>(P);
}
```

```cpp
#include <hip/hip_runtime.h>
#include <cstdio>
#include <cstdint>

constexpr int D_MODEL = 2048, BATCH = 4, SEQ = 4096, MTOK = BATCH * SEQ;
constexpr int IN_COLS = 4656, NPROJ = 4864;
constexpr int D_FF = 5632, N_UP = 2 * D_FF;
constexpr int NBG = 16;
constexpr size_t KVSZ = (size_t)NBG * SEQ * 64;
constexpr float LOG2E = 1.4426950408889634f;

constexpr size_t MiB = 1u << 20;
constexpr size_t WS_CTL = 0;
constexpr size_t WS_WIN = 1 * MiB, WS_WOUT = 20 * MiB, WS_WUP = 28 * MiB, WS_WDOWN = 72 * MiB, WS_W1C = 94 * MiB;
constexpr size_t WS_SMALL = 96 * MiB;
constexpr size_t SM_BIASP = 0, SM_BIAS1 = 65536, SM_R2 = 131072, SM_W2T = 196608  , SM_SWB = 262144  , SM_RINV = 524288  , SM_INVW = 589824  ;
constexpr size_t WS_XN = 97 * MiB;
constexpr size_t WS_Q = 161 * MiB;
constexpr size_t WS_KV6 = 193 * MiB;
constexpr size_t WS_U = 241 * MiB, WS_GV = 273 * MiB;
constexpr size_t WS_GATES = 305 * MiB;
constexpr size_t WS_VSTAT = 308 * MiB;
constexpr size_t WS_KC = 310 * MiB, WS_VC = 310 * MiB + 524288;
constexpr size_t WS_HC = 311 * MiB;
constexpr size_t WS_AB = 315 * MiB;
constexpr size_t WS_SSQ = 379 * MiB;
constexpr size_t WS_G = 161 * MiB;
constexpr size_t WS_HID = 381 * MiB;
constexpr size_t WS_HLAST = 381 * MiB, WS_FIRST = 388 * MiB;
constexpr size_t WS_END = 469 * MiB;

#define LAS __attribute__((address_space(3)))
typedef unsigned short bf16_t;
typedef unsigned u32x4_t __attribute__((ext_vector_type(4)));
typedef unsigned u32x2_t __attribute__((ext_vector_type(2)));
typedef float f32x4_t __attribute__((ext_vector_type(4)));

__device__ __forceinline__ float bf2f(unsigned short h) { return __uint_as_float(((unsigned)h) << 16); }
__device__ __forceinline__ unsigned f2bf(float f) { unsigned u = __float_as_uint(f); return (u + 0x7fffu + ((u >> 16) & 1u)) >> 16; }
__device__ __forceinline__ unsigned pk2(float lo, float hi) { return f2bf(lo) | (f2bf(hi) << 16); }
__device__ __forceinline__ float gelu_tanh(float x) {
    const float u = 0.7978845608028654f * (x + 0.044715f * x * x * x);
    const float e = __builtin_amdgcn_exp2f(-2.8853900817779268f * u);
    return x * __builtin_amdgcn_rcpf(1.0f + e);
}
__device__ __forceinline__ float sigmoidf_(float x) { return __builtin_amdgcn_rcpf(1.0f + __builtin_amdgcn_exp2f(-LOG2E * x)); }
__device__ __forceinline__ float wave_sum(float v) {
#pragma unroll
    for (int o = 1; o < 64; o <<= 1) v += __shfl_xor(v, o);
    return v;
}
__device__ __forceinline__ void unpack8(u32x4_t r, float (&f)[8]) {
    f[0] = __uint_as_float(r.x << 16); f[1] = __uint_as_float(r.x & 0xffff0000u);
    f[2] = __uint_as_float(r.y << 16); f[3] = __uint_as_float(r.y & 0xffff0000u);
    f[4] = __uint_as_float(r.z << 16); f[5] = __uint_as_float(r.z & 0xffff0000u);
    f[6] = __uint_as_float(r.w << 16); f[7] = __uint_as_float(r.w & 0xffff0000u);
}

__device__ __forceinline__ int fresh_lane() { unsigned z_ = 0u; asm volatile("" : "+v"(z_)); return (int)__builtin_amdgcn_mbcnt_hi(~0u, __builtin_amdgcn_mbcnt_lo(~0u, z_)); }
__device__ __forceinline__ int fresh_tid(int wave_s) { return wave_s * 64 + fresh_lane(); }
namespace pg8 {
#define PG8_LAS __attribute__((address_space(3)))
typedef unsigned short bf16_t;
typedef short bf16x8 __attribute__((ext_vector_type(8)));
typedef float f32x4 __attribute__((ext_vector_type(4)));
typedef unsigned u32x4 __attribute__((ext_vector_type(4)));
constexpr int BM = 256, BK = 64, HALF = 128, HTB = HALF * BK * 2  , STAGE_BYTES = 8 * HTB, NXCD = 8, WGM = 8;

__host__ __device__ __forceinline__ int lds_byte(int r, int c) { const int st = (r >> 4) * 2 + (c >> 5), rr = r & 15, cc = c & 31, ob = rr * 64 + cc * 2; return st * 1024 + (ob ^ (((ob >> 9) & 1) << 5)); }
__host__ __device__ __forceinline__ void stage_rc(int b, int& R, int& C) { const int st = b / 1024, sb = b % 1024, swz = sb ^ (((sb >> 9) & 1) << 5); R = (st >> 1) * 16 + swz / 64; C = (st & 1) * 32 + (swz % 64) / 2; }
__host__ __device__ __forceinline__ int perm32(int rho) { const int n = rho >> 4, i = rho & 15; return 8 * (i >> 2) + 4 * n + (i & 3); }

struct Unit { int pm, pn; };
struct Gemm { const bf16_t* A; const bf16_t* Bt; int M, N, K, lda; };

struct StaticOrder {
    int nM, nN, nwg, G, c;
    __host__ __device__ void init(int M, int N, int G_, int c_) { nM = M / BM; nN = N / BM; nwg = nM * nN; G = G_; c = c_; }
    __host__ __device__ bool next(int i, Unit& u) const {
        const long L = (long)i * G + c; if (L >= nwg) return false;
        int wgid = (int)L; { const int q = nwg / NXCD, r = nwg % NXCD, xcd = wgid % NXCD, off = wgid / NXCD; wgid = (xcd < r ? xcd * (q + 1) : r * (q + 1) + (xcd - r) * q) + off; }
        const int nig = WGM * nN, gid = wgid / nig, fm = gid * WGM, gsz = (nM - fm) < WGM ? (nM - fm) : WGM;
        u.pm = fm + ((wgid % nig) % gsz); u.pn = (wgid % nig) / gsz; return true;
    }
    __device__ __forceinline__ void a_ready(const Unit&) const {}
    __device__ __forceinline__ void done(const Unit&) const {}
};

__device__ __forceinline__ unsigned cvt_pk_bf16(float lo, float hi) { unsigned r; asm volatile("v_cvt_pk_bf16_f32 %0, %1, %2" : "=v"(r) : "v"(lo), "v"(hi)); return r; }

struct EpiProj {
    static constexpr bool PERM = true, AFTER_DRAIN = false, PERMA = false;
    bf16_t* Q; bf16_t* KV6; bf16_t* U; bf16_t* GV; float* GATES; float* VSTAT; const float* q_norm_w; const float* k_norm_w;
    __device__ __forceinline__ void operator()(const f32x4 (&acc)[2][2][4][2], const Unit& u, int wr, int wc, int fr, int fq) const {
        const int pn = u.pn, row0 = u.pm * BM + wr * 64 + fr;
        if (pn < 10) {
            const bool normed = (pn < 4) || pn == 6 || pn == 8;
            const float* w = pn < 4 ? q_norm_w : (k_norm_w + (pn == 6 ? 64 : 128));
            const float sc = pn < 4 ? 0.125f * LOG2E : 1.0f;
            f32x4 wv[2][2];
#pragma unroll
            for (int bj = 0; bj < 2; ++bj)
#pragma unroll
                for (int n = 0; n < 2; ++n) wv[bj][n] = normed ? (*(const f32x4*)(w + 32 * bj + 8 * fq + 4 * n)) * sc : (f32x4){1.f, 1.f, 1.f, 1.f};
#pragma unroll
            for (int ai = 0; ai < 2; ++ai)
#pragma unroll
                for (int m = 0; m < 4; ++m) {
                    const int row = row0 + ai * HALF + m * 16;
                    float r = 1.f;
                    if (normed) {
                        float ss = 0.f;
#pragma unroll
                        for (int bj = 0; bj < 2; ++bj)
#pragma unroll
                            for (int n = 0; n < 2; ++n) { const f32x4 x = acc[ai][bj][m][n]; ss += (x[0] * x[0] + x[1] * x[1]) + (x[2] * x[2] + x[3] * x[3]); }
                        ss += __shfl_xor(ss, 16); ss += __shfl_xor(ss, 32);
                        r = __builtin_amdgcn_rsqf(ss * (1.0f / 64.0f) + 1e-6f);
                    }
                    bf16_t* dst;
                    if (pn < 4) dst = Q + (size_t)row * 1024 + pn * 256 + wc * 64 + 8 * fq;
                    else { const int b = row >> 12, t = row & 4095; dst = KV6 + (size_t)(pn - 4) * KVSZ + ((size_t)((b * 4 + wc) * 4096 + t)) * 64 + 8 * fq; }
#pragma unroll
                    for (int bj = 0; bj < 2; ++bj) {
                        const f32x4 v0 = acc[ai][bj][m][0] * r * wv[bj][0], v1 = acc[ai][bj][m][1] * r * wv[bj][1];
                        u32x4 o; o.x = cvt_pk_bf16(v0[0], v0[1]); o.y = cvt_pk_bf16(v0[2], v0[3]); o.z = cvt_pk_bf16(v1[0], v1[1]); o.w = cvt_pk_bf16(v1[2], v1[3]);
                        *(u32x4*)(dst + 32 * bj) = o;
                    }
                }
        } else if (pn < 18) {
            const bool isv = pn >= 14; const int ct = isv ? pn - 14 : pn - 10;
            bf16_t* base = (isv ? GV : U) + ct * 256 + wc * 64 + 8 * fq;
#pragma unroll
            for (int ai = 0; ai < 2; ++ai)
#pragma unroll
                for (int m = 0; m < 4; ++m) {
                    const int row = row0 + ai * HALF + m * 16; float s1 = 0.f, s2 = 0.f;
#pragma unroll
                    for (int bj = 0; bj < 2; ++bj) {
                        f32x4 v0 = acc[ai][bj][m][0], v1 = acc[ai][bj][m][1];
#pragma unroll
                        for (int e = 0; e < 4; ++e) { v0[e] = gelu_tanh(v0[e]); v1[e] = gelu_tanh(v1[e]); s1 += v0[e] + v1[e]; s2 += v0[e] * v0[e] + v1[e] * v1[e]; }
                        u32x4 o; o.x = cvt_pk_bf16(v0[0], v0[1]); o.y = cvt_pk_bf16(v0[2], v0[3]); o.z = cvt_pk_bf16(v1[0], v1[1]); o.w = cvt_pk_bf16(v1[2], v1[3]);
                        *(u32x4*)(base + (size_t)row * 1024 + 32 * bj) = o;
                    }
                    if (isv) {
                        s1 += __shfl_xor(s1, 16); s1 += __shfl_xor(s1, 32); s2 += __shfl_xor(s2, 16); s2 += __shfl_xor(s2, 32);
                        if (fq == 0) { float* p = VSTAT + ((size_t)row * 16 + ct * 4 + wc) * 2; p[0] = s1; p[1] = s2; }
                    }
                }
        } else {
            if (wc == 0) {
#pragma unroll
                for (int ai = 0; ai < 2; ++ai)
#pragma unroll
                    for (int m = 0; m < 4; ++m) {
                        const int row = row0 + ai * HALF + m * 16;
#pragma unroll
                        for (int bj = 0; bj < 2; ++bj)
#pragma unroll
                            for (int n = 0; n < 2; ++n) {
                                const int L = 32 * bj + 8 * fq + 4 * n;
                                if (L < 48) { f32x4 v = acc[ai][bj][m][n]; f32x4 o; o[0] = sigmoidf_(v[0]); o[1] = sigmoidf_(v[1]); o[2] = sigmoidf_(v[2]); o[3] = sigmoidf_(v[3]); *(f32x4*)(GATES + (size_t)row * 48 + L) = o; }
                            }
                    }
            }
        }
    }
};
struct EpiCmp {
    static constexpr bool PERM = true, AFTER_DRAIN = false, PERMA = false;
    bf16_t* HC; const float* bias1;
    __device__ __forceinline__ void operator()(const f32x4 (&acc)[2][2][4][2], const Unit& u, int wr, int wc, int fr, int fq) const {
        const int row0 = u.pm * BM + wr * 64 + fr, col0 = wc * 32 + 8 * fq;
        f32x4 bv[2][2];
#pragma unroll
        for (int bj = 0; bj < 2; ++bj)
#pragma unroll
            for (int n = 0; n < 2; ++n) bv[bj][n] = *(const f32x4*)(bias1 + u.pn * 256 + col0 + bj * HALF + 4 * n);
#pragma unroll
        for (int ai = 0; ai < 2; ++ai)
#pragma unroll
            for (int m = 0; m < 4; ++m) { bf16_t* rowp = HC + (size_t)(row0 + ai * HALF + m * 16) * 256 + col0;
#pragma unroll
                for (int bj = 0; bj < 2; ++bj) { f32x4 v0 = acc[ai][bj][m][0] + bv[bj][0], v1 = acc[ai][bj][m][1] + bv[bj][1];
#pragma unroll
                    for (int e = 0; e < 4; ++e) { v0[e] = gelu_tanh(v0[e]); v1[e] = gelu_tanh(v1[e]); }
                    u32x4 o; o.x = cvt_pk_bf16(v0[0], v0[1]); o.y = cvt_pk_bf16(v0[2], v0[3]); o.z = cvt_pk_bf16(v1[0], v1[1]); o.w = cvt_pk_bf16(v1[2], v1[3]);
                    *(u32x4*)(rowp + bj * HALF) = o; } }
    }
};
struct CmpOrder {
    int c, G;
    __device__ bool next(int i, Unit& u) const { const int L = i * G + c; if (L >= 32) return false; u.pm = L; u.pn = L >> 4; return true; }
    __device__ __forceinline__ void a_ready(const Unit&) const {}
    __device__ __forceinline__ void done(const Unit&) const {}
};
struct EpiRes1 {
    static constexpr bool PERM = true, AFTER_DRAIN = false, PERMA = false;
    const float* RINV; const float* INVW; bf16_t* X1b; float* SSQ;
    __device__ __forceinline__ void operator()(const f32x4 (&acc)[2][2][4][2], const Unit& u, int wr, int wc, int fr, int fq) const {
        const int row0 = u.pm * BM + wr * 64 + fr, col0 = u.pn * BM + wc * 32 + 8 * fq;
        f32x4 iw[2][2];
#pragma unroll
        for (int bj = 0; bj < 2; ++bj)
#pragma unroll
            for (int n = 0; n < 2; ++n) iw[bj][n] = *(const f32x4*)(INVW + col0 + bj * HALF + n * 4);
#pragma unroll
        for (int ai = 0; ai < 2; ++ai) {
            u32x4 xin[4][2]; float ri[4];
#pragma unroll
            for (int m = 0; m < 4; ++m) { ri[m] = RINV[row0 + ai * HALF + m * 16];
#pragma unroll
                for (int bj = 0; bj < 2; ++bj) xin[m][bj] = *(const u32x4*)(X1b + (size_t)(row0 + ai * HALF + m * 16) * D_MODEL + col0 + bj * HALF); }
            __builtin_amdgcn_sched_barrier(0);
#pragma unroll
            for (int m = 0; m < 4; ++m) { const int row = row0 + ai * HALF + m * 16; const size_t off = (size_t)row * D_MODEL + col0; float ss = 0.f;
#pragma unroll
                for (int bj = 0; bj < 2; ++bj) { const u32x4 w_ = xin[m][bj];
                    f32x4 x0, x1; x0[0] = __uint_as_float(w_.x << 16); x0[1] = __uint_as_float(w_.x & 0xffff0000u); x0[2] = __uint_as_float(w_.y << 16); x0[3] = __uint_as_float(w_.y & 0xffff0000u);
                    x1[0] = __uint_as_float(w_.z << 16); x1[1] = __uint_as_float(w_.z & 0xffff0000u); x1[2] = __uint_as_float(w_.w << 16); x1[3] = __uint_as_float(w_.w & 0xffff0000u);
                    const f32x4 v0 = x0 * ri[m] * iw[bj][0] + acc[ai][bj][m][0], v1 = x1 * ri[m] * iw[bj][1] + acc[ai][bj][m][1];
                    ss += ((v0[0] * v0[0] + v0[1] * v0[1]) + (v0[2] * v0[2] + v0[3] * v0[3])) + ((v1[0] * v1[0] + v1[1] * v1[1]) + (v1[2] * v1[2] + v1[3] * v1[3]));
                    u32x4 w; w.x = cvt_pk_bf16(v0[0], v0[1]); w.y = cvt_pk_bf16(v0[2], v0[3]); w.z = cvt_pk_bf16(v1[0], v1[1]); w.w = cvt_pk_bf16(v1[2], v1[3]); *(u32x4*)(X1b + off + bj * HALF) = w; }
                ss += __shfl_xor(ss, 16); ss += __shfl_xor(ss, 32);
                if (fq == 0) SSQ[(size_t)row * 32 + u.pn * 4 + wc] = ss; }
            __builtin_amdgcn_sched_barrier(0);
        }
    }
};
struct EpiUpV1 {
    static constexpr bool PERM = true, AFTER_DRAIN = false, PERMA = false;
    bf16_t* HID; const float* R2;
    __device__ __forceinline__ void operator()(const f32x4 (&acc)[2][2][4][2], const Unit& u, int wr, int wc, int fr, int fq) const {
        const int row0 = u.pm * BM + wr * 64 + fr, col0 = u.pn * BM + wc * 32 + 8 * fq;
#pragma unroll
        for (int ai = 0; ai < 2; ++ai)
#pragma unroll
            for (int m = 0; m < 4; ++m) { const int row = row0 + ai * HALF + m * 16; const float r = R2[row]; bf16_t* rowp = HID + (size_t)row * N_UP + col0;
#pragma unroll
                for (int bj = 0; bj < 2; ++bj) { const f32x4 v0 = acc[ai][bj][m][0] * r, v1 = acc[ai][bj][m][1] * r;
                    u32x4 o; o.x = cvt_pk_bf16(v0[0], v0[1]); o.y = cvt_pk_bf16(v0[2], v0[3]); o.z = cvt_pk_bf16(v1[0], v1[1]); o.w = cvt_pk_bf16(v1[2], v1[3]);
                    *(u32x4*)(rowp + bj * HALF) = o; } }
    }
};
struct EpiDown {
    static constexpr bool PERM = true, AFTER_DRAIN = false, PERMA = false;
    float* out; const bf16_t* X1b;
    __device__ __forceinline__ void operator()(const f32x4 (&acc)[2][2][4][2], const Unit& u, int wr, int wc, int fr, int fq) const {
        const int row0 = u.pm * BM + wr * 64 + fr, col0 = u.pn * BM + wc * 32 + 8 * fq;
#pragma unroll
        for (int ai = 0; ai < 2; ++ai) {
            u32x4 xin[4][2];
#pragma unroll
            for (int m = 0; m < 4; ++m)
#pragma unroll
                for (int bj = 0; bj < 2; ++bj) xin[m][bj] = *(const u32x4*)(X1b + (size_t)(row0 + ai * HALF + m * 16) * D_MODEL + col0 + bj * HALF);
            __builtin_amdgcn_sched_barrier(0);
#pragma unroll
            for (int m = 0; m < 4; ++m) { const size_t off = (size_t)(row0 + ai * HALF + m * 16) * D_MODEL + col0;
#pragma unroll
                for (int bj = 0; bj < 2; ++bj) { const u32x4 w = xin[m][bj];
                    f32x4 v0, v1; v0[0] = __uint_as_float(w.x << 16); v0[1] = __uint_as_float(w.x & 0xffff0000u); v0[2] = __uint_as_float(w.y << 16); v0[3] = __uint_as_float(w.y & 0xffff0000u);
                    v1[0] = __uint_as_float(w.z << 16); v1[1] = __uint_as_float(w.z & 0xffff0000u); v1[2] = __uint_as_float(w.w << 16); v1[3] = __uint_as_float(w.w & 0xffff0000u);
                    *(f32x4*)(out + off + bj * HALF) = v0 + acc[ai][bj][m][0]; *(f32x4*)(out + off + bj * HALF + 4) = v1 + acc[ai][bj][m][1]; } }
            __builtin_amdgcn_sched_barrier(0);
        }
    }
};
__device__ __forceinline__ unsigned f2bf_(float f) { unsigned u = __float_as_uint(f); return (u + 0x7fffu + ((u >> 16) & 1u)) >> 16; }
typedef float f32x2 __attribute__((ext_vector_type(2)));
struct EpiUpConv {
    static constexpr bool PERM = true, AFTER_DRAIN = false, PERMA = true;
    bf16_t* G; const float* R2; const float* cw; const float* cb; float* HLAST; float* FIRST; PG8_LAS unsigned char* xlds;
    __device__ __forceinline__ void prefetch(const Unit& u, int par, const int wave_s) const {
        const int lane_ = fresh_lane();
        PG8_LAS float* Wl = (PG8_LAS float*)xlds + (par ? 3344 : 2048);
#pragma unroll
        for (int i2 = 0; i2 < 2; ++i2) { const int i = wave_s * 64 + lane_ + 512 * i2, k = i >> 8, p = i & 255, c = (p < 128 ? 0 : D_FF - 128) + u.pn * 128 + p;
            const float* src = k < 3 ? cw + (unsigned)(k * N_UP + c) : cb + (unsigned)c;
            __builtin_amdgcn_global_load_lds((const unsigned*)src, (PG8_LAS unsigned*)(Wl + wave_s * 64 + 512 * i2), 4, 0, 0); }
        if (wave_s < 4) __builtin_amdgcn_global_load_lds((const unsigned*)(R2 + u.pm * BM + wave_s * 64 + lane_), (PG8_LAS unsigned*)(Wl + 1024 + wave_s * 64), 4, 0, 0);
    }
    __device__ __forceinline__ void run(const f32x4 (&acc)[2][2][4][2], const Unit& u, const Unit& nxt, const bool has_next, const int par, int wr, int wc, const int wave_s) const {
        unsigned z_ = 0u; asm volatile("" : "+v"(z_));
        const int lane_ = (int)__builtin_amdgcn_mbcnt_hi(~0u, __builtin_amdgcn_mbcnt_lo(~0u, z_)); const int fr = lane_ & 15, fq = lane_ >> 4;
        const int row0 = u.pm * BM + wr * 64 + 4 * fr;
        PG8_LAS float* X = (PG8_LAS float*)xlds;
        PG8_LAS float* Wl = X + (par ? 3344 : 2048);
        PG8_LAS float* R2L = Wl + 1024;
        const unsigned tile = (unsigned)(u.pm * (N_UP / 256) + u.pn);
        asm volatile("s_waitcnt vmcnt(8)" ::: "memory"); __builtin_amdgcn_s_barrier(); asm volatile("" ::: "memory");
        if (has_next) prefetch(nxt, par ^ 1, wave_s);
        if (fr == 15) {
#pragma unroll
            for (int ai = 0; ai < 2; ++ai) { const int sg = 2 * ai + wr; const float r2a = R2L[ai * HALF + wr * 64 + 62], r2b = R2L[ai * HALF + wr * 64 + 63];
#pragma unroll
                for (int mm = 0; mm < 2; ++mm)
#pragma unroll
                for (int bj = 0; bj < 2; ++bj)
#pragma unroll
                    for (int n = 0; n < 2; ++n) { const f32x4 h = acc[ai][bj][2 + mm][n] * (mm ? r2b : r2a);
                        *(PG8_LAS f32x4*)(X + ((sg * 4 + wc) * 2 + mm) * 64 + bj * 32 + 8 * fq + 4 * n) = h;
                        if (ai == 1 && wr == 1) *(f32x4*)(HLAST + (unsigned)((tile * 2 + mm) * 256 + bj * HALF + wc * 32 + 8 * fq + 4 * n)) = h; } }
        }
        asm volatile("s_waitcnt lgkmcnt(0)" ::: "memory"); __builtin_amdgcn_s_barrier(); asm volatile("" ::: "memory");
        const int cbase = u.pn * 128 + wc * 32 + 8 * fq;
        const bool seq_start = (u.pm & 15) == 0;
#pragma unroll
        for (int ai = 0; ai < 2; ++ai) {
            const int sg = 2 * ai + wr;
            const f32x4 rs = *(PG8_LAS const f32x4*)(R2L + ai * HALF + wr * 64 + 4 * fr);
            const bool defer = (ai == 0) && (wr == 0) && !seq_start && (fr == 0);
            unsigned pk[2][4][2];
#pragma unroll
            for (int n = 0; n < 2; ++n) {
#pragma unroll
                for (int e2 = 0; e2 < 2; ++e2) {
                    asm volatile("" ::: "memory"); __builtin_amdgcn_sched_barrier(0);
                    PG8_LAS const f32x2* wp = (PG8_LAS const f32x2*)(Wl + wc * 32 + 8 * fq + 4 * n + 2 * e2);
                    const f32x2 wg0 = wp[0], wg1 = wp[128], wg2 = wp[256], bg = wp[384], wu0 = wp[64], wu1 = wp[192], wu2 = wp[320], bu = wp[448];
                    f32x2 hg1 = {0.f, 0.f}, hg2 = {0.f, 0.f}, hu1 = {0.f, 0.f}, hu2 = {0.f, 0.f};
                    if (ai == 1 || wr == 1) { PG8_LAS const f32x2* xp = (PG8_LAS const f32x2*)(X + (((sg - 1) * 4 + wc) * 2) * 64 + 8 * fq + 4 * n + 2 * e2); hg2 = xp[0]; hg1 = xp[32]; hu2 = xp[16]; hu1 = xp[48]; }
                    f32x2 vg[4], vu[4], cg[4], cu[4];
#pragma unroll
                    for (int m = 0; m < 4; ++m) { const f32x2 r2 = {rs[m], rs[m]};
                        vg[m] = (f32x2){acc[ai][0][m][n][2 * e2], acc[ai][0][m][n][2 * e2 + 1]} * r2; vu[m] = (f32x2){acc[ai][1][m][n][2 * e2], acc[ai][1][m][n][2 * e2 + 1]} * r2; }
#define EPI_SHR1(old_, v_) (f32x2){__uint_as_float(__builtin_amdgcn_update_dpp(__float_as_uint((old_).x), __float_as_uint((v_).x), 0x111, 0xf, 0xf, false)), __uint_as_float(__builtin_amdgcn_update_dpp(__float_as_uint((old_).y), __float_as_uint((v_).y), 0x111, 0xf, 0xf, false))}
                    const f32x2 pg1 = EPI_SHR1(hg1, vg[3]), pg2 = EPI_SHR1(hg2, vg[2]), pu1 = EPI_SHR1(hu1, vu[3]), pu2 = EPI_SHR1(hu2, vu[2]);
#undef EPI_SHR1
                    cg[0] = bg + wg0 * pg2 + wg1 * pg1 + wg2 * vg[0]; cu[0] = bu + wu0 * pu2 + wu1 * pu1 + wu2 * vu[0];
                    cg[1] = bg + wg0 * pg1 + wg1 * vg[0] + wg2 * vg[1]; cu[1] = bu + wu0 * pu1 + wu1 * vu[0] + wu2 * vu[1];
                    cg[2] = bg + wg0 * vg[0] + wg1 * vg[1] + wg2 * vg[2]; cu[2] = bu + wu0 * vu[0] + wu1 * vu[1] + wu2 * vu[2];
                    cg[3] = bg + wg0 * vg[1] + wg1 * vg[2] + wg2 * vg[3]; cu[3] = bu + wu0 * vu[1] + wu1 * vu[2] + wu2 * vu[3];
                    if (defer) {
#pragma unroll
                        for (int m = 0; m < 2; ++m) { float* fp = FIRST + (unsigned)((tile * 2 + m) * 256 + wc * 32 + 8 * fq + 4 * n + 2 * e2); *(f32x2*)fp = cg[m]; *(f32x2*)(fp + HALF) = cu[m]; }
                    }
#pragma unroll
                    for (int m = 0; m < 4; ++m) {
                        const f32x2 t = cg[m] * (f32x2){-LOG2E, -LOG2E};
                        f32x2 sg_ = {__builtin_amdgcn_exp2f(t.x), __builtin_amdgcn_exp2f(t.y)};
                        sg_ = sg_ + (f32x2){1.0f, 1.0f};
                        const f32x2 rc = {__builtin_amdgcn_rcpf(sg_.x), __builtin_amdgcn_rcpf(sg_.y)};
                        const f32x2 gv = cg[m] * rc * cu[m];
                        pk[n][m][e2] = cvt_pk_bf16(gv.x, gv.y);
                    }
                }
            }
#pragma unroll
            for (int m = 0; m < 4; ++m)
                if (!(m < 2 && defer)) { u32x4 o; o.x = pk[0][m][0]; o.y = pk[0][m][1]; o.z = pk[1][m][0]; o.w = pk[1][m][1]; *(u32x4*)(G + (unsigned)((row0 + ai * HALF + m) * D_FF + cbase)) = o; }
        }
    }
};
template <class Epi, class Sched, bool ALIGN_EPI = false, bool SP2 = false>
__device__ __forceinline__ void gemm_phase(PG8_LAS unsigned char* lds, const Gemm g, const Sched& S, const Epi& E, const int wave_s) {
    const int tid = fresh_tid(wave_s), wid = wave_s, lane = tid & 63,
          wr = wid >> 2, wc = wid & 3, fr = lane & 15, fq = lane >> 4;
    const int K = g.K, nt = K / BK;
    unsigned voffA[2], voffB[2];
#pragma unroll
    for (int i = 0; i < 2; ++i) { int R, C; stage_rc(tid * 16 + i * 8192, R, C); const int Rb = Epi::PERM ? ((R & ~31) + perm32(R & 31)) : R;
        const int Ra = Epi::PERMA ? ((R & ~63) + 4 * (R & 15) + ((R >> 4) & 3)) : R;
        voffA[i] = (unsigned)(Ra * g.lda + C) * 2u; voffB[i] = (unsigned)(Rb * K + C) * 2u; }
    const size_t kstep = (size_t)(BK * 2);
    const size_t hstepA = (size_t)HALF * g.lda * 2, hstepB = (size_t)HALF * K * 2;
    const size_t tstepA = 2 * hstepA, tstepB = 2 * hstepB;
    const unsigned ldsw = (unsigned)wid * 1024u;
    const int aoff = lds_byte(wr * 64 + fr, fq * 8), boff = lds_byte(wc * 32 + fr, fq * 8);
#define PG8_SA(b, h) (((b) * 2 + (h)) * HTB)
#define PG8_SB(b, h) ((4 + (b) * 2 + (h)) * HTB)
#define PG8_STAGE(bufoff, gbase, voff) do { _Pragma("unroll") for (int _i = 0; _i < 2; ++_i) \
        __builtin_amdgcn_global_load_lds((const unsigned*)((const char*)(gbase) + (voff)[_i]), (PG8_LAS unsigned*)(lds + (bufoff) + ldsw + _i * 8192), 16, 0, 0); } while (0)
#define PG8_LDA(dst, b, h) do { _Pragma("unroll") for (int m = 0; m < 4; ++m) _Pragma("unroll") for (int k = 0; k < 2; ++k) dst[m][k] = *(const PG8_LAS bf16x8*)(lds + PG8_SA(b, h) + aoff + m * 2048 + k * 1024); } while (0)
#define PG8_LDB(dst, b, h) do { _Pragma("unroll") for (int n = 0; n < 2; ++n) _Pragma("unroll") for (int k = 0; k < 2; ++k) dst[n][k] = *(const PG8_LAS bf16x8*)(lds + PG8_SB(b, h) + boff + n * 2048 + k * 1024); } while (0)
#define PG8_MMA(ai, bj, At, Bt) do { __builtin_amdgcn_s_setprio(1); _Pragma("unroll") for (int m = 0; m < 4; ++m) _Pragma("unroll") for (int n = 0; n < 2; ++n) _Pragma("unroll") for (int k = 0; k < 2; ++k) \
        acc[ai][bj][m][n] = __builtin_amdgcn_mfma_f32_16x16x32_bf16(Bt[n][k], At[m][k], acc[ai][bj][m][n], 0, 0, 0); __builtin_amdgcn_s_setprio(0); } while (0)
#define PG8_WAIT_V(n) asm volatile("s_waitcnt vmcnt(" #n ")" ::: "memory")
#define PG8_WAIT_L(n) asm volatile("s_waitcnt lgkmcnt(" #n ")" ::: "memory")
#define PG8_BAR __builtin_amdgcn_s_barrier()
#define PG8_SCHED __builtin_amdgcn_sched_barrier(0)
    Unit cur, nxt; int ui = 0;
    if (!S.next(0, cur)) return;
    f32x4 acc[2][2][4][2];
#pragma unroll
    for (int a = 0; a < 2; ++a)
#pragma unroll
        for (int b = 0; b < 2; ++b)
#pragma unroll
            for (int m = 0; m < 4; ++m)
#pragma unroll
                for (int n = 0; n < 2; ++n) acc[a][b][m][n] = (f32x4){0.f, 0.f, 0.f, 0.f};
    bf16x8 At[4][2], B0[2][2], B1[2][2];
    const char* cA = (const char*)g.A + (size_t)cur.pm * tstepA; const char* cB = (const char*)g.Bt + (size_t)cur.pn * tstepB;
    S.a_ready(cur);
    if constexpr (Epi::PERMA) E.prefetch(cur, 0, wave_s);
    if constexpr (SP2) {
        PG8_STAGE(PG8_SB(0, 0), cB, voffB); PG8_STAGE(PG8_SB(0, 1), cB + hstepB, voffB); PG8_STAGE(PG8_SA(0, 0), cA, voffA); PG8_STAGE(PG8_SA(0, 1), cA + hstepA, voffA);
        if (wr == 1) PG8_BAR;
        PG8_WAIT_V(2); PG8_BAR;
        PG8_STAGE(PG8_SB(1, 0), cB + kstep, voffB); PG8_STAGE(PG8_SA(1, 0), cA + kstep, voffA); PG8_STAGE(PG8_SB(1, 1), cB + hstepB + kstep, voffB);
        PG8_WAIT_V(6); PG8_BAR;
    } else {
        PG8_STAGE(PG8_SB(0, 0), cB, voffB); PG8_STAGE(PG8_SA(0, 0), cA, voffA); PG8_STAGE(PG8_SB(0, 1), cB + hstepB, voffB); PG8_STAGE(PG8_SA(0, 1), cA + hstepA, voffA);
        if (wr == 1) PG8_BAR;
        PG8_WAIT_V(4); PG8_BAR;
        PG8_STAGE(PG8_SB(1, 0), cB + kstep, voffB); PG8_STAGE(PG8_SA(1, 0), cA + kstep, voffA); PG8_STAGE(PG8_SB(1, 1), cB + hstepB + kstep, voffB);
        PG8_WAIT_V(6); PG8_BAR;
    }
    for (;;) {
        const bool has_next = S.next(ui + 1, nxt);
        const char* nA = has_next ? (const char*)g.A + (size_t)nxt.pm * tstepA : cA; const char* nB = has_next ? (const char*)g.Bt + (size_t)nxt.pn * tstepB : cB;
        for (int t = 0; t < nt; t += 2) {
            const bool last = (t == nt - 2);
            const char* a1 = cA + (size_t)(t + 1) * kstep;
            const char* a2 = last ? nA : cA + (size_t)(t + 2) * kstep; const char* b2 = last ? nB : cB + (size_t)(t + 2) * kstep;
            const char* a3 = a2 + kstep; const char* b3 = b2 + kstep;
            if (last && has_next) S.a_ready(nxt);
            if constexpr (SP2) {
            PG8_LDB(B0, 0, 0); PG8_LDB(B1, 0, 1); PG8_SCHED; PG8_LDA(At, 0, 0); PG8_STAGE(PG8_SA(1, 1), a1 + hstepA, voffA);
            PG8_WAIT_V(8); PG8_WAIT_L(0); PG8_BAR; PG8_MMA(0, 0, At, B0); PG8_MMA(0, 1, At, B1); PG8_BAR; PG8_SCHED;
            PG8_LDA(At, 0, 1); PG8_STAGE(PG8_SB(0, 0), b2, voffB); PG8_STAGE(PG8_SB(0, 1), b2 + hstepB, voffB); PG8_STAGE(PG8_SA(0, 0), a2, voffA);
            PG8_WAIT_V(8); PG8_WAIT_L(0); PG8_BAR; PG8_MMA(1, 0, At, B0); PG8_MMA(1, 1, At, B1); PG8_BAR; PG8_SCHED;
            PG8_LDB(B0, 1, 0); PG8_LDB(B1, 1, 1); PG8_SCHED; PG8_LDA(At, 1, 0); PG8_STAGE(PG8_SA(0, 1), a2 + hstepA, voffA);
            PG8_WAIT_V(8); PG8_WAIT_L(0); PG8_BAR; PG8_MMA(0, 0, At, B0); PG8_MMA(0, 1, At, B1); PG8_BAR; PG8_SCHED;
            PG8_LDA(At, 1, 1); PG8_STAGE(PG8_SB(1, 0), b3, voffB); PG8_STAGE(PG8_SB(1, 1), b3 + hstepB, voffB); PG8_STAGE(PG8_SA(1, 0), a3, voffA);
            PG8_WAIT_V(8); PG8_WAIT_L(0); PG8_BAR; PG8_MMA(1, 0, At, B0); PG8_MMA(1, 1, At, B1); PG8_BAR; PG8_SCHED;
            } else {
            PG8_LDB(B0, 0, 0); PG8_SCHED; PG8_LDA(At, 0, 0); PG8_STAGE(PG8_SA(1, 1), a1 + hstepA, voffA);
            PG8_WAIT_L(8); PG8_BAR; PG8_WAIT_L(0); PG8_MMA(0, 0, At, B0); PG8_BAR; PG8_SCHED;
            PG8_LDB(B1, 0, 1); PG8_STAGE(PG8_SB(0, 0), b2, voffB);
            PG8_BAR; PG8_WAIT_L(0); PG8_MMA(0, 1, At, B1); PG8_BAR;
            PG8_LDA(At, 0, 1); PG8_STAGE(PG8_SA(0, 0), a2, voffA);
            PG8_BAR; PG8_WAIT_L(0); PG8_MMA(1, 0, At, B0); PG8_BAR; PG8_SCHED;
            PG8_STAGE(PG8_SB(0, 1), b2 + hstepB, voffB);
            PG8_WAIT_V(6); PG8_BAR; PG8_MMA(1, 1, At, B1); PG8_BAR;
            PG8_LDB(B0, 1, 0); PG8_SCHED; PG8_LDA(At, 1, 0); PG8_STAGE(PG8_SA(0, 1), a2 + hstepA, voffA);
            PG8_WAIT_L(8); PG8_BAR; PG8_WAIT_L(0); PG8_MMA(0, 0, At, B0); PG8_BAR; PG8_SCHED;
            PG8_LDB(B1, 1, 1); PG8_STAGE(PG8_SB(1, 0), b3, voffB);
            PG8_BAR; PG8_WAIT_L(0); PG8_MMA(0, 1, At, B1); PG8_BAR;
            PG8_LDA(At, 1, 1); PG8_STAGE(PG8_SA(1, 0), a3, voffA);
            PG8_BAR; PG8_WAIT_L(0); PG8_MMA(1, 0, At, B0); PG8_BAR; PG8_SCHED;
            PG8_STAGE(PG8_SB(1, 1), b3 + hstepB, voffB);
            PG8_WAIT_V(6); PG8_BAR; PG8_MMA(1, 1, At, B1); PG8_BAR;
            }
        }
        if constexpr (ALIGN_EPI) { if (wr == 0) PG8_BAR; }
        if constexpr (Epi::PERMA) { E.run(acc, cur, nxt, has_next, ui & 1, wr, wc, wave_s); S.done(cur); }
        else if constexpr (!Epi::AFTER_DRAIN) { E(acc, cur, wr, wc, fr, fq); S.done(cur); }
        if (!has_next) break;
#pragma unroll
        for (int a = 0; a < 2; ++a)
#pragma unroll
            for (int b = 0; b < 2; ++b)
#pragma unroll
                for (int m = 0; m < 4; ++m)
#pragma unroll
                    for (int n = 0; n < 2; ++n) acc[a][b][m][n] = (f32x4){0.f, 0.f, 0.f, 0.f};
        cur = nxt; cA = nA; cB = nB; ++ui;
        if constexpr (ALIGN_EPI) { if (wr == 1) PG8_BAR; }
    }
    PG8_WAIT_V(0);
    if constexpr (!ALIGN_EPI) { if (wr == 0) PG8_BAR; }
    PG8_BAR;
    if constexpr (Epi::AFTER_DRAIN) { E.fused(acc, cur, wr, wc, fr, fq, lds, wid, lane); S.done(cur); }
#undef PG8_SA
#undef PG8_SB
#undef PG8_STAGE
#undef PG8_LDA
#undef PG8_LDB
#undef PG8_MMA
#undef PG8_WAIT_V
#undef PG8_WAIT_L
#undef PG8_BAR
#undef PG8_SCHED
}
}
constexpr int NWAVES = 8;
template <class RowMap>
__device__ __forceinline__ void transpose_item(const float* __restrict__ W, int K, int N, bf16_t* WT, const float* __restrict__ kscale, RowMap rm, LAS float* scr, int item, int lane) {
    const int nblk = (N + 31) / 32, kb = item / nblk, nb = item % nblk, k0 = 64 * kb, n0 = 32 * nb;
    const int nr = n0 + (lane & 31);
    float v[32];
#pragma unroll
    for (int i = 0; i < 32; ++i) { const int kk = 2 * i + (lane >> 5); v[i] = (nr < N) ? __builtin_nontemporal_load(W + (size_t)(k0 + kk) * N + nr) : 0.f; }
    if (kscale) {
#pragma unroll
        for (int i = 0; i < 32; ++i) v[i] *= kscale[k0 + 2 * i + (lane >> 5)];
    }
#pragma unroll
    for (int i = 0; i < 32; ++i) scr[(2 * i + (lane >> 5)) * 33 + (lane & 31)] = v[i];
    asm volatile("s_waitcnt lgkmcnt(0)" ::: "memory");
    const int c = lane & 7;
#pragma unroll
    for (int j = 0; j < 4; ++j) { const int nl = (lane >> 3) + 8 * j, n = n0 + nl;
        if (n < N) { const LAS float* s = scr + (8 * c) * 33 + nl;
            u32x4_t o; o.x = pk2(s[0 * 33], s[1 * 33]); o.y = pk2(s[2 * 33], s[3 * 33]); o.z = pk2(s[4 * 33], s[5 * 33]); o.w = pk2(s[6 * 33], s[7 * 33]);
            *(u32x4_t*)(WT + (size_t)rm(n) * K + k0 + 8 * c) = o; } }
    asm volatile("s_waitcnt lgkmcnt(0)" ::: "memory");
}
struct RmIdent { __device__ __forceinline__ int operator()(int n) const { return n; } };
struct RmWin {
    __device__ __forceinline__ int operator()(int c) const {
        const int nc = c < 2560 ? c : (c < 2608 ? 4608 + (c - 2560) : 2560 + (c - 2608));
        const int tile = nc >> 8, L = nc & 255, wc = L >> 6, bj = (L >> 5) & 1, j = L & 31;
        return tile * 256 + 128 * bj + 32 * wc + j;
    }
};
struct RmWup {
    __device__ __forceinline__ int operator()(int c) const { const int up = c >= D_FF, cc = up ? c - D_FF : c; return (cc >> 7) * 256 + up * 128 + (cc & 127); }
};

struct Ptrs {
    const float* in[18]; float* out; unsigned char* ws;
};

__device__ __forceinline__ void p0_prologue(const Ptrs& P, LAS unsigned char* lds, int vcu, int G, const int wave) {
    const int lane = fresh_lane();
    LAS float* scr = (LAS float*)(lds + wave * 16384);
    const int gw = vcu * NWAVES + wave, NGW = G * NWAVES;
    unsigned char* ws = P.ws;
    bf16_t* WinT = (bf16_t*)(ws + WS_WIN); bf16_t* WoutT = (bf16_t*)(ws + WS_WOUT); bf16_t* WupT = (bf16_t*)(ws + WS_WUP); bf16_t* WdownT = (bf16_t*)(ws + WS_WDOWN); bf16_t* W1cT = (bf16_t*)(ws + WS_W1C);
    const float* x = P.in[0]; const float* attn_norm_w = P.in[1]; const float* w_in = P.in[2]; const float* cmp_pos = P.in[5]; const float* cmp_w1 = P.in[6];
    const float* w_out = P.in[12]; const float* ffn_norm_w = P.in[13]; const float* w_up = P.in[14]; const float* w_down = P.in[17];
    constexpr int I_IN = 32 * 146, I_W1 = 32 * 8, I_W2 = 4 * 2;
    constexpr int NITEMS = I_IN + 2 * I_W1 + 2 * I_W2;
    (void)w_out; (void)w_up; (void)w_down; (void)ffn_norm_w; (void)WoutT; (void)WupT; (void)WdownT;
    for (int it = gw; it < NITEMS; it += NGW) {
        int r = it;
        if (r < I_IN) { transpose_item(w_in, 2048, IN_COLS, WinT, nullptr, RmWin(), scr, r, lane); continue; } r -= I_IN;
        if (r < I_W1) { transpose_item(cmp_w1, 2048, 256, W1cT, nullptr, RmIdent(), scr, r, lane); continue; } r -= I_W1;
        if (r < I_W1) { transpose_item(cmp_w1 + (size_t)2048 * 256, 2048, 256, W1cT + (size_t)256 * 2048, nullptr, RmIdent(), scr, r, lane); continue; } r -= I_W1;
        { const int kv = r >= I_W2 ? 1 : 0; transpose_item(P.in[7] + (size_t)kv * 256 * 64, 256, 64, (bf16_t*)(ws + WS_SMALL + SM_W2T) + (size_t)kv * 64 * 256, nullptr, RmIdent(), scr, r - kv * I_W2, lane); }
    }
    for (int i = gw * 64 + lane; i < 8 * 16384; i += NGW * 64) { const int t = (i >> 7) & 127, sx = i & 127; ((bf16_t*)(ws + WS_SMALL + SM_SWB))[i] = (bf16_t)(sx <= t ? f2bf(P.in[10][i]) : 0u); }
    for (int p = gw; p < 256; p += NGW) {
        const int L = 64 * ((p >> 5) & 3) + 32 * (p >> 7) + (p & 31);
        if (L >= 48) { u32x4_t z = {0u, 0u, 0u, 0u}; u32x4_t* d = (u32x4_t*)(WinT + (size_t)(18 * 256 + p) * 2048);
#pragma unroll
            for (int j = 0; j < 4; ++j) d[lane + 64 * j] = z; }
    }
    bf16_t* XN = (bf16_t*)(ws + WS_XN);
    for (int m = gw; m < MTOK; m += 2 * NGW) {
        const int m2 = m + NGW;
        const f32x4_t* xr = (const f32x4_t*)(x + (size_t)m * D_MODEL) + lane;
        const f32x4_t* xr2 = (const f32x4_t*)(x + (size_t)(m2 < MTOK ? m2 : m) * D_MODEL) + lane;
        f32x4_t v[8], v2[8]; float s = 0.f, s2 = 0.f;
#pragma unroll
        for (int j = 0; j < 8; ++j) { v[j] = __builtin_nontemporal_load(xr + 64 * j); v2[j] = __builtin_nontemporal_load(xr2 + 64 * j); }
#pragma unroll
        for (int j = 0; j < 8; ++j) { s += (v[j][0] * v[j][0] + v[j][1] * v[j][1]) + (v[j][2] * v[j][2] + v[j][3] * v[j][3]); s2 += (v2[j][0] * v2[j][0] + v2[j][1] * v2[j][1]) + (v2[j][2] * v2[j][2] + v2[j][3] * v2[j][3]); }
        const float ms1 = wave_sum(s) * (1.0f / D_MODEL) + 1e-6f, ms2 = wave_sum(s2) * (1.0f / D_MODEL) + 1e-6f;
        const float r = __builtin_amdgcn_rsqf(ms1), r2 = __builtin_amdgcn_rsqf(ms2);
        if (lane == 0) { float* rinv = (float*)(ws + WS_SMALL + SM_RINV); rinv[m] = ms1 * r; if (m2 < MTOK) rinv[m2] = ms2 * r2; }
        u32x2_t* o8 = (u32x2_t*)(XN + (size_t)m * D_MODEL) + lane; u32x2_t* o82 = (u32x2_t*)(XN + (size_t)m2 * D_MODEL) + lane;
#pragma unroll
        for (int j = 0; j < 8; ++j) { const f32x4_t w = ((const f32x4_t*)attn_norm_w)[lane + 64 * j];
            u32x2_t o; o.x = pk2(v[j][0] * r * w[0], v[j][1] * r * w[1]); o.y = pk2(v[j][2] * r * w[2], v[j][3] * r * w[3]); o8[64 * j] = o;
            if (m2 < MTOK) { u32x2_t q; q.x = pk2(v2[j][0] * r2 * w[0], v2[j][1] * r2 * w[1]); q.y = pk2(v2[j][2] * r2 * w[2], v2[j][3] * r2 * w[3]); o82[64 * j] = q; } }
    }
    for (int i = gw * 64 + lane; i < D_MODEL; i += NGW * 64) ((float*)(ws + WS_SMALL + SM_INVW))[i] = 1.0f / attn_norm_w[i];
    float* BIASP = (float*)(ws + WS_SMALL + SM_BIASP);
    for (int it = gw; it < 64; it += NGW) {
        const int kv = it >> 5, kc = it & 31; f32x4_t a = {0.f, 0.f, 0.f, 0.f};
        const float* pp = cmp_pos + kv * 2048 + kc * 64; const float* w1 = cmp_w1 + ((size_t)kv * 2048 + kc * 64) * 256;
        for (int k = 0; k < 64; ++k) { const f32x4_t w = ((const f32x4_t*)(w1 + (size_t)k * 256))[lane]; a += w * pp[k]; }
        ((f32x4_t*)(BIASP + (size_t)it * 256))[lane] = a;
    }
}

__device__ __forceinline__ void bias1_stage(unsigned char* ws, int idx  ) {
    const float* BIASP = (const float*)(ws + WS_SMALL + SM_BIASP); float* BIAS1 = (float*)(ws + WS_SMALL + SM_BIAS1);
    const int kv = idx >> 8, j = idx & 255; float s = 0.f;
    for (int kc = 0; kc < 32; ++kc) s += BIASP[(size_t)(kv * 32 + kc) * 256 + j];
    BIAS1[idx] = s;
}
__device__ __forceinline__ void cmp2_row(const Ptrs& P, int R, int lane) {
    unsigned char* ws = P.ws; const bf16_t* HC = (const bf16_t*)(ws + WS_HC);
    const int kv = R >> 12, rr = R & 4095, n = rr & 255;
    bf16_t* dst = (bf16_t*)(ws + (kv ? WS_VC : WS_KC)) + (size_t)rr * 64 + lane;
    if (n == 255) { *dst = 0; return; }
    const float* w2 = P.in[7] + (size_t)kv * 256 * 64;
    const u32x2_t hr = *(const u32x2_t*)(HC + (size_t)R * 256 + 4 * lane);
    float h[4] = {__uint_as_float(hr.x << 16), __uint_as_float(hr.x & 0xffff0000u), __uint_as_float(hr.y << 16), __uint_as_float(hr.y & 0xffff0000u)};
    float o = 0.f;
    for (int jj = 0; jj < 64; ++jj) {
#pragma unroll
        for (int i = 0; i < 4; ++i) o += __shfl(h[i], jj) * w2[(size_t)(4 * jj + i) * 64 + lane];
    }
    if (kv == 0) { const float ss = wave_sum(o * o); o *= __builtin_amdgcn_rsqf(ss * (1.0f / 64.0f) + 1e-6f) * P.in[4][lane]; }
    *dst = (bf16_t)f2bf(o);
}

__device__ __forceinline__ void gmlp_unit_v1(const Ptrs& P, LAS unsigned char* lds, int unit, const int wave_s) {
    unsigned char* ws = P.ws; const int tid = fresh_tid(wave_s);
    const int g = unit & 7, chunk = (unit >> 3) & 31, b = unit >> 8; const int m0 = b * SEQ + chunk * 128;
    LAS float* vn = (LAS float*)lds; LAS float* Wl = (LAS float*)(lds + 65536); LAS float* st = (LAS float*)(lds + 131072);
    const bf16_t* GV = (const bf16_t*)(ws + WS_GV); const bf16_t* U = (const bf16_t*)(ws + WS_U); const float* VSTAT = (const float*)(ws + WS_VSTAT);
    bf16_t* AB = (bf16_t*)(ws + WS_AB);
    const float* ln_w = P.in[8]; const float* ln_b = P.in[9]; const float* sw = P.in[10]; const float* sb = P.in[11];
    if (tid < 128) { const float* p = VSTAT + (size_t)(m0 + tid) * 32; float s1 = 0.f, s2 = 0.f;
#pragma unroll
        for (int i = 0; i < 16; ++i) { s1 += p[2 * i]; s2 += p[2 * i + 1]; }
        const float mean = s1 * (1.0f / 1024.0f); float var = s2 * (1.0f / 1024.0f) - mean * mean; var = var < 0.f ? 0.f : var;
        st[2 * tid] = mean; st[2 * tid + 1] = __builtin_amdgcn_rsqf(var + 1e-5f); }
    for (int i = 0; i < 32; ++i) { const int idx = tid + 512 * i, t = idx >> 7, s = idx & 127; Wl[idx] = (s <= t) ? sw[(size_t)g * 16384 + idx] : 0.f; }
    __syncthreads();
#pragma unroll
    for (int i = 0; i < 4; ++i) { const int idx = tid + 512 * i, s = idx >> 4, c8 = idx & 15;
        const u32x4_t raw = *(const u32x4_t*)(GV + (size_t)(m0 + s) * 1024 + g * 128 + 8 * c8); float f[8]; unpack8(raw, f);
        const float mean = st[2 * s], rstd = st[2 * s + 1];
#pragma unroll
        for (int e = 0; e < 8; ++e) { const int c = g * 128 + 8 * c8 + e; vn[s * 128 + 8 * c8 + e] = (f[e] - mean) * rstd * ln_w[c] + ln_b[c]; } }
    __syncthreads();
    const int c = tid & 127, tq = tid >> 7;
    for (int i = 0; i < 8; ++i) {
        const int t0 = 4 * (tq + 4 * i); float a0 = 0.f, a1 = 0.f, a2 = 0.f, a3 = 0.f;
        for (int s4 = 0; s4 <= t0; s4 += 4) {
            const f32x4_t w0 = *(const LAS f32x4_t*)(Wl + (t0 + 0) * 128 + s4), w1 = *(const LAS f32x4_t*)(Wl + (t0 + 1) * 128 + s4), w2 = *(const LAS f32x4_t*)(Wl + (t0 + 2) * 128 + s4), w3 = *(const LAS f32x4_t*)(Wl + (t0 + 3) * 128 + s4);
#pragma unroll
            for (int k = 0; k < 4; ++k) { const float v = vn[(s4 + k) * 128 + c]; a0 += w0[k] * v; a1 += w1[k] * v; a2 += w2[k] * v; a3 += w3[k] * v; }
        }
        const float av[4] = {a0, a1, a2, a3};
#pragma unroll
        for (int k = 0; k < 4; ++k) { const int t = t0 + k; const size_t row = (size_t)(m0 + t);
            const float uu = bf2f(U[row * 1024 + g * 128 + c]); AB[row * 2048 + 1024 + g * 128 + c] = (bf16_t)f2bf(uu * (av[k] + sb[g * 128 + t])); }
    }
    __syncthreads();
}

__device__ __forceinline__ void conv_item(const Ptrs& P, int b, int idx) {
    const int t = idx / 704, c8 = idx % 704, c0 = 8 * c8, j = c0 >> 7, i0 = c0 & 127;
    const bf16_t* HID = (const bf16_t*)(P.ws + WS_HID); const float* cw = P.in[15]; const float* cb = P.in[16];
    float gt[8], up[8];
#pragma unroll
    for (int e = 0; e < 8; ++e) { gt[e] = cb[c0 + e]; up[e] = cb[D_FF + c0 + e]; }
#pragma unroll
    for (int k = 0; k < 3; ++k) { const int tt = t - 2 + k; if (tt < 0) continue;
        float hg[8], hu[8]; unpack8(*(const u32x4_t*)(HID + (size_t)tt * N_UP + 256 * j + i0), hg); unpack8(*(const u32x4_t*)(HID + (size_t)tt * N_UP + 256 * j + 128 + i0), hu);
#pragma unroll
        for (int e = 0; e < 8; ++e) { gt[e] += cw[(size_t)k * N_UP + c0 + e] * hg[e]; up[e] += cw[(size_t)k * N_UP + D_FF + c0 + e] * hu[e]; } }
    float r[8];
#pragma unroll
    for (int e = 0; e < 8; ++e) r[e] = gt[e] * sigmoidf_(gt[e]) * up[e];
    u32x4_t o; o.x = pk2(r[0], r[1]); o.y = pk2(r[2], r[3]); o.z = pk2(r[4], r[5]); o.w = pk2(r[6], r[7]);
    *(u32x4_t*)((bf16_t*)(P.ws + WS_G) + ((size_t)b * SEQ + t) * D_FF + c0) = o;
}

constexpr int LW_CH = 32;
constexpr int LW_OUT = 32 * 64, LW_UP = 32 * 352, LW_DOWN = 88 * 64, LW_C_OUT = LW_OUT / LW_CH, LW_C_UP = LW_UP / LW_CH, LW_C_DOWN = LW_DOWN / LW_CH, LW_CHUNKS = LW_C_OUT + LW_C_UP + LW_C_DOWN;
static_assert(LW_OUT % LW_CH == 0 && LW_UP % LW_CH == 0 && LW_DOWN % LW_CH == 0, "late weight items per chunk");
template <class RowMap>
__device__ __forceinline__ void lw_load(float (&v)[32], const float* __restrict__ W, int N, int item, int lane) {
    const int nblk = N / 32, kb = item / nblk, nb = item % nblk;
    const float* p = W + (size_t)(64 * kb + (lane >> 5)) * N + 32 * nb + (lane & 31);
#pragma unroll
    for (int i = 0; i < 32; ++i) v[i] = __builtin_nontemporal_load(p + (size_t)(2 * i) * N);
}
template <class RowMap>
__device__ __forceinline__ void lw_store(const float (&v)[32], int K, int N, bf16_t* WT, const float* __restrict__ kscale, RowMap rm, LAS float* scr, int item, int lane) {
    const int nblk = N / 32, kb = item / nblk, nb = item % nblk, k0 = 64 * kb, n0 = 32 * nb;
    const int c = lane & 7;
    f32x4_t sc0 = {1.f, 1.f, 1.f, 1.f}, sc1 = sc0;
    if (kscale) { sc0 = *(const f32x4_t*)(kscale + k0 + 8 * c); sc1 = *(const f32x4_t*)(kscale + k0 + 8 * c + 4); }
#pragma unroll
    for (int i = 0; i < 32; ++i) scr[(2 * i + (lane >> 5)) * 33 + (lane & 31)] = v[i];
    asm volatile("s_waitcnt lgkmcnt(0)" ::: "memory");
#pragma unroll
    for (int j = 0; j < 4; ++j) { const int nl = (lane >> 3) + 8 * j; const LAS float* s = scr + (8 * c) * 33 + nl;
        u32x4_t o; o.x = pk2(s[0 * 33] * sc0[0], s[1 * 33] * sc0[1]); o.y = pk2(s[2 * 33] * sc0[2], s[3 * 33] * sc0[3]); o.z = pk2(s[4 * 33] * sc1[0], s[5 * 33] * sc1[1]); o.w = pk2(s[6 * 33] * sc1[2], s[7 * 33] * sc1[3]);
        *(u32x4_t*)(WT + (size_t)rm(n0 + nl) * K + k0 + 8 * c) = o; }
    asm volatile("s_waitcnt lgkmcnt(0)" ::: "memory");
}
template <class RowMap>
__device__ __forceinline__ void lw_run(const float* __restrict__ W, int K, int N, bf16_t* WT, const float* __restrict__ kscale, RowMap rm, LAS float* scr, int item0, int wave, int lane) {
    float va[32], vb[32];
    lw_load<RowMap>(va, W, N, item0 + wave, lane);
    lw_load<RowMap>(vb, W, N, item0 + wave + 8, lane);  lw_store(va, K, N, WT, kscale, rm, scr, item0 + wave, lane);
    lw_load<RowMap>(va, W, N, item0 + wave + 16, lane); lw_store(vb, K, N, WT, kscale, rm, scr, item0 + wave + 8, lane);
    lw_load<RowMap>(vb, W, N, item0 + wave + 24, lane); lw_store(va, K, N, WT, kscale, rm, scr, item0 + wave + 16, lane);
    lw_store(vb, K, N, WT, kscale, rm, scr, item0 + wave + 24, lane);
}
__device__ __forceinline__ void late_weight_chunk(const Ptrs& P, LAS unsigned char* lds, int chunk, const int wave) {
    const int lane = fresh_lane();
    LAS float* scr = (LAS float*)(lds + wave * 16384);
    unsigned char* ws = P.ws;
    if (chunk < LW_C_UP) lw_run(P.in[14], 2048, N_UP, (bf16_t*)(ws + WS_WUP), P.in[13], RmWup(), scr, chunk * LW_CH, wave, lane);
    else if (chunk < LW_C_UP + LW_C_DOWN) lw_run(P.in[17], D_FF, 2048, (bf16_t*)(ws + WS_WDOWN), nullptr, RmIdent(), scr, (chunk - LW_C_UP) * LW_CH, wave, lane);
    else lw_run(P.in[12], 2048, 2048, (bf16_t*)(ws + WS_WOUT), nullptr, RmIdent(), scr, (chunk - LW_C_UP - LW_C_DOWN) * LW_CH, wave, lane);
}

namespace nsa {
using bf16x8 = __attribute__((ext_vector_type(8))) short;
using s16x4 = __attribute__((ext_vector_type(4))) short;
using f32x16 = __attribute__((ext_vector_type(16))) float;
typedef float f32x2_t __attribute__((ext_vector_type(2))); typedef __bf16 bf16x2_t __attribute__((ext_vector_type(2)));
constexpr int L_K = 0, L_V = 16384, L_WSF = 32768, L_OST = 34816, L_IMP = 100352, L_MASK = 116736, L_WU = 117248, L_END = 117312;
constexpr int SLOTB = 8192;
constexpr float THR = 8.0f;
#define NSA_SBAR() __builtin_amdgcn_sched_barrier(0)
__device__ __forceinline__ int crow(int r, int hi) { return (r & 3) + 8 * (r >> 2) + 4 * hi; }
__device__ __forceinline__ void glds16(const void* gbase  , unsigned voff  , unsigned lds_dst) { unsigned keep;
    asm volatile("s_mov_b32 %0, m0\n\ts_mov_b32 m0, %3\n\ts_nop 0\n\tglobal_load_lds_dwordx4 %1, %2\n\ts_mov_b32 m0, %0" : "=&s"(keep) : "v"(voff), "s"(gbase), "s"(lds_dst) : "memory"); }
__device__ __forceinline__ unsigned cvtpk_s(float lo, float hi) { f32x2_t v = {lo, hi}; bf16x2_t b = __builtin_convertvector(v, bf16x2_t); return __builtin_bit_cast(unsigned, b); }
#define NSA_WAIT_BAR() asm volatile("s_waitcnt vmcnt(0) lgkmcnt(0)\n\ts_barrier" ::: "memory")

__device__ __forceinline__ void qkt(f32x16& p0, f32x16& p1, LAS const char* Kslot, const bf16x8 (&qr)[4], int r32, int hi) {
    LAS const char* kb = Kslot + hi * 1024 + r32 * 16;
#pragma unroll
    for (int d0 = 0; d0 < 4; ++d0) {
        const bf16x8 b0 = *(LAS const bf16x8*)(kb + d0 * 2048);
        const bf16x8 b1 = *(LAS const bf16x8*)(kb + d0 * 2048 + 512);
        p0 = __builtin_amdgcn_mfma_f32_32x32x16_bf16(b0, qr[d0], p0, 0, 0, 0); p1 = __builtin_amdgcn_mfma_f32_32x32x16_bf16(b1, qr[d0], p1, 0, 0, 0);
    }
}
struct VFrag { s16x4 lo[2][4], hi[2][4]; };
__device__ __forceinline__ void vload(VFrag& f, int vb) {
#pragma unroll
    for (int d0 = 0; d0 < 2; ++d0)
#pragma unroll
        for (int ks = 0; ks < 4; ++ks) {
            asm volatile("ds_read_b64_tr_b16 %0,%1 offset:%c2" : "=&v"(f.lo[d0][ks]) : "v"(vb), "i"(d0 * 4096 + ks * 1024) : "memory");
            asm volatile("ds_read_b64_tr_b16 %0,%1 offset:%c2" : "=&v"(f.hi[d0][ks]) : "v"(vb), "i"(d0 * 4096 + ks * 1024 + 512) : "memory"); }
}
__device__ __forceinline__ void pvmma(f32x16 (&o)[2], VFrag& f, bf16x8 pa0, bf16x8 pa1, bf16x8 pa2, bf16x8 pa3) {
    asm volatile("s_waitcnt lgkmcnt(0)" : "+v"(f.lo[0][0]), "+v"(f.lo[0][1]), "+v"(f.lo[0][2]), "+v"(f.lo[0][3]), "+v"(f.hi[0][0]), "+v"(f.hi[0][1]), "+v"(f.hi[0][2]), "+v"(f.hi[0][3]) :: "memory");
    asm volatile("" : "+v"(f.lo[1][0]), "+v"(f.lo[1][1]), "+v"(f.lo[1][2]), "+v"(f.lo[1][3]), "+v"(f.hi[1][0]), "+v"(f.hi[1][1]), "+v"(f.hi[1][2]), "+v"(f.hi[1][3]));
    NSA_SBAR();
#pragma unroll
    for (int d0 = 0; d0 < 2; ++d0) {
#define NSA_PK(k) (bf16x8){f.lo[d0][k][0], f.lo[d0][k][1], f.lo[d0][k][2], f.lo[d0][k][3], f.hi[d0][k][0], f.hi[d0][k][1], f.hi[d0][k][2], f.hi[d0][k][3]}
        o[d0] = __builtin_amdgcn_mfma_f32_32x32x16_bf16(pa0, NSA_PK(0), o[d0], 0, 0, 0);
        o[d0] = __builtin_amdgcn_mfma_f32_32x32x16_bf16(pa1, NSA_PK(1), o[d0], 0, 0, 0);
        o[d0] = __builtin_amdgcn_mfma_f32_32x32x16_bf16(pa2, NSA_PK(2), o[d0], 0, 0, 0);
        o[d0] = __builtin_amdgcn_mfma_f32_32x32x16_bf16(pa3, NSA_PK(3), o[d0], 0, 0, 0);
#undef NSA_PK
    }
}
__device__ __forceinline__ void pv(f32x16 (&o)[2], int vb, bf16x8 pa0, bf16x8 pa1, bf16x8 pa2, bf16x8 pa3) { VFrag f; vload(f, vb); pvmma(o, f, pa0, pa1, pa2, pa3); }
__device__ __forceinline__ float rowmax32(const f32x16& p0, const f32x16& p1) {
    float a = __builtin_fmaxf(p0[0], p1[0]);
#pragma unroll
    for (int r = 1; r < 16; ++r) a = __builtin_fmaxf(a, __builtin_fmaxf(p0[r], p1[r]));
    auto rr = __builtin_amdgcn_permlane32_swap(__float_as_uint(a), __float_as_uint(a), false, false);
    return __builtin_fmaxf(__uint_as_float(rr[0]), __uint_as_float(rr[1]));
}
struct State { float m, l; f32x16 o[2]; };
__device__ __forceinline__ void state_init(State& s) { s.m = -1e30f; s.l = 0.f; s.o[0] = f32x16{}; s.o[1] = f32x16{}; }

template <int BMUL, int MASK, bool LOADV>
__device__ __forceinline__ void tile_scores(f32x16& p0, f32x16& p1, LAS const char* Kslot, const bf16x8 (&qr)[4], const f32x16& bk, float c0, float b32, int lim, int r32, int hi, VFrag& vf, int vb) {
#pragma unroll
    for (int r = 0; r < 16; ++r) { const float b = (BMUL == 1) ? bk[r] + c0 : __builtin_fmaf(bk[r], (float)BMUL, c0); p0[r] = b; p1[r] = b + b32; }
    qkt(p0, p1, Kslot, qr, r32, hi);
    if (LOADV) vload(vf, vb);
    const int limh = lim - 4 * hi;
#pragma unroll
    for (int r = 0; r < 16; ++r) {
        const int kk = (r & 3) + 8 * (r >> 2);
        if (MASK == 1) { if (!(kk <= limh)) p0[r] = -INFINITY; if (!(kk + 32 <= limh)) p1[r] = -INFINITY; }
        if (MASK == 2) { if (!(kk > limh)) p0[r] = -INFINITY; if (!(kk + 32 > limh)) p1[r] = -INFINITY; }
        if (MASK == 3) { if (!(kk < limh)) p0[r] = -INFINITY; if (!(kk + 32 < limh)) p1[r] = -INFINITY; }
    }
}
__device__ __forceinline__ float tile_ref(const State& st, float rb0, bool rowlive) { return (st.m < -1e29f && rowlive) ? rb0 : st.m; }
__device__ __forceinline__ void tile_softmax_pv(State& st, f32x16& p0, f32x16& p1, float mref, VFrag& vf, LAS float* wsf, int r32, int hi) {
    float a0 = p0[0], a1 = p1[0];
#pragma unroll
    for (int r = 1; r < 16; ++r) { a0 = __builtin_fmaxf(a0, p0[r]); a1 = __builtin_fmaxf(a1, p1[r]); }
    float mx = __builtin_fmaxf(a0, a1);
    { auto rr = __builtin_amdgcn_permlane32_swap(__float_as_uint(mx), __float_as_uint(mx), false, false); mx = __builtin_fmaxf(__uint_as_float(rr[0]), __uint_as_float(rr[1])); }
    if (__any(mx > THR)) {
        const float dl = __builtin_fmaxf(mx, 0.f), alpha = __builtin_amdgcn_exp2f(-dl);
        mref += dl; st.l *= alpha;
        if (hi == 0) wsf[r32] = alpha;
        asm volatile("s_waitcnt lgkmcnt(0)" ::: "memory");
#pragma unroll
        for (int r = 0; r < 16; ++r) { const float a = wsf[crow(r, hi)]; st.o[0][r] *= a; st.o[1][r] *= a; p0[r] -= dl; p1[r] -= dl; }
    }
    st.m = mref;
    float ls = 0.f;
#pragma unroll
    for (int r = 0; r < 16; ++r) { p0[r] = __builtin_amdgcn_exp2f(p0[r]); p1[r] = __builtin_amdgcn_exp2f(p1[r]); ls += p0[r] + p1[r]; }
    st.l += ls;
    u32x4_t pw0, pw1, pw2, pw3;
    pw0 = (u32x4_t){cvtpk_s(p0[0], p0[1]), cvtpk_s(p0[2], p0[3]), cvtpk_s(p0[4], p0[5]), cvtpk_s(p0[6], p0[7])};
    pw1 = (u32x4_t){cvtpk_s(p0[8], p0[9]), cvtpk_s(p0[10], p0[11]), cvtpk_s(p0[12], p0[13]), cvtpk_s(p0[14], p0[15])};
    pw2 = (u32x4_t){cvtpk_s(p1[0], p1[1]), cvtpk_s(p1[2], p1[3]), cvtpk_s(p1[4], p1[5]), cvtpk_s(p1[6], p1[7])};
    pw3 = (u32x4_t){cvtpk_s(p1[8], p1[9]), cvtpk_s(p1[10], p1[11]), cvtpk_s(p1[12], p1[13]), cvtpk_s(p1[14], p1[15])};
    pvmma(st.o, vf, __builtin_bit_cast(bf16x8, pw0), __builtin_bit_cast(bf16x8, pw1), __builtin_bit_cast(bf16x8, pw2), __builtin_bit_cast(bf16x8, pw3));
}
template <bool FIRST>
__device__ __forceinline__ void fold_branch(LAS float* ostg, State& st, float gate, LAS float* wsf, int r32, int hi) {
    float l = st.l;
    { auto rr = __builtin_amdgcn_permlane32_swap(__float_as_uint(l), __float_as_uint(l), false, false); l = __uint_as_float(rr[0]) + __uint_as_float(rr[1]); }
    const float f = l > 0.f ? gate / l : 0.f;
    asm volatile("s_waitcnt lgkmcnt(0)" ::: "memory");
    if (hi == 0) wsf[r32] = f;
    asm volatile("s_waitcnt lgkmcnt(0)" ::: "memory");
#pragma unroll
    for (int r = 0; r < 16; ++r) { const int orow = crow(r, hi); const float a = wsf[orow];
#pragma unroll
        for (int d0 = 0; d0 < 2; ++d0) { LAS float* p = ostg + orow * 64 + d0 * 32 + r32; if (FIRST) *p = st.o[d0][r] * a; else *p += st.o[d0][r] * a; } }
    asm volatile("s_waitcnt lgkmcnt(0)" ::: "memory");
}

__device__ __forceinline__ int nsa_unit(const Ptrs& P, LAS unsigned char* lds, int bg, int qt, const int wave_s, unsigned* qctr, int qbase) {
    unsigned char* ws = P.ws;
    const int lane = fresh_lane(), r32 = lane & 31, hi = lane >> 5; const int wid = wave_s;
    const int b = bg >> 2, g = bg & 3, t0 = 64 * qt;
    const int tl = 8 * wid + (r32 >> 2), hq = r32 & 3;
    const size_t m0 = (size_t)b * SEQ + t0;
    const bf16_t* Q = (const bf16_t*)(ws + WS_Q); const bf16_t* KV6 = (const bf16_t*)(ws + WS_KV6);
    const bf16_t* KSb = KV6 + 2 * KVSZ + (size_t)bg * SEQ * 64; const bf16_t* VSb = KV6 + 3 * KVSZ + (size_t)bg * SEQ * 64;
    const bf16_t* KWb = KV6 + 4 * KVSZ + (size_t)bg * SEQ * 64; const bf16_t* VWb = KV6 + 5 * KVSZ + (size_t)bg * SEQ * 64;
    const bf16_t* KCb = (const bf16_t*)(ws + WS_KC) + (size_t)bg * 256 * 64; const bf16_t* VCb = (const bf16_t*)(ws + WS_VC) + (size_t)bg * 256 * 64;
    const float* GATES = (const float*)(ws + WS_GATES); bf16_t* AB = (bf16_t*)(ws + WS_AB);
    const unsigned lds0 = (unsigned)(uintptr_t)lds;
    LAS float* wsf = (LAS float*)(lds + L_WSF) + wid * 64;
    LAS float* IMP = (LAS float*)(lds + L_IMP);
    LAS unsigned* MASK = (LAS unsigned*)(lds + L_MASK); LAS unsigned* WU = (LAS unsigned*)(lds + L_WU);
    const int koff = lane * 64 + wid * 8, voff = (16 * (wid & 3) + (lane >> 2)) * 64 + (wid >> 2) * 32 + (lane & 3) * 8;
    const unsigned kdst = lds0 + L_K + wid * 1024, vdst = lds0 + L_V + wid * 1024;
#define NSA_DMA_K(base, tile, slot) glds16((base) + (size_t)(tile) * 4096, (unsigned)koff * 2u, (unsigned)__builtin_amdgcn_readfirstlane(kdst + (slot) * SLOTB))
#define NSA_DMA_V(base, tile, slot) glds16((base) + (size_t)(tile) * 4096, (unsigned)voff * 2u, (unsigned)__builtin_amdgcn_readfirstlane(vdst + (slot) * SLOTB))
    const int vb0 = (int)(lds0 + L_V) + ((lane >> 4) & 1) * 32 + (lane & 3) * 8 + (4 * hi + ((lane & 15) >> 2)) * 64;
    LAS const char* Kbase = (LAS const char*)(lds + L_K);
    bf16x8 qr[4];
    { const bf16_t* qp = Q + (m0 + tl) * 1024 + (4 * g + hq) * 64 + hi * 8;
#pragma unroll
      for (int d0 = 0; d0 < 4; ++d0) qr[d0] = *(const bf16x8*)(qp + d0 * 16); }
    const float sl2 = __builtin_amdgcn_exp2f(-0.5f * (float)(4 * g + hq + 1)) * LOG2E;
    f32x16 bk;
#pragma unroll
    for (int r = 0; r < 16; ++r) bk[r] = sl2 * (float)((r & 3) + 8 * (r >> 2));
    const float b32t = 32.0f * sl2, b32c = 512.0f * sl2, hoff_t = 4.0f * (float)hi * sl2, hoff_c = 64.0f * (float)hi * sl2;
    float gate[3];
    { const float* gp = GATES + (m0 + tl) * 48 + (4 * g + hq) * 3; gate[0] = gp[0]; gate[1] = gp[1]; gate[2] = gp[2]; }
    LAS float* ostg = (LAS float*)(lds + L_OST) + wid * 2048;
    State st;
    f32x16 p0, p1;
    int nxt_ticket = 0;

    int tc = 0;
    VFrag vf;
    const int nvmax = (t0 + 63 >= 31) ? ((t0 + 63 - 31) >> 4) + 1 : 0;
    const int nct = (nvmax + 63) >> 6;
    const int tq = t0 + tl, nv = tq >= 31 ? ((tq - 31) >> 4) + 1 : 0;
    {
        state_init(st);
        const int j0 = qt >= 8 ? qt - 8 : 0, nt = qt - j0 + 1;
        NSA_DMA_K(KWb, qt, 0); NSA_DMA_V(VWb, qt, 0); NSA_WAIT_BAR();
        for (int i = 0; i < nt; ++i) {
            const int j = qt - i, slot = (tc + i) & 1;
            if (i + 1 < nt) { NSA_DMA_K(KWb, j - 1, slot ^ 1); NSA_DMA_V(VWb, j - 1, slot ^ 1); }
            else { NSA_DMA_K(KCb, nct - 1, slot ^ 1); NSA_DMA_V(VCb, nct - 1, slot ^ 1); }
            const float rb0 = sl2 * (float)(64 * j - t0), mref = tile_ref(st, rb0, true), c0 = rb0 + hoff_t - mref;
            if (j == qt) tile_scores<1, 1, true>(p0, p1, Kbase + slot * SLOTB, qr, bk, c0, b32t, tl, r32, hi, vf, vb0 + slot * SLOTB);
            else if (j == qt - 8) tile_scores<1, 2, true>(p0, p1, Kbase + slot * SLOTB, qr, bk, c0, b32t, tl, r32, hi, vf, vb0 + slot * SLOTB);
            else tile_scores<1, 0, true>(p0, p1, Kbase + slot * SLOTB, qr, bk, c0, b32t, 0, r32, hi, vf, vb0 + slot * SLOTB);
            tile_softmax_pv(st, p0, p1, mref, vf, wsf, r32, hi);
            NSA_WAIT_BAR();
        }
        tc += nt;
        fold_branch<true>(ostg, st, gate[2], wsf, r32, hi);
    }
    {
        state_init(st);
        for (int ci = 0; ci < nct; ++ci) {
            const int c = nct - 1 - ci, slot = (tc + ci) & 1;
            if (ci + 1 < nct) { NSA_DMA_K(KCb, c - 1, slot ^ 1); NSA_DMA_V(VCb, c - 1, slot ^ 1); }
            else if (qt >= 16) { NSA_DMA_K(KCb, 0, slot ^ 1); }
            else { NSA_DMA_K(KSb, qt, slot ^ 1); NSA_DMA_V(VSb, qt, slot ^ 1); }
            const float rb0 = sl2 * ((float)(1024 * c - t0) + 15.5f), mref = tile_ref(st, rb0, true), c0 = rb0 + hoff_c - mref;
            tile_scores<16, 3, true>(p0, p1, Kbase + slot * SLOTB, qr, bk, c0, b32c, nv - 64 * c, r32, hi, vf, vb0 + slot * SLOTB);
            tile_softmax_pv(st, p0, p1, mref, vf, wsf, r32, hi);
            NSA_WAIT_BAR();
        }
        tc += nct;
    }
    const float mc_fin = st.m; float lc = st.l;
    fold_branch<false>(ostg, st, gate[0], wsf, r32, hi);
    if (qt >= 16) {
        { auto rr = __builtin_amdgcn_permlane32_swap(__float_as_uint(lc), __float_as_uint(lc), false, false); lc = __uint_as_float(rr[0]) + __uint_as_float(rr[1]); }
        const float invl = lc > 0.f ? 1.0f / lc : 0.f;
        float carry = 0.f;
        for (int c = 0; c < nct; ++c) {
            const int slot = (tc + c) & 1;
            if (c + 1 < nct) { NSA_DMA_K(KCb, c + 1, slot ^ 1); }
            else { NSA_DMA_K(KSb, qt, slot ^ 1); NSA_DMA_V(VSb, qt, slot ^ 1); }
            const float c0 = sl2 * ((float)(1024 * c - t0) + 15.5f) + hoff_c - mc_fin;
            tile_scores<16, 3, false>(p0, p1, Kbase + slot * SLOTB, qr, bk, c0, b32c, nv - 64 * c, r32, hi, vf, 0);
#pragma unroll
            for (int r = 0; r < 16; ++r) { p0[r] = __builtin_amdgcn_exp2f(p0[r]) * invl; p1[r] = __builtin_amdgcn_exp2f(p1[r]) * invl; }
            float imp0[4], imp1[4], pl0[4], pl1[4];
#pragma unroll
            for (int a = 0; a < 4; ++a) {
                imp0[a] = (p0[4 * a] + p0[4 * a + 1]) + (p0[4 * a + 2] + p0[4 * a + 3]); imp1[a] = (p1[4 * a] + p1[4 * a + 1]) + (p1[4 * a + 2] + p1[4 * a + 3]);
                pl0[a] = __shfl_xor(p0[4 * a + 3], 32); pl1[a] = __shfl_xor(p1[4 * a + 3], 32);
            }
            if (hi) {
#pragma unroll
                for (int a = 0; a < 4; ++a) { imp0[a] += pl0[a]; imp1[a] += pl1[a]; }
            } else {
                imp0[0] += carry; imp1[0] += pl0[3];
#pragma unroll
                for (int a = 1; a < 4; ++a) { imp0[a] += pl0[a - 1]; imp1[a] += pl1[a - 1]; }
            }
            carry = pl1[3];
#pragma unroll
            for (int a = 0; a < 4; ++a) {
                imp0[a] += __shfl_xor(imp0[a], 1); imp0[a] += __shfl_xor(imp0[a], 2); imp1[a] += __shfl_xor(imp1[a], 1); imp1[a] += __shfl_xor(imp1[a], 2);
                if (hq == 0) { IMP[tl * 64 + 16 * c + 2 * a + hi] = imp0[a]; IMP[tl * 64 + 16 * c + 8 + 2 * a + hi] = imp1[a]; }
            }
            NSA_WAIT_BAR();
        }
        tc += nct;
    }
    unsigned long long wu = 0ull;
    if (qt < 16) {
        wu = (2ull << qt) - 1ull;
        if (lane < 8) { MASK[2 * (8 * wid + lane)] = (unsigned)wu; MASK[2 * (8 * wid + lane) + 1] = (unsigned)(wu >> 32); }
    } else {
        const int j = lane; const bool valid = j <= qt, forced = (j == 0) || (j == qt) || (j == qt - 1);
        for (int k = 0; k < 8; ++k) {
            const float imp = IMP[(8 * wid + k) * 64 + j];
            const float scv = valid ? (forced ? 1e9f : imp) : -1e9f;
            const unsigned fb = __float_as_uint(scv), key = fb ^ ((fb >> 31) ? 0xffffffffu : 0x80000000u);
            unsigned T = 0u;
#pragma unroll
            for (int bit = 31; bit >= 0; --bit) { const unsigned cand = T | (1u << bit); if (__builtin_popcountll(__ballot(key >= cand)) >= 16) T = cand; }
            const unsigned long long gt = __ballot(key > T), eq = __ballot(key == T);
            const int need = 16 - __builtin_popcountll(gt);
            const int before = (int)__builtin_amdgcn_mbcnt_hi((unsigned)(eq >> 32), __builtin_amdgcn_mbcnt_lo((unsigned)eq, 0u));
            const bool sel = (key > T) || ((key == T) && (before < need));
            const unsigned long long mk = __ballot(sel && (scv > -0.5e9f));
            wu |= mk;
            if (lane == 0) { MASK[2 * (8 * wid + k)] = (unsigned)mk; MASK[2 * (8 * wid + k) + 1] = (unsigned)(mk >> 32); }
        }
    }
    if (lane == 0) { WU[2 * wid] = (unsigned)wu; WU[2 * wid + 1] = (unsigned)(wu >> 32); }
    NSA_WAIT_BAR();
    unsigned long long uni = 0ull;
#pragma unroll
    for (int w = 0; w < 8; ++w) uni |= ((unsigned long long)WU[2 * w]) | (((unsigned long long)WU[2 * w + 1]) << 32);
    uni = ((unsigned long long)(unsigned)__builtin_amdgcn_readfirstlane((unsigned)uni)) | (((unsigned long long)(unsigned)__builtin_amdgcn_readfirstlane((unsigned)(uni >> 32))) << 32);
    const unsigned long long mymask = ((unsigned long long)MASK[2 * tl]) | (((unsigned long long)MASK[2 * tl + 1]) << 32);
    {
        state_init(st);
        unsigned long long rem = uni;
        int j = 63 - __builtin_clzll(rem); rem &= ~(1ull << j);
        for (int i = 0;; ++i) {
            const int slot = (tc + i) & 1; const bool more = rem != 0ull;
            int jn = 0;
            if (more) { jn = 63 - __builtin_clzll(rem); rem &= ~(1ull << jn); NSA_DMA_K(KSb, jn, slot ^ 1); NSA_DMA_V(VSb, jn, slot ^ 1); }
            if ((wu >> j) & 1ull) {
                const bool live = ((mymask >> j) & 1ull) != 0ull;
                const float rb0 = sl2 * (float)(64 * j - t0), mref = tile_ref(st, rb0, live), c0 = live ? rb0 + hoff_t - mref : -INFINITY;
                if (j == qt) tile_scores<1, 1, true>(p0, p1, Kbase + slot * SLOTB, qr, bk, c0, b32t, tl, r32, hi, vf, vb0 + slot * SLOTB);
                else tile_scores<1, 0, true>(p0, p1, Kbase + slot * SLOTB, qr, bk, c0, b32t, 0, r32, hi, vf, vb0 + slot * SLOTB);
                tile_softmax_pv(st, p0, p1, mref, vf, wsf, r32, hi);
            }
            NSA_WAIT_BAR();
            if (!more) break;
            j = jn;
        }
        if (wid == 0 && lane == 0) nxt_ticket = qbase + (int)__hip_atomic_fetch_add(qctr, 1u, __ATOMIC_RELAXED, __HIP_MEMORY_SCOPE_AGENT);
        fold_branch<false>(ostg, st, gate[1], wsf, r32, hi);
    }
    {
#pragma unroll
        for (int i = 0; i < 4; ++i) { const int row = i * 8 + (lane >> 3), ch = lane & 7;
            const f32x4_t v0 = *(LAS const f32x4_t*)(ostg + row * 64 + ch * 8), v1 = *(LAS const f32x4_t*)(ostg + row * 64 + ch * 8 + 4);
            u32x4_t v; v.x = cvtpk_s(v0[0], v0[1]); v.y = cvtpk_s(v0[2], v0[3]); v.z = cvtpk_s(v1[0], v1[1]); v.w = cvtpk_s(v1[2], v1[3]);
            *(u32x4_t*)(AB + (m0 + 8 * wid + (row >> 2)) * 2048 + 256 * g + (row & 3) * 64 + ch * 8) = v; }
    }
    NSA_WAIT_BAR();
#undef NSA_DMA_K
#undef NSA_DMA_V
    return nxt_ticket;
}
constexpr int L_QS = 145416;
__device__ __forceinline__ void nsa_phase(const Ptrs& P, LAS unsigned char* lds, int bid, int G, const int wave_s) {
    unsigned* qctr = (unsigned*)(P.ws + WS_CTL) + 3584;
    LAS int* qs = (LAS int*)(lds + L_QS);
    const int lwq = (G == 256) ? LW_CHUNKS - 128 : LW_CHUNKS;
    const int nrest = 1024 - G + lwq;
    int k = bid;
    while (k < 1024 + lwq) {
        int nxt, unit = k, chunk = -1;
        if (k >= G) { const int t = k - G, cb = (t * lwq) / nrest, ca = ((t + 1) * lwq) / nrest;
            if (ca > cb) chunk = cb; else unit = G + t - cb; }
        if (chunk < 0) {
            const int qt = 63 - (unit >> 4), g = 3 - ((unit >> 2) & 3), b = unit & 3;
            nxt = nsa_unit(P, lds, b * 4 + g, qt, wave_s, qctr, G);
        } else {
            nxt = 0;
            if (wave_s == 0 && fresh_lane() == 0) nxt = G + (int)__hip_atomic_fetch_add(qctr, 1u, __ATOMIC_RELAXED, __HIP_MEMORY_SCOPE_AGENT);
            late_weight_chunk(P, lds, chunk, wave_s);
        }
        if (wave_s == 0 && fresh_lane() == 0) *qs = nxt;
        NSA_WAIT_BAR();
        k = __builtin_amdgcn_readfirstlane(*qs);
    }
}
}

namespace p2 {
using nsa::bf16x8; using nsa::f32x16; using nsa::s16x4; using nsa::crow; using nsa::glds16; using nsa::cvtpk_s;
#define P2_WAIT_BAR() asm volatile("s_waitcnt vmcnt(0) lgkmcnt(0)\n\ts_barrier" ::: "memory")
constexpr int CB_BUF = 40960;
constexpr int CP_STRIDE = 65;
__device__ __forceinline__ void compress_unit(const Ptrs& P, LAS unsigned char* lds, int u, const int wave_s) {
    unsigned char* ws = P.ws;
    const int lane = fresh_lane(), r32 = lane & 31, hi = lane >> 5, wid = wave_s;
    const int kv = u >> 6, bg = (u >> 2) & 15, n0 = 64 * (u & 3);
    const bf16_t* Ag = (const bf16_t*)(ws + WS_KV6) + (size_t)kv * KVSZ + (size_t)bg * SEQ * 64 + (size_t)n0 * 1024;
    const bf16_t* Bg = (const bf16_t*)(ws + WS_W1C) + (size_t)kv * 256 * 2048;
    const unsigned lds0 = (unsigned)(uintptr_t)lds;
    const int drow = 8 * wid + (lane >> 3), dchk = (lane & 7) ^ ((drow >> 1) & 7);
    const unsigned aoff = (unsigned)(drow * 1024 + dchk * 8) * 2u, boff = (unsigned)(drow * 2048 + dchk * 8) * 2u;
    const unsigned dstw = lds0 + wid * 1024;
#define P2_DMA_TILE(kt, buf) do { const unsigned d_ = (unsigned)__builtin_amdgcn_readfirstlane(dstw + (buf) * CB_BUF); \
        glds16(Ag + (kt) * 64, aoff, d_); \
        _Pragma("unroll") for (int ct_ = 0; ct_ < 4; ++ct_) glds16(Bg + (size_t)ct_ * 64 * 2048 + (kt) * 64, boff, d_ + 8192u * (ct_ + 1)); } while (0)
    const int ct = wid >> 1, half = wid & 1, ncol0 = 64 * ct + 32 * half;
    f32x16 hT[2]; hT[0] = f32x16{}; hT[1] = f32x16{};
    P2_DMA_TILE(0, 0); P2_DMA_TILE(1, 1);
    asm volatile("s_waitcnt vmcnt(5) lgkmcnt(0)\n\ts_barrier" ::: "memory");
    for (int kt = 0; kt < 32; ++kt) {
        const int buf = kt % 3;
        if (kt + 2 < 32) P2_DMA_TILE(kt + 2, (kt + 2) % 3);
        LAS const char* sa = (LAS const char*)(lds + buf * CB_BUF) + r32 * 128;
        LAS const char* sb = (LAS const char*)(lds + buf * CB_BUF + 8192 * (ct + 1)) + (32 * half + r32) * 128;
        const int sw = (r32 >> 1) & 7;
#pragma unroll
        for (int d0 = 0; d0 < 4; ++d0) {
            const int co = ((2 * d0 + hi) ^ sw) * 16;
            const bf16x8 bf = *(LAS const bf16x8*)(sb + co), a0 = *(LAS const bf16x8*)(sa + co), a1 = *(LAS const bf16x8*)(sa + 4096 + co);
            hT[0] = __builtin_amdgcn_mfma_f32_32x32x16_bf16(bf, a0, hT[0], 0, 0, 0);
            hT[1] = __builtin_amdgcn_mfma_f32_32x32x16_bf16(bf, a1, hT[1], 0, 0, 0);
        }
        if (kt + 2 < 32) asm volatile("s_waitcnt vmcnt(5) lgkmcnt(0)\n\ts_barrier" ::: "memory");
        else asm volatile("s_waitcnt vmcnt(0) lgkmcnt(0)\n\ts_barrier" ::: "memory");
    }
    const float* bias1 = (const float*)(ws + WS_SMALL + SM_BIAS1) + kv * 256 + ncol0;
    bf16x8 hb[2][2];
#pragma unroll
    for (int mt = 0; mt < 2; ++mt) {
        float g[16];
#pragma unroll
        for (int r = 0; r < 16; ++r) g[r] = gelu_tanh(hT[mt][r] + bias1[crow(r, hi)]);
#pragma unroll
        for (int s = 0; s < 2; ++s) { u32x4_t w; w.x = cvtpk_s(g[8 * s], g[8 * s + 1]); w.y = cvtpk_s(g[8 * s + 2], g[8 * s + 3]); w.z = cvtpk_s(g[8 * s + 4], g[8 * s + 5]); w.w = cvtpk_s(g[8 * s + 6], g[8 * s + 7]);
            hb[mt][s] = __builtin_bit_cast(bf16x8, w); }
    }
    const bf16_t* w2t = (const bf16_t*)(ws + WS_SMALL + SM_W2T) + (size_t)kv * 64 * 256;
    f32x16 oT[2][2];
#pragma unroll
    for (int dt = 0; dt < 2; ++dt)
#pragma unroll
        for (int mt = 0; mt < 2; ++mt) oT[dt][mt] = f32x16{};
#pragma unroll
    for (int dt = 0; dt < 2; ++dt)
#pragma unroll
        for (int s = 0; s < 2; ++s) {
            const bf16_t* wp = w2t + (size_t)(32 * dt + r32) * 256 + ncol0 + 16 * s + 4 * hi;
            const u32x2_t lo = *(const u32x2_t*)wp, hi2 = *(const u32x2_t*)(wp + 8);
            const u32x4_t wv = {lo.x, lo.y, hi2.x, hi2.y}; const bf16x8 wf = __builtin_bit_cast(bf16x8, wv);
#pragma unroll
            for (int mt = 0; mt < 2; ++mt) oT[dt][mt] = __builtin_amdgcn_mfma_f32_32x32x16_bf16(wf, hb[mt][s], oT[dt][mt], 0, 0, 0);
        }
    LAS float* part = (LAS float*)lds + wid * 64 * CP_STRIDE;
#pragma unroll
    for (int dt = 0; dt < 2; ++dt)
#pragma unroll
        for (int mt = 0; mt < 2; ++mt)
#pragma unroll
            for (int r = 0; r < 16; ++r) part[(32 * mt + r32) * CP_STRIDE + 32 * dt + crow(r, hi)] = oT[dt][mt][r];
    P2_WAIT_BAR();
    {
        const int tid = wid * 64 + lane, m = tid >> 3, dg = tid & 7;
        float o[8];
#pragma unroll
        for (int e = 0; e < 8; ++e) { float s = 0.f;
#pragma unroll
            for (int w = 0; w < 8; ++w) s += ((LAS const float*)lds)[(w * 64 + m) * CP_STRIDE + 8 * dg + e];
            o[e] = s; }
        if (kv == 0) {
            float ss = 0.f;
#pragma unroll
            for (int e = 0; e < 8; ++e) ss += o[e] * o[e];
            ss += __shfl_xor(ss, 1); ss += __shfl_xor(ss, 2); ss += __shfl_xor(ss, 4);
            const float rr = __builtin_amdgcn_rsqf(ss * (1.0f / 64.0f) + 1e-6f);
#pragma unroll
            for (int e = 0; e < 8; ++e) o[e] *= rr * P.in[4][8 * dg + e];
        }
        const int n = n0 + m;
        u32x4_t v = {0u, 0u, 0u, 0u};
        if (n < 255) { v.x = cvtpk_s(o[0], o[1]); v.y = cvtpk_s(o[2], o[3]); v.z = cvtpk_s(o[4], o[5]); v.w = cvtpk_s(o[6], o[7]); }
        *(u32x4_t*)((bf16_t*)(ws + (kv ? WS_VC : WS_KC)) + ((size_t)bg * 256 + n) * 64 + 8 * dg) = v;
    }
    P2_WAIT_BAR();
#undef P2_DMA_TILE
}

constexpr int G_V = 0, G_ST = 32768, G_OST = 33792, G_END = 33792 + 65536;
struct GmlpIn { u32x4_t raw[4]; u32x4_t uraw[4]; float sbv[4]; };
__device__ __forceinline__ void gmlp_load(GmlpIn& in, const Ptrs& P, int unit, int tid, int lane, int r32, int hi, int wid) {
    unsigned char* ws = P.ws;
    const int g = unit & 7, chunk = (unit >> 3) & 31, b = unit >> 8; const int m0 = b * SEQ + chunk * 128;
    const bf16_t* GV = (const bf16_t*)(ws + WS_GV); const bf16_t* U = (const bf16_t*)(ws + WS_U);
    const int tb = wid >> 1, ch = wid & 1; (void)r32; (void)hi;
#pragma unroll
    for (int i = 0; i < 4; ++i) { const int idx = tid + 512 * i, s = idx >> 4, c8 = idx & 15; in.raw[i] = *(const u32x4_t*)(GV + (size_t)(m0 + s) * 1024 + g * 128 + 8 * c8); }
#pragma unroll
    for (int i = 0; i < 4; ++i) { const int row = i * 8 + (lane >> 3), t = 32 * tb + row; in.uraw[i] = *(const u32x4_t*)(U + (size_t)(m0 + t) * 1024 + g * 128 + 64 * ch + 8 * (lane & 7)); in.sbv[i] = P.in[11][g * 128 + t]; }
}
__device__ __forceinline__ void gmlp_compute(const GmlpIn& in, const f32x4_t (&sv)[8], const bf16x8 (&pa)[2][4], const f32x4_t w0, const f32x4_t w1, const f32x4_t b0, const f32x4_t b1, const Ptrs& P, LAS unsigned char* lds, int unit, int tid, int lane, int r32, int hi, int wid) {
    unsigned char* ws = P.ws;
    const int g = unit & 7, chunk = (unit >> 3) & 31, b = unit >> 8; const int m0 = b * SEQ + chunk * 128;
    bf16_t* AB = (bf16_t*)(ws + WS_AB);
    LAS float* st = (LAS float*)(lds + G_ST);
    const int tb = wid >> 1, ch = wid & 1;
    if (tid < 128) { float s1 = 0.f, s2 = 0.f;
#pragma unroll
        for (int i = 0; i < 8; ++i) { s1 += sv[i][0] + sv[i][2]; s2 += sv[i][1] + sv[i][3]; }
        const float mean = s1 * (1.0f / 1024.0f); float var = s2 * (1.0f / 1024.0f) - mean * mean; var = var < 0.f ? 0.f : var;
        st[2 * tid] = mean; st[2 * tid + 1] = __builtin_amdgcn_rsqf(var + 1e-5f); }
    asm volatile("s_waitcnt lgkmcnt(0)\n\ts_barrier" ::: "memory");
#pragma unroll
    for (int i = 0; i < 4; ++i) { const int idx = tid + 512 * i, s = idx >> 4, c8 = idx & 15;
        float f[8]; unpack8(in.raw[i], f);
        const float mean = st[2 * s], rstd = st[2 * s + 1];
        float y[8];
#pragma unroll
        for (int e = 0; e < 4; ++e) { y[e] = (f[e] - mean) * rstd * w0[e] + b0[e]; y[4 + e] = (f[4 + e] - mean) * rstd * w1[e] + b1[e]; }
        u32x4_t o; o.x = cvtpk_s(y[0], y[1]); o.y = cvtpk_s(y[2], y[3]); o.z = cvtpk_s(y[4], y[5]); o.w = cvtpk_s(y[6], y[7]);
        const int st_ = s >> 6, sk = s & 63, chh = c8 >> 3, x = c8 & 7;
        *(LAS u32x4_t*)(lds + G_V + (st_ * 2 + chh) * 8192 + (x >> 2) * 4096 + (sk >> 4) * 1024 + (sk & 15) * 64 + (x & 3) * 16) = o; }
    asm volatile("s_waitcnt lgkmcnt(0)\n\ts_barrier" ::: "memory");
    f32x16 o[2]; o[0] = f32x16{}; o[1] = f32x16{};
    const int vb0 = (int)((unsigned)(uintptr_t)lds + G_V) + ((lane >> 4) & 1) * 32 + (lane & 3) * 8 + (4 * hi + ((lane & 15) >> 2)) * 64;
    nsa::pv(o, vb0 + ch * 8192, pa[0][0], pa[0][1], pa[0][2], pa[0][3]);
    if (tb >= 2) nsa::pv(o, vb0 + (2 + ch) * 8192, pa[1][0], pa[1][1], pa[1][2], pa[1][3]);
    LAS float* ostg = (LAS float*)(lds + G_OST) + wid * 2048;
#pragma unroll
    for (int r = 0; r < 16; ++r) { const int orow = crow(r, hi);
#pragma unroll
        for (int d0 = 0; d0 < 2; ++d0) ostg[orow * 64 + d0 * 32 + r32] = o[d0][r]; }
    asm volatile("s_waitcnt lgkmcnt(0)" ::: "memory");
#pragma unroll
    for (int i = 0; i < 4; ++i) { const int row = i * 8 + (lane >> 3), c8 = lane & 7, t = 32 * tb + row;
        const f32x4_t v0 = *(LAS const f32x4_t*)(ostg + row * 64 + c8 * 8), v1 = *(LAS const f32x4_t*)(ostg + row * 64 + c8 * 8 + 4);
        const size_t grow = (size_t)(m0 + t); const int col = g * 128 + 64 * ch + 8 * c8;
        float uf[8]; unpack8(in.uraw[i], uf);
        const float sb_ = in.sbv[i];
        u32x4_t w; w.x = cvtpk_s(uf[0] * (v0[0] + sb_), uf[1] * (v0[1] + sb_)); w.y = cvtpk_s(uf[2] * (v0[2] + sb_), uf[3] * (v0[3] + sb_));
        w.z = cvtpk_s(uf[4] * (v1[0] + sb_), uf[5] * (v1[1] + sb_)); w.w = cvtpk_s(uf[6] * (v1[2] + sb_), uf[7] * (v1[3] + sb_));
        *(u32x4_t*)(AB + grow * 2048 + 1024 + col) = w; }
    asm volatile("s_waitcnt lgkmcnt(0)\n\ts_barrier" ::: "memory");
}
__device__ __forceinline__ void gmlp_run(const Ptrs& P, LAS unsigned char* lds, int u0, int stride, int nunits, const int wave_s) {
    const int lane = fresh_lane(), r32 = lane & 31, hi = lane >> 5, wid = wave_s, tid = wid * 64 + lane;
    GmlpIn A, B;
    int u = u0;
    bf16x8 pa[2][4];
    { const bf16_t* SWB = (const bf16_t*)(P.ws + WS_SMALL + SM_SWB) + (size_t)(u0 & 7) * 16384; const int tb = wid >> 1;
#pragma unroll
      for (int st_ = 0; st_ < 2; ++st_)
#pragma unroll
        for (int ks = 0; ks < 4; ++ks) {
            const bf16_t* wp = SWB + (size_t)(32 * tb + r32) * 128 + 64 * st_ + 16 * ks + 4 * hi;
            const u32x2_t lo = *(const u32x2_t*)wp, hi2 = *(const u32x2_t*)(wp + 8);
            const u32x4_t wv = {lo.x, lo.y, hi2.x, hi2.y}; pa[st_][ks] = __builtin_bit_cast(bf16x8, wv); } }
    const int c8v = tid & 15, g0 = u0 & 7;
    const f32x4_t w0 = *(const f32x4_t*)(P.in[8] + g0 * 128 + 8 * c8v), w1 = *(const f32x4_t*)(P.in[8] + g0 * 128 + 8 * c8v + 4), b0 = *(const f32x4_t*)(P.in[9] + g0 * 128 + 8 * c8v), b1 = *(const f32x4_t*)(P.in[9] + g0 * 128 + 8 * c8v + 4);
    const float* VSTAT = (const float*)(P.ws + WS_VSTAT);
#define GMLP_STATS(sv_, unit_) do { const int m0_ = ((unit_) >> 8) * SEQ + (((unit_) >> 3) & 31) * 128; const f32x4_t* p_ = (const f32x4_t*)(VSTAT + (size_t)(m0_ + (tid & 127)) * 32); \
        _Pragma("unroll") for (int i_ = 0; i_ < 8; ++i_) sv_[i_] = p_[i_]; } while (0)
    f32x4_t sv[8];
    if (u < nunits) gmlp_load(A, P, u, tid, lane, r32, hi, wid);
    while (u < nunits) {
        GMLP_STATS(sv, u);
        if (u + stride < nunits) gmlp_load(B, P, u + stride, tid, lane, r32, hi, wid);
        gmlp_compute(A, sv, pa, w0, w1, b0, b1, P, lds, u, tid, lane, r32, hi, wid);
        u += stride; if (u >= nunits) break;
        GMLP_STATS(sv, u);
        if (u + stride < nunits) gmlp_load(A, P, u + stride, tid, lane, r32, hi, wid);
        gmlp_compute(B, sv, pa, w0, w1, b0, b1, P, lds, u, tid, lane, r32, hi, wid);
        u += stride;
    }
#undef GMLP_STATS
    asm volatile("s_waitcnt vmcnt(0) lgkmcnt(0)\n\ts_barrier" ::: "memory");
}
#undef P2_WAIT_BAR
}

#define XB_TMO      128
#define XB_XCNT(j)  (256  + 64 * (j))
#define XB_XSUB(j)  (1280 + 64 * (j))
#define XB_XGEN(j)  (2304 + 64 * (j))
#define XB_TOP      3328
#define XB_TOPGEN   3392
#define XCD_BAR_WORDS 3456
#define XB_SPIN_CAP (1u << 18)

__device__ __forceinline__ unsigned xb_ld(unsigned* p)              { return __hip_atomic_load(p, __ATOMIC_RELAXED, __HIP_MEMORY_SCOPE_AGENT); }
__device__ __forceinline__ unsigned xb_add(unsigned* p, unsigned v) { return __hip_atomic_fetch_add(p, v, __ATOMIC_RELAXED, __HIP_MEMORY_SCOPE_AGENT); }
__device__ __forceinline__ unsigned xb_xcc_id() { return (unsigned)__builtin_amdgcn_s_getreg((3 << 11) | 20) & 0xFu; }
#define XB_SPIN(cond, bar) do { unsigned _sp = 0; while (cond) { __builtin_amdgcn_s_sleep(1); \
    if ((++_sp & 255u) == 0u) { if (xb_ld(&(bar)[XB_TMO])) break; if (_sp > XB_SPIN_CAP) { atomicAdd(&(bar)[XB_TMO], 1u); break; } } } } while (0)

struct XcdBarrier {
    unsigned* bar; unsigned x; unsigned w0;
    volatile LAS unsigned* st;
};

__device__ __forceinline__ XcdBarrier xcd_barrier_post(unsigned* bar, volatile LAS unsigned* st, int wave_s) {
    XcdBarrier b; b.bar = bar; b.x = xb_xcc_id(); b.st = st; b.w0 = wave_s == 0 ? 1u : 0u;
    if (b.w0 && fresh_lane() == 0) (void)xb_add(&bar[XB_XCNT(b.x)], 1u);
    return b;
}
__device__ __forceinline__ void xcd_barrier_complete(unsigned* bar, unsigned x, unsigned& nloc, unsigned& nx) {
    const unsigned G = gridDim.x * gridDim.y * gridDim.z;
    unsigned sum, cnt, mine, sp = 0u;
    for (;;) {
        sum = 0u; cnt = 0u; mine = 0u;
#pragma unroll
        for (unsigned j = 0; j < 16; ++j) { const unsigned c = xb_ld(&bar[XB_XCNT(j)]); sum += c; cnt += (c > 0u) ? 1u : 0u; mine = (j == x) ? c : mine; }
        if (sum == G) break;
        __builtin_amdgcn_s_sleep(1);
        if ((++sp & 255u) == 0u) { if (xb_ld(&bar[XB_TMO])) break; if (sp > XB_SPIN_CAP) { atomicAdd(&bar[XB_TMO], 1u); break; } }
    }
    nloc = mine > 0u ? mine : 1u; nx = cnt > 0u ? cnt : 1u;
}

__device__ __forceinline__ void xcd_barrier(const XcdBarrier& b) {
    asm volatile("s_waitcnt vmcnt(0)" ::: "memory");
    __syncthreads();
    if (b.w0 && fresh_lane() == 0) {
        unsigned* bar = b.bar;
        __builtin_amdgcn_s_waitcnt(0);
        unsigned nloc = b.st[0], nx = b.st[1];
        if (nloc == 0u) { xcd_barrier_complete(bar, b.x, nloc, nx); b.st[0] = nloc; b.st[1] = nx; }
        const unsigned old = xb_add(&bar[XB_XSUB(b.x)], 1u);
        const unsigned gen = old / nloc;
        if (old + 1u == (gen + 1u) * nloc) {
            __builtin_amdgcn_fence(__ATOMIC_RELEASE, "agent");
            asm volatile("s_waitcnt vmcnt(0)" ::: "memory");
            const unsigned og = xb_add(&bar[XB_TOP], 1u);
            const unsigned tg = og / nx;
            if (og + 1u == (tg + 1u) * nx) xb_add(&bar[XB_TOPGEN], 1u);
            else XB_SPIN(xb_ld(&bar[XB_TOPGEN]) == tg, bar);
            __builtin_amdgcn_fence(__ATOMIC_ACQUIRE, "agent");
            xb_add(&bar[XB_XGEN(b.x)], 1u);
            asm volatile("s_waitcnt vmcnt(0)" ::: "memory");
        } else {
            XB_SPIN(xb_ld(&bar[XB_XGEN(b.x)]) == gen, bar);
            __builtin_amdgcn_fence(__ATOMIC_ACQUIRE, "agent");
            asm volatile("s_waitcnt vmcnt(0)" ::: "memory");
        }
    }
    __syncthreads();
}

constexpr int LDS_BYTES = 151552;
constexpr int LDS_XCH = 132096;
constexpr int LDS_MISC = 145408;
__global__ void __launch_bounds__(512, 2) mega_fwd(Ptrs P) {
    extern __shared__ __attribute__((aligned(16))) unsigned char lds_raw[];
    LAS unsigned char* lds = (LAS unsigned char*)lds_raw;
    unsigned char* ws = P.ws;
    const int wave = __builtin_amdgcn_readfirstlane(threadIdx.x >> 6);
    const int G = gridDim.x, bid = blockIdx.x;
    if (wave == 0) { const int l_ = fresh_lane(); if (l_ < 2) ((LAS unsigned*)(lds + LDS_MISC))[l_] = 0u; }
    __syncthreads();
    const XcdBarrier bar = xcd_barrier_post((unsigned*)(ws + WS_CTL), (volatile LAS unsigned*)(lds + LDS_MISC), wave);
    p0_prologue(P, lds, bid, G, wave);
    xcd_barrier(bar);
    if (bid == 0) bias1_stage(ws, fresh_tid(wave));
    {
        pg8::Gemm g{(const bf16_t*)(ws + WS_XN), (const bf16_t*)(ws + WS_WIN), MTOK, NPROJ, 2048, 2048};
        pg8::StaticOrder S; S.init(MTOK, NPROJ, G, bid);
        pg8::EpiProj E{(bf16_t*)(ws + WS_Q), (bf16_t*)(ws + WS_KV6), (bf16_t*)(ws + WS_U), (bf16_t*)(ws + WS_GV), (float*)(ws + WS_GATES), (float*)(ws + WS_VSTAT), P.in[3], P.in[4]};
        pg8::gemm_phase<pg8::EpiProj, pg8::StaticOrder, true, true>(lds, g, S, E, wave);
    }
    xcd_barrier(bar);
    if (bid < 128 && G >= 256) { p2::compress_unit(P, lds, bid, wave); if (G == 256) late_weight_chunk(P, lds, LW_CHUNKS - 128 + bid, wave); }
    else if (G >= 256) p2::gmlp_run(P, lds, bid - 128, G - 128, 1024, wave);
    xcd_barrier(bar);
    nsa::nsa_phase(P, lds, bid, G, wave);
    xcd_barrier(bar);
    {
        pg8::Gemm g{(const bf16_t*)(ws + WS_AB), (const bf16_t*)(ws + WS_WOUT), MTOK, 2048, 2048, 2048};
        pg8::StaticOrder S; S.init(MTOK, 2048, G, bid);
        pg8::EpiRes1 E{(const float*)(ws + WS_SMALL + SM_RINV), (const float*)(ws + WS_SMALL + SM_INVW), (bf16_t*)(ws + WS_XN), (float*)(ws + WS_SSQ)};
        pg8::gemm_phase<pg8::EpiRes1, pg8::StaticOrder, true, true>(lds, g, S, E, wave);
    }
    xcd_barrier(bar);
    for (int m = bid * 512 + fresh_tid(wave); m < MTOK; m += G * 512) {
        const float* p = (const float*)(ws + WS_SSQ) + (size_t)m * 32; float s = 0.f;
#pragma unroll
        for (int i = 0; i < 32; ++i) s += p[i];
        ((float*)(ws + WS_SMALL + SM_R2))[m] = __builtin_amdgcn_rsqf(s * (1.0f / D_MODEL) + 1e-6f);
    }
    xcd_barrier(bar);
    {
        pg8::Gemm g{(const bf16_t*)(ws + WS_XN), (const bf16_t*)(ws + WS_WUP), MTOK, N_UP, 2048, 2048};
        pg8::StaticOrder S; S.init(MTOK, N_UP, G, bid);
        pg8::EpiUpConv E{(bf16_t*)(ws + WS_G), (const float*)(ws + WS_SMALL + SM_R2), P.in[15], P.in[16], (float*)(ws + WS_HLAST), (float*)(ws + WS_FIRST), lds + LDS_XCH};
        pg8::gemm_phase<pg8::EpiUpConv, pg8::StaticOrder, true, true>(lds, g, S, E, wave);
    }
    xcd_barrier(bar);
    for (int it = bid * 512 + fresh_tid(wave); it < 60 * 44 * 2 * 16; it += G * 512) {
        const int c8 = it & 15, row = (it >> 4) & 1, tl_ = it >> 5, pn = tl_ % 44, pmi = tl_ / 44, pm = pmi + pmi / 15 + 1;
        const float* cw = P.in[15]; const float* cb = P.in[16]; (void)cb;
        const float* fp = (const float*)(ws + WS_FIRST) + ((size_t)(pm * 44 + pn) * 2 + row) * 256 + 8 * c8;
        const float* lp = (const float*)(ws + WS_HLAST) + ((size_t)((pm - 1) * 44 + pn) * 2) * 256 + 8 * c8;
        const int ch = pn * 128 + 8 * c8;
        float r[8];
#pragma unroll
        for (int e = 0; e < 8; ++e) {
            const float l0g = lp[e], l1g = lp[256 + e], l0u = lp[128 + e], l1u = lp[256 + 128 + e];
            const float w0g = cw[ch + e], w1g = cw[N_UP + ch + e], w0u = cw[D_FF + ch + e], w1u = cw[N_UP + D_FF + ch + e];
            const float cg = fp[e] + (row == 0 ? w1g * l1g + w0g * l0g : w0g * l1g), cu = fp[128 + e] + (row == 0 ? w1u * l1u + w0u * l0u : w0u * l1u);
            r[e] = cg * sigmoidf_(cg) * cu;
        }
        u32x4_t o; o.x = pk2(r[0], r[1]); o.y = pk2(r[2], r[3]); o.z = pk2(r[4], r[5]); o.w = pk2(r[6], r[7]);
        *(u32x4_t*)((bf16_t*)(ws + WS_G) + (size_t)(pm * 256 + row) * D_FF + ch) = o;
    }
    xcd_barrier(bar);
    {
        pg8::Gemm g{(const bf16_t*)(ws + WS_G), (const bf16_t*)(ws + WS_WDOWN), MTOK, 2048, D_FF, D_FF};
        pg8::StaticOrder S; S.init(MTOK, 2048, G, bid);
        pg8::EpiDown E{P.out, (const bf16_t*)(ws + WS_XN)};
        pg8::gemm_phase<pg8::EpiDown, pg8::StaticOrder, true, true>(lds, g, S, E, wave);
    }
}

extern "C" void kernel_launch(void* const* d_in, const int* in_sizes, int n_in, void* d_out, int out_size, void* d_ws, size_t ws_size, hipStream_t stream) {
    static int grid_blocks = 0;
    if (!grid_blocks) {
        int dev = 0, cus = 0, per_cu = 0;
        (void)hipGetDevice(&dev);
        (void)hipDeviceGetAttribute(&cus, hipDeviceAttributeMultiprocessorCount, dev);
        (void)hipFuncSetAttribute((const void*)mega_fwd, hipFuncAttributeMaxDynamicSharedMemorySize, LDS_BYTES);
        (void)hipOccupancyMaxActiveBlocksPerMultiprocessor(&per_cu, (const void*)mega_fwd, 512, LDS_BYTES);
        if (per_cu < 1) { fprintf(stderr, "kernel_launch: occupancy query says %d blocks/CU\n", per_cu); per_cu = 1; }
        grid_blocks = cus * 1;
        (void)hipGetLastError();
    }
    if (n_in != 18 || ws_size < WS_END) { fprintf(stderr, "kernel_launch: unexpected n_in %d / ws %zu\n", n_in, ws_size); return; }
    Ptrs P{};
    for (int i = 0; i < 18; ++i) P.in[i] = (const float*)d_in[i];
    P.out = (float*)d_out; P.ws = (unsigned char*)d_ws;
    (void)hipMemsetAsync((char*)d_ws + WS_CTL, 0, 16384, stream);
    mega_fwd<<<dim3(grid_blocks), dim3(512), LDS_BYTES, stream>>>(P);
}
```

```cpp
#include <hip/hip_runtime.h>
#include <cstdio>
#include <cstdint>

constexpr int D_MODEL = 2048, BATCH = 4, SEQ = 4096, MTOK = BATCH * SEQ;
constexpr int IN_COLS = 4656, NPROJ = 4864;
constexpr int D_FF = 5632, N_UP = 2 * D_FF;
constexpr int NBG = 16;
constexpr size_t KVSZ = (size_t)NBG * SEQ * 64;
constexpr float LOG2E = 1.4426950408889634f;

constexpr size_t MiB = 1u << 20;
constexpr size_t WS_CTL = 0;
__device__ unsigned g_ctl[4096];
constexpr int CTL_EXIT = 3648;
constexpr size_t WS_WIN = 1 * MiB, WS_WOUT = 20 * MiB, WS_WUP = 28 * MiB, WS_WDOWN = 72 * MiB, WS_W1C = 94 * MiB;
constexpr size_t WS_SMALL = 96 * MiB;
constexpr size_t SM_BIASP = 0, SM_BIAS1 = 65536, SM_R2 = 131072, SM_W2T = 196608  , SM_SWB = 262144  , SM_RINV = 524288  , SM_INVW = 589824  ;
constexpr size_t WS_XN = 97 * MiB;
constexpr size_t WS_Q = 161 * MiB;
constexpr size_t WS_KV6 = 193 * MiB;
constexpr size_t WS_U = 241 * MiB, WS_GV = 273 * MiB;
constexpr size_t WS_GATES = 305 * MiB;
constexpr size_t WS_VSTAT = 308 * MiB;
constexpr size_t WS_KC = 310 * MiB, WS_VC = 310 * MiB + 524288;
constexpr size_t WS_HC = 311 * MiB;
constexpr size_t WS_AB = 315 * MiB;
constexpr size_t WS_SSQ = 379 * MiB;
constexpr size_t WS_G = 161 * MiB;
constexpr size_t WS_HID = 381 * MiB;
constexpr size_t WS_HLAST = 381 * MiB, WS_FIRST = 388 * MiB;
constexpr size_t WS_END = 469 * MiB;

#define LAS __attribute__((address_space(3)))
typedef unsigned short bf16_t;
typedef unsigned u32x4_t __attribute__((ext_vector_type(4)));
typedef unsigned u32x2_t __attribute__((ext_vector_type(2)));
typedef float f32x4_t __attribute__((ext_vector_type(4)));

__device__ __forceinline__ float bf2f(unsigned short h) { return __uint_as_float(((unsigned)h) << 16); }
__device__ __forceinline__ unsigned f2bf(float f) { unsigned u = __float_as_uint(f); return (u + 0x7fffu + ((u >> 16) & 1u)) >> 16; }
__device__ __forceinline__ unsigned pk2(float lo, float hi) { return f2bf(lo) | (f2bf(hi) << 16); }
__device__ __forceinline__ float gelu_tanh(float x) {
    const float u = 0.7978845608028654f * (x + 0.044715f * x * x * x);
    const float e = __builtin_amdgcn_exp2f(-2.8853900817779268f * u);
    return x * __builtin_amdgcn_rcpf(1.0f + e);
}
__device__ __forceinline__ float sigmoidf_(float x) { return __builtin_amdgcn_rcpf(1.0f + __builtin_amdgcn_exp2f(-LOG2E * x)); }
__device__ __forceinline__ float wave_sum(float v) {
#pragma unroll
    for (int o = 1; o < 64; o <<= 1) v += __shfl_xor(v, o);
    return v;
}
__device__ __forceinline__ void unpack8(u32x4_t r, float (&f)[8]) {
    f[0] = __uint_as_float(r.x << 16); f[1] = __uint_as_float(r.x & 0xffff0000u);
    f[2] = __uint_as_float(r.y << 16); f[3] = __uint_as_float(r.y & 0xffff0000u);
    f[4] = __uint_as_float(r.z << 16); f[5] = __uint_as_float(r.z & 0xffff0000u);
    f[6] = __uint_as_float(r.w << 16); f[7] = __uint_as_float(r.w & 0xffff0000u);
}

__device__ __forceinline__ int fresh_lane() { unsigned z_ = 0u; asm volatile("" : "+v"(z_)); return (int)__builtin_amdgcn_mbcnt_hi(~0u, __builtin_amdgcn_mbcnt_lo(~0u, z_)); }
__device__ __forceinline__ int fresh_tid(int wave_s) { return wave_s * 64 + fresh_lane(); }
namespace pg8 {
#define PG8_LAS __attribute__((address_space(3)))
typedef unsigned short bf16_t;
typedef short bf16x8 __attribute__((ext_vector_type(8)));
typedef float f32x4 __attribute__((ext_vector_type(4)));
typedef unsigned u32x4 __attribute__((ext_vector_type(4)));
constexpr int BM = 256, BK = 64, HALF = 128, HTB = HALF * BK * 2  , STAGE_BYTES = 8 * HTB, NXCD = 8, WGM = 8;

__host__ __device__ __forceinline__ int lds_byte(int r, int c) { const int st = (r >> 4) * 2 + (c >> 5), rr = r & 15, cc = c & 31, ob = rr * 64 + cc * 2; return st * 1024 + (ob ^ (((ob >> 9) & 1) << 5)); }
__host__ __device__ __forceinline__ void stage_rc(int b, int& R, int& C) { const int st = b / 1024, sb = b % 1024, swz = sb ^ (((sb >> 9) & 1) << 5); R = (st >> 1) * 16 + swz / 64; C = (st & 1) * 32 + (swz % 64) / 2; }
__host__ __device__ __forceinline__ int perm32(int rho) { const int n = rho >> 4, i = rho & 15; return 8 * (i >> 2) + 4 * n + (i & 3); }

__device__ __forceinline__ void pg8_glds16(const void* gbase  , unsigned voff  , unsigned lds_dst  ) { unsigned keep;
    asm volatile("s_mov_b32 %0, m0\n\ts_mov_b32 m0, %3\n\ts_nop 0\n\tglobal_load_lds_dwordx4 %1, %2\n\ts_mov_b32 m0, %0" : "=&s"(keep) : "v"(voff), "s"(gbase), "s"(lds_dst) : "memory"); }
struct Unit { int pm, pn; };
struct Gemm { const bf16_t* A; const bf16_t* Bt; int M, N, K, lda; };

struct StaticOrder {
    int nM, nN, nwg, G, c;
    __host__ __device__ void init(int M, int N, int G_, int c_) { nM = M / BM; nN = N / BM; nwg = nM * nN; G = G_; c = c_; }
    __host__ __device__ bool next(int i, Unit& u) const {
        const long L = (long)i * G + c; if (L >= nwg) return false;
        int wgid = (int)L; { const int q = nwg / NXCD, r = nwg % NXCD, xcd = wgid % NXCD, off = wgid / NXCD; wgid = (xcd < r ? xcd * (q + 1) : r * (q + 1) + (xcd - r) * q) + off; }
        const int nig = WGM * nN, gid = wgid / nig, fm = gid * WGM, gsz = (nM - fm) < WGM ? (nM - fm) : WGM;
        u.pm = fm + ((wgid % nig) % gsz); u.pn = (wgid % nig) / gsz; return true;
    }
    __device__ __forceinline__ void a_ready(const Unit&) const {}
    __device__ __forceinline__ void done(const Unit&) const {}
};

__device__ __forceinline__ unsigned cvt_pk_bf16(float lo, float hi) { unsigned r; asm volatile("v_cvt_pk_bf16_f32 %0, %1, %2" : "=v"(r) : "v"(lo), "v"(hi)); return r; }

struct EpiProj {
    static constexpr bool PERM = true, AFTER_DRAIN = false, PERMA = false;
    bf16_t* Q; bf16_t* KV6; bf16_t* U; bf16_t* GV; float* GATES; float* VSTAT; const float* q_norm_w; const float* k_norm_w;
    __device__ __forceinline__ void operator()(const f32x4 (&acc)[2][2][4][2], const Unit& u, int wr, int wc, int fr, int fq) const {
        const int pn = u.pn, row0 = u.pm * BM + wr * 64 + fr;
        if (pn < 10) {
            const bool normed = (pn < 4) || pn == 6 || pn == 8;
            const float* w = pn < 4 ? q_norm_w : (k_norm_w + (pn == 6 ? 64 : 128));
            const float sc = pn < 4 ? 0.125f * LOG2E : 1.0f;
            f32x4 wv[2][2];
#pragma unroll
            for (int bj = 0; bj < 2; ++bj)
#pragma unroll
                for (int n = 0; n < 2; ++n) wv[bj][n] = normed ? (*(const f32x4*)(w + 32 * bj + 8 * fq + 4 * n)) * sc : (f32x4){1.f, 1.f, 1.f, 1.f};
#pragma unroll
            for (int ai = 0; ai < 2; ++ai)
#pragma unroll
                for (int m = 0; m < 4; ++m) {
                    const int row = row0 + ai * HALF + m * 16;
                    float r = 1.f;
                    if (normed) {
                        float ss = 0.f;
#pragma unroll
                        for (int bj = 0; bj < 2; ++bj)
#pragma unroll
                            for (int n = 0; n < 2; ++n) { const f32x4 x = acc[ai][bj][m][n]; ss += (x[0] * x[0] + x[1] * x[1]) + (x[2] * x[2] + x[3] * x[3]); }
                        ss += __shfl_xor(ss, 16); ss += __shfl_xor(ss, 32);
                        r = __builtin_amdgcn_rsqf(ss * (1.0f / 64.0f) + 1e-6f);
                    }
                    bf16_t* dst;
                    if (pn < 4) dst = Q + (size_t)row * 1024 + pn * 256 + wc * 64 + 8 * fq;
                    else { const int b = row >> 12, t = row & 4095; dst = KV6 + (size_t)(pn - 4) * KVSZ + ((size_t)((b * 4 + wc) * 4096 + t)) * 64 + 8 * fq; }
#pragma unroll
                    for (int bj = 0; bj < 2; ++bj) {
                        const f32x4 v0 = acc[ai][bj][m][0] * r * wv[bj][0], v1 = acc[ai][bj][m][1] * r * wv[bj][1];
                        u32x4 o; o.x = cvt_pk_bf16(v0[0], v0[1]); o.y = cvt_pk_bf16(v0[2], v0[3]); o.z = cvt_pk_bf16(v1[0], v1[1]); o.w = cvt_pk_bf16(v1[2], v1[3]);
                        *(u32x4*)(dst + 32 * bj) = o;
                    }
                }
        } else if (pn < 18) {
            const bool isv = pn >= 14; const int ct = isv ? pn - 14 : pn - 10;
            bf16_t* base = (isv ? GV : U) + ct * 256 + wc * 64 + 8 * fq;
#pragma unroll
            for (int ai = 0; ai < 2; ++ai)
#pragma unroll
                for (int m = 0; m < 4; ++m) {
                    const int row = row0 + ai * HALF + m * 16; float s1 = 0.f, s2 = 0.f;
#pragma unroll
                    for (int bj = 0; bj < 2; ++bj) {
                        f32x4 v0 = acc[ai][bj][m][0], v1 = acc[ai][bj][m][1];
#pragma unroll
                        for (int e = 0; e < 4; ++e) { v0[e] = gelu_tanh(v0[e]); v1[e] = gelu_tanh(v1[e]); s1 += v0[e] + v1[e]; s2 += v0[e] * v0[e] + v1[e] * v1[e]; }
                        u32x4 o; o.x = cvt_pk_bf16(v0[0], v0[1]); o.y = cvt_pk_bf16(v0[2], v0[3]); o.z = cvt_pk_bf16(v1[0], v1[1]); o.w = cvt_pk_bf16(v1[2], v1[3]);
                        *(u32x4*)(base + (size_t)row * 1024 + 32 * bj) = o;
                    }
                    if (isv) {
                        s1 += __shfl_xor(s1, 16); s1 += __shfl_xor(s1, 32); s2 += __shfl_xor(s2, 16); s2 += __shfl_xor(s2, 32);
                        if (fq == 0) { float* p = VSTAT + ((size_t)row * 16 + ct * 4 + wc) * 2; p[0] = s1; p[1] = s2; }
                    }
                }
        } else {
            if (wc == 0) {
#pragma unroll
                for (int ai = 0; ai < 2; ++ai)
#pragma unroll
                    for (int m = 0; m < 4; ++m) {
                        const int row = row0 + ai * HALF + m * 16;
#pragma unroll
                        for (int bj = 0; bj < 2; ++bj)
#pragma unroll
                            for (int n = 0; n < 2; ++n) {
                                const int L = 32 * bj + 8 * fq + 4 * n;
                                if (L < 48) { f32x4 v = acc[ai][bj][m][n]; f32x4 o; o[0] = sigmoidf_(v[0]); o[1] = sigmoidf_(v[1]); o[2] = sigmoidf_(v[2]); o[3] = sigmoidf_(v[3]); *(f32x4*)(GATES + (size_t)row * 48 + L) = o; }
                            }
                    }
            }
        }
    }
};
struct EpiCmp {
    static constexpr bool PERM = true, AFTER_DRAIN = false, PERMA = false;
    bf16_t* HC; const float* bias1;
    __device__ __forceinline__ void operator()(const f32x4 (&acc)[2][2][4][2], const Unit& u, int wr, int wc, int fr, int fq) const {
        const int row0 = u.pm * BM + wr * 64 + fr, col0 = wc * 32 + 8 * fq;
        f32x4 bv[2][2];
#pragma unroll
        for (int bj = 0; bj < 2; ++bj)
#pragma unroll
            for (int n = 0; n < 2; ++n) bv[bj][n] = *(const f32x4*)(bias1 + u.pn * 256 + col0 + bj * HALF + 4 * n);
#pragma unroll
        for (int ai = 0; ai < 2; ++ai)
#pragma unroll
            for (int m = 0; m < 4; ++m) { bf16_t* rowp = HC + (size_t)(row0 + ai * HALF + m * 16) * 256 + col0;
#pragma unroll
                for (int bj = 0; bj < 2; ++bj) { f32x4 v0 = acc[ai][bj][m][0] + bv[bj][0], v1 = acc[ai][bj][m][1] + bv[bj][1];
#pragma unroll
                    for (int e = 0; e < 4; ++e) { v0[e] = gelu_tanh(v0[e]); v1[e] = gelu_tanh(v1[e]); }
                    u32x4 o; o.x = cvt_pk_bf16(v0[0], v0[1]); o.y = cvt_pk_bf16(v0[2], v0[3]); o.z = cvt_pk_bf16(v1[0], v1[1]); o.w = cvt_pk_bf16(v1[2], v1[3]);
                    *(u32x4*)(rowp + bj * HALF) = o; } }
    }
};
struct CmpOrder {
    int c, G;
    __device__ bool next(int i, Unit& u) const { const int L = i * G + c; if (L >= 32) return false; u.pm = L; u.pn = L >> 4; return true; }
    __device__ __forceinline__ void a_ready(const Unit&) const {}
    __device__ __forceinline__ void done(const Unit&) const {}
};
struct EpiRes1 {
    static constexpr bool PERM = true, AFTER_DRAIN = false, PERMA = false;
    const float* RINV; const float* INVW; bf16_t* X1b; float* SSQ;
    __device__ __forceinline__ void operator()(const f32x4 (&acc)[2][2][4][2], const Unit& u, int wr, int wc, int fr, int fq) const {
        const int row0 = u.pm * BM + wr * 64 + fr, col0 = u.pn * BM + wc * 32 + 8 * fq;
        f32x4 iw[2][2];
#pragma unroll
        for (int bj = 0; bj < 2; ++bj)
#pragma unroll
            for (int n = 0; n < 2; ++n) iw[bj][n] = *(const f32x4*)(INVW + col0 + bj * HALF + n * 4);
#pragma unroll
        for (int ai = 0; ai < 2; ++ai) {
            u32x4 xin[4][2]; float ri[4];
#pragma unroll
            for (int m = 0; m < 4; ++m) { ri[m] = RINV[row0 + ai * HALF + m * 16];
#pragma unroll
                for (int bj = 0; bj < 2; ++bj) xin[m][bj] = *(const u32x4*)(X1b + (size_t)(row0 + ai * HALF + m * 16) * D_MODEL + col0 + bj * HALF); }
            __builtin_amdgcn_sched_barrier(0);
#pragma unroll
            for (int m = 0; m < 4; ++m) { const int row = row0 + ai * HALF + m * 16; const size_t off = (size_t)row * D_MODEL + col0; float ss = 0.f;
#pragma unroll
                for (int bj = 0; bj < 2; ++bj) { const u32x4 w_ = xin[m][bj];
                    f32x4 x0, x1; x0[0] = __uint_as_float(w_.x << 16); x0[1] = __uint_as_float(w_.x & 0xffff0000u); x0[2] = __uint_as_float(w_.y << 16); x0[3] = __uint_as_float(w_.y & 0xffff0000u);
                    x1[0] = __uint_as_float(w_.z << 16); x1[1] = __uint_as_float(w_.z & 0xffff0000u); x1[2] = __uint_as_float(w_.w << 16); x1[3] = __uint_as_float(w_.w & 0xffff0000u);
                    const f32x4 v0 = x0 * ri[m] * iw[bj][0] + acc[ai][bj][m][0], v1 = x1 * ri[m] * iw[bj][1] + acc[ai][bj][m][1];
                    ss += ((v0[0] * v0[0] + v0[1] * v0[1]) + (v0[2] * v0[2] + v0[3] * v0[3])) + ((v1[0] * v1[0] + v1[1] * v1[1]) + (v1[2] * v1[2] + v1[3] * v1[3]));
                    u32x4 w; w.x = cvt_pk_bf16(v0[0], v0[1]); w.y = cvt_pk_bf16(v0[2], v0[3]); w.z = cvt_pk_bf16(v1[0], v1[1]); w.w = cvt_pk_bf16(v1[2], v1[3]); *(u32x4*)(X1b + off + bj * HALF) = w; }
                ss += __shfl_xor(ss, 16); ss += __shfl_xor(ss, 32);
                if (fq == 0) SSQ[(size_t)row * 32 + u.pn * 4 + wc] = ss; }
            __builtin_amdgcn_sched_barrier(0);
        }
    }
};
struct EpiUpV1 {
    static constexpr bool PERM = true, AFTER_DRAIN = false, PERMA = false;
    bf16_t* HID; const float* R2;
    __device__ __forceinline__ void operator()(const f32x4 (&acc)[2][2][4][2], const Unit& u, int wr, int wc, int fr, int fq) const {
        const int row0 = u.pm * BM + wr * 64 + fr, col0 = u.pn * BM + wc * 32 + 8 * fq;
#pragma unroll
        for (int ai = 0; ai < 2; ++ai)
#pragma unroll
            for (int m = 0; m < 4; ++m) { const int row = row0 + ai * HALF + m * 16; const float r = R2[row]; bf16_t* rowp = HID + (size_t)row * N_UP + col0;
#pragma unroll
                for (int bj = 0; bj < 2; ++bj) { const f32x4 v0 = acc[ai][bj][m][0] * r, v1 = acc[ai][bj][m][1] * r;
                    u32x4 o; o.x = cvt_pk_bf16(v0[0], v0[1]); o.y = cvt_pk_bf16(v0[2], v0[3]); o.z = cvt_pk_bf16(v1[0], v1[1]); o.w = cvt_pk_bf16(v1[2], v1[3]);
                    *(u32x4*)(rowp + bj * HALF) = o; } }
    }
};
struct EpiDown {
    static constexpr bool PERM = true, AFTER_DRAIN = false, PERMA = false;
    float* out; const bf16_t* X1b;
    __device__ __forceinline__ void operator()(const f32x4 (&acc)[2][2][4][2], const Unit& u, int wr, int wc, int fr, int fq) const {
        const int row0 = u.pm * BM + wr * 64 + fr, col0 = u.pn * BM + wc * 32 + 8 * fq;
#pragma unroll
        for (int ai = 0; ai < 2; ++ai) {
            u32x4 xin[4][2];
#pragma unroll
            for (int m = 0; m < 4; ++m)
#pragma unroll
                for (int bj = 0; bj < 2; ++bj) xin[m][bj] = *(const u32x4*)(X1b + (size_t)(row0 + ai * HALF + m * 16) * D_MODEL + col0 + bj * HALF);
            __builtin_amdgcn_sched_barrier(0);
#pragma unroll
            for (int m = 0; m < 4; ++m) { const size_t off = (size_t)(row0 + ai * HALF + m * 16) * D_MODEL + col0;
#pragma unroll
                for (int bj = 0; bj < 2; ++bj) { const u32x4 w = xin[m][bj];
                    f32x4 v0, v1; v0[0] = __uint_as_float(w.x << 16); v0[1] = __uint_as_float(w.x & 0xffff0000u); v0[2] = __uint_as_float(w.y << 16); v0[3] = __uint_as_float(w.y & 0xffff0000u);
                    v1[0] = __uint_as_float(w.z << 16); v1[1] = __uint_as_float(w.z & 0xffff0000u); v1[2] = __uint_as_float(w.w << 16); v1[3] = __uint_as_float(w.w & 0xffff0000u);
                    *(f32x4*)(out + off + bj * HALF) = v0 + acc[ai][bj][m][0]; *(f32x4*)(out + off + bj * HALF + 4) = v1 + acc[ai][bj][m][1]; } }
            __builtin_amdgcn_sched_barrier(0);
        }
    }
};
__device__ __forceinline__ unsigned f2bf_(float f) { unsigned u = __float_as_uint(f); return (u + 0x7fffu + ((u >> 16) & 1u)) >> 16; }
typedef float f32x2 __attribute__((ext_vector_type(2)));
struct EpiUpConv {
    static constexpr bool PERM = true, AFTER_DRAIN = false, PERMA = true;
    bf16_t* G; const float* R2; const float* cw; const float* cb; float* HLAST; float* FIRST; PG8_LAS unsigned char* xlds;
    __device__ __forceinline__ void prefetch(const Unit& u, int par, const int wave_s) const {
        const int lane_ = fresh_lane();
        PG8_LAS float* Wl = (PG8_LAS float*)xlds + (par ? 3344 : 2048);
#pragma unroll
        for (int i2 = 0; i2 < 2; ++i2) { const int i = wave_s * 64 + lane_ + 512 * i2, k = i >> 8, p = i & 255, c = (p < 128 ? 0 : D_FF - 128) + u.pn * 128 + p;
            const float* src = k < 3 ? cw + (unsigned)(k * N_UP + c) : cb + (unsigned)c;
            __builtin_amdgcn_global_load_lds((const unsigned*)src, (PG8_LAS unsigned*)(Wl + wave_s * 64 + 512 * i2), 4, 0, 0); }
    }
    __device__ __forceinline__ void run(const f32x4 (&acc)[2][2][4][2], const Unit& u, const Unit& nxt, const bool has_next, const int par, int wr, int wc, const int wave_s) const {
        unsigned z_ = 0u; asm volatile("" : "+v"(z_));
        const int lane_ = (int)__builtin_amdgcn_mbcnt_hi(~0u, __builtin_amdgcn_mbcnt_lo(~0u, z_)); const int fr = lane_ & 15, fq = lane_ >> 4;
        const int row0 = u.pm * BM + wr * 64 + 4 * fr;
        PG8_LAS float* X = (PG8_LAS float*)xlds;
        PG8_LAS float* Wl = X + (par ? 3344 : 2048);
        PG8_LAS float* R2L = X + 4624;
        const unsigned tile = (unsigned)(u.pm * (N_UP / 256) + u.pn);
        asm volatile("s_waitcnt vmcnt(8)" ::: "memory"); __builtin_amdgcn_s_barrier(); asm volatile("" ::: "memory");
        if (has_next) prefetch(nxt, par ^ 1, wave_s);
        if (fr == 15) {
#pragma unroll
            for (int ai = 0; ai < 2; ++ai) { const int sg = 2 * ai + wr; const float r2a = R2L[ai * HALF + wr * 64 + 62], r2b = R2L[ai * HALF + wr * 64 + 63];
#pragma unroll
                for (int mm = 0; mm < 2; ++mm)
#pragma unroll
                for (int bj = 0; bj < 2; ++bj)
#pragma unroll
                    for (int n = 0; n < 2; ++n) { const f32x4 h = acc[ai][bj][2 + mm][n] * (mm ? r2b : r2a);
                        *(PG8_LAS f32x4*)(X + ((sg * 4 + wc) * 2 + mm) * 64 + bj * 32 + 8 * fq + 4 * n) = h;
                        if (ai == 1 && wr == 1) *(f32x4*)(HLAST + (unsigned)((tile * 2 + mm) * 256 + bj * HALF + wc * 32 + 8 * fq + 4 * n)) = h; } }
        }
        asm volatile("s_waitcnt lgkmcnt(0)" ::: "memory"); __builtin_amdgcn_s_barrier(); asm volatile("" ::: "memory");
        const int cbase = u.pn * 128 + wc * 32 + 8 * fq;
        const bool seq_start = (u.pm & 15) == 0;
#pragma unroll
        for (int ai = 0; ai < 2; ++ai) {
            const int sg = 2 * ai + wr;
            const f32x4 rs = *(PG8_LAS const f32x4*)(R2L + ai * HALF + wr * 64 + 4 * fr);
            const bool defer = (ai == 0) && (wr == 0) && !seq_start && (fr == 0);
            unsigned pk[2][4][2];
#pragma unroll
            for (int n = 0; n < 2; ++n) {
#pragma unroll
                for (int e2 = 0; e2 < 2; ++e2) {
                    asm volatile("" ::: "memory"); __builtin_amdgcn_sched_barrier(0);
                    PG8_LAS const f32x2* wp = (PG8_LAS const f32x2*)(Wl + wc * 32 + 8 * fq + 4 * n + 2 * e2);
                    const f32x2 wg0 = wp[0], wg1 = wp[128], wg2 = wp[256], bg = wp[384], wu0 = wp[64], wu1 = wp[192], wu2 = wp[320], bu = wp[448];
                    f32x2 hg1 = {0.f, 0.f}, hg2 = {0.f, 0.f}, hu1 = {0.f, 0.f}, hu2 = {0.f, 0.f};
                    if (ai == 1 || wr == 1) { PG8_LAS const f32x2* xp = (PG8_LAS const f32x2*)(X + (((sg - 1) * 4 + wc) * 2) * 64 + 8 * fq + 4 * n + 2 * e2); hg2 = xp[0]; hg1 = xp[32]; hu2 = xp[16]; hu1 = xp[48]; }
                    f32x2 vg[4], vu[4], cg[4], cu[4];
#pragma unroll
                    for (int m = 0; m < 4; ++m) { const f32x2 r2 = {rs[m], rs[m]};
                        vg[m] = (f32x2){acc[ai][0][m][n][2 * e2], acc[ai][0][m][n][2 * e2 + 1]} * r2; vu[m] = (f32x2){acc[ai][1][m][n][2 * e2], acc[ai][1][m][n][2 * e2 + 1]} * r2; }
#define EPI_SHR1(old_, v_) (f32x2){__uint_as_float(__builtin_amdgcn_update_dpp(__float_as_uint((old_).x), __float_as_uint((v_).x), 0x111, 0xf, 0xf, false)), __uint_as_float(__builtin_amdgcn_update_dpp(__float_as_uint((old_).y), __float_as_uint((v_).y), 0x111, 0xf, 0xf, false))}
                    const f32x2 pg1 = EPI_SHR1(hg1, vg[3]), pg2 = EPI_SHR1(hg2, vg[2]), pu1 = EPI_SHR1(hu1, vu[3]), pu2 = EPI_SHR1(hu2, vu[2]);
#undef EPI_SHR1
                    cg[0] = bg + wg0 * pg2 + wg1 * pg1 + wg2 * vg[0]; cu[0] = bu + wu0 * pu2 + wu1 * pu1 + wu2 * vu[0];
                    cg[1] = bg + wg0 * pg1 + wg1 * vg[0] + wg2 * vg[1]; cu[1] = bu + wu0 * pu1 + wu1 * vu[0] + wu2 * vu[1];
                    cg[2] = bg + wg0 * vg[0] + wg1 * vg[1] + wg2 * vg[2]; cu[2] = bu + wu0 * vu[0] + wu1 * vu[1] + wu2 * vu[2];
                    cg[3] = bg + wg0 * vg[1] + wg1 * vg[2] + wg2 * vg[3]; cu[3] = bu + wu0 * vu[1] + wu1 * vu[2] + wu2 * vu[3];
                    if (defer) {
#pragma unroll
                        for (int m = 0; m < 2; ++m) { float* fp = FIRST + (unsigned)((tile * 2 + m) * 256 + wc * 32 + 8 * fq + 4 * n + 2 * e2); *(f32x2*)fp = cg[m]; *(f32x2*)(fp + HALF) = cu[m]; }
                    }
#pragma unroll
                    for (int m = 0; m < 4; ++m) {
                        const f32x2 t = cg[m] * (f32x2){-LOG2E, -LOG2E};
                        f32x2 sg_ = {__builtin_amdgcn_exp2f(t.x), __builtin_amdgcn_exp2f(t.y)};
                        sg_ = sg_ + (f32x2){1.0f, 1.0f};
                        const f32x2 rc = {__builtin_amdgcn_rcpf(sg_.x), __builtin_amdgcn_rcpf(sg_.y)};
                        const f32x2 gv = cg[m] * rc * cu[m];
                        pk[n][m][e2] = cvt_pk_bf16(gv.x, gv.y);
                    }
                }
            }
#pragma unroll
            for (int m = 0; m < 4; ++m)
                if (!(m < 2 && defer)) { u32x4 o; o.x = pk[0][m][0]; o.y = pk[0][m][1]; o.z = pk[1][m][0]; o.w = pk[1][m][1]; *(u32x4*)(G + (unsigned)((row0 + ai * HALF + m) * D_FF + cbase)) = o; }
        }
    }
};
template <class Epi, class Sched, bool ALIGN_EPI = false, bool SP2 = false>
__device__ __forceinline__ void gemm_phase(PG8_LAS unsigned char* lds, const Gemm g, const Sched& S, const Epi& E, const int wave_s) {
    const int tid = fresh_tid(wave_s), wid = wave_s, lane = tid & 63,
          wr = wid >> 2, wc = wid & 3, fr = lane & 15, fq = lane >> 4;
    const int K = g.K, nt = K / BK;
    unsigned voffA[2], voffB[2];
#pragma unroll
    for (int i = 0; i < 2; ++i) { int R, C; stage_rc(tid * 16 + i * 8192, R, C); const int Rb = Epi::PERM ? ((R & ~31) + perm32(R & 31)) : R;
        const int Ra = Epi::PERMA ? ((R & ~63) + 4 * (R & 15) + ((R >> 4) & 3)) : R;
        voffA[i] = (unsigned)(Ra * g.lda + C) * 2u; voffB[i] = (unsigned)(Rb * K + C) * 2u; }
    const size_t kstep = (size_t)(BK * 2);
    const size_t hstepA = (size_t)HALF * g.lda * 2, hstepB = (size_t)HALF * K * 2;
    const size_t tstepA = 2 * hstepA, tstepB = 2 * hstepB;
    const unsigned lds0_ = (unsigned)(uintptr_t)lds;
    const unsigned ldsw = (unsigned)wid * 1024u;
    const int aoff = lds_byte(wr * 64 + fr, fq * 8), boff = lds_byte(wc * 32 + fr, fq * 8);
#define PG8_SA(b, h) (((b) * 2 + (h)) * HTB)
#define PG8_SB(b, h) ((4 + (b) * 2 + (h)) * HTB)
#define PG8_STAGE(bufoff, gbase, voff) do { _Pragma("unroll") for (int _i = 0; _i < 2; ++_i) \
        pg8_glds16((const void*)(gbase), (voff)[_i], lds0_ + (unsigned)(bufoff) + ldsw + (unsigned)_i * 8192u); } while (0)
#define PG8_LDA(dst, b, h) do { _Pragma("unroll") for (int m = 0; m < 4; ++m) _Pragma("unroll") for (int k = 0; k < 2; ++k) dst[m][k] = *(const PG8_LAS bf16x8*)(lds + PG8_SA(b, h) + aoff + m * 2048 + k * 1024); } while (0)
#define PG8_LDB(dst, b, h) do { _Pragma("unroll") for (int n = 0; n < 2; ++n) _Pragma("unroll") for (int k = 0; k < 2; ++k) dst[n][k] = *(const PG8_LAS bf16x8*)(lds + PG8_SB(b, h) + boff + n * 2048 + k * 1024); } while (0)
#define PG8_MMA(ai, bj, At, Bt) do { __builtin_amdgcn_s_setprio(1); _Pragma("unroll") for (int m = 0; m < 4; ++m) _Pragma("unroll") for (int n = 0; n < 2; ++n) _Pragma("unroll") for (int k = 0; k < 2; ++k) \
        acc[ai][bj][m][n] = __builtin_amdgcn_mfma_f32_16x16x32_bf16(Bt[n][k], At[m][k], acc[ai][bj][m][n], 0, 0, 0); __builtin_amdgcn_s_setprio(0); } while (0)
#define PG8_WAIT_V(n) asm volatile("s_waitcnt vmcnt(" #n ")" ::: "memory")
#define PG8_WAIT_L(n) asm volatile("s_waitcnt lgkmcnt(" #n ")" ::: "memory")
#define PG8_BAR __builtin_amdgcn_s_barrier()
#define PG8_SCHED __builtin_amdgcn_sched_barrier(0)
    Unit cur, nxt; int ui = 0;
    if (!S.next(0, cur)) return;
    f32x4 acc[2][2][4][2];
#pragma unroll
    for (int a = 0; a < 2; ++a)
#pragma unroll
        for (int b = 0; b < 2; ++b)
#pragma unroll
            for (int m = 0; m < 4; ++m)
#pragma unroll
                for (int n = 0; n < 2; ++n) acc[a][b][m][n] = (f32x4){0.f, 0.f, 0.f, 0.f};
    bf16x8 At[4][2], B0[2][2], B1[2][2];
    const char* cA = (const char*)g.A + (size_t)cur.pm * tstepA; const char* cB = (const char*)g.Bt + (size_t)cur.pn * tstepB;
    S.a_ready(cur);
    if constexpr (Epi::PERMA) E.prefetch(cur, 0, wave_s);
    if constexpr (SP2) {
        PG8_STAGE(PG8_SB(0, 0), cB, voffB); PG8_STAGE(PG8_SB(0, 1), cB + hstepB, voffB); PG8_STAGE(PG8_SA(0, 0), cA, voffA); PG8_STAGE(PG8_SA(0, 1), cA + hstepA, voffA);
        if (wr == 1) PG8_BAR;
        PG8_WAIT_V(2); PG8_BAR;
        PG8_STAGE(PG8_SB(1, 0), cB + kstep, voffB); PG8_STAGE(PG8_SA(1, 0), cA + kstep, voffA); PG8_STAGE(PG8_SB(1, 1), cB + hstepB + kstep, voffB);
        PG8_WAIT_V(6); PG8_BAR;
    } else {
        PG8_STAGE(PG8_SB(0, 0), cB, voffB); PG8_STAGE(PG8_SA(0, 0), cA, voffA); PG8_STAGE(PG8_SB(0, 1), cB + hstepB, voffB); PG8_STAGE(PG8_SA(0, 1), cA + hstepA, voffA);
        if (wr == 1) PG8_BAR;
        PG8_WAIT_V(4); PG8_BAR;
        PG8_STAGE(PG8_SB(1, 0), cB + kstep, voffB); PG8_STAGE(PG8_SA(1, 0), cA + kstep, voffA); PG8_STAGE(PG8_SB(1, 1), cB + hstepB + kstep, voffB);
        PG8_WAIT_V(6); PG8_BAR;
    }
    for (;;) {
        const bool has_next = S.next(ui + 1, nxt);
        const char* nA = has_next ? (const char*)g.A + (size_t)nxt.pm * tstepA : cA; const char* nB = has_next ? (const char*)g.Bt + (size_t)nxt.pn * tstepB : cB;
        for (int t = 0; t < nt; t += 2) {
            const bool last = (t == nt - 2);
            const char* a1 = cA + (size_t)(t + 1) * kstep;
            const char* a2 = last ? nA : cA + (size_t)(t + 2) * kstep; const char* b2 = last ? nB : cB + (size_t)(t + 2) * kstep;
            const char* a3 = a2 + kstep; const char* b3 = b2 + kstep;
            if (last && has_next) S.a_ready(nxt);
            if constexpr (SP2) {
            PG8_LDB(B0, 0, 0); PG8_LDB(B1, 0, 1); PG8_SCHED; PG8_LDA(At, 0, 0); PG8_STAGE(PG8_SA(1, 1), a1 + hstepA, voffA);
            PG8_WAIT_V(8); PG8_WAIT_L(0); PG8_BAR; PG8_MMA(0, 0, At, B0); PG8_MMA(0, 1, At, B1); PG8_BAR; PG8_SCHED;
            PG8_LDA(At, 0, 1); PG8_STAGE(PG8_SB(0, 0), b2, voffB); PG8_STAGE(PG8_SB(0, 1), b2 + hstepB, voffB); PG8_STAGE(PG8_SA(0, 0), a2, voffA);
            PG8_WAIT_V(8); PG8_WAIT_L(0); PG8_BAR; PG8_MMA(1, 0, At, B0); PG8_MMA(1, 1, At, B1); PG8_BAR; PG8_SCHED;
            PG8_LDB(B0, 1, 0); PG8_LDB(B1, 1, 1); PG8_SCHED; PG8_LDA(At, 1, 0); PG8_STAGE(PG8_SA(0, 1), a2 + hstepA, voffA);
            PG8_WAIT_V(8); PG8_WAIT_L(0); PG8_BAR; PG8_MMA(0, 0, At, B0); PG8_MMA(0, 1, At, B1); PG8_BAR; PG8_SCHED;
            PG8_LDA(At, 1, 1); PG8_STAGE(PG8_SB(1, 0), b3, voffB); PG8_STAGE(PG8_SB(1, 1), b3 + hstepB, voffB); PG8_STAGE(PG8_SA(1, 0), a3, voffA);
            PG8_WAIT_V(8); PG8_WAIT_L(0); PG8_BAR; PG8_MMA(1, 0, At, B0); PG8_MMA(1, 1, At, B1); PG8_BAR; PG8_SCHED;
            } else {
            PG8_LDB(B0, 0, 0); PG8_SCHED; PG8_LDA(At, 0, 0); PG8_STAGE(PG8_SA(1, 1), a1 + hstepA, voffA);
            PG8_WAIT_L(8); PG8_BAR; PG8_WAIT_L(0); PG8_MMA(0, 0, At, B0); PG8_BAR; PG8_SCHED;
            PG8_LDB(B1, 0, 1); PG8_STAGE(PG8_SB(0, 0), b2, voffB);
            PG8_BAR; PG8_WAIT_L(0); PG8_MMA(0, 1, At, B1); PG8_BAR;
            PG8_LDA(At, 0, 1); PG8_STAGE(PG8_SA(0, 0), a2, voffA);
            PG8_BAR; PG8_WAIT_L(0); PG8_MMA(1, 0, At, B0); PG8_BAR; PG8_SCHED;
            PG8_STAGE(PG8_SB(0, 1), b2 + hstepB, voffB);
            PG8_WAIT_V(6); PG8_BAR; PG8_MMA(1, 1, At, B1); PG8_BAR;
            PG8_LDB(B0, 1, 0); PG8_SCHED; PG8_LDA(At, 1, 0); PG8_STAGE(PG8_SA(0, 1), a2 + hstepA, voffA);
            PG8_WAIT_L(8); PG8_BAR; PG8_WAIT_L(0); PG8_MMA(0, 0, At, B0); PG8_BAR; PG8_SCHED;
            PG8_LDB(B1, 1, 1); PG8_STAGE(PG8_SB(1, 0), b3, voffB);
            PG8_BAR; PG8_WAIT_L(0); PG8_MMA(0, 1, At, B1); PG8_BAR;
            PG8_LDA(At, 1, 1); PG8_STAGE(PG8_SA(1, 0), a3, voffA);
            PG8_BAR; PG8_WAIT_L(0); PG8_MMA(1, 0, At, B0); PG8_BAR; PG8_SCHED;
            PG8_STAGE(PG8_SB(1, 1), b3 + hstepB, voffB);
            PG8_WAIT_V(6); PG8_BAR; PG8_MMA(1, 1, At, B1); PG8_BAR;
            }
        }
        if constexpr (ALIGN_EPI) { if (wr == 0) PG8_BAR; }
        if constexpr (Epi::PERMA) { E.run(acc, cur, nxt, has_next, ui & 1, wr, wc, wave_s); S.done(cur); }
        else if constexpr (!Epi::AFTER_DRAIN) { E(acc, cur, wr, wc, fr, fq); S.done(cur); }
        if (!has_next) break;
#pragma unroll
        for (int a = 0; a < 2; ++a)
#pragma unroll
            for (int b = 0; b < 2; ++b)
#pragma unroll
                for (int m = 0; m < 4; ++m)
#pragma unroll
                    for (int n = 0; n < 2; ++n) acc[a][b][m][n] = (f32x4){0.f, 0.f, 0.f, 0.f};
        cur = nxt; cA = nA; cB = nB; ++ui;
        if constexpr (ALIGN_EPI) { if (wr == 1) PG8_BAR; }
    }
    PG8_WAIT_V(0);
    if constexpr (!ALIGN_EPI) { if (wr == 0) PG8_BAR; }
    PG8_BAR;
    if constexpr (Epi::AFTER_DRAIN) { E.fused(acc, cur, wr, wc, fr, fq, lds, wid, lane); S.done(cur); }
#undef PG8_SA
#undef PG8_SB
#undef PG8_STAGE
#undef PG8_LDA
#undef PG8_LDB
#undef PG8_MMA
#undef PG8_WAIT_V
#undef PG8_WAIT_L
#undef PG8_BAR
#undef PG8_SCHED
}
}
constexpr int NWAVES = 8;
template <class RowMap>
__device__ __forceinline__ void transpose_item(const float* __restrict__ W, int K, int N, bf16_t* WT, const float* __restrict__ kscale, RowMap rm, LAS float* scr, int item, int lane) {
    const int nblk = (N + 31) / 32, kb = item / nblk, nb = item % nblk, k0 = 64 * kb, n0 = 32 * nb;
    const int nr = n0 + (lane & 31);
    float v[32];
#pragma unroll
    for (int i = 0; i < 32; ++i) { const int kk = 2 * i + (lane >> 5); v[i] = (nr < N) ? __builtin_nontemporal_load(W + (size_t)(k0 + kk) * N + nr) : 0.f; }
    if (kscale) {
#pragma unroll
        for (int i = 0; i < 32; ++i) v[i] *= kscale[k0 + 2 * i + (lane >> 5)];
    }
#pragma unroll
    for (int i = 0; i < 32; ++i) scr[(2 * i + (lane >> 5)) * 33 + (lane & 31)] = v[i];
    asm volatile("s_waitcnt lgkmcnt(0)" ::: "memory");
    const int c = lane & 7;
#pragma unroll
    for (int j = 0; j < 4; ++j) { const int nl = (lane >> 3) + 8 * j, n = n0 + nl;
        if (n < N) { const LAS float* s = scr + (8 * c) * 33 + nl;
            u32x4_t o; o.x = pk2(s[0 * 33], s[1 * 33]); o.y = pk2(s[2 * 33], s[3 * 33]); o.z = pk2(s[4 * 33], s[5 * 33]); o.w = pk2(s[6 * 33], s[7 * 33]);
            *(u32x4_t*)(WT + (size_t)rm(n) * K + k0 + 8 * c) = o; } }
    asm volatile("s_waitcnt lgkmcnt(0)" ::: "memory");
}
struct RmIdent { __device__ __forceinline__ int operator()(int n) const { return n; } };
struct RmWin {
    __device__ __forceinline__ int operator()(int c) const {
        const int nc = c < 2560 ? c : (c < 2608 ? 4608 + (c - 2560) : 2560 + (c - 2608));
        const int tile = nc >> 8, L = nc & 255, wc = L >> 6, bj = (L >> 5) & 1, j = L & 31;
        return tile * 256 + 128 * bj + 32 * wc + j;
    }
};
struct RmWup {
    __device__ __forceinline__ int operator()(int c) const { const int up = c >= D_FF, cc = up ? c - D_FF : c; return (cc >> 7) * 256 + up * 128 + (cc & 127); }
};

struct Ptrs {
    const float* in[18]; float* out; unsigned char* ws;
};

__device__ __forceinline__ void p0_prologue(const Ptrs& P, LAS unsigned char* lds, int vcu, int G, const int wave) {
    const int lane = fresh_lane();
    LAS float* scr = (LAS float*)(lds + wave * 16384);
    const int gw = vcu * NWAVES + wave, NGW = G * NWAVES;
    unsigned char* ws = P.ws;
    bf16_t* WinT = (bf16_t*)(ws + WS_WIN); bf16_t* WoutT = (bf16_t*)(ws + WS_WOUT); bf16_t* WupT = (bf16_t*)(ws + WS_WUP); bf16_t* WdownT = (bf16_t*)(ws + WS_WDOWN); bf16_t* W1cT = (bf16_t*)(ws + WS_W1C);
    const float* x = P.in[0]; const float* attn_norm_w = P.in[1]; const float* w_in = P.in[2]; const float* cmp_pos = P.in[5]; const float* cmp_w1 = P.in[6];
    const float* w_out = P.in[12]; const float* ffn_norm_w = P.in[13]; const float* w_up = P.in[14]; const float* w_down = P.in[17];
    constexpr int I_IN = 32 * 146, I_W1 = 32 * 8, I_W2 = 4 * 2;
    constexpr int NITEMS = I_IN + 2 * I_W1 + 2 * I_W2;
    (void)w_out; (void)w_up; (void)w_down; (void)ffn_norm_w; (void)WoutT; (void)WupT; (void)WdownT;
    for (int it = gw; it < NITEMS; it += NGW) {
        int r = it;
        if (r < I_IN) { transpose_item(w_in, 2048, IN_COLS, WinT, nullptr, RmWin(), scr, r, lane); continue; } r -= I_IN;
        if (r < I_W1) { transpose_item(cmp_w1, 2048, 256, W1cT, nullptr, RmIdent(), scr, r, lane); continue; } r -= I_W1;
        if (r < I_W1) { transpose_item(cmp_w1 + (size_t)2048 * 256, 2048, 256, W1cT + (size_t)256 * 2048, nullptr, RmIdent(), scr, r, lane); continue; } r -= I_W1;
        { const int kv = r >= I_W2 ? 1 : 0; transpose_item(P.in[7] + (size_t)kv * 256 * 64, 256, 64, (bf16_t*)(ws + WS_SMALL + SM_W2T) + (size_t)kv * 64 * 256, nullptr, RmIdent(), scr, r - kv * I_W2, lane); }
    }
    for (int i = gw * 64 + lane; i < 8 * 16384; i += NGW * 64) { const int t = (i >> 7) & 127, sx = i & 127; ((bf16_t*)(ws + WS_SMALL + SM_SWB))[i] = (bf16_t)(sx <= t ? f2bf(P.in[10][i]) : 0u); }
    for (int p = gw; p < 256; p += NGW) {
        const int L = 64 * ((p >> 5) & 3) + 32 * (p >> 7) + (p & 31);
        if (L >= 48) { u32x4_t z = {0u, 0u, 0u, 0u}; u32x4_t* d = (u32x4_t*)(WinT + (size_t)(18 * 256 + p) * 2048);
#pragma unroll
            for (int j = 0; j < 4; ++j) d[lane + 64 * j] = z; }
    }
    bf16_t* XN = (bf16_t*)(ws + WS_XN);
    for (int m = gw; m < MTOK; m += 2 * NGW) {
        const int m2 = m + NGW;
        const f32x4_t* xr = (const f32x4_t*)(x + (size_t)m * D_MODEL) + lane;
        const f32x4_t* xr2 = (const f32x4_t*)(x + (size_t)(m2 < MTOK ? m2 : m) * D_MODEL) + lane;
        f32x4_t v[8], v2[8]; float s = 0.f, s2 = 0.f;
#pragma unroll
        for (int j = 0; j < 8; ++j) { v[j] = __builtin_nontemporal_load(xr + 64 * j); v2[j] = __builtin_nontemporal_load(xr2 + 64 * j); }
#pragma unroll
        for (int j = 0; j < 8; ++j) { s += (v[j][0] * v[j][0] + v[j][1] * v[j][1]) + (v[j][2] * v[j][2] + v[j][3] * v[j][3]); s2 += (v2[j][0] * v2[j][0] + v2[j][1] * v2[j][1]) + (v2[j][2] * v2[j][2] + v2[j][3] * v2[j][3]); }
        const float ms1 = wave_sum(s) * (1.0f / D_MODEL) + 1e-6f, ms2 = wave_sum(s2) * (1.0f / D_MODEL) + 1e-6f;
        const float r = __builtin_amdgcn_rsqf(ms1), r2 = __builtin_amdgcn_rsqf(ms2);
        if (lane == 0) { float* rinv = (float*)(ws + WS_SMALL + SM_RINV); rinv[m] = ms1 * r; if (m2 < MTOK) rinv[m2] = ms2 * r2; }
        u32x2_t* o8 = (u32x2_t*)(XN + (size_t)m * D_MODEL) + lane; u32x2_t* o82 = (u32x2_t*)(XN + (size_t)m2 * D_MODEL) + lane;
#pragma unroll
        for (int j = 0; j < 8; ++j) { const f32x4_t w = ((const f32x4_t*)attn_norm_w)[lane + 64 * j];
            u32x2_t o; o.x = pk2(v[j][0] * r * w[0], v[j][1] * r * w[1]); o.y = pk2(v[j][2] * r * w[2], v[j][3] * r * w[3]); o8[64 * j] = o;
            if (m2 < MTOK) { u32x2_t q; q.x = pk2(v2[j][0] * r2 * w[0], v2[j][1] * r2 * w[1]); q.y = pk2(v2[j][2] * r2 * w[2], v2[j][3] * r2 * w[3]); o82[64 * j] = q; } }
    }
    for (int i = gw * 64 + lane; i < D_MODEL; i += NGW * 64) ((float*)(ws + WS_SMALL + SM_INVW))[i] = 1.0f / attn_norm_w[i];
    float* BIASP = (float*)(ws + WS_SMALL + SM_BIASP);
    for (int it = gw; it < 64; it += NGW) {
        const int kv = it >> 5, kc = it & 31; f32x4_t a = {0.f, 0.f, 0.f, 0.f};
        const float* pp = cmp_pos + kv * 2048 + kc * 64; const float* w1 = cmp_w1 + ((size_t)kv * 2048 + kc * 64) * 256;
        for (int k = 0; k < 64; ++k) { const f32x4_t w = ((const f32x4_t*)(w1 + (size_t)k * 256))[lane]; a += w * pp[k]; }
        ((f32x4_t*)(BIASP + (size_t)it * 256))[lane] = a;
    }
}

__device__ __forceinline__ void bias1_stage(unsigned char* ws, int idx  ) {
    const float* BIASP = (const float*)(ws + WS_SMALL + SM_BIASP); float* BIAS1 = (float*)(ws + WS_SMALL + SM_BIAS1);
    const int kv = idx >> 8, j = idx & 255; float s = 0.f;
    for (int kc = 0; kc < 32; ++kc) s += BIASP[(size_t)(kv * 32 + kc) * 256 + j];
    BIAS1[idx] = s;
}
__device__ __forceinline__ void cmp2_row(const Ptrs& P, int R, int lane) {
    unsigned char* ws = P.ws; const bf16_t* HC = (const bf16_t*)(ws + WS_HC);
    const int kv = R >> 12, rr = R & 4095, n = rr & 255;
    bf16_t* dst = (bf16_t*)(ws + (kv ? WS_VC : WS_KC)) + (size_t)rr * 64 + lane;
    if (n == 255) { *dst = 0; return; }
    const float* w2 = P.in[7] + (size_t)kv * 256 * 64;
    const u32x2_t hr = *(const u32x2_t*)(HC + (size_t)R * 256 + 4 * lane);
    float h[4] = {__uint_as_float(hr.x << 16), __uint_as_float(hr.x & 0xffff0000u), __uint_as_float(hr.y << 16), __uint_as_float(hr.y & 0xffff0000u)};
    float o = 0.f;
    for (int jj = 0; jj < 64; ++jj) {
#pragma unroll
        for (int i = 0; i < 4; ++i) o += __shfl(h[i], jj) * w2[(size_t)(4 * jj + i) * 64 + lane];
    }
    if (kv == 0) { const float ss = wave_sum(o * o); o *= __builtin_amdgcn_rsqf(ss * (1.0f / 64.0f) + 1e-6f) * P.in[4][lane]; }
    *dst = (bf16_t)f2bf(o);
}

__device__ __forceinline__ void gmlp_unit_v1(const Ptrs& P, LAS unsigned char* lds, int unit, const int wave_s) {
    unsigned char* ws = P.ws; const int tid = fresh_tid(wave_s);
    const int g = unit & 7, chunk = (unit >> 3) & 31, b = unit >> 8; const int m0 = b * SEQ + chunk * 128;
    LAS float* vn = (LAS float*)lds; LAS float* Wl = (LAS float*)(lds + 65536); LAS float* st = (LAS float*)(lds + 131072);
    const bf16_t* GV = (const bf16_t*)(ws + WS_GV); const bf16_t* U = (const bf16_t*)(ws + WS_U); const float* VSTAT = (const float*)(ws + WS_VSTAT);
    bf16_t* AB = (bf16_t*)(ws + WS_AB);
    const float* ln_w = P.in[8]; const float* ln_b = P.in[9]; const float* sw = P.in[10]; const float* sb = P.in[11];
    if (tid < 128) { const float* p = VSTAT + (size_t)(m0 + tid) * 32; float s1 = 0.f, s2 = 0.f;
#pragma unroll
        for (int i = 0; i < 16; ++i) { s1 += p[2 * i]; s2 += p[2 * i + 1]; }
        const float mean = s1 * (1.0f / 1024.0f); float var = s2 * (1.0f / 1024.0f) - mean * mean; var = var < 0.f ? 0.f : var;
        st[2 * tid] = mean; st[2 * tid + 1] = __builtin_amdgcn_rsqf(var + 1e-5f); }
    for (int i = 0; i < 32; ++i) { const int idx = tid + 512 * i, t = idx >> 7, s = idx & 127; Wl[idx] = (s <= t) ? sw[(size_t)g * 16384 + idx] : 0.f; }
    __syncthreads();
#pragma unroll
    for (int i = 0; i < 4; ++i) { const int idx = tid + 512 * i, s = idx >> 4, c8 = idx & 15;
        const u32x4_t raw = *(const u32x4_t*)(GV + (size_t)(m0 + s) * 1024 + g * 128 + 8 * c8); float f[8]; unpack8(raw, f);
        const float mean = st[2 * s], rstd = st[2 * s + 1];
#pragma unroll
        for (int e = 0; e < 8; ++e) { const int c = g * 128 + 8 * c8 + e; vn[s * 128 + 8 * c8 + e] = (f[e] - mean) * rstd * ln_w[c] + ln_b[c]; } }
    __syncthreads();
    const int c = tid & 127, tq = tid >> 7;
    for (int i = 0; i < 8; ++i) {
        const int t0 = 4 * (tq + 4 * i); float a0 = 0.f, a1 = 0.f, a2 = 0.f, a3 = 0.f;
        for (int s4 = 0; s4 <= t0; s4 += 4) {
            const f32x4_t w0 = *(const LAS f32x4_t*)(Wl + (t0 + 0) * 128 + s4), w1 = *(const LAS f32x4_t*)(Wl + (t0 + 1) * 128 + s4), w2 = *(const LAS f32x4_t*)(Wl + (t0 + 2) * 128 + s4), w3 = *(const LAS f32x4_t*)(Wl + (t0 + 3) * 128 + s4);
#pragma unroll
            for (int k = 0; k < 4; ++k) { const float v = vn[(s4 + k) * 128 + c]; a0 += w0[k] * v; a1 += w1[k] * v; a2 += w2[k] * v; a3 += w3[k] * v; }
        }
        const float av[4] = {a0, a1, a2, a3};
#pragma unroll
        for (int k = 0; k < 4; ++k) { const int t = t0 + k; const size_t row = (size_t)(m0 + t);
            const float uu = bf2f(U[row * 1024 + g * 128 + c]); AB[row * 2048 + 1024 + g * 128 + c] = (bf16_t)f2bf(uu * (av[k] + sb[g * 128 + t])); }
    }
    __syncthreads();
}

__device__ __forceinline__ void conv_item(const Ptrs& P, int b, int idx) {
    const int t = idx / 704, c8 = idx % 704, c0 = 8 * c8, j = c0 >> 7, i0 = c0 & 127;
    const bf16_t* HID = (const bf16_t*)(P.ws + WS_HID); const float* cw = P.in[15]; const float* cb = P.in[16];
    float gt[8], up[8];
#pragma unroll
    for (int e = 0; e < 8; ++e) { gt[e] = cb[c0 + e]; up[e] = cb[D_FF + c0 + e]; }
#pragma unroll
    for (int k = 0; k < 3; ++k) { const int tt = t - 2 + k; if (tt < 0) continue;
        float hg[8], hu[8]; unpack8(*(const u32x4_t*)(HID + (size_t)tt * N_UP + 256 * j + i0), hg); unpack8(*(const u32x4_t*)(HID + (size_t)tt * N_UP + 256 * j + 128 + i0), hu);
#pragma unroll
        for (int e = 0; e < 8; ++e) { gt[e] += cw[(size_t)k * N_UP + c0 + e] * hg[e]; up[e] += cw[(size_t)k * N_UP + D_FF + c0 + e] * hu[e]; } }
    float r[8];
#pragma unroll
    for (int e = 0; e < 8; ++e) r[e] = gt[e] * sigmoidf_(gt[e]) * up[e];
    u32x4_t o; o.x = pk2(r[0], r[1]); o.y = pk2(r[2], r[3]); o.z = pk2(r[4], r[5]); o.w = pk2(r[6], r[7]);
    *(u32x4_t*)((bf16_t*)(P.ws + WS_G) + ((size_t)b * SEQ + t) * D_FF + c0) = o;
}

constexpr int LW_CH = 32;
constexpr int LW_OUT = 32 * 64, LW_UP = 32 * 352, LW_DOWN = 88 * 64, LW_C_OUT = LW_OUT / LW_CH, LW_C_UP = LW_UP / LW_CH, LW_C_DOWN = LW_DOWN / LW_CH, LW_CHUNKS = LW_C_OUT + LW_C_UP + LW_C_DOWN;
static_assert(LW_OUT % LW_CH == 0 && LW_UP % LW_CH == 0 && LW_DOWN % LW_CH == 0, "late weight items per chunk");
template <class RowMap>
__device__ __forceinline__ void lw_load(f32x4_t (&v)[8], const float* __restrict__ W, int N, int item, int lane) {
    const int nblk = N / 32, kb = item / nblk, nb = item % nblk;
    const float* p = W + (size_t)(64 * kb + (lane >> 3)) * N + 32 * nb + 4 * (lane & 7);
#pragma unroll
    for (int i = 0; i < 8; ++i) v[i] = __builtin_nontemporal_load((const f32x4_t*)(p + (size_t)(8 * i) * N));
}
template <class RowMap>
__device__ __forceinline__ void lw_store(const f32x4_t (&v)[8], int K, int N, bf16_t* WT, const float* __restrict__ kscale, RowMap rm, LAS float* scr, int item, int lane) {
    const int nblk = N / 32, kb = item / nblk, nb = item % nblk, k0 = 64 * kb, n0 = 32 * nb;
    const int c = lane & 7;
    f32x4_t sc0 = {1.f, 1.f, 1.f, 1.f}, sc1 = sc0;
    if (kscale) { sc0 = *(const f32x4_t*)(kscale + k0 + 8 * c); sc1 = *(const f32x4_t*)(kscale + k0 + 8 * c + 4); }
#pragma unroll
    for (int i = 0; i < 8; ++i) { LAS float* d = scr + (8 * i + (lane >> 3)) * 33 + 4 * (lane & 7); d[0] = v[i][0]; d[1] = v[i][1]; d[2] = v[i][2]; d[3] = v[i][3]; }
    asm volatile("s_waitcnt lgkmcnt(0)" ::: "memory");
#pragma unroll
    for (int j = 0; j < 4; ++j) { const int nl = (lane >> 3) + 8 * j; const LAS float* s = scr + (8 * c) * 33 + nl;
        u32x4_t o; o.x = pg8::cvt_pk_bf16(s[0 * 33] * sc0[0], s[1 * 33] * sc0[1]); o.y = pg8::cvt_pk_bf16(s[2 * 33] * sc0[2], s[3 * 33] * sc0[3]); o.z = pg8::cvt_pk_bf16(s[4 * 33] * sc1[0], s[5 * 33] * sc1[1]); o.w = pg8::cvt_pk_bf16(s[6 * 33] * sc1[2], s[7 * 33] * sc1[3]);
        *(u32x4_t*)(WT + (size_t)rm(n0 + nl) * K + k0 + 8 * c) = o; }
    asm volatile("s_waitcnt lgkmcnt(0)" ::: "memory");
}
template <class RowMap>
__device__ __forceinline__ void lw_run(const float* __restrict__ W, int K, int N, bf16_t* WT, const float* __restrict__ kscale, RowMap rm, LAS float* scr, int item0, int wave, int lane) {
    f32x4_t va[8], vb[8], vc[8], vd[8];
    lw_load<RowMap>(va, W, N, item0 + wave, lane);
    lw_load<RowMap>(vb, W, N, item0 + wave + 8, lane);
    lw_load<RowMap>(vc, W, N, item0 + wave + 16, lane);
    lw_load<RowMap>(vd, W, N, item0 + wave + 24, lane);
    __builtin_amdgcn_sched_barrier(0);
    lw_store(va, K, N, WT, kscale, rm, scr, item0 + wave, lane);
    lw_store(vb, K, N, WT, kscale, rm, scr, item0 + wave + 8, lane);
    lw_store(vc, K, N, WT, kscale, rm, scr, item0 + wave + 16, lane);
    lw_store(vd, K, N, WT, kscale, rm, scr, item0 + wave + 24, lane);
}
__device__ __forceinline__ void late_weight_chunk(const Ptrs& P, LAS unsigned char* lds, int chunk, const int wave) {
    const int lane = fresh_lane();
    LAS float* scr = (LAS float*)(lds + wave * 16384);
    unsigned char* ws = P.ws;
    if (chunk < LW_C_UP) lw_run(P.in[14], 2048, N_UP, (bf16_t*)(ws + WS_WUP), P.in[13], RmWup(), scr, chunk * LW_CH, wave, lane);
    else if (chunk < LW_C_UP + LW_C_DOWN) lw_run(P.in[17], D_FF, 2048, (bf16_t*)(ws + WS_WDOWN), nullptr, RmIdent(), scr, (chunk - LW_C_UP) * LW_CH, wave, lane);
    else lw_run(P.in[12], 2048, 2048, (bf16_t*)(ws + WS_WOUT), nullptr, RmIdent(), scr, (chunk - LW_C_UP - LW_C_DOWN) * LW_CH, wave, lane);
}

namespace nsa {
using bf16x8 = __attribute__((ext_vector_type(8))) short;
using s16x4 = __attribute__((ext_vector_type(4))) short;
using f32x16 = __attribute__((ext_vector_type(16))) float;
typedef float f32x2_t __attribute__((ext_vector_type(2))); typedef __bf16 bf16x2_t __attribute__((ext_vector_type(2)));
constexpr int L_K = 0, L_V = 16384, L_WSF = 32768, L_OST = 34816, L_IMP = 100352, L_MASK = 116736, L_WU = 117248, L_END = 117312;
constexpr int SLOTB = 8192;
constexpr int L_QS = 145416;
constexpr float THR = 8.0f;
#define NSA_SBAR() __builtin_amdgcn_sched_barrier(0)
__device__ __forceinline__ int crow(int r, int hi) { return (r & 3) + 8 * (r >> 2) + 4 * hi; }
__device__ __forceinline__ void glds16(const void* gbase  , unsigned voff  , unsigned lds_dst) { unsigned keep;
    asm volatile("s_mov_b32 %0, m0\n\ts_mov_b32 m0, %3\n\ts_nop 0\n\tglobal_load_lds_dwordx4 %1, %2\n\ts_mov_b32 m0, %0" : "=&s"(keep) : "v"(voff), "s"(gbase), "s"(lds_dst) : "memory"); }
__device__ __forceinline__ unsigned cvtpk_s(float lo, float hi) { f32x2_t v = {lo, hi}; bf16x2_t b = __builtin_convertvector(v, bf16x2_t); return __builtin_bit_cast(unsigned, b); }
#define NSA_WAIT_BAR() asm volatile("s_waitcnt vmcnt(0) lgkmcnt(0)\n\ts_barrier" ::: "memory")

__device__ __forceinline__ void qkt(f32x16& p0, f32x16& p1, LAS const char* Kslot, const bf16x8 (&qr)[4], int r32, int hi) {
    LAS const char* kb = Kslot + hi * 1024 + r32 * 16;
#pragma unroll
    for (int d0 = 0; d0 < 4; ++d0) {
        const bf16x8 b0 = *(LAS const bf16x8*)(kb + d0 * 2048);
        const bf16x8 b1 = *(LAS const bf16x8*)(kb + d0 * 2048 + 512);
        p0 = __builtin_amdgcn_mfma_f32_32x32x16_bf16(b0, qr[d0], p0, 0, 0, 0); p1 = __builtin_amdgcn_mfma_f32_32x32x16_bf16(b1, qr[d0], p1, 0, 0, 0);
    }
}
struct VFrag { s16x4 lo[2][4], hi[2][4]; };
__device__ __forceinline__ void vload(VFrag& f, int vb) {
#pragma unroll
    for (int d0 = 0; d0 < 2; ++d0)
#pragma unroll
        for (int ks = 0; ks < 4; ++ks) {
            asm volatile("ds_read_b64_tr_b16 %0,%1 offset:%c2" : "=&v"(f.lo[d0][ks]) : "v"(vb), "i"(d0 * 4096 + ks * 1024) : "memory");
            asm volatile("ds_read_b64_tr_b16 %0,%1 offset:%c2" : "=&v"(f.hi[d0][ks]) : "v"(vb), "i"(d0 * 4096 + ks * 1024 + 512) : "memory"); }
}
__device__ __forceinline__ void pvmma(f32x16 (&o)[2], VFrag& f, bf16x8 pa0, bf16x8 pa1, bf16x8 pa2, bf16x8 pa3) {
    asm volatile("s_waitcnt lgkmcnt(0)" : "+v"(f.lo[0][0]), "+v"(f.lo[0][1]), "+v"(f.lo[0][2]), "+v"(f.lo[0][3]), "+v"(f.hi[0][0]), "+v"(f.hi[0][1]), "+v"(f.hi[0][2]), "+v"(f.hi[0][3]) :: "memory");
    asm volatile("" : "+v"(f.lo[1][0]), "+v"(f.lo[1][1]), "+v"(f.lo[1][2]), "+v"(f.lo[1][3]), "+v"(f.hi[1][0]), "+v"(f.hi[1][1]), "+v"(f.hi[1][2]), "+v"(f.hi[1][3]));
    NSA_SBAR();
#pragma unroll
    for (int d0 = 0; d0 < 2; ++d0) {
#define NSA_PK(k) (bf16x8){f.lo[d0][k][0], f.lo[d0][k][1], f.lo[d0][k][2], f.lo[d0][k][3], f.hi[d0][k][0], f.hi[d0][k][1], f.hi[d0][k][2], f.hi[d0][k][3]}
        o[d0] = __builtin_amdgcn_mfma_f32_32x32x16_bf16(pa0, NSA_PK(0), o[d0], 0, 0, 0);
        o[d0] = __builtin_amdgcn_mfma_f32_32x32x16_bf16(pa1, NSA_PK(1), o[d0], 0, 0, 0);
        o[d0] = __builtin_amdgcn_mfma_f32_32x32x16_bf16(pa2, NSA_PK(2), o[d0], 0, 0, 0);
        o[d0] = __builtin_amdgcn_mfma_f32_32x32x16_bf16(pa3, NSA_PK(3), o[d0], 0, 0, 0);
#undef NSA_PK
    }
}
__device__ __forceinline__ void pv(f32x16 (&o)[2], int vb, bf16x8 pa0, bf16x8 pa1, bf16x8 pa2, bf16x8 pa3) { VFrag f; vload(f, vb); pvmma(o, f, pa0, pa1, pa2, pa3); }
__device__ __forceinline__ float rowmax32(const f32x16& p0, const f32x16& p1) {
    float a = __builtin_fmaxf(p0[0], p1[0]);
#pragma unroll
    for (int r = 1; r < 16; ++r) a = __builtin_fmaxf(a, __builtin_fmaxf(p0[r], p1[r]));
    auto rr = __builtin_amdgcn_permlane32_swap(__float_as_uint(a), __float_as_uint(a), false, false);
    return __builtin_fmaxf(__uint_as_float(rr[0]), __uint_as_float(rr[1]));
}
struct State { float m, l; f32x16 o[2]; };
__device__ __forceinline__ void state_init(State& s) { s.m = -1e30f; s.l = 0.f; s.o[0] = f32x16{}; s.o[1] = f32x16{}; }

template <int BMUL, int MASK, bool LOADV>
__device__ __forceinline__ void tile_scores(f32x16& p0, f32x16& p1, LAS const char* Kslot, const bf16x8 (&qr)[4], const f32x16& bk, float c0, float b32, int lim, int r32, int hi, VFrag& vf, int vb) {
#pragma unroll
    for (int r = 0; r < 16; ++r) { const float b = (BMUL == 1) ? bk[r] + c0 : __builtin_fmaf(bk[r], (float)BMUL, c0); p0[r] = b; p1[r] = b + b32; }
    qkt(p0, p1, Kslot, qr, r32, hi);
    if (LOADV) vload(vf, vb);
    const int limh = lim - 4 * hi;
#pragma unroll
    for (int r = 0; r < 16; ++r) {
        const int kk = (r & 3) + 8 * (r >> 2);
        if (MASK == 1) { if (!(kk <= limh)) p0[r] = -INFINITY; if (!(kk + 32 <= limh)) p1[r] = -INFINITY; }
        if (MASK == 2) { if (!(kk > limh)) p0[r] = -INFINITY; if (!(kk + 32 > limh)) p1[r] = -INFINITY; }
        if (MASK == 3) { if (!(kk < limh)) p0[r] = -INFINITY; if (!(kk + 32 < limh)) p1[r] = -INFINITY; }
    }
}
__device__ __forceinline__ float tile_ref(const State& st, float rb0, bool rowlive) { return (st.m < -1e29f && rowlive) ? rb0 : st.m; }
template <bool NOMAX>
__device__ __forceinline__ void tile_softmax_pv(State& st, f32x16& p0, f32x16& p1, float mref, VFrag& vf, LAS float* wsf, int r32, int hi) {
    if (!NOMAX) {
    float a0 = p0[0], a1 = p1[0];
#pragma unroll
    for (int r = 1; r < 16; ++r) { a0 = __builtin_fmaxf(a0, p0[r]); a1 = __builtin_fmaxf(a1, p1[r]); }
    float mx = __builtin_fmaxf(a0, a1);
    { auto rr = __builtin_amdgcn_permlane32_swap(__float_as_uint(mx), __float_as_uint(mx), false, false); mx = __builtin_fmaxf(__uint_as_float(rr[0]), __uint_as_float(rr[1])); }
    if (__any(mx > THR)) {
        const float dl = __builtin_fmaxf(mx, 0.f), alpha = __builtin_amdgcn_exp2f(-dl);
        mref += dl; st.l *= alpha;
        if (hi == 0) wsf[r32] = alpha;
        asm volatile("s_waitcnt lgkmcnt(0)" ::: "memory");
#pragma unroll
        for (int r = 0; r < 16; ++r) { const float a = wsf[crow(r, hi)]; st.o[0][r] *= a; st.o[1][r] *= a; p0[r] -= dl; p1[r] -= dl; }
    }
    }
    st.m = mref;
    float ls = 0.f;
#define NSA_PKV(d0, k) (bf16x8){vf.lo[d0][k][0], vf.lo[d0][k][1], vf.lo[d0][k][2], vf.lo[d0][k][3], vf.hi[d0][k][0], vf.hi[d0][k][1], vf.hi[d0][k][2], vf.hi[d0][k][3]}
#define NSA_GROUP(src, base, k) do { NSA_SBAR(); \
        _Pragma("unroll") for (int r_ = 0; r_ < 8; ++r_) src[(base) + r_] = __builtin_amdgcn_exp2f(src[(base) + r_]); \
        const u32x4_t pw_ = {cvtpk_s(src[(base)], src[(base) + 1]), cvtpk_s(src[(base) + 2], src[(base) + 3]), cvtpk_s(src[(base) + 4], src[(base) + 5]), cvtpk_s(src[(base) + 6], src[(base) + 7])}; \
        NSA_SBAR(); \
        if ((k) == 0) { asm volatile("s_waitcnt lgkmcnt(0)" : "+v"(vf.lo[0][0]), "+v"(vf.lo[0][1]), "+v"(vf.lo[0][2]), "+v"(vf.lo[0][3]), "+v"(vf.hi[0][0]), "+v"(vf.hi[0][1]), "+v"(vf.hi[0][2]), "+v"(vf.hi[0][3]) :: "memory");        \
                        asm volatile("" : "+v"(vf.lo[1][0]), "+v"(vf.lo[1][1]), "+v"(vf.lo[1][2]), "+v"(vf.lo[1][3]), "+v"(vf.hi[1][0]), "+v"(vf.hi[1][1]), "+v"(vf.hi[1][2]), "+v"(vf.hi[1][3])); } \
        st.o[0] = __builtin_amdgcn_mfma_f32_32x32x16_bf16(__builtin_bit_cast(bf16x8, pw_), NSA_PKV(0, k), st.o[0], 0, 0, 0); \
        st.o[1] = __builtin_amdgcn_mfma_f32_32x32x16_bf16(__builtin_bit_cast(bf16x8, pw_), NSA_PKV(1, k), st.o[1], 0, 0, 0); \
        NSA_SBAR(); \
        _Pragma("unroll") for (int r_ = 0; r_ < 8; ++r_) ls += src[(base) + r_]; } while (0)
    NSA_GROUP(p0, 0, 0); NSA_GROUP(p0, 8, 1); NSA_GROUP(p1, 0, 2); NSA_GROUP(p1, 8, 3);
    NSA_SBAR();
#undef NSA_GROUP
#undef NSA_PKV
    st.l += ls;
}
template <bool FIRST>
__device__ __forceinline__ void fold_branch(LAS float* ostg, State& st, float gate, LAS float* wsf, int r32, int hi) {
    float l = st.l;
    { auto rr = __builtin_amdgcn_permlane32_swap(__float_as_uint(l), __float_as_uint(l), false, false); l = __uint_as_float(rr[0]) + __uint_as_float(rr[1]); }
    const float f = l > 0.f ? gate / l : 0.f;
    asm volatile("s_waitcnt lgkmcnt(0)" ::: "memory");
    if (hi == 0) wsf[r32] = f;
    asm volatile("s_waitcnt lgkmcnt(0)" ::: "memory");
#pragma unroll
    for (int r = 0; r < 16; ++r) { const int orow = crow(r, hi); const float a = wsf[orow];
#pragma unroll
        for (int d0 = 0; d0 < 2; ++d0) { LAS float* p = ostg + orow * 64 + d0 * 32 + r32; if (FIRST) *p = st.o[d0][r] * a; else *p += st.o[d0][r] * a; } }
    asm volatile("s_waitcnt lgkmcnt(0)" ::: "memory");
}

template <bool SAFE>
__device__ __forceinline__ int nsa_unit(const Ptrs& P, LAS unsigned char* lds, int bg, int qt, const int wave_s, unsigned* qctr, int qbase) {
    unsigned char* ws = P.ws;
    const int lane = fresh_lane(), r32 = lane & 31, hi = lane >> 5; const int wid = wave_s;
    const int b = bg >> 2, g = bg & 3, t0 = 64 * qt;
    const int tl = 8 * wid + (r32 >> 2), hq = r32 & 3;
    const size_t m0 = (size_t)b * SEQ + t0;
    const bf16_t* Q = (const bf16_t*)(ws + WS_Q); const bf16_t* KV6 = (const bf16_t*)(ws + WS_KV6);
    const bf16_t* KSb = KV6 + 2 * KVSZ + (size_t)bg * SEQ * 64; const bf16_t* VSb = KV6 + 3 * KVSZ + (size_t)bg * SEQ * 64;
    const bf16_t* KWb = KV6 + 4 * KVSZ + (size_t)bg * SEQ * 64; const bf16_t* VWb = KV6 + 5 * KVSZ + (size_t)bg * SEQ * 64;
    const bf16_t* KCb = (const bf16_t*)(ws + WS_KC) + (size_t)bg * 256 * 64; const bf16_t* VCb = (const bf16_t*)(ws + WS_VC) + (size_t)bg * 256 * 64;
    const float* GATES = (const float*)(ws + WS_GATES); bf16_t* AB = (bf16_t*)(ws + WS_AB);
    const unsigned lds0 = (unsigned)(uintptr_t)lds;
    LAS float* wsf = (LAS float*)(lds + L_WSF) + wid * 64;
    LAS float* IMP = (LAS float*)(lds + L_IMP);
    LAS unsigned* MASK = (LAS unsigned*)(lds + L_MASK); LAS unsigned* WU = (LAS unsigned*)(lds + L_WU);
    const int koff = lane * 64 + wid * 8, voff = (16 * (wid & 3) + (lane >> 2)) * 64 + (wid >> 2) * 32 + (lane & 3) * 8;
    const unsigned kdst = lds0 + L_K + wid * 1024, vdst = lds0 + L_V + wid * 1024;
#define NSA_DMA_K(base, tile, slot) glds16((base) + (size_t)(tile) * 4096, (unsigned)koff * 2u, (unsigned)__builtin_amdgcn_readfirstlane(kdst + (slot) * SLOTB))
#define NSA_DMA_V(base, tile, slot) glds16((base) + (size_t)(tile) * 4096, (unsigned)voff * 2u, (unsigned)__builtin_amdgcn_readfirstlane(vdst + (slot) * SLOTB))
    const int vb0 = (int)(lds0 + L_V) + ((lane >> 4) & 1) * 32 + (lane & 3) * 8 + (4 * hi + ((lane & 15) >> 2)) * 64;
    LAS const char* Kbase = (LAS const char*)(lds + L_K);
    bf16x8 qr[4];
    { const bf16_t* qp = Q + (m0 + tl) * 1024 + (4 * g + hq) * 64 + hi * 8;
#pragma unroll
      for (int d0 = 0; d0 < 4; ++d0) qr[d0] = *(const bf16x8*)(qp + d0 * 16); }
    const float sl2 = __builtin_amdgcn_exp2f(-0.5f * (float)(4 * g + hq + 1)) * LOG2E;
    f32x16 bk;
#pragma unroll
    for (int r = 0; r < 16; ++r) bk[r] = sl2 * (float)((r & 3) + 8 * (r >> 2));
    const float b32t = 32.0f * sl2, b32c = 512.0f * sl2, hoff_t = 4.0f * (float)hi * sl2, hoff_c = 64.0f * (float)hi * sl2;
    float gate[3];
    { const float* gp = GATES + (m0 + tl) * 48 + (4 * g + hq) * 3; gate[0] = gp[0]; gate[1] = gp[1]; gate[2] = gp[2]; }
    LAS float* ostg = (LAS float*)(lds + L_OST) + wid * 2048;
    State st;
    f32x16 p0, p1;
    int nxt_ticket = 0;

    int tc = 0;
    VFrag vf;
    const int nvmax = (t0 + 63 >= 31) ? ((t0 + 63 - 31) >> 4) + 1 : 0;
    const int nct = (nvmax + 63) >> 6;
    const int tq = t0 + tl, nv = tq >= 31 ? ((tq - 31) >> 4) + 1 : 0;
    const float mref_t = sl2 * (float)tl, mref_c = nv > 0 ? sl2 * ((float)(16 * (nv - 1) - t0) + 15.5f) : 0.f;
    {
        state_init(st);
        const int j0 = qt >= 8 ? qt - 8 : 0, nt = qt - j0 + 1;
        NSA_DMA_K(KWb, qt, 0); NSA_DMA_V(VWb, qt, 0); NSA_WAIT_BAR();
        for (int i = 0; i < nt; ++i) {
            const int j = qt - i, slot = (tc + i) & 1;
            if (i + 1 < nt) { NSA_DMA_K(KWb, j - 1, slot ^ 1); NSA_DMA_V(VWb, j - 1, slot ^ 1); }
            else { NSA_DMA_K(KCb, nct - 1, slot ^ 1); NSA_DMA_V(VCb, nct - 1, slot ^ 1); }
            const float rb0 = sl2 * (float)(64 * j - t0), mref = SAFE ? mref_t : tile_ref(st, rb0, true), c0 = rb0 + hoff_t - mref;
            if (j == qt) tile_scores<1, 1, true>(p0, p1, Kbase + slot * SLOTB, qr, bk, c0, b32t, tl, r32, hi, vf, vb0 + slot * SLOTB);
            else if (j == qt - 8) tile_scores<1, 2, true>(p0, p1, Kbase + slot * SLOTB, qr, bk, c0, b32t, tl, r32, hi, vf, vb0 + slot * SLOTB);
            else tile_scores<1, 0, true>(p0, p1, Kbase + slot * SLOTB, qr, bk, c0, b32t, 0, r32, hi, vf, vb0 + slot * SLOTB);
            tile_softmax_pv<SAFE>(st, p0, p1, mref, vf, wsf, r32, hi);
            NSA_WAIT_BAR();
        }
        tc += nt;
        fold_branch<true>(ostg, st, gate[2], wsf, r32, hi);
    }
    {
        state_init(st);
        for (int ci = 0; ci < nct; ++ci) {
            const int c = nct - 1 - ci, slot = (tc + ci) & 1;
            if (ci + 1 < nct) { NSA_DMA_K(KCb, c - 1, slot ^ 1); NSA_DMA_V(VCb, c - 1, slot ^ 1); }
            else if (qt >= 16) { NSA_DMA_K(KCb, 0, slot ^ 1); }
            else { NSA_DMA_K(KSb, qt, slot ^ 1); NSA_DMA_V(VSb, qt, slot ^ 1); }
            const float rb0 = sl2 * ((float)(1024 * c - t0) + 15.5f), mref = SAFE ? mref_c : tile_ref(st, rb0, true), c0 = rb0 + hoff_c - mref;
            tile_scores<16, 3, true>(p0, p1, Kbase + slot * SLOTB, qr, bk, c0, b32c, nv - 64 * c, r32, hi, vf, vb0 + slot * SLOTB);
            tile_softmax_pv<SAFE>(st, p0, p1, mref, vf, wsf, r32, hi);
            NSA_WAIT_BAR();
        }
        tc += nct;
    }
    const float mc_fin = st.m; float lc = st.l;
    fold_branch<false>(ostg, st, gate[0], wsf, r32, hi);
    if (qt >= 16) {
        { auto rr = __builtin_amdgcn_permlane32_swap(__float_as_uint(lc), __float_as_uint(lc), false, false); lc = __uint_as_float(rr[0]) + __uint_as_float(rr[1]); }
        const float lgl = lc > 0.f ? __builtin_amdgcn_logf(lc) : INFINITY;
        float carry = 0.f;
        for (int c = 0; c < nct; ++c) {
            const int slot = (tc + c) & 1;
            if (c + 1 < nct) { NSA_DMA_K(KCb, c + 1, slot ^ 1); }
            else { NSA_DMA_K(KSb, qt, slot ^ 1); NSA_DMA_V(VSb, qt, slot ^ 1); }
            const float c0 = sl2 * ((float)(1024 * c - t0) + 15.5f) + hoff_c - mc_fin - lgl;
            tile_scores<16, 3, false>(p0, p1, Kbase + slot * SLOTB, qr, bk, c0, b32c, nv - 64 * c, r32, hi, vf, 0);
#pragma unroll
            for (int r = 0; r < 16; ++r) { p0[r] = __builtin_amdgcn_exp2f(p0[r]); p1[r] = __builtin_amdgcn_exp2f(p1[r]); }
            float imp0[4], imp1[4], pl0[4], pl1[4];
#pragma unroll
            for (int a = 0; a < 4; ++a) {
                imp0[a] = (p0[4 * a] + p0[4 * a + 1]) + (p0[4 * a + 2] + p0[4 * a + 3]); imp1[a] = (p1[4 * a] + p1[4 * a + 1]) + (p1[4 * a + 2] + p1[4 * a + 3]);
                pl0[a] = __shfl_xor(p0[4 * a + 3], 32); pl1[a] = __shfl_xor(p1[4 * a + 3], 32);
            }
            if (hi) {
#pragma unroll
                for (int a = 0; a < 4; ++a) { imp0[a] += pl0[a]; imp1[a] += pl1[a]; }
            } else {
                imp0[0] += carry; imp1[0] += pl0[3];
#pragma unroll
                for (int a = 1; a < 4; ++a) { imp0[a] += pl0[a - 1]; imp1[a] += pl1[a - 1]; }
            }
            carry = pl1[3];
#pragma unroll
            for (int a = 0; a < 4; ++a) {
                imp0[a] += __shfl_xor(imp0[a], 1); imp0[a] += __shfl_xor(imp0[a], 2); imp1[a] += __shfl_xor(imp1[a], 1); imp1[a] += __shfl_xor(imp1[a], 2);
                if (hq == 0) { IMP[tl * 64 + 16 * c + 2 * a + hi] = imp0[a]; IMP[tl * 64 + 16 * c + 8 + 2 * a + hi] = imp1[a]; }
            }
            NSA_WAIT_BAR();
        }
        tc += nct;
    }
    unsigned long long wu = 0ull;
    if (qt < 16) {
        wu = (2ull << qt) - 1ull;
        if (lane < 8) { MASK[2 * (8 * wid + lane)] = (unsigned)wu; MASK[2 * (8 * wid + lane) + 1] = (unsigned)(wu >> 32); }
    } else {
        const int j = lane; const bool valid = j <= qt, forced = (j == 0) || (j == qt) || (j == qt - 1);
        for (int k = 0; k < 8; ++k) {
            const float imp = IMP[(8 * wid + k) * 64 + j];
            const unsigned fb = __float_as_uint(imp), key = valid ? (forced ? 0xffffffffu : (fb | 0x80000000u)) : 0u;
            unsigned T = 0u;
#pragma unroll
            for (int bit = 31; bit >= 0; --bit) { const unsigned cand = T | (1u << bit); const unsigned long long bm = __ballot(key >= cand);
                const unsigned n = (unsigned)__builtin_popcount((unsigned)bm) + (unsigned)__builtin_popcount((unsigned)(bm >> 32));
                if (n >= 16u) T = cand; }
            const unsigned long long gt = __ballot(key > T), eq = __ballot(key == T);
            const int need = 16 - __builtin_popcountll(gt);
            const int before = (int)__builtin_amdgcn_mbcnt_hi((unsigned)(eq >> 32), __builtin_amdgcn_mbcnt_lo((unsigned)eq, 0u));
            const bool sel = (key > T) || ((key == T) && (before < need));
            const unsigned long long mk = __ballot(sel && valid);
            wu |= mk;
            if (lane == 0) { MASK[2 * (8 * wid + k)] = (unsigned)mk; MASK[2 * (8 * wid + k) + 1] = (unsigned)(mk >> 32); }
        }
    }
    if (lane == 0) { WU[2 * wid] = (unsigned)wu; WU[2 * wid + 1] = (unsigned)(wu >> 32); }
    NSA_WAIT_BAR();
    unsigned long long uni = 0ull;
#pragma unroll
    for (int w = 0; w < 8; ++w) uni |= ((unsigned long long)WU[2 * w]) | (((unsigned long long)WU[2 * w + 1]) << 32);
    uni = ((unsigned long long)(unsigned)__builtin_amdgcn_readfirstlane((unsigned)uni)) | (((unsigned long long)(unsigned)__builtin_amdgcn_readfirstlane((unsigned)(uni >> 32))) << 32);
    const unsigned long long mymask = ((unsigned long long)MASK[2 * tl]) | (((unsigned long long)MASK[2 * tl + 1]) << 32);
    {
        state_init(st);
        unsigned long long rem = uni;
        int j = 63 - __builtin_clzll(rem); rem &= ~(1ull << j);
        for (int i = 0;; ++i) {
            const int slot = (tc + i) & 1; const bool more = rem != 0ull;
            int jn = 0;
            if (more) { jn = 63 - __builtin_clzll(rem); rem &= ~(1ull << jn); NSA_DMA_K(KSb, jn, slot ^ 1); NSA_DMA_V(VSb, jn, slot ^ 1); }
            if ((wu >> j) & 1ull) {
                const bool live = ((mymask >> j) & 1ull) != 0ull;
                const float rb0 = sl2 * (float)(64 * j - t0), mref = SAFE ? mref_t : tile_ref(st, rb0, live), c0 = live ? rb0 + hoff_t - mref : -INFINITY;
                if (j == qt) tile_scores<1, 1, true>(p0, p1, Kbase + slot * SLOTB, qr, bk, c0, b32t, tl, r32, hi, vf, vb0 + slot * SLOTB);
                else tile_scores<1, 0, true>(p0, p1, Kbase + slot * SLOTB, qr, bk, c0, b32t, 0, r32, hi, vf, vb0 + slot * SLOTB);
                tile_softmax_pv<SAFE>(st, p0, p1, mref, vf, wsf, r32, hi);
            }
            NSA_WAIT_BAR();
            if (!more) break;
            j = jn;
        }
        if (wid == 0 && lane == 0) nxt_ticket = qbase + (int)__hip_atomic_fetch_add(qctr, 1u, __ATOMIC_RELAXED, __HIP_MEMORY_SCOPE_AGENT);
        fold_branch<false>(ostg, st, gate[1], wsf, r32, hi);
    }
    {
#pragma unroll
        for (int i = 0; i < 4; ++i) { const int row = i * 8 + (lane >> 3), ch = lane & 7;
            const f32x4_t v0 = *(LAS const f32x4_t*)(ostg + row * 64 + ch * 8), v1 = *(LAS const f32x4_t*)(ostg + row * 64 + ch * 8 + 4);
            u32x4_t v; v.x = cvtpk_s(v0[0], v0[1]); v.y = cvtpk_s(v0[2], v0[3]); v.z = cvtpk_s(v1[0], v1[1]); v.w = cvtpk_s(v1[2], v1[3]);
            *(u32x4_t*)(AB + (m0 + 8 * wid + (row >> 2)) * 2048 + 256 * g + (row & 3) * 64 + ch * 8) = v; }
    }
    if (wid == 0 && lane == 0) *(LAS int*)(lds + L_QS) = nxt_ticket;
    NSA_WAIT_BAR();
#undef NSA_DMA_K
#undef NSA_DMA_V
    return __builtin_amdgcn_readfirstlane(*(LAS const int*)(lds + L_QS));
}
__device__ __forceinline__ void nsa_phase(const Ptrs& P, LAS unsigned char* lds, int bid, int G, const int wave_s) {
    unsigned* qctr = g_ctl + 3584;
    LAS int* qs = (LAS int*)(lds + L_QS);
    const int lwq = (G == 256) ? LW_CHUNKS - 128 : LW_CHUNKS;
    const int nrest = 1024 - G + lwq;
    int safe;
    { const int l_ = fresh_lane(); float a = __builtin_fabsf(P.in[3][l_]), b = __builtin_fmaxf(__builtin_fabsf(P.in[4][l_]), __builtin_fmaxf(__builtin_fabsf(P.in[4][64 + l_]), __builtin_fabsf(P.in[4][128 + l_])));
#pragma unroll
      for (int o = 1; o < 64; o <<= 1) { a = __builtin_fmaxf(a, __shfl_xor(a, o)); b = __builtin_fmaxf(b, __shfl_xor(b, o)); }
      safe = __builtin_amdgcn_readfirstlane((64.0f * 0.125f * LOG2E * a * b < 80.0f) ? 1 : 0); }
    int k = bid;
    while (k < 1024 + lwq) {
        int nxt, unit = k, chunk = -1;
        if (k >= G) { const int t = k - G, cb = (t * lwq) / nrest, ca = ((t + 1) * lwq) / nrest;
            if (ca > cb) chunk = cb; else unit = G + t - cb; }
        if (chunk < 0) {
            const int qt = 63 - (unit >> 4), g = 3 - ((unit >> 2) & 3), b = unit & 3;
            nxt = safe ? nsa_unit<true>(P, lds, b * 4 + g, qt, wave_s, qctr, G) : nsa_unit<false>(P, lds, b * 4 + g, qt, wave_s, qctr, G);
        } else {
            nxt = 0;
            if (wave_s == 0 && fresh_lane() == 0) nxt = G + (int)__hip_atomic_fetch_add(qctr, 1u, __ATOMIC_RELAXED, __HIP_MEMORY_SCOPE_AGENT);
            late_weight_chunk(P, lds, chunk, wave_s);
        }
        if (chunk < 0) k = __builtin_amdgcn_readfirstlane(nxt);
        else { if (wave_s == 0 && fresh_lane() == 0) *qs = nxt;
               NSA_WAIT_BAR();
               k = __builtin_amdgcn_readfirstlane(*qs); }
    }
}
}

namespace p2 {
using nsa::bf16x8; using nsa::f32x16; using nsa::s16x4; using nsa::crow; using nsa::glds16; using nsa::cvtpk_s;
#define P2_WAIT_BAR() asm volatile("s_waitcnt vmcnt(0) lgkmcnt(0)\n\ts_barrier" ::: "memory")
constexpr int CB_BUF = 40960;
constexpr int CP_STRIDE = 65;
__device__ __forceinline__ void compress_unit(const Ptrs& P, LAS unsigned char* lds, int u, const int wave_s) {
    unsigned char* ws = P.ws;
    const int lane = fresh_lane(), r32 = lane & 31, hi = lane >> 5, wid = wave_s;
    const int kv = u >> 6, bg = (u >> 2) & 15, n0 = 64 * (u & 3);
    const bf16_t* Ag = (const bf16_t*)(ws + WS_KV6) + (size_t)kv * KVSZ + (size_t)bg * SEQ * 64 + (size_t)n0 * 1024;
    const bf16_t* Bg = (const bf16_t*)(ws + WS_W1C) + (size_t)kv * 256 * 2048;
    const unsigned lds0 = (unsigned)(uintptr_t)lds;
    const int drow = 8 * wid + (lane >> 3), dchk = (lane & 7) ^ ((drow >> 1) & 7);
    const unsigned aoff = (unsigned)(drow * 1024 + dchk * 8) * 2u, boff = (unsigned)(drow * 2048 + dchk * 8) * 2u;
    const unsigned dstw = lds0 + wid * 1024;
#define P2_DMA_TILE(kt, buf) do { const unsigned d_ = (unsigned)__builtin_amdgcn_readfirstlane(dstw + (buf) * CB_BUF); \
        glds16(Ag + (kt) * 64, aoff, d_); \
        _Pragma("unroll") for (int ct_ = 0; ct_ < 4; ++ct_) glds16(Bg + (size_t)ct_ * 64 * 2048 + (kt) * 64, boff, d_ + 8192u * (ct_ + 1)); } while (0)
    const int ct = wid >> 1, half = wid & 1, ncol0 = 64 * ct + 32 * half;
    f32x16 hT[2]; hT[0] = f32x16{}; hT[1] = f32x16{};
    P2_DMA_TILE(0, 0); P2_DMA_TILE(1, 1);
    asm volatile("s_waitcnt vmcnt(5) lgkmcnt(0)\n\ts_barrier" ::: "memory");
    for (int kt = 0; kt < 32; ++kt) {
        const int buf = kt % 3;
        if (kt + 2 < 32) P2_DMA_TILE(kt + 2, (kt + 2) % 3);
        LAS const char* sa = (LAS const char*)(lds + buf * CB_BUF) + r32 * 128;
        LAS const char* sb = (LAS const char*)(lds + buf * CB_BUF + 8192 * (ct + 1)) + (32 * half + r32) * 128;
        const int sw = (r32 >> 1) & 7;
#pragma unroll
        for (int d0 = 0; d0 < 4; ++d0) {
            const int co = ((2 * d0 + hi) ^ sw) * 16;
            const bf16x8 bf = *(LAS const bf16x8*)(sb + co), a0 = *(LAS const bf16x8*)(sa + co), a1 = *(LAS const bf16x8*)(sa + 4096 + co);
            hT[0] = __builtin_amdgcn_mfma_f32_32x32x16_bf16(bf, a0, hT[0], 0, 0, 0);
            hT[1] = __builtin_amdgcn_mfma_f32_32x32x16_bf16(bf, a1, hT[1], 0, 0, 0);
        }
        if (kt + 2 < 32) asm volatile("s_waitcnt vmcnt(5) lgkmcnt(0)\n\ts_barrier" ::: "memory");
        else asm volatile("s_waitcnt vmcnt(0) lgkmcnt(0)\n\ts_barrier" ::: "memory");
    }
    const float* bias1 = (const float*)(ws + WS_SMALL + SM_BIAS1) + kv * 256 + ncol0;
    bf16x8 hb[2][2];
#pragma unroll
    for (int mt = 0; mt < 2; ++mt) {
        float g[16];
#pragma unroll
        for (int r = 0; r < 16; ++r) g[r] = gelu_tanh(hT[mt][r] + bias1[crow(r, hi)]);
#pragma unroll
        for (int s = 0; s < 2; ++s) { u32x4_t w; w.x = cvtpk_s(g[8 * s], g[8 * s + 1]); w.y = cvtpk_s(g[8 * s + 2], g[8 * s + 3]); w.z = cvtpk_s(g[8 * s + 4], g[8 * s + 5]); w.w = cvtpk_s(g[8 * s + 6], g[8 * s + 7]);
            hb[mt][s] = __builtin_bit_cast(bf16x8, w); }
    }
    const bf16_t* w2t = (const bf16_t*)(ws + WS_SMALL + SM_W2T) + (size_t)kv * 64 * 256;
    f32x16 oT[2][2];
#pragma unroll
    for (int dt = 0; dt < 2; ++dt)
#pragma unroll
        for (int mt = 0; mt < 2; ++mt) oT[dt][mt] = f32x16{};
#pragma unroll
    for (int dt = 0; dt < 2; ++dt)
#pragma unroll
        for (int s = 0; s < 2; ++s) {
            const bf16_t* wp = w2t + (size_t)(32 * dt + r32) * 256 + ncol0 + 16 * s + 4 * hi;
            const u32x2_t lo = *(const u32x2_t*)wp, hi2 = *(const u32x2_t*)(wp + 8);
            const u32x4_t wv = {lo.x, lo.y, hi2.x, hi2.y}; const bf16x8 wf = __builtin_bit_cast(bf16x8, wv);
#pragma unroll
            for (int mt = 0; mt < 2; ++mt) oT[dt][mt] = __builtin_amdgcn_mfma_f32_32x32x16_bf16(wf, hb[mt][s], oT[dt][mt], 0, 0, 0);
        }
    LAS float* part = (LAS float*)lds + wid * 64 * CP_STRIDE;
#pragma unroll
    for (int dt = 0; dt < 2; ++dt)
#pragma unroll
        for (int mt = 0; mt < 2; ++mt)
#pragma unroll
            for (int r = 0; r < 16; ++r) part[(32 * mt + r32) * CP_STRIDE + 32 * dt + crow(r, hi)] = oT[dt][mt][r];
    P2_WAIT_BAR();
    {
        const int tid = wid * 64 + lane, m = tid >> 3, dg = tid & 7;
        float o[8];
#pragma unroll
        for (int e = 0; e < 8; ++e) { float s = 0.f;
#pragma unroll
            for (int w = 0; w < 8; ++w) s += ((LAS const float*)lds)[(w * 64 + m) * CP_STRIDE + 8 * dg + e];
            o[e] = s; }
        if (kv == 0) {
            float ss = 0.f;
#pragma unroll
            for (int e = 0; e < 8; ++e) ss += o[e] * o[e];
            ss += __shfl_xor(ss, 1); ss += __shfl_xor(ss, 2); ss += __shfl_xor(ss, 4);
            const float rr = __builtin_amdgcn_rsqf(ss * (1.0f / 64.0f) + 1e-6f);
#pragma unroll
            for (int e = 0; e < 8; ++e) o[e] *= rr * P.in[4][8 * dg + e];
        }
        const int n = n0 + m;
        u32x4_t v = {0u, 0u, 0u, 0u};
        if (n < 255) { v.x = cvtpk_s(o[0], o[1]); v.y = cvtpk_s(o[2], o[3]); v.z = cvtpk_s(o[4], o[5]); v.w = cvtpk_s(o[6], o[7]); }
        *(u32x4_t*)((bf16_t*)(ws + (kv ? WS_VC : WS_KC)) + ((size_t)bg * 256 + n) * 64 + 8 * dg) = v;
    }
    P2_WAIT_BAR();
#undef P2_DMA_TILE
}

constexpr int G_V = 0, G_ST = 32768, G_OST = 33792, G_END = 33792 + 65536;
struct GmlpIn { u32x4_t raw[4]; u32x4_t uraw[4]; float sbv[4]; };
__device__ __forceinline__ void gmlp_load(GmlpIn& in, const Ptrs& P, int unit, int tid, int lane, int r32, int hi, int wid) {
    unsigned char* ws = P.ws;
    const int g = unit & 7, chunk = (unit >> 3) & 31, b = unit >> 8; const int m0 = b * SEQ + chunk * 128;
    const bf16_t* GV = (const bf16_t*)(ws + WS_GV); const bf16_t* U = (const bf16_t*)(ws + WS_U);
    const int tb = wid >> 1, ch = wid & 1; (void)r32; (void)hi;
#pragma unroll
    for (int i = 0; i < 4; ++i) { const int idx = tid + 512 * i, s = idx >> 4, c8 = idx & 15; in.raw[i] = *(const u32x4_t*)(GV + (size_t)(m0 + s) * 1024 + g * 128 + 8 * c8); }
#pragma unroll
    for (int i = 0; i < 4; ++i) { const int row = i * 8 + (lane >> 3), t = 32 * tb + row; in.uraw[i] = *(const u32x4_t*)(U + (size_t)(m0 + t) * 1024 + g * 128 + 64 * ch + 8 * (lane & 7)); in.sbv[i] = P.in[11][g * 128 + t]; }
}
__device__ __forceinline__ void gmlp_compute(const GmlpIn& in, const f32x4_t (&sv)[8], const bf16x8 (&pa)[2][4], const f32x4_t w0, const f32x4_t w1, const f32x4_t b0, const f32x4_t b1, const Ptrs& P, LAS unsigned char* lds, int unit, int tid, int lane, int r32, int hi, int wid) {
    unsigned char* ws = P.ws;
    const int g = unit & 7, chunk = (unit >> 3) & 31, b = unit >> 8; const int m0 = b * SEQ + chunk * 128;
    bf16_t* AB = (bf16_t*)(ws + WS_AB);
    LAS float* st = (LAS float*)(lds + G_ST);
    const int tb = wid >> 1, ch = wid & 1;
    if (tid < 128) { float s1 = 0.f, s2 = 0.f;
#pragma unroll
        for (int i = 0; i < 8; ++i) { s1 += sv[i][0] + sv[i][2]; s2 += sv[i][1] + sv[i][3]; }
        const float mean = s1 * (1.0f / 1024.0f); float var = s2 * (1.0f / 1024.0f) - mean * mean; var = var < 0.f ? 0.f : var;
        st[2 * tid] = mean; st[2 * tid + 1] = __builtin_amdgcn_rsqf(var + 1e-5f); }
    asm volatile("s_waitcnt lgkmcnt(0)\n\ts_barrier" ::: "memory");
#pragma unroll
    for (int i = 0; i < 4; ++i) { const int idx = tid + 512 * i, s = idx >> 4, c8 = idx & 15;
        float f[8]; unpack8(in.raw[i], f);
        const float mean = st[2 * s], rstd = st[2 * s + 1];
        float y[8];
#pragma unroll
        for (int e = 0; e < 4; ++e) { y[e] = (f[e] - mean) * rstd * w0[e] + b0[e]; y[4 + e] = (f[4 + e] - mean) * rstd * w1[e] + b1[e]; }
        u32x4_t o; o.x = cvtpk_s(y[0], y[1]); o.y = cvtpk_s(y[2], y[3]); o.z = cvtpk_s(y[4], y[5]); o.w = cvtpk_s(y[6], y[7]);
        const int st_ = s >> 6, sk = s & 63, chh = c8 >> 3, x = c8 & 7;
        *(LAS u32x4_t*)(lds + G_V + (st_ * 2 + chh) * 8192 + (x >> 2) * 4096 + (sk >> 4) * 1024 + (sk & 15) * 64 + (x & 3) * 16) = o; }
    asm volatile("s_waitcnt lgkmcnt(0)\n\ts_barrier" ::: "memory");
    f32x16 o[2]; o[0] = f32x16{}; o[1] = f32x16{};
    const int vb0 = (int)((unsigned)(uintptr_t)lds + G_V) + ((lane >> 4) & 1) * 32 + (lane & 3) * 8 + (4 * hi + ((lane & 15) >> 2)) * 64;
    nsa::pv(o, vb0 + ch * 8192, pa[0][0], pa[0][1], pa[0][2], pa[0][3]);
    if (tb >= 2) nsa::pv(o, vb0 + (2 + ch) * 8192, pa[1][0], pa[1][1], pa[1][2], pa[1][3]);
    LAS float* ostg = (LAS float*)(lds + G_OST) + wid * 2048;
#pragma unroll
    for (int r = 0; r < 16; ++r) { const int orow = crow(r, hi);
#pragma unroll
        for (int d0 = 0; d0 < 2; ++d0) ostg[orow * 64 + d0 * 32 + r32] = o[d0][r]; }
    asm volatile("s_waitcnt lgkmcnt(0)" ::: "memory");
#pragma unroll
    for (int i = 0; i < 4; ++i) { const int row = i * 8 + (lane >> 3), c8 = lane & 7, t = 32 * tb + row;
        const f32x4_t v0 = *(LAS const f32x4_t*)(ostg + row * 64 + c8 * 8), v1 = *(LAS const f32x4_t*)(ostg + row * 64 + c8 * 8 + 4);
        const size_t grow = (size_t)(m0 + t); const int col = g * 128 + 64 * ch + 8 * c8;
        float uf[8]; unpack8(in.uraw[i], uf);
        const float sb_ = in.sbv[i];
        u32x4_t w; w.x = cvtpk_s(uf[0] * (v0[0] + sb_), uf[1] * (v0[1] + sb_)); w.y = cvtpk_s(uf[2] * (v0[2] + sb_), uf[3] * (v0[3] + sb_));
        w.z = cvtpk_s(uf[4] * (v1[0] + sb_), uf[5] * (v1[1] + sb_)); w.w = cvtpk_s(uf[6] * (v1[2] + sb_), uf[7] * (v1[3] + sb_));
        *(u32x4_t*)(AB + grow * 2048 + 1024 + col) = w; }
    asm volatile("s_waitcnt lgkmcnt(0)\n\ts_barrier" ::: "memory");
}
__device__ __forceinline__ void gmlp_run(const Ptrs& P, LAS unsigned char* lds, int u0, int stride, int nunits, const int wave_s) {
    const int lane = fresh_lane(), r32 = lane & 31, hi = lane >> 5, wid = wave_s, tid = wid * 64 + lane;
    GmlpIn A, B;
    int u = u0;
    bf16x8 pa[2][4];
    { const bf16_t* SWB = (const bf16_t*)(P.ws + WS_SMALL + SM_SWB) + (size_t)(u0 & 7) * 16384; const int tb = wid >> 1;
#pragma unroll
      for (int st_ = 0; st_ < 2; ++st_)
#pragma unroll
        for (int ks = 0; ks < 4; ++ks) {
            const bf16_t* wp = SWB + (size_t)(32 * tb + r32) * 128 + 64 * st_ + 16 * ks + 4 * hi;
            const u32x2_t lo = *(const u32x2_t*)wp, hi2 = *(const u32x2_t*)(wp + 8);
            const u32x4_t wv = {lo.x, lo.y, hi2.x, hi2.y}; pa[st_][ks] = __builtin_bit_cast(bf16x8, wv); } }
    const int c8v = tid & 15, g0 = u0 & 7;
    const f32x4_t w0 = *(const f32x4_t*)(P.in[8] + g0 * 128 + 8 * c8v), w1 = *(const f32x4_t*)(P.in[8] + g0 * 128 + 8 * c8v + 4), b0 = *(const f32x4_t*)(P.in[9] + g0 * 128 + 8 * c8v), b1 = *(const f32x4_t*)(P.in[9] + g0 * 128 + 8 * c8v + 4);
    const float* VSTAT = (const float*)(P.ws + WS_VSTAT);
#define GMLP_STATS(sv_, unit_) do { const int m0_ = ((unit_) >> 8) * SEQ + (((unit_) >> 3) & 31) * 128; const f32x4_t* p_ = (const f32x4_t*)(VSTAT + (size_t)(m0_ + (tid & 127)) * 32); \
        _Pragma("unroll") for (int i_ = 0; i_ < 8; ++i_) sv_[i_] = p_[i_]; } while (0)
    f32x4_t sv[8];
    if (u < nunits) gmlp_load(A, P, u, tid, lane, r32, hi, wid);
    while (u < nunits) {
        GMLP_STATS(sv, u);
        if (u + stride < nunits) gmlp_load(B, P, u + stride, tid, lane, r32, hi, wid);
        gmlp_compute(A, sv, pa, w0, w1, b0, b1, P, lds, u, tid, lane, r32, hi, wid);
        u += stride; if (u >= nunits) break;
        GMLP_STATS(sv, u);
        if (u + stride < nunits) gmlp_load(A, P, u + stride, tid, lane, r32, hi, wid);
        gmlp_compute(B, sv, pa, w0, w1, b0, b1, P, lds, u, tid, lane, r32, hi, wid);
        u += stride;
    }
#undef GMLP_STATS
    asm volatile("s_waitcnt vmcnt(0) lgkmcnt(0)\n\ts_barrier" ::: "memory");
}
#undef P2_WAIT_BAR
}

#define XB_TMO      128
#define XB_XCNT(j)  (256  + 64 * (j))
#define XB_XSUB(j)  (1280 + 64 * (j))
#define XB_XGEN(j)  (2304 + 64 * (j))
#define XB_TOP      3328
#define XB_TOPGEN   3392
#define XCD_BAR_WORDS 3456
#define XB_SPIN_CAP (1u << 18)

__device__ __forceinline__ unsigned xb_ld(unsigned* p)              { return __hip_atomic_load(p, __ATOMIC_RELAXED, __HIP_MEMORY_SCOPE_AGENT); }
__device__ __forceinline__ unsigned xb_add(unsigned* p, unsigned v) { return __hip_atomic_fetch_add(p, v, __ATOMIC_RELAXED, __HIP_MEMORY_SCOPE_AGENT); }
__device__ __forceinline__ unsigned xb_xcc_id() { return (unsigned)__builtin_amdgcn_s_getreg((3 << 11) | 20) & 0xFu; }
#define XB_SPIN(cond, bar) do { unsigned _sp = 0; while (cond) { __builtin_amdgcn_s_sleep(1); \
    if ((++_sp & 255u) == 0u) { if (xb_ld(&(bar)[XB_TMO])) break; if (_sp > XB_SPIN_CAP) { atomicAdd(&(bar)[XB_TMO], 1u); break; } } } } while (0)

struct XcdBarrier {
    unsigned* bar; unsigned x; unsigned w0;
    volatile LAS unsigned* st;
};

__device__ __forceinline__ XcdBarrier xcd_barrier_post(unsigned* bar, volatile LAS unsigned* st, int wave_s) {
    XcdBarrier b; b.bar = bar; b.x = xb_xcc_id(); b.st = st; b.w0 = wave_s == 0 ? 1u : 0u;
    if (b.w0 && fresh_lane() == 0) (void)xb_add(&bar[XB_XCNT(b.x)], 1u);
    return b;
}
__device__ __forceinline__ void xcd_barrier_complete(unsigned* bar, unsigned x, unsigned& nloc, unsigned& nx) {
    const unsigned G = gridDim.x * gridDim.y * gridDim.z;
    unsigned sum, cnt, mine, sp = 0u;
    for (;;) {
        sum = 0u; cnt = 0u; mine = 0u;
#pragma unroll
        for (unsigned j = 0; j < 16; ++j) { const unsigned c = xb_ld(&bar[XB_XCNT(j)]); sum += c; cnt += (c > 0u) ? 1u : 0u; mine = (j == x) ? c : mine; }
        if (sum == G) break;
        __builtin_amdgcn_s_sleep(1);
        if ((++sp & 255u) == 0u) { if (xb_ld(&bar[XB_TMO])) break; if (sp > XB_SPIN_CAP) { atomicAdd(&bar[XB_TMO], 1u); break; } }
    }
    nloc = mine > 0u ? mine : 1u; nx = cnt > 0u ? cnt : 1u;
}

__device__ __forceinline__ void xcd_barrier(const XcdBarrier& b) {
    asm volatile("s_waitcnt vmcnt(0)" ::: "memory");
    __syncthreads();
    if (b.w0 && fresh_lane() == 0) {
        unsigned* bar = b.bar;
        __builtin_amdgcn_s_waitcnt(0);
        unsigned nloc = b.st[0], nx = b.st[1];
        if (nloc == 0u) { xcd_barrier_complete(bar, b.x, nloc, nx); b.st[0] = nloc; b.st[1] = nx; }
        const unsigned old = xb_add(&bar[XB_XSUB(b.x)], 1u);
        const unsigned gen = old / nloc;
        if (old + 1u == (gen + 1u) * nloc) {
            __builtin_amdgcn_fence(__ATOMIC_RELEASE, "agent");
            asm volatile("s_waitcnt vmcnt(0)" ::: "memory");
            const unsigned og = xb_add(&bar[XB_TOP], 1u);
            const unsigned tg = og / nx;
            if (og + 1u == (tg + 1u) * nx) xb_add(&bar[XB_TOPGEN], 1u);
            else XB_SPIN(xb_ld(&bar[XB_TOPGEN]) == tg, bar);
            __builtin_amdgcn_fence(__ATOMIC_ACQUIRE, "agent");
            xb_add(&bar[XB_XGEN(b.x)], 1u);
            asm volatile("s_waitcnt vmcnt(0)" ::: "memory");
        } else {
            XB_SPIN(xb_ld(&bar[XB_XGEN(b.x)]) == gen, bar);
            __builtin_amdgcn_fence(__ATOMIC_ACQUIRE, "agent");
            asm volatile("s_waitcnt vmcnt(0)" ::: "memory");
        }
    }
    __syncthreads();
}

constexpr int LDS_BYTES = 152576;
constexpr int LDS_XCH = 132096;
constexpr int LDS_MISC = 145408;
__global__ void __launch_bounds__(512, 2) mega_fwd(Ptrs P) {
    extern __shared__ __attribute__((aligned(16))) unsigned char lds_raw[];
    LAS unsigned char* lds = (LAS unsigned char*)lds_raw;
    unsigned char* ws = P.ws;
    const int wave = __builtin_amdgcn_readfirstlane(threadIdx.x >> 6);
    const int G = gridDim.x, bid = blockIdx.x;
    if (wave == 0) { const int l_ = fresh_lane(); if (l_ < 2) ((LAS unsigned*)(lds + LDS_MISC))[l_] = 0u; }
    __syncthreads();
    const XcdBarrier bar = xcd_barrier_post(g_ctl, (volatile LAS unsigned*)(lds + LDS_MISC), wave);
    p0_prologue(P, lds, bid, G, wave);
    xcd_barrier(bar);
    if (bid == 0) bias1_stage(ws, fresh_tid(wave));
    {
        pg8::Gemm g{(const bf16_t*)(ws + WS_XN), (const bf16_t*)(ws + WS_WIN), MTOK, NPROJ, 2048, 2048};
        pg8::StaticOrder S; S.init(MTOK, NPROJ, G, bid);
        pg8::EpiProj E{(bf16_t*)(ws + WS_Q), (bf16_t*)(ws + WS_KV6), (bf16_t*)(ws + WS_U), (bf16_t*)(ws + WS_GV), (float*)(ws + WS_GATES), (float*)(ws + WS_VSTAT), P.in[3], P.in[4]};
        pg8::gemm_phase<pg8::EpiProj, pg8::StaticOrder, true, true>(lds, g, S, E, wave);
    }
    xcd_barrier(bar);
    if (bid < 128 && G >= 256) { p2::compress_unit(P, lds, bid, wave); if (G == 256) late_weight_chunk(P, lds, LW_CHUNKS - 128 + bid, wave); }
    else if (G >= 256) p2::gmlp_run(P, lds, bid - 128, G - 128, 1024, wave);
    xcd_barrier(bar);
    nsa::nsa_phase(P, lds, bid, G, wave);
    xcd_barrier(bar);
    {
        pg8::Gemm g{(const bf16_t*)(ws + WS_AB), (const bf16_t*)(ws + WS_WOUT), MTOK, 2048, 2048, 2048};
        pg8::StaticOrder S; S.init(MTOK, 2048, G, bid);
        pg8::EpiRes1 E{(const float*)(ws + WS_SMALL + SM_RINV), (const float*)(ws + WS_SMALL + SM_INVW), (bf16_t*)(ws + WS_XN), (float*)(ws + WS_SSQ)};
        pg8::gemm_phase<pg8::EpiRes1, pg8::StaticOrder, true, true>(lds, g, S, E, wave);
    }
    xcd_barrier(bar);
    {
        pg8::Gemm g{(const bf16_t*)(ws + WS_XN), (const bf16_t*)(ws + WS_WUP), MTOK, N_UP, 2048, 2048};
        pg8::StaticOrder S; S.init(MTOK, N_UP, G, bid);
        { pg8::Unit u0; (void)S.next(0, u0); const int t_ = fresh_tid(wave);
          if (t_ < 256) { const float* p = (const float*)(ws + WS_SSQ) + (size_t)(u0.pm * 256 + t_) * 32; float s = 0.f;
#pragma unroll
              for (int i = 0; i < 32; ++i) s += p[i];
              ((LAS float*)(lds + LDS_XCH))[4624 + t_] = __builtin_amdgcn_rsqf(s * (1.0f / D_MODEL) + 1e-6f); } }
        pg8::EpiUpConv E{(bf16_t*)(ws + WS_G), (const float*)(ws + WS_SMALL + SM_R2), P.in[15], P.in[16], (float*)(ws + WS_HLAST), (float*)(ws + WS_FIRST), lds + LDS_XCH};
        pg8::gemm_phase<pg8::EpiUpConv, pg8::StaticOrder, true, true>(lds, g, S, E, wave);
    }
    xcd_barrier(bar);
    { pg8::StaticOrder S7; S7.init(MTOK, 2048, G, bid); pg8::Unit u7; (void)S7.next(0, u7);
      const int pm = u7.pm;
      if ((pm & 15) != 0) {
        const float* cw = P.in[15];
        const int t0_ = fresh_tid(wave);
        f32x4_t L0g[3][2], L1g[3][2], L0u[3][2], L1u[3][2], W0g[3][2], W1g[3][2], W0u[3][2], W1u[3][2], Fg[3][2], Fu[3][2];
#pragma unroll
        for (int q3 = 0; q3 < 3; ++q3) { const int it = t0_ + 512 * q3; if (it < 44 * 2 * 16) {
            const int c8 = it & 15, row = (it >> 4) & 1, pn = it >> 5;
            const float* fp = (const float*)(ws + WS_FIRST) + ((size_t)(pm * 44 + pn) * 2 + row) * 256 + 8 * c8;
            const float* lp = (const float*)(ws + WS_HLAST) + ((size_t)((pm - 1) * 44 + pn) * 2) * 256 + 8 * c8;
            const int ch = pn * 128 + 8 * c8;
#pragma unroll
            for (int h = 0; h < 2; ++h) {
                L0g[q3][h] = *(const f32x4_t*)(lp + 4 * h); L1g[q3][h] = *(const f32x4_t*)(lp + 256 + 4 * h); L0u[q3][h] = *(const f32x4_t*)(lp + 128 + 4 * h); L1u[q3][h] = *(const f32x4_t*)(lp + 256 + 128 + 4 * h);
                W0g[q3][h] = *(const f32x4_t*)(cw + ch + 4 * h); W1g[q3][h] = *(const f32x4_t*)(cw + N_UP + ch + 4 * h); W0u[q3][h] = *(const f32x4_t*)(cw + D_FF + ch + 4 * h); W1u[q3][h] = *(const f32x4_t*)(cw + N_UP + D_FF + ch + 4 * h);
                Fg[q3][h] = *(const f32x4_t*)(fp + 4 * h); Fu[q3][h] = *(const f32x4_t*)(fp + 128 + 4 * h); } } }
#pragma unroll
        for (int q3 = 0; q3 < 3; ++q3) { const int it = t0_ + 512 * q3; if (it < 44 * 2 * 16) {
            const int c8 = it & 15, row = (it >> 4) & 1, pn = it >> 5, ch = pn * 128 + 8 * c8;
            float r[8];
#pragma unroll
            for (int e = 0; e < 8; ++e) { const int h = e >> 2, q = e & 3;
                const float l0g = L0g[q3][h][q], l1g = L1g[q3][h][q], l0u = L0u[q3][h][q], l1u = L1u[q3][h][q];
                const float w0g = W0g[q3][h][q], w1g = W1g[q3][h][q], w0u = W0u[q3][h][q], w1u = W1u[q3][h][q];
                const float cg = Fg[q3][h][q] + (row == 0 ? w1g * l1g + w0g * l0g : w0g * l1g), cu = Fu[q3][h][q] + (row == 0 ? w1u * l1u + w0u * l0u : w0u * l1u);
                r[e] = cg * sigmoidf_(cg) * cu; }
            u32x4_t o; o.x = pk2(r[0], r[1]); o.y = pk2(r[2], r[3]); o.z = pk2(r[4], r[5]); o.w = pk2(r[6], r[7]);
            *(u32x4_t*)((bf16_t*)(ws + WS_G) + (size_t)(pm * 256 + row) * D_FF + ch) = o; } }
      }
    }
    asm volatile("s_waitcnt vmcnt(0)" ::: "memory"); __syncthreads();
    {
        pg8::Gemm g{(const bf16_t*)(ws + WS_G), (const bf16_t*)(ws + WS_WDOWN), MTOK, 2048, D_FF, D_FF};
        pg8::StaticOrder S; S.init(MTOK, 2048, G, bid);
        pg8::EpiDown E{P.out, (const bf16_t*)(ws + WS_XN)};
        pg8::gemm_phase<pg8::EpiDown, pg8::StaticOrder, true, true>(lds, g, S, E, wave);
    }
    __syncthreads();
    { volatile LAS unsigned* fl = (volatile LAS unsigned*)(lds + LDS_MISC) + 2;
      if (threadIdx.x == 0) fl[0] = (xb_add(&g_ctl[CTL_EXIT], 1u) == (unsigned)G - 1u) ? 1u : 0u;
      __syncthreads();
      if (fl[0]) {
#pragma unroll
          for (int i = 0; i < 8; ++i) __hip_atomic_store(&g_ctl[threadIdx.x + 512 * i], 0u, __ATOMIC_RELAXED, __HIP_MEMORY_SCOPE_AGENT);
      } }
}

extern "C" void kernel_launch(void* const* d_in, const int* in_sizes, int n_in, void* d_out, int out_size, void* d_ws, size_t ws_size, hipStream_t stream) {
    static int grid_blocks = 0;
    if (!grid_blocks) {
        int dev = 0, cus = 0, per_cu = 0;
        (void)hipGetDevice(&dev);
        (void)hipDeviceGetAttribute(&cus, hipDeviceAttributeMultiprocessorCount, dev);
        (void)hipFuncSetAttribute((const void*)mega_fwd, hipFuncAttributeMaxDynamicSharedMemorySize, LDS_BYTES);
        (void)hipOccupancyMaxActiveBlocksPerMultiprocessor(&per_cu, (const void*)mega_fwd, 512, LDS_BYTES);
        if (per_cu < 1) { fprintf(stderr, "kernel_launch: occupancy query says %d blocks/CU\n", per_cu); per_cu = 1; }
        grid_blocks = cus * 1;
        (void)hipGetLastError();
    }
    if (n_in != 18 || ws_size < WS_END) { fprintf(stderr, "kernel_launch: unexpected n_in %d / ws %zu\n", n_in, ws_size); return; }
    Ptrs P{};
    for (int i = 0; i < 18; ++i) P.in[i] = (const float*)d_in[i];
    P.out = (float*)d_out; P.ws = (unsigned char*)d_ws;
    mega_fwd<<<dim3(grid_blocks), dim3(512), LDS_BYTES, stream>>>(P);
}
```
